# Optimizing an MI355X kernel written in HIP

```python
import math
import jax, jax.numpy as jnp
from jax import lax
import numpy as np

D_MODEL = 1024
BATCH = 8
SEQ = 8192
DEPTH = 2

N_META = 16
CHUNK = 128
N_PAD = (-N_META) % CHUNK

HEAD_DIM = 64
C_GRP = D_MODEL // 4
H_GRP = C_GRP // HEAD_DIM
D_MIX = 4 * C_GRP

RWKV_DECAY_LORA = 64
RWKV_AAA_LORA = 64
RWKV_GATE_LORA = 64
RWKV_LN_EPS = 64e-5
IDX_HEADS = 8
IDX_DIM = 32
INDEX_TOPK_MAX = 256
ROPE_THETA = 500000.0
ROPE_FRACTION = 4
CONV_WIDTH = 4
LRU_C = 8.0
LN_EPS = 1e-5
RMS_EPS = 1e-5
NEG_INF = -1e30
N_EXPERTS = 32
TOP_K = 4
D_EXPERT = D_MODEL
SWIGLU_ALPHA = 1.702
SWIGLU_LIMIT = 7.0
DEEPNORM_ALPHA = (2 * DEPTH) ** 0.25
DEEPNORM_BETA = (8 * DEPTH) ** -0.25

RWKV_COLS = (C_GRP, RWKV_DECAY_LORA, C_GRP, C_GRP, RWKV_AAA_LORA, RWKV_GATE_LORA)
DSA_COLS = (C_GRP, C_GRP, C_GRP, IDX_HEADS * IDX_DIM, IDX_DIM, IDX_HEADS)
LRU_COLS = (C_GRP, C_GRP)
HGRN_COLS = (C_GRP, C_GRP, C_GRP, C_GRP)
GROUP_COLS = (sum(RWKV_COLS), sum(DSA_COLS), sum(LRU_COLS), sum(HGRN_COLS))
N_IN = sum(GROUP_COLS)

kernel_name = 'hybrid_rwkv7_dsa_rglru_hgrn2_moe_trunk'


def _split(t, sizes):
    return jnp.split(t, np.cumsum(sizes)[:-1].tolist(), axis=-1)


def _layernorm(x, g, b):
    xf = x.astype(jnp.float32)
    mu = jnp.mean(xf, axis=-1, keepdims=True)
    var = jnp.mean(jnp.square(xf - mu), axis=-1, keepdims=True)
    return ((xf - mu) * lax.rsqrt(var + LN_EPS) * g + b).astype(x.dtype)


def _rope_partial(x, pos):
    d = x.shape[-1]
    rd = d // ROPE_FRACTION
    half = rd // 2
    inv_freq = ROPE_THETA ** (-jnp.arange(half, dtype=jnp.float32) / half)
    ang = pos.astype(jnp.float32)[:, None] * inv_freq[None, :]
    cos = jnp.cos(ang)[None, :, None, :]
    sin = jnp.sin(ang)[None, :, None, :]
    x1 = x[..., :half].astype(jnp.float32)
    x2 = x[..., half:rd].astype(jnp.float32)
    rot = jnp.concatenate([x1 * cos - x2 * sin, x1 * sin + x2 * cos], axis=-1).astype(x.dtype)
    return jnp.concatenate([rot, x[..., rd:]], axis=-1)


def _to_blocks(t):
    b, lp = t.shape[:2]
    return jnp.moveaxis(t.reshape((b, lp // CHUNK, CHUNK) + t.shape[2:]), 1, 0)


def _from_blocks(t):
    t = jnp.moveaxis(t, 0, 1)
    return t.reshape((t.shape[0], -1) + t.shape[3:])


def _pad_front(t):
    return jnp.pad(t, ((0, 0), (N_PAD, 0)) + ((0, 0),) * (t.ndim - 2))


def _rwkv7(p, mu, w0, w2, a0, a2, g2, k_k, k_a, r_k, ln_g, ln_b):
    f32 = jnp.float32
    B, L, _ = p.shape
    p_prev = jnp.pad(p, ((0, 0), (1, 0), (0, 0)))[:, :-1]
    p = p + (p_prev - p) * mu
    r, wd, k, v, ad, gd = _split(p, RWKV_COLS)
    w = -jax.nn.softplus(-(w0 + jnp.tanh(wd) @ w2).astype(f32)) - 0.5
    decay = jnp.exp(-jnp.exp(w))
    a = jax.nn.sigmoid((a0 + ad @ a2).astype(f32))
    g = (jax.nn.sigmoid(gd) @ g2).astype(f32)
    kf = k.astype(f32)
    kk = (kf * k_k).reshape(B, L, H_GRP, HEAD_DIM)
    kk = kk / jnp.maximum(jnp.linalg.norm(kk, axis=-1, keepdims=True), 1e-12)
    k_mod = kf * (1.0 + (a - 1.0) * k_a)
    hs = lambda t: t.astype(f32).reshape(B, L, H_GRP, HEAD_DIM)
    r_h, k_h, v_h, w_h, a_h = hs(r), hs(k_mod), hs(v), hs(decay), hs(a)
    a_vec = -kk
    b_vec = kk * a_h

    def step(S, inp):
        r_t, w_t, k_t, v_t, a_t, b_t = inp
        sa = jnp.einsum('bhvk,bhk->bhv', S, a_t)
        S = S * w_t[:, :, None, :] + sa[..., None] * b_t[:, :, None, :] + v_t[..., None] * k_t[:, :, None, :]
        return S, jnp.einsum('bhvk,bhk->bhv', S, r_t)

    xs = tuple(jnp.swapaxes(t, 0, 1) for t in (r_h, w_h, k_h, v_h, a_vec, b_vec))
    S0 = jnp.zeros((B, H_GRP, HEAD_DIM, HEAD_DIM), f32)
    _, y = lax.scan(step, S0, xs)
    y = jnp.swapaxes(y, 0, 1)
    y_mu = jnp.mean(y, axis=-1, keepdims=True)
    y_var = jnp.mean(jnp.square(y - y_mu), axis=-1, keepdims=True)
    y = ((y - y_mu) * lax.rsqrt(y_var + RWKV_LN_EPS)).reshape(B, L, C_GRP) * ln_g + ln_b
    bonus = jnp.sum(r_h * k_h * r_k, axis=-1, keepdims=True) * v_h
    y = y + bonus.reshape(B, L, C_GRP)
    return (y * g).astype(p.dtype)


def _dsa_attention(p, pos, topk):
    f32 = jnp.float32
    q, k, v, qi, ki, wi = _split(p, DSA_COLS)
    B, L, _ = q.shape
    q = _rope_partial(q.reshape(B, L, H_GRP, HEAD_DIM), pos)
    k = _rope_partial(k.reshape(B, L, H_GRP, HEAD_DIM), pos)
    v = v.reshape(B, L, H_GRP, HEAD_DIM)
    qi = _rope_partial(qi.reshape(B, L, IDX_HEADS, IDX_DIM), pos)
    ki = _rope_partial(ki[:, :, None, :], pos)[:, :, 0]
    wi = wi.astype(f32) * (IDX_HEADS ** -0.5 * IDX_DIM ** -0.5)
    q, k, v, qi, ki, wi = (_pad_front(t) for t in (q, k, v, qi, ki, wi))
    key_pos = jnp.arange(L + N_PAD, dtype=jnp.int32) - N_PAD
    ki32 = ki.astype(f32)
    bidx = jnp.arange(B)[:, None, None]

    def attend_block(blk):
        qb, qib, wib, qpos = blk
        s_idx = jax.nn.relu(jnp.einsum('bqhd,bsd->bqhs', qib.astype(f32), ki32))
        s_idx = jnp.einsum('bqhs,bqh->bqs', s_idx, wib)
        visible = (key_pos[None, :] <= qpos[:, None]) & (key_pos[None, :] >= 0)
        s_idx = jnp.where(visible[None], s_idx, NEG_INF)
        _, sel = lax.top_k(s_idx, topk)
        k_sel = k[bidx, sel].astype(f32)
        v_sel = v[bidx, sel].astype(f32)
        sel_pos = key_pos[sel]
        valid = (sel_pos <= qpos[None, :, None]) & (sel_pos >= 0)
        s = jnp.einsum('bqhd,bqkhd->bqhk', qb.astype(f32), k_sel) * (HEAD_DIM ** -0.5)
        s = jnp.where(valid[:, :, None, :], s, NEG_INF)
        return jnp.einsum('bqhk,bqkhd->bqhd', jax.nn.softmax(s, axis=-1), v_sel)

    out = lax.map(attend_block, (_to_blocks(q), _to_blocks(qi), _to_blocks(wi), key_pos.reshape(-1, CHUNK)))
    return _from_blocks(out)[:, N_PAD:].reshape(B, L, C_GRP).astype(p.dtype)


def _rglru(p, conv_w, conv_b, wa, ba, wx, bx, lam):
    f32 = jnp.float32
    xb, gate = _split(p, LRU_COLS)
    B, L, C = xb.shape
    xc = lax.conv_general_dilated(xb, conv_w[:, None, :].astype(xb.dtype), window_strides=(1,),
                                  padding=[(CONV_WIDTH - 1, 0)], dimension_numbers=('NWC', 'WIO', 'NWC'),
                                  feature_group_count=C) + conv_b
    xh = xc.reshape(B, L, H_GRP, HEAD_DIM)
    r = jax.nn.sigmoid((jnp.einsum('blhi,hij->blhj', xh, wa).reshape(B, L, C) + ba).astype(f32))
    i = jax.nn.sigmoid((jnp.einsum('blhi,hij->blhj', xh, wx).reshape(B, L, C) + bx).astype(f32))
    log_a = -LRU_C * r * jax.nn.softplus(-lam.astype(f32))
    a = jnp.exp(log_a)
    u = xc.astype(f32) * i * jnp.sqrt(-jnp.expm1(2.0 * log_a))

    def combine(e1, e2):
        a1, b1 = e1
        a2, b2 = e2
        return a1 * a2, a2 * b1 + b2

    _, h = lax.associative_scan(combine, (a, u), axis=1)
    return (h * jax.nn.gelu(gate.astype(f32))).astype(p.dtype)


def _hgrn2(p, lb, norm_g):
    f32 = jnp.float32
    q, fz, i, g = _split(p, HGRN_COLS)
    B, L, _ = q.shape
    lb = lb.astype(f32)
    z = fz.astype(f32)
    log_f = jnp.log(lb + (1.0 - lb) * jax.nn.sigmoid(z))
    k = (1.0 - lb) * jax.nn.sigmoid(-z)
    hs = lambda t: _pad_front(t.astype(f32).reshape(B, L, H_GRP, HEAD_DIM))
    qb, kb, vb, fb = (_to_blocks(hs(t)) for t in (jax.nn.silu(q.astype(f32)), k, i, log_f))
    tri = jnp.tril(jnp.ones((CHUNK, CHUNK), bool))[None, :, :, None, None]

    def chunk_step(S, inp):
        qc, kc, vc, lfc = inp
        bc = jnp.cumsum(lfc, axis=1)
        o = jnp.einsum('bthk,bhkv->bthv', qc * jnp.exp(bc), S)
        decay = jnp.exp(jnp.where(tri, bc[:, :, None] - bc[:, None, :], -jnp.inf))
        A = jnp.einsum('bthk,bshk,btshk->bths', qc, kc, decay)
        o = o + jnp.einsum('bths,bshv->bthv', A, vc)
        b_last = bc[:, -1]
        S = jnp.exp(b_last)[..., None] * S + jnp.einsum('bshk,bshv->bhkv', kc * jnp.exp(b_last[:, None] - bc), vc)
        return S, o

    S0 = jnp.zeros((B, H_GRP, HEAD_DIM, HEAD_DIM), f32)
    _, o = lax.scan(chunk_step, S0, (qb, kb, vb, fb))
    o = _from_blocks(o)[:, N_PAD:]
    o = o * lax.rsqrt(jnp.mean(o * o, axis=-1, keepdims=True) + RMS_EPS)
    o = o.reshape(B, L, C_GRP) * norm_g * jax.nn.silu(g.astype(f32))
    return o.astype(p.dtype)


def _moe(h, router_w, router_b, w1, b1, w2, b2):
    B, L, D = h.shape
    tok = h.reshape(B * L, D)
    logits = (tok @ router_w + router_b).astype(jnp.float32)
    top_val, top_idx = lax.top_k(logits, TOP_K)
    top_w = jax.nn.softmax(top_val, axis=-1)
    gates = jnp.sum(jax.nn.one_hot(top_idx, N_EXPERTS, dtype=jnp.float32) * top_w[..., None], axis=1)
    y = jnp.zeros((B * L, D), jnp.float32)
    for e in range(N_EXPERTS):
        u = (tok @ w1[e] + b1[e]).astype(jnp.float32)
        glu = jnp.minimum(u[:, :D_EXPERT], SWIGLU_LIMIT)
        lin = jnp.clip(u[:, D_EXPERT:], -SWIGLU_LIMIT, SWIGLU_LIMIT)
        act = glu * jax.nn.sigmoid(SWIGLU_ALPHA * glu) * (lin + 1.0)
        y = y + gates[:, e:e + 1] * (act.astype(h.dtype) @ w2[e] + b2[e]).astype(jnp.float32)
    return y.reshape(B, L, D).astype(h.dtype)


def setup_inputs(seed: int = 0) -> dict:
    key = jax.random.key(seed)
    ks = iter(jax.random.split(key, 48))
    f32 = jnp.float32

    def nrm(shape, scale):
        return scale * jax.random.normal(next(ks), shape, f32)

    def unif(shape, lo, hi):
        return jax.random.uniform(next(ks), shape, f32, lo, hi)

    Dp = DEPTH
    lru_a = unif((Dp, C_GRP), 0.9, 0.999) ** (1.0 / LRU_C)
    return {
        'x': nrm((BATCH, SEQ, D_MODEL), 1.0),
        'meta_tokens': nrm((N_META, D_MODEL), 1.0),
        'ln_in_g': 1.0 + nrm((D_MODEL,), 0.02),
        'ln_in_b': nrm((D_MODEL,), 0.02),
        'w_in': nrm((Dp, D_MODEL, N_IN), D_MODEL ** -0.5),
        'rwkv_mu': unif((Dp, GROUP_COLS[0]), 0.0, 1.0),
        'rwkv_w0': unif((Dp, C_GRP), -6.0, 0.0),
        'rwkv_w2': nrm((Dp, RWKV_DECAY_LORA, C_GRP), 0.1),
        'rwkv_a0': nrm((Dp, C_GRP), 0.5),
        'rwkv_a2': nrm((Dp, RWKV_AAA_LORA, C_GRP), 0.1),
        'rwkv_g2': nrm((Dp, RWKV_GATE_LORA, C_GRP), RWKV_GATE_LORA ** -0.5),
        'rwkv_k_k': 0.85 + nrm((Dp, C_GRP), 0.05),
        'rwkv_k_a': 1.0 + nrm((Dp, C_GRP), 0.05),
        'rwkv_r_k': nrm((Dp, H_GRP, HEAD_DIM), 0.1),
        'rwkv_ln_g': 1.0 + nrm((Dp, C_GRP), 0.02),
        'rwkv_ln_b': nrm((Dp, C_GRP), 0.02),
        'lru_conv_w': nrm((Dp, CONV_WIDTH, C_GRP), CONV_WIDTH ** -0.5),
        'lru_conv_b': nrm((Dp, C_GRP), 0.02),
        'lru_wa': nrm((Dp, H_GRP, HEAD_DIM, HEAD_DIM), HEAD_DIM ** -0.5),
        'lru_ba': nrm((Dp, C_GRP), 0.02),
        'lru_wx': nrm((Dp, H_GRP, HEAD_DIM, HEAD_DIM), HEAD_DIM ** -0.5),
        'lru_bx': nrm((Dp, C_GRP), 0.02),
        'lru_lambda': jnp.log(lru_a) - jnp.log1p(-lru_a),
        'hgrn_lower_bounds': 1.0 + nrm((Dp, C_GRP), 0.1),
        'hgrn_norm_g': 1.0 + nrm((Dp, C_GRP), 0.02),
        'w_out': nrm((Dp, D_MIX, D_MODEL), DEEPNORM_BETA * D_MIX ** -0.5),
        'ln_mix_g': 1.0 + nrm((Dp, D_MODEL), 0.02),
        'ln_mix_b': nrm((Dp, D_MODEL), 0.02),
        'router_w': nrm((Dp, D_MODEL, N_EXPERTS), D_MODEL ** -0.5),
        'router_b': nrm((Dp, N_EXPERTS), 0.01),
        'moe_w1': nrm((Dp, N_EXPERTS, D_MODEL, 2 * D_EXPERT), D_MODEL ** -0.5),
        'moe_b1': nrm((Dp, N_EXPERTS, 2 * D_EXPERT), 0.01),
        'moe_w2': nrm((Dp, N_EXPERTS, D_EXPERT, D_MODEL), DEEPNORM_BETA * D_EXPERT ** -0.5),
        'moe_b2': nrm((Dp, N_EXPERTS, D_MODEL), 0.01),
        'ln_ffn_g': 1.0 + nrm((Dp, D_MODEL), 0.02),
        'ln_ffn_b': nrm((Dp, D_MODEL), 0.02),
    }


def reference(x, meta_tokens, ln_in_g, ln_in_b, w_in, rwkv_mu, rwkv_w0, rwkv_w2, rwkv_a0, rwkv_a2,
              rwkv_g2, rwkv_k_k, rwkv_k_a, rwkv_r_k, rwkv_ln_g, rwkv_ln_b, lru_conv_w, lru_conv_b,
              lru_wa, lru_ba, lru_wx, lru_bx, lru_lambda, hgrn_lower_bounds, hgrn_norm_g, w_out,
              ln_mix_g, ln_mix_b, router_w, router_b, moe_w1, moe_b1, moe_w2, moe_b2,
              ln_ffn_g, ln_ffn_b):
    B, S, D = x.shape
    topk = min(INDEX_TOPK_MAX, S // 4)
    L = S + N_META
    pos = jnp.arange(L, dtype=jnp.int32)
    h = jnp.concatenate([jnp.broadcast_to(meta_tokens[None].astype(x.dtype), (B, N_META, D)), x], axis=1)
    h = _layernorm(h, ln_in_g, ln_in_b)
    s_lb = jax.nn.softmax(hgrn_lower_bounds.astype(jnp.float32), axis=0)
    lower_bounds = jnp.cumsum(s_lb, axis=0) - s_lb[0]
    for l in range(DEPTH):
        proj = h @ w_in[l]
        p_rwkv, p_dsa, p_lru, p_hgrn = _split(proj, GROUP_COLS)
        y_rwkv = _rwkv7(p_rwkv, rwkv_mu[l], rwkv_w0[l], rwkv_w2[l], rwkv_a0[l], rwkv_a2[l], rwkv_g2[l],
                        rwkv_k_k[l], rwkv_k_a[l], rwkv_r_k[l], rwkv_ln_g[l], rwkv_ln_b[l])
        y_dsa = _dsa_attention(p_dsa, pos, topk)
        y_lru = _rglru(p_lru, lru_conv_w[l], lru_conv_b[l], lru_wa[l], lru_ba[l], lru_wx[l], lru_bx[l],
                       lru_lambda[l])
        y_hgrn = _hgrn2(p_hgrn, lower_bounds[l], hgrn_norm_g[l])
        mix = jnp.concatenate([y_rwkv, y_dsa, y_lru, y_hgrn], axis=-1) @ w_out[l]
        h = _layernorm(DEEPNORM_ALPHA * h + mix, ln_mix_g[l], ln_mix_b[l])
        ffn = _moe(h, router_w[l], router_b[l], moe_w1[l], moe_b1[l], moe_w2[l], moe_b2[l])
        h = _layernorm(DEEPNORM_ALPHA * h + ffn, ln_ffn_g[l], ln_ffn_b[l])
    return h[:, N_META:]
```

```cpp
#include <hip/hip_runtime.h>
#include <cstdio>
#include <cstdint>
#include <cstring>

#ifndef MK_ONE_LAUNCH
#define MK_ONE_LAUNCH 0
#endif

#ifndef PHASE_FN
#define PHASE_FN __forceinline__
#endif
#define GAS __attribute__((address_space(1)))
#define LAS __attribute__((address_space(3)))
typedef unsigned short bf16;
typedef unsigned v4u __attribute__((ext_vector_type(4)));
typedef unsigned v2u __attribute__((ext_vector_type(2)));
typedef float v4f __attribute__((ext_vector_type(4)));
typedef float v2f __attribute__((ext_vector_type(2)));

constexpr int NB = 8, SEQ = 8192, NMETA = 16, L = SEQ + NMETA  , T = NB * L  , TP = 65792  , D = 1024;
constexpr int NINP = 3584;
constexpr int NE = 32, TOPK = 4;
constexpr int RMAX = 1058 * 256;
constexpr int C_RW = 0, C_RW_R = 0, C_RW_WD = 256, C_RW_K = 320, C_RW_V = 576, C_RW_AD = 832, C_RW_GD = 896;
constexpr int C_DS_Q = 960, C_DS_K = 1216, C_DS_V = 1472, C_DS_QI = 1728, C_DS_KI = 1984, C_DS_WI = 2016;
constexpr int C_LR_X = 2024, C_LR_G = 2280;
constexpr int C_HG_Q = 2536, C_HG_F = 2792, C_HG_I = 3048, C_HG_G = 3304;
constexpr float ALPHA = 1.41421356237f;
constexpr float LN_EPS = 1e-5f;

constexpr size_t MiB = 1u << 20;
constexpr size_t WS_CTL = 0, CTL_ZERO_BYTES = 1 * MiB;
constexpr size_t WS_WIN = 2 * MiB;
constexpr size_t WS_WOUT = 16 * MiB;
constexpr size_t WS_W1 = 20 * MiB;
constexpr size_t WS_W2 = 276 * MiB;
constexpr size_t WS_H = 404 * MiB;
constexpr size_t WS_HB = 661 * MiB;
constexpr size_t WS_BIG = 790 * MiB;
constexpr size_t WS_PROJ = WS_BIG;
constexpr size_t SZ_HM32 = (size_t)32 * L * 64 * 4;
constexpr size_t SZ_HM16 = SZ_HM32 / 2;
constexpr size_t SZ_TM16 = (size_t)T * 256 * 2;
constexpr size_t WS_RW_W = 1240 * MiB;
constexpr size_t WS_RW_A = WS_RW_W + SZ_HM32, WS_RW_B = WS_RW_A + SZ_HM16, WS_RW_K = WS_RW_B + SZ_HM16, WS_RW_WR = WS_RW_K + SZ_HM16, WS_RW_V = WS_RW_WR + SZ_HM16;
constexpr size_t WS_RW_G = WS_RW_V + SZ_HM16;
constexpr size_t WS_RW_SC = WS_RW_G + SZ_TM16;
constexpr size_t WS_DS_Q = WS_RW_SC + (size_t)32 * L * 16;
constexpr size_t WS_DS_K = WS_DS_Q + SZ_TM16, WS_DS_V = WS_DS_K + SZ_TM16, WS_DS_QI = WS_DS_V + SZ_TM16;
constexpr size_t WS_DS_KI = WS_DS_QI + SZ_TM16;
constexpr size_t WS_DS_WI = WS_DS_KI + (size_t)T * 64;
constexpr size_t WS_LR_A = WS_DS_WI + (size_t)T * 32;
constexpr size_t WS_LR_U = WS_LR_A + (size_t)T * 1024, WS_LR_G = WS_LR_U + SZ_TM16;
constexpr size_t WS_HG_F = WS_LR_G + SZ_TM16;
constexpr size_t WS_HG_K = WS_HG_F + SZ_HM32, WS_HG_Q = WS_HG_K + SZ_HM16, WS_HG_V = WS_HG_Q + SZ_HM16, WS_HG_G = WS_HG_V + SZ_HM16;
constexpr size_t WS_MIX_END = WS_HG_G + SZ_TM16;
constexpr size_t SZ_SORT = (size_t)RMAX * 1024 * 2;
constexpr size_t WS_SORTA = WS_BIG, WS_YBUF = WS_BIG, WS_ACT = WS_BIG + SZ_SORT;
constexpr size_t WS_TIDX = WS_ACT + SZ_SORT;
constexpr size_t WS_TGATE = WS_TIDX + (size_t)T * 16;
constexpr size_t WS_SPOS = WS_TGATE + (size_t)T * 16;
constexpr size_t WS_GSORT = WS_SPOS + (size_t)T * 16;
constexpr size_t WS_MOE_END = WS_GSORT + (size_t)RMAX * 4;
constexpr size_t WS_END = 2040 * MiB;
static_assert(WS_MIX_END <= WS_END && WS_MOE_END <= WS_END, "workspace map");
static_assert(WS_PROJ + (size_t)TP * NINP * 2 <= WS_RW_W, "proj vs prep");
static_assert(WS_HB + (size_t)TP * 1024 * 2 <= WS_BIG && WS_H + (size_t)TP * 4096 <= WS_HB, "h/hb");

constexpr int CW_TMO = 0, CW_CODE = 1;
constexpr int CW_BAR = 4096;
constexpr int CW_DSAQ = 8192;
constexpr int CW_ECNT = 8448;
constexpr int CW_ECUR = 8704;

constexpr int LDS_BYTES = 163840;
constexpr int MISC_OFF = 155648;
constexpr int MI_BAR = 0, MI_HIST = 64, MI_LCUR = 192, MI_LBASE = 320, MI_NT = 448, MI_OFFS = 512, MI_TILE = 1024;
constexpr int NWAVES = 8, NTHR = 512;

__device__ __forceinline__ float bf2f(unsigned short x) { return __uint_as_float((unsigned)x << 16); }
__device__ __forceinline__ float bflo(unsigned x) { return __uint_as_float(x << 16); }
__device__ __forceinline__ float bfhi(unsigned x) { return __uint_as_float(x & 0xffff0000u); }
__device__ __forceinline__ unsigned pk2(float lo, float hi) { unsigned r; asm volatile("v_cvt_pk_bf16_f32 %0, %1, %2" : "=v"(r) : "v"(lo), "v"(hi)); return r; }
__device__ __forceinline__ bf16 f2bf(float f) { return (bf16)(pk2(f, 0.f) & 0xffffu); }
__device__ __forceinline__ v4f ld_bf4(const bf16* p) { const v2u x = *(const v2u*)p; return (v4f){bflo(x.x), bfhi(x.x), bflo(x.y), bfhi(x.y)}; }
__device__ __forceinline__ void st_bf4(bf16* p, v4f v) { v2u o; o.x = pk2(v.x, v.y); o.y = pk2(v.z, v.w); *(v2u*)p = o; }
__device__ __forceinline__ float wave_sum(float v) {
#pragma unroll
    for (int o = 1; o < 64; o <<= 1) v += __shfl_xor(v, o);
    return v;
}
__device__ __forceinline__ float wave_max(float v) {
#pragma unroll
    for (int o = 1; o < 64; o <<= 1) v = fmaxf(v, __shfl_xor(v, o));
    return v;
}
template <int CTRL> __device__ __forceinline__ float dpp_f(float x) { return __int_as_float(__builtin_amdgcn_update_dpp(0, __float_as_int(x), CTRL, 0xF, 0xF, true)); }
__device__ __forceinline__ float sum8(float x) { x += dpp_f<0xB1>(x); x += dpp_f<0x4E>(x); x += dpp_f<0x141>(x); return x; }
__device__ __forceinline__ float sum16(float x) { x = sum8(x); x += dpp_f<0x140>(x); return x; }
__device__ __forceinline__ float sigmoidf_(float x) { return 1.f / (1.f + __expf(-x)); }
__device__ __forceinline__ float softplusf_(float x) { return x > 20.f ? x : log1pf(__expf(x)); }
__device__ __forceinline__ float gelu_tanh(float x) { const float u = 0.7978845608028654f * (x + 0.044715f * x * x * x); return 0.5f * x * (1.f + tanhf(u)); }
__device__ __forceinline__ int lds_add(LAS int* p, int v) { return __hip_atomic_fetch_add(p, v, __ATOMIC_RELAXED, __HIP_MEMORY_SCOPE_WORKGROUP); }
#define LDS_WAIT() asm volatile("s_waitcnt lgkmcnt(0)" ::: "memory")
#define VM_WAIT() asm volatile("s_waitcnt vmcnt(0)" ::: "memory")

__device__ __forceinline__ unsigned char* launder(unsigned char* p) { asm volatile("" : "+s"(p)); return p; }
__device__ __forceinline__ int opaque_tid() { int t = (int)threadIdx.x; asm volatile("" : "+v"(t)); return t; }
struct Args { const float* in[36]; float* out; unsigned char* ws; int ph_lo, ph_hi; };
struct Ctx { const float* const* in; float* out; unsigned char* ws; };
namespace pg8 {
#define PG8_LAS __attribute__((address_space(3)))
typedef unsigned short bf16_t;
typedef short bf16x8 __attribute__((ext_vector_type(8)));
typedef float f32x4 __attribute__((ext_vector_type(4)));
typedef unsigned u32x4 __attribute__((ext_vector_type(4)));
constexpr int BM = 256, BK = 64, HALF = 128, HTB = HALF * BK * 2  , STAGE_BYTES = 8 * HTB, NXCD = 8, WGM = 8;

__host__ __device__ __forceinline__ int lds_byte(int r, int c) { const int st = (r >> 4) * 2 + (c >> 5), rr = r & 15, cc = c & 31, ob = rr * 64 + cc * 2; return st * 1024 + (ob ^ (((ob >> 9) & 1) << 5)); }
__host__ __device__ __forceinline__ void stage_rc(int b, int& R, int& C) { const int st = b / 1024, sb = b % 1024, swz = sb ^ (((sb >> 9) & 1) << 5); R = (st >> 1) * 16 + swz / 64; C = (st & 1) * 32 + (swz % 64) / 2; }
__host__ __device__ __forceinline__ int perm32(int rho) { const int n = rho >> 4, i = rho & 15; return 8 * (i >> 2) + 4 * n + (i & 3); }

struct Unit { int pm, pn; };
struct Gemm { const bf16_t* A; const bf16_t* Bt; int M, N, K; };

struct StaticOrder {
    int nM, nN, nwg, G, c;
    __host__ __device__ void init(int M, int N, int G_, int c_) { nM = M / BM; nN = N / BM; nwg = nM * nN; G = G_; c = c_; }
    __host__ __device__ bool next(int i, Unit& u) const {
        const long L = (long)i * G + c; if (L >= nwg) return false;
        int wgid = (int)L; { const int q = nwg / NXCD, r = nwg % NXCD, xcd = wgid % NXCD, off = wgid / NXCD; wgid = (xcd < r ? xcd * (q + 1) : r * (q + 1) + (xcd - r) * q) + off; }
        const int nig = WGM * nN, gid = wgid / nig, fm = gid * WGM, gsz = (nM - fm) < WGM ? (nM - fm) : WGM;
        u.pm = fm + ((wgid % nig) % gsz); u.pn = (wgid % nig) / gsz; return true;
    }
    __device__ __forceinline__ void a_ready(const Unit&) const {}
    __device__ __forceinline__ void done(const Unit&) const {}
};

__device__ __forceinline__ unsigned cvt_pk_bf16(float lo, float hi) { unsigned r; asm volatile("v_cvt_pk_bf16_f32 %0, %1, %2" : "=v"(r) : "v"(lo), "v"(hi)); return r; }
typedef float f32x2 __attribute__((ext_vector_type(2)));
typedef unsigned u32x2v __attribute__((ext_vector_type(2)));
struct EpiStoreBf16 {
    static constexpr bool PERM = true, AFTER_DRAIN = false;
    bf16_t* O; int ldc;
    __device__ __forceinline__ void operator()(const f32x4 (&acc)[2][2][4][2], const Unit& u, int wr, int wc, int fr, int fq) const {
        const int row0 = u.pm * BM + wr * 64 + fr, col0 = u.pn * BM + wc * 32 + 8 * fq;
#pragma unroll
        for (int ai = 0; ai < 2; ++ai)
#pragma unroll
            for (int m = 0; m < 4; ++m) { bf16_t* rowp = O + (size_t)(row0 + ai * HALF + m * 16) * ldc + col0;
#pragma unroll
                for (int bj = 0; bj < 2; ++bj) { const f32x4 v0 = acc[ai][bj][m][0], v1 = acc[ai][bj][m][1];
                    u32x4 w; w.x = cvt_pk_bf16(v0[0], v0[1]); w.y = cvt_pk_bf16(v0[2], v0[3]); w.z = cvt_pk_bf16(v1[0], v1[1]); w.w = cvt_pk_bf16(v1[2], v1[3]);
                    *(u32x4*)(rowp + bj * HALF) = w; } }
    }
};
struct EpiResid {
    static constexpr bool PERM = false, AFTER_DRAIN = false;
    float* Hres; int ldc; float alpha;
    __device__ __forceinline__ void operator()(const f32x4 (&acc)[2][2][4][2], const Unit& u, int wr, int wc, int fr, int fq) const {
        const int row0 = u.pm * BM + wr * 64 + fr, col0 = u.pn * BM + wc * 32 + 4 * fq;
#pragma unroll
        for (int ai = 0; ai < 2; ++ai)
#pragma unroll
            for (int m = 0; m < 4; ++m) { float* rowp = Hres + (size_t)(row0 + ai * HALF + m * 16) * ldc + col0;
#pragma unroll
                for (int bj = 0; bj < 2; ++bj)
#pragma unroll
                    for (int n = 0; n < 2; ++n) { f32x4* p = (f32x4*)(rowp + bj * HALF + n * 16); const f32x4 old = *p; *p = old * alpha + acc[ai][bj][m][n]; } }
    }
};
struct EpiSwiGLU {
    static constexpr bool PERM = true, AFTER_DRAIN = false;
    bf16_t* ACT; const float* b1;
    __device__ __forceinline__ void operator()(const f32x4 (&acc)[2][2][4][2], const Unit& u, int wr, int wc, int fr, int fq) const {
        const int e = u.pn >> 3, pnl = u.pn & 7;
        const int row0 = u.pm * BM + wr * 64 + fr, c8 = pnl * 128 + wc * 32 + 8 * fq;
        const float* bg = b1 + (size_t)e * 2048 + c8; const float* bl = bg + 1024;
        const f32x4 bg0 = *(const f32x4*)bg, bg1 = *(const f32x4*)(bg + 4), bl0 = *(const f32x4*)bl, bl1 = *(const f32x4*)(bl + 4);
#pragma unroll
        for (int ai = 0; ai < 2; ++ai)
#pragma unroll
            for (int m = 0; m < 4; ++m) {
                float o[8];
#pragma unroll
                for (int n = 0; n < 2; ++n) { const f32x4 g4 = acc[ai][0][m][n] + (n ? bg1 : bg0), l4 = acc[ai][1][m][n] + (n ? bl1 : bl0);
#pragma unroll
                    for (int j = 0; j < 4; ++j) { const float glu = fminf(g4[j], 7.f), lin = fminf(fmaxf(l4[j], -7.f), 7.f);
                        o[n * 4 + j] = glu * (1.f / (1.f + __expf(-1.702f * glu))) * (lin + 1.f); } }
                u32x4 w; w.x = cvt_pk_bf16(o[0], o[1]); w.y = cvt_pk_bf16(o[2], o[3]); w.z = cvt_pk_bf16(o[4], o[5]); w.w = cvt_pk_bf16(o[6], o[7]);
                *(u32x4*)(ACT + (size_t)(row0 + ai * HALF + m * 16) * 1024 + c8) = w; }
    }
};
struct EpiMoeOut {
    static constexpr bool PERM = true, AFTER_DRAIN = false;
    bf16_t* Y; const float* b2; const float* gate;
    __device__ __forceinline__ void operator()(const f32x4 (&acc)[2][2][4][2], const Unit& u, int wr, int wc, int fr, int fq) const {
        const int e = u.pn >> 2, pnl = u.pn & 3;
        const int row0 = u.pm * BM + wr * 64 + fr, c8 = pnl * 256 + wc * 32 + 8 * fq;
        const float* bb = b2 + (size_t)e * 1024 + c8;
        f32x4 bv[2][2];
#pragma unroll
        for (int bj = 0; bj < 2; ++bj) { bv[bj][0] = *(const f32x4*)(bb + bj * HALF); bv[bj][1] = *(const f32x4*)(bb + bj * HALF + 4); }
#pragma unroll
        for (int ai = 0; ai < 2; ++ai)
#pragma unroll
            for (int m = 0; m < 4; ++m) { const int row = row0 + ai * HALF + m * 16; const float gt = gate[row];
#pragma unroll
                for (int bj = 0; bj < 2; ++bj) { const f32x4 v0 = (acc[ai][bj][m][0] + bv[bj][0]) * gt, v1 = (acc[ai][bj][m][1] + bv[bj][1]) * gt;
                    u32x4 w; w.x = cvt_pk_bf16(v0[0], v0[1]); w.y = cvt_pk_bf16(v0[2], v0[3]); w.z = cvt_pk_bf16(v1[0], v1[1]); w.w = cvt_pk_bf16(v1[2], v1[3]);
                    *(u32x4*)(Y + (size_t)row * 1024 + c8 + bj * HALF) = w; } }
    }
};
struct MoeOrder {
    int n_units, G, c, npn; const PG8_LAS int* tile_e;
    __device__ __forceinline__ bool next(int i, Unit& u) const {
        const int Lx = i * G + c; if (Lx >= n_units) return false;
        const int tile = Lx / npn, pnl = Lx - tile * npn;
        u.pm = tile; u.pn = tile_e[tile] * npn + pnl; return true;
    }
    __device__ __forceinline__ void a_ready(const Unit&) const {}
    __device__ __forceinline__ void done(const Unit&) const {}
};

template <class Epi, class Sched, bool ALIGN_EPI = false, bool SP2 = false>
__device__ __forceinline__ void gemm_phase(PG8_LAS unsigned char* lds, const Gemm g, const Sched& S, const Epi& E) {
    const int tid = opaque_tid(), wid = __builtin_amdgcn_readfirstlane(tid >> 6), lane = tid & 63, wr = wid >> 2, wc = wid & 3, fr = lane & 15, fq = lane >> 4;
    const int K = g.K, nt = K / BK;
    unsigned voffA[2], voffB[2];
#pragma unroll
    for (int i = 0; i < 2; ++i) { int R, C; stage_rc(tid * 16 + i * 8192, R, C); const int Rb = Epi::PERM ? ((R & ~31) + perm32(R & 31)) : R;
        voffA[i] = (unsigned)(R * K + C) * 2u; voffB[i] = (unsigned)(Rb * K + C) * 2u; }
    const size_t kstep = (size_t)(BK * 2);
    const size_t hstep = (size_t)HALF * K * 2;
    const size_t tstep = 2 * hstep;
    const unsigned ldsw = (unsigned)wid * 1024u;
    const int aoff = lds_byte(wr * 64 + fr, fq * 8), boff = lds_byte(wc * 32 + fr, fq * 8);
#define PG8_SA(b, h) (((b) * 2 + (h)) * HTB)
#define PG8_SB(b, h) ((4 + (b) * 2 + (h)) * HTB)
#define PG8_STAGE(bufoff, gbase, voff) do { _Pragma("unroll") for (int _i = 0; _i < 2; ++_i) \
        __builtin_amdgcn_global_load_lds((const unsigned*)((const char*)(gbase) + (voff)[_i]), (PG8_LAS unsigned*)(lds + (bufoff) + ldsw + _i * 8192), 16, 0, 0); } while (0)
#define PG8_LDA(dst, b, h) do { _Pragma("unroll") for (int m = 0; m < 4; ++m) _Pragma("unroll") for (int k = 0; k < 2; ++k) dst[m][k] = *(const PG8_LAS bf16x8*)(lds + PG8_SA(b, h) + aoff + m * 2048 + k * 1024); } while (0)
#define PG8_LDB(dst, b, h) do { _Pragma("unroll") for (int n = 0; n < 2; ++n) _Pragma("unroll") for (int k = 0; k < 2; ++k) dst[n][k] = *(const PG8_LAS bf16x8*)(lds + PG8_SB(b, h) + boff + n * 2048 + k * 1024); } while (0)
#define PG8_MMA(ai, bj, At, Bt) do { __builtin_amdgcn_s_setprio(1); _Pragma("unroll") for (int m = 0; m < 4; ++m) _Pragma("unroll") for (int n = 0; n < 2; ++n) _Pragma("unroll") for (int k = 0; k < 2; ++k) \
        acc[ai][bj][m][n] = __builtin_amdgcn_mfma_f32_16x16x32_bf16(Bt[n][k], At[m][k], acc[ai][bj][m][n], 0, 0, 0); __builtin_amdgcn_s_setprio(0); } while (0)
#define PG8_WAIT_V(n) asm volatile("s_waitcnt vmcnt(" #n ")" ::: "memory")
#define PG8_WAIT_L(n) asm volatile("s_waitcnt lgkmcnt(" #n ")" ::: "memory")
#define PG8_BAR __builtin_amdgcn_s_barrier()
#define PG8_SCHED __builtin_amdgcn_sched_barrier(0)
    Unit cur, nxt; int ui = 0;
    if (!S.next(0, cur)) return;
    f32x4 acc[2][2][4][2];
#pragma unroll
    for (int a = 0; a < 2; ++a)
#pragma unroll
        for (int b = 0; b < 2; ++b)
#pragma unroll
            for (int m = 0; m < 4; ++m)
#pragma unroll
                for (int n = 0; n < 2; ++n) acc[a][b][m][n] = (f32x4){0.f, 0.f, 0.f, 0.f};
    bf16x8 At[4][2], B0[2][2], B1[2][2];
    const char* cA = (const char*)g.A + (size_t)cur.pm * tstep; const char* cB = (const char*)g.Bt + (size_t)cur.pn * tstep;
    S.a_ready(cur);
    if constexpr (SP2) {
        PG8_STAGE(PG8_SB(0, 0), cB, voffB); PG8_STAGE(PG8_SB(0, 1), cB + hstep, voffB); PG8_STAGE(PG8_SA(0, 0), cA, voffA); PG8_STAGE(PG8_SA(0, 1), cA + hstep, voffA);
        if (wr == 1) PG8_BAR;
        PG8_WAIT_V(2); PG8_BAR;
        PG8_STAGE(PG8_SB(1, 0), cB + kstep, voffB); PG8_STAGE(PG8_SA(1, 0), cA + kstep, voffA); PG8_STAGE(PG8_SB(1, 1), cB + hstep + kstep, voffB);
        PG8_WAIT_V(6); PG8_BAR;
    } else {
        PG8_STAGE(PG8_SB(0, 0), cB, voffB); PG8_STAGE(PG8_SA(0, 0), cA, voffA); PG8_STAGE(PG8_SB(0, 1), cB + hstep, voffB); PG8_STAGE(PG8_SA(0, 1), cA + hstep, voffA);
        if (wr == 1) PG8_BAR;
        PG8_WAIT_V(4); PG8_BAR;
        PG8_STAGE(PG8_SB(1, 0), cB + kstep, voffB); PG8_STAGE(PG8_SA(1, 0), cA + kstep, voffA); PG8_STAGE(PG8_SB(1, 1), cB + hstep + kstep, voffB);
        PG8_WAIT_V(6); PG8_BAR;
    }
    for (;;) {
        const bool has_next = S.next(ui + 1, nxt);
        const char* nA = has_next ? (const char*)g.A + (size_t)nxt.pm * tstep : cA; const char* nB = has_next ? (const char*)g.Bt + (size_t)nxt.pn * tstep : cB;
        for (int t = 0; t < nt; t += 2) {
            const bool last = (t == nt - 2);
            const char* a1 = cA + (size_t)(t + 1) * kstep;
            const char* a2 = last ? nA : cA + (size_t)(t + 2) * kstep; const char* b2 = last ? nB : cB + (size_t)(t + 2) * kstep;
            const char* a3 = a2 + kstep; const char* b3 = b2 + kstep;
            if (last && has_next) S.a_ready(nxt);
            if constexpr (SP2) {
            PG8_LDB(B0, 0, 0); PG8_LDB(B1, 0, 1); PG8_SCHED; PG8_LDA(At, 0, 0); PG8_STAGE(PG8_SA(1, 1), a1 + hstep, voffA);
            PG8_WAIT_V(8); PG8_WAIT_L(0); PG8_BAR; PG8_MMA(0, 0, At, B0); PG8_MMA(0, 1, At, B1); PG8_BAR; PG8_SCHED;
            PG8_LDA(At, 0, 1); PG8_STAGE(PG8_SB(0, 0), b2, voffB); PG8_STAGE(PG8_SB(0, 1), b2 + hstep, voffB); PG8_STAGE(PG8_SA(0, 0), a2, voffA);
            PG8_WAIT_V(8); PG8_WAIT_L(0); PG8_BAR; PG8_MMA(1, 0, At, B0); PG8_MMA(1, 1, At, B1); PG8_BAR; PG8_SCHED;
            PG8_LDB(B0, 1, 0); PG8_LDB(B1, 1, 1); PG8_SCHED; PG8_LDA(At, 1, 0); PG8_STAGE(PG8_SA(0, 1), a2 + hstep, voffA);
            PG8_WAIT_V(8); PG8_WAIT_L(0); PG8_BAR; PG8_MMA(0, 0, At, B0); PG8_MMA(0, 1, At, B1); PG8_BAR; PG8_SCHED;
            PG8_LDA(At, 1, 1); PG8_STAGE(PG8_SB(1, 0), b3, voffB); PG8_STAGE(PG8_SB(1, 1), b3 + hstep, voffB); PG8_STAGE(PG8_SA(1, 0), a3, voffA);
            PG8_WAIT_V(8); PG8_WAIT_L(0); PG8_BAR; PG8_MMA(1, 0, At, B0); PG8_MMA(1, 1, At, B1); PG8_BAR; PG8_SCHED;
            } else {
            PG8_LDB(B0, 0, 0); PG8_SCHED; PG8_LDA(At, 0, 0); PG8_STAGE(PG8_SA(1, 1), a1 + hstep, voffA);
            PG8_WAIT_L(8); PG8_BAR; PG8_WAIT_L(0); PG8_MMA(0, 0, At, B0); PG8_BAR; PG8_SCHED;
            PG8_LDB(B1, 0, 1); PG8_STAGE(PG8_SB(0, 0), b2, voffB);
            PG8_BAR; PG8_WAIT_L(0); PG8_MMA(0, 1, At, B1); PG8_BAR;
            PG8_LDA(At, 0, 1); PG8_STAGE(PG8_SA(0, 0), a2, voffA);
            PG8_BAR; PG8_WAIT_L(0); PG8_MMA(1, 0, At, B0); PG8_BAR; PG8_SCHED;
            PG8_STAGE(PG8_SB(0, 1), b2 + hstep, voffB);
            PG8_WAIT_V(6); PG8_BAR; PG8_MMA(1, 1, At, B1); PG8_BAR;
            PG8_LDB(B0, 1, 0); PG8_SCHED; PG8_LDA(At, 1, 0); PG8_STAGE(PG8_SA(0, 1), a2 + hstep, voffA);
            PG8_WAIT_L(8); PG8_BAR; PG8_WAIT_L(0); PG8_MMA(0, 0, At, B0); PG8_BAR; PG8_SCHED;
            PG8_LDB(B1, 1, 1); PG8_STAGE(PG8_SB(1, 0), b3, voffB);
            PG8_BAR; PG8_WAIT_L(0); PG8_MMA(0, 1, At, B1); PG8_BAR;
            PG8_LDA(At, 1, 1); PG8_STAGE(PG8_SA(1, 0), a3, voffA);
            PG8_BAR; PG8_WAIT_L(0); PG8_MMA(1, 0, At, B0); PG8_BAR; PG8_SCHED;
            PG8_STAGE(PG8_SB(1, 1), b3 + hstep, voffB);
            PG8_WAIT_V(6); PG8_BAR; PG8_MMA(1, 1, At, B1); PG8_BAR;
            }
        }
        if constexpr (ALIGN_EPI) { if (wr == 0) PG8_BAR; }
        if constexpr (!Epi::AFTER_DRAIN) { E(acc, cur, wr, wc, fr, fq); S.done(cur); }
        if (!has_next) break;
#pragma unroll
        for (int a = 0; a < 2; ++a)
#pragma unroll
            for (int b = 0; b < 2; ++b)
#pragma unroll
                for (int m = 0; m < 4; ++m)
#pragma unroll
                    for (int n = 0; n < 2; ++n) acc[a][b][m][n] = (f32x4){0.f, 0.f, 0.f, 0.f};
        cur = nxt; cA = nA; cB = nB; ++ui;
        if constexpr (ALIGN_EPI) { if (wr == 1) PG8_BAR; }
    }
    PG8_WAIT_V(0);
    if constexpr (!ALIGN_EPI) { if (wr == 0) PG8_BAR; }
    PG8_BAR;
    if constexpr (Epi::AFTER_DRAIN) { E.fused(acc, cur, wr, wc, fr, fq, lds, wid, lane); S.done(cur); }
#undef PG8_SA
#undef PG8_SB
#undef PG8_STAGE
#undef PG8_LDA
#undef PG8_LDB
#undef PG8_MMA
#undef PG8_WAIT_V
#undef PG8_WAIT_L
#undef PG8_BAR
#undef PG8_SCHED
}
}
#define XB_TMO      128
#define XB_XCNT(j)  (256  + 64 * (j))
#define XB_XSUB(j)  (1280 + 64 * (j))
#define XB_XGEN(j)  (2304 + 64 * (j))
#define XB_TOP      3328
#define XB_TOPGEN   3392
#define XCD_BAR_WORDS 3456
#define XB_SPIN_CAP (1u << 18)
#define LAS __attribute__((address_space(3)))

__device__ __forceinline__ unsigned xb_ld(unsigned* p)              { return __hip_atomic_load(p, __ATOMIC_RELAXED, __HIP_MEMORY_SCOPE_AGENT); }
__device__ __forceinline__ unsigned xb_add(unsigned* p, unsigned v) { return __hip_atomic_fetch_add(p, v, __ATOMIC_RELAXED, __HIP_MEMORY_SCOPE_AGENT); }
__device__ __forceinline__ unsigned xb_xcc_id() { return (unsigned)__builtin_amdgcn_s_getreg((3 << 11) | 20) & 0xFu; }
#define XB_SPIN(cond, bar) do { unsigned _sp = 0; while (cond) { __builtin_amdgcn_s_sleep(1); \
    if ((++_sp & 255u) == 0u) { if (xb_ld(&(bar)[XB_TMO])) break; if (_sp > XB_SPIN_CAP) { atomicAdd(&(bar)[XB_TMO], 1u); break; } } } } while (0)

struct XcdBarrier {
    unsigned* bar; unsigned x;
    volatile LAS unsigned* st;
};

__device__ __forceinline__ XcdBarrier xcd_barrier_post(unsigned* bar, volatile LAS unsigned* st) {
    XcdBarrier b; b.bar = bar; b.x = xb_xcc_id(); b.st = st;
    if (threadIdx.x == 0) (void)xb_add(&bar[XB_XCNT(b.x)], 1u);
    return b;
}
__device__ __forceinline__ void xcd_barrier_complete(unsigned* bar, unsigned x, unsigned& nloc, unsigned& nx) {
    const unsigned G = gridDim.x * gridDim.y * gridDim.z;
    unsigned sum, cnt, mine, sp = 0u;
    for (;;) {
        sum = 0u; cnt = 0u; mine = 0u;
#pragma unroll
        for (unsigned j = 0; j < 16; ++j) { const unsigned c = xb_ld(&bar[XB_XCNT(j)]); sum += c; cnt += (c > 0u) ? 1u : 0u; mine = (j == x) ? c : mine; }
        if (sum == G) break;
        __builtin_amdgcn_s_sleep(1);
        if ((++sp & 255u) == 0u) { if (xb_ld(&bar[XB_TMO])) break; if (sp > XB_SPIN_CAP) { atomicAdd(&bar[XB_TMO], 1u); break; } }
    }
    nloc = mine > 0u ? mine : 1u; nx = cnt > 0u ? cnt : 1u;
}

__device__ __forceinline__ void xcd_barrier(const XcdBarrier& b) {
    asm volatile("s_waitcnt vmcnt(0)" ::: "memory");
    __syncthreads();
    if (threadIdx.x == 0) {
        unsigned* bar = b.bar;
        __builtin_amdgcn_s_waitcnt(0);
        unsigned nloc = b.st[0], nx = b.st[1];
        if (nloc == 0u) { xcd_barrier_complete(bar, b.x, nloc, nx); b.st[0] = nloc; b.st[1] = nx; }
        const unsigned old = xb_add(&bar[XB_XSUB(b.x)], 1u);
        const unsigned gen = old / nloc;
        if (old + 1u == (gen + 1u) * nloc) {
            __builtin_amdgcn_fence(__ATOMIC_RELEASE, "agent");
            asm volatile("s_waitcnt vmcnt(0)" ::: "memory");
            const unsigned og = xb_add(&bar[XB_TOP], 1u);
            const unsigned tg = og / nx;
            if (og + 1u == (tg + 1u) * nx) xb_add(&bar[XB_TOPGEN], 1u);
            else XB_SPIN(xb_ld(&bar[XB_TOPGEN]) == tg, bar);
            __builtin_amdgcn_fence(__ATOMIC_ACQUIRE, "agent");
            xb_add(&bar[XB_XGEN(b.x)], 1u);
            asm volatile("s_waitcnt vmcnt(0)" ::: "memory");
        } else {
            XB_SPIN(xb_ld(&bar[XB_XGEN(b.x)]) == gen, bar);
            __builtin_amdgcn_fence(__ATOMIC_ACQUIRE, "agent");
            asm volatile("s_waitcnt vmcnt(0)" ::: "memory");
        }
    }
    __syncthreads();
}
__device__ __forceinline__ void p0_transpose_item(const float* W, int ldw, int ncols_valid, int k0, int n0, bf16* WT, size_t dst_row0, int Kdst, LAS float* scr, int lane) {
    const int nn = n0 + (lane & 31); const bool ok = nn < ncols_valid;
#pragma unroll 8
    for (int i = 0; i < 32; ++i) { const int kk = 2 * i + (lane >> 5); scr[kk * 33 + (lane & 31)] = ok ? W[(size_t)(k0 + kk) * ldw + nn] : 0.f; }
    LDS_WAIT();
    const int c = lane & 7;
#pragma unroll
    for (int j = 0; j < 4; ++j) { const int n = (lane >> 3) + 8 * j; const LAS float* s = scr + (8 * c) * 33 + n;
        v4u o; o.x = pk2(s[0 * 33], s[1 * 33]); o.y = pk2(s[2 * 33], s[3 * 33]); o.z = pk2(s[4 * 33], s[5 * 33]); o.w = pk2(s[6 * 33], s[7 * 33]);
        *(v4u*)(WT + (dst_row0 + n) * (size_t)Kdst + k0 + 8 * c) = o; }
    LDS_WAIT();
}
__device__ __forceinline__ void ln_row(v4f (&v)[4], const float* g, const float* b, int lane) {
    float s = 0.f;
#pragma unroll
    for (int j = 0; j < 4; ++j) s += (v[j].x + v[j].y) + (v[j].z + v[j].w);
    const float mean = wave_sum(s) * (1.f / D); float s2 = 0.f;
#pragma unroll
    for (int j = 0; j < 4; ++j) { v[j] = v[j] - mean; s2 += (v[j].x * v[j].x + v[j].y * v[j].y) + (v[j].z * v[j].z + v[j].w * v[j].w); }
    const float rstd = 1.f / sqrtf(wave_sum(s2) * (1.f / D) + LN_EPS);
#pragma unroll
    for (int j = 0; j < 4; ++j) { const v4f gg = *(const v4f*)(g + 256 * j + 4 * lane), bb = *(const v4f*)(b + 256 * j + 4 * lane); v[j] = v[j] * rstd * gg + bb; }
}
__device__ PHASE_FN void p0_prologue(const Ctx A, LAS unsigned char* lds, int vcu, int G) {
    const int tid = opaque_tid(), lane = tid & 63, wave = tid >> 6;
    LAS float* scr = (LAS float*)(lds + wave * 16384);
    const int gw = vcu * NWAVES + wave, NGW = G * NWAVES;
    bf16* Win_t = (bf16*)(A.ws + WS_WIN); bf16* Wout_t = (bf16*)(A.ws + WS_WOUT); bf16* W1_t = (bf16*)(A.ws + WS_W1); bf16* W2_t = (bf16*)(A.ws + WS_W2);
    constexpr int I_IN = 2 * 16 * (NINP / 32), I_OUT = 2 * 16 * 32, I_W1 = 64 * 16 * 64, I_W2 = 64 * 16 * 32;
    constexpr int NITEMS = I_IN + I_OUT + I_W1 + I_W2;
    for (int it = gw; it < NITEMS; it += NGW) {
        int r = it;
        if (r < I_IN) { const int l = r / (16 * 112), q = r % (16 * 112), kb = q / 112, nb = q % 112;
            p0_transpose_item(A.in[4] + (size_t)l * 1024 * 3560, 3560, 3560, kb * 64, nb * 32, Win_t + (size_t)l * NINP * 1024, (size_t)nb * 32, 1024, scr, lane); continue; }
        r -= I_IN;
        if (r < I_OUT) { const int l = r / 512, q = r % 512, kb = q / 32, nb = q % 32;
            p0_transpose_item(A.in[25] + (size_t)l * 1024 * 1024, 1024, 1024, kb * 64, nb * 32, Wout_t + (size_t)l * 1024 * 1024, (size_t)nb * 32, 1024, scr, lane); continue; }
        r -= I_OUT;
        if (r < I_W1) { const int le = r / 1024, q = r % 1024, kb = q / 64, nb = q % 64, n0 = nb * 32;
            const int np = n0 & 1023; const size_t drow = (size_t)256 * (np >> 7) + (n0 >= 1024 ? 128 : 0) + (np & 127);
            p0_transpose_item(A.in[30] + (size_t)le * 1024 * 2048, 2048, 2048, kb * 64, n0, W1_t + (size_t)le * 2048 * 1024, drow, 1024, scr, lane); continue; }
        r -= I_W1;
        { const int le = r / 512, q = r % 512, kb = q / 32, nb = q % 32;
            p0_transpose_item(A.in[32] + (size_t)le * 1024 * 1024, 1024, 1024, kb * 64, nb * 32, W2_t + (size_t)le * 1024 * 1024, (size_t)nb * 32, 1024, scr, lane); }
    }
    float* H = (float*)(A.ws + WS_H); bf16* HB = (bf16*)(A.ws + WS_HB);
    for (int m = gw; m < T; m += NGW) {
        const int b = m / L, i = m - b * L;
        const float* src = (i < NMETA) ? A.in[1] + (size_t)i * D : A.in[0] + ((size_t)b * SEQ + (i - NMETA)) * D;
        v4f v[4];
#pragma unroll
        for (int j = 0; j < 4; ++j) v[j] = *(const v4f*)(src + 256 * j + 4 * lane);
        ln_row(v, A.in[2], A.in[3], lane);
#pragma unroll
        for (int j = 0; j < 4; ++j) { *(v4f*)(H + (size_t)m * D + 256 * j + 4 * lane) = v[j]; st_bf4(HB + (size_t)m * D + 256 * j + 4 * lane, v[j]); }
    }
}
constexpr int NTK = 4;
__device__ __forceinline__ float softplus_fast(float x) { return x > 15.f ? x : __logf(1.f + __expf(x)); }
__device__ __forceinline__ float tanh_fast(float x) { return 1.f - 2.f / (1.f + __expf(2.f * x)); }
__device__ __forceinline__ void sincos_red(float ang, float& sn, float& cs) {
    const float k = rintf(ang * 0.15915494309189535f);
    float r = fmaf(-k, 6.28318548202514648f, ang); r = fmaf(-k, -1.7484555e-7f, r);
    sn = __sinf(r); cs = __cosf(r);
}
__device__ PHASE_FN void prep_phase(const Ctx A, LAS unsigned char* lds, int l, int vcu, int G) {
    const int tid = opaque_tid(), lane = tid & 63, wave = tid >> 6;
    LAS float* scr = (LAS float*)(lds + wave * 16384);
    LAS float* lin = scr + 3072;
    const int gw = vcu * NWAVES + wave, NGW = G * NWAVES;
    const bf16* PROJ = (const bf16*)(A.ws + WS_PROJ);
    const int c4 = 4 * lane, hh = lane >> 4, d4 = 4 * (lane & 15);
    const float* mu = A.in[5] + l * 960; const float* w0 = A.in[6] + l * 256; const float* w2 = A.in[7] + l * 64 * 256;
    const float* a0 = A.in[8] + l * 256; const float* a2 = A.in[9] + l * 64 * 256; const float* g2 = A.in[10] + l * 64 * 256;
    const float* k_k = A.in[11] + l * 256; const float* k_a = A.in[12] + l * 256; const float* r_k = A.in[13] + l * 256;
    const float* conv_w = A.in[16] + l * 4 * 256; const float* conv_b = A.in[17] + l * 256;
    const float* wa = A.in[18] + l * 4 * 64 * 64; const float* ba = A.in[19] + l * 256; const float* wx = A.in[20] + l * 4 * 64 * 64; const float* bx = A.in[21] + l * 256;
    const float* lam = A.in[22] + l * 256; const float* lbs = A.in[23];
    float* RW_W = (float*)(A.ws + WS_RW_W); bf16* RW_A = (bf16*)(A.ws + WS_RW_A); bf16* RW_B = (bf16*)(A.ws + WS_RW_B); bf16* RW_K = (bf16*)(A.ws + WS_RW_K);
    bf16* RW_WR = (bf16*)(A.ws + WS_RW_WR); bf16* RW_V = (bf16*)(A.ws + WS_RW_V); bf16* RW_G = (bf16*)(A.ws + WS_RW_G); float* RW_SC = (float*)(A.ws + WS_RW_SC);
    bf16* DS_Q = (bf16*)(A.ws + WS_DS_Q); bf16* DS_K = (bf16*)(A.ws + WS_DS_K); bf16* DS_V = (bf16*)(A.ws + WS_DS_V); bf16* DS_QI = (bf16*)(A.ws + WS_DS_QI);
    bf16* DS_KI = (bf16*)(A.ws + WS_DS_KI); float* DS_WI = (float*)(A.ws + WS_DS_WI);
    float* LR_A = (float*)(A.ws + WS_LR_A); bf16* LR_U = (bf16*)(A.ws + WS_LR_U); bf16* LR_G = (bf16*)(A.ws + WS_LR_G);
    float* HG_F = (float*)(A.ws + WS_HG_F); bf16* HG_K = (bf16*)(A.ws + WS_HG_K); bf16* HG_Q = (bf16*)(A.ws + WS_HG_Q); bf16* HG_V = (bf16*)(A.ws + WS_HG_V); bf16* HG_G = (bf16*)(A.ws + WS_HG_G);
    const bool q_rot = (lane & 15) < 4, q_hi = (lane & 15) >= 2;
    const bool i_rot = (lane & 7) < 2, i_hi = (lane & 7) == 1;

#pragma unroll 1
    for (int grp = gw; grp < T / NTK; grp += NGW) {
        const int m0 = grp * NTK, b = m0 / L, i0 = m0 - b * L;
        const bf16* P = PROJ + (size_t)m0 * NINP;
        {
            const float mu_wd = mu[C_RW_WD + lane], mu_ad = mu[C_RW_AD + lane], mu_gd = mu[C_RW_GD + lane];
            float pwd = 0.f, pad = 0.f, pgd = 0.f;
            if (i0 > 0) { pwd = bf2f(P[-NINP + C_RW_WD + lane]); pad = bf2f(P[-NINP + C_RW_AD + lane]); pgd = bf2f(P[-NINP + C_RW_GD + lane]); }
#pragma unroll
            for (int j = 0; j < NTK; ++j) {
                const float cwd = bf2f(P[j * NINP + C_RW_WD + lane]), cad = bf2f(P[j * NINP + C_RW_AD + lane]), cgd = bf2f(P[j * NINP + C_RW_GD + lane]);
                const float swd = cwd + (pwd - cwd) * mu_wd, sad = cad + (pad - cad) * mu_ad, sgd = cgd + (pgd - cgd) * mu_gd;
                lin[(0 * NTK + j) * 64 + lane] = tanh_fast(swd); lin[(1 * NTK + j) * 64 + lane] = sad; lin[(2 * NTK + j) * 64 + lane] = sigmoidf_(sgd);
                pwd = cwd; pad = cad; pgd = cgd;
            }
            LDS_WAIT();
        }
#pragma unroll 1
        for (int mat = 0; mat < 3; ++mat) {
            const float* Wm = mat == 0 ? w2 : (mat == 1 ? a2 : g2);
            v4f acc[NTK];
#pragma unroll
            for (int j = 0; j < NTK; ++j) acc[j] = (v4f){0.f, 0.f, 0.f, 0.f};
#pragma unroll 2
            for (int k = 0; k < 64; k += 4) {
                v4f xx[NTK];
#pragma unroll
                for (int j = 0; j < NTK; ++j) xx[j] = *(const LAS v4f*)(lin + (mat * NTK + j) * 64 + k);
#pragma unroll
                for (int kk = 0; kk < 4; ++kk) { const v4f ww = *(const v4f*)(Wm + (k + kk) * 256 + c4);
#pragma unroll
                    for (int j = 0; j < NTK; ++j) acc[j] += ww * xx[j][kk]; }
            }
#pragma unroll
            for (int j = 0; j < NTK; ++j) *(LAS v4f*)(scr + (mat * NTK + j) * 256 + c4) = acc[j];
        }
        LDS_WAIT();
        {
            const v4f mu_r = *(const v4f*)(mu + C_RW_R + c4), mu_k = *(const v4f*)(mu + C_RW_K + c4), mu_v = *(const v4f*)(mu + C_RW_V + c4);
            const v4f w0v = *(const v4f*)(w0 + c4), a0v = *(const v4f*)(a0 + c4), kkv = *(const v4f*)(k_k + c4), kav = *(const v4f*)(k_a + c4), rkv = *(const v4f*)(r_k + c4);
            v4f pr = (v4f){0.f, 0.f, 0.f, 0.f}, pk = pr, pv = pr;
            if (i0 > 0) { pr = ld_bf4(P - NINP + C_RW_R + c4); pk = ld_bf4(P - NINP + C_RW_K + c4); pv = ld_bf4(P - NINP + C_RW_V + c4); }
#pragma unroll 1
            for (int j = 0; j < NTK; ++j) {
                const v4f cr = ld_bf4(P + j * NINP + C_RW_R + c4), ck = ld_bf4(P + j * NINP + C_RW_K + c4), cv = ld_bf4(P + j * NINP + C_RW_V + c4);
                const v4f rs = cr + (pr - cr) * mu_r, ks = ck + (pk - ck) * mu_k, vs = cv + (pv - cv) * mu_v;
                pr = cr; pk = ck; pv = cv;
                const v4f lw = *(const LAS v4f*)(scr + (0 * NTK + j) * 256 + c4), la = *(const LAS v4f*)(scr + (1 * NTK + j) * 256 + c4), lg = *(const LAS v4f*)(scr + (2 * NTK + j) * 256 + c4);
                v4f dec, av, kkn, km, bv, wr;
                float n2 = 0.f, sbr = 0.f, skr = 0.f, sbo = 0.f;
#pragma unroll
                for (int e = 0; e < 4; ++e) {
                    const float wv = -softplus_fast(-(w0v[e] + lw[e])) - 0.5f;
                    dec[e] = __expf(-__expf(wv));
                    av[e] = sigmoidf_(a0v[e] + la[e]);
                    kkn[e] = ks[e] * kkv[e]; n2 += kkn[e] * kkn[e];
                    km[e] = ks[e] * (1.f + (av[e] - 1.f) * kav[e]);
                }
                n2 = sum16(n2);
                const float inv = 1.f / fmaxf(sqrtf(n2), 1e-12f);
#pragma unroll
                for (int e = 0; e < 4; ++e) { kkn[e] *= inv; bv[e] = kkn[e] * av[e]; wr[e] = dec[e] * rs[e]; sbr += bv[e] * rs[e]; skr += km[e] * rs[e]; sbo += rs[e] * km[e] * rkv[e]; kkn[e] = -kkn[e]; }
                sbr = sum16(sbr); skr = sum16(skr); sbo = sum16(sbo);
                const size_t hm = ((size_t)(b * 4 + hh) * L + (i0 + j)) * 64 + d4;
                *(v4f*)(RW_W + hm) = dec; st_bf4(RW_A + hm, kkn); st_bf4(RW_B + hm, bv); st_bf4(RW_K + hm, km); st_bf4(RW_WR + hm, wr); st_bf4(RW_V + hm, vs);
                st_bf4(RW_G + (size_t)(m0 + j) * 256 + c4, lg);
                if ((lane & 15) == 0) *(v4f*)(RW_SC + ((size_t)(b * 4 + hh) * L + (i0 + j)) * 4) = (v4f){sbr, skr, sbo, 0.f};
            }
        }
        {
            float invf_q[4], invf_i[4];
#pragma unroll
            for (int e = 0; e < 4; ++e) { invf_q[e] = exp2f(-(float)((d4 + e) & 7) * (18.931568569324174f / 8.f)); invf_i[e] = exp2f(-(float)e * (18.931568569324174f / 4.f)); }
#pragma unroll 1
            for (int j = 0; j < NTK; ++j) {
                const int m = m0 + j; const float pos = (float)(i0 + j);
                const bf16* Pj = P + j * NINP;
                v4f q = ld_bf4(Pj + C_DS_Q + c4), k = ld_bf4(Pj + C_DS_K + c4);
                const v4f v = ld_bf4(Pj + C_DS_V + c4);
                v4f qi = ld_bf4(Pj + C_DS_QI + c4), ki = ld_bf4(Pj + C_DS_KI + 4 * (lane & 7));
#pragma unroll
                for (int e = 0; e < 4; ++e) {
                    const float qp = __shfl_xor(q[e], 2), kp = __shfl_xor(k[e], 2), qip = __shfl_xor(qi[e], 1), kip = __shfl_xor(ki[e], 1);
                    float sn, cs; sincos_red(pos * invf_q[e], sn, cs);
                    if (q_rot) { q[e] = q_hi ? (qp * sn + q[e] * cs) : (q[e] * cs - qp * sn); k[e] = q_hi ? (kp * sn + k[e] * cs) : (k[e] * cs - kp * sn); }
                    sincos_red(pos * invf_i[e], sn, cs);
                    if (i_rot) { qi[e] = i_hi ? (qip * sn + qi[e] * cs) : (qi[e] * cs - qip * sn); ki[e] = i_hi ? (kip * sn + ki[e] * cs) : (ki[e] * cs - kip * sn); }
                }
                st_bf4(DS_Q + (size_t)m * 256 + c4, q); st_bf4(DS_K + (size_t)m * 256 + c4, k); st_bf4(DS_V + (size_t)m * 256 + c4, v); st_bf4(DS_QI + (size_t)m * 256 + c4, qi);
                if (lane < 8) { st_bf4(DS_KI + (size_t)m * 32 + 4 * lane, ki); DS_WI[(size_t)m * 8 + lane] = bf2f(Pj[C_DS_WI + lane]) * 0.0625f; }
            }
        }
        {
            LDS_WAIT();
            {
                const v4f cb = *(const v4f*)(conv_b + c4), cw0 = *(const v4f*)(conv_w + c4), cw1 = *(const v4f*)(conv_w + 256 + c4), cw2 = *(const v4f*)(conv_w + 512 + c4), cw3 = *(const v4f*)(conv_w + 768 + c4);
                v4f xb[NTK + 3];
#pragma unroll
                for (int r = 0; r < NTK + 3; ++r) xb[r] = (i0 + r - 3 >= 0) ? ld_bf4(P + (r - 3) * NINP + C_LR_X + c4) : (v4f){0.f, 0.f, 0.f, 0.f};
#pragma unroll
                for (int j = 0; j < NTK; ++j) *(LAS v4f*)(scr + j * 256 + c4) = cb + cw0 * xb[j] + cw1 * xb[j + 1] + cw2 * xb[j + 2] + cw3 * xb[j + 3];
            }
            LDS_WAIT();
#pragma unroll 1
            for (int mat = 0; mat < 2; ++mat) {
                const float* Wm = (mat == 0 ? wa : wx) + hh * 4096 + d4;
                v4f acc[NTK];
#pragma unroll
                for (int j = 0; j < NTK; ++j) acc[j] = (v4f){0.f, 0.f, 0.f, 0.f};
#pragma unroll 2
                for (int i = 0; i < 64; i += 4) {
                    v4f xx[NTK];
#pragma unroll
                    for (int j = 0; j < NTK; ++j) xx[j] = *(const LAS v4f*)(scr + j * 256 + hh * 64 + i);
#pragma unroll
                    for (int ii = 0; ii < 4; ++ii) { const v4f w4 = *(const v4f*)(Wm + (i + ii) * 64);
#pragma unroll
                        for (int j = 0; j < NTK; ++j) acc[j] += w4 * xx[j][ii]; }
                }
#pragma unroll
                for (int j = 0; j < NTK; ++j) *(LAS v4f*)(scr + (1 + mat) * 1024 + j * 256 + c4) = acc[j];
            }
            LDS_WAIT();
            const v4f bav = *(const v4f*)(ba + c4), bxv = *(const v4f*)(bx + c4), lamv = *(const v4f*)(lam + c4);
            v4f spl; spl.x = softplusf_(-lamv.x); spl.y = softplusf_(-lamv.y); spl.z = softplusf_(-lamv.z); spl.w = softplusf_(-lamv.w);
#pragma unroll 1
            for (int j = 0; j < NTK; ++j) {
                const size_t m = m0 + j; v4f aa, uu, gg; const v4f gr = ld_bf4(P + j * NINP + C_LR_G + c4);
                const v4f xc = *(const LAS v4f*)(scr + j * 256 + c4), ar = *(const LAS v4f*)(scr + 1024 + j * 256 + c4), ai = *(const LAS v4f*)(scr + 2048 + j * 256 + c4);
#pragma unroll
                for (int e = 0; e < 4; ++e) { const float r = sigmoidf_(ar[e] + bav[e]), ig = sigmoidf_(ai[e] + bxv[e]);
                    const float la = -8.f * r * spl[e]; aa[e] = __expf(la);
                    const float x2 = 2.f * la; const float om = (x2 > -0.1f) ? -(x2 * (1.f + x2 * (0.5f + x2 * (0.16666667f + x2 * 0.041666668f)))) : (1.f - __expf(x2));
                    uu[e] = xc[e] * ig * sqrtf(om);
                    const float t = 0.7978845608028654f * (gr[e] + 0.044715f * gr[e] * gr[e] * gr[e]); gg[e] = 0.5f * gr[e] * (1.f + tanh_fast(t)); }
                *(v4f*)(LR_A + m * 256 + c4) = aa; st_bf4(LR_U + m * 256 + c4, uu); st_bf4(LR_G + m * 256 + c4, gg);
            }
            LDS_WAIT();
        }
        {
            v4f lb = (v4f){0.f, 0.f, 0.f, 0.f};
            if (l == 1) { const v4f x0 = *(const v4f*)(lbs + c4), x1 = *(const v4f*)(lbs + 256 + c4);
                lb.x = 1.f / (1.f + __expf(x0.x - x1.x)); lb.y = 1.f / (1.f + __expf(x0.y - x1.y)); lb.z = 1.f / (1.f + __expf(x0.z - x1.z)); lb.w = 1.f / (1.f + __expf(x0.w - x1.w)); }
#pragma unroll 1
            for (int j = 0; j < NTK; ++j) {
                const bf16* Pj = P + j * NINP; const size_t m = m0 + j;
                const v4f q = ld_bf4(Pj + C_HG_Q + c4), z = ld_bf4(Pj + C_HG_F + c4), vi = ld_bf4(Pj + C_HG_I + c4), g = ld_bf4(Pj + C_HG_G + c4);
                v4f qs, f, kq, gs;
#pragma unroll
                for (int e = 0; e < 4; ++e) { const float sg = sigmoidf_(z[e]); qs[e] = q[e] * sigmoidf_(q[e]); f[e] = lb[e] + (1.f - lb[e]) * sg; kq[e] = (1.f - lb[e]) * (1.f - sg); gs[e] = g[e] * sigmoidf_(g[e]); }
                const size_t hm = ((size_t)(b * 4 + hh) * L + (i0 + j)) * 64 + d4;
                *(v4f*)(HG_F + hm) = f; st_bf4(HG_K + hm, kq); st_bf4(HG_Q + hm, qs); st_bf4(HG_V + hm, vi); st_bf4(HG_G + m * 256 + c4, gs);
            }
        }
    }
}
constexpr int SC_C = 32;
__device__ PHASE_FN void rwkv_scan(const Ctx A, LAS unsigned char* lds, int l, int bh) {
    const int tid = opaque_tid(), lane = tid & 63, wave = tid >> 6, v = tid >> 3, kp = tid & 7;
    const int b = bh >> 2, h = bh & 3;
    const size_t base = (size_t)bh * L * 64;
    const float* W = (const float*)(A.ws + WS_RW_W) + base;
    const bf16* Av = (const bf16*)(A.ws + WS_RW_A) + base; const bf16* Bv = (const bf16*)(A.ws + WS_RW_B) + base; const bf16* Kv = (const bf16*)(A.ws + WS_RW_K) + base;
    const bf16* WRv = (const bf16*)(A.ws + WS_RW_WR) + base; const bf16* Vv = (const bf16*)(A.ws + WS_RW_V) + base;
    const float* SC = (const float*)(A.ws + WS_RW_SC) + (size_t)bh * L * 4;
    const bf16* Gt = (const bf16*)(A.ws + WS_RW_G); bf16* MIX = (bf16*)(A.ws + WS_HB);
    const float* ln_g = A.in[14] + l * 256 + h * 64; const float* ln_b = A.in[15] + l * 256 + h * 64;
    constexpr int ARR = SC_C * 64;
    constexpr int BUF = 6 * ARR * 4 + SC_C * 16;
    LAS float* ybuf = (LAS float*)(lds + 2 * BUF);
    const float lg = ln_g[lane], lbias = ln_b[lane];
    float S[8];
#pragma unroll
    for (int j = 0; j < 8; ++j) S[j] = 0.f;
    v4f rw; v2u ra, rb, rk, rwr, rv; float rsc = 0.f;
    const int e4 = tid * 4;
#define RW_LOAD(c) do { const int t0_ = (c) * SC_C; const bool ok_ = (t0_ + (e4 >> 6)) < L; const size_t o_ = (size_t)t0_ * 64 + e4; \
        rw = ok_ ? *(const v4f*)(W + o_) : (v4f){1.f, 1.f, 1.f, 1.f}; ra = ok_ ? *(const v2u*)(Av + o_) : (v2u){0u, 0u}; rb = ok_ ? *(const v2u*)(Bv + o_) : (v2u){0u, 0u}; \
        rk = ok_ ? *(const v2u*)(Kv + o_) : (v2u){0u, 0u}; rwr = ok_ ? *(const v2u*)(WRv + o_) : (v2u){0u, 0u}; rv = ok_ ? *(const v2u*)(Vv + o_) : (v2u){0u, 0u}; \
        if (tid < SC_C * 4) rsc = (t0_ + (tid >> 2)) < L ? SC[(size_t)t0_ * 4 + tid] : 0.f; } while (0)
#define RW_STORE(p) do { LAS float* d_ = (LAS float*)(lds + (p) * BUF); \
        *(LAS v4f*)(d_ + e4) = rw; *(LAS v4f*)(d_ + ARR + e4) = (v4f){bflo(ra.x), bfhi(ra.x), bflo(ra.y), bfhi(ra.y)}; *(LAS v4f*)(d_ + 2 * ARR + e4) = (v4f){bflo(rb.x), bfhi(rb.x), bflo(rb.y), bfhi(rb.y)}; \
        *(LAS v4f*)(d_ + 3 * ARR + e4) = (v4f){bflo(rk.x), bfhi(rk.x), bflo(rk.y), bfhi(rk.y)}; *(LAS v4f*)(d_ + 4 * ARR + e4) = (v4f){bflo(rwr.x), bfhi(rwr.x), bflo(rwr.y), bfhi(rwr.y)}; \
        *(LAS v4f*)(d_ + 5 * ARR + e4) = (v4f){bflo(rv.x), bfhi(rv.x), bflo(rv.y), bfhi(rv.y)}; if (tid < SC_C * 4) d_[6 * ARR + tid] = rsc; } while (0)
    constexpr int NCH = (L + SC_C - 1) / SC_C;
    RW_LOAD(0); RW_STORE(0); __syncthreads();
    for (int c = 0; c < NCH; ++c) {
        const int p = c & 1;
        if (c + 1 < NCH) RW_LOAD(c + 1);
        const int ns = (L - c * SC_C) < SC_C ? (L - c * SC_C) : SC_C;
        const LAS float* d = (const LAS float*)(lds + p * BUF);
        for (int s = 0; s < ns; ++s) {
            const LAS float* q = d + s * 64 + kp * 8;
            const v4f w0 = *(const LAS v4f*)(q), w1 = *(const LAS v4f*)(q + 4);
            const v4f a0 = *(const LAS v4f*)(q + ARR), a1 = *(const LAS v4f*)(q + ARR + 4);
            const v4f b0 = *(const LAS v4f*)(q + 2 * ARR), b1 = *(const LAS v4f*)(q + 2 * ARR + 4);
            const v4f k0 = *(const LAS v4f*)(q + 3 * ARR), k1 = *(const LAS v4f*)(q + 3 * ARR + 4);
            const v4f r0 = *(const LAS v4f*)(q + 4 * ARR), r1 = *(const LAS v4f*)(q + 4 * ARR + 4);
            const float vv = d[5 * ARR + s * 64 + v];
            const v2f sc = *(const LAS v2f*)(d + 6 * ARR + s * 4);
            float sa = 0.f, y1 = 0.f;
#pragma unroll
            for (int j = 0; j < 4; ++j) { sa += S[j] * a0[j]; y1 += S[j] * r0[j]; }
#pragma unroll
            for (int j = 0; j < 4; ++j) { sa += S[4 + j] * a1[j]; y1 += S[4 + j] * r1[j]; }
            sa = sum8(sa); y1 = sum8(y1);
#pragma unroll
            for (int j = 0; j < 4; ++j) { S[j] = S[j] * w0[j] + sa * b0[j] + vv * k0[j]; S[4 + j] = S[4 + j] * w1[j] + sa * b1[j] + vv * k1[j]; }
            if (kp == 0) ybuf[s * 64 + v] = y1 + sa * sc.x + vv * sc.y;
        }
        __syncthreads();
        for (int s = wave; s < ns; s += NWAVES) {
            const int i = c * SC_C + s; const size_t m = (size_t)b * L + i;
            const float y = ybuf[s * 64 + lane];
            const float mean = wave_sum(y) * (1.f / 64.f); const float dy = y - mean;
            const float var = wave_sum(dy * dy) * (1.f / 64.f);
            const float yn = dy * rsqrtf(var + 64e-5f) * lg + lbias;
            const float bonus = d[6 * ARR + s * 4 + 2], vv = d[5 * ARR + s * 64 + lane];
            const float g = bf2f(Gt[m * 256 + h * 64 + lane]);
            MIX[m * 1024 + h * 64 + lane] = f2bf((yn + bonus * vv) * g);
        }
        if (c + 1 < NCH) RW_STORE(1 - p);
        __syncthreads();
    }
#undef RW_LOAD
#undef RW_STORE
}
__device__ PHASE_FN void hgrn_scan(const Ctx A, LAS unsigned char* lds, int l, int bh) {
    const int tid = opaque_tid(), lane = tid & 63, wave = tid >> 6, v = tid >> 3, kp = tid & 7;
    const int b = bh >> 2, h = bh & 3;
    const size_t base = (size_t)bh * L * 64;
    const float* Fv = (const float*)(A.ws + WS_HG_F) + base;
    const bf16* Kv = (const bf16*)(A.ws + WS_HG_K) + base; const bf16* Qv = (const bf16*)(A.ws + WS_HG_Q) + base; const bf16* Vv = (const bf16*)(A.ws + WS_HG_V) + base;
    const bf16* Gt = (const bf16*)(A.ws + WS_HG_G); bf16* MIX = (bf16*)(A.ws + WS_HB);
    const float ng = (A.in[24] + l * 256 + h * 64)[lane];
    constexpr int ARR = SC_C * 64; constexpr int BUF = 4 * ARR * 4;
    LAS float* obuf = (LAS float*)(lds + 2 * BUF);
    float S[8];
#pragma unroll
    for (int j = 0; j < 8; ++j) S[j] = 0.f;
    v4f rf; v2u rk, rq, rv;
    const int e4 = tid * 4;
#define HG_LOAD(c) do { const int t0_ = (c) * SC_C; const bool ok_ = (t0_ + (e4 >> 6)) < L; const size_t o_ = (size_t)t0_ * 64 + e4; \
        rf = ok_ ? *(const v4f*)(Fv + o_) : (v4f){1.f, 1.f, 1.f, 1.f}; rk = ok_ ? *(const v2u*)(Kv + o_) : (v2u){0u, 0u}; rq = ok_ ? *(const v2u*)(Qv + o_) : (v2u){0u, 0u}; rv = ok_ ? *(const v2u*)(Vv + o_) : (v2u){0u, 0u}; } while (0)
#define HG_STORE(p) do { LAS float* d_ = (LAS float*)(lds + (p) * BUF); \
        *(LAS v4f*)(d_ + e4) = rf; *(LAS v4f*)(d_ + ARR + e4) = (v4f){bflo(rk.x), bfhi(rk.x), bflo(rk.y), bfhi(rk.y)}; \
        *(LAS v4f*)(d_ + 2 * ARR + e4) = (v4f){bflo(rq.x), bfhi(rq.x), bflo(rq.y), bfhi(rq.y)}; *(LAS v4f*)(d_ + 3 * ARR + e4) = (v4f){bflo(rv.x), bfhi(rv.x), bflo(rv.y), bfhi(rv.y)}; } while (0)
    constexpr int NCH = (L + SC_C - 1) / SC_C;
    HG_LOAD(0); HG_STORE(0); __syncthreads();
    for (int c = 0; c < NCH; ++c) {
        const int p = c & 1;
        if (c + 1 < NCH) HG_LOAD(c + 1);
        const int ns = (L - c * SC_C) < SC_C ? (L - c * SC_C) : SC_C;
        const LAS float* d = (const LAS float*)(lds + p * BUF);
        for (int s = 0; s < ns; ++s) {
            const LAS float* q = d + s * 64 + kp * 8;
            const v4f f0 = *(const LAS v4f*)(q), f1 = *(const LAS v4f*)(q + 4);
            const v4f k0 = *(const LAS v4f*)(q + ARR), k1 = *(const LAS v4f*)(q + ARR + 4);
            const v4f q0 = *(const LAS v4f*)(q + 2 * ARR), q1 = *(const LAS v4f*)(q + 2 * ARR + 4);
            const float vv = d[3 * ARR + s * 64 + v];
            float o = 0.f;
#pragma unroll
            for (int j = 0; j < 4; ++j) { S[j] = S[j] * f0[j] + k0[j] * vv; o += q0[j] * S[j]; }
#pragma unroll
            for (int j = 0; j < 4; ++j) { S[4 + j] = S[4 + j] * f1[j] + k1[j] * vv; o += q1[j] * S[4 + j]; }
            o = sum8(o);
            if (kp == 0) obuf[s * 64 + v] = o;
        }
        __syncthreads();
        for (int s = wave; s < ns; s += NWAVES) {
            const int i = c * SC_C + s; const size_t m = (size_t)b * L + i;
            const float o = obuf[s * 64 + lane];
            const float ms = wave_sum(o * o) * (1.f / 64.f);
            const float g = bf2f(Gt[m * 256 + h * 64 + lane]);
            MIX[m * 1024 + 768 + h * 64 + lane] = f2bf(o * rsqrtf(ms + 1e-5f) * ng * g);
        }
        if (c + 1 < NCH) HG_STORE(1 - p);
        __syncthreads();
    }
#undef HG_LOAD
#undef HG_STORE
}
__device__ PHASE_FN void lru_scan(const Ctx A, LAS unsigned char* lds, int bh) {
    const int tid = opaque_tid(), lane = tid & 63, wave = tid >> 6;
    const int b = bh >> 2, h = bh & 3, ch = h * 64 + lane;
    const float* LA = (const float*)(A.ws + WS_LR_A); const bf16* LU = (const bf16*)(A.ws + WS_LR_U); const bf16* LG = (const bf16*)(A.ws + WS_LR_G);
    bf16* MIX = (bf16*)(A.ws + WS_HB);
    constexpr int SEG = L / 8;
    const size_t m0 = (size_t)b * L + wave * SEG;
    LAS float* agg = (LAS float*)lds;
    float Ap = 1.f, Hl = 0.f;
    for (int i = 0; i < SEG; i += 6) {
        float a[6], u[6];
#pragma unroll
        for (int j = 0; j < 6; ++j) { a[j] = LA[(m0 + i + j) * 256 + ch]; u[j] = bf2f(LU[(m0 + i + j) * 256 + ch]); }
#pragma unroll
        for (int j = 0; j < 6; ++j) { Hl = a[j] * Hl + u[j]; Ap *= a[j]; }
    }
    agg[(wave * 2 + 0) * 64 + lane] = Ap; agg[(wave * 2 + 1) * 64 + lane] = Hl;
    __syncthreads();
    float hc = 0.f;
    for (int w = 0; w < wave; ++w) hc = agg[(w * 2 + 0) * 64 + lane] * hc + agg[(w * 2 + 1) * 64 + lane];
    for (int i = 0; i < SEG; i += 6) {
        float a[6], u[6], g[6];
#pragma unroll
        for (int j = 0; j < 6; ++j) { a[j] = LA[(m0 + i + j) * 256 + ch]; u[j] = bf2f(LU[(m0 + i + j) * 256 + ch]); g[j] = bf2f(LG[(m0 + i + j) * 256 + ch]); }
#pragma unroll
        for (int j = 0; j < 6; ++j) { hc = a[j] * hc + u[j]; MIX[(m0 + i + j) * 1024 + 512 + ch] = f2bf(hc * g[j]); }
    }
    __syncthreads();
}
static_assert((L / 8) % 6 == 0 && L % 8 == 0, "lru segments");
constexpr int DSA_WBYTES = 34944;
constexpr int DSA_NW = 4;
__device__ __forceinline__ unsigned fkey(float f) { const unsigned u = __float_as_uint(f); return (u & 0x80000000u) ? ~u : (u | 0x80000000u); }
__device__ __forceinline__ void dsa_query(const Ctx A, LAS unsigned char* wl, int b, int i, int lane) {
    const bf16* DQ = (const bf16*)(A.ws + WS_DS_Q); const bf16* DK = (const bf16*)(A.ws + WS_DS_K); const bf16* DV = (const bf16*)(A.ws + WS_DS_V);
    const bf16* DQI = (const bf16*)(A.ws + WS_DS_QI); const bf16* DKI = (const bf16*)(A.ws + WS_DS_KI); const float* DWI = (const float*)(A.ws + WS_DS_WI);
    bf16* MIX = (bf16*)(A.ws + WS_HB);
    LAS unsigned* keys = (LAS unsigned*)wl; LAS float* qv = (LAS float*)(wl + 32896); LAS int* sel = (LAS int*)(wl + 32896 + 1024);
    const size_t m = (size_t)b * L + i, mb = (size_t)b * L;
    const int n = i + 1;
    LAS float* wil = (LAS float*)(wl + 32832);
    { const v4f q4 = ld_bf4(DQI + m * 256 + 4 * lane); *(LAS v4f*)(qv + 4 * lane) = q4; if (lane < 8) wil[lane] = DWI[m * 8 + lane]; }
    LDS_WAIT();
    for (int s = lane; s < n; s += 64) {
        const v4u* kp = (const v4u*)(DKI + (mb + s) * 32);
        float kf[32];
#pragma unroll
        for (int c = 0; c < 4; ++c) { const v4u x = kp[c]; kf[8 * c + 0] = bflo(x.x); kf[8 * c + 1] = bfhi(x.x); kf[8 * c + 2] = bflo(x.y); kf[8 * c + 3] = bfhi(x.y); kf[8 * c + 4] = bflo(x.z); kf[8 * c + 5] = bfhi(x.z); kf[8 * c + 6] = bflo(x.w); kf[8 * c + 7] = bfhi(x.w); }
        float sc = 0.f;
#pragma unroll 1
        for (int hx = 0; hx < 8; ++hx) { float dt = 0.f;
#pragma unroll
            for (int c = 0; c < 8; ++c) { const v4f q4 = *(const LAS v4f*)(qv + hx * 32 + 4 * c); dt += q4.x * kf[4 * c] + q4.y * kf[4 * c + 1] + q4.z * kf[4 * c + 2] + q4.w * kf[4 * c + 3]; }
            sc += wil[hx] * fmaxf(dt, 0.f); }
        keys[s] = fkey(sc);
    }
    LDS_WAIT();
    unsigned thr = 0u; int need = 0;
    if (n > 256) {
        unsigned prefix = 0u; need = 256;
#pragma unroll 1
        for (int shift = 28; shift >= 0; shift -= 4) {
            unsigned long long lo = 0ull, hi = 0ull;
            const unsigned himask = (shift == 28) ? 0u : (0xFFFFFFFFu << (shift + 4));
            for (int s = lane; s < n; s += 64) { const unsigned k = keys[s];
                if ((k & himask) == prefix) { const unsigned dg = (k >> shift) & 15u; const unsigned long long inc = 1ull << ((dg & 7u) * 8u); if (dg < 8u) lo += inc; else hi += inc; } }
            int cum = 0; unsigned dsel = 0u; int below = 0; bool found = false;
#pragma unroll
            for (int dg = 15; dg >= 0; --dg) {
                const unsigned mine = (unsigned)(((dg < 8 ? lo : hi) >> ((dg & 7) * 8)) & 0xFFull);
                int tot = (int)mine;
#pragma unroll
                for (int o = 1; o < 64; o <<= 1) tot += __shfl_xor(tot, o);
                if (!found && cum + tot >= need) { found = true; dsel = (unsigned)dg; below = cum; }
                cum += tot;
            }
            prefix |= dsel << shift; need -= below;
        }
        thr = prefix;
    }
    int cnt = 0;
    if (n <= 256) { for (int s = lane; s < n; s += 64) sel[s] = s; cnt = n; }
    else {
        int eq_taken = 0;
        for (int s0 = 0; s0 < n; s0 += 64) { const int s = s0 + lane; const unsigned k = (s < n) ? keys[s] : 0u; const bool in = s < n;
            const bool gt = in && (k > thr), eq = in && (k == thr);
            const unsigned long long meq = __ballot(eq); const int eq_before = __popcll(meq & ((1ull << lane) - 1ull));
            const bool take = gt || (eq && (eq_taken + eq_before) < need);
            const unsigned long long mt = __ballot(take); const int pos = cnt + __popcll(mt & ((1ull << lane) - 1ull));
            if (take && pos < 256) sel[pos] = s;
            cnt += __popcll(mt); eq_taken += __popcll(meq);
        }
        if (cnt > 256) cnt = 256;
    }
    LDS_WAIT();
    LAS float* pbuf = (LAS float*)wl;
    for (int h = 0; h < 4; ++h) {
        { const float qx = bf2f(DQ[m * 256 + h * 64 + lane]); qv[lane] = qx * 0.125f; }
        LDS_WAIT();
        float sj[4]; float mx = -3.0e38f;
#pragma unroll
        for (int r = 0; r < 4; ++r) { const int j = lane + 64 * r; sj[r] = -3.0e38f;
            if (j < cnt) { const int s = sel[j]; const v4u* kp = (const v4u*)(DK + (mb + s) * 256 + h * 64); float dt = 0.f;
#pragma unroll
                for (int c = 0; c < 8; ++c) { const v4u x = kp[c]; const v4f q0 = *(const LAS v4f*)(qv + 8 * c), q1 = *(const LAS v4f*)(qv + 8 * c + 4);
                    dt += q0.x * bflo(x.x) + q0.y * bfhi(x.x) + q0.z * bflo(x.y) + q0.w * bfhi(x.y) + q1.x * bflo(x.z) + q1.y * bfhi(x.z) + q1.z * bflo(x.w) + q1.w * bfhi(x.w); }
                sj[r] = dt; mx = fmaxf(mx, dt); } }
        mx = wave_max(mx);
        float sum = 0.f;
#pragma unroll
        for (int r = 0; r < 4; ++r) { const int j = lane + 64 * r; const float p = (j < cnt) ? __expf(sj[r] - mx) : 0.f; sum += p; pbuf[j] = p; }
        sum = wave_sum(sum);
        LDS_WAIT();
        float o = 0.f;
        for (int j = 0; j < cnt; ++j) { const int s = sel[j]; o += pbuf[j] * bf2f(DV[(mb + s) * 256 + h * 64 + lane]); }
        MIX[m * 1024 + 256 + h * 64 + lane] = f2bf(o / sum);
        LDS_WAIT();
    }
}
__device__ PHASE_FN void dsa_phase(const Ctx A, LAS unsigned char* lds, int l) {
    const int tid = opaque_tid(), lane = tid & 63, wave = tid >> 6;
    if (wave >= DSA_NW) return;
    unsigned* qhead = (unsigned*)(A.ws + WS_CTL) + CW_DSAQ + 64 * l;
    LAS unsigned char* wl = lds + wave * DSA_WBYTES;
    for (;;) {
        unsigned it = 0u;
        if (lane == 0) it = atomicAdd(qhead, 1u);
        it = __builtin_amdgcn_readfirstlane(it);
        if (it >= (unsigned)T) break;
        const int i = L - 1 - (int)(it >> 3), b = (int)(it & 7u);
        dsa_query(A, wl, b, i, lane);
    }
}
static_assert(DSA_NW * DSA_WBYTES <= MISC_OFF, "dsa lds");
__device__ PHASE_FN void ln_router_phase(const Ctx A, LAS unsigned char* lds, int l, int vcu, int G) {
    const int tid = opaque_tid(), lane = tid & 63, wave = tid >> 6;
    const int gw = vcu * NWAVES + wave, NGW = G * NWAVES;
    float* H = (float*)(A.ws + WS_H); bf16* HB = (bf16*)(A.ws + WS_HB);
    int* TIDX = (int*)(A.ws + WS_TIDX); float* TGATE = (float*)(A.ws + WS_TGATE);
    unsigned* ecnt = (unsigned*)(A.ws + WS_CTL) + CW_ECNT + 64 * l;
    const float* g = A.in[26] + l * D; const float* bb = A.in[27] + l * D;
    const float* rw = A.in[28] + (size_t)l * D * NE; const float* rb = A.in[29] + l * NE;
    LAS int* hist = (LAS int*)(lds + MISC_OFF + MI_HIST);
    LAS float* red = (LAS float*)(lds + wave * 16640);
    if (tid < 32) hist[tid] = 0;
    __syncthreads();
    const float rbias = rb[lane & 31];
    for (int pr = gw; pr < T / 2; pr += NGW) {
        const size_t m0 = (size_t)pr * 2;
        v4f x[2][4];
#pragma unroll
        for (int t = 0; t < 2; ++t) {
#pragma unroll
            for (int j = 0; j < 4; ++j) x[t][j] = *(const v4f*)(H + (m0 + t) * D + 256 * j + 4 * lane);
            ln_row(x[t], g, bb, lane);
#pragma unroll
            for (int j = 0; j < 4; ++j) { *(v4f*)(H + (m0 + t) * D + 256 * j + 4 * lane) = x[t][j]; st_bf4(HB + (m0 + t) * D + 256 * j + 4 * lane, x[t][j]); }
        }
#pragma unroll
        for (int t = 0; t < 2; ++t)
#pragma unroll
            for (int j = 0; j < 4; ++j) *(LAS v4f*)(red + t * 1024 + 256 * j + 4 * lane) = x[t][j];
        LDS_WAIT();
        float acc[2][32];
#pragma unroll
        for (int t = 0; t < 2; ++t)
#pragma unroll
            for (int e = 0; e < 32; ++e) acc[t][e] = 0.f;
#pragma unroll 2
        for (int it = 0; it < 16; ++it) {
            const int k = it * 64 + lane;
            const float x0 = red[k], x1 = red[1024 + k];
            const float* wrow = rw + (size_t)k * NE;
#pragma unroll
            for (int e4 = 0; e4 < 8; ++e4) { const v4f w4 = *(const v4f*)(wrow + 4 * e4);
#pragma unroll
                for (int q = 0; q < 4; ++q) { acc[0][4 * e4 + q] += x0 * w4[q]; acc[1][4 * e4 + q] += x1 * w4[q]; } }
        }
        LDS_WAIT();
#pragma unroll
        for (int t = 0; t < 2; ++t)
#pragma unroll
            for (int e = 0; e < 32; ++e) red[lane * 65 + t * 32 + e] = acc[t][e];
        LDS_WAIT();
        float lg = 0.f;
#pragma unroll 8
        for (int r = 0; r < 64; ++r) lg += red[r * 65 + lane];
        lg += rbias;
        LDS_WAIT();
        float cur = lg; const int my = lane & 31;
        float tv[4]; int ti[4];
#pragma unroll
        for (int r = 0; r < 4; ++r) {
            float bv = cur; int bi = my;
#pragma unroll
            for (int o = 1; o < 32; o <<= 1) { const float ov = __shfl_xor(bv, o); const int oi = __shfl_xor(bi, o); if (ov > bv || (ov == bv && oi < bi)) { bv = ov; bi = oi; } }
            tv[r] = bv; ti[r] = bi; if (my == bi) cur = -3.0e38f;
        }
        const float e1 = __expf(tv[1] - tv[0]), e2 = __expf(tv[2] - tv[0]), e3 = __expf(tv[3] - tv[0]); const float inv = 1.f / (1.f + e1 + e2 + e3);
        if (my == 0) { const size_t m = m0 + (lane >> 5); *(int4*)(TIDX + m * 4) = make_int4(ti[0], ti[1], ti[2], ti[3]); *(v4f*)(TGATE + m * 4) = (v4f){inv, e1 * inv, e2 * inv, e3 * inv}; }
        if (my < 4) lds_add(&hist[my == 0 ? ti[0] : my == 1 ? ti[1] : my == 2 ? ti[2] : ti[3]], 1);
    }
    __syncthreads();
    if (tid < 32) atomicAdd(&ecnt[tid], (unsigned)hist[tid]);
}
__device__ __forceinline__ int build_tiles(const Ctx A, LAS unsigned char* lds, int l) {
    const int tid = opaque_tid();
    const unsigned* ecnt = (const unsigned*)(A.ws + WS_CTL) + CW_ECNT + 64 * l;
    LAS int* offs = (LAS int*)(lds + MISC_OFF + MI_OFFS); LAS int* tile_e = (LAS int*)(lds + MISC_OFF + MI_TILE); LAS int* nt = (LAS int*)(lds + MISC_OFF + MI_NT);
    __syncthreads();
    if (tid < 32) { int off = 0, mycnt = 0;
        for (int e = 0; e < 32; ++e) { const int c = (int)__hip_atomic_load(ecnt + e, __ATOMIC_RELAXED, __HIP_MEMORY_SCOPE_AGENT); if (e < tid) off += (c + 255) & ~255; if (e == tid) mycnt = c; }
        offs[tid] = off;
        const int t0 = off >> 8, t1 = (off + ((mycnt + 255) & ~255)) >> 8;
        for (int t = t0; t < t1; ++t) tile_e[t] = tid;
        if (tid == 31) nt[0] = t1; }
    __syncthreads();
    return nt[0];
}
__device__ PHASE_FN void moe_sort_phase(const Ctx A, LAS unsigned char* lds, int l) {
    const int tid = opaque_tid(), lane = tid & 63, wave = tid >> 6;
    const int* TIDX = (const int*)(A.ws + WS_TIDX); const float* TGATE = (const float*)(A.ws + WS_TGATE);
    int* SPOS = (int*)(A.ws + WS_SPOS); float* GSORT = (float*)(A.ws + WS_GSORT);
    const bf16* HB = (const bf16*)(A.ws + WS_HB); bf16* SORTA = (bf16*)(A.ws + WS_SORTA);
    unsigned* ecur = (unsigned*)(A.ws + WS_CTL) + CW_ECUR + 64 * l;
    LAS int* hist = (LAS int*)(lds + MISC_OFF + MI_HIST); LAS int* lcur = (LAS int*)(lds + MISC_OFF + MI_LCUR); LAS int* lbase = (LAS int*)(lds + MISC_OFF + MI_LBASE);
    LAS int* offs = (LAS int*)(lds + MISC_OFF + MI_OFFS);
    LAS int* srcm = (LAS int*)lds; LAS int* dstp = (LAS int*)(lds + 8192);
    (void)build_tiles(A, lds, l);
    const int TPB = (T + (int)gridDim.x - 1) / (int)gridDim.x;
    const int mbeg = blockIdx.x * TPB, mend = (mbeg + TPB < T) ? mbeg + TPB : T;
    const int nslot = (mend > mbeg) ? (mend - mbeg) * 4 : 0;
    if (tid < 32) { hist[tid] = 0; lcur[tid] = 0; }
    __syncthreads();
    for (int s = tid; s < nslot; s += NTHR) lds_add(&hist[TIDX[(size_t)mbeg * 4 + s]], 1);
    __syncthreads();
    if (tid < 32) lbase[tid] = offs[tid] + (int)atomicAdd(&ecur[tid], (unsigned)hist[tid]);
    __syncthreads();
    for (int s = tid; s < nslot; s += NTHR) { const size_t gs = (size_t)mbeg * 4 + s; const int e = TIDX[gs];
        const int pos = lbase[e] + lds_add(&lcur[e], 1);
        SPOS[gs] = pos; GSORT[pos] = TGATE[gs]; srcm[s] = mbeg + (s >> 2); dstp[s] = pos; }
    __syncthreads();
    for (int s = wave; s < nslot; s += NWAVES) { const v4u* src = (const v4u*)(HB + (size_t)srcm[s] * D); v4u* dst = (v4u*)(SORTA + (size_t)dstp[s] * D);
        const v4u a0 = src[lane], a1 = src[64 + lane]; dst[lane] = a0; dst[64 + lane] = a1; }
}
__device__ PHASE_FN void combine_ln_phase(const Ctx A, int l, int vcu, int G) {
    const int tid = opaque_tid(), lane = tid & 63, wave = tid >> 6;
    const int gw = vcu * NWAVES + wave, NGW = G * NWAVES;
    float* H = (float*)(A.ws + WS_H); bf16* HB = (bf16*)(A.ws + WS_HB); const bf16* Y = (const bf16*)(A.ws + WS_YBUF); const int* SPOS = (const int*)(A.ws + WS_SPOS);
    const float* g = A.in[34] + l * D; const float* bb = A.in[35] + l * D;
    for (int m = gw; m < T; m += NGW) {
        const int4 sp = *(const int4*)(SPOS + (size_t)m * 4);
        v4f v[4];
#pragma unroll
        for (int j = 0; j < 4; ++j) { const size_t co = 256 * j + 4 * lane;
            const v4f y = ld_bf4(Y + (size_t)sp.x * D + co) + ld_bf4(Y + (size_t)sp.y * D + co) + ld_bf4(Y + (size_t)sp.z * D + co) + ld_bf4(Y + (size_t)sp.w * D + co);
            v[j] = *(const v4f*)(H + (size_t)m * D + co) * ALPHA + y; }
        ln_row(v, g, bb, lane);
        if (l == 0) {
#pragma unroll
            for (int j = 0; j < 4; ++j) { *(v4f*)(H + (size_t)m * D + 256 * j + 4 * lane) = v[j]; st_bf4(HB + (size_t)m * D + 256 * j + 4 * lane, v[j]); }
        } else {
            const int b = m / L, i = m - b * L;
            if (i >= NMETA) { float* o = A.out + ((size_t)b * SEQ + (i - NMETA)) * D;
#pragma unroll
                for (int j = 0; j < 4; ++j) *(v4f*)(o + 256 * j + 4 * lane) = v[j]; }
        }
    }
}
constexpr int N_PHASES = 19;
#ifndef PH_ONLY
#define PH_ONLY -1
#endif
#define PHSEL(j) (PH_ONLY < 0 || PH_ONLY == (j))
#define IN(k) (lo <= (k) && (k) < hi)
#if MK_ONE_LAUNCH
#define GRID_BAR() xcd_barrier(bar)
#else
#define GRID_BAR() do { } while (0)
#endif
#define SEAM(k) do { if (IN(k) && IN((k) + 1)) GRID_BAR(); } while (0)
#define CTX() Ctx{args.in, args.out, launder(args.ws)}
__device__ __forceinline__ void layer_phases(const int l, const Args& args, LAS unsigned char* lds, const int G, const int bx, const int vcu, const int lo, const int hi, const XcdBarrier& bar) {

        const int pb = 1 + 9 * l;
        if (PHSEL(0) && IN(pb + 0)) { unsigned char* wsl = launder(args.ws);
            pg8::Gemm g{(const pg8::bf16_t*)(wsl + WS_HB), (const pg8::bf16_t*)(wsl + WS_WIN) + (size_t)l * NINP * 1024, TP, NINP, 1024};
            pg8::StaticOrder S; S.init(TP, NINP, G, bx);
            pg8::EpiStoreBf16 E{(pg8::bf16_t*)(wsl + WS_PROJ), NINP};
            pg8::gemm_phase<pg8::EpiStoreBf16, pg8::StaticOrder, true, true>(lds, g, S, E);
            SEAM(pb + 0);
        }
        if (PHSEL(1) && IN(pb + 1)) { prep_phase(CTX(), lds, l, vcu, G); SEAM(pb + 1); }
        if (PHSEL(2) && IN(pb + 2)) {
#ifndef PH2_SEL
#define PH2_SEL 15
#endif
            if ((PH2_SEL & 1) && bx < 32) rwkv_scan(CTX(), lds, l, bx); else if ((PH2_SEL & 2) && bx >= 32 && bx < 64) hgrn_scan(CTX(), lds, l, bx - 32); else if ((PH2_SEL & 4) && bx >= 64 && bx < 96) lru_scan(CTX(), lds, bx - 64);
            __syncthreads();
            if (PH2_SEL & 8) dsa_phase(CTX(), lds, l);
            SEAM(pb + 2);
        }
        if (PHSEL(3) && IN(pb + 3)) { unsigned char* wsl = launder(args.ws);
            pg8::Gemm g{(const pg8::bf16_t*)(wsl + WS_HB), (const pg8::bf16_t*)(wsl + WS_WOUT) + (size_t)l * 1024 * 1024, TP, 1024, 1024};
            pg8::StaticOrder S; S.init(TP, 1024, G, bx);
            pg8::EpiResid E{(float*)(wsl + WS_H), 1024, ALPHA};
            pg8::gemm_phase<pg8::EpiResid, pg8::StaticOrder, true, true>(lds, g, S, E);
            SEAM(pb + 3);
        }
        if (PHSEL(4) && IN(pb + 4)) { ln_router_phase(CTX(), lds, l, vcu, G); SEAM(pb + 4); }
        if (PHSEL(5) && IN(pb + 5)) { moe_sort_phase(CTX(), lds, l); SEAM(pb + 5); }
        if (PHSEL(6) && IN(pb + 6)) { unsigned char* wsl = launder(args.ws);
            const int nt = build_tiles(CTX(), lds, l);
            pg8::Gemm g{(const pg8::bf16_t*)(wsl + WS_SORTA), (const pg8::bf16_t*)(wsl + WS_W1) + (size_t)l * 32 * 2048 * 1024, RMAX, 32 * 2048, 1024};
            pg8::MoeOrder S{nt * 8, G, bx, 8, (const LAS int*)(lds + MISC_OFF + MI_TILE)};
            pg8::EpiSwiGLU E{(pg8::bf16_t*)(wsl + WS_ACT), args.in[31] + (size_t)l * 32 * 2048};
            pg8::gemm_phase<pg8::EpiSwiGLU, pg8::MoeOrder, true, true>(lds, g, S, E);
            SEAM(pb + 6);
        }
        if (PHSEL(7) && IN(pb + 7)) { unsigned char* wsl = launder(args.ws);
            const int nt = build_tiles(CTX(), lds, l);
            pg8::Gemm g{(const pg8::bf16_t*)(wsl + WS_ACT), (const pg8::bf16_t*)(wsl + WS_W2) + (size_t)l * 32 * 1024 * 1024, RMAX, 32 * 1024, 1024};
            pg8::MoeOrder S{nt * 4, G, bx, 4, (const LAS int*)(lds + MISC_OFF + MI_TILE)};
            pg8::EpiMoeOut E{(pg8::bf16_t*)(wsl + WS_YBUF), args.in[33] + (size_t)l * 32 * 1024, (const float*)(wsl + WS_GSORT)};
            pg8::gemm_phase<pg8::EpiMoeOut, pg8::MoeOrder, true, true>(lds, g, S, E);
            SEAM(pb + 7);
        }
        if (PHSEL(8) && IN(pb + 8)) { combine_ln_phase(CTX(), l, vcu, G); SEAM(pb + 8); }
}
__global__ void __launch_bounds__(NTHR, 2) trunk_fwd(Args args) {
    extern __shared__ __attribute__((aligned(16))) unsigned char lds_raw[];
    LAS unsigned char* lds = (LAS unsigned char*)lds_raw;
    const int tid = threadIdx.x;
    const int G = gridDim.x; const int bx = blockIdx.x; const int vcu = (G % 8 == 0) ? (bx % 8) * (G / 8) + bx / 8 : bx;
    unsigned* ctl = (unsigned*)(args.ws + WS_CTL);
    for (int u = tid; u < (LDS_BYTES - MISC_OFF) / 4; u += NTHR) ((LAS unsigned*)(lds + MISC_OFF))[u] = 0u;
    __syncthreads();
#if MK_ONE_LAUNCH
    XcdBarrier bar = xcd_barrier_post(ctl + CW_BAR, (volatile LAS unsigned*)(lds + MISC_OFF + MI_BAR));
#else
    XcdBarrier bar; bar.bar = ctl + CW_BAR; bar.x = 0; bar.st = nullptr;
#endif
    const int lo = args.ph_lo, hi = args.ph_hi;

    if (PHSEL(9) && IN(0)) { p0_prologue(CTX(), lds, vcu, G); SEAM(0); }

#pragma unroll 1
    for (int l = 0; l < 2; ++l) layer_phases(l, args, lds, G, bx, vcu, lo, hi, bar);
#undef IN
#undef SEAM
}

extern "C" void kernel_launch(void* const* d_in, const int* in_sizes, int n_in, void* d_out, int out_size, void* d_ws, size_t ws_size, hipStream_t stream) {
    static int grid = 0;
    if (grid == 0) {
        if (n_in != 36 || in_sizes[0] != NB * SEQ * D || out_size != NB * SEQ * D || ws_size < WS_END) {
            fprintf(stderr, "kernel_launch: unexpected problem (n_in %d, in0 %d, out %d, ws %zu, need %zu); nothing launched\n", n_in, n_in > 0 ? in_sizes[0] : -1, out_size, ws_size, (size_t)WS_END); grid = -1; return; }
        int dev = 0, cus = 0, per_cu = 0;
        if (hipGetDevice(&dev) != hipSuccess || hipDeviceGetAttribute(&cus, hipDeviceAttributeMultiprocessorCount, dev) != hipSuccess) { grid = -1; return; }
        if (hipFuncSetAttribute((const void*)trunk_fwd, hipFuncAttributeMaxDynamicSharedMemorySize, LDS_BYTES) != hipSuccess) { fprintf(stderr, "kernel_launch: hipFuncSetAttribute failed\n"); grid = -1; return; }
        if (hipOccupancyMaxActiveBlocksPerMultiprocessor(&per_cu, (const void*)trunk_fwd, NTHR, LDS_BYTES) != hipSuccess || per_cu < 1) { fprintf(stderr, "kernel_launch: occupancy query says %d\n", per_cu); (void)hipGetLastError(); }
        grid = cus;
        if (grid < 129 || grid > 512) { fprintf(stderr, "kernel_launch: unsupported CU count %d\n", cus); grid = -1; return; }
    }
    if (grid < 0) return;
    if (hipMemsetAsync((char*)d_ws + WS_CTL, 0, CTL_ZERO_BYTES, stream) != hipSuccess) return;
    Args a; memset(&a, 0, sizeof(a));
    for (int i = 0; i < 36; ++i) a.in[i] = (const float*)d_in[i];
    a.out = (float*)d_out; a.ws = (unsigned char*)d_ws;
#if MK_ONE_LAUNCH
    a.ph_lo = 0; a.ph_hi = N_PHASES;
    hipLaunchKernelGGL(trunk_fwd, dim3(grid), dim3(NTHR), LDS_BYTES, stream, a);
#else
    for (int p = 0; p < N_PHASES; ++p) { a.ph_lo = p; a.ph_hi = p + 1; hipLaunchKernelGGL(trunk_fwd, dim3(grid), dim3(NTHR), LDS_BYTES, stream, a); }
#endif
}
```

```cpp
#include <hip/hip_runtime.h>
#include <cstdio>
#include <cstdint>
#include <cstring>

#ifndef MK_ONE_LAUNCH
#define MK_ONE_LAUNCH 1
#endif

#ifndef DSA_NAIVE
#define DSA_NAIVE 0
#endif
#ifndef PHASE_FN
#define PHASE_FN __forceinline__
#endif
#define GAS __attribute__((address_space(1)))
#define LAS __attribute__((address_space(3)))
typedef unsigned short bf16;
typedef unsigned v4u __attribute__((ext_vector_type(4)));
typedef unsigned v2u __attribute__((ext_vector_type(2)));
typedef float v4f __attribute__((ext_vector_type(4)));
typedef float v2f __attribute__((ext_vector_type(2)));

constexpr int NB = 8, SEQ = 8192, NMETA = 16, L = SEQ + NMETA  , T = NB * L  , TP = 65792  , D = 1024;
constexpr int NINP = 3584;
constexpr int NE = 32, TOPK = 4;
constexpr int RMAX = 1058 * 256;
constexpr int C_RW = 0, C_RW_R = 0, C_RW_WD = 256, C_RW_K = 320, C_RW_V = 576, C_RW_AD = 832, C_RW_GD = 896;
constexpr int C_DS_Q = 960, C_DS_K = 1216, C_DS_V = 1472, C_DS_QI = 1728, C_DS_KI = 1984, C_DS_WI = 2016;
constexpr int C_LR_X = 2024, C_LR_G = 2280;
constexpr int C_HG_Q = 2536, C_HG_F = 2792, C_HG_I = 3048, C_HG_G = 3304;
constexpr float ALPHA = 1.41421356237f;
constexpr float LN_EPS = 1e-5f;

constexpr size_t MiB = 1u << 20;
constexpr size_t WS_CTL = 0, CTL_ZERO_BYTES = 1 * MiB;
constexpr size_t WS_WIN = 2 * MiB;
constexpr size_t WS_WOUT = 16 * MiB;
constexpr size_t WS_W1 = 20 * MiB;
constexpr size_t WS_W2 = 276 * MiB;
constexpr size_t WS_H = 404 * MiB;
constexpr size_t WS_HB = 661 * MiB;
constexpr size_t WS_BIG = 790 * MiB;
constexpr size_t WS_PROJ = WS_BIG;
constexpr size_t SZ_HM32 = (size_t)32 * L * 64 * 4;
constexpr size_t SZ_HM16 = SZ_HM32 / 2;
constexpr size_t SZ_TM16 = (size_t)T * 256 * 2;
constexpr size_t WS_RW_W = 1240 * MiB;
constexpr size_t WS_RW_A = WS_RW_W + SZ_HM32, WS_RW_B = WS_RW_A + SZ_HM16, WS_RW_K = WS_RW_B + SZ_HM16, WS_RW_WR = WS_RW_K + SZ_HM16, WS_RW_V = WS_RW_WR + SZ_HM16;
constexpr size_t WS_RW_G = WS_RW_V + SZ_HM16;
constexpr size_t WS_RW_SC = WS_RW_G + SZ_TM16;
constexpr size_t WS_DS_Q = WS_RW_SC + (size_t)32 * L * 16;
constexpr size_t WS_DS_K = WS_DS_Q + SZ_TM16, WS_DS_V = WS_DS_K + SZ_TM16, WS_DS_QI = WS_DS_V + SZ_TM16;
constexpr size_t WS_DS_KI = WS_DS_QI + SZ_TM16;
constexpr size_t WS_DS_WI = WS_DS_KI + (size_t)T * 64;
constexpr size_t WS_LR_A = WS_DS_WI + (size_t)T * 32;
constexpr size_t WS_LR_U = WS_LR_A + (size_t)T * 1024, WS_LR_G = WS_LR_U + SZ_TM16;
constexpr size_t WS_HG_F = WS_LR_G + SZ_TM16;
constexpr size_t WS_HG_K = WS_HG_F + SZ_HM32, WS_HG_Q = WS_HG_K + SZ_HM16, WS_HG_V = WS_HG_Q + SZ_HM16, WS_HG_G = WS_HG_V + SZ_HM16;
constexpr size_t WS_MIX_END = WS_HG_G + SZ_TM16;
constexpr size_t SZ_SORT = (size_t)RMAX * 1024 * 2;
constexpr size_t WS_SORTA = WS_BIG, WS_YBUF = WS_BIG, WS_ACT = WS_BIG + SZ_SORT;
constexpr size_t WS_TIDX = WS_ACT + SZ_SORT;
constexpr size_t WS_TGATE = WS_TIDX + (size_t)T * 16;
constexpr size_t WS_SPOS = WS_TGATE + (size_t)T * 16;
constexpr size_t WS_GSORT = WS_SPOS + (size_t)T * 16;
constexpr size_t WS_MOE_END = WS_GSORT + (size_t)RMAX * 4;
constexpr size_t WS_END = 2040 * MiB;
static_assert(WS_MIX_END <= WS_END && WS_MOE_END <= WS_END, "workspace map");
static_assert(WS_PROJ + (size_t)TP * NINP * 2 <= WS_RW_W, "proj vs prep");
static_assert(WS_HB + (size_t)TP * 1024 * 2 <= WS_BIG && WS_H + (size_t)TP * 4096 <= WS_HB, "h/hb");

constexpr int CW_TMO = 0, CW_CODE = 1;
constexpr int CW_BAR = 4096;
constexpr int CW_DSAQ = 8192;
constexpr int CW_ECNT = 8448;
constexpr int CW_ECUR = 8704;

constexpr int LDS_BYTES = 163840;
constexpr int MISC_OFF = 155648;
constexpr int MI_BAR = 0, MI_HIST = 64, MI_LCUR = 192, MI_LBASE = 320, MI_NT = 448, MI_OFFS = 512, MI_TILE = 1024;
constexpr int NWAVES = 8, NTHR = 512;

__device__ __forceinline__ float bf2f(unsigned short x) { return __uint_as_float((unsigned)x << 16); }
__device__ __forceinline__ float bflo(unsigned x) { return __uint_as_float(x << 16); }
__device__ __forceinline__ float bfhi(unsigned x) { return __uint_as_float(x & 0xffff0000u); }
__device__ __forceinline__ unsigned pk2(float lo, float hi) { unsigned r; asm volatile("v_cvt_pk_bf16_f32 %0, %1, %2" : "=v"(r) : "v"(lo), "v"(hi)); return r; }
__device__ __forceinline__ bf16 f2bf(float f) { return (bf16)(pk2(f, 0.f) & 0xffffu); }
__device__ __forceinline__ v4f ld_bf4(const bf16* p) { const v2u x = *(const v2u*)p; return (v4f){bflo(x.x), bfhi(x.x), bflo(x.y), bfhi(x.y)}; }
__device__ __forceinline__ void st_bf4(bf16* p, v4f v) { v2u o; o.x = pk2(v.x, v.y); o.y = pk2(v.z, v.w); *(v2u*)p = o; }
__device__ __forceinline__ float wave_sum(float v) {
#pragma unroll
    for (int o = 1; o < 64; o <<= 1) v += __shfl_xor(v, o);
    return v;
}
__device__ __forceinline__ float wave_max(float v) {
#pragma unroll
    for (int o = 1; o < 64; o <<= 1) v = fmaxf(v, __shfl_xor(v, o));
    return v;
}
template <int CTRL> __device__ __forceinline__ float dpp_f(float x) { return __int_as_float(__builtin_amdgcn_update_dpp(0, __float_as_int(x), CTRL, 0xF, 0xF, true)); }
__device__ __forceinline__ float sum8(float x) { x += dpp_f<0xB1>(x); x += dpp_f<0x4E>(x); x += dpp_f<0x141>(x); return x; }
__device__ __forceinline__ float sum16(float x) { x = sum8(x); x += dpp_f<0x140>(x); return x; }
__device__ __forceinline__ float sigmoidf_(float x) { return 1.f / (1.f + __expf(-x)); }
__device__ __forceinline__ float softplusf_(float x) { return x > 20.f ? x : log1pf(__expf(x)); }
__device__ __forceinline__ float gelu_tanh(float x) { const float u = 0.7978845608028654f * (x + 0.044715f * x * x * x); return 0.5f * x * (1.f + tanhf(u)); }
__device__ __forceinline__ int lds_add(LAS int* p, int v) { return __hip_atomic_fetch_add(p, v, __ATOMIC_RELAXED, __HIP_MEMORY_SCOPE_WORKGROUP); }
#define LDS_WAIT() asm volatile("s_waitcnt lgkmcnt(0)" ::: "memory")
#define VM_WAIT() asm volatile("s_waitcnt vmcnt(0)" ::: "memory")

__device__ __forceinline__ unsigned char* launder(unsigned char* p) { asm volatile("" : "+s"(p)); return p; }
__device__ __forceinline__ int opaque_tid() { int t = (int)threadIdx.x; asm volatile("" : "+v"(t)); return t; }
struct Args { const float* in[36]; float* out; unsigned char* ws; int ph_lo, ph_hi; };
struct Ctx { const float* const* in; float* out; unsigned char* ws; };
namespace pg8 {
#define PG8_LAS __attribute__((address_space(3)))
typedef unsigned short bf16_t;
typedef short bf16x8 __attribute__((ext_vector_type(8)));
typedef float f32x4 __attribute__((ext_vector_type(4)));
typedef unsigned u32x4 __attribute__((ext_vector_type(4)));
constexpr int BM = 256, BK = 64, HALF = 128, HTB = HALF * BK * 2  , STAGE_BYTES = 8 * HTB, NXCD = 8, WGM = 8;

__host__ __device__ __forceinline__ int lds_byte(int r, int c) { const int st = (r >> 4) * 2 + (c >> 5), rr = r & 15, cc = c & 31, ob = rr * 64 + cc * 2; return st * 1024 + (ob ^ (((ob >> 9) & 1) << 5)); }
__host__ __device__ __forceinline__ void stage_rc(int b, int& R, int& C) { const int st = b / 1024, sb = b % 1024, swz = sb ^ (((sb >> 9) & 1) << 5); R = (st >> 1) * 16 + swz / 64; C = (st & 1) * 32 + (swz % 64) / 2; }
__host__ __device__ __forceinline__ int perm32(int rho) { const int n = rho >> 4, i = rho & 15; return 8 * (i >> 2) + 4 * n + (i & 3); }

struct Unit { int pm, pn; };
struct Gemm { const bf16_t* A; const bf16_t* Bt; int M, N, K; };

struct StaticOrder {
    int nM, nN, nwg, G, c;
    __host__ __device__ void init(int M, int N, int G_, int c_) { nM = M / BM; nN = N / BM; nwg = nM * nN; G = G_; c = c_; }
    __host__ __device__ bool next(int i, Unit& u) const {
        const long L = (long)i * G + c; if (L >= nwg) return false;
        int wgid = (int)L; { const int q = nwg / NXCD, r = nwg % NXCD, xcd = wgid % NXCD, off = wgid / NXCD; wgid = (xcd < r ? xcd * (q + 1) : r * (q + 1) + (xcd - r) * q) + off; }
        const int nig = WGM * nN, gid = wgid / nig, fm = gid * WGM, gsz = (nM - fm) < WGM ? (nM - fm) : WGM;
        u.pm = fm + ((wgid % nig) % gsz); u.pn = (wgid % nig) / gsz; return true;
    }
    __device__ __forceinline__ void a_ready(const Unit&) const {}
    __device__ __forceinline__ void done(const Unit&) const {}
};

__device__ __forceinline__ unsigned cvt_pk_bf16(float lo, float hi) { unsigned r; asm volatile("v_cvt_pk_bf16_f32 %0, %1, %2" : "=v"(r) : "v"(lo), "v"(hi)); return r; }
typedef float f32x2 __attribute__((ext_vector_type(2)));
typedef unsigned u32x2v __attribute__((ext_vector_type(2)));
struct EpiStoreBf16 {
    static constexpr bool PERM = true, AFTER_DRAIN = false;
    bf16_t* O; int ldc;
    __device__ __forceinline__ void operator()(const f32x4 (&acc)[2][2][4][2], const Unit& u, int wr, int wc, int fr, int fq) const {
        const int row0 = u.pm * BM + wr * 64 + fr, col0 = u.pn * BM + wc * 32 + 8 * fq;
#pragma unroll
        for (int ai = 0; ai < 2; ++ai)
#pragma unroll
            for (int m = 0; m < 4; ++m) { bf16_t* rowp = O + (size_t)(row0 + ai * HALF + m * 16) * ldc + col0;
#pragma unroll
                for (int bj = 0; bj < 2; ++bj) { const f32x4 v0 = acc[ai][bj][m][0], v1 = acc[ai][bj][m][1];
                    u32x4 w; w.x = cvt_pk_bf16(v0[0], v0[1]); w.y = cvt_pk_bf16(v0[2], v0[3]); w.z = cvt_pk_bf16(v1[0], v1[1]); w.w = cvt_pk_bf16(v1[2], v1[3]);
                    *(u32x4*)(rowp + bj * HALF) = w; } }
    }
};
struct EpiResid {
    static constexpr bool PERM = false, AFTER_DRAIN = false;
    float* Hres; int ldc; float alpha;
    __device__ __forceinline__ void operator()(const f32x4 (&acc)[2][2][4][2], const Unit& u, int wr, int wc, int fr, int fq) const {
        const int row0 = u.pm * BM + wr * 64 + fr, col0 = u.pn * BM + wc * 32 + 4 * fq;
#pragma unroll
        for (int ai = 0; ai < 2; ++ai)
#pragma unroll
            for (int m = 0; m < 4; ++m) { float* rowp = Hres + (size_t)(row0 + ai * HALF + m * 16) * ldc + col0;
#pragma unroll
                for (int bj = 0; bj < 2; ++bj)
#pragma unroll
                    for (int n = 0; n < 2; ++n) { f32x4* p = (f32x4*)(rowp + bj * HALF + n * 16); const f32x4 old = *p; *p = old * alpha + acc[ai][bj][m][n]; } }
    }
};
struct EpiSwiGLU {
    static constexpr bool PERM = true, AFTER_DRAIN = false;
    bf16_t* ACT; const float* b1;
    __device__ __forceinline__ void operator()(const f32x4 (&acc)[2][2][4][2], const Unit& u, int wr, int wc, int fr, int fq) const {
        const int e = u.pn >> 3, pnl = u.pn & 7;
        const int row0 = u.pm * BM + wr * 64 + fr, c8 = pnl * 128 + wc * 32 + 8 * fq;
        const float* bg = b1 + (size_t)e * 2048 + c8; const float* bl = bg + 1024;
        const f32x4 bg0 = *(const f32x4*)bg, bg1 = *(const f32x4*)(bg + 4), bl0 = *(const f32x4*)bl, bl1 = *(const f32x4*)(bl + 4);
#pragma unroll
        for (int ai = 0; ai < 2; ++ai)
#pragma unroll
            for (int m = 0; m < 4; ++m) {
                float o[8];
#pragma unroll
                for (int n = 0; n < 2; ++n) { const f32x4 g4 = acc[ai][0][m][n] + (n ? bg1 : bg0), l4 = acc[ai][1][m][n] + (n ? bl1 : bl0);
#pragma unroll
                    for (int j = 0; j < 4; ++j) { const float glu = fminf(g4[j], 7.f), lin = fminf(fmaxf(l4[j], -7.f), 7.f);
                        o[n * 4 + j] = glu * (1.f / (1.f + __expf(-1.702f * glu))) * (lin + 1.f); } }
                u32x4 w; w.x = cvt_pk_bf16(o[0], o[1]); w.y = cvt_pk_bf16(o[2], o[3]); w.z = cvt_pk_bf16(o[4], o[5]); w.w = cvt_pk_bf16(o[6], o[7]);
                *(u32x4*)(ACT + (size_t)(row0 + ai * HALF + m * 16) * 1024 + c8) = w; }
    }
};
struct EpiMoeOut {
    static constexpr bool PERM = true, AFTER_DRAIN = false;
    bf16_t* Y; const float* b2; const float* gate;
    __device__ __forceinline__ void operator()(const f32x4 (&acc)[2][2][4][2], const Unit& u, int wr, int wc, int fr, int fq) const {
        const int e = u.pn >> 2, pnl = u.pn & 3;
        const int row0 = u.pm * BM + wr * 64 + fr, c8 = pnl * 256 + wc * 32 + 8 * fq;
        const float* bb = b2 + (size_t)e * 1024 + c8;
        f32x4 bv[2][2];
#pragma unroll
        for (int bj = 0; bj < 2; ++bj) { bv[bj][0] = *(const f32x4*)(bb + bj * HALF); bv[bj][1] = *(const f32x4*)(bb + bj * HALF + 4); }
#pragma unroll
        for (int ai = 0; ai < 2; ++ai)
#pragma unroll
            for (int m = 0; m < 4; ++m) { const int row = row0 + ai * HALF + m * 16; const float gt = gate[row];
#pragma unroll
                for (int bj = 0; bj < 2; ++bj) { const f32x4 v0 = (acc[ai][bj][m][0] + bv[bj][0]) * gt, v1 = (acc[ai][bj][m][1] + bv[bj][1]) * gt;
                    u32x4 w; w.x = cvt_pk_bf16(v0[0], v0[1]); w.y = cvt_pk_bf16(v0[2], v0[3]); w.z = cvt_pk_bf16(v1[0], v1[1]); w.w = cvt_pk_bf16(v1[2], v1[3]);
                    *(u32x4*)(Y + (size_t)row * 1024 + c8 + bj * HALF) = w; } }
    }
};
struct MoeOrder {
    int n_units, G, c, npn; const PG8_LAS int* tile_e;
    __device__ __forceinline__ bool next(int i, Unit& u) const {
        const int Lx = i * G + c; if (Lx >= n_units) return false;
        const int tile = Lx / npn, pnl = Lx - tile * npn;
        u.pm = tile; u.pn = tile_e[tile] * npn + pnl; return true;
    }
    __device__ __forceinline__ void a_ready(const Unit&) const {}
    __device__ __forceinline__ void done(const Unit&) const {}
};

template <class Epi, class Sched, bool ALIGN_EPI = false, bool SP2 = false>
__device__ __forceinline__ void gemm_phase(PG8_LAS unsigned char* lds, const Gemm g, const Sched& S, const Epi& E) {
    const int tid = opaque_tid(), wid = __builtin_amdgcn_readfirstlane(tid >> 6), lane = tid & 63, wr = wid >> 2, wc = wid & 3, fr = lane & 15, fq = lane >> 4;
    const int K = g.K, nt = K / BK;
    unsigned voffA[2], voffB[2];
#pragma unroll
    for (int i = 0; i < 2; ++i) { int R, C; stage_rc(tid * 16 + i * 8192, R, C); const int Rb = Epi::PERM ? ((R & ~31) + perm32(R & 31)) : R;
        voffA[i] = (unsigned)(R * K + C) * 2u; voffB[i] = (unsigned)(Rb * K + C) * 2u; }
    const size_t kstep = (size_t)(BK * 2);
    const size_t hstep = (size_t)HALF * K * 2;
    const size_t tstep = 2 * hstep;
    const unsigned ldsw = (unsigned)wid * 1024u;
    const int aoff = lds_byte(wr * 64 + fr, fq * 8), boff = lds_byte(wc * 32 + fr, fq * 8);
#define PG8_SA(b, h) (((b) * 2 + (h)) * HTB)
#define PG8_SB(b, h) ((4 + (b) * 2 + (h)) * HTB)
#define PG8_STAGE(bufoff, gbase, voff) do { _Pragma("unroll") for (int _i = 0; _i < 2; ++_i) \
        __builtin_amdgcn_global_load_lds((const unsigned*)((const char*)(gbase) + (voff)[_i]), (PG8_LAS unsigned*)(lds + (bufoff) + ldsw + _i * 8192), 16, 0, 0); } while (0)
#define PG8_LDA(dst, b, h) do { _Pragma("unroll") for (int m = 0; m < 4; ++m) _Pragma("unroll") for (int k = 0; k < 2; ++k) dst[m][k] = *(const PG8_LAS bf16x8*)(lds + PG8_SA(b, h) + aoff + m * 2048 + k * 1024); } while (0)
#define PG8_LDB(dst, b, h) do { _Pragma("unroll") for (int n = 0; n < 2; ++n) _Pragma("unroll") for (int k = 0; k < 2; ++k) dst[n][k] = *(const PG8_LAS bf16x8*)(lds + PG8_SB(b, h) + boff + n * 2048 + k * 1024); } while (0)
#define PG8_MMA(ai, bj, At, Bt) do { __builtin_amdgcn_s_setprio(1); _Pragma("unroll") for (int m = 0; m < 4; ++m) _Pragma("unroll") for (int n = 0; n < 2; ++n) _Pragma("unroll") for (int k = 0; k < 2; ++k) \
        acc[ai][bj][m][n] = __builtin_amdgcn_mfma_f32_16x16x32_bf16(Bt[n][k], At[m][k], acc[ai][bj][m][n], 0, 0, 0); __builtin_amdgcn_s_setprio(0); } while (0)
#define PG8_WAIT_V(n) asm volatile("s_waitcnt vmcnt(" #n ")" ::: "memory")
#define PG8_WAIT_L(n) asm volatile("s_waitcnt lgkmcnt(" #n ")" ::: "memory")
#define PG8_BAR __builtin_amdgcn_s_barrier()
#define PG8_SCHED __builtin_amdgcn_sched_barrier(0)
    Unit cur, nxt; int ui = 0;
    if (!S.next(0, cur)) return;
    f32x4 acc[2][2][4][2];
#pragma unroll
    for (int a = 0; a < 2; ++a)
#pragma unroll
        for (int b = 0; b < 2; ++b)
#pragma unroll
            for (int m = 0; m < 4; ++m)
#pragma unroll
                for (int n = 0; n < 2; ++n) acc[a][b][m][n] = (f32x4){0.f, 0.f, 0.f, 0.f};
    bf16x8 At[4][2], B0[2][2], B1[2][2];
    const char* cA = (const char*)g.A + (size_t)cur.pm * tstep; const char* cB = (const char*)g.Bt + (size_t)cur.pn * tstep;
    S.a_ready(cur);
    if constexpr (SP2) {
        PG8_STAGE(PG8_SB(0, 0), cB, voffB); PG8_STAGE(PG8_SB(0, 1), cB + hstep, voffB); PG8_STAGE(PG8_SA(0, 0), cA, voffA); PG8_STAGE(PG8_SA(0, 1), cA + hstep, voffA);
        if (wr == 1) PG8_BAR;
        PG8_WAIT_V(2); PG8_BAR;
        PG8_STAGE(PG8_SB(1, 0), cB + kstep, voffB); PG8_STAGE(PG8_SA(1, 0), cA + kstep, voffA); PG8_STAGE(PG8_SB(1, 1), cB + hstep + kstep, voffB);
        PG8_WAIT_V(6); PG8_BAR;
    } else {
        PG8_STAGE(PG8_SB(0, 0), cB, voffB); PG8_STAGE(PG8_SA(0, 0), cA, voffA); PG8_STAGE(PG8_SB(0, 1), cB + hstep, voffB); PG8_STAGE(PG8_SA(0, 1), cA + hstep, voffA);
        if (wr == 1) PG8_BAR;
        PG8_WAIT_V(4); PG8_BAR;
        PG8_STAGE(PG8_SB(1, 0), cB + kstep, voffB); PG8_STAGE(PG8_SA(1, 0), cA + kstep, voffA); PG8_STAGE(PG8_SB(1, 1), cB + hstep + kstep, voffB);
        PG8_WAIT_V(6); PG8_BAR;
    }
    for (;;) {
        const bool has_next = S.next(ui + 1, nxt);
        const char* nA = has_next ? (const char*)g.A + (size_t)nxt.pm * tstep : cA; const char* nB = has_next ? (const char*)g.Bt + (size_t)nxt.pn * tstep : cB;
        for (int t = 0; t < nt; t += 2) {
            const bool last = (t == nt - 2);
            const char* a1 = cA + (size_t)(t + 1) * kstep;
            const char* a2 = last ? nA : cA + (size_t)(t + 2) * kstep; const char* b2 = last ? nB : cB + (size_t)(t + 2) * kstep;
            const char* a3 = a2 + kstep; const char* b3 = b2 + kstep;
            if (last && has_next) S.a_ready(nxt);
            if constexpr (SP2) {
            PG8_LDB(B0, 0, 0); PG8_LDB(B1, 0, 1); PG8_SCHED; PG8_LDA(At, 0, 0); PG8_STAGE(PG8_SA(1, 1), a1 + hstep, voffA);
            PG8_WAIT_V(8); PG8_WAIT_L(0); PG8_BAR; PG8_MMA(0, 0, At, B0); PG8_MMA(0, 1, At, B1); PG8_BAR; PG8_SCHED;
            PG8_LDA(At, 0, 1); PG8_STAGE(PG8_SB(0, 0), b2, voffB); PG8_STAGE(PG8_SB(0, 1), b2 + hstep, voffB); PG8_STAGE(PG8_SA(0, 0), a2, voffA);
            PG8_WAIT_V(8); PG8_WAIT_L(0); PG8_BAR; PG8_MMA(1, 0, At, B0); PG8_MMA(1, 1, At, B1); PG8_BAR; PG8_SCHED;
            PG8_LDB(B0, 1, 0); PG8_LDB(B1, 1, 1); PG8_SCHED; PG8_LDA(At, 1, 0); PG8_STAGE(PG8_SA(0, 1), a2 + hstep, voffA);
            PG8_WAIT_V(8); PG8_WAIT_L(0); PG8_BAR; PG8_MMA(0, 0, At, B0); PG8_MMA(0, 1, At, B1); PG8_BAR; PG8_SCHED;
            PG8_LDA(At, 1, 1); PG8_STAGE(PG8_SB(1, 0), b3, voffB); PG8_STAGE(PG8_SB(1, 1), b3 + hstep, voffB); PG8_STAGE(PG8_SA(1, 0), a3, voffA);
            PG8_WAIT_V(8); PG8_WAIT_L(0); PG8_BAR; PG8_MMA(1, 0, At, B0); PG8_MMA(1, 1, At, B1); PG8_BAR; PG8_SCHED;
            } else {
            PG8_LDB(B0, 0, 0); PG8_SCHED; PG8_LDA(At, 0, 0); PG8_STAGE(PG8_SA(1, 1), a1 + hstep, voffA);
            PG8_WAIT_L(8); PG8_BAR; PG8_WAIT_L(0); PG8_MMA(0, 0, At, B0); PG8_BAR; PG8_SCHED;
            PG8_LDB(B1, 0, 1); PG8_STAGE(PG8_SB(0, 0), b2, voffB);
            PG8_BAR; PG8_WAIT_L(0); PG8_MMA(0, 1, At, B1); PG8_BAR;
            PG8_LDA(At, 0, 1); PG8_STAGE(PG8_SA(0, 0), a2, voffA);
            PG8_BAR; PG8_WAIT_L(0); PG8_MMA(1, 0, At, B0); PG8_BAR; PG8_SCHED;
            PG8_STAGE(PG8_SB(0, 1), b2 + hstep, voffB);
            PG8_WAIT_V(6); PG8_BAR; PG8_MMA(1, 1, At, B1); PG8_BAR;
            PG8_LDB(B0, 1, 0); PG8_SCHED; PG8_LDA(At, 1, 0); PG8_STAGE(PG8_SA(0, 1), a2 + hstep, voffA);
            PG8_WAIT_L(8); PG8_BAR; PG8_WAIT_L(0); PG8_MMA(0, 0, At, B0); PG8_BAR; PG8_SCHED;
            PG8_LDB(B1, 1, 1); PG8_STAGE(PG8_SB(1, 0), b3, voffB);
            PG8_BAR; PG8_WAIT_L(0); PG8_MMA(0, 1, At, B1); PG8_BAR;
            PG8_LDA(At, 1, 1); PG8_STAGE(PG8_SA(1, 0), a3, voffA);
            PG8_BAR; PG8_WAIT_L(0); PG8_MMA(1, 0, At, B0); PG8_BAR; PG8_SCHED;
            PG8_STAGE(PG8_SB(1, 1), b3 + hstep, voffB);
            PG8_WAIT_V(6); PG8_BAR; PG8_MMA(1, 1, At, B1); PG8_BAR;
            }
        }
        if constexpr (ALIGN_EPI) { if (wr == 0) PG8_BAR; }
        if constexpr (!Epi::AFTER_DRAIN) { E(acc, cur, wr, wc, fr, fq); S.done(cur); }
        if (!has_next) break;
#pragma unroll
        for (int a = 0; a < 2; ++a)
#pragma unroll
            for (int b = 0; b < 2; ++b)
#pragma unroll
                for (int m = 0; m < 4; ++m)
#pragma unroll
                    for (int n = 0; n < 2; ++n) acc[a][b][m][n] = (f32x4){0.f, 0.f, 0.f, 0.f};
        cur = nxt; cA = nA; cB = nB; ++ui;
        if constexpr (ALIGN_EPI) { if (wr == 1) PG8_BAR; }
    }
    PG8_WAIT_V(0);
    if constexpr (!ALIGN_EPI) { if (wr == 0) PG8_BAR; }
    PG8_BAR;
    if constexpr (Epi::AFTER_DRAIN) { E.fused(acc, cur, wr, wc, fr, fq, lds, wid, lane); S.done(cur); }
#undef PG8_SA
#undef PG8_SB
#undef PG8_STAGE
#undef PG8_LDA
#undef PG8_LDB
#undef PG8_MMA
#undef PG8_WAIT_V
#undef PG8_WAIT_L
#undef PG8_BAR
#undef PG8_SCHED
}
}
#define XB_TMO      128
#define XB_XCNT(j)  (256  + 64 * (j))
#define XB_XSUB(j)  (1280 + 64 * (j))
#define XB_XGEN(j)  (2304 + 64 * (j))
#define XB_TOP      3328
#define XB_TOPGEN   3392
#define XCD_BAR_WORDS 3456
#define XB_SPIN_CAP (1u << 18)
#define LAS __attribute__((address_space(3)))

__device__ __forceinline__ unsigned xb_ld(unsigned* p)              { return __hip_atomic_load(p, __ATOMIC_RELAXED, __HIP_MEMORY_SCOPE_AGENT); }
__device__ __forceinline__ unsigned xb_add(unsigned* p, unsigned v) { return __hip_atomic_fetch_add(p, v, __ATOMIC_RELAXED, __HIP_MEMORY_SCOPE_AGENT); }
__device__ __forceinline__ unsigned xb_xcc_id() { return (unsigned)__builtin_amdgcn_s_getreg((3 << 11) | 20) & 0xFu; }
#define XB_SPIN(cond, bar) do { unsigned _sp = 0; while (cond) { __builtin_amdgcn_s_sleep(1); \
    if ((++_sp & 255u) == 0u) { if (xb_ld(&(bar)[XB_TMO])) break; if (_sp > XB_SPIN_CAP) { atomicAdd(&(bar)[XB_TMO], 1u); break; } } } } while (0)

struct XcdBarrier {
    unsigned* bar; unsigned x;
    volatile LAS unsigned* st;
};

__device__ __forceinline__ XcdBarrier xcd_barrier_post(unsigned* bar, volatile LAS unsigned* st) {
    XcdBarrier b; b.bar = bar; b.x = xb_xcc_id(); b.st = st;
    if (threadIdx.x == 0) (void)xb_add(&bar[XB_XCNT(b.x)], 1u);
    return b;
}
__device__ __forceinline__ void xcd_barrier_complete(unsigned* bar, unsigned x, unsigned& nloc, unsigned& nx) {
    const unsigned G = gridDim.x * gridDim.y * gridDim.z;
    unsigned sum, cnt, mine, sp = 0u;
    for (;;) {
        sum = 0u; cnt = 0u; mine = 0u;
#pragma unroll
        for (unsigned j = 0; j < 16; ++j) { const unsigned c = xb_ld(&bar[XB_XCNT(j)]); sum += c; cnt += (c > 0u) ? 1u : 0u; mine = (j == x) ? c : mine; }
        if (sum == G) break;
        __builtin_amdgcn_s_sleep(1);
        if ((++sp & 255u) == 0u) { if (xb_ld(&bar[XB_TMO])) break; if (sp > XB_SPIN_CAP) { atomicAdd(&bar[XB_TMO], 1u); break; } }
    }
    nloc = mine > 0u ? mine : 1u; nx = cnt > 0u ? cnt : 1u;
}

__device__ __forceinline__ void xcd_barrier(const XcdBarrier& b) {
    asm volatile("s_waitcnt vmcnt(0)" ::: "memory");
    __syncthreads();
    if (threadIdx.x == 0) {
        unsigned* bar = b.bar;
        __builtin_amdgcn_s_waitcnt(0);
        unsigned nloc = b.st[0], nx = b.st[1];
        if (nloc == 0u) { xcd_barrier_complete(bar, b.x, nloc, nx); b.st[0] = nloc; b.st[1] = nx; }
        const unsigned old = xb_add(&bar[XB_XSUB(b.x)], 1u);
        const unsigned gen = old / nloc;
        if (old + 1u == (gen + 1u) * nloc) {
            __builtin_amdgcn_fence(__ATOMIC_RELEASE, "agent");
            asm volatile("s_waitcnt vmcnt(0)" ::: "memory");
            const unsigned og = xb_add(&bar[XB_TOP], 1u);
            const unsigned tg = og / nx;
            if (og + 1u == (tg + 1u) * nx) xb_add(&bar[XB_TOPGEN], 1u);
            else XB_SPIN(xb_ld(&bar[XB_TOPGEN]) == tg, bar);
            __builtin_amdgcn_fence(__ATOMIC_ACQUIRE, "agent");
            xb_add(&bar[XB_XGEN(b.x)], 1u);
            asm volatile("s_waitcnt vmcnt(0)" ::: "memory");
        } else {
            XB_SPIN(xb_ld(&bar[XB_XGEN(b.x)]) == gen, bar);
            __builtin_amdgcn_fence(__ATOMIC_ACQUIRE, "agent");
            asm volatile("s_waitcnt vmcnt(0)" ::: "memory");
        }
    }
    __syncthreads();
}
__device__ __forceinline__ void p0_transpose_item(const float* W, int ldw, int ncols_valid, int k0, int n0, bf16* WT, size_t dst_row0, int Kdst, LAS float* scr, int lane) {
    const int nn = n0 + (lane & 31); const bool ok = nn < ncols_valid;
#pragma unroll 8
    for (int i = 0; i < 32; ++i) { const int kk = 2 * i + (lane >> 5); scr[kk * 33 + (lane & 31)] = ok ? W[(size_t)(k0 + kk) * ldw + nn] : 0.f; }
    LDS_WAIT();
    const int c = lane & 7;
#pragma unroll
    for (int j = 0; j < 4; ++j) { const int n = (lane >> 3) + 8 * j; const LAS float* s = scr + (8 * c) * 33 + n;
        v4u o; o.x = pk2(s[0 * 33], s[1 * 33]); o.y = pk2(s[2 * 33], s[3 * 33]); o.z = pk2(s[4 * 33], s[5 * 33]); o.w = pk2(s[6 * 33], s[7 * 33]);
        *(v4u*)(WT + (dst_row0 + n) * (size_t)Kdst + k0 + 8 * c) = o; }
    LDS_WAIT();
}
__device__ __forceinline__ void ln_row(v4f (&v)[4], const float* g, const float* b, int lane) {
    float s = 0.f;
#pragma unroll
    for (int j = 0; j < 4; ++j) s += (v[j].x + v[j].y) + (v[j].z + v[j].w);
    const float mean = wave_sum(s) * (1.f / D); float s2 = 0.f;
#pragma unroll
    for (int j = 0; j < 4; ++j) { v[j] = v[j] - mean; s2 += (v[j].x * v[j].x + v[j].y * v[j].y) + (v[j].z * v[j].z + v[j].w * v[j].w); }
    const float rstd = 1.f / sqrtf(wave_sum(s2) * (1.f / D) + LN_EPS);
#pragma unroll
    for (int j = 0; j < 4; ++j) { const v4f gg = *(const v4f*)(g + 256 * j + 4 * lane), bb = *(const v4f*)(b + 256 * j + 4 * lane); v[j] = v[j] * rstd * gg + bb; }
}
__device__ PHASE_FN void p0_prologue(const Ctx A, LAS unsigned char* lds, int vcu, int G) {
    const int tid = opaque_tid(), lane = tid & 63, wave = tid >> 6;
    LAS float* scr = (LAS float*)(lds + wave * 16384);
    const int gw = vcu * NWAVES + wave, NGW = G * NWAVES;
    bf16* Win_t = (bf16*)(A.ws + WS_WIN); bf16* Wout_t = (bf16*)(A.ws + WS_WOUT); bf16* W1_t = (bf16*)(A.ws + WS_W1); bf16* W2_t = (bf16*)(A.ws + WS_W2);
    constexpr int I_IN = 2 * 16 * (NINP / 32), I_OUT = 2 * 16 * 32, I_W1 = 64 * 16 * 64, I_W2 = 64 * 16 * 32;
    constexpr int NITEMS = I_IN + I_OUT + I_W1 + I_W2;
    for (int it = gw; it < NITEMS; it += NGW) {
        int r = it;
        if (r < I_IN) { const int l = r / (16 * 112), q = r % (16 * 112), kb = q / 112, nb = q % 112;
            p0_transpose_item(A.in[4] + (size_t)l * 1024 * 3560, 3560, 3560, kb * 64, nb * 32, Win_t + (size_t)l * NINP * 1024, (size_t)nb * 32, 1024, scr, lane); continue; }
        r -= I_IN;
        if (r < I_OUT) { const int l = r / 512, q = r % 512, kb = q / 32, nb = q % 32;
            p0_transpose_item(A.in[25] + (size_t)l * 1024 * 1024, 1024, 1024, kb * 64, nb * 32, Wout_t + (size_t)l * 1024 * 1024, (size_t)nb * 32, 1024, scr, lane); continue; }
        r -= I_OUT;
        if (r < I_W1) { const int le = r / 1024, q = r % 1024, kb = q / 64, nb = q % 64, n0 = nb * 32;
            const int np = n0 & 1023; const size_t drow = (size_t)256 * (np >> 7) + (n0 >= 1024 ? 128 : 0) + (np & 127);
            p0_transpose_item(A.in[30] + (size_t)le * 1024 * 2048, 2048, 2048, kb * 64, n0, W1_t + (size_t)le * 2048 * 1024, drow, 1024, scr, lane); continue; }
        r -= I_W1;
        { const int le = r / 512, q = r % 512, kb = q / 32, nb = q % 32;
            p0_transpose_item(A.in[32] + (size_t)le * 1024 * 1024, 1024, 1024, kb * 64, nb * 32, W2_t + (size_t)le * 1024 * 1024, (size_t)nb * 32, 1024, scr, lane); }
    }
    float* H = (float*)(A.ws + WS_H); bf16* HB = (bf16*)(A.ws + WS_HB);
    for (int m = gw; m < T; m += NGW) {
        const int b = m / L, i = m - b * L;
        const float* src = (i < NMETA) ? A.in[1] + (size_t)i * D : A.in[0] + ((size_t)b * SEQ + (i - NMETA)) * D;
        v4f v[4];
#pragma unroll
        for (int j = 0; j < 4; ++j) v[j] = *(const v4f*)(src + 256 * j + 4 * lane);
        ln_row(v, A.in[2], A.in[3], lane);
#pragma unroll
        for (int j = 0; j < 4; ++j) { *(v4f*)(H + (size_t)m * D + 256 * j + 4 * lane) = v[j]; st_bf4(HB + (size_t)m * D + 256 * j + 4 * lane, v[j]); }
    }
}
constexpr int NTK = 4;
__device__ __forceinline__ float softplus_fast(float x) { return x > 15.f ? x : __logf(1.f + __expf(x)); }
__device__ __forceinline__ float tanh_fast(float x) { return 1.f - 2.f / (1.f + __expf(2.f * x)); }
__device__ __forceinline__ void sincos_red(float ang, float& sn, float& cs) {
    const float k = rintf(ang * 0.15915494309189535f);
    float r = fmaf(-k, 6.28318548202514648f, ang); r = fmaf(-k, -1.7484555e-7f, r);
    sn = __sinf(r); cs = __cosf(r);
}
__device__ PHASE_FN void prep_phase(const Ctx A, LAS unsigned char* lds, int l, int vcu, int G) {
    const int tid = opaque_tid(), lane = tid & 63, wave = tid >> 6;
    LAS float* scr = (LAS float*)(lds + wave * 16384);
    LAS float* lin = scr + 3072;
    const int gw = vcu * NWAVES + wave, NGW = G * NWAVES;
    const bf16* PROJ = (const bf16*)(A.ws + WS_PROJ);
    const int c4 = 4 * lane, hh = lane >> 4, d4 = 4 * (lane & 15);
    const float* mu = A.in[5] + l * 960; const float* w0 = A.in[6] + l * 256; const float* w2 = A.in[7] + l * 64 * 256;
    const float* a0 = A.in[8] + l * 256; const float* a2 = A.in[9] + l * 64 * 256; const float* g2 = A.in[10] + l * 64 * 256;
    const float* k_k = A.in[11] + l * 256; const float* k_a = A.in[12] + l * 256; const float* r_k = A.in[13] + l * 256;
    const float* conv_w = A.in[16] + l * 4 * 256; const float* conv_b = A.in[17] + l * 256;
    const float* wa = A.in[18] + l * 4 * 64 * 64; const float* ba = A.in[19] + l * 256; const float* wx = A.in[20] + l * 4 * 64 * 64; const float* bx = A.in[21] + l * 256;
    const float* lam = A.in[22] + l * 256; const float* lbs = A.in[23];
    float* RW_W = (float*)(A.ws + WS_RW_W); bf16* RW_A = (bf16*)(A.ws + WS_RW_A); bf16* RW_B = (bf16*)(A.ws + WS_RW_B); bf16* RW_K = (bf16*)(A.ws + WS_RW_K);
    bf16* RW_WR = (bf16*)(A.ws + WS_RW_WR); bf16* RW_V = (bf16*)(A.ws + WS_RW_V); bf16* RW_G = (bf16*)(A.ws + WS_RW_G); float* RW_SC = (float*)(A.ws + WS_RW_SC);
    bf16* DS_Q = (bf16*)(A.ws + WS_DS_Q); bf16* DS_K = (bf16*)(A.ws + WS_DS_K); bf16* DS_V = (bf16*)(A.ws + WS_DS_V); bf16* DS_QI = (bf16*)(A.ws + WS_DS_QI);
    bf16* DS_KI = (bf16*)(A.ws + WS_DS_KI); float* DS_WI = (float*)(A.ws + WS_DS_WI);
    float* LR_A = (float*)(A.ws + WS_LR_A); bf16* LR_U = (bf16*)(A.ws + WS_LR_U); bf16* LR_G = (bf16*)(A.ws + WS_LR_G);
    float* HG_F = (float*)(A.ws + WS_HG_F); bf16* HG_K = (bf16*)(A.ws + WS_HG_K); bf16* HG_Q = (bf16*)(A.ws + WS_HG_Q); bf16* HG_V = (bf16*)(A.ws + WS_HG_V); bf16* HG_G = (bf16*)(A.ws + WS_HG_G);
    LAS unsigned* kmaxl = (LAS unsigned*)(lds + MISC_OFF + 640);
    if (tid < 32) kmaxl[tid] = 0u;
    __syncthreads();
    const bool q_rot = (lane & 15) < 4, q_hi = (lane & 15) >= 2;
    const bool i_rot = (lane & 7) < 2, i_hi = (lane & 7) == 1;

#pragma unroll 1
    for (int grp = gw; grp < T / NTK; grp += NGW) {
        const int m0 = grp * NTK, b = m0 / L, i0 = m0 - b * L;
        const bf16* P = PROJ + (size_t)m0 * NINP;
        {
            const float mu_wd = mu[C_RW_WD + lane], mu_ad = mu[C_RW_AD + lane], mu_gd = mu[C_RW_GD + lane];
            float pwd = 0.f, pad = 0.f, pgd = 0.f;
            if (i0 > 0) { pwd = bf2f(P[-NINP + C_RW_WD + lane]); pad = bf2f(P[-NINP + C_RW_AD + lane]); pgd = bf2f(P[-NINP + C_RW_GD + lane]); }
#pragma unroll
            for (int j = 0; j < NTK; ++j) {
                const float cwd = bf2f(P[j * NINP + C_RW_WD + lane]), cad = bf2f(P[j * NINP + C_RW_AD + lane]), cgd = bf2f(P[j * NINP + C_RW_GD + lane]);
                const float swd = cwd + (pwd - cwd) * mu_wd, sad = cad + (pad - cad) * mu_ad, sgd = cgd + (pgd - cgd) * mu_gd;
                lin[(0 * NTK + j) * 64 + lane] = tanh_fast(swd); lin[(1 * NTK + j) * 64 + lane] = sad; lin[(2 * NTK + j) * 64 + lane] = sigmoidf_(sgd);
                pwd = cwd; pad = cad; pgd = cgd;
            }
            LDS_WAIT();
        }
#pragma unroll 1
        for (int mat = 0; mat < 3; ++mat) {
            const float* Wm = mat == 0 ? w2 : (mat == 1 ? a2 : g2);
            v4f acc[NTK];
#pragma unroll
            for (int j = 0; j < NTK; ++j) acc[j] = (v4f){0.f, 0.f, 0.f, 0.f};
#pragma unroll 2
            for (int k = 0; k < 64; k += 4) {
                v4f xx[NTK];
#pragma unroll
                for (int j = 0; j < NTK; ++j) xx[j] = *(const LAS v4f*)(lin + (mat * NTK + j) * 64 + k);
#pragma unroll
                for (int kk = 0; kk < 4; ++kk) { const v4f ww = *(const v4f*)(Wm + (k + kk) * 256 + c4);
#pragma unroll
                    for (int j = 0; j < NTK; ++j) acc[j] += ww * xx[j][kk]; }
            }
#pragma unroll
            for (int j = 0; j < NTK; ++j) *(LAS v4f*)(scr + (mat * NTK + j) * 256 + c4) = acc[j];
        }
        LDS_WAIT();
        {
            const v4f mu_r = *(const v4f*)(mu + C_RW_R + c4), mu_k = *(const v4f*)(mu + C_RW_K + c4), mu_v = *(const v4f*)(mu + C_RW_V + c4);
            const v4f w0v = *(const v4f*)(w0 + c4), a0v = *(const v4f*)(a0 + c4), kkv = *(const v4f*)(k_k + c4), kav = *(const v4f*)(k_a + c4), rkv = *(const v4f*)(r_k + c4);
            v4f pr = (v4f){0.f, 0.f, 0.f, 0.f}, pk = pr, pv = pr;
            if (i0 > 0) { pr = ld_bf4(P - NINP + C_RW_R + c4); pk = ld_bf4(P - NINP + C_RW_K + c4); pv = ld_bf4(P - NINP + C_RW_V + c4); }
#pragma unroll 1
            for (int j = 0; j < NTK; ++j) {
                const v4f cr = ld_bf4(P + j * NINP + C_RW_R + c4), ck = ld_bf4(P + j * NINP + C_RW_K + c4), cv = ld_bf4(P + j * NINP + C_RW_V + c4);
                const v4f rs = cr + (pr - cr) * mu_r, ks = ck + (pk - ck) * mu_k, vs = cv + (pv - cv) * mu_v;
                pr = cr; pk = ck; pv = cv;
                const v4f lw = *(const LAS v4f*)(scr + (0 * NTK + j) * 256 + c4), la = *(const LAS v4f*)(scr + (1 * NTK + j) * 256 + c4), lg = *(const LAS v4f*)(scr + (2 * NTK + j) * 256 + c4);
                v4f dec, av, kkn, km, bv, wr;
                float n2 = 0.f, sbr = 0.f, skr = 0.f, sbo = 0.f;
#pragma unroll
                for (int e = 0; e < 4; ++e) {
                    const float wv = -softplus_fast(-(w0v[e] + lw[e])) - 0.5f;
                    dec[e] = __expf(-__expf(wv));
                    av[e] = sigmoidf_(a0v[e] + la[e]);
                    kkn[e] = ks[e] * kkv[e]; n2 += kkn[e] * kkn[e];
                    km[e] = ks[e] * (1.f + (av[e] - 1.f) * kav[e]);
                }
                n2 = sum16(n2);
                const float inv = 1.f / fmaxf(sqrtf(n2), 1e-12f);
#pragma unroll
                for (int e = 0; e < 4; ++e) { kkn[e] *= inv; bv[e] = kkn[e] * av[e]; wr[e] = dec[e] * rs[e]; sbr += bv[e] * rs[e]; skr += km[e] * rs[e]; sbo += rs[e] * km[e] * rkv[e]; kkn[e] = -kkn[e]; }
                sbr = sum16(sbr); skr = sum16(skr); sbo = sum16(sbo);
                const size_t hm = ((size_t)(b * 4 + hh) * L + (i0 + j)) * 64 + d4;
                *(v4f*)(RW_W + hm) = dec; st_bf4(RW_A + hm, kkn); st_bf4(RW_B + hm, bv); st_bf4(RW_K + hm, km); st_bf4(RW_WR + hm, wr); st_bf4(RW_V + hm, vs);
                st_bf4(RW_G + (size_t)(m0 + j) * 256 + c4, lg);
                if ((lane & 15) == 0) *(v4f*)(RW_SC + ((size_t)(b * 4 + hh) * L + (i0 + j)) * 4) = (v4f){sbr, skr, sbo, 0.f};
            }
        }
        {
            float invf_q[4], invf_i[4];
#pragma unroll
            for (int e = 0; e < 4; ++e) { invf_q[e] = exp2f(-(float)((d4 + e) & 7) * (18.931568569324174f / 8.f)); invf_i[e] = exp2f(-(float)e * (18.931568569324174f / 4.f)); }
#pragma unroll 1
            for (int j = 0; j < NTK; ++j) {
                const int m = m0 + j; const float pos = (float)(i0 + j);
                const bf16* Pj = P + j * NINP;
                v4f q = ld_bf4(Pj + C_DS_Q + c4), k = ld_bf4(Pj + C_DS_K + c4);
                const v4f v = ld_bf4(Pj + C_DS_V + c4);
                v4f qi = ld_bf4(Pj + C_DS_QI + c4), ki = ld_bf4(Pj + C_DS_KI + 4 * (lane & 7));
#pragma unroll
                for (int e = 0; e < 4; ++e) {
                    const float qp = __shfl_xor(q[e], 2), kp = __shfl_xor(k[e], 2), qip = __shfl_xor(qi[e], 1), kip = __shfl_xor(ki[e], 1);
                    float sn, cs; sincos_red(pos * invf_q[e], sn, cs);
                    if (q_rot) { q[e] = q_hi ? (qp * sn + q[e] * cs) : (q[e] * cs - qp * sn); k[e] = q_hi ? (kp * sn + k[e] * cs) : (k[e] * cs - kp * sn); }
                    sincos_red(pos * invf_i[e], sn, cs);
                    if (i_rot) { qi[e] = i_hi ? (qip * sn + qi[e] * cs) : (qi[e] * cs - qip * sn); ki[e] = i_hi ? (kip * sn + ki[e] * cs) : (ki[e] * cs - kip * sn); }
                }
                { float kn2 = sum16(k.x * k.x + k.y * k.y + k.z * k.z + k.w * k.w); if ((lane & 15) == 0) __hip_atomic_fetch_max(kmaxl + b * 4 + hh, __float_as_uint(kn2 * 1.02f), __ATOMIC_RELAXED, __HIP_MEMORY_SCOPE_WORKGROUP); }
                st_bf4(DS_Q + (size_t)m * 256 + c4, q); st_bf4(DS_K + (size_t)m * 256 + c4, k); st_bf4(DS_V + (size_t)m * 256 + c4, v); st_bf4(DS_QI + (size_t)m * 256 + c4, qi);
                if (lane < 8) { st_bf4(DS_KI + (size_t)m * 32 + 4 * lane, ki); DS_WI[(size_t)m * 8 + lane] = bf2f(Pj[C_DS_WI + lane]) * 0.0625f; }
            }
        }
        {
            LDS_WAIT();
            {
                const v4f cb = *(const v4f*)(conv_b + c4), cw0 = *(const v4f*)(conv_w + c4), cw1 = *(const v4f*)(conv_w + 256 + c4), cw2 = *(const v4f*)(conv_w + 512 + c4), cw3 = *(const v4f*)(conv_w + 768 + c4);
                v4f xb[NTK + 3];
#pragma unroll
                for (int r = 0; r < NTK + 3; ++r) xb[r] = (i0 + r - 3 >= 0) ? ld_bf4(P + (r - 3) * NINP + C_LR_X + c4) : (v4f){0.f, 0.f, 0.f, 0.f};
#pragma unroll
                for (int j = 0; j < NTK; ++j) *(LAS v4f*)(scr + j * 256 + c4) = cb + cw0 * xb[j] + cw1 * xb[j + 1] + cw2 * xb[j + 2] + cw3 * xb[j + 3];
            }
            LDS_WAIT();
#pragma unroll 1
            for (int mat = 0; mat < 2; ++mat) {
                const float* Wm = (mat == 0 ? wa : wx) + hh * 4096 + d4;
                v4f acc[NTK];
#pragma unroll
                for (int j = 0; j < NTK; ++j) acc[j] = (v4f){0.f, 0.f, 0.f, 0.f};
#pragma unroll 2
                for (int i = 0; i < 64; i += 4) {
                    v4f xx[NTK];
#pragma unroll
                    for (int j = 0; j < NTK; ++j) xx[j] = *(const LAS v4f*)(scr + j * 256 + hh * 64 + i);
#pragma unroll
                    for (int ii = 0; ii < 4; ++ii) { const v4f w4 = *(const v4f*)(Wm + (i + ii) * 64);
#pragma unroll
                        for (int j = 0; j < NTK; ++j) acc[j] += w4 * xx[j][ii]; }
                }
#pragma unroll
                for (int j = 0; j < NTK; ++j) *(LAS v4f*)(scr + (1 + mat) * 1024 + j * 256 + c4) = acc[j];
            }
            LDS_WAIT();
            const v4f bav = *(const v4f*)(ba + c4), bxv = *(const v4f*)(bx + c4), lamv = *(const v4f*)(lam + c4);
            v4f spl; spl.x = softplusf_(-lamv.x); spl.y = softplusf_(-lamv.y); spl.z = softplusf_(-lamv.z); spl.w = softplusf_(-lamv.w);
#pragma unroll 1
            for (int j = 0; j < NTK; ++j) {
                const size_t m = m0 + j; v4f aa, uu, gg; const v4f gr = ld_bf4(P + j * NINP + C_LR_G + c4);
                const v4f xc = *(const LAS v4f*)(scr + j * 256 + c4), ar = *(const LAS v4f*)(scr + 1024 + j * 256 + c4), ai = *(const LAS v4f*)(scr + 2048 + j * 256 + c4);
#pragma unroll
                for (int e = 0; e < 4; ++e) { const float r = sigmoidf_(ar[e] + bav[e]), ig = sigmoidf_(ai[e] + bxv[e]);
                    const float la = -8.f * r * spl[e]; aa[e] = __expf(la);
                    const float x2 = 2.f * la; const float om = (x2 > -0.1f) ? -(x2 * (1.f + x2 * (0.5f + x2 * (0.16666667f + x2 * 0.041666668f)))) : (1.f - __expf(x2));
                    uu[e] = xc[e] * ig * sqrtf(om);
                    const float t = 0.7978845608028654f * (gr[e] + 0.044715f * gr[e] * gr[e] * gr[e]); gg[e] = 0.5f * gr[e] * (1.f + tanh_fast(t)); }
                *(v4f*)(LR_A + m * 256 + c4) = aa; st_bf4(LR_U + m * 256 + c4, uu); st_bf4(LR_G + m * 256 + c4, gg);
            }
            LDS_WAIT();
        }
        {
            v4f lb = (v4f){0.f, 0.f, 0.f, 0.f};
            if (l == 1) { const v4f x0 = *(const v4f*)(lbs + c4), x1 = *(const v4f*)(lbs + 256 + c4);
                lb.x = 1.f / (1.f + __expf(x0.x - x1.x)); lb.y = 1.f / (1.f + __expf(x0.y - x1.y)); lb.z = 1.f / (1.f + __expf(x0.z - x1.z)); lb.w = 1.f / (1.f + __expf(x0.w - x1.w)); }
#pragma unroll 1
            for (int j = 0; j < NTK; ++j) {
                const bf16* Pj = P + j * NINP; const size_t m = m0 + j;
                const v4f q = ld_bf4(Pj + C_HG_Q + c4), z = ld_bf4(Pj + C_HG_F + c4), vi = ld_bf4(Pj + C_HG_I + c4), g = ld_bf4(Pj + C_HG_G + c4);
                v4f qs, f, kq, gs;
#pragma unroll
                for (int e = 0; e < 4; ++e) { const float sg = sigmoidf_(z[e]); qs[e] = q[e] * sigmoidf_(q[e]); f[e] = lb[e] + (1.f - lb[e]) * sg; kq[e] = (1.f - lb[e]) * (1.f - sg); gs[e] = g[e] * sigmoidf_(g[e]); }
                const size_t hm = ((size_t)(b * 4 + hh) * L + (i0 + j)) * 64 + d4;
                *(v4f*)(HG_F + hm) = f; st_bf4(HG_K + hm, kq); st_bf4(HG_Q + hm, qs); st_bf4(HG_V + hm, vi); st_bf4(HG_G + m * 256 + c4, gs);
            }
        }
    }
    __syncthreads();
    if (tid < 32) atomicMax((unsigned*)(A.ws + WS_CTL) + 8960 + 64 * l + tid, kmaxl[tid]);
}
constexpr int SC_C = 32;
__device__ PHASE_FN void rwkv_scan(const Ctx A, LAS unsigned char* lds, int l, int bh) {
    const int tid = opaque_tid(), lane = tid & 63, wave = tid >> 6, v = tid >> 3, kp = tid & 7;
    const int b = bh >> 2, h = bh & 3;
    const size_t base = (size_t)bh * L * 64;
    const float* W = (const float*)(A.ws + WS_RW_W) + base;
    const bf16* Av = (const bf16*)(A.ws + WS_RW_A) + base; const bf16* Bv = (const bf16*)(A.ws + WS_RW_B) + base; const bf16* Kv = (const bf16*)(A.ws + WS_RW_K) + base;
    const bf16* WRv = (const bf16*)(A.ws + WS_RW_WR) + base; const bf16* Vv = (const bf16*)(A.ws + WS_RW_V) + base;
    const float* SC = (const float*)(A.ws + WS_RW_SC) + (size_t)bh * L * 4;
    const bf16* Gt = (const bf16*)(A.ws + WS_RW_G); bf16* MIX = (bf16*)(A.ws + WS_HB);
    const float* ln_g = A.in[14] + l * 256 + h * 64; const float* ln_b = A.in[15] + l * 256 + h * 64;
    constexpr int ARR = SC_C * 64;
    constexpr int BUF = 6 * ARR * 4 + SC_C * 16;
    LAS float* ybuf = (LAS float*)(lds + 2 * BUF);
    const float lg = ln_g[lane], lbias = ln_b[lane];
    float S[8];
#pragma unroll
    for (int j = 0; j < 8; ++j) S[j] = 0.f;
    v4f rw; v2u ra, rb, rk, rwr, rv; float rsc = 0.f;
    const int e4 = tid * 4;
#define RW_LOAD(c) do { const int t0_ = (c) * SC_C; const bool ok_ = (t0_ + (e4 >> 6)) < L; const size_t o_ = (size_t)t0_ * 64 + e4; \
        rw = ok_ ? *(const v4f*)(W + o_) : (v4f){1.f, 1.f, 1.f, 1.f}; ra = ok_ ? *(const v2u*)(Av + o_) : (v2u){0u, 0u}; rb = ok_ ? *(const v2u*)(Bv + o_) : (v2u){0u, 0u}; \
        rk = ok_ ? *(const v2u*)(Kv + o_) : (v2u){0u, 0u}; rwr = ok_ ? *(const v2u*)(WRv + o_) : (v2u){0u, 0u}; rv = ok_ ? *(const v2u*)(Vv + o_) : (v2u){0u, 0u}; \
        if (tid < SC_C * 4) rsc = (t0_ + (tid >> 2)) < L ? SC[(size_t)t0_ * 4 + tid] : 0.f; } while (0)
#define RW_STORE(p) do { LAS float* d_ = (LAS float*)(lds + (p) * BUF); \
        *(LAS v4f*)(d_ + e4) = rw; *(LAS v4f*)(d_ + ARR + e4) = (v4f){bflo(ra.x), bfhi(ra.x), bflo(ra.y), bfhi(ra.y)}; *(LAS v4f*)(d_ + 2 * ARR + e4) = (v4f){bflo(rb.x), bfhi(rb.x), bflo(rb.y), bfhi(rb.y)}; \
        *(LAS v4f*)(d_ + 3 * ARR + e4) = (v4f){bflo(rk.x), bfhi(rk.x), bflo(rk.y), bfhi(rk.y)}; *(LAS v4f*)(d_ + 4 * ARR + e4) = (v4f){bflo(rwr.x), bfhi(rwr.x), bflo(rwr.y), bfhi(rwr.y)}; \
        *(LAS v4f*)(d_ + 5 * ARR + e4) = (v4f){bflo(rv.x), bfhi(rv.x), bflo(rv.y), bfhi(rv.y)}; if (tid < SC_C * 4) d_[6 * ARR + tid] = rsc; } while (0)
    constexpr int NCH = (L + SC_C - 1) / SC_C;
    RW_LOAD(0); RW_STORE(0); __syncthreads();
    for (int c = 0; c < NCH; ++c) {
        const int p = c & 1;
        if (c + 1 < NCH) RW_LOAD(c + 1);
        const int ns = (L - c * SC_C) < SC_C ? (L - c * SC_C) : SC_C;
        const LAS float* d = (const LAS float*)(lds + p * BUF);
        for (int s = 0; s < ns; ++s) {
            const LAS float* q = d + s * 64 + kp * 8;
            const v4f w0 = *(const LAS v4f*)(q), w1 = *(const LAS v4f*)(q + 4);
            const v4f a0 = *(const LAS v4f*)(q + ARR), a1 = *(const LAS v4f*)(q + ARR + 4);
            const v4f b0 = *(const LAS v4f*)(q + 2 * ARR), b1 = *(const LAS v4f*)(q + 2 * ARR + 4);
            const v4f k0 = *(const LAS v4f*)(q + 3 * ARR), k1 = *(const LAS v4f*)(q + 3 * ARR + 4);
            const v4f r0 = *(const LAS v4f*)(q + 4 * ARR), r1 = *(const LAS v4f*)(q + 4 * ARR + 4);
            const float vv = d[5 * ARR + s * 64 + v];
            const v2f sc = *(const LAS v2f*)(d + 6 * ARR + s * 4);
            float sa = 0.f, y1 = 0.f;
#pragma unroll
            for (int j = 0; j < 4; ++j) { sa += S[j] * a0[j]; y1 += S[j] * r0[j]; }
#pragma unroll
            for (int j = 0; j < 4; ++j) { sa += S[4 + j] * a1[j]; y1 += S[4 + j] * r1[j]; }
            sa = sum8(sa); y1 = sum8(y1);
#pragma unroll
            for (int j = 0; j < 4; ++j) { S[j] = S[j] * w0[j] + sa * b0[j] + vv * k0[j]; S[4 + j] = S[4 + j] * w1[j] + sa * b1[j] + vv * k1[j]; }
            if (kp == 0) ybuf[s * 64 + v] = y1 + sa * sc.x + vv * sc.y;
        }
        __syncthreads();
        for (int s = wave; s < ns; s += NWAVES) {
            const int i = c * SC_C + s; const size_t m = (size_t)b * L + i;
            const float y = ybuf[s * 64 + lane];
            const float mean = wave_sum(y) * (1.f / 64.f); const float dy = y - mean;
            const float var = wave_sum(dy * dy) * (1.f / 64.f);
            const float yn = dy * rsqrtf(var + 64e-5f) * lg + lbias;
            const float bonus = d[6 * ARR + s * 4 + 2], vv = d[5 * ARR + s * 64 + lane];
            const float g = bf2f(Gt[m * 256 + h * 64 + lane]);
            MIX[m * 1024 + h * 64 + lane] = f2bf((yn + bonus * vv) * g);
        }
        if (c + 1 < NCH) RW_STORE(1 - p);
        __syncthreads();
    }
#undef RW_LOAD
#undef RW_STORE
}
__device__ PHASE_FN void hgrn_scan(const Ctx A, LAS unsigned char* lds, int l, int bh) {
    const int tid = opaque_tid(), lane = tid & 63, wave = tid >> 6, v = tid >> 3, kp = tid & 7;
    const int b = bh >> 2, h = bh & 3;
    const size_t base = (size_t)bh * L * 64;
    const float* Fv = (const float*)(A.ws + WS_HG_F) + base;
    const bf16* Kv = (const bf16*)(A.ws + WS_HG_K) + base; const bf16* Qv = (const bf16*)(A.ws + WS_HG_Q) + base; const bf16* Vv = (const bf16*)(A.ws + WS_HG_V) + base;
    const bf16* Gt = (const bf16*)(A.ws + WS_HG_G); bf16* MIX = (bf16*)(A.ws + WS_HB);
    const float ng = (A.in[24] + l * 256 + h * 64)[lane];
    constexpr int ARR = SC_C * 64; constexpr int BUF = 4 * ARR * 4;
    LAS float* obuf = (LAS float*)(lds + 2 * BUF);
    float S[8];
#pragma unroll
    for (int j = 0; j < 8; ++j) S[j] = 0.f;
    v4f rf; v2u rk, rq, rv;
    const int e4 = tid * 4;
#define HG_LOAD(c) do { const int t0_ = (c) * SC_C; const bool ok_ = (t0_ + (e4 >> 6)) < L; const size_t o_ = (size_t)t0_ * 64 + e4; \
        rf = ok_ ? *(const v4f*)(Fv + o_) : (v4f){1.f, 1.f, 1.f, 1.f}; rk = ok_ ? *(const v2u*)(Kv + o_) : (v2u){0u, 0u}; rq = ok_ ? *(const v2u*)(Qv + o_) : (v2u){0u, 0u}; rv = ok_ ? *(const v2u*)(Vv + o_) : (v2u){0u, 0u}; } while (0)
#define HG_STORE(p) do { LAS float* d_ = (LAS float*)(lds + (p) * BUF); \
        *(LAS v4f*)(d_ + e4) = rf; *(LAS v4f*)(d_ + ARR + e4) = (v4f){bflo(rk.x), bfhi(rk.x), bflo(rk.y), bfhi(rk.y)}; \
        *(LAS v4f*)(d_ + 2 * ARR + e4) = (v4f){bflo(rq.x), bfhi(rq.x), bflo(rq.y), bfhi(rq.y)}; *(LAS v4f*)(d_ + 3 * ARR + e4) = (v4f){bflo(rv.x), bfhi(rv.x), bflo(rv.y), bfhi(rv.y)}; } while (0)
    constexpr int NCH = (L + SC_C - 1) / SC_C;
    HG_LOAD(0); HG_STORE(0); __syncthreads();
    for (int c = 0; c < NCH; ++c) {
        const int p = c & 1;
        if (c + 1 < NCH) HG_LOAD(c + 1);
        const int ns = (L - c * SC_C) < SC_C ? (L - c * SC_C) : SC_C;
        const LAS float* d = (const LAS float*)(lds + p * BUF);
        for (int s = 0; s < ns; ++s) {
            const LAS float* q = d + s * 64 + kp * 8;
            const v4f f0 = *(const LAS v4f*)(q), f1 = *(const LAS v4f*)(q + 4);
            const v4f k0 = *(const LAS v4f*)(q + ARR), k1 = *(const LAS v4f*)(q + ARR + 4);
            const v4f q0 = *(const LAS v4f*)(q + 2 * ARR), q1 = *(const LAS v4f*)(q + 2 * ARR + 4);
            const float vv = d[3 * ARR + s * 64 + v];
            float o = 0.f;
#pragma unroll
            for (int j = 0; j < 4; ++j) { S[j] = S[j] * f0[j] + k0[j] * vv; o += q0[j] * S[j]; }
#pragma unroll
            for (int j = 0; j < 4; ++j) { S[4 + j] = S[4 + j] * f1[j] + k1[j] * vv; o += q1[j] * S[4 + j]; }
            o = sum8(o);
            if (kp == 0) obuf[s * 64 + v] = o;
        }
        __syncthreads();
        for (int s = wave; s < ns; s += NWAVES) {
            const int i = c * SC_C + s; const size_t m = (size_t)b * L + i;
            const float o = obuf[s * 64 + lane];
            const float ms = wave_sum(o * o) * (1.f / 64.f);
            const float g = bf2f(Gt[m * 256 + h * 64 + lane]);
            MIX[m * 1024 + 768 + h * 64 + lane] = f2bf(o * rsqrtf(ms + 1e-5f) * ng * g);
        }
        if (c + 1 < NCH) HG_STORE(1 - p);
        __syncthreads();
    }
#undef HG_LOAD
#undef HG_STORE
}
__device__ PHASE_FN void lru_scan(const Ctx A, LAS unsigned char* lds, int bh) {
    const int tid = opaque_tid(), lane = tid & 63, wave = tid >> 6;
    const int b = bh >> 2, h = bh & 3, ch = h * 64 + lane;
    const float* LA = (const float*)(A.ws + WS_LR_A); const bf16* LU = (const bf16*)(A.ws + WS_LR_U); const bf16* LG = (const bf16*)(A.ws + WS_LR_G);
    bf16* MIX = (bf16*)(A.ws + WS_HB);
    constexpr int SEG = L / 8;
    const size_t m0 = (size_t)b * L + wave * SEG;
    LAS float* agg = (LAS float*)lds;
    float Ap = 1.f, Hl = 0.f;
    for (int i = 0; i < SEG; i += 6) {
        float a[6], u[6];
#pragma unroll
        for (int j = 0; j < 6; ++j) { a[j] = LA[(m0 + i + j) * 256 + ch]; u[j] = bf2f(LU[(m0 + i + j) * 256 + ch]); }
#pragma unroll
        for (int j = 0; j < 6; ++j) { Hl = a[j] * Hl + u[j]; Ap *= a[j]; }
    }
    agg[(wave * 2 + 0) * 64 + lane] = Ap; agg[(wave * 2 + 1) * 64 + lane] = Hl;
    __syncthreads();
    float hc = 0.f;
    for (int w = 0; w < wave; ++w) hc = agg[(w * 2 + 0) * 64 + lane] * hc + agg[(w * 2 + 1) * 64 + lane];
    for (int i = 0; i < SEG; i += 6) {
        float a[6], u[6], g[6];
#pragma unroll
        for (int j = 0; j < 6; ++j) { a[j] = LA[(m0 + i + j) * 256 + ch]; u[j] = bf2f(LU[(m0 + i + j) * 256 + ch]); g[j] = bf2f(LG[(m0 + i + j) * 256 + ch]); }
#pragma unroll
        for (int j = 0; j < 6; ++j) { hc = a[j] * hc + u[j]; MIX[(m0 + i + j) * 1024 + 512 + ch] = f2bf(hc * g[j]); }
    }
    __syncthreads();
}
static_assert((L / 8) % 6 == 0 && L % 8 == 0, "lru segments");
constexpr int DSA_WBYTES = 34944;
constexpr int DSA_NW = 4;
__device__ __forceinline__ unsigned fkey(float f) { const unsigned u = __float_as_uint(f); return (u & 0x80000000u) ? ~u : (u | 0x80000000u); }
__device__ __forceinline__ void dsa_query(const Ctx A, LAS unsigned char* wl, int b, int i, int lane) {
    const bf16* DQ = (const bf16*)(A.ws + WS_DS_Q); const bf16* DK = (const bf16*)(A.ws + WS_DS_K); const bf16* DV = (const bf16*)(A.ws + WS_DS_V);
    const bf16* DQI = (const bf16*)(A.ws + WS_DS_QI); const bf16* DKI = (const bf16*)(A.ws + WS_DS_KI); const float* DWI = (const float*)(A.ws + WS_DS_WI);
    bf16* MIX = (bf16*)(A.ws + WS_HB);
    LAS unsigned* keys = (LAS unsigned*)wl; LAS float* qv = (LAS float*)(wl + 32896); LAS int* sel = (LAS int*)(wl + 32896 + 1024);
    const size_t m = (size_t)b * L + i, mb = (size_t)b * L;
    const int n = i + 1;
    LAS float* wil = (LAS float*)(wl + 32832);
    { const v4f q4 = ld_bf4(DQI + m * 256 + 4 * lane); *(LAS v4f*)(qv + 4 * lane) = q4; if (lane < 8) wil[lane] = DWI[m * 8 + lane]; }
    LDS_WAIT();
    for (int s = lane; s < n; s += 64) {
        const v4u* kp = (const v4u*)(DKI + (mb + s) * 32);
        float kf[32];
#pragma unroll
        for (int c = 0; c < 4; ++c) { const v4u x = kp[c]; kf[8 * c + 0] = bflo(x.x); kf[8 * c + 1] = bfhi(x.x); kf[8 * c + 2] = bflo(x.y); kf[8 * c + 3] = bfhi(x.y); kf[8 * c + 4] = bflo(x.z); kf[8 * c + 5] = bfhi(x.z); kf[8 * c + 6] = bflo(x.w); kf[8 * c + 7] = bfhi(x.w); }
        float sc = 0.f;
#pragma unroll 1
        for (int hx = 0; hx < 8; ++hx) { float dt = 0.f;
#pragma unroll
            for (int c = 0; c < 8; ++c) { const v4f q4 = *(const LAS v4f*)(qv + hx * 32 + 4 * c); dt += q4.x * kf[4 * c] + q4.y * kf[4 * c + 1] + q4.z * kf[4 * c + 2] + q4.w * kf[4 * c + 3]; }
            sc += wil[hx] * fmaxf(dt, 0.f); }
        keys[s] = fkey(sc);
    }
    LDS_WAIT();
    unsigned thr = 0u; int need = 0;
    if (n > 256) {
        unsigned prefix = 0u; need = 256;
#pragma unroll 1
        for (int shift = 28; shift >= 0; shift -= 4) {
            unsigned long long lo = 0ull, hi = 0ull;
            const unsigned himask = (shift == 28) ? 0u : (0xFFFFFFFFu << (shift + 4));
            for (int s = lane; s < n; s += 64) { const unsigned k = keys[s];
                if ((k & himask) == prefix) { const unsigned dg = (k >> shift) & 15u; const unsigned long long inc = 1ull << ((dg & 7u) * 8u); if (dg < 8u) lo += inc; else hi += inc; } }
            int cum = 0; unsigned dsel = 0u; int below = 0; bool found = false;
#pragma unroll
            for (int dg = 15; dg >= 0; --dg) {
                const unsigned mine = (unsigned)(((dg < 8 ? lo : hi) >> ((dg & 7) * 8)) & 0xFFull);
                int tot = (int)mine;
#pragma unroll
                for (int o = 1; o < 64; o <<= 1) tot += __shfl_xor(tot, o);
                if (!found && cum + tot >= need) { found = true; dsel = (unsigned)dg; below = cum; }
                cum += tot;
            }
            prefix |= dsel << shift; need -= below;
        }
        thr = prefix;
    }
    int cnt = 0;
    if (n <= 256) { for (int s = lane; s < n; s += 64) sel[s] = s; cnt = n; }
    else {
        int eq_taken = 0;
        for (int s0 = 0; s0 < n; s0 += 64) { const int s = s0 + lane; const unsigned k = (s < n) ? keys[s] : 0u; const bool in = s < n;
            const bool gt = in && (k > thr), eq = in && (k == thr);
            const unsigned long long meq = __ballot(eq); const int eq_before = __popcll(meq & ((1ull << lane) - 1ull));
            const bool take = gt || (eq && (eq_taken + eq_before) < need);
            const unsigned long long mt = __ballot(take); const int pos = cnt + __popcll(mt & ((1ull << lane) - 1ull));
            if (take && pos < 256) sel[pos] = s;
            cnt += __popcll(mt); eq_taken += __popcll(meq);
        }
        if (cnt > 256) cnt = 256;
    }
    LDS_WAIT();
    LAS float* pbuf = (LAS float*)wl;
    for (int h = 0; h < 4; ++h) {
        { const float qx = bf2f(DQ[m * 256 + h * 64 + lane]); qv[lane] = qx * 0.125f; }
        LDS_WAIT();
        float sj[4]; float mx = -3.0e38f;
#pragma unroll
        for (int r = 0; r < 4; ++r) { const int j = lane + 64 * r; sj[r] = -3.0e38f;
            if (j < cnt) { const int s = sel[j]; const v4u* kp = (const v4u*)(DK + (mb + s) * 256 + h * 64); float dt = 0.f;
#pragma unroll
                for (int c = 0; c < 8; ++c) { const v4u x = kp[c]; const v4f q0 = *(const LAS v4f*)(qv + 8 * c), q1 = *(const LAS v4f*)(qv + 8 * c + 4);
                    dt += q0.x * bflo(x.x) + q0.y * bfhi(x.x) + q0.z * bflo(x.y) + q0.w * bfhi(x.y) + q1.x * bflo(x.z) + q1.y * bfhi(x.z) + q1.z * bflo(x.w) + q1.w * bfhi(x.w); }
                sj[r] = dt; mx = fmaxf(mx, dt); } }
        mx = wave_max(mx);
        float sum = 0.f;
#pragma unroll
        for (int r = 0; r < 4; ++r) { const int j = lane + 64 * r; const float p = (j < cnt) ? __expf(sj[r] - mx) : 0.f; sum += p; pbuf[j] = p; }
        sum = wave_sum(sum);
        LDS_WAIT();
        float o = 0.f;
        for (int j = 0; j < cnt; ++j) { const int s = sel[j]; o += pbuf[j] * bf2f(DV[(mb + s) * 256 + h * 64 + lane]); }
        MIX[m * 1024 + 256 + h * 64 + lane] = f2bf(o / sum);
        LDS_WAIT();
    }
}
__device__ PHASE_FN void dsa_phase(const Ctx A, LAS unsigned char* lds, int l) {
    const int tid = opaque_tid(), lane = tid & 63, wave = tid >> 6;
    if (wave >= DSA_NW) return;
    unsigned* qhead = (unsigned*)(A.ws + WS_CTL) + CW_DSAQ + 64 * l;
    LAS unsigned char* wl = lds + wave * DSA_WBYTES;
    for (;;) {
        unsigned it = 0u;
        if (lane == 0) it = atomicAdd(qhead, 1u);
        it = __builtin_amdgcn_readfirstlane(it);
        if (it >= (unsigned)T) break;
        const int i = L - 1 - (int)(it >> 3), b = (int)(it & 7u);
        dsa_query(A, wl, b, i, lane);
    }
}
static_assert(DSA_NW * DSA_WBYTES <= MISC_OFF, "dsa lds");
typedef short s8 __attribute__((ext_vector_type(8)));
typedef unsigned long long u64;
constexpr int NQT16 = L / 16;
constexpr int NKB32 = (L + 31) / 32;
constexpr size_t WS_MASK = 1956 * MiB;
static_assert(WS_MASK >= WS_MIX_END && WS_MASK + (size_t)NB * NQT16 * NKB32 * 64 <= WS_END, "mask region");
constexpr int CW_KMAX = 8960;
constexpr int MI_KMAX = 640, MI_UNIT = 768;
constexpr int SEL_HROW = 257;

template <int MODE  >
__device__ __forceinline__ void sel_pass(const bf16* KIb, const s8 (&qb)[8], const float (&wv)[8], int nkb, int tq, int r, int g, int lane,
                                         LAS unsigned* hist, int lvl, unsigned prefix, unsigned thr24, u64* mrow) {
    const int shift = 24 - 8 * lvl;
    const bf16* kp = KIb + (size_t)(8 * (r >> 2) + (r & 3)) * 32 + 8 * g;
    s8 a1 = *(const s8*)kp, a2 = *(const s8*)(kp + 4 * 32);
#pragma unroll 1
    for (int kb = 0; kb < nkb; ++kb) {
        s8 n1 = a1, n2 = a2;
        if (kb + 1 < nkb) { n1 = *(const s8*)(kp + (size_t)(kb + 1) * 1024); n2 = *(const s8*)(kp + (size_t)(kb + 1) * 1024 + 4 * 32); }
        pg8::f32x4 i1 = (pg8::f32x4){0.f, 0.f, 0.f, 0.f}, i2 = i1;
#pragma unroll
        for (int h = 0; h < 8; ++h) {
            const pg8::f32x4 z = (pg8::f32x4){0.f, 0.f, 0.f, 0.f};
            const pg8::f32x4 c1 = __builtin_amdgcn_mfma_f32_16x16x32_bf16(a1, qb[h], z, 0, 0, 0), c2 = __builtin_amdgcn_mfma_f32_16x16x32_bf16(a2, qb[h], z, 0, 0, 0);
#pragma unroll
            for (int j = 0; j < 4; ++j) { i1[j] += wv[h] * fmaxf(c1[j], 0.f); i2[j] += wv[h] * fmaxf(c2[j], 0.f); }
        }
        const int s0 = kb * 32 + 8 * g;
        u64 wds[8];
#pragma unroll
        for (int j = 0; j < 8; ++j) {
            const int s = s0 + j; const unsigned key = fkey(j < 4 ? i1[j & 3] : i2[j & 3]); const bool vis = s <= tq;
            if (MODE == 0) { const bool m = vis && (lvl == 0 || ((key ^ prefix) >> (shift + 8)) == 0u);
                if (m) __hip_atomic_fetch_add(hist + r * SEL_HROW + ((key >> shift) & 255u), 1u, __ATOMIC_RELAXED, __HIP_MEMORY_SCOPE_WORKGROUP); }
            else wds[j] = __ballot(vis && (key >> 8) >= thr24);
        }
        if (MODE == 1 && lane == 0) { u64* d = mrow + (size_t)kb * 8;
#pragma unroll
            for (int j = 0; j < 8; j += 2) { v4u o; o.x = (unsigned)wds[j]; o.y = (unsigned)(wds[j] >> 32); o.z = (unsigned)wds[j + 1]; o.w = (unsigned)(wds[j + 1] >> 32); *(v4u*)(d + j) = o; } }
        a1 = n1; a2 = n2;
    }
}
__device__ PHASE_FN void dsa_select_phase(const Ctx A, LAS unsigned char* lds, int l) {
    const int tid = opaque_tid(), lane = tid & 63, wave = tid >> 6, r = lane & 15, g = lane >> 4;
    const bf16* DQI = (const bf16*)(A.ws + WS_DS_QI); const bf16* DKI = (const bf16*)(A.ws + WS_DS_KI); const float* DWI = (const float*)(A.ws + WS_DS_WI);
    u64* MASK = (u64*)(A.ws + WS_MASK);
    unsigned* qhead = (unsigned*)(A.ws + WS_CTL) + CW_DSAQ + 64 * l;
    LAS unsigned* hist = (LAS unsigned*)(lds + wave * (16 * SEL_HROW * 4));
    for (;;) {
        unsigned it = 0u;
        if (lane == 0) it = atomicAdd(qhead, 1u);
        it = __builtin_amdgcn_readfirstlane(it);
        if (it >= (unsigned)(NB * NQT16)) break;
        const int qt = NQT16 - 1 - (int)(it >> 3), b = (int)(it & 7u);
        const size_t mb = (size_t)b * L, m0 = mb + (size_t)qt * 16;
        const int tq = qt * 16 + r, nkb = ((qt * 16 + 15) >> 5) + 1;
        s8 qb[8]; float wv[8];
#pragma unroll
        for (int h = 0; h < 8; ++h) qb[h] = *(const s8*)(DQI + (m0 + r) * 256 + h * 32 + 8 * g);
        { const v4f w0 = *(const v4f*)(DWI + (m0 + r) * 8), w1 = *(const v4f*)(DWI + (m0 + r) * 8 + 4);
          wv[0] = w0.x; wv[1] = w0.y; wv[2] = w0.z; wv[3] = w0.w; wv[4] = w1.x; wv[5] = w1.y; wv[6] = w1.z; wv[7] = w1.w; }
        const bf16* KIb = DKI + mb * 32;
        unsigned prefix = 0u; int need = 256;
        if (qt * 16 + 15 >= 256) {
#pragma unroll 1
            for (int lvl = 0; lvl < 3; ++lvl) {
                for (int i = lane; i < 16 * SEL_HROW; i += 64) hist[i] = 0u;
                LDS_WAIT();
                sel_pass<0>(KIb, qb, wv, nkb, tq, r, g, lane, hist, lvl, prefix, 0u, nullptr);
                LDS_WAIT();
                int cum = 0, sel = 0, above = 0; bool found = false;
#pragma unroll 8
                for (int bin = 255; bin >= 0; --bin) { const int c = (int)hist[r * SEL_HROW + bin];
                    if (!found && cum + c >= need) { found = true; sel = bin; above = cum; }
                    cum += c; }
                prefix |= (unsigned)sel << (24 - 8 * lvl); need -= above;
                LDS_WAIT();
            }
        }
        const unsigned thr24 = (tq + 1 <= 256) ? 0u : (prefix >> 8);
        sel_pass<1>(KIb, qb, wv, nkb, tq, r, g, lane, hist, 3, 0u, thr24, MASK + ((size_t)(b * NQT16 + qt) * NKB32) * 8);
    }
}

constexpr int AT_ROW = 144;
constexpr int AT_TILE = 64 * AT_ROW;
constexpr int AT_NQT = (L + 127) / 128;
constexpr int AT_NKT = (L + 63) / 64;
__device__ PHASE_FN void dsa_attn_phase(const Ctx A, LAS unsigned char* lds, int l) {
    const int tid = opaque_tid(), lane = tid & 63, wave = tid >> 6, r = lane & 15, g = lane >> 4;
    const bf16* DQ = (const bf16*)(A.ws + WS_DS_Q); const bf16* DK = (const bf16*)(A.ws + WS_DS_K); const bf16* DV = (const bf16*)(A.ws + WS_DS_V);
    const u64* MASK = (const u64*)(A.ws + WS_MASK); bf16* MIX = (bf16*)(A.ws + WS_HB);
    unsigned* qhead = (unsigned*)(A.ws + WS_CTL) + CW_DSAQ + 64 * l + 16;
    const unsigned* kmaxw = (const unsigned*)(A.ws + WS_CTL) + CW_KMAX + 64 * l;
    LAS unsigned* unitw = (LAS unsigned*)(lds + MISC_OFF + MI_UNIT);
    const int ldkey = tid >> 3, ldch = tid & 7;
    for (;;) {
        __syncthreads();
        if (tid == 0) unitw[0] = atomicAdd(qhead, 1u);
        __syncthreads();
        const unsigned u = unitw[0];
        if (u >= (unsigned)(NB * 4 * AT_NQT)) break;
        const int qt = AT_NQT - 1 - (int)(u >> 5), b = (int)((u & 31u) >> 2), h = (int)(u & 3u);
        const size_t mb = (size_t)b * L;
        const int t0 = qt * 128 + wave * 16; const bool active = t0 < L;
        const int nkt = (2 * (qt + 1) < AT_NKT) ? 2 * (qt + 1) : AT_NKT;
        const int lastblk = active ? ((t0 + 15) >> 5) : -1;
        s8 qf[2]; float qn2 = 0.f;
#pragma unroll
        for (int ks = 0; ks < 2; ++ks) { qf[ks] = active ? *(const s8*)(DQ + (mb + t0 + r) * 256 + h * 64 + 32 * ks + 8 * g) : (s8){0, 0, 0, 0, 0, 0, 0, 0};
#pragma unroll
            for (int e = 0; e < 8; ++e) { const float x = bf2f((unsigned short)qf[ks][e]); qn2 += x * x; } }
        qn2 += __shfl_xor(qn2, 16); qn2 += __shfl_xor(qn2, 32);
        const float kmax2 = __uint_as_float(__hip_atomic_load(kmaxw + b * 4 + h, __ATOMIC_RELAXED, __HIP_MEMORY_SCOPE_AGENT));
        const float c1 = 0.125f * 1.4426950408889634f, c2 = sqrtf(qn2 * kmax2) * c1;
        pg8::f32x4 O[4];
#pragma unroll
        for (int db = 0; db < 4; ++db) O[db] = (pg8::f32x4){0.f, 0.f, 0.f, 0.f};
        float lsum = 0.f;
        const u64* mrow = MASK + ((size_t)(b * NQT16 + (t0 >> 4)) * NKB32) * 8;
        const bf16* kg = DK + (mb + ldkey) * 256 + h * 64 + ldch * 8; const bf16* vg = DV + (mb + ldkey) * 256 + h * 64 + ldch * 8;
        v4u rk = *(const v4u*)kg, rv = *(const v4u*)vg;
#define AT_STORE(buf) do { LAS unsigned char* kb_ = lds + (buf) * 2 * AT_TILE; LAS unsigned char* vb_ = kb_ + AT_TILE; \
            *(LAS v4u*)(kb_ + ldkey * AT_ROW + ldch * 16) = rk; \
            LAS unsigned short* vd_ = (LAS unsigned short*)(vb_ + (ldch * 8) * AT_ROW + ldkey * 2); \
            vd_[0] = (unsigned short)rv.x; vd_[AT_ROW / 2] = (unsigned short)(rv.x >> 16); vd_[2 * (AT_ROW / 2)] = (unsigned short)rv.y; vd_[3 * (AT_ROW / 2)] = (unsigned short)(rv.y >> 16); \
            vd_[4 * (AT_ROW / 2)] = (unsigned short)rv.z; vd_[5 * (AT_ROW / 2)] = (unsigned short)(rv.z >> 16); vd_[6 * (AT_ROW / 2)] = (unsigned short)rv.w; vd_[7 * (AT_ROW / 2)] = (unsigned short)(rv.w >> 16); } while (0)
        AT_STORE(0);
        __syncthreads();
#pragma unroll 1
        for (int kt = 0; kt < nkt; ++kt) {
            if (kt + 1 < nkt) { rk = *(const v4u*)(kg + (size_t)(kt + 1) * 64 * 256); rv = *(const v4u*)(vg + (size_t)(kt + 1) * 64 * 256); }
            const LAS unsigned char* kbuf = lds + (kt & 1) * 2 * AT_TILE; const LAS unsigned char* vbuf = kbuf + AT_TILE;
#pragma unroll
            for (int blk = 0; blk < 2; ++blk) {
                const int kb = 2 * kt + blk;
                if (kb <= lastblk) {
                    const v4u m0 = *(const v4u*)(mrow + (size_t)kb * 8), m1 = *(const v4u*)(mrow + (size_t)kb * 8 + 2), m2 = *(const v4u*)(mrow + (size_t)kb * 8 + 4), m3 = *(const v4u*)(mrow + (size_t)kb * 8 + 6);
                    pg8::f32x4 S1 = (pg8::f32x4){0.f, 0.f, 0.f, 0.f}, S2 = S1;
                    const LAS unsigned char* ka = kbuf + (blk * 32 + 8 * (r >> 2) + (r & 3)) * AT_ROW + g * 16;
#pragma unroll
                    for (int ks = 0; ks < 2; ++ks) { const s8 a1 = *(const LAS s8*)(ka + ks * 64), a2 = *(const LAS s8*)(ka + 4 * AT_ROW + ks * 64);
                        S1 = __builtin_amdgcn_mfma_f32_16x16x32_bf16(a1, qf[ks], S1, 0, 0, 0); S2 = __builtin_amdgcn_mfma_f32_16x16x32_bf16(a2, qf[ks], S2, 0, 0, 0); }
                    const unsigned sh = (unsigned)lane & 31u; const bool hi = lane >= 32;
                    const unsigned b0 = (hi ? m0.y : m0.x) >> sh, b1 = (hi ? m0.w : m0.z) >> sh, b2 = (hi ? m1.y : m1.x) >> sh, b3 = (hi ? m1.w : m1.z) >> sh;
                    const unsigned b4 = (hi ? m2.y : m2.x) >> sh, b5 = (hi ? m2.w : m2.z) >> sh, b6 = (hi ? m3.y : m3.x) >> sh, b7 = (hi ? m3.w : m3.z) >> sh;
                    float p[8];
                    p[0] = (b0 & 1u) ? exp2f(S1[0] * c1 - c2) : 0.f; p[1] = (b1 & 1u) ? exp2f(S1[1] * c1 - c2) : 0.f; p[2] = (b2 & 1u) ? exp2f(S1[2] * c1 - c2) : 0.f; p[3] = (b3 & 1u) ? exp2f(S1[3] * c1 - c2) : 0.f;
                    p[4] = (b4 & 1u) ? exp2f(S2[0] * c1 - c2) : 0.f; p[5] = (b5 & 1u) ? exp2f(S2[1] * c1 - c2) : 0.f; p[6] = (b6 & 1u) ? exp2f(S2[2] * c1 - c2) : 0.f; p[7] = (b7 & 1u) ? exp2f(S2[3] * c1 - c2) : 0.f;
                    lsum += ((p[0] + p[1]) + (p[2] + p[3])) + ((p[4] + p[5]) + (p[6] + p[7]));
                    v4u pk; pk.x = pk2(p[0], p[1]); pk.y = pk2(p[2], p[3]); pk.z = pk2(p[4], p[5]); pk.w = pk2(p[6], p[7]);
                    const s8 pa = __builtin_bit_cast(s8, pk);
                    const LAS unsigned char* va = vbuf + r * AT_ROW + (blk * 32 + 8 * g) * 2;
#pragma unroll
                    for (int db = 0; db < 4; ++db) { const s8 vb = *(const LAS s8*)(va + db * 16 * AT_ROW); O[db] = __builtin_amdgcn_mfma_f32_16x16x32_bf16(pa, vb, O[db], 0, 0, 0); }
                }
            }
            if (kt + 1 < nkt) AT_STORE((kt + 1) & 1);
            __syncthreads();
        }
#undef AT_STORE
        lsum += __shfl_xor(lsum, 16); lsum += __shfl_xor(lsum, 32);
        const float inv = lsum > 0.f ? 1.f / lsum : 0.f;
#pragma unroll
        for (int j = 0; j < 4; ++j) { const float ij = __shfl(inv, 4 * g + j); const int t = t0 + 4 * g + j;
            if (t < L) {
#pragma unroll
                for (int db = 0; db < 4; ++db) MIX[(mb + t) * 1024 + 256 + h * 64 + db * 16 + r] = f2bf(O[db][j] * ij); } }
    }
}
__device__ PHASE_FN void ln_router_phase(const Ctx A, LAS unsigned char* lds, int l, int vcu, int G) {
    const int tid = opaque_tid(), lane = tid & 63, wave = tid >> 6;
    const int gw = vcu * NWAVES + wave, NGW = G * NWAVES;
    float* H = (float*)(A.ws + WS_H); bf16* HB = (bf16*)(A.ws + WS_HB);
    int* TIDX = (int*)(A.ws + WS_TIDX); float* TGATE = (float*)(A.ws + WS_TGATE);
    unsigned* ecnt = (unsigned*)(A.ws + WS_CTL) + CW_ECNT + 64 * l;
    const float* g = A.in[26] + l * D; const float* bb = A.in[27] + l * D;
    const float* rw = A.in[28] + (size_t)l * D * NE; const float* rb = A.in[29] + l * NE;
    LAS int* hist = (LAS int*)(lds + MISC_OFF + MI_HIST);
    LAS float* red = (LAS float*)(lds + wave * 16640);
    if (tid < 32) hist[tid] = 0;
    __syncthreads();
    const float rbias = rb[lane & 31];
    for (int pr = gw; pr < T / 2; pr += NGW) {
        const size_t m0 = (size_t)pr * 2;
        v4f x[2][4];
#pragma unroll
        for (int t = 0; t < 2; ++t) {
#pragma unroll
            for (int j = 0; j < 4; ++j) x[t][j] = *(const v4f*)(H + (m0 + t) * D + 256 * j + 4 * lane);
            ln_row(x[t], g, bb, lane);
#pragma unroll
            for (int j = 0; j < 4; ++j) { *(v4f*)(H + (m0 + t) * D + 256 * j + 4 * lane) = x[t][j]; st_bf4(HB + (m0 + t) * D + 256 * j + 4 * lane, x[t][j]); }
        }
#pragma unroll
        for (int t = 0; t < 2; ++t)
#pragma unroll
            for (int j = 0; j < 4; ++j) *(LAS v4f*)(red + t * 1024 + 256 * j + 4 * lane) = x[t][j];
        LDS_WAIT();
        float acc[2][32];
#pragma unroll
        for (int t = 0; t < 2; ++t)
#pragma unroll
            for (int e = 0; e < 32; ++e) acc[t][e] = 0.f;
#pragma unroll 2
        for (int it = 0; it < 16; ++it) {
            const int k = it * 64 + lane;
            const float x0 = red[k], x1 = red[1024 + k];
            const float* wrow = rw + (size_t)k * NE;
#pragma unroll
            for (int e4 = 0; e4 < 8; ++e4) { const v4f w4 = *(const v4f*)(wrow + 4 * e4);
#pragma unroll
                for (int q = 0; q < 4; ++q) { acc[0][4 * e4 + q] += x0 * w4[q]; acc[1][4 * e4 + q] += x1 * w4[q]; } }
        }
        LDS_WAIT();
#pragma unroll
        for (int t = 0; t < 2; ++t)
#pragma unroll
            for (int e = 0; e < 32; ++e) red[lane * 65 + t * 32 + e] = acc[t][e];
        LDS_WAIT();
        float lg = 0.f;
#pragma unroll 8
        for (int r = 0; r < 64; ++r) lg += red[r * 65 + lane];
        lg += rbias;
        LDS_WAIT();
        float cur = lg; const int my = lane & 31;
        float tv[4]; int ti[4];
#pragma unroll
        for (int r = 0; r < 4; ++r) {
            float bv = cur; int bi = my;
#pragma unroll
            for (int o = 1; o < 32; o <<= 1) { const float ov = __shfl_xor(bv, o); const int oi = __shfl_xor(bi, o); if (ov > bv || (ov == bv && oi < bi)) { bv = ov; bi = oi; } }
            tv[r] = bv; ti[r] = bi; if (my == bi) cur = -3.0e38f;
        }
        const float e1 = __expf(tv[1] - tv[0]), e2 = __expf(tv[2] - tv[0]), e3 = __expf(tv[3] - tv[0]); const float inv = 1.f / (1.f + e1 + e2 + e3);
        if (my == 0) { const size_t m = m0 + (lane >> 5); *(int4*)(TIDX + m * 4) = make_int4(ti[0], ti[1], ti[2], ti[3]); *(v4f*)(TGATE + m * 4) = (v4f){inv, e1 * inv, e2 * inv, e3 * inv}; }
        if (my < 4) lds_add(&hist[my == 0 ? ti[0] : my == 1 ? ti[1] : my == 2 ? ti[2] : ti[3]], 1);
    }
    __syncthreads();
    if (tid < 32) atomicAdd(&ecnt[tid], (unsigned)hist[tid]);
}
__device__ __forceinline__ int build_tiles(const Ctx A, LAS unsigned char* lds, int l) {
    const int tid = opaque_tid();
    const unsigned* ecnt = (const unsigned*)(A.ws + WS_CTL) + CW_ECNT + 64 * l;
    LAS int* offs = (LAS int*)(lds + MISC_OFF + MI_OFFS); LAS int* tile_e = (LAS int*)(lds + MISC_OFF + MI_TILE); LAS int* nt = (LAS int*)(lds + MISC_OFF + MI_NT);
    __syncthreads();
    if (tid < 32) { int off = 0, mycnt = 0;
        for (int e = 0; e < 32; ++e) { const int c = (int)__hip_atomic_load(ecnt + e, __ATOMIC_RELAXED, __HIP_MEMORY_SCOPE_AGENT); if (e < tid) off += (c + 255) & ~255; if (e == tid) mycnt = c; }
        offs[tid] = off;
        const int t0 = off >> 8, t1 = (off + ((mycnt + 255) & ~255)) >> 8;
        for (int t = t0; t < t1; ++t) tile_e[t] = tid;
        if (tid == 31) nt[0] = t1; }
    __syncthreads();
    return nt[0];
}
__device__ PHASE_FN void moe_sort_phase(const Ctx A, LAS unsigned char* lds, int l) {
    const int tid = opaque_tid(), lane = tid & 63, wave = tid >> 6;
    const int* TIDX = (const int*)(A.ws + WS_TIDX); const float* TGATE = (const float*)(A.ws + WS_TGATE);
    int* SPOS = (int*)(A.ws + WS_SPOS); float* GSORT = (float*)(A.ws + WS_GSORT);
    const bf16* HB = (const bf16*)(A.ws + WS_HB); bf16* SORTA = (bf16*)(A.ws + WS_SORTA);
    unsigned* ecur = (unsigned*)(A.ws + WS_CTL) + CW_ECUR + 64 * l;
    LAS int* hist = (LAS int*)(lds + MISC_OFF + MI_HIST); LAS int* lcur = (LAS int*)(lds + MISC_OFF + MI_LCUR); LAS int* lbase = (LAS int*)(lds + MISC_OFF + MI_LBASE);
    LAS int* offs = (LAS int*)(lds + MISC_OFF + MI_OFFS);
    LAS int* srcm = (LAS int*)lds; LAS int* dstp = (LAS int*)(lds + 8192);
    (void)build_tiles(A, lds, l);
    const int TPB = (T + (int)gridDim.x - 1) / (int)gridDim.x;
    const int mbeg = blockIdx.x * TPB, mend = (mbeg + TPB < T) ? mbeg + TPB : T;
    const int nslot = (mend > mbeg) ? (mend - mbeg) * 4 : 0;
    if (tid < 32) { hist[tid] = 0; lcur[tid] = 0; }
    __syncthreads();
    for (int s = tid; s < nslot; s += NTHR) lds_add(&hist[TIDX[(size_t)mbeg * 4 + s]], 1);
    __syncthreads();
    if (tid < 32) lbase[tid] = offs[tid] + (int)atomicAdd(&ecur[tid], (unsigned)hist[tid]);
    __syncthreads();
    for (int s = tid; s < nslot; s += NTHR) { const size_t gs = (size_t)mbeg * 4 + s; const int e = TIDX[gs];
        const int pos = lbase[e] + lds_add(&lcur[e], 1);
        SPOS[gs] = pos; GSORT[pos] = TGATE[gs]; srcm[s] = mbeg + (s >> 2); dstp[s] = pos; }
    __syncthreads();
    for (int s = wave; s < nslot; s += NWAVES) { const v4u* src = (const v4u*)(HB + (size_t)srcm[s] * D); v4u* dst = (v4u*)(SORTA + (size_t)dstp[s] * D);
        const v4u a0 = src[lane], a1 = src[64 + lane]; dst[lane] = a0; dst[64 + lane] = a1; }
}
__device__ PHASE_FN void combine_ln_phase(const Ctx A, int l, int vcu, int G) {
    const int tid = opaque_tid(), lane = tid & 63, wave = tid >> 6;
    const int gw = vcu * NWAVES + wave, NGW = G * NWAVES;
    float* H = (float*)(A.ws + WS_H); bf16* HB = (bf16*)(A.ws + WS_HB); const bf16* Y = (const bf16*)(A.ws + WS_YBUF); const int* SPOS = (const int*)(A.ws + WS_SPOS);
    const float* g = A.in[34] + l * D; const float* bb = A.in[35] + l * D;
    for (int m = gw; m < T; m += NGW) {
        const int4 sp = *(const int4*)(SPOS + (size_t)m * 4);
        v4f v[4];
#pragma unroll
        for (int j = 0; j < 4; ++j) { const size_t co = 256 * j + 4 * lane;
            const v4f y = ld_bf4(Y + (size_t)sp.x * D + co) + ld_bf4(Y + (size_t)sp.y * D + co) + ld_bf4(Y + (size_t)sp.z * D + co) + ld_bf4(Y + (size_t)sp.w * D + co);
            v[j] = *(const v4f*)(H + (size_t)m * D + co) * ALPHA + y; }
        ln_row(v, g, bb, lane);
        if (l == 0) {
#pragma unroll
            for (int j = 0; j < 4; ++j) { *(v4f*)(H + (size_t)m * D + 256 * j + 4 * lane) = v[j]; st_bf4(HB + (size_t)m * D + 256 * j + 4 * lane, v[j]); }
        } else {
            const int b = m / L, i = m - b * L;
            if (i >= NMETA) { float* o = A.out + ((size_t)b * SEQ + (i - NMETA)) * D;
#pragma unroll
                for (int j = 0; j < 4; ++j) *(v4f*)(o + 256 * j + 4 * lane) = v[j]; }
        }
    }
}
constexpr int N_PHASES = 21;
#ifndef PH_ONLY
#define PH_ONLY -1
#endif
#define PHSEL(j) (PH_ONLY < 0 || PH_ONLY == (j))
#define IN(k) (lo <= (k) && (k) < hi)
#if MK_ONE_LAUNCH
#define GRID_BAR() xcd_barrier(bar)
#else
#define GRID_BAR() do { } while (0)
#endif
#define SEAM(k) do { if (IN(k) && IN((k) + 1)) GRID_BAR(); } while (0)
#define CTX() Ctx{args.in, args.out, launder(args.ws)}
__device__ __forceinline__ void layer_phases(const int l, const Args& args, LAS unsigned char* lds, const int G, const int bx, const int vcu, const int lo, const int hi, const XcdBarrier& bar) {

        const int pb = 1 + 10 * l;
        if (PHSEL(0) && IN(pb + 0)) { unsigned char* wsl = launder(args.ws);
            pg8::Gemm g{(const pg8::bf16_t*)(wsl + WS_HB), (const pg8::bf16_t*)(wsl + WS_WIN) + (size_t)l * NINP * 1024, TP, NINP, 1024};
            pg8::StaticOrder S; S.init(TP, NINP, G, bx);
            pg8::EpiStoreBf16 E{(pg8::bf16_t*)(wsl + WS_PROJ), NINP};
            pg8::gemm_phase<pg8::EpiStoreBf16, pg8::StaticOrder, true, true>(lds, g, S, E);
            SEAM(pb + 0);
        }
        if (PHSEL(1) && IN(pb + 1)) { prep_phase(CTX(), lds, l, vcu, G); SEAM(pb + 1); }
        if (PHSEL(2) && IN(pb + 2)) {
#ifndef PH2_SEL
#define PH2_SEL 15
#endif
            if ((PH2_SEL & 1) && bx < 32) rwkv_scan(CTX(), lds, l, bx); else if ((PH2_SEL & 2) && bx >= 32 && bx < 64) hgrn_scan(CTX(), lds, l, bx - 32); else if ((PH2_SEL & 4) && bx >= 64 && bx < 96) lru_scan(CTX(), lds, bx - 64);
            __syncthreads();
#if DSA_NAIVE
            if (PH2_SEL & 8) dsa_phase(CTX(), lds, l);
#else
            if (PH2_SEL & 8) dsa_select_phase(CTX(), lds, l);
#endif
            SEAM(pb + 2);
        }
        if (PHSEL(3) && IN(pb + 3)) {
#if !DSA_NAIVE
            dsa_attn_phase(CTX(), lds, l);
#endif
            SEAM(pb + 3);
        }
        if (PHSEL(4) && IN(pb + 4)) { unsigned char* wsl = launder(args.ws);
            pg8::Gemm g{(const pg8::bf16_t*)(wsl + WS_HB), (const pg8::bf16_t*)(wsl + WS_WOUT) + (size_t)l * 1024 * 1024, TP, 1024, 1024};
            pg8::StaticOrder S; S.init(TP, 1024, G, bx);
            pg8::EpiResid E{(float*)(wsl + WS_H), 1024, ALPHA};
            pg8::gemm_phase<pg8::EpiResid, pg8::StaticOrder, true, true>(lds, g, S, E);
            SEAM(pb + 4);
        }
        if (PHSEL(5) && IN(pb + 5)) { ln_router_phase(CTX(), lds, l, vcu, G); SEAM(pb + 5); }
        if (PHSEL(6) && IN(pb + 6)) { moe_sort_phase(CTX(), lds, l); SEAM(pb + 6); }
        if (PHSEL(7) && IN(pb + 7)) { unsigned char* wsl = launder(args.ws);
            const int nt = build_tiles(CTX(), lds, l);
            pg8::Gemm g{(const pg8::bf16_t*)(wsl + WS_SORTA), (const pg8::bf16_t*)(wsl + WS_W1) + (size_t)l * 32 * 2048 * 1024, RMAX, 32 * 2048, 1024};
            pg8::MoeOrder S{nt * 8, G, bx, 8, (const LAS int*)(lds + MISC_OFF + MI_TILE)};
            pg8::EpiSwiGLU E{(pg8::bf16_t*)(wsl + WS_ACT), args.in[31] + (size_t)l * 32 * 2048};
            pg8::gemm_phase<pg8::EpiSwiGLU, pg8::MoeOrder, true, true>(lds, g, S, E);
            SEAM(pb + 7);
        }
        if (PHSEL(8) && IN(pb + 8)) { unsigned char* wsl = launder(args.ws);
            const int nt = build_tiles(CTX(), lds, l);
            pg8::Gemm g{(const pg8::bf16_t*)(wsl + WS_ACT), (const pg8::bf16_t*)(wsl + WS_W2) + (size_t)l * 32 * 1024 * 1024, RMAX, 32 * 1024, 1024};
            pg8::MoeOrder S{nt * 4, G, bx, 4, (const LAS int*)(lds + MISC_OFF + MI_TILE)};
            pg8::EpiMoeOut E{(pg8::bf16_t*)(wsl + WS_YBUF), args.in[33] + (size_t)l * 32 * 1024, (const float*)(wsl + WS_GSORT)};
            pg8::gemm_phase<pg8::EpiMoeOut, pg8::MoeOrder, true, true>(lds, g, S, E);
            SEAM(pb + 8);
        }
        if (PHSEL(9) && IN(pb + 9)) { combine_ln_phase(CTX(), l, vcu, G); SEAM(pb + 9); }
}
__global__ void __launch_bounds__(NTHR, 2) trunk_fwd(Args args) {
    extern __shared__ __attribute__((aligned(16))) unsigned char lds_raw[];
    LAS unsigned char* lds = (LAS unsigned char*)lds_raw;
    const int tid = threadIdx.x;
    const int G = gridDim.x; const int bx = blockIdx.x; const int vcu = (G % 8 == 0) ? (bx % 8) * (G / 8) + bx / 8 : bx;
    unsigned* ctl = (unsigned*)(args.ws + WS_CTL);
    for (int u = tid; u < (LDS_BYTES - MISC_OFF) / 4; u += NTHR) ((LAS unsigned*)(lds + MISC_OFF))[u] = 0u;
    __syncthreads();
#if MK_ONE_LAUNCH
    XcdBarrier bar = xcd_barrier_post(ctl + CW_BAR, (volatile LAS unsigned*)(lds + MISC_OFF + MI_BAR));
#else
    XcdBarrier bar; bar.bar = ctl + CW_BAR; bar.x = 0; bar.st = nullptr;
#endif
    const int lo = args.ph_lo, hi = args.ph_hi;

    if (PHSEL(11) && IN(0)) { p0_prologue(CTX(), lds, vcu, G); SEAM(0); }

#pragma unroll 1
    for (int l = 0; l < 2; ++l) layer_phases(l, args, lds, G, bx, vcu, lo, hi, bar);
#undef IN
#undef SEAM
}

extern "C" void kernel_launch(void* const* d_in, const int* in_sizes, int n_in, void* d_out, int out_size, void* d_ws, size_t ws_size, hipStream_t stream) {
    static int grid = 0;
    if (grid == 0) {
        if (n_in != 36 || in_sizes[0] != NB * SEQ * D || out_size != NB * SEQ * D || ws_size < WS_END) {
            fprintf(stderr, "kernel_launch: unexpected problem (n_in %d, in0 %d, out %d, ws %zu, need %zu); nothing launched\n", n_in, n_in > 0 ? in_sizes[0] : -1, out_size, ws_size, (size_t)WS_END); grid = -1; return; }
        int dev = 0, cus = 0, per_cu = 0;
        if (hipGetDevice(&dev) != hipSuccess || hipDeviceGetAttribute(&cus, hipDeviceAttributeMultiprocessorCount, dev) != hipSuccess) { grid = -1; return; }
        if (hipFuncSetAttribute((const void*)trunk_fwd, hipFuncAttributeMaxDynamicSharedMemorySize, LDS_BYTES) != hipSuccess) { fprintf(stderr, "kernel_launch: hipFuncSetAttribute failed\n"); grid = -1; return; }
        if (hipOccupancyMaxActiveBlocksPerMultiprocessor(&per_cu, (const void*)trunk_fwd, NTHR, LDS_BYTES) != hipSuccess || per_cu < 1) { fprintf(stderr, "kernel_launch: occupancy query says %d\n", per_cu); (void)hipGetLastError(); }
        grid = cus;
        if (grid < 129 || grid > 512) { fprintf(stderr, "kernel_launch: unsupported CU count %d\n", cus); grid = -1; return; }
    }
    if (grid < 0) return;
    if (hipMemsetAsync((char*)d_ws + WS_CTL, 0, CTL_ZERO_BYTES, stream) != hipSuccess) return;
    Args a; memset(&a, 0, sizeof(a));
    for (int i = 0; i < 36; ++i) a.in[i] = (const float*)d_in[i];
    a.out = (float*)d_out; a.ws = (unsigned char*)d_ws;
#if MK_ONE_LAUNCH
    a.ph_lo = 0; a.ph_hi = N_PHASES;
    hipLaunchKernelGGL(trunk_fwd, dim3(grid), dim3(NTHR), LDS_BYTES, stream, a);
#else
    for (int p = 0; p < N_PHASES; ++p) { a.ph_lo = p; a.ph_hi = p + 1; hipLaunchKernelGGL(trunk_fwd, dim3(grid), dim3(NTHR), LDS_BYTES, stream, a); }
#endif
}
```

```cpp
#include <hip/hip_runtime.h>
#include <cstdio>
#include <cstdint>
#include <cstring>

#ifndef MK_ONE_LAUNCH
#define MK_ONE_LAUNCH 1
#endif

#ifndef SCAN_SEQ
#define SCAN_SEQ 0
#endif
#ifndef SCAN_MIX
#define SCAN_MIX 0
#endif
#ifndef DSA_NAIVE
#define DSA_NAIVE 0
#endif
#ifndef PHASE_FN
#define PHASE_FN __forceinline__
#endif
#define GAS __attribute__((address_space(1)))
#define LAS __attribute__((address_space(3)))
typedef unsigned short bf16;
typedef unsigned v4u __attribute__((ext_vector_type(4)));
typedef unsigned v2u __attribute__((ext_vector_type(2)));
typedef float v4f __attribute__((ext_vector_type(4)));
typedef float v2f __attribute__((ext_vector_type(2)));

constexpr int NB = 8, SEQ = 8192, NMETA = 16, L = SEQ + NMETA  , T = NB * L  , TP = 65792  , D = 1024;
constexpr int NINP = 3584;
constexpr int NE = 32, TOPK = 4;
constexpr int RMAX = 1058 * 256;
constexpr int C_RW = 0, C_RW_R = 0, C_RW_WD = 256, C_RW_K = 320, C_RW_V = 576, C_RW_AD = 832, C_RW_GD = 896;
constexpr int C_DS_Q = 960, C_DS_K = 1216, C_DS_V = 1472, C_DS_QI = 1728, C_DS_KI = 1984, C_DS_WI = 2016;
constexpr int C_LR_X = 2024, C_LR_G = 2280;
constexpr int C_HG_Q = 2536, C_HG_F = 2792, C_HG_I = 3048, C_HG_G = 3304;
constexpr float ALPHA = 1.41421356237f;
constexpr float LN_EPS = 1e-5f;

constexpr size_t MiB = 1u << 20;
constexpr size_t WS_CTL = 0, CTL_ZERO_BYTES = 1 * MiB;
constexpr size_t WS_WIN = 2 * MiB;
constexpr size_t WS_WOUT = 16 * MiB;
constexpr size_t WS_W1 = 20 * MiB;
constexpr size_t WS_W2 = 276 * MiB;
constexpr size_t WS_H = 404 * MiB;
constexpr size_t WS_MIX = WS_H;
constexpr size_t WS_HB = 661 * MiB;
constexpr size_t WS_BIG = 790 * MiB;
constexpr size_t WS_PROJ = WS_BIG;
constexpr size_t SZ_HM32 = (size_t)32 * L * 64 * 4;
constexpr size_t SZ_HM16 = SZ_HM32 / 2;
constexpr size_t SZ_TM16 = (size_t)T * 256 * 2;
constexpr size_t WS_RW_W = 1240 * MiB;
constexpr size_t WS_RW_A = WS_RW_W + SZ_HM32, WS_RW_B = WS_RW_A + SZ_HM16, WS_RW_K = WS_RW_B + SZ_HM16, WS_RW_WR = WS_RW_K + SZ_HM16, WS_RW_V = WS_RW_WR + SZ_HM16;
constexpr size_t WS_RW_G = WS_RW_V + SZ_HM16;
constexpr size_t WS_RW_SC = WS_RW_G + SZ_TM16;
constexpr size_t WS_DS_Q = WS_RW_SC + (size_t)32 * L * 16;
constexpr size_t WS_DS_K = WS_DS_Q + SZ_TM16, WS_DS_V = WS_DS_K + SZ_TM16, WS_DS_QI = WS_DS_V + SZ_TM16;
constexpr size_t WS_DS_KI = WS_DS_QI + SZ_TM16;
constexpr size_t WS_DS_WI = WS_DS_KI + (size_t)T * 64;
constexpr size_t WS_LR_A = WS_DS_WI + (size_t)T * 32;
constexpr size_t WS_LR_U = WS_LR_A + (size_t)T * 1024, WS_LR_G = WS_LR_U + SZ_TM16;
constexpr size_t WS_HG_F = WS_LR_G + SZ_TM16;
constexpr size_t WS_HG_K = WS_HG_F + SZ_HM32, WS_HG_Q = WS_HG_K + SZ_HM16, WS_HG_V = WS_HG_Q + SZ_HM16, WS_HG_G = WS_HG_V + SZ_HM16;
constexpr size_t WS_MIX_END = WS_HG_G + SZ_TM16;
constexpr size_t SZ_SORT = (size_t)RMAX * 1024 * 2;
constexpr size_t WS_SORTA = WS_BIG, WS_YBUF = WS_BIG, WS_ACT = WS_BIG + SZ_SORT;
constexpr size_t WS_TIDX = WS_ACT + SZ_SORT;
constexpr size_t WS_TGATE = WS_TIDX + (size_t)T * 16;
constexpr size_t WS_SPOS = WS_TGATE + (size_t)T * 16;
constexpr size_t WS_GSORT = WS_SPOS + (size_t)T * 16;
constexpr size_t WS_RMAP = WS_GSORT + (size_t)RMAX * 4;
constexpr size_t WS_MOE_END = WS_RMAP + (size_t)RMAX * 4;
constexpr size_t WS_END = 2040 * MiB;
static_assert(WS_MIX_END <= WS_END && WS_MOE_END <= WS_END, "workspace map");
static_assert(WS_PROJ + (size_t)TP * NINP * 2 <= WS_RW_W, "proj vs prep");
static_assert(WS_HB + (size_t)TP * 1024 * 2 <= WS_BIG && WS_H + (size_t)TP * 4096 <= WS_HB, "h/hb");

constexpr int CW_TMO = 0, CW_CODE = 1;
constexpr int CW_BAR = 4096;
constexpr int CW_DSAQ = 8192;
constexpr int CW_ECNT = 8448;
constexpr int CW_ECUR = 8704;

constexpr int LDS_BYTES = 163840;
constexpr int MISC_OFF = 155648;
constexpr int MI_BAR = 0, MI_HIST = 64, MI_LCUR = 192, MI_LBASE = 320, MI_NT = 448, MI_OFFS = 512, MI_TILE = 1024;
constexpr int NWAVES = 8, NTHR = 512;

__device__ __forceinline__ float bf2f(unsigned short x) { return __uint_as_float((unsigned)x << 16); }
__device__ __forceinline__ float bflo(unsigned x) { return __uint_as_float(x << 16); }
__device__ __forceinline__ float bfhi(unsigned x) { return __uint_as_float(x & 0xffff0000u); }
typedef float f32x2_t __attribute__((ext_vector_type(2))); typedef __bf16 bf16x2_t __attribute__((ext_vector_type(2)));
__device__ __forceinline__ unsigned pk2(float lo, float hi) { const f32x2_t v = {lo, hi}; const bf16x2_t b = __builtin_convertvector(v, bf16x2_t); return __builtin_bit_cast(unsigned, b); }
__device__ __forceinline__ bf16 f2bf(float f) { return (bf16)(pk2(f, 0.f) & 0xffffu); }
__device__ __forceinline__ v4f ld_bf4(const bf16* p) { const v2u x = *(const v2u*)p; return (v4f){bflo(x.x), bfhi(x.x), bflo(x.y), bfhi(x.y)}; }
__device__ __forceinline__ void st_bf4(bf16* p, v4f v) { v2u o; o.x = pk2(v.x, v.y); o.y = pk2(v.z, v.w); *(v2u*)p = o; }
__device__ __forceinline__ float wave_max(float v) {
#pragma unroll
    for (int o = 1; o < 64; o <<= 1) v = fmaxf(v, __shfl_xor(v, o));
    return v;
}
template <int CTRL> __device__ __forceinline__ float dpp_f(float x) { return __int_as_float(__builtin_amdgcn_update_dpp(0, __float_as_int(x), CTRL, 0xF, 0xF, true)); }
__device__ __forceinline__ float sum8(float x) { x += dpp_f<0xB1>(x); x += dpp_f<0x4E>(x); x += dpp_f<0x141>(x); return x; }
__device__ __forceinline__ float sum16(float x) { x = sum8(x); x += dpp_f<0x140>(x); return x; }
__device__ __forceinline__ float wave_sum(float v) {
    v = sum16(v);
    v += __shfl_xor(v, 16); v += __shfl_xor(v, 32);
    return v;
}
__device__ __forceinline__ float rcp_(float x) { return __builtin_amdgcn_rcpf(x); }
__device__ __forceinline__ float rsq_(float x) { return __builtin_amdgcn_rsqf(x); }
__device__ __forceinline__ float sigmoidf_(float x) { return rcp_(1.f + __expf(-x)); }
__device__ __forceinline__ float softplusf_(float x) { return x > 20.f ? x : log1pf(__expf(x)); }
__device__ __forceinline__ float gelu_tanh(float x) { const float u = 0.7978845608028654f * (x + 0.044715f * x * x * x); return 0.5f * x * (1.f + tanhf(u)); }
__device__ __forceinline__ int lds_add(LAS int* p, int v) { return __hip_atomic_fetch_add(p, v, __ATOMIC_RELAXED, __HIP_MEMORY_SCOPE_WORKGROUP); }
#define LDS_WAIT() asm volatile("s_waitcnt lgkmcnt(0)" ::: "memory")
#define VM_WAIT() asm volatile("s_waitcnt vmcnt(0)" ::: "memory")

__device__ __forceinline__ GAS unsigned char* launder(unsigned char* p) { GAS unsigned char* g = (GAS unsigned char*)p; asm volatile("" : "+s"(g)); return g; }
__device__ __forceinline__ int opaque_tid() { int t = (int)threadIdx.x; asm volatile("" : "+v"(t)); return t; }
__device__ __forceinline__ int opaque_s(int x) { return __builtin_amdgcn_readfirstlane(x); }
struct Args { const float* in[36]; float* out; unsigned char* ws; int ph_lo, ph_hi; };
struct Ctx { const float* const* in; float* out; GAS unsigned char* ws; };
__device__ __forceinline__ const float* gin(const Ctx& A, int k) { return (const float*)(const GAS float*)A.in[k]; }
namespace pg8 {
#define PG8_LAS __attribute__((address_space(3)))
typedef unsigned short bf16_t;
typedef short bf16x8 __attribute__((ext_vector_type(8)));
typedef float f32x4 __attribute__((ext_vector_type(4)));
typedef unsigned u32x4 __attribute__((ext_vector_type(4)));
constexpr int BM = 256, BK = 64, HALF = 128, HTB = HALF * BK * 2  , STAGE_BYTES = 8 * HTB, NXCD = 8, WGM = 8;

__host__ __device__ __forceinline__ int lds_byte(int r, int c) { const int st = (r >> 4) * 2 + (c >> 5), rr = r & 15, cc = c & 31, ob = rr * 64 + cc * 2; return st * 1024 + (ob ^ (((ob >> 9) & 1) << 5)); }
__host__ __device__ __forceinline__ void stage_rc(int b, int& R, int& C) { const int st = b / 1024, sb = b % 1024, swz = sb ^ (((sb >> 9) & 1) << 5); R = (st >> 1) * 16 + swz / 64; C = (st & 1) * 32 + (swz % 64) / 2; }
__host__ __device__ __forceinline__ int perm32(int rho) { const int n = rho >> 4, i = rho & 15; return 8 * (i >> 2) + 4 * n + (i & 3); }

struct Unit { int pm, pn; };
struct Gemm { const bf16_t* A; const bf16_t* Bt; int M, N, K; };

struct StaticOrder {
    int nM, nN, nwg, G, c;
    __host__ __device__ void init(int M, int N, int G_, int c_) { nM = M / BM; nN = N / BM; nwg = nM * nN; G = G_; c = c_; }
    __host__ __device__ bool next(int i, Unit& u) const {
        const long L = (long)i * G + c; if (L >= nwg) return false;
        int wgid = (int)L; { const int q = nwg / NXCD, r = nwg % NXCD, xcd = wgid % NXCD, off = wgid / NXCD; wgid = (xcd < r ? xcd * (q + 1) : r * (q + 1) + (xcd - r) * q) + off; }
        const int nig = WGM * nN, gid = wgid / nig, fm = gid * WGM, gsz = (nM - fm) < WGM ? (nM - fm) : WGM;
        u.pm = fm + ((wgid % nig) % gsz); u.pn = (wgid % nig) / gsz; return true;
    }
    __device__ __forceinline__ void a_ready(const Unit&) const {}
    __device__ __forceinline__ void done(const Unit&) const {}
};

__device__ __forceinline__ unsigned cvt_pk_bf16(float lo, float hi) { unsigned r; asm volatile("v_cvt_pk_bf16_f32 %0, %1, %2" : "=v"(r) : "v"(lo), "v"(hi)); return r; }
typedef float f32x2 __attribute__((ext_vector_type(2)));
typedef unsigned u32x2v __attribute__((ext_vector_type(2)));
typedef float pf32x2_t __attribute__((ext_vector_type(2))); typedef __bf16 pbf16x2_t __attribute__((ext_vector_type(2)));
__device__ __forceinline__ unsigned cvt_pk_bf16c(float lo, float hi) { const pf32x2_t v = {lo, hi}; const pbf16x2_t q = __builtin_convertvector(v, pbf16x2_t); return __builtin_bit_cast(unsigned, q); }
struct EpiStoreBf16 {
    static constexpr bool PERM = true, AFTER_DRAIN = false;
    bf16_t* O; int ldc;
    __device__ __forceinline__ void operator()(const f32x4 (&acc)[2][2][4][2], const Unit& u, int wr, int wc, int fr, int fq) const {
        const int row0 = u.pm * BM + wr * 64 + fr, col0 = u.pn * BM + wc * 32 + 8 * fq;
#pragma unroll
        for (int ai = 0; ai < 2; ++ai)
#pragma unroll
            for (int m = 0; m < 4; ++m) { bf16_t* rowp = O + (size_t)(row0 + ai * HALF + m * 16) * ldc + col0;
#pragma unroll
                for (int bj = 0; bj < 2; ++bj) { const f32x4 v0 = acc[ai][bj][m][0], v1 = acc[ai][bj][m][1];
                    u32x4 w; w.x = cvt_pk_bf16c(v0[0], v0[1]); w.y = cvt_pk_bf16c(v0[2], v0[3]); w.z = cvt_pk_bf16c(v1[0], v1[1]); w.w = cvt_pk_bf16c(v1[2], v1[3]);
                    *(u32x4*)(rowp + bj * HALF) = w; } }
    }
};
struct EpiResid {
    static constexpr bool PERM = false, AFTER_DRAIN = false;
    float* Hres; int ldc; float alpha;
    __device__ __forceinline__ void operator()(const f32x4 (&acc)[2][2][4][2], const Unit& u, int wr, int wc, int fr, int fq) const {
        const int row0 = u.pm * BM + wr * 64 + fr, col0 = u.pn * BM + wc * 32 + 4 * fq;
#pragma unroll
        for (int ai = 0; ai < 2; ++ai)
#pragma unroll
            for (int m = 0; m < 4; ++m) { float* rowp = Hres + (size_t)(row0 + ai * HALF + m * 16) * ldc + col0;
#pragma unroll
                for (int bj = 0; bj < 2; ++bj)
#pragma unroll
                    for (int n = 0; n < 2; ++n) { f32x4* p = (f32x4*)(rowp + bj * HALF + n * 16); const f32x4 old = *p; *p = old * alpha + acc[ai][bj][m][n]; } }
    }
};
struct EpiResidBf {
    static constexpr bool PERM = true, AFTER_DRAIN = false;
    bf16_t* Hb; int ldc; float alpha;
    __device__ __forceinline__ void operator()(const f32x4 (&acc)[2][2][4][2], const Unit& u, int wr, int wc, int fr, int fq) const {
        const int row0 = u.pm * BM + wr * 64 + fr, col0 = u.pn * BM + wc * 32 + 8 * fq;
#pragma unroll
        for (int ai = 0; ai < 2; ++ai)
#pragma unroll
            for (int m = 0; m < 4; ++m) { bf16_t* rowp = Hb + (size_t)(row0 + ai * HALF + m * 16) * ldc + col0;
#pragma unroll
                for (int bj = 0; bj < 2; ++bj) { const f32x4 v0 = acc[ai][bj][m][0], v1 = acc[ai][bj][m][1]; const u32x4 o = *(const u32x4*)(rowp + bj * HALF);
#define RB_LO(x_) __builtin_bit_cast(float, (x_) << 16)
#define RB_HI(x_) __builtin_bit_cast(float, (x_) & 0xffff0000u)
                    u32x4 w; w.x = cvt_pk_bf16c(RB_LO(o.x) * alpha + v0[0], RB_HI(o.x) * alpha + v0[1]); w.y = cvt_pk_bf16c(RB_LO(o.y) * alpha + v0[2], RB_HI(o.y) * alpha + v0[3]);
                    w.z = cvt_pk_bf16c(RB_LO(o.z) * alpha + v1[0], RB_HI(o.z) * alpha + v1[1]); w.w = cvt_pk_bf16c(RB_LO(o.w) * alpha + v1[2], RB_HI(o.w) * alpha + v1[3]);
#undef RB_LO
#undef RB_HI
                    *(u32x4*)(rowp + bj * HALF) = w; } }
    }
};
struct EpiSwiGLU {
    static constexpr bool PERM = true, AFTER_DRAIN = false;
    bf16_t* ACT; const float* b1;
    __device__ __forceinline__ void operator()(const f32x4 (&acc)[2][2][4][2], const Unit& u, int wr, int wc, int fr, int fq) const {
        const int e = u.pn >> 3, pnl = u.pn & 7;
        const int row0 = u.pm * BM + wr * 64 + fr, c8 = pnl * 128 + wc * 32 + 8 * fq;
        const float* bg = b1 + (size_t)e * 2048 + c8; const float* bl = bg + 1024;
        const f32x4 bg0 = *(const f32x4*)bg, bg1 = *(const f32x4*)(bg + 4), bl0 = *(const f32x4*)bl, bl1 = *(const f32x4*)(bl + 4);
#pragma unroll
        for (int ai = 0; ai < 2; ++ai)
#pragma unroll
            for (int m = 0; m < 4; ++m) {
                float o[8];
#pragma unroll
                for (int n = 0; n < 2; ++n) { const f32x4 g4 = acc[ai][0][m][n] + (n ? bg1 : bg0), l4 = acc[ai][1][m][n] + (n ? bl1 : bl0);
#pragma unroll
                    for (int j = 0; j < 4; ++j) { const float glu = fminf(g4[j], 7.f), lin = fminf(fmaxf(l4[j], -7.f), 7.f);
                        o[n * 4 + j] = glu * __builtin_amdgcn_rcpf(1.f + __builtin_amdgcn_exp2f(glu * (-1.702f * 1.4426950408889634f))) * (lin + 1.f); } }
                u32x4 w; w.x = cvt_pk_bf16c(o[0], o[1]); w.y = cvt_pk_bf16c(o[2], o[3]); w.z = cvt_pk_bf16c(o[4], o[5]); w.w = cvt_pk_bf16c(o[6], o[7]);
                *(u32x4*)(ACT + (size_t)(row0 + ai * HALF + m * 16) * 1024 + c8) = w; }
    }
};
struct EpiMoeOut {
    static constexpr bool PERM = true, AFTER_DRAIN = false;
    bf16_t* Y; const float* b2; const float* gate;
    __device__ __forceinline__ void operator()(const f32x4 (&acc)[2][2][4][2], const Unit& u, int wr, int wc, int fr, int fq) const {
        const int e = u.pn >> 2, pnl = u.pn & 3;
        const int row0 = u.pm * BM + wr * 64 + fr, c8 = pnl * 256 + wc * 32 + 8 * fq;
        const float* bb = b2 + (size_t)e * 1024 + c8;
        f32x4 bv[2][2];
#pragma unroll
        for (int bj = 0; bj < 2; ++bj) { bv[bj][0] = *(const f32x4*)(bb + bj * HALF); bv[bj][1] = *(const f32x4*)(bb + bj * HALF + 4); }
#pragma unroll
        for (int ai = 0; ai < 2; ++ai)
#pragma unroll
            for (int m = 0; m < 4; ++m) { const int row = row0 + ai * HALF + m * 16; const float gt = gate[row];
#pragma unroll
                for (int bj = 0; bj < 2; ++bj) { const f32x4 v0 = (acc[ai][bj][m][0] + bv[bj][0]) * gt, v1 = (acc[ai][bj][m][1] + bv[bj][1]) * gt;
                    u32x4 w; w.x = cvt_pk_bf16c(v0[0], v0[1]); w.y = cvt_pk_bf16c(v0[2], v0[3]); w.z = cvt_pk_bf16c(v1[0], v1[1]); w.w = cvt_pk_bf16c(v1[2], v1[3]);
                    *(u32x4*)(Y + (size_t)row * 1024 + c8 + bj * HALF) = w; } }
    }
};
struct MoeOrder {
    int n_units, G, c, npn; const PG8_LAS int* tile_e;
    __device__ __forceinline__ bool next(int i, Unit& u) const {
        const int Lx = i * G + c; if (Lx >= n_units) return false;
        const int tile = Lx / npn, pnl = Lx - tile * npn;
        u.pm = tile; u.pn = tile_e[tile] * npn + pnl; return true;
    }
    __device__ __forceinline__ void a_ready(const Unit&) const {}
    __device__ __forceinline__ void done(const Unit&) const {}
};

template <class Epi, class Sched, bool ALIGN_EPI = false, bool SP2 = false>
__device__ __forceinline__ void gemm_phase(PG8_LAS unsigned char* lds, const Gemm g, const Sched& S, const Epi& E) {
    const int tid = opaque_tid(), wid = __builtin_amdgcn_readfirstlane(tid >> 6), lane = tid & 63, wr = wid >> 2, wc = wid & 3, fr = lane & 15, fq = lane >> 4;
    const int K = g.K, nt = K / BK;
    unsigned voffA[2], voffB[2];
#pragma unroll
    for (int i = 0; i < 2; ++i) { int R, C; stage_rc(tid * 16 + i * 8192, R, C); const int Rb = Epi::PERM ? ((R & ~31) + perm32(R & 31)) : R;
        voffA[i] = (unsigned)(R * K + C) * 2u; voffB[i] = (unsigned)(Rb * K + C) * 2u; }
    const size_t kstep = (size_t)(BK * 2);
    const size_t hstep = (size_t)HALF * K * 2;
    const size_t tstep = 2 * hstep;
    const unsigned ldsw = (unsigned)wid * 1024u;
    const int aoff = lds_byte(wr * 64 + fr, fq * 8), boff = lds_byte(wc * 32 + fr, fq * 8);
#define PG8_SA(b, h) (((b) * 2 + (h)) * HTB)
#define PG8_SB(b, h) ((4 + (b) * 2 + (h)) * HTB)
#define PG8_STAGE(bufoff, gbase, voff) do { _Pragma("unroll") for (int _i = 0; _i < 2; ++_i) \
        __builtin_amdgcn_global_load_lds((const unsigned*)((const char*)(gbase) + (voff)[_i]), (PG8_LAS unsigned*)(lds + (bufoff) + ldsw + _i * 8192), 16, 0, 0); } while (0)
#define PG8_LDA(dst, b, h) do { _Pragma("unroll") for (int m = 0; m < 4; ++m) _Pragma("unroll") for (int k = 0; k < 2; ++k) dst[m][k] = *(const PG8_LAS bf16x8*)(lds + PG8_SA(b, h) + aoff + m * 2048 + k * 1024); } while (0)
#define PG8_LDB(dst, b, h) do { _Pragma("unroll") for (int n = 0; n < 2; ++n) _Pragma("unroll") for (int k = 0; k < 2; ++k) dst[n][k] = *(const PG8_LAS bf16x8*)(lds + PG8_SB(b, h) + boff + n * 2048 + k * 1024); } while (0)
#define PG8_MMA(ai, bj, At, Bt) do { __builtin_amdgcn_s_setprio(1); _Pragma("unroll") for (int m = 0; m < 4; ++m) _Pragma("unroll") for (int n = 0; n < 2; ++n) _Pragma("unroll") for (int k = 0; k < 2; ++k) \
        acc[ai][bj][m][n] = __builtin_amdgcn_mfma_f32_16x16x32_bf16(Bt[n][k], At[m][k], acc[ai][bj][m][n], 0, 0, 0); __builtin_amdgcn_s_setprio(0); } while (0)
#define PG8_WAIT_V(n) asm volatile("s_waitcnt vmcnt(" #n ")" ::: "memory")
#define PG8_WAIT_L(n) asm volatile("s_waitcnt lgkmcnt(" #n ")" ::: "memory")
#define PG8_BAR __builtin_amdgcn_s_barrier()
#define PG8_SCHED __builtin_amdgcn_sched_barrier(0)
    Unit cur, nxt; int ui = 0;
    if (!S.next(0, cur)) return;
    f32x4 acc[2][2][4][2];
#pragma unroll
    for (int a = 0; a < 2; ++a)
#pragma unroll
        for (int b = 0; b < 2; ++b)
#pragma unroll
            for (int m = 0; m < 4; ++m)
#pragma unroll
                for (int n = 0; n < 2; ++n) acc[a][b][m][n] = (f32x4){0.f, 0.f, 0.f, 0.f};
    bf16x8 At[4][2], B0[2][2], B1[2][2];
    const char* cA = (const char*)g.A + (size_t)cur.pm * tstep; const char* cB = (const char*)g.Bt + (size_t)cur.pn * tstep;
    S.a_ready(cur);
    if constexpr (SP2) {
        PG8_STAGE(PG8_SB(0, 0), cB, voffB); PG8_STAGE(PG8_SB(0, 1), cB + hstep, voffB); PG8_STAGE(PG8_SA(0, 0), cA, voffA); PG8_STAGE(PG8_SA(0, 1), cA + hstep, voffA);
        if (wr == 1) PG8_BAR;
        PG8_WAIT_V(2); PG8_BAR;
        PG8_STAGE(PG8_SB(1, 0), cB + kstep, voffB); PG8_STAGE(PG8_SA(1, 0), cA + kstep, voffA); PG8_STAGE(PG8_SB(1, 1), cB + hstep + kstep, voffB);
        PG8_WAIT_V(6); PG8_BAR;
    } else {
        PG8_STAGE(PG8_SB(0, 0), cB, voffB); PG8_STAGE(PG8_SA(0, 0), cA, voffA); PG8_STAGE(PG8_SB(0, 1), cB + hstep, voffB); PG8_STAGE(PG8_SA(0, 1), cA + hstep, voffA);
        if (wr == 1) PG8_BAR;
        PG8_WAIT_V(4); PG8_BAR;
        PG8_STAGE(PG8_SB(1, 0), cB + kstep, voffB); PG8_STAGE(PG8_SA(1, 0), cA + kstep, voffA); PG8_STAGE(PG8_SB(1, 1), cB + hstep + kstep, voffB);
        PG8_WAIT_V(6); PG8_BAR;
    }
    for (;;) {
        const bool has_next = S.next(ui + 1, nxt);
        const char* nA = has_next ? (const char*)g.A + (size_t)nxt.pm * tstep : cA; const char* nB = has_next ? (const char*)g.Bt + (size_t)nxt.pn * tstep : cB;
        for (int t = 0; t < nt; t += 2) {
            const bool last = (t == nt - 2);
            const char* a1 = cA + (size_t)(t + 1) * kstep;
            const char* a2 = last ? nA : cA + (size_t)(t + 2) * kstep; const char* b2 = last ? nB : cB + (size_t)(t + 2) * kstep;
            const char* a3 = a2 + kstep; const char* b3 = b2 + kstep;
            if (last && has_next) S.a_ready(nxt);
            if constexpr (SP2) {
            PG8_LDB(B0, 0, 0); PG8_LDB(B1, 0, 1); PG8_SCHED; PG8_LDA(At, 0, 0); PG8_STAGE(PG8_SA(1, 1), a1 + hstep, voffA);
            PG8_WAIT_V(8); PG8_WAIT_L(0); PG8_BAR; PG8_MMA(0, 0, At, B0); PG8_MMA(0, 1, At, B1); PG8_BAR; PG8_SCHED;
            PG8_LDA(At, 0, 1); PG8_STAGE(PG8_SB(0, 0), b2, voffB); PG8_STAGE(PG8_SB(0, 1), b2 + hstep, voffB); PG8_STAGE(PG8_SA(0, 0), a2, voffA);
            PG8_WAIT_V(8); PG8_WAIT_L(0); PG8_BAR; PG8_MMA(1, 0, At, B0); PG8_MMA(1, 1, At, B1); PG8_BAR; PG8_SCHED;
            PG8_LDB(B0, 1, 0); PG8_LDB(B1, 1, 1); PG8_SCHED; PG8_LDA(At, 1, 0); PG8_STAGE(PG8_SA(0, 1), a2 + hstep, voffA);
            PG8_WAIT_V(8); PG8_WAIT_L(0); PG8_BAR; PG8_MMA(0, 0, At, B0); PG8_MMA(0, 1, At, B1); PG8_BAR; PG8_SCHED;
            PG8_LDA(At, 1, 1); PG8_STAGE(PG8_SB(1, 0), b3, voffB); PG8_STAGE(PG8_SB(1, 1), b3 + hstep, voffB); PG8_STAGE(PG8_SA(1, 0), a3, voffA);
            PG8_WAIT_V(8); PG8_WAIT_L(0); PG8_BAR; PG8_MMA(1, 0, At, B0); PG8_MMA(1, 1, At, B1); PG8_BAR; PG8_SCHED;
            } else {
            PG8_LDB(B0, 0, 0); PG8_SCHED; PG8_LDA(At, 0, 0); PG8_STAGE(PG8_SA(1, 1), a1 + hstep, voffA);
            PG8_WAIT_L(8); PG8_BAR; PG8_WAIT_L(0); PG8_MMA(0, 0, At, B0); PG8_BAR; PG8_SCHED;
            PG8_LDB(B1, 0, 1); PG8_STAGE(PG8_SB(0, 0), b2, voffB);
            PG8_BAR; PG8_WAIT_L(0); PG8_MMA(0, 1, At, B1); PG8_BAR;
            PG8_LDA(At, 0, 1); PG8_STAGE(PG8_SA(0, 0), a2, voffA);
            PG8_BAR; PG8_WAIT_L(0); PG8_MMA(1, 0, At, B0); PG8_BAR; PG8_SCHED;
            PG8_STAGE(PG8_SB(0, 1), b2 + hstep, voffB);
            PG8_WAIT_V(6); PG8_BAR; PG8_MMA(1, 1, At, B1); PG8_BAR;
            PG8_LDB(B0, 1, 0); PG8_SCHED; PG8_LDA(At, 1, 0); PG8_STAGE(PG8_SA(0, 1), a2 + hstep, voffA);
            PG8_WAIT_L(8); PG8_BAR; PG8_WAIT_L(0); PG8_MMA(0, 0, At, B0); PG8_BAR; PG8_SCHED;
            PG8_LDB(B1, 1, 1); PG8_STAGE(PG8_SB(1, 0), b3, voffB);
            PG8_BAR; PG8_WAIT_L(0); PG8_MMA(0, 1, At, B1); PG8_BAR;
            PG8_LDA(At, 1, 1); PG8_STAGE(PG8_SA(1, 0), a3, voffA);
            PG8_BAR; PG8_WAIT_L(0); PG8_MMA(1, 0, At, B0); PG8_BAR; PG8_SCHED;
            PG8_STAGE(PG8_SB(1, 1), b3 + hstep, voffB);
            PG8_WAIT_V(6); PG8_BAR; PG8_MMA(1, 1, At, B1); PG8_BAR;
            }
        }
        if constexpr (ALIGN_EPI) { if (wr == 0) PG8_BAR; }
        if constexpr (!Epi::AFTER_DRAIN) { E(acc, cur, wr, wc, fr, fq); S.done(cur); }
        if (!has_next) break;
#pragma unroll
        for (int a = 0; a < 2; ++a)
#pragma unroll
            for (int b = 0; b < 2; ++b)
#pragma unroll
                for (int m = 0; m < 4; ++m)
#pragma unroll
                    for (int n = 0; n < 2; ++n) acc[a][b][m][n] = (f32x4){0.f, 0.f, 0.f, 0.f};
        cur = nxt; cA = nA; cB = nB; ++ui;
        if constexpr (ALIGN_EPI) { if (wr == 1) PG8_BAR; }
    }
    PG8_WAIT_V(0);
    if constexpr (!ALIGN_EPI) { if (wr == 0) PG8_BAR; }
    PG8_BAR;
    if constexpr (Epi::AFTER_DRAIN) { E.fused(acc, cur, wr, wc, fr, fq, lds, wid, lane); S.done(cur); }
#undef PG8_SA
#undef PG8_SB
#undef PG8_STAGE
#undef PG8_LDA
#undef PG8_LDB
#undef PG8_MMA
#undef PG8_WAIT_V
#undef PG8_WAIT_L
#undef PG8_BAR
#undef PG8_SCHED
}
}
namespace pg8 {
template <class Epi, class Sched>
__device__ __forceinline__ void gemm_phase_gather(PG8_LAS unsigned char* lds, const Gemm g, const Sched& S, const Epi& E, const int* rmap) {
    constexpr bool ALIGN_EPI = true, SP2 = true;
    const int tid = opaque_tid(), wid = __builtin_amdgcn_readfirstlane(tid >> 6), lane = tid & 63, wr = wid >> 2, wc = wid & 3, fr = lane & 15, fq = lane >> 4;
    const int K = g.K, nt = K / BK;
    unsigned voffB[2];
#pragma unroll
    for (int i = 0; i < 2; ++i) { int R, C; stage_rc(tid * 16 + i * 8192, R, C); const int Rb = Epi::PERM ? ((R & ~31) + perm32(R & 31)) : R;
        voffB[i] = (unsigned)(Rb * K + C) * 2u; }
    const size_t kstep = (size_t)(BK * 2);
    const size_t hstep = (size_t)HALF * K * 2;
    const size_t tstep = 2 * hstep;
    const unsigned ldsw = (unsigned)wid * 1024u;
    const int aoff = lds_byte(wr * 64 + fr, fq * 8), boff = lds_byte(wc * 32 + fr, fq * 8);
#define PG8_SA(b, h) (((b) * 2 + (h)) * HTB)
#define PG8_SB(b, h) ((4 + (b) * 2 + (h)) * HTB)
#define PG8_STAGE(bufoff, gbase, voff) do { _Pragma("unroll") for (int _i = 0; _i < 2; ++_i) \
        __builtin_amdgcn_global_load_lds((const unsigned*)((const char*)(gbase) + (voff)[_i]), (PG8_LAS unsigned*)(lds + (bufoff) + ldsw + _i * 8192), 16, 0, 0); } while (0)
#define PG8_LDA(dst, b, h) do { _Pragma("unroll") for (int m = 0; m < 4; ++m) _Pragma("unroll") for (int k = 0; k < 2; ++k) dst[m][k] = *(const PG8_LAS bf16x8*)(lds + PG8_SA(b, h) + aoff + m * 2048 + k * 1024); } while (0)
#define PG8_LDB(dst, b, h) do { _Pragma("unroll") for (int n = 0; n < 2; ++n) _Pragma("unroll") for (int k = 0; k < 2; ++k) dst[n][k] = *(const PG8_LAS bf16x8*)(lds + PG8_SB(b, h) + boff + n * 2048 + k * 1024); } while (0)
#define PG8_MMA(ai, bj, At, Bt) do { __builtin_amdgcn_s_setprio(1); _Pragma("unroll") for (int m = 0; m < 4; ++m) _Pragma("unroll") for (int n = 0; n < 2; ++n) _Pragma("unroll") for (int k = 0; k < 2; ++k) \
        acc[ai][bj][m][n] = __builtin_amdgcn_mfma_f32_16x16x32_bf16(Bt[n][k], At[m][k], acc[ai][bj][m][n], 0, 0, 0); __builtin_amdgcn_s_setprio(0); } while (0)
#define PG8_WAIT_V(n) asm volatile("s_waitcnt vmcnt(" #n ")" ::: "memory")
#define PG8_WAIT_L(n) asm volatile("s_waitcnt lgkmcnt(" #n ")" ::: "memory")
#define PG8_BAR __builtin_amdgcn_s_barrier()
#define PG8_SCHED __builtin_amdgcn_sched_barrier(0)
    Unit cur, nxt; int ui = 0;
    if (!S.next(0, cur)) return;
    f32x4 acc[2][2][4][2];
#pragma unroll
    for (int a = 0; a < 2; ++a)
#pragma unroll
        for (int b = 0; b < 2; ++b)
#pragma unroll
            for (int m = 0; m < 4; ++m)
#pragma unroll
                for (int n = 0; n < 2; ++n) acc[a][b][m][n] = (f32x4){0.f, 0.f, 0.f, 0.f};
    bf16x8 At[4][2], B0[2][2], B1[2][2];
    const char* gA = (const char*)g.A; const char* cB = (const char*)g.Bt + (size_t)cur.pn * tstep;
    unsigned gofc[2][2];
    constexpr int RM_OFF = 8 * HTB;
#pragma unroll
    for (int i_ = 0; i_ < 2; ++i_) { int R, C; stage_rc(tid * 16 + i_ * 8192, R, C);
#pragma unroll
        for (int h_ = 0; h_ < 2; ++h_) gofc[h_][i_] = (unsigned)rmap[(size_t)cur.pm * BM + h_ * HALF + R] * (unsigned)(K * 2) + (unsigned)C * 2u; }
    S.a_ready(cur);
    if constexpr (SP2) {
        PG8_STAGE(PG8_SB(0, 0), cB, voffB); PG8_STAGE(PG8_SB(0, 1), cB + hstep, voffB); PG8_STAGE(PG8_SA(0, 0), gA, gofc[0]); PG8_STAGE(PG8_SA(0, 1), gA, gofc[1]);
        if (wr == 1) PG8_BAR;
        PG8_WAIT_V(2); PG8_BAR;
        PG8_STAGE(PG8_SB(1, 0), cB + kstep, voffB); PG8_STAGE(PG8_SA(1, 0), gA + kstep, gofc[0]); PG8_STAGE(PG8_SB(1, 1), cB + hstep + kstep, voffB);
        PG8_WAIT_V(6); PG8_BAR;
    }
    for (;;) {
        const bool has_next = S.next(ui + 1, nxt);
        const char* nB = has_next ? (const char*)g.Bt + (size_t)nxt.pn * tstep : cB;
        if (has_next) { const unsigned rmoff = (unsigned)(opaque_tid() & 255) * 4u;
            __builtin_amdgcn_global_load_lds((const unsigned*)((const char*)(rmap + (size_t)nxt.pm * BM) + rmoff), (PG8_LAS unsigned*)(lds + RM_OFF + wid * 256), 4, 0, 0); }
        for (int t = 0; t < nt; t += 2) {
            const bool last = (t == nt - 2);
            const char* a1 = gA + (size_t)(t + 1) * kstep;
            const char* a2 = last ? gA : gA + (size_t)(t + 2) * kstep; const char* b2 = last ? nB : cB + (size_t)(t + 2) * kstep;
            const char* a3 = a2 + kstep; const char* b3 = b2 + kstep;
            if (last && has_next) S.a_ready(nxt);
            if constexpr (SP2) {
            PG8_LDB(B0, 0, 0); PG8_LDB(B1, 0, 1); PG8_SCHED; PG8_LDA(At, 0, 0); PG8_STAGE(PG8_SA(1, 1), a1, gofc[1]);
            PG8_WAIT_V(8); PG8_WAIT_L(0); PG8_BAR; PG8_MMA(0, 0, At, B0); PG8_MMA(0, 1, At, B1); PG8_BAR; PG8_SCHED;
            if (last && has_next) { const int tid2 = opaque_tid();
#pragma unroll
                for (int i_ = 0; i_ < 2; ++i_) { int R, C; stage_rc(tid2 * 16 + i_ * 8192, R, C);
#pragma unroll
                    for (int h_ = 0; h_ < 2; ++h_) gofc[h_][i_] = (unsigned)*(const PG8_LAS int*)(lds + RM_OFF + (h_ * HALF + R) * 4) * (unsigned)(K * 2) + (unsigned)C * 2u; }
                PG8_SCHED; }
            PG8_LDA(At, 0, 1); PG8_STAGE(PG8_SB(0, 0), b2, voffB); PG8_STAGE(PG8_SB(0, 1), b2 + hstep, voffB); PG8_STAGE(PG8_SA(0, 0), a2, gofc[0]);
            PG8_WAIT_V(8); PG8_WAIT_L(0); PG8_BAR; PG8_MMA(1, 0, At, B0); PG8_MMA(1, 1, At, B1); PG8_BAR; PG8_SCHED;
            PG8_LDB(B0, 1, 0); PG8_LDB(B1, 1, 1); PG8_SCHED; PG8_LDA(At, 1, 0); PG8_STAGE(PG8_SA(0, 1), a2, gofc[1]);
            PG8_WAIT_V(8); PG8_WAIT_L(0); PG8_BAR; PG8_MMA(0, 0, At, B0); PG8_MMA(0, 1, At, B1); PG8_BAR; PG8_SCHED;
            PG8_LDA(At, 1, 1); PG8_STAGE(PG8_SB(1, 0), b3, voffB); PG8_STAGE(PG8_SB(1, 1), b3 + hstep, voffB); PG8_STAGE(PG8_SA(1, 0), a3, gofc[0]);
            PG8_WAIT_V(8); PG8_WAIT_L(0); PG8_BAR; PG8_MMA(1, 0, At, B0); PG8_MMA(1, 1, At, B1); PG8_BAR; PG8_SCHED;
            }
        }
        if constexpr (ALIGN_EPI) { if (wr == 0) PG8_BAR; }
        if constexpr (!Epi::AFTER_DRAIN) { const int lane2 = opaque_tid() & 63; E(acc, cur, wr, wc, lane2 & 15, lane2 >> 4); S.done(cur); }
        if (!has_next) break;
#pragma unroll
        for (int a = 0; a < 2; ++a)
#pragma unroll
            for (int b = 0; b < 2; ++b)
#pragma unroll
                for (int m = 0; m < 4; ++m)
#pragma unroll
                    for (int n = 0; n < 2; ++n) acc[a][b][m][n] = (f32x4){0.f, 0.f, 0.f, 0.f};
        cur = nxt; cB = nB; ++ui;
        if constexpr (ALIGN_EPI) { if (wr == 1) PG8_BAR; }
    }
    PG8_WAIT_V(0);
    if constexpr (!ALIGN_EPI) { if (wr == 0) PG8_BAR; }
    PG8_BAR;
    if constexpr (Epi::AFTER_DRAIN) { E.fused(acc, cur, wr, wc, fr, fq, lds, wid, lane); S.done(cur); }
#undef PG8_SA
#undef PG8_SB
#undef PG8_STAGE
#undef PG8_LDA
#undef PG8_LDB
#undef PG8_MMA
#undef PG8_WAIT_V
#undef PG8_WAIT_L
#undef PG8_BAR
#undef PG8_SCHED
}
}
#define XB_TMO      128
#define XB_XCNT(j)  (256  + 64 * (j))
#define XB_XSUB(j)  (1280 + 64 * (j))
#define XB_XGEN(j)  (2304 + 64 * (j))
#define XB_TOP      3328
#define XB_TOPGEN   3392
#define XCD_BAR_WORDS 3456
#define XB_SPIN_CAP (1u << 18)
#define LAS __attribute__((address_space(3)))

__device__ __forceinline__ unsigned xb_ld(unsigned* p)              { return __hip_atomic_load(p, __ATOMIC_RELAXED, __HIP_MEMORY_SCOPE_AGENT); }
__device__ __forceinline__ unsigned xb_add(unsigned* p, unsigned v) { return __hip_atomic_fetch_add(p, v, __ATOMIC_RELAXED, __HIP_MEMORY_SCOPE_AGENT); }
__device__ __forceinline__ unsigned xb_xcc_id() { return (unsigned)__builtin_amdgcn_s_getreg((3 << 11) | 20) & 0xFu; }
#define XB_SPIN(cond, bar) do { unsigned _sp = 0; while (cond) { __builtin_amdgcn_s_sleep(1); \
    if ((++_sp & 255u) == 0u) { if (xb_ld(&(bar)[XB_TMO])) break; if (_sp > XB_SPIN_CAP) { atomicAdd(&(bar)[XB_TMO], 1u); break; } } } } while (0)

struct XcdBarrier {
    unsigned* bar; unsigned x;
    volatile LAS unsigned* st;
};

__device__ __forceinline__ XcdBarrier xcd_barrier_post(unsigned* bar, volatile LAS unsigned* st) {
    XcdBarrier b; b.bar = bar; b.x = xb_xcc_id(); b.st = st;
    if (threadIdx.x == 0) (void)xb_add(&bar[XB_XCNT(b.x)], 1u);
    return b;
}
__device__ __forceinline__ void xcd_barrier_complete(unsigned* bar, unsigned x, unsigned& nloc, unsigned& nx) {
    const unsigned G = gridDim.x * gridDim.y * gridDim.z;
    unsigned sum, cnt, mine, sp = 0u;
    for (;;) {
        sum = 0u; cnt = 0u; mine = 0u;
#pragma unroll
        for (unsigned j = 0; j < 16; ++j) { const unsigned c = xb_ld(&bar[XB_XCNT(j)]); sum += c; cnt += (c > 0u) ? 1u : 0u; mine = (j == x) ? c : mine; }
        if (sum == G) break;
        __builtin_amdgcn_s_sleep(1);
        if ((++sp & 255u) == 0u) { if (xb_ld(&bar[XB_TMO])) break; if (sp > XB_SPIN_CAP) { atomicAdd(&bar[XB_TMO], 1u); break; } }
    }
    nloc = mine > 0u ? mine : 1u; nx = cnt > 0u ? cnt : 1u;
}

__device__ __forceinline__ void xcd_barrier(const XcdBarrier& b) {
    asm volatile("s_waitcnt vmcnt(0)" ::: "memory");
    __syncthreads();
    if (threadIdx.x == 0) {
        unsigned* bar = b.bar;
        __builtin_amdgcn_s_waitcnt(0);
        unsigned nloc = b.st[0], nx = b.st[1];
        if (nloc == 0u) { xcd_barrier_complete(bar, b.x, nloc, nx); b.st[0] = nloc; b.st[1] = nx; }
        const unsigned old = xb_add(&bar[XB_XSUB(b.x)], 1u);
        const unsigned gen = old / nloc;
        if (old + 1u == (gen + 1u) * nloc) {
            __builtin_amdgcn_fence(__ATOMIC_RELEASE, "agent");
            asm volatile("s_waitcnt vmcnt(0)" ::: "memory");
            const unsigned og = xb_add(&bar[XB_TOP], 1u);
            const unsigned tg = og / nx;
            if (og + 1u == (tg + 1u) * nx) xb_add(&bar[XB_TOPGEN], 1u);
            else XB_SPIN(xb_ld(&bar[XB_TOPGEN]) == tg, bar);
            __builtin_amdgcn_fence(__ATOMIC_ACQUIRE, "agent");
            xb_add(&bar[XB_XGEN(b.x)], 1u);
            asm volatile("s_waitcnt vmcnt(0)" ::: "memory");
        } else {
            XB_SPIN(xb_ld(&bar[XB_XGEN(b.x)]) == gen, bar);
            __builtin_amdgcn_fence(__ATOMIC_ACQUIRE, "agent");
            asm volatile("s_waitcnt vmcnt(0)" ::: "memory");
        }
    }
    __syncthreads();
}
__device__ __forceinline__ void p0_transpose_item(const float* W, int ldw, int ncols_valid, int k0, int n0, bf16* WT, size_t dst_row0, int Kdst, LAS float* scr, int lane) {
    const int nn = n0 + (lane & 31); const bool ok = nn < ncols_valid;
#pragma unroll 8
    for (int i = 0; i < 32; ++i) { const int kk = 2 * i + (lane >> 5); scr[kk * 33 + (lane & 31)] = ok ? W[(size_t)(k0 + kk) * ldw + nn] : 0.f; }
    LDS_WAIT();
    const int c = lane & 7;
#pragma unroll
    for (int j = 0; j < 4; ++j) { const int n = (lane >> 3) + 8 * j; const LAS float* s = scr + (8 * c) * 33 + n;
        v4u o; o.x = pk2(s[0 * 33], s[1 * 33]); o.y = pk2(s[2 * 33], s[3 * 33]); o.z = pk2(s[4 * 33], s[5 * 33]); o.w = pk2(s[6 * 33], s[7 * 33]);
        *(v4u*)(WT + (dst_row0 + n) * (size_t)Kdst + k0 + 8 * c) = o; }
    LDS_WAIT();
}
__device__ __forceinline__ void ln_row(v4f (&v)[4], const float* g, const float* b, int lane) {
    float s = 0.f, s2 = 0.f;
#pragma unroll
    for (int j = 0; j < 4; ++j) { s += (v[j].x + v[j].y) + (v[j].z + v[j].w); s2 += (v[j].x * v[j].x + v[j].y * v[j].y) + (v[j].z * v[j].z + v[j].w * v[j].w); }
    s = wave_sum(s); s2 = wave_sum(s2);
    const float mean = s * (1.f / D);
    const float rstd = rsq_(fmaxf(s2 * (1.f / D) - mean * mean, 0.f) + LN_EPS);
#pragma unroll
    for (int j = 0; j < 4; ++j) v[j] = v[j] - mean;
#pragma unroll
    for (int j = 0; j < 4; ++j) { const v4f gg = *(const v4f*)(g + 256 * j + 4 * lane), bb = *(const v4f*)(b + 256 * j + 4 * lane); v[j] = v[j] * rstd * gg + bb; }
}
__device__ PHASE_FN void p0_prologue(const Ctx A, LAS unsigned char* lds, int vcu, int G) {
    const int tid = opaque_tid(), lane = tid & 63, wave = tid >> 6;
    LAS float* scr = (LAS float*)(lds + wave * 16384);
    const int gw = vcu * NWAVES + wave, NGW = G * NWAVES;
    bf16* Win_t = (bf16*)(A.ws + WS_WIN); bf16* Wout_t = (bf16*)(A.ws + WS_WOUT); bf16* W1_t = (bf16*)(A.ws + WS_W1); bf16* W2_t = (bf16*)(A.ws + WS_W2);
    constexpr int I_IN = 2 * 16 * (NINP / 32), I_OUT = 2 * 16 * 32, I_W1 = 64 * 16 * 64, I_W2 = 64 * 16 * 32;
    constexpr int NITEMS = I_IN + I_OUT + I_W1 + I_W2;
    for (int it = gw; it < NITEMS; it += NGW) {
        int r = it;
        if (r < I_IN) { const int l = r / (16 * 112), q = r % (16 * 112), kb = q / 112, nb = q % 112;
            p0_transpose_item(gin(A, 4) + (size_t)l * 1024 * 3560, 3560, 3560, kb * 64, nb * 32, Win_t + (size_t)l * NINP * 1024, (size_t)nb * 32, 1024, scr, lane); continue; }
        r -= I_IN;
        if (r < I_OUT) { const int l = r / 512, q = r % 512, kb = q / 32, nb = q % 32;
            p0_transpose_item(gin(A, 25) + (size_t)l * 1024 * 1024, 1024, 1024, kb * 64, nb * 32, Wout_t + (size_t)l * 1024 * 1024, (size_t)nb * 32, 1024, scr, lane); continue; }
        r -= I_OUT;
        if (r < I_W1) { const int le = r / 1024, q = r % 1024, kb = q / 64, nb = q % 64, n0 = nb * 32;
            const int np = n0 & 1023; const size_t drow = (size_t)256 * (np >> 7) + (n0 >= 1024 ? 128 : 0) + (np & 127);
            p0_transpose_item(gin(A, 30) + (size_t)le * 1024 * 2048, 2048, 2048, kb * 64, n0, W1_t + (size_t)le * 2048 * 1024, drow, 1024, scr, lane); continue; }
        r -= I_W1;
        { const int le = r / 512, q = r % 512, kb = q / 32, nb = q % 32;
            p0_transpose_item(gin(A, 32) + (size_t)le * 1024 * 1024, 1024, 1024, kb * 64, nb * 32, W2_t + (size_t)le * 1024 * 1024, (size_t)nb * 32, 1024, scr, lane); }
    }
    bf16* HB = (bf16*)(A.ws + WS_HB);
    for (int m = gw; m < T; m += NGW) {
        const int b = m / L, i = m - b * L;
        const float* src = (i < NMETA) ? gin(A, 1) + (size_t)i * D : gin(A, 0) + ((size_t)b * SEQ + (i - NMETA)) * D;
        v4f v[4];
#pragma unroll
        for (int j = 0; j < 4; ++j) v[j] = *(const v4f*)(src + 256 * j + 4 * lane);
        ln_row(v, gin(A, 2), gin(A, 3), lane);
#pragma unroll
        for (int j = 0; j < 4; ++j) st_bf4(HB + (size_t)m * D + 256 * j + 4 * lane, v[j]);
    }
}
constexpr int NTK = 2;
__device__ __forceinline__ float softplus_fast(float x) { return x > 15.f ? x : __logf(1.f + __expf(x)); }
__device__ __forceinline__ float tanh_fast(float x) { return 1.f - 2.f * rcp_(1.f + __expf(2.f * x)); }
__device__ __forceinline__ void sincos_red(float ang, float& sn, float& cs) {
    const float k = rintf(ang * 0.15915494309189535f);
    float r = fmaf(-k, 6.28318548202514648f, ang); r = fmaf(-k, -1.7484555e-7f, r);
    sn = __sinf(r); cs = __cosf(r);
}
constexpr int PREP_W = 98304, PREP_SCR = 4096;
__device__ __forceinline__ void prep_load_w(LAS unsigned char* lds, const float* src, int n, int dst_elem, int tid) {
    for (int i = tid * 4; i < n; i += NTHR * 4) { const v4f x = *(const v4f*)(src + i); v2u o; o.x = pk2(x.x, x.y); o.y = pk2(x.z, x.w); *(LAS v2u*)(lds + (size_t)(dst_elem + i) * 2) = o; }
}
__device__ PHASE_FN void prep_phase(const Ctx A, LAS unsigned char* lds, int l, int vcu, int G) {
    const int tid = opaque_tid(), lane = tid & 63, wave = tid >> 6;
    LAS float* scr = (LAS float*)(lds + PREP_W + wave * PREP_SCR);
    const int gw = vcu * NWAVES + wave, NGW = G * NWAVES;
    const bf16* PROJ = (const bf16*)(A.ws + WS_PROJ);
    const int c4 = 4 * lane, hh = lane >> 4, d4 = 4 * (lane & 15);
    const float* mu = gin(A, 5) + l * 960; const float* w0 = gin(A, 6) + l * 256; const float* w2 = gin(A, 7) + l * 64 * 256;
    const float* a0 = gin(A, 8) + l * 256; const float* a2 = gin(A, 9) + l * 64 * 256; const float* g2 = gin(A, 10) + l * 64 * 256;
    const float* k_k = gin(A, 11) + l * 256; const float* k_a = gin(A, 12) + l * 256; const float* r_k = gin(A, 13) + l * 256;
    const float* conv_w = gin(A, 16) + l * 4 * 256; const float* conv_b = gin(A, 17) + l * 256;
    const float* wa = gin(A, 18) + l * 4 * 64 * 64; const float* ba = gin(A, 19) + l * 256; const float* wx = gin(A, 20) + l * 4 * 64 * 64; const float* bx = gin(A, 21) + l * 256;
    const float* lam = gin(A, 22) + l * 256; const float* lbs = gin(A, 23);
    float* RW_W = (float*)(A.ws + WS_RW_W); bf16* RW_A = (bf16*)(A.ws + WS_RW_A); bf16* RW_B = (bf16*)(A.ws + WS_RW_B); bf16* RW_K = (bf16*)(A.ws + WS_RW_K);
    bf16* RW_WR = (bf16*)(A.ws + WS_RW_WR); bf16* RW_V = (bf16*)(A.ws + WS_RW_V); bf16* RW_G = (bf16*)(A.ws + WS_RW_G); float* RW_SC = (float*)(A.ws + WS_RW_SC);
    bf16* DS_Q = (bf16*)(A.ws + WS_DS_Q); bf16* DS_K = (bf16*)(A.ws + WS_DS_K); bf16* DS_V = (bf16*)(A.ws + WS_DS_V); bf16* DS_QI = (bf16*)(A.ws + WS_DS_QI);
    bf16* DS_KI = (bf16*)(A.ws + WS_DS_KI); float* DS_WI = (float*)(A.ws + WS_DS_WI);
    float* LR_A = (float*)(A.ws + WS_LR_A); bf16* LR_U = (bf16*)(A.ws + WS_LR_U); bf16* LR_G = (bf16*)(A.ws + WS_LR_G);
    float* HG_F = (float*)(A.ws + WS_HG_F); bf16* HG_K = (bf16*)(A.ws + WS_HG_K); bf16* HG_Q = (bf16*)(A.ws + WS_HG_Q); bf16* HG_V = (bf16*)(A.ws + WS_HG_V); bf16* HG_G = (bf16*)(A.ws + WS_HG_G);
    LAS unsigned* kmaxl = (LAS unsigned*)(lds + MISC_OFF + 640);
    LAS unsigned* kimaxl = (LAS unsigned*)(lds + MISC_OFF + 832);
    if (tid < 32) kmaxl[tid] = 0u;
    if (tid < 8) kimaxl[tid] = 0u;
    const bool q_rot = (lane & 15) < 4, q_hi = (lane & 15) >= 2;
    const bool i_rot = (lane & 7) < 2, i_hi = (lane & 7) == 1;

    prep_load_w(lds, w2, 64 * 256, 0, tid); prep_load_w(lds, a2, 64 * 256, 16384, tid); prep_load_w(lds, g2, 64 * 256, 32768, tid);
    __syncthreads();
    unsigned short cs1[NTK + 1][3], ns1[NTK + 1][3]; v2u cs3[NTK + 1][3], ns3[NTK + 1][3];
#define PREP_R_LOAD(S1, S3, grp_) do { const int mm_ = (grp_) * NTK; const int bb_ = mm_ / L; const bool first_ = (mm_ - bb_ * L) == 0; \
        const bf16* Pq_ = PROJ + (size_t)mm_ * NINP; \
        _Pragma("unroll") for (int j = 0; j <= NTK; ++j) { const bf16* row_ = Pq_ + (size_t)(j - 1 + (j == 0 && first_ ? 1 : 0)) * NINP;     \
            S1[j][0] = row_[C_RW_WD + lane]; S1[j][1] = row_[C_RW_AD + lane]; S1[j][2] = row_[C_RW_GD + lane]; \
            S3[j][0] = *(const v2u*)(row_ + C_RW_R + c4); S3[j][1] = *(const v2u*)(row_ + C_RW_K + c4); S3[j][2] = *(const v2u*)(row_ + C_RW_V + c4); } } while (0)
    if (gw < T / NTK) PREP_R_LOAD(cs1, cs3, gw);
#pragma unroll 1
    for (int grp = gw; grp < T / NTK; grp += NGW) {
        const int m0 = grp * NTK, b = m0 / L, i0 = m0 - b * L;
        { const int gn = grp + NGW < T / NTK ? grp + NGW : grp; PREP_R_LOAD(ns1, ns3, gn); }
        {
            const float mu_wd = mu[C_RW_WD + lane], mu_ad = mu[C_RW_AD + lane], mu_gd = mu[C_RW_GD + lane];
            float pwd = i0 > 0 ? bf2f(cs1[0][0]) : 0.f, pad = i0 > 0 ? bf2f(cs1[0][1]) : 0.f, pgd = i0 > 0 ? bf2f(cs1[0][2]) : 0.f;
#pragma unroll
            for (int j = 0; j < NTK; ++j) {
                const float cwd = bf2f(cs1[j + 1][0]), cad = bf2f(cs1[j + 1][1]), cgd = bf2f(cs1[j + 1][2]);
                const float swd = cwd + (pwd - cwd) * mu_wd, sad = cad + (pad - cad) * mu_ad, sgd = cgd + (pgd - cgd) * mu_gd;
                scr[(0 * NTK + j) * 64 + lane] = tanh_fast(swd); scr[(1 * NTK + j) * 64 + lane] = sad; scr[(2 * NTK + j) * 64 + lane] = sigmoidf_(sgd);
                pwd = cwd; pad = cad; pgd = cgd;
            }
            LDS_WAIT();
        }
        v4f lor[3][NTK];
#pragma unroll
        for (int mat = 0; mat < 3; ++mat) {
#pragma unroll
            for (int j = 0; j < NTK; ++j) lor[mat][j] = (v4f){0.f, 0.f, 0.f, 0.f};
            const LAS unsigned char* Wm = lds + mat * 32768 + c4 * 2;
            v2u wA[4], wB[4]; v4f xA[NTK], xB[NTK];
#define PREP_LQ(W_, X_, k_) do { _Pragma("unroll") for (int kk = 0; kk < 4; ++kk) W_[kk] = *(const LAS v2u*)(Wm + ((k_) + kk) * 512); \
                _Pragma("unroll") for (int j = 0; j < NTK; ++j) X_[j] = *(const LAS v4f*)(scr + (mat * NTK + j) * 64 + (k_)); } while (0)
#define PREP_FQ(W_, X_) do { _Pragma("unroll") for (int kk = 0; kk < 4; ++kk) { const v4f ww = (v4f){bflo(W_[kk].x), bfhi(W_[kk].x), bflo(W_[kk].y), bfhi(W_[kk].y)}; \
                _Pragma("unroll") for (int j = 0; j < NTK; ++j) lor[mat][j] += ww * X_[j][kk]; } } while (0)
            PREP_LQ(wA, xA, 0);
#pragma unroll 1
            for (int k = 0; k < 64; k += 8) {
                PREP_LQ(wB, xB, k + 4);
                PREP_FQ(wA, xA);
                PREP_LQ(wA, xA, (k + 8) & 63);
                PREP_FQ(wB, xB);
            }
#undef PREP_LQ
#undef PREP_FQ
        }
        LDS_WAIT();
        {
            const v4f mu_r = *(const v4f*)(mu + C_RW_R + c4), mu_k = *(const v4f*)(mu + C_RW_K + c4), mu_v = *(const v4f*)(mu + C_RW_V + c4);
            const v4f w0v = *(const v4f*)(w0 + c4), a0v = *(const v4f*)(a0 + c4), kkv = *(const v4f*)(k_k + c4), kav = *(const v4f*)(k_a + c4), rkv = *(const v4f*)(r_k + c4);
#define BF4R(q_) ((v4f){bflo((q_).x), bfhi((q_).x), bflo((q_).y), bfhi((q_).y)})
            v4f pr = (v4f){0.f, 0.f, 0.f, 0.f}, pk = pr, pv = pr;
            if (i0 > 0) { pr = BF4R(cs3[0][0]); pk = BF4R(cs3[0][1]); pv = BF4R(cs3[0][2]); }
#pragma unroll
            for (int j = 0; j < NTK; ++j) {
                const v4f cr = BF4R(cs3[j + 1][0]), ck = BF4R(cs3[j + 1][1]), cv = BF4R(cs3[j + 1][2]);
                const v4f rs = cr + (pr - cr) * mu_r, ks = ck + (pk - ck) * mu_k, vs = cv + (pv - cv) * mu_v;
                pr = cr; pk = ck; pv = cv;
                const v4f lw = lor[0][j], la = lor[1][j], lg = lor[2][j];
                v4f dec, av, kkn, km, bv, wr;
                float n2 = 0.f, sbr = 0.f, skr = 0.f, sbo = 0.f;
#pragma unroll
                for (int e = 0; e < 4; ++e) {
                    const float wv = -softplus_fast(-(w0v[e] + lw[e])) - 0.5f;
                    dec[e] = __expf(-__expf(wv));
                    av[e] = sigmoidf_(a0v[e] + la[e]);
                    kkn[e] = ks[e] * kkv[e]; n2 += kkn[e] * kkn[e];
                    km[e] = ks[e] * (1.f + (av[e] - 1.f) * kav[e]);
                }
                n2 = sum16(n2);
                const float inv = rcp_(fmaxf(sqrtf(n2), 1e-12f));
#pragma unroll
                for (int e = 0; e < 4; ++e) { kkn[e] *= inv; bv[e] = kkn[e] * av[e]; wr[e] = dec[e] * rs[e]; sbr += bv[e] * rs[e]; skr += km[e] * rs[e]; sbo += rs[e] * km[e] * rkv[e]; kkn[e] = -kkn[e]; }
                sbr = sum16(sbr); skr = sum16(skr); sbo = sum16(sbo);
                const size_t hm = ((size_t)(b * 4 + hh) * L + (i0 + j)) * 64 + d4;
                *(v4f*)(RW_W + hm) = dec; st_bf4(RW_A + hm, kkn); st_bf4(RW_B + hm, bv); st_bf4(RW_K + hm, km); st_bf4(RW_WR + hm, wr); st_bf4(RW_V + hm, vs);
                st_bf4(RW_G + (size_t)(m0 + j) * 256 + c4, lg);
                if ((lane & 15) == 0) *(v4f*)(RW_SC + ((size_t)(b * 4 + hh) * L + (i0 + j)) * 4) = (v4f){sbr, skr, sbo, 0.f};
            }
        }
#pragma unroll
        for (int j = 0; j <= NTK; ++j) { cs1[j][0] = ns1[j][0]; cs1[j][1] = ns1[j][1]; cs1[j][2] = ns1[j][2]; cs3[j][0] = ns3[j][0]; cs3[j][1] = ns3[j][1]; cs3[j][2] = ns3[j][2]; }
    }
#undef PREP_R_LOAD
    __syncthreads();
    prep_load_w(lds, wa, 4 * 64 * 64, 0, tid); prep_load_w(lds, wx, 4 * 64 * 64, 16384, tid);
    __syncthreads();
    v2u cxb[NTK + 3], nxb[NTK + 3], cgr[NTK], ngr[NTK];
#define PREP_L_LOAD(XB, GR, grp_) do { const int mm_ = (grp_) * NTK; const int bb_ = mm_ / L; const int ii_ = mm_ - bb_ * L; const bf16* Pq_ = PROJ + (size_t)mm_ * NINP; \
        _Pragma("unroll") for (int r_ = 0; r_ < NTK + 3; ++r_) { const int ro_ = (ii_ + r_ - 3 >= 0) ? r_ - 3 : 0; XB[r_] = *(const v2u*)(Pq_ + (size_t)ro_ * NINP + C_LR_X + c4); }     \
        _Pragma("unroll") for (int j_ = 0; j_ < NTK; ++j_) GR[j_] = *(const v2u*)(Pq_ + (size_t)j_ * NINP + C_LR_G + c4); } while (0)
    if (gw < T / NTK) PREP_L_LOAD(cxb, cgr, gw);
#pragma unroll 1
    for (int grp = gw; grp < T / NTK; grp += NGW) {
        const int m0 = grp * NTK, b = m0 / L, i0 = m0 - b * L;
        { const int gn = grp + NGW < T / NTK ? grp + NGW : grp; PREP_L_LOAD(nxb, ngr, gn); }
        v4f xc[NTK];
        {
            const v4f cb = *(const v4f*)(conv_b + c4), cw0 = *(const v4f*)(conv_w + c4), cw1 = *(const v4f*)(conv_w + 256 + c4), cw2 = *(const v4f*)(conv_w + 512 + c4), cw3 = *(const v4f*)(conv_w + 768 + c4);
            v4f xb[NTK + 3];
#pragma unroll
            for (int r = 0; r < NTK + 3; ++r) xb[r] = (i0 + r - 3 >= 0) ? BF4R(cxb[r]) : (v4f){0.f, 0.f, 0.f, 0.f};
#pragma unroll
            for (int j = 0; j < NTK; ++j) { xc[j] = cb + cw0 * xb[j] + cw1 * xb[j + 1] + cw2 * xb[j + 2] + cw3 * xb[j + 3]; *(LAS v4f*)(scr + j * 256 + c4) = xc[j]; }
        }
        LDS_WAIT();
        v4f gat[2][NTK];
#pragma unroll
        for (int mat = 0; mat < 2; ++mat) {
#pragma unroll
            for (int j = 0; j < NTK; ++j) gat[mat][j] = (v4f){0.f, 0.f, 0.f, 0.f};
            const LAS unsigned char* Wm = lds + mat * 32768 + (hh * 4096 + d4) * 2;
            v2u wA[4], wB[4]; v4f xA[NTK], xB[NTK];
#define PREP_LQ(W_, X_, k_) do { _Pragma("unroll") for (int kk = 0; kk < 4; ++kk) W_[kk] = *(const LAS v2u*)(Wm + ((k_) + kk) * 128); \
                _Pragma("unroll") for (int j = 0; j < NTK; ++j) X_[j] = *(const LAS v4f*)(scr + j * 256 + hh * 64 + (k_)); } while (0)
#define PREP_FQ(W_, X_) do { _Pragma("unroll") for (int kk = 0; kk < 4; ++kk) { const v4f w4 = (v4f){bflo(W_[kk].x), bfhi(W_[kk].x), bflo(W_[kk].y), bfhi(W_[kk].y)}; \
                _Pragma("unroll") for (int j = 0; j < NTK; ++j) gat[mat][j] += w4 * X_[j][kk]; } } while (0)
            PREP_LQ(wA, xA, 0);
#pragma unroll 1
            for (int i = 0; i < 64; i += 8) {
                PREP_LQ(wB, xB, i + 4);
                PREP_FQ(wA, xA);
                PREP_LQ(wA, xA, (i + 8) & 63);
                PREP_FQ(wB, xB);
            }
#undef PREP_LQ
#undef PREP_FQ
        }
        LDS_WAIT();
        const v4f bav = *(const v4f*)(ba + c4), bxv = *(const v4f*)(bx + c4), lamv = *(const v4f*)(lam + c4);
        v4f spl; spl.x = softplusf_(-lamv.x); spl.y = softplusf_(-lamv.y); spl.z = softplusf_(-lamv.z); spl.w = softplusf_(-lamv.w);
#pragma unroll
        for (int j = 0; j < NTK; ++j) {
            const size_t m = m0 + j; v4f aa, uu, gg; const v4f gr = BF4R(cgr[j]);
#pragma unroll
            for (int e = 0; e < 4; ++e) { const float r = sigmoidf_(gat[0][j][e] + bav[e]), ig = sigmoidf_(gat[1][j][e] + bxv[e]);
                const float la = -8.f * r * spl[e]; aa[e] = __expf(la);
                const float x2 = 2.f * la; const float om = (x2 > -0.1f) ? -(x2 * (1.f + x2 * (0.5f + x2 * (0.16666667f + x2 * 0.041666668f)))) : (1.f - __expf(x2));
                uu[e] = xc[j][e] * ig * __builtin_amdgcn_sqrtf(om);
                const float t = 0.7978845608028654f * (gr[e] + 0.044715f * gr[e] * gr[e] * gr[e]); gg[e] = 0.5f * gr[e] * (1.f + tanh_fast(t)); }
            *(v4f*)(LR_A + m * 256 + c4) = aa; st_bf4(LR_U + m * 256 + c4, uu); st_bf4(LR_G + m * 256 + c4, gg);
        }
#pragma unroll
        for (int r = 0; r < NTK + 3; ++r) cxb[r] = nxb[r];
#pragma unroll
        for (int j = 0; j < NTK; ++j) cgr[j] = ngr[j];
    }
#undef PREP_L_LOAD
    {
        float invf_q[4], invf_i[4];
#pragma unroll
        for (int e = 0; e < 4; ++e) { invf_q[e] = exp2f(-(float)((d4 + e) & 7) * (18.931568569324174f / 8.f)); invf_i[e] = exp2f(-(float)e * (18.931568569324174f / 4.f)); }
        v4f lb = (v4f){0.f, 0.f, 0.f, 0.f};
        if (l == 1) { const v4f x0 = *(const v4f*)(lbs + c4), x1 = *(const v4f*)(lbs + 256 + c4);
            lb.x = 1.f / (1.f + __expf(x0.x - x1.x)); lb.y = 1.f / (1.f + __expf(x0.y - x1.y)); lb.z = 1.f / (1.f + __expf(x0.z - x1.z)); lb.w = 1.f / (1.f + __expf(x0.w - x1.w)); }
#pragma unroll 2
        for (int m = gw; m < T; m += NGW) {
            const int b = m / L, i = m - b * L; const float pos = (float)i;
            const bf16* Pj = PROJ + (size_t)m * NINP;
            v4f q = ld_bf4(Pj + C_DS_Q + c4), k = ld_bf4(Pj + C_DS_K + c4);
            const v4f v = ld_bf4(Pj + C_DS_V + c4);
            v4f qi = ld_bf4(Pj + C_DS_QI + c4), ki = ld_bf4(Pj + C_DS_KI + 4 * (lane & 7));
            const v4f hq = ld_bf4(Pj + C_HG_Q + c4), z = ld_bf4(Pj + C_HG_F + c4), vi = ld_bf4(Pj + C_HG_I + c4), hgt = ld_bf4(Pj + C_HG_G + c4);
#pragma unroll
            for (int e = 0; e < 4; ++e) {
                const float qp = __shfl_xor(q[e], 2), kp = __shfl_xor(k[e], 2), qip = __shfl_xor(qi[e], 1), kip = __shfl_xor(ki[e], 1);
                float sn, cs; sincos_red(pos * invf_q[e], sn, cs);
                if (q_rot) { q[e] = q_hi ? (qp * sn + q[e] * cs) : (q[e] * cs - qp * sn); k[e] = q_hi ? (kp * sn + k[e] * cs) : (k[e] * cs - kp * sn); }
                sincos_red(pos * invf_i[e], sn, cs);
                if (i_rot) { qi[e] = i_hi ? (qip * sn + qi[e] * cs) : (qi[e] * cs - qip * sn); ki[e] = i_hi ? (kip * sn + ki[e] * cs) : (ki[e] * cs - kip * sn); }
            }
            { float kn2 = sum16(k.x * k.x + k.y * k.y + k.z * k.z + k.w * k.w); if ((lane & 15) == 0) __hip_atomic_fetch_max(kmaxl + b * 4 + hh, __float_as_uint(kn2 * 1.02f), __ATOMIC_RELAXED, __HIP_MEMORY_SCOPE_WORKGROUP); }
            st_bf4(DS_Q + (size_t)m * 256 + c4, q * (0.125f * 1.4426950408889634f));      st_bf4(DS_K + (size_t)m * 256 + c4, k); st_bf4(DS_V + (size_t)m * 256 + c4, v); st_bf4(DS_QI + (size_t)m * 256 + c4, qi);
            { float in2 = sum8(ki.x * ki.x + ki.y * ki.y + ki.z * ki.z + ki.w * ki.w); if (lane == 0) __hip_atomic_fetch_max(kimaxl + b, __float_as_uint(in2 * 1.02f), __ATOMIC_RELAXED, __HIP_MEMORY_SCOPE_WORKGROUP); }
            if (lane < 8) { st_bf4(DS_KI + (size_t)m * 32 + 4 * lane, ki); DS_WI[(size_t)m * 8 + lane] = bf2f(Pj[C_DS_WI + lane]) * 0.0625f; }
            v4f qs, f, kq, gs;
#pragma unroll
            for (int e = 0; e < 4; ++e) { const float sg = sigmoidf_(z[e]); qs[e] = hq[e] * sigmoidf_(hq[e]); f[e] = lb[e] + (1.f - lb[e]) * sg; kq[e] = (1.f - lb[e]) * (1.f - sg); gs[e] = hgt[e] * sigmoidf_(hgt[e]); }
            const size_t hm = ((size_t)(b * 4 + hh) * L + i) * 64 + d4;
            *(v4f*)(HG_F + hm) = f; st_bf4(HG_K + hm, kq); st_bf4(HG_Q + hm, qs); st_bf4(HG_V + hm, vi); st_bf4(HG_G + (size_t)m * 256 + c4, gs);
        }
    }
    __syncthreads();
    if (tid < 32) atomicMax((unsigned*)(A.ws + WS_CTL) + 8960 + 64 * l + tid, kmaxl[tid]);
    if (tid < 8) atomicMax((unsigned*)(A.ws + WS_CTL) + 9216 + 64 * l + tid, kimaxl[tid]);
}
constexpr int SC_C = 32;
constexpr size_t WS_YRAW = WS_PROJ;
constexpr size_t WS_ORAW = WS_PROJ + (size_t)T * 1024;
__device__ PHASE_FN void rwkv_scan(const Ctx A, LAS unsigned char* lds, int unit_) {
    const int unit = opaque_s(unit_);
    const int tid = opaque_tid(), row = tid >> 4, kp = tid & 15;
    const int bh = unit >> 1, half = unit & 1, b = bh >> 2, h = bh & 3;
    const size_t base = (size_t)bh * L * 64;
    const float* W = (const float*)(A.ws + WS_RW_W) + base;
    const bf16* Av = (const bf16*)(A.ws + WS_RW_A) + base; const bf16* Bv = (const bf16*)(A.ws + WS_RW_B) + base; const bf16* Kv = (const bf16*)(A.ws + WS_RW_K) + base;
    const bf16* WRv = (const bf16*)(A.ws + WS_RW_WR) + base; const bf16* Vv = (const bf16*)(A.ws + WS_RW_V) + base + half * 32;
    const float* SC = (const float*)(A.ws + WS_RW_SC) + (size_t)bh * L * 4;
    float* YR = (float*)(A.ws + WS_YRAW) + (size_t)b * L * 256 + h * 64 + half * 32;
    constexpr int ARR = SC_C * 64;
    constexpr int BUF = (5 * ARR + SC_C * 32 + SC_C * 4) * 4;
    LAS float* ybuf = (LAS float*)(lds + 2 * BUF);
    float S0 = 0.f, S1 = 0.f, S2 = 0.f, S3 = 0.f;
    v4f rw; v2u ra, rb, rk, rwr, rv; float rsc = 0.f;
    const int e4 = tid * 4;
#define RW_LOAD(c) do { const int t0_ = (c) * SC_C; const bool ok_ = (t0_ + (e4 >> 6)) < L; const size_t o_ = (size_t)t0_ * 64 + e4; \
        rw = ok_ ? *(const v4f*)(W + o_) : (v4f){1.f, 1.f, 1.f, 1.f}; ra = ok_ ? *(const v2u*)(Av + o_) : (v2u){0u, 0u}; rb = ok_ ? *(const v2u*)(Bv + o_) : (v2u){0u, 0u}; \
        rk = ok_ ? *(const v2u*)(Kv + o_) : (v2u){0u, 0u}; rwr = ok_ ? *(const v2u*)(WRv + o_) : (v2u){0u, 0u}; \
        if (tid < SC_C * 8) rv = (t0_ + (tid >> 3)) < L ? *(const v2u*)(Vv + (size_t)(t0_ + (tid >> 3)) * 64 + (tid & 7) * 4) : (v2u){0u, 0u}; \
        if (tid < SC_C * 4) rsc = (t0_ + (tid >> 2)) < L ? SC[(size_t)t0_ * 4 + tid] : 0.f; } while (0)
#define RW_STORE(p) do { LAS float* d_ = (LAS float*)(lds + (p) * BUF); \
        *(LAS v4f*)(d_ + e4) = rw; *(LAS v4f*)(d_ + ARR + e4) = (v4f){bflo(ra.x), bfhi(ra.x), bflo(ra.y), bfhi(ra.y)}; *(LAS v4f*)(d_ + 2 * ARR + e4) = (v4f){bflo(rb.x), bfhi(rb.x), bflo(rb.y), bfhi(rb.y)}; \
        *(LAS v4f*)(d_ + 3 * ARR + e4) = (v4f){bflo(rk.x), bfhi(rk.x), bflo(rk.y), bfhi(rk.y)}; *(LAS v4f*)(d_ + 4 * ARR + e4) = (v4f){bflo(rwr.x), bfhi(rwr.x), bflo(rwr.y), bfhi(rwr.y)}; \
        if (tid < SC_C * 8) *(LAS v4f*)(d_ + 5 * ARR + tid * 4) = (v4f){bflo(rv.x), bfhi(rv.x), bflo(rv.y), bfhi(rv.y)}; if (tid < SC_C * 4) d_[5 * ARR + SC_C * 32 + tid] = rsc; } while (0)
    constexpr int NCH = (L + SC_C - 1) / SC_C;
    RW_LOAD(0); RW_STORE(0); __syncthreads();
#pragma unroll 1
    for (int c = 0; c < NCH; ++c) {
        const int p = c & 1;
        if (c + 1 < NCH) RW_LOAD(c + 1);
        const int ns = (L - c * SC_C) < SC_C ? (L - c * SC_C) : SC_C;
        const LAS float* d = (const LAS float*)(lds + p * BUF);
        const LAS float* q = d + kp * 4; const LAS float* dv = d + 5 * ARR + row; const LAS float* dsc = d + 5 * ARR + SC_C * 32;
        v4f w4 = *(const LAS v4f*)(q), a4 = *(const LAS v4f*)(q + ARR), b4 = *(const LAS v4f*)(q + 2 * ARR), k4 = *(const LAS v4f*)(q + 3 * ARR), r4 = *(const LAS v4f*)(q + 4 * ARR);
        float vv = dv[0]; v2f sc = *(const LAS v2f*)(dsc);
#pragma unroll 2
        for (int s = 0; s < ns; ++s) {
            const int sn = (s + 1 < SC_C) ? s + 1 : s;
            const v4f nw4 = *(const LAS v4f*)(q + sn * 64), na4 = *(const LAS v4f*)(q + ARR + sn * 64), nb4 = *(const LAS v4f*)(q + 2 * ARR + sn * 64);
            const v4f nk4 = *(const LAS v4f*)(q + 3 * ARR + sn * 64), nr4 = *(const LAS v4f*)(q + 4 * ARR + sn * 64);
            const float nvv = dv[sn * 32]; const v2f nsc = *(const LAS v2f*)(dsc + sn * 4);
            float sa = (S0 * a4.x + S1 * a4.y) + (S2 * a4.z + S3 * a4.w), y1 = (S0 * r4.x + S1 * r4.y) + (S2 * r4.z + S3 * r4.w);
            sa = sum16(sa); y1 = sum16(y1);
            S0 = S0 * w4.x + sa * b4.x + vv * k4.x; S1 = S1 * w4.y + sa * b4.y + vv * k4.y; S2 = S2 * w4.z + sa * b4.z + vv * k4.z; S3 = S3 * w4.w + sa * b4.w + vv * k4.w;
            const float yo = y1 + sa * sc.x + vv * sc.y;
            if (kp == 0) ybuf[s * 32 + row] = yo;
            w4 = nw4; a4 = na4; b4 = nb4; k4 = nk4; r4 = nr4; vv = nvv; sc = nsc;
        }
        __syncthreads();
        { const int s = tid >> 4, r2 = (tid & 15) * 2;
          if (s < ns) *(v2f*)(YR + (size_t)(c * SC_C + s) * 256 + r2) = *(const LAS v2f*)(ybuf + s * 32 + r2); }
        if (c + 1 < NCH) RW_STORE(1 - p);
        __syncthreads();
    }
#undef RW_LOAD
#undef RW_STORE
}
__device__ PHASE_FN void hgrn_scan(const Ctx A, LAS unsigned char* lds, int unit_) {
    const int unit = opaque_s(unit_);
    const int tid = opaque_tid(), row = tid >> 4, kp = tid & 15;
    const int bh = unit >> 1, half = unit & 1, b = bh >> 2, h = bh & 3;
    const size_t base = (size_t)bh * L * 64;
    const float* Fv = (const float*)(A.ws + WS_HG_F) + base;
    const bf16* Kv = (const bf16*)(A.ws + WS_HG_K) + base; const bf16* Qv = (const bf16*)(A.ws + WS_HG_Q) + base; const bf16* Vv = (const bf16*)(A.ws + WS_HG_V) + base + half * 32;
    float* OR = (float*)(A.ws + WS_ORAW) + (size_t)b * L * 256 + h * 64 + half * 32;
    constexpr int ARR = SC_C * 64; constexpr int BUF = (3 * ARR + SC_C * 32) * 4;
    LAS float* obuf = (LAS float*)(lds + 2 * BUF);
    float S0 = 0.f, S1 = 0.f, S2 = 0.f, S3 = 0.f;
    v4f rf; v2u rk, rq, rv;
    const int e4 = tid * 4;
#define HG_LOAD(c) do { const int t0_ = (c) * SC_C; const bool ok_ = (t0_ + (e4 >> 6)) < L; const size_t o_ = (size_t)t0_ * 64 + e4; \
        rf = ok_ ? *(const v4f*)(Fv + o_) : (v4f){1.f, 1.f, 1.f, 1.f}; rk = ok_ ? *(const v2u*)(Kv + o_) : (v2u){0u, 0u}; rq = ok_ ? *(const v2u*)(Qv + o_) : (v2u){0u, 0u}; \
        if (tid < SC_C * 8) rv = (t0_ + (tid >> 3)) < L ? *(const v2u*)(Vv + (size_t)(t0_ + (tid >> 3)) * 64 + (tid & 7) * 4) : (v2u){0u, 0u}; } while (0)
#define HG_STORE(p) do { LAS float* d_ = (LAS float*)(lds + (p) * BUF); \
        *(LAS v4f*)(d_ + e4) = rf; *(LAS v4f*)(d_ + ARR + e4) = (v4f){bflo(rk.x), bfhi(rk.x), bflo(rk.y), bfhi(rk.y)}; \
        *(LAS v4f*)(d_ + 2 * ARR + e4) = (v4f){bflo(rq.x), bfhi(rq.x), bflo(rq.y), bfhi(rq.y)}; \
        if (tid < SC_C * 8) *(LAS v4f*)(d_ + 3 * ARR + tid * 4) = (v4f){bflo(rv.x), bfhi(rv.x), bflo(rv.y), bfhi(rv.y)}; } while (0)
    constexpr int NCH = (L + SC_C - 1) / SC_C;
    HG_LOAD(0); HG_STORE(0); __syncthreads();
#pragma unroll 1
    for (int c = 0; c < NCH; ++c) {
        const int p = c & 1;
        if (c + 1 < NCH) HG_LOAD(c + 1);
        const int ns = (L - c * SC_C) < SC_C ? (L - c * SC_C) : SC_C;
        const LAS float* d = (const LAS float*)(lds + p * BUF);
        const LAS float* q = d + kp * 4; const LAS float* dv = d + 3 * ARR + row;
        v4f f4 = *(const LAS v4f*)(q), k4 = *(const LAS v4f*)(q + ARR), q4 = *(const LAS v4f*)(q + 2 * ARR); float vv = dv[0];
#pragma unroll 2
        for (int s = 0; s < ns; ++s) {
            const int sn = (s + 1 < SC_C) ? s + 1 : s;
            const v4f nf4 = *(const LAS v4f*)(q + sn * 64), nk4 = *(const LAS v4f*)(q + ARR + sn * 64), nq4 = *(const LAS v4f*)(q + 2 * ARR + sn * 64);
            const float nvv = dv[sn * 32];
            S0 = S0 * f4.x + k4.x * vv; S1 = S1 * f4.y + k4.y * vv; S2 = S2 * f4.z + k4.z * vv; S3 = S3 * f4.w + k4.w * vv;
            float o = (q4.x * S0 + q4.y * S1) + (q4.z * S2 + q4.w * S3);
            o = sum16(o);
            if (kp == 0) obuf[s * 32 + row] = o;
            f4 = nf4; k4 = nk4; q4 = nq4; vv = nvv;
        }
        __syncthreads();
        { const int s = tid >> 4, r2 = (tid & 15) * 2;
          if (s < ns) *(v2f*)(OR + (size_t)(c * SC_C + s) * 256 + r2) = *(const LAS v2f*)(obuf + s * 32 + r2); }
        if (c + 1 < NCH) HG_STORE(1 - p);
        __syncthreads();
    }
#undef HG_LOAD
#undef HG_STORE
}
__device__ PHASE_FN void mixers_finish(const Ctx A, int l, int vcu, int G) {
    const int tid = opaque_tid(), lane = tid & 63, wave = tid >> 6;
    const int gw = vcu * NWAVES + wave, NGW = G * NWAVES;
    const int c4 = 4 * lane, hh = lane >> 4, d4 = 4 * (lane & 15);
    const float* YR = (const float*)(A.ws + WS_YRAW); const float* OR = (const float*)(A.ws + WS_ORAW);
    const bf16* RV = (const bf16*)(A.ws + WS_RW_V); const float* SC = (const float*)(A.ws + WS_RW_SC); const bf16* RG = (const bf16*)(A.ws + WS_RW_G); const bf16* HGt = (const bf16*)(A.ws + WS_HG_G);
    bf16* MIX = (bf16*)(A.ws + WS_MIX);
    const v4f lg = *(const v4f*)(gin(A, 14) + l * 256 + c4), lb = *(const v4f*)(gin(A, 15) + l * 256 + c4), ng = *(const v4f*)(gin(A, 24) + l * 256 + c4);
#pragma unroll 4
    for (int m = gw; m < T; m += NGW) {
        const int b = m / L, i = m - b * L; const size_t hm = ((size_t)(b * 4 + hh) * L + i);
        const v4f y = *(const v4f*)(YR + (size_t)m * 256 + c4), o = *(const v4f*)(OR + (size_t)m * 256 + c4);
        const v4f vv = ld_bf4(RV + hm * 64 + d4), g = ld_bf4(RG + (size_t)m * 256 + c4), hg = ld_bf4(HGt + (size_t)m * 256 + c4);
        const float bonus = SC[hm * 4 + 2];
        const float mean = sum16((y.x + y.y) + (y.z + y.w)) * (1.f / 64.f); const v4f dy = y - mean;
        const float var = sum16((dy.x * dy.x + dy.y * dy.y) + (dy.z * dy.z + dy.w * dy.w)) * (1.f / 64.f);
        const v4f yn = (dy * rsqrtf(var + 64e-5f) * lg + lb + vv * bonus) * g;
        st_bf4(MIX + (size_t)m * 1024 + c4, yn);
        const float ms = sum16((o.x * o.x + o.y * o.y) + (o.z * o.z + o.w * o.w)) * (1.f / 64.f);
        st_bf4(MIX + (size_t)m * 1024 + 768 + c4, o * rsqrtf(ms + 1e-5f) * ng * hg);
    }
}
constexpr int LR_SEG = 64, LR_NSEG = (L + LR_SEG - 1) / LR_SEG;
constexpr size_t WS_LR_AGG = 2032 * MiB;
constexpr size_t WS_LR_CARRY = WS_LR_AGG + 3 * MiB;
static_assert(WS_LR_CARRY + (size_t)NB * LR_NSEG * 256 * 4 <= WS_END, "lru aggregates");
__device__ PHASE_FN void lru_agg_phase(const Ctx A, int vcu, int G) {
    const int tid = opaque_tid(), lane = tid & 63, wave = tid >> 6;
    const int gw = vcu * NWAVES + wave, NGW = G * NWAVES;
    const float* LA = (const float*)(A.ws + WS_LR_A); const bf16* LU = (const bf16*)(A.ws + WS_LR_U); v2f* AGG = (v2f*)(A.ws + WS_LR_AGG);
#pragma unroll 1
    for (int it = gw; it < NB * LR_NSEG * 4; it += NGW) {
        const int cg = it & 3, q = it >> 2; const bool tail_ = q >= NB * (LR_NSEG - 1);
        const int b = tail_ ? q - NB * (LR_NSEG - 1) : q / (LR_NSEG - 1), sg = tail_ ? LR_NSEG - 1 : q - b * (LR_NSEG - 1), ch = cg * 64 + lane;
        const int t0 = sg * LR_SEG, ns = (L - t0) < LR_SEG ? (L - t0) : LR_SEG;
        const size_t m0 = (size_t)b * L + t0;
        float Ap = 1.f, Hl = 0.f;
#pragma unroll 1
        for (int i = 0; i < ns; i += 16) {
            float a[16], u[16];
#pragma unroll
            for (int j = 0; j < 16; ++j) { a[j] = LA[(m0 + i + j) * 256 + ch]; u[j] = bf2f(LU[(m0 + i + j) * 256 + ch]); }
#pragma unroll
            for (int j = 0; j < 16; ++j) { Hl = a[j] * Hl + u[j]; Ap *= a[j]; }
        }
        AGG[((size_t)b * LR_NSEG + sg) * 256 + ch] = (v2f){Ap, Hl};
    }
}
__device__ PHASE_FN void lru_carry_phase(const Ctx A, int first) {
    const int tid = opaque_tid(), lane = tid & 63, wave = tid >> 6;
    const int w = (opaque_s((int)blockIdx.x) - first) * NWAVES + wave;
    const int b = w >> 2, ch = (w & 3) * 64 + lane;
    const v2f* ag = (const v2f*)(A.ws + WS_LR_AGG) + (size_t)b * LR_NSEG * 256 + ch;
    float* CR = (float*)(A.ws + WS_LR_CARRY) + (size_t)b * LR_NSEG * 256 + ch;
    float hc = 0.f;
#pragma unroll 1
    for (int s0 = 0; s0 < LR_NSEG; s0 += 16) {
        v2f x[16];
#pragma unroll
        for (int j = 0; j < 16; ++j) { const int s = s0 + j < LR_NSEG ? s0 + j : LR_NSEG - 1; x[j] = ag[(size_t)s * 256]; }
#pragma unroll
        for (int j = 0; j < 16; ++j) if (s0 + j < LR_NSEG) { CR[(size_t)(s0 + j) * 256] = hc; hc = x[j].x * hc + x[j].y; }
    }
}
__device__ PHASE_FN void lru_out_phase(const Ctx A, int vcu, int G) {
    const int tid = opaque_tid(), lane = tid & 63, wave = tid >> 6;
    const int gw = vcu * NWAVES + wave, NGW = G * NWAVES;
    const float* LA = (const float*)(A.ws + WS_LR_A); const bf16* LU = (const bf16*)(A.ws + WS_LR_U); const bf16* LG = (const bf16*)(A.ws + WS_LR_G);
    const float* CR = (const float*)(A.ws + WS_LR_CARRY); bf16* MIX = (bf16*)(A.ws + WS_MIX);
#pragma unroll 1
    for (int it = gw; it < NB * LR_NSEG * 4; it += NGW) {
        const int cg = it & 3, q = it >> 2; const bool tail_ = q >= NB * (LR_NSEG - 1);
        const int b = tail_ ? q - NB * (LR_NSEG - 1) : q / (LR_NSEG - 1), sg = tail_ ? LR_NSEG - 1 : q - b * (LR_NSEG - 1), ch = cg * 64 + lane;
        const int t0 = sg * LR_SEG, ns = (L - t0) < LR_SEG ? (L - t0) : LR_SEG;
        const size_t m0 = (size_t)b * L + t0;
        float hc = CR[((size_t)b * LR_NSEG + sg) * 256 + ch];
#pragma unroll 1
        for (int i = 0; i < ns; i += 16) {
            float a[16], u[16], g[16];
#pragma unroll
            for (int j = 0; j < 16; ++j) { a[j] = LA[(m0 + i + j) * 256 + ch]; u[j] = bf2f(LU[(m0 + i + j) * 256 + ch]); g[j] = bf2f(LG[(m0 + i + j) * 256 + ch]); }
#pragma unroll
            for (int j = 0; j < 16; ++j) { hc = a[j] * hc + u[j]; MIX[(m0 + i + j) * 1024 + 512 + ch] = f2bf(hc * g[j]); }
        }
    }
}
static_assert(L % 16 == 0, "lru step groups");
constexpr int DSA_WBYTES = 34944;
constexpr int DSA_NW = 4;
__device__ __forceinline__ unsigned fkey(float f) { const unsigned u = __float_as_uint(f); return (u & 0x80000000u) ? ~u : (u | 0x80000000u); }
__device__ __forceinline__ void dsa_query(const Ctx A, LAS unsigned char* wl, int b, int i, int lane) {
    const bf16* DQ = (const bf16*)(A.ws + WS_DS_Q); const bf16* DK = (const bf16*)(A.ws + WS_DS_K); const bf16* DV = (const bf16*)(A.ws + WS_DS_V);
    const bf16* DQI = (const bf16*)(A.ws + WS_DS_QI); const bf16* DKI = (const bf16*)(A.ws + WS_DS_KI); const float* DWI = (const float*)(A.ws + WS_DS_WI);
    bf16* MIX = (bf16*)(A.ws + WS_HB);
    LAS unsigned* keys = (LAS unsigned*)wl; LAS float* qv = (LAS float*)(wl + 32896); LAS int* sel = (LAS int*)(wl + 32896 + 1024);
    const size_t m = (size_t)b * L + i, mb = (size_t)b * L;
    const int n = i + 1;
    LAS float* wil = (LAS float*)(wl + 32832);
    { const v4f q4 = ld_bf4(DQI + m * 256 + 4 * lane); *(LAS v4f*)(qv + 4 * lane) = q4; if (lane < 8) wil[lane] = DWI[m * 8 + lane]; }
    LDS_WAIT();
    for (int s = lane; s < n; s += 64) {
        const v4u* kp = (const v4u*)(DKI + (mb + s) * 32);
        float kf[32];
#pragma unroll
        for (int c = 0; c < 4; ++c) { const v4u x = kp[c]; kf[8 * c + 0] = bflo(x.x); kf[8 * c + 1] = bfhi(x.x); kf[8 * c + 2] = bflo(x.y); kf[8 * c + 3] = bfhi(x.y); kf[8 * c + 4] = bflo(x.z); kf[8 * c + 5] = bfhi(x.z); kf[8 * c + 6] = bflo(x.w); kf[8 * c + 7] = bfhi(x.w); }
        float sc = 0.f;
#pragma unroll 1
        for (int hx = 0; hx < 8; ++hx) { float dt = 0.f;
#pragma unroll
            for (int c = 0; c < 8; ++c) { const v4f q4 = *(const LAS v4f*)(qv + hx * 32 + 4 * c); dt += q4.x * kf[4 * c] + q4.y * kf[4 * c + 1] + q4.z * kf[4 * c + 2] + q4.w * kf[4 * c + 3]; }
            sc += wil[hx] * fmaxf(dt, 0.f); }
        keys[s] = fkey(sc);
    }
    LDS_WAIT();
    unsigned thr = 0u; int need = 0;
    if (n > 256) {
        unsigned prefix = 0u; need = 256;
#pragma unroll 1
        for (int shift = 28; shift >= 0; shift -= 4) {
            unsigned long long lo = 0ull, hi = 0ull;
            const unsigned himask = (shift == 28) ? 0u : (0xFFFFFFFFu << (shift + 4));
            for (int s = lane; s < n; s += 64) { const unsigned k = keys[s];
                if ((k & himask) == prefix) { const unsigned dg = (k >> shift) & 15u; const unsigned long long inc = 1ull << ((dg & 7u) * 8u); if (dg < 8u) lo += inc; else hi += inc; } }
            int cum = 0; unsigned dsel = 0u; int below = 0; bool found = false;
#pragma unroll
            for (int dg = 15; dg >= 0; --dg) {
                const unsigned mine = (unsigned)(((dg < 8 ? lo : hi) >> ((dg & 7) * 8)) & 0xFFull);
                int tot = (int)mine;
#pragma unroll
                for (int o = 1; o < 64; o <<= 1) tot += __shfl_xor(tot, o);
                if (!found && cum + tot >= need) { found = true; dsel = (unsigned)dg; below = cum; }
                cum += tot;
            }
            prefix |= dsel << shift; need -= below;
        }
        thr = prefix;
    }
    int cnt = 0;
    if (n <= 256) { for (int s = lane; s < n; s += 64) sel[s] = s; cnt = n; }
    else {
        int eq_taken = 0;
        for (int s0 = 0; s0 < n; s0 += 64) { const int s = s0 + lane; const unsigned k = (s < n) ? keys[s] : 0u; const bool in = s < n;
            const bool gt = in && (k > thr), eq = in && (k == thr);
            const unsigned long long meq = __ballot(eq); const int eq_before = __popcll(meq & ((1ull << lane) - 1ull));
            const bool take = gt || (eq && (eq_taken + eq_before) < need);
            const unsigned long long mt = __ballot(take); const int pos = cnt + __popcll(mt & ((1ull << lane) - 1ull));
            if (take && pos < 256) sel[pos] = s;
            cnt += __popcll(mt); eq_taken += __popcll(meq);
        }
        if (cnt > 256) cnt = 256;
    }
    LDS_WAIT();
    LAS float* pbuf = (LAS float*)wl;
    for (int h = 0; h < 4; ++h) {
        { const float qx = bf2f(DQ[m * 256 + h * 64 + lane]); qv[lane] = qx * 0.125f; }
        LDS_WAIT();
        float sj[4]; float mx = -3.0e38f;
#pragma unroll
        for (int r = 0; r < 4; ++r) { const int j = lane + 64 * r; sj[r] = -3.0e38f;
            if (j < cnt) { const int s = sel[j]; const v4u* kp = (const v4u*)(DK + (mb + s) * 256 + h * 64); float dt = 0.f;
#pragma unroll
                for (int c = 0; c < 8; ++c) { const v4u x = kp[c]; const v4f q0 = *(const LAS v4f*)(qv + 8 * c), q1 = *(const LAS v4f*)(qv + 8 * c + 4);
                    dt += q0.x * bflo(x.x) + q0.y * bfhi(x.x) + q0.z * bflo(x.y) + q0.w * bfhi(x.y) + q1.x * bflo(x.z) + q1.y * bfhi(x.z) + q1.z * bflo(x.w) + q1.w * bfhi(x.w); }
                sj[r] = dt; mx = fmaxf(mx, dt); } }
        mx = wave_max(mx);
        float sum = 0.f;
#pragma unroll
        for (int r = 0; r < 4; ++r) { const int j = lane + 64 * r; const float p = (j < cnt) ? __expf(sj[r] - mx) : 0.f; sum += p; pbuf[j] = p; }
        sum = wave_sum(sum);
        LDS_WAIT();
        float o = 0.f;
        for (int j = 0; j < cnt; ++j) { const int s = sel[j]; o += pbuf[j] * bf2f(DV[(mb + s) * 256 + h * 64 + lane]); }
        MIX[m * 1024 + 256 + h * 64 + lane] = f2bf(o / sum);
        LDS_WAIT();
    }
}
__device__ PHASE_FN void dsa_phase(const Ctx A, LAS unsigned char* lds, int l) {
    const int tid = opaque_tid(), lane = tid & 63, wave = tid >> 6;
    if (wave >= DSA_NW) return;
    unsigned* qhead = (unsigned*)(A.ws + WS_CTL) + CW_DSAQ + 64 * l;
    LAS unsigned char* wl = lds + wave * DSA_WBYTES;
    for (;;) {
        unsigned it = 0u;
        if (lane == 0) it = atomicAdd(qhead, 1u);
        it = __builtin_amdgcn_readfirstlane(it);
        if (it >= (unsigned)T) break;
        const int i = L - 1 - (int)(it >> 3), b = (int)(it & 7u);
        dsa_query(A, wl, b, i, lane);
    }
}
static_assert(DSA_NW * DSA_WBYTES <= MISC_OFF, "dsa lds");
typedef short s8 __attribute__((ext_vector_type(8)));
typedef short v4i16_t __attribute__((ext_vector_type(4)));
typedef unsigned u16v __attribute__((ext_vector_type(16)));
typedef unsigned long long u64;
constexpr int NQT16 = L / 16;
constexpr int NKB32 = (L + 31) / 32;
constexpr int MASK_PB = 66112;
constexpr size_t MASK_LAYER = (size_t)NB * MASK_PB * 64;
constexpr size_t WS_MASK = 1956 * MiB;
static_assert(WS_MASK >= WS_MIX_END && WS_MASK + 2 * MASK_LAYER + 256 <= 2032 * MiB, "mask region");
__device__ __forceinline__ size_t mask_row(int l, int b, int qt) { const int a = qt >> 1; return (size_t)l * (NB * MASK_PB) + (size_t)b * MASK_PB + ((qt & 1) ? (a + 1) * (a + 1) : a * (a + 1)); }
constexpr int CW_KMAX = 8960;
constexpr int CW_KIMAX = 9216;
constexpr int MI_KMAX = 640, MI_UNIT = 768, MI_KIMAX = 832;
constexpr int SEL_PF = 3;
constexpr int SEL_HROW = 259;

__device__ __forceinline__ void sel_scores(const s8 a1, const s8 a2, const s8 (&qb)[9], const float (&wv)[8], pg8::f32x4& i1, pg8::f32x4& i2) {
    const pg8::f32x4 z = (pg8::f32x4){0.f, 0.f, 0.f, 0.f};
    i1 = __builtin_amdgcn_mfma_f32_16x16x32_bf16(a1, qb[8], z, 0, 0, 0); i2 = __builtin_amdgcn_mfma_f32_16x16x32_bf16(a2, qb[8], z, 0, 0, 0);
#pragma unroll
    for (int h = 0; h < 8; ++h) {
        const pg8::f32x4 c1 = __builtin_amdgcn_mfma_f32_16x16x32_bf16(a1, qb[h], z, 0, 0, 0), c2 = __builtin_amdgcn_mfma_f32_16x16x32_bf16(a2, qb[h], z, 0, 0, 0);
#pragma unroll
        for (int j = 0; j < 4; ++j) { float t1 = fmaf(fabsf(c1[j]), wv[h], i1[j]), t2 = fmaf(fabsf(c2[j]), wv[h], i2[j]);
            asm("" : "+v"(t1)); asm("" : "+v"(t2)); i1[j] = t1; i2[j] = t2; }
    }
}
template <int MODE, bool DIAG>
__device__ __forceinline__ void sel_block(const s8 a1, const s8 a2, const s8 (&qb)[9], const float (&wv)[8], int kb, int tq, int r, int g, int lane,
                                          LAS unsigned* hrow, float sc_mul, float sc_add, u64* mrow) {
    pg8::f32x4 i1, i2; sel_scores(a1, a2, qb, wv, i1, i2);
    const int s0 = kb * 32 + 8 * g;
    u64 wds[8];
#pragma unroll
    for (int j = 0; j < 8; ++j) {
        const float sc = j < 4 ? i1[j & 3] : i2[j & 3];
        if (MODE == 3) { if (sc == 123456.789f) hrow[256] = 1u; }
        else if (MODE == 2) { wds[j] = DIAG ? __ballot((s0 + j) <= tq && sc >= sc_add) : __ballot(sc >= sc_add); }
        else { int xi = (int)__builtin_floorf(fmaf(sc, sc_mul, sc_add));
            unsigned bin = MODE == 0 ? (unsigned)min(max(xi, 0), 255) : (unsigned)(min(max(xi, -1), 256) + 1);
            if (DIAG) bin = ((s0 + j) <= tq) ? bin : (MODE == 0 ? 256u : 0u);
            if (MODE == 0 || bin != 0u) __hip_atomic_fetch_add(hrow + bin, 1u, __ATOMIC_RELAXED, __HIP_MEMORY_SCOPE_WORKGROUP); }
    }
    if (MODE == 2 && lane == 0) { u64* d = mrow + (size_t)kb * 8;
#pragma unroll
        for (int j = 0; j < 8; j += 2) { v4u o; o.x = (unsigned)wds[j]; o.y = (unsigned)(wds[j] >> 32); o.z = (unsigned)wds[j + 1]; o.w = (unsigned)(wds[j + 1] >> 32); *(v4u*)(d + j) = o; } }
}
template <int MODE>
__device__ __forceinline__ void sel_pass(const bf16* KIb, const s8 (&qb)[9], const float (&wv)[8], int nkb, int tq, int r, int g, int lane,
                                         LAS unsigned* hrow, float sc_mul, float sc_add, u64* mrow, int kb_first = 0, int kb_step = 1) {
    const bf16* kp = KIb + (size_t)(8 * (r >> 2) + (r & 3)) * 32 + 8 * g;
    v4u cur[2 * SEL_PF], nxt[2 * SEL_PF];
#pragma unroll
    for (int i = 0; i < SEL_PF; ++i) { const size_t kb = kb_first + i * kb_step; cur[2 * i] = *(const v4u*)(kp + kb * 1024); cur[2 * i + 1] = *(const v4u*)(kp + kb * 1024 + 128); }
#pragma unroll 1
    for (int kb0 = kb_first; kb0 < nkb; kb0 += SEL_PF * kb_step) {
#pragma unroll
        for (int i = 0; i < SEL_PF; ++i) { const size_t kb = kb0 + (SEL_PF + i) * kb_step; nxt[2 * i] = *(const v4u*)(kp + kb * 1024); nxt[2 * i + 1] = *(const v4u*)(kp + kb * 1024 + 128); }
#pragma unroll
        for (int i = 0; i < SEL_PF; ++i) { const int kb = kb0 + i * kb_step;
            if (kb < nkb - 1) sel_block<MODE, false>(__builtin_bit_cast(s8, cur[2 * i]), __builtin_bit_cast(s8, cur[2 * i + 1]), qb, wv, kb, tq, r, g, lane, hrow, sc_mul, sc_add, mrow);
            else if (kb == nkb - 1) sel_block<MODE, true>(__builtin_bit_cast(s8, cur[2 * i]), __builtin_bit_cast(s8, cur[2 * i + 1]), qb, wv, kb, tq, r, g, lane, hrow, sc_mul, sc_add, mrow); }
#pragma unroll
        for (int i = 0; i < 2 * SEL_PF; ++i) cur[i] = nxt[i];
    }
}
__device__ __forceinline__ void sel_scan(const LAS unsigned* hrow, int need, int& sel, int& above) {
    int cum = 0; sel = 0; above = 0; bool found = false;
#pragma unroll 8
    for (int bin = 255; bin >= 0; --bin) { const int c = (int)hrow[bin];
        if (!found && cum + c >= need) { found = true; sel = bin; above = cum; }
        cum += c; }
}
__device__ PHASE_FN void dsa_select_phase(const Ctx A, LAS unsigned char* lds, int l) {
    const int tid = opaque_tid(), lane = tid & 63, wave = tid >> 6, r = lane & 15, g = lane >> 4;
    const bf16* DQI = (const bf16*)(A.ws + WS_DS_QI); const bf16* DKI = (const bf16*)(A.ws + WS_DS_KI); const float* DWI = (const float*)(A.ws + WS_DS_WI);
    u64* MASK = (u64*)(A.ws + WS_MASK);
    unsigned* qhead = (unsigned*)(A.ws + WS_CTL) + CW_DSAQ + 64 * l;
    const unsigned* kimaxw = (const unsigned*)(A.ws + WS_CTL) + CW_KIMAX + 64 * l;
    LAS unsigned* hist = (LAS unsigned*)(lds + wave * (16 * SEL_HROW * 4));
    LAS unsigned* hrow = hist + r * SEL_HROW;
    for (;;) {
        unsigned it = 0u;
        if (lane == 0) it = atomicAdd(qhead, 1u);
        it = __builtin_amdgcn_readfirstlane(it);
        if (it >= (unsigned)(NB * NQT16)) break;
        const int qt = NQT16 - 1 - (int)(it >> 3), b = (int)(it & 7u);
        const size_t mb = (size_t)b * L, m0 = mb + (size_t)qt * 16;
        const int tq = qt * 16 + r, nkb = ((qt * 16 + 15) >> 5) + 1;
        s8 qb[9]; float wv[8];
#pragma unroll
        for (int h = 0; h < 8; ++h) qb[h] = *(const s8*)(DQI + (m0 + r) * 256 + h * 32 + 8 * g);
        { const v4f w0 = *(const v4f*)(DWI + (m0 + r) * 8), w1 = *(const v4f*)(DWI + (m0 + r) * 8 + 4);
          wv[0] = w0.x; wv[1] = w0.y; wv[2] = w0.z; wv[3] = w0.w; wv[4] = w1.x; wv[5] = w1.y; wv[6] = w1.z; wv[7] = w1.w; }
        float bq = 0.f;
        { float ql[8];
#pragma unroll
          for (int e = 0; e < 8; ++e) ql[e] = 0.f;
#pragma unroll
          for (int h = 0; h < 8; ++h) { float n2 = 0.f;
#pragma unroll
              for (int e = 0; e < 8; ++e) { const float x = bf2f((unsigned short)qb[h][e]); ql[e] += wv[h] * x; n2 += x * x; }
              n2 += __shfl_xor(n2, 16); n2 += __shfl_xor(n2, 32); bq += fabsf(wv[h]) * sqrtf(n2); }
          v4u pk; pk.x = pk2(ql[0], ql[1]); pk.y = pk2(ql[2], ql[3]); pk.z = pk2(ql[4], ql[5]); pk.w = pk2(ql[6], ql[7]); qb[8] = __builtin_bit_cast(s8, pk); }
        const bf16* KIb = DKI + mb * 32;
        float thr_f = -__builtin_inff();
        if (qt * 16 + 15 >= 256) {
            const float kim = sqrtf(__uint_as_float(__hip_atomic_load(kimaxw + b, __ATOMIC_RELAXED, __HIP_MEMORY_SCOPE_AGENT)));
            const float R = fmaxf(2.06f * bq * kim, 1e-30f), s0 = 128.f / R, w0 = R * (1.f / 128.f);
            const int n = tq + 1;
            bool done = false;
            if (qt * 16 >= 2048) {
                for (int i = lane; i < 16 * SEL_HROW; i += 64) hist[i] = 0u;
                LDS_WAIT();
                sel_pass<0>(KIb, qb, wv, nkb - 1, tq, r, g, lane, hrow, s0, 128.f, nullptr, 3, 8);
                LDS_WAIT();
                const int ns = 32 * ((nkb - 1 - 3 + 7) >> 3);
                const float rho = 256.f * (float)ns / (float)n, dev = 4.f * sqrtf(rho) + 2.f;
                int bl, ab; sel_scan(hrow, (int)(rho + dev) + 1, bl, ab);
                int bh = 255, ab2 = 0; const int rhi = (int)(rho - dev);
                if (rhi >= 1) sel_scan(hrow, rhi, bh, ab2);
                LDS_WAIT();
                const float lo = -R + (float)bl * w0, hi = (rhi >= 1) ? (-R + (float)(bh + 1) * w0) : (R * 1.001f);
                const float s1 = 256.f / (hi - lo);
                for (int i = lane; i < 16 * SEL_HROW; i += 64) hist[i] = 0u;
                LDS_WAIT();
                sel_pass<1>(KIb, qb, wv, nkb, tq, r, g, lane, hrow, s1, -lo * s1, nullptr);
                LDS_WAIT();
                const int above = (int)hrow[257]; int inr = 0;
#pragma unroll 8
                for (int bin = 1; bin <= 256; ++bin) inr += (int)hrow[bin];
                const bool ok = above < 256 && above + inr >= 256;
                if (ok) { int sel1, ab1; sel_scan(hrow + 1, 256 - above, sel1, ab1); thr_f = lo + (float)sel1 * ((hi - lo) * (1.f / 256.f)); }
                LDS_WAIT();
                done = __all(ok);
            }
            if (!done) {
                for (int i = lane; i < 16 * SEL_HROW; i += 64) hist[i] = 0u;
                LDS_WAIT();
                sel_pass<0>(KIb, qb, wv, nkb, tq, r, g, lane, hrow, s0, 128.f, nullptr);
                LDS_WAIT();
                int sel0, above0; sel_scan(hrow, 256, sel0, above0);
                LDS_WAIT();
                const float lo0 = -R + (float)sel0 * w0, s1 = 256.f / w0;
                for (int i = lane; i < 16 * SEL_HROW; i += 64) hist[i] = 0u;
                LDS_WAIT();
                sel_pass<1>(KIb, qb, wv, nkb, tq, r, g, lane, hrow, s1, -lo0 * s1, nullptr);
                LDS_WAIT();
                int sel1, above1; sel_scan(hrow + 1, 256 - above0, sel1, above1);
                LDS_WAIT();
                thr_f = lo0 + (float)sel1 * (w0 * (1.f / 256.f));
            }
            if (n <= 256) thr_f = -__builtin_inff();
        }
        sel_pass<2>(KIb, qb, wv, nkb, tq, r, g, lane, hrow, 0.f, thr_f, MASK + mask_row(l, b, qt) * 8);
    }
}

constexpr int AT_ROW = 144;
constexpr int AT_TILE = 64 * AT_ROW;
constexpr int AT_NQT = (L - 16) / 256;
constexpr int AT_NKT = (L + 63) / 64;
static_assert(16 + AT_NQT * 256 == L, "query tiling");
__device__ PHASE_FN void dsa_attn_phase(const Ctx A, LAS unsigned char* lds, int l) {
    const int tid = opaque_tid(), lane = tid & 63, wave = tid >> 6, r = lane & 15, g = lane >> 4;
    const bf16* DQ = (const bf16*)(A.ws + WS_DS_Q); const bf16* DK = (const bf16*)(A.ws + WS_DS_K); const bf16* DV = (const bf16*)(A.ws + WS_DS_V);
    const u64* MASK = (const u64*)(A.ws + WS_MASK); bf16* MIX = (bf16*)(A.ws + WS_MIX);
    unsigned* qhead = (unsigned*)(A.ws + WS_CTL) + CW_DSAQ + 64 * l + 16;
    const unsigned* kmaxw = (const unsigned*)(A.ws + WS_CTL) + CW_KMAX + 64 * l;
    LAS unsigned* unitw = (LAS unsigned*)(lds + MISC_OFF + MI_UNIT);
    const int ldkey = tid >> 3, ldch = tid & 7;
    for (;;) {
        __syncthreads();
        if (tid == 0) unitw[0] = atomicAdd(qhead, 1u);
        __syncthreads();
        const unsigned u = unitw[0];
        if (u >= (unsigned)(NB * 4 * (AT_NQT + 1))) break;
        const bool mini = u >= (unsigned)(NB * 4 * AT_NQT);
        const int qt = mini ? 0 : AT_NQT - 1 - (int)(u >> 5), b = (int)((u & 31u) >> 2), h = (int)(u & 3u);
        const size_t mb = (size_t)b * L;
        const int kmain = mini ? 0 : 4 * qt;
        const int nkt = mini ? 1 : ((4 * qt + 5 < AT_NKT) ? 4 * qt + 5 : AT_NKT);
        const float kmax2 = __uint_as_float(__hip_atomic_load(kmaxw + b * 4 + h, __ATOMIC_RELAXED, __HIP_MEMORY_SCOPE_AGENT));
        int tq[2], lb[2]; bool act[2];
        s8 qf[2][2]; float nc2[2];
        const GAS unsigned* mrow[2];
#pragma unroll
        for (int qi = 0; qi < 2; ++qi) { act[qi] = mini ? (wave == 0 && qi == 0) : true; tq[qi] = mini ? 0 : 16 + qt * 256 + wave * 32 + 16 * qi;
            lb[qi] = __builtin_amdgcn_readfirstlane(act[qi] ? ((tq[qi] + 15) >> 5) : -1);
            float qn2 = 0.f;
#pragma unroll
            for (int ks = 0; ks < 2; ++ks) { qf[qi][ks] = act[qi] ? *(const s8*)(DQ + (mb + tq[qi] + r) * 256 + h * 64 + 32 * ks + 8 * g) : (s8){0, 0, 0, 0, 0, 0, 0, 0};
#pragma unroll
                for (int e = 0; e < 8; ++e) { const float x = bf2f((unsigned short)qf[qi][ks][e]); qn2 += x * x; } }
            qn2 += __shfl_xor(qn2, 16); qn2 += __shfl_xor(qn2, 32);
            nc2[qi] = -sqrtf(qn2 * kmax2);
            const u64 mrow_u = (u64)(MASK + mask_row(l, b, tq[qi] >> 4) * 8);
            const unsigned lo = (unsigned)__builtin_amdgcn_readfirstlane((unsigned)mrow_u), hi = (unsigned)__builtin_amdgcn_readfirstlane((unsigned)(mrow_u >> 32));
            mrow[qi] = (const GAS unsigned*)(((u64)hi << 32) | (u64)lo); }
        pg8::f32x4 O[2][4], Ls[2];
#pragma unroll
        for (int qi = 0; qi < 2; ++qi) { Ls[qi] = (pg8::f32x4){0.f, 0.f, 0.f, 0.f};
#pragma unroll
            for (int db = 0; db < 4; ++db) O[qi][db] = (pg8::f32x4){0.f, 0.f, 0.f, 0.f}; }
        const s8 ones8 = (s8){0x3F80, 0x3F80, 0x3F80, 0x3F80, 0x3F80, 0x3F80, 0x3F80, 0x3F80};
#define AT_SLOAD(dst, qi_, kb_) asm volatile("s_load_dwordx16 %0, %1, 0x0" : "=s"(dst) : "s"(mrow[qi_] + (size_t)(kb_) * 16))
#define AT_MWAIT(m0_, m1_) asm volatile("s_waitcnt lgkmcnt(0)" : "+s"(m0_), "+s"(m1_))
#define AT_MWAIT_S2(a0_, a1_, b0_, b1_) asm volatile("s_waitcnt lgkmcnt(0)" : "+s"(a0_), "+s"(a1_), "+s"(b0_), "+s"(b1_), "+v"(Sa), "+v"(Sb), "+v"(Sc), "+v"(Sd), "+v"(Se), "+v"(Sf), "+v"(Sg), "+v"(Sh) :: "memory")
#define AT_MWAIT_O(a0_, a1_, b0_, b1_) asm volatile("s_waitcnt lgkmcnt(0)" : "+s"(a0_), "+s"(a1_), "+s"(b0_), "+s"(b1_), "+v"(O[1][0]), "+v"(O[1][1]), "+v"(O[1][2]), "+v"(O[1][3]), "+v"(Ls[1]) :: "memory")
        const bf16* kg = DK + (mb + ldkey) * 256 + h * 64 + ldch * 8; const bf16* vg = DV + (mb + ldkey) * 256 + h * 64 + ldch * 8;
        v4u rk0 = *(const v4u*)kg, rv0 = *(const v4u*)vg;
        const size_t to1 = (size_t)(nkt > 1 ? 1 : nkt - 1) * 64 * 256, to2 = (size_t)(nkt > 2 ? 2 : nkt - 1) * 64 * 256, to3 = (size_t)(nkt > 3 ? 3 : nkt - 1) * 64 * 256;
        v4u rk1 = *(const v4u*)(kg + to1), rv1 = *(const v4u*)(vg + to1), rk2 = *(const v4u*)(kg + to2), rv2 = *(const v4u*)(vg + to2), rk3 = *(const v4u*)(kg + to3), rv3 = *(const v4u*)(vg + to3);
        u16v m0, m1, n0, n1;
#define AT_STORE(boff, rk, rv) do { LAS unsigned char* kb_ = lds + (boff); LAS unsigned char* vb_ = kb_ + AT_TILE; \
            *(LAS v4u*)(kb_ + ldkey * AT_ROW + ldch * 16) = rk; *(LAS v4u*)(vb_ + ldkey * AT_ROW + ldch * 16) = rv; } while (0)
#define AT_LOAD(kt_, rk, rv) do { rk = *(const v4u*)(kg + (size_t)(kt_) * 64 * 256); rv = *(const v4u*)(vg + (size_t)(kt_) * 64 * 256); } while (0)
#define AT_KREAD(boff, blk) do { const LAS unsigned char* ka = lds + (boff) + ((blk) * 32 + 8 * (r >> 2) + (r & 3)) * AT_ROW + g * 16; \
            _Pragma("unroll") for (int ks = 0; ks < 2; ++ks) { kf[blk][ks][0] = *(const LAS s8*)(ka + ks * 64); kf[blk][ks][1] = *(const LAS s8*)(ka + 4 * AT_ROW + ks * 64); } } while (0)
#define AT_VREAD(boff, blk) do { const LAS unsigned char* va = lds + (boff) + AT_TILE + ((blk) * 32 + 8 * g + (r >> 2)) * AT_ROW + (r & 3) * 8; \
            _Pragma("unroll") for (int db = 0; db < 4; ++db) { \
                const v4i16_t x0 = __builtin_amdgcn_ds_read_tr16_b64_v4i16((LAS v4i16_t*)(va + db * 32)), x1 = __builtin_amdgcn_ds_read_tr16_b64_v4i16((LAS v4i16_t*)(va + 4 * AT_ROW + db * 32)); \
                vf[blk][db] = (s8){x0[0], x0[1], x0[2], x0[3], x1[0], x1[1], x1[2], x1[3]}; } } while (0)
#define AT_BLK_S(blk, qi, S1, S2) do { S1 = (pg8::f32x4){nc2[qi], nc2[qi], nc2[qi], nc2[qi]}; S2 = S1; \
            _Pragma("unroll") for (int ks = 0; ks < 2; ++ks) { \
                S1 = __builtin_amdgcn_mfma_f32_16x16x32_bf16(kf[blk][ks][0], qf[qi][ks], S1, 0, 0, 0); S2 = __builtin_amdgcn_mfma_f32_16x16x32_bf16(kf[blk][ks][1], qf[qi][ks], S2, 0, 0, 0); } } while (0)
#define AT_BLK_P(mq, S1, S2, pa) do { float p[8]; \
            _Pragma("unroll") for (int j = 0; j < 8; ++j) { \
                const bool bit = __builtin_amdgcn_inverse_ballot_w64(((u64)mq[2 * j + 1] << 32) | mq[2 * j]); \
                p[j] = bit ? __builtin_amdgcn_exp2f(j < 4 ? S1[j & 3] : S2[j & 3]) : 0.f; } \
            v4u pk; pk.x = pk2(p[0], p[1]); pk.y = pk2(p[2], p[3]); pk.z = pk2(p[4], p[5]); pk.w = pk2(p[6], p[7]); \
            pa = __builtin_bit_cast(s8, pk); } while (0)
#define AT_BLK_V(blk, qi, pa) do { \
            _Pragma("unroll") for (int db = 0; db < 4; ++db) O[qi][db] = __builtin_amdgcn_mfma_f32_16x16x32_bf16(pa, vf[blk][db], O[qi][db], 0, 0, 0); \
            Ls[qi] = __builtin_amdgcn_mfma_f32_16x16x32_bf16(pa, ones8, Ls[qi], 0, 0, 0); } while (0)
#define AT_ROTATE do { const int t_ = bc; bc = bn; bn = bs; bs = t_; } while (0)
#define AT_MAIN_BODY(kt, RK_LD, RV_LD, RK_ST, RV_ST, LASTWAIT) do { \
            { const int ktn_ = (kt) + 5 < nkt ? (kt) + 5 : nkt - 1; AT_LOAD(ktn_, RK_LD, RV_LD); } \
            AT_STORE(bs, RK_ST, RV_ST); \
            pg8::f32x4 Sa, Sb, Sc, Sd, Se, Sf, Sg, Sh; s8 pa0, pa1, pb0, pb1; \
            AT_BLK_S(0, 0, Sa, Sb); AT_BLK_S(1, 0, Sc, Sd); AT_BLK_S(0, 1, Se, Sf); AT_BLK_S(1, 1, Sg, Sh);        \
            AT_MWAIT_S2(m0, m1, n0, n1); \
            AT_KREAD(bn, 0); AT_KREAD(bn, 1); \
            AT_BLK_P(m0, Sa, Sb, pa0); AT_SLOAD(m0, 0, 2 * (kt) + 2); AT_BLK_P(m1, Sc, Sd, pa1); AT_SLOAD(m1, 0, 2 * (kt) + 3); \
            AT_BLK_V(0, 0, pa0); AT_BLK_V(1, 0, pa1); \
            AT_BLK_P(n0, Se, Sf, pb0); AT_SLOAD(n0, 1, 2 * (kt) + 2); AT_BLK_P(n1, Sg, Sh, pb1); AT_SLOAD(n1, 1, 2 * (kt) + 3); \
            AT_BLK_V(0, 1, pb0); AT_BLK_V(1, 1, pb1); \
            if (LASTWAIT) AT_MWAIT_O(m0, m1, n0, n1);                   \
            AT_VREAD(bn, 0); AT_VREAD(bn, 1); \
            AT_ROTATE; \
            __builtin_amdgcn_s_barrier(); } while (0)
#define AT_DIAG_STEP(kt, qi) do { \
            if (2 * (kt) + 1 <= lb[qi]) { pg8::f32x4 Sa, Sb, Sc, Sd; s8 pa0, pa1; AT_SLOAD(m0, qi, 2 * (kt)); AT_SLOAD(m1, qi, 2 * (kt) + 1); \
                AT_BLK_S(0, qi, Sa, Sb); AT_BLK_S(1, qi, Sc, Sd); AT_MWAIT(m0, m1); AT_BLK_P(m0, Sa, Sb, pa0); AT_BLK_P(m1, Sc, Sd, pa1); AT_BLK_V(0, qi, pa0); AT_BLK_V(1, qi, pa1); } \
            else if (2 * (kt) <= lb[qi]) { pg8::f32x4 Sa, Sb; s8 pa0; AT_SLOAD(m0, qi, 2 * (kt)); AT_SLOAD(m1, qi, 2 * (kt)); \
                AT_BLK_S(0, qi, Sa, Sb); AT_MWAIT(m0, m1); AT_BLK_P(m0, Sa, Sb, pa0); AT_BLK_V(0, qi, pa0); } } while (0)
#define AT_DIAG_BODY(kt, RK_LD, RV_LD, RK_ST, RV_ST) do { \
            { const int ktn_ = (kt) + 5 < nkt ? (kt) + 5 : nkt - 1; AT_LOAD(ktn_, RK_LD, RV_LD); } \
            AT_STORE(bs, RK_ST, RV_ST); \
            if (2 * (kt) <= lb[1] || 2 * (kt) <= lb[0]) { \
                AT_KREAD(bc, 0); AT_KREAD(bc, 1); AT_VREAD(bc, 0); AT_VREAD(bc, 1); \
                AT_DIAG_STEP(kt, 0); AT_DIAG_STEP(kt, 1); } \
            asm volatile("s_waitcnt lgkmcnt(0)" ::: "memory"); \
            AT_ROTATE; \
            __builtin_amdgcn_s_barrier(); } while (0)
        int bc = 0, bn = 2 * AT_TILE, bs = 4 * AT_TILE;
        s8 kf[2][2][2], vf[2][4];
        AT_SLOAD(m0, 0, 0); AT_SLOAD(m1, 0, 1); AT_SLOAD(n0, 1, 0); AT_SLOAD(n1, 1, 1);
        AT_STORE(bc, rk0, rv0);
        AT_STORE(bn, rk1, rv1);
        AT_LOAD(nkt > 4 ? 4 : nkt - 1, rk0, rv0);
        AT_MWAIT(m0, m1); AT_MWAIT(n0, n1);
        __syncthreads();
        AT_KREAD(bc, 0); AT_KREAD(bc, 1); AT_VREAD(bc, 0); AT_VREAD(bc, 1);
#pragma unroll 1
        for (int kt = 0; kt < kmain; kt += 4) {
            AT_MAIN_BODY(kt, rk1, rv1, rk2, rv2, false);
            AT_MAIN_BODY(kt + 1, rk2, rv2, rk3, rv3, false);
            AT_MAIN_BODY(kt + 2, rk3, rv3, rk0, rv0, false);
            AT_MAIN_BODY(kt + 3, rk0, rv0, rk1, rv1, true);
        }
#pragma unroll 1
        for (int kt = kmain; kt < nkt; kt += 4) {
            AT_DIAG_BODY(kt, rk1, rv1, rk2, rv2);
            AT_DIAG_BODY(kt + 1, rk2, rv2, rk3, rv3);
            AT_DIAG_BODY(kt + 2, rk3, rv3, rk0, rv0);
            AT_DIAG_BODY(kt + 3, rk0, rv0, rk1, rv1);
        }
#undef AT_ROTATE
#undef AT_MAIN_BODY
#undef AT_DIAG_BODY
#undef AT_DIAG_STEP
#undef AT_BLK_S
#undef AT_BLK_P
#undef AT_BLK_V
#undef AT_KREAD
#undef AT_VREAD
#undef AT_SLOAD
#undef AT_MWAIT
#undef AT_MWAIT_S2
#undef AT_MWAIT_O
#undef AT_LOAD
#undef AT_STORE
#pragma unroll
        for (int qi = 0; qi < 2; ++qi)
#pragma unroll
            for (int j = 0; j < 4; ++j) { const float ij = Ls[qi][j] > 0.f ? 1.f / Ls[qi][j] : 0.f; const int t = tq[qi] + 4 * g + j;
                if (act[qi]) {
#pragma unroll
                    for (int db = 0; db < 4; ++db) MIX[(mb + t) * 1024 + 256 + h * 64 + db * 16 + r] = f2bf(O[qi][db][j] * ij); } }
    }
}
constexpr int CK = 16;
constexpr int NCHK = L / CK;
static_assert(L % CK == 0, "chunk length");
constexpr int CKP_RW = 10, CKP_HG = 7;
constexpr int CKR_RW = CKP_RW * 1024 + 512, CKR_HG = CKP_HG * 1024 + 256;
constexpr size_t WS_CKF_RW = WS_PROJ + 136 * MiB;
constexpr size_t WS_CKF_HG = WS_CKF_RW + (size_t)32 * NCHK * CKR_RW;
static_assert(WS_CKF_HG + (size_t)32 * NCHK * CKR_HG <= WS_PROJ + (size_t)TP * NINP * 2, "chunk fragments fit in the dead proj region");
__device__ __forceinline__ s8 pack8(const pg8::f32x4 lo, const pg8::f32x4 hi) { v4u p; p.x = pk2(lo[0], lo[1]); p.y = pk2(lo[2], lo[3]); p.z = pk2(hi[0], hi[1]); p.w = pk2(hi[2], hi[3]); return __builtin_bit_cast(s8, p); }
template <int CTRL> __device__ __forceinline__ float dpp_shr1(float x) { return __int_as_float(__builtin_amdgcn_update_dpp(0x3F800000, __float_as_int(x), CTRL, 0xF, 0xF, false)); }
__device__ __forceinline__ float row_cumprod(float x) { x *= dpp_shr1<0x111>(x); x *= dpp_shr1<0x112>(x); x *= dpp_shr1<0x114>(x); x *= dpp_shr1<0x118>(x); return x; }

template <bool RWKV>
__device__ __forceinline__ void chunk_prep_item(const Ctx A, int bh, int c, int lane) {
    const int r = lane & 15, g = lane >> 4;
    const size_t base = ((size_t)bh * L + (size_t)c * CK + r) * 64;
    const float* Wg = (const float*)(A.ws + (RWKV ? WS_RW_W : WS_HG_F)) + base;
    const bf16* Ag = (const bf16*)(A.ws + WS_RW_A) + base; const bf16* Bg = (const bf16*)(A.ws + WS_RW_B) + base;
    const bf16* Kg = (const bf16*)(A.ws + (RWKV ? WS_RW_K : WS_HG_K)) + base; const bf16* Rg = (const bf16*)(A.ws + (RWKV ? WS_RW_WR : WS_HG_Q)) + base;
    GAS unsigned char* recb = A.ws + (RWKV ? WS_CKF_RW : WS_CKF_HG) + ((size_t)bh * NCHK + c) * (RWKV ? CKR_RW : CKR_HG);
    v4u* REC = (v4u*)recb + lane; v4f* GCp = (v4f*)(recb + (RWKV ? CKP_RW : CKP_HG) * 1024); float* Dp = (float*)(recb + CKP_RW * 1024 + 256);
    s8 Af[2], Bf[2], Kf[2], Rf[2], BTf[2], KTf[2];
    v4f gcv[4];
#pragma unroll
    for (int ks = 0; ks < 2; ++ks) {
        pg8::f32x4 ah[2], bh_[2], kh[2], rh[2], bt[2], kt[2];
#pragma unroll
        for (int hf = 0; hf < 2; ++hf) {
            const int k0 = 32 * ks + 16 * hf + 4 * g;
            const v4f w4 = *(const v4f*)(Wg + k0);
            v4f gt, gm, gc;
#pragma unroll
            for (int e = 0; e < 4; ++e) { gt[e] = row_cumprod(w4[e]); gm[e] = dpp_shr1<0x111>(gt[e]); gc[e] = __shfl(gt[e], 16 * g + 15); }
            gcv[2 * ks + hf] = gc;
            v4f inv; inv.x = __builtin_amdgcn_rcpf(gt.x); inv.y = __builtin_amdgcn_rcpf(gt.y); inv.z = __builtin_amdgcn_rcpf(gt.z); inv.w = __builtin_amdgcn_rcpf(gt.w);
            const v4f kk4 = ld_bf4(Kg + k0) * inv, rr4 = ld_bf4(Rg + k0) * (RWKV ? gm : gt);
            kh[hf] = kk4; rh[hf] = rr4; kt[hf] = kk4 * gc;
            if (RWKV) { ah[hf] = ld_bf4(Ag + k0) * gm; bh_[hf] = ld_bf4(Bg + k0) * inv; bt[hf] = bh_[hf] * gc; }
        }
        Kf[ks] = pack8(kh[0], kh[1]); Rf[ks] = pack8(rh[0], rh[1]); KTf[ks] = pack8(kt[0], kt[1]);
        if (RWKV) { Af[ks] = pack8(ah[0], ah[1]); Bf[ks] = pack8(bh_[0], bh_[1]); BTf[ks] = pack8(bt[0], bt[1]); }
    }
    const pg8::f32x4 z4 = (pg8::f32x4){0.f, 0.f, 0.f, 0.f};
    s8 selE, selO;
    { v4u e = (v4u){0u, 0u, 0u, 0u}, o = e; const int jj = r - 4 * g;
      if (jj >= 0 && jj < 4) { const unsigned one = 0x3F80u << (16 * (jj & 1)); if (jj < 2) { e.x = one; o.z = one; } else { e.y = one; o.w = one; } }
      selE = __builtin_bit_cast(s8, e); selO = __builtin_bit_cast(s8, o); }
    pg8::f32x4 MrkT = __builtin_amdgcn_mfma_f32_16x16x32_bf16(Kf[0], Rf[0], z4, 0, 0, 0); MrkT = __builtin_amdgcn_mfma_f32_16x16x32_bf16(Kf[1], Rf[1], MrkT, 0, 0, 0);
    const int tb = r >> 2, tj = r & 3;
    if (RWKV) {
        pg8::f32x4 LabT = __builtin_amdgcn_mfma_f32_16x16x32_bf16(Bf[0], Af[0], z4, 0, 0, 0); LabT = __builtin_amdgcn_mfma_f32_16x16x32_bf16(Bf[1], Af[1], LabT, 0, 0, 0);
        pg8::f32x4 LakT = __builtin_amdgcn_mfma_f32_16x16x32_bf16(Kf[0], Af[0], z4, 0, 0, 0); LakT = __builtin_amdgcn_mfma_f32_16x16x32_bf16(Kf[1], Af[1], LakT, 0, 0, 0);
        pg8::f32x4 MrbT = __builtin_amdgcn_mfma_f32_16x16x32_bf16(Bf[0], Rf[0], z4, 0, 0, 0); MrbT = __builtin_amdgcn_mfma_f32_16x16x32_bf16(Bf[1], Rf[1], MrbT, 0, 0, 0);
        const float d10 = __shfl(LabT[0], 20 * g + 1), d20 = __shfl(LabT[0], 20 * g + 2), d21 = __shfl(LabT[1], 20 * g + 2);
        const float d30 = __shfl(LabT[0], 20 * g + 3), d31 = __shfl(LabT[1], 20 * g + 3), d32 = __shfl(LabT[2], 20 * g + 3);
        pg8::f32x4 Loff, Lak, Mrb, Mrk;
#pragma unroll
        for (int j = 0; j < 4; ++j) { const bool below = g < tb, diag = g == tb;
            Loff[j] = below ? LabT[j] : 0.f; Lak[j] = (below || (diag && j < tj)) ? LakT[j] : 0.f;
            Mrb[j] = (below || (diag && j <= tj)) ? MrbT[j] : 0.f; Mrk[j] = (below || (diag && j <= tj)) ? MrkT[j] : 0.f; }
        REC[0 * 64] = __builtin_bit_cast(v4u, Af[0]); REC[1 * 64] = __builtin_bit_cast(v4u, Af[1]); REC[2 * 64] = __builtin_bit_cast(v4u, Rf[0]); REC[3 * 64] = __builtin_bit_cast(v4u, Rf[1]);
        REC[4 * 64] = __builtin_bit_cast(v4u, pack8(Loff, Lak)); REC[5 * 64] = __builtin_bit_cast(v4u, pack8(Mrb, Mrk));
        if (r == 0) { *(v4f*)(Dp + 8 * g) = (v4f){d10, d20, d21, d30}; *(v4f*)(Dp + 8 * g + 4) = (v4f){d31, d32, 0.f, 0.f}; }
#pragma unroll
        for (int mt = 0; mt < 4; ++mt) { const s8 sel = (mt & 1) ? selO : selE;
            const pg8::f32x4 K2 = __builtin_amdgcn_mfma_f32_16x16x32_bf16(KTf[mt >> 1], sel, z4, 0, 0, 0), B2 = __builtin_amdgcn_mfma_f32_16x16x32_bf16(BTf[mt >> 1], sel, z4, 0, 0, 0);
            REC[(6 + mt) * 64] = __builtin_bit_cast(v4u, pack8(B2, K2)); if (r == 15) GCp[4 * mt + g] = gcv[mt]; }
    } else {
        pg8::f32x4 Mrk;
#pragma unroll
        for (int j = 0; j < 4; ++j) Mrk[j] = (g < tb || (g == tb && j <= tj)) ? MrkT[j] : 0.f;
        REC[0 * 64] = __builtin_bit_cast(v4u, Rf[0]); REC[1 * 64] = __builtin_bit_cast(v4u, Rf[1]); REC[2 * 64] = __builtin_bit_cast(v4u, pack8(z4, Mrk));
#pragma unroll
        for (int mt = 0; mt < 4; ++mt) { const s8 sel = (mt & 1) ? selO : selE;
            const pg8::f32x4 K2 = __builtin_amdgcn_mfma_f32_16x16x32_bf16(KTf[mt >> 1], sel, z4, 0, 0, 0);
            REC[(3 + mt) * 64] = __builtin_bit_cast(v4u, pack8(z4, K2)); if (r == 15) GCp[4 * mt + g] = gcv[mt]; }
    }
}
__device__ PHASE_FN void chunk_prep_phase(const Ctx A, int vcu, int G) {
    const int tid = opaque_tid(), lane = tid & 63, wave = tid >> 6;
    const int gw = vcu * NWAVES + wave, NGW = G * NWAVES;
#pragma unroll 1
    for (int it = gw; it < 2 * 32 * NCHK; it += NGW) {
        const int mix = it >= 32 * NCHK, q = mix ? it - 32 * NCHK : it, bh = q / NCHK, c = q - bh * NCHK;
        if (mix) chunk_prep_item<false>(A, bh, c, lane); else chunk_prep_item<true>(A, bh, c, lane);
    }
}
template <bool RWKV>
__device__ PHASE_FN void chunk_scan(const Ctx A, LAS unsigned char* lds, int unit_) {
    const int unit = opaque_s(unit_);
    const int tid = opaque_tid(), lane = tid & 63, wave = tid >> 6, r = lane & 15, g = lane >> 4;
    const int slot = wave >> 2, nt = wave & 3;
    const int bh = 2 * unit + slot, b = bh >> 2, h = bh & 3;
    constexpr int NP = RWKV ? CKP_RW : CKP_HG;
    constexpr int NU = NP + 3;
    constexpr int NQ = (NU + 3) / 4;
    constexpr int RING = NU * 1024;
    constexpr size_t RB = RWKV ? CKR_RW : CKR_HG;
    const GAS unsigned char* recb = A.ws + (RWKV ? WS_CKF_RW : WS_CKF_HG) + (size_t)bh * NCHK * RB;
    const GAS unsigned char* vb = A.ws + (RWKV ? WS_RW_V : WS_HG_V) + (size_t)bh * L * 128;
    float* YR = (float*)(A.ws + (RWKV ? WS_YRAW : WS_ORAW)) + (size_t)b * L * 256 + h * 64 + nt * 16 + r;
    LAS unsigned char* ring = lds + slot * 2 * RING;
    static_assert(4 * (size_t)(CKP_RW + 3) * 1024 <= MISC_OFF, "chunk ring");
    auto unit_src = [&](int c_, int u) -> const GAS v4u* {
        if (u < NP) return (const GAS v4u*)(recb + (size_t)c_ * RB + u * 1024) + lane;
        if (u == NP) { const int q = lane * 16 < (int)(RB - NP * 1024) ? lane * 16 : (int)(RB - NP * 1024) - 16; return (const GAS v4u*)(recb + (size_t)c_ * RB + NP * 1024 + q); }
        return (const GAS v4u*)(vb + (size_t)c_ * CK * 128 + (u - NP - 1) * 1024) + lane; };
    v4u st0[NQ], st1[NQ], st2[NQ], st3[NQ];
#define CK_LD(S, c_) do { const int cc_ = (c_) < NCHK ? (c_) : NCHK - 1; _Pragma("unroll") for (int q = 0; q < NQ; ++q) { const int u = nt + 4 * q; if (u < NU) S[q] = *unit_src(cc_, u); } } while (0)
#define CK_ST(S, p_) do { _Pragma("unroll") for (int q = 0; q < NQ; ++q) { const int u = nt + 4 * q; if (u < NU) *(LAS v4u*)(ring + (p_) * RING + u * 1024 + lane * 16) = S[q]; } } while (0)
    pg8::f32x4 ST[4];
#pragma unroll
    for (int mt = 0; mt < 4; ++mt) ST[mt] = (pg8::f32x4){0.f, 0.f, 0.f, 0.f};
    const pg8::f32x4 z4 = (pg8::f32x4){0.f, 0.f, 0.f, 0.f};
    auto body = [&](const int c, const int p) __attribute__((always_inline)) {
        const LAS unsigned char* rb_ = ring + p * RING;
        const LAS unsigned char* sm = rb_ + NP * 1024;
        v4u pcs[NP]; v4f gqs[4]; v4f da = (v4f){0.f, 0.f, 0.f, 0.f}, db = da;
#pragma unroll
        for (int i = 0; i < NP; ++i) pcs[i] = *(const LAS v4u*)(rb_ + i * 1024 + lane * 16);
#pragma unroll
        for (int mt = 0; mt < 4; ++mt) gqs[mt] = *(const LAS v4f*)(sm + (16 * mt + 4 * g) * 4);
        if (RWKV) { da = *(const LAS v4f*)(sm + 256 + g * 32); db = *(const LAS v4f*)(sm + 256 + g * 32 + 16); }
#define PIECE(i) __builtin_bit_cast(s8, pcs[i])
        unsigned vp0, vp1;
        { const LAS unsigned short* vv = (const LAS unsigned short*)(rb_ + (NP + 1) * 1024) + (4 * g) * 64 + 16 * nt + r;
          vp0 = (unsigned)vv[0] | ((unsigned)vv[64] << 16); vp1 = (unsigned)vv[128] | ((unsigned)vv[192] << 16); }
        __builtin_amdgcn_sched_barrier(0);
        const s8 Sf0 = pack8(ST[0], ST[1]), Sf1 = pack8(ST[2], ST[3]);
        pg8::f32x4 U = z4, R0;
        if (RWKV) {
            R0 = __builtin_amdgcn_mfma_f32_16x16x32_bf16(PIECE(2), Sf0, z4, 0, 0, 0); R0 = __builtin_amdgcn_mfma_f32_16x16x32_bf16(PIECE(3), Sf1, R0, 0, 0, 0);
            pg8::f32x4 W0 = __builtin_amdgcn_mfma_f32_16x16x32_bf16(PIECE(0), Sf0, z4, 0, 0, 0); W0 = __builtin_amdgcn_mfma_f32_16x16x32_bf16(PIECE(1), Sf1, W0, 0, 0, 0);
            const float d10 = da.x, d20 = da.y, d21 = da.z, d30 = da.w, d31 = db.x, d32 = db.y;
            const s8 Ajac = PIECE(4);
#pragma unroll
            for (int rnd = 0; rnd < 4; ++rnd) {
                v4u bu; bu.x = pk2(U[0], U[1]); bu.y = pk2(U[2], U[3]); bu.z = vp0; bu.w = vp1;
                const pg8::f32x4 Wr = __builtin_amdgcn_mfma_f32_16x16x32_bf16(Ajac, __builtin_bit_cast(s8, bu), W0, 0, 0, 0);
                U[0] = Wr[0]; U[1] = Wr[1] + d10 * U[0]; U[2] = Wr[2] + d20 * U[0] + d21 * U[1]; U[3] = Wr[3] + d30 * U[0] + d31 * U[1] + d32 * U[2];
            }
        } else {
            R0 = __builtin_amdgcn_mfma_f32_16x16x32_bf16(PIECE(0), Sf0, z4, 0, 0, 0); R0 = __builtin_amdgcn_mfma_f32_16x16x32_bf16(PIECE(1), Sf1, R0, 0, 0, 0);
        }
        v4u buv; buv.x = pk2(U[0], U[1]); buv.y = pk2(U[2], U[3]); buv.z = vp0; buv.w = vp1;
        const s8 Buv = __builtin_bit_cast(s8, buv);
        const pg8::f32x4 Yt = __builtin_amdgcn_mfma_f32_16x16x32_bf16(PIECE(RWKV ? 5 : 2), Buv, R0, 0, 0, 0);
#pragma unroll
        for (int j = 0; j < 4; ++j) YR[(size_t)(c * CK + 4 * g + j) * 256] = Yt[j];
#pragma unroll
        for (int mt = 0; mt < 4; ++mt) {
            const v4f gq = gqs[mt];
            ST[mt][0] *= gq.x; ST[mt][1] *= gq.y; ST[mt][2] *= gq.z; ST[mt][3] *= gq.w;
            ST[mt] = __builtin_amdgcn_mfma_f32_16x16x32_bf16(PIECE((RWKV ? 6 : 3) + mt), Buv, ST[mt], 0, 0, 0);
        }
#undef PIECE
    };
    CK_LD(st0, 0); CK_LD(st1, 1); CK_LD(st2, 2); CK_LD(st3, 3);
    CK_ST(st0, 0);
    __syncthreads();
#define CK_TRIP(c_, SLD, SST, p_) do { CK_LD(SLD, (c_) + 4); body((c_), (p_)); CK_ST(SST, 1 - (p_)); __syncthreads(); } while (0)
    static_assert(NCHK % 4 == 1, "chunk loop: whole groups of four trips + one");
#pragma unroll 1
    for (int c = 0; c < NCHK - 1; c += 4) {
        CK_TRIP(c, st0, st1, 0);
        CK_TRIP(c + 1, st1, st2, 1);
        CK_TRIP(c + 2, st2, st3, 0);
        CK_TRIP(c + 3, st3, st0, 1);
    }
    CK_TRIP(NCHK - 1, st0, st1, 0);
#undef CK_TRIP
#undef CK_LD
#undef CK_ST
}
__device__ __forceinline__ float rowmax16(float x) { x = fmaxf(x, dpp_f<0xB1>(x)); x = fmaxf(x, dpp_f<0x4E>(x)); x = fmaxf(x, dpp_f<0x141>(x)); x = fmaxf(x, dpp_f<0x140>(x)); return x; }
__device__ __forceinline__ int rowmin16i(int x) { x = min(x, __builtin_amdgcn_update_dpp(0, x, 0xB1, 0xF, 0xF, true)); x = min(x, __builtin_amdgcn_update_dpp(0, x, 0x4E, 0xF, 0xF, true));
    x = min(x, __builtin_amdgcn_update_dpp(0, x, 0x141, 0xF, 0xF, true)); x = min(x, __builtin_amdgcn_update_dpp(0, x, 0x140, 0xF, 0xF, true)); return x; }
__device__ PHASE_FN void ln_router_phase(const Ctx A, LAS unsigned char* lds, int l, int vcu, int G) {
    const int tid = opaque_tid(), lane = tid & 63, wave = tid >> 6, r = lane & 15, g = lane >> 4;
    const int gw = vcu * NWAVES + wave, NGW = G * NWAVES;
    bf16* HB = (bf16*)(A.ws + WS_HB);
    int* TIDX = (int*)(A.ws + WS_TIDX); float* TGATE = (float*)(A.ws + WS_TGATE);
    unsigned* ecnt = (unsigned*)(A.ws + WS_CTL) + CW_ECNT + 64 * l;
    const float* gg = gin(A, 26) + l * D; const float* bb = gin(A, 27) + l * D;
    const float* rw = gin(A, 28) + (size_t)l * D * NE; const float* rb = gin(A, 29) + l * NE;
    LAS int* hist = (LAS int*)(lds + MISC_OFF + MI_HIST);
    if (tid < 32) hist[tid] = 0;
    for (int f = tid; f < 32 * 2 * 64; f += NTHR) { const int ks = f >> 7, nt = (f >> 6) & 1, ln = f & 63, n = ln & 15, g8 = ln >> 4;
        float w8[8];
#pragma unroll
        for (int e = 0; e < 8; ++e) w8[e] = rw[(size_t)(32 * ks + 8 * g8 + e) * NE + 16 * nt + n];
        v4u hi, lo; unsigned hh[4], ll[4];
#pragma unroll
        for (int e = 0; e < 4; ++e) { const unsigned ph = pk2(w8[2 * e], w8[2 * e + 1]); hh[e] = ph; ll[e] = pk2(w8[2 * e] - bflo(ph), w8[2 * e + 1] - bfhi(ph)); }
        hi = (v4u){hh[0], hh[1], hh[2], hh[3]}; lo = (v4u){ll[0], ll[1], ll[2], ll[3]};
        *(LAS v4u*)(lds + ((size_t)((ks * 2 + nt) * 2 + 0) * 64 + ln) * 16) = hi; *(LAS v4u*)(lds + ((size_t)((ks * 2 + nt) * 2 + 1) * 64 + ln) * 16) = lo; }
    __syncthreads();
    const float rb0 = rb[r], rb1 = rb[16 + r];
    auto lnrows = [&](size_t mrow, auto nrows_c) {
        constexpr int NR = decltype(nrows_c)::value;
        v4f x[NR][4];
#pragma unroll
        for (int u = 0; u < NR; ++u)
#pragma unroll
            for (int j = 0; j < 4; ++j) x[u][j] = ld_bf4(HB + (mrow + u) * D + 256 * j + 4 * lane);
#pragma unroll
        for (int u = 0; u < NR; ++u) { ln_row(x[u], gg, bb, lane);
#pragma unroll
            for (int j = 0; j < 4; ++j) { const size_t o = (mrow + u) * D + 256 * j + 4 * lane;
                v2u hi; hi.x = pk2(x[u][j].x, x[u][j].y); hi.y = pk2(x[u][j].z, x[u][j].w);
                *(v2u*)(HB + o) = hi; } }
    };
    auto ln2 = [&](size_t mrow) { lnrows(mrow, std::integral_constant<int, 2>{}); };
    auto route = [&](size_t m0) {
        pg8::f32x4 C0 = (pg8::f32x4){0.f, 0.f, 0.f, 0.f}, C1 = C0;
        const bf16* ah = HB + (m0 + r) * D + 8 * g;
#pragma unroll 4
        for (int ks = 0; ks < 32; ++ks) {
            const s8 xh = *(const s8*)(ah + 32 * ks);
            const LAS unsigned char* wf = lds + (size_t)(ks * 4) * 1024 + lane * 16;
            const s8 w0h = *(const LAS s8*)(wf), w0l = *(const LAS s8*)(wf + 1024), w1h = *(const LAS s8*)(wf + 2048), w1l = *(const LAS s8*)(wf + 3072);
            C0 = __builtin_amdgcn_mfma_f32_16x16x32_bf16(xh, w0h, C0, 0, 0, 0); C0 = __builtin_amdgcn_mfma_f32_16x16x32_bf16(xh, w0l, C0, 0, 0, 0);
            C1 = __builtin_amdgcn_mfma_f32_16x16x32_bf16(xh, w1h, C1, 0, 0, 0); C1 = __builtin_amdgcn_mfma_f32_16x16x32_bf16(xh, w1l, C1, 0, 0, 0);
        }
#pragma unroll
        for (int j = 0; j < 4; ++j) {
            float v0 = C0[j] + rb0, v1 = C1[j] + rb1;
            float tv[4]; int ti[4];
#pragma unroll
            for (int q = 0; q < 4; ++q) {
                const float mx = rowmax16(fmaxf(v0, v1));
                const int cand = (v0 == mx) ? r : ((v1 == mx) ? 16 + r : 64);
                const int bi = rowmin16i(cand);
                tv[q] = mx; ti[q] = bi;
                if (bi == r) v0 = -3.0e38f; if (bi == 16 + r) v1 = -3.0e38f;
            }
            const float e1 = __expf(tv[1] - tv[0]), e2 = __expf(tv[2] - tv[0]), e3 = __expf(tv[3] - tv[0]); const float inv = rcp_(1.f + e1 + e2 + e3);
            const size_t m = m0 + 4 * g + j;
            if (r == 0) { *(int4*)(TIDX + m * 4) = make_int4(ti[0], ti[1], ti[2], ti[3]); *(v4f*)(TGATE + m * 4) = (v4f){inv, e1 * inv, e2 * inv, e3 * inv}; }
            if (r < 4) lds_add(&hist[r == 0 ? ti[0] : r == 1 ? ti[1] : r == 2 ? ti[2] : ti[3]], 1);
        }
    };
    const int NT16 = T / 16, nfull = (NT16 / NGW) * NGW;
#pragma unroll 1
    for (int tile = gw; tile < nfull; tile += NGW) {
        const size_t m0 = (size_t)tile * 16;
#pragma unroll 1
        for (int t = 0; t < 16; t += 4) lnrows(m0 + t, std::integral_constant<int, 4>{});
        asm volatile("s_waitcnt vmcnt(0)" ::: "memory");
        route(m0);
    }
#pragma unroll 1
    for (int tile = nfull + vcu; tile < NT16; tile += G) {
        const size_t m0 = (size_t)tile * 16;
        ln2(m0 + 2 * wave);
        asm volatile("s_waitcnt vmcnt(0)" ::: "memory");
        __syncthreads();
        if (wave == 0) route(m0);
    }
    __syncthreads();
    if (tid < 32) atomicAdd(&ecnt[tid], (unsigned)hist[tid]);
}
__device__ __forceinline__ int build_tiles(const Ctx A, LAS unsigned char* lds, int l) {
    const int tid = opaque_tid();
    const unsigned* ecnt = (const unsigned*)(A.ws + WS_CTL) + CW_ECNT + 64 * l;
    LAS int* offs = (LAS int*)(lds + MISC_OFF + MI_OFFS); LAS int* tile_e = (LAS int*)(lds + MISC_OFF + MI_TILE); LAS int* nt = (LAS int*)(lds + MISC_OFF + MI_NT);
    __syncthreads();
    if (tid < 32) { int off = 0, mycnt = 0;
        for (int e = 0; e < 32; ++e) { const int c = (int)__hip_atomic_load(ecnt + e, __ATOMIC_RELAXED, __HIP_MEMORY_SCOPE_AGENT); if (e < tid) off += (c + 255) & ~255; if (e == tid) mycnt = c; }
        offs[tid] = off;
        const int t0 = off >> 8, t1 = (off + ((mycnt + 255) & ~255)) >> 8;
        for (int t = t0; t < t1; ++t) tile_e[t] = tid;
        if (tid == 31) nt[0] = t1; }
    __syncthreads();
    return nt[0];
}
__device__ PHASE_FN void moe_sort_phase(const Ctx A, LAS unsigned char* lds, int l) {
    const int tid = opaque_tid();
    const int* TIDX = (const int*)(A.ws + WS_TIDX); const float* TGATE = (const float*)(A.ws + WS_TGATE);
    int* SPOS = (int*)(A.ws + WS_SPOS); float* GSORT = (float*)(A.ws + WS_GSORT); int* RMAP = (int*)(A.ws + WS_RMAP);
    unsigned* ecur = (unsigned*)(A.ws + WS_CTL) + CW_ECUR + 64 * l; const unsigned* ecnt = (const unsigned*)(A.ws + WS_CTL) + CW_ECNT + 64 * l;
    LAS int* hist = (LAS int*)(lds + MISC_OFF + MI_HIST); LAS int* lcur = (LAS int*)(lds + MISC_OFF + MI_LCUR); LAS int* lbase = (LAS int*)(lds + MISC_OFF + MI_LBASE);
    LAS int* offs = (LAS int*)(lds + MISC_OFF + MI_OFFS);
    (void)build_tiles(A, lds, l);
    const int TPB = (T + (int)gridDim.x - 1) / (int)gridDim.x;
    const int mbeg = blockIdx.x * TPB, mend = (mbeg + TPB < T) ? mbeg + TPB : T;
    const int nslot = (mend > mbeg) ? (mend - mbeg) * 4 : 0;
    if (tid < 32) { hist[tid] = 0; lcur[tid] = 0; }
    __syncthreads();
    for (int s = tid; s < nslot; s += NTHR) lds_add(&hist[TIDX[(size_t)mbeg * 4 + s]], 1);
    __syncthreads();
    if (tid < 32) lbase[tid] = offs[tid] + (int)atomicAdd(&ecur[tid], (unsigned)hist[tid]);
    __syncthreads();
    for (int s = tid; s < nslot; s += NTHR) { const size_t gs = (size_t)mbeg * 4 + s; const int e = TIDX[gs];
        const int pos = lbase[e] + lds_add(&lcur[e], 1);
        SPOS[gs] = pos; GSORT[pos] = TGATE[gs]; RMAP[pos] = mbeg + (s >> 2); }
    if (blockIdx.x < 32) { const int e = blockIdx.x; const int c = (int)__hip_atomic_load(ecnt + e, __ATOMIC_RELAXED, __HIP_MEMORY_SCOPE_AGENT);
        const int p0 = offs[e] + c, p1 = offs[e] + ((c + 255) & ~255);
        for (int p = p0 + tid; p < p1; p += NTHR) RMAP[p] = 0; }
}
__device__ PHASE_FN void combine_ln_phase(const Ctx A, int l, int vcu, int G) {
    const int tid = opaque_tid(), lane = tid & 63, wave = tid >> 6;
    const int gw = vcu * NWAVES + wave, NGW = G * NWAVES;
    bf16* HB = (bf16*)(A.ws + WS_HB); const bf16* Y = (const bf16*)(A.ws + WS_YBUF); const int* SPOS = (const int*)(A.ws + WS_SPOS);
    const float* g = gin(A, 34) + l * D; const float* bb = gin(A, 35) + l * D;
#pragma unroll 1
    for (int m0 = 2 * gw; m0 < T; m0 += 2 * NGW) {
        v4f v[2][4];
#pragma unroll
        for (int t = 0; t < 2; ++t) { const int m = m0 + t;
            const int4 sp = *(const int4*)(SPOS + (size_t)m * 4);
#pragma unroll
            for (int j = 0; j < 4; ++j) { const size_t co = 256 * j + 4 * lane;
                const v4f y = ld_bf4(Y + (size_t)sp.x * D + co) + ld_bf4(Y + (size_t)sp.y * D + co) + ld_bf4(Y + (size_t)sp.z * D + co) + ld_bf4(Y + (size_t)sp.w * D + co);
                v[t][j] = ld_bf4(HB + (size_t)m * D + co) * ALPHA + y; } }
#pragma unroll
        for (int t = 0; t < 2; ++t) { const int m = m0 + t;
            ln_row(v[t], g, bb, lane);
            if (l == 0) {
#pragma unroll
                for (int j = 0; j < 4; ++j) st_bf4(HB + (size_t)m * D + 256 * j + 4 * lane, v[t][j]);
            } else {
                const int b = m / L, i = m - b * L;
                if (i >= NMETA) { float* o = (float*)(GAS float*)A.out + ((size_t)b * SEQ + (i - NMETA)) * D;
#pragma unroll
                    for (int j = 0; j < 4; ++j) *(v4f*)(o + 256 * j + 4 * lane) = v[t][j]; }
            }
        }
    }
}
constexpr int N_PHASES = 23;
#ifndef PH_ONLY
#define PH_ONLY -1
#endif
#define PHSEL(j) (PH_ONLY < 0 || PH_ONLY == (j))
#define IN(k) (lo <= (k) && (k) < hi)
#if MK_ONE_LAUNCH
#define GRID_BAR() xcd_barrier(bar)
#else
#define GRID_BAR() do { } while (0)
#endif
#define SEAM(k) do { if (IN(k) && IN((k) + 1)) GRID_BAR(); } while (0)
#define CTX() Ctx{args.in, args.out, launder(args.ws)}
#ifndef PROBE_PHASE
#define PROBE_PHASE -1
#endif
#ifndef PROBE_MULT
#define PROBE_MULT 4
#endif
#define PB_BEGIN(j) do { if (PROBE_PHASE == (j)) { pstamp = __builtin_amdgcn_s_memrealtime(); } } while (0)
#define PB_END(j) do { if (PROBE_PHASE == (j)) { pacc += __builtin_amdgcn_s_memrealtime() - pstamp; } } while (0)
__device__ __forceinline__ void layer_phases(const int l, const Args& args, LAS unsigned char* lds, const int G, const int bx, const int vcu, const int lo, const int hi, const XcdBarrier& bar, unsigned long long& pacc) {
    unsigned long long pstamp = 0ull; (void)pstamp;

        const int pb = 1 + 11 * l;
        PB_BEGIN(0);
        if (PHSEL(0) && IN(pb + 0)) { GAS unsigned char* wsl = launder(args.ws);
            pg8::Gemm g{(const pg8::bf16_t*)(wsl + WS_HB), (const pg8::bf16_t*)(wsl + WS_WIN) + (size_t)l * NINP * 1024, TP, NINP, 1024};
            pg8::StaticOrder S; S.init(TP, NINP, G, bx);
            pg8::EpiStoreBf16 E{(pg8::bf16_t*)(wsl + WS_PROJ), NINP};
            pg8::gemm_phase<pg8::EpiStoreBf16, pg8::StaticOrder, true, true>(lds, g, S, E);
            SEAM(pb + 0); PB_END(0);
        }
        PB_BEGIN(1);
        if (PHSEL(1) && IN(pb + 1)) { prep_phase(CTX(), lds, l, vcu, G); SEAM(pb + 1); PB_END(1); }
        PB_BEGIN(2);
        if (PHSEL(2) && IN(pb + 2)) { chunk_prep_phase(CTX(), vcu, G); lru_agg_phase(CTX(), vcu, G); SEAM(pb + 2); PB_END(2); }
        PB_BEGIN(3);
        if (PHSEL(3) && IN(pb + 3)) {
#ifndef PH2_SEL
#define PH2_SEL 15
#endif
            PB_BEGIN(20); PB_BEGIN(21); PB_BEGIN(22); PB_BEGIN(23);
#if SCAN_SEQ
            if ((PH2_SEL & 1) && bx < 64) rwkv_scan(CTX(), lds, bx); else if ((PH2_SEL & 2) && bx >= 64 && bx < 128) hgrn_scan(CTX(), lds, bx - 64); else if ((PH2_SEL & 4) && bx >= 128 && bx < 132) lru_carry_phase(CTX(), 128);
#else
            if ((PH2_SEL & 1) && bx < 16) chunk_scan<true>(CTX(), lds, bx); else if ((PH2_SEL & 2) && bx >= 16 && bx < 32) chunk_scan<false>(CTX(), lds, bx - 16); else if ((PH2_SEL & 4) && bx >= 32 && bx < 36) lru_carry_phase(CTX(), 32);
#endif
            __syncthreads();
            PB_END(20); PB_END(21); PB_END(22);
#if DSA_NAIVE
            if (PH2_SEL & 8) dsa_phase(CTX(), lds, l);
#else
            if (PH2_SEL & 8) dsa_select_phase(CTX(), lds, l);
#endif
            __syncthreads();
            PB_END(23);
            SEAM(pb + 3); PB_END(3);
        }
        PB_BEGIN(4);
        if (PHSEL(4) && IN(pb + 4)) {
            PB_BEGIN(24);
            lru_out_phase(CTX(), vcu, G);
            mixers_finish(CTX(), l, vcu, G);
            __syncthreads(); PB_END(24);
#if !DSA_NAIVE
            dsa_attn_phase(CTX(), lds, l);
#endif
            SEAM(pb + 4); PB_END(4);
        }
        PB_BEGIN(5);
        if (PHSEL(5) && IN(pb + 5)) { GAS unsigned char* wsl = launder(args.ws);
            pg8::Gemm g{(const pg8::bf16_t*)(wsl + WS_MIX), (const pg8::bf16_t*)(wsl + WS_WOUT) + (size_t)l * 1024 * 1024, TP, 1024, 1024};
            pg8::StaticOrder S; S.init(TP, 1024, G, bx);
            pg8::EpiResidBf E{(pg8::bf16_t*)(wsl + WS_HB), 1024, ALPHA};
            pg8::gemm_phase<pg8::EpiResidBf, pg8::StaticOrder, true, true>(lds, g, S, E);
            SEAM(pb + 5); PB_END(5);
        }
        PB_BEGIN(6);
        if (PHSEL(6) && IN(pb + 6)) { ln_router_phase(CTX(), lds, l, vcu, G); SEAM(pb + 6); PB_END(6); }
        PB_BEGIN(7);
        if (PHSEL(7) && IN(pb + 7)) { moe_sort_phase(CTX(), lds, l); SEAM(pb + 7); PB_END(7); }
        PB_BEGIN(8);
        if (PHSEL(8) && IN(pb + 8)) { GAS unsigned char* wsl = launder(args.ws);
            const int nt = build_tiles(CTX(), lds, l);
            pg8::Gemm g{(const pg8::bf16_t*)(wsl + WS_HB), (const pg8::bf16_t*)(wsl + WS_W1) + (size_t)l * 32 * 2048 * 1024, RMAX, 32 * 2048, 1024};
            pg8::MoeOrder S{nt * 8, G, vcu, 8, (const LAS int*)(lds + MISC_OFF + MI_TILE)};
            pg8::EpiSwiGLU E{(pg8::bf16_t*)(wsl + WS_ACT), (const float*)(const GAS float*)args.in[31] + (size_t)l * 32 * 2048};
            pg8::gemm_phase_gather<pg8::EpiSwiGLU, pg8::MoeOrder>(lds, g, S, E, (const int*)(wsl + WS_RMAP));
            SEAM(pb + 8); PB_END(8);
        }
        PB_BEGIN(9);
        if (PHSEL(9) && IN(pb + 9)) { GAS unsigned char* wsl = launder(args.ws);
            const int nt = build_tiles(CTX(), lds, l);
            pg8::Gemm g{(const pg8::bf16_t*)(wsl + WS_ACT), (const pg8::bf16_t*)(wsl + WS_W2) + (size_t)l * 32 * 1024 * 1024, RMAX, 32 * 1024, 1024};
            pg8::MoeOrder S{nt * 4, G, vcu, 4, (const LAS int*)(lds + MISC_OFF + MI_TILE)};
            pg8::EpiMoeOut E{(pg8::bf16_t*)(wsl + WS_YBUF), (const float*)(const GAS float*)args.in[33] + (size_t)l * 32 * 1024, (const float*)(wsl + WS_GSORT)};
            pg8::gemm_phase<pg8::EpiMoeOut, pg8::MoeOrder, true, true>(lds, g, S, E);
            SEAM(pb + 9); PB_END(9);
        }
        PB_BEGIN(10);
        if (PHSEL(10) && IN(pb + 10)) { combine_ln_phase(CTX(), l, vcu, G); SEAM(pb + 10); PB_END(10); }
}
__global__ void __launch_bounds__(NTHR, 2) trunk_fwd(Args args) {
    extern __shared__ __attribute__((aligned(16))) unsigned char lds_raw[];
    LAS unsigned char* lds = (LAS unsigned char*)lds_raw;
    const int tid = threadIdx.x;
    const int G = gridDim.x; const int bx = blockIdx.x; const int vcu = (G % 8 == 0) ? (bx % 8) * (G / 8) + bx / 8 : bx;
    unsigned* ctl = (unsigned*)(args.ws + WS_CTL);
    for (int u = tid; u < (LDS_BYTES - MISC_OFF) / 4; u += NTHR) ((LAS unsigned*)(lds + MISC_OFF))[u] = 0u;
    __syncthreads();
#if MK_ONE_LAUNCH
    XcdBarrier bar = xcd_barrier_post(ctl + CW_BAR, (volatile LAS unsigned*)(lds + MISC_OFF + MI_BAR));
#else
    XcdBarrier bar; bar.bar = ctl + CW_BAR; bar.x = 0; bar.st = nullptr;
#endif
    const int lo = args.ph_lo, hi = args.ph_hi;

    unsigned long long pacc = 0ull, pstamp = 0ull; (void)pstamp;
    PB_BEGIN(11);
    if (PHSEL(11) && IN(0)) { p0_prologue(CTX(), lds, vcu, G); SEAM(0); }
    PB_END(11);

#pragma unroll 1
    for (int l = 0; l < 2; ++l) layer_phases(l, args, lds, G, bx, vcu, lo, hi, bar, pacc);
    if (PROBE_PHASE >= 0 && bx == (PROBE_PHASE == 21 ? 16 : PROBE_PHASE == 22 ? 32 : PROBE_PHASE == 23 ? 255 : 0)) { const unsigned long long t0 = __builtin_amdgcn_s_memrealtime(); while (__builtin_amdgcn_s_memrealtime() - t0 < pacc * PROBE_MULT) __builtin_amdgcn_s_sleep(8); }
#undef IN
#undef SEAM
}

extern "C" void kernel_launch(void* const* d_in, const int* in_sizes, int n_in, void* d_out, int out_size, void* d_ws, size_t ws_size, hipStream_t stream) {
    static int grid = 0;
    if (grid == 0) {
        if (n_in != 36 || in_sizes[0] != NB * SEQ * D || out_size != NB * SEQ * D || ws_size < WS_END) {
            fprintf(stderr, "kernel_launch: unexpected problem (n_in %d, in0 %d, out %d, ws %zu, need %zu); nothing launched\n", n_in, n_in > 0 ? in_sizes[0] : -1, out_size, ws_size, (size_t)WS_END); grid = -1; return; }
        int dev = 0, cus = 0, per_cu = 0;
        if (hipGetDevice(&dev) != hipSuccess || hipDeviceGetAttribute(&cus, hipDeviceAttributeMultiprocessorCount, dev) != hipSuccess) { grid = -1; return; }
        if (hipFuncSetAttribute((const void*)trunk_fwd, hipFuncAttributeMaxDynamicSharedMemorySize, LDS_BYTES) != hipSuccess) { fprintf(stderr, "kernel_launch: hipFuncSetAttribute failed\n"); grid = -1; return; }
        if (hipOccupancyMaxActiveBlocksPerMultiprocessor(&per_cu, (const void*)trunk_fwd, NTHR, LDS_BYTES) != hipSuccess || per_cu < 1) { fprintf(stderr, "kernel_launch: occupancy query says %d\n", per_cu); (void)hipGetLastError(); }
        grid = cus;
        if (grid < 160 || grid > 512) { fprintf(stderr, "kernel_launch: unsupported CU count %d\n", cus); grid = -1; return; }
    }
    if (grid < 0) return;
    if (hipMemsetAsync((char*)d_ws + WS_CTL, 0, CTL_ZERO_BYTES, stream) != hipSuccess) return;
    Args a; memset(&a, 0, sizeof(a));
    for (int i = 0; i < 36; ++i) a.in[i] = (const float*)d_in[i];
    a.out = (float*)d_out; a.ws = (unsigned char*)d_ws;
#if MK_ONE_LAUNCH
    a.ph_lo = 0; a.ph_hi = N_PHASES;
    hipLaunchKernelGGL(trunk_fwd, dim3(grid), dim3(NTHR), LDS_BYTES, stream, a);
#else
    for (int p = 0; p < N_PHASES; ++p) { a.ph_lo = p; a.ph_hi = p + 1; hipLaunchKernelGGL(trunk_fwd, dim3(grid), dim3(NTHR), LDS_BYTES, stream, a); }
#endif
}
```

```cpp
#include <hip/hip_runtime.h>
#include <cstdio>
#include <cstdint>
#include <cstring>

#ifndef MK_ONE_LAUNCH
#define MK_ONE_LAUNCH 1
#endif

#ifndef SCAN_SEQ
#define SCAN_SEQ 0
#endif
#ifndef SCAN_MIX
#define SCAN_MIX 0
#endif
#ifndef DSA_NAIVE
#define DSA_NAIVE 0
#endif
#ifndef PHASE_FN
#define PHASE_FN __forceinline__
#endif
#define GAS __attribute__((address_space(1)))
#define LAS __attribute__((address_space(3)))
typedef unsigned short bf16;
typedef unsigned v4u __attribute__((ext_vector_type(4)));
typedef unsigned v2u __attribute__((ext_vector_type(2)));
typedef float v4f __attribute__((ext_vector_type(4)));
typedef float v2f __attribute__((ext_vector_type(2)));

constexpr int NB = 8, SEQ = 8192, NMETA = 16, L = SEQ + NMETA  , T = NB * L  , TP = 65792  , D = 1024;
constexpr int NINP = 3584;
constexpr int NE = 32, TOPK = 4;
constexpr int RMAX = 1058 * 256;
constexpr int C_RW = 0, C_RW_R = 0, C_RW_WD = 256, C_RW_K = 320, C_RW_V = 576, C_RW_AD = 832, C_RW_GD = 896;
constexpr int C_DS_Q = 960, C_DS_K = 1216, C_DS_V = 1472, C_DS_QI = 1728, C_DS_KI = 1984, C_DS_WI = 2016;
constexpr int C_LR_X = 2024, C_LR_G = 2280;
constexpr int C_HG_Q = 2536, C_HG_F = 2792, C_HG_I = 3048, C_HG_G = 3304;
constexpr float ALPHA = 1.41421356237f;
constexpr float LN_EPS = 1e-5f;

constexpr size_t MiB = 1u << 20;
constexpr size_t WS_CTL = 0, CTL_ZERO_BYTES = 1 * MiB;
constexpr size_t WS_WIN = 2 * MiB;
constexpr size_t WS_WOUT = 16 * MiB;
constexpr size_t WS_W1 = 20 * MiB;
constexpr size_t WS_W2 = 276 * MiB;
constexpr size_t WS_H = 404 * MiB;
constexpr size_t WS_MIX = WS_H;
constexpr size_t WS_HB = 661 * MiB;
constexpr size_t WS_BIG = 790 * MiB;
constexpr size_t WS_PROJ = WS_BIG;
constexpr size_t SZ_HM32 = (size_t)32 * L * 64 * 4;
constexpr size_t SZ_HM16 = SZ_HM32 / 2;
constexpr size_t SZ_TM16 = (size_t)T * 256 * 2;
constexpr size_t WS_RW_W = 1240 * MiB;
constexpr size_t WS_RW_A = WS_RW_W + SZ_HM32, WS_RW_B = WS_RW_A + SZ_HM16, WS_RW_K = WS_RW_B + SZ_HM16, WS_RW_WR = WS_RW_K + SZ_HM16, WS_RW_V = WS_RW_WR + SZ_HM16;
constexpr size_t WS_RW_G = WS_RW_V + SZ_HM16;
constexpr size_t WS_RW_SC = WS_RW_G + SZ_TM16;
constexpr size_t WS_DS_Q = WS_RW_SC + (size_t)32 * L * 16;
constexpr size_t WS_DS_K = WS_DS_Q + SZ_TM16, WS_DS_V = WS_DS_K + SZ_TM16, WS_DS_QI = WS_DS_V + SZ_TM16;
constexpr size_t WS_DS_KI = WS_DS_QI + SZ_TM16;
constexpr size_t WS_DS_WI = WS_DS_KI + (size_t)T * 64;
constexpr size_t WS_LR_A = WS_DS_WI + (size_t)T * 32;
constexpr size_t WS_LR_U = WS_LR_A + (size_t)T * 1024, WS_LR_G = WS_LR_U + SZ_TM16;
constexpr size_t WS_HG_F = WS_LR_G + SZ_TM16;
constexpr size_t WS_HG_K = WS_HG_F + SZ_HM32, WS_HG_Q = WS_HG_K + SZ_HM16, WS_HG_V = WS_HG_Q + SZ_HM16, WS_HG_G = WS_HG_V + SZ_HM16;
constexpr size_t WS_MIX_END = WS_HG_G + SZ_TM16;
constexpr size_t SZ_SORT = (size_t)RMAX * 1024 * 2;
constexpr size_t WS_SORTA = WS_BIG, WS_YBUF = WS_BIG, WS_ACT = WS_BIG + SZ_SORT;
constexpr size_t WS_TIDX = WS_ACT + SZ_SORT;
constexpr size_t WS_TGATE = WS_TIDX + (size_t)T * 16;
constexpr size_t WS_SPOS = WS_TGATE + (size_t)T * 16;
constexpr size_t WS_GSORT = WS_SPOS + (size_t)T * 16;
constexpr size_t WS_RMAP = WS_GSORT + (size_t)RMAX * 4;
constexpr size_t WS_MOE_END = WS_RMAP + (size_t)RMAX * 4;
constexpr size_t WS_END = 2040 * MiB;
static_assert(WS_MIX_END <= WS_END && WS_MOE_END <= WS_END, "workspace map");
static_assert(WS_PROJ + (size_t)TP * NINP * 2 <= WS_RW_W, "proj vs prep");
static_assert(WS_HB + (size_t)TP * 1024 * 2 <= WS_BIG && WS_H + (size_t)TP * 4096 <= WS_HB, "h/hb");

constexpr int CW_TMO = 0, CW_CODE = 1;
constexpr int CW_BAR = 4096;
constexpr int CW_DSAQ = 8192;
constexpr int CW_ECNT = 8448;
constexpr int CW_ECUR = 8704;

constexpr int LDS_BYTES = 163840;
constexpr int MISC_OFF = 155648;
constexpr int MI_BAR = 0, MI_HIST = 64, MI_LCUR = 192, MI_LBASE = 320, MI_NT = 448, MI_OFFS = 512, MI_TILE = 1024;
constexpr int NWAVES = 8, NTHR = 512;

__device__ __forceinline__ float bf2f(unsigned short x) { return __uint_as_float((unsigned)x << 16); }
__device__ __forceinline__ float bflo(unsigned x) { return __uint_as_float(x << 16); }
__device__ __forceinline__ float bfhi(unsigned x) { return __uint_as_float(x & 0xffff0000u); }
typedef float f32x2_t __attribute__((ext_vector_type(2))); typedef __bf16 bf16x2_t __attribute__((ext_vector_type(2)));
__device__ __forceinline__ unsigned pk2(float lo, float hi) { const f32x2_t v = {lo, hi}; const bf16x2_t b = __builtin_convertvector(v, bf16x2_t); return __builtin_bit_cast(unsigned, b); }
__device__ __forceinline__ bf16 f2bf(float f) { return (bf16)(pk2(f, 0.f) & 0xffffu); }
__device__ __forceinline__ v4f ld_bf4(const bf16* p) { const v2u x = *(const v2u*)p; return (v4f){bflo(x.x), bfhi(x.x), bflo(x.y), bfhi(x.y)}; }
__device__ __forceinline__ void st_bf4(bf16* p, v4f v) { v2u o; o.x = pk2(v.x, v.y); o.y = pk2(v.z, v.w); *(v2u*)p = o; }
__device__ __forceinline__ float wave_max(float v) {
#pragma unroll
    for (int o = 1; o < 64; o <<= 1) v = fmaxf(v, __shfl_xor(v, o));
    return v;
}
template <int CTRL> __device__ __forceinline__ float dpp_f(float x) { return __int_as_float(__builtin_amdgcn_update_dpp(0, __float_as_int(x), CTRL, 0xF, 0xF, true)); }
__device__ __forceinline__ float sum8(float x) { x += dpp_f<0xB1>(x); x += dpp_f<0x4E>(x); x += dpp_f<0x141>(x); return x; }
__device__ __forceinline__ float sum16(float x) { x = sum8(x); x += dpp_f<0x140>(x); return x; }
__device__ __forceinline__ float wave_sum(float v) {
    v = sum16(v);
    v += __shfl_xor(v, 16); v += __shfl_xor(v, 32);
    return v;
}
__device__ __forceinline__ float rcp_(float x) { return __builtin_amdgcn_rcpf(x); }
__device__ __forceinline__ float rsq_(float x) { return __builtin_amdgcn_rsqf(x); }
__device__ __forceinline__ float sigmoidf_(float x) { return rcp_(1.f + __expf(-x)); }
__device__ __forceinline__ float softplusf_(float x) { return x > 20.f ? x : log1pf(__expf(x)); }
__device__ __forceinline__ float gelu_tanh(float x) { const float u = 0.7978845608028654f * (x + 0.044715f * x * x * x); return 0.5f * x * (1.f + tanhf(u)); }
__device__ __forceinline__ int lds_add(LAS int* p, int v) { return __hip_atomic_fetch_add(p, v, __ATOMIC_RELAXED, __HIP_MEMORY_SCOPE_WORKGROUP); }
#define LDS_WAIT() asm volatile("s_waitcnt lgkmcnt(0)" ::: "memory")
#define VM_WAIT() asm volatile("s_waitcnt vmcnt(0)" ::: "memory")

__device__ __forceinline__ GAS unsigned char* launder(unsigned char* p) { GAS unsigned char* g = (GAS unsigned char*)p; asm volatile("" : "+s"(g)); return g; }
__device__ __forceinline__ int opaque_tid() { int t = (int)threadIdx.x; asm volatile("" : "+v"(t)); return t; }
__device__ __forceinline__ int opaque_s(int x) { return __builtin_amdgcn_readfirstlane(x); }
struct Args { const float* in[36]; float* out; unsigned char* ws; int ph_lo, ph_hi; };
struct Ctx { const float* const* in; float* out; GAS unsigned char* ws; };
__device__ __forceinline__ const float* gin(const Ctx& A, int k) { return (const float*)(const GAS float*)A.in[k]; }
namespace pg8 {
#define PG8_LAS __attribute__((address_space(3)))
typedef unsigned short bf16_t;
typedef short bf16x8 __attribute__((ext_vector_type(8)));
typedef float f32x4 __attribute__((ext_vector_type(4)));
typedef unsigned u32x4 __attribute__((ext_vector_type(4)));
constexpr int BM = 256, BK = 64, HALF = 128, HTB = HALF * BK * 2  , STAGE_BYTES = 8 * HTB, NXCD = 8, WGM = 8;

__host__ __device__ __forceinline__ int lds_byte(int r, int c) { const int st = (r >> 4) * 2 + (c >> 5), rr = r & 15, cc = c & 31, ob = rr * 64 + cc * 2; return st * 1024 + (ob ^ (((ob >> 9) & 1) << 5)); }
__host__ __device__ __forceinline__ void stage_rc(int b, int& R, int& C) { const int st = b / 1024, sb = b % 1024, swz = sb ^ (((sb >> 9) & 1) << 5); R = (st >> 1) * 16 + swz / 64; C = (st & 1) * 32 + (swz % 64) / 2; }
__host__ __device__ __forceinline__ int perm32(int rho) { const int n = rho >> 4, i = rho & 15; return 8 * (i >> 2) + 4 * n + (i & 3); }

struct Unit { int pm, pn; };
struct Gemm { const bf16_t* A; const bf16_t* Bt; int M, N, K; };

struct StaticOrder {
    int nM, nN, nwg, G, c;
    __host__ __device__ void init(int M, int N, int G_, int c_) { nM = M / BM; nN = N / BM; nwg = nM * nN; G = G_; c = c_; }
    __host__ __device__ bool next(int i, Unit& u) const {
        const long L = (long)i * G + c; if (L >= nwg) return false;
        int wgid = (int)L; { const int q = nwg / NXCD, r = nwg % NXCD, xcd = wgid % NXCD, off = wgid / NXCD; wgid = (xcd < r ? xcd * (q + 1) : r * (q + 1) + (xcd - r) * q) + off; }
        const int nig = WGM * nN, gid = wgid / nig, fm = gid * WGM, gsz = (nM - fm) < WGM ? (nM - fm) : WGM;
        u.pm = fm + ((wgid % nig) % gsz); u.pn = (wgid % nig) / gsz; return true;
    }
    __device__ __forceinline__ void a_ready(const Unit&) const {}
    __device__ __forceinline__ void done(const Unit&) const {}
};

__device__ __forceinline__ unsigned cvt_pk_bf16(float lo, float hi) { unsigned r; asm volatile("v_cvt_pk_bf16_f32 %0, %1, %2" : "=v"(r) : "v"(lo), "v"(hi)); return r; }
typedef float f32x2 __attribute__((ext_vector_type(2)));
typedef unsigned u32x2v __attribute__((ext_vector_type(2)));
typedef float pf32x2_t __attribute__((ext_vector_type(2))); typedef __bf16 pbf16x2_t __attribute__((ext_vector_type(2)));
__device__ __forceinline__ unsigned cvt_pk_bf16c(float lo, float hi) { const pf32x2_t v = {lo, hi}; const pbf16x2_t q = __builtin_convertvector(v, pbf16x2_t); return __builtin_bit_cast(unsigned, q); }
struct EpiStoreBf16 {
    static constexpr bool PERM = true, AFTER_DRAIN = false;
    bf16_t* O; int ldc;
    __device__ __forceinline__ void operator()(const f32x4 (&acc)[2][2][4][2], const Unit& u, int wr, int wc, int fr, int fq) const {
        const int row0 = u.pm * BM + wr * 64 + fr, col0 = u.pn * BM + wc * 32 + 8 * fq;
#pragma unroll
        for (int ai = 0; ai < 2; ++ai)
#pragma unroll
            for (int m = 0; m < 4; ++m) { bf16_t* rowp = O + (size_t)(row0 + ai * HALF + m * 16) * ldc + col0;
#pragma unroll
                for (int bj = 0; bj < 2; ++bj) { const f32x4 v0 = acc[ai][bj][m][0], v1 = acc[ai][bj][m][1];
                    u32x4 w; w.x = cvt_pk_bf16c(v0[0], v0[1]); w.y = cvt_pk_bf16c(v0[2], v0[3]); w.z = cvt_pk_bf16c(v1[0], v1[1]); w.w = cvt_pk_bf16c(v1[2], v1[3]);
                    *(u32x4*)(rowp + bj * HALF) = w; } }
    }
};
struct EpiResid {
    static constexpr bool PERM = false, AFTER_DRAIN = false;
    float* Hres; int ldc; float alpha;
    __device__ __forceinline__ void operator()(const f32x4 (&acc)[2][2][4][2], const Unit& u, int wr, int wc, int fr, int fq) const {
        const int row0 = u.pm * BM + wr * 64 + fr, col0 = u.pn * BM + wc * 32 + 4 * fq;
#pragma unroll
        for (int ai = 0; ai < 2; ++ai)
#pragma unroll
            for (int m = 0; m < 4; ++m) { float* rowp = Hres + (size_t)(row0 + ai * HALF + m * 16) * ldc + col0;
#pragma unroll
                for (int bj = 0; bj < 2; ++bj)
#pragma unroll
                    for (int n = 0; n < 2; ++n) { f32x4* p = (f32x4*)(rowp + bj * HALF + n * 16); const f32x4 old = *p; *p = old * alpha + acc[ai][bj][m][n]; } }
    }
};
struct EpiResidBf {
    static constexpr bool PERM = true, AFTER_DRAIN = false;
    bf16_t* Hb; int ldc; float alpha;
    __device__ __forceinline__ void operator()(const f32x4 (&acc)[2][2][4][2], const Unit& u, int wr, int wc, int fr, int fq) const {
        const int row0 = u.pm * BM + wr * 64 + fr, col0 = u.pn * BM + wc * 32 + 8 * fq;
#pragma unroll
        for (int ai = 0; ai < 2; ++ai)
#pragma unroll
            for (int m = 0; m < 4; ++m) { bf16_t* rowp = Hb + (size_t)(row0 + ai * HALF + m * 16) * ldc + col0;
#pragma unroll
                for (int bj = 0; bj < 2; ++bj) { const f32x4 v0 = acc[ai][bj][m][0], v1 = acc[ai][bj][m][1]; const u32x4 o = *(const u32x4*)(rowp + bj * HALF);
#define RB_LO(x_) __builtin_bit_cast(float, (x_) << 16)
#define RB_HI(x_) __builtin_bit_cast(float, (x_) & 0xffff0000u)
                    u32x4 w; w.x = cvt_pk_bf16c(RB_LO(o.x) * alpha + v0[0], RB_HI(o.x) * alpha + v0[1]); w.y = cvt_pk_bf16c(RB_LO(o.y) * alpha + v0[2], RB_HI(o.y) * alpha + v0[3]);
                    w.z = cvt_pk_bf16c(RB_LO(o.z) * alpha + v1[0], RB_HI(o.z) * alpha + v1[1]); w.w = cvt_pk_bf16c(RB_LO(o.w) * alpha + v1[2], RB_HI(o.w) * alpha + v1[3]);
#undef RB_LO
#undef RB_HI
                    *(u32x4*)(rowp + bj * HALF) = w; } }
    }
};
struct EpiSwiGLU {
    static constexpr bool PERM = true, AFTER_DRAIN = false;
    bf16_t* ACT; const float* b1;
    __device__ __forceinline__ void operator()(const f32x4 (&acc)[2][2][4][2], const Unit& u, int wr, int wc, int fr, int fq) const {
        const int e = u.pn >> 3, pnl = u.pn & 7;
        const int row0 = u.pm * BM + wr * 64 + fr, c8 = pnl * 128 + wc * 32 + 8 * fq;
        const float* bg = b1 + (size_t)e * 2048 + c8; const float* bl = bg + 1024;
        const f32x4 bg0 = *(const f32x4*)bg, bg1 = *(const f32x4*)(bg + 4), bl0 = *(const f32x4*)bl, bl1 = *(const f32x4*)(bl + 4);
#pragma unroll
        for (int ai = 0; ai < 2; ++ai)
#pragma unroll
            for (int m = 0; m < 4; ++m) {
                float o[8];
#pragma unroll
                for (int n = 0; n < 2; ++n) { const f32x4 g4 = acc[ai][0][m][n] + (n ? bg1 : bg0), l4 = acc[ai][1][m][n] + (n ? bl1 : bl0);
#pragma unroll
                    for (int j = 0; j < 4; ++j) { const float glu = fminf(g4[j], 7.f), lin = fminf(fmaxf(l4[j], -7.f), 7.f);
                        o[n * 4 + j] = glu * __builtin_amdgcn_rcpf(1.f + __builtin_amdgcn_exp2f(glu * (-1.702f * 1.4426950408889634f))) * (lin + 1.f); } }
                u32x4 w; w.x = cvt_pk_bf16c(o[0], o[1]); w.y = cvt_pk_bf16c(o[2], o[3]); w.z = cvt_pk_bf16c(o[4], o[5]); w.w = cvt_pk_bf16c(o[6], o[7]);
                *(u32x4*)(ACT + (size_t)(row0 + ai * HALF + m * 16) * 1024 + c8) = w; }
    }
};
struct EpiMoeOut {
    static constexpr bool PERM = true, AFTER_DRAIN = false;
    bf16_t* Y; const float* b2; const float* gate;
    __device__ __forceinline__ void operator()(const f32x4 (&acc)[2][2][4][2], const Unit& u, int wr, int wc, int fr, int fq) const {
        const int e = u.pn >> 2, pnl = u.pn & 3;
        const int row0 = u.pm * BM + wr * 64 + fr, c8 = pnl * 256 + wc * 32 + 8 * fq;
        const float* bb = b2 + (size_t)e * 1024 + c8;
        f32x4 bv[2][2];
#pragma unroll
        for (int bj = 0; bj < 2; ++bj) { bv[bj][0] = *(const f32x4*)(bb + bj * HALF); bv[bj][1] = *(const f32x4*)(bb + bj * HALF + 4); }
#pragma unroll
        for (int ai = 0; ai < 2; ++ai)
#pragma unroll
            for (int m = 0; m < 4; ++m) { const int row = row0 + ai * HALF + m * 16; const float gt = gate[row];
#pragma unroll
                for (int bj = 0; bj < 2; ++bj) { const f32x4 v0 = (acc[ai][bj][m][0] + bv[bj][0]) * gt, v1 = (acc[ai][bj][m][1] + bv[bj][1]) * gt;
                    u32x4 w; w.x = cvt_pk_bf16c(v0[0], v0[1]); w.y = cvt_pk_bf16c(v0[2], v0[3]); w.z = cvt_pk_bf16c(v1[0], v1[1]); w.w = cvt_pk_bf16c(v1[2], v1[3]);
                    *(u32x4*)(Y + (size_t)row * 1024 + c8 + bj * HALF) = w; } }
    }
};
struct MoeOrder {
    int n_units, G, c, npn; const PG8_LAS int* tile_e;
    __device__ __forceinline__ bool next(int i, Unit& u) const {
        const int Lx = i * G + c; if (Lx >= n_units) return false;
        const int tile = Lx / npn, pnl = Lx - tile * npn;
        u.pm = tile; u.pn = tile_e[tile] * npn + pnl; return true;
    }
    __device__ __forceinline__ void a_ready(const Unit&) const {}
    __device__ __forceinline__ void done(const Unit&) const {}
};

template <class Epi, class Sched, bool ALIGN_EPI = false, bool SP2 = false>
__device__ __forceinline__ void gemm_phase(PG8_LAS unsigned char* lds, const Gemm g, const Sched& S, const Epi& E) {
    const int tid = opaque_tid(), wid = __builtin_amdgcn_readfirstlane(tid >> 6), lane = tid & 63, wr = wid >> 2, wc = wid & 3, fr = lane & 15, fq = lane >> 4;
    const int K = g.K, nt = K / BK;
    unsigned voffA[2], voffB[2];
#pragma unroll
    for (int i = 0; i < 2; ++i) { int R, C; stage_rc(tid * 16 + i * 8192, R, C); const int Rb = Epi::PERM ? ((R & ~31) + perm32(R & 31)) : R;
        voffA[i] = (unsigned)(R * K + C) * 2u; voffB[i] = (unsigned)(Rb * K + C) * 2u; }
    const size_t kstep = (size_t)(BK * 2);
    const size_t hstep = (size_t)HALF * K * 2;
    const size_t tstep = 2 * hstep;
    const unsigned ldsw = (unsigned)wid * 1024u;
    const int aoff = lds_byte(wr * 64 + fr, fq * 8), boff = lds_byte(wc * 32 + fr, fq * 8);
#define PG8_SA(b, h) (((b) * 2 + (h)) * HTB)
#define PG8_SB(b, h) ((4 + (b) * 2 + (h)) * HTB)
#define PG8_STAGE(bufoff, gbase, voff) do { _Pragma("unroll") for (int _i = 0; _i < 2; ++_i) \
        __builtin_amdgcn_global_load_lds((const unsigned*)((const char*)(gbase) + (voff)[_i]), (PG8_LAS unsigned*)(lds + (bufoff) + ldsw + _i * 8192), 16, 0, 0); } while (0)
#define PG8_LDA(dst, b, h) do { _Pragma("unroll") for (int m = 0; m < 4; ++m) _Pragma("unroll") for (int k = 0; k < 2; ++k) dst[m][k] = *(const PG8_LAS bf16x8*)(lds + PG8_SA(b, h) + aoff + m * 2048 + k * 1024); } while (0)
#define PG8_LDB(dst, b, h) do { _Pragma("unroll") for (int n = 0; n < 2; ++n) _Pragma("unroll") for (int k = 0; k < 2; ++k) dst[n][k] = *(const PG8_LAS bf16x8*)(lds + PG8_SB(b, h) + boff + n * 2048 + k * 1024); } while (0)
#define PG8_MMA(ai, bj, At, Bt) do { __builtin_amdgcn_s_setprio(1); _Pragma("unroll") for (int m = 0; m < 4; ++m) _Pragma("unroll") for (int n = 0; n < 2; ++n) _Pragma("unroll") for (int k = 0; k < 2; ++k) \
        acc[ai][bj][m][n] = __builtin_amdgcn_mfma_f32_16x16x32_bf16(Bt[n][k], At[m][k], acc[ai][bj][m][n], 0, 0, 0); __builtin_amdgcn_s_setprio(0); } while (0)
#define PG8_WAIT_V(n) asm volatile("s_waitcnt vmcnt(" #n ")" ::: "memory")
#define PG8_WAIT_L(n) asm volatile("s_waitcnt lgkmcnt(" #n ")" ::: "memory")
#define PG8_BAR __builtin_amdgcn_s_barrier()
#define PG8_SCHED __builtin_amdgcn_sched_barrier(0)
    Unit cur, nxt; int ui = 0;
    if (!S.next(0, cur)) return;
    f32x4 acc[2][2][4][2];
#pragma unroll
    for (int a = 0; a < 2; ++a)
#pragma unroll
        for (int b = 0; b < 2; ++b)
#pragma unroll
            for (int m = 0; m < 4; ++m)
#pragma unroll
                for (int n = 0; n < 2; ++n) acc[a][b][m][n] = (f32x4){0.f, 0.f, 0.f, 0.f};
    bf16x8 At[4][2], B0[2][2], B1[2][2];
    const char* cA = (const char*)g.A + (size_t)cur.pm * tstep; const char* cB = (const char*)g.Bt + (size_t)cur.pn * tstep;
    S.a_ready(cur);
    if constexpr (SP2) {
        PG8_STAGE(PG8_SB(0, 0), cB, voffB); PG8_STAGE(PG8_SB(0, 1), cB + hstep, voffB); PG8_STAGE(PG8_SA(0, 0), cA, voffA); PG8_STAGE(PG8_SA(0, 1), cA + hstep, voffA);
        if (wr == 1) PG8_BAR;
        PG8_WAIT_V(2); PG8_BAR;
        PG8_STAGE(PG8_SB(1, 0), cB + kstep, voffB); PG8_STAGE(PG8_SA(1, 0), cA + kstep, voffA); PG8_STAGE(PG8_SB(1, 1), cB + hstep + kstep, voffB);
        PG8_WAIT_V(6); PG8_BAR;
    } else {
        PG8_STAGE(PG8_SB(0, 0), cB, voffB); PG8_STAGE(PG8_SA(0, 0), cA, voffA); PG8_STAGE(PG8_SB(0, 1), cB + hstep, voffB); PG8_STAGE(PG8_SA(0, 1), cA + hstep, voffA);
        if (wr == 1) PG8_BAR;
        PG8_WAIT_V(4); PG8_BAR;
        PG8_STAGE(PG8_SB(1, 0), cB + kstep, voffB); PG8_STAGE(PG8_SA(1, 0), cA + kstep, voffA); PG8_STAGE(PG8_SB(1, 1), cB + hstep + kstep, voffB);
        PG8_WAIT_V(6); PG8_BAR;
    }
    for (;;) {
        const bool has_next = S.next(ui + 1, nxt);
        const char* nA = has_next ? (const char*)g.A + (size_t)nxt.pm * tstep : cA; const char* nB = has_next ? (const char*)g.Bt + (size_t)nxt.pn * tstep : cB;
        for (int t = 0; t < nt; t += 2) {
            const bool last = (t == nt - 2);
            const char* a1 = cA + (size_t)(t + 1) * kstep;
            const char* a2 = last ? nA : cA + (size_t)(t + 2) * kstep; const char* b2 = last ? nB : cB + (size_t)(t + 2) * kstep;
            const char* a3 = a2 + kstep; const char* b3 = b2 + kstep;
            if (last && has_next) S.a_ready(nxt);
            if constexpr (SP2) {
            PG8_LDB(B0, 0, 0); PG8_LDB(B1, 0, 1); PG8_SCHED; PG8_LDA(At, 0, 0); PG8_STAGE(PG8_SA(1, 1), a1 + hstep, voffA);
            PG8_WAIT_V(8); PG8_WAIT_L(0); PG8_BAR; PG8_MMA(0, 0, At, B0); PG8_MMA(0, 1, At, B1); PG8_BAR; PG8_SCHED;
            PG8_LDA(At, 0, 1); PG8_STAGE(PG8_SB(0, 0), b2, voffB); PG8_STAGE(PG8_SB(0, 1), b2 + hstep, voffB); PG8_STAGE(PG8_SA(0, 0), a2, voffA);
            PG8_WAIT_V(8); PG8_WAIT_L(0); PG8_BAR; PG8_MMA(1, 0, At, B0); PG8_MMA(1, 1, At, B1); PG8_BAR; PG8_SCHED;
            PG8_LDB(B0, 1, 0); PG8_LDB(B1, 1, 1); PG8_SCHED; PG8_LDA(At, 1, 0); PG8_STAGE(PG8_SA(0, 1), a2 + hstep, voffA);
            PG8_WAIT_V(8); PG8_WAIT_L(0); PG8_BAR; PG8_MMA(0, 0, At, B0); PG8_MMA(0, 1, At, B1); PG8_BAR; PG8_SCHED;
            PG8_LDA(At, 1, 1); PG8_STAGE(PG8_SB(1, 0), b3, voffB); PG8_STAGE(PG8_SB(1, 1), b3 + hstep, voffB); PG8_STAGE(PG8_SA(1, 0), a3, voffA);
            PG8_WAIT_V(8); PG8_WAIT_L(0); PG8_BAR; PG8_MMA(1, 0, At, B0); PG8_MMA(1, 1, At, B1); PG8_BAR; PG8_SCHED;
            } else {
            PG8_LDB(B0, 0, 0); PG8_SCHED; PG8_LDA(At, 0, 0); PG8_STAGE(PG8_SA(1, 1), a1 + hstep, voffA);
            PG8_WAIT_L(8); PG8_BAR; PG8_WAIT_L(0); PG8_MMA(0, 0, At, B0); PG8_BAR; PG8_SCHED;
            PG8_LDB(B1, 0, 1); PG8_STAGE(PG8_SB(0, 0), b2, voffB);
            PG8_BAR; PG8_WAIT_L(0); PG8_MMA(0, 1, At, B1); PG8_BAR;
            PG8_LDA(At, 0, 1); PG8_STAGE(PG8_SA(0, 0), a2, voffA);
            PG8_BAR; PG8_WAIT_L(0); PG8_MMA(1, 0, At, B0); PG8_BAR; PG8_SCHED;
            PG8_STAGE(PG8_SB(0, 1), b2 + hstep, voffB);
            PG8_WAIT_V(6); PG8_BAR; PG8_MMA(1, 1, At, B1); PG8_BAR;
            PG8_LDB(B0, 1, 0); PG8_SCHED; PG8_LDA(At, 1, 0); PG8_STAGE(PG8_SA(0, 1), a2 + hstep, voffA);
            PG8_WAIT_L(8); PG8_BAR; PG8_WAIT_L(0); PG8_MMA(0, 0, At, B0); PG8_BAR; PG8_SCHED;
            PG8_LDB(B1, 1, 1); PG8_STAGE(PG8_SB(1, 0), b3, voffB);
            PG8_BAR; PG8_WAIT_L(0); PG8_MMA(0, 1, At, B1); PG8_BAR;
            PG8_LDA(At, 1, 1); PG8_STAGE(PG8_SA(1, 0), a3, voffA);
            PG8_BAR; PG8_WAIT_L(0); PG8_MMA(1, 0, At, B0); PG8_BAR; PG8_SCHED;
            PG8_STAGE(PG8_SB(1, 1), b3 + hstep, voffB);
            PG8_WAIT_V(6); PG8_BAR; PG8_MMA(1, 1, At, B1); PG8_BAR;
            }
        }
        if constexpr (ALIGN_EPI) { if (wr == 0) PG8_BAR; }
        if constexpr (!Epi::AFTER_DRAIN) { E(acc, cur, wr, wc, fr, fq); S.done(cur); }
        if (!has_next) break;
#pragma unroll
        for (int a = 0; a < 2; ++a)
#pragma unroll
            for (int b = 0; b < 2; ++b)
#pragma unroll
                for (int m = 0; m < 4; ++m)
#pragma unroll
                    for (int n = 0; n < 2; ++n) acc[a][b][m][n] = (f32x4){0.f, 0.f, 0.f, 0.f};
        cur = nxt; cA = nA; cB = nB; ++ui;
        if constexpr (ALIGN_EPI) { if (wr == 1) PG8_BAR; }
    }
    PG8_WAIT_V(0);
    if constexpr (!ALIGN_EPI) { if (wr == 0) PG8_BAR; }
    PG8_BAR;
    if constexpr (Epi::AFTER_DRAIN) { E.fused(acc, cur, wr, wc, fr, fq, lds, wid, lane); S.done(cur); }
#undef PG8_SA
#undef PG8_SB
#undef PG8_STAGE
#undef PG8_LDA
#undef PG8_LDB
#undef PG8_MMA
#undef PG8_WAIT_V
#undef PG8_WAIT_L
#undef PG8_BAR
#undef PG8_SCHED
}
}
namespace pg8 {
template <class Epi, class Sched>
__device__ __forceinline__ void gemm_phase_gather(PG8_LAS unsigned char* lds, const Gemm g, const Sched& S, const Epi& E, const int* rmap) {
    constexpr bool ALIGN_EPI = true, SP2 = true;
    const int tid = opaque_tid(), wid = __builtin_amdgcn_readfirstlane(tid >> 6), lane = tid & 63, wr = wid >> 2, wc = wid & 3, fr = lane & 15, fq = lane >> 4;
    const int K = g.K, nt = K / BK;
    unsigned voffB[2];
#pragma unroll
    for (int i = 0; i < 2; ++i) { int R, C; stage_rc(tid * 16 + i * 8192, R, C); const int Rb = Epi::PERM ? ((R & ~31) + perm32(R & 31)) : R;
        voffB[i] = (unsigned)(Rb * K + C) * 2u; }
    const size_t kstep = (size_t)(BK * 2);
    const size_t hstep = (size_t)HALF * K * 2;
    const size_t tstep = 2 * hstep;
    const unsigned ldsw = (unsigned)wid * 1024u;
    const int aoff = lds_byte(wr * 64 + fr, fq * 8), boff = lds_byte(wc * 32 + fr, fq * 8);
#define PG8_SA(b, h) (((b) * 2 + (h)) * HTB)
#define PG8_SB(b, h) ((4 + (b) * 2 + (h)) * HTB)
#define PG8_STAGE(bufoff, gbase, voff) do { _Pragma("unroll") for (int _i = 0; _i < 2; ++_i) \
        __builtin_amdgcn_global_load_lds((const unsigned*)((const char*)(gbase) + (voff)[_i]), (PG8_LAS unsigned*)(lds + (bufoff) + ldsw + _i * 8192), 16, 0, 0); } while (0)
#define PG8_LDA(dst, b, h) do { _Pragma("unroll") for (int m = 0; m < 4; ++m) _Pragma("unroll") for (int k = 0; k < 2; ++k) dst[m][k] = *(const PG8_LAS bf16x8*)(lds + PG8_SA(b, h) + aoff + m * 2048 + k * 1024); } while (0)
#define PG8_LDB(dst, b, h) do { _Pragma("unroll") for (int n = 0; n < 2; ++n) _Pragma("unroll") for (int k = 0; k < 2; ++k) dst[n][k] = *(const PG8_LAS bf16x8*)(lds + PG8_SB(b, h) + boff + n * 2048 + k * 1024); } while (0)
#define PG8_MMA(ai, bj, At, Bt) do { __builtin_amdgcn_s_setprio(1); _Pragma("unroll") for (int m = 0; m < 4; ++m) _Pragma("unroll") for (int n = 0; n < 2; ++n) _Pragma("unroll") for (int k = 0; k < 2; ++k) \
        acc[ai][bj][m][n] = __builtin_amdgcn_mfma_f32_16x16x32_bf16(Bt[n][k], At[m][k], acc[ai][bj][m][n], 0, 0, 0); __builtin_amdgcn_s_setprio(0); } while (0)
#define PG8_WAIT_V(n) asm volatile("s_waitcnt vmcnt(" #n ")" ::: "memory")
#define PG8_WAIT_L(n) asm volatile("s_waitcnt lgkmcnt(" #n ")" ::: "memory")
#define PG8_BAR __builtin_amdgcn_s_barrier()
#define PG8_SCHED __builtin_amdgcn_sched_barrier(0)
    Unit cur, nxt; int ui = 0;
    if (!S.next(0, cur)) return;
    f32x4 acc[2][2][4][2];
#pragma unroll
    for (int a = 0; a < 2; ++a)
#pragma unroll
        for (int b = 0; b < 2; ++b)
#pragma unroll
            for (int m = 0; m < 4; ++m)
#pragma unroll
                for (int n = 0; n < 2; ++n) acc[a][b][m][n] = (f32x4){0.f, 0.f, 0.f, 0.f};
    bf16x8 At[4][2], B0[2][2], B1[2][2];
    const char* gA = (const char*)g.A; const char* cB = (const char*)g.Bt + (size_t)cur.pn * tstep;
    unsigned gofc[2][2];
    constexpr int RM_OFF = 8 * HTB;
#pragma unroll
    for (int i_ = 0; i_ < 2; ++i_) { int R, C; stage_rc(tid * 16 + i_ * 8192, R, C);
#pragma unroll
        for (int h_ = 0; h_ < 2; ++h_) gofc[h_][i_] = (unsigned)rmap[(size_t)cur.pm * BM + h_ * HALF + R] * (unsigned)(K * 2) + (unsigned)C * 2u; }
    S.a_ready(cur);
    if constexpr (SP2) {
        PG8_STAGE(PG8_SB(0, 0), cB, voffB); PG8_STAGE(PG8_SB(0, 1), cB + hstep, voffB); PG8_STAGE(PG8_SA(0, 0), gA, gofc[0]); PG8_STAGE(PG8_SA(0, 1), gA, gofc[1]);
        if (wr == 1) PG8_BAR;
        PG8_WAIT_V(2); PG8_BAR;
        PG8_STAGE(PG8_SB(1, 0), cB + kstep, voffB); PG8_STAGE(PG8_SA(1, 0), gA + kstep, gofc[0]); PG8_STAGE(PG8_SB(1, 1), cB + hstep + kstep, voffB);
        PG8_WAIT_V(6); PG8_BAR;
    }
    for (;;) {
        const bool has_next = S.next(ui + 1, nxt);
        const char* nB = has_next ? (const char*)g.Bt + (size_t)nxt.pn * tstep : cB;
        if (has_next) { const unsigned rmoff = (unsigned)(opaque_tid() & 255) * 4u;
            __builtin_amdgcn_global_load_lds((const unsigned*)((const char*)(rmap + (size_t)nxt.pm * BM) + rmoff), (PG8_LAS unsigned*)(lds + RM_OFF + wid * 256), 4, 0, 0); }
        for (int t = 0; t < nt; t += 2) {
            const bool last = (t == nt - 2);
            const char* a1 = gA + (size_t)(t + 1) * kstep;
            const char* a2 = last ? gA : gA + (size_t)(t + 2) * kstep; const char* b2 = last ? nB : cB + (size_t)(t + 2) * kstep;
            const char* a3 = a2 + kstep; const char* b3 = b2 + kstep;
            if (last && has_next) S.a_ready(nxt);
            if constexpr (SP2) {
            PG8_LDB(B0, 0, 0); PG8_LDB(B1, 0, 1); PG8_SCHED; PG8_LDA(At, 0, 0); PG8_STAGE(PG8_SA(1, 1), a1, gofc[1]);
            PG8_WAIT_V(8); PG8_WAIT_L(0); PG8_BAR; PG8_MMA(0, 0, At, B0); PG8_MMA(0, 1, At, B1); PG8_BAR; PG8_SCHED;
            if (last && has_next) { const int tid2 = opaque_tid();
#pragma unroll
                for (int i_ = 0; i_ < 2; ++i_) { int R, C; stage_rc(tid2 * 16 + i_ * 8192, R, C);
#pragma unroll
                    for (int h_ = 0; h_ < 2; ++h_) gofc[h_][i_] = (unsigned)*(const PG8_LAS int*)(lds + RM_OFF + (h_ * HALF + R) * 4) * (unsigned)(K * 2) + (unsigned)C * 2u; }
                PG8_SCHED; }
            PG8_LDA(At, 0, 1); PG8_STAGE(PG8_SB(0, 0), b2, voffB); PG8_STAGE(PG8_SB(0, 1), b2 + hstep, voffB); PG8_STAGE(PG8_SA(0, 0), a2, gofc[0]);
            PG8_WAIT_V(8); PG8_WAIT_L(0); PG8_BAR; PG8_MMA(1, 0, At, B0); PG8_MMA(1, 1, At, B1); PG8_BAR; PG8_SCHED;
            PG8_LDB(B0, 1, 0); PG8_LDB(B1, 1, 1); PG8_SCHED; PG8_LDA(At, 1, 0); PG8_STAGE(PG8_SA(0, 1), a2, gofc[1]);
            PG8_WAIT_V(8); PG8_WAIT_L(0); PG8_BAR; PG8_MMA(0, 0, At, B0); PG8_MMA(0, 1, At, B1); PG8_BAR; PG8_SCHED;
            PG8_LDA(At, 1, 1); PG8_STAGE(PG8_SB(1, 0), b3, voffB); PG8_STAGE(PG8_SB(1, 1), b3 + hstep, voffB); PG8_STAGE(PG8_SA(1, 0), a3, gofc[0]);
            PG8_WAIT_V(8); PG8_WAIT_L(0); PG8_BAR; PG8_MMA(1, 0, At, B0); PG8_MMA(1, 1, At, B1); PG8_BAR; PG8_SCHED;
            }
        }
        if constexpr (ALIGN_EPI) { if (wr == 0) PG8_BAR; }
        if constexpr (!Epi::AFTER_DRAIN) { const int lane2 = opaque_tid() & 63; E(acc, cur, wr, wc, lane2 & 15, lane2 >> 4); S.done(cur); }
        if (!has_next) break;
#pragma unroll
        for (int a = 0; a < 2; ++a)
#pragma unroll
            for (int b = 0; b < 2; ++b)
#pragma unroll
                for (int m = 0; m < 4; ++m)
#pragma unroll
                    for (int n = 0; n < 2; ++n) acc[a][b][m][n] = (f32x4){0.f, 0.f, 0.f, 0.f};
        cur = nxt; cB = nB; ++ui;
        if constexpr (ALIGN_EPI) { if (wr == 1) PG8_BAR; }
    }
    PG8_WAIT_V(0);
    if constexpr (!ALIGN_EPI) { if (wr == 0) PG8_BAR; }
    PG8_BAR;
    if constexpr (Epi::AFTER_DRAIN) { E.fused(acc, cur, wr, wc, fr, fq, lds, wid, lane); S.done(cur); }
#undef PG8_SA
#undef PG8_SB
#undef PG8_STAGE
#undef PG8_LDA
#undef PG8_LDB
#undef PG8_MMA
#undef PG8_WAIT_V
#undef PG8_WAIT_L
#undef PG8_BAR
#undef PG8_SCHED
}
}
#define XB_TMO      128
#define XB_XCNT(j)  (256  + 64 * (j))
#define XB_XSUB(j)  (1280 + 64 * (j))
#define XB_XGEN(j)  (2304 + 64 * (j))
#define XB_TOP      3328
#define XB_TOPGEN   3392
#define XCD_BAR_WORDS 3456
#define XB_SPIN_CAP (1u << 18)
#define LAS __attribute__((address_space(3)))

__device__ __forceinline__ unsigned xb_ld(unsigned* p)              { return __hip_atomic_load(p, __ATOMIC_RELAXED, __HIP_MEMORY_SCOPE_AGENT); }
__device__ __forceinline__ unsigned xb_add(unsigned* p, unsigned v) { return __hip_atomic_fetch_add(p, v, __ATOMIC_RELAXED, __HIP_MEMORY_SCOPE_AGENT); }
__device__ __forceinline__ unsigned xb_xcc_id() { return (unsigned)__builtin_amdgcn_s_getreg((3 << 11) | 20) & 0xFu; }
#define XB_SPIN(cond, bar) do { unsigned _sp = 0; while (cond) { __builtin_amdgcn_s_sleep(1); \
    if ((++_sp & 255u) == 0u) { if (xb_ld(&(bar)[XB_TMO])) break; if (_sp > XB_SPIN_CAP) { atomicAdd(&(bar)[XB_TMO], 1u); break; } } } } while (0)

struct XcdBarrier {
    unsigned* bar; unsigned x;
    volatile LAS unsigned* st;
};

__device__ __forceinline__ XcdBarrier xcd_barrier_post(unsigned* bar, volatile LAS unsigned* st) {
    XcdBarrier b; b.bar = bar; b.x = xb_xcc_id(); b.st = st;
    if (threadIdx.x == 0) (void)xb_add(&bar[XB_XCNT(b.x)], 1u);
    return b;
}
__device__ __forceinline__ void xcd_barrier_complete(unsigned* bar, unsigned x, unsigned& nloc, unsigned& nx) {
    const unsigned G = gridDim.x * gridDim.y * gridDim.z;
    unsigned sum, cnt, mine, sp = 0u;
    for (;;) {
        sum = 0u; cnt = 0u; mine = 0u;
#pragma unroll
        for (unsigned j = 0; j < 16; ++j) { const unsigned c = xb_ld(&bar[XB_XCNT(j)]); sum += c; cnt += (c > 0u) ? 1u : 0u; mine = (j == x) ? c : mine; }
        if (sum == G) break;
        __builtin_amdgcn_s_sleep(1);
        if ((++sp & 255u) == 0u) { if (xb_ld(&bar[XB_TMO])) break; if (sp > XB_SPIN_CAP) { atomicAdd(&bar[XB_TMO], 1u); break; } }
    }
    nloc = mine > 0u ? mine : 1u; nx = cnt > 0u ? cnt : 1u;
}

__device__ __forceinline__ void xcd_barrier(const XcdBarrier& b) {
    asm volatile("s_waitcnt vmcnt(0)" ::: "memory");
    __syncthreads();
    if (threadIdx.x == 0) {
        unsigned* bar = b.bar;
        __builtin_amdgcn_s_waitcnt(0);
        unsigned nloc = b.st[0], nx = b.st[1];
        if (nloc == 0u) { xcd_barrier_complete(bar, b.x, nloc, nx); b.st[0] = nloc; b.st[1] = nx; }
        const unsigned old = xb_add(&bar[XB_XSUB(b.x)], 1u);
        const unsigned gen = old / nloc;
        if (old + 1u == (gen + 1u) * nloc) {
            __builtin_amdgcn_fence(__ATOMIC_RELEASE, "agent");
            asm volatile("s_waitcnt vmcnt(0)" ::: "memory");
            const unsigned og = xb_add(&bar[XB_TOP], 1u);
            const unsigned tg = og / nx;
            if (og + 1u == (tg + 1u) * nx) xb_add(&bar[XB_TOPGEN], 1u);
            else XB_SPIN(xb_ld(&bar[XB_TOPGEN]) == tg, bar);
            __builtin_amdgcn_fence(__ATOMIC_ACQUIRE, "agent");
            xb_add(&bar[XB_XGEN(b.x)], 1u);
            asm volatile("s_waitcnt vmcnt(0)" ::: "memory");
        } else {
            XB_SPIN(xb_ld(&bar[XB_XGEN(b.x)]) == gen, bar);
            __builtin_amdgcn_fence(__ATOMIC_ACQUIRE, "agent");
            asm volatile("s_waitcnt vmcnt(0)" ::: "memory");
        }
    }
    __syncthreads();
}
__device__ __forceinline__ void p0_transpose_item(const float* W, int ldw, int ncols_valid, int k0, int n0, bf16* WT, size_t dst_row0, int Kdst, LAS float* scr, int lane) {
    const int nn = n0 + (lane & 31); const bool ok = nn < ncols_valid;
#pragma unroll 8
    for (int i = 0; i < 32; ++i) { const int kk = 2 * i + (lane >> 5); scr[kk * 33 + (lane & 31)] = ok ? W[(size_t)(k0 + kk) * ldw + nn] : 0.f; }
    LDS_WAIT();
    const int c = lane & 7;
#pragma unroll
    for (int j = 0; j < 4; ++j) { const int n = (lane >> 3) + 8 * j; const LAS float* s = scr + (8 * c) * 33 + n;
        v4u o; o.x = pk2(s[0 * 33], s[1 * 33]); o.y = pk2(s[2 * 33], s[3 * 33]); o.z = pk2(s[4 * 33], s[5 * 33]); o.w = pk2(s[6 * 33], s[7 * 33]);
        *(v4u*)(WT + (dst_row0 + n) * (size_t)Kdst + k0 + 8 * c) = o; }
    LDS_WAIT();
}
__device__ __forceinline__ void ln_row(v4f (&v)[4], const float* g, const float* b, int lane) {
    float s = 0.f, s2 = 0.f;
#pragma unroll
    for (int j = 0; j < 4; ++j) { s += (v[j].x + v[j].y) + (v[j].z + v[j].w); s2 += (v[j].x * v[j].x + v[j].y * v[j].y) + (v[j].z * v[j].z + v[j].w * v[j].w); }
    s = wave_sum(s); s2 = wave_sum(s2);
    const float mean = s * (1.f / D);
    const float rstd = rsq_(fmaxf(s2 * (1.f / D) - mean * mean, 0.f) + LN_EPS);
#pragma unroll
    for (int j = 0; j < 4; ++j) v[j] = v[j] - mean;
#pragma unroll
    for (int j = 0; j < 4; ++j) { const v4f gg = *(const v4f*)(g + 256 * j + 4 * lane), bb = *(const v4f*)(b + 256 * j + 4 * lane); v[j] = v[j] * rstd * gg + bb; }
}
__device__ PHASE_FN void p0_prologue(const Ctx A, LAS unsigned char* lds, int vcu, int G) {
    const int tid = opaque_tid(), lane = tid & 63, wave = tid >> 6;
    LAS float* scr = (LAS float*)(lds + wave * 16384);
    const int gw = vcu * NWAVES + wave, NGW = G * NWAVES;
    bf16* Win_t = (bf16*)(A.ws + WS_WIN); bf16* Wout_t = (bf16*)(A.ws + WS_WOUT); bf16* W1_t = (bf16*)(A.ws + WS_W1); bf16* W2_t = (bf16*)(A.ws + WS_W2);
    constexpr int I_IN = 2 * 16 * (NINP / 32), I_OUT = 2 * 16 * 32, I_W1 = 64 * 16 * 64, I_W2 = 64 * 16 * 32;
    constexpr int NITEMS = I_IN + I_OUT + I_W1 + I_W2;
    for (int it = gw; it < NITEMS; it += NGW) {
        int r = it;
        if (r < I_IN) { const int l = r / (16 * 112), q = r % (16 * 112), kb = q / 112, nb = q % 112;
            p0_transpose_item(gin(A, 4) + (size_t)l * 1024 * 3560, 3560, 3560, kb * 64, nb * 32, Win_t + (size_t)l * NINP * 1024, (size_t)nb * 32, 1024, scr, lane); continue; }
        r -= I_IN;
        if (r < I_OUT) { const int l = r / 512, q = r % 512, kb = q / 32, nb = q % 32;
            p0_transpose_item(gin(A, 25) + (size_t)l * 1024 * 1024, 1024, 1024, kb * 64, nb * 32, Wout_t + (size_t)l * 1024 * 1024, (size_t)nb * 32, 1024, scr, lane); continue; }
        r -= I_OUT;
        if (r < I_W1) { const int le = r / 1024, q = r % 1024, kb = q / 64, nb = q % 64, n0 = nb * 32;
            const int np = n0 & 1023; const size_t drow = (size_t)256 * (np >> 7) + (n0 >= 1024 ? 128 : 0) + (np & 127);
            p0_transpose_item(gin(A, 30) + (size_t)le * 1024 * 2048, 2048, 2048, kb * 64, n0, W1_t + (size_t)le * 2048 * 1024, drow, 1024, scr, lane); continue; }
        r -= I_W1;
        { const int le = r / 512, q = r % 512, kb = q / 32, nb = q % 32;
            p0_transpose_item(gin(A, 32) + (size_t)le * 1024 * 1024, 1024, 1024, kb * 64, nb * 32, W2_t + (size_t)le * 1024 * 1024, (size_t)nb * 32, 1024, scr, lane); }
    }
    bf16* HB = (bf16*)(A.ws + WS_HB);
    for (int m = gw; m < T; m += NGW) {
        const int b = m / L, i = m - b * L;
        const float* src = (i < NMETA) ? gin(A, 1) + (size_t)i * D : gin(A, 0) + ((size_t)b * SEQ + (i - NMETA)) * D;
        v4f v[4];
#pragma unroll
        for (int j = 0; j < 4; ++j) v[j] = *(const v4f*)(src + 256 * j + 4 * lane);
        ln_row(v, gin(A, 2), gin(A, 3), lane);
#pragma unroll
        for (int j = 0; j < 4; ++j) st_bf4(HB + (size_t)m * D + 256 * j + 4 * lane, v[j]);
    }
}
constexpr int NTK = 2;
__device__ __forceinline__ float softplus_fast(float x) { return x > 15.f ? x : __logf(1.f + __expf(x)); }
__device__ __forceinline__ float tanh_fast(float x) { return 1.f - 2.f * rcp_(1.f + __expf(2.f * x)); }
__device__ __forceinline__ void sincos_red(float ang, float& sn, float& cs) {
    const float k = rintf(ang * 0.15915494309189535f);
    float r = fmaf(-k, 6.28318548202514648f, ang); r = fmaf(-k, -1.7484555e-7f, r);
    sn = __sinf(r); cs = __cosf(r);
}
constexpr int PREP_W = 98304, PREP_SCR = 4096;
__device__ __forceinline__ void prep_load_w(LAS unsigned char* lds, const float* src, int n, int dst_elem, int tid) {
    for (int i = tid * 4; i < n; i += NTHR * 4) { const v4f x = *(const v4f*)(src + i); v2u o; o.x = pk2(x.x, x.y); o.y = pk2(x.z, x.w); *(LAS v2u*)(lds + (size_t)(dst_elem + i) * 2) = o; }
}
__device__ PHASE_FN void prep_phase(const Ctx A, LAS unsigned char* lds, int l, int vcu, int G) {
    const int tid = opaque_tid(), lane = tid & 63, wave = tid >> 6;
    LAS float* scr = (LAS float*)(lds + PREP_W + wave * PREP_SCR);
    const int gw = vcu * NWAVES + wave, NGW = G * NWAVES;
    const bf16* PROJ = (const bf16*)(A.ws + WS_PROJ);
    const int c4 = 4 * lane, hh = lane >> 4, d4 = 4 * (lane & 15);
    const float* mu = gin(A, 5) + l * 960; const float* w0 = gin(A, 6) + l * 256; const float* w2 = gin(A, 7) + l * 64 * 256;
    const float* a0 = gin(A, 8) + l * 256; const float* a2 = gin(A, 9) + l * 64 * 256; const float* g2 = gin(A, 10) + l * 64 * 256;
    const float* k_k = gin(A, 11) + l * 256; const float* k_a = gin(A, 12) + l * 256; const float* r_k = gin(A, 13) + l * 256;
    const float* conv_w = gin(A, 16) + l * 4 * 256; const float* conv_b = gin(A, 17) + l * 256;
    const float* wa = gin(A, 18) + l * 4 * 64 * 64; const float* ba = gin(A, 19) + l * 256; const float* wx = gin(A, 20) + l * 4 * 64 * 64; const float* bx = gin(A, 21) + l * 256;
    const float* lam = gin(A, 22) + l * 256; const float* lbs = gin(A, 23);
    float* RW_W = (float*)(A.ws + WS_RW_W); bf16* RW_A = (bf16*)(A.ws + WS_RW_A); bf16* RW_B = (bf16*)(A.ws + WS_RW_B); bf16* RW_K = (bf16*)(A.ws + WS_RW_K);
    bf16* RW_WR = (bf16*)(A.ws + WS_RW_WR); bf16* RW_V = (bf16*)(A.ws + WS_RW_V); bf16* RW_G = (bf16*)(A.ws + WS_RW_G); float* RW_SC = (float*)(A.ws + WS_RW_SC);
    bf16* DS_Q = (bf16*)(A.ws + WS_DS_Q); bf16* DS_K = (bf16*)(A.ws + WS_DS_K); bf16* DS_V = (bf16*)(A.ws + WS_DS_V); bf16* DS_QI = (bf16*)(A.ws + WS_DS_QI);
    bf16* DS_KI = (bf16*)(A.ws + WS_DS_KI); float* DS_WI = (float*)(A.ws + WS_DS_WI);
    float* LR_A = (float*)(A.ws + WS_LR_A); bf16* LR_U = (bf16*)(A.ws + WS_LR_U); bf16* LR_G = (bf16*)(A.ws + WS_LR_G);
    float* HG_F = (float*)(A.ws + WS_HG_F); bf16* HG_K = (bf16*)(A.ws + WS_HG_K); bf16* HG_Q = (bf16*)(A.ws + WS_HG_Q); bf16* HG_V = (bf16*)(A.ws + WS_HG_V); bf16* HG_G = (bf16*)(A.ws + WS_HG_G);
    LAS unsigned* kmaxl = (LAS unsigned*)(lds + MISC_OFF + 640);
    LAS unsigned* kimaxl = (LAS unsigned*)(lds + MISC_OFF + 832);
    if (tid < 32) kmaxl[tid] = 0u;
    if (tid < 8) kimaxl[tid] = 0u;
    const bool q_rot = (lane & 15) < 4, q_hi = (lane & 15) >= 2;
    const bool i_rot = (lane & 7) < 2, i_hi = (lane & 7) == 1;

    prep_load_w(lds, w2, 64 * 256, 0, tid); prep_load_w(lds, a2, 64 * 256, 16384, tid); prep_load_w(lds, g2, 64 * 256, 32768, tid);
    __syncthreads();
    unsigned short cs1[NTK + 1][3], ns1[NTK + 1][3]; v2u cs3[NTK + 1][3], ns3[NTK + 1][3];
#define PREP_R_LOAD(S1, S3, grp_) do { const int mm_ = (grp_) * NTK; const int bb_ = mm_ / L; const bool first_ = (mm_ - bb_ * L) == 0; \
        const bf16* Pq_ = PROJ + (size_t)mm_ * NINP; \
        _Pragma("unroll") for (int j = 0; j <= NTK; ++j) { const bf16* row_ = Pq_ + (size_t)(j - 1 + (j == 0 && first_ ? 1 : 0)) * NINP;     \
            S1[j][0] = row_[C_RW_WD + lane]; S1[j][1] = row_[C_RW_AD + lane]; S1[j][2] = row_[C_RW_GD + lane]; \
            S3[j][0] = *(const v2u*)(row_ + C_RW_R + c4); S3[j][1] = *(const v2u*)(row_ + C_RW_K + c4); S3[j][2] = *(const v2u*)(row_ + C_RW_V + c4); } } while (0)
    if (gw < T / NTK) PREP_R_LOAD(cs1, cs3, gw);
#pragma unroll 1
    for (int grp = gw; grp < T / NTK; grp += NGW) {
        const int m0 = grp * NTK, b = m0 / L, i0 = m0 - b * L;
        { const int gn = grp + NGW < T / NTK ? grp + NGW : grp; PREP_R_LOAD(ns1, ns3, gn); }
        {
            const float mu_wd = mu[C_RW_WD + lane], mu_ad = mu[C_RW_AD + lane], mu_gd = mu[C_RW_GD + lane];
            float pwd = i0 > 0 ? bf2f(cs1[0][0]) : 0.f, pad = i0 > 0 ? bf2f(cs1[0][1]) : 0.f, pgd = i0 > 0 ? bf2f(cs1[0][2]) : 0.f;
#pragma unroll
            for (int j = 0; j < NTK; ++j) {
                const float cwd = bf2f(cs1[j + 1][0]), cad = bf2f(cs1[j + 1][1]), cgd = bf2f(cs1[j + 1][2]);
                const float swd = cwd + (pwd - cwd) * mu_wd, sad = cad + (pad - cad) * mu_ad, sgd = cgd + (pgd - cgd) * mu_gd;
                scr[(0 * NTK + j) * 64 + lane] = tanh_fast(swd); scr[(1 * NTK + j) * 64 + lane] = sad; scr[(2 * NTK + j) * 64 + lane] = sigmoidf_(sgd);
                pwd = cwd; pad = cad; pgd = cgd;
            }
            LDS_WAIT();
        }
        v4f lor[3][NTK];
#pragma unroll
        for (int mat = 0; mat < 3; ++mat) {
#pragma unroll
            for (int j = 0; j < NTK; ++j) lor[mat][j] = (v4f){0.f, 0.f, 0.f, 0.f};
            const LAS unsigned char* Wm = lds + mat * 32768 + c4 * 2;
            v2u wA[4], wB[4]; v4f xA[NTK], xB[NTK];
#define PREP_LQ(W_, X_, k_) do { _Pragma("unroll") for (int kk = 0; kk < 4; ++kk) W_[kk] = *(const LAS v2u*)(Wm + ((k_) + kk) * 512); \
                _Pragma("unroll") for (int j = 0; j < NTK; ++j) X_[j] = *(const LAS v4f*)(scr + (mat * NTK + j) * 64 + (k_)); } while (0)
#define PREP_FQ(W_, X_) do { _Pragma("unroll") for (int kk = 0; kk < 4; ++kk) { const v4f ww = (v4f){bflo(W_[kk].x), bfhi(W_[kk].x), bflo(W_[kk].y), bfhi(W_[kk].y)}; \
                _Pragma("unroll") for (int j = 0; j < NTK; ++j) lor[mat][j] += ww * X_[j][kk]; } } while (0)
            PREP_LQ(wA, xA, 0);
#pragma unroll 1
            for (int k = 0; k < 64; k += 8) {
                PREP_LQ(wB, xB, k + 4);
                PREP_FQ(wA, xA);
                PREP_LQ(wA, xA, (k + 8) & 63);
                PREP_FQ(wB, xB);
            }
#undef PREP_LQ
#undef PREP_FQ
        }
        LDS_WAIT();
        {
            const v4f mu_r = *(const v4f*)(mu + C_RW_R + c4), mu_k = *(const v4f*)(mu + C_RW_K + c4), mu_v = *(const v4f*)(mu + C_RW_V + c4);
            const v4f w0v = *(const v4f*)(w0 + c4), a0v = *(const v4f*)(a0 + c4), kkv = *(const v4f*)(k_k + c4), kav = *(const v4f*)(k_a + c4), rkv = *(const v4f*)(r_k + c4);
#define BF4R(q_) ((v4f){bflo((q_).x), bfhi((q_).x), bflo((q_).y), bfhi((q_).y)})
            v4f pr = (v4f){0.f, 0.f, 0.f, 0.f}, pk = pr, pv = pr;
            if (i0 > 0) { pr = BF4R(cs3[0][0]); pk = BF4R(cs3[0][1]); pv = BF4R(cs3[0][2]); }
#pragma unroll
            for (int j = 0; j < NTK; ++j) {
                const v4f cr = BF4R(cs3[j + 1][0]), ck = BF4R(cs3[j + 1][1]), cv = BF4R(cs3[j + 1][2]);
                const v4f rs = cr + (pr - cr) * mu_r, ks = ck + (pk - ck) * mu_k, vs = cv + (pv - cv) * mu_v;
                pr = cr; pk = ck; pv = cv;
                const v4f lw = lor[0][j], la = lor[1][j], lg = lor[2][j];
                v4f dec, av, kkn, km, bv, wr;
                float n2 = 0.f, sbr = 0.f, skr = 0.f, sbo = 0.f;
#pragma unroll
                for (int e = 0; e < 4; ++e) {
                    const float wv = -softplus_fast(-(w0v[e] + lw[e])) - 0.5f;
                    dec[e] = __expf(-__expf(wv));
                    av[e] = sigmoidf_(a0v[e] + la[e]);
                    kkn[e] = ks[e] * kkv[e]; n2 += kkn[e] * kkn[e];
                    km[e] = ks[e] * (1.f + (av[e] - 1.f) * kav[e]);
                }
                n2 = sum16(n2);
                const float inv = rcp_(fmaxf(sqrtf(n2), 1e-12f));
#pragma unroll
                for (int e = 0; e < 4; ++e) { kkn[e] *= inv; bv[e] = kkn[e] * av[e]; wr[e] = dec[e] * rs[e]; sbr += bv[e] * rs[e]; skr += km[e] * rs[e]; sbo += rs[e] * km[e] * rkv[e]; kkn[e] = -kkn[e]; }
                sbr = sum16(sbr); skr = sum16(skr); sbo = sum16(sbo);
                const size_t hm = ((size_t)(b * 4 + hh) * L + (i0 + j)) * 64 + d4;
                *(v4f*)(RW_W + hm) = dec; st_bf4(RW_A + hm, kkn); st_bf4(RW_B + hm, bv); st_bf4(RW_K + hm, km); st_bf4(RW_WR + hm, wr); st_bf4(RW_V + hm, vs);
                st_bf4(RW_G + (size_t)(m0 + j) * 256 + c4, lg);
                if ((lane & 15) == 0) *(v4f*)(RW_SC + ((size_t)(b * 4 + hh) * L + (i0 + j)) * 4) = (v4f){sbr, skr, sbo, 0.f};
            }
        }
#pragma unroll
        for (int j = 0; j <= NTK; ++j) { cs1[j][0] = ns1[j][0]; cs1[j][1] = ns1[j][1]; cs1[j][2] = ns1[j][2]; cs3[j][0] = ns3[j][0]; cs3[j][1] = ns3[j][1]; cs3[j][2] = ns3[j][2]; }
    }
#undef PREP_R_LOAD
    __syncthreads();
    {
        constexpr int XT_PITCH = 528, XT_BYTES = 16 * XT_PITCH, XT_OFF = 65536, LCST_OFF = XT_OFF + NWAVES * XT_BYTES;
        static_assert(LCST_OFF + 3 * 1024 <= MISC_OFF, "pass L lds");
        for (int f = tid; f < 64 * 64; f += NTHR) { const int ln = f & 63, fr = f >> 6, ks = fr & 1, nt = (fr >> 1) & 3, hd = (fr >> 3) & 3, mat = fr >> 5, rr = ln & 15, g8 = ln >> 4;
            const float* W = (mat ? wx : wa) + hd * 4096 + (32 * ks + 8 * g8) * 64 + 16 * nt + rr;
            v4u o; o.x = pk2(W[0], W[64]); o.y = pk2(W[128], W[192]); o.z = pk2(W[256], W[320]); o.w = pk2(W[384], W[448]);
            *(LAS v4u*)(lds + (size_t)fr * 1024 + ln * 16) = o; }
        LAS float* cst = (LAS float*)(lds + LCST_OFF);
        if (tid < 256) { cst[tid] = ba[tid]; cst[256 + tid] = bx[tid];
            const float xs = -lam[tid], ys = __expf(xs);
            cst[512 + tid] = xs > 15.f ? xs : (ys < 0.01f ? ys * (1.f - ys * (0.5f - ys * 0.33333334f)) : __logf(1.f + ys)); }
        __syncthreads();
        LAS unsigned char* xt = lds + XT_OFF + wave * XT_BYTES;
        const int r = lane & 15, g = lane >> 4;
        const v4f cb = *(const v4f*)(conv_b + c4), cw0 = *(const v4f*)(conv_w + c4), cw1 = *(const v4f*)(conv_w + 256 + c4), cw2 = *(const v4f*)(conv_w + 512 + c4), cw3 = *(const v4f*)(conv_w + 768 + c4);
#pragma unroll 1
        for (int tile = gw; tile < T / 16; tile += NGW) {
            const int m0 = tile * 16, b = m0 / L, i0 = m0 - b * L;
            const bf16* Pq = PROJ + (size_t)m0 * NINP;
            v2u xb[19], gr[16];
#pragma unroll
            for (int q = 0; q < 19; ++q) { const int ro = (i0 + q - 3 >= 0) ? q - 3 : 0; xb[q] = *(const v2u*)(Pq + (ptrdiff_t)ro * NINP + C_LR_X + c4); }
#pragma unroll
            for (int t = 0; t < 16; ++t) gr[t] = *(const v2u*)(Pq + (size_t)t * NINP + C_LR_G + c4);
            const v4f z4 = (v4f){0.f, 0.f, 0.f, 0.f};
            v4f x0 = i0 > 0 ? BF4R(xb[0]) : z4, x1 = i0 > 0 ? BF4R(xb[1]) : z4, x2 = i0 > 0 ? BF4R(xb[2]) : z4;
#pragma unroll
            for (int t = 0; t < 16; ++t) {
                const v4f x3 = BF4R(xb[t + 3]);
                const v4f xc = cb + cw0 * x0 + cw1 * x1 + cw2 * x2 + cw3 * x3;
                v2u o; o.x = pk2(xc.x, xc.y); o.y = pk2(xc.z, xc.w);
                *(LAS v2u*)(xt + t * XT_PITCH + c4 * 2) = o;
                x0 = x1; x1 = x2; x2 = x3;
                const v4f gv = BF4R(gr[t]); v4f gg;
#pragma unroll
                for (int e = 0; e < 4; ++e) { const float tt = 0.7978845608028654f * (gv[e] + 0.044715f * gv[e] * gv[e] * gv[e]); gg[e] = 0.5f * gv[e] * (1.f + tanh_fast(tt)); }
                st_bf4(LR_G + (size_t)(m0 + t) * 256 + c4, gg);
            }
            LDS_WAIT();
#pragma unroll 1
            for (int hd = 0; hd < 4; ++hd) {
                const LAS unsigned char* xrow = xt + r * XT_PITCH + hd * 128;
                const pg8::bf16x8 bk0 = *(const LAS pg8::bf16x8*)(xrow + g * 16), bk1 = *(const LAS pg8::bf16x8*)(xrow + 64 + g * 16);
                pg8::f32x4 Ca[4], Cx[4];
#pragma unroll
                for (int nt = 0; nt < 4; ++nt) {
                    const LAS unsigned char* wf = lds + (size_t)((hd * 4 + nt) * 2) * 1024 + lane * 16;
                    const pg8::bf16x8 a0 = *(const LAS pg8::bf16x8*)(wf), a1 = *(const LAS pg8::bf16x8*)(wf + 1024), x0f = *(const LAS pg8::bf16x8*)(wf + 32768), x1f = *(const LAS pg8::bf16x8*)(wf + 32768 + 1024);
                    pg8::f32x4 ca = (pg8::f32x4){0.f, 0.f, 0.f, 0.f}, cx = ca;
                    ca = __builtin_amdgcn_mfma_f32_16x16x32_bf16(a0, bk0, ca, 0, 0, 0); ca = __builtin_amdgcn_mfma_f32_16x16x32_bf16(a1, bk1, ca, 0, 0, 0);
                    cx = __builtin_amdgcn_mfma_f32_16x16x32_bf16(x0f, bk0, cx, 0, 0, 0); cx = __builtin_amdgcn_mfma_f32_16x16x32_bf16(x1f, bk1, cx, 0, 0, 0);
                    Ca[nt] = ca; Cx[nt] = cx;
                }
#pragma unroll
                for (int nt = 0; nt < 4; ++nt) {
                    const int c0 = hd * 64 + 16 * nt + 4 * g;
                    const v4f bav = *(const LAS v4f*)(cst + c0), bxv = *(const LAS v4f*)(cst + 256 + c0), spl = *(const LAS v4f*)(cst + 512 + c0);
                    const v2u xq = *(const LAS v2u*)(xt + r * XT_PITCH + c0 * 2); const v4f xc = BF4R(xq);
                    v4f aa, uu;
#pragma unroll
                    for (int e = 0; e < 4; ++e) { const float rg = sigmoidf_(Ca[nt][e] + bav[e]), ig = sigmoidf_(Cx[nt][e] + bxv[e]);
                        const float la = -8.f * rg * spl[e]; aa[e] = __expf(la);
                        const float x2l = 2.f * la; const float om = (x2l > -0.1f) ? -(x2l * (1.f + x2l * (0.5f + x2l * (0.16666667f + x2l * 0.041666668f)))) : (1.f - __expf(x2l));
                        uu[e] = xc[e] * ig * __builtin_amdgcn_sqrtf(om); }
                    const size_t mo = (size_t)(m0 + r) * 256 + c0;
                    *(v4f*)(LR_A + mo) = aa; st_bf4(LR_U + mo, uu);
                }
            }
        }
    }
    {
        float invf_q[4], invf_i[4];
#pragma unroll
        for (int e = 0; e < 4; ++e) { invf_q[e] = exp2f(-(float)((d4 + e) & 7) * (18.931568569324174f / 8.f)); invf_i[e] = exp2f(-(float)e * (18.931568569324174f / 4.f)); }
        v4f lb = (v4f){0.f, 0.f, 0.f, 0.f};
        if (l == 1) { const v4f x0 = *(const v4f*)(lbs + c4), x1 = *(const v4f*)(lbs + 256 + c4);
            lb.x = 1.f / (1.f + __expf(x0.x - x1.x)); lb.y = 1.f / (1.f + __expf(x0.y - x1.y)); lb.z = 1.f / (1.f + __expf(x0.z - x1.z)); lb.w = 1.f / (1.f + __expf(x0.w - x1.w)); }
#pragma unroll 2
        for (int m = gw; m < T; m += NGW) {
            const int b = m / L, i = m - b * L; const float pos = (float)i;
            const bf16* Pj = PROJ + (size_t)m * NINP;
            v4f q = ld_bf4(Pj + C_DS_Q + c4), k = ld_bf4(Pj + C_DS_K + c4);
            const v4f v = ld_bf4(Pj + C_DS_V + c4);
            v4f qi = ld_bf4(Pj + C_DS_QI + c4), ki = ld_bf4(Pj + C_DS_KI + 4 * (lane & 7));
            const v4f hq = ld_bf4(Pj + C_HG_Q + c4), z = ld_bf4(Pj + C_HG_F + c4), vi = ld_bf4(Pj + C_HG_I + c4), hgt = ld_bf4(Pj + C_HG_G + c4);
#pragma unroll
            for (int e = 0; e < 4; ++e) {
                const float qp = __shfl_xor(q[e], 2), kp = __shfl_xor(k[e], 2), qip = __shfl_xor(qi[e], 1), kip = __shfl_xor(ki[e], 1);
                float sn, cs; sincos_red(pos * invf_q[e], sn, cs);
                if (q_rot) { q[e] = q_hi ? (qp * sn + q[e] * cs) : (q[e] * cs - qp * sn); k[e] = q_hi ? (kp * sn + k[e] * cs) : (k[e] * cs - kp * sn); }
                sincos_red(pos * invf_i[e], sn, cs);
                if (i_rot) { qi[e] = i_hi ? (qip * sn + qi[e] * cs) : (qi[e] * cs - qip * sn); ki[e] = i_hi ? (kip * sn + ki[e] * cs) : (ki[e] * cs - kip * sn); }
            }
            { float kn2 = sum16(k.x * k.x + k.y * k.y + k.z * k.z + k.w * k.w); if ((lane & 15) == 0) __hip_atomic_fetch_max(kmaxl + b * 4 + hh, __float_as_uint(kn2 * 1.02f), __ATOMIC_RELAXED, __HIP_MEMORY_SCOPE_WORKGROUP); }
            st_bf4(DS_Q + (size_t)m * 256 + c4, q * (0.125f * 1.4426950408889634f));      st_bf4(DS_K + (size_t)m * 256 + c4, k); st_bf4(DS_V + (size_t)m * 256 + c4, v); st_bf4(DS_QI + (size_t)m * 256 + c4, qi);
            { float in2 = sum8(ki.x * ki.x + ki.y * ki.y + ki.z * ki.z + ki.w * ki.w); if (lane == 0) __hip_atomic_fetch_max(kimaxl + b, __float_as_uint(in2 * 1.02f), __ATOMIC_RELAXED, __HIP_MEMORY_SCOPE_WORKGROUP); }
            if (lane < 8) { st_bf4(DS_KI + (size_t)m * 32 + 4 * lane, ki); DS_WI[(size_t)m * 8 + lane] = bf2f(Pj[C_DS_WI + lane]) * 0.0625f; }
            v4f qs, f, kq, gs;
#pragma unroll
            for (int e = 0; e < 4; ++e) { const float sg = sigmoidf_(z[e]); qs[e] = hq[e] * sigmoidf_(hq[e]); f[e] = lb[e] + (1.f - lb[e]) * sg; kq[e] = (1.f - lb[e]) * (1.f - sg); gs[e] = hgt[e] * sigmoidf_(hgt[e]); }
            const size_t hm = ((size_t)(b * 4 + hh) * L + i) * 64 + d4;
            *(v4f*)(HG_F + hm) = f; st_bf4(HG_K + hm, kq); st_bf4(HG_Q + hm, qs); st_bf4(HG_V + hm, vi); st_bf4(HG_G + (size_t)m * 256 + c4, gs);
        }
    }
    __syncthreads();
    if (tid < 32) atomicMax((unsigned*)(A.ws + WS_CTL) + 8960 + 64 * l + tid, kmaxl[tid]);
    if (tid < 8) atomicMax((unsigned*)(A.ws + WS_CTL) + 9216 + 64 * l + tid, kimaxl[tid]);
}
constexpr int SC_C = 32;
constexpr size_t WS_YRAW = WS_PROJ;
constexpr size_t WS_ORAW = WS_PROJ + (size_t)T * 1024;
__device__ PHASE_FN void rwkv_scan(const Ctx A, LAS unsigned char* lds, int unit_) {
    const int unit = opaque_s(unit_);
    const int tid = opaque_tid(), row = tid >> 4, kp = tid & 15;
    const int bh = unit >> 1, half = unit & 1, b = bh >> 2, h = bh & 3;
    const size_t base = (size_t)bh * L * 64;
    const float* W = (const float*)(A.ws + WS_RW_W) + base;
    const bf16* Av = (const bf16*)(A.ws + WS_RW_A) + base; const bf16* Bv = (const bf16*)(A.ws + WS_RW_B) + base; const bf16* Kv = (const bf16*)(A.ws + WS_RW_K) + base;
    const bf16* WRv = (const bf16*)(A.ws + WS_RW_WR) + base; const bf16* Vv = (const bf16*)(A.ws + WS_RW_V) + base + half * 32;
    const float* SC = (const float*)(A.ws + WS_RW_SC) + (size_t)bh * L * 4;
    float* YR = (float*)(A.ws + WS_YRAW) + (size_t)b * L * 256 + h * 64 + half * 32;
    constexpr int ARR = SC_C * 64;
    constexpr int BUF = (5 * ARR + SC_C * 32 + SC_C * 4) * 4;
    LAS float* ybuf = (LAS float*)(lds + 2 * BUF);
    float S0 = 0.f, S1 = 0.f, S2 = 0.f, S3 = 0.f;
    v4f rw; v2u ra, rb, rk, rwr, rv; float rsc = 0.f;
    const int e4 = tid * 4;
#define RW_LOAD(c) do { const int t0_ = (c) * SC_C; const bool ok_ = (t0_ + (e4 >> 6)) < L; const size_t o_ = (size_t)t0_ * 64 + e4; \
        rw = ok_ ? *(const v4f*)(W + o_) : (v4f){1.f, 1.f, 1.f, 1.f}; ra = ok_ ? *(const v2u*)(Av + o_) : (v2u){0u, 0u}; rb = ok_ ? *(const v2u*)(Bv + o_) : (v2u){0u, 0u}; \
        rk = ok_ ? *(const v2u*)(Kv + o_) : (v2u){0u, 0u}; rwr = ok_ ? *(const v2u*)(WRv + o_) : (v2u){0u, 0u}; \
        if (tid < SC_C * 8) rv = (t0_ + (tid >> 3)) < L ? *(const v2u*)(Vv + (size_t)(t0_ + (tid >> 3)) * 64 + (tid & 7) * 4) : (v2u){0u, 0u}; \
        if (tid < SC_C * 4) rsc = (t0_ + (tid >> 2)) < L ? SC[(size_t)t0_ * 4 + tid] : 0.f; } while (0)
#define RW_STORE(p) do { LAS float* d_ = (LAS float*)(lds + (p) * BUF); \
        *(LAS v4f*)(d_ + e4) = rw; *(LAS v4f*)(d_ + ARR + e4) = (v4f){bflo(ra.x), bfhi(ra.x), bflo(ra.y), bfhi(ra.y)}; *(LAS v4f*)(d_ + 2 * ARR + e4) = (v4f){bflo(rb.x), bfhi(rb.x), bflo(rb.y), bfhi(rb.y)}; \
        *(LAS v4f*)(d_ + 3 * ARR + e4) = (v4f){bflo(rk.x), bfhi(rk.x), bflo(rk.y), bfhi(rk.y)}; *(LAS v4f*)(d_ + 4 * ARR + e4) = (v4f){bflo(rwr.x), bfhi(rwr.x), bflo(rwr.y), bfhi(rwr.y)}; \
        if (tid < SC_C * 8) *(LAS v4f*)(d_ + 5 * ARR + tid * 4) = (v4f){bflo(rv.x), bfhi(rv.x), bflo(rv.y), bfhi(rv.y)}; if (tid < SC_C * 4) d_[5 * ARR + SC_C * 32 + tid] = rsc; } while (0)
    constexpr int NCH = (L + SC_C - 1) / SC_C;
    RW_LOAD(0); RW_STORE(0); __syncthreads();
#pragma unroll 1
    for (int c = 0; c < NCH; ++c) {
        const int p = c & 1;
        if (c + 1 < NCH) RW_LOAD(c + 1);
        const int ns = (L - c * SC_C) < SC_C ? (L - c * SC_C) : SC_C;
        const LAS float* d = (const LAS float*)(lds + p * BUF);
        const LAS float* q = d + kp * 4; const LAS float* dv = d + 5 * ARR + row; const LAS float* dsc = d + 5 * ARR + SC_C * 32;
        v4f w4 = *(const LAS v4f*)(q), a4 = *(const LAS v4f*)(q + ARR), b4 = *(const LAS v4f*)(q + 2 * ARR), k4 = *(const LAS v4f*)(q + 3 * ARR), r4 = *(const LAS v4f*)(q + 4 * ARR);
        float vv = dv[0]; v2f sc = *(const LAS v2f*)(dsc);
#pragma unroll 2
        for (int s = 0; s < ns; ++s) {
            const int sn = (s + 1 < SC_C) ? s + 1 : s;
            const v4f nw4 = *(const LAS v4f*)(q + sn * 64), na4 = *(const LAS v4f*)(q + ARR + sn * 64), nb4 = *(const LAS v4f*)(q + 2 * ARR + sn * 64);
            const v4f nk4 = *(const LAS v4f*)(q + 3 * ARR + sn * 64), nr4 = *(const LAS v4f*)(q + 4 * ARR + sn * 64);
            const float nvv = dv[sn * 32]; const v2f nsc = *(const LAS v2f*)(dsc + sn * 4);
            float sa = (S0 * a4.x + S1 * a4.y) + (S2 * a4.z + S3 * a4.w), y1 = (S0 * r4.x + S1 * r4.y) + (S2 * r4.z + S3 * r4.w);
            sa = sum16(sa); y1 = sum16(y1);
            S0 = S0 * w4.x + sa * b4.x + vv * k4.x; S1 = S1 * w4.y + sa * b4.y + vv * k4.y; S2 = S2 * w4.z + sa * b4.z + vv * k4.z; S3 = S3 * w4.w + sa * b4.w + vv * k4.w;
            const float yo = y1 + sa * sc.x + vv * sc.y;
            if (kp == 0) ybuf[s * 32 + row] = yo;
            w4 = nw4; a4 = na4; b4 = nb4; k4 = nk4; r4 = nr4; vv = nvv; sc = nsc;
        }
        __syncthreads();
        { const int s = tid >> 4, r2 = (tid & 15) * 2;
          if (s < ns) *(v2f*)(YR + (size_t)(c * SC_C + s) * 256 + r2) = *(const LAS v2f*)(ybuf + s * 32 + r2); }
        if (c + 1 < NCH) RW_STORE(1 - p);
        __syncthreads();
    }
#undef RW_LOAD
#undef RW_STORE
}
__device__ PHASE_FN void hgrn_scan(const Ctx A, LAS unsigned char* lds, int unit_) {
    const int unit = opaque_s(unit_);
    const int tid = opaque_tid(), row = tid >> 4, kp = tid & 15;
    const int bh = unit >> 1, half = unit & 1, b = bh >> 2, h = bh & 3;
    const size_t base = (size_t)bh * L * 64;
    const float* Fv = (const float*)(A.ws + WS_HG_F) + base;
    const bf16* Kv = (const bf16*)(A.ws + WS_HG_K) + base; const bf16* Qv = (const bf16*)(A.ws + WS_HG_Q) + base; const bf16* Vv = (const bf16*)(A.ws + WS_HG_V) + base + half * 32;
    float* OR = (float*)(A.ws + WS_ORAW) + (size_t)b * L * 256 + h * 64 + half * 32;
    constexpr int ARR = SC_C * 64; constexpr int BUF = (3 * ARR + SC_C * 32) * 4;
    LAS float* obuf = (LAS float*)(lds + 2 * BUF);
    float S0 = 0.f, S1 = 0.f, S2 = 0.f, S3 = 0.f;
    v4f rf; v2u rk, rq, rv;
    const int e4 = tid * 4;
#define HG_LOAD(c) do { const int t0_ = (c) * SC_C; const bool ok_ = (t0_ + (e4 >> 6)) < L; const size_t o_ = (size_t)t0_ * 64 + e4; \
        rf = ok_ ? *(const v4f*)(Fv + o_) : (v4f){1.f, 1.f, 1.f, 1.f}; rk = ok_ ? *(const v2u*)(Kv + o_) : (v2u){0u, 0u}; rq = ok_ ? *(const v2u*)(Qv + o_) : (v2u){0u, 0u}; \
        if (tid < SC_C * 8) rv = (t0_ + (tid >> 3)) < L ? *(const v2u*)(Vv + (size_t)(t0_ + (tid >> 3)) * 64 + (tid & 7) * 4) : (v2u){0u, 0u}; } while (0)
#define HG_STORE(p) do { LAS float* d_ = (LAS float*)(lds + (p) * BUF); \
        *(LAS v4f*)(d_ + e4) = rf; *(LAS v4f*)(d_ + ARR + e4) = (v4f){bflo(rk.x), bfhi(rk.x), bflo(rk.y), bfhi(rk.y)}; \
        *(LAS v4f*)(d_ + 2 * ARR + e4) = (v4f){bflo(rq.x), bfhi(rq.x), bflo(rq.y), bfhi(rq.y)}; \
        if (tid < SC_C * 8) *(LAS v4f*)(d_ + 3 * ARR + tid * 4) = (v4f){bflo(rv.x), bfhi(rv.x), bflo(rv.y), bfhi(rv.y)}; } while (0)
    constexpr int NCH = (L + SC_C - 1) / SC_C;
    HG_LOAD(0); HG_STORE(0); __syncthreads();
#pragma unroll 1
    for (int c = 0; c < NCH; ++c) {
        const int p = c & 1;
        if (c + 1 < NCH) HG_LOAD(c + 1);
        const int ns = (L - c * SC_C) < SC_C ? (L - c * SC_C) : SC_C;
        const LAS float* d = (const LAS float*)(lds + p * BUF);
        const LAS float* q = d + kp * 4; const LAS float* dv = d + 3 * ARR + row;
        v4f f4 = *(const LAS v4f*)(q), k4 = *(const LAS v4f*)(q + ARR), q4 = *(const LAS v4f*)(q + 2 * ARR); float vv = dv[0];
#pragma unroll 2
        for (int s = 0; s < ns; ++s) {
            const int sn = (s + 1 < SC_C) ? s + 1 : s;
            const v4f nf4 = *(const LAS v4f*)(q + sn * 64), nk4 = *(const LAS v4f*)(q + ARR + sn * 64), nq4 = *(const LAS v4f*)(q + 2 * ARR + sn * 64);
            const float nvv = dv[sn * 32];
            S0 = S0 * f4.x + k4.x * vv; S1 = S1 * f4.y + k4.y * vv; S2 = S2 * f4.z + k4.z * vv; S3 = S3 * f4.w + k4.w * vv;
            float o = (q4.x * S0 + q4.y * S1) + (q4.z * S2 + q4.w * S3);
            o = sum16(o);
            if (kp == 0) obuf[s * 32 + row] = o;
            f4 = nf4; k4 = nk4; q4 = nq4; vv = nvv;
        }
        __syncthreads();
        { const int s = tid >> 4, r2 = (tid & 15) * 2;
          if (s < ns) *(v2f*)(OR + (size_t)(c * SC_C + s) * 256 + r2) = *(const LAS v2f*)(obuf + s * 32 + r2); }
        if (c + 1 < NCH) HG_STORE(1 - p);
        __syncthreads();
    }
#undef HG_LOAD
#undef HG_STORE
}
__device__ PHASE_FN void mixers_finish(const Ctx A, int l, int vcu, int G) {
    const int tid = opaque_tid(), lane = tid & 63, wave = tid >> 6;
    const int gw = vcu * NWAVES + wave, NGW = G * NWAVES;
    const int c4 = 4 * lane, hh = lane >> 4, d4 = 4 * (lane & 15);
    const float* YR = (const float*)(A.ws + WS_YRAW); const float* OR = (const float*)(A.ws + WS_ORAW);
    const bf16* RV = (const bf16*)(A.ws + WS_RW_V); const float* SC = (const float*)(A.ws + WS_RW_SC); const bf16* RG = (const bf16*)(A.ws + WS_RW_G); const bf16* HGt = (const bf16*)(A.ws + WS_HG_G);
    bf16* MIX = (bf16*)(A.ws + WS_MIX);
    const v4f lg = *(const v4f*)(gin(A, 14) + l * 256 + c4), lb = *(const v4f*)(gin(A, 15) + l * 256 + c4), ng = *(const v4f*)(gin(A, 24) + l * 256 + c4);
#pragma unroll 2
    for (int m = gw; m < T; m += NGW) {
        const int b = m / L, i = m - b * L; const size_t hm = ((size_t)(b * 4 + hh) * L + i);
        const v4f y = *(const v4f*)(YR + (size_t)m * 256 + c4), o = *(const v4f*)(OR + (size_t)m * 256 + c4);
        const v4f vv = ld_bf4(RV + hm * 64 + d4), g = ld_bf4(RG + (size_t)m * 256 + c4), hg = ld_bf4(HGt + (size_t)m * 256 + c4);
        const float bonus = SC[hm * 4 + 2];
        const float mean = sum16((y.x + y.y) + (y.z + y.w)) * (1.f / 64.f); const v4f dy = y - mean;
        const float var = sum16((dy.x * dy.x + dy.y * dy.y) + (dy.z * dy.z + dy.w * dy.w)) * (1.f / 64.f);
        const v4f yn = (dy * rsqrtf(var + 64e-5f) * lg + lb + vv * bonus) * g;
        st_bf4(MIX + (size_t)m * 1024 + c4, yn);
        const float ms = sum16((o.x * o.x + o.y * o.y) + (o.z * o.z + o.w * o.w)) * (1.f / 64.f);
        st_bf4(MIX + (size_t)m * 1024 + 768 + c4, o * rsqrtf(ms + 1e-5f) * ng * hg);
    }
}
constexpr int LR_SEG = 64, LR_NSEG = (L + LR_SEG - 1) / LR_SEG;
constexpr size_t WS_LR_AGG = 2032 * MiB;
constexpr size_t WS_LR_CARRY = WS_LR_AGG + 3 * MiB;
static_assert(WS_LR_CARRY + (size_t)NB * LR_NSEG * 256 * 4 <= WS_END, "lru aggregates");
__device__ PHASE_FN void lru_agg_phase(const Ctx A, int vcu, int G) {
    const int tid = opaque_tid(), lane = tid & 63, wave = tid >> 6;
    const int gw = vcu * NWAVES + wave, NGW = G * NWAVES;
    const float* LA = (const float*)(A.ws + WS_LR_A); const bf16* LU = (const bf16*)(A.ws + WS_LR_U); v2f* AGG = (v2f*)(A.ws + WS_LR_AGG);
#pragma unroll 1
    for (int it = gw; it < NB * LR_NSEG * 4; it += NGW) {
        const int cg = it & 3, q = it >> 2; const bool tail_ = q >= NB * (LR_NSEG - 1);
        const int b = tail_ ? q - NB * (LR_NSEG - 1) : q / (LR_NSEG - 1), sg = tail_ ? LR_NSEG - 1 : q - b * (LR_NSEG - 1), ch = cg * 64 + lane;
        const int t0 = sg * LR_SEG, ns = (L - t0) < LR_SEG ? (L - t0) : LR_SEG;
        const size_t m0 = (size_t)b * L + t0;
        float Ap = 1.f, Hl = 0.f;
#pragma unroll 1
        for (int i = 0; i < ns; i += 16) {
            float a[16], u[16];
#pragma unroll
            for (int j = 0; j < 16; ++j) { a[j] = LA[(m0 + i + j) * 256 + ch]; u[j] = bf2f(LU[(m0 + i + j) * 256 + ch]); }
#pragma unroll
            for (int j = 0; j < 16; ++j) { Hl = a[j] * Hl + u[j]; Ap *= a[j]; }
        }
        AGG[((size_t)b * LR_NSEG + sg) * 256 + ch] = (v2f){Ap, Hl};
    }
}
__device__ PHASE_FN void lru_carry_phase(const Ctx A, int first) {
    const int tid = opaque_tid(), lane = tid & 63, wave = tid >> 6;
    const int w = (opaque_s((int)blockIdx.x) - first) * NWAVES + wave;
    const int b = w >> 2, ch = (w & 3) * 64 + lane;
    const v2f* ag = (const v2f*)(A.ws + WS_LR_AGG) + (size_t)b * LR_NSEG * 256 + ch;
    float* CR = (float*)(A.ws + WS_LR_CARRY) + (size_t)b * LR_NSEG * 256 + ch;
    float hc = 0.f;
#pragma unroll 1
    for (int s0 = 0; s0 < LR_NSEG; s0 += 16) {
        v2f x[16];
#pragma unroll
        for (int j = 0; j < 16; ++j) { const int s = s0 + j < LR_NSEG ? s0 + j : LR_NSEG - 1; x[j] = ag[(size_t)s * 256]; }
#pragma unroll
        for (int j = 0; j < 16; ++j) if (s0 + j < LR_NSEG) { CR[(size_t)(s0 + j) * 256] = hc; hc = x[j].x * hc + x[j].y; }
    }
}
__device__ PHASE_FN void lru_out_phase(const Ctx A, int vcu, int G) {
    const int tid = opaque_tid(), lane = tid & 63, wave = tid >> 6;
    const int gw = vcu * NWAVES + wave, NGW = G * NWAVES;
    const float* LA = (const float*)(A.ws + WS_LR_A); const bf16* LU = (const bf16*)(A.ws + WS_LR_U); const bf16* LG = (const bf16*)(A.ws + WS_LR_G);
    const float* CR = (const float*)(A.ws + WS_LR_CARRY); bf16* MIX = (bf16*)(A.ws + WS_MIX);
#pragma unroll 1
    for (int it = gw; it < NB * LR_NSEG * 4; it += NGW) {
        const int cg = it & 3, q = it >> 2; const bool tail_ = q >= NB * (LR_NSEG - 1);
        const int b = tail_ ? q - NB * (LR_NSEG - 1) : q / (LR_NSEG - 1), sg = tail_ ? LR_NSEG - 1 : q - b * (LR_NSEG - 1), ch = cg * 64 + lane;
        const int t0 = sg * LR_SEG, ns = (L - t0) < LR_SEG ? (L - t0) : LR_SEG;
        const size_t m0 = (size_t)b * L + t0;
        float hc = CR[((size_t)b * LR_NSEG + sg) * 256 + ch];
#pragma unroll 1
        for (int i = 0; i < ns; i += 16) {
            float a[16], u[16], g[16];
#pragma unroll
            for (int j = 0; j < 16; ++j) { a[j] = LA[(m0 + i + j) * 256 + ch]; u[j] = bf2f(LU[(m0 + i + j) * 256 + ch]); g[j] = bf2f(LG[(m0 + i + j) * 256 + ch]); }
#pragma unroll
            for (int j = 0; j < 16; ++j) { hc = a[j] * hc + u[j]; MIX[(m0 + i + j) * 1024 + 512 + ch] = f2bf(hc * g[j]); }
        }
    }
}
static_assert(L % 16 == 0, "lru step groups");
constexpr int DSA_WBYTES = 34944;
constexpr int DSA_NW = 4;
__device__ __forceinline__ unsigned fkey(float f) { const unsigned u = __float_as_uint(f); return (u & 0x80000000u) ? ~u : (u | 0x80000000u); }
__device__ __forceinline__ void dsa_query(const Ctx A, LAS unsigned char* wl, int b, int i, int lane) {
    const bf16* DQ = (const bf16*)(A.ws + WS_DS_Q); const bf16* DK = (const bf16*)(A.ws + WS_DS_K); const bf16* DV = (const bf16*)(A.ws + WS_DS_V);
    const bf16* DQI = (const bf16*)(A.ws + WS_DS_QI); const bf16* DKI = (const bf16*)(A.ws + WS_DS_KI); const float* DWI = (const float*)(A.ws + WS_DS_WI);
    bf16* MIX = (bf16*)(A.ws + WS_HB);
    LAS unsigned* keys = (LAS unsigned*)wl; LAS float* qv = (LAS float*)(wl + 32896); LAS int* sel = (LAS int*)(wl + 32896 + 1024);
    const size_t m = (size_t)b * L + i, mb = (size_t)b * L;
    const int n = i + 1;
    LAS float* wil = (LAS float*)(wl + 32832);
    { const v4f q4 = ld_bf4(DQI + m * 256 + 4 * lane); *(LAS v4f*)(qv + 4 * lane) = q4; if (lane < 8) wil[lane] = DWI[m * 8 + lane]; }
    LDS_WAIT();
    for (int s = lane; s < n; s += 64) {
        const v4u* kp = (const v4u*)(DKI + (mb + s) * 32);
        float kf[32];
#pragma unroll
        for (int c = 0; c < 4; ++c) { const v4u x = kp[c]; kf[8 * c + 0] = bflo(x.x); kf[8 * c + 1] = bfhi(x.x); kf[8 * c + 2] = bflo(x.y); kf[8 * c + 3] = bfhi(x.y); kf[8 * c + 4] = bflo(x.z); kf[8 * c + 5] = bfhi(x.z); kf[8 * c + 6] = bflo(x.w); kf[8 * c + 7] = bfhi(x.w); }
        float sc = 0.f;
#pragma unroll 1
        for (int hx = 0; hx < 8; ++hx) { float dt = 0.f;
#pragma unroll
            for (int c = 0; c < 8; ++c) { const v4f q4 = *(const LAS v4f*)(qv + hx * 32 + 4 * c); dt += q4.x * kf[4 * c] + q4.y * kf[4 * c + 1] + q4.z * kf[4 * c + 2] + q4.w * kf[4 * c + 3]; }
            sc += wil[hx] * fmaxf(dt, 0.f); }
        keys[s] = fkey(sc);
    }
    LDS_WAIT();
    unsigned thr = 0u; int need = 0;
    if (n > 256) {
        unsigned prefix = 0u; need = 256;
#pragma unroll 1
        for (int shift = 28; shift >= 0; shift -= 4) {
            unsigned long long lo = 0ull, hi = 0ull;
            const unsigned himask = (shift == 28) ? 0u : (0xFFFFFFFFu << (shift + 4));
            for (int s = lane; s < n; s += 64) { const unsigned k = keys[s];
                if ((k & himask) == prefix) { const unsigned dg = (k >> shift) & 15u; const unsigned long long inc = 1ull << ((dg & 7u) * 8u); if (dg < 8u) lo += inc; else hi += inc; } }
            int cum = 0; unsigned dsel = 0u; int below = 0; bool found = false;
#pragma unroll
            for (int dg = 15; dg >= 0; --dg) {
                const unsigned mine = (unsigned)(((dg < 8 ? lo : hi) >> ((dg & 7) * 8)) & 0xFFull);
                int tot = (int)mine;
#pragma unroll
                for (int o = 1; o < 64; o <<= 1) tot += __shfl_xor(tot, o);
                if (!found && cum + tot >= need) { found = true; dsel = (unsigned)dg; below = cum; }
                cum += tot;
            }
            prefix |= dsel << shift; need -= below;
        }
        thr = prefix;
    }
    int cnt = 0;
    if (n <= 256) { for (int s = lane; s < n; s += 64) sel[s] = s; cnt = n; }
    else {
        int eq_taken = 0;
        for (int s0 = 0; s0 < n; s0 += 64) { const int s = s0 + lane; const unsigned k = (s < n) ? keys[s] : 0u; const bool in = s < n;
            const bool gt = in && (k > thr), eq = in && (k == thr);
            const unsigned long long meq = __ballot(eq); const int eq_before = __popcll(meq & ((1ull << lane) - 1ull));
            const bool take = gt || (eq && (eq_taken + eq_before) < need);
            const unsigned long long mt = __ballot(take); const int pos = cnt + __popcll(mt & ((1ull << lane) - 1ull));
            if (take && pos < 256) sel[pos] = s;
            cnt += __popcll(mt); eq_taken += __popcll(meq);
        }
        if (cnt > 256) cnt = 256;
    }
    LDS_WAIT();
    LAS float* pbuf = (LAS float*)wl;
    for (int h = 0; h < 4; ++h) {
        { const float qx = bf2f(DQ[m * 256 + h * 64 + lane]); qv[lane] = qx * 0.125f; }
        LDS_WAIT();
        float sj[4]; float mx = -3.0e38f;
#pragma unroll
        for (int r = 0; r < 4; ++r) { const int j = lane + 64 * r; sj[r] = -3.0e38f;
            if (j < cnt) { const int s = sel[j]; const v4u* kp = (const v4u*)(DK + (mb + s) * 256 + h * 64); float dt = 0.f;
#pragma unroll
                for (int c = 0; c < 8; ++c) { const v4u x = kp[c]; const v4f q0 = *(const LAS v4f*)(qv + 8 * c), q1 = *(const LAS v4f*)(qv + 8 * c + 4);
                    dt += q0.x * bflo(x.x) + q0.y * bfhi(x.x) + q0.z * bflo(x.y) + q0.w * bfhi(x.y) + q1.x * bflo(x.z) + q1.y * bfhi(x.z) + q1.z * bflo(x.w) + q1.w * bfhi(x.w); }
                sj[r] = dt; mx = fmaxf(mx, dt); } }
        mx = wave_max(mx);
        float sum = 0.f;
#pragma unroll
        for (int r = 0; r < 4; ++r) { const int j = lane + 64 * r; const float p = (j < cnt) ? __expf(sj[r] - mx) : 0.f; sum += p; pbuf[j] = p; }
        sum = wave_sum(sum);
        LDS_WAIT();
        float o = 0.f;
        for (int j = 0; j < cnt; ++j) { const int s = sel[j]; o += pbuf[j] * bf2f(DV[(mb + s) * 256 + h * 64 + lane]); }
        MIX[m * 1024 + 256 + h * 64 + lane] = f2bf(o / sum);
        LDS_WAIT();
    }
}
__device__ PHASE_FN void dsa_phase(const Ctx A, LAS unsigned char* lds, int l) {
    const int tid = opaque_tid(), lane = tid & 63, wave = tid >> 6;
    if (wave >= DSA_NW) return;
    unsigned* qhead = (unsigned*)(A.ws + WS_CTL) + CW_DSAQ + 64 * l;
    LAS unsigned char* wl = lds + wave * DSA_WBYTES;
    for (;;) {
        unsigned it = 0u;
        if (lane == 0) it = atomicAdd(qhead, 1u);
        it = __builtin_amdgcn_readfirstlane(it);
        if (it >= (unsigned)T) break;
        const int i = L - 1 - (int)(it >> 3), b = (int)(it & 7u);
        dsa_query(A, wl, b, i, lane);
    }
}
static_assert(DSA_NW * DSA_WBYTES <= MISC_OFF, "dsa lds");
typedef short s8 __attribute__((ext_vector_type(8)));
typedef short v4i16_t __attribute__((ext_vector_type(4)));
typedef unsigned u16v __attribute__((ext_vector_type(16)));
typedef unsigned long long u64;
constexpr int NQT16 = L / 16;
constexpr int NKB32 = (L + 31) / 32;
constexpr int MASK_PB = 66112;
constexpr size_t MASK_LAYER = (size_t)NB * MASK_PB * 64;
constexpr size_t WS_MASK = 1956 * MiB;
static_assert(WS_MASK >= WS_MIX_END && WS_MASK + 2 * MASK_LAYER + 256 <= 2032 * MiB, "mask region");
__device__ __forceinline__ size_t mask_row(int l, int b, int qt) { const int a = qt >> 1; return (size_t)l * (NB * MASK_PB) + (size_t)b * MASK_PB + ((qt & 1) ? (a + 1) * (a + 1) : a * (a + 1)); }
constexpr int CW_KMAX = 8960;
constexpr int CW_KIMAX = 9216;
constexpr int MI_KMAX = 640, MI_UNIT = 768, MI_KIMAX = 832;
constexpr int SEL_PF = 3;
constexpr int SEL_HROW = 259;

__device__ __forceinline__ void sel_scores(const s8 a1, const s8 a2, const s8 (&qb)[9], const float (&wv)[8], pg8::f32x4& i1, pg8::f32x4& i2) {
    const pg8::f32x4 z = (pg8::f32x4){0.f, 0.f, 0.f, 0.f};
    i1 = __builtin_amdgcn_mfma_f32_16x16x32_bf16(a1, qb[8], z, 0, 0, 0); i2 = __builtin_amdgcn_mfma_f32_16x16x32_bf16(a2, qb[8], z, 0, 0, 0);
#pragma unroll
    for (int h = 0; h < 8; ++h) {
        const pg8::f32x4 c1 = __builtin_amdgcn_mfma_f32_16x16x32_bf16(a1, qb[h], z, 0, 0, 0), c2 = __builtin_amdgcn_mfma_f32_16x16x32_bf16(a2, qb[h], z, 0, 0, 0);
#pragma unroll
        for (int j = 0; j < 4; ++j) { float t1 = fmaf(fabsf(c1[j]), wv[h], i1[j]), t2 = fmaf(fabsf(c2[j]), wv[h], i2[j]);
            asm("" : "+v"(t1)); asm("" : "+v"(t2)); i1[j] = t1; i2[j] = t2; }
    }
}
template <int MODE, bool DIAG>
__device__ __forceinline__ void sel_block(const s8 a1, const s8 a2, const s8 (&qb)[9], const float (&wv)[8], int kb, int tq, int r, int g, int lane,
                                          LAS unsigned* hrow, float sc_mul, float sc_add, u64* mrow) {
    pg8::f32x4 i1, i2; sel_scores(a1, a2, qb, wv, i1, i2);
    const int s0 = kb * 32 + 8 * g;
    u64 wds[8];
#pragma unroll
    for (int j = 0; j < 8; ++j) {
        const float sc = j < 4 ? i1[j & 3] : i2[j & 3];
        if (MODE == 3) { if (sc == 123456.789f) hrow[256] = 1u; }
        else if (MODE == 2) { wds[j] = DIAG ? __ballot((s0 + j) <= tq && sc >= sc_add) : __ballot(sc >= sc_add); }
        else { int xi = (int)__builtin_floorf(fmaf(sc, sc_mul, sc_add));
            unsigned bin = MODE == 0 ? (unsigned)min(max(xi, 0), 255) : (unsigned)(min(max(xi, -1), 256) + 1);
            if (DIAG) bin = ((s0 + j) <= tq) ? bin : (MODE == 0 ? 256u : 0u);
            if (MODE == 0 || bin != 0u) __hip_atomic_fetch_add(hrow + bin, 1u, __ATOMIC_RELAXED, __HIP_MEMORY_SCOPE_WORKGROUP); }
    }
    if (MODE == 2 && lane == 0) { u64* d = mrow + (size_t)kb * 8;
#pragma unroll
        for (int j = 0; j < 8; j += 2) { v4u o; o.x = (unsigned)wds[j]; o.y = (unsigned)(wds[j] >> 32); o.z = (unsigned)wds[j + 1]; o.w = (unsigned)(wds[j + 1] >> 32); *(v4u*)(d + j) = o; } }
}
template <int MODE>
__device__ __forceinline__ void sel_pass(const bf16* KIb, const s8 (&qb)[9], const float (&wv)[8], int nkb, int tq, int r, int g, int lane,
                                         LAS unsigned* hrow, float sc_mul, float sc_add, u64* mrow, int kb_first = 0, int kb_step = 1) {
    const bf16* kp = KIb + (size_t)(8 * (r >> 2) + (r & 3)) * 32 + 8 * g;
    v4u cur[2 * SEL_PF], nxt[2 * SEL_PF];
#pragma unroll
    for (int i = 0; i < SEL_PF; ++i) { const size_t kb = kb_first + i * kb_step; cur[2 * i] = *(const v4u*)(kp + kb * 1024); cur[2 * i + 1] = *(const v4u*)(kp + kb * 1024 + 128); }
#pragma unroll 1
    for (int kb0 = kb_first; kb0 < nkb; kb0 += SEL_PF * kb_step) {
#pragma unroll
        for (int i = 0; i < SEL_PF; ++i) { const size_t kb = kb0 + (SEL_PF + i) * kb_step; nxt[2 * i] = *(const v4u*)(kp + kb * 1024); nxt[2 * i + 1] = *(const v4u*)(kp + kb * 1024 + 128); }
#pragma unroll
        for (int i = 0; i < SEL_PF; ++i) { const int kb = kb0 + i * kb_step;
            if (kb < nkb - 1) sel_block<MODE, false>(__builtin_bit_cast(s8, cur[2 * i]), __builtin_bit_cast(s8, cur[2 * i + 1]), qb, wv, kb, tq, r, g, lane, hrow, sc_mul, sc_add, mrow);
            else if (kb == nkb - 1) sel_block<MODE, true>(__builtin_bit_cast(s8, cur[2 * i]), __builtin_bit_cast(s8, cur[2 * i + 1]), qb, wv, kb, tq, r, g, lane, hrow, sc_mul, sc_add, mrow); }
#pragma unroll
        for (int i = 0; i < 2 * SEL_PF; ++i) cur[i] = nxt[i];
    }
}
__device__ __forceinline__ void sel_scan(const LAS unsigned* hrow, int need, int& sel, int& above) {
    int cum = 0; sel = 0; above = 0; bool found = false;
#pragma unroll 8
    for (int bin = 255; bin >= 0; --bin) { const int c = (int)hrow[bin];
        if (!found && cum + c >= need) { found = true; sel = bin; above = cum; }
        cum += c; }
}
__device__ PHASE_FN void dsa_select_phase(const Ctx A, LAS unsigned char* lds, int l) {
    const int tid = opaque_tid(), lane = tid & 63, wave = tid >> 6, r = lane & 15, g = lane >> 4;
    const bf16* DQI = (const bf16*)(A.ws + WS_DS_QI); const bf16* DKI = (const bf16*)(A.ws + WS_DS_KI); const float* DWI = (const float*)(A.ws + WS_DS_WI);
    u64* MASK = (u64*)(A.ws + WS_MASK);
    unsigned* qhead = (unsigned*)(A.ws + WS_CTL) + CW_DSAQ + 64 * l;
    const unsigned* kimaxw = (const unsigned*)(A.ws + WS_CTL) + CW_KIMAX + 64 * l;
    LAS unsigned* hist = (LAS unsigned*)(lds + wave * (16 * SEL_HROW * 4));
    LAS unsigned* hrow = hist + r * SEL_HROW;
    for (;;) {
        unsigned it = 0u;
        if (lane == 0) it = atomicAdd(qhead, 1u);
        it = __builtin_amdgcn_readfirstlane(it);
        if (it >= (unsigned)(NB * NQT16)) break;
        const int qt = NQT16 - 1 - (int)(it >> 3), b = (int)(it & 7u);
        const size_t mb = (size_t)b * L, m0 = mb + (size_t)qt * 16;
        const int tq = qt * 16 + r, nkb = ((qt * 16 + 15) >> 5) + 1;
        s8 qb[9]; float wv[8];
#pragma unroll
        for (int h = 0; h < 8; ++h) qb[h] = *(const s8*)(DQI + (m0 + r) * 256 + h * 32 + 8 * g);
        { const v4f w0 = *(const v4f*)(DWI + (m0 + r) * 8), w1 = *(const v4f*)(DWI + (m0 + r) * 8 + 4);
          wv[0] = w0.x; wv[1] = w0.y; wv[2] = w0.z; wv[3] = w0.w; wv[4] = w1.x; wv[5] = w1.y; wv[6] = w1.z; wv[7] = w1.w; }
        float bq = 0.f;
        { float ql[8];
#pragma unroll
          for (int e = 0; e < 8; ++e) ql[e] = 0.f;
#pragma unroll
          for (int h = 0; h < 8; ++h) { float n2 = 0.f;
#pragma unroll
              for (int e = 0; e < 8; ++e) { const float x = bf2f((unsigned short)qb[h][e]); ql[e] += wv[h] * x; n2 += x * x; }
              n2 += __shfl_xor(n2, 16); n2 += __shfl_xor(n2, 32); bq += fabsf(wv[h]) * sqrtf(n2); }
          v4u pk; pk.x = pk2(ql[0], ql[1]); pk.y = pk2(ql[2], ql[3]); pk.z = pk2(ql[4], ql[5]); pk.w = pk2(ql[6], ql[7]); qb[8] = __builtin_bit_cast(s8, pk); }
        const bf16* KIb = DKI + mb * 32;
        float thr_f = -__builtin_inff();
        if (qt * 16 + 15 >= 256) {
            const float kim = sqrtf(__uint_as_float(__hip_atomic_load(kimaxw + b, __ATOMIC_RELAXED, __HIP_MEMORY_SCOPE_AGENT)));
            const float R = fmaxf(2.06f * bq * kim, 1e-30f), s0 = 128.f / R, w0 = R * (1.f / 128.f);
            const int n = tq + 1;
            bool done = false;
            if (qt * 16 >= 2048) {
                for (int i = lane; i < 16 * SEL_HROW; i += 64) hist[i] = 0u;
                LDS_WAIT();
                sel_pass<0>(KIb, qb, wv, nkb - 1, tq, r, g, lane, hrow, s0, 128.f, nullptr, 3, 8);
                LDS_WAIT();
                const int ns = 32 * ((nkb - 1 - 3 + 7) >> 3);
                const float rho = 256.f * (float)ns / (float)n, dev = 4.f * sqrtf(rho) + 2.f;
                int bl, ab; sel_scan(hrow, (int)(rho + dev) + 1, bl, ab);
                int bh = 255, ab2 = 0; const int rhi = (int)(rho - dev);
                if (rhi >= 1) sel_scan(hrow, rhi, bh, ab2);
                LDS_WAIT();
                const float lo = -R + (float)bl * w0, hi = (rhi >= 1) ? (-R + (float)(bh + 1) * w0) : (R * 1.001f);
                const float s1 = 256.f / (hi - lo);
                for (int i = lane; i < 16 * SEL_HROW; i += 64) hist[i] = 0u;
                LDS_WAIT();
                sel_pass<1>(KIb, qb, wv, nkb, tq, r, g, lane, hrow, s1, -lo * s1, nullptr);
                LDS_WAIT();
                const int above = (int)hrow[257]; int inr = 0;
#pragma unroll 8
                for (int bin = 1; bin <= 256; ++bin) inr += (int)hrow[bin];
                const bool ok = above < 256 && above + inr >= 256;
                if (ok) { int sel1, ab1; sel_scan(hrow + 1, 256 - above, sel1, ab1); thr_f = lo + (float)sel1 * ((hi - lo) * (1.f / 256.f)); }
                LDS_WAIT();
                done = __all(ok);
            }
            if (!done) {
                for (int i = lane; i < 16 * SEL_HROW; i += 64) hist[i] = 0u;
                LDS_WAIT();
                sel_pass<0>(KIb, qb, wv, nkb, tq, r, g, lane, hrow, s0, 128.f, nullptr);
                LDS_WAIT();
                int sel0, above0; sel_scan(hrow, 256, sel0, above0);
                LDS_WAIT();
                const float lo0 = -R + (float)sel0 * w0, s1 = 256.f / w0;
                for (int i = lane; i < 16 * SEL_HROW; i += 64) hist[i] = 0u;
                LDS_WAIT();
                sel_pass<1>(KIb, qb, wv, nkb, tq, r, g, lane, hrow, s1, -lo0 * s1, nullptr);
                LDS_WAIT();
                int sel1, above1; sel_scan(hrow + 1, 256 - above0, sel1, above1);
                LDS_WAIT();
                thr_f = lo0 + (float)sel1 * (w0 * (1.f / 256.f));
            }
            if (n <= 256) thr_f = -__builtin_inff();
        }
        sel_pass<2>(KIb, qb, wv, nkb, tq, r, g, lane, hrow, 0.f, thr_f, MASK + mask_row(l, b, qt) * 8);
    }
}

constexpr int AT_ROW = 144;
constexpr int AT_TILE = 64 * AT_ROW;
constexpr int AT_NQT = (L - 16) / 256;
constexpr int AT_NKT = (L + 63) / 64;
static_assert(16 + AT_NQT * 256 == L, "query tiling");
__device__ PHASE_FN void dsa_attn_phase(const Ctx A, LAS unsigned char* lds, int l) {
    const int tid = opaque_tid(), lane = tid & 63, wave = tid >> 6, r = lane & 15, g = lane >> 4;
    const bf16* DQ = (const bf16*)(A.ws + WS_DS_Q); const bf16* DK = (const bf16*)(A.ws + WS_DS_K); const bf16* DV = (const bf16*)(A.ws + WS_DS_V);
    const u64* MASK = (const u64*)(A.ws + WS_MASK); bf16* MIX = (bf16*)(A.ws + WS_MIX);
    unsigned* qhead = (unsigned*)(A.ws + WS_CTL) + CW_DSAQ + 64 * l + 16;
    const unsigned* kmaxw = (const unsigned*)(A.ws + WS_CTL) + CW_KMAX + 64 * l;
    LAS unsigned* unitw = (LAS unsigned*)(lds + MISC_OFF + MI_UNIT);
    const int ldkey = tid >> 3, ldch = tid & 7;
    for (;;) {
        __syncthreads();
        if (tid == 0) unitw[0] = atomicAdd(qhead, 1u);
        __syncthreads();
        const unsigned u = unitw[0];
        if (u >= (unsigned)(NB * 4 * (AT_NQT + 1))) break;
        const bool mini = u >= (unsigned)(NB * 4 * AT_NQT);
        const int qt = mini ? 0 : AT_NQT - 1 - (int)(u >> 5), b = (int)((u & 31u) >> 2), h = (int)(u & 3u);
        const size_t mb = (size_t)b * L;
        const int kmain = mini ? 0 : 4 * qt;
        const int nkt = mini ? 1 : ((4 * qt + 5 < AT_NKT) ? 4 * qt + 5 : AT_NKT);
        const float kmax2 = __uint_as_float(__hip_atomic_load(kmaxw + b * 4 + h, __ATOMIC_RELAXED, __HIP_MEMORY_SCOPE_AGENT));
        int tq[2], lb[2]; bool act[2];
        s8 qf[2][2]; float nc2[2];
        const GAS unsigned* mrow[2];
#pragma unroll
        for (int qi = 0; qi < 2; ++qi) { act[qi] = mini ? (wave == 0 && qi == 0) : true; tq[qi] = mini ? 0 : 16 + qt * 256 + wave * 32 + 16 * qi;
            lb[qi] = __builtin_amdgcn_readfirstlane(act[qi] ? ((tq[qi] + 15) >> 5) : -1);
            float qn2 = 0.f;
#pragma unroll
            for (int ks = 0; ks < 2; ++ks) { qf[qi][ks] = act[qi] ? *(const s8*)(DQ + (mb + tq[qi] + r) * 256 + h * 64 + 32 * ks + 8 * g) : (s8){0, 0, 0, 0, 0, 0, 0, 0};
#pragma unroll
                for (int e = 0; e < 8; ++e) { const float x = bf2f((unsigned short)qf[qi][ks][e]); qn2 += x * x; } }
            qn2 += __shfl_xor(qn2, 16); qn2 += __shfl_xor(qn2, 32);
            nc2[qi] = -sqrtf(qn2 * kmax2);
            const u64 mrow_u = (u64)(MASK + mask_row(l, b, tq[qi] >> 4) * 8);
            const unsigned lo = (unsigned)__builtin_amdgcn_readfirstlane((unsigned)mrow_u), hi = (unsigned)__builtin_amdgcn_readfirstlane((unsigned)(mrow_u >> 32));
            mrow[qi] = (const GAS unsigned*)(((u64)hi << 32) | (u64)lo); }
        pg8::f32x4 O[2][4], Ls[2];
#pragma unroll
        for (int qi = 0; qi < 2; ++qi) { Ls[qi] = (pg8::f32x4){0.f, 0.f, 0.f, 0.f};
#pragma unroll
            for (int db = 0; db < 4; ++db) O[qi][db] = (pg8::f32x4){0.f, 0.f, 0.f, 0.f}; }
        const s8 ones8 = (s8){0x3F80, 0x3F80, 0x3F80, 0x3F80, 0x3F80, 0x3F80, 0x3F80, 0x3F80};
#define AT_SLOAD(dst, qi_, kb_) asm volatile("s_load_dwordx16 %0, %1, 0x0" : "=s"(dst) : "s"(mrow[qi_] + (size_t)(kb_) * 16))
#define AT_MWAIT(m0_, m1_) asm volatile("s_waitcnt lgkmcnt(0)" : "+s"(m0_), "+s"(m1_))
#define AT_MWAIT_S2(a0_, a1_, b0_, b1_) asm volatile("s_waitcnt lgkmcnt(0)" : "+s"(a0_), "+s"(a1_), "+s"(b0_), "+s"(b1_), "+v"(Sa), "+v"(Sb), "+v"(Sc), "+v"(Sd), "+v"(Se), "+v"(Sf), "+v"(Sg), "+v"(Sh) :: "memory")
#define AT_MWAIT_O(a0_, a1_, b0_, b1_) asm volatile("s_waitcnt lgkmcnt(0)" : "+s"(a0_), "+s"(a1_), "+s"(b0_), "+s"(b1_), "+v"(O[1][0]), "+v"(O[1][1]), "+v"(O[1][2]), "+v"(O[1][3]), "+v"(Ls[1]) :: "memory")
        const bf16* kg = DK + (mb + ldkey) * 256 + h * 64 + ldch * 8; const bf16* vg = DV + (mb + ldkey) * 256 + h * 64 + ldch * 8;
        v4u rk0 = *(const v4u*)kg, rv0 = *(const v4u*)vg;
        const size_t to1 = (size_t)(nkt > 1 ? 1 : nkt - 1) * 64 * 256, to2 = (size_t)(nkt > 2 ? 2 : nkt - 1) * 64 * 256, to3 = (size_t)(nkt > 3 ? 3 : nkt - 1) * 64 * 256;
        v4u rk1 = *(const v4u*)(kg + to1), rv1 = *(const v4u*)(vg + to1), rk2 = *(const v4u*)(kg + to2), rv2 = *(const v4u*)(vg + to2), rk3 = *(const v4u*)(kg + to3), rv3 = *(const v4u*)(vg + to3);
        u16v m0, m1, n0, n1;
#define AT_STORE(boff, rk, rv) do { LAS unsigned char* kb_ = lds + (boff); LAS unsigned char* vb_ = kb_ + AT_TILE; \
            *(LAS v4u*)(kb_ + ldkey * AT_ROW + ldch * 16) = rk; *(LAS v4u*)(vb_ + ldkey * AT_ROW + ldch * 16) = rv; } while (0)
#define AT_LOAD(kt_, rk, rv) do { rk = *(const v4u*)(kg + (size_t)(kt_) * 64 * 256); rv = *(const v4u*)(vg + (size_t)(kt_) * 64 * 256); } while (0)
#define AT_KREAD(boff, blk) do { const LAS unsigned char* ka = lds + (boff) + ((blk) * 32 + 8 * (r >> 2) + (r & 3)) * AT_ROW + g * 16; \
            _Pragma("unroll") for (int ks = 0; ks < 2; ++ks) { kf[blk][ks][0] = *(const LAS s8*)(ka + ks * 64); kf[blk][ks][1] = *(const LAS s8*)(ka + 4 * AT_ROW + ks * 64); } } while (0)
#define AT_VREAD(boff, blk) do { const LAS unsigned char* va = lds + (boff) + AT_TILE + ((blk) * 32 + 8 * g + (r >> 2)) * AT_ROW + (r & 3) * 8; \
            _Pragma("unroll") for (int db = 0; db < 4; ++db) { \
                const v4i16_t x0 = __builtin_amdgcn_ds_read_tr16_b64_v4i16((LAS v4i16_t*)(va + db * 32)), x1 = __builtin_amdgcn_ds_read_tr16_b64_v4i16((LAS v4i16_t*)(va + 4 * AT_ROW + db * 32)); \
                vf[blk][db] = (s8){x0[0], x0[1], x0[2], x0[3], x1[0], x1[1], x1[2], x1[3]}; } } while (0)
#define AT_BLK_S(blk, qi, S1, S2) do { S1 = (pg8::f32x4){nc2[qi], nc2[qi], nc2[qi], nc2[qi]}; S2 = S1; \
            _Pragma("unroll") for (int ks = 0; ks < 2; ++ks) { \
                S1 = __builtin_amdgcn_mfma_f32_16x16x32_bf16(kf[blk][ks][0], qf[qi][ks], S1, 0, 0, 0); S2 = __builtin_amdgcn_mfma_f32_16x16x32_bf16(kf[blk][ks][1], qf[qi][ks], S2, 0, 0, 0); } } while (0)
#define AT_BLK_P(mq, S1, S2, pa) do { float p[8]; \
            _Pragma("unroll") for (int j = 0; j < 8; ++j) { \
                const bool bit = __builtin_amdgcn_inverse_ballot_w64(((u64)mq[2 * j + 1] << 32) | mq[2 * j]); \
                p[j] = bit ? __builtin_amdgcn_exp2f(j < 4 ? S1[j & 3] : S2[j & 3]) : 0.f; } \
            v4u pk; pk.x = pk2(p[0], p[1]); pk.y = pk2(p[2], p[3]); pk.z = pk2(p[4], p[5]); pk.w = pk2(p[6], p[7]); \
            pa = __builtin_bit_cast(s8, pk); } while (0)
#define AT_BLK_V(blk, qi, pa) do { \
            _Pragma("unroll") for (int db = 0; db < 4; ++db) O[qi][db] = __builtin_amdgcn_mfma_f32_16x16x32_bf16(pa, vf[blk][db], O[qi][db], 0, 0, 0); \
            Ls[qi] = __builtin_amdgcn_mfma_f32_16x16x32_bf16(pa, ones8, Ls[qi], 0, 0, 0); } while (0)
#define AT_ROTATE do { const int t_ = bc; bc = bn; bn = bs; bs = t_; } while (0)
#define AT_MAIN_BODY(kt, RK_LD, RV_LD, RK_ST, RV_ST, LASTWAIT) do { \
            { const int ktn_ = (kt) + 5 < nkt ? (kt) + 5 : nkt - 1; AT_LOAD(ktn_, RK_LD, RV_LD); } \
            AT_STORE(bs, RK_ST, RV_ST); \
            pg8::f32x4 Sa, Sb, Sc, Sd, Se, Sf, Sg, Sh; s8 pa0, pa1, pb0, pb1; \
            AT_BLK_S(0, 0, Sa, Sb); AT_BLK_S(1, 0, Sc, Sd); AT_BLK_S(0, 1, Se, Sf); AT_BLK_S(1, 1, Sg, Sh);        \
            AT_MWAIT_S2(m0, m1, n0, n1); \
            AT_KREAD(bn, 0); AT_KREAD(bn, 1); \
            AT_BLK_P(m0, Sa, Sb, pa0); AT_SLOAD(m0, 0, 2 * (kt) + 2); AT_BLK_P(m1, Sc, Sd, pa1); AT_SLOAD(m1, 0, 2 * (kt) + 3); \
            AT_BLK_V(0, 0, pa0); AT_BLK_V(1, 0, pa1); \
            AT_BLK_P(n0, Se, Sf, pb0); AT_SLOAD(n0, 1, 2 * (kt) + 2); AT_BLK_P(n1, Sg, Sh, pb1); AT_SLOAD(n1, 1, 2 * (kt) + 3); \
            AT_BLK_V(0, 1, pb0); AT_BLK_V(1, 1, pb1); \
            if (LASTWAIT) AT_MWAIT_O(m0, m1, n0, n1);                   \
            AT_VREAD(bn, 0); AT_VREAD(bn, 1); \
            AT_ROTATE; \
            __builtin_amdgcn_s_barrier(); } while (0)
#define AT_DIAG_STEP(kt, qi) do { \
            if (2 * (kt) + 1 <= lb[qi]) { pg8::f32x4 Sa, Sb, Sc, Sd; s8 pa0, pa1; AT_SLOAD(m0, qi, 2 * (kt)); AT_SLOAD(m1, qi, 2 * (kt) + 1); \
                AT_BLK_S(0, qi, Sa, Sb); AT_BLK_S(1, qi, Sc, Sd); AT_MWAIT(m0, m1); AT_BLK_P(m0, Sa, Sb, pa0); AT_BLK_P(m1, Sc, Sd, pa1); AT_BLK_V(0, qi, pa0); AT_BLK_V(1, qi, pa1); } \
            else if (2 * (kt) <= lb[qi]) { pg8::f32x4 Sa, Sb; s8 pa0; AT_SLOAD(m0, qi, 2 * (kt)); AT_SLOAD(m1, qi, 2 * (kt)); \
                AT_BLK_S(0, qi, Sa, Sb); AT_MWAIT(m0, m1); AT_BLK_P(m0, Sa, Sb, pa0); AT_BLK_V(0, qi, pa0); } } while (0)
#define AT_DIAG_BODY(kt, RK_LD, RV_LD, RK_ST, RV_ST) do { \
            { const int ktn_ = (kt) + 5 < nkt ? (kt) + 5 : nkt - 1; AT_LOAD(ktn_, RK_LD, RV_LD); } \
            AT_STORE(bs, RK_ST, RV_ST); \
            if (2 * (kt) <= lb[1] || 2 * (kt) <= lb[0]) { \
                AT_KREAD(bc, 0); AT_KREAD(bc, 1); AT_VREAD(bc, 0); AT_VREAD(bc, 1); \
                AT_DIAG_STEP(kt, 0); AT_DIAG_STEP(kt, 1); } \
            asm volatile("s_waitcnt lgkmcnt(0)" ::: "memory"); \
            AT_ROTATE; \
            __builtin_amdgcn_s_barrier(); } while (0)
        int bc = 0, bn = 2 * AT_TILE, bs = 4 * AT_TILE;
        s8 kf[2][2][2], vf[2][4];
        AT_SLOAD(m0, 0, 0); AT_SLOAD(m1, 0, 1); AT_SLOAD(n0, 1, 0); AT_SLOAD(n1, 1, 1);
        AT_STORE(bc, rk0, rv0);
        AT_STORE(bn, rk1, rv1);
        AT_LOAD(nkt > 4 ? 4 : nkt - 1, rk0, rv0);
        AT_MWAIT(m0, m1); AT_MWAIT(n0, n1);
        __syncthreads();
        AT_KREAD(bc, 0); AT_KREAD(bc, 1); AT_VREAD(bc, 0); AT_VREAD(bc, 1);
#pragma unroll 1
        for (int kt = 0; kt < kmain; kt += 4) {
            AT_MAIN_BODY(kt, rk1, rv1, rk2, rv2, false);
            AT_MAIN_BODY(kt + 1, rk2, rv2, rk3, rv3, false);
            AT_MAIN_BODY(kt + 2, rk3, rv3, rk0, rv0, false);
            AT_MAIN_BODY(kt + 3, rk0, rv0, rk1, rv1, true);
        }
#pragma unroll 1
        for (int kt = kmain; kt < nkt; kt += 4) {
            AT_DIAG_BODY(kt, rk1, rv1, rk2, rv2);
            AT_DIAG_BODY(kt + 1, rk2, rv2, rk3, rv3);
            AT_DIAG_BODY(kt + 2, rk3, rv3, rk0, rv0);
            AT_DIAG_BODY(kt + 3, rk0, rv0, rk1, rv1);
        }
#undef AT_ROTATE
#undef AT_MAIN_BODY
#undef AT_DIAG_BODY
#undef AT_DIAG_STEP
#undef AT_BLK_S
#undef AT_BLK_P
#undef AT_BLK_V
#undef AT_KREAD
#undef AT_VREAD
#undef AT_SLOAD
#undef AT_MWAIT
#undef AT_MWAIT_S2
#undef AT_MWAIT_O
#undef AT_LOAD
#undef AT_STORE
#pragma unroll
        for (int qi = 0; qi < 2; ++qi)
#pragma unroll
            for (int j = 0; j < 4; ++j) { const float ij = Ls[qi][j] > 0.f ? 1.f / Ls[qi][j] : 0.f; const int t = tq[qi] + 4 * g + j;
                if (act[qi]) {
#pragma unroll
                    for (int db = 0; db < 4; ++db) MIX[(mb + t) * 1024 + 256 + h * 64 + db * 16 + r] = f2bf(O[qi][db][j] * ij); } }
    }
}
constexpr int CK = 16;
constexpr int NCHK = L / CK;
static_assert(L % CK == 0, "chunk length");
constexpr int CKP_RW = 10, CKP_HG = 7;
constexpr int CKR_RW = CKP_RW * 1024 + 512, CKR_HG = CKP_HG * 1024 + 256;
constexpr size_t WS_CKF_RW = WS_PROJ + 136 * MiB;
constexpr size_t WS_CKF_HG = WS_CKF_RW + (size_t)32 * NCHK * CKR_RW;
static_assert(WS_CKF_HG + (size_t)32 * NCHK * CKR_HG <= WS_PROJ + (size_t)TP * NINP * 2, "chunk fragments fit in the dead proj region");
__device__ __forceinline__ s8 pack8(const pg8::f32x4 lo, const pg8::f32x4 hi) { v4u p; p.x = pk2(lo[0], lo[1]); p.y = pk2(lo[2], lo[3]); p.z = pk2(hi[0], hi[1]); p.w = pk2(hi[2], hi[3]); return __builtin_bit_cast(s8, p); }
template <int CTRL> __device__ __forceinline__ float dpp_shr1(float x) { return __int_as_float(__builtin_amdgcn_update_dpp(0x3F800000, __float_as_int(x), CTRL, 0xF, 0xF, false)); }
__device__ __forceinline__ float row_cumprod(float x) { x *= dpp_shr1<0x111>(x); x *= dpp_shr1<0x112>(x); x *= dpp_shr1<0x114>(x); x *= dpp_shr1<0x118>(x); return x; }

template <bool RWKV>
__device__ __forceinline__ void chunk_prep_item(const Ctx A, int bh, int c, int lane) {
    const int r = lane & 15, g = lane >> 4;
    const size_t base = ((size_t)bh * L + (size_t)c * CK + r) * 64;
    const float* Wg = (const float*)(A.ws + (RWKV ? WS_RW_W : WS_HG_F)) + base;
    const bf16* Ag = (const bf16*)(A.ws + WS_RW_A) + base; const bf16* Bg = (const bf16*)(A.ws + WS_RW_B) + base;
    const bf16* Kg = (const bf16*)(A.ws + (RWKV ? WS_RW_K : WS_HG_K)) + base; const bf16* Rg = (const bf16*)(A.ws + (RWKV ? WS_RW_WR : WS_HG_Q)) + base;
    GAS unsigned char* recb = A.ws + (RWKV ? WS_CKF_RW : WS_CKF_HG) + ((size_t)bh * NCHK + c) * (RWKV ? CKR_RW : CKR_HG);
    v4u* REC = (v4u*)recb + lane; v4f* GCp = (v4f*)(recb + (RWKV ? CKP_RW : CKP_HG) * 1024); float* Dp = (float*)(recb + CKP_RW * 1024 + 256);
    s8 Af[2], Bf[2], Kf[2], Rf[2], BTf[2], KTf[2];
    v4f gcv[4];
#pragma unroll
    for (int ks = 0; ks < 2; ++ks) {
        pg8::f32x4 ah[2], bh_[2], kh[2], rh[2], bt[2], kt[2];
#pragma unroll
        for (int hf = 0; hf < 2; ++hf) {
            const int k0 = 32 * ks + 16 * hf + 4 * g;
            const v4f w4 = *(const v4f*)(Wg + k0);
            v4f gt, gm, gc;
#pragma unroll
            for (int e = 0; e < 4; ++e) { gt[e] = row_cumprod(w4[e]); gm[e] = dpp_shr1<0x111>(gt[e]); gc[e] = __shfl(gt[e], 16 * g + 15); }
            gcv[2 * ks + hf] = gc;
            v4f inv; inv.x = __builtin_amdgcn_rcpf(gt.x); inv.y = __builtin_amdgcn_rcpf(gt.y); inv.z = __builtin_amdgcn_rcpf(gt.z); inv.w = __builtin_amdgcn_rcpf(gt.w);
            const v4f kk4 = ld_bf4(Kg + k0) * inv, rr4 = ld_bf4(Rg + k0) * (RWKV ? gm : gt);
            kh[hf] = kk4; rh[hf] = rr4; kt[hf] = kk4 * gc;
            if (RWKV) { ah[hf] = ld_bf4(Ag + k0) * gm; bh_[hf] = ld_bf4(Bg + k0) * inv; bt[hf] = bh_[hf] * gc; }
        }
        Kf[ks] = pack8(kh[0], kh[1]); Rf[ks] = pack8(rh[0], rh[1]); KTf[ks] = pack8(kt[0], kt[1]);
        if (RWKV) { Af[ks] = pack8(ah[0], ah[1]); Bf[ks] = pack8(bh_[0], bh_[1]); BTf[ks] = pack8(bt[0], bt[1]); }
    }
    const pg8::f32x4 z4 = (pg8::f32x4){0.f, 0.f, 0.f, 0.f};
    s8 selE, selO;
    { v4u e = (v4u){0u, 0u, 0u, 0u}, o = e; const int jj = r - 4 * g;
      if (jj >= 0 && jj < 4) { const unsigned one = 0x3F80u << (16 * (jj & 1)); if (jj < 2) { e.x = one; o.z = one; } else { e.y = one; o.w = one; } }
      selE = __builtin_bit_cast(s8, e); selO = __builtin_bit_cast(s8, o); }
    pg8::f32x4 MrkT = __builtin_amdgcn_mfma_f32_16x16x32_bf16(Kf[0], Rf[0], z4, 0, 0, 0); MrkT = __builtin_amdgcn_mfma_f32_16x16x32_bf16(Kf[1], Rf[1], MrkT, 0, 0, 0);
    const int tb = r >> 2, tj = r & 3;
    if (RWKV) {
        pg8::f32x4 LabT = __builtin_amdgcn_mfma_f32_16x16x32_bf16(Bf[0], Af[0], z4, 0, 0, 0); LabT = __builtin_amdgcn_mfma_f32_16x16x32_bf16(Bf[1], Af[1], LabT, 0, 0, 0);
        pg8::f32x4 LakT = __builtin_amdgcn_mfma_f32_16x16x32_bf16(Kf[0], Af[0], z4, 0, 0, 0); LakT = __builtin_amdgcn_mfma_f32_16x16x32_bf16(Kf[1], Af[1], LakT, 0, 0, 0);
        pg8::f32x4 MrbT = __builtin_amdgcn_mfma_f32_16x16x32_bf16(Bf[0], Rf[0], z4, 0, 0, 0); MrbT = __builtin_amdgcn_mfma_f32_16x16x32_bf16(Bf[1], Rf[1], MrbT, 0, 0, 0);
        const float d10 = __shfl(LabT[0], 20 * g + 1), d20 = __shfl(LabT[0], 20 * g + 2), d21 = __shfl(LabT[1], 20 * g + 2);
        const float d30 = __shfl(LabT[0], 20 * g + 3), d31 = __shfl(LabT[1], 20 * g + 3), d32 = __shfl(LabT[2], 20 * g + 3);
        pg8::f32x4 Loff, Lak, Mrb, Mrk;
#pragma unroll
        for (int j = 0; j < 4; ++j) { const bool below = g < tb, diag = g == tb;
            Loff[j] = below ? LabT[j] : 0.f; Lak[j] = (below || (diag && j < tj)) ? LakT[j] : 0.f;
            Mrb[j] = (below || (diag && j <= tj)) ? MrbT[j] : 0.f; Mrk[j] = (below || (diag && j <= tj)) ? MrkT[j] : 0.f; }
        REC[0 * 64] = __builtin_bit_cast(v4u, Af[0]); REC[1 * 64] = __builtin_bit_cast(v4u, Af[1]); REC[2 * 64] = __builtin_bit_cast(v4u, Rf[0]); REC[3 * 64] = __builtin_bit_cast(v4u, Rf[1]);
        REC[4 * 64] = __builtin_bit_cast(v4u, pack8(Loff, Lak)); REC[5 * 64] = __builtin_bit_cast(v4u, pack8(Mrb, Mrk));
        if (r == 0) { *(v4f*)(Dp + 8 * g) = (v4f){d10, d20, d21, d30}; *(v4f*)(Dp + 8 * g + 4) = (v4f){d31, d32, 0.f, 0.f}; }
#pragma unroll
        for (int mt = 0; mt < 4; ++mt) { const s8 sel = (mt & 1) ? selO : selE;
            const pg8::f32x4 K2 = __builtin_amdgcn_mfma_f32_16x16x32_bf16(KTf[mt >> 1], sel, z4, 0, 0, 0), B2 = __builtin_amdgcn_mfma_f32_16x16x32_bf16(BTf[mt >> 1], sel, z4, 0, 0, 0);
            REC[(6 + mt) * 64] = __builtin_bit_cast(v4u, pack8(B2, K2)); if (r == 15) GCp[4 * mt + g] = gcv[mt]; }
    } else {
        pg8::f32x4 Mrk;
#pragma unroll
        for (int j = 0; j < 4; ++j) Mrk[j] = (g < tb || (g == tb && j <= tj)) ? MrkT[j] : 0.f;
        REC[0 * 64] = __builtin_bit_cast(v4u, Rf[0]); REC[1 * 64] = __builtin_bit_cast(v4u, Rf[1]); REC[2 * 64] = __builtin_bit_cast(v4u, pack8(z4, Mrk));
#pragma unroll
        for (int mt = 0; mt < 4; ++mt) { const s8 sel = (mt & 1) ? selO : selE;
            const pg8::f32x4 K2 = __builtin_amdgcn_mfma_f32_16x16x32_bf16(KTf[mt >> 1], sel, z4, 0, 0, 0);
            REC[(3 + mt) * 64] = __builtin_bit_cast(v4u, pack8(z4, K2)); if (r == 15) GCp[4 * mt + g] = gcv[mt]; }
    }
}
__device__ PHASE_FN void chunk_prep_phase(const Ctx A, int vcu, int G) {
    const int tid = opaque_tid(), lane = tid & 63, wave = tid >> 6;
    const int gw = vcu * NWAVES + wave, NGW = G * NWAVES;
#pragma unroll 1
    for (int it = gw; it < 2 * 32 * NCHK; it += NGW) {
        const int mix = it >= 32 * NCHK, q = mix ? it - 32 * NCHK : it, bh = q / NCHK, c = q - bh * NCHK;
        if (mix) chunk_prep_item<false>(A, bh, c, lane); else chunk_prep_item<true>(A, bh, c, lane);
    }
}
template <bool RWKV>
__device__ PHASE_FN void chunk_scan(const Ctx A, LAS unsigned char* lds, int unit_) {
    const int unit = opaque_s(unit_);
    const int tid = opaque_tid(), lane = tid & 63, wave = tid >> 6, r = lane & 15, g = lane >> 4;
    const int slot = wave >> 2, nt = wave & 3;
    const int bh = 2 * unit + slot, b = bh >> 2, h = bh & 3;
    constexpr int NP = RWKV ? CKP_RW : CKP_HG;
    constexpr int NU = NP + 3;
    constexpr int NQ = (NU + 3) / 4;
    constexpr int RING = NU * 1024;
    constexpr size_t RB = RWKV ? CKR_RW : CKR_HG;
    const GAS unsigned char* recb = A.ws + (RWKV ? WS_CKF_RW : WS_CKF_HG) + (size_t)bh * NCHK * RB;
    const GAS unsigned char* vb = A.ws + (RWKV ? WS_RW_V : WS_HG_V) + (size_t)bh * L * 128;
    float* YR = (float*)(A.ws + (RWKV ? WS_YRAW : WS_ORAW)) + (size_t)b * L * 256 + h * 64 + nt * 16 + r;
    LAS unsigned char* ring = lds + slot * 2 * RING;
    static_assert(4 * (size_t)(CKP_RW + 3) * 1024 <= MISC_OFF, "chunk ring");
    auto unit_src = [&](int c_, int u) -> const GAS v4u* {
        if (u < NP) return (const GAS v4u*)(recb + (size_t)c_ * RB + u * 1024) + lane;
        if (u == NP) { const int q = lane * 16 < (int)(RB - NP * 1024) ? lane * 16 : (int)(RB - NP * 1024) - 16; return (const GAS v4u*)(recb + (size_t)c_ * RB + NP * 1024 + q); }
        return (const GAS v4u*)(vb + (size_t)c_ * CK * 128 + (u - NP - 1) * 1024) + lane; };
    v4u st0[NQ], st1[NQ], st2[NQ], st3[NQ];
#define CK_LD(S, c_) do { const int cc_ = (c_) < NCHK ? (c_) : NCHK - 1; _Pragma("unroll") for (int q = 0; q < NQ; ++q) { const int u = nt + 4 * q; if (u < NU) S[q] = *unit_src(cc_, u); } } while (0)
#define CK_ST(S, p_) do { _Pragma("unroll") for (int q = 0; q < NQ; ++q) { const int u = nt + 4 * q; if (u < NU) *(LAS v4u*)(ring + (p_) * RING + u * 1024 + lane * 16) = S[q]; } } while (0)
    pg8::f32x4 ST[4];
#pragma unroll
    for (int mt = 0; mt < 4; ++mt) ST[mt] = (pg8::f32x4){0.f, 0.f, 0.f, 0.f};
    const pg8::f32x4 z4 = (pg8::f32x4){0.f, 0.f, 0.f, 0.f};
    auto body = [&](const int c, const int p) __attribute__((always_inline)) {
        const LAS unsigned char* rb_ = ring + p * RING;
        const LAS unsigned char* sm = rb_ + NP * 1024;
        v4u pcs[NP]; v4f gqs[4]; v4f da = (v4f){0.f, 0.f, 0.f, 0.f}, db = da;
#pragma unroll
        for (int i = 0; i < NP; ++i) pcs[i] = *(const LAS v4u*)(rb_ + i * 1024 + lane * 16);
#pragma unroll
        for (int mt = 0; mt < 4; ++mt) gqs[mt] = *(const LAS v4f*)(sm + (16 * mt + 4 * g) * 4);
        if (RWKV) { da = *(const LAS v4f*)(sm + 256 + g * 32); db = *(const LAS v4f*)(sm + 256 + g * 32 + 16); }
#define PIECE(i) __builtin_bit_cast(s8, pcs[i])
        unsigned vp0, vp1;
        { const LAS unsigned short* vv = (const LAS unsigned short*)(rb_ + (NP + 1) * 1024) + (4 * g) * 64 + 16 * nt + r;
          vp0 = (unsigned)vv[0] | ((unsigned)vv[64] << 16); vp1 = (unsigned)vv[128] | ((unsigned)vv[192] << 16); }
        __builtin_amdgcn_sched_barrier(0);
        const s8 Sf0 = pack8(ST[0], ST[1]), Sf1 = pack8(ST[2], ST[3]);
        pg8::f32x4 U = z4, R0;
        if (RWKV) {
            R0 = __builtin_amdgcn_mfma_f32_16x16x32_bf16(PIECE(2), Sf0, z4, 0, 0, 0); R0 = __builtin_amdgcn_mfma_f32_16x16x32_bf16(PIECE(3), Sf1, R0, 0, 0, 0);
            pg8::f32x4 W0 = __builtin_amdgcn_mfma_f32_16x16x32_bf16(PIECE(0), Sf0, z4, 0, 0, 0); W0 = __builtin_amdgcn_mfma_f32_16x16x32_bf16(PIECE(1), Sf1, W0, 0, 0, 0);
            const float d10 = da.x, d20 = da.y, d21 = da.z, d30 = da.w, d31 = db.x, d32 = db.y;
            const s8 Ajac = PIECE(4);
#pragma unroll
            for (int rnd = 0; rnd < 4; ++rnd) {
                v4u bu; bu.x = pk2(U[0], U[1]); bu.y = pk2(U[2], U[3]); bu.z = vp0; bu.w = vp1;
                const pg8::f32x4 Wr = __builtin_amdgcn_mfma_f32_16x16x32_bf16(Ajac, __builtin_bit_cast(s8, bu), W0, 0, 0, 0);
                U[0] = Wr[0]; U[1] = Wr[1] + d10 * U[0]; U[2] = Wr[2] + d20 * U[0] + d21 * U[1]; U[3] = Wr[3] + d30 * U[0] + d31 * U[1] + d32 * U[2];
            }
        } else {
            R0 = __builtin_amdgcn_mfma_f32_16x16x32_bf16(PIECE(0), Sf0, z4, 0, 0, 0); R0 = __builtin_amdgcn_mfma_f32_16x16x32_bf16(PIECE(1), Sf1, R0, 0, 0, 0);
        }
        v4u buv; buv.x = pk2(U[0], U[1]); buv.y = pk2(U[2], U[3]); buv.z = vp0; buv.w = vp1;
        const s8 Buv = __builtin_bit_cast(s8, buv);
        const pg8::f32x4 Yt = __builtin_amdgcn_mfma_f32_16x16x32_bf16(PIECE(RWKV ? 5 : 2), Buv, R0, 0, 0, 0);
#pragma unroll
        for (int j = 0; j < 4; ++j) YR[(size_t)(c * CK + 4 * g + j) * 256] = Yt[j];
#pragma unroll
        for (int mt = 0; mt < 4; ++mt) {
            const v4f gq = gqs[mt];
            ST[mt][0] *= gq.x; ST[mt][1] *= gq.y; ST[mt][2] *= gq.z; ST[mt][3] *= gq.w;
            ST[mt] = __builtin_amdgcn_mfma_f32_16x16x32_bf16(PIECE((RWKV ? 6 : 3) + mt), Buv, ST[mt], 0, 0, 0);
        }
#undef PIECE
    };
    CK_LD(st0, 0); CK_LD(st1, 1); CK_LD(st2, 2); CK_LD(st3, 3);
    CK_ST(st0, 0);
    __syncthreads();
#define CK_TRIP(c_, SLD, SST, p_) do { CK_LD(SLD, (c_) + 4); body((c_), (p_)); CK_ST(SST, 1 - (p_)); __syncthreads(); } while (0)
    static_assert(NCHK % 4 == 1, "chunk loop: whole groups of four trips + one");
#pragma unroll 1
    for (int c = 0; c < NCHK - 1; c += 4) {
        CK_TRIP(c, st0, st1, 0);
        CK_TRIP(c + 1, st1, st2, 1);
        CK_TRIP(c + 2, st2, st3, 0);
        CK_TRIP(c + 3, st3, st0, 1);
    }
    CK_TRIP(NCHK - 1, st0, st1, 0);
#undef CK_TRIP
#undef CK_LD
#undef CK_ST
}
__device__ __forceinline__ float rowmax16(float x) { x = fmaxf(x, dpp_f<0xB1>(x)); x = fmaxf(x, dpp_f<0x4E>(x)); x = fmaxf(x, dpp_f<0x141>(x)); x = fmaxf(x, dpp_f<0x140>(x)); return x; }
__device__ __forceinline__ int rowmin16i(int x) { x = min(x, __builtin_amdgcn_update_dpp(0, x, 0xB1, 0xF, 0xF, true)); x = min(x, __builtin_amdgcn_update_dpp(0, x, 0x4E, 0xF, 0xF, true));
    x = min(x, __builtin_amdgcn_update_dpp(0, x, 0x141, 0xF, 0xF, true)); x = min(x, __builtin_amdgcn_update_dpp(0, x, 0x140, 0xF, 0xF, true)); return x; }
__device__ PHASE_FN void ln_router_phase(const Ctx A, LAS unsigned char* lds, int l, int vcu, int G) {
    const int tid = opaque_tid(), lane = tid & 63, wave = tid >> 6, r = lane & 15, g = lane >> 4;
    const int gw = vcu * NWAVES + wave, NGW = G * NWAVES;
    bf16* HB = (bf16*)(A.ws + WS_HB);
    int* TIDX = (int*)(A.ws + WS_TIDX); float* TGATE = (float*)(A.ws + WS_TGATE);
    unsigned* ecnt = (unsigned*)(A.ws + WS_CTL) + CW_ECNT + 64 * l;
    const float* gg = gin(A, 26) + l * D; const float* bb = gin(A, 27) + l * D;
    const float* rw = gin(A, 28) + (size_t)l * D * NE; const float* rb = gin(A, 29) + l * NE;
    LAS int* hist = (LAS int*)(lds + MISC_OFF + MI_HIST);
    if (tid < 32) hist[tid] = 0;
    for (int f = tid; f < 32 * 2 * 64; f += NTHR) { const int ks = f >> 7, nt = (f >> 6) & 1, ln = f & 63, n = ln & 15, g8 = ln >> 4;
        float w8[8];
#pragma unroll
        for (int e = 0; e < 8; ++e) w8[e] = rw[(size_t)(32 * ks + 8 * g8 + e) * NE + 16 * nt + n];
        v4u hi, lo; unsigned hh[4], ll[4];
#pragma unroll
        for (int e = 0; e < 4; ++e) { const unsigned ph = pk2(w8[2 * e], w8[2 * e + 1]); hh[e] = ph; ll[e] = pk2(w8[2 * e] - bflo(ph), w8[2 * e + 1] - bfhi(ph)); }
        hi = (v4u){hh[0], hh[1], hh[2], hh[3]}; lo = (v4u){ll[0], ll[1], ll[2], ll[3]};
        *(LAS v4u*)(lds + ((size_t)((ks * 2 + nt) * 2 + 0) * 64 + ln) * 16) = hi; *(LAS v4u*)(lds + ((size_t)((ks * 2 + nt) * 2 + 1) * 64 + ln) * 16) = lo; }
    __syncthreads();
    const float rb0 = rb[r], rb1 = rb[16 + r];
    auto lnrows = [&](size_t mrow, auto nrows_c) {
        constexpr int NR = decltype(nrows_c)::value;
        v4f x[NR][4];
#pragma unroll
        for (int u = 0; u < NR; ++u)
#pragma unroll
            for (int j = 0; j < 4; ++j) x[u][j] = ld_bf4(HB + (mrow + u) * D + 256 * j + 4 * lane);
#pragma unroll
        for (int u = 0; u < NR; ++u) { ln_row(x[u], gg, bb, lane);
#pragma unroll
            for (int j = 0; j < 4; ++j) { const size_t o = (mrow + u) * D + 256 * j + 4 * lane;
                v2u hi; hi.x = pk2(x[u][j].x, x[u][j].y); hi.y = pk2(x[u][j].z, x[u][j].w);
                *(v2u*)(HB + o) = hi; } }
    };
    auto ln2 = [&](size_t mrow) { lnrows(mrow, std::integral_constant<int, 2>{}); };
    auto route = [&](size_t m0) {
        pg8::f32x4 C0 = (pg8::f32x4){0.f, 0.f, 0.f, 0.f}, C1 = C0;
        const bf16* ah = HB + (m0 + r) * D + 8 * g;
#pragma unroll 4
        for (int ks = 0; ks < 32; ++ks) {
            const s8 xh = *(const s8*)(ah + 32 * ks);
            const LAS unsigned char* wf = lds + (size_t)(ks * 4) * 1024 + lane * 16;
            const s8 w0h = *(const LAS s8*)(wf), w0l = *(const LAS s8*)(wf + 1024), w1h = *(const LAS s8*)(wf + 2048), w1l = *(const LAS s8*)(wf + 3072);
            C0 = __builtin_amdgcn_mfma_f32_16x16x32_bf16(xh, w0h, C0, 0, 0, 0); C0 = __builtin_amdgcn_mfma_f32_16x16x32_bf16(xh, w0l, C0, 0, 0, 0);
            C1 = __builtin_amdgcn_mfma_f32_16x16x32_bf16(xh, w1h, C1, 0, 0, 0); C1 = __builtin_amdgcn_mfma_f32_16x16x32_bf16(xh, w1l, C1, 0, 0, 0);
        }
#pragma unroll
        for (int j = 0; j < 4; ++j) {
            float v0 = C0[j] + rb0, v1 = C1[j] + rb1;
            float tv[4]; int ti[4];
#pragma unroll
            for (int q = 0; q < 4; ++q) {
                const float mx = rowmax16(fmaxf(v0, v1));
                const int cand = (v0 == mx) ? r : ((v1 == mx) ? 16 + r : 64);
                const int bi = rowmin16i(cand);
                tv[q] = mx; ti[q] = bi;
                if (bi == r) v0 = -3.0e38f; if (bi == 16 + r) v1 = -3.0e38f;
            }
            const float e1 = __expf(tv[1] - tv[0]), e2 = __expf(tv[2] - tv[0]), e3 = __expf(tv[3] - tv[0]); const float inv = rcp_(1.f + e1 + e2 + e3);
            const size_t m = m0 + 4 * g + j;
            if (r == 0) { *(int4*)(TIDX + m * 4) = make_int4(ti[0], ti[1], ti[2], ti[3]); *(v4f*)(TGATE + m * 4) = (v4f){inv, e1 * inv, e2 * inv, e3 * inv}; }
            if (r < 4) lds_add(&hist[r == 0 ? ti[0] : r == 1 ? ti[1] : r == 2 ? ti[2] : ti[3]], 1);
        }
    };
    const int NT16 = T / 16, nfull = (NT16 / NGW) * NGW;
#pragma unroll 1
    for (int tile = gw; tile < nfull; tile += NGW) {
        const size_t m0 = (size_t)tile * 16;
#pragma unroll 1
        for (int t = 0; t < 16; t += 4) lnrows(m0 + t, std::integral_constant<int, 4>{});
        asm volatile("s_waitcnt vmcnt(0)" ::: "memory");
        route(m0);
    }
#pragma unroll 1
    for (int tile = nfull + vcu; tile < NT16; tile += G) {
        const size_t m0 = (size_t)tile * 16;
        ln2(m0 + 2 * wave);
        asm volatile("s_waitcnt vmcnt(0)" ::: "memory");
        __syncthreads();
        if (wave == 0) route(m0);
    }
    __syncthreads();
    if (tid < 32) atomicAdd(&ecnt[tid], (unsigned)hist[tid]);
}
__device__ __forceinline__ int build_tiles(const Ctx A, LAS unsigned char* lds, int l) {
    const int tid = opaque_tid();
    const unsigned* ecnt = (const unsigned*)(A.ws + WS_CTL) + CW_ECNT + 64 * l;
    LAS int* offs = (LAS int*)(lds + MISC_OFF + MI_OFFS); LAS int* tile_e = (LAS int*)(lds + MISC_OFF + MI_TILE); LAS int* nt = (LAS int*)(lds + MISC_OFF + MI_NT);
    __syncthreads();
    if (tid < 32) { int off = 0, mycnt = 0;
        for (int e = 0; e < 32; ++e) { const int c = (int)__hip_atomic_load(ecnt + e, __ATOMIC_RELAXED, __HIP_MEMORY_SCOPE_AGENT); if (e < tid) off += (c + 255) & ~255; if (e == tid) mycnt = c; }
        offs[tid] = off;
        const int t0 = off >> 8, t1 = (off + ((mycnt + 255) & ~255)) >> 8;
        for (int t = t0; t < t1; ++t) tile_e[t] = tid;
        if (tid == 31) nt[0] = t1; }
    __syncthreads();
    return nt[0];
}
__device__ PHASE_FN void moe_sort_phase(const Ctx A, LAS unsigned char* lds, int l) {
    const int tid = opaque_tid();
    const int* TIDX = (const int*)(A.ws + WS_TIDX); const float* TGATE = (const float*)(A.ws + WS_TGATE);
    int* SPOS = (int*)(A.ws + WS_SPOS); float* GSORT = (float*)(A.ws + WS_GSORT); int* RMAP = (int*)(A.ws + WS_RMAP);
    unsigned* ecur = (unsigned*)(A.ws + WS_CTL) + CW_ECUR + 64 * l; const unsigned* ecnt = (const unsigned*)(A.ws + WS_CTL) + CW_ECNT + 64 * l;
    LAS int* hist = (LAS int*)(lds + MISC_OFF + MI_HIST); LAS int* lcur = (LAS int*)(lds + MISC_OFF + MI_LCUR); LAS int* lbase = (LAS int*)(lds + MISC_OFF + MI_LBASE);
    LAS int* offs = (LAS int*)(lds + MISC_OFF + MI_OFFS);
    (void)build_tiles(A, lds, l);
    const int TPB = (T + (int)gridDim.x - 1) / (int)gridDim.x;
    const int mbeg = blockIdx.x * TPB, mend = (mbeg + TPB < T) ? mbeg + TPB : T;
    const int nslot = (mend > mbeg) ? (mend - mbeg) * 4 : 0;
    if (tid < 32) { hist[tid] = 0; lcur[tid] = 0; }
    __syncthreads();
    for (int s = tid; s < nslot; s += NTHR) lds_add(&hist[TIDX[(size_t)mbeg * 4 + s]], 1);
    __syncthreads();
    if (tid < 32) lbase[tid] = offs[tid] + (int)atomicAdd(&ecur[tid], (unsigned)hist[tid]);
    __syncthreads();
    for (int s = tid; s < nslot; s += NTHR) { const size_t gs = (size_t)mbeg * 4 + s; const int e = TIDX[gs];
        const int pos = lbase[e] + lds_add(&lcur[e], 1);
        SPOS[gs] = pos; GSORT[pos] = TGATE[gs]; RMAP[pos] = mbeg + (s >> 2); }
    if (blockIdx.x < 32) { const int e = blockIdx.x; const int c = (int)__hip_atomic_load(ecnt + e, __ATOMIC_RELAXED, __HIP_MEMORY_SCOPE_AGENT);
        const int p0 = offs[e] + c, p1 = offs[e] + ((c + 255) & ~255);
        for (int p = p0 + tid; p < p1; p += NTHR) RMAP[p] = 0; }
}
__device__ PHASE_FN void combine_ln_phase(const Ctx A, int l, int vcu, int G) {
    const int tid = opaque_tid(), lane = tid & 63, wave = tid >> 6;
    const int gw = vcu * NWAVES + wave, NGW = G * NWAVES;
    bf16* HB = (bf16*)(A.ws + WS_HB); const bf16* Y = (const bf16*)(A.ws + WS_YBUF); const int* SPOS = (const int*)(A.ws + WS_SPOS);
    const float* g = gin(A, 34) + l * D; const float* bb = gin(A, 35) + l * D;
#pragma unroll 1
    for (int m0 = 2 * gw; m0 < T; m0 += 2 * NGW) {
        v4f v[2][4];
#pragma unroll
        for (int t = 0; t < 2; ++t) { const int m = m0 + t;
            const int4 sp = *(const int4*)(SPOS + (size_t)m * 4);
#pragma unroll
            for (int j = 0; j < 4; ++j) { const size_t co = 256 * j + 4 * lane;
                const v4f y = ld_bf4(Y + (size_t)sp.x * D + co) + ld_bf4(Y + (size_t)sp.y * D + co) + ld_bf4(Y + (size_t)sp.z * D + co) + ld_bf4(Y + (size_t)sp.w * D + co);
                v[t][j] = ld_bf4(HB + (size_t)m * D + co) * ALPHA + y; } }
#pragma unroll
        for (int t = 0; t < 2; ++t) { const int m = m0 + t;
            ln_row(v[t], g, bb, lane);
            if (l == 0) {
#pragma unroll
                for (int j = 0; j < 4; ++j) st_bf4(HB + (size_t)m * D + 256 * j + 4 * lane, v[t][j]);
            } else {
                const int b = m / L, i = m - b * L;
                if (i >= NMETA) { float* o = (float*)(GAS float*)A.out + ((size_t)b * SEQ + (i - NMETA)) * D;
#pragma unroll
                    for (int j = 0; j < 4; ++j) *(v4f*)(o + 256 * j + 4 * lane) = v[t][j]; }
            }
        }
    }
}
constexpr int N_PHASES = 23;
#ifndef PH_ONLY
#define PH_ONLY -1
#endif
#define PHSEL(j) (PH_ONLY < 0 || PH_ONLY == (j))
#define IN(k) (lo <= (k) && (k) < hi)
#if MK_ONE_LAUNCH
#define GRID_BAR() xcd_barrier(bar)
#else
#define GRID_BAR() do { } while (0)
#endif
#define SEAM(k) do { if (IN(k) && IN((k) + 1)) GRID_BAR(); } while (0)
#define CTX() Ctx{args.in, args.out, launder(args.ws)}
#ifndef PROBE_PHASE
#define PROBE_PHASE -1
#endif
#ifndef PROBE_MULT
#define PROBE_MULT 4
#endif
#define PB_BEGIN(j) do { if (PROBE_PHASE == (j)) { pstamp = __builtin_amdgcn_s_memrealtime(); } } while (0)
#define PB_END(j) do { if (PROBE_PHASE == (j)) { pacc += __builtin_amdgcn_s_memrealtime() - pstamp; } } while (0)
__device__ __forceinline__ void layer_phases(const int l, const Args& args, LAS unsigned char* lds, const int G, const int bx, const int vcu, const int lo, const int hi, const XcdBarrier& bar, unsigned long long& pacc) {
    unsigned long long pstamp = 0ull; (void)pstamp;

        const int pb = 1 + 11 * l;
        PB_BEGIN(0);
        if (PHSEL(0) && IN(pb + 0)) { GAS unsigned char* wsl = launder(args.ws);
            pg8::Gemm g{(const pg8::bf16_t*)(wsl + WS_HB), (const pg8::bf16_t*)(wsl + WS_WIN) + (size_t)l * NINP * 1024, TP, NINP, 1024};
            pg8::StaticOrder S; S.init(TP, NINP, G, bx);
            pg8::EpiStoreBf16 E{(pg8::bf16_t*)(wsl + WS_PROJ), NINP};
            pg8::gemm_phase<pg8::EpiStoreBf16, pg8::StaticOrder, true, true>(lds, g, S, E);
            SEAM(pb + 0); PB_END(0);
        }
        PB_BEGIN(1);
        if (PHSEL(1) && IN(pb + 1)) { prep_phase(CTX(), lds, l, vcu, G); SEAM(pb + 1); PB_END(1); }
        PB_BEGIN(2);
        if (PHSEL(2) && IN(pb + 2)) { chunk_prep_phase(CTX(), vcu, G); lru_agg_phase(CTX(), vcu, G); SEAM(pb + 2); PB_END(2); }
        PB_BEGIN(3);
        if (PHSEL(3) && IN(pb + 3)) {
#ifndef PH2_SEL
#define PH2_SEL 15
#endif
            PB_BEGIN(20); PB_BEGIN(21); PB_BEGIN(22); PB_BEGIN(23);
#if SCAN_SEQ
            if ((PH2_SEL & 1) && bx < 64) rwkv_scan(CTX(), lds, bx); else if ((PH2_SEL & 2) && bx >= 64 && bx < 128) hgrn_scan(CTX(), lds, bx - 64); else if ((PH2_SEL & 4) && bx >= 128 && bx < 132) lru_carry_phase(CTX(), 128);
#else
            if ((PH2_SEL & 1) && bx < 16) chunk_scan<true>(CTX(), lds, bx); else if ((PH2_SEL & 2) && bx >= 16 && bx < 32) chunk_scan<false>(CTX(), lds, bx - 16); else if ((PH2_SEL & 4) && bx >= 32 && bx < 36) lru_carry_phase(CTX(), 32);
#endif
            __syncthreads();
            PB_END(20); PB_END(21); PB_END(22);
#if DSA_NAIVE
            if (PH2_SEL & 8) dsa_phase(CTX(), lds, l);
#else
            if (PH2_SEL & 8) dsa_select_phase(CTX(), lds, l);
#endif
            __syncthreads();
            PB_END(23);
            SEAM(pb + 3); PB_END(3);
        }
        PB_BEGIN(4);
        if (PHSEL(4) && IN(pb + 4)) {
            PB_BEGIN(24);
            lru_out_phase(CTX(), vcu, G);
            mixers_finish(CTX(), l, vcu, G);
            __syncthreads(); PB_END(24);
#if !DSA_NAIVE
            dsa_attn_phase(CTX(), lds, l);
#endif
            SEAM(pb + 4); PB_END(4);
        }
        PB_BEGIN(5);
        if (PHSEL(5) && IN(pb + 5)) { GAS unsigned char* wsl = launder(args.ws);
            pg8::Gemm g{(const pg8::bf16_t*)(wsl + WS_MIX), (const pg8::bf16_t*)(wsl + WS_WOUT) + (size_t)l * 1024 * 1024, TP, 1024, 1024};
            pg8::StaticOrder S; S.init(TP, 1024, G, bx);
            pg8::EpiResidBf E{(pg8::bf16_t*)(wsl + WS_HB), 1024, ALPHA};
            pg8::gemm_phase<pg8::EpiResidBf, pg8::StaticOrder, true, true>(lds, g, S, E);
            SEAM(pb + 5); PB_END(5);
        }
        PB_BEGIN(6);
        if (PHSEL(6) && IN(pb + 6)) { ln_router_phase(CTX(), lds, l, vcu, G); SEAM(pb + 6); PB_END(6); }
        PB_BEGIN(7);
        if (PHSEL(7) && IN(pb + 7)) { moe_sort_phase(CTX(), lds, l); SEAM(pb + 7); PB_END(7); }
        PB_BEGIN(8);
        if (PHSEL(8) && IN(pb + 8)) { GAS unsigned char* wsl = launder(args.ws);
            const int nt = build_tiles(CTX(), lds, l);
            pg8::Gemm g{(const pg8::bf16_t*)(wsl + WS_HB), (const pg8::bf16_t*)(wsl + WS_W1) + (size_t)l * 32 * 2048 * 1024, RMAX, 32 * 2048, 1024};
            pg8::MoeOrder S{nt * 8, G, vcu, 8, (const LAS int*)(lds + MISC_OFF + MI_TILE)};
            pg8::EpiSwiGLU E{(pg8::bf16_t*)(wsl + WS_ACT), (const float*)(const GAS float*)args.in[31] + (size_t)l * 32 * 2048};
            pg8::gemm_phase_gather<pg8::EpiSwiGLU, pg8::MoeOrder>(lds, g, S, E, (const int*)(wsl + WS_RMAP));
            SEAM(pb + 8); PB_END(8);
        }
        PB_BEGIN(9);
        if (PHSEL(9) && IN(pb + 9)) { GAS unsigned char* wsl = launder(args.ws);
            const int nt = build_tiles(CTX(), lds, l);
            pg8::Gemm g{(const pg8::bf16_t*)(wsl + WS_ACT), (const pg8::bf16_t*)(wsl + WS_W2) + (size_t)l * 32 * 1024 * 1024, RMAX, 32 * 1024, 1024};
            pg8::MoeOrder S{nt * 4, G, vcu, 4, (const LAS int*)(lds + MISC_OFF + MI_TILE)};
            pg8::EpiMoeOut E{(pg8::bf16_t*)(wsl + WS_YBUF), (const float*)(const GAS float*)args.in[33] + (size_t)l * 32 * 1024, (const float*)(wsl + WS_GSORT)};
            pg8::gemm_phase<pg8::EpiMoeOut, pg8::MoeOrder, true, true>(lds, g, S, E);
            SEAM(pb + 9); PB_END(9);
        }
        PB_BEGIN(10);
        if (PHSEL(10) && IN(pb + 10)) { combine_ln_phase(CTX(), l, vcu, G); SEAM(pb + 10); PB_END(10); }
}
__global__ void __launch_bounds__(NTHR, 2) trunk_fwd(Args args) {
    extern __shared__ __attribute__((aligned(16))) unsigned char lds_raw[];
    LAS unsigned char* lds = (LAS unsigned char*)lds_raw;
    const int tid = threadIdx.x;
    const int G = gridDim.x; const int bx = blockIdx.x; const int vcu = (G % 8 == 0) ? (bx % 8) * (G / 8) + bx / 8 : bx;
    unsigned* ctl = (unsigned*)(args.ws + WS_CTL);
    for (int u = tid; u < (LDS_BYTES - MISC_OFF) / 4; u += NTHR) ((LAS unsigned*)(lds + MISC_OFF))[u] = 0u;
    __syncthreads();
#if MK_ONE_LAUNCH
    XcdBarrier bar = xcd_barrier_post(ctl + CW_BAR, (volatile LAS unsigned*)(lds + MISC_OFF + MI_BAR));
#else
    XcdBarrier bar; bar.bar = ctl + CW_BAR; bar.x = 0; bar.st = nullptr;
#endif
    const int lo = args.ph_lo, hi = args.ph_hi;

    unsigned long long pacc = 0ull, pstamp = 0ull; (void)pstamp;
    PB_BEGIN(11);
    if (PHSEL(11) && IN(0)) { p0_prologue(CTX(), lds, vcu, G); SEAM(0); }
    PB_END(11);

#pragma unroll 1
    for (int l = 0; l < 2; ++l) layer_phases(l, args, lds, G, bx, vcu, lo, hi, bar, pacc);
    if (PROBE_PHASE >= 0 && bx == (PROBE_PHASE == 21 ? 16 : PROBE_PHASE == 22 ? 32 : PROBE_PHASE == 23 ? 255 : 0)) { const unsigned long long t0 = __builtin_amdgcn_s_memrealtime(); while (__builtin_amdgcn_s_memrealtime() - t0 < pacc * PROBE_MULT) __builtin_amdgcn_s_sleep(8); }
#undef IN
#undef SEAM
}

extern "C" void kernel_launch(void* const* d_in, const int* in_sizes, int n_in, void* d_out, int out_size, void* d_ws, size_t ws_size, hipStream_t stream) {
    static int grid = 0;
    if (grid == 0) {
        if (n_in != 36 || in_sizes[0] != NB * SEQ * D || out_size != NB * SEQ * D || ws_size < WS_END) {
            fprintf(stderr, "kernel_launch: unexpected problem (n_in %d, in0 %d, out %d, ws %zu, need %zu); nothing launched\n", n_in, n_in > 0 ? in_sizes[0] : -1, out_size, ws_size, (size_t)WS_END); grid = -1; return; }
        int dev = 0, cus = 0, per_cu = 0;
        if (hipGetDevice(&dev) != hipSuccess || hipDeviceGetAttribute(&cus, hipDeviceAttributeMultiprocessorCount, dev) != hipSuccess) { grid = -1; return; }
        if (hipFuncSetAttribute((const void*)trunk_fwd, hipFuncAttributeMaxDynamicSharedMemorySize, LDS_BYTES) != hipSuccess) { fprintf(stderr, "kernel_launch: hipFuncSetAttribute failed\n"); grid = -1; return; }
        if (hipOccupancyMaxActiveBlocksPerMultiprocessor(&per_cu, (const void*)trunk_fwd, NTHR, LDS_BYTES) != hipSuccess || per_cu < 1) { fprintf(stderr, "kernel_launch: occupancy query says %d\n", per_cu); (void)hipGetLastError(); }
        grid = cus;
        if (grid < 160 || grid > 512) { fprintf(stderr, "kernel_launch: unsupported CU count %d\n", cus); grid = -1; return; }
    }
    if (grid < 0) return;
    if (hipMemsetAsync((char*)d_ws + WS_CTL, 0, CTL_ZERO_BYTES, stream) != hipSuccess) return;
    Args a; memset(&a, 0, sizeof(a));
    for (int i = 0; i < 36; ++i) a.in[i] = (const float*)d_in[i];
    a.out = (float*)d_out; a.ws = (unsigned char*)d_ws;
#if MK_ONE_LAUNCH
    a.ph_lo = 0; a.ph_hi = N_PHASES;
    hipLaunchKernelGGL(trunk_fwd, dim3(grid), dim3(NTHR), LDS_BYTES, stream, a);
#else
    for (int p = 0; p < N_PHASES; ++p) { a.ph_lo = p; a.ph_hi = p + 1; hipLaunchKernelGGL(trunk_fwd, dim3(grid), dim3(NTHR), LDS_BYTES, stream, a); }
#endif
}
```

```cpp
#include <hip/hip_runtime.h>
#include <cstdio>
#include <cstdint>
#include <cstring>

#ifndef MK_ONE_LAUNCH
#define MK_ONE_LAUNCH 1
#endif

#ifndef SCAN_SEQ
#define SCAN_SEQ 0
#endif
#ifndef SCAN_MIX
#define SCAN_MIX 0
#endif
#ifndef DSA_NAIVE
#define DSA_NAIVE 0
#endif
#ifndef PHASE_FN
#define PHASE_FN __forceinline__
#endif
#define GAS __attribute__((address_space(1)))
#define LAS __attribute__((address_space(3)))
typedef unsigned short bf16;
typedef unsigned v4u __attribute__((ext_vector_type(4)));
typedef unsigned v2u __attribute__((ext_vector_type(2)));
typedef float v4f __attribute__((ext_vector_type(4)));
typedef float v2f __attribute__((ext_vector_type(2)));

constexpr int NB = 8, SEQ = 8192, NMETA = 16, L = SEQ + NMETA  , T = NB * L  , TP = 65792  , D = 1024;
constexpr int NINP = 3584;
constexpr int NE = 32, TOPK = 4;
constexpr int RMAX = 1058 * 256;
constexpr int C_RW = 0, C_RW_R = 0, C_RW_WD = 256, C_RW_K = 320, C_RW_V = 576, C_RW_AD = 832, C_RW_GD = 896;
constexpr int C_DS_Q = 960, C_DS_K = 1216, C_DS_V = 1472, C_DS_QI = 1728, C_DS_KI = 1984, C_DS_WI = 2016;
constexpr int C_LR_X = 2024, C_LR_G = 2280;
constexpr int C_HG_Q = 2536, C_HG_F = 2792, C_HG_I = 3048, C_HG_G = 3304;
constexpr float ALPHA = 1.41421356237f;
constexpr float LN_EPS = 1e-5f;

constexpr size_t MiB = 1u << 20;
constexpr size_t WS_CTL = 0, CTL_ZERO_BYTES = 1 * MiB;
constexpr size_t WS_WIN = 2 * MiB;
constexpr size_t WS_WOUT = 16 * MiB;
constexpr size_t WS_W1 = 20 * MiB;
constexpr size_t WS_W2 = 276 * MiB;
constexpr size_t WS_H = 404 * MiB;
constexpr size_t WS_MIX = WS_H;
constexpr size_t WS_HB = 661 * MiB;
constexpr size_t WS_BIG = 790 * MiB;
constexpr size_t WS_PROJ = WS_BIG;
constexpr size_t SZ_HM32 = (size_t)32 * L * 64 * 4;
constexpr size_t SZ_HM16 = SZ_HM32 / 2;
constexpr size_t SZ_TM16 = (size_t)T * 256 * 2;
constexpr size_t WS_RW_W = 1240 * MiB;
constexpr size_t WS_RW_A = WS_RW_W + SZ_HM32, WS_RW_B = WS_RW_A + SZ_HM16, WS_RW_K = WS_RW_B + SZ_HM16, WS_RW_WR = WS_RW_K + SZ_HM16, WS_RW_V = WS_RW_WR + SZ_HM16;
constexpr size_t WS_RW_G = WS_RW_V + SZ_HM16;
constexpr size_t WS_RW_SC = WS_RW_G + SZ_TM16;
constexpr size_t WS_DS_Q = WS_RW_SC + (size_t)32 * L * 16;
constexpr size_t WS_DS_K = WS_DS_Q + SZ_TM16, WS_DS_V = WS_DS_K + SZ_TM16, WS_DS_QI = WS_DS_V + SZ_TM16;
constexpr size_t WS_DS_KI = WS_DS_QI + SZ_TM16;
constexpr size_t WS_DS_WI = WS_DS_KI + (size_t)T * 64;
constexpr size_t WS_LR_A = WS_DS_WI + (size_t)T * 32;
constexpr size_t WS_LR_U = WS_LR_A + (size_t)T * 1024, WS_LR_G = WS_LR_U + SZ_TM16;
constexpr size_t WS_HG_F = WS_LR_G + SZ_TM16;
constexpr size_t WS_HG_K = WS_HG_F + SZ_HM32, WS_HG_Q = WS_HG_K + SZ_HM16, WS_HG_V = WS_HG_Q + SZ_HM16, WS_HG_G = WS_HG_V + SZ_HM16;
constexpr size_t WS_MIX_END = WS_HG_G + SZ_TM16;
constexpr size_t SZ_SORT = (size_t)RMAX * 1024 * 2;
constexpr size_t WS_SORTA = WS_BIG, WS_YBUF = WS_BIG, WS_ACT = WS_BIG + SZ_SORT;
constexpr size_t WS_TIDX = WS_ACT + SZ_SORT;
constexpr size_t WS_TGATE = WS_TIDX + (size_t)T * 16;
constexpr size_t WS_SPOS = WS_TGATE + (size_t)T * 16;
constexpr size_t WS_GSORT = WS_SPOS + (size_t)T * 16;
constexpr size_t WS_RMAP = WS_GSORT + (size_t)RMAX * 4;
constexpr size_t WS_MOE_END = WS_RMAP + (size_t)RMAX * 4;
constexpr size_t WS_END = 2040 * MiB;
static_assert(WS_MIX_END <= WS_END && WS_MOE_END <= WS_END, "workspace map");
static_assert(WS_PROJ + (size_t)TP * NINP * 2 <= WS_RW_W, "proj vs prep");
static_assert(WS_HB + (size_t)TP * 1024 * 2 <= WS_BIG && WS_H + (size_t)TP * 4096 <= WS_HB, "h/hb");

constexpr int CW_TMO = 0, CW_CODE = 1;
constexpr int CW_BAR = 4096;
constexpr int CW_DSAQ = 8192;
constexpr int CW_ECNT = 8448;
constexpr int CW_ECUR = 8704;

constexpr int LDS_BYTES = 163840;
constexpr int MISC_OFF = 155648;
constexpr int MI_BAR = 0, MI_HIST = 64, MI_LCUR = 192, MI_LBASE = 320, MI_NT = 448, MI_OFFS = 512, MI_TILE = 1024;
constexpr int NWAVES = 8, NTHR = 512;

__device__ __forceinline__ float bf2f(unsigned short x) { return __uint_as_float((unsigned)x << 16); }
__device__ __forceinline__ float bflo(unsigned x) { return __uint_as_float(x << 16); }
__device__ __forceinline__ float bfhi(unsigned x) { return __uint_as_float(x & 0xffff0000u); }
typedef float f32x2_t __attribute__((ext_vector_type(2))); typedef __bf16 bf16x2_t __attribute__((ext_vector_type(2)));
__device__ __forceinline__ unsigned pk2(float lo, float hi) { const f32x2_t v = {lo, hi}; const bf16x2_t b = __builtin_convertvector(v, bf16x2_t); return __builtin_bit_cast(unsigned, b); }
__device__ __forceinline__ bf16 f2bf(float f) { return (bf16)(pk2(f, 0.f) & 0xffffu); }
__device__ __forceinline__ v4f ld_bf4(const bf16* p) { const v2u x = *(const v2u*)p; return (v4f){bflo(x.x), bfhi(x.x), bflo(x.y), bfhi(x.y)}; }
__device__ __forceinline__ void st_bf4(bf16* p, v4f v) { v2u o; o.x = pk2(v.x, v.y); o.y = pk2(v.z, v.w); *(v2u*)p = o; }
__device__ __forceinline__ float wave_max(float v) {
#pragma unroll
    for (int o = 1; o < 64; o <<= 1) v = fmaxf(v, __shfl_xor(v, o));
    return v;
}
template <int CTRL> __device__ __forceinline__ float dpp_f(float x) { return __int_as_float(__builtin_amdgcn_update_dpp(0, __float_as_int(x), CTRL, 0xF, 0xF, true)); }
__device__ __forceinline__ float sum8(float x) { x += dpp_f<0xB1>(x); x += dpp_f<0x4E>(x); x += dpp_f<0x141>(x); return x; }
__device__ __forceinline__ float sum16(float x) { x = sum8(x); x += dpp_f<0x140>(x); return x; }
__device__ __forceinline__ float wave_sum(float v) {
    v = sum16(v);
    v += __shfl_xor(v, 16); v += __shfl_xor(v, 32);
    return v;
}
__device__ __forceinline__ float rcp_(float x) { return __builtin_amdgcn_rcpf(x); }
__device__ __forceinline__ float rsq_(float x) { return __builtin_amdgcn_rsqf(x); }
__device__ __forceinline__ float sigmoidf_(float x) { return rcp_(1.f + __expf(-x)); }
__device__ __forceinline__ float softplusf_(float x) { return x > 20.f ? x : log1pf(__expf(x)); }
__device__ __forceinline__ float gelu_tanh(float x) { const float u = 0.7978845608028654f * (x + 0.044715f * x * x * x); return 0.5f * x * (1.f + tanhf(u)); }
__device__ __forceinline__ int lds_add(LAS int* p, int v) { return __hip_atomic_fetch_add(p, v, __ATOMIC_RELAXED, __HIP_MEMORY_SCOPE_WORKGROUP); }
#define LDS_WAIT() asm volatile("s_waitcnt lgkmcnt(0)" ::: "memory")
#define VM_WAIT() asm volatile("s_waitcnt vmcnt(0)" ::: "memory")

__device__ __forceinline__ GAS unsigned char* launder(unsigned char* p) { GAS unsigned char* g = (GAS unsigned char*)p; asm volatile("" : "+s"(g)); return g; }
__device__ __forceinline__ int opaque_tid() { int t = (int)threadIdx.x; asm volatile("" : "+v"(t)); return t; }
__device__ __forceinline__ int opaque_s(int x) { return __builtin_amdgcn_readfirstlane(x); }
struct Args { const float* in[36]; float* out; unsigned char* ws; int ph_lo, ph_hi; };
struct Ctx { const float* const* in; float* out; GAS unsigned char* ws; };
__device__ __forceinline__ const float* gin(const Ctx& A, int k) { return (const float*)(const GAS float*)A.in[k]; }
namespace pg8 {
#define PG8_LAS __attribute__((address_space(3)))
typedef unsigned short bf16_t;
typedef short bf16x8 __attribute__((ext_vector_type(8)));
typedef float f32x4 __attribute__((ext_vector_type(4)));
typedef unsigned u32x4 __attribute__((ext_vector_type(4)));
constexpr int BM = 256, BK = 64, HALF = 128, HTB = HALF * BK * 2  , STAGE_BYTES = 8 * HTB, NXCD = 8, WGM = 8;

__host__ __device__ __forceinline__ int lds_byte(int r, int c) { const int st = (r >> 4) * 2 + (c >> 5), rr = r & 15, cc = c & 31, ob = rr * 64 + cc * 2; return st * 1024 + (ob ^ (((ob >> 9) & 1) << 5)); }
__host__ __device__ __forceinline__ void stage_rc(int b, int& R, int& C) { const int st = b / 1024, sb = b % 1024, swz = sb ^ (((sb >> 9) & 1) << 5); R = (st >> 1) * 16 + swz / 64; C = (st & 1) * 32 + (swz % 64) / 2; }
__host__ __device__ __forceinline__ int perm32(int rho) { const int n = rho >> 4, i = rho & 15; return 8 * (i >> 2) + 4 * n + (i & 3); }

struct Unit { int pm, pn; };
struct Gemm { const bf16_t* A; const bf16_t* Bt; int M, N, K; };

struct StaticOrder {
    int nM, nN, nwg, G, c;
    __host__ __device__ void init(int M, int N, int G_, int c_) { nM = M / BM; nN = N / BM; nwg = nM * nN; G = G_; c = c_; }
    __host__ __device__ bool next(int i, Unit& u) const {
        const long L = (long)i * G + c; if (L >= nwg) return false;
        int wgid = (int)L; { const int q = nwg / NXCD, r = nwg % NXCD, xcd = wgid % NXCD, off = wgid / NXCD; wgid = (xcd < r ? xcd * (q + 1) : r * (q + 1) + (xcd - r) * q) + off; }
        const int nig = WGM * nN, gid = wgid / nig, fm = gid * WGM, gsz = (nM - fm) < WGM ? (nM - fm) : WGM;
        u.pm = fm + ((wgid % nig) % gsz); u.pn = (wgid % nig) / gsz; return true;
    }
    __device__ __forceinline__ void a_ready(const Unit&) const {}
    __device__ __forceinline__ void done(const Unit&) const {}
};

__device__ __forceinline__ unsigned cvt_pk_bf16(float lo, float hi) { unsigned r; asm volatile("v_cvt_pk_bf16_f32 %0, %1, %2" : "=v"(r) : "v"(lo), "v"(hi)); return r; }
typedef float f32x2 __attribute__((ext_vector_type(2)));
typedef unsigned u32x2v __attribute__((ext_vector_type(2)));
typedef float pf32x2_t __attribute__((ext_vector_type(2))); typedef __bf16 pbf16x2_t __attribute__((ext_vector_type(2)));
__device__ __forceinline__ unsigned cvt_pk_bf16c(float lo, float hi) { const pf32x2_t v = {lo, hi}; const pbf16x2_t q = __builtin_convertvector(v, pbf16x2_t); return __builtin_bit_cast(unsigned, q); }
struct EpiStoreBf16 {
    static constexpr bool PERM = true, AFTER_DRAIN = false;
    bf16_t* O; int ldc;
    __device__ __forceinline__ void operator()(const f32x4 (&acc)[2][2][4][2], const Unit& u, int wr, int wc, int fr, int fq) const {
        const int row0 = u.pm * BM + wr * 64 + fr, col0 = u.pn * BM + wc * 32 + 8 * fq;
#pragma unroll
        for (int ai = 0; ai < 2; ++ai)
#pragma unroll
            for (int m = 0; m < 4; ++m) { bf16_t* rowp = O + (size_t)(row0 + ai * HALF + m * 16) * ldc + col0;
#pragma unroll
                for (int bj = 0; bj < 2; ++bj) { const f32x4 v0 = acc[ai][bj][m][0], v1 = acc[ai][bj][m][1];
                    u32x4 w; w.x = cvt_pk_bf16c(v0[0], v0[1]); w.y = cvt_pk_bf16c(v0[2], v0[3]); w.z = cvt_pk_bf16c(v1[0], v1[1]); w.w = cvt_pk_bf16c(v1[2], v1[3]);
                    *(u32x4*)(rowp + bj * HALF) = w; } }
    }
};
struct EpiResid {
    static constexpr bool PERM = false, AFTER_DRAIN = false;
    float* Hres; int ldc; float alpha;
    __device__ __forceinline__ void operator()(const f32x4 (&acc)[2][2][4][2], const Unit& u, int wr, int wc, int fr, int fq) const {
        const int row0 = u.pm * BM + wr * 64 + fr, col0 = u.pn * BM + wc * 32 + 4 * fq;
#pragma unroll
        for (int ai = 0; ai < 2; ++ai)
#pragma unroll
            for (int m = 0; m < 4; ++m) { float* rowp = Hres + (size_t)(row0 + ai * HALF + m * 16) * ldc + col0;
#pragma unroll
                for (int bj = 0; bj < 2; ++bj)
#pragma unroll
                    for (int n = 0; n < 2; ++n) { f32x4* p = (f32x4*)(rowp + bj * HALF + n * 16); const f32x4 old = *p; *p = old * alpha + acc[ai][bj][m][n]; } }
    }
};
struct EpiResidBf {
    static constexpr bool PERM = true, AFTER_DRAIN = false;
    bf16_t* Hb; int ldc; float alpha;
    __device__ __forceinline__ void operator()(const f32x4 (&acc)[2][2][4][2], const Unit& u, int wr, int wc, int fr, int fq) const {
        const int row0 = u.pm * BM + wr * 64 + fr, col0 = u.pn * BM + wc * 32 + 8 * fq;
#pragma unroll
        for (int ai = 0; ai < 2; ++ai)
#pragma unroll
            for (int m = 0; m < 4; ++m) { bf16_t* rowp = Hb + (size_t)(row0 + ai * HALF + m * 16) * ldc + col0;
#pragma unroll
                for (int bj = 0; bj < 2; ++bj) { const f32x4 v0 = acc[ai][bj][m][0], v1 = acc[ai][bj][m][1]; const u32x4 o = *(const u32x4*)(rowp + bj * HALF);
#define RB_LO(x_) __builtin_bit_cast(float, (x_) << 16)
#define RB_HI(x_) __builtin_bit_cast(float, (x_) & 0xffff0000u)
                    u32x4 w; w.x = cvt_pk_bf16c(RB_LO(o.x) * alpha + v0[0], RB_HI(o.x) * alpha + v0[1]); w.y = cvt_pk_bf16c(RB_LO(o.y) * alpha + v0[2], RB_HI(o.y) * alpha + v0[3]);
                    w.z = cvt_pk_bf16c(RB_LO(o.z) * alpha + v1[0], RB_HI(o.z) * alpha + v1[1]); w.w = cvt_pk_bf16c(RB_LO(o.w) * alpha + v1[2], RB_HI(o.w) * alpha + v1[3]);
#undef RB_LO
#undef RB_HI
                    *(u32x4*)(rowp + bj * HALF) = w; } }
    }
};
struct EpiSwiGLU {
    static constexpr bool PERM = true, AFTER_DRAIN = false;
    bf16_t* ACT; const float* b1;
    __device__ __forceinline__ void operator()(const f32x4 (&acc)[2][2][4][2], const Unit& u, int wr, int wc, int fr, int fq) const {
        const int e = u.pn >> 3, pnl = u.pn & 7;
        const int row0 = u.pm * BM + wr * 64 + fr, c8 = pnl * 128 + wc * 32 + 8 * fq;
        const float* bg = b1 + (size_t)e * 2048 + c8; const float* bl = bg + 1024;
        const f32x4 bg0 = *(const f32x4*)bg, bg1 = *(const f32x4*)(bg + 4), bl0 = *(const f32x4*)bl, bl1 = *(const f32x4*)(bl + 4);
#pragma unroll
        for (int ai = 0; ai < 2; ++ai)
#pragma unroll
            for (int m = 0; m < 4; ++m) {
                float o[8];
#pragma unroll
                for (int n = 0; n < 2; ++n) { const f32x4 g4 = acc[ai][0][m][n] + (n ? bg1 : bg0), l4 = acc[ai][1][m][n] + (n ? bl1 : bl0);
#pragma unroll
                    for (int j = 0; j < 4; ++j) { const float glu = fminf(g4[j], 7.f), lin = fminf(fmaxf(l4[j], -7.f), 7.f);
                        o[n * 4 + j] = glu * __builtin_amdgcn_rcpf(1.f + __builtin_amdgcn_exp2f(glu * (-1.702f * 1.4426950408889634f))) * (lin + 1.f); } }
                u32x4 w; w.x = cvt_pk_bf16c(o[0], o[1]); w.y = cvt_pk_bf16c(o[2], o[3]); w.z = cvt_pk_bf16c(o[4], o[5]); w.w = cvt_pk_bf16c(o[6], o[7]);
                *(u32x4*)(ACT + (size_t)(row0 + ai * HALF + m * 16) * 1024 + c8) = w; }
    }
};
struct EpiMoeOut {
    static constexpr bool PERM = true, AFTER_DRAIN = false;
    bf16_t* Y; const float* b2; const float* gate;
    __device__ __forceinline__ void operator()(const f32x4 (&acc)[2][2][4][2], const Unit& u, int wr, int wc, int fr, int fq) const {
        const int e = u.pn >> 2, pnl = u.pn & 3;
        const int row0 = u.pm * BM + wr * 64 + fr, c8 = pnl * 256 + wc * 32 + 8 * fq;
        const float* bb = b2 + (size_t)e * 1024 + c8;
        f32x4 bv[2][2];
#pragma unroll
        for (int bj = 0; bj < 2; ++bj) { bv[bj][0] = *(const f32x4*)(bb + bj * HALF); bv[bj][1] = *(const f32x4*)(bb + bj * HALF + 4); }
#pragma unroll
        for (int ai = 0; ai < 2; ++ai)
#pragma unroll
            for (int m = 0; m < 4; ++m) { const int row = row0 + ai * HALF + m * 16; const float gt = gate[row];
#pragma unroll
                for (int bj = 0; bj < 2; ++bj) { const f32x4 v0 = (acc[ai][bj][m][0] + bv[bj][0]) * gt, v1 = (acc[ai][bj][m][1] + bv[bj][1]) * gt;
                    u32x4 w; w.x = cvt_pk_bf16c(v0[0], v0[1]); w.y = cvt_pk_bf16c(v0[2], v0[3]); w.z = cvt_pk_bf16c(v1[0], v1[1]); w.w = cvt_pk_bf16c(v1[2], v1[3]);
                    *(u32x4*)(Y + (size_t)row * 1024 + c8 + bj * HALF) = w; } }
    }
};
struct MoeOrder {
    int n_units, G, c, npn; const PG8_LAS int* tile_e;
    __device__ __forceinline__ bool next(int i, Unit& u) const {
        const int Lx = i * G + c; if (Lx >= n_units) return false;
        const int tile = Lx / npn, pnl = Lx - tile * npn;
        u.pm = tile; u.pn = tile_e[tile] * npn + pnl; return true;
    }
    __device__ __forceinline__ void a_ready(const Unit&) const {}
    __device__ __forceinline__ void done(const Unit&) const {}
};

template <class Epi, class Sched, bool ALIGN_EPI = false, bool SP2 = false>
__device__ __forceinline__ void gemm_phase(PG8_LAS unsigned char* lds, const Gemm g, const Sched& S, const Epi& E) {
    const int tid = opaque_tid(), wid = __builtin_amdgcn_readfirstlane(tid >> 6), lane = tid & 63, wr = wid >> 2, wc = wid & 3, fr = lane & 15, fq = lane >> 4;
    const int K = g.K, nt = K / BK;
    unsigned voffA[2], voffB[2];
#pragma unroll
    for (int i = 0; i < 2; ++i) { int R, C; stage_rc(tid * 16 + i * 8192, R, C); const int Rb = Epi::PERM ? ((R & ~31) + perm32(R & 31)) : R;
        voffA[i] = (unsigned)(R * K + C) * 2u; voffB[i] = (unsigned)(Rb * K + C) * 2u; }
    const size_t kstep = (size_t)(BK * 2);
    const size_t hstep = (size_t)HALF * K * 2;
    const size_t tstep = 2 * hstep;
    const unsigned ldsw = (unsigned)wid * 1024u;
    const int aoff = lds_byte(wr * 64 + fr, fq * 8), boff = lds_byte(wc * 32 + fr, fq * 8);
#define PG8_SA(b, h) (((b) * 2 + (h)) * HTB)
#define PG8_SB(b, h) ((4 + (b) * 2 + (h)) * HTB)
#define PG8_STAGE(bufoff, gbase, voff) do { _Pragma("unroll") for (int _i = 0; _i < 2; ++_i) \
        __builtin_amdgcn_global_load_lds((const unsigned*)((const char*)(gbase) + (voff)[_i]), (PG8_LAS unsigned*)(lds + (bufoff) + ldsw + _i * 8192), 16, 0, 0); } while (0)
#define PG8_LDA(dst, b, h) do { _Pragma("unroll") for (int m = 0; m < 4; ++m) _Pragma("unroll") for (int k = 0; k < 2; ++k) dst[m][k] = *(const PG8_LAS bf16x8*)(lds + PG8_SA(b, h) + aoff + m * 2048 + k * 1024); } while (0)
#define PG8_LDB(dst, b, h) do { _Pragma("unroll") for (int n = 0; n < 2; ++n) _Pragma("unroll") for (int k = 0; k < 2; ++k) dst[n][k] = *(const PG8_LAS bf16x8*)(lds + PG8_SB(b, h) + boff + n * 2048 + k * 1024); } while (0)
#define PG8_MMA(ai, bj, At, Bt) do { __builtin_amdgcn_s_setprio(1); _Pragma("unroll") for (int m = 0; m < 4; ++m) _Pragma("unroll") for (int n = 0; n < 2; ++n) _Pragma("unroll") for (int k = 0; k < 2; ++k) \
        acc[ai][bj][m][n] = __builtin_amdgcn_mfma_f32_16x16x32_bf16(Bt[n][k], At[m][k], acc[ai][bj][m][n], 0, 0, 0); __builtin_amdgcn_s_setprio(0); } while (0)
#define PG8_WAIT_V(n) asm volatile("s_waitcnt vmcnt(" #n ")" ::: "memory")
#define PG8_WAIT_L(n) asm volatile("s_waitcnt lgkmcnt(" #n ")" ::: "memory")
#define PG8_BAR __builtin_amdgcn_s_barrier()
#define PG8_SCHED __builtin_amdgcn_sched_barrier(0)
    Unit cur, nxt; int ui = 0;
    if (!S.next(0, cur)) return;
    f32x4 acc[2][2][4][2];
#pragma unroll
    for (int a = 0; a < 2; ++a)
#pragma unroll
        for (int b = 0; b < 2; ++b)
#pragma unroll
            for (int m = 0; m < 4; ++m)
#pragma unroll
                for (int n = 0; n < 2; ++n) acc[a][b][m][n] = (f32x4){0.f, 0.f, 0.f, 0.f};
    bf16x8 At[4][2], B0[2][2], B1[2][2];
    const char* cA = (const char*)g.A + (size_t)cur.pm * tstep; const char* cB = (const char*)g.Bt + (size_t)cur.pn * tstep;
    S.a_ready(cur);
    if constexpr (SP2) {
        PG8_STAGE(PG8_SB(0, 0), cB, voffB); PG8_STAGE(PG8_SB(0, 1), cB + hstep, voffB); PG8_STAGE(PG8_SA(0, 0), cA, voffA); PG8_STAGE(PG8_SA(0, 1), cA + hstep, voffA);
        if (wr == 1) PG8_BAR;
        PG8_WAIT_V(2); PG8_BAR;
        PG8_STAGE(PG8_SB(1, 0), cB + kstep, voffB); PG8_STAGE(PG8_SA(1, 0), cA + kstep, voffA); PG8_STAGE(PG8_SB(1, 1), cB + hstep + kstep, voffB);
        PG8_WAIT_V(6); PG8_BAR;
    } else {
        PG8_STAGE(PG8_SB(0, 0), cB, voffB); PG8_STAGE(PG8_SA(0, 0), cA, voffA); PG8_STAGE(PG8_SB(0, 1), cB + hstep, voffB); PG8_STAGE(PG8_SA(0, 1), cA + hstep, voffA);
        if (wr == 1) PG8_BAR;
        PG8_WAIT_V(4); PG8_BAR;
        PG8_STAGE(PG8_SB(1, 0), cB + kstep, voffB); PG8_STAGE(PG8_SA(1, 0), cA + kstep, voffA); PG8_STAGE(PG8_SB(1, 1), cB + hstep + kstep, voffB);
        PG8_WAIT_V(6); PG8_BAR;
    }
    for (;;) {
        const bool has_next = S.next(ui + 1, nxt);
        const char* nA = has_next ? (const char*)g.A + (size_t)nxt.pm * tstep : cA; const char* nB = has_next ? (const char*)g.Bt + (size_t)nxt.pn * tstep : cB;
        for (int t = 0; t < nt; t += 2) {
            const bool last = (t == nt - 2);
            const char* a1 = cA + (size_t)(t + 1) * kstep;
            const char* a2 = last ? nA : cA + (size_t)(t + 2) * kstep; const char* b2 = last ? nB : cB + (size_t)(t + 2) * kstep;
            const char* a3 = a2 + kstep; const char* b3 = b2 + kstep;
            if (last && has_next) S.a_ready(nxt);
            if constexpr (SP2) {
            PG8_LDB(B0, 0, 0); PG8_LDB(B1, 0, 1); PG8_SCHED; PG8_LDA(At, 0, 0); PG8_STAGE(PG8_SA(1, 1), a1 + hstep, voffA);
            PG8_WAIT_V(8); PG8_WAIT_L(0); PG8_BAR; PG8_MMA(0, 0, At, B0); PG8_MMA(0, 1, At, B1); PG8_BAR; PG8_SCHED;
            PG8_LDA(At, 0, 1); PG8_STAGE(PG8_SB(0, 0), b2, voffB); PG8_STAGE(PG8_SB(0, 1), b2 + hstep, voffB); PG8_STAGE(PG8_SA(0, 0), a2, voffA);
            PG8_WAIT_V(8); PG8_WAIT_L(0); PG8_BAR; PG8_MMA(1, 0, At, B0); PG8_MMA(1, 1, At, B1); PG8_BAR; PG8_SCHED;
            PG8_LDB(B0, 1, 0); PG8_LDB(B1, 1, 1); PG8_SCHED; PG8_LDA(At, 1, 0); PG8_STAGE(PG8_SA(0, 1), a2 + hstep, voffA);
            PG8_WAIT_V(8); PG8_WAIT_L(0); PG8_BAR; PG8_MMA(0, 0, At, B0); PG8_MMA(0, 1, At, B1); PG8_BAR; PG8_SCHED;
            PG8_LDA(At, 1, 1); PG8_STAGE(PG8_SB(1, 0), b3, voffB); PG8_STAGE(PG8_SB(1, 1), b3 + hstep, voffB); PG8_STAGE(PG8_SA(1, 0), a3, voffA);
            PG8_WAIT_V(8); PG8_WAIT_L(0); PG8_BAR; PG8_MMA(1, 0, At, B0); PG8_MMA(1, 1, At, B1); PG8_BAR; PG8_SCHED;
            } else {
            PG8_LDB(B0, 0, 0); PG8_SCHED; PG8_LDA(At, 0, 0); PG8_STAGE(PG8_SA(1, 1), a1 + hstep, voffA);
            PG8_WAIT_L(8); PG8_BAR; PG8_WAIT_L(0); PG8_MMA(0, 0, At, B0); PG8_BAR; PG8_SCHED;
            PG8_LDB(B1, 0, 1); PG8_STAGE(PG8_SB(0, 0), b2, voffB);
            PG8_BAR; PG8_WAIT_L(0); PG8_MMA(0, 1, At, B1); PG8_BAR;
            PG8_LDA(At, 0, 1); PG8_STAGE(PG8_SA(0, 0), a2, voffA);
            PG8_BAR; PG8_WAIT_L(0); PG8_MMA(1, 0, At, B0); PG8_BAR; PG8_SCHED;
            PG8_STAGE(PG8_SB(0, 1), b2 + hstep, voffB);
            PG8_WAIT_V(6); PG8_BAR; PG8_MMA(1, 1, At, B1); PG8_BAR;
            PG8_LDB(B0, 1, 0); PG8_SCHED; PG8_LDA(At, 1, 0); PG8_STAGE(PG8_SA(0, 1), a2 + hstep, voffA);
            PG8_WAIT_L(8); PG8_BAR; PG8_WAIT_L(0); PG8_MMA(0, 0, At, B0); PG8_BAR; PG8_SCHED;
            PG8_LDB(B1, 1, 1); PG8_STAGE(PG8_SB(1, 0), b3, voffB);
            PG8_BAR; PG8_WAIT_L(0); PG8_MMA(0, 1, At, B1); PG8_BAR;
            PG8_LDA(At, 1, 1); PG8_STAGE(PG8_SA(1, 0), a3, voffA);
            PG8_BAR; PG8_WAIT_L(0); PG8_MMA(1, 0, At, B0); PG8_BAR; PG8_SCHED;
            PG8_STAGE(PG8_SB(1, 1), b3 + hstep, voffB);
            PG8_WAIT_V(6); PG8_BAR; PG8_MMA(1, 1, At, B1); PG8_BAR;
            }
        }
        if constexpr (ALIGN_EPI) { if (wr == 0) PG8_BAR; }
        if constexpr (!Epi::AFTER_DRAIN) { E(acc, cur, wr, wc, fr, fq); S.done(cur); }
        if (!has_next) break;
#pragma unroll
        for (int a = 0; a < 2; ++a)
#pragma unroll
            for (int b = 0; b < 2; ++b)
#pragma unroll
                for (int m = 0; m < 4; ++m)
#pragma unroll
                    for (int n = 0; n < 2; ++n) acc[a][b][m][n] = (f32x4){0.f, 0.f, 0.f, 0.f};
        cur = nxt; cA = nA; cB = nB; ++ui;
        if constexpr (ALIGN_EPI) { if (wr == 1) PG8_BAR; }
    }
    PG8_WAIT_V(0);
    if constexpr (!ALIGN_EPI) { if (wr == 0) PG8_BAR; }
    PG8_BAR;
    if constexpr (Epi::AFTER_DRAIN) { E.fused(acc, cur, wr, wc, fr, fq, lds, wid, lane); S.done(cur); }
#undef PG8_SA
#undef PG8_SB
#undef PG8_STAGE
#undef PG8_LDA
#undef PG8_LDB
#undef PG8_MMA
#undef PG8_WAIT_V
#undef PG8_WAIT_L
#undef PG8_BAR
#undef PG8_SCHED
}
}
namespace pg8 {
template <class Epi, class Sched>
__device__ __forceinline__ void gemm_phase_gather(PG8_LAS unsigned char* lds, const Gemm g, const Sched& S, const Epi& E, const int* rmap) {
    constexpr bool ALIGN_EPI = true, SP2 = true;
    const int tid = opaque_tid(), wid = __builtin_amdgcn_readfirstlane(tid >> 6), lane = tid & 63, wr = wid >> 2, wc = wid & 3, fr = lane & 15, fq = lane >> 4;
    const int K = g.K, nt = K / BK;
    unsigned voffB[2];
#pragma unroll
    for (int i = 0; i < 2; ++i) { int R, C; stage_rc(tid * 16 + i * 8192, R, C); const int Rb = Epi::PERM ? ((R & ~31) + perm32(R & 31)) : R;
        voffB[i] = (unsigned)(Rb * K + C) * 2u; }
    const size_t kstep = (size_t)(BK * 2);
    const size_t hstep = (size_t)HALF * K * 2;
    const size_t tstep = 2 * hstep;
    const unsigned ldsw = (unsigned)wid * 1024u;
    const int aoff = lds_byte(wr * 64 + fr, fq * 8), boff = lds_byte(wc * 32 + fr, fq * 8);
#define PG8_SA(b, h) (((b) * 2 + (h)) * HTB)
#define PG8_SB(b, h) ((4 + (b) * 2 + (h)) * HTB)
#define PG8_STAGE(bufoff, gbase, voff) do { _Pragma("unroll") for (int _i = 0; _i < 2; ++_i) \
        __builtin_amdgcn_global_load_lds((const unsigned*)((const char*)(gbase) + (voff)[_i]), (PG8_LAS unsigned*)(lds + (bufoff) + ldsw + _i * 8192), 16, 0, 0); } while (0)
#define PG8_LDA(dst, b, h) do { _Pragma("unroll") for (int m = 0; m < 4; ++m) _Pragma("unroll") for (int k = 0; k < 2; ++k) dst[m][k] = *(const PG8_LAS bf16x8*)(lds + PG8_SA(b, h) + aoff + m * 2048 + k * 1024); } while (0)
#define PG8_LDB(dst, b, h) do { _Pragma("unroll") for (int n = 0; n < 2; ++n) _Pragma("unroll") for (int k = 0; k < 2; ++k) dst[n][k] = *(const PG8_LAS bf16x8*)(lds + PG8_SB(b, h) + boff + n * 2048 + k * 1024); } while (0)
#define PG8_MMA(ai, bj, At, Bt) do { __builtin_amdgcn_s_setprio(1); _Pragma("unroll") for (int m = 0; m < 4; ++m) _Pragma("unroll") for (int n = 0; n < 2; ++n) _Pragma("unroll") for (int k = 0; k < 2; ++k) \
        acc[ai][bj][m][n] = __builtin_amdgcn_mfma_f32_16x16x32_bf16(Bt[n][k], At[m][k], acc[ai][bj][m][n], 0, 0, 0); __builtin_amdgcn_s_setprio(0); } while (0)
#define PG8_WAIT_V(n) asm volatile("s_waitcnt vmcnt(" #n ")" ::: "memory")
#define PG8_WAIT_L(n) asm volatile("s_waitcnt lgkmcnt(" #n ")" ::: "memory")
#define PG8_BAR __builtin_amdgcn_s_barrier()
#define PG8_SCHED __builtin_amdgcn_sched_barrier(0)
    Unit cur, nxt; int ui = 0;
    if (!S.next(0, cur)) return;
    f32x4 acc[2][2][4][2];
#pragma unroll
    for (int a = 0; a < 2; ++a)
#pragma unroll
        for (int b = 0; b < 2; ++b)
#pragma unroll
            for (int m = 0; m < 4; ++m)
#pragma unroll
                for (int n = 0; n < 2; ++n) acc[a][b][m][n] = (f32x4){0.f, 0.f, 0.f, 0.f};
    bf16x8 At[4][2], B0[2][2], B1[2][2];
    const char* gA = (const char*)g.A; const char* cB = (const char*)g.Bt + (size_t)cur.pn * tstep;
    unsigned gofc[2][2];
    constexpr int RM_OFF = 8 * HTB;
#pragma unroll
    for (int i_ = 0; i_ < 2; ++i_) { int R, C; stage_rc(tid * 16 + i_ * 8192, R, C);
#pragma unroll
        for (int h_ = 0; h_ < 2; ++h_) gofc[h_][i_] = (unsigned)rmap[(size_t)cur.pm * BM + h_ * HALF + R] * (unsigned)(K * 2) + (unsigned)C * 2u; }
    S.a_ready(cur);
    if constexpr (SP2) {
        PG8_STAGE(PG8_SB(0, 0), cB, voffB); PG8_STAGE(PG8_SB(0, 1), cB + hstep, voffB); PG8_STAGE(PG8_SA(0, 0), gA, gofc[0]); PG8_STAGE(PG8_SA(0, 1), gA, gofc[1]);
        if (wr == 1) PG8_BAR;
        PG8_WAIT_V(2); PG8_BAR;
        PG8_STAGE(PG8_SB(1, 0), cB + kstep, voffB); PG8_STAGE(PG8_SA(1, 0), gA + kstep, gofc[0]); PG8_STAGE(PG8_SB(1, 1), cB + hstep + kstep, voffB);
        PG8_WAIT_V(6); PG8_BAR;
    }
    for (;;) {
        const bool has_next = S.next(ui + 1, nxt);
        const char* nB = has_next ? (const char*)g.Bt + (size_t)nxt.pn * tstep : cB;
        if (has_next) { const unsigned rmoff = (unsigned)(opaque_tid() & 255) * 4u;
            __builtin_amdgcn_global_load_lds((const unsigned*)((const char*)(rmap + (size_t)nxt.pm * BM) + rmoff), (PG8_LAS unsigned*)(lds + RM_OFF + wid * 256), 4, 0, 0); }
        for (int t = 0; t < nt; t += 2) {
            const bool last = (t == nt - 2);
            const char* a1 = gA + (size_t)(t + 1) * kstep;
            const char* a2 = last ? gA : gA + (size_t)(t + 2) * kstep; const char* b2 = last ? nB : cB + (size_t)(t + 2) * kstep;
            const char* a3 = a2 + kstep; const char* b3 = b2 + kstep;
            if (last && has_next) S.a_ready(nxt);
            if constexpr (SP2) {
            PG8_LDB(B0, 0, 0); PG8_LDB(B1, 0, 1); PG8_SCHED; PG8_LDA(At, 0, 0); PG8_STAGE(PG8_SA(1, 1), a1, gofc[1]);
            PG8_WAIT_V(8); PG8_WAIT_L(0); PG8_BAR; PG8_MMA(0, 0, At, B0); PG8_MMA(0, 1, At, B1); PG8_BAR; PG8_SCHED;
            if (last && has_next) { const int tid2 = opaque_tid();
#pragma unroll
                for (int i_ = 0; i_ < 2; ++i_) { int R, C; stage_rc(tid2 * 16 + i_ * 8192, R, C);
#pragma unroll
                    for (int h_ = 0; h_ < 2; ++h_) gofc[h_][i_] = (unsigned)*(const PG8_LAS int*)(lds + RM_OFF + (h_ * HALF + R) * 4) * (unsigned)(K * 2) + (unsigned)C * 2u; }
                PG8_SCHED; }
            PG8_LDA(At, 0, 1); PG8_STAGE(PG8_SB(0, 0), b2, voffB); PG8_STAGE(PG8_SB(0, 1), b2 + hstep, voffB); PG8_STAGE(PG8_SA(0, 0), a2, gofc[0]);
            PG8_WAIT_V(8); PG8_WAIT_L(0); PG8_BAR; PG8_MMA(1, 0, At, B0); PG8_MMA(1, 1, At, B1); PG8_BAR; PG8_SCHED;
            PG8_LDB(B0, 1, 0); PG8_LDB(B1, 1, 1); PG8_SCHED; PG8_LDA(At, 1, 0); PG8_STAGE(PG8_SA(0, 1), a2, gofc[1]);
            PG8_WAIT_V(8); PG8_WAIT_L(0); PG8_BAR; PG8_MMA(0, 0, At, B0); PG8_MMA(0, 1, At, B1); PG8_BAR; PG8_SCHED;
            PG8_LDA(At, 1, 1); PG8_STAGE(PG8_SB(1, 0), b3, voffB); PG8_STAGE(PG8_SB(1, 1), b3 + hstep, voffB); PG8_STAGE(PG8_SA(1, 0), a3, gofc[0]);
            PG8_WAIT_V(8); PG8_WAIT_L(0); PG8_BAR; PG8_MMA(1, 0, At, B0); PG8_MMA(1, 1, At, B1); PG8_BAR; PG8_SCHED;
            }
        }
        if constexpr (ALIGN_EPI) { if (wr == 0) PG8_BAR; }
        if constexpr (!Epi::AFTER_DRAIN) { const int lane2 = opaque_tid() & 63; E(acc, cur, wr, wc, lane2 & 15, lane2 >> 4); S.done(cur); }
        if (!has_next) break;
#pragma unroll
        for (int a = 0; a < 2; ++a)
#pragma unroll
            for (int b = 0; b < 2; ++b)
#pragma unroll
                for (int m = 0; m < 4; ++m)
#pragma unroll
                    for (int n = 0; n < 2; ++n) acc[a][b][m][n] = (f32x4){0.f, 0.f, 0.f, 0.f};
        cur = nxt; cB = nB; ++ui;
        if constexpr (ALIGN_EPI) { if (wr == 1) PG8_BAR; }
    }
    PG8_WAIT_V(0);
    if constexpr (!ALIGN_EPI) { if (wr == 0) PG8_BAR; }
    PG8_BAR;
    if constexpr (Epi::AFTER_DRAIN) { E.fused(acc, cur, wr, wc, fr, fq, lds, wid, lane); S.done(cur); }
#undef PG8_SA
#undef PG8_SB
#undef PG8_STAGE
#undef PG8_LDA
#undef PG8_LDB
#undef PG8_MMA
#undef PG8_WAIT_V
#undef PG8_WAIT_L
#undef PG8_BAR
#undef PG8_SCHED
}
}
#define XB_TMO      128
#define XB_XCNT(j)  (256  + 64 * (j))
#define XB_XSUB(j)  (1280 + 64 * (j))
#define XB_XGEN(j)  (2304 + 64 * (j))
#define XB_TOP      3328
#define XB_TOPGEN   3392
#define XCD_BAR_WORDS 3456
#define XB_SPIN_CAP (1u << 18)
#define LAS __attribute__((address_space(3)))

__device__ __forceinline__ unsigned xb_ld(unsigned* p)              { return __hip_atomic_load(p, __ATOMIC_RELAXED, __HIP_MEMORY_SCOPE_AGENT); }
__device__ __forceinline__ unsigned xb_add(unsigned* p, unsigned v) { return __hip_atomic_fetch_add(p, v, __ATOMIC_RELAXED, __HIP_MEMORY_SCOPE_AGENT); }
__device__ __forceinline__ unsigned xb_xcc_id() { return (unsigned)__builtin_amdgcn_s_getreg((3 << 11) | 20) & 0xFu; }
#define XB_SPIN(cond, bar) do { unsigned _sp = 0; while (cond) { __builtin_amdgcn_s_sleep(1); \
    if ((++_sp & 255u) == 0u) { if (xb_ld(&(bar)[XB_TMO])) break; if (_sp > XB_SPIN_CAP) { atomicAdd(&(bar)[XB_TMO], 1u); break; } } } } while (0)

struct XcdBarrier {
    unsigned* bar; unsigned x;
    volatile LAS unsigned* st;
};

__device__ __forceinline__ XcdBarrier xcd_barrier_post(unsigned* bar, volatile LAS unsigned* st) {
    XcdBarrier b; b.bar = bar; b.x = xb_xcc_id(); b.st = st;
    if (threadIdx.x == 0) (void)xb_add(&bar[XB_XCNT(b.x)], 1u);
    return b;
}
__device__ __forceinline__ void xcd_barrier_complete(unsigned* bar, unsigned x, unsigned& nloc, unsigned& nx) {
    const unsigned G = gridDim.x * gridDim.y * gridDim.z;
    unsigned sum, cnt, mine, sp = 0u;
    for (;;) {
        sum = 0u; cnt = 0u; mine = 0u;
#pragma unroll
        for (unsigned j = 0; j < 16; ++j) { const unsigned c = xb_ld(&bar[XB_XCNT(j)]); sum += c; cnt += (c > 0u) ? 1u : 0u; mine = (j == x) ? c : mine; }
        if (sum == G) break;
        __builtin_amdgcn_s_sleep(1);
        if ((++sp & 255u) == 0u) { if (xb_ld(&bar[XB_TMO])) break; if (sp > XB_SPIN_CAP) { atomicAdd(&bar[XB_TMO], 1u); break; } }
    }
    nloc = mine > 0u ? mine : 1u; nx = cnt > 0u ? cnt : 1u;
}

__device__ __forceinline__ void xcd_barrier(const XcdBarrier& b) {
    asm volatile("s_waitcnt vmcnt(0)" ::: "memory");
    __syncthreads();
    if (threadIdx.x == 0) {
        unsigned* bar = b.bar;
        __builtin_amdgcn_s_waitcnt(0);
        unsigned nloc = b.st[0], nx = b.st[1];
        if (nloc == 0u) { xcd_barrier_complete(bar, b.x, nloc, nx); b.st[0] = nloc; b.st[1] = nx; }
        const unsigned old = xb_add(&bar[XB_XSUB(b.x)], 1u);
        const unsigned gen = old / nloc;
        if (old + 1u == (gen + 1u) * nloc) {
            __builtin_amdgcn_fence(__ATOMIC_RELEASE, "agent");
            asm volatile("s_waitcnt vmcnt(0)" ::: "memory");
            const unsigned og = xb_add(&bar[XB_TOP], 1u);
            const unsigned tg = og / nx;
            if (og + 1u == (tg + 1u) * nx) xb_add(&bar[XB_TOPGEN], 1u);
            else XB_SPIN(xb_ld(&bar[XB_TOPGEN]) == tg, bar);
            __builtin_amdgcn_fence(__ATOMIC_ACQUIRE, "agent");
            xb_add(&bar[XB_XGEN(b.x)], 1u);
            asm volatile("s_waitcnt vmcnt(0)" ::: "memory");
        } else {
            XB_SPIN(xb_ld(&bar[XB_XGEN(b.x)]) == gen, bar);
            __builtin_amdgcn_fence(__ATOMIC_ACQUIRE, "agent");
            asm volatile("s_waitcnt vmcnt(0)" ::: "memory");
        }
    }
    __syncthreads();
}
__device__ __forceinline__ void p0_transpose_item(const float* W, int ldw, int ncols_valid, int k0, int n0, bf16* WT, size_t dst_row0, int Kdst, LAS float* scr, int lane) {
    const int nn = n0 + (lane & 31); const bool ok = nn < ncols_valid;
#pragma unroll 8
    for (int i = 0; i < 32; ++i) { const int kk = 2 * i + (lane >> 5); scr[kk * 33 + (lane & 31)] = ok ? W[(size_t)(k0 + kk) * ldw + nn] : 0.f; }
    LDS_WAIT();
    const int c = lane & 7;
#pragma unroll
    for (int j = 0; j < 4; ++j) { const int n = (lane >> 3) + 8 * j; const LAS float* s = scr + (8 * c) * 33 + n;
        v4u o; o.x = pk2(s[0 * 33], s[1 * 33]); o.y = pk2(s[2 * 33], s[3 * 33]); o.z = pk2(s[4 * 33], s[5 * 33]); o.w = pk2(s[6 * 33], s[7 * 33]);
        *(v4u*)(WT + (dst_row0 + n) * (size_t)Kdst + k0 + 8 * c) = o; }
    LDS_WAIT();
}
__device__ __forceinline__ void ln_row(v4f (&v)[4], const float* g, const float* b, int lane) {
    float s = 0.f, s2 = 0.f;
#pragma unroll
    for (int j = 0; j < 4; ++j) { s += (v[j].x + v[j].y) + (v[j].z + v[j].w); s2 += (v[j].x * v[j].x + v[j].y * v[j].y) + (v[j].z * v[j].z + v[j].w * v[j].w); }
    s = wave_sum(s); s2 = wave_sum(s2);
    const float mean = s * (1.f / D);
    const float rstd = rsq_(fmaxf(s2 * (1.f / D) - mean * mean, 0.f) + LN_EPS);
#pragma unroll
    for (int j = 0; j < 4; ++j) v[j] = v[j] - mean;
#pragma unroll
    for (int j = 0; j < 4; ++j) { const v4f gg = *(const v4f*)(g + 256 * j + 4 * lane), bb = *(const v4f*)(b + 256 * j + 4 * lane); v[j] = v[j] * rstd * gg + bb; }
}
__device__ PHASE_FN void p0_prologue(const Ctx A, LAS unsigned char* lds, int vcu, int G) {
    const int tid = opaque_tid(), lane = tid & 63, wave = tid >> 6;
    LAS float* scr = (LAS float*)(lds + wave * 16384);
    const int gw = vcu * NWAVES + wave, NGW = G * NWAVES;
    bf16* Win_t = (bf16*)(A.ws + WS_WIN); bf16* Wout_t = (bf16*)(A.ws + WS_WOUT); bf16* W1_t = (bf16*)(A.ws + WS_W1); bf16* W2_t = (bf16*)(A.ws + WS_W2);
    constexpr int I_IN = 2 * 16 * (NINP / 32), I_OUT = 2 * 16 * 32, I_W1 = 64 * 16 * 64, I_W2 = 64 * 16 * 32;
    constexpr int NITEMS = I_IN + I_OUT + I_W1 + I_W2;
    for (int it = gw; it < NITEMS; it += NGW) {
        int r = it;
        if (r < I_IN) { const int l = r / (16 * 112), q = r % (16 * 112), kb = q / 112, nb = q % 112;
            p0_transpose_item(gin(A, 4) + (size_t)l * 1024 * 3560, 3560, 3560, kb * 64, nb * 32, Win_t + (size_t)l * NINP * 1024, (size_t)nb * 32, 1024, scr, lane); continue; }
        r -= I_IN;
        if (r < I_OUT) { const int l = r / 512, q = r % 512, kb = q / 32, nb = q % 32;
            p0_transpose_item(gin(A, 25) + (size_t)l * 1024 * 1024, 1024, 1024, kb * 64, nb * 32, Wout_t + (size_t)l * 1024 * 1024, (size_t)nb * 32, 1024, scr, lane); continue; }
        r -= I_OUT;
        if (r < I_W1) { const int le = r / 1024, q = r % 1024, kb = q / 64, nb = q % 64, n0 = nb * 32;
            const int np = n0 & 1023; const size_t drow = (size_t)256 * (np >> 7) + (n0 >= 1024 ? 128 : 0) + (np & 127);
            p0_transpose_item(gin(A, 30) + (size_t)le * 1024 * 2048, 2048, 2048, kb * 64, n0, W1_t + (size_t)le * 2048 * 1024, drow, 1024, scr, lane); continue; }
        r -= I_W1;
        { const int le = r / 512, q = r % 512, kb = q / 32, nb = q % 32;
            p0_transpose_item(gin(A, 32) + (size_t)le * 1024 * 1024, 1024, 1024, kb * 64, nb * 32, W2_t + (size_t)le * 1024 * 1024, (size_t)nb * 32, 1024, scr, lane); }
    }
    bf16* HB = (bf16*)(A.ws + WS_HB);
    for (int m = gw; m < T; m += NGW) {
        const int b = m / L, i = m - b * L;
        const float* src = (i < NMETA) ? gin(A, 1) + (size_t)i * D : gin(A, 0) + ((size_t)b * SEQ + (i - NMETA)) * D;
        v4f v[4];
#pragma unroll
        for (int j = 0; j < 4; ++j) v[j] = *(const v4f*)(src + 256 * j + 4 * lane);
        ln_row(v, gin(A, 2), gin(A, 3), lane);
#pragma unroll
        for (int j = 0; j < 4; ++j) st_bf4(HB + (size_t)m * D + 256 * j + 4 * lane, v[j]);
    }
}
constexpr int NTK = 2;
__device__ __forceinline__ float softplus_fast(float x) { return x > 15.f ? x : __logf(1.f + __expf(x)); }
__device__ __forceinline__ float tanh_fast(float x) { return 1.f - 2.f * rcp_(1.f + __expf(2.f * x)); }
__device__ __forceinline__ void sincos_red(float ang, float& sn, float& cs) {
    const float k = rintf(ang * 0.15915494309189535f);
    float r = fmaf(-k, 6.28318548202514648f, ang); r = fmaf(-k, -1.7484555e-7f, r);
    sn = __sinf(r); cs = __cosf(r);
}
constexpr int PREP_W = 98304, PREP_SCR = 4096;
__device__ __forceinline__ void prep_load_w(LAS unsigned char* lds, const float* src, int n, int dst_elem, int tid) {
    for (int i = tid * 4; i < n; i += NTHR * 4) { const v4f x = *(const v4f*)(src + i); v2u o; o.x = pk2(x.x, x.y); o.y = pk2(x.z, x.w); *(LAS v2u*)(lds + (size_t)(dst_elem + i) * 2) = o; }
}
__device__ PHASE_FN void prep_phase(const Ctx A, LAS unsigned char* lds, int l, int vcu, int G) {
    const int tid = opaque_tid(), lane = tid & 63, wave = tid >> 6;
    LAS float* scr = (LAS float*)(lds + PREP_W + wave * PREP_SCR);
    const int gw = vcu * NWAVES + wave, NGW = G * NWAVES;
    const bf16* PROJ = (const bf16*)(A.ws + WS_PROJ);
    const int c4 = 4 * lane, hh = lane >> 4, d4 = 4 * (lane & 15);
    const float* mu = gin(A, 5) + l * 960; const float* w0 = gin(A, 6) + l * 256; const float* w2 = gin(A, 7) + l * 64 * 256;
    const float* a0 = gin(A, 8) + l * 256; const float* a2 = gin(A, 9) + l * 64 * 256; const float* g2 = gin(A, 10) + l * 64 * 256;
    const float* k_k = gin(A, 11) + l * 256; const float* k_a = gin(A, 12) + l * 256; const float* r_k = gin(A, 13) + l * 256;
    const float* conv_w = gin(A, 16) + l * 4 * 256; const float* conv_b = gin(A, 17) + l * 256;
    const float* wa = gin(A, 18) + l * 4 * 64 * 64; const float* ba = gin(A, 19) + l * 256; const float* wx = gin(A, 20) + l * 4 * 64 * 64; const float* bx = gin(A, 21) + l * 256;
    const float* lam = gin(A, 22) + l * 256; const float* lbs = gin(A, 23);
    float* RW_W = (float*)(A.ws + WS_RW_W); bf16* RW_A = (bf16*)(A.ws + WS_RW_A); bf16* RW_B = (bf16*)(A.ws + WS_RW_B); bf16* RW_K = (bf16*)(A.ws + WS_RW_K);
    bf16* RW_WR = (bf16*)(A.ws + WS_RW_WR); bf16* RW_V = (bf16*)(A.ws + WS_RW_V); bf16* RW_G = (bf16*)(A.ws + WS_RW_G); float* RW_SC = (float*)(A.ws + WS_RW_SC);
    bf16* DS_Q = (bf16*)(A.ws + WS_DS_Q); bf16* DS_K = (bf16*)(A.ws + WS_DS_K); bf16* DS_V = (bf16*)(A.ws + WS_DS_V); bf16* DS_QI = (bf16*)(A.ws + WS_DS_QI);
    bf16* DS_KI = (bf16*)(A.ws + WS_DS_KI); float* DS_WI = (float*)(A.ws + WS_DS_WI);
    float* LR_A = (float*)(A.ws + WS_LR_A); bf16* LR_U = (bf16*)(A.ws + WS_LR_U); bf16* LR_G = (bf16*)(A.ws + WS_LR_G);
    float* HG_F = (float*)(A.ws + WS_HG_F); bf16* HG_K = (bf16*)(A.ws + WS_HG_K); bf16* HG_Q = (bf16*)(A.ws + WS_HG_Q); bf16* HG_V = (bf16*)(A.ws + WS_HG_V); bf16* HG_G = (bf16*)(A.ws + WS_HG_G);
    LAS unsigned* kmaxl = (LAS unsigned*)(lds + MISC_OFF + 640);
    LAS unsigned* kimaxl = (LAS unsigned*)(lds + MISC_OFF + 832);
    if (tid < 32) kmaxl[tid] = 0u;
    if (tid < 8) kimaxl[tid] = 0u;
    const bool q_rot = (lane & 15) < 4, q_hi = (lane & 15) >= 2;
    const bool i_rot = (lane & 7) < 2, i_hi = (lane & 7) == 1;

#define BF4R(q_) ((v4f){bflo((q_).x), bfhi((q_).x), bflo((q_).y), bfhi((q_).y)})
    {
        constexpr int RC_OFF = 98304;
        static_assert(RC_OFF + 8 * 1024 <= MISC_OFF, "pass R lds");
        for (int f = tid; f < 96 * 64; f += NTHR) { const int ln = f & 63, fr = f >> 6, ks = fr & 1, nt = (fr >> 1) & 15, mat = fr >> 5, rr = ln & 15, g8 = ln >> 4;
            const float* W = (mat == 0 ? w2 : mat == 1 ? a2 : g2) + (32 * ks + 8 * g8) * 256 + 16 * nt + rr;
            v4u o; o.x = pk2(W[0], W[256]); o.y = pk2(W[512], W[768]); o.z = pk2(W[1024], W[1280]); o.w = pk2(W[1536], W[1792]);
            *(LAS v4u*)(lds + (size_t)fr * 1024 + ln * 16) = o; }
        LAS float* rc = (LAS float*)(lds + RC_OFF);
        if (tid < 256) { rc[tid] = mu[C_RW_R + tid]; rc[256 + tid] = mu[C_RW_K + tid]; rc[512 + tid] = mu[C_RW_V + tid]; rc[768 + tid] = w0[tid];
            rc[1024 + tid] = a0[tid]; rc[1280 + tid] = k_k[tid]; rc[1536 + tid] = k_a[tid]; rc[1792 + tid] = r_k[tid]; }
        __syncthreads();
        const int r = lane & 15, g = lane >> 4;
        const v4f z4 = (v4f){0.f, 0.f, 0.f, 0.f};
#pragma unroll 1
        for (int tile = gw; tile < T / 16; tile += NGW) {
            const int m0 = tile * 16, b = m0 / L, i = m0 - b * L + r;
            const bf16* rowc = PROJ + (size_t)(m0 + r) * NINP;
            const bool hasp = i > 0; const bf16* rowp = hasp ? rowc - NINP : rowc;
            pg8::bf16x8 Bf[3][2];
#pragma unroll
            for (int mat = 0; mat < 3; ++mat)
#pragma unroll
                for (int ks = 0; ks < 2; ++ks) { const int off = (mat == 0 ? C_RW_WD : mat == 1 ? C_RW_AD : C_RW_GD) + 32 * ks + 8 * g;
                    const v4u cq = *(const v4u*)(rowc + off), pq = *(const v4u*)(rowp + off);
                    const v4f m0v = *(const v4f*)(mu + off), m1v = *(const v4f*)(mu + off + 4);
                    float o8[8];
#pragma unroll
                    for (int e = 0; e < 8; ++e) { const unsigned cw = cq[e >> 1], pw = pq[e >> 1];
                        const float cur = (e & 1) ? bfhi(cw) : bflo(cw), prv = hasp ? ((e & 1) ? bfhi(pw) : bflo(pw)) : 0.f;
                        const float sv = cur + (prv - cur) * (e < 4 ? m0v[e & 3] : m1v[e & 3]);
                        o8[e] = mat == 0 ? tanh_fast(sv) : mat == 1 ? sv : sigmoidf_(sv); }
                    v4u pk; pk.x = pk2(o8[0], o8[1]); pk.y = pk2(o8[2], o8[3]); pk.z = pk2(o8[4], o8[5]); pk.w = pk2(o8[6], o8[7]);
                    Bf[mat][ks] = __builtin_bit_cast(pg8::bf16x8, pk); }
#pragma unroll 1
            for (int hd = 0; hd < 4; ++hd) {
                pg8::f32x4 Cw[4], Ca[4], Cg[4];
#pragma unroll
                for (int nt = 0; nt < 4; ++nt) {
                    const LAS unsigned char* wf = lds + (size_t)((hd * 4 + nt) * 2) * 1024 + lane * 16;
                    pg8::f32x4 cw = (pg8::f32x4){0.f, 0.f, 0.f, 0.f}, ca = cw, cg = cw;
#pragma unroll
                    for (int ks = 0; ks < 2; ++ks) {
                        cw = __builtin_amdgcn_mfma_f32_16x16x32_bf16(*(const LAS pg8::bf16x8*)(wf + ks * 1024), Bf[0][ks], cw, 0, 0, 0);
                        ca = __builtin_amdgcn_mfma_f32_16x16x32_bf16(*(const LAS pg8::bf16x8*)(wf + 32768 + ks * 1024), Bf[1][ks], ca, 0, 0, 0);
                        cg = __builtin_amdgcn_mfma_f32_16x16x32_bf16(*(const LAS pg8::bf16x8*)(wf + 65536 + ks * 1024), Bf[2][ks], cg, 0, 0, 0); }
                    Cw[nt] = cw; Ca[nt] = ca; Cg[nt] = cg;
                }
                const size_t hrow = ((size_t)(b * 4 + hd) * L + i);
                v4f kun[4], kav_[4];
                float n2 = 0.f, sbr = 0.f, skr = 0.f, sbo = 0.f;
#pragma unroll
                for (int nt = 0; nt < 4; ++nt) {
                    const int cc = hd * 64 + 16 * nt + 4 * g, d4h = 16 * nt + 4 * g;
                    const v4f cr = BF4R(*(const v2u*)(rowc + C_RW_R + cc)), ck = BF4R(*(const v2u*)(rowc + C_RW_K + cc)), cv = BF4R(*(const v2u*)(rowc + C_RW_V + cc));
                    const v4f pr = hasp ? BF4R(*(const v2u*)(rowp + C_RW_R + cc)) : z4, pk_ = hasp ? BF4R(*(const v2u*)(rowp + C_RW_K + cc)) : z4, pv = hasp ? BF4R(*(const v2u*)(rowp + C_RW_V + cc)) : z4;
                    const v4f mu_r = *(const LAS v4f*)(rc + cc), mu_k = *(const LAS v4f*)(rc + 256 + cc), mu_v = *(const LAS v4f*)(rc + 512 + cc), w0v = *(const LAS v4f*)(rc + 768 + cc);
                    const v4f a0v = *(const LAS v4f*)(rc + 1024 + cc), kkv = *(const LAS v4f*)(rc + 1280 + cc), kav = *(const LAS v4f*)(rc + 1536 + cc), rkv = *(const LAS v4f*)(rc + 1792 + cc);
                    const v4f rs = cr + (pr - cr) * mu_r, kx = ck + (pk_ - ck) * mu_k, vs = cv + (pv - cv) * mu_v;
                    v4f dec, km, wr, lg;
#pragma unroll
                    for (int e = 0; e < 4; ++e) {
                        const float wv = -softplus_fast(-(w0v[e] + Cw[nt][e])) - 0.5f;
                        dec[e] = __expf(-__expf(wv));
                        const float av = sigmoidf_(a0v[e] + Ca[nt][e]);
                        const float ku = kx[e] * kkv[e]; kun[nt][e] = ku; kav_[nt][e] = ku * av; n2 += ku * ku;
                        km[e] = kx[e] * (1.f + (av - 1.f) * kav[e]);
                        wr[e] = dec[e] * rs[e]; sbr += ku * av * rs[e]; skr += km[e] * rs[e]; sbo += rs[e] * km[e] * rkv[e];
                        lg[e] = Cg[nt][e]; }
                    *(v4f*)(RW_W + hrow * 64 + d4h) = dec; st_bf4(RW_K + hrow * 64 + d4h, km); st_bf4(RW_WR + hrow * 64 + d4h, wr); st_bf4(RW_V + hrow * 64 + d4h, vs);
                    st_bf4(RW_G + (size_t)(m0 + r) * 256 + cc, lg);
                }
                n2 += __shfl_xor(n2, 16); n2 += __shfl_xor(n2, 32);
                const float inv = rcp_(fmaxf(sqrtf(n2), 1e-12f));
#pragma unroll
                for (int nt = 0; nt < 4; ++nt) { const int d4h = 16 * nt + 4 * g;
                    st_bf4(RW_A + hrow * 64 + d4h, kun[nt] * (-inv)); st_bf4(RW_B + hrow * 64 + d4h, kav_[nt] * inv); }
                sbr *= inv;
                sbr += __shfl_xor(sbr, 16); sbr += __shfl_xor(sbr, 32); skr += __shfl_xor(skr, 16); skr += __shfl_xor(skr, 32); sbo += __shfl_xor(sbo, 16); sbo += __shfl_xor(sbo, 32);
                if (g == 0) *(v4f*)(RW_SC + hrow * 4) = (v4f){sbr, skr, sbo, 0.f};
            }
        }
    }
    __syncthreads();
    {
        constexpr int XT_PITCH = 528, XT_BYTES = 16 * XT_PITCH, XT_OFF = 65536, LCST_OFF = XT_OFF + NWAVES * XT_BYTES;
        static_assert(LCST_OFF + 3 * 1024 <= MISC_OFF, "pass L lds");
        for (int f = tid; f < 64 * 64; f += NTHR) { const int ln = f & 63, fr = f >> 6, ks = fr & 1, nt = (fr >> 1) & 3, hd = (fr >> 3) & 3, mat = fr >> 5, rr = ln & 15, g8 = ln >> 4;
            const float* W = (mat ? wx : wa) + hd * 4096 + (32 * ks + 8 * g8) * 64 + 16 * nt + rr;
            v4u o; o.x = pk2(W[0], W[64]); o.y = pk2(W[128], W[192]); o.z = pk2(W[256], W[320]); o.w = pk2(W[384], W[448]);
            *(LAS v4u*)(lds + (size_t)fr * 1024 + ln * 16) = o; }
        LAS float* cst = (LAS float*)(lds + LCST_OFF);
        if (tid < 256) { cst[tid] = ba[tid]; cst[256 + tid] = bx[tid];
            const float xs = -lam[tid], ys = __expf(xs);
            cst[512 + tid] = xs > 15.f ? xs : (ys < 0.01f ? ys * (1.f - ys * (0.5f - ys * 0.33333334f)) : __logf(1.f + ys)); }
        __syncthreads();
        LAS unsigned char* xt = lds + XT_OFF + wave * XT_BYTES;
        const int r = lane & 15, g = lane >> 4;
        const v4f cb = *(const v4f*)(conv_b + c4), cw0 = *(const v4f*)(conv_w + c4), cw1 = *(const v4f*)(conv_w + 256 + c4), cw2 = *(const v4f*)(conv_w + 512 + c4), cw3 = *(const v4f*)(conv_w + 768 + c4);
#pragma unroll 1
        for (int tile = gw; tile < T / 16; tile += NGW) {
            const int m0 = tile * 16, b = m0 / L, i0 = m0 - b * L;
            const bf16* Pq = PROJ + (size_t)m0 * NINP;
            v2u xb[19], gr[16];
#pragma unroll
            for (int q = 0; q < 19; ++q) { const int ro = (i0 + q - 3 >= 0) ? q - 3 : 0; xb[q] = *(const v2u*)(Pq + (ptrdiff_t)ro * NINP + C_LR_X + c4); }
#pragma unroll
            for (int t = 0; t < 16; ++t) gr[t] = *(const v2u*)(Pq + (size_t)t * NINP + C_LR_G + c4);
            const v4f z4 = (v4f){0.f, 0.f, 0.f, 0.f};
            v4f x0 = i0 > 0 ? BF4R(xb[0]) : z4, x1 = i0 > 0 ? BF4R(xb[1]) : z4, x2 = i0 > 0 ? BF4R(xb[2]) : z4;
#pragma unroll
            for (int t = 0; t < 16; ++t) {
                const v4f x3 = BF4R(xb[t + 3]);
                const v4f xc = cb + cw0 * x0 + cw1 * x1 + cw2 * x2 + cw3 * x3;
                v2u o; o.x = pk2(xc.x, xc.y); o.y = pk2(xc.z, xc.w);
                *(LAS v2u*)(xt + t * XT_PITCH + c4 * 2) = o;
                x0 = x1; x1 = x2; x2 = x3;
                const v4f gv = BF4R(gr[t]); v4f gg;
#pragma unroll
                for (int e = 0; e < 4; ++e) { const float tt = 0.7978845608028654f * (gv[e] + 0.044715f * gv[e] * gv[e] * gv[e]); gg[e] = 0.5f * gv[e] * (1.f + tanh_fast(tt)); }
                st_bf4(LR_G + (size_t)(m0 + t) * 256 + c4, gg);
            }
            LDS_WAIT();
#pragma unroll 1
            for (int hd = 0; hd < 4; ++hd) {
                const LAS unsigned char* xrow = xt + r * XT_PITCH + hd * 128;
                const pg8::bf16x8 bk0 = *(const LAS pg8::bf16x8*)(xrow + g * 16), bk1 = *(const LAS pg8::bf16x8*)(xrow + 64 + g * 16);
                pg8::f32x4 Ca[4], Cx[4];
#pragma unroll
                for (int nt = 0; nt < 4; ++nt) {
                    const LAS unsigned char* wf = lds + (size_t)((hd * 4 + nt) * 2) * 1024 + lane * 16;
                    const pg8::bf16x8 a0 = *(const LAS pg8::bf16x8*)(wf), a1 = *(const LAS pg8::bf16x8*)(wf + 1024), x0f = *(const LAS pg8::bf16x8*)(wf + 32768), x1f = *(const LAS pg8::bf16x8*)(wf + 32768 + 1024);
                    pg8::f32x4 ca = (pg8::f32x4){0.f, 0.f, 0.f, 0.f}, cx = ca;
                    ca = __builtin_amdgcn_mfma_f32_16x16x32_bf16(a0, bk0, ca, 0, 0, 0); ca = __builtin_amdgcn_mfma_f32_16x16x32_bf16(a1, bk1, ca, 0, 0, 0);
                    cx = __builtin_amdgcn_mfma_f32_16x16x32_bf16(x0f, bk0, cx, 0, 0, 0); cx = __builtin_amdgcn_mfma_f32_16x16x32_bf16(x1f, bk1, cx, 0, 0, 0);
                    Ca[nt] = ca; Cx[nt] = cx;
                }
#pragma unroll
                for (int nt = 0; nt < 4; ++nt) {
                    const int c0 = hd * 64 + 16 * nt + 4 * g;
                    const v4f bav = *(const LAS v4f*)(cst + c0), bxv = *(const LAS v4f*)(cst + 256 + c0), spl = *(const LAS v4f*)(cst + 512 + c0);
                    const v2u xq = *(const LAS v2u*)(xt + r * XT_PITCH + c0 * 2); const v4f xc = BF4R(xq);
                    v4f aa, uu;
#pragma unroll
                    for (int e = 0; e < 4; ++e) { const float rg = sigmoidf_(Ca[nt][e] + bav[e]), ig = sigmoidf_(Cx[nt][e] + bxv[e]);
                        const float la = -8.f * rg * spl[e]; aa[e] = __expf(la);
                        const float x2l = 2.f * la; const float om = (x2l > -0.1f) ? -(x2l * (1.f + x2l * (0.5f + x2l * (0.16666667f + x2l * 0.041666668f)))) : (1.f - __expf(x2l));
                        uu[e] = xc[e] * ig * __builtin_amdgcn_sqrtf(om); }
                    const size_t mo = (size_t)(m0 + r) * 256 + c0;
                    *(v4f*)(LR_A + mo) = aa; st_bf4(LR_U + mo, uu);
                }
            }
        }
    }
    {
        float invf_q[4], invf_i[4];
#pragma unroll
        for (int e = 0; e < 4; ++e) { invf_q[e] = exp2f(-(float)((d4 + e) & 7) * (18.931568569324174f / 8.f)); invf_i[e] = exp2f(-(float)e * (18.931568569324174f / 4.f)); }
        v4f lb = (v4f){0.f, 0.f, 0.f, 0.f};
        if (l == 1) { const v4f x0 = *(const v4f*)(lbs + c4), x1 = *(const v4f*)(lbs + 256 + c4);
            lb.x = 1.f / (1.f + __expf(x0.x - x1.x)); lb.y = 1.f / (1.f + __expf(x0.y - x1.y)); lb.z = 1.f / (1.f + __expf(x0.z - x1.z)); lb.w = 1.f / (1.f + __expf(x0.w - x1.w)); }
#pragma unroll 2
        for (int m = gw; m < T; m += NGW) {
            const int b = m / L, i = m - b * L; const float pos = (float)i;
            const bf16* Pj = PROJ + (size_t)m * NINP;
            v4f q = ld_bf4(Pj + C_DS_Q + c4), k = ld_bf4(Pj + C_DS_K + c4);
            const v4f v = ld_bf4(Pj + C_DS_V + c4);
            v4f qi = ld_bf4(Pj + C_DS_QI + c4), ki = ld_bf4(Pj + C_DS_KI + 4 * (lane & 7));
            const v4f hq = ld_bf4(Pj + C_HG_Q + c4), z = ld_bf4(Pj + C_HG_F + c4), vi = ld_bf4(Pj + C_HG_I + c4), hgt = ld_bf4(Pj + C_HG_G + c4);
#pragma unroll
            for (int e = 0; e < 4; ++e) {
                const float qp = __shfl_xor(q[e], 2), kp = __shfl_xor(k[e], 2), qip = __shfl_xor(qi[e], 1), kip = __shfl_xor(ki[e], 1);
                float sn, cs; sincos_red(pos * invf_q[e], sn, cs);
                if (q_rot) { q[e] = q_hi ? (qp * sn + q[e] * cs) : (q[e] * cs - qp * sn); k[e] = q_hi ? (kp * sn + k[e] * cs) : (k[e] * cs - kp * sn); }
                sincos_red(pos * invf_i[e], sn, cs);
                if (i_rot) { qi[e] = i_hi ? (qip * sn + qi[e] * cs) : (qi[e] * cs - qip * sn); ki[e] = i_hi ? (kip * sn + ki[e] * cs) : (ki[e] * cs - kip * sn); }
            }
            { float kn2 = sum16(k.x * k.x + k.y * k.y + k.z * k.z + k.w * k.w); if ((lane & 15) == 0) __hip_atomic_fetch_max(kmaxl + b * 4 + hh, __float_as_uint(kn2 * 1.02f), __ATOMIC_RELAXED, __HIP_MEMORY_SCOPE_WORKGROUP); }
            st_bf4(DS_Q + (size_t)m * 256 + c4, q * (0.125f * 1.4426950408889634f));      st_bf4(DS_K + (size_t)m * 256 + c4, k); st_bf4(DS_V + (size_t)m * 256 + c4, v); st_bf4(DS_QI + (size_t)m * 256 + c4, qi);
            { float in2 = sum8(ki.x * ki.x + ki.y * ki.y + ki.z * ki.z + ki.w * ki.w); if (lane == 0) __hip_atomic_fetch_max(kimaxl + b, __float_as_uint(in2 * 1.02f), __ATOMIC_RELAXED, __HIP_MEMORY_SCOPE_WORKGROUP); }
            if (lane < 8) { st_bf4(DS_KI + (size_t)m * 32 + 4 * lane, ki); DS_WI[(size_t)m * 8 + lane] = bf2f(Pj[C_DS_WI + lane]) * 0.0625f; }
            v4f qs, f, kq, gs;
#pragma unroll
            for (int e = 0; e < 4; ++e) { const float sg = sigmoidf_(z[e]); qs[e] = hq[e] * sigmoidf_(hq[e]); f[e] = lb[e] + (1.f - lb[e]) * sg; kq[e] = (1.f - lb[e]) * (1.f - sg); gs[e] = hgt[e] * sigmoidf_(hgt[e]); }
            const size_t hm = ((size_t)(b * 4 + hh) * L + i) * 64 + d4;
            *(v4f*)(HG_F + hm) = f; st_bf4(HG_K + hm, kq); st_bf4(HG_Q + hm, qs); st_bf4(HG_V + hm, vi); st_bf4(HG_G + (size_t)m * 256 + c4, gs);
        }
    }
    __syncthreads();
    if (tid < 32) atomicMax((unsigned*)(A.ws + WS_CTL) + 8960 + 64 * l + tid, kmaxl[tid]);
    if (tid < 8) atomicMax((unsigned*)(A.ws + WS_CTL) + 9216 + 64 * l + tid, kimaxl[tid]);
}
constexpr int SC_C = 32;
constexpr size_t WS_YRAW = WS_PROJ;
constexpr size_t WS_ORAW = WS_PROJ + (size_t)T * 1024;
__device__ PHASE_FN void rwkv_scan(const Ctx A, LAS unsigned char* lds, int unit_) {
    const int unit = opaque_s(unit_);
    const int tid = opaque_tid(), row = tid >> 4, kp = tid & 15;
    const int bh = unit >> 1, half = unit & 1, b = bh >> 2, h = bh & 3;
    const size_t base = (size_t)bh * L * 64;
    const float* W = (const float*)(A.ws + WS_RW_W) + base;
    const bf16* Av = (const bf16*)(A.ws + WS_RW_A) + base; const bf16* Bv = (const bf16*)(A.ws + WS_RW_B) + base; const bf16* Kv = (const bf16*)(A.ws + WS_RW_K) + base;
    const bf16* WRv = (const bf16*)(A.ws + WS_RW_WR) + base; const bf16* Vv = (const bf16*)(A.ws + WS_RW_V) + base + half * 32;
    const float* SC = (const float*)(A.ws + WS_RW_SC) + (size_t)bh * L * 4;
    float* YR = (float*)(A.ws + WS_YRAW) + (size_t)b * L * 256 + h * 64 + half * 32;
    constexpr int ARR = SC_C * 64;
    constexpr int BUF = (5 * ARR + SC_C * 32 + SC_C * 4) * 4;
    LAS float* ybuf = (LAS float*)(lds + 2 * BUF);
    float S0 = 0.f, S1 = 0.f, S2 = 0.f, S3 = 0.f;
    v4f rw; v2u ra, rb, rk, rwr, rv; float rsc = 0.f;
    const int e4 = tid * 4;
#define RW_LOAD(c) do { const int t0_ = (c) * SC_C; const bool ok_ = (t0_ + (e4 >> 6)) < L; const size_t o_ = (size_t)t0_ * 64 + e4; \
        rw = ok_ ? *(const v4f*)(W + o_) : (v4f){1.f, 1.f, 1.f, 1.f}; ra = ok_ ? *(const v2u*)(Av + o_) : (v2u){0u, 0u}; rb = ok_ ? *(const v2u*)(Bv + o_) : (v2u){0u, 0u}; \
        rk = ok_ ? *(const v2u*)(Kv + o_) : (v2u){0u, 0u}; rwr = ok_ ? *(const v2u*)(WRv + o_) : (v2u){0u, 0u}; \
        if (tid < SC_C * 8) rv = (t0_ + (tid >> 3)) < L ? *(const v2u*)(Vv + (size_t)(t0_ + (tid >> 3)) * 64 + (tid & 7) * 4) : (v2u){0u, 0u}; \
        if (tid < SC_C * 4) rsc = (t0_ + (tid >> 2)) < L ? SC[(size_t)t0_ * 4 + tid] : 0.f; } while (0)
#define RW_STORE(p) do { LAS float* d_ = (LAS float*)(lds + (p) * BUF); \
        *(LAS v4f*)(d_ + e4) = rw; *(LAS v4f*)(d_ + ARR + e4) = (v4f){bflo(ra.x), bfhi(ra.x), bflo(ra.y), bfhi(ra.y)}; *(LAS v4f*)(d_ + 2 * ARR + e4) = (v4f){bflo(rb.x), bfhi(rb.x), bflo(rb.y), bfhi(rb.y)}; \
        *(LAS v4f*)(d_ + 3 * ARR + e4) = (v4f){bflo(rk.x), bfhi(rk.x), bflo(rk.y), bfhi(rk.y)}; *(LAS v4f*)(d_ + 4 * ARR + e4) = (v4f){bflo(rwr.x), bfhi(rwr.x), bflo(rwr.y), bfhi(rwr.y)}; \
        if (tid < SC_C * 8) *(LAS v4f*)(d_ + 5 * ARR + tid * 4) = (v4f){bflo(rv.x), bfhi(rv.x), bflo(rv.y), bfhi(rv.y)}; if (tid < SC_C * 4) d_[5 * ARR + SC_C * 32 + tid] = rsc; } while (0)
    constexpr int NCH = (L + SC_C - 1) / SC_C;
    RW_LOAD(0); RW_STORE(0); __syncthreads();
#pragma unroll 1
    for (int c = 0; c < NCH; ++c) {
        const int p = c & 1;
        if (c + 1 < NCH) RW_LOAD(c + 1);
        const int ns = (L - c * SC_C) < SC_C ? (L - c * SC_C) : SC_C;
        const LAS float* d = (const LAS float*)(lds + p * BUF);
        const LAS float* q = d + kp * 4; const LAS float* dv = d + 5 * ARR + row; const LAS float* dsc = d + 5 * ARR + SC_C * 32;
        v4f w4 = *(const LAS v4f*)(q), a4 = *(const LAS v4f*)(q + ARR), b4 = *(const LAS v4f*)(q + 2 * ARR), k4 = *(const LAS v4f*)(q + 3 * ARR), r4 = *(const LAS v4f*)(q + 4 * ARR);
        float vv = dv[0]; v2f sc = *(const LAS v2f*)(dsc);
#pragma unroll 2
        for (int s = 0; s < ns; ++s) {
            const int sn = (s + 1 < SC_C) ? s + 1 : s;
            const v4f nw4 = *(const LAS v4f*)(q + sn * 64), na4 = *(const LAS v4f*)(q + ARR + sn * 64), nb4 = *(const LAS v4f*)(q + 2 * ARR + sn * 64);
            const v4f nk4 = *(const LAS v4f*)(q + 3 * ARR + sn * 64), nr4 = *(const LAS v4f*)(q + 4 * ARR + sn * 64);
            const float nvv = dv[sn * 32]; const v2f nsc = *(const LAS v2f*)(dsc + sn * 4);
            float sa = (S0 * a4.x + S1 * a4.y) + (S2 * a4.z + S3 * a4.w), y1 = (S0 * r4.x + S1 * r4.y) + (S2 * r4.z + S3 * r4.w);
            sa = sum16(sa); y1 = sum16(y1);
            S0 = S0 * w4.x + sa * b4.x + vv * k4.x; S1 = S1 * w4.y + sa * b4.y + vv * k4.y; S2 = S2 * w4.z + sa * b4.z + vv * k4.z; S3 = S3 * w4.w + sa * b4.w + vv * k4.w;
            const float yo = y1 + sa * sc.x + vv * sc.y;
            if (kp == 0) ybuf[s * 32 + row] = yo;
            w4 = nw4; a4 = na4; b4 = nb4; k4 = nk4; r4 = nr4; vv = nvv; sc = nsc;
        }
        __syncthreads();
        { const int s = tid >> 4, r2 = (tid & 15) * 2;
          if (s < ns) *(v2f*)(YR + (size_t)(c * SC_C + s) * 256 + r2) = *(const LAS v2f*)(ybuf + s * 32 + r2); }
        if (c + 1 < NCH) RW_STORE(1 - p);
        __syncthreads();
    }
#undef RW_LOAD
#undef RW_STORE
}
__device__ PHASE_FN void hgrn_scan(const Ctx A, LAS unsigned char* lds, int unit_) {
    const int unit = opaque_s(unit_);
    const int tid = opaque_tid(), row = tid >> 4, kp = tid & 15;
    const int bh = unit >> 1, half = unit & 1, b = bh >> 2, h = bh & 3;
    const size_t base = (size_t)bh * L * 64;
    const float* Fv = (const float*)(A.ws + WS_HG_F) + base;
    const bf16* Kv = (const bf16*)(A.ws + WS_HG_K) + base; const bf16* Qv = (const bf16*)(A.ws + WS_HG_Q) + base; const bf16* Vv = (const bf16*)(A.ws + WS_HG_V) + base + half * 32;
    float* OR = (float*)(A.ws + WS_ORAW) + (size_t)b * L * 256 + h * 64 + half * 32;
    constexpr int ARR = SC_C * 64; constexpr int BUF = (3 * ARR + SC_C * 32) * 4;
    LAS float* obuf = (LAS float*)(lds + 2 * BUF);
    float S0 = 0.f, S1 = 0.f, S2 = 0.f, S3 = 0.f;
    v4f rf; v2u rk, rq, rv;
    const int e4 = tid * 4;
#define HG_LOAD(c) do { const int t0_ = (c) * SC_C; const bool ok_ = (t0_ + (e4 >> 6)) < L; const size_t o_ = (size_t)t0_ * 64 + e4; \
        rf = ok_ ? *(const v4f*)(Fv + o_) : (v4f){1.f, 1.f, 1.f, 1.f}; rk = ok_ ? *(const v2u*)(Kv + o_) : (v2u){0u, 0u}; rq = ok_ ? *(const v2u*)(Qv + o_) : (v2u){0u, 0u}; \
        if (tid < SC_C * 8) rv = (t0_ + (tid >> 3)) < L ? *(const v2u*)(Vv + (size_t)(t0_ + (tid >> 3)) * 64 + (tid & 7) * 4) : (v2u){0u, 0u}; } while (0)
#define HG_STORE(p) do { LAS float* d_ = (LAS float*)(lds + (p) * BUF); \
        *(LAS v4f*)(d_ + e4) = rf; *(LAS v4f*)(d_ + ARR + e4) = (v4f){bflo(rk.x), bfhi(rk.x), bflo(rk.y), bfhi(rk.y)}; \
        *(LAS v4f*)(d_ + 2 * ARR + e4) = (v4f){bflo(rq.x), bfhi(rq.x), bflo(rq.y), bfhi(rq.y)}; \
        if (tid < SC_C * 8) *(LAS v4f*)(d_ + 3 * ARR + tid * 4) = (v4f){bflo(rv.x), bfhi(rv.x), bflo(rv.y), bfhi(rv.y)}; } while (0)
    constexpr int NCH = (L + SC_C - 1) / SC_C;
    HG_LOAD(0); HG_STORE(0); __syncthreads();
#pragma unroll 1
    for (int c = 0; c < NCH; ++c) {
        const int p = c & 1;
        if (c + 1 < NCH) HG_LOAD(c + 1);
        const int ns = (L - c * SC_C) < SC_C ? (L - c * SC_C) : SC_C;
        const LAS float* d = (const LAS float*)(lds + p * BUF);
        const LAS float* q = d + kp * 4; const LAS float* dv = d + 3 * ARR + row;
        v4f f4 = *(const LAS v4f*)(q), k4 = *(const LAS v4f*)(q + ARR), q4 = *(const LAS v4f*)(q + 2 * ARR); float vv = dv[0];
#pragma unroll 2
        for (int s = 0; s < ns; ++s) {
            const int sn = (s + 1 < SC_C) ? s + 1 : s;
            const v4f nf4 = *(const LAS v4f*)(q + sn * 64), nk4 = *(const LAS v4f*)(q + ARR + sn * 64), nq4 = *(const LAS v4f*)(q + 2 * ARR + sn * 64);
            const float nvv = dv[sn * 32];
            S0 = S0 * f4.x + k4.x * vv; S1 = S1 * f4.y + k4.y * vv; S2 = S2 * f4.z + k4.z * vv; S3 = S3 * f4.w + k4.w * vv;
            float o = (q4.x * S0 + q4.y * S1) + (q4.z * S2 + q4.w * S3);
            o = sum16(o);
            if (kp == 0) obuf[s * 32 + row] = o;
            f4 = nf4; k4 = nk4; q4 = nq4; vv = nvv;
        }
        __syncthreads();
        { const int s = tid >> 4, r2 = (tid & 15) * 2;
          if (s < ns) *(v2f*)(OR + (size_t)(c * SC_C + s) * 256 + r2) = *(const LAS v2f*)(obuf + s * 32 + r2); }
        if (c + 1 < NCH) HG_STORE(1 - p);
        __syncthreads();
    }
#undef HG_LOAD
#undef HG_STORE
}
__device__ PHASE_FN void mixers_finish(const Ctx A, int l, int vcu, int G) {
    const int tid = opaque_tid(), lane = tid & 63, wave = tid >> 6;
    const int gw = vcu * NWAVES + wave, NGW = G * NWAVES;
    const int c4 = 4 * lane, hh = lane >> 4, d4 = 4 * (lane & 15);
    const float* YR = (const float*)(A.ws + WS_YRAW); const float* OR = (const float*)(A.ws + WS_ORAW);
    const bf16* RV = (const bf16*)(A.ws + WS_RW_V); const float* SC = (const float*)(A.ws + WS_RW_SC); const bf16* RG = (const bf16*)(A.ws + WS_RW_G); const bf16* HGt = (const bf16*)(A.ws + WS_HG_G);
    bf16* MIX = (bf16*)(A.ws + WS_MIX);
    const v4f lg = *(const v4f*)(gin(A, 14) + l * 256 + c4), lb = *(const v4f*)(gin(A, 15) + l * 256 + c4), ng = *(const v4f*)(gin(A, 24) + l * 256 + c4);
#pragma unroll 2
    for (int m = gw; m < T; m += NGW) {
        const int b = m / L, i = m - b * L; const size_t hm = ((size_t)(b * 4 + hh) * L + i);
        const v4f y = *(const v4f*)(YR + (size_t)m * 256 + c4), o = *(const v4f*)(OR + (size_t)m * 256 + c4);
        const v4f vv = ld_bf4(RV + hm * 64 + d4), g = ld_bf4(RG + (size_t)m * 256 + c4), hg = ld_bf4(HGt + (size_t)m * 256 + c4);
        const float bonus = SC[hm * 4 + 2];
        const float mean = sum16((y.x + y.y) + (y.z + y.w)) * (1.f / 64.f); const v4f dy = y - mean;
        const float var = sum16((dy.x * dy.x + dy.y * dy.y) + (dy.z * dy.z + dy.w * dy.w)) * (1.f / 64.f);
        const v4f yn = (dy * rsqrtf(var + 64e-5f) * lg + lb + vv * bonus) * g;
        st_bf4(MIX + (size_t)m * 1024 + c4, yn);
        const float ms = sum16((o.x * o.x + o.y * o.y) + (o.z * o.z + o.w * o.w)) * (1.f / 64.f);
        st_bf4(MIX + (size_t)m * 1024 + 768 + c4, o * rsqrtf(ms + 1e-5f) * ng * hg);
    }
}
constexpr int LR_SEG = 64, LR_NSEG = (L + LR_SEG - 1) / LR_SEG;
constexpr size_t WS_LR_AGG = 2032 * MiB;
constexpr size_t WS_LR_CARRY = WS_LR_AGG + 3 * MiB;
static_assert(WS_LR_CARRY + (size_t)NB * LR_NSEG * 256 * 4 <= WS_END, "lru aggregates");
__device__ PHASE_FN void lru_agg_phase(const Ctx A, int vcu, int G) {
    const int tid = opaque_tid(), lane = tid & 63, wave = tid >> 6;
    const int gw = vcu * NWAVES + wave, NGW = G * NWAVES;
    const float* LA = (const float*)(A.ws + WS_LR_A); const bf16* LU = (const bf16*)(A.ws + WS_LR_U); v2f* AGG = (v2f*)(A.ws + WS_LR_AGG);
#pragma unroll 1
    for (int it = gw; it < NB * LR_NSEG * 4; it += NGW) {
        const int cg = it & 3, q = it >> 2; const bool tail_ = q >= NB * (LR_NSEG - 1);
        const int b = tail_ ? q - NB * (LR_NSEG - 1) : q / (LR_NSEG - 1), sg = tail_ ? LR_NSEG - 1 : q - b * (LR_NSEG - 1), ch = cg * 64 + lane;
        const int t0 = sg * LR_SEG, ns = (L - t0) < LR_SEG ? (L - t0) : LR_SEG;
        const size_t m0 = (size_t)b * L + t0;
        float Ap = 1.f, Hl = 0.f;
#pragma unroll 1
        for (int i = 0; i < ns; i += 16) {
            float a[16], u[16];
#pragma unroll
            for (int j = 0; j < 16; ++j) { a[j] = LA[(m0 + i + j) * 256 + ch]; u[j] = bf2f(LU[(m0 + i + j) * 256 + ch]); }
#pragma unroll
            for (int j = 0; j < 16; ++j) { Hl = a[j] * Hl + u[j]; Ap *= a[j]; }
        }
        AGG[((size_t)b * LR_NSEG + sg) * 256 + ch] = (v2f){Ap, Hl};
    }
}
__device__ PHASE_FN void lru_carry_phase(const Ctx A, int first) {
    const int tid = opaque_tid(), lane = tid & 63, wave = tid >> 6;
    const int w = (opaque_s((int)blockIdx.x) - first) * NWAVES + wave;
    const int b = w >> 2, ch = (w & 3) * 64 + lane;
    const v2f* ag = (const v2f*)(A.ws + WS_LR_AGG) + (size_t)b * LR_NSEG * 256 + ch;
    float* CR = (float*)(A.ws + WS_LR_CARRY) + (size_t)b * LR_NSEG * 256 + ch;
    float hc = 0.f;
#pragma unroll 1
    for (int s0 = 0; s0 < LR_NSEG; s0 += 16) {
        v2f x[16];
#pragma unroll
        for (int j = 0; j < 16; ++j) { const int s = s0 + j < LR_NSEG ? s0 + j : LR_NSEG - 1; x[j] = ag[(size_t)s * 256]; }
#pragma unroll
        for (int j = 0; j < 16; ++j) if (s0 + j < LR_NSEG) { CR[(size_t)(s0 + j) * 256] = hc; hc = x[j].x * hc + x[j].y; }
    }
}
__device__ PHASE_FN void lru_out_phase(const Ctx A, int vcu, int G) {
    const int tid = opaque_tid(), lane = tid & 63, wave = tid >> 6;
    const int gw = vcu * NWAVES + wave, NGW = G * NWAVES;
    const float* LA = (const float*)(A.ws + WS_LR_A); const bf16* LU = (const bf16*)(A.ws + WS_LR_U); const bf16* LG = (const bf16*)(A.ws + WS_LR_G);
    const float* CR = (const float*)(A.ws + WS_LR_CARRY); bf16* MIX = (bf16*)(A.ws + WS_MIX);
#pragma unroll 1
    for (int it = gw; it < NB * LR_NSEG * 4; it += NGW) {
        const int cg = it & 3, q = it >> 2; const bool tail_ = q >= NB * (LR_NSEG - 1);
        const int b = tail_ ? q - NB * (LR_NSEG - 1) : q / (LR_NSEG - 1), sg = tail_ ? LR_NSEG - 1 : q - b * (LR_NSEG - 1), ch = cg * 64 + lane;
        const int t0 = sg * LR_SEG, ns = (L - t0) < LR_SEG ? (L - t0) : LR_SEG;
        const size_t m0 = (size_t)b * L + t0;
        float hc = CR[((size_t)b * LR_NSEG + sg) * 256 + ch];
#pragma unroll 1
        for (int i = 0; i < ns; i += 16) {
            float a[16], u[16], g[16];
#pragma unroll
            for (int j = 0; j < 16; ++j) { a[j] = LA[(m0 + i + j) * 256 + ch]; u[j] = bf2f(LU[(m0 + i + j) * 256 + ch]); g[j] = bf2f(LG[(m0 + i + j) * 256 + ch]); }
#pragma unroll
            for (int j = 0; j < 16; ++j) { hc = a[j] * hc + u[j]; MIX[(m0 + i + j) * 1024 + 512 + ch] = f2bf(hc * g[j]); }
        }
    }
}
static_assert(L % 16 == 0, "lru step groups");
constexpr int DSA_WBYTES = 34944;
constexpr int DSA_NW = 4;
__device__ __forceinline__ unsigned fkey(float f) { const unsigned u = __float_as_uint(f); return (u & 0x80000000u) ? ~u : (u | 0x80000000u); }
__device__ __forceinline__ void dsa_query(const Ctx A, LAS unsigned char* wl, int b, int i, int lane) {
    const bf16* DQ = (const bf16*)(A.ws + WS_DS_Q); const bf16* DK = (const bf16*)(A.ws + WS_DS_K); const bf16* DV = (const bf16*)(A.ws + WS_DS_V);
    const bf16* DQI = (const bf16*)(A.ws + WS_DS_QI); const bf16* DKI = (const bf16*)(A.ws + WS_DS_KI); const float* DWI = (const float*)(A.ws + WS_DS_WI);
    bf16* MIX = (bf16*)(A.ws + WS_HB);
    LAS unsigned* keys = (LAS unsigned*)wl; LAS float* qv = (LAS float*)(wl + 32896); LAS int* sel = (LAS int*)(wl + 32896 + 1024);
    const size_t m = (size_t)b * L + i, mb = (size_t)b * L;
    const int n = i + 1;
    LAS float* wil = (LAS float*)(wl + 32832);
    { const v4f q4 = ld_bf4(DQI + m * 256 + 4 * lane); *(LAS v4f*)(qv + 4 * lane) = q4; if (lane < 8) wil[lane] = DWI[m * 8 + lane]; }
    LDS_WAIT();
    for (int s = lane; s < n; s += 64) {
        const v4u* kp = (const v4u*)(DKI + (mb + s) * 32);
        float kf[32];
#pragma unroll
        for (int c = 0; c < 4; ++c) { const v4u x = kp[c]; kf[8 * c + 0] = bflo(x.x); kf[8 * c + 1] = bfhi(x.x); kf[8 * c + 2] = bflo(x.y); kf[8 * c + 3] = bfhi(x.y); kf[8 * c + 4] = bflo(x.z); kf[8 * c + 5] = bfhi(x.z); kf[8 * c + 6] = bflo(x.w); kf[8 * c + 7] = bfhi(x.w); }
        float sc = 0.f;
#pragma unroll 1
        for (int hx = 0; hx < 8; ++hx) { float dt = 0.f;
#pragma unroll
            for (int c = 0; c < 8; ++c) { const v4f q4 = *(const LAS v4f*)(qv + hx * 32 + 4 * c); dt += q4.x * kf[4 * c] + q4.y * kf[4 * c + 1] + q4.z * kf[4 * c + 2] + q4.w * kf[4 * c + 3]; }
            sc += wil[hx] * fmaxf(dt, 0.f); }
        keys[s] = fkey(sc);
    }
    LDS_WAIT();
    unsigned thr = 0u; int need = 0;
    if (n > 256) {
        unsigned prefix = 0u; need = 256;
#pragma unroll 1
        for (int shift = 28; shift >= 0; shift -= 4) {
            unsigned long long lo = 0ull, hi = 0ull;
            const unsigned himask = (shift == 28) ? 0u : (0xFFFFFFFFu << (shift + 4));
            for (int s = lane; s < n; s += 64) { const unsigned k = keys[s];
                if ((k & himask) == prefix) { const unsigned dg = (k >> shift) & 15u; const unsigned long long inc = 1ull << ((dg & 7u) * 8u); if (dg < 8u) lo += inc; else hi += inc; } }
            int cum = 0; unsigned dsel = 0u; int below = 0; bool found = false;
#pragma unroll
            for (int dg = 15; dg >= 0; --dg) {
                const unsigned mine = (unsigned)(((dg < 8 ? lo : hi) >> ((dg & 7) * 8)) & 0xFFull);
                int tot = (int)mine;
#pragma unroll
                for (int o = 1; o < 64; o <<= 1) tot += __shfl_xor(tot, o);
                if (!found && cum + tot >= need) { found = true; dsel = (unsigned)dg; below = cum; }
                cum += tot;
            }
            prefix |= dsel << shift; need -= below;
        }
        thr = prefix;
    }
    int cnt = 0;
    if (n <= 256) { for (int s = lane; s < n; s += 64) sel[s] = s; cnt = n; }
    else {
        int eq_taken = 0;
        for (int s0 = 0; s0 < n; s0 += 64) { const int s = s0 + lane; const unsigned k = (s < n) ? keys[s] : 0u; const bool in = s < n;
            const bool gt = in && (k > thr), eq = in && (k == thr);
            const unsigned long long meq = __ballot(eq); const int eq_before = __popcll(meq & ((1ull << lane) - 1ull));
            const bool take = gt || (eq && (eq_taken + eq_before) < need);
            const unsigned long long mt = __ballot(take); const int pos = cnt + __popcll(mt & ((1ull << lane) - 1ull));
            if (take && pos < 256) sel[pos] = s;
            cnt += __popcll(mt); eq_taken += __popcll(meq);
        }
        if (cnt > 256) cnt = 256;
    }
    LDS_WAIT();
    LAS float* pbuf = (LAS float*)wl;
    for (int h = 0; h < 4; ++h) {
        { const float qx = bf2f(DQ[m * 256 + h * 64 + lane]); qv[lane] = qx * 0.125f; }
        LDS_WAIT();
        float sj[4]; float mx = -3.0e38f;
#pragma unroll
        for (int r = 0; r < 4; ++r) { const int j = lane + 64 * r; sj[r] = -3.0e38f;
            if (j < cnt) { const int s = sel[j]; const v4u* kp = (const v4u*)(DK + (mb + s) * 256 + h * 64); float dt = 0.f;
#pragma unroll
                for (int c = 0; c < 8; ++c) { const v4u x = kp[c]; const v4f q0 = *(const LAS v4f*)(qv + 8 * c), q1 = *(const LAS v4f*)(qv + 8 * c + 4);
                    dt += q0.x * bflo(x.x) + q0.y * bfhi(x.x) + q0.z * bflo(x.y) + q0.w * bfhi(x.y) + q1.x * bflo(x.z) + q1.y * bfhi(x.z) + q1.z * bflo(x.w) + q1.w * bfhi(x.w); }
                sj[r] = dt; mx = fmaxf(mx, dt); } }
        mx = wave_max(mx);
        float sum = 0.f;
#pragma unroll
        for (int r = 0; r < 4; ++r) { const int j = lane + 64 * r; const float p = (j < cnt) ? __expf(sj[r] - mx) : 0.f; sum += p; pbuf[j] = p; }
        sum = wave_sum(sum);
        LDS_WAIT();
        float o = 0.f;
        for (int j = 0; j < cnt; ++j) { const int s = sel[j]; o += pbuf[j] * bf2f(DV[(mb + s) * 256 + h * 64 + lane]); }
        MIX[m * 1024 + 256 + h * 64 + lane] = f2bf(o / sum);
        LDS_WAIT();
    }
}
__device__ PHASE_FN void dsa_phase(const Ctx A, LAS unsigned char* lds, int l) {
    const int tid = opaque_tid(), lane = tid & 63, wave = tid >> 6;
    if (wave >= DSA_NW) return;
    unsigned* qhead = (unsigned*)(A.ws + WS_CTL) + CW_DSAQ + 64 * l;
    LAS unsigned char* wl = lds + wave * DSA_WBYTES;
    for (;;) {
        unsigned it = 0u;
        if (lane == 0) it = atomicAdd(qhead, 1u);
        it = __builtin_amdgcn_readfirstlane(it);
        if (it >= (unsigned)T) break;
        const int i = L - 1 - (int)(it >> 3), b = (int)(it & 7u);
        dsa_query(A, wl, b, i, lane);
    }
}
static_assert(DSA_NW * DSA_WBYTES <= MISC_OFF, "dsa lds");
typedef short s8 __attribute__((ext_vector_type(8)));
typedef short v4i16_t __attribute__((ext_vector_type(4)));
typedef unsigned u16v __attribute__((ext_vector_type(16)));
typedef unsigned long long u64;
constexpr int NQT16 = L / 16;
constexpr int NKB32 = (L + 31) / 32;
constexpr int MASK_PB = 66112;
constexpr size_t MASK_LAYER = (size_t)NB * MASK_PB * 64;
constexpr size_t WS_MASK = 1956 * MiB;
static_assert(WS_MASK >= WS_MIX_END && WS_MASK + 2 * MASK_LAYER + 256 <= 2032 * MiB, "mask region");
__device__ __forceinline__ size_t mask_row(int l, int b, int qt) { const int a = qt >> 1; return (size_t)l * (NB * MASK_PB) + (size_t)b * MASK_PB + ((qt & 1) ? (a + 1) * (a + 1) : a * (a + 1)); }
constexpr int CW_KMAX = 8960;
constexpr int CW_KIMAX = 9216;
constexpr int MI_KMAX = 640, MI_UNIT = 768, MI_KIMAX = 832;
constexpr int SEL_PF = 3;
constexpr int SEL_HROW = 259;

__device__ __forceinline__ void sel_scores(const s8 a1, const s8 a2, const s8 (&qb)[9], const float (&wv)[8], pg8::f32x4& i1, pg8::f32x4& i2) {
    const pg8::f32x4 z = (pg8::f32x4){0.f, 0.f, 0.f, 0.f};
    i1 = __builtin_amdgcn_mfma_f32_16x16x32_bf16(a1, qb[8], z, 0, 0, 0); i2 = __builtin_amdgcn_mfma_f32_16x16x32_bf16(a2, qb[8], z, 0, 0, 0);
#pragma unroll
    for (int h = 0; h < 8; ++h) {
        const pg8::f32x4 c1 = __builtin_amdgcn_mfma_f32_16x16x32_bf16(a1, qb[h], z, 0, 0, 0), c2 = __builtin_amdgcn_mfma_f32_16x16x32_bf16(a2, qb[h], z, 0, 0, 0);
#pragma unroll
        for (int j = 0; j < 4; ++j) { float t1 = fmaf(fabsf(c1[j]), wv[h], i1[j]), t2 = fmaf(fabsf(c2[j]), wv[h], i2[j]);
            asm("" : "+v"(t1)); asm("" : "+v"(t2)); i1[j] = t1; i2[j] = t2; }
    }
}
template <int MODE, bool DIAG>
__device__ __forceinline__ void sel_block(const s8 a1, const s8 a2, const s8 (&qb)[9], const float (&wv)[8], int kb, int tq, int r, int g, int lane,
                                          LAS unsigned* hrow, float sc_mul, float sc_add, u64* mrow) {
    pg8::f32x4 i1, i2; sel_scores(a1, a2, qb, wv, i1, i2);
    const int s0 = kb * 32 + 8 * g;
    u64 wds[8];
#pragma unroll
    for (int j = 0; j < 8; ++j) {
        const float sc = j < 4 ? i1[j & 3] : i2[j & 3];
        if (MODE == 3) { if (sc == 123456.789f) hrow[256] = 1u; }
        else if (MODE == 2) { wds[j] = DIAG ? __ballot((s0 + j) <= tq && sc >= sc_add) : __ballot(sc >= sc_add); }
        else { int xi = (int)__builtin_floorf(fmaf(sc, sc_mul, sc_add));
            unsigned bin = MODE == 0 ? (unsigned)min(max(xi, 0), 255) : (unsigned)(min(max(xi, -1), 256) + 1);
            if (DIAG) bin = ((s0 + j) <= tq) ? bin : (MODE == 0 ? 256u : 0u);
            if (MODE == 0 || bin != 0u) __hip_atomic_fetch_add(hrow + bin, 1u, __ATOMIC_RELAXED, __HIP_MEMORY_SCOPE_WORKGROUP); }
    }
    if (MODE == 2 && lane == 0) { u64* d = mrow + (size_t)kb * 8;
#pragma unroll
        for (int j = 0; j < 8; j += 2) { v4u o; o.x = (unsigned)wds[j]; o.y = (unsigned)(wds[j] >> 32); o.z = (unsigned)wds[j + 1]; o.w = (unsigned)(wds[j + 1] >> 32); *(v4u*)(d + j) = o; } }
}
template <int MODE>
__device__ __forceinline__ void sel_pass(const bf16* KIb, const s8 (&qb)[9], const float (&wv)[8], int nkb, int tq, int r, int g, int lane,
                                         LAS unsigned* hrow, float sc_mul, float sc_add, u64* mrow, int kb_first = 0, int kb_step = 1) {
    const bf16* kp = KIb + (size_t)(8 * (r >> 2) + (r & 3)) * 32 + 8 * g;
    v4u cur[2 * SEL_PF], nxt[2 * SEL_PF];
#pragma unroll
    for (int i = 0; i < SEL_PF; ++i) { const size_t kb = kb_first + i * kb_step; cur[2 * i] = *(const v4u*)(kp + kb * 1024); cur[2 * i + 1] = *(const v4u*)(kp + kb * 1024 + 128); }
#pragma unroll 1
    for (int kb0 = kb_first; kb0 < nkb; kb0 += SEL_PF * kb_step) {
#pragma unroll
        for (int i = 0; i < SEL_PF; ++i) { const size_t kb = kb0 + (SEL_PF + i) * kb_step; nxt[2 * i] = *(const v4u*)(kp + kb * 1024); nxt[2 * i + 1] = *(const v4u*)(kp + kb * 1024 + 128); }
#pragma unroll
        for (int i = 0; i < SEL_PF; ++i) { const int kb = kb0 + i * kb_step;
            if (kb < nkb - 1) sel_block<MODE, false>(__builtin_bit_cast(s8, cur[2 * i]), __builtin_bit_cast(s8, cur[2 * i + 1]), qb, wv, kb, tq, r, g, lane, hrow, sc_mul, sc_add, mrow);
            else if (kb == nkb - 1) sel_block<MODE, true>(__builtin_bit_cast(s8, cur[2 * i]), __builtin_bit_cast(s8, cur[2 * i + 1]), qb, wv, kb, tq, r, g, lane, hrow, sc_mul, sc_add, mrow); }
#pragma unroll
        for (int i = 0; i < 2 * SEL_PF; ++i) cur[i] = nxt[i];
    }
}
__device__ __forceinline__ void sel_scan(const LAS unsigned* hrow, int need, int& sel, int& above) {
    int cum = 0; sel = 0; above = 0; bool found = false;
#pragma unroll 8
    for (int bin = 255; bin >= 0; --bin) { const int c = (int)hrow[bin];
        if (!found && cum + c >= need) { found = true; sel = bin; above = cum; }
        cum += c; }
}
__device__ PHASE_FN void dsa_select_phase(const Ctx A, LAS unsigned char* lds, int l) {
    const int tid = opaque_tid(), lane = tid & 63, wave = tid >> 6, r = lane & 15, g = lane >> 4;
    const bf16* DQI = (const bf16*)(A.ws + WS_DS_QI); const bf16* DKI = (const bf16*)(A.ws + WS_DS_KI); const float* DWI = (const float*)(A.ws + WS_DS_WI);
    u64* MASK = (u64*)(A.ws + WS_MASK);
    unsigned* qhead = (unsigned*)(A.ws + WS_CTL) + CW_DSAQ + 64 * l;
    const unsigned* kimaxw = (const unsigned*)(A.ws + WS_CTL) + CW_KIMAX + 64 * l;
    LAS unsigned* hist = (LAS unsigned*)(lds + wave * (16 * SEL_HROW * 4));
    LAS unsigned* hrow = hist + r * SEL_HROW;
    for (;;) {
        unsigned it = 0u;
        if (lane == 0) it = atomicAdd(qhead, 1u);
        it = __builtin_amdgcn_readfirstlane(it);
        if (it >= (unsigned)(NB * NQT16)) break;
        const int qt = NQT16 - 1 - (int)(it >> 3), b = (int)(it & 7u);
        const size_t mb = (size_t)b * L, m0 = mb + (size_t)qt * 16;
        const int tq = qt * 16 + r, nkb = ((qt * 16 + 15) >> 5) + 1;
        s8 qb[9]; float wv[8];
#pragma unroll
        for (int h = 0; h < 8; ++h) qb[h] = *(const s8*)(DQI + (m0 + r) * 256 + h * 32 + 8 * g);
        { const v4f w0 = *(const v4f*)(DWI + (m0 + r) * 8), w1 = *(const v4f*)(DWI + (m0 + r) * 8 + 4);
          wv[0] = w0.x; wv[1] = w0.y; wv[2] = w0.z; wv[3] = w0.w; wv[4] = w1.x; wv[5] = w1.y; wv[6] = w1.z; wv[7] = w1.w; }
        float bq = 0.f;
        { float ql[8];
#pragma unroll
          for (int e = 0; e < 8; ++e) ql[e] = 0.f;
#pragma unroll
          for (int h = 0; h < 8; ++h) { float n2 = 0.f;
#pragma unroll
              for (int e = 0; e < 8; ++e) { const float x = bf2f((unsigned short)qb[h][e]); ql[e] += wv[h] * x; n2 += x * x; }
              n2 += __shfl_xor(n2, 16); n2 += __shfl_xor(n2, 32); bq += fabsf(wv[h]) * sqrtf(n2); }
          v4u pk; pk.x = pk2(ql[0], ql[1]); pk.y = pk2(ql[2], ql[3]); pk.z = pk2(ql[4], ql[5]); pk.w = pk2(ql[6], ql[7]); qb[8] = __builtin_bit_cast(s8, pk); }
        const bf16* KIb = DKI + mb * 32;
        float thr_f = -__builtin_inff();
        if (qt * 16 + 15 >= 256) {
            const float kim = sqrtf(__uint_as_float(__hip_atomic_load(kimaxw + b, __ATOMIC_RELAXED, __HIP_MEMORY_SCOPE_AGENT)));
            const float R = fmaxf(2.06f * bq * kim, 1e-30f), s0 = 128.f / R, w0 = R * (1.f / 128.f);
            const int n = tq + 1;
            bool done = false;
            if (qt * 16 >= 2048) {
                for (int i = lane; i < 16 * SEL_HROW; i += 64) hist[i] = 0u;
                LDS_WAIT();
                sel_pass<0>(KIb, qb, wv, nkb - 1, tq, r, g, lane, hrow, s0, 128.f, nullptr, 3, 8);
                LDS_WAIT();
                const int ns = 32 * ((nkb - 1 - 3 + 7) >> 3);
                const float rho = 256.f * (float)ns / (float)n, dev = 4.f * sqrtf(rho) + 2.f;
                int bl, ab; sel_scan(hrow, (int)(rho + dev) + 1, bl, ab);
                int bh = 255, ab2 = 0; const int rhi = (int)(rho - dev);
                if (rhi >= 1) sel_scan(hrow, rhi, bh, ab2);
                LDS_WAIT();
                const float lo = -R + (float)bl * w0, hi = (rhi >= 1) ? (-R + (float)(bh + 1) * w0) : (R * 1.001f);
                const float s1 = 256.f / (hi - lo);
                for (int i = lane; i < 16 * SEL_HROW; i += 64) hist[i] = 0u;
                LDS_WAIT();
                sel_pass<1>(KIb, qb, wv, nkb, tq, r, g, lane, hrow, s1, -lo * s1, nullptr);
                LDS_WAIT();
                const int above = (int)hrow[257]; int inr = 0;
#pragma unroll 8
                for (int bin = 1; bin <= 256; ++bin) inr += (int)hrow[bin];
                const bool ok = above < 256 && above + inr >= 256;
                if (ok) { int sel1, ab1; sel_scan(hrow + 1, 256 - above, sel1, ab1); thr_f = lo + (float)sel1 * ((hi - lo) * (1.f / 256.f)); }
                LDS_WAIT();
                done = __all(ok);
            }
            if (!done) {
                for (int i = lane; i < 16 * SEL_HROW; i += 64) hist[i] = 0u;
                LDS_WAIT();
                sel_pass<0>(KIb, qb, wv, nkb, tq, r, g, lane, hrow, s0, 128.f, nullptr);
                LDS_WAIT();
                int sel0, above0; sel_scan(hrow, 256, sel0, above0);
                LDS_WAIT();
                const float lo0 = -R + (float)sel0 * w0, s1 = 256.f / w0;
                for (int i = lane; i < 16 * SEL_HROW; i += 64) hist[i] = 0u;
                LDS_WAIT();
                sel_pass<1>(KIb, qb, wv, nkb, tq, r, g, lane, hrow, s1, -lo0 * s1, nullptr);
                LDS_WAIT();
                int sel1, above1; sel_scan(hrow + 1, 256 - above0, sel1, above1);
                LDS_WAIT();
                thr_f = lo0 + (float)sel1 * (w0 * (1.f / 256.f));
            }
            if (n <= 256) thr_f = -__builtin_inff();
        }
        sel_pass<2>(KIb, qb, wv, nkb, tq, r, g, lane, hrow, 0.f, thr_f, MASK + mask_row(l, b, qt) * 8);
    }
}

constexpr int AT_ROW = 144;
constexpr int AT_TILE = 64 * AT_ROW;
constexpr int AT_NQT = (L - 16) / 256;
constexpr int AT_NKT = (L + 63) / 64;
static_assert(16 + AT_NQT * 256 == L, "query tiling");
__device__ PHASE_FN void dsa_attn_phase(const Ctx A, LAS unsigned char* lds, int l) {
    const int tid = opaque_tid(), lane = tid & 63, wave = tid >> 6, r = lane & 15, g = lane >> 4;
    const bf16* DQ = (const bf16*)(A.ws + WS_DS_Q); const bf16* DK = (const bf16*)(A.ws + WS_DS_K); const bf16* DV = (const bf16*)(A.ws + WS_DS_V);
    const u64* MASK = (const u64*)(A.ws + WS_MASK); bf16* MIX = (bf16*)(A.ws + WS_MIX);
    unsigned* qhead = (unsigned*)(A.ws + WS_CTL) + CW_DSAQ + 64 * l + 16;
    const unsigned* kmaxw = (const unsigned*)(A.ws + WS_CTL) + CW_KMAX + 64 * l;
    LAS unsigned* unitw = (LAS unsigned*)(lds + MISC_OFF + MI_UNIT);
    const int ldkey = tid >> 3, ldch = tid & 7;
    for (;;) {
        __syncthreads();
        if (tid == 0) unitw[0] = atomicAdd(qhead, 1u);
        __syncthreads();
        const unsigned u = unitw[0];
        if (u >= (unsigned)(NB * 4 * (AT_NQT + 1))) break;
        const bool mini = u >= (unsigned)(NB * 4 * AT_NQT);
        const int qt = mini ? 0 : AT_NQT - 1 - (int)(u >> 5), b = (int)((u & 31u) >> 2), h = (int)(u & 3u);
        const size_t mb = (size_t)b * L;
        const int kmain = mini ? 0 : 4 * qt;
        const int nkt = mini ? 1 : ((4 * qt + 5 < AT_NKT) ? 4 * qt + 5 : AT_NKT);
        const float kmax2 = __uint_as_float(__hip_atomic_load(kmaxw + b * 4 + h, __ATOMIC_RELAXED, __HIP_MEMORY_SCOPE_AGENT));
        int tq[2], lb[2]; bool act[2];
        s8 qf[2][2]; float nc2[2];
        const GAS unsigned* mrow[2];
#pragma unroll
        for (int qi = 0; qi < 2; ++qi) { act[qi] = mini ? (wave == 0 && qi == 0) : true; tq[qi] = mini ? 0 : 16 + qt * 256 + wave * 32 + 16 * qi;
            lb[qi] = __builtin_amdgcn_readfirstlane(act[qi] ? ((tq[qi] + 15) >> 5) : -1);
            float qn2 = 0.f;
#pragma unroll
            for (int ks = 0; ks < 2; ++ks) { qf[qi][ks] = act[qi] ? *(const s8*)(DQ + (mb + tq[qi] + r) * 256 + h * 64 + 32 * ks + 8 * g) : (s8){0, 0, 0, 0, 0, 0, 0, 0};
#pragma unroll
                for (int e = 0; e < 8; ++e) { const float x = bf2f((unsigned short)qf[qi][ks][e]); qn2 += x * x; } }
            qn2 += __shfl_xor(qn2, 16); qn2 += __shfl_xor(qn2, 32);
            nc2[qi] = -sqrtf(qn2 * kmax2);
            const u64 mrow_u = (u64)(MASK + mask_row(l, b, tq[qi] >> 4) * 8);
            const unsigned lo = (unsigned)__builtin_amdgcn_readfirstlane((unsigned)mrow_u), hi = (unsigned)__builtin_amdgcn_readfirstlane((unsigned)(mrow_u >> 32));
            mrow[qi] = (const GAS unsigned*)(((u64)hi << 32) | (u64)lo); }
        pg8::f32x4 O[2][4], Ls[2];
#pragma unroll
        for (int qi = 0; qi < 2; ++qi) { Ls[qi] = (pg8::f32x4){0.f, 0.f, 0.f, 0.f};
#pragma unroll
            for (int db = 0; db < 4; ++db) O[qi][db] = (pg8::f32x4){0.f, 0.f, 0.f, 0.f}; }
        const s8 ones8 = (s8){0x3F80, 0x3F80, 0x3F80, 0x3F80, 0x3F80, 0x3F80, 0x3F80, 0x3F80};
#define AT_SLOAD(dst, qi_, kb_) asm volatile("s_load_dwordx16 %0, %1, 0x0" : "=s"(dst) : "s"(mrow[qi_] + (size_t)(kb_) * 16))
#define AT_MWAIT(m0_, m1_) asm volatile("s_waitcnt lgkmcnt(0)" : "+s"(m0_), "+s"(m1_))
#define AT_MWAIT_S2(a0_, a1_, b0_, b1_) asm volatile("s_waitcnt lgkmcnt(0)" : "+s"(a0_), "+s"(a1_), "+s"(b0_), "+s"(b1_), "+v"(Sa), "+v"(Sb), "+v"(Sc), "+v"(Sd), "+v"(Se), "+v"(Sf), "+v"(Sg), "+v"(Sh) :: "memory")
#define AT_MWAIT_O(a0_, a1_, b0_, b1_) asm volatile("s_waitcnt lgkmcnt(0)" : "+s"(a0_), "+s"(a1_), "+s"(b0_), "+s"(b1_), "+v"(O[1][0]), "+v"(O[1][1]), "+v"(O[1][2]), "+v"(O[1][3]), "+v"(Ls[1]) :: "memory")
        const bf16* kg = DK + (mb + ldkey) * 256 + h * 64 + ldch * 8; const bf16* vg = DV + (mb + ldkey) * 256 + h * 64 + ldch * 8;
        v4u rk0 = *(const v4u*)kg, rv0 = *(const v4u*)vg;
        const size_t to1 = (size_t)(nkt > 1 ? 1 : nkt - 1) * 64 * 256, to2 = (size_t)(nkt > 2 ? 2 : nkt - 1) * 64 * 256, to3 = (size_t)(nkt > 3 ? 3 : nkt - 1) * 64 * 256;
        v4u rk1 = *(const v4u*)(kg + to1), rv1 = *(const v4u*)(vg + to1), rk2 = *(const v4u*)(kg + to2), rv2 = *(const v4u*)(vg + to2), rk3 = *(const v4u*)(kg + to3), rv3 = *(const v4u*)(vg + to3);
        u16v m0, m1, n0, n1;
#define AT_STORE(boff, rk, rv) do { LAS unsigned char* kb_ = lds + (boff); LAS unsigned char* vb_ = kb_ + AT_TILE; \
            *(LAS v4u*)(kb_ + ldkey * AT_ROW + ldch * 16) = rk; *(LAS v4u*)(vb_ + ldkey * AT_ROW + ldch * 16) = rv; } while (0)
#define AT_LOAD(kt_, rk, rv) do { rk = *(const v4u*)(kg + (size_t)(kt_) * 64 * 256); rv = *(const v4u*)(vg + (size_t)(kt_) * 64 * 256); } while (0)
#define AT_KREAD(boff, blk) do { const LAS unsigned char* ka = lds + (boff) + ((blk) * 32 + 8 * (r >> 2) + (r & 3)) * AT_ROW + g * 16; \
            _Pragma("unroll") for (int ks = 0; ks < 2; ++ks) { kf[blk][ks][0] = *(const LAS s8*)(ka + ks * 64); kf[blk][ks][1] = *(const LAS s8*)(ka + 4 * AT_ROW + ks * 64); } } while (0)
#define AT_VREAD(boff, blk) do { const LAS unsigned char* va = lds + (boff) + AT_TILE + ((blk) * 32 + 8 * g + (r >> 2)) * AT_ROW + (r & 3) * 8; \
            _Pragma("unroll") for (int db = 0; db < 4; ++db) { \
                const v4i16_t x0 = __builtin_amdgcn_ds_read_tr16_b64_v4i16((LAS v4i16_t*)(va + db * 32)), x1 = __builtin_amdgcn_ds_read_tr16_b64_v4i16((LAS v4i16_t*)(va + 4 * AT_ROW + db * 32)); \
                vf[blk][db] = (s8){x0[0], x0[1], x0[2], x0[3], x1[0], x1[1], x1[2], x1[3]}; } } while (0)
#define AT_BLK_S(blk, qi, S1, S2) do { S1 = (pg8::f32x4){nc2[qi], nc2[qi], nc2[qi], nc2[qi]}; S2 = S1; \
            _Pragma("unroll") for (int ks = 0; ks < 2; ++ks) { \
                S1 = __builtin_amdgcn_mfma_f32_16x16x32_bf16(kf[blk][ks][0], qf[qi][ks], S1, 0, 0, 0); S2 = __builtin_amdgcn_mfma_f32_16x16x32_bf16(kf[blk][ks][1], qf[qi][ks], S2, 0, 0, 0); } } while (0)
#define AT_BLK_P(mq, S1, S2, pa) do { float p[8]; \
            _Pragma("unroll") for (int j = 0; j < 8; ++j) { \
                const bool bit = __builtin_amdgcn_inverse_ballot_w64(((u64)mq[2 * j + 1] << 32) | mq[2 * j]); \
                p[j] = bit ? __builtin_amdgcn_exp2f(j < 4 ? S1[j & 3] : S2[j & 3]) : 0.f; } \
            v4u pk; pk.x = pk2(p[0], p[1]); pk.y = pk2(p[2], p[3]); pk.z = pk2(p[4], p[5]); pk.w = pk2(p[6], p[7]); \
            pa = __builtin_bit_cast(s8, pk); } while (0)
#define AT_BLK_V(blk, qi, pa) do { \
            _Pragma("unroll") for (int db = 0; db < 4; ++db) O[qi][db] = __builtin_amdgcn_mfma_f32_16x16x32_bf16(pa, vf[blk][db], O[qi][db], 0, 0, 0); \
            Ls[qi] = __builtin_amdgcn_mfma_f32_16x16x32_bf16(pa, ones8, Ls[qi], 0, 0, 0); } while (0)
#define AT_ROTATE do { const int t_ = bc; bc = bn; bn = bs; bs = t_; } while (0)
#define AT_MAIN_BODY(kt, RK_LD, RV_LD, RK_ST, RV_ST, LASTWAIT) do { \
            { const int ktn_ = (kt) + 5 < nkt ? (kt) + 5 : nkt - 1; AT_LOAD(ktn_, RK_LD, RV_LD); } \
            AT_STORE(bs, RK_ST, RV_ST); \
            pg8::f32x4 Sa, Sb, Sc, Sd, Se, Sf, Sg, Sh; s8 pa0, pa1, pb0, pb1; \
            AT_BLK_S(0, 0, Sa, Sb); AT_BLK_S(1, 0, Sc, Sd); AT_BLK_S(0, 1, Se, Sf); AT_BLK_S(1, 1, Sg, Sh);        \
            AT_MWAIT_S2(m0, m1, n0, n1); \
            AT_KREAD(bn, 0); AT_KREAD(bn, 1); \
            AT_BLK_P(m0, Sa, Sb, pa0); AT_SLOAD(m0, 0, 2 * (kt) + 2); AT_BLK_P(m1, Sc, Sd, pa1); AT_SLOAD(m1, 0, 2 * (kt) + 3); \
            AT_BLK_V(0, 0, pa0); AT_BLK_V(1, 0, pa1); \
            AT_BLK_P(n0, Se, Sf, pb0); AT_SLOAD(n0, 1, 2 * (kt) + 2); AT_BLK_P(n1, Sg, Sh, pb1); AT_SLOAD(n1, 1, 2 * (kt) + 3); \
            AT_BLK_V(0, 1, pb0); AT_BLK_V(1, 1, pb1); \
            if (LASTWAIT) AT_MWAIT_O(m0, m1, n0, n1);                   \
            AT_VREAD(bn, 0); AT_VREAD(bn, 1); \
            AT_ROTATE; \
            __builtin_amdgcn_s_barrier(); } while (0)
#define AT_DIAG_STEP(kt, qi) do { \
            if (2 * (kt) + 1 <= lb[qi]) { pg8::f32x4 Sa, Sb, Sc, Sd; s8 pa0, pa1; AT_SLOAD(m0, qi, 2 * (kt)); AT_SLOAD(m1, qi, 2 * (kt) + 1); \
                AT_BLK_S(0, qi, Sa, Sb); AT_BLK_S(1, qi, Sc, Sd); AT_MWAIT(m0, m1); AT_BLK_P(m0, Sa, Sb, pa0); AT_BLK_P(m1, Sc, Sd, pa1); AT_BLK_V(0, qi, pa0); AT_BLK_V(1, qi, pa1); } \
            else if (2 * (kt) <= lb[qi]) { pg8::f32x4 Sa, Sb; s8 pa0; AT_SLOAD(m0, qi, 2 * (kt)); AT_SLOAD(m1, qi, 2 * (kt)); \
                AT_BLK_S(0, qi, Sa, Sb); AT_MWAIT(m0, m1); AT_BLK_P(m0, Sa, Sb, pa0); AT_BLK_V(0, qi, pa0); } } while (0)
#define AT_DIAG_BODY(kt, RK_LD, RV_LD, RK_ST, RV_ST) do { \
            { const int ktn_ = (kt) + 5 < nkt ? (kt) + 5 : nkt - 1; AT_LOAD(ktn_, RK_LD, RV_LD); } \
            AT_STORE(bs, RK_ST, RV_ST); \
            if (2 * (kt) <= lb[1] || 2 * (kt) <= lb[0]) { \
                AT_KREAD(bc, 0); AT_KREAD(bc, 1); AT_VREAD(bc, 0); AT_VREAD(bc, 1); \
                AT_DIAG_STEP(kt, 0); AT_DIAG_STEP(kt, 1); } \
            asm volatile("s_waitcnt lgkmcnt(0)" ::: "memory"); \
            AT_ROTATE; \
            __builtin_amdgcn_s_barrier(); } while (0)
        int bc = 0, bn = 2 * AT_TILE, bs = 4 * AT_TILE;
        s8 kf[2][2][2], vf[2][4];
        AT_SLOAD(m0, 0, 0); AT_SLOAD(m1, 0, 1); AT_SLOAD(n0, 1, 0); AT_SLOAD(n1, 1, 1);
        AT_STORE(bc, rk0, rv0);
        AT_STORE(bn, rk1, rv1);
        AT_LOAD(nkt > 4 ? 4 : nkt - 1, rk0, rv0);
        AT_MWAIT(m0, m1); AT_MWAIT(n0, n1);
        __syncthreads();
        AT_KREAD(bc, 0); AT_KREAD(bc, 1); AT_VREAD(bc, 0); AT_VREAD(bc, 1);
#pragma unroll 1
        for (int kt = 0; kt < kmain; kt += 4) {
            AT_MAIN_BODY(kt, rk1, rv1, rk2, rv2, false);
            AT_MAIN_BODY(kt + 1, rk2, rv2, rk3, rv3, false);
            AT_MAIN_BODY(kt + 2, rk3, rv3, rk0, rv0, false);
            AT_MAIN_BODY(kt + 3, rk0, rv0, rk1, rv1, true);
        }
#pragma unroll 1
        for (int kt = kmain; kt < nkt; kt += 4) {
            AT_DIAG_BODY(kt, rk1, rv1, rk2, rv2);
            AT_DIAG_BODY(kt + 1, rk2, rv2, rk3, rv3);
            AT_DIAG_BODY(kt + 2, rk3, rv3, rk0, rv0);
            AT_DIAG_BODY(kt + 3, rk0, rv0, rk1, rv1);
        }
#undef AT_ROTATE
#undef AT_MAIN_BODY
#undef AT_DIAG_BODY
#undef AT_DIAG_STEP
#undef AT_BLK_S
#undef AT_BLK_P
#undef AT_BLK_V
#undef AT_KREAD
#undef AT_VREAD
#undef AT_SLOAD
#undef AT_MWAIT
#undef AT_MWAIT_S2
#undef AT_MWAIT_O
#undef AT_LOAD
#undef AT_STORE
#pragma unroll
        for (int qi = 0; qi < 2; ++qi)
#pragma unroll
            for (int j = 0; j < 4; ++j) { const float ij = Ls[qi][j] > 0.f ? 1.f / Ls[qi][j] : 0.f; const int t = tq[qi] + 4 * g + j;
                if (act[qi]) {
#pragma unroll
                    for (int db = 0; db < 4; ++db) MIX[(mb + t) * 1024 + 256 + h * 64 + db * 16 + r] = f2bf(O[qi][db][j] * ij); } }
    }
}
constexpr int CK = 16;
constexpr int NCHK = L / CK;
static_assert(L % CK == 0, "chunk length");
constexpr int CKP_RW = 10, CKP_HG = 7;
constexpr int CKR_RW = CKP_RW * 1024 + 512, CKR_HG = CKP_HG * 1024 + 256;
constexpr size_t WS_CKF_RW = WS_PROJ + 136 * MiB;
constexpr size_t WS_CKF_HG = WS_CKF_RW + (size_t)32 * NCHK * CKR_RW;
static_assert(WS_CKF_HG + (size_t)32 * NCHK * CKR_HG <= WS_PROJ + (size_t)TP * NINP * 2, "chunk fragments fit in the dead proj region");
__device__ __forceinline__ s8 pack8(const pg8::f32x4 lo, const pg8::f32x4 hi) { v4u p; p.x = pk2(lo[0], lo[1]); p.y = pk2(lo[2], lo[3]); p.z = pk2(hi[0], hi[1]); p.w = pk2(hi[2], hi[3]); return __builtin_bit_cast(s8, p); }
template <int CTRL> __device__ __forceinline__ float dpp_shr1(float x) { return __int_as_float(__builtin_amdgcn_update_dpp(0x3F800000, __float_as_int(x), CTRL, 0xF, 0xF, false)); }
__device__ __forceinline__ float row_cumprod(float x) { x *= dpp_shr1<0x111>(x); x *= dpp_shr1<0x112>(x); x *= dpp_shr1<0x114>(x); x *= dpp_shr1<0x118>(x); return x; }

template <bool RWKV>
__device__ __forceinline__ void chunk_prep_item(const Ctx A, int bh, int c, int lane) {
    const int r = lane & 15, g = lane >> 4;
    const size_t base = ((size_t)bh * L + (size_t)c * CK + r) * 64;
    const float* Wg = (const float*)(A.ws + (RWKV ? WS_RW_W : WS_HG_F)) + base;
    const bf16* Ag = (const bf16*)(A.ws + WS_RW_A) + base; const bf16* Bg = (const bf16*)(A.ws + WS_RW_B) + base;
    const bf16* Kg = (const bf16*)(A.ws + (RWKV ? WS_RW_K : WS_HG_K)) + base; const bf16* Rg = (const bf16*)(A.ws + (RWKV ? WS_RW_WR : WS_HG_Q)) + base;
    GAS unsigned char* recb = A.ws + (RWKV ? WS_CKF_RW : WS_CKF_HG) + ((size_t)bh * NCHK + c) * (RWKV ? CKR_RW : CKR_HG);
    v4u* REC = (v4u*)recb + lane; v4f* GCp = (v4f*)(recb + (RWKV ? CKP_RW : CKP_HG) * 1024); float* Dp = (float*)(recb + CKP_RW * 1024 + 256);
    s8 Af[2], Bf[2], Kf[2], Rf[2], BTf[2], KTf[2];
    v4f gcv[4];
#pragma unroll
    for (int ks = 0; ks < 2; ++ks) {
        pg8::f32x4 ah[2], bh_[2], kh[2], rh[2], bt[2], kt[2];
#pragma unroll
        for (int hf = 0; hf < 2; ++hf) {
            const int k0 = 32 * ks + 16 * hf + 4 * g;
            const v4f w4 = *(const v4f*)(Wg + k0);
            v4f gt, gm, gc;
#pragma unroll
            for (int e = 0; e < 4; ++e) { gt[e] = row_cumprod(w4[e]); gm[e] = dpp_shr1<0x111>(gt[e]); gc[e] = __shfl(gt[e], 16 * g + 15); }
            gcv[2 * ks + hf] = gc;
            v4f inv; inv.x = __builtin_amdgcn_rcpf(gt.x); inv.y = __builtin_amdgcn_rcpf(gt.y); inv.z = __builtin_amdgcn_rcpf(gt.z); inv.w = __builtin_amdgcn_rcpf(gt.w);
            const v4f kk4 = ld_bf4(Kg + k0) * inv, rr4 = ld_bf4(Rg + k0) * (RWKV ? gm : gt);
            kh[hf] = kk4; rh[hf] = rr4; kt[hf] = kk4 * gc;
            if (RWKV) { ah[hf] = ld_bf4(Ag + k0) * gm; bh_[hf] = ld_bf4(Bg + k0) * inv; bt[hf] = bh_[hf] * gc; }
        }
        Kf[ks] = pack8(kh[0], kh[1]); Rf[ks] = pack8(rh[0], rh[1]); KTf[ks] = pack8(kt[0], kt[1]);
        if (RWKV) { Af[ks] = pack8(ah[0], ah[1]); Bf[ks] = pack8(bh_[0], bh_[1]); BTf[ks] = pack8(bt[0], bt[1]); }
    }
    const pg8::f32x4 z4 = (pg8::f32x4){0.f, 0.f, 0.f, 0.f};
    s8 selE, selO;
    { v4u e = (v4u){0u, 0u, 0u, 0u}, o = e; const int jj = r - 4 * g;
      if (jj >= 0 && jj < 4) { const unsigned one = 0x3F80u << (16 * (jj & 1)); if (jj < 2) { e.x = one; o.z = one; } else { e.y = one; o.w = one; } }
      selE = __builtin_bit_cast(s8, e); selO = __builtin_bit_cast(s8, o); }
    pg8::f32x4 MrkT = __builtin_amdgcn_mfma_f32_16x16x32_bf16(Kf[0], Rf[0], z4, 0, 0, 0); MrkT = __builtin_amdgcn_mfma_f32_16x16x32_bf16(Kf[1], Rf[1], MrkT, 0, 0, 0);
    const int tb = r >> 2, tj = r & 3;
    if (RWKV) {
        pg8::f32x4 LabT = __builtin_amdgcn_mfma_f32_16x16x32_bf16(Bf[0], Af[0], z4, 0, 0, 0); LabT = __builtin_amdgcn_mfma_f32_16x16x32_bf16(Bf[1], Af[1], LabT, 0, 0, 0);
        pg8::f32x4 LakT = __builtin_amdgcn_mfma_f32_16x16x32_bf16(Kf[0], Af[0], z4, 0, 0, 0); LakT = __builtin_amdgcn_mfma_f32_16x16x32_bf16(Kf[1], Af[1], LakT, 0, 0, 0);
        pg8::f32x4 MrbT = __builtin_amdgcn_mfma_f32_16x16x32_bf16(Bf[0], Rf[0], z4, 0, 0, 0); MrbT = __builtin_amdgcn_mfma_f32_16x16x32_bf16(Bf[1], Rf[1], MrbT, 0, 0, 0);
        const float d10 = __shfl(LabT[0], 20 * g + 1), d20 = __shfl(LabT[0], 20 * g + 2), d21 = __shfl(LabT[1], 20 * g + 2);
        const float d30 = __shfl(LabT[0], 20 * g + 3), d31 = __shfl(LabT[1], 20 * g + 3), d32 = __shfl(LabT[2], 20 * g + 3);
        pg8::f32x4 Loff, Lak, Mrb, Mrk;
#pragma unroll
        for (int j = 0; j < 4; ++j) { const bool below = g < tb, diag = g == tb;
            Loff[j] = below ? LabT[j] : 0.f; Lak[j] = (below || (diag && j < tj)) ? LakT[j] : 0.f;
            Mrb[j] = (below || (diag && j <= tj)) ? MrbT[j] : 0.f; Mrk[j] = (below || (diag && j <= tj)) ? MrkT[j] : 0.f; }
        REC[0 * 64] = __builtin_bit_cast(v4u, Af[0]); REC[1 * 64] = __builtin_bit_cast(v4u, Af[1]); REC[2 * 64] = __builtin_bit_cast(v4u, Rf[0]); REC[3 * 64] = __builtin_bit_cast(v4u, Rf[1]);
        REC[4 * 64] = __builtin_bit_cast(v4u, pack8(Loff, Lak)); REC[5 * 64] = __builtin_bit_cast(v4u, pack8(Mrb, Mrk));
        if (r == 0) { *(v4f*)(Dp + 8 * g) = (v4f){d10, d20, d21, d30}; *(v4f*)(Dp + 8 * g + 4) = (v4f){d31, d32, 0.f, 0.f}; }
#pragma unroll
        for (int mt = 0; mt < 4; ++mt) { const s8 sel = (mt & 1) ? selO : selE;
            const pg8::f32x4 K2 = __builtin_amdgcn_mfma_f32_16x16x32_bf16(KTf[mt >> 1], sel, z4, 0, 0, 0), B2 = __builtin_amdgcn_mfma_f32_16x16x32_bf16(BTf[mt >> 1], sel, z4, 0, 0, 0);
            REC[(6 + mt) * 64] = __builtin_bit_cast(v4u, pack8(B2, K2)); if (r == 15) GCp[4 * mt + g] = gcv[mt]; }
    } else {
        pg8::f32x4 Mrk;
#pragma unroll
        for (int j = 0; j < 4; ++j) Mrk[j] = (g < tb || (g == tb && j <= tj)) ? MrkT[j] : 0.f;
        REC[0 * 64] = __builtin_bit_cast(v4u, Rf[0]); REC[1 * 64] = __builtin_bit_cast(v4u, Rf[1]); REC[2 * 64] = __builtin_bit_cast(v4u, pack8(z4, Mrk));
#pragma unroll
        for (int mt = 0; mt < 4; ++mt) { const s8 sel = (mt & 1) ? selO : selE;
            const pg8::f32x4 K2 = __builtin_amdgcn_mfma_f32_16x16x32_bf16(KTf[mt >> 1], sel, z4, 0, 0, 0);
            REC[(3 + mt) * 64] = __builtin_bit_cast(v4u, pack8(z4, K2)); if (r == 15) GCp[4 * mt + g] = gcv[mt]; }
    }
}
__device__ PHASE_FN void chunk_prep_phase(const Ctx A, int vcu, int G) {
    const int tid = opaque_tid(), lane = tid & 63, wave = tid >> 6;
    const int gw = vcu * NWAVES + wave, NGW = G * NWAVES;
#pragma unroll 1
    for (int it = gw; it < 2 * 32 * NCHK; it += NGW) {
        const int mix = it >= 32 * NCHK, q = mix ? it - 32 * NCHK : it, bh = q / NCHK, c = q - bh * NCHK;
        if (mix) chunk_prep_item<false>(A, bh, c, lane); else chunk_prep_item<true>(A, bh, c, lane);
    }
}
template <bool RWKV>
__device__ PHASE_FN void chunk_scan(const Ctx A, LAS unsigned char* lds, int unit_) {
    const int unit = opaque_s(unit_);
    const int tid = opaque_tid(), lane = tid & 63, wave = tid >> 6, r = lane & 15, g = lane >> 4;
    const int slot = wave >> 2, nt = wave & 3;
    const int bh = 2 * unit + slot, b = bh >> 2, h = bh & 3;
    constexpr int NP = RWKV ? CKP_RW : CKP_HG;
    constexpr int NU = NP + 3;
    constexpr int NQ = (NU + 3) / 4;
    constexpr int RING = NU * 1024;
    constexpr size_t RB = RWKV ? CKR_RW : CKR_HG;
    const GAS unsigned char* recb = A.ws + (RWKV ? WS_CKF_RW : WS_CKF_HG) + (size_t)bh * NCHK * RB;
    const GAS unsigned char* vb = A.ws + (RWKV ? WS_RW_V : WS_HG_V) + (size_t)bh * L * 128;
    float* YR = (float*)(A.ws + (RWKV ? WS_YRAW : WS_ORAW)) + (size_t)b * L * 256 + h * 64 + nt * 16 + r;
    LAS unsigned char* ring = lds + slot * 2 * RING;
    static_assert(4 * (size_t)(CKP_RW + 3) * 1024 <= MISC_OFF, "chunk ring");
    auto unit_src = [&](int c_, int u) -> const GAS v4u* {
        if (u < NP) return (const GAS v4u*)(recb + (size_t)c_ * RB + u * 1024) + lane;
        if (u == NP) { const int q = lane * 16 < (int)(RB - NP * 1024) ? lane * 16 : (int)(RB - NP * 1024) - 16; return (const GAS v4u*)(recb + (size_t)c_ * RB + NP * 1024 + q); }
        return (const GAS v4u*)(vb + (size_t)c_ * CK * 128 + (u - NP - 1) * 1024) + lane; };
    v4u st0[NQ], st1[NQ], st2[NQ], st3[NQ];
#define CK_LD(S, c_) do { const int cc_ = (c_) < NCHK ? (c_) : NCHK - 1; _Pragma("unroll") for (int q = 0; q < NQ; ++q) { const int u = nt + 4 * q; if (u < NU) S[q] = *unit_src(cc_, u); } } while (0)
#define CK_ST(S, p_) do { _Pragma("unroll") for (int q = 0; q < NQ; ++q) { const int u = nt + 4 * q; if (u < NU) *(LAS v4u*)(ring + (p_) * RING + u * 1024 + lane * 16) = S[q]; } } while (0)
    pg8::f32x4 ST[4];
#pragma unroll
    for (int mt = 0; mt < 4; ++mt) ST[mt] = (pg8::f32x4){0.f, 0.f, 0.f, 0.f};
    const pg8::f32x4 z4 = (pg8::f32x4){0.f, 0.f, 0.f, 0.f};
    auto body = [&](const int c, const int p) __attribute__((always_inline)) {
        const LAS unsigned char* rb_ = ring + p * RING;
        const LAS unsigned char* sm = rb_ + NP * 1024;
        v4u pcs[NP]; v4f gqs[4]; v4f da = (v4f){0.f, 0.f, 0.f, 0.f}, db = da;
#pragma unroll
        for (int i = 0; i < NP; ++i) pcs[i] = *(const LAS v4u*)(rb_ + i * 1024 + lane * 16);
#pragma unroll
        for (int mt = 0; mt < 4; ++mt) gqs[mt] = *(const LAS v4f*)(sm + (16 * mt + 4 * g) * 4);
        if (RWKV) { da = *(const LAS v4f*)(sm + 256 + g * 32); db = *(const LAS v4f*)(sm + 256 + g * 32 + 16); }
#define PIECE(i) __builtin_bit_cast(s8, pcs[i])
        unsigned vp0, vp1;
        { const LAS unsigned short* vv = (const LAS unsigned short*)(rb_ + (NP + 1) * 1024) + (4 * g) * 64 + 16 * nt + r;
          vp0 = (unsigned)vv[0] | ((unsigned)vv[64] << 16); vp1 = (unsigned)vv[128] | ((unsigned)vv[192] << 16); }
        __builtin_amdgcn_sched_barrier(0);
        const s8 Sf0 = pack8(ST[0], ST[1]), Sf1 = pack8(ST[2], ST[3]);
        pg8::f32x4 U = z4, R0;
        if (RWKV) {
            R0 = __builtin_amdgcn_mfma_f32_16x16x32_bf16(PIECE(2), Sf0, z4, 0, 0, 0); R0 = __builtin_amdgcn_mfma_f32_16x16x32_bf16(PIECE(3), Sf1, R0, 0, 0, 0);
            pg8::f32x4 W0 = __builtin_amdgcn_mfma_f32_16x16x32_bf16(PIECE(0), Sf0, z4, 0, 0, 0); W0 = __builtin_amdgcn_mfma_f32_16x16x32_bf16(PIECE(1), Sf1, W0, 0, 0, 0);
            const float d10 = da.x, d20 = da.y, d21 = da.z, d30 = da.w, d31 = db.x, d32 = db.y;
            const s8 Ajac = PIECE(4);
#pragma unroll
            for (int rnd = 0; rnd < 4; ++rnd) {
                v4u bu; bu.x = pk2(U[0], U[1]); bu.y = pk2(U[2], U[3]); bu.z = vp0; bu.w = vp1;
                const pg8::f32x4 Wr = __builtin_amdgcn_mfma_f32_16x16x32_bf16(Ajac, __builtin_bit_cast(s8, bu), W0, 0, 0, 0);
                U[0] = Wr[0]; U[1] = Wr[1] + d10 * U[0]; U[2] = Wr[2] + d20 * U[0] + d21 * U[1]; U[3] = Wr[3] + d30 * U[0] + d31 * U[1] + d32 * U[2];
            }
        } else {
            R0 = __builtin_amdgcn_mfma_f32_16x16x32_bf16(PIECE(0), Sf0, z4, 0, 0, 0); R0 = __builtin_amdgcn_mfma_f32_16x16x32_bf16(PIECE(1), Sf1, R0, 0, 0, 0);
        }
        v4u buv; buv.x = pk2(U[0], U[1]); buv.y = pk2(U[2], U[3]); buv.z = vp0; buv.w = vp1;
        const s8 Buv = __builtin_bit_cast(s8, buv);
        const pg8::f32x4 Yt = __builtin_amdgcn_mfma_f32_16x16x32_bf16(PIECE(RWKV ? 5 : 2), Buv, R0, 0, 0, 0);
#pragma unroll
        for (int j = 0; j < 4; ++j) YR[(size_t)(c * CK + 4 * g + j) * 256] = Yt[j];
#pragma unroll
        for (int mt = 0; mt < 4; ++mt) {
            const v4f gq = gqs[mt];
            ST[mt][0] *= gq.x; ST[mt][1] *= gq.y; ST[mt][2] *= gq.z; ST[mt][3] *= gq.w;
            ST[mt] = __builtin_amdgcn_mfma_f32_16x16x32_bf16(PIECE((RWKV ? 6 : 3) + mt), Buv, ST[mt], 0, 0, 0);
        }
#undef PIECE
    };
    CK_LD(st0, 0); CK_LD(st1, 1); CK_LD(st2, 2); CK_LD(st3, 3);
    CK_ST(st0, 0);
    __syncthreads();
#define CK_TRIP(c_, SLD, SST, p_) do { CK_LD(SLD, (c_) + 4); body((c_), (p_)); CK_ST(SST, 1 - (p_)); __syncthreads(); } while (0)
    static_assert(NCHK % 4 == 1, "chunk loop: whole groups of four trips + one");
#pragma unroll 1
    for (int c = 0; c < NCHK - 1; c += 4) {
        CK_TRIP(c, st0, st1, 0);
        CK_TRIP(c + 1, st1, st2, 1);
        CK_TRIP(c + 2, st2, st3, 0);
        CK_TRIP(c + 3, st3, st0, 1);
    }
    CK_TRIP(NCHK - 1, st0, st1, 0);
#undef CK_TRIP
#undef CK_LD
#undef CK_ST
}
__device__ __forceinline__ float rowmax16(float x) { x = fmaxf(x, dpp_f<0xB1>(x)); x = fmaxf(x, dpp_f<0x4E>(x)); x = fmaxf(x, dpp_f<0x141>(x)); x = fmaxf(x, dpp_f<0x140>(x)); return x; }
__device__ __forceinline__ int rowmin16i(int x) { x = min(x, __builtin_amdgcn_update_dpp(0, x, 0xB1, 0xF, 0xF, true)); x = min(x, __builtin_amdgcn_update_dpp(0, x, 0x4E, 0xF, 0xF, true));
    x = min(x, __builtin_amdgcn_update_dpp(0, x, 0x141, 0xF, 0xF, true)); x = min(x, __builtin_amdgcn_update_dpp(0, x, 0x140, 0xF, 0xF, true)); return x; }
__device__ PHASE_FN void ln_router_phase(const Ctx A, LAS unsigned char* lds, int l, int vcu, int G) {
    const int tid = opaque_tid(), lane = tid & 63, wave = tid >> 6, r = lane & 15, g = lane >> 4;
    const int gw = vcu * NWAVES + wave, NGW = G * NWAVES;
    bf16* HB = (bf16*)(A.ws + WS_HB);
    int* TIDX = (int*)(A.ws + WS_TIDX); float* TGATE = (float*)(A.ws + WS_TGATE);
    unsigned* ecnt = (unsigned*)(A.ws + WS_CTL) + CW_ECNT + 64 * l;
    const float* gg = gin(A, 26) + l * D; const float* bb = gin(A, 27) + l * D;
    const float* rw = gin(A, 28) + (size_t)l * D * NE; const float* rb = gin(A, 29) + l * NE;
    LAS int* hist = (LAS int*)(lds + MISC_OFF + MI_HIST);
    if (tid < 32) hist[tid] = 0;
    for (int f = tid; f < 32 * 2 * 64; f += NTHR) { const int ks = f >> 7, nt = (f >> 6) & 1, ln = f & 63, n = ln & 15, g8 = ln >> 4;
        float w8[8];
#pragma unroll
        for (int e = 0; e < 8; ++e) w8[e] = rw[(size_t)(32 * ks + 8 * g8 + e) * NE + 16 * nt + n];
        v4u hi, lo; unsigned hh[4], ll[4];
#pragma unroll
        for (int e = 0; e < 4; ++e) { const unsigned ph = pk2(w8[2 * e], w8[2 * e + 1]); hh[e] = ph; ll[e] = pk2(w8[2 * e] - bflo(ph), w8[2 * e + 1] - bfhi(ph)); }
        hi = (v4u){hh[0], hh[1], hh[2], hh[3]}; lo = (v4u){ll[0], ll[1], ll[2], ll[3]};
        *(LAS v4u*)(lds + ((size_t)((ks * 2 + nt) * 2 + 0) * 64 + ln) * 16) = hi; *(LAS v4u*)(lds + ((size_t)((ks * 2 + nt) * 2 + 1) * 64 + ln) * 16) = lo; }
    __syncthreads();
    const float rb0 = rb[r], rb1 = rb[16 + r];
    auto lnrows = [&](size_t mrow, auto nrows_c) {
        constexpr int NR = decltype(nrows_c)::value;
        v4f x[NR][4];
#pragma unroll
        for (int u = 0; u < NR; ++u)
#pragma unroll
            for (int j = 0; j < 4; ++j) x[u][j] = ld_bf4(HB + (mrow + u) * D + 256 * j + 4 * lane);
#pragma unroll
        for (int u = 0; u < NR; ++u) { ln_row(x[u], gg, bb, lane);
#pragma unroll
            for (int j = 0; j < 4; ++j) { const size_t o = (mrow + u) * D + 256 * j + 4 * lane;
                v2u hi; hi.x = pk2(x[u][j].x, x[u][j].y); hi.y = pk2(x[u][j].z, x[u][j].w);
                *(v2u*)(HB + o) = hi; } }
    };
    auto ln2 = [&](size_t mrow) { lnrows(mrow, std::integral_constant<int, 2>{}); };
    auto route = [&](size_t m0) {
        pg8::f32x4 C0 = (pg8::f32x4){0.f, 0.f, 0.f, 0.f}, C1 = C0;
        const bf16* ah = HB + (m0 + r) * D + 8 * g;
#pragma unroll 4
        for (int ks = 0; ks < 32; ++ks) {
            const s8 xh = *(const s8*)(ah + 32 * ks);
            const LAS unsigned char* wf = lds + (size_t)(ks * 4) * 1024 + lane * 16;
            const s8 w0h = *(const LAS s8*)(wf), w0l = *(const LAS s8*)(wf + 1024), w1h = *(const LAS s8*)(wf + 2048), w1l = *(const LAS s8*)(wf + 3072);
            C0 = __builtin_amdgcn_mfma_f32_16x16x32_bf16(xh, w0h, C0, 0, 0, 0); C0 = __builtin_amdgcn_mfma_f32_16x16x32_bf16(xh, w0l, C0, 0, 0, 0);
            C1 = __builtin_amdgcn_mfma_f32_16x16x32_bf16(xh, w1h, C1, 0, 0, 0); C1 = __builtin_amdgcn_mfma_f32_16x16x32_bf16(xh, w1l, C1, 0, 0, 0);
        }
#pragma unroll
        for (int j = 0; j < 4; ++j) {
            float v0 = C0[j] + rb0, v1 = C1[j] + rb1;
            float tv[4]; int ti[4];
#pragma unroll
            for (int q = 0; q < 4; ++q) {
                const float mx = rowmax16(fmaxf(v0, v1));
                const int cand = (v0 == mx) ? r : ((v1 == mx) ? 16 + r : 64);
                const int bi = rowmin16i(cand);
                tv[q] = mx; ti[q] = bi;
                if (bi == r) v0 = -3.0e38f; if (bi == 16 + r) v1 = -3.0e38f;
            }
            const float e1 = __expf(tv[1] - tv[0]), e2 = __expf(tv[2] - tv[0]), e3 = __expf(tv[3] - tv[0]); const float inv = rcp_(1.f + e1 + e2 + e3);
            const size_t m = m0 + 4 * g + j;
            if (r == 0) { *(int4*)(TIDX + m * 4) = make_int4(ti[0], ti[1], ti[2], ti[3]); *(v4f*)(TGATE + m * 4) = (v4f){inv, e1 * inv, e2 * inv, e3 * inv}; }
            if (r < 4) lds_add(&hist[r == 0 ? ti[0] : r == 1 ? ti[1] : r == 2 ? ti[2] : ti[3]], 1);
        }
    };
    const int NT16 = T / 16, nfull = (NT16 / NGW) * NGW;
#pragma unroll 1
    for (int tile = gw; tile < nfull; tile += NGW) {
        const size_t m0 = (size_t)tile * 16;
#pragma unroll 1
        for (int t = 0; t < 16; t += 4) lnrows(m0 + t, std::integral_constant<int, 4>{});
        asm volatile("s_waitcnt vmcnt(0)" ::: "memory");
        route(m0);
    }
#pragma unroll 1
    for (int tile = nfull + vcu; tile < NT16; tile += G) {
        const size_t m0 = (size_t)tile * 16;
        ln2(m0 + 2 * wave);
        asm volatile("s_waitcnt vmcnt(0)" ::: "memory");
        __syncthreads();
        if (wave == 0) route(m0);
    }
    __syncthreads();
    if (tid < 32) atomicAdd(&ecnt[tid], (unsigned)hist[tid]);
}
__device__ __forceinline__ int build_tiles(const Ctx A, LAS unsigned char* lds, int l) {
    const int tid = opaque_tid();
    const unsigned* ecnt = (const unsigned*)(A.ws + WS_CTL) + CW_ECNT + 64 * l;
    LAS int* offs = (LAS int*)(lds + MISC_OFF + MI_OFFS); LAS int* tile_e = (LAS int*)(lds + MISC_OFF + MI_TILE); LAS int* nt = (LAS int*)(lds + MISC_OFF + MI_NT);
    __syncthreads();
    if (tid < 32) { int off = 0, mycnt = 0;
        for (int e = 0; e < 32; ++e) { const int c = (int)__hip_atomic_load(ecnt + e, __ATOMIC_RELAXED, __HIP_MEMORY_SCOPE_AGENT); if (e < tid) off += (c + 255) & ~255; if (e == tid) mycnt = c; }
        offs[tid] = off;
        const int t0 = off >> 8, t1 = (off + ((mycnt + 255) & ~255)) >> 8;
        for (int t = t0; t < t1; ++t) tile_e[t] = tid;
        if (tid == 31) nt[0] = t1; }
    __syncthreads();
    return nt[0];
}
__device__ PHASE_FN void moe_sort_phase(const Ctx A, LAS unsigned char* lds, int l) {
    const int tid = opaque_tid();
    const int* TIDX = (const int*)(A.ws + WS_TIDX); const float* TGATE = (const float*)(A.ws + WS_TGATE);
    int* SPOS = (int*)(A.ws + WS_SPOS); float* GSORT = (float*)(A.ws + WS_GSORT); int* RMAP = (int*)(A.ws + WS_RMAP);
    unsigned* ecur = (unsigned*)(A.ws + WS_CTL) + CW_ECUR + 64 * l; const unsigned* ecnt = (const unsigned*)(A.ws + WS_CTL) + CW_ECNT + 64 * l;
    LAS int* hist = (LAS int*)(lds + MISC_OFF + MI_HIST); LAS int* lcur = (LAS int*)(lds + MISC_OFF + MI_LCUR); LAS int* lbase = (LAS int*)(lds + MISC_OFF + MI_LBASE);
    LAS int* offs = (LAS int*)(lds + MISC_OFF + MI_OFFS);
    (void)build_tiles(A, lds, l);
    const int TPB = (T + (int)gridDim.x - 1) / (int)gridDim.x;
    const int mbeg = blockIdx.x * TPB, mend = (mbeg + TPB < T) ? mbeg + TPB : T;
    const int nslot = (mend > mbeg) ? (mend - mbeg) * 4 : 0;
    if (tid < 32) { hist[tid] = 0; lcur[tid] = 0; }
    __syncthreads();
    for (int s = tid; s < nslot; s += NTHR) lds_add(&hist[TIDX[(size_t)mbeg * 4 + s]], 1);
    __syncthreads();
    if (tid < 32) lbase[tid] = offs[tid] + (int)atomicAdd(&ecur[tid], (unsigned)hist[tid]);
    __syncthreads();
    for (int s = tid; s < nslot; s += NTHR) { const size_t gs = (size_t)mbeg * 4 + s; const int e = TIDX[gs];
        const int pos = lbase[e] + lds_add(&lcur[e], 1);
        SPOS[gs] = pos; GSORT[pos] = TGATE[gs]; RMAP[pos] = mbeg + (s >> 2); }
    if (blockIdx.x < 32) { const int e = blockIdx.x; const int c = (int)__hip_atomic_load(ecnt + e, __ATOMIC_RELAXED, __HIP_MEMORY_SCOPE_AGENT);
        const int p0 = offs[e] + c, p1 = offs[e] + ((c + 255) & ~255);
        for (int p = p0 + tid; p < p1; p += NTHR) RMAP[p] = 0; }
}
__device__ PHASE_FN void combine_ln_phase(const Ctx A, int l, int vcu, int G) {
    const int tid = opaque_tid(), lane = tid & 63, wave = tid >> 6;
    const int gw = vcu * NWAVES + wave, NGW = G * NWAVES;
    bf16* HB = (bf16*)(A.ws + WS_HB); const bf16* Y = (const bf16*)(A.ws + WS_YBUF); const int* SPOS = (const int*)(A.ws + WS_SPOS);
    const float* g = gin(A, 34) + l * D; const float* bb = gin(A, 35) + l * D;
#pragma unroll 1
    for (int m0 = 2 * gw; m0 < T; m0 += 2 * NGW) {
        v4f v[2][4];
#pragma unroll
        for (int t = 0; t < 2; ++t) { const int m = m0 + t;
            const int4 sp = *(const int4*)(SPOS + (size_t)m * 4);
#pragma unroll
            for (int j = 0; j < 4; ++j) { const size_t co = 256 * j + 4 * lane;
                const v4f y = ld_bf4(Y + (size_t)sp.x * D + co) + ld_bf4(Y + (size_t)sp.y * D + co) + ld_bf4(Y + (size_t)sp.z * D + co) + ld_bf4(Y + (size_t)sp.w * D + co);
                v[t][j] = ld_bf4(HB + (size_t)m * D + co) * ALPHA + y; } }
#pragma unroll
        for (int t = 0; t < 2; ++t) { const int m = m0 + t;
            ln_row(v[t], g, bb, lane);
            if (l == 0) {
#pragma unroll
                for (int j = 0; j < 4; ++j) st_bf4(HB + (size_t)m * D + 256 * j + 4 * lane, v[t][j]);
            } else {
                const int b = m / L, i = m - b * L;
                if (i >= NMETA) { float* o = (float*)(GAS float*)A.out + ((size_t)b * SEQ + (i - NMETA)) * D;
#pragma unroll
                    for (int j = 0; j < 4; ++j) *(v4f*)(o + 256 * j + 4 * lane) = v[t][j]; }
            }
        }
    }
}
constexpr int N_PHASES = 23;
#ifndef PH_ONLY
#define PH_ONLY -1
#endif
#define PHSEL(j) (PH_ONLY < 0 || PH_ONLY == (j))
#define IN(k) (lo <= (k) && (k) < hi)
#if MK_ONE_LAUNCH
#define GRID_BAR() xcd_barrier(bar)
#else
#define GRID_BAR() do { } while (0)
#endif
#define SEAM(k) do { if (IN(k) && IN((k) + 1)) GRID_BAR(); } while (0)
#define CTX() Ctx{args.in, args.out, launder(args.ws)}
#ifndef PROBE_PHASE
#define PROBE_PHASE -1
#endif
#ifndef PROBE_MULT
#define PROBE_MULT 4
#endif
#define PB_BEGIN(j) do { if (PROBE_PHASE == (j)) { pstamp = __builtin_amdgcn_s_memrealtime(); } } while (0)
#define PB_END(j) do { if (PROBE_PHASE == (j)) { pacc += __builtin_amdgcn_s_memrealtime() - pstamp; } } while (0)
__device__ __forceinline__ void layer_phases(const int l, const Args& args, LAS unsigned char* lds, const int G, const int bx, const int vcu, const int lo, const int hi, const XcdBarrier& bar, unsigned long long& pacc) {
    unsigned long long pstamp = 0ull; (void)pstamp;

        const int pb = 1 + 11 * l;
        PB_BEGIN(0);
        if (PHSEL(0) && IN(pb + 0)) { GAS unsigned char* wsl = launder(args.ws);
            pg8::Gemm g{(const pg8::bf16_t*)(wsl + WS_HB), (const pg8::bf16_t*)(wsl + WS_WIN) + (size_t)l * NINP * 1024, TP, NINP, 1024};
            pg8::StaticOrder S; S.init(TP, NINP, G, bx);
            pg8::EpiStoreBf16 E{(pg8::bf16_t*)(wsl + WS_PROJ), NINP};
            pg8::gemm_phase<pg8::EpiStoreBf16, pg8::StaticOrder, true, true>(lds, g, S, E);
            SEAM(pb + 0); PB_END(0);
        }
        PB_BEGIN(1);
        if (PHSEL(1) && IN(pb + 1)) { prep_phase(CTX(), lds, l, vcu, G); SEAM(pb + 1); PB_END(1); }
        PB_BEGIN(2);
        if (PHSEL(2) && IN(pb + 2)) { chunk_prep_phase(CTX(), vcu, G); lru_agg_phase(CTX(), vcu, G); SEAM(pb + 2); PB_END(2); }
        PB_BEGIN(3);
        if (PHSEL(3) && IN(pb + 3)) {
#ifndef PH2_SEL
#define PH2_SEL 15
#endif
            PB_BEGIN(20); PB_BEGIN(21); PB_BEGIN(22); PB_BEGIN(23);
#if SCAN_SEQ
            if ((PH2_SEL & 1) && bx < 64) rwkv_scan(CTX(), lds, bx); else if ((PH2_SEL & 2) && bx >= 64 && bx < 128) hgrn_scan(CTX(), lds, bx - 64); else if ((PH2_SEL & 4) && bx >= 128 && bx < 132) lru_carry_phase(CTX(), 128);
#else
            if ((PH2_SEL & 1) && bx < 16) chunk_scan<true>(CTX(), lds, bx); else if ((PH2_SEL & 2) && bx >= 16 && bx < 32) chunk_scan<false>(CTX(), lds, bx - 16); else if ((PH2_SEL & 4) && bx >= 32 && bx < 36) lru_carry_phase(CTX(), 32);
#endif
            __syncthreads();
            PB_END(20); PB_END(21); PB_END(22);
#if DSA_NAIVE
            if (PH2_SEL & 8) dsa_phase(CTX(), lds, l);
#else
            if (PH2_SEL & 8) dsa_select_phase(CTX(), lds, l);
#endif
            __syncthreads();
            PB_END(23);
            SEAM(pb + 3); PB_END(3);
        }
        PB_BEGIN(4);
        if (PHSEL(4) && IN(pb + 4)) {
            PB_BEGIN(24);
            lru_out_phase(CTX(), vcu, G);
            mixers_finish(CTX(), l, vcu, G);
            __syncthreads(); PB_END(24);
#if !DSA_NAIVE
            dsa_attn_phase(CTX(), lds, l);
#endif
            SEAM(pb + 4); PB_END(4);
        }
        PB_BEGIN(5);
        if (PHSEL(5) && IN(pb + 5)) { GAS unsigned char* wsl = launder(args.ws);
            pg8::Gemm g{(const pg8::bf16_t*)(wsl + WS_MIX), (const pg8::bf16_t*)(wsl + WS_WOUT) + (size_t)l * 1024 * 1024, TP, 1024, 1024};
            pg8::StaticOrder S; S.init(TP, 1024, G, bx);
            pg8::EpiResidBf E{(pg8::bf16_t*)(wsl + WS_HB), 1024, ALPHA};
            pg8::gemm_phase<pg8::EpiResidBf, pg8::StaticOrder, true, true>(lds, g, S, E);
            SEAM(pb + 5); PB_END(5);
        }
        PB_BEGIN(6);
        if (PHSEL(6) && IN(pb + 6)) { ln_router_phase(CTX(), lds, l, vcu, G); SEAM(pb + 6); PB_END(6); }
        PB_BEGIN(7);
        if (PHSEL(7) && IN(pb + 7)) { moe_sort_phase(CTX(), lds, l); SEAM(pb + 7); PB_END(7); }
        PB_BEGIN(8);
        if (PHSEL(8) && IN(pb + 8)) { GAS unsigned char* wsl = launder(args.ws);
            const int nt = build_tiles(CTX(), lds, l);
            pg8::Gemm g{(const pg8::bf16_t*)(wsl + WS_HB), (const pg8::bf16_t*)(wsl + WS_W1) + (size_t)l * 32 * 2048 * 1024, RMAX, 32 * 2048, 1024};
            pg8::MoeOrder S{nt * 8, G, vcu, 8, (const LAS int*)(lds + MISC_OFF + MI_TILE)};
            pg8::EpiSwiGLU E{(pg8::bf16_t*)(wsl + WS_ACT), (const float*)(const GAS float*)args.in[31] + (size_t)l * 32 * 2048};
            pg8::gemm_phase_gather<pg8::EpiSwiGLU, pg8::MoeOrder>(lds, g, S, E, (const int*)(wsl + WS_RMAP));
            SEAM(pb + 8); PB_END(8);
        }
        PB_BEGIN(9);
        if (PHSEL(9) && IN(pb + 9)) { GAS unsigned char* wsl = launder(args.ws);
            const int nt = build_tiles(CTX(), lds, l);
            pg8::Gemm g{(const pg8::bf16_t*)(wsl + WS_ACT), (const pg8::bf16_t*)(wsl + WS_W2) + (size_t)l * 32 * 1024 * 1024, RMAX, 32 * 1024, 1024};
            pg8::MoeOrder S{nt * 4, G, vcu, 4, (const LAS int*)(lds + MISC_OFF + MI_TILE)};
            pg8::EpiMoeOut E{(pg8::bf16_t*)(wsl + WS_YBUF), (const float*)(const GAS float*)args.in[33] + (size_t)l * 32 * 1024, (const float*)(wsl + WS_GSORT)};
            pg8::gemm_phase<pg8::EpiMoeOut, pg8::MoeOrder, true, true>(lds, g, S, E);
            SEAM(pb + 9); PB_END(9);
        }
        PB_BEGIN(10);
        if (PHSEL(10) && IN(pb + 10)) { combine_ln_phase(CTX(), l, vcu, G); SEAM(pb + 10); PB_END(10); }
}
__global__ void __launch_bounds__(NTHR, 2) trunk_fwd(Args args) {
    extern __shared__ __attribute__((aligned(16))) unsigned char lds_raw[];
    LAS unsigned char* lds = (LAS unsigned char*)lds_raw;
    const int tid = threadIdx.x;
    const int G = gridDim.x; const int bx = blockIdx.x; const int vcu = (G % 8 == 0) ? (bx % 8) * (G / 8) + bx / 8 : bx;
    unsigned* ctl = (unsigned*)(args.ws + WS_CTL);
    for (int u = tid; u < (LDS_BYTES - MISC_OFF) / 4; u += NTHR) ((LAS unsigned*)(lds + MISC_OFF))[u] = 0u;
    __syncthreads();
#if MK_ONE_LAUNCH
    XcdBarrier bar = xcd_barrier_post(ctl + CW_BAR, (volatile LAS unsigned*)(lds + MISC_OFF + MI_BAR));
#else
    XcdBarrier bar; bar.bar = ctl + CW_BAR; bar.x = 0; bar.st = nullptr;
#endif
    const int lo = args.ph_lo, hi = args.ph_hi;

    unsigned long long pacc = 0ull, pstamp = 0ull; (void)pstamp;
    PB_BEGIN(11);
    if (PHSEL(11) && IN(0)) { p0_prologue(CTX(), lds, vcu, G); SEAM(0); }
    PB_END(11);

#pragma unroll 1
    for (int l = 0; l < 2; ++l) layer_phases(l, args, lds, G, bx, vcu, lo, hi, bar, pacc);
    if (PROBE_PHASE >= 0 && bx == (PROBE_PHASE == 21 ? 16 : PROBE_PHASE == 22 ? 32 : PROBE_PHASE == 23 ? 255 : 0)) { const unsigned long long t0 = __builtin_amdgcn_s_memrealtime(); while (__builtin_amdgcn_s_memrealtime() - t0 < pacc * PROBE_MULT) __builtin_amdgcn_s_sleep(8); }
#undef IN
#undef SEAM
}

extern "C" void kernel_launch(void* const* d_in, const int* in_sizes, int n_in, void* d_out, int out_size, void* d_ws, size_t ws_size, hipStream_t stream) {
    static int grid = 0;
    if (grid == 0) {
        if (n_in != 36 || in_sizes[0] != NB * SEQ * D || out_size != NB * SEQ * D || ws_size < WS_END) {
            fprintf(stderr, "kernel_launch: unexpected problem (n_in %d, in0 %d, out %d, ws %zu, need %zu); nothing launched\n", n_in, n_in > 0 ? in_sizes[0] : -1, out_size, ws_size, (size_t)WS_END); grid = -1; return; }
        int dev = 0, cus = 0, per_cu = 0;
        if (hipGetDevice(&dev) != hipSuccess || hipDeviceGetAttribute(&cus, hipDeviceAttributeMultiprocessorCount, dev) != hipSuccess) { grid = -1; return; }
        if (hipFuncSetAttribute((const void*)trunk_fwd, hipFuncAttributeMaxDynamicSharedMemorySize, LDS_BYTES) != hipSuccess) { fprintf(stderr, "kernel_launch: hipFuncSetAttribute failed\n"); grid = -1; return; }
        if (hipOccupancyMaxActiveBlocksPerMultiprocessor(&per_cu, (const void*)trunk_fwd, NTHR, LDS_BYTES) != hipSuccess || per_cu < 1) { fprintf(stderr, "kernel_launch: occupancy query says %d\n", per_cu); (void)hipGetLastError(); }
        grid = cus;
        if (grid < 160 || grid > 512) { fprintf(stderr, "kernel_launch: unsupported CU count %d\n", cus); grid = -1; return; }
    }
    if (grid < 0) return;
    if (hipMemsetAsync((char*)d_ws + WS_CTL, 0, CTL_ZERO_BYTES, stream) != hipSuccess) return;
    Args a; memset(&a, 0, sizeof(a));
    for (int i = 0; i < 36; ++i) a.in[i] = (const float*)d_in[i];
    a.out = (float*)d_out; a.ws = (unsigned char*)d_ws;
#if MK_ONE_LAUNCH
    a.ph_lo = 0; a.ph_hi = N_PHASES;
    hipLaunchKernelGGL(trunk_fwd, dim3(grid), dim3(NTHR), LDS_BYTES, stream, a);
#else
    for (int p = 0; p < N_PHASES; ++p) { a.ph_lo = p; a.ph_hi = p + 1; hipLaunchKernelGGL(trunk_fwd, dim3(grid), dim3(NTHR), LDS_BYTES, stream, a); }
#endif
}
```

```cpp
#include <hip/hip_runtime.h>
#include <cstdio>
#include <cstdint>
#include <cstring>

#ifndef MK_ONE_LAUNCH
#define MK_ONE_LAUNCH 1
#endif

#ifndef SCAN_SEQ
#define SCAN_SEQ 0
#endif
#ifndef SCAN_MIX
#define SCAN_MIX 0
#endif
#ifndef DSA_NAIVE
#define DSA_NAIVE 0
#endif
#ifndef PHASE_FN
#define PHASE_FN __forceinline__
#endif
#define GAS __attribute__((address_space(1)))
#define LAS __attribute__((address_space(3)))
typedef unsigned short bf16;
typedef unsigned v4u __attribute__((ext_vector_type(4)));
typedef unsigned v2u __attribute__((ext_vector_type(2)));
typedef float v4f __attribute__((ext_vector_type(4)));
typedef float v2f __attribute__((ext_vector_type(2)));

constexpr int NB = 8, SEQ = 8192, NMETA = 16, L = SEQ + NMETA  , T = NB * L  , TP = 65792  , D = 1024;
constexpr int NINP = 3584;
constexpr int NE = 32, TOPK = 4;
constexpr int RMAX = 1058 * 256;
constexpr int C_RW = 0, C_RW_R = 0, C_RW_WD = 256, C_RW_K = 320, C_RW_V = 576, C_RW_AD = 832, C_RW_GD = 896;
constexpr int C_DS_Q = 960, C_DS_K = 1216, C_DS_V = 1472, C_DS_QI = 1728, C_DS_KI = 1984, C_DS_WI = 2016;
constexpr int C_LR_X = 2024, C_LR_G = 2280;
constexpr int C_HG_Q = 2536, C_HG_F = 2792, C_HG_I = 3048, C_HG_G = 3304;
constexpr float ALPHA = 1.41421356237f;
constexpr float LN_EPS = 1e-5f;

constexpr size_t MiB = 1u << 20;
constexpr size_t WS_CTL = 0, CTL_ZERO_BYTES = 1 * MiB;
constexpr size_t WS_WIN = 2 * MiB;
constexpr size_t WS_WOUT = 16 * MiB;
constexpr size_t WS_W1 = 20 * MiB;
constexpr size_t WS_W2 = 276 * MiB;
constexpr size_t WS_H = 404 * MiB;
constexpr size_t WS_MIX = WS_H;
constexpr size_t WS_HB = 661 * MiB;
constexpr size_t WS_BIG = 790 * MiB;
constexpr size_t WS_PROJ = WS_BIG;
constexpr size_t SZ_HM32 = (size_t)32 * L * 64 * 4;
constexpr size_t SZ_HM16 = SZ_HM32 / 2;
constexpr size_t SZ_TM16 = (size_t)T * 256 * 2;
constexpr size_t WS_RW_W = 1240 * MiB;
constexpr size_t WS_RW_A = WS_RW_W + SZ_HM32, WS_RW_B = WS_RW_A + SZ_HM16, WS_RW_K = WS_RW_B + SZ_HM16, WS_RW_WR = WS_RW_K + SZ_HM16, WS_RW_V = WS_RW_WR + SZ_HM16;
constexpr size_t WS_RW_G = WS_RW_V + SZ_HM16;
constexpr size_t WS_RW_SC = WS_RW_G + SZ_TM16;
constexpr size_t WS_DS_Q = WS_RW_SC + (size_t)32 * L * 16;
constexpr size_t WS_DS_K = WS_DS_Q + SZ_TM16, WS_DS_V = WS_DS_K + SZ_TM16, WS_DS_QI = WS_DS_V + SZ_TM16;
constexpr size_t WS_DS_KI = WS_DS_QI + SZ_TM16;
constexpr size_t WS_DS_WI = WS_DS_KI + (size_t)T * 64;
constexpr size_t WS_LR_A = WS_DS_WI + (size_t)T * 32;
constexpr size_t WS_LR_U = WS_LR_A + (size_t)T * 1024, WS_LR_G = WS_LR_U + SZ_TM16;
constexpr size_t WS_HG_F = WS_LR_G + SZ_TM16;
constexpr size_t WS_HG_K = WS_HG_F + SZ_HM32, WS_HG_Q = WS_HG_K + SZ_HM16, WS_HG_V = WS_HG_Q + SZ_HM16, WS_HG_G = WS_HG_V + SZ_HM16;
constexpr size_t WS_MIX_END = WS_HG_G + SZ_TM16;
constexpr size_t SZ_SORT = (size_t)RMAX * 1024 * 2;
constexpr size_t WS_SORTA = WS_BIG, WS_YBUF = WS_BIG, WS_ACT = WS_BIG + SZ_SORT;
constexpr size_t WS_TIDX = WS_ACT + SZ_SORT;
constexpr size_t WS_TGATE = WS_TIDX + (size_t)T * 16;
constexpr size_t WS_SPOS = WS_TGATE + (size_t)T * 16;
constexpr size_t WS_GSORT = WS_SPOS + (size_t)T * 16;
constexpr size_t WS_RMAP = WS_GSORT + (size_t)RMAX * 4;
constexpr size_t WS_MOE_END = WS_RMAP + (size_t)RMAX * 4;
constexpr size_t WS_END = 2040 * MiB;
static_assert(WS_MIX_END <= WS_END && WS_MOE_END <= WS_END, "workspace map");
static_assert(WS_PROJ + (size_t)TP * NINP * 2 <= WS_RW_W, "proj vs prep");
static_assert(WS_HB + (size_t)TP * 1024 * 2 <= WS_BIG && WS_H + (size_t)TP * 4096 <= WS_HB, "h/hb");

constexpr int CW_TMO = 0, CW_CODE = 1;
constexpr int CW_BAR = 4096;
constexpr int CW_DSAQ = 8192;
constexpr int CW_ECNT = 8448;
constexpr int CW_ECUR = 8704;

constexpr int LDS_BYTES = 163840;
constexpr int MISC_OFF = 155648;
constexpr int MI_BAR = 0, MI_HIST = 64, MI_LCUR = 192, MI_LBASE = 320, MI_NT = 448, MI_OFFS = 512, MI_TILE = 1024;
constexpr int NWAVES = 8, NTHR = 512;

__device__ __forceinline__ float bf2f(unsigned short x) { return __uint_as_float((unsigned)x << 16); }
__device__ __forceinline__ float bflo(unsigned x) { return __uint_as_float(x << 16); }
__device__ __forceinline__ float bfhi(unsigned x) { return __uint_as_float(x & 0xffff0000u); }
typedef float f32x2_t __attribute__((ext_vector_type(2))); typedef __bf16 bf16x2_t __attribute__((ext_vector_type(2)));
__device__ __forceinline__ unsigned pk2(float lo, float hi) { const f32x2_t v = {lo, hi}; const bf16x2_t b = __builtin_convertvector(v, bf16x2_t); return __builtin_bit_cast(unsigned, b); }
__device__ __forceinline__ bf16 f2bf(float f) { return (bf16)(pk2(f, 0.f) & 0xffffu); }
__device__ __forceinline__ v4f ld_bf4(const bf16* p) { const v2u x = *(const v2u*)p; return (v4f){bflo(x.x), bfhi(x.x), bflo(x.y), bfhi(x.y)}; }
__device__ __forceinline__ void st_bf4(bf16* p, v4f v) { v2u o; o.x = pk2(v.x, v.y); o.y = pk2(v.z, v.w); *(v2u*)p = o; }
__device__ __forceinline__ float wave_max(float v) {
#pragma unroll
    for (int o = 1; o < 64; o <<= 1) v = fmaxf(v, __shfl_xor(v, o));
    return v;
}
template <int CTRL> __device__ __forceinline__ float dpp_f(float x) { return __int_as_float(__builtin_amdgcn_update_dpp(0, __float_as_int(x), CTRL, 0xF, 0xF, true)); }
__device__ __forceinline__ float sum8(float x) { x += dpp_f<0xB1>(x); x += dpp_f<0x4E>(x); x += dpp_f<0x141>(x); return x; }
__device__ __forceinline__ float sum16(float x) { x = sum8(x); x += dpp_f<0x140>(x); return x; }
__device__ __forceinline__ float wave_sum(float v) {
    v = sum16(v);
    v += __shfl_xor(v, 16); v += __shfl_xor(v, 32);
    return v;
}
__device__ __forceinline__ float rcp_(float x) { return __builtin_amdgcn_rcpf(x); }
__device__ __forceinline__ float rsq_(float x) { return __builtin_amdgcn_rsqf(x); }
__device__ __forceinline__ float sigmoidf_(float x) { return rcp_(1.f + __expf(-x)); }
__device__ __forceinline__ float softplusf_(float x) { return x > 20.f ? x : log1pf(__expf(x)); }
__device__ __forceinline__ float gelu_tanh(float x) { const float u = 0.7978845608028654f * (x + 0.044715f * x * x * x); return 0.5f * x * (1.f + tanhf(u)); }
__device__ __forceinline__ int lds_add(LAS int* p, int v) { return __hip_atomic_fetch_add(p, v, __ATOMIC_RELAXED, __HIP_MEMORY_SCOPE_WORKGROUP); }
#define LDS_WAIT() asm volatile("s_waitcnt lgkmcnt(0)" ::: "memory")
#define VM_WAIT() asm volatile("s_waitcnt vmcnt(0)" ::: "memory")

__device__ __forceinline__ GAS unsigned char* launder(unsigned char* p) { GAS unsigned char* g = (GAS unsigned char*)p; asm volatile("" : "+s"(g)); return g; }
__device__ __forceinline__ int opaque_tid() { int t = (int)threadIdx.x; asm volatile("" : "+v"(t)); return t; }
__device__ __forceinline__ int opaque_s(int x) { return __builtin_amdgcn_readfirstlane(x); }
struct Args { const float* in[36]; float* out; unsigned char* ws; int ph_lo, ph_hi; };
struct Ctx { const float* const* in; float* out; GAS unsigned char* ws; };
__device__ __forceinline__ const float* gin(const Ctx& A, int k) { return (const float*)(const GAS float*)A.in[k]; }
namespace pg8 {
#define PG8_LAS __attribute__((address_space(3)))
typedef unsigned short bf16_t;
typedef short bf16x8 __attribute__((ext_vector_type(8)));
typedef float f32x4 __attribute__((ext_vector_type(4)));
typedef unsigned u32x4 __attribute__((ext_vector_type(4)));
constexpr int BM = 256, BK = 64, HALF = 128, HTB = HALF * BK * 2  , STAGE_BYTES = 8 * HTB, NXCD = 8, WGM = 8;

__host__ __device__ __forceinline__ int lds_byte(int r, int c) { const int st = (r >> 4) * 2 + (c >> 5), rr = r & 15, cc = c & 31, ob = rr * 64 + cc * 2; return st * 1024 + (ob ^ (((ob >> 9) & 1) << 5)); }
__host__ __device__ __forceinline__ void stage_rc(int b, int& R, int& C) { const int st = b / 1024, sb = b % 1024, swz = sb ^ (((sb >> 9) & 1) << 5); R = (st >> 1) * 16 + swz / 64; C = (st & 1) * 32 + (swz % 64) / 2; }
__host__ __device__ __forceinline__ int perm32(int rho) { const int n = rho >> 4, i = rho & 15; return 8 * (i >> 2) + 4 * n + (i & 3); }

struct Unit { int pm, pn; };
struct Gemm { const bf16_t* A; const bf16_t* Bt; int M, N, K; };

struct StaticOrder {
    int nM, nN, nwg, G, c;
    __host__ __device__ void init(int M, int N, int G_, int c_) { nM = M / BM; nN = N / BM; nwg = nM * nN; G = G_; c = c_; }
    __host__ __device__ bool next(int i, Unit& u) const {
        const long L = (long)i * G + c; if (L >= nwg) return false;
        int wgid = (int)L; { const int q = nwg / NXCD, r = nwg % NXCD, xcd = wgid % NXCD, off = wgid / NXCD; wgid = (xcd < r ? xcd * (q + 1) : r * (q + 1) + (xcd - r) * q) + off; }
        const int nig = WGM * nN, gid = wgid / nig, fm = gid * WGM, gsz = (nM - fm) < WGM ? (nM - fm) : WGM;
        u.pm = fm + ((wgid % nig) % gsz); u.pn = (wgid % nig) / gsz; return true;
    }
    __device__ __forceinline__ void a_ready(const Unit&) const {}
    __device__ __forceinline__ void done(const Unit&) const {}
};

__device__ __forceinline__ unsigned cvt_pk_bf16(float lo, float hi) { unsigned r; asm volatile("v_cvt_pk_bf16_f32 %0, %1, %2" : "=v"(r) : "v"(lo), "v"(hi)); return r; }
typedef float f32x2 __attribute__((ext_vector_type(2)));
typedef unsigned u32x2v __attribute__((ext_vector_type(2)));
typedef float pf32x2_t __attribute__((ext_vector_type(2))); typedef __bf16 pbf16x2_t __attribute__((ext_vector_type(2)));
__device__ __forceinline__ unsigned cvt_pk_bf16c(float lo, float hi) { const pf32x2_t v = {lo, hi}; const pbf16x2_t q = __builtin_convertvector(v, pbf16x2_t); return __builtin_bit_cast(unsigned, q); }
struct EpiStoreBf16 {
    static constexpr bool PERM = true, AFTER_DRAIN = false;
    bf16_t* O; int ldc;
    __device__ __forceinline__ void operator()(const f32x4 (&acc)[2][2][4][2], const Unit& u, int wr, int wc, int fr, int fq) const {
        const int row0 = u.pm * BM + wr * 64 + fr, col0 = u.pn * BM + wc * 32 + 8 * fq;
#pragma unroll
        for (int ai = 0; ai < 2; ++ai)
#pragma unroll
            for (int m = 0; m < 4; ++m) { bf16_t* rowp = O + (size_t)(row0 + ai * HALF + m * 16) * ldc + col0;
#pragma unroll
                for (int bj = 0; bj < 2; ++bj) { const f32x4 v0 = acc[ai][bj][m][0], v1 = acc[ai][bj][m][1];
                    u32x4 w; w.x = cvt_pk_bf16c(v0[0], v0[1]); w.y = cvt_pk_bf16c(v0[2], v0[3]); w.z = cvt_pk_bf16c(v1[0], v1[1]); w.w = cvt_pk_bf16c(v1[2], v1[3]);
                    *(u32x4*)(rowp + bj * HALF) = w; } }
    }
};
struct EpiResid {
    static constexpr bool PERM = false, AFTER_DRAIN = false;
    float* Hres; int ldc; float alpha;
    __device__ __forceinline__ void operator()(const f32x4 (&acc)[2][2][4][2], const Unit& u, int wr, int wc, int fr, int fq) const {
        const int row0 = u.pm * BM + wr * 64 + fr, col0 = u.pn * BM + wc * 32 + 4 * fq;
#pragma unroll
        for (int ai = 0; ai < 2; ++ai)
#pragma unroll
            for (int m = 0; m < 4; ++m) { float* rowp = Hres + (size_t)(row0 + ai * HALF + m * 16) * ldc + col0;
#pragma unroll
                for (int bj = 0; bj < 2; ++bj)
#pragma unroll
                    for (int n = 0; n < 2; ++n) { f32x4* p = (f32x4*)(rowp + bj * HALF + n * 16); const f32x4 old = *p; *p = old * alpha + acc[ai][bj][m][n]; } }
    }
};
struct EpiResidBf {
    static constexpr bool PERM = true, AFTER_DRAIN = false;
    bf16_t* Hb; int ldc; float alpha;
    __device__ __forceinline__ void operator()(const f32x4 (&acc)[2][2][4][2], const Unit& u, int wr, int wc, int fr, int fq) const {
        const int row0 = u.pm * BM + wr * 64 + fr, col0 = u.pn * BM + wc * 32 + 8 * fq;
#pragma unroll
        for (int ai = 0; ai < 2; ++ai)
#pragma unroll
            for (int m = 0; m < 4; ++m) { bf16_t* rowp = Hb + (size_t)(row0 + ai * HALF + m * 16) * ldc + col0;
#pragma unroll
                for (int bj = 0; bj < 2; ++bj) { const f32x4 v0 = acc[ai][bj][m][0], v1 = acc[ai][bj][m][1]; const u32x4 o = *(const u32x4*)(rowp + bj * HALF);
#define RB_LO(x_) __builtin_bit_cast(float, (x_) << 16)
#define RB_HI(x_) __builtin_bit_cast(float, (x_) & 0xffff0000u)
                    u32x4 w; w.x = cvt_pk_bf16c(RB_LO(o.x) * alpha + v0[0], RB_HI(o.x) * alpha + v0[1]); w.y = cvt_pk_bf16c(RB_LO(o.y) * alpha + v0[2], RB_HI(o.y) * alpha + v0[3]);
                    w.z = cvt_pk_bf16c(RB_LO(o.z) * alpha + v1[0], RB_HI(o.z) * alpha + v1[1]); w.w = cvt_pk_bf16c(RB_LO(o.w) * alpha + v1[2], RB_HI(o.w) * alpha + v1[3]);
#undef RB_LO
#undef RB_HI
                    *(u32x4*)(rowp + bj * HALF) = w; } }
    }
};
struct EpiSwiGLU {
    static constexpr bool PERM = true, AFTER_DRAIN = false;
    bf16_t* ACT; const float* b1;
    __device__ __forceinline__ void operator()(const f32x4 (&acc)[2][2][4][2], const Unit& u, int wr, int wc, int fr, int fq) const {
        const int e = u.pn >> 3, pnl = u.pn & 7;
        const int row0 = u.pm * BM + wr * 64 + fr, c8 = pnl * 128 + wc * 32 + 8 * fq;
        const float* bg = b1 + (size_t)e * 2048 + c8; const float* bl = bg + 1024;
        const f32x4 bg0 = *(const f32x4*)bg, bg1 = *(const f32x4*)(bg + 4), bl0 = *(const f32x4*)bl, bl1 = *(const f32x4*)(bl + 4);
#pragma unroll
        for (int ai = 0; ai < 2; ++ai)
#pragma unroll
            for (int m = 0; m < 4; ++m) {
                float o[8];
#pragma unroll
                for (int n = 0; n < 2; ++n) { const f32x4 g4 = acc[ai][0][m][n] + (n ? bg1 : bg0), l4 = acc[ai][1][m][n] + (n ? bl1 : bl0);
#pragma unroll
                    for (int j = 0; j < 4; ++j) { const float glu = fminf(g4[j], 7.f), lin = fminf(fmaxf(l4[j], -7.f), 7.f);
                        o[n * 4 + j] = glu * __builtin_amdgcn_rcpf(1.f + __builtin_amdgcn_exp2f(glu * (-1.702f * 1.4426950408889634f))) * (lin + 1.f); } }
                u32x4 w; w.x = cvt_pk_bf16c(o[0], o[1]); w.y = cvt_pk_bf16c(o[2], o[3]); w.z = cvt_pk_bf16c(o[4], o[5]); w.w = cvt_pk_bf16c(o[6], o[7]);
                *(u32x4*)(ACT + (size_t)(row0 + ai * HALF + m * 16) * 1024 + c8) = w; }
    }
};
struct EpiMoeOut {
    static constexpr bool PERM = true, AFTER_DRAIN = false;
    bf16_t* Y; const float* b2; const float* gate;
    __device__ __forceinline__ void operator()(const f32x4 (&acc)[2][2][4][2], const Unit& u, int wr, int wc, int fr, int fq) const {
        const int e = u.pn >> 2, pnl = u.pn & 3;
        const int row0 = u.pm * BM + wr * 64 + fr, c8 = pnl * 256 + wc * 32 + 8 * fq;
        const float* bb = b2 + (size_t)e * 1024 + c8;
        f32x4 bv[2][2];
#pragma unroll
        for (int bj = 0; bj < 2; ++bj) { bv[bj][0] = *(const f32x4*)(bb + bj * HALF); bv[bj][1] = *(const f32x4*)(bb + bj * HALF + 4); }
#pragma unroll
        for (int ai = 0; ai < 2; ++ai)
#pragma unroll
            for (int m = 0; m < 4; ++m) { const int row = row0 + ai * HALF + m * 16; const float gt = gate[row];
#pragma unroll
                for (int bj = 0; bj < 2; ++bj) { const f32x4 v0 = (acc[ai][bj][m][0] + bv[bj][0]) * gt, v1 = (acc[ai][bj][m][1] + bv[bj][1]) * gt;
                    u32x4 w; w.x = cvt_pk_bf16c(v0[0], v0[1]); w.y = cvt_pk_bf16c(v0[2], v0[3]); w.z = cvt_pk_bf16c(v1[0], v1[1]); w.w = cvt_pk_bf16c(v1[2], v1[3]);
                    *(u32x4*)(Y + (size_t)row * 1024 + c8 + bj * HALF) = w; } }
    }
};
struct MoeOrder {
    int n_units, G, c, npn; const PG8_LAS int* tile_e;
    __device__ __forceinline__ bool next(int i, Unit& u) const {
        const int Lx = i * G + c; if (Lx >= n_units) return false;
        const int tile = Lx / npn, pnl = Lx - tile * npn;
        u.pm = tile; u.pn = tile_e[tile] * npn + pnl; return true;
    }
    __device__ __forceinline__ void a_ready(const Unit&) const {}
    __device__ __forceinline__ void done(const Unit&) const {}
};

template <class Epi, class Sched, bool ALIGN_EPI = false, bool SP2 = false>
__device__ __forceinline__ void gemm_phase(PG8_LAS unsigned char* lds, const Gemm g, const Sched& S, const Epi& E) {
    const int tid = opaque_tid(), wid = __builtin_amdgcn_readfirstlane(tid >> 6), lane = tid & 63, wr = wid >> 2, wc = wid & 3, fr = lane & 15, fq = lane >> 4;
    const int K = g.K, nt = K / BK;
    unsigned voffA[2], voffB[2];
#pragma unroll
    for (int i = 0; i < 2; ++i) { int R, C; stage_rc(tid * 16 + i * 8192, R, C); const int Rb = Epi::PERM ? ((R & ~31) + perm32(R & 31)) : R;
        voffA[i] = (unsigned)(R * K + C) * 2u; voffB[i] = (unsigned)(Rb * K + C) * 2u; }
    const size_t kstep = (size_t)(BK * 2);
    const size_t hstep = (size_t)HALF * K * 2;
    const size_t tstep = 2 * hstep;
    const unsigned ldsw = (unsigned)wid * 1024u;
    const int aoff = lds_byte(wr * 64 + fr, fq * 8), boff = lds_byte(wc * 32 + fr, fq * 8);
#define PG8_SA(b, h) (((b) * 2 + (h)) * HTB)
#define PG8_SB(b, h) ((4 + (b) * 2 + (h)) * HTB)
#define PG8_STAGE(bufoff, gbase, voff) do { _Pragma("unroll") for (int _i = 0; _i < 2; ++_i) \
        __builtin_amdgcn_global_load_lds((const unsigned*)((const char*)(gbase) + (voff)[_i]), (PG8_LAS unsigned*)(lds + (bufoff) + ldsw + _i * 8192), 16, 0, 0); } while (0)
#define PG8_LDA(dst, b, h) do { _Pragma("unroll") for (int m = 0; m < 4; ++m) _Pragma("unroll") for (int k = 0; k < 2; ++k) dst[m][k] = *(const PG8_LAS bf16x8*)(lds + PG8_SA(b, h) + aoff + m * 2048 + k * 1024); } while (0)
#define PG8_LDB(dst, b, h) do { _Pragma("unroll") for (int n = 0; n < 2; ++n) _Pragma("unroll") for (int k = 0; k < 2; ++k) dst[n][k] = *(const PG8_LAS bf16x8*)(lds + PG8_SB(b, h) + boff + n * 2048 + k * 1024); } while (0)
#define PG8_MMA(ai, bj, At, Bt) do { __builtin_amdgcn_s_setprio(1); _Pragma("unroll") for (int m = 0; m < 4; ++m) _Pragma("unroll") for (int n = 0; n < 2; ++n) _Pragma("unroll") for (int k = 0; k < 2; ++k) \
        acc[ai][bj][m][n] = __builtin_amdgcn_mfma_f32_16x16x32_bf16(Bt[n][k], At[m][k], acc[ai][bj][m][n], 0, 0, 0); __builtin_amdgcn_s_setprio(0); } while (0)
#define PG8_WAIT_V(n) asm volatile("s_waitcnt vmcnt(" #n ")" ::: "memory")
#define PG8_WAIT_L(n) asm volatile("s_waitcnt lgkmcnt(" #n ")" ::: "memory")
#define PG8_BAR __builtin_amdgcn_s_barrier()
#define PG8_SCHED __builtin_amdgcn_sched_barrier(0)
    Unit cur, nxt; int ui = 0;
    if (!S.next(0, cur)) return;
    f32x4 acc[2][2][4][2];
#pragma unroll
    for (int a = 0; a < 2; ++a)
#pragma unroll
        for (int b = 0; b < 2; ++b)
#pragma unroll
            for (int m = 0; m < 4; ++m)
#pragma unroll
                for (int n = 0; n < 2; ++n) acc[a][b][m][n] = (f32x4){0.f, 0.f, 0.f, 0.f};
    bf16x8 At[4][2], B0[2][2], B1[2][2];
    const char* cA = (const char*)g.A + (size_t)cur.pm * tstep; const char* cB = (const char*)g.Bt + (size_t)cur.pn * tstep;
    S.a_ready(cur);
    if constexpr (SP2) {
        PG8_STAGE(PG8_SB(0, 0), cB, voffB); PG8_STAGE(PG8_SB(0, 1), cB + hstep, voffB); PG8_STAGE(PG8_SA(0, 0), cA, voffA); PG8_STAGE(PG8_SA(0, 1), cA + hstep, voffA);
        if (wr == 1) PG8_BAR;
        PG8_WAIT_V(2); PG8_BAR;
        PG8_STAGE(PG8_SB(1, 0), cB + kstep, voffB); PG8_STAGE(PG8_SA(1, 0), cA + kstep, voffA); PG8_STAGE(PG8_SB(1, 1), cB + hstep + kstep, voffB);
        PG8_WAIT_V(6); PG8_BAR;
    } else {
        PG8_STAGE(PG8_SB(0, 0), cB, voffB); PG8_STAGE(PG8_SA(0, 0), cA, voffA); PG8_STAGE(PG8_SB(0, 1), cB + hstep, voffB); PG8_STAGE(PG8_SA(0, 1), cA + hstep, voffA);
        if (wr == 1) PG8_BAR;
        PG8_WAIT_V(4); PG8_BAR;
        PG8_STAGE(PG8_SB(1, 0), cB + kstep, voffB); PG8_STAGE(PG8_SA(1, 0), cA + kstep, voffA); PG8_STAGE(PG8_SB(1, 1), cB + hstep + kstep, voffB);
        PG8_WAIT_V(6); PG8_BAR;
    }
    for (;;) {
        const bool has_next = S.next(ui + 1, nxt);
        const char* nA = has_next ? (const char*)g.A + (size_t)nxt.pm * tstep : cA; const char* nB = has_next ? (const char*)g.Bt + (size_t)nxt.pn * tstep : cB;
        for (int t = 0; t < nt; t += 2) {
            const bool last = (t == nt - 2);
            const char* a1 = cA + (size_t)(t + 1) * kstep;
            const char* a2 = last ? nA : cA + (size_t)(t + 2) * kstep; const char* b2 = last ? nB : cB + (size_t)(t + 2) * kstep;
            const char* a3 = a2 + kstep; const char* b3 = b2 + kstep;
            if (last && has_next) S.a_ready(nxt);
            if constexpr (SP2) {
            PG8_LDB(B0, 0, 0); PG8_LDB(B1, 0, 1); PG8_SCHED; PG8_LDA(At, 0, 0); PG8_STAGE(PG8_SA(1, 1), a1 + hstep, voffA);
            PG8_WAIT_V(8); PG8_WAIT_L(0); PG8_BAR; PG8_MMA(0, 0, At, B0); PG8_MMA(0, 1, At, B1); PG8_BAR; PG8_SCHED;
            PG8_LDA(At, 0, 1); PG8_STAGE(PG8_SB(0, 0), b2, voffB); PG8_STAGE(PG8_SB(0, 1), b2 + hstep, voffB); PG8_STAGE(PG8_SA(0, 0), a2, voffA);
            PG8_WAIT_V(8); PG8_WAIT_L(0); PG8_BAR; PG8_MMA(1, 0, At, B0); PG8_MMA(1, 1, At, B1); PG8_BAR; PG8_SCHED;
            PG8_LDB(B0, 1, 0); PG8_LDB(B1, 1, 1); PG8_SCHED; PG8_LDA(At, 1, 0); PG8_STAGE(PG8_SA(0, 1), a2 + hstep, voffA);
            PG8_WAIT_V(8); PG8_WAIT_L(0); PG8_BAR; PG8_MMA(0, 0, At, B0); PG8_MMA(0, 1, At, B1); PG8_BAR; PG8_SCHED;
            PG8_LDA(At, 1, 1); PG8_STAGE(PG8_SB(1, 0), b3, voffB); PG8_STAGE(PG8_SB(1, 1), b3 + hstep, voffB); PG8_STAGE(PG8_SA(1, 0), a3, voffA);
            PG8_WAIT_V(8); PG8_WAIT_L(0); PG8_BAR; PG8_MMA(1, 0, At, B0); PG8_MMA(1, 1, At, B1); PG8_BAR; PG8_SCHED;
            } else {
            PG8_LDB(B0, 0, 0); PG8_SCHED; PG8_LDA(At, 0, 0); PG8_STAGE(PG8_SA(1, 1), a1 + hstep, voffA);
            PG8_WAIT_L(8); PG8_BAR; PG8_WAIT_L(0); PG8_MMA(0, 0, At, B0); PG8_BAR; PG8_SCHED;
            PG8_LDB(B1, 0, 1); PG8_STAGE(PG8_SB(0, 0), b2, voffB);
            PG8_BAR; PG8_WAIT_L(0); PG8_MMA(0, 1, At, B1); PG8_BAR;
            PG8_LDA(At, 0, 1); PG8_STAGE(PG8_SA(0, 0), a2, voffA);
            PG8_BAR; PG8_WAIT_L(0); PG8_MMA(1, 0, At, B0); PG8_BAR; PG8_SCHED;
            PG8_STAGE(PG8_SB(0, 1), b2 + hstep, voffB);
            PG8_WAIT_V(6); PG8_BAR; PG8_MMA(1, 1, At, B1); PG8_BAR;
            PG8_LDB(B0, 1, 0); PG8_SCHED; PG8_LDA(At, 1, 0); PG8_STAGE(PG8_SA(0, 1), a2 + hstep, voffA);
            PG8_WAIT_L(8); PG8_BAR; PG8_WAIT_L(0); PG8_MMA(0, 0, At, B0); PG8_BAR; PG8_SCHED;
            PG8_LDB(B1, 1, 1); PG8_STAGE(PG8_SB(1, 0), b3, voffB);
            PG8_BAR; PG8_WAIT_L(0); PG8_MMA(0, 1, At, B1); PG8_BAR;
            PG8_LDA(At, 1, 1); PG8_STAGE(PG8_SA(1, 0), a3, voffA);
            PG8_BAR; PG8_WAIT_L(0); PG8_MMA(1, 0, At, B0); PG8_BAR; PG8_SCHED;
            PG8_STAGE(PG8_SB(1, 1), b3 + hstep, voffB);
            PG8_WAIT_V(6); PG8_BAR; PG8_MMA(1, 1, At, B1); PG8_BAR;
            }
        }
        if constexpr (ALIGN_EPI) { if (wr == 0) PG8_BAR; }
        if constexpr (!Epi::AFTER_DRAIN) { E(acc, cur, wr, wc, fr, fq); S.done(cur); }
        if (!has_next) break;
#pragma unroll
        for (int a = 0; a < 2; ++a)
#pragma unroll
            for (int b = 0; b < 2; ++b)
#pragma unroll
                for (int m = 0; m < 4; ++m)
#pragma unroll
                    for (int n = 0; n < 2; ++n) acc[a][b][m][n] = (f32x4){0.f, 0.f, 0.f, 0.f};
        cur = nxt; cA = nA; cB = nB; ++ui;
        if constexpr (ALIGN_EPI) { if (wr == 1) PG8_BAR; }
    }
    PG8_WAIT_V(0);
    if constexpr (!ALIGN_EPI) { if (wr == 0) PG8_BAR; }
    PG8_BAR;
    if constexpr (Epi::AFTER_DRAIN) { E.fused(acc, cur, wr, wc, fr, fq, lds, wid, lane); S.done(cur); }
#undef PG8_SA
#undef PG8_SB
#undef PG8_STAGE
#undef PG8_LDA
#undef PG8_LDB
#undef PG8_MMA
#undef PG8_WAIT_V
#undef PG8_WAIT_L
#undef PG8_BAR
#undef PG8_SCHED
}
}
namespace pg8 {
template <class Epi, class Sched>
__device__ __forceinline__ void gemm_phase_gather(PG8_LAS unsigned char* lds, const Gemm g, const Sched& S, const Epi& E, const int* rmap) {
    constexpr bool ALIGN_EPI = true, SP2 = true;
    const int tid = opaque_tid(), wid = __builtin_amdgcn_readfirstlane(tid >> 6), lane = tid & 63, wr = wid >> 2, wc = wid & 3, fr = lane & 15, fq = lane >> 4;
    const int K = g.K, nt = K / BK;
    unsigned voffB[2];
#pragma unroll
    for (int i = 0; i < 2; ++i) { int R, C; stage_rc(tid * 16 + i * 8192, R, C); const int Rb = Epi::PERM ? ((R & ~31) + perm32(R & 31)) : R;
        voffB[i] = (unsigned)(Rb * K + C) * 2u; }
    const size_t kstep = (size_t)(BK * 2);
    const size_t hstep = (size_t)HALF * K * 2;
    const size_t tstep = 2 * hstep;
    const unsigned ldsw = (unsigned)wid * 1024u;
    const int aoff = lds_byte(wr * 64 + fr, fq * 8), boff = lds_byte(wc * 32 + fr, fq * 8);
#define PG8_SA(b, h) (((b) * 2 + (h)) * HTB)
#define PG8_SB(b, h) ((4 + (b) * 2 + (h)) * HTB)
#define PG8_STAGE(bufoff, gbase, voff) do { _Pragma("unroll") for (int _i = 0; _i < 2; ++_i) \
        __builtin_amdgcn_global_load_lds((const unsigned*)((const char*)(gbase) + (voff)[_i]), (PG8_LAS unsigned*)(lds + (bufoff) + ldsw + _i * 8192), 16, 0, 0); } while (0)
#define PG8_LDA(dst, b, h) do { _Pragma("unroll") for (int m = 0; m < 4; ++m) _Pragma("unroll") for (int k = 0; k < 2; ++k) dst[m][k] = *(const PG8_LAS bf16x8*)(lds + PG8_SA(b, h) + aoff + m * 2048 + k * 1024); } while (0)
#define PG8_LDB(dst, b, h) do { _Pragma("unroll") for (int n = 0; n < 2; ++n) _Pragma("unroll") for (int k = 0; k < 2; ++k) dst[n][k] = *(const PG8_LAS bf16x8*)(lds + PG8_SB(b, h) + boff + n * 2048 + k * 1024); } while (0)
#define PG8_MMA(ai, bj, At, Bt) do { __builtin_amdgcn_s_setprio(1); _Pragma("unroll") for (int m = 0; m < 4; ++m) _Pragma("unroll") for (int n = 0; n < 2; ++n) _Pragma("unroll") for (int k = 0; k < 2; ++k) \
        acc[ai][bj][m][n] = __builtin_amdgcn_mfma_f32_16x16x32_bf16(Bt[n][k], At[m][k], acc[ai][bj][m][n], 0, 0, 0); __builtin_amdgcn_s_setprio(0); } while (0)
#define PG8_WAIT_V(n) asm volatile("s_waitcnt vmcnt(" #n ")" ::: "memory")
#define PG8_WAIT_L(n) asm volatile("s_waitcnt lgkmcnt(" #n ")" ::: "memory")
#define PG8_BAR __builtin_amdgcn_s_barrier()
#define PG8_SCHED __builtin_amdgcn_sched_barrier(0)
    Unit cur, nxt; int ui = 0;
    if (!S.next(0, cur)) return;
    f32x4 acc[2][2][4][2];
#pragma unroll
    for (int a = 0; a < 2; ++a)
#pragma unroll
        for (int b = 0; b < 2; ++b)
#pragma unroll
            for (int m = 0; m < 4; ++m)
#pragma unroll
                for (int n = 0; n < 2; ++n) acc[a][b][m][n] = (f32x4){0.f, 0.f, 0.f, 0.f};
    bf16x8 At[4][2], B0[2][2], B1[2][2];
    const char* gA = (const char*)g.A; const char* cB = (const char*)g.Bt + (size_t)cur.pn * tstep;
    unsigned gofc[2][2];
    constexpr int RM_OFF = 8 * HTB;
#pragma unroll
    for (int i_ = 0; i_ < 2; ++i_) { int R, C; stage_rc(tid * 16 + i_ * 8192, R, C);
#pragma unroll
        for (int h_ = 0; h_ < 2; ++h_) gofc[h_][i_] = (unsigned)rmap[(size_t)cur.pm * BM + h_ * HALF + R] * (unsigned)(K * 2) + (unsigned)C * 2u; }
    S.a_ready(cur);
    if constexpr (SP2) {
        PG8_STAGE(PG8_SB(0, 0), cB, voffB); PG8_STAGE(PG8_SB(0, 1), cB + hstep, voffB); PG8_STAGE(PG8_SA(0, 0), gA, gofc[0]); PG8_STAGE(PG8_SA(0, 1), gA, gofc[1]);
        if (wr == 1) PG8_BAR;
        PG8_WAIT_V(2); PG8_BAR;
        PG8_STAGE(PG8_SB(1, 0), cB + kstep, voffB); PG8_STAGE(PG8_SA(1, 0), gA + kstep, gofc[0]); PG8_STAGE(PG8_SB(1, 1), cB + hstep + kstep, voffB);
        PG8_WAIT_V(6); PG8_BAR;
    }
    for (;;) {
        const bool has_next = S.next(ui + 1, nxt);
        const char* nB = has_next ? (const char*)g.Bt + (size_t)nxt.pn * tstep : cB;
        if (has_next) { const unsigned rmoff = (unsigned)(opaque_tid() & 255) * 4u;
            __builtin_amdgcn_global_load_lds((const unsigned*)((const char*)(rmap + (size_t)nxt.pm * BM) + rmoff), (PG8_LAS unsigned*)(lds + RM_OFF + wid * 256), 4, 0, 0); }
        for (int t = 0; t < nt; t += 2) {
            const bool last = (t == nt - 2);
            const char* a1 = gA + (size_t)(t + 1) * kstep;
            const char* a2 = last ? gA : gA + (size_t)(t + 2) * kstep; const char* b2 = last ? nB : cB + (size_t)(t + 2) * kstep;
            const char* a3 = a2 + kstep; const char* b3 = b2 + kstep;
            if (last && has_next) S.a_ready(nxt);
            if constexpr (SP2) {
            PG8_LDB(B0, 0, 0); PG8_LDB(B1, 0, 1); PG8_SCHED; PG8_LDA(At, 0, 0); PG8_STAGE(PG8_SA(1, 1), a1, gofc[1]);
            PG8_WAIT_V(8); PG8_WAIT_L(0); PG8_BAR; PG8_MMA(0, 0, At, B0); PG8_MMA(0, 1, At, B1); PG8_BAR; PG8_SCHED;
            if (last && has_next) { const int tid2 = opaque_tid();
#pragma unroll
                for (int i_ = 0; i_ < 2; ++i_) { int R, C; stage_rc(tid2 * 16 + i_ * 8192, R, C);
#pragma unroll
                    for (int h_ = 0; h_ < 2; ++h_) gofc[h_][i_] = (unsigned)*(const PG8_LAS int*)(lds + RM_OFF + (h_ * HALF + R) * 4) * (unsigned)(K * 2) + (unsigned)C * 2u; }
                PG8_SCHED; }
            PG8_LDA(At, 0, 1); PG8_STAGE(PG8_SB(0, 0), b2, voffB); PG8_STAGE(PG8_SB(0, 1), b2 + hstep, voffB); PG8_STAGE(PG8_SA(0, 0), a2, gofc[0]);
            PG8_WAIT_V(8); PG8_WAIT_L(0); PG8_BAR; PG8_MMA(1, 0, At, B0); PG8_MMA(1, 1, At, B1); PG8_BAR; PG8_SCHED;
            PG8_LDB(B0, 1, 0); PG8_LDB(B1, 1, 1); PG8_SCHED; PG8_LDA(At, 1, 0); PG8_STAGE(PG8_SA(0, 1), a2, gofc[1]);
            PG8_WAIT_V(8); PG8_WAIT_L(0); PG8_BAR; PG8_MMA(0, 0, At, B0); PG8_MMA(0, 1, At, B1); PG8_BAR; PG8_SCHED;
            PG8_LDA(At, 1, 1); PG8_STAGE(PG8_SB(1, 0), b3, voffB); PG8_STAGE(PG8_SB(1, 1), b3 + hstep, voffB); PG8_STAGE(PG8_SA(1, 0), a3, gofc[0]);
            PG8_WAIT_V(8); PG8_WAIT_L(0); PG8_BAR; PG8_MMA(1, 0, At, B0); PG8_MMA(1, 1, At, B1); PG8_BAR; PG8_SCHED;
            }
        }
        if constexpr (ALIGN_EPI) { if (wr == 0) PG8_BAR; }
        if constexpr (!Epi::AFTER_DRAIN) { const int lane2 = opaque_tid() & 63; E(acc, cur, wr, wc, lane2 & 15, lane2 >> 4); S.done(cur); }
        if (!has_next) break;
#pragma unroll
        for (int a = 0; a < 2; ++a)
#pragma unroll
            for (int b = 0; b < 2; ++b)
#pragma unroll
                for (int m = 0; m < 4; ++m)
#pragma unroll
                    for (int n = 0; n < 2; ++n) acc[a][b][m][n] = (f32x4){0.f, 0.f, 0.f, 0.f};
        cur = nxt; cB = nB; ++ui;
        if constexpr (ALIGN_EPI) { if (wr == 1) PG8_BAR; }
    }
    PG8_WAIT_V(0);
    if constexpr (!ALIGN_EPI) { if (wr == 0) PG8_BAR; }
    PG8_BAR;
    if constexpr (Epi::AFTER_DRAIN) { E.fused(acc, cur, wr, wc, fr, fq, lds, wid, lane); S.done(cur); }
#undef PG8_SA
#undef PG8_SB
#undef PG8_STAGE
#undef PG8_LDA
#undef PG8_LDB
#undef PG8_MMA
#undef PG8_WAIT_V
#undef PG8_WAIT_L
#undef PG8_BAR
#undef PG8_SCHED
}
}
#define XB_TMO      128
#define XB_XCNT(j)  (256  + 64 * (j))
#define XB_XSUB(j)  (1280 + 64 * (j))
#define XB_XGEN(j)  (2304 + 64 * (j))
#define XB_TOP      3328
#define XB_TOPGEN   3392
#define XCD_BAR_WORDS 3456
#define XB_SPIN_CAP (1u << 18)
#define LAS __attribute__((address_space(3)))

__device__ __forceinline__ unsigned xb_ld(unsigned* p)              { return __hip_atomic_load(p, __ATOMIC_RELAXED, __HIP_MEMORY_SCOPE_AGENT); }
__device__ __forceinline__ unsigned xb_add(unsigned* p, unsigned v) { return __hip_atomic_fetch_add(p, v, __ATOMIC_RELAXED, __HIP_MEMORY_SCOPE_AGENT); }
__device__ __forceinline__ unsigned xb_xcc_id() { return (unsigned)__builtin_amdgcn_s_getreg((3 << 11) | 20) & 0xFu; }
#define XB_SPIN(cond, bar) do { unsigned _sp = 0; while (cond) { __builtin_amdgcn_s_sleep(1); \
    if ((++_sp & 255u) == 0u) { if (xb_ld(&(bar)[XB_TMO])) break; if (_sp > XB_SPIN_CAP) { atomicAdd(&(bar)[XB_TMO], 1u); break; } } } } while (0)

struct XcdBarrier {
    unsigned* bar; unsigned x;
    volatile LAS unsigned* st;
};

__device__ __forceinline__ XcdBarrier xcd_barrier_post(unsigned* bar, volatile LAS unsigned* st) {
    XcdBarrier b; b.bar = bar; b.x = xb_xcc_id(); b.st = st;
    if (threadIdx.x == 0) (void)xb_add(&bar[XB_XCNT(b.x)], 1u);
    return b;
}
__device__ __forceinline__ void xcd_barrier_complete(unsigned* bar, unsigned x, unsigned& nloc, unsigned& nx) {
    const unsigned G = gridDim.x * gridDim.y * gridDim.z;
    unsigned sum, cnt, mine, sp = 0u;
    for (;;) {
        sum = 0u; cnt = 0u; mine = 0u;
#pragma unroll
        for (unsigned j = 0; j < 16; ++j) { const unsigned c = xb_ld(&bar[XB_XCNT(j)]); sum += c; cnt += (c > 0u) ? 1u : 0u; mine = (j == x) ? c : mine; }
        if (sum == G) break;
        __builtin_amdgcn_s_sleep(1);
        if ((++sp & 255u) == 0u) { if (xb_ld(&bar[XB_TMO])) break; if (sp > XB_SPIN_CAP) { atomicAdd(&bar[XB_TMO], 1u); break; } }
    }
    nloc = mine > 0u ? mine : 1u; nx = cnt > 0u ? cnt : 1u;
}

__device__ __forceinline__ void xcd_barrier(const XcdBarrier& b) {
    asm volatile("s_waitcnt vmcnt(0)" ::: "memory");
    __syncthreads();
    if (threadIdx.x == 0) {
        unsigned* bar = b.bar;
        __builtin_amdgcn_s_waitcnt(0);
        unsigned nloc = b.st[0], nx = b.st[1];
        if (nloc == 0u) { xcd_barrier_complete(bar, b.x, nloc, nx); b.st[0] = nloc; b.st[1] = nx; }
        const unsigned old = xb_add(&bar[XB_XSUB(b.x)], 1u);
        const unsigned gen = old / nloc;
        if (old + 1u == (gen + 1u) * nloc) {
            __builtin_amdgcn_fence(__ATOMIC_RELEASE, "agent");
            asm volatile("s_waitcnt vmcnt(0)" ::: "memory");
            const unsigned og = xb_add(&bar[XB_TOP], 1u);
            const unsigned tg = og / nx;
            if (og + 1u == (tg + 1u) * nx) xb_add(&bar[XB_TOPGEN], 1u);
            else XB_SPIN(xb_ld(&bar[XB_TOPGEN]) == tg, bar);
            __builtin_amdgcn_fence(__ATOMIC_ACQUIRE, "agent");
            xb_add(&bar[XB_XGEN(b.x)], 1u);
            asm volatile("s_waitcnt vmcnt(0)" ::: "memory");
        } else {
            XB_SPIN(xb_ld(&bar[XB_XGEN(b.x)]) == gen, bar);
            __builtin_amdgcn_fence(__ATOMIC_ACQUIRE, "agent");
            asm volatile("s_waitcnt vmcnt(0)" ::: "memory");
        }
    }
    __syncthreads();
}
__device__ __forceinline__ void p0_transpose_item(const float* W, int ldw, int ncols_valid, int k0, int n0, bf16* WT, size_t dst_row0, int Kdst, LAS float* scr, int lane) {
    const int nn = n0 + (lane & 31); const bool ok = nn < ncols_valid;
#pragma unroll 8
    for (int i = 0; i < 32; ++i) { const int kk = 2 * i + (lane >> 5); scr[kk * 33 + (lane & 31)] = ok ? W[(size_t)(k0 + kk) * ldw + nn] : 0.f; }
    LDS_WAIT();
    const int c = lane & 7;
#pragma unroll
    for (int j = 0; j < 4; ++j) { const int n = (lane >> 3) + 8 * j; const LAS float* s = scr + (8 * c) * 33 + n;
        v4u o; o.x = pk2(s[0 * 33], s[1 * 33]); o.y = pk2(s[2 * 33], s[3 * 33]); o.z = pk2(s[4 * 33], s[5 * 33]); o.w = pk2(s[6 * 33], s[7 * 33]);
        *(v4u*)(WT + (dst_row0 + n) * (size_t)Kdst + k0 + 8 * c) = o; }
    LDS_WAIT();
}
__device__ __forceinline__ void ln_row(v4f (&v)[4], const float* g, const float* b, int lane) {
    float s = 0.f, s2 = 0.f;
#pragma unroll
    for (int j = 0; j < 4; ++j) { s += (v[j].x + v[j].y) + (v[j].z + v[j].w); s2 += (v[j].x * v[j].x + v[j].y * v[j].y) + (v[j].z * v[j].z + v[j].w * v[j].w); }
    s = wave_sum(s); s2 = wave_sum(s2);
    const float mean = s * (1.f / D);
    const float rstd = rsq_(fmaxf(s2 * (1.f / D) - mean * mean, 0.f) + LN_EPS);
#pragma unroll
    for (int j = 0; j < 4; ++j) v[j] = v[j] - mean;
#pragma unroll
    for (int j = 0; j < 4; ++j) { const v4f gg = *(const v4f*)(g + 256 * j + 4 * lane), bb = *(const v4f*)(b + 256 * j + 4 * lane); v[j] = v[j] * rstd * gg + bb; }
}
__device__ PHASE_FN void p0_prologue(const Ctx A, LAS unsigned char* lds, int vcu, int G) {
    const int tid = opaque_tid(), lane = tid & 63, wave = tid >> 6;
    LAS float* scr = (LAS float*)(lds + wave * 16384);
    const int gw = vcu * NWAVES + wave, NGW = G * NWAVES;
    bf16* Win_t = (bf16*)(A.ws + WS_WIN); bf16* Wout_t = (bf16*)(A.ws + WS_WOUT); bf16* W1_t = (bf16*)(A.ws + WS_W1); bf16* W2_t = (bf16*)(A.ws + WS_W2);
    constexpr int I_IN = 2 * 16 * (NINP / 32), I_OUT = 2 * 16 * 32, I_W1 = 64 * 16 * 64, I_W2 = 64 * 16 * 32;
    constexpr int NITEMS = I_IN + I_OUT + I_W1 + I_W2;
    for (int it = gw; it < NITEMS; it += NGW) {
        int r = it;
        if (r < I_IN) { const int l = r / (16 * 112), q = r % (16 * 112), kb = q / 112, nb = q % 112;
            p0_transpose_item(gin(A, 4) + (size_t)l * 1024 * 3560, 3560, 3560, kb * 64, nb * 32, Win_t + (size_t)l * NINP * 1024, (size_t)nb * 32, 1024, scr, lane); continue; }
        r -= I_IN;
        if (r < I_OUT) { const int l = r / 512, q = r % 512, kb = q / 32, nb = q % 32;
            p0_transpose_item(gin(A, 25) + (size_t)l * 1024 * 1024, 1024, 1024, kb * 64, nb * 32, Wout_t + (size_t)l * 1024 * 1024, (size_t)nb * 32, 1024, scr, lane); continue; }
        r -= I_OUT;
        if (r < I_W1) { const int le = r / 1024, q = r % 1024, kb = q / 64, nb = q % 64, n0 = nb * 32;
            const int np = n0 & 1023; const size_t drow = (size_t)256 * (np >> 7) + (n0 >= 1024 ? 128 : 0) + (np & 127);
            p0_transpose_item(gin(A, 30) + (size_t)le * 1024 * 2048, 2048, 2048, kb * 64, n0, W1_t + (size_t)le * 2048 * 1024, drow, 1024, scr, lane); continue; }
        r -= I_W1;
        { const int le = r / 512, q = r % 512, kb = q / 32, nb = q % 32;
            p0_transpose_item(gin(A, 32) + (size_t)le * 1024 * 1024, 1024, 1024, kb * 64, nb * 32, W2_t + (size_t)le * 1024 * 1024, (size_t)nb * 32, 1024, scr, lane); }
    }
    bf16* HB = (bf16*)(A.ws + WS_HB);
    for (int m = gw; m < T; m += NGW) {
        const int b = m / L, i = m - b * L;
        const float* src = (i < NMETA) ? gin(A, 1) + (size_t)i * D : gin(A, 0) + ((size_t)b * SEQ + (i - NMETA)) * D;
        v4f v[4];
#pragma unroll
        for (int j = 0; j < 4; ++j) v[j] = *(const v4f*)(src + 256 * j + 4 * lane);
        ln_row(v, gin(A, 2), gin(A, 3), lane);
#pragma unroll
        for (int j = 0; j < 4; ++j) st_bf4(HB + (size_t)m * D + 256 * j + 4 * lane, v[j]);
    }
}
constexpr int NTK = 2;
__device__ __forceinline__ float softplus_fast(float x) { return x > 15.f ? x : __logf(1.f + __expf(x)); }
__device__ __forceinline__ float tanh_fast(float x) { return 1.f - 2.f * rcp_(1.f + __expf(2.f * x)); }
__device__ __forceinline__ void sincos_red(float ang, float& sn, float& cs) {
    const float k = rintf(ang * 0.15915494309189535f);
    float r = fmaf(-k, 6.28318548202514648f, ang); r = fmaf(-k, -1.7484555e-7f, r);
    sn = __sinf(r); cs = __cosf(r);
}
constexpr int PREP_W = 98304, PREP_SCR = 4096;
__device__ __forceinline__ void prep_load_w(LAS unsigned char* lds, const float* src, int n, int dst_elem, int tid) {
    for (int i = tid * 4; i < n; i += NTHR * 4) { const v4f x = *(const v4f*)(src + i); v2u o; o.x = pk2(x.x, x.y); o.y = pk2(x.z, x.w); *(LAS v2u*)(lds + (size_t)(dst_elem + i) * 2) = o; }
}
__device__ PHASE_FN void prep_phase(const Ctx A, LAS unsigned char* lds, int l, int vcu, int G) {
    const int tid = opaque_tid(), lane = tid & 63, wave = tid >> 6;
    LAS float* scr = (LAS float*)(lds + PREP_W + wave * PREP_SCR);
    const int gw = vcu * NWAVES + wave, NGW = G * NWAVES;
    const bf16* PROJ = (const bf16*)(A.ws + WS_PROJ);
    const int c4 = 4 * lane, hh = lane >> 4, d4 = 4 * (lane & 15);
    const float* mu = gin(A, 5) + l * 960; const float* w0 = gin(A, 6) + l * 256; const float* w2 = gin(A, 7) + l * 64 * 256;
    const float* a0 = gin(A, 8) + l * 256; const float* a2 = gin(A, 9) + l * 64 * 256; const float* g2 = gin(A, 10) + l * 64 * 256;
    const float* k_k = gin(A, 11) + l * 256; const float* k_a = gin(A, 12) + l * 256; const float* r_k = gin(A, 13) + l * 256;
    const float* conv_w = gin(A, 16) + l * 4 * 256; const float* conv_b = gin(A, 17) + l * 256;
    const float* wa = gin(A, 18) + l * 4 * 64 * 64; const float* ba = gin(A, 19) + l * 256; const float* wx = gin(A, 20) + l * 4 * 64 * 64; const float* bx = gin(A, 21) + l * 256;
    const float* lam = gin(A, 22) + l * 256; const float* lbs = gin(A, 23);
    float* RW_W = (float*)(A.ws + WS_RW_W); bf16* RW_A = (bf16*)(A.ws + WS_RW_A); bf16* RW_B = (bf16*)(A.ws + WS_RW_B); bf16* RW_K = (bf16*)(A.ws + WS_RW_K);
    bf16* RW_WR = (bf16*)(A.ws + WS_RW_WR); bf16* RW_V = (bf16*)(A.ws + WS_RW_V); bf16* RW_G = (bf16*)(A.ws + WS_RW_G); float* RW_SC = (float*)(A.ws + WS_RW_SC);
    bf16* DS_Q = (bf16*)(A.ws + WS_DS_Q); bf16* DS_K = (bf16*)(A.ws + WS_DS_K); bf16* DS_V = (bf16*)(A.ws + WS_DS_V); bf16* DS_QI = (bf16*)(A.ws + WS_DS_QI);
    bf16* DS_KI = (bf16*)(A.ws + WS_DS_KI); float* DS_WI = (float*)(A.ws + WS_DS_WI);
    float* LR_A = (float*)(A.ws + WS_LR_A); bf16* LR_U = (bf16*)(A.ws + WS_LR_U); bf16* LR_G = (bf16*)(A.ws + WS_LR_G);
    float* HG_F = (float*)(A.ws + WS_HG_F); bf16* HG_K = (bf16*)(A.ws + WS_HG_K); bf16* HG_Q = (bf16*)(A.ws + WS_HG_Q); bf16* HG_V = (bf16*)(A.ws + WS_HG_V); bf16* HG_G = (bf16*)(A.ws + WS_HG_G);
    LAS unsigned* kmaxl = (LAS unsigned*)(lds + MISC_OFF + 640);
    LAS unsigned* kimaxl = (LAS unsigned*)(lds + MISC_OFF + 832);
    if (tid < 32) kmaxl[tid] = 0u;
    if (tid < 8) kimaxl[tid] = 0u;
    const bool q_rot = (lane & 15) < 4, q_hi = (lane & 15) >= 2;
    const bool i_rot = (lane & 7) < 2, i_hi = (lane & 7) == 1;

#define BF4R(q_) ((v4f){bflo((q_).x), bfhi((q_).x), bflo((q_).y), bfhi((q_).y)})
    {
        constexpr int RC_OFF = 98304;
        static_assert(RC_OFF + 8 * 1024 <= MISC_OFF, "pass R lds");
        for (int f = tid; f < 96 * 64; f += NTHR) { const int ln = f & 63, fr = f >> 6, ks = fr & 1, nt = (fr >> 1) & 15, mat = fr >> 5, rr = ln & 15, g8 = ln >> 4;
            const float* W = (mat == 0 ? w2 : mat == 1 ? a2 : g2) + (32 * ks + 8 * g8) * 256 + 16 * nt + rr;
            v4u o; o.x = pk2(W[0], W[256]); o.y = pk2(W[512], W[768]); o.z = pk2(W[1024], W[1280]); o.w = pk2(W[1536], W[1792]);
            *(LAS v4u*)(lds + (size_t)fr * 1024 + ln * 16) = o; }
        LAS float* rc = (LAS float*)(lds + RC_OFF);
        if (tid < 256) { rc[tid] = mu[C_RW_R + tid]; rc[256 + tid] = mu[C_RW_K + tid]; rc[512 + tid] = mu[C_RW_V + tid]; rc[768 + tid] = w0[tid];
            rc[1024 + tid] = a0[tid]; rc[1280 + tid] = k_k[tid]; rc[1536 + tid] = k_a[tid]; rc[1792 + tid] = r_k[tid]; }
        __syncthreads();
        const int r = lane & 15, g = lane >> 4;
        const v4f z4 = (v4f){0.f, 0.f, 0.f, 0.f};
        auto r_tile = [&](const int tile, const int hd_lo, const int hd_hi) {
            const int m0 = tile * 16, b = m0 / L, i = m0 - b * L + r;
            const bf16* rowc = PROJ + (size_t)(m0 + r) * NINP;
            const bool hasp = i > 0; const bf16* rowp = hasp ? rowc - NINP : rowc;
            pg8::bf16x8 Bf[3][2];
#pragma unroll
            for (int mat = 0; mat < 3; ++mat)
#pragma unroll
                for (int ks = 0; ks < 2; ++ks) { const int off = (mat == 0 ? C_RW_WD : mat == 1 ? C_RW_AD : C_RW_GD) + 32 * ks + 8 * g;
                    const v4u cq = *(const v4u*)(rowc + off), pq = *(const v4u*)(rowp + off);
                    const v4f m0v = *(const v4f*)(mu + off), m1v = *(const v4f*)(mu + off + 4);
                    float o8[8];
#pragma unroll
                    for (int e = 0; e < 8; ++e) { const unsigned cw = cq[e >> 1], pw = pq[e >> 1];
                        const float cur = (e & 1) ? bfhi(cw) : bflo(cw), prv = hasp ? ((e & 1) ? bfhi(pw) : bflo(pw)) : 0.f;
                        const float sv = cur + (prv - cur) * (e < 4 ? m0v[e & 3] : m1v[e & 3]);
                        o8[e] = mat == 0 ? tanh_fast(sv) : mat == 1 ? sv : sigmoidf_(sv); }
                    v4u pk; pk.x = pk2(o8[0], o8[1]); pk.y = pk2(o8[2], o8[3]); pk.z = pk2(o8[4], o8[5]); pk.w = pk2(o8[6], o8[7]);
                    Bf[mat][ks] = __builtin_bit_cast(pg8::bf16x8, pk); }
#pragma unroll 1
            for (int hd = hd_lo; hd < hd_hi; ++hd) {
                pg8::f32x4 Cw[4], Ca[4], Cg[4];
#pragma unroll
                for (int nt = 0; nt < 4; ++nt) {
                    const LAS unsigned char* wf = lds + (size_t)((hd * 4 + nt) * 2) * 1024 + lane * 16;
                    pg8::f32x4 cw = (pg8::f32x4){0.f, 0.f, 0.f, 0.f}, ca = cw, cg = cw;
#pragma unroll
                    for (int ks = 0; ks < 2; ++ks) {
                        cw = __builtin_amdgcn_mfma_f32_16x16x32_bf16(*(const LAS pg8::bf16x8*)(wf + ks * 1024), Bf[0][ks], cw, 0, 0, 0);
                        ca = __builtin_amdgcn_mfma_f32_16x16x32_bf16(*(const LAS pg8::bf16x8*)(wf + 32768 + ks * 1024), Bf[1][ks], ca, 0, 0, 0);
                        cg = __builtin_amdgcn_mfma_f32_16x16x32_bf16(*(const LAS pg8::bf16x8*)(wf + 65536 + ks * 1024), Bf[2][ks], cg, 0, 0, 0); }
                    Cw[nt] = cw; Ca[nt] = ca; Cg[nt] = cg;
                }
                const size_t hrow = ((size_t)(b * 4 + hd) * L + i);
                v4f kun[4], kav_[4];
                float n2 = 0.f, sbr = 0.f, skr = 0.f, sbo = 0.f;
#pragma unroll
                for (int nt = 0; nt < 4; ++nt) {
                    const int cc = hd * 64 + 16 * nt + 4 * g, d4h = 16 * nt + 4 * g;
                    const v4f cr = BF4R(*(const v2u*)(rowc + C_RW_R + cc)), ck = BF4R(*(const v2u*)(rowc + C_RW_K + cc)), cv = BF4R(*(const v2u*)(rowc + C_RW_V + cc));
                    const v4f pr = hasp ? BF4R(*(const v2u*)(rowp + C_RW_R + cc)) : z4, pk_ = hasp ? BF4R(*(const v2u*)(rowp + C_RW_K + cc)) : z4, pv = hasp ? BF4R(*(const v2u*)(rowp + C_RW_V + cc)) : z4;
                    const v4f mu_r = *(const LAS v4f*)(rc + cc), mu_k = *(const LAS v4f*)(rc + 256 + cc), mu_v = *(const LAS v4f*)(rc + 512 + cc), w0v = *(const LAS v4f*)(rc + 768 + cc);
                    const v4f a0v = *(const LAS v4f*)(rc + 1024 + cc), kkv = *(const LAS v4f*)(rc + 1280 + cc), kav = *(const LAS v4f*)(rc + 1536 + cc), rkv = *(const LAS v4f*)(rc + 1792 + cc);
                    const v4f rs = cr + (pr - cr) * mu_r, kx = ck + (pk_ - ck) * mu_k, vs = cv + (pv - cv) * mu_v;
                    v4f dec, km, wr, lg;
#pragma unroll
                    for (int e = 0; e < 4; ++e) {
                        const float wv = -softplus_fast(-(w0v[e] + Cw[nt][e])) - 0.5f;
                        dec[e] = __expf(-__expf(wv));
                        const float av = sigmoidf_(a0v[e] + Ca[nt][e]);
                        const float ku = kx[e] * kkv[e]; kun[nt][e] = ku; kav_[nt][e] = ku * av; n2 += ku * ku;
                        km[e] = kx[e] * (1.f + (av - 1.f) * kav[e]);
                        wr[e] = dec[e] * rs[e]; sbr += ku * av * rs[e]; skr += km[e] * rs[e]; sbo += rs[e] * km[e] * rkv[e];
                        lg[e] = Cg[nt][e]; }
                    *(v4f*)(RW_W + hrow * 64 + d4h) = dec; st_bf4(RW_K + hrow * 64 + d4h, km); st_bf4(RW_WR + hrow * 64 + d4h, wr); st_bf4(RW_V + hrow * 64 + d4h, vs);
                    st_bf4(RW_G + (size_t)(m0 + r) * 256 + cc, lg);
                }
                n2 += __shfl_xor(n2, 16); n2 += __shfl_xor(n2, 32);
                const float inv = rcp_(fmaxf(sqrtf(n2), 1e-12f));
#pragma unroll
                for (int nt = 0; nt < 4; ++nt) { const int d4h = 16 * nt + 4 * g;
                    st_bf4(RW_A + hrow * 64 + d4h, kun[nt] * (-inv)); st_bf4(RW_B + hrow * 64 + d4h, kav_[nt] * inv); }
                sbr *= inv;
                sbr += __shfl_xor(sbr, 16); sbr += __shfl_xor(sbr, 32); skr += __shfl_xor(skr, 16); skr += __shfl_xor(skr, 32); sbo += __shfl_xor(sbo, 16); sbo += __shfl_xor(sbo, 32);
                if (g == 0) *(v4f*)(RW_SC + hrow * 4) = (v4f){sbr, skr, sbo, 0.f};
            }
        };
        const int NT16 = T / 16, nfull = (NT16 / NGW) * NGW;
#pragma unroll 1
        for (int it = gw; it < nfull + (NT16 - nfull) * 4; it += NGW) { const int q = it - nfull; const bool part = q >= 0;
            r_tile(part ? nfull + (q >> 2) : it, part ? (q & 3) : 0, part ? (q & 3) + 1 : 4); }
    }
    __syncthreads();
    {
        constexpr int XT_PITCH = 528, XT_BYTES = 16 * XT_PITCH, XT_OFF = 65536, LCST_OFF = XT_OFF + NWAVES * XT_BYTES;
        static_assert(LCST_OFF + 3 * 1024 <= MISC_OFF, "pass L lds");
        for (int f = tid; f < 64 * 64; f += NTHR) { const int ln = f & 63, fr = f >> 6, ks = fr & 1, nt = (fr >> 1) & 3, hd = (fr >> 3) & 3, mat = fr >> 5, rr = ln & 15, g8 = ln >> 4;
            const float* W = (mat ? wx : wa) + hd * 4096 + (32 * ks + 8 * g8) * 64 + 16 * nt + rr;
            v4u o; o.x = pk2(W[0], W[64]); o.y = pk2(W[128], W[192]); o.z = pk2(W[256], W[320]); o.w = pk2(W[384], W[448]);
            *(LAS v4u*)(lds + (size_t)fr * 1024 + ln * 16) = o; }
        LAS float* cst = (LAS float*)(lds + LCST_OFF);
        if (tid < 256) { cst[tid] = ba[tid]; cst[256 + tid] = bx[tid];
            const float xs = -lam[tid], ys = __expf(xs);
            cst[512 + tid] = xs > 15.f ? xs : (ys < 0.01f ? ys * (1.f - ys * (0.5f - ys * 0.33333334f)) : __logf(1.f + ys)); }
        __syncthreads();
        LAS unsigned char* xt = lds + XT_OFF + wave * XT_BYTES;
        const int r = lane & 15, g = lane >> 4;
        const v4f cb = *(const v4f*)(conv_b + c4), cw0 = *(const v4f*)(conv_w + c4), cw1 = *(const v4f*)(conv_w + 256 + c4), cw2 = *(const v4f*)(conv_w + 512 + c4), cw3 = *(const v4f*)(conv_w + 768 + c4);
        auto l_tile = [&](const int tile, const int hd_lo, const int hd_hi) {
            const int m0 = tile * 16, b = m0 / L, i0 = m0 - b * L;
            const bf16* Pq = PROJ + (size_t)m0 * NINP;
            v2u xb[19], gr[16];
#pragma unroll
            for (int q = 0; q < 19; ++q) { const int ro = (i0 + q - 3 >= 0) ? q - 3 : 0; xb[q] = *(const v2u*)(Pq + (ptrdiff_t)ro * NINP + C_LR_X + c4); }
#pragma unroll
            for (int t = 0; t < 16; ++t) gr[t] = *(const v2u*)(Pq + (size_t)t * NINP + C_LR_G + c4);
            const v4f z4 = (v4f){0.f, 0.f, 0.f, 0.f};
            v4f x0 = i0 > 0 ? BF4R(xb[0]) : z4, x1 = i0 > 0 ? BF4R(xb[1]) : z4, x2 = i0 > 0 ? BF4R(xb[2]) : z4;
#pragma unroll
            for (int t = 0; t < 16; ++t) {
                const v4f x3 = BF4R(xb[t + 3]);
                const v4f xc = cb + cw0 * x0 + cw1 * x1 + cw2 * x2 + cw3 * x3;
                v2u o; o.x = pk2(xc.x, xc.y); o.y = pk2(xc.z, xc.w);
                *(LAS v2u*)(xt + t * XT_PITCH + c4 * 2) = o;
                x0 = x1; x1 = x2; x2 = x3;
                const v4f gv = BF4R(gr[t]); v4f gg;
#pragma unroll
                for (int e = 0; e < 4; ++e) { const float tt = 0.7978845608028654f * (gv[e] + 0.044715f * gv[e] * gv[e] * gv[e]); gg[e] = 0.5f * gv[e] * (1.f + tanh_fast(tt)); }
                if (hd_lo == 0) st_bf4(LR_G + (size_t)(m0 + t) * 256 + c4, gg);
            }
            LDS_WAIT();
#pragma unroll 1
            for (int hd = hd_lo; hd < hd_hi; ++hd) {
                const LAS unsigned char* xrow = xt + r * XT_PITCH + hd * 128;
                const pg8::bf16x8 bk0 = *(const LAS pg8::bf16x8*)(xrow + g * 16), bk1 = *(const LAS pg8::bf16x8*)(xrow + 64 + g * 16);
                pg8::f32x4 Ca[4], Cx[4];
#pragma unroll
                for (int nt = 0; nt < 4; ++nt) {
                    const LAS unsigned char* wf = lds + (size_t)((hd * 4 + nt) * 2) * 1024 + lane * 16;
                    const pg8::bf16x8 a0 = *(const LAS pg8::bf16x8*)(wf), a1 = *(const LAS pg8::bf16x8*)(wf + 1024), x0f = *(const LAS pg8::bf16x8*)(wf + 32768), x1f = *(const LAS pg8::bf16x8*)(wf + 32768 + 1024);
                    pg8::f32x4 ca = (pg8::f32x4){0.f, 0.f, 0.f, 0.f}, cx = ca;
                    ca = __builtin_amdgcn_mfma_f32_16x16x32_bf16(a0, bk0, ca, 0, 0, 0); ca = __builtin_amdgcn_mfma_f32_16x16x32_bf16(a1, bk1, ca, 0, 0, 0);
                    cx = __builtin_amdgcn_mfma_f32_16x16x32_bf16(x0f, bk0, cx, 0, 0, 0); cx = __builtin_amdgcn_mfma_f32_16x16x32_bf16(x1f, bk1, cx, 0, 0, 0);
                    Ca[nt] = ca; Cx[nt] = cx;
                }
#pragma unroll
                for (int nt = 0; nt < 4; ++nt) {
                    const int c0 = hd * 64 + 16 * nt + 4 * g;
                    const v4f bav = *(const LAS v4f*)(cst + c0), bxv = *(const LAS v4f*)(cst + 256 + c0), spl = *(const LAS v4f*)(cst + 512 + c0);
                    const v2u xq = *(const LAS v2u*)(xt + r * XT_PITCH + c0 * 2); const v4f xc = BF4R(xq);
                    v4f aa, uu;
#pragma unroll
                    for (int e = 0; e < 4; ++e) { const float rg = sigmoidf_(Ca[nt][e] + bav[e]), ig = sigmoidf_(Cx[nt][e] + bxv[e]);
                        const float la = -8.f * rg * spl[e]; aa[e] = __expf(la);
                        const float x2l = 2.f * la; const float om = (x2l > -0.1f) ? -(x2l * (1.f + x2l * (0.5f + x2l * (0.16666667f + x2l * 0.041666668f)))) : (1.f - __expf(x2l));
                        uu[e] = xc[e] * ig * __builtin_amdgcn_sqrtf(om); }
                    const size_t mo = (size_t)(m0 + r) * 256 + c0;
                    *(v4f*)(LR_A + mo) = aa; st_bf4(LR_U + mo, uu);
                }
            }
        };
        const int NT16 = T / 16, nfull = (NT16 / NGW) * NGW;
#pragma unroll 1
        for (int it = gw; it < nfull + (NT16 - nfull) * 4; it += NGW) { const int q = it - nfull; const bool part = q >= 0;
            l_tile(part ? nfull + (q >> 2) : it, part ? (q & 3) : 0, part ? (q & 3) + 1 : 4); }
    }
    {
        float invf_q[4], invf_i[4];
#pragma unroll
        for (int e = 0; e < 4; ++e) { invf_q[e] = exp2f(-(float)((d4 + e) & 7) * (18.931568569324174f / 8.f)); invf_i[e] = exp2f(-(float)e * (18.931568569324174f / 4.f)); }
        v4f lb = (v4f){0.f, 0.f, 0.f, 0.f};
        if (l == 1) { const v4f x0 = *(const v4f*)(lbs + c4), x1 = *(const v4f*)(lbs + 256 + c4);
            lb.x = 1.f / (1.f + __expf(x0.x - x1.x)); lb.y = 1.f / (1.f + __expf(x0.y - x1.y)); lb.z = 1.f / (1.f + __expf(x0.z - x1.z)); lb.w = 1.f / (1.f + __expf(x0.w - x1.w)); }
#pragma unroll 2
        for (int m = gw; m < T; m += NGW) {
            const int b = m / L, i = m - b * L; const float pos = (float)i;
            const bf16* Pj = PROJ + (size_t)m * NINP;
            v4f q = ld_bf4(Pj + C_DS_Q + c4), k = ld_bf4(Pj + C_DS_K + c4);
            const v4f v = ld_bf4(Pj + C_DS_V + c4);
            v4f qi = ld_bf4(Pj + C_DS_QI + c4), ki = ld_bf4(Pj + C_DS_KI + 4 * (lane & 7));
            const v4f hq = ld_bf4(Pj + C_HG_Q + c4), z = ld_bf4(Pj + C_HG_F + c4), vi = ld_bf4(Pj + C_HG_I + c4), hgt = ld_bf4(Pj + C_HG_G + c4);
#pragma unroll
            for (int e = 0; e < 4; ++e) {
                const float qp = __shfl_xor(q[e], 2), kp = __shfl_xor(k[e], 2), qip = __shfl_xor(qi[e], 1), kip = __shfl_xor(ki[e], 1);
                float sn, cs; sincos_red(pos * invf_q[e], sn, cs);
                if (q_rot) { q[e] = q_hi ? (qp * sn + q[e] * cs) : (q[e] * cs - qp * sn); k[e] = q_hi ? (kp * sn + k[e] * cs) : (k[e] * cs - kp * sn); }
                sincos_red(pos * invf_i[e], sn, cs);
                if (i_rot) { qi[e] = i_hi ? (qip * sn + qi[e] * cs) : (qi[e] * cs - qip * sn); ki[e] = i_hi ? (kip * sn + ki[e] * cs) : (ki[e] * cs - kip * sn); }
            }
            { float kn2 = sum16(k.x * k.x + k.y * k.y + k.z * k.z + k.w * k.w); if ((lane & 15) == 0) __hip_atomic_fetch_max(kmaxl + b * 4 + hh, __float_as_uint(kn2 * 1.02f), __ATOMIC_RELAXED, __HIP_MEMORY_SCOPE_WORKGROUP); }
            st_bf4(DS_Q + (size_t)m * 256 + c4, q * (0.125f * 1.4426950408889634f));      st_bf4(DS_K + (size_t)m * 256 + c4, k); st_bf4(DS_V + (size_t)m * 256 + c4, v); st_bf4(DS_QI + (size_t)m * 256 + c4, qi);
            { float in2 = sum8(ki.x * ki.x + ki.y * ki.y + ki.z * ki.z + ki.w * ki.w); if (lane == 0) __hip_atomic_fetch_max(kimaxl + b, __float_as_uint(in2 * 1.02f), __ATOMIC_RELAXED, __HIP_MEMORY_SCOPE_WORKGROUP); }
            if (lane < 8) { st_bf4(DS_KI + (size_t)m * 32 + 4 * lane, ki); DS_WI[(size_t)m * 8 + lane] = bf2f(Pj[C_DS_WI + lane]) * 0.0625f; }
            v4f qs, f, kq, gs;
#pragma unroll
            for (int e = 0; e < 4; ++e) { const float sg = sigmoidf_(z[e]); qs[e] = hq[e] * sigmoidf_(hq[e]); f[e] = lb[e] + (1.f - lb[e]) * sg; kq[e] = (1.f - lb[e]) * (1.f - sg); gs[e] = hgt[e] * sigmoidf_(hgt[e]); }
            const size_t hm = ((size_t)(b * 4 + hh) * L + i) * 64 + d4;
            *(v4f*)(HG_F + hm) = f; st_bf4(HG_K + hm, kq); st_bf4(HG_Q + hm, qs); st_bf4(HG_V + hm, vi); st_bf4(HG_G + (size_t)m * 256 + c4, gs);
        }
    }
    __syncthreads();
    if (tid < 32) atomicMax((unsigned*)(A.ws + WS_CTL) + 8960 + 64 * l + tid, kmaxl[tid]);
    if (tid < 8) atomicMax((unsigned*)(A.ws + WS_CTL) + 9216 + 64 * l + tid, kimaxl[tid]);
}
constexpr int SC_C = 32;
constexpr size_t WS_YRAW = WS_PROJ;
constexpr size_t WS_ORAW = WS_PROJ + (size_t)T * 1024;
__device__ PHASE_FN void rwkv_scan(const Ctx A, LAS unsigned char* lds, int unit_) {
    const int unit = opaque_s(unit_);
    const int tid = opaque_tid(), row = tid >> 4, kp = tid & 15;
    const int bh = unit >> 1, half = unit & 1, b = bh >> 2, h = bh & 3;
    const size_t base = (size_t)bh * L * 64;
    const float* W = (const float*)(A.ws + WS_RW_W) + base;
    const bf16* Av = (const bf16*)(A.ws + WS_RW_A) + base; const bf16* Bv = (const bf16*)(A.ws + WS_RW_B) + base; const bf16* Kv = (const bf16*)(A.ws + WS_RW_K) + base;
    const bf16* WRv = (const bf16*)(A.ws + WS_RW_WR) + base; const bf16* Vv = (const bf16*)(A.ws + WS_RW_V) + base + half * 32;
    const float* SC = (const float*)(A.ws + WS_RW_SC) + (size_t)bh * L * 4;
    float* YR = (float*)(A.ws + WS_YRAW) + (size_t)b * L * 256 + h * 64 + half * 32;
    constexpr int ARR = SC_C * 64;
    constexpr int BUF = (5 * ARR + SC_C * 32 + SC_C * 4) * 4;
    LAS float* ybuf = (LAS float*)(lds + 2 * BUF);
    float S0 = 0.f, S1 = 0.f, S2 = 0.f, S3 = 0.f;
    v4f rw; v2u ra, rb, rk, rwr, rv; float rsc = 0.f;
    const int e4 = tid * 4;
#define RW_LOAD(c) do { const int t0_ = (c) * SC_C; const bool ok_ = (t0_ + (e4 >> 6)) < L; const size_t o_ = (size_t)t0_ * 64 + e4; \
        rw = ok_ ? *(const v4f*)(W + o_) : (v4f){1.f, 1.f, 1.f, 1.f}; ra = ok_ ? *(const v2u*)(Av + o_) : (v2u){0u, 0u}; rb = ok_ ? *(const v2u*)(Bv + o_) : (v2u){0u, 0u}; \
        rk = ok_ ? *(const v2u*)(Kv + o_) : (v2u){0u, 0u}; rwr = ok_ ? *(const v2u*)(WRv + o_) : (v2u){0u, 0u}; \
        if (tid < SC_C * 8) rv = (t0_ + (tid >> 3)) < L ? *(const v2u*)(Vv + (size_t)(t0_ + (tid >> 3)) * 64 + (tid & 7) * 4) : (v2u){0u, 0u}; \
        if (tid < SC_C * 4) rsc = (t0_ + (tid >> 2)) < L ? SC[(size_t)t0_ * 4 + tid] : 0.f; } while (0)
#define RW_STORE(p) do { LAS float* d_ = (LAS float*)(lds + (p) * BUF); \
        *(LAS v4f*)(d_ + e4) = rw; *(LAS v4f*)(d_ + ARR + e4) = (v4f){bflo(ra.x), bfhi(ra.x), bflo(ra.y), bfhi(ra.y)}; *(LAS v4f*)(d_ + 2 * ARR + e4) = (v4f){bflo(rb.x), bfhi(rb.x), bflo(rb.y), bfhi(rb.y)}; \
        *(LAS v4f*)(d_ + 3 * ARR + e4) = (v4f){bflo(rk.x), bfhi(rk.x), bflo(rk.y), bfhi(rk.y)}; *(LAS v4f*)(d_ + 4 * ARR + e4) = (v4f){bflo(rwr.x), bfhi(rwr.x), bflo(rwr.y), bfhi(rwr.y)}; \
        if (tid < SC_C * 8) *(LAS v4f*)(d_ + 5 * ARR + tid * 4) = (v4f){bflo(rv.x), bfhi(rv.x), bflo(rv.y), bfhi(rv.y)}; if (tid < SC_C * 4) d_[5 * ARR + SC_C * 32 + tid] = rsc; } while (0)
    constexpr int NCH = (L + SC_C - 1) / SC_C;
    RW_LOAD(0); RW_STORE(0); __syncthreads();
#pragma unroll 1
    for (int c = 0; c < NCH; ++c) {
        const int p = c & 1;
        if (c + 1 < NCH) RW_LOAD(c + 1);
        const int ns = (L - c * SC_C) < SC_C ? (L - c * SC_C) : SC_C;
        const LAS float* d = (const LAS float*)(lds + p * BUF);
        const LAS float* q = d + kp * 4; const LAS float* dv = d + 5 * ARR + row; const LAS float* dsc = d + 5 * ARR + SC_C * 32;
        v4f w4 = *(const LAS v4f*)(q), a4 = *(const LAS v4f*)(q + ARR), b4 = *(const LAS v4f*)(q + 2 * ARR), k4 = *(const LAS v4f*)(q + 3 * ARR), r4 = *(const LAS v4f*)(q + 4 * ARR);
        float vv = dv[0]; v2f sc = *(const LAS v2f*)(dsc);
#pragma unroll 2
        for (int s = 0; s < ns; ++s) {
            const int sn = (s + 1 < SC_C) ? s + 1 : s;
            const v4f nw4 = *(const LAS v4f*)(q + sn * 64), na4 = *(const LAS v4f*)(q + ARR + sn * 64), nb4 = *(const LAS v4f*)(q + 2 * ARR + sn * 64);
            const v4f nk4 = *(const LAS v4f*)(q + 3 * ARR + sn * 64), nr4 = *(const LAS v4f*)(q + 4 * ARR + sn * 64);
            const float nvv = dv[sn * 32]; const v2f nsc = *(const LAS v2f*)(dsc + sn * 4);
            float sa = (S0 * a4.x + S1 * a4.y) + (S2 * a4.z + S3 * a4.w), y1 = (S0 * r4.x + S1 * r4.y) + (S2 * r4.z + S3 * r4.w);
            sa = sum16(sa); y1 = sum16(y1);
            S0 = S0 * w4.x + sa * b4.x + vv * k4.x; S1 = S1 * w4.y + sa * b4.y + vv * k4.y; S2 = S2 * w4.z + sa * b4.z + vv * k4.z; S3 = S3 * w4.w + sa * b4.w + vv * k4.w;
            const float yo = y1 + sa * sc.x + vv * sc.y;
            if (kp == 0) ybuf[s * 32 + row] = yo;
            w4 = nw4; a4 = na4; b4 = nb4; k4 = nk4; r4 = nr4; vv = nvv; sc = nsc;
        }
        __syncthreads();
        { const int s = tid >> 4, r2 = (tid & 15) * 2;
          if (s < ns) *(v2f*)(YR + (size_t)(c * SC_C + s) * 256 + r2) = *(const LAS v2f*)(ybuf + s * 32 + r2); }
        if (c + 1 < NCH) RW_STORE(1 - p);
        __syncthreads();
    }
#undef RW_LOAD
#undef RW_STORE
}
__device__ PHASE_FN void hgrn_scan(const Ctx A, LAS unsigned char* lds, int unit_) {
    const int unit = opaque_s(unit_);
    const int tid = opaque_tid(), row = tid >> 4, kp = tid & 15;
    const int bh = unit >> 1, half = unit & 1, b = bh >> 2, h = bh & 3;
    const size_t base = (size_t)bh * L * 64;
    const float* Fv = (const float*)(A.ws + WS_HG_F) + base;
    const bf16* Kv = (const bf16*)(A.ws + WS_HG_K) + base; const bf16* Qv = (const bf16*)(A.ws + WS_HG_Q) + base; const bf16* Vv = (const bf16*)(A.ws + WS_HG_V) + base + half * 32;
    float* OR = (float*)(A.ws + WS_ORAW) + (size_t)b * L * 256 + h * 64 + half * 32;
    constexpr int ARR = SC_C * 64; constexpr int BUF = (3 * ARR + SC_C * 32) * 4;
    LAS float* obuf = (LAS float*)(lds + 2 * BUF);
    float S0 = 0.f, S1 = 0.f, S2 = 0.f, S3 = 0.f;
    v4f rf; v2u rk, rq, rv;
    const int e4 = tid * 4;
#define HG_LOAD(c) do { const int t0_ = (c) * SC_C; const bool ok_ = (t0_ + (e4 >> 6)) < L; const size_t o_ = (size_t)t0_ * 64 + e4; \
        rf = ok_ ? *(const v4f*)(Fv + o_) : (v4f){1.f, 1.f, 1.f, 1.f}; rk = ok_ ? *(const v2u*)(Kv + o_) : (v2u){0u, 0u}; rq = ok_ ? *(const v2u*)(Qv + o_) : (v2u){0u, 0u}; \
        if (tid < SC_C * 8) rv = (t0_ + (tid >> 3)) < L ? *(const v2u*)(Vv + (size_t)(t0_ + (tid >> 3)) * 64 + (tid & 7) * 4) : (v2u){0u, 0u}; } while (0)
#define HG_STORE(p) do { LAS float* d_ = (LAS float*)(lds + (p) * BUF); \
        *(LAS v4f*)(d_ + e4) = rf; *(LAS v4f*)(d_ + ARR + e4) = (v4f){bflo(rk.x), bfhi(rk.x), bflo(rk.y), bfhi(rk.y)}; \
        *(LAS v4f*)(d_ + 2 * ARR + e4) = (v4f){bflo(rq.x), bfhi(rq.x), bflo(rq.y), bfhi(rq.y)}; \
        if (tid < SC_C * 8) *(LAS v4f*)(d_ + 3 * ARR + tid * 4) = (v4f){bflo(rv.x), bfhi(rv.x), bflo(rv.y), bfhi(rv.y)}; } while (0)
    constexpr int NCH = (L + SC_C - 1) / SC_C;
    HG_LOAD(0); HG_STORE(0); __syncthreads();
#pragma unroll 1
    for (int c = 0; c < NCH; ++c) {
        const int p = c & 1;
        if (c + 1 < NCH) HG_LOAD(c + 1);
        const int ns = (L - c * SC_C) < SC_C ? (L - c * SC_C) : SC_C;
        const LAS float* d = (const LAS float*)(lds + p * BUF);
        const LAS float* q = d + kp * 4; const LAS float* dv = d + 3 * ARR + row;
        v4f f4 = *(const LAS v4f*)(q), k4 = *(const LAS v4f*)(q + ARR), q4 = *(const LAS v4f*)(q + 2 * ARR); float vv = dv[0];
#pragma unroll 2
        for (int s = 0; s < ns; ++s) {
            const int sn = (s + 1 < SC_C) ? s + 1 : s;
            const v4f nf4 = *(const LAS v4f*)(q + sn * 64), nk4 = *(const LAS v4f*)(q + ARR + sn * 64), nq4 = *(const LAS v4f*)(q + 2 * ARR + sn * 64);
            const float nvv = dv[sn * 32];
            S0 = S0 * f4.x + k4.x * vv; S1 = S1 * f4.y + k4.y * vv; S2 = S2 * f4.z + k4.z * vv; S3 = S3 * f4.w + k4.w * vv;
            float o = (q4.x * S0 + q4.y * S1) + (q4.z * S2 + q4.w * S3);
            o = sum16(o);
            if (kp == 0) obuf[s * 32 + row] = o;
            f4 = nf4; k4 = nk4; q4 = nq4; vv = nvv;
        }
        __syncthreads();
        { const int s = tid >> 4, r2 = (tid & 15) * 2;
          if (s < ns) *(v2f*)(OR + (size_t)(c * SC_C + s) * 256 + r2) = *(const LAS v2f*)(obuf + s * 32 + r2); }
        if (c + 1 < NCH) HG_STORE(1 - p);
        __syncthreads();
    }
#undef HG_LOAD
#undef HG_STORE
}
__device__ PHASE_FN void mixers_finish(const Ctx A, int l, int vcu, int G) {
    const int tid = opaque_tid(), lane = tid & 63, wave = tid >> 6;
    const int gw = vcu * NWAVES + wave, NGW = G * NWAVES;
    const int c4 = 4 * lane, hh = lane >> 4, d4 = 4 * (lane & 15);
    const float* YR = (const float*)(A.ws + WS_YRAW); const float* OR = (const float*)(A.ws + WS_ORAW);
    const bf16* RV = (const bf16*)(A.ws + WS_RW_V); const float* SC = (const float*)(A.ws + WS_RW_SC); const bf16* RG = (const bf16*)(A.ws + WS_RW_G); const bf16* HGt = (const bf16*)(A.ws + WS_HG_G);
    bf16* MIX = (bf16*)(A.ws + WS_MIX);
    const v4f lg = *(const v4f*)(gin(A, 14) + l * 256 + c4), lb = *(const v4f*)(gin(A, 15) + l * 256 + c4), ng = *(const v4f*)(gin(A, 24) + l * 256 + c4);
#pragma unroll 2
    for (int m = gw; m < T; m += NGW) {
        const int b = m / L, i = m - b * L; const size_t hm = ((size_t)(b * 4 + hh) * L + i);
        const v4f y = *(const v4f*)(YR + (size_t)m * 256 + c4), o = *(const v4f*)(OR + (size_t)m * 256 + c4);
        const v4f vv = ld_bf4(RV + hm * 64 + d4), g = ld_bf4(RG + (size_t)m * 256 + c4), hg = ld_bf4(HGt + (size_t)m * 256 + c4);
        const float bonus = SC[hm * 4 + 2];
        const float mean = sum16((y.x + y.y) + (y.z + y.w)) * (1.f / 64.f); const v4f dy = y - mean;
        const float var = sum16((dy.x * dy.x + dy.y * dy.y) + (dy.z * dy.z + dy.w * dy.w)) * (1.f / 64.f);
        const v4f yn = (dy * rsqrtf(var + 64e-5f) * lg + lb + vv * bonus) * g;
        st_bf4(MIX + (size_t)m * 1024 + c4, yn);
        const float ms = sum16((o.x * o.x + o.y * o.y) + (o.z * o.z + o.w * o.w)) * (1.f / 64.f);
        st_bf4(MIX + (size_t)m * 1024 + 768 + c4, o * rsqrtf(ms + 1e-5f) * ng * hg);
    }
}
constexpr int LR_SEG = 64, LR_NSEG = (L + LR_SEG - 1) / LR_SEG;
constexpr size_t WS_LR_AGG = 2032 * MiB;
constexpr size_t WS_LR_CARRY = WS_LR_AGG + 3 * MiB;
static_assert(WS_LR_CARRY + (size_t)NB * LR_NSEG * 256 * 4 <= WS_END, "lru aggregates");
__device__ PHASE_FN void lru_agg_phase(const Ctx A, int vcu, int G) {
    const int tid = opaque_tid(), lane = tid & 63, wave = tid >> 6;
    const int gw = vcu * NWAVES + wave, NGW = G * NWAVES;
    const float* LA = (const float*)(A.ws + WS_LR_A); const bf16* LU = (const bf16*)(A.ws + WS_LR_U); v2f* AGG = (v2f*)(A.ws + WS_LR_AGG);
#pragma unroll 1
    for (int it = gw; it < NB * LR_NSEG * 4; it += NGW) {
        const int cg = it & 3, q = it >> 2; const bool tail_ = q >= NB * (LR_NSEG - 1);
        const int b = tail_ ? q - NB * (LR_NSEG - 1) : q / (LR_NSEG - 1), sg = tail_ ? LR_NSEG - 1 : q - b * (LR_NSEG - 1), ch = cg * 64 + lane;
        const int t0 = sg * LR_SEG, ns = (L - t0) < LR_SEG ? (L - t0) : LR_SEG;
        const size_t m0 = (size_t)b * L + t0;
        float Ap = 1.f, Hl = 0.f;
#pragma unroll 1
        for (int i = 0; i < ns; i += 16) {
            float a[16], u[16];
#pragma unroll
            for (int j = 0; j < 16; ++j) { a[j] = LA[(m0 + i + j) * 256 + ch]; u[j] = bf2f(LU[(m0 + i + j) * 256 + ch]); }
#pragma unroll
            for (int j = 0; j < 16; ++j) { Hl = a[j] * Hl + u[j]; Ap *= a[j]; }
        }
        AGG[((size_t)b * LR_NSEG + sg) * 256 + ch] = (v2f){Ap, Hl};
    }
}
__device__ PHASE_FN void lru_carry_phase(const Ctx A, int first) {
    const int tid = opaque_tid(), lane = tid & 63, wave = tid >> 6;
    const int w = (opaque_s((int)blockIdx.x) - first) * NWAVES + wave;
    const int b = w >> 2, ch = (w & 3) * 64 + lane;
    const v2f* ag = (const v2f*)(A.ws + WS_LR_AGG) + (size_t)b * LR_NSEG * 256 + ch;
    float* CR = (float*)(A.ws + WS_LR_CARRY) + (size_t)b * LR_NSEG * 256 + ch;
    float hc = 0.f;
#pragma unroll 1
    for (int s0 = 0; s0 < LR_NSEG; s0 += 16) {
        v2f x[16];
#pragma unroll
        for (int j = 0; j < 16; ++j) { const int s = s0 + j < LR_NSEG ? s0 + j : LR_NSEG - 1; x[j] = ag[(size_t)s * 256]; }
#pragma unroll
        for (int j = 0; j < 16; ++j) if (s0 + j < LR_NSEG) { CR[(size_t)(s0 + j) * 256] = hc; hc = x[j].x * hc + x[j].y; }
    }
}
__device__ PHASE_FN void lru_out_phase(const Ctx A, int vcu, int G) {
    const int tid = opaque_tid(), lane = tid & 63, wave = tid >> 6;
    const int gw = vcu * NWAVES + wave, NGW = G * NWAVES;
    const float* LA = (const float*)(A.ws + WS_LR_A); const bf16* LU = (const bf16*)(A.ws + WS_LR_U); const bf16* LG = (const bf16*)(A.ws + WS_LR_G);
    const float* CR = (const float*)(A.ws + WS_LR_CARRY); bf16* MIX = (bf16*)(A.ws + WS_MIX);
#pragma unroll 1
    for (int it = gw; it < NB * LR_NSEG * 4; it += NGW) {
        const int cg = it & 3, q = it >> 2; const bool tail_ = q >= NB * (LR_NSEG - 1);
        const int b = tail_ ? q - NB * (LR_NSEG - 1) : q / (LR_NSEG - 1), sg = tail_ ? LR_NSEG - 1 : q - b * (LR_NSEG - 1), ch = cg * 64 + lane;
        const int t0 = sg * LR_SEG, ns = (L - t0) < LR_SEG ? (L - t0) : LR_SEG;
        const size_t m0 = (size_t)b * L + t0;
        float hc = CR[((size_t)b * LR_NSEG + sg) * 256 + ch];
#pragma unroll 1
        for (int i = 0; i < ns; i += 16) {
            float a[16], u[16], g[16];
#pragma unroll
            for (int j = 0; j < 16; ++j) { a[j] = LA[(m0 + i + j) * 256 + ch]; u[j] = bf2f(LU[(m0 + i + j) * 256 + ch]); g[j] = bf2f(LG[(m0 + i + j) * 256 + ch]); }
#pragma unroll
            for (int j = 0; j < 16; ++j) { hc = a[j] * hc + u[j]; MIX[(m0 + i + j) * 1024 + 512 + ch] = f2bf(hc * g[j]); }
        }
    }
}
static_assert(L % 16 == 0, "lru step groups");
constexpr int DSA_WBYTES = 34944;
constexpr int DSA_NW = 4;
__device__ __forceinline__ unsigned fkey(float f) { const unsigned u = __float_as_uint(f); return (u & 0x80000000u) ? ~u : (u | 0x80000000u); }
__device__ __forceinline__ void dsa_query(const Ctx A, LAS unsigned char* wl, int b, int i, int lane) {
    const bf16* DQ = (const bf16*)(A.ws + WS_DS_Q); const bf16* DK = (const bf16*)(A.ws + WS_DS_K); const bf16* DV = (const bf16*)(A.ws + WS_DS_V);
    const bf16* DQI = (const bf16*)(A.ws + WS_DS_QI); const bf16* DKI = (const bf16*)(A.ws + WS_DS_KI); const float* DWI = (const float*)(A.ws + WS_DS_WI);
    bf16* MIX = (bf16*)(A.ws + WS_HB);
    LAS unsigned* keys = (LAS unsigned*)wl; LAS float* qv = (LAS float*)(wl + 32896); LAS int* sel = (LAS int*)(wl + 32896 + 1024);
    const size_t m = (size_t)b * L + i, mb = (size_t)b * L;
    const int n = i + 1;
    LAS float* wil = (LAS float*)(wl + 32832);
    { const v4f q4 = ld_bf4(DQI + m * 256 + 4 * lane); *(LAS v4f*)(qv + 4 * lane) = q4; if (lane < 8) wil[lane] = DWI[m * 8 + lane]; }
    LDS_WAIT();
    for (int s = lane; s < n; s += 64) {
        const v4u* kp = (const v4u*)(DKI + (mb + s) * 32);
        float kf[32];
#pragma unroll
        for (int c = 0; c < 4; ++c) { const v4u x = kp[c]; kf[8 * c + 0] = bflo(x.x); kf[8 * c + 1] = bfhi(x.x); kf[8 * c + 2] = bflo(x.y); kf[8 * c + 3] = bfhi(x.y); kf[8 * c + 4] = bflo(x.z); kf[8 * c + 5] = bfhi(x.z); kf[8 * c + 6] = bflo(x.w); kf[8 * c + 7] = bfhi(x.w); }
        float sc = 0.f;
#pragma unroll 1
        for (int hx = 0; hx < 8; ++hx) { float dt = 0.f;
#pragma unroll
            for (int c = 0; c < 8; ++c) { const v4f q4 = *(const LAS v4f*)(qv + hx * 32 + 4 * c); dt += q4.x * kf[4 * c] + q4.y * kf[4 * c + 1] + q4.z * kf[4 * c + 2] + q4.w * kf[4 * c + 3]; }
            sc += wil[hx] * fmaxf(dt, 0.f); }
        keys[s] = fkey(sc);
    }
    LDS_WAIT();
    unsigned thr = 0u; int need = 0;
    if (n > 256) {
        unsigned prefix = 0u; need = 256;
#pragma unroll 1
        for (int shift = 28; shift >= 0; shift -= 4) {
            unsigned long long lo = 0ull, hi = 0ull;
            const unsigned himask = (shift == 28) ? 0u : (0xFFFFFFFFu << (shift + 4));
            for (int s = lane; s < n; s += 64) { const unsigned k = keys[s];
                if ((k & himask) == prefix) { const unsigned dg = (k >> shift) & 15u; const unsigned long long inc = 1ull << ((dg & 7u) * 8u); if (dg < 8u) lo += inc; else hi += inc; } }
            int cum = 0; unsigned dsel = 0u; int below = 0; bool found = false;
#pragma unroll
            for (int dg = 15; dg >= 0; --dg) {
                const unsigned mine = (unsigned)(((dg < 8 ? lo : hi) >> ((dg & 7) * 8)) & 0xFFull);
                int tot = (int)mine;
#pragma unroll
                for (int o = 1; o < 64; o <<= 1) tot += __shfl_xor(tot, o);
                if (!found && cum + tot >= need) { found = true; dsel = (unsigned)dg; below = cum; }
                cum += tot;
            }
            prefix |= dsel << shift; need -= below;
        }
        thr = prefix;
    }
    int cnt = 0;
    if (n <= 256) { for (int s = lane; s < n; s += 64) sel[s] = s; cnt = n; }
    else {
        int eq_taken = 0;
        for (int s0 = 0; s0 < n; s0 += 64) { const int s = s0 + lane; const unsigned k = (s < n) ? keys[s] : 0u; const bool in = s < n;
            const bool gt = in && (k > thr), eq = in && (k == thr);
            const unsigned long long meq = __ballot(eq); const int eq_before = __popcll(meq & ((1ull << lane) - 1ull));
            const bool take = gt || (eq && (eq_taken + eq_before) < need);
            const unsigned long long mt = __ballot(take); const int pos = cnt + __popcll(mt & ((1ull << lane) - 1ull));
            if (take && pos < 256) sel[pos] = s;
            cnt += __popcll(mt); eq_taken += __popcll(meq);
        }
        if (cnt > 256) cnt = 256;
    }
    LDS_WAIT();
    LAS float* pbuf = (LAS float*)wl;
    for (int h = 0; h < 4; ++h) {
        { const float qx = bf2f(DQ[m * 256 + h * 64 + lane]); qv[lane] = qx * 0.125f; }
        LDS_WAIT();
        float sj[4]; float mx = -3.0e38f;
#pragma unroll
        for (int r = 0; r < 4; ++r) { const int j = lane + 64 * r; sj[r] = -3.0e38f;
            if (j < cnt) { const int s = sel[j]; const v4u* kp = (const v4u*)(DK + (mb + s) * 256 + h * 64); float dt = 0.f;
#pragma unroll
                for (int c = 0; c < 8; ++c) { const v4u x = kp[c]; const v4f q0 = *(const LAS v4f*)(qv + 8 * c), q1 = *(const LAS v4f*)(qv + 8 * c + 4);
                    dt += q0.x * bflo(x.x) + q0.y * bfhi(x.x) + q0.z * bflo(x.y) + q0.w * bfhi(x.y) + q1.x * bflo(x.z) + q1.y * bfhi(x.z) + q1.z * bflo(x.w) + q1.w * bfhi(x.w); }
                sj[r] = dt; mx = fmaxf(mx, dt); } }
        mx = wave_max(mx);
        float sum = 0.f;
#pragma unroll
        for (int r = 0; r < 4; ++r) { const int j = lane + 64 * r; const float p = (j < cnt) ? __expf(sj[r] - mx) : 0.f; sum += p; pbuf[j] = p; }
        sum = wave_sum(sum);
        LDS_WAIT();
        float o = 0.f;
        for (int j = 0; j < cnt; ++j) { const int s = sel[j]; o += pbuf[j] * bf2f(DV[(mb + s) * 256 + h * 64 + lane]); }
        MIX[m * 1024 + 256 + h * 64 + lane] = f2bf(o / sum);
        LDS_WAIT();
    }
}
__device__ PHASE_FN void dsa_phase(const Ctx A, LAS unsigned char* lds, int l) {
    const int tid = opaque_tid(), lane = tid & 63, wave = tid >> 6;
    if (wave >= DSA_NW) return;
    unsigned* qhead = (unsigned*)(A.ws + WS_CTL) + CW_DSAQ + 64 * l;
    LAS unsigned char* wl = lds + wave * DSA_WBYTES;
    for (;;) {
        unsigned it = 0u;
        if (lane == 0) it = atomicAdd(qhead, 1u);
        it = __builtin_amdgcn_readfirstlane(it);
        if (it >= (unsigned)T) break;
        const int i = L - 1 - (int)(it >> 3), b = (int)(it & 7u);
        dsa_query(A, wl, b, i, lane);
    }
}
static_assert(DSA_NW * DSA_WBYTES <= MISC_OFF, "dsa lds");
typedef short s8 __attribute__((ext_vector_type(8)));
typedef short v4i16_t __attribute__((ext_vector_type(4)));
typedef unsigned u16v __attribute__((ext_vector_type(16)));
typedef unsigned long long u64;
constexpr int NQT16 = L / 16;
constexpr int NKB32 = (L + 31) / 32;
constexpr int MASK_PB = 66112;
constexpr size_t MASK_LAYER = (size_t)NB * MASK_PB * 64;
constexpr size_t WS_MASK = 1956 * MiB;
static_assert(WS_MASK >= WS_MIX_END && WS_MASK + 2 * MASK_LAYER + 256 <= 2032 * MiB, "mask region");
__device__ __forceinline__ size_t mask_row(int l, int b, int qt) { const int a = qt >> 1; return (size_t)l * (NB * MASK_PB) + (size_t)b * MASK_PB + ((qt & 1) ? (a + 1) * (a + 1) : a * (a + 1)); }
constexpr int CW_KMAX = 8960;
constexpr int CW_KIMAX = 9216;
constexpr int MI_KMAX = 640, MI_UNIT = 768, MI_KIMAX = 832;
constexpr int SEL_PF = 3;
constexpr int SEL_HROW = 259;

__device__ __forceinline__ void sel_scores(const s8 a1, const s8 a2, const s8 (&qb)[9], const float (&wv)[8], pg8::f32x4& i1, pg8::f32x4& i2) {
    const pg8::f32x4 z = (pg8::f32x4){0.f, 0.f, 0.f, 0.f};
    i1 = __builtin_amdgcn_mfma_f32_16x16x32_bf16(a1, qb[8], z, 0, 0, 0); i2 = __builtin_amdgcn_mfma_f32_16x16x32_bf16(a2, qb[8], z, 0, 0, 0);
#pragma unroll
    for (int h = 0; h < 8; ++h) {
        const pg8::f32x4 c1 = __builtin_amdgcn_mfma_f32_16x16x32_bf16(a1, qb[h], z, 0, 0, 0), c2 = __builtin_amdgcn_mfma_f32_16x16x32_bf16(a2, qb[h], z, 0, 0, 0);
#pragma unroll
        for (int j = 0; j < 4; ++j) { float t1 = fmaf(fabsf(c1[j]), wv[h], i1[j]), t2 = fmaf(fabsf(c2[j]), wv[h], i2[j]);
            asm("" : "+v"(t1)); asm("" : "+v"(t2)); i1[j] = t1; i2[j] = t2; }
    }
}
template <int MODE, bool DIAG>
__device__ __forceinline__ void sel_block(const s8 a1, const s8 a2, const s8 (&qb)[9], const float (&wv)[8], int kb, int tq, int r, int g, int lane,
                                          LAS unsigned* hrow, float sc_mul, float sc_add, u64* mrow) {
    pg8::f32x4 i1, i2; sel_scores(a1, a2, qb, wv, i1, i2);
    const int s0 = kb * 32 + 8 * g;
    u64 wds[8];
#pragma unroll
    for (int j = 0; j < 8; ++j) {
        const float sc = j < 4 ? i1[j & 3] : i2[j & 3];
        if (MODE == 3) { if (sc == 123456.789f) hrow[256] = 1u; }
        else if (MODE == 2) { wds[j] = DIAG ? __ballot((s0 + j) <= tq && sc >= sc_add) : __ballot(sc >= sc_add); }
        else { int xi = (int)__builtin_floorf(fmaf(sc, sc_mul, sc_add));
            unsigned bin = MODE == 0 ? (unsigned)min(max(xi, 0), 255) : (unsigned)(min(max(xi, -1), 256) + 1);
            if (DIAG) bin = ((s0 + j) <= tq) ? bin : (MODE == 0 ? 256u : 0u);
            if (MODE == 0 || bin != 0u) __hip_atomic_fetch_add(hrow + bin, 1u, __ATOMIC_RELAXED, __HIP_MEMORY_SCOPE_WORKGROUP); }
    }
    if (MODE == 2 && lane == 0) { u64* d = mrow + (size_t)kb * 8;
#pragma unroll
        for (int j = 0; j < 8; j += 2) { v4u o; o.x = (unsigned)wds[j]; o.y = (unsigned)(wds[j] >> 32); o.z = (unsigned)wds[j + 1]; o.w = (unsigned)(wds[j + 1] >> 32); *(v4u*)(d + j) = o; } }
}
template <int MODE>
__device__ __forceinline__ void sel_pass(const bf16* KIb, const s8 (&qb)[9], const float (&wv)[8], int nkb, int tq, int r, int g, int lane,
                                         LAS unsigned* hrow, float sc_mul, float sc_add, u64* mrow, int kb_first = 0, int kb_step = 1) {
    const bf16* kp = KIb + (size_t)(8 * (r >> 2) + (r & 3)) * 32 + 8 * g;
    v4u cur[2 * SEL_PF], nxt[2 * SEL_PF];
#pragma unroll
    for (int i = 0; i < SEL_PF; ++i) { const size_t kb = kb_first + i * kb_step; cur[2 * i] = *(const v4u*)(kp + kb * 1024); cur[2 * i + 1] = *(const v4u*)(kp + kb * 1024 + 128); }
#pragma unroll 1
    for (int kb0 = kb_first; kb0 < nkb; kb0 += SEL_PF * kb_step) {
#pragma unroll
        for (int i = 0; i < SEL_PF; ++i) { const size_t kb = kb0 + (SEL_PF + i) * kb_step; nxt[2 * i] = *(const v4u*)(kp + kb * 1024); nxt[2 * i + 1] = *(const v4u*)(kp + kb * 1024 + 128); }
#pragma unroll
        for (int i = 0; i < SEL_PF; ++i) { const int kb = kb0 + i * kb_step;
            if (kb < nkb - 1) sel_block<MODE, false>(__builtin_bit_cast(s8, cur[2 * i]), __builtin_bit_cast(s8, cur[2 * i + 1]), qb, wv, kb, tq, r, g, lane, hrow, sc_mul, sc_add, mrow);
            else if (kb == nkb - 1) sel_block<MODE, true>(__builtin_bit_cast(s8, cur[2 * i]), __builtin_bit_cast(s8, cur[2 * i + 1]), qb, wv, kb, tq, r, g, lane, hrow, sc_mul, sc_add, mrow); }
#pragma unroll
        for (int i = 0; i < 2 * SEL_PF; ++i) cur[i] = nxt[i];
    }
}
__device__ __forceinline__ void sel_scan(const LAS unsigned* hrow, int need, int& sel, int& above) {
    int cum = 0; sel = 0; above = 0; bool found = false;
#pragma unroll 8
    for (int bin = 255; bin >= 0; --bin) { const int c = (int)hrow[bin];
        if (!found && cum + c >= need) { found = true; sel = bin; above = cum; }
        cum += c; }
}
__device__ PHASE_FN void dsa_select_phase(const Ctx A, LAS unsigned char* lds, int l) {
    const int tid = opaque_tid(), lane = tid & 63, wave = tid >> 6, r = lane & 15, g = lane >> 4;
    const bf16* DQI = (const bf16*)(A.ws + WS_DS_QI); const bf16* DKI = (const bf16*)(A.ws + WS_DS_KI); const float* DWI = (const float*)(A.ws + WS_DS_WI);
    u64* MASK = (u64*)(A.ws + WS_MASK);
    unsigned* qhead = (unsigned*)(A.ws + WS_CTL) + CW_DSAQ + 64 * l;
    const unsigned* kimaxw = (const unsigned*)(A.ws + WS_CTL) + CW_KIMAX + 64 * l;
    LAS unsigned* hist = (LAS unsigned*)(lds + wave * (16 * SEL_HROW * 4));
    LAS unsigned* hrow = hist + r * SEL_HROW;
    for (;;) {
        unsigned it = 0u;
        if (lane == 0) it = atomicAdd(qhead, 1u);
        it = __builtin_amdgcn_readfirstlane(it);
        if (it >= (unsigned)(NB * NQT16)) break;
        const int qt = NQT16 - 1 - (int)(it >> 3), b = (int)(it & 7u);
        const size_t mb = (size_t)b * L, m0 = mb + (size_t)qt * 16;
        const int tq = qt * 16 + r, nkb = ((qt * 16 + 15) >> 5) + 1;
        s8 qb[9]; float wv[8];
#pragma unroll
        for (int h = 0; h < 8; ++h) qb[h] = *(const s8*)(DQI + (m0 + r) * 256 + h * 32 + 8 * g);
        { const v4f w0 = *(const v4f*)(DWI + (m0 + r) * 8), w1 = *(const v4f*)(DWI + (m0 + r) * 8 + 4);
          wv[0] = w0.x; wv[1] = w0.y; wv[2] = w0.z; wv[3] = w0.w; wv[4] = w1.x; wv[5] = w1.y; wv[6] = w1.z; wv[7] = w1.w; }
        float bq = 0.f;
        { float ql[8];
#pragma unroll
          for (int e = 0; e < 8; ++e) ql[e] = 0.f;
#pragma unroll
          for (int h = 0; h < 8; ++h) { float n2 = 0.f;
#pragma unroll
              for (int e = 0; e < 8; ++e) { const float x = bf2f((unsigned short)qb[h][e]); ql[e] += wv[h] * x; n2 += x * x; }
              n2 += __shfl_xor(n2, 16); n2 += __shfl_xor(n2, 32); bq += fabsf(wv[h]) * sqrtf(n2); }
          v4u pk; pk.x = pk2(ql[0], ql[1]); pk.y = pk2(ql[2], ql[3]); pk.z = pk2(ql[4], ql[5]); pk.w = pk2(ql[6], ql[7]); qb[8] = __builtin_bit_cast(s8, pk); }
        const bf16* KIb = DKI + mb * 32;
        float thr_f = -__builtin_inff();
        if (qt * 16 + 15 >= 256) {
            const float kim = sqrtf(__uint_as_float(__hip_atomic_load(kimaxw + b, __ATOMIC_RELAXED, __HIP_MEMORY_SCOPE_AGENT)));
            const float R = fmaxf(2.06f * bq * kim, 1e-30f), s0 = 128.f / R, w0 = R * (1.f / 128.f);
            const int n = tq + 1;
            bool done = false;
            if (qt * 16 >= 2048) {
                for (int i = lane; i < 16 * SEL_HROW; i += 64) hist[i] = 0u;
                LDS_WAIT();
                sel_pass<0>(KIb, qb, wv, nkb - 1, tq, r, g, lane, hrow, s0, 128.f, nullptr, 3, 8);
                LDS_WAIT();
                const int ns = 32 * ((nkb - 1 - 3 + 7) >> 3);
                const float rho = 256.f * (float)ns / (float)n, dev = 4.f * sqrtf(rho) + 2.f;
                int bl, ab; sel_scan(hrow, (int)(rho + dev) + 1, bl, ab);
                int bh = 255, ab2 = 0; const int rhi = (int)(rho - dev);
                if (rhi >= 1) sel_scan(hrow, rhi, bh, ab2);
                LDS_WAIT();
                const float lo = -R + (float)bl * w0, hi = (rhi >= 1) ? (-R + (float)(bh + 1) * w0) : (R * 1.001f);
                const float s1 = 256.f / (hi - lo);
                for (int i = lane; i < 16 * SEL_HROW; i += 64) hist[i] = 0u;
                LDS_WAIT();
                sel_pass<1>(KIb, qb, wv, nkb, tq, r, g, lane, hrow, s1, -lo * s1, nullptr);
                LDS_WAIT();
                const int above = (int)hrow[257]; int inr = 0;
#pragma unroll 8
                for (int bin = 1; bin <= 256; ++bin) inr += (int)hrow[bin];
                const bool ok = above < 256 && above + inr >= 256;
                if (ok) { int sel1, ab1; sel_scan(hrow + 1, 256 - above, sel1, ab1); thr_f = lo + (float)sel1 * ((hi - lo) * (1.f / 256.f)); }
                LDS_WAIT();
                done = __all(ok);
            }
            if (!done) {
                for (int i = lane; i < 16 * SEL_HROW; i += 64) hist[i] = 0u;
                LDS_WAIT();
                sel_pass<0>(KIb, qb, wv, nkb, tq, r, g, lane, hrow, s0, 128.f, nullptr);
                LDS_WAIT();
                int sel0, above0; sel_scan(hrow, 256, sel0, above0);
                LDS_WAIT();
                const float lo0 = -R + (float)sel0 * w0, s1 = 256.f / w0;
                for (int i = lane; i < 16 * SEL_HROW; i += 64) hist[i] = 0u;
                LDS_WAIT();
                sel_pass<1>(KIb, qb, wv, nkb, tq, r, g, lane, hrow, s1, -lo0 * s1, nullptr);
                LDS_WAIT();
                int sel1, above1; sel_scan(hrow + 1, 256 - above0, sel1, above1);
                LDS_WAIT();
                thr_f = lo0 + (float)sel1 * (w0 * (1.f / 256.f));
            }
            if (n <= 256) thr_f = -__builtin_inff();
        }
        sel_pass<2>(KIb, qb, wv, nkb, tq, r, g, lane, hrow, 0.f, thr_f, MASK + mask_row(l, b, qt) * 8);
    }
}

constexpr int AT_ROW = 144;
constexpr int AT_TILE = 64 * AT_ROW;
constexpr int AT_NQT = (L - 16) / 256;
constexpr int AT_NKT = (L + 63) / 64;
static_assert(16 + AT_NQT * 256 == L, "query tiling");
__device__ PHASE_FN void dsa_attn_phase(const Ctx A, LAS unsigned char* lds, int l) {
    const int tid = opaque_tid(), lane = tid & 63, wave = tid >> 6, r = lane & 15, g = lane >> 4;
    const bf16* DQ = (const bf16*)(A.ws + WS_DS_Q); const bf16* DK = (const bf16*)(A.ws + WS_DS_K); const bf16* DV = (const bf16*)(A.ws + WS_DS_V);
    const u64* MASK = (const u64*)(A.ws + WS_MASK); bf16* MIX = (bf16*)(A.ws + WS_MIX);
    unsigned* qhead = (unsigned*)(A.ws + WS_CTL) + CW_DSAQ + 64 * l + 16;
    const unsigned* kmaxw = (const unsigned*)(A.ws + WS_CTL) + CW_KMAX + 64 * l;
    LAS unsigned* unitw = (LAS unsigned*)(lds + MISC_OFF + MI_UNIT);
    const int ldkey = tid >> 3, ldch = tid & 7;
    for (;;) {
        __syncthreads();
        if (tid == 0) unitw[0] = atomicAdd(qhead, 1u);
        __syncthreads();
        const unsigned u = unitw[0];
        if (u >= (unsigned)(NB * 4 * (AT_NQT + 1))) break;
        const bool mini = u >= (unsigned)(NB * 4 * AT_NQT);
        const int qt = mini ? 0 : AT_NQT - 1 - (int)(u >> 5), b = (int)((u & 31u) >> 2), h = (int)(u & 3u);
        const size_t mb = (size_t)b * L;
        const int kmain = mini ? 0 : 4 * qt;
        const int nkt = mini ? 1 : ((4 * qt + 5 < AT_NKT) ? 4 * qt + 5 : AT_NKT);
        const float kmax2 = __uint_as_float(__hip_atomic_load(kmaxw + b * 4 + h, __ATOMIC_RELAXED, __HIP_MEMORY_SCOPE_AGENT));
        int tq[2], lb[2]; bool act[2];
        s8 qf[2][2]; float nc2[2];
        const GAS unsigned* mrow[2];
#pragma unroll
        for (int qi = 0; qi < 2; ++qi) { act[qi] = mini ? (wave == 0 && qi == 0) : true; tq[qi] = mini ? 0 : 16 + qt * 256 + wave * 32 + 16 * qi;
            lb[qi] = __builtin_amdgcn_readfirstlane(act[qi] ? ((tq[qi] + 15) >> 5) : -1);
            float qn2 = 0.f;
#pragma unroll
            for (int ks = 0; ks < 2; ++ks) { qf[qi][ks] = act[qi] ? *(const s8*)(DQ + (mb + tq[qi] + r) * 256 + h * 64 + 32 * ks + 8 * g) : (s8){0, 0, 0, 0, 0, 0, 0, 0};
#pragma unroll
                for (int e = 0; e < 8; ++e) { const float x = bf2f((unsigned short)qf[qi][ks][e]); qn2 += x * x; } }
            qn2 += __shfl_xor(qn2, 16); qn2 += __shfl_xor(qn2, 32);
            nc2[qi] = -sqrtf(qn2 * kmax2);
            const u64 mrow_u = (u64)(MASK + mask_row(l, b, tq[qi] >> 4) * 8);
            const unsigned lo = (unsigned)__builtin_amdgcn_readfirstlane((unsigned)mrow_u), hi = (unsigned)__builtin_amdgcn_readfirstlane((unsigned)(mrow_u >> 32));
            mrow[qi] = (const GAS unsigned*)(((u64)hi << 32) | (u64)lo); }
        pg8::f32x4 O[2][4], Ls[2];
#pragma unroll
        for (int qi = 0; qi < 2; ++qi) { Ls[qi] = (pg8::f32x4){0.f, 0.f, 0.f, 0.f};
#pragma unroll
            for (int db = 0; db < 4; ++db) O[qi][db] = (pg8::f32x4){0.f, 0.f, 0.f, 0.f}; }
        const s8 ones8 = (s8){0x3F80, 0x3F80, 0x3F80, 0x3F80, 0x3F80, 0x3F80, 0x3F80, 0x3F80};
#define AT_SLOAD(dst, qi_, kb_) asm volatile("s_load_dwordx16 %0, %1, 0x0" : "=s"(dst) : "s"(mrow[qi_] + (size_t)(kb_) * 16))
#define AT_MWAIT(m0_, m1_) asm volatile("s_waitcnt lgkmcnt(0)" : "+s"(m0_), "+s"(m1_))
#define AT_MWAIT_S2(a0_, a1_, b0_, b1_) asm volatile("s_waitcnt lgkmcnt(0)" : "+s"(a0_), "+s"(a1_), "+s"(b0_), "+s"(b1_), "+v"(Sa), "+v"(Sb), "+v"(Sc), "+v"(Sd), "+v"(Se), "+v"(Sf), "+v"(Sg), "+v"(Sh) :: "memory")
#define AT_MWAIT_O(a0_, a1_, b0_, b1_) asm volatile("s_waitcnt lgkmcnt(0)" : "+s"(a0_), "+s"(a1_), "+s"(b0_), "+s"(b1_), "+v"(O[1][0]), "+v"(O[1][1]), "+v"(O[1][2]), "+v"(O[1][3]), "+v"(Ls[1]) :: "memory")
        const bf16* kg = DK + (mb + ldkey) * 256 + h * 64 + ldch * 8; const bf16* vg = DV + (mb + ldkey) * 256 + h * 64 + ldch * 8;
        v4u rk0 = *(const v4u*)kg, rv0 = *(const v4u*)vg;
        const size_t to1 = (size_t)(nkt > 1 ? 1 : nkt - 1) * 64 * 256, to2 = (size_t)(nkt > 2 ? 2 : nkt - 1) * 64 * 256, to3 = (size_t)(nkt > 3 ? 3 : nkt - 1) * 64 * 256;
        v4u rk1 = *(const v4u*)(kg + to1), rv1 = *(const v4u*)(vg + to1), rk2 = *(const v4u*)(kg + to2), rv2 = *(const v4u*)(vg + to2), rk3 = *(const v4u*)(kg + to3), rv3 = *(const v4u*)(vg + to3);
        u16v m0, m1, n0, n1;
#define AT_STORE(boff, rk, rv) do { LAS unsigned char* kb_ = lds + (boff); LAS unsigned char* vb_ = kb_ + AT_TILE; \
            *(LAS v4u*)(kb_ + ldkey * AT_ROW + ldch * 16) = rk; *(LAS v4u*)(vb_ + ldkey * AT_ROW + ldch * 16) = rv; } while (0)
#define AT_LOAD(kt_, rk, rv) do { rk = *(const v4u*)(kg + (size_t)(kt_) * 64 * 256); rv = *(const v4u*)(vg + (size_t)(kt_) * 64 * 256); } while (0)
#define AT_KREAD(boff, blk) do { const LAS unsigned char* ka = lds + (boff) + ((blk) * 32 + 8 * (r >> 2) + (r & 3)) * AT_ROW + g * 16; \
            _Pragma("unroll") for (int ks = 0; ks < 2; ++ks) { kf[blk][ks][0] = *(const LAS s8*)(ka + ks * 64); kf[blk][ks][1] = *(const LAS s8*)(ka + 4 * AT_ROW + ks * 64); } } while (0)
#define AT_VREAD(boff, blk) do { const LAS unsigned char* va = lds + (boff) + AT_TILE + ((blk) * 32 + 8 * g + (r >> 2)) * AT_ROW + (r & 3) * 8; \
            _Pragma("unroll") for (int db = 0; db < 4; ++db) { \
                const v4i16_t x0 = __builtin_amdgcn_ds_read_tr16_b64_v4i16((LAS v4i16_t*)(va + db * 32)), x1 = __builtin_amdgcn_ds_read_tr16_b64_v4i16((LAS v4i16_t*)(va + 4 * AT_ROW + db * 32)); \
                vf[blk][db] = (s8){x0[0], x0[1], x0[2], x0[3], x1[0], x1[1], x1[2], x1[3]}; } } while (0)
#define AT_BLK_S(blk, qi, S1, S2) do { S1 = (pg8::f32x4){nc2[qi], nc2[qi], nc2[qi], nc2[qi]}; S2 = S1; \
            _Pragma("unroll") for (int ks = 0; ks < 2; ++ks) { \
                S1 = __builtin_amdgcn_mfma_f32_16x16x32_bf16(kf[blk][ks][0], qf[qi][ks], S1, 0, 0, 0); S2 = __builtin_amdgcn_mfma_f32_16x16x32_bf16(kf[blk][ks][1], qf[qi][ks], S2, 0, 0, 0); } } while (0)
#define AT_BLK_P(mq, S1, S2, pa) do { float p[8]; \
            _Pragma("unroll") for (int j = 0; j < 8; ++j) { \
                const bool bit = __builtin_amdgcn_inverse_ballot_w64(((u64)mq[2 * j + 1] << 32) | mq[2 * j]); \
                p[j] = bit ? __builtin_amdgcn_exp2f(j < 4 ? S1[j & 3] : S2[j & 3]) : 0.f; } \
            v4u pk; pk.x = pk2(p[0], p[1]); pk.y = pk2(p[2], p[3]); pk.z = pk2(p[4], p[5]); pk.w = pk2(p[6], p[7]); \
            pa = __builtin_bit_cast(s8, pk); } while (0)
#define AT_BLK_V(blk, qi, pa) do { \
            _Pragma("unroll") for (int db = 0; db < 4; ++db) O[qi][db] = __builtin_amdgcn_mfma_f32_16x16x32_bf16(pa, vf[blk][db], O[qi][db], 0, 0, 0); \
            Ls[qi] = __builtin_amdgcn_mfma_f32_16x16x32_bf16(pa, ones8, Ls[qi], 0, 0, 0); } while (0)
#define AT_ROTATE do { const int t_ = bc; bc = bn; bn = bs; bs = t_; } while (0)
#define AT_MAIN_BODY(kt, RK_LD, RV_LD, RK_ST, RV_ST, LASTWAIT) do { \
            { const int ktn_ = (kt) + 5 < nkt ? (kt) + 5 : nkt - 1; AT_LOAD(ktn_, RK_LD, RV_LD); } \
            AT_STORE(bs, RK_ST, RV_ST); \
            pg8::f32x4 Sa, Sb, Sc, Sd, Se, Sf, Sg, Sh; s8 pa0, pa1, pb0, pb1; \
            AT_BLK_S(0, 0, Sa, Sb); AT_BLK_S(1, 0, Sc, Sd); AT_BLK_S(0, 1, Se, Sf); AT_BLK_S(1, 1, Sg, Sh);        \
            AT_MWAIT_S2(m0, m1, n0, n1); \
            AT_KREAD(bn, 0); AT_KREAD(bn, 1); \
            AT_BLK_P(m0, Sa, Sb, pa0); AT_SLOAD(m0, 0, 2 * (kt) + 2); AT_BLK_P(m1, Sc, Sd, pa1); AT_SLOAD(m1, 0, 2 * (kt) + 3); \
            AT_BLK_V(0, 0, pa0); AT_BLK_V(1, 0, pa1); \
            AT_BLK_P(n0, Se, Sf, pb0); AT_SLOAD(n0, 1, 2 * (kt) + 2); AT_BLK_P(n1, Sg, Sh, pb1); AT_SLOAD(n1, 1, 2 * (kt) + 3); \
            AT_BLK_V(0, 1, pb0); AT_BLK_V(1, 1, pb1); \
            if (LASTWAIT) AT_MWAIT_O(m0, m1, n0, n1);                   \
            AT_VREAD(bn, 0); AT_VREAD(bn, 1); \
            AT_ROTATE; \
            __builtin_amdgcn_s_barrier(); } while (0)
#define AT_DIAG_STEP(kt, qi) do { \
            if (2 * (kt) + 1 <= lb[qi]) { pg8::f32x4 Sa, Sb, Sc, Sd; s8 pa0, pa1; AT_SLOAD(m0, qi, 2 * (kt)); AT_SLOAD(m1, qi, 2 * (kt) + 1); \
                AT_BLK_S(0, qi, Sa, Sb); AT_BLK_S(1, qi, Sc, Sd); AT_MWAIT(m0, m1); AT_BLK_P(m0, Sa, Sb, pa0); AT_BLK_P(m1, Sc, Sd, pa1); AT_BLK_V(0, qi, pa0); AT_BLK_V(1, qi, pa1); } \
            else if (2 * (kt) <= lb[qi]) { pg8::f32x4 Sa, Sb; s8 pa0; AT_SLOAD(m0, qi, 2 * (kt)); AT_SLOAD(m1, qi, 2 * (kt)); \
                AT_BLK_S(0, qi, Sa, Sb); AT_MWAIT(m0, m1); AT_BLK_P(m0, Sa, Sb, pa0); AT_BLK_V(0, qi, pa0); } } while (0)
#define AT_DIAG_BODY(kt, RK_LD, RV_LD, RK_ST, RV_ST) do { \
            { const int ktn_ = (kt) + 5 < nkt ? (kt) + 5 : nkt - 1; AT_LOAD(ktn_, RK_LD, RV_LD); } \
            AT_STORE(bs, RK_ST, RV_ST); \
            if (2 * (kt) <= lb[1] || 2 * (kt) <= lb[0]) { \
                AT_KREAD(bc, 0); AT_KREAD(bc, 1); AT_VREAD(bc, 0); AT_VREAD(bc, 1); \
                AT_DIAG_STEP(kt, 0); AT_DIAG_STEP(kt, 1); } \
            asm volatile("s_waitcnt lgkmcnt(0)" ::: "memory"); \
            AT_ROTATE; \
            __builtin_amdgcn_s_barrier(); } while (0)
        int bc = 0, bn = 2 * AT_TILE, bs = 4 * AT_TILE;
        s8 kf[2][2][2], vf[2][4];
        AT_SLOAD(m0, 0, 0); AT_SLOAD(m1, 0, 1); AT_SLOAD(n0, 1, 0); AT_SLOAD(n1, 1, 1);
        AT_STORE(bc, rk0, rv0);
        AT_STORE(bn, rk1, rv1);
        AT_LOAD(nkt > 4 ? 4 : nkt - 1, rk0, rv0);
        AT_MWAIT(m0, m1); AT_MWAIT(n0, n1);
        __syncthreads();
        AT_KREAD(bc, 0); AT_KREAD(bc, 1); AT_VREAD(bc, 0); AT_VREAD(bc, 1);
#pragma unroll 1
        for (int kt = 0; kt < kmain; kt += 4) {
            AT_MAIN_BODY(kt, rk1, rv1, rk2, rv2, false);
            AT_MAIN_BODY(kt + 1, rk2, rv2, rk3, rv3, false);
            AT_MAIN_BODY(kt + 2, rk3, rv3, rk0, rv0, false);
            AT_MAIN_BODY(kt + 3, rk0, rv0, rk1, rv1, true);
        }
#pragma unroll 1
        for (int kt = kmain; kt < nkt; kt += 4) {
            AT_DIAG_BODY(kt, rk1, rv1, rk2, rv2);
            AT_DIAG_BODY(kt + 1, rk2, rv2, rk3, rv3);
            AT_DIAG_BODY(kt + 2, rk3, rv3, rk0, rv0);
            AT_DIAG_BODY(kt + 3, rk0, rv0, rk1, rv1);
        }
#undef AT_ROTATE
#undef AT_MAIN_BODY
#undef AT_DIAG_BODY
#undef AT_DIAG_STEP
#undef AT_BLK_S
#undef AT_BLK_P
#undef AT_BLK_V
#undef AT_KREAD
#undef AT_VREAD
#undef AT_SLOAD
#undef AT_MWAIT
#undef AT_MWAIT_S2
#undef AT_MWAIT_O
#undef AT_LOAD
#undef AT_STORE
#pragma unroll
        for (int qi = 0; qi < 2; ++qi)
#pragma unroll
            for (int j = 0; j < 4; ++j) { const float ij = Ls[qi][j] > 0.f ? 1.f / Ls[qi][j] : 0.f; const int t = tq[qi] + 4 * g + j;
                if (act[qi]) {
#pragma unroll
                    for (int db = 0; db < 4; ++db) MIX[(mb + t) * 1024 + 256 + h * 64 + db * 16 + r] = f2bf(O[qi][db][j] * ij); } }
    }
}
constexpr int CK = 16;
constexpr int NCHK = L / CK;
static_assert(L % CK == 0, "chunk length");
constexpr int CKP_RW = 10, CKP_HG = 7;
constexpr int CKR_RW = CKP_RW * 1024 + 512, CKR_HG = CKP_HG * 1024 + 256;
constexpr size_t WS_CKF_RW = WS_PROJ + 136 * MiB;
constexpr size_t WS_CKF_HG = WS_CKF_RW + (size_t)32 * NCHK * CKR_RW;
static_assert(WS_CKF_HG + (size_t)32 * NCHK * CKR_HG <= WS_PROJ + (size_t)TP * NINP * 2, "chunk fragments fit in the dead proj region");
__device__ __forceinline__ s8 pack8(const pg8::f32x4 lo, const pg8::f32x4 hi) { v4u p; p.x = pk2(lo[0], lo[1]); p.y = pk2(lo[2], lo[3]); p.z = pk2(hi[0], hi[1]); p.w = pk2(hi[2], hi[3]); return __builtin_bit_cast(s8, p); }
template <int CTRL> __device__ __forceinline__ float dpp_shr1(float x) { return __int_as_float(__builtin_amdgcn_update_dpp(0x3F800000, __float_as_int(x), CTRL, 0xF, 0xF, false)); }
__device__ __forceinline__ float row_cumprod(float x) { x *= dpp_shr1<0x111>(x); x *= dpp_shr1<0x112>(x); x *= dpp_shr1<0x114>(x); x *= dpp_shr1<0x118>(x); return x; }

template <bool RWKV>
__device__ __forceinline__ void chunk_prep_item(const Ctx A, int bh, int c, int lane) {
    const int r = lane & 15, g = lane >> 4;
    const size_t base = ((size_t)bh * L + (size_t)c * CK + r) * 64;
    const float* Wg = (const float*)(A.ws + (RWKV ? WS_RW_W : WS_HG_F)) + base;
    const bf16* Ag = (const bf16*)(A.ws + WS_RW_A) + base; const bf16* Bg = (const bf16*)(A.ws + WS_RW_B) + base;
    const bf16* Kg = (const bf16*)(A.ws + (RWKV ? WS_RW_K : WS_HG_K)) + base; const bf16* Rg = (const bf16*)(A.ws + (RWKV ? WS_RW_WR : WS_HG_Q)) + base;
    GAS unsigned char* recb = A.ws + (RWKV ? WS_CKF_RW : WS_CKF_HG) + ((size_t)bh * NCHK + c) * (RWKV ? CKR_RW : CKR_HG);
    v4u* REC = (v4u*)recb + lane; v4f* GCp = (v4f*)(recb + (RWKV ? CKP_RW : CKP_HG) * 1024); float* Dp = (float*)(recb + CKP_RW * 1024 + 256);
    s8 Af[2], Bf[2], Kf[2], Rf[2], BTf[2], KTf[2];
    v4f gcv[4];
#pragma unroll
    for (int ks = 0; ks < 2; ++ks) {
        pg8::f32x4 ah[2], bh_[2], kh[2], rh[2], bt[2], kt[2];
#pragma unroll
        for (int hf = 0; hf < 2; ++hf) {
            const int k0 = 32 * ks + 16 * hf + 4 * g;
            const v4f w4 = *(const v4f*)(Wg + k0);
            v4f gt, gm, gc;
#pragma unroll
            for (int e = 0; e < 4; ++e) { gt[e] = row_cumprod(w4[e]); gm[e] = dpp_shr1<0x111>(gt[e]); gc[e] = __shfl(gt[e], 16 * g + 15); }
            gcv[2 * ks + hf] = gc;
            v4f inv; inv.x = __builtin_amdgcn_rcpf(gt.x); inv.y = __builtin_amdgcn_rcpf(gt.y); inv.z = __builtin_amdgcn_rcpf(gt.z); inv.w = __builtin_amdgcn_rcpf(gt.w);
            const v4f kk4 = ld_bf4(Kg + k0) * inv, rr4 = ld_bf4(Rg + k0) * (RWKV ? gm : gt);
            kh[hf] = kk4; rh[hf] = rr4; kt[hf] = kk4 * gc;
            if (RWKV) { ah[hf] = ld_bf4(Ag + k0) * gm; bh_[hf] = ld_bf4(Bg + k0) * inv; bt[hf] = bh_[hf] * gc; }
        }
        Kf[ks] = pack8(kh[0], kh[1]); Rf[ks] = pack8(rh[0], rh[1]); KTf[ks] = pack8(kt[0], kt[1]);
        if (RWKV) { Af[ks] = pack8(ah[0], ah[1]); Bf[ks] = pack8(bh_[0], bh_[1]); BTf[ks] = pack8(bt[0], bt[1]); }
    }
    const pg8::f32x4 z4 = (pg8::f32x4){0.f, 0.f, 0.f, 0.f};
    s8 selE, selO;
    { v4u e = (v4u){0u, 0u, 0u, 0u}, o = e; const int jj = r - 4 * g;
      if (jj >= 0 && jj < 4) { const unsigned one = 0x3F80u << (16 * (jj & 1)); if (jj < 2) { e.x = one; o.z = one; } else { e.y = one; o.w = one; } }
      selE = __builtin_bit_cast(s8, e); selO = __builtin_bit_cast(s8, o); }
    pg8::f32x4 MrkT = __builtin_amdgcn_mfma_f32_16x16x32_bf16(Kf[0], Rf[0], z4, 0, 0, 0); MrkT = __builtin_amdgcn_mfma_f32_16x16x32_bf16(Kf[1], Rf[1], MrkT, 0, 0, 0);
    const int tb = r >> 2, tj = r & 3;
    if (RWKV) {
        pg8::f32x4 LabT = __builtin_amdgcn_mfma_f32_16x16x32_bf16(Bf[0], Af[0], z4, 0, 0, 0); LabT = __builtin_amdgcn_mfma_f32_16x16x32_bf16(Bf[1], Af[1], LabT, 0, 0, 0);
        pg8::f32x4 LakT = __builtin_amdgcn_mfma_f32_16x16x32_bf16(Kf[0], Af[0], z4, 0, 0, 0); LakT = __builtin_amdgcn_mfma_f32_16x16x32_bf16(Kf[1], Af[1], LakT, 0, 0, 0);
        pg8::f32x4 MrbT = __builtin_amdgcn_mfma_f32_16x16x32_bf16(Bf[0], Rf[0], z4, 0, 0, 0); MrbT = __builtin_amdgcn_mfma_f32_16x16x32_bf16(Bf[1], Rf[1], MrbT, 0, 0, 0);
        const float d10 = __shfl(LabT[0], 20 * g + 1), d20 = __shfl(LabT[0], 20 * g + 2), d21 = __shfl(LabT[1], 20 * g + 2);
        const float d30 = __shfl(LabT[0], 20 * g + 3), d31 = __shfl(LabT[1], 20 * g + 3), d32 = __shfl(LabT[2], 20 * g + 3);
        pg8::f32x4 Loff, Lak, Mrb, Mrk;
#pragma unroll
        for (int j = 0; j < 4; ++j) { const bool below = g < tb, diag = g == tb;
            Loff[j] = below ? LabT[j] : 0.f; Lak[j] = (below || (diag && j < tj)) ? LakT[j] : 0.f;
            Mrb[j] = (below || (diag && j <= tj)) ? MrbT[j] : 0.f; Mrk[j] = (below || (diag && j <= tj)) ? MrkT[j] : 0.f; }
        REC[0 * 64] = __builtin_bit_cast(v4u, Af[0]); REC[1 * 64] = __builtin_bit_cast(v4u, Af[1]); REC[2 * 64] = __builtin_bit_cast(v4u, Rf[0]); REC[3 * 64] = __builtin_bit_cast(v4u, Rf[1]);
        REC[4 * 64] = __builtin_bit_cast(v4u, pack8(Loff, Lak)); REC[5 * 64] = __builtin_bit_cast(v4u, pack8(Mrb, Mrk));
        if (r == 0) { *(v4f*)(Dp + 8 * g) = (v4f){d10, d20, d21, d30}; *(v4f*)(Dp + 8 * g + 4) = (v4f){d31, d32, 0.f, 0.f}; }
#pragma unroll
        for (int mt = 0; mt < 4; ++mt) { const s8 sel = (mt & 1) ? selO : selE;
            const pg8::f32x4 K2 = __builtin_amdgcn_mfma_f32_16x16x32_bf16(KTf[mt >> 1], sel, z4, 0, 0, 0), B2 = __builtin_amdgcn_mfma_f32_16x16x32_bf16(BTf[mt >> 1], sel, z4, 0, 0, 0);
            REC[(6 + mt) * 64] = __builtin_bit_cast(v4u, pack8(B2, K2)); if (r == 15) GCp[4 * mt + g] = gcv[mt]; }
    } else {
        pg8::f32x4 Mrk;
#pragma unroll
        for (int j = 0; j < 4; ++j) Mrk[j] = (g < tb || (g == tb && j <= tj)) ? MrkT[j] : 0.f;
        REC[0 * 64] = __builtin_bit_cast(v4u, Rf[0]); REC[1 * 64] = __builtin_bit_cast(v4u, Rf[1]); REC[2 * 64] = __builtin_bit_cast(v4u, pack8(z4, Mrk));
#pragma unroll
        for (int mt = 0; mt < 4; ++mt) { const s8 sel = (mt & 1) ? selO : selE;
            const pg8::f32x4 K2 = __builtin_amdgcn_mfma_f32_16x16x32_bf16(KTf[mt >> 1], sel, z4, 0, 0, 0);
            REC[(3 + mt) * 64] = __builtin_bit_cast(v4u, pack8(z4, K2)); if (r == 15) GCp[4 * mt + g] = gcv[mt]; }
    }
}
__device__ PHASE_FN void chunk_prep_phase(const Ctx A, int vcu, int G) {
    const int tid = opaque_tid(), lane = tid & 63, wave = tid >> 6;
    const int gw = vcu * NWAVES + wave, NGW = G * NWAVES;
#pragma unroll 1
    for (int it = gw; it < 2 * 32 * NCHK; it += NGW) {
        const int mix = it >= 32 * NCHK, q = mix ? it - 32 * NCHK : it, bh = q / NCHK, c = q - bh * NCHK;
        if (mix) chunk_prep_item<false>(A, bh, c, lane); else chunk_prep_item<true>(A, bh, c, lane);
    }
}
template <bool RWKV>
__device__ PHASE_FN void chunk_scan(const Ctx A, LAS unsigned char* lds, int unit_) {
    const int unit = opaque_s(unit_);
    const int tid = opaque_tid(), lane = tid & 63, wave = tid >> 6, r = lane & 15, g = lane >> 4;
    const int slot = wave >> 2, nt = wave & 3;
    const int bh = 2 * unit + slot, b = bh >> 2, h = bh & 3;
    constexpr int NP = RWKV ? CKP_RW : CKP_HG;
    constexpr int NU = NP + 3;
    constexpr int NQ = (NU + 3) / 4;
    constexpr int RING = NU * 1024;
    constexpr size_t RB = RWKV ? CKR_RW : CKR_HG;
    const GAS unsigned char* recb = A.ws + (RWKV ? WS_CKF_RW : WS_CKF_HG) + (size_t)bh * NCHK * RB;
    const GAS unsigned char* vb = A.ws + (RWKV ? WS_RW_V : WS_HG_V) + (size_t)bh * L * 128;
    float* YR = (float*)(A.ws + (RWKV ? WS_YRAW : WS_ORAW)) + (size_t)b * L * 256 + h * 64 + nt * 16 + r;
    LAS unsigned char* ring = lds + slot * 2 * RING;
    static_assert(4 * (size_t)(CKP_RW + 3) * 1024 <= MISC_OFF, "chunk ring");
    auto unit_src = [&](int c_, int u) -> const GAS v4u* {
        if (u < NP) return (const GAS v4u*)(recb + (size_t)c_ * RB + u * 1024) + lane;
        if (u == NP) { const int q = lane * 16 < (int)(RB - NP * 1024) ? lane * 16 : (int)(RB - NP * 1024) - 16; return (const GAS v4u*)(recb + (size_t)c_ * RB + NP * 1024 + q); }
        return (const GAS v4u*)(vb + (size_t)c_ * CK * 128 + (u - NP - 1) * 1024) + lane; };
    v4u st0[NQ], st1[NQ], st2[NQ], st3[NQ];
#define CK_LD(S, c_) do { const int cc_ = (c_) < NCHK ? (c_) : NCHK - 1; _Pragma("unroll") for (int q = 0; q < NQ; ++q) { const int u = nt + 4 * q; if (u < NU) S[q] = *unit_src(cc_, u); } } while (0)
#define CK_ST(S, p_) do { _Pragma("unroll") for (int q = 0; q < NQ; ++q) { const int u = nt + 4 * q; if (u < NU) *(LAS v4u*)(ring + (p_) * RING + u * 1024 + lane * 16) = S[q]; } } while (0)
    pg8::f32x4 ST[4];
#pragma unroll
    for (int mt = 0; mt < 4; ++mt) ST[mt] = (pg8::f32x4){0.f, 0.f, 0.f, 0.f};
    const pg8::f32x4 z4 = (pg8::f32x4){0.f, 0.f, 0.f, 0.f};
    auto body = [&](const int c, const int p) __attribute__((always_inline)) {
        const LAS unsigned char* rb_ = ring + p * RING;
        const LAS unsigned char* sm = rb_ + NP * 1024;
        v4u pcs[NP]; v4f gqs[4]; v4f da = (v4f){0.f, 0.f, 0.f, 0.f}, db = da;
#pragma unroll
        for (int i = 0; i < NP; ++i) pcs[i] = *(const LAS v4u*)(rb_ + i * 1024 + lane * 16);
#pragma unroll
        for (int mt = 0; mt < 4; ++mt) gqs[mt] = *(const LAS v4f*)(sm + (16 * mt + 4 * g) * 4);
        if (RWKV) { da = *(const LAS v4f*)(sm + 256 + g * 32); db = *(const LAS v4f*)(sm + 256 + g * 32 + 16); }
#define PIECE(i) __builtin_bit_cast(s8, pcs[i])
        unsigned vp0, vp1;
        { const LAS unsigned short* vv = (const LAS unsigned short*)(rb_ + (NP + 1) * 1024) + (4 * g) * 64 + 16 * nt + r;
          vp0 = (unsigned)vv[0] | ((unsigned)vv[64] << 16); vp1 = (unsigned)vv[128] | ((unsigned)vv[192] << 16); }
        __builtin_amdgcn_sched_barrier(0);
        const s8 Sf0 = pack8(ST[0], ST[1]), Sf1 = pack8(ST[2], ST[3]);
        pg8::f32x4 U = z4, R0;
        if (RWKV) {
            R0 = __builtin_amdgcn_mfma_f32_16x16x32_bf16(PIECE(2), Sf0, z4, 0, 0, 0); R0 = __builtin_amdgcn_mfma_f32_16x16x32_bf16(PIECE(3), Sf1, R0, 0, 0, 0);
            pg8::f32x4 W0 = __builtin_amdgcn_mfma_f32_16x16x32_bf16(PIECE(0), Sf0, z4, 0, 0, 0); W0 = __builtin_amdgcn_mfma_f32_16x16x32_bf16(PIECE(1), Sf1, W0, 0, 0, 0);
            const float d10 = da.x, d20 = da.y, d21 = da.z, d30 = da.w, d31 = db.x, d32 = db.y;
            const s8 Ajac = PIECE(4);
#pragma unroll
            for (int rnd = 0; rnd < 4; ++rnd) {
                v4u bu; bu.x = pk2(U[0], U[1]); bu.y = pk2(U[2], U[3]); bu.z = vp0; bu.w = vp1;
                const pg8::f32x4 Wr = __builtin_amdgcn_mfma_f32_16x16x32_bf16(Ajac, __builtin_bit_cast(s8, bu), W0, 0, 0, 0);
                U[0] = Wr[0]; U[1] = Wr[1] + d10 * U[0]; U[2] = Wr[2] + d20 * U[0] + d21 * U[1]; U[3] = Wr[3] + d30 * U[0] + d31 * U[1] + d32 * U[2];
            }
        } else {
            R0 = __builtin_amdgcn_mfma_f32_16x16x32_bf16(PIECE(0), Sf0, z4, 0, 0, 0); R0 = __builtin_amdgcn_mfma_f32_16x16x32_bf16(PIECE(1), Sf1, R0, 0, 0, 0);
        }
        v4u buv; buv.x = pk2(U[0], U[1]); buv.y = pk2(U[2], U[3]); buv.z = vp0; buv.w = vp1;
        const s8 Buv = __builtin_bit_cast(s8, buv);
        const pg8::f32x4 Yt = __builtin_amdgcn_mfma_f32_16x16x32_bf16(PIECE(RWKV ? 5 : 2), Buv, R0, 0, 0, 0);
#pragma unroll
        for (int j = 0; j < 4; ++j) YR[(size_t)(c * CK + 4 * g + j) * 256] = Yt[j];
#pragma unroll
        for (int mt = 0; mt < 4; ++mt) {
            const v4f gq = gqs[mt];
            ST[mt][0] *= gq.x; ST[mt][1] *= gq.y; ST[mt][2] *= gq.z; ST[mt][3] *= gq.w;
            ST[mt] = __builtin_amdgcn_mfma_f32_16x16x32_bf16(PIECE((RWKV ? 6 : 3) + mt), Buv, ST[mt], 0, 0, 0);
        }
#undef PIECE
    };
    CK_LD(st0, 0); CK_LD(st1, 1); CK_LD(st2, 2); CK_LD(st3, 3);
    CK_ST(st0, 0);
    __syncthreads();
#define CK_TRIP(c_, SLD, SST, p_) do { CK_LD(SLD, (c_) + 4); body((c_), (p_)); CK_ST(SST, 1 - (p_)); __syncthreads(); } while (0)
    static_assert(NCHK % 4 == 1, "chunk loop: whole groups of four trips + one");
#pragma unroll 1
    for (int c = 0; c < NCHK - 1; c += 4) {
        CK_TRIP(c, st0, st1, 0);
        CK_TRIP(c + 1, st1, st2, 1);
        CK_TRIP(c + 2, st2, st3, 0);
        CK_TRIP(c + 3, st3, st0, 1);
    }
    CK_TRIP(NCHK - 1, st0, st1, 0);
#undef CK_TRIP
#undef CK_LD
#undef CK_ST
}
__device__ __forceinline__ float rowmax16(float x) { x = fmaxf(x, dpp_f<0xB1>(x)); x = fmaxf(x, dpp_f<0x4E>(x)); x = fmaxf(x, dpp_f<0x141>(x)); x = fmaxf(x, dpp_f<0x140>(x)); return x; }
__device__ __forceinline__ int rowmin16i(int x) { x = min(x, __builtin_amdgcn_update_dpp(0, x, 0xB1, 0xF, 0xF, true)); x = min(x, __builtin_amdgcn_update_dpp(0, x, 0x4E, 0xF, 0xF, true));
    x = min(x, __builtin_amdgcn_update_dpp(0, x, 0x141, 0xF, 0xF, true)); x = min(x, __builtin_amdgcn_update_dpp(0, x, 0x140, 0xF, 0xF, true)); return x; }
__device__ PHASE_FN void ln_router_phase(const Ctx A, LAS unsigned char* lds, int l, int vcu, int G) {
    const int tid = opaque_tid(), lane = tid & 63, wave = tid >> 6, r = lane & 15, g = lane >> 4;
    const int gw = vcu * NWAVES + wave, NGW = G * NWAVES;
    bf16* HB = (bf16*)(A.ws + WS_HB);
    int* TIDX = (int*)(A.ws + WS_TIDX); float* TGATE = (float*)(A.ws + WS_TGATE);
    unsigned* ecnt = (unsigned*)(A.ws + WS_CTL) + CW_ECNT + 64 * l;
    const float* gg = gin(A, 26) + l * D; const float* bb = gin(A, 27) + l * D;
    const float* rw = gin(A, 28) + (size_t)l * D * NE; const float* rb = gin(A, 29) + l * NE;
    LAS int* hist = (LAS int*)(lds + MISC_OFF + MI_HIST);
    if (tid < 32) hist[tid] = 0;
    for (int f = tid; f < 32 * 2 * 64; f += NTHR) { const int ks = f >> 7, nt = (f >> 6) & 1, ln = f & 63, n = ln & 15, g8 = ln >> 4;
        float w8[8];
#pragma unroll
        for (int e = 0; e < 8; ++e) w8[e] = rw[(size_t)(32 * ks + 8 * g8 + e) * NE + 16 * nt + n];
        v4u hi, lo; unsigned hh[4], ll[4];
#pragma unroll
        for (int e = 0; e < 4; ++e) { const unsigned ph = pk2(w8[2 * e], w8[2 * e + 1]); hh[e] = ph; ll[e] = pk2(w8[2 * e] - bflo(ph), w8[2 * e + 1] - bfhi(ph)); }
        hi = (v4u){hh[0], hh[1], hh[2], hh[3]}; lo = (v4u){ll[0], ll[1], ll[2], ll[3]};
        *(LAS v4u*)(lds + ((size_t)((ks * 2 + nt) * 2 + 0) * 64 + ln) * 16) = hi; *(LAS v4u*)(lds + ((size_t)((ks * 2 + nt) * 2 + 1) * 64 + ln) * 16) = lo; }
    __syncthreads();
    const float rb0 = rb[r], rb1 = rb[16 + r];
    auto lnrows = [&](size_t mrow, auto nrows_c) {
        constexpr int NR = decltype(nrows_c)::value;
        v4f x[NR][4];
#pragma unroll
        for (int u = 0; u < NR; ++u)
#pragma unroll
            for (int j = 0; j < 4; ++j) x[u][j] = ld_bf4(HB + (mrow + u) * D + 256 * j + 4 * lane);
#pragma unroll
        for (int u = 0; u < NR; ++u) { ln_row(x[u], gg, bb, lane);
#pragma unroll
            for (int j = 0; j < 4; ++j) { const size_t o = (mrow + u) * D + 256 * j + 4 * lane;
                v2u hi; hi.x = pk2(x[u][j].x, x[u][j].y); hi.y = pk2(x[u][j].z, x[u][j].w);
                *(v2u*)(HB + o) = hi; } }
    };
    auto ln2 = [&](size_t mrow) { lnrows(mrow, std::integral_constant<int, 2>{}); };
    auto route = [&](size_t m0) {
        pg8::f32x4 C0 = (pg8::f32x4){0.f, 0.f, 0.f, 0.f}, C1 = C0;
        const bf16* ah = HB + (m0 + r) * D + 8 * g;
#pragma unroll 4
        for (int ks = 0; ks < 32; ++ks) {
            const s8 xh = *(const s8*)(ah + 32 * ks);
            const LAS unsigned char* wf = lds + (size_t)(ks * 4) * 1024 + lane * 16;
            const s8 w0h = *(const LAS s8*)(wf), w0l = *(const LAS s8*)(wf + 1024), w1h = *(const LAS s8*)(wf + 2048), w1l = *(const LAS s8*)(wf + 3072);
            C0 = __builtin_amdgcn_mfma_f32_16x16x32_bf16(xh, w0h, C0, 0, 0, 0); C0 = __builtin_amdgcn_mfma_f32_16x16x32_bf16(xh, w0l, C0, 0, 0, 0);
            C1 = __builtin_amdgcn_mfma_f32_16x16x32_bf16(xh, w1h, C1, 0, 0, 0); C1 = __builtin_amdgcn_mfma_f32_16x16x32_bf16(xh, w1l, C1, 0, 0, 0);
        }
#pragma unroll
        for (int j = 0; j < 4; ++j) {
            float v0 = C0[j] + rb0, v1 = C1[j] + rb1;
            float tv[4]; int ti[4];
#pragma unroll
            for (int q = 0; q < 4; ++q) {
                const float mx = rowmax16(fmaxf(v0, v1));
                const int cand = (v0 == mx) ? r : ((v1 == mx) ? 16 + r : 64);
                const int bi = rowmin16i(cand);
                tv[q] = mx; ti[q] = bi;
                if (bi == r) v0 = -3.0e38f; if (bi == 16 + r) v1 = -3.0e38f;
            }
            const float e1 = __expf(tv[1] - tv[0]), e2 = __expf(tv[2] - tv[0]), e3 = __expf(tv[3] - tv[0]); const float inv = rcp_(1.f + e1 + e2 + e3);
            const size_t m = m0 + 4 * g + j;
            if (r == 0) { *(int4*)(TIDX + m * 4) = make_int4(ti[0], ti[1], ti[2], ti[3]); *(v4f*)(TGATE + m * 4) = (v4f){inv, e1 * inv, e2 * inv, e3 * inv}; }
            if (r < 4) lds_add(&hist[r == 0 ? ti[0] : r == 1 ? ti[1] : r == 2 ? ti[2] : ti[3]], 1);
        }
    };
    const int NT16 = T / 16, nfull = (NT16 / NGW) * NGW;
#pragma unroll 1
    for (int tile = gw; tile < nfull; tile += NGW) {
        const size_t m0 = (size_t)tile * 16;
#pragma unroll 1
        for (int t = 0; t < 16; t += 4) lnrows(m0 + t, std::integral_constant<int, 4>{});
        asm volatile("s_waitcnt vmcnt(0)" ::: "memory");
        route(m0);
    }
#pragma unroll 1
    for (int tile = nfull + vcu; tile < NT16; tile += G) {
        const size_t m0 = (size_t)tile * 16;
        ln2(m0 + 2 * wave);
        asm volatile("s_waitcnt vmcnt(0)" ::: "memory");
        __syncthreads();
        if (wave == 0) route(m0);
    }
    __syncthreads();
    if (tid < 32) atomicAdd(&ecnt[tid], (unsigned)hist[tid]);
}
__device__ __forceinline__ int build_tiles(const Ctx A, LAS unsigned char* lds, int l) {
    const int tid = opaque_tid();
    const unsigned* ecnt = (const unsigned*)(A.ws + WS_CTL) + CW_ECNT + 64 * l;
    LAS int* offs = (LAS int*)(lds + MISC_OFF + MI_OFFS); LAS int* tile_e = (LAS int*)(lds + MISC_OFF + MI_TILE); LAS int* nt = (LAS int*)(lds + MISC_OFF + MI_NT);
    __syncthreads();
    if (tid < 32) { int off = 0, mycnt = 0;
        for (int e = 0; e < 32; ++e) { const int c = (int)__hip_atomic_load(ecnt + e, __ATOMIC_RELAXED, __HIP_MEMORY_SCOPE_AGENT); if (e < tid) off += (c + 255) & ~255; if (e == tid) mycnt = c; }
        offs[tid] = off;
        const int t0 = off >> 8, t1 = (off + ((mycnt + 255) & ~255)) >> 8;
        for (int t = t0; t < t1; ++t) tile_e[t] = tid;
        if (tid == 31) nt[0] = t1; }
    __syncthreads();
    return nt[0];
}
__device__ PHASE_FN void moe_sort_phase(const Ctx A, LAS unsigned char* lds, int l) {
    const int tid = opaque_tid();
    const int* TIDX = (const int*)(A.ws + WS_TIDX); const float* TGATE = (const float*)(A.ws + WS_TGATE);
    int* SPOS = (int*)(A.ws + WS_SPOS); float* GSORT = (float*)(A.ws + WS_GSORT); int* RMAP = (int*)(A.ws + WS_RMAP);
    unsigned* ecur = (unsigned*)(A.ws + WS_CTL) + CW_ECUR + 64 * l; const unsigned* ecnt = (const unsigned*)(A.ws + WS_CTL) + CW_ECNT + 64 * l;
    LAS int* hist = (LAS int*)(lds + MISC_OFF + MI_HIST); LAS int* lcur = (LAS int*)(lds + MISC_OFF + MI_LCUR); LAS int* lbase = (LAS int*)(lds + MISC_OFF + MI_LBASE);
    LAS int* offs = (LAS int*)(lds + MISC_OFF + MI_OFFS);
    (void)build_tiles(A, lds, l);
    const int TPB = (T + (int)gridDim.x - 1) / (int)gridDim.x;
    const int mbeg = blockIdx.x * TPB, mend = (mbeg + TPB < T) ? mbeg + TPB : T;
    const int nslot = (mend > mbeg) ? (mend - mbeg) * 4 : 0;
    if (tid < 32) { hist[tid] = 0; lcur[tid] = 0; }
    __syncthreads();
    for (int s = tid; s < nslot; s += NTHR) lds_add(&hist[TIDX[(size_t)mbeg * 4 + s]], 1);
    __syncthreads();
    if (tid < 32) lbase[tid] = offs[tid] + (int)atomicAdd(&ecur[tid], (unsigned)hist[tid]);
    __syncthreads();
    for (int s = tid; s < nslot; s += NTHR) { const size_t gs = (size_t)mbeg * 4 + s; const int e = TIDX[gs];
        const int pos = lbase[e] + lds_add(&lcur[e], 1);
        SPOS[gs] = pos; GSORT[pos] = TGATE[gs]; RMAP[pos] = mbeg + (s >> 2); }
    if (blockIdx.x < 32) { const int e = blockIdx.x; const int c = (int)__hip_atomic_load(ecnt + e, __ATOMIC_RELAXED, __HIP_MEMORY_SCOPE_AGENT);
        const int p0 = offs[e] + c, p1 = offs[e] + ((c + 255) & ~255);
        for (int p = p0 + tid; p < p1; p += NTHR) RMAP[p] = 0; }
}
__device__ PHASE_FN void combine_ln_phase(const Ctx A, int l, int vcu, int G) {
    const int tid = opaque_tid(), lane = tid & 63, wave = tid >> 6;
    const int gw = vcu * NWAVES + wave, NGW = G * NWAVES;
    bf16* HB = (bf16*)(A.ws + WS_HB); const bf16* Y = (const bf16*)(A.ws + WS_YBUF); const int* SPOS = (const int*)(A.ws + WS_SPOS);
    const float* g = gin(A, 34) + l * D; const float* bb = gin(A, 35) + l * D;
#pragma unroll 1
    for (int m0 = 2 * gw; m0 < T; m0 += 2 * NGW) {
        v4f v[2][4];
#pragma unroll
        for (int t = 0; t < 2; ++t) { const int m = m0 + t;
            const int4 sp = *(const int4*)(SPOS + (size_t)m * 4);
#pragma unroll
            for (int j = 0; j < 4; ++j) { const size_t co = 256 * j + 4 * lane;
                const v4f y = ld_bf4(Y + (size_t)sp.x * D + co) + ld_bf4(Y + (size_t)sp.y * D + co) + ld_bf4(Y + (size_t)sp.z * D + co) + ld_bf4(Y + (size_t)sp.w * D + co);
                v[t][j] = ld_bf4(HB + (size_t)m * D + co) * ALPHA + y; } }
#pragma unroll
        for (int t = 0; t < 2; ++t) { const int m = m0 + t;
            ln_row(v[t], g, bb, lane);
            if (l == 0) {
#pragma unroll
                for (int j = 0; j < 4; ++j) st_bf4(HB + (size_t)m * D + 256 * j + 4 * lane, v[t][j]);
            } else {
                const int b = m / L, i = m - b * L;
                if (i >= NMETA) { float* o = (float*)(GAS float*)A.out + ((size_t)b * SEQ + (i - NMETA)) * D;
#pragma unroll
                    for (int j = 0; j < 4; ++j) *(v4f*)(o + 256 * j + 4 * lane) = v[t][j]; }
            }
        }
    }
}
constexpr int N_PHASES = 23;
#ifndef PH_ONLY
#define PH_ONLY -1
#endif
#define PHSEL(j) (PH_ONLY < 0 || PH_ONLY == (j))
#define IN(k) (lo <= (k) && (k) < hi)
#if MK_ONE_LAUNCH
#define GRID_BAR() xcd_barrier(bar)
#else
#define GRID_BAR() do { } while (0)
#endif
#define SEAM(k) do { if (IN(k) && IN((k) + 1)) GRID_BAR(); } while (0)
#define CTX() Ctx{args.in, args.out, launder(args.ws)}
#ifndef PROBE_PHASE
#define PROBE_PHASE -1
#endif
#ifndef PROBE_MULT
#define PROBE_MULT 4
#endif
#define PB_BEGIN(j) do { if (PROBE_PHASE == (j)) { pstamp = __builtin_amdgcn_s_memrealtime(); } } while (0)
#define PB_END(j) do { if (PROBE_PHASE == (j)) { pacc += __builtin_amdgcn_s_memrealtime() - pstamp; } } while (0)
__device__ __forceinline__ void layer_phases(const int l, const Args& args, LAS unsigned char* lds, const int G, const int bx, const int vcu, const int lo, const int hi, const XcdBarrier& bar, unsigned long long& pacc) {
    unsigned long long pstamp = 0ull; (void)pstamp;

        const int pb = 1 + 11 * l;
        PB_BEGIN(0);
        if (PHSEL(0) && IN(pb + 0)) { GAS unsigned char* wsl = launder(args.ws);
            pg8::Gemm g{(const pg8::bf16_t*)(wsl + WS_HB), (const pg8::bf16_t*)(wsl + WS_WIN) + (size_t)l * NINP * 1024, TP, NINP, 1024};
            pg8::StaticOrder S; S.init(TP, NINP, G, bx);
            pg8::EpiStoreBf16 E{(pg8::bf16_t*)(wsl + WS_PROJ), NINP};
            pg8::gemm_phase<pg8::EpiStoreBf16, pg8::StaticOrder, true, true>(lds, g, S, E);
            SEAM(pb + 0); PB_END(0);
        }
        PB_BEGIN(1);
        if (PHSEL(1) && IN(pb + 1)) { prep_phase(CTX(), lds, l, vcu, G); SEAM(pb + 1); PB_END(1); }
        PB_BEGIN(2);
        if (PHSEL(2) && IN(pb + 2)) { chunk_prep_phase(CTX(), vcu, G); lru_agg_phase(CTX(), vcu, G); SEAM(pb + 2); PB_END(2); }
        PB_BEGIN(3);
        if (PHSEL(3) && IN(pb + 3)) {
#ifndef PH2_SEL
#define PH2_SEL 15
#endif
            PB_BEGIN(20); PB_BEGIN(21); PB_BEGIN(22); PB_BEGIN(23);
#if SCAN_SEQ
            if ((PH2_SEL & 1) && bx < 64) rwkv_scan(CTX(), lds, bx); else if ((PH2_SEL & 2) && bx >= 64 && bx < 128) hgrn_scan(CTX(), lds, bx - 64); else if ((PH2_SEL & 4) && bx >= 128 && bx < 132) lru_carry_phase(CTX(), 128);
#else
            if ((PH2_SEL & 1) && bx < 16) chunk_scan<true>(CTX(), lds, bx); else if ((PH2_SEL & 2) && bx >= 16 && bx < 32) chunk_scan<false>(CTX(), lds, bx - 16); else if ((PH2_SEL & 4) && bx >= 32 && bx < 36) lru_carry_phase(CTX(), 32);
#endif
            __syncthreads();
            PB_END(20); PB_END(21); PB_END(22);
#if DSA_NAIVE
            if (PH2_SEL & 8) dsa_phase(CTX(), lds, l);
#else
            if (PH2_SEL & 8) dsa_select_phase(CTX(), lds, l);
#endif
            __syncthreads();
            PB_END(23);
            SEAM(pb + 3); PB_END(3);
        }
        PB_BEGIN(4);
        if (PHSEL(4) && IN(pb + 4)) {
            PB_BEGIN(24);
            lru_out_phase(CTX(), vcu, G);
            mixers_finish(CTX(), l, vcu, G);
            __syncthreads(); PB_END(24);
#if !DSA_NAIVE
            dsa_attn_phase(CTX(), lds, l);
#endif
            SEAM(pb + 4); PB_END(4);
        }
        PB_BEGIN(5);
        if (PHSEL(5) && IN(pb + 5)) { GAS unsigned char* wsl = launder(args.ws);
            pg8::Gemm g{(const pg8::bf16_t*)(wsl + WS_MIX), (const pg8::bf16_t*)(wsl + WS_WOUT) + (size_t)l * 1024 * 1024, TP, 1024, 1024};
            pg8::StaticOrder S; S.init(TP, 1024, G, bx);
            pg8::EpiResidBf E{(pg8::bf16_t*)(wsl + WS_HB), 1024, ALPHA};
            pg8::gemm_phase<pg8::EpiResidBf, pg8::StaticOrder, true, true>(lds, g, S, E);
            SEAM(pb + 5); PB_END(5);
        }
        PB_BEGIN(6);
        if (PHSEL(6) && IN(pb + 6)) { ln_router_phase(CTX(), lds, l, vcu, G); SEAM(pb + 6); PB_END(6); }
        PB_BEGIN(7);
        if (PHSEL(7) && IN(pb + 7)) { moe_sort_phase(CTX(), lds, l); SEAM(pb + 7); PB_END(7); }
        PB_BEGIN(8);
        if (PHSEL(8) && IN(pb + 8)) { GAS unsigned char* wsl = launder(args.ws);
            const int nt = build_tiles(CTX(), lds, l);
            pg8::Gemm g{(const pg8::bf16_t*)(wsl + WS_HB), (const pg8::bf16_t*)(wsl + WS_W1) + (size_t)l * 32 * 2048 * 1024, RMAX, 32 * 2048, 1024};
            pg8::MoeOrder S{nt * 8, G, vcu, 8, (const LAS int*)(lds + MISC_OFF + MI_TILE)};
            pg8::EpiSwiGLU E{(pg8::bf16_t*)(wsl + WS_ACT), (const float*)(const GAS float*)args.in[31] + (size_t)l * 32 * 2048};
            pg8::gemm_phase_gather<pg8::EpiSwiGLU, pg8::MoeOrder>(lds, g, S, E, (const int*)(wsl + WS_RMAP));
            SEAM(pb + 8); PB_END(8);
        }
        PB_BEGIN(9);
        if (PHSEL(9) && IN(pb + 9)) { GAS unsigned char* wsl = launder(args.ws);
            const int nt = build_tiles(CTX(), lds, l);
            pg8::Gemm g{(const pg8::bf16_t*)(wsl + WS_ACT), (const pg8::bf16_t*)(wsl + WS_W2) + (size_t)l * 32 * 1024 * 1024, RMAX, 32 * 1024, 1024};
            pg8::MoeOrder S{nt * 4, G, vcu, 4, (const LAS int*)(lds + MISC_OFF + MI_TILE)};
            pg8::EpiMoeOut E{(pg8::bf16_t*)(wsl + WS_YBUF), (const float*)(const GAS float*)args.in[33] + (size_t)l * 32 * 1024, (const float*)(wsl + WS_GSORT)};
            pg8::gemm_phase<pg8::EpiMoeOut, pg8::MoeOrder, true, true>(lds, g, S, E);
            SEAM(pb + 9); PB_END(9);
        }
        PB_BEGIN(10);
        if (PHSEL(10) && IN(pb + 10)) { combine_ln_phase(CTX(), l, vcu, G); SEAM(pb + 10); PB_END(10); }
}
__global__ void __launch_bounds__(NTHR, 2) trunk_fwd(Args args) {
    extern __shared__ __attribute__((aligned(16))) unsigned char lds_raw[];
    LAS unsigned char* lds = (LAS unsigned char*)lds_raw;
    const int tid = threadIdx.x;
    const int G = gridDim.x; const int bx = blockIdx.x; const int vcu = (G % 8 == 0) ? (bx % 8) * (G / 8) + bx / 8 : bx;
    unsigned* ctl = (unsigned*)(args.ws + WS_CTL);
    for (int u = tid; u < (LDS_BYTES - MISC_OFF) / 4; u += NTHR) ((LAS unsigned*)(lds + MISC_OFF))[u] = 0u;
    __syncthreads();
#if MK_ONE_LAUNCH
    XcdBarrier bar = xcd_barrier_post(ctl + CW_BAR, (volatile LAS unsigned*)(lds + MISC_OFF + MI_BAR));
#else
    XcdBarrier bar; bar.bar = ctl + CW_BAR; bar.x = 0; bar.st = nullptr;
#endif
    const int lo = args.ph_lo, hi = args.ph_hi;

    unsigned long long pacc = 0ull, pstamp = 0ull; (void)pstamp;
    PB_BEGIN(11);
    if (PHSEL(11) && IN(0)) { p0_prologue(CTX(), lds, vcu, G); SEAM(0); }
    PB_END(11);

#pragma unroll 1
    for (int l = 0; l < 2; ++l) layer_phases(l, args, lds, G, bx, vcu, lo, hi, bar, pacc);
    if (PROBE_PHASE >= 0 && bx == (PROBE_PHASE == 21 ? 16 : PROBE_PHASE == 22 ? 32 : PROBE_PHASE == 23 ? 255 : 0)) { const unsigned long long t0 = __builtin_amdgcn_s_memrealtime(); while (__builtin_amdgcn_s_memrealtime() - t0 < pacc * PROBE_MULT) __builtin_amdgcn_s_sleep(8); }
#undef IN
#undef SEAM
}

extern "C" void kernel_launch(void* const* d_in, const int* in_sizes, int n_in, void* d_out, int out_size, void* d_ws, size_t ws_size, hipStream_t stream) {
    static int grid = 0;
    if (grid == 0) {
        if (n_in != 36 || in_sizes[0] != NB * SEQ * D || out_size != NB * SEQ * D || ws_size < WS_END) {
            fprintf(stderr, "kernel_launch: unexpected problem (n_in %d, in0 %d, out %d, ws %zu, need %zu); nothing launched\n", n_in, n_in > 0 ? in_sizes[0] : -1, out_size, ws_size, (size_t)WS_END); grid = -1; return; }
        int dev = 0, cus = 0, per_cu = 0;
        if (hipGetDevice(&dev) != hipSuccess || hipDeviceGetAttribute(&cus, hipDeviceAttributeMultiprocessorCount, dev) != hipSuccess) { grid = -1; return; }
        if (hipFuncSetAttribute((const void*)trunk_fwd, hipFuncAttributeMaxDynamicSharedMemorySize, LDS_BYTES) != hipSuccess) { fprintf(stderr, "kernel_launch: hipFuncSetAttribute failed\n"); grid = -1; return; }
        if (hipOccupancyMaxActiveBlocksPerMultiprocessor(&per_cu, (const void*)trunk_fwd, NTHR, LDS_BYTES) != hipSuccess || per_cu < 1) { fprintf(stderr, "kernel_launch: occupancy query says %d\n", per_cu); (void)hipGetLastError(); }
        grid = cus;
        if (grid < 160 || grid > 512) { fprintf(stderr, "kernel_launch: unsupported CU count %d\n", cus); grid = -1; return; }
    }
    if (grid < 0) return;
    if (hipMemsetAsync((char*)d_ws + WS_CTL, 0, CTL_ZERO_BYTES, stream) != hipSuccess) return;
    Args a; memset(&a, 0, sizeof(a));
    for (int i = 0; i < 36; ++i) a.in[i] = (const float*)d_in[i];
    a.out = (float*)d_out; a.ws = (unsigned char*)d_ws;
#if MK_ONE_LAUNCH
    a.ph_lo = 0; a.ph_hi = N_PHASES;
    hipLaunchKernelGGL(trunk_fwd, dim3(grid), dim3(NTHR), LDS_BYTES, stream, a);
#else
    for (int p = 0; p < N_PHASES; ++p) { a.ph_lo = p; a.ph_hi = p + 1; hipLaunchKernelGGL(trunk_fwd, dim3(grid), dim3(NTHR), LDS_BYTES, stream, a); }
#endif
}
```

```cpp
#include <hip/hip_runtime.h>
#include <cstdio>
#include <cstdint>
#include <cstring>

#ifndef MK_ONE_LAUNCH
#define MK_ONE_LAUNCH 1
#endif

#ifndef SCAN_SEQ
#define SCAN_SEQ 0
#endif
#ifndef SCAN_MIX
#define SCAN_MIX 0
#endif
#ifndef DSA_NAIVE
#define DSA_NAIVE 0
#endif
#ifndef PHASE_FN
#define PHASE_FN __forceinline__
#endif
#define GAS __attribute__((address_space(1)))
#define LAS __attribute__((address_space(3)))
typedef unsigned short bf16;
typedef unsigned v4u __attribute__((ext_vector_type(4)));
typedef unsigned v2u __attribute__((ext_vector_type(2)));
typedef float v4f __attribute__((ext_vector_type(4)));
typedef float v2f __attribute__((ext_vector_type(2)));

constexpr int NB = 8, SEQ = 8192, NMETA = 16, L = SEQ + NMETA  , T = NB * L  , TP = 65792  , D = 1024;
constexpr int NINP = 3584;
constexpr int NE = 32, TOPK = 4;
constexpr int RMAX = 1058 * 256;
constexpr int C_RW = 0, C_RW_R = 0, C_RW_WD = 256, C_RW_K = 320, C_RW_V = 576, C_RW_AD = 832, C_RW_GD = 896;
constexpr int C_DS_Q = 960, C_DS_K = 1216, C_DS_V = 1472, C_DS_QI = 1728, C_DS_KI = 1984, C_DS_WI = 2016;
constexpr int C_LR_X = 2024, C_LR_G = 2280;
constexpr int C_HG_Q = 2536, C_HG_F = 2792, C_HG_I = 3048, C_HG_G = 3304;
constexpr float ALPHA = 1.41421356237f;
constexpr float LN_EPS = 1e-5f;

constexpr size_t MiB = 1u << 20;
constexpr size_t WS_CTL = 0, CTL_ZERO_BYTES = 1 * MiB;
constexpr size_t WS_WIN = 2 * MiB;
constexpr size_t WS_WOUT = 16 * MiB;
constexpr size_t WS_W1 = 20 * MiB;
constexpr size_t WS_W2 = 276 * MiB;
constexpr size_t WS_H = 404 * MiB;
constexpr size_t WS_MIX = WS_H;
constexpr size_t WS_HB = 661 * MiB;
constexpr size_t WS_BIG = 790 * MiB;
constexpr size_t WS_PROJ = WS_BIG;
constexpr size_t SZ_HM32 = (size_t)32 * L * 64 * 4;
constexpr size_t SZ_HM16 = SZ_HM32 / 2;
constexpr size_t SZ_TM16 = (size_t)T * 256 * 2;
constexpr size_t WS_RW_W = 1240 * MiB;
constexpr size_t WS_RW_A = WS_RW_W + SZ_HM32, WS_RW_B = WS_RW_A + SZ_HM16, WS_RW_K = WS_RW_B + SZ_HM16, WS_RW_WR = WS_RW_K + SZ_HM16, WS_RW_V = WS_RW_WR + SZ_HM16;
constexpr size_t WS_RW_G = WS_RW_V + SZ_HM16;
constexpr size_t WS_RW_SC = WS_RW_G + SZ_TM16;
constexpr size_t WS_DS_Q = WS_RW_SC + (size_t)32 * L * 16;
constexpr size_t WS_DS_K = WS_DS_Q + SZ_TM16, WS_DS_V = WS_DS_K + SZ_TM16, WS_DS_QI = WS_DS_V + SZ_TM16;
constexpr size_t WS_DS_KI = WS_DS_QI + SZ_TM16;
constexpr size_t WS_DS_WI = WS_DS_KI + (size_t)T * 64;
constexpr size_t WS_LR_A = WS_DS_WI + (size_t)T * 32;
constexpr size_t WS_LR_U = WS_LR_A + (size_t)T * 1024, WS_LR_G = WS_LR_U + SZ_TM16;
constexpr size_t WS_HG_F = WS_LR_G + SZ_TM16;
constexpr size_t WS_HG_K = WS_HG_F + SZ_HM32, WS_HG_Q = WS_HG_K + SZ_HM16, WS_HG_V = WS_HG_Q + SZ_HM16, WS_HG_G = WS_HG_V + SZ_HM16;
constexpr size_t WS_MIX_END = WS_HG_G + SZ_TM16;
constexpr size_t SZ_SORT = (size_t)RMAX * 1024 * 2;
constexpr size_t WS_SORTA = WS_BIG, WS_YBUF = WS_BIG, WS_ACT = WS_BIG + SZ_SORT;
constexpr size_t WS_TIDX = WS_ACT + SZ_SORT;
constexpr size_t WS_TGATE = WS_TIDX + (size_t)T * 16;
constexpr size_t WS_SPOS = WS_TGATE + (size_t)T * 16;
constexpr size_t WS_GSORT = WS_SPOS + (size_t)T * 16;
constexpr size_t WS_RMAP = WS_GSORT + (size_t)RMAX * 4;
constexpr size_t WS_MOE_END = WS_RMAP + (size_t)RMAX * 4;
constexpr size_t WS_END = 2040 * MiB;
static_assert(WS_MIX_END <= WS_END && WS_MOE_END <= WS_END, "workspace map");
static_assert(WS_PROJ + (size_t)TP * NINP * 2 <= WS_RW_W, "proj vs prep");
static_assert(WS_HB + (size_t)TP * 1024 * 2 <= WS_BIG && WS_H + (size_t)TP * 4096 <= WS_HB, "h/hb");

constexpr int CW_TMO = 0, CW_CODE = 1;
constexpr int CW_BAR = 4096;
constexpr int CW_DSAQ = 8192;
constexpr int CW_ECNT = 8448;
constexpr int CW_ECUR = 8704;

constexpr int LDS_BYTES = 163840;
constexpr int MISC_OFF = 155648;
constexpr int MI_BAR = 0, MI_HIST = 64, MI_LCUR = 192, MI_LBASE = 320, MI_NT = 448, MI_OFFS = 512, MI_TILE = 1024;
constexpr int NWAVES = 8, NTHR = 512;

__device__ __forceinline__ float bf2f(unsigned short x) { return __uint_as_float((unsigned)x << 16); }
__device__ __forceinline__ float bflo(unsigned x) { return __uint_as_float(x << 16); }
__device__ __forceinline__ float bfhi(unsigned x) { return __uint_as_float(x & 0xffff0000u); }
typedef float f32x2_t __attribute__((ext_vector_type(2))); typedef __bf16 bf16x2_t __attribute__((ext_vector_type(2)));
__device__ __forceinline__ unsigned pk2(float lo, float hi) { const f32x2_t v = {lo, hi}; const bf16x2_t b = __builtin_convertvector(v, bf16x2_t); return __builtin_bit_cast(unsigned, b); }
__device__ __forceinline__ bf16 f2bf(float f) { return (bf16)(pk2(f, 0.f) & 0xffffu); }
__device__ __forceinline__ v4f ld_bf4(const bf16* p) { const v2u x = *(const v2u*)p; return (v4f){bflo(x.x), bfhi(x.x), bflo(x.y), bfhi(x.y)}; }
__device__ __forceinline__ void st_bf4(bf16* p, v4f v) { v2u o; o.x = pk2(v.x, v.y); o.y = pk2(v.z, v.w); *(v2u*)p = o; }
__device__ __forceinline__ float wave_max(float v) {
#pragma unroll
    for (int o = 1; o < 64; o <<= 1) v = fmaxf(v, __shfl_xor(v, o));
    return v;
}
template <int CTRL> __device__ __forceinline__ float dpp_f(float x) { return __int_as_float(__builtin_amdgcn_update_dpp(0, __float_as_int(x), CTRL, 0xF, 0xF, true)); }
__device__ __forceinline__ float sum8(float x) { x += dpp_f<0xB1>(x); x += dpp_f<0x4E>(x); x += dpp_f<0x141>(x); return x; }
__device__ __forceinline__ float sum16(float x) { x = sum8(x); x += dpp_f<0x140>(x); return x; }
__device__ __forceinline__ float wave_sum(float v) {
    v = sum16(v);
    v += __shfl_xor(v, 16); v += __shfl_xor(v, 32);
    return v;
}
__device__ __forceinline__ float rcp_(float x) { return __builtin_amdgcn_rcpf(x); }
__device__ __forceinline__ float rsq_(float x) { return __builtin_amdgcn_rsqf(x); }
__device__ __forceinline__ float sigmoidf_(float x) { return rcp_(1.f + __expf(-x)); }
__device__ __forceinline__ float softplusf_(float x) { return x > 20.f ? x : log1pf(__expf(x)); }
__device__ __forceinline__ float gelu_tanh(float x) { const float u = 0.7978845608028654f * (x + 0.044715f * x * x * x); return 0.5f * x * (1.f + tanhf(u)); }
__device__ __forceinline__ int lds_add(LAS int* p, int v) { return __hip_atomic_fetch_add(p, v, __ATOMIC_RELAXED, __HIP_MEMORY_SCOPE_WORKGROUP); }
#define LDS_WAIT() asm volatile("s_waitcnt lgkmcnt(0)" ::: "memory")
#define VM_WAIT() asm volatile("s_waitcnt vmcnt(0)" ::: "memory")

__device__ __forceinline__ GAS unsigned char* launder(unsigned char* p) { GAS unsigned char* g = (GAS unsigned char*)p; asm volatile("" : "+s"(g)); return g; }
__device__ __forceinline__ int opaque_tid() { int t = (int)threadIdx.x; asm volatile("" : "+v"(t)); return t; }
__device__ __forceinline__ int opaque_s(int x) { return __builtin_amdgcn_readfirstlane(x); }
struct Args { const float* in[36]; float* out; unsigned char* ws; int ph_lo, ph_hi; };
struct Ctx { const float* const* in; float* out; GAS unsigned char* ws; };
__device__ __forceinline__ const float* gin(const Ctx& A, int k) { return (const float*)(const GAS float*)A.in[k]; }
namespace pg8 {
#define PG8_LAS __attribute__((address_space(3)))
typedef unsigned short bf16_t;
typedef short bf16x8 __attribute__((ext_vector_type(8)));
typedef float f32x4 __attribute__((ext_vector_type(4)));
typedef unsigned u32x4 __attribute__((ext_vector_type(4)));
constexpr int BM = 256, BK = 64, HALF = 128, HTB = HALF * BK * 2  , STAGE_BYTES = 8 * HTB, NXCD = 8, WGM = 8;

__host__ __device__ __forceinline__ int lds_byte(int r, int c) { const int st = (r >> 4) * 2 + (c >> 5), rr = r & 15, cc = c & 31, ob = rr * 64 + cc * 2; return st * 1024 + (ob ^ (((ob >> 9) & 1) << 5)); }
__host__ __device__ __forceinline__ void stage_rc(int b, int& R, int& C) { const int st = b / 1024, sb = b % 1024, swz = sb ^ (((sb >> 9) & 1) << 5); R = (st >> 1) * 16 + swz / 64; C = (st & 1) * 32 + (swz % 64) / 2; }
__host__ __device__ __forceinline__ int perm32(int rho) { const int n = rho >> 4, i = rho & 15; return 8 * (i >> 2) + 4 * n + (i & 3); }

struct Unit { int pm, pn; };
struct Gemm { const bf16_t* A; const bf16_t* Bt; int M, N, K; };

struct StaticOrder {
    int nM, nN, nwg, G, c;
    __host__ __device__ void init(int M, int N, int G_, int c_) { nM = M / BM; nN = N / BM; nwg = nM * nN; G = G_; c = c_; }
    __host__ __device__ bool next(int i, Unit& u) const {
        const long L = (long)i * G + c; if (L >= nwg) return false;
        int wgid = (int)L; { const int q = nwg / NXCD, r = nwg % NXCD, xcd = wgid % NXCD, off = wgid / NXCD; wgid = (xcd < r ? xcd * (q + 1) : r * (q + 1) + (xcd - r) * q) + off; }
        const int nig = WGM * nN, gid = wgid / nig, fm = gid * WGM, gsz = (nM - fm) < WGM ? (nM - fm) : WGM;
        u.pm = fm + ((wgid % nig) % gsz); u.pn = (wgid % nig) / gsz; return true;
    }
    __device__ __forceinline__ void a_ready(const Unit&) const {}
    __device__ __forceinline__ void done(const Unit&) const {}
};

__device__ __forceinline__ unsigned cvt_pk_bf16(float lo, float hi) { unsigned r; asm volatile("v_cvt_pk_bf16_f32 %0, %1, %2" : "=v"(r) : "v"(lo), "v"(hi)); return r; }
typedef float f32x2 __attribute__((ext_vector_type(2)));
typedef unsigned u32x2v __attribute__((ext_vector_type(2)));
typedef float pf32x2_t __attribute__((ext_vector_type(2))); typedef __bf16 pbf16x2_t __attribute__((ext_vector_type(2)));
__device__ __forceinline__ unsigned cvt_pk_bf16c(float lo, float hi) { const pf32x2_t v = {lo, hi}; const pbf16x2_t q = __builtin_convertvector(v, pbf16x2_t); return __builtin_bit_cast(unsigned, q); }
struct EpiStoreBf16 {
    static constexpr bool PERM = true, AFTER_DRAIN = false;
    bf16_t* O; int ldc;
    __device__ __forceinline__ void operator()(const f32x4 (&acc)[2][2][4][2], const Unit& u, int wr, int wc, int fr, int fq) const {
        const int row0 = u.pm * BM + wr * 64 + fr, col0 = u.pn * BM + wc * 32 + 8 * fq;
#pragma unroll
        for (int ai = 0; ai < 2; ++ai)
#pragma unroll
            for (int m = 0; m < 4; ++m) { bf16_t* rowp = O + (size_t)(row0 + ai * HALF + m * 16) * ldc + col0;
#pragma unroll
                for (int bj = 0; bj < 2; ++bj) { const f32x4 v0 = acc[ai][bj][m][0], v1 = acc[ai][bj][m][1];
                    u32x4 w; w.x = cvt_pk_bf16c(v0[0], v0[1]); w.y = cvt_pk_bf16c(v0[2], v0[3]); w.z = cvt_pk_bf16c(v1[0], v1[1]); w.w = cvt_pk_bf16c(v1[2], v1[3]);
                    *(u32x4*)(rowp + bj * HALF) = w; } }
    }
};
struct EpiResid {
    static constexpr bool PERM = false, AFTER_DRAIN = false;
    float* Hres; int ldc; float alpha;
    __device__ __forceinline__ void operator()(const f32x4 (&acc)[2][2][4][2], const Unit& u, int wr, int wc, int fr, int fq) const {
        const int row0 = u.pm * BM + wr * 64 + fr, col0 = u.pn * BM + wc * 32 + 4 * fq;
#pragma unroll
        for (int ai = 0; ai < 2; ++ai)
#pragma unroll
            for (int m = 0; m < 4; ++m) { float* rowp = Hres + (size_t)(row0 + ai * HALF + m * 16) * ldc + col0;
#pragma unroll
                for (int bj = 0; bj < 2; ++bj)
#pragma unroll
                    for (int n = 0; n < 2; ++n) { f32x4* p = (f32x4*)(rowp + bj * HALF + n * 16); const f32x4 old = *p; *p = old * alpha + acc[ai][bj][m][n]; } }
    }
};
struct EpiResidBf {
    static constexpr bool PERM = true, AFTER_DRAIN = false;
    bf16_t* Hb; int ldc; float alpha;
    __device__ __forceinline__ void operator()(const f32x4 (&acc)[2][2][4][2], const Unit& u, int wr, int wc, int fr, int fq) const {
        const int row0 = u.pm * BM + wr * 64 + fr, col0 = u.pn * BM + wc * 32 + 8 * fq;
#pragma unroll
        for (int ai = 0; ai < 2; ++ai)
#pragma unroll
            for (int m = 0; m < 4; ++m) { bf16_t* rowp = Hb + (size_t)(row0 + ai * HALF + m * 16) * ldc + col0;
#pragma unroll
                for (int bj = 0; bj < 2; ++bj) { const f32x4 v0 = acc[ai][bj][m][0], v1 = acc[ai][bj][m][1]; const u32x4 o = *(const u32x4*)(rowp + bj * HALF);
#define RB_LO(x_) __builtin_bit_cast(float, (x_) << 16)
#define RB_HI(x_) __builtin_bit_cast(float, (x_) & 0xffff0000u)
                    u32x4 w; w.x = cvt_pk_bf16c(RB_LO(o.x) * alpha + v0[0], RB_HI(o.x) * alpha + v0[1]); w.y = cvt_pk_bf16c(RB_LO(o.y) * alpha + v0[2], RB_HI(o.y) * alpha + v0[3]);
                    w.z = cvt_pk_bf16c(RB_LO(o.z) * alpha + v1[0], RB_HI(o.z) * alpha + v1[1]); w.w = cvt_pk_bf16c(RB_LO(o.w) * alpha + v1[2], RB_HI(o.w) * alpha + v1[3]);
#undef RB_LO
#undef RB_HI
                    *(u32x4*)(rowp + bj * HALF) = w; } }
    }
};
struct EpiSwiGLU {
    static constexpr bool PERM = true, AFTER_DRAIN = false;
    bf16_t* ACT; const float* b1;
    __device__ __forceinline__ void operator()(const f32x4 (&acc)[2][2][4][2], const Unit& u, int wr, int wc, int fr, int fq) const {
        const int e = u.pn >> 3, pnl = u.pn & 7;
        const int row0 = u.pm * BM + wr * 64 + fr, c8 = pnl * 128 + wc * 32 + 8 * fq;
        const float* bg = b1 + (size_t)e * 2048 + c8; const float* bl = bg + 1024;
        const f32x4 bg0 = *(const f32x4*)bg, bg1 = *(const f32x4*)(bg + 4), bl0 = *(const f32x4*)bl, bl1 = *(const f32x4*)(bl + 4);
#pragma unroll
        for (int ai = 0; ai < 2; ++ai)
#pragma unroll
            for (int m = 0; m < 4; ++m) {
                float o[8];
#pragma unroll
                for (int n = 0; n < 2; ++n) { const f32x4 g4 = acc[ai][0][m][n] + (n ? bg1 : bg0), l4 = acc[ai][1][m][n] + (n ? bl1 : bl0);
#pragma unroll
                    for (int j = 0; j < 4; ++j) { const float glu = fminf(g4[j], 7.f), lin = fminf(fmaxf(l4[j], -7.f), 7.f);
                        o[n * 4 + j] = glu * __builtin_amdgcn_rcpf(1.f + __builtin_amdgcn_exp2f(glu * (-1.702f * 1.4426950408889634f))) * (lin + 1.f); } }
                u32x4 w; w.x = cvt_pk_bf16c(o[0], o[1]); w.y = cvt_pk_bf16c(o[2], o[3]); w.z = cvt_pk_bf16c(o[4], o[5]); w.w = cvt_pk_bf16c(o[6], o[7]);
                *(u32x4*)(ACT + (size_t)(row0 + ai * HALF + m * 16) * 1024 + c8) = w; }
    }
};
struct EpiMoeOut {
    static constexpr bool PERM = true, AFTER_DRAIN = false;
    bf16_t* Y; const float* b2; const float* gate;
    __device__ __forceinline__ void operator()(const f32x4 (&acc)[2][2][4][2], const Unit& u, int wr, int wc, int fr, int fq) const {
        const int e = u.pn >> 2, pnl = u.pn & 3;
        const int row0 = u.pm * BM + wr * 64 + fr, c8 = pnl * 256 + wc * 32 + 8 * fq;
        const float* bb = b2 + (size_t)e * 1024 + c8;
        f32x4 bv[2][2];
#pragma unroll
        for (int bj = 0; bj < 2; ++bj) { bv[bj][0] = *(const f32x4*)(bb + bj * HALF); bv[bj][1] = *(const f32x4*)(bb + bj * HALF + 4); }
#pragma unroll
        for (int ai = 0; ai < 2; ++ai)
#pragma unroll
            for (int m = 0; m < 4; ++m) { const int row = row0 + ai * HALF + m * 16; const float gt = gate[row];
#pragma unroll
                for (int bj = 0; bj < 2; ++bj) { const f32x4 v0 = (acc[ai][bj][m][0] + bv[bj][0]) * gt, v1 = (acc[ai][bj][m][1] + bv[bj][1]) * gt;
                    u32x4 w; w.x = cvt_pk_bf16c(v0[0], v0[1]); w.y = cvt_pk_bf16c(v0[2], v0[3]); w.z = cvt_pk_bf16c(v1[0], v1[1]); w.w = cvt_pk_bf16c(v1[2], v1[3]);
                    *(u32x4*)(Y + (size_t)row * 1024 + c8 + bj * HALF) = w; } }
    }
};
struct MoeOrder {
    int n_units, G, c, npn; const PG8_LAS int* tile_e;
    __device__ __forceinline__ bool next(int i, Unit& u) const {
        const int Lx = i * G + c; if (Lx >= n_units) return false;
        const int tile = Lx / npn, pnl = Lx - tile * npn;
        u.pm = tile; u.pn = tile_e[tile] * npn + pnl; return true;
    }
    __device__ __forceinline__ void a_ready(const Unit&) const {}
    __device__ __forceinline__ void done(const Unit&) const {}
};

template <class Epi, class Sched, bool ALIGN_EPI = false, bool SP2 = false>
__device__ __forceinline__ void gemm_phase(PG8_LAS unsigned char* lds, const Gemm g, const Sched& S, const Epi& E) {
    const int tid = opaque_tid(), wid = __builtin_amdgcn_readfirstlane(tid >> 6), lane = tid & 63, wr = wid >> 2, wc = wid & 3, fr = lane & 15, fq = lane >> 4;
    const int K = g.K, nt = K / BK;
    unsigned voffA[2], voffB[2];
#pragma unroll
    for (int i = 0; i < 2; ++i) { int R, C; stage_rc(tid * 16 + i * 8192, R, C); const int Rb = Epi::PERM ? ((R & ~31) + perm32(R & 31)) : R;
        voffA[i] = (unsigned)(R * K + C) * 2u; voffB[i] = (unsigned)(Rb * K + C) * 2u; }
    const size_t kstep = (size_t)(BK * 2);
    const size_t hstep = (size_t)HALF * K * 2;
    const size_t tstep = 2 * hstep;
    const unsigned ldsw = (unsigned)wid * 1024u;
    const int aoff = lds_byte(wr * 64 + fr, fq * 8), boff = lds_byte(wc * 32 + fr, fq * 8);
#define PG8_SA(b, h) (((b) * 2 + (h)) * HTB)
#define PG8_SB(b, h) ((4 + (b) * 2 + (h)) * HTB)
#define PG8_STAGE(bufoff, gbase, voff) do { _Pragma("unroll") for (int _i = 0; _i < 2; ++_i) \
        __builtin_amdgcn_global_load_lds((const unsigned*)((const char*)(gbase) + (voff)[_i]), (PG8_LAS unsigned*)(lds + (bufoff) + ldsw + _i * 8192), 16, 0, 0); } while (0)
#define PG8_LDA(dst, b, h) do { _Pragma("unroll") for (int m = 0; m < 4; ++m) _Pragma("unroll") for (int k = 0; k < 2; ++k) dst[m][k] = *(const PG8_LAS bf16x8*)(lds + PG8_SA(b, h) + aoff + m * 2048 + k * 1024); } while (0)
#define PG8_LDB(dst, b, h) do { _Pragma("unroll") for (int n = 0; n < 2; ++n) _Pragma("unroll") for (int k = 0; k < 2; ++k) dst[n][k] = *(const PG8_LAS bf16x8*)(lds + PG8_SB(b, h) + boff + n * 2048 + k * 1024); } while (0)
#define PG8_MMA(ai, bj, At, Bt) do { __builtin_amdgcn_s_setprio(1); _Pragma("unroll") for (int m = 0; m < 4; ++m) _Pragma("unroll") for (int n = 0; n < 2; ++n) _Pragma("unroll") for (int k = 0; k < 2; ++k) \
        acc[ai][bj][m][n] = __builtin_amdgcn_mfma_f32_16x16x32_bf16(Bt[n][k], At[m][k], acc[ai][bj][m][n], 0, 0, 0); __builtin_amdgcn_s_setprio(0); } while (0)
#define PG8_WAIT_V(n) asm volatile("s_waitcnt vmcnt(" #n ")" ::: "memory")
#define PG8_WAIT_L(n) asm volatile("s_waitcnt lgkmcnt(" #n ")" ::: "memory")
#define PG8_BAR __builtin_amdgcn_s_barrier()
#define PG8_SCHED __builtin_amdgcn_sched_barrier(0)
    Unit cur, nxt; int ui = 0;
    if (!S.next(0, cur)) return;
    f32x4 acc[2][2][4][2];
#pragma unroll
    for (int a = 0; a < 2; ++a)
#pragma unroll
        for (int b = 0; b < 2; ++b)
#pragma unroll
            for (int m = 0; m < 4; ++m)
#pragma unroll
                for (int n = 0; n < 2; ++n) acc[a][b][m][n] = (f32x4){0.f, 0.f, 0.f, 0.f};
    bf16x8 At[4][2], B0[2][2], B1[2][2];
    const char* cA = (const char*)g.A + (size_t)cur.pm * tstep; const char* cB = (const char*)g.Bt + (size_t)cur.pn * tstep;
    S.a_ready(cur);
    if constexpr (SP2) {
        PG8_STAGE(PG8_SB(0, 0), cB, voffB); PG8_STAGE(PG8_SB(0, 1), cB + hstep, voffB); PG8_STAGE(PG8_SA(0, 0), cA, voffA); PG8_STAGE(PG8_SA(0, 1), cA + hstep, voffA);
        if (wr == 1) PG8_BAR;
        PG8_WAIT_V(2); PG8_BAR;
        PG8_STAGE(PG8_SB(1, 0), cB + kstep, voffB); PG8_STAGE(PG8_SA(1, 0), cA + kstep, voffA); PG8_STAGE(PG8_SB(1, 1), cB + hstep + kstep, voffB);
        PG8_WAIT_V(6); PG8_BAR;
    } else {
        PG8_STAGE(PG8_SB(0, 0), cB, voffB); PG8_STAGE(PG8_SA(0, 0), cA, voffA); PG8_STAGE(PG8_SB(0, 1), cB + hstep, voffB); PG8_STAGE(PG8_SA(0, 1), cA + hstep, voffA);
        if (wr == 1) PG8_BAR;
        PG8_WAIT_V(4); PG8_BAR;
        PG8_STAGE(PG8_SB(1, 0), cB + kstep, voffB); PG8_STAGE(PG8_SA(1, 0), cA + kstep, voffA); PG8_STAGE(PG8_SB(1, 1), cB + hstep + kstep, voffB);
        PG8_WAIT_V(6); PG8_BAR;
    }
    for (;;) {
        const bool has_next = S.next(ui + 1, nxt);
        const char* nA = has_next ? (const char*)g.A + (size_t)nxt.pm * tstep : cA; const char* nB = has_next ? (const char*)g.Bt + (size_t)nxt.pn * tstep : cB;
        for (int t = 0; t < nt; t += 2) {
            const bool last = (t == nt - 2);
            const char* a1 = cA + (size_t)(t + 1) * kstep;
            const char* a2 = last ? nA : cA + (size_t)(t + 2) * kstep; const char* b2 = last ? nB : cB + (size_t)(t + 2) * kstep;
            const char* a3 = a2 + kstep; const char* b3 = b2 + kstep;
            if (last && has_next) S.a_ready(nxt);
            if constexpr (SP2) {
            PG8_LDB(B0, 0, 0); PG8_LDB(B1, 0, 1); PG8_SCHED; PG8_LDA(At, 0, 0); PG8_STAGE(PG8_SA(1, 1), a1 + hstep, voffA);
            PG8_WAIT_V(8); PG8_WAIT_L(0); PG8_BAR; PG8_MMA(0, 0, At, B0); PG8_MMA(0, 1, At, B1); PG8_BAR; PG8_SCHED;
            PG8_LDA(At, 0, 1); PG8_STAGE(PG8_SB(0, 0), b2, voffB); PG8_STAGE(PG8_SB(0, 1), b2 + hstep, voffB); PG8_STAGE(PG8_SA(0, 0), a2, voffA);
            PG8_WAIT_V(8); PG8_WAIT_L(0); PG8_BAR; PG8_MMA(1, 0, At, B0); PG8_MMA(1, 1, At, B1); PG8_BAR; PG8_SCHED;
            PG8_LDB(B0, 1, 0); PG8_LDB(B1, 1, 1); PG8_SCHED; PG8_LDA(At, 1, 0); PG8_STAGE(PG8_SA(0, 1), a2 + hstep, voffA);
            PG8_WAIT_V(8); PG8_WAIT_L(0); PG8_BAR; PG8_MMA(0, 0, At, B0); PG8_MMA(0, 1, At, B1); PG8_BAR; PG8_SCHED;
            PG8_LDA(At, 1, 1); PG8_STAGE(PG8_SB(1, 0), b3, voffB); PG8_STAGE(PG8_SB(1, 1), b3 + hstep, voffB); PG8_STAGE(PG8_SA(1, 0), a3, voffA);
            PG8_WAIT_V(8); PG8_WAIT_L(0); PG8_BAR; PG8_MMA(1, 0, At, B0); PG8_MMA(1, 1, At, B1); PG8_BAR; PG8_SCHED;
            } else {
            PG8_LDB(B0, 0, 0); PG8_SCHED; PG8_LDA(At, 0, 0); PG8_STAGE(PG8_SA(1, 1), a1 + hstep, voffA);
            PG8_WAIT_L(8); PG8_BAR; PG8_WAIT_L(0); PG8_MMA(0, 0, At, B0); PG8_BAR; PG8_SCHED;
            PG8_LDB(B1, 0, 1); PG8_STAGE(PG8_SB(0, 0), b2, voffB);
            PG8_BAR; PG8_WAIT_L(0); PG8_MMA(0, 1, At, B1); PG8_BAR;
            PG8_LDA(At, 0, 1); PG8_STAGE(PG8_SA(0, 0), a2, voffA);
            PG8_BAR; PG8_WAIT_L(0); PG8_MMA(1, 0, At, B0); PG8_BAR; PG8_SCHED;
            PG8_STAGE(PG8_SB(0, 1), b2 + hstep, voffB);
            PG8_WAIT_V(6); PG8_BAR; PG8_MMA(1, 1, At, B1); PG8_BAR;
            PG8_LDB(B0, 1, 0); PG8_SCHED; PG8_LDA(At, 1, 0); PG8_STAGE(PG8_SA(0, 1), a2 + hstep, voffA);
            PG8_WAIT_L(8); PG8_BAR; PG8_WAIT_L(0); PG8_MMA(0, 0, At, B0); PG8_BAR; PG8_SCHED;
            PG8_LDB(B1, 1, 1); PG8_STAGE(PG8_SB(1, 0), b3, voffB);
            PG8_BAR; PG8_WAIT_L(0); PG8_MMA(0, 1, At, B1); PG8_BAR;
            PG8_LDA(At, 1, 1); PG8_STAGE(PG8_SA(1, 0), a3, voffA);
            PG8_BAR; PG8_WAIT_L(0); PG8_MMA(1, 0, At, B0); PG8_BAR; PG8_SCHED;
            PG8_STAGE(PG8_SB(1, 1), b3 + hstep, voffB);
            PG8_WAIT_V(6); PG8_BAR; PG8_MMA(1, 1, At, B1); PG8_BAR;
            }
        }
        if constexpr (ALIGN_EPI) { if (wr == 0) PG8_BAR; }
        if constexpr (!Epi::AFTER_DRAIN) { E(acc, cur, wr, wc, fr, fq); S.done(cur); }
        if (!has_next) break;
#pragma unroll
        for (int a = 0; a < 2; ++a)
#pragma unroll
            for (int b = 0; b < 2; ++b)
#pragma unroll
                for (int m = 0; m < 4; ++m)
#pragma unroll
                    for (int n = 0; n < 2; ++n) acc[a][b][m][n] = (f32x4){0.f, 0.f, 0.f, 0.f};
        cur = nxt; cA = nA; cB = nB; ++ui;
        if constexpr (ALIGN_EPI) { if (wr == 1) PG8_BAR; }
    }
    PG8_WAIT_V(0);
    if constexpr (!ALIGN_EPI) { if (wr == 0) PG8_BAR; }
    PG8_BAR;
    if constexpr (Epi::AFTER_DRAIN) { E.fused(acc, cur, wr, wc, fr, fq, lds, wid, lane); S.done(cur); }
#undef PG8_SA
#undef PG8_SB
#undef PG8_STAGE
#undef PG8_LDA
#undef PG8_LDB
#undef PG8_MMA
#undef PG8_WAIT_V
#undef PG8_WAIT_L
#undef PG8_BAR
#undef PG8_SCHED
}
}
namespace pg8 {
template <class Epi, class Sched>
__device__ __forceinline__ void gemm_phase_gather(PG8_LAS unsigned char* lds, const Gemm g, const Sched& S, const Epi& E, const int* rmap) {
    constexpr bool ALIGN_EPI = true, SP2 = true;
    const int tid = opaque_tid(), wid = __builtin_amdgcn_readfirstlane(tid >> 6), lane = tid & 63, wr = wid >> 2, wc = wid & 3, fr = lane & 15, fq = lane >> 4;
    const int K = g.K, nt = K / BK;
    unsigned voffB[2];
#pragma unroll
    for (int i = 0; i < 2; ++i) { int R, C; stage_rc(tid * 16 + i * 8192, R, C); const int Rb = Epi::PERM ? ((R & ~31) + perm32(R & 31)) : R;
        voffB[i] = (unsigned)(Rb * K + C) * 2u; }
    const size_t kstep = (size_t)(BK * 2);
    const size_t hstep = (size_t)HALF * K * 2;
    const size_t tstep = 2 * hstep;
    const unsigned ldsw = (unsigned)wid * 1024u;
    const int aoff = lds_byte(wr * 64 + fr, fq * 8), boff = lds_byte(wc * 32 + fr, fq * 8);
#define PG8_SA(b, h) (((b) * 2 + (h)) * HTB)
#define PG8_SB(b, h) ((4 + (b) * 2 + (h)) * HTB)
#define PG8_STAGE(bufoff, gbase, voff) do { _Pragma("unroll") for (int _i = 0; _i < 2; ++_i) \
        __builtin_amdgcn_global_load_lds((const unsigned*)((const char*)(gbase) + (voff)[_i]), (PG8_LAS unsigned*)(lds + (bufoff) + ldsw + _i * 8192), 16, 0, 0); } while (0)
#define PG8_LDA(dst, b, h) do { _Pragma("unroll") for (int m = 0; m < 4; ++m) _Pragma("unroll") for (int k = 0; k < 2; ++k) dst[m][k] = *(const PG8_LAS bf16x8*)(lds + PG8_SA(b, h) + aoff + m * 2048 + k * 1024); } while (0)
#define PG8_LDB(dst, b, h) do { _Pragma("unroll") for (int n = 0; n < 2; ++n) _Pragma("unroll") for (int k = 0; k < 2; ++k) dst[n][k] = *(const PG8_LAS bf16x8*)(lds + PG8_SB(b, h) + boff + n * 2048 + k * 1024); } while (0)
#define PG8_MMA(ai, bj, At, Bt) do { __builtin_amdgcn_s_setprio(1); _Pragma("unroll") for (int m = 0; m < 4; ++m) _Pragma("unroll") for (int n = 0; n < 2; ++n) _Pragma("unroll") for (int k = 0; k < 2; ++k) \
        acc[ai][bj][m][n] = __builtin_amdgcn_mfma_f32_16x16x32_bf16(Bt[n][k], At[m][k], acc[ai][bj][m][n], 0, 0, 0); __builtin_amdgcn_s_setprio(0); } while (0)
#define PG8_WAIT_V(n) asm volatile("s_waitcnt vmcnt(" #n ")" ::: "memory")
#define PG8_WAIT_L(n) asm volatile("s_waitcnt lgkmcnt(" #n ")" ::: "memory")
#define PG8_BAR __builtin_amdgcn_s_barrier()
#define PG8_SCHED __builtin_amdgcn_sched_barrier(0)
    Unit cur, nxt; int ui = 0;
    if (!S.next(0, cur)) return;
    f32x4 acc[2][2][4][2];
#pragma unroll
    for (int a = 0; a < 2; ++a)
#pragma unroll
        for (int b = 0; b < 2; ++b)
#pragma unroll
            for (int m = 0; m < 4; ++m)
#pragma unroll
                for (int n = 0; n < 2; ++n) acc[a][b][m][n] = (f32x4){0.f, 0.f, 0.f, 0.f};
    bf16x8 At[4][2], B0[2][2], B1[2][2];
    const char* gA = (const char*)g.A; const char* cB = (const char*)g.Bt + (size_t)cur.pn * tstep;
    unsigned gofc[2][2];
    constexpr int RM_OFF = 8 * HTB;
#pragma unroll
    for (int i_ = 0; i_ < 2; ++i_) { int R, C; stage_rc(tid * 16 + i_ * 8192, R, C);
#pragma unroll
        for (int h_ = 0; h_ < 2; ++h_) gofc[h_][i_] = (unsigned)rmap[(size_t)cur.pm * BM + h_ * HALF + R] * (unsigned)(K * 2) + (unsigned)C * 2u; }
    S.a_ready(cur);
    if constexpr (SP2) {
        PG8_STAGE(PG8_SB(0, 0), cB, voffB); PG8_STAGE(PG8_SB(0, 1), cB + hstep, voffB); PG8_STAGE(PG8_SA(0, 0), gA, gofc[0]); PG8_STAGE(PG8_SA(0, 1), gA, gofc[1]);
        if (wr == 1) PG8_BAR;
        PG8_WAIT_V(2); PG8_BAR;
        PG8_STAGE(PG8_SB(1, 0), cB + kstep, voffB); PG8_STAGE(PG8_SA(1, 0), gA + kstep, gofc[0]); PG8_STAGE(PG8_SB(1, 1), cB + hstep + kstep, voffB);
        PG8_WAIT_V(6); PG8_BAR;
    }
    for (;;) {
        const bool has_next = S.next(ui + 1, nxt);
        const char* nB = has_next ? (const char*)g.Bt + (size_t)nxt.pn * tstep : cB;
        if (has_next) { const unsigned rmoff = (unsigned)(opaque_tid() & 255) * 4u;
            __builtin_amdgcn_global_load_lds((const unsigned*)((const char*)(rmap + (size_t)nxt.pm * BM) + rmoff), (PG8_LAS unsigned*)(lds + RM_OFF + wid * 256), 4, 0, 0); }
        for (int t = 0; t < nt; t += 2) {
            const bool last = (t == nt - 2);
            const char* a1 = gA + (size_t)(t + 1) * kstep;
            const char* a2 = last ? gA : gA + (size_t)(t + 2) * kstep; const char* b2 = last ? nB : cB + (size_t)(t + 2) * kstep;
            const char* a3 = a2 + kstep; const char* b3 = b2 + kstep;
            if (last && has_next) S.a_ready(nxt);
            if constexpr (SP2) {
            PG8_LDB(B0, 0, 0); PG8_LDB(B1, 0, 1); PG8_SCHED; PG8_LDA(At, 0, 0); PG8_STAGE(PG8_SA(1, 1), a1, gofc[1]);
            PG8_WAIT_V(8); PG8_WAIT_L(0); PG8_BAR; PG8_MMA(0, 0, At, B0); PG8_MMA(0, 1, At, B1); PG8_BAR; PG8_SCHED;
            if (last && has_next) { const int tid2 = opaque_tid();
#pragma unroll
                for (int i_ = 0; i_ < 2; ++i_) { int R, C; stage_rc(tid2 * 16 + i_ * 8192, R, C);
#pragma unroll
                    for (int h_ = 0; h_ < 2; ++h_) gofc[h_][i_] = (unsigned)*(const PG8_LAS int*)(lds + RM_OFF + (h_ * HALF + R) * 4) * (unsigned)(K * 2) + (unsigned)C * 2u; }
                PG8_SCHED; }
            PG8_LDA(At, 0, 1); PG8_STAGE(PG8_SB(0, 0), b2, voffB); PG8_STAGE(PG8_SB(0, 1), b2 + hstep, voffB); PG8_STAGE(PG8_SA(0, 0), a2, gofc[0]);
            PG8_WAIT_V(8); PG8_WAIT_L(0); PG8_BAR; PG8_MMA(1, 0, At, B0); PG8_MMA(1, 1, At, B1); PG8_BAR; PG8_SCHED;
            PG8_LDB(B0, 1, 0); PG8_LDB(B1, 1, 1); PG8_SCHED; PG8_LDA(At, 1, 0); PG8_STAGE(PG8_SA(0, 1), a2, gofc[1]);
            PG8_WAIT_V(8); PG8_WAIT_L(0); PG8_BAR; PG8_MMA(0, 0, At, B0); PG8_MMA(0, 1, At, B1); PG8_BAR; PG8_SCHED;
            PG8_LDA(At, 1, 1); PG8_STAGE(PG8_SB(1, 0), b3, voffB); PG8_STAGE(PG8_SB(1, 1), b3 + hstep, voffB); PG8_STAGE(PG8_SA(1, 0), a3, gofc[0]);
            PG8_WAIT_V(8); PG8_WAIT_L(0); PG8_BAR; PG8_MMA(1, 0, At, B0); PG8_MMA(1, 1, At, B1); PG8_BAR; PG8_SCHED;
            }
        }
        if constexpr (ALIGN_EPI) { if (wr == 0) PG8_BAR; }
        if constexpr (!Epi::AFTER_DRAIN) { const int lane2 = opaque_tid() & 63; E(acc, cur, wr, wc, lane2 & 15, lane2 >> 4); S.done(cur); }
        if (!has_next) break;
#pragma unroll
        for (int a = 0; a < 2; ++a)
#pragma unroll
            for (int b = 0; b < 2; ++b)
#pragma unroll
                for (int m = 0; m < 4; ++m)
#pragma unroll
                    for (int n = 0; n < 2; ++n) acc[a][b][m][n] = (f32x4){0.f, 0.f, 0.f, 0.f};
        cur = nxt; cB = nB; ++ui;
        if constexpr (ALIGN_EPI) { if (wr == 1) PG8_BAR; }
    }
    PG8_WAIT_V(0);
    if constexpr (!ALIGN_EPI) { if (wr == 0) PG8_BAR; }
    PG8_BAR;
    if constexpr (Epi::AFTER_DRAIN) { E.fused(acc, cur, wr, wc, fr, fq, lds, wid, lane); S.done(cur); }
#undef PG8_SA
#undef PG8_SB
#undef PG8_STAGE
#undef PG8_LDA
#undef PG8_LDB
#undef PG8_MMA
#undef PG8_WAIT_V
#undef PG8_WAIT_L
#undef PG8_BAR
#undef PG8_SCHED
}
}
#define XB_TMO      128
#define XB_XCNT(j)  (256  + 64 * (j))
#define XB_XSUB(j)  (1280 + 64 * (j))
#define XB_XGEN(j)  (2304 + 64 * (j))
#define XB_TOP      3328
#define XB_TOPGEN   3392
#define XCD_BAR_WORDS 3456
#define XB_SPIN_CAP (1u << 18)
#define LAS __attribute__((address_space(3)))

__device__ __forceinline__ unsigned xb_ld(unsigned* p)              { return __hip_atomic_load(p, __ATOMIC_RELAXED, __HIP_MEMORY_SCOPE_AGENT); }
__device__ __forceinline__ unsigned xb_add(unsigned* p, unsigned v) { return __hip_atomic_fetch_add(p, v, __ATOMIC_RELAXED, __HIP_MEMORY_SCOPE_AGENT); }
__device__ __forceinline__ unsigned xb_xcc_id() { return (unsigned)__builtin_amdgcn_s_getreg((3 << 11) | 20) & 0xFu; }
#define XB_SPIN(cond, bar) do { unsigned _sp = 0; while (cond) { __builtin_amdgcn_s_sleep(1); \
    if ((++_sp & 255u) == 0u) { if (xb_ld(&(bar)[XB_TMO])) break; if (_sp > XB_SPIN_CAP) { atomicAdd(&(bar)[XB_TMO], 1u); break; } } } } while (0)

struct XcdBarrier {
    unsigned* bar; unsigned x;
    volatile LAS unsigned* st;
};

__device__ __forceinline__ XcdBarrier xcd_barrier_post(unsigned* bar, volatile LAS unsigned* st) {
    XcdBarrier b; b.bar = bar; b.x = xb_xcc_id(); b.st = st;
    if (threadIdx.x == 0) (void)xb_add(&bar[XB_XCNT(b.x)], 1u);
    return b;
}
__device__ __forceinline__ void xcd_barrier_complete(unsigned* bar, unsigned x, unsigned& nloc, unsigned& nx) {
    const unsigned G = gridDim.x * gridDim.y * gridDim.z;
    unsigned sum, cnt, mine, sp = 0u;
    for (;;) {
        sum = 0u; cnt = 0u; mine = 0u;
#pragma unroll
        for (unsigned j = 0; j < 16; ++j) { const unsigned c = xb_ld(&bar[XB_XCNT(j)]); sum += c; cnt += (c > 0u) ? 1u : 0u; mine = (j == x) ? c : mine; }
        if (sum == G) break;
        __builtin_amdgcn_s_sleep(1);
        if ((++sp & 255u) == 0u) { if (xb_ld(&bar[XB_TMO])) break; if (sp > XB_SPIN_CAP) { atomicAdd(&bar[XB_TMO], 1u); break; } }
    }
    nloc = mine > 0u ? mine : 1u; nx = cnt > 0u ? cnt : 1u;
}

__device__ __forceinline__ void xcd_barrier(const XcdBarrier& b) {
    asm volatile("s_waitcnt vmcnt(0)" ::: "memory");
    __syncthreads();
    if (threadIdx.x == 0) {
        unsigned* bar = b.bar;
        __builtin_amdgcn_s_waitcnt(0);
        unsigned nloc = b.st[0], nx = b.st[1];
        if (nloc == 0u) { xcd_barrier_complete(bar, b.x, nloc, nx); b.st[0] = nloc; b.st[1] = nx; }
        const unsigned old = xb_add(&bar[XB_XSUB(b.x)], 1u);
        const unsigned gen = old / nloc;
        if (old + 1u == (gen + 1u) * nloc) {
            __builtin_amdgcn_fence(__ATOMIC_RELEASE, "agent");
            asm volatile("s_waitcnt vmcnt(0)" ::: "memory");
            const unsigned og = xb_add(&bar[XB_TOP], 1u);
            const unsigned tg = og / nx;
            if (og + 1u == (tg + 1u) * nx) xb_add(&bar[XB_TOPGEN], 1u);
            else XB_SPIN(xb_ld(&bar[XB_TOPGEN]) == tg, bar);
            __builtin_amdgcn_fence(__ATOMIC_ACQUIRE, "agent");
            xb_add(&bar[XB_XGEN(b.x)], 1u);
            asm volatile("s_waitcnt vmcnt(0)" ::: "memory");
        } else {
            XB_SPIN(xb_ld(&bar[XB_XGEN(b.x)]) == gen, bar);
            __builtin_amdgcn_fence(__ATOMIC_ACQUIRE, "agent");
            asm volatile("s_waitcnt vmcnt(0)" ::: "memory");
        }
    }
    __syncthreads();
}
__device__ __forceinline__ void p0_transpose_item(const float* W, int ldw, int ncols_valid, int k0, int n0, bf16* WT, size_t dst_row0, int Kdst, LAS float* scr, int lane) {
    const int nn = n0 + (lane & 31); const bool ok = nn < ncols_valid;
#pragma unroll 8
    for (int i = 0; i < 32; ++i) { const int kk = 2 * i + (lane >> 5); scr[kk * 33 + (lane & 31)] = ok ? W[(size_t)(k0 + kk) * ldw + nn] : 0.f; }
    LDS_WAIT();
    const int c = lane & 7;
#pragma unroll
    for (int j = 0; j < 4; ++j) { const int n = (lane >> 3) + 8 * j; const LAS float* s = scr + (8 * c) * 33 + n;
        v4u o; o.x = pk2(s[0 * 33], s[1 * 33]); o.y = pk2(s[2 * 33], s[3 * 33]); o.z = pk2(s[4 * 33], s[5 * 33]); o.w = pk2(s[6 * 33], s[7 * 33]);
        *(v4u*)(WT + (dst_row0 + n) * (size_t)Kdst + k0 + 8 * c) = o; }
    LDS_WAIT();
}
__device__ __forceinline__ void ln_row(v4f (&v)[4], const float* g, const float* b, int lane) {
    float s = 0.f, s2 = 0.f;
#pragma unroll
    for (int j = 0; j < 4; ++j) { s += (v[j].x + v[j].y) + (v[j].z + v[j].w); s2 += (v[j].x * v[j].x + v[j].y * v[j].y) + (v[j].z * v[j].z + v[j].w * v[j].w); }
    s = wave_sum(s); s2 = wave_sum(s2);
    const float mean = s * (1.f / D);
    const float rstd = rsq_(fmaxf(s2 * (1.f / D) - mean * mean, 0.f) + LN_EPS);
#pragma unroll
    for (int j = 0; j < 4; ++j) v[j] = v[j] - mean;
#pragma unroll
    for (int j = 0; j < 4; ++j) { const v4f gg = *(const v4f*)(g + 256 * j + 4 * lane), bb = *(const v4f*)(b + 256 * j + 4 * lane); v[j] = v[j] * rstd * gg + bb; }
}
__device__ PHASE_FN void p0_prologue(const Ctx A, LAS unsigned char* lds, int vcu, int G) {
    const int tid = opaque_tid(), lane = tid & 63, wave = tid >> 6;
    LAS float* scr = (LAS float*)(lds + wave * 16384);
    const int gw = vcu * NWAVES + wave, NGW = G * NWAVES;
    bf16* Win_t = (bf16*)(A.ws + WS_WIN); bf16* Wout_t = (bf16*)(A.ws + WS_WOUT); bf16* W1_t = (bf16*)(A.ws + WS_W1); bf16* W2_t = (bf16*)(A.ws + WS_W2);
    constexpr int I_IN = 2 * 16 * (NINP / 32), I_OUT = 2 * 16 * 32, I_W1 = 64 * 16 * 64, I_W2 = 64 * 16 * 32;
    constexpr int NITEMS = I_IN + I_OUT + I_W1 + I_W2;
    for (int it = gw; it < NITEMS; it += NGW) {
        int r = it;
        if (r < I_IN) { const int l = r / (16 * 112), q = r % (16 * 112), kb = q / 112, nb = q % 112;
            p0_transpose_item(gin(A, 4) + (size_t)l * 1024 * 3560, 3560, 3560, kb * 64, nb * 32, Win_t + (size_t)l * NINP * 1024, (size_t)nb * 32, 1024, scr, lane); continue; }
        r -= I_IN;
        if (r < I_OUT) { const int l = r / 512, q = r % 512, kb = q / 32, nb = q % 32;
            p0_transpose_item(gin(A, 25) + (size_t)l * 1024 * 1024, 1024, 1024, kb * 64, nb * 32, Wout_t + (size_t)l * 1024 * 1024, (size_t)nb * 32, 1024, scr, lane); continue; }
        r -= I_OUT;
        if (r < I_W1) { const int le = r / 1024, q = r % 1024, kb = q / 64, nb = q % 64, n0 = nb * 32;
            const int np = n0 & 1023; const size_t drow = (size_t)256 * (np >> 7) + (n0 >= 1024 ? 128 : 0) + (np & 127);
            p0_transpose_item(gin(A, 30) + (size_t)le * 1024 * 2048, 2048, 2048, kb * 64, n0, W1_t + (size_t)le * 2048 * 1024, drow, 1024, scr, lane); continue; }
        r -= I_W1;
        { const int le = r / 512, q = r % 512, kb = q / 32, nb = q % 32;
            p0_transpose_item(gin(A, 32) + (size_t)le * 1024 * 1024, 1024, 1024, kb * 64, nb * 32, W2_t + (size_t)le * 1024 * 1024, (size_t)nb * 32, 1024, scr, lane); }
    }
    bf16* HB = (bf16*)(A.ws + WS_HB);
    for (int m = gw; m < T; m += NGW) {
        const int b = m / L, i = m - b * L;
        const float* src = (i < NMETA) ? gin(A, 1) + (size_t)i * D : gin(A, 0) + ((size_t)b * SEQ + (i - NMETA)) * D;
        v4f v[4];
#pragma unroll
        for (int j = 0; j < 4; ++j) v[j] = *(const v4f*)(src + 256 * j + 4 * lane);
        ln_row(v, gin(A, 2), gin(A, 3), lane);
#pragma unroll
        for (int j = 0; j < 4; ++j) st_bf4(HB + (size_t)m * D + 256 * j + 4 * lane, v[j]);
    }
}
constexpr int NTK = 2;
__device__ __forceinline__ float softplus_fast(float x) { return x > 15.f ? x : __logf(1.f + __expf(x)); }
__device__ __forceinline__ float tanh_fast(float x) { return 1.f - 2.f * rcp_(1.f + __expf(2.f * x)); }
__device__ __forceinline__ void sincos_red(float ang, float& sn, float& cs) {
    const float k = rintf(ang * 0.15915494309189535f);
    float r = fmaf(-k, 6.28318548202514648f, ang); r = fmaf(-k, -1.7484555e-7f, r);
    sn = __sinf(r); cs = __cosf(r);
}
constexpr int PREP_W = 98304, PREP_SCR = 4096;
__device__ __forceinline__ void prep_load_w(LAS unsigned char* lds, const float* src, int n, int dst_elem, int tid) {
    for (int i = tid * 4; i < n; i += NTHR * 4) { const v4f x = *(const v4f*)(src + i); v2u o; o.x = pk2(x.x, x.y); o.y = pk2(x.z, x.w); *(LAS v2u*)(lds + (size_t)(dst_elem + i) * 2) = o; }
}
__device__ PHASE_FN void prep_phase(const Ctx A, LAS unsigned char* lds, int l, int vcu, int G) {
    const int tid = opaque_tid(), lane = tid & 63, wave = tid >> 6;
    LAS float* scr = (LAS float*)(lds + PREP_W + wave * PREP_SCR);
    const int gw = vcu * NWAVES + wave, NGW = G * NWAVES;
    const bf16* PROJ = (const bf16*)(A.ws + WS_PROJ);
    const int c4 = 4 * lane, hh = lane >> 4, d4 = 4 * (lane & 15);
    const float* mu = gin(A, 5) + l * 960; const float* w0 = gin(A, 6) + l * 256; const float* w2 = gin(A, 7) + l * 64 * 256;
    const float* a0 = gin(A, 8) + l * 256; const float* a2 = gin(A, 9) + l * 64 * 256; const float* g2 = gin(A, 10) + l * 64 * 256;
    const float* k_k = gin(A, 11) + l * 256; const float* k_a = gin(A, 12) + l * 256; const float* r_k = gin(A, 13) + l * 256;
    const float* conv_w = gin(A, 16) + l * 4 * 256; const float* conv_b = gin(A, 17) + l * 256;
    const float* wa = gin(A, 18) + l * 4 * 64 * 64; const float* ba = gin(A, 19) + l * 256; const float* wx = gin(A, 20) + l * 4 * 64 * 64; const float* bx = gin(A, 21) + l * 256;
    const float* lam = gin(A, 22) + l * 256; const float* lbs = gin(A, 23);
    float* RW_W = (float*)(A.ws + WS_RW_W); bf16* RW_A = (bf16*)(A.ws + WS_RW_A); bf16* RW_B = (bf16*)(A.ws + WS_RW_B); bf16* RW_K = (bf16*)(A.ws + WS_RW_K);
    bf16* RW_WR = (bf16*)(A.ws + WS_RW_WR); bf16* RW_V = (bf16*)(A.ws + WS_RW_V); bf16* RW_G = (bf16*)(A.ws + WS_RW_G); float* RW_SC = (float*)(A.ws + WS_RW_SC);
    bf16* DS_Q = (bf16*)(A.ws + WS_DS_Q); bf16* DS_K = (bf16*)(A.ws + WS_DS_K); bf16* DS_V = (bf16*)(A.ws + WS_DS_V); bf16* DS_QI = (bf16*)(A.ws + WS_DS_QI);
    bf16* DS_KI = (bf16*)(A.ws + WS_DS_KI); float* DS_WI = (float*)(A.ws + WS_DS_WI);
    float* LR_A = (float*)(A.ws + WS_LR_A); bf16* LR_U = (bf16*)(A.ws + WS_LR_U); bf16* LR_G = (bf16*)(A.ws + WS_LR_G);
    float* HG_F = (float*)(A.ws + WS_HG_F); bf16* HG_K = (bf16*)(A.ws + WS_HG_K); bf16* HG_Q = (bf16*)(A.ws + WS_HG_Q); bf16* HG_V = (bf16*)(A.ws + WS_HG_V); bf16* HG_G = (bf16*)(A.ws + WS_HG_G);
    LAS unsigned* kmaxl = (LAS unsigned*)(lds + MISC_OFF + 640);
    LAS unsigned* kimaxl = (LAS unsigned*)(lds + MISC_OFF + 832);
    if (tid < 32) kmaxl[tid] = 0u;
    if (tid < 8) kimaxl[tid] = 0u;
    const bool q_rot = (lane & 15) < 4, q_hi = (lane & 15) >= 2;
    const bool i_rot = (lane & 7) < 2, i_hi = (lane & 7) == 1;

#define BF4R(q_) ((v4f){bflo((q_).x), bfhi((q_).x), bflo((q_).y), bfhi((q_).y)})
    {
        constexpr int RC_OFF = 98304;
        static_assert(RC_OFF + 8 * 1024 <= MISC_OFF, "pass R lds");
        for (int f = tid; f < 96 * 64; f += NTHR) { const int ln = f & 63, fr = f >> 6, ks = fr & 1, nt = (fr >> 1) & 15, mat = fr >> 5, rr = ln & 15, g8 = ln >> 4;
            const float* W = (mat == 0 ? w2 : mat == 1 ? a2 : g2) + (32 * ks + 8 * g8) * 256 + 64 * (nt >> 2) + 16 * (rr >> 2) + 4 * (nt & 3) + (rr & 3);
            v4u o; o.x = pk2(W[0], W[256]); o.y = pk2(W[512], W[768]); o.z = pk2(W[1024], W[1280]); o.w = pk2(W[1536], W[1792]);
            *(LAS v4u*)(lds + (size_t)fr * 1024 + ln * 16) = o; }
        LAS float* rc = (LAS float*)(lds + RC_OFF);
        if (tid < 256) { rc[tid] = mu[C_RW_R + tid]; rc[256 + tid] = mu[C_RW_K + tid]; rc[512 + tid] = mu[C_RW_V + tid]; rc[768 + tid] = w0[tid];
            rc[1024 + tid] = a0[tid]; rc[1280 + tid] = k_k[tid]; rc[1536 + tid] = k_a[tid]; rc[1792 + tid] = r_k[tid]; }
        __syncthreads();
        const int r = lane & 15, g = lane >> 4;
        const v4f z4 = (v4f){0.f, 0.f, 0.f, 0.f};
        auto r_tile = [&](const int tile, const int hd_lo, const int hd_hi) {
            const int m0 = tile * 16, b = m0 / L, i = m0 - b * L + r;
            const bf16* rowc = PROJ + (size_t)(m0 + r) * NINP;
            const bool hasp = i > 0; const bf16* rowp = hasp ? rowc - NINP : rowc;
            pg8::bf16x8 Bf[3][2];
#pragma unroll
            for (int mat = 0; mat < 3; ++mat)
#pragma unroll
                for (int ks = 0; ks < 2; ++ks) { const int off = (mat == 0 ? C_RW_WD : mat == 1 ? C_RW_AD : C_RW_GD) + 32 * ks + 8 * g;
                    const v4u cq = *(const v4u*)(rowc + off), pq = *(const v4u*)(rowp + off);
                    const v4f m0v = *(const v4f*)(mu + off), m1v = *(const v4f*)(mu + off + 4);
                    float o8[8];
#pragma unroll
                    for (int e = 0; e < 8; ++e) { const unsigned cw = cq[e >> 1], pw = pq[e >> 1];
                        const float cur = (e & 1) ? bfhi(cw) : bflo(cw), prv = hasp ? ((e & 1) ? bfhi(pw) : bflo(pw)) : 0.f;
                        const float sv = cur + (prv - cur) * (e < 4 ? m0v[e & 3] : m1v[e & 3]);
                        o8[e] = mat == 0 ? tanh_fast(sv) : mat == 1 ? sv : sigmoidf_(sv); }
                    v4u pk; pk.x = pk2(o8[0], o8[1]); pk.y = pk2(o8[2], o8[3]); pk.z = pk2(o8[4], o8[5]); pk.w = pk2(o8[6], o8[7]);
                    Bf[mat][ks] = __builtin_bit_cast(pg8::bf16x8, pk); }
#pragma unroll 1
            for (int hd = hd_lo; hd < hd_hi; ++hd) {
                pg8::f32x4 Cw[4], Ca[4], Cg[4];
#pragma unroll
                for (int nt = 0; nt < 4; ++nt) {
                    const LAS unsigned char* wf = lds + (size_t)((hd * 4 + nt) * 2) * 1024 + lane * 16;
                    pg8::f32x4 cw = (pg8::f32x4){0.f, 0.f, 0.f, 0.f}, ca = cw, cg = cw;
#pragma unroll
                    for (int ks = 0; ks < 2; ++ks) {
                        cw = __builtin_amdgcn_mfma_f32_16x16x32_bf16(*(const LAS pg8::bf16x8*)(wf + ks * 1024), Bf[0][ks], cw, 0, 0, 0);
                        ca = __builtin_amdgcn_mfma_f32_16x16x32_bf16(*(const LAS pg8::bf16x8*)(wf + 32768 + ks * 1024), Bf[1][ks], ca, 0, 0, 0);
                        cg = __builtin_amdgcn_mfma_f32_16x16x32_bf16(*(const LAS pg8::bf16x8*)(wf + 65536 + ks * 1024), Bf[2][ks], cg, 0, 0, 0); }
                    Cw[nt] = cw; Ca[nt] = ca; Cg[nt] = cg;
                }
                const size_t hrow = ((size_t)(b * 4 + hd) * L + i);
                v4f kun[4], kav_[4];
                float n2 = 0.f, sbr = 0.f, skr = 0.f, sbo = 0.f;
                const int cbh = hd * 64 + 16 * g;
                v4u Lr[2], Lk[2], Lv[2], Qr[2], Qk[2], Qv[2]; v2u oK[4], oWR[4], oV[4], oG[4];
#pragma unroll
                for (int h2 = 0; h2 < 2; ++h2) { Lr[h2] = *(const v4u*)(rowc + C_RW_R + cbh + 8 * h2); Lk[h2] = *(const v4u*)(rowc + C_RW_K + cbh + 8 * h2); Lv[h2] = *(const v4u*)(rowc + C_RW_V + cbh + 8 * h2);
                    Qr[h2] = *(const v4u*)(rowp + C_RW_R + cbh + 8 * h2); Qk[h2] = *(const v4u*)(rowp + C_RW_K + cbh + 8 * h2); Qv[h2] = *(const v4u*)(rowp + C_RW_V + cbh + 8 * h2); }
#define PREP_W4(V_, nt_) ((v4f){bflo(V_[(nt_) >> 1][2 * ((nt_) & 1)]), bfhi(V_[(nt_) >> 1][2 * ((nt_) & 1)]), bflo(V_[(nt_) >> 1][2 * ((nt_) & 1) + 1]), bfhi(V_[(nt_) >> 1][2 * ((nt_) & 1) + 1])})
#pragma unroll
                for (int nt = 0; nt < 4; ++nt) {
                    const int cc = cbh + 4 * nt, d4h = 16 * g + 4 * nt;
                    const v4f cr = PREP_W4(Lr, nt), ck = PREP_W4(Lk, nt), cv = PREP_W4(Lv, nt);
                    const v4f pr = hasp ? PREP_W4(Qr, nt) : z4, pk_ = hasp ? PREP_W4(Qk, nt) : z4, pv = hasp ? PREP_W4(Qv, nt) : z4;
                    const v4f mu_r = *(const LAS v4f*)(rc + cc), mu_k = *(const LAS v4f*)(rc + 256 + cc), mu_v = *(const LAS v4f*)(rc + 512 + cc), w0v = *(const LAS v4f*)(rc + 768 + cc);
                    const v4f a0v = *(const LAS v4f*)(rc + 1024 + cc), kkv = *(const LAS v4f*)(rc + 1280 + cc), kav = *(const LAS v4f*)(rc + 1536 + cc), rkv = *(const LAS v4f*)(rc + 1792 + cc);
                    const v4f rs = cr + (pr - cr) * mu_r, kx = ck + (pk_ - ck) * mu_k, vs = cv + (pv - cv) * mu_v;
                    v4f dec, km, wr, lg;
#pragma unroll
                    for (int e = 0; e < 4; ++e) {
                        const float wv = -softplus_fast(-(w0v[e] + Cw[nt][e])) - 0.5f;
                        dec[e] = __expf(-__expf(wv));
                        const float av = sigmoidf_(a0v[e] + Ca[nt][e]);
                        const float ku = kx[e] * kkv[e]; kun[nt][e] = ku; kav_[nt][e] = ku * av; n2 += ku * ku;
                        km[e] = kx[e] * (1.f + (av - 1.f) * kav[e]);
                        wr[e] = dec[e] * rs[e]; sbr += ku * av * rs[e]; skr += km[e] * rs[e]; sbo += rs[e] * km[e] * rkv[e];
                        lg[e] = Cg[nt][e]; }
                    *(v4f*)(RW_W + hrow * 64 + d4h) = dec;
                    oK[nt].x = pk2(km[0], km[1]); oK[nt].y = pk2(km[2], km[3]); oWR[nt].x = pk2(wr[0], wr[1]); oWR[nt].y = pk2(wr[2], wr[3]);
                    oV[nt].x = pk2(vs[0], vs[1]); oV[nt].y = pk2(vs[2], vs[3]); oG[nt].x = pk2(lg[0], lg[1]); oG[nt].y = pk2(lg[2], lg[3]);
                }
#undef PREP_W4
#pragma unroll
                for (int h2 = 0; h2 < 2; ++h2) { const size_t ho = hrow * 64 + 16 * g + 8 * h2;
                    *(v4u*)(RW_K + ho) = (v4u){oK[2 * h2].x, oK[2 * h2].y, oK[2 * h2 + 1].x, oK[2 * h2 + 1].y}; *(v4u*)(RW_WR + ho) = (v4u){oWR[2 * h2].x, oWR[2 * h2].y, oWR[2 * h2 + 1].x, oWR[2 * h2 + 1].y};
                    *(v4u*)(RW_V + ho) = (v4u){oV[2 * h2].x, oV[2 * h2].y, oV[2 * h2 + 1].x, oV[2 * h2 + 1].y};
                    *(v4u*)(RW_G + (size_t)(m0 + r) * 256 + cbh + 8 * h2) = (v4u){oG[2 * h2].x, oG[2 * h2].y, oG[2 * h2 + 1].x, oG[2 * h2 + 1].y}; }
                n2 += __shfl_xor(n2, 16); n2 += __shfl_xor(n2, 32);
                const float inv = rcp_(fmaxf(sqrtf(n2), 1e-12f));
#pragma unroll
                for (int h2 = 0; h2 < 2; ++h2) { const size_t ho = hrow * 64 + 16 * g + 8 * h2; const v4f a0_ = kun[2 * h2] * (-inv), a1_ = kun[2 * h2 + 1] * (-inv), b0_ = kav_[2 * h2] * inv, b1_ = kav_[2 * h2 + 1] * inv;
                    *(v4u*)(RW_A + ho) = (v4u){pk2(a0_[0], a0_[1]), pk2(a0_[2], a0_[3]), pk2(a1_[0], a1_[1]), pk2(a1_[2], a1_[3])};
                    *(v4u*)(RW_B + ho) = (v4u){pk2(b0_[0], b0_[1]), pk2(b0_[2], b0_[3]), pk2(b1_[0], b1_[1]), pk2(b1_[2], b1_[3])}; }
                sbr *= inv;
                sbr += __shfl_xor(sbr, 16); sbr += __shfl_xor(sbr, 32); skr += __shfl_xor(skr, 16); skr += __shfl_xor(skr, 32); sbo += __shfl_xor(sbo, 16); sbo += __shfl_xor(sbo, 32);
                if (g == 0) *(v4f*)(RW_SC + hrow * 4) = (v4f){sbr, skr, sbo, 0.f};
            }
        };
        const int NT16 = T / 16, nfull = (NT16 / NGW) * NGW;
#pragma unroll 1
        for (int it = gw; it < nfull + (NT16 - nfull) * 4; it += NGW) { const int q = it - nfull; const bool part = q >= 0;
            r_tile(part ? nfull + (q >> 2) : it, part ? (q & 3) : 0, part ? (q & 3) + 1 : 4); }
    }
    __syncthreads();
    {
        constexpr int XT_PITCH = 528, XT_BYTES = 16 * XT_PITCH, XT_OFF = 65536, LCST_OFF = XT_OFF + NWAVES * XT_BYTES;
        static_assert(LCST_OFF + 3 * 1024 <= MISC_OFF, "pass L lds");
        for (int f = tid; f < 64 * 64; f += NTHR) { const int ln = f & 63, fr = f >> 6, ks = fr & 1, nt = (fr >> 1) & 3, hd = (fr >> 3) & 3, mat = fr >> 5, rr = ln & 15, g8 = ln >> 4;
            const float* W = (mat ? wx : wa) + hd * 4096 + (32 * ks + 8 * g8) * 64 + 16 * (rr >> 2) + 4 * nt + (rr & 3);
            v4u o; o.x = pk2(W[0], W[64]); o.y = pk2(W[128], W[192]); o.z = pk2(W[256], W[320]); o.w = pk2(W[384], W[448]);
            *(LAS v4u*)(lds + (size_t)fr * 1024 + ln * 16) = o; }
        LAS float* cst = (LAS float*)(lds + LCST_OFF);
        if (tid < 256) { cst[tid] = ba[tid]; cst[256 + tid] = bx[tid];
            const float xs = -lam[tid], ys = __expf(xs);
            cst[512 + tid] = xs > 15.f ? xs : (ys < 0.01f ? ys * (1.f - ys * (0.5f - ys * 0.33333334f)) : __logf(1.f + ys)); }
        __syncthreads();
        LAS unsigned char* xt = lds + XT_OFF + wave * XT_BYTES;
        const int r = lane & 15, g = lane >> 4;
        const v4f cb = *(const v4f*)(conv_b + c4), cw0 = *(const v4f*)(conv_w + c4), cw1 = *(const v4f*)(conv_w + 256 + c4), cw2 = *(const v4f*)(conv_w + 512 + c4), cw3 = *(const v4f*)(conv_w + 768 + c4);
        auto l_tile = [&](const int tile, const int hd_lo, const int hd_hi) {
            const int m0 = tile * 16, b = m0 / L, i0 = m0 - b * L;
            const bf16* Pq = PROJ + (size_t)m0 * NINP;
            v2u xb[19], gr[16];
#pragma unroll
            for (int q = 0; q < 19; ++q) { const int ro = (i0 + q - 3 >= 0) ? q - 3 : 0; xb[q] = *(const v2u*)(Pq + (ptrdiff_t)ro * NINP + C_LR_X + c4); }
#pragma unroll
            for (int t = 0; t < 16; ++t) gr[t] = *(const v2u*)(Pq + (size_t)t * NINP + C_LR_G + c4);
            const v4f z4 = (v4f){0.f, 0.f, 0.f, 0.f};
            v4f x0 = i0 > 0 ? BF4R(xb[0]) : z4, x1 = i0 > 0 ? BF4R(xb[1]) : z4, x2 = i0 > 0 ? BF4R(xb[2]) : z4;
#pragma unroll
            for (int t = 0; t < 16; ++t) {
                const v4f x3 = BF4R(xb[t + 3]);
                const v4f xc = cb + cw0 * x0 + cw1 * x1 + cw2 * x2 + cw3 * x3;
                v2u o; o.x = pk2(xc.x, xc.y); o.y = pk2(xc.z, xc.w);
                *(LAS v2u*)(xt + t * XT_PITCH + c4 * 2) = o;
                x0 = x1; x1 = x2; x2 = x3;
                const v4f gv = BF4R(gr[t]); v4f gg;
#pragma unroll
                for (int e = 0; e < 4; ++e) { const float tt = 0.7978845608028654f * (gv[e] + 0.044715f * gv[e] * gv[e] * gv[e]); gg[e] = 0.5f * gv[e] * (1.f + tanh_fast(tt)); }
                if (hd_lo == 0) st_bf4(LR_G + (size_t)(m0 + t) * 256 + c4, gg);
            }
            LDS_WAIT();
#pragma unroll 1
            for (int hd = hd_lo; hd < hd_hi; ++hd) {
                const LAS unsigned char* xrow = xt + r * XT_PITCH + hd * 128;
                const pg8::bf16x8 bk0 = *(const LAS pg8::bf16x8*)(xrow + g * 16), bk1 = *(const LAS pg8::bf16x8*)(xrow + 64 + g * 16);
                pg8::f32x4 Ca[4], Cx[4];
#pragma unroll
                for (int nt = 0; nt < 4; ++nt) {
                    const LAS unsigned char* wf = lds + (size_t)((hd * 4 + nt) * 2) * 1024 + lane * 16;
                    const pg8::bf16x8 a0 = *(const LAS pg8::bf16x8*)(wf), a1 = *(const LAS pg8::bf16x8*)(wf + 1024), x0f = *(const LAS pg8::bf16x8*)(wf + 32768), x1f = *(const LAS pg8::bf16x8*)(wf + 32768 + 1024);
                    pg8::f32x4 ca = (pg8::f32x4){0.f, 0.f, 0.f, 0.f}, cx = ca;
                    ca = __builtin_amdgcn_mfma_f32_16x16x32_bf16(a0, bk0, ca, 0, 0, 0); ca = __builtin_amdgcn_mfma_f32_16x16x32_bf16(a1, bk1, ca, 0, 0, 0);
                    cx = __builtin_amdgcn_mfma_f32_16x16x32_bf16(x0f, bk0, cx, 0, 0, 0); cx = __builtin_amdgcn_mfma_f32_16x16x32_bf16(x1f, bk1, cx, 0, 0, 0);
                    Ca[nt] = ca; Cx[nt] = cx;
                }
                v2u oU[4];
#pragma unroll
                for (int nt = 0; nt < 4; ++nt) {
                    const int c0 = hd * 64 + 16 * g + 4 * nt;
                    const v4f bav = *(const LAS v4f*)(cst + c0), bxv = *(const LAS v4f*)(cst + 256 + c0), spl = *(const LAS v4f*)(cst + 512 + c0);
                    const v2u xq = *(const LAS v2u*)(xt + r * XT_PITCH + c0 * 2); const v4f xc = BF4R(xq);
                    v4f aa, uu;
#pragma unroll
                    for (int e = 0; e < 4; ++e) { const float rg = sigmoidf_(Ca[nt][e] + bav[e]), ig = sigmoidf_(Cx[nt][e] + bxv[e]);
                        const float la = -8.f * rg * spl[e]; aa[e] = __expf(la);
                        const float x2l = 2.f * la; const float om = (x2l > -0.1f) ? -(x2l * (1.f + x2l * (0.5f + x2l * (0.16666667f + x2l * 0.041666668f)))) : (1.f - __expf(x2l));
                        uu[e] = xc[e] * ig * __builtin_amdgcn_sqrtf(om); }
                    const size_t mo = (size_t)(m0 + r) * 256 + c0;
                    *(v4f*)(LR_A + mo) = aa; oU[nt].x = pk2(uu[0], uu[1]); oU[nt].y = pk2(uu[2], uu[3]);
                }
#pragma unroll
                for (int h2 = 0; h2 < 2; ++h2) *(v4u*)(LR_U + (size_t)(m0 + r) * 256 + hd * 64 + 16 * g + 8 * h2) = (v4u){oU[2 * h2].x, oU[2 * h2].y, oU[2 * h2 + 1].x, oU[2 * h2 + 1].y};
            }
        };
        const int NT16 = T / 16, nfull = (NT16 / NGW) * NGW;
#pragma unroll 1
        for (int it = gw; it < nfull + (NT16 - nfull) * 4; it += NGW) { const int q = it - nfull; const bool part = q >= 0;
            l_tile(part ? nfull + (q >> 2) : it, part ? (q & 3) : 0, part ? (q & 3) + 1 : 4); }
    }
    {
        float invf_q[4], invf_i[4];
#pragma unroll
        for (int e = 0; e < 4; ++e) { invf_q[e] = exp2f(-(float)((d4 + e) & 7) * (18.931568569324174f / 8.f)); invf_i[e] = exp2f(-(float)e * (18.931568569324174f / 4.f)); }
        v4f lb = (v4f){0.f, 0.f, 0.f, 0.f};
        if (l == 1) { const v4f x0 = *(const v4f*)(lbs + c4), x1 = *(const v4f*)(lbs + 256 + c4);
            lb.x = 1.f / (1.f + __expf(x0.x - x1.x)); lb.y = 1.f / (1.f + __expf(x0.y - x1.y)); lb.z = 1.f / (1.f + __expf(x0.z - x1.z)); lb.w = 1.f / (1.f + __expf(x0.w - x1.w)); }
#pragma unroll 2
        for (int m = gw; m < T; m += NGW) {
            const int b = m / L, i = m - b * L; const float pos = (float)i;
            const bf16* Pj = PROJ + (size_t)m * NINP;
            v4f q = ld_bf4(Pj + C_DS_Q + c4), k = ld_bf4(Pj + C_DS_K + c4);
            const v4f v = ld_bf4(Pj + C_DS_V + c4);
            v4f qi = ld_bf4(Pj + C_DS_QI + c4), ki = ld_bf4(Pj + C_DS_KI + 4 * (lane & 7));
            const v4f hq = ld_bf4(Pj + C_HG_Q + c4), z = ld_bf4(Pj + C_HG_F + c4), vi = ld_bf4(Pj + C_HG_I + c4), hgt = ld_bf4(Pj + C_HG_G + c4);
#pragma unroll
            for (int e = 0; e < 4; ++e) {
                const float qp = __shfl_xor(q[e], 2), kp = __shfl_xor(k[e], 2), qip = __shfl_xor(qi[e], 1), kip = __shfl_xor(ki[e], 1);
                float sn, cs; sincos_red(pos * invf_q[e], sn, cs);
                if (q_rot) { q[e] = q_hi ? (qp * sn + q[e] * cs) : (q[e] * cs - qp * sn); k[e] = q_hi ? (kp * sn + k[e] * cs) : (k[e] * cs - kp * sn); }
                sincos_red(pos * invf_i[e], sn, cs);
                if (i_rot) { qi[e] = i_hi ? (qip * sn + qi[e] * cs) : (qi[e] * cs - qip * sn); ki[e] = i_hi ? (kip * sn + ki[e] * cs) : (ki[e] * cs - kip * sn); }
            }
            { float kn2 = sum16(k.x * k.x + k.y * k.y + k.z * k.z + k.w * k.w); if ((lane & 15) == 0) __hip_atomic_fetch_max(kmaxl + b * 4 + hh, __float_as_uint(kn2 * 1.02f), __ATOMIC_RELAXED, __HIP_MEMORY_SCOPE_WORKGROUP); }
            st_bf4(DS_Q + (size_t)m * 256 + c4, q * (0.125f * 1.4426950408889634f));      st_bf4(DS_K + (size_t)m * 256 + c4, k); st_bf4(DS_V + (size_t)m * 256 + c4, v); st_bf4(DS_QI + (size_t)m * 256 + c4, qi);
            { float in2 = sum8(ki.x * ki.x + ki.y * ki.y + ki.z * ki.z + ki.w * ki.w); if (lane == 0) __hip_atomic_fetch_max(kimaxl + b, __float_as_uint(in2 * 1.02f), __ATOMIC_RELAXED, __HIP_MEMORY_SCOPE_WORKGROUP); }
            if (lane < 8) { st_bf4(DS_KI + (size_t)m * 32 + 4 * lane, ki); DS_WI[(size_t)m * 8 + lane] = bf2f(Pj[C_DS_WI + lane]) * 0.0625f; }
            v4f qs, f, kq, gs;
#pragma unroll
            for (int e = 0; e < 4; ++e) { const float sg = sigmoidf_(z[e]); qs[e] = hq[e] * sigmoidf_(hq[e]); f[e] = lb[e] + (1.f - lb[e]) * sg; kq[e] = (1.f - lb[e]) * (1.f - sg); gs[e] = hgt[e] * sigmoidf_(hgt[e]); }
            const size_t hm = ((size_t)(b * 4 + hh) * L + i) * 64 + d4;
            *(v4f*)(HG_F + hm) = f; st_bf4(HG_K + hm, kq); st_bf4(HG_Q + hm, qs); st_bf4(HG_V + hm, vi); st_bf4(HG_G + (size_t)m * 256 + c4, gs);
        }
    }
    __syncthreads();
    if (tid < 32) atomicMax((unsigned*)(A.ws + WS_CTL) + 8960 + 64 * l + tid, kmaxl[tid]);
    if (tid < 8) atomicMax((unsigned*)(A.ws + WS_CTL) + 9216 + 64 * l + tid, kimaxl[tid]);
}
constexpr int SC_C = 32;
constexpr size_t WS_YRAW = WS_PROJ;
constexpr size_t WS_ORAW = WS_PROJ + (size_t)T * 1024;
__device__ PHASE_FN void rwkv_scan(const Ctx A, LAS unsigned char* lds, int unit_) {
    const int unit = opaque_s(unit_);
    const int tid = opaque_tid(), row = tid >> 4, kp = tid & 15;
    const int bh = unit >> 1, half = unit & 1, b = bh >> 2, h = bh & 3;
    const size_t base = (size_t)bh * L * 64;
    const float* W = (const float*)(A.ws + WS_RW_W) + base;
    const bf16* Av = (const bf16*)(A.ws + WS_RW_A) + base; const bf16* Bv = (const bf16*)(A.ws + WS_RW_B) + base; const bf16* Kv = (const bf16*)(A.ws + WS_RW_K) + base;
    const bf16* WRv = (const bf16*)(A.ws + WS_RW_WR) + base; const bf16* Vv = (const bf16*)(A.ws + WS_RW_V) + base + half * 32;
    const float* SC = (const float*)(A.ws + WS_RW_SC) + (size_t)bh * L * 4;
    float* YR = (float*)(A.ws + WS_YRAW) + (size_t)b * L * 256 + h * 64 + half * 32;
    constexpr int ARR = SC_C * 64;
    constexpr int BUF = (5 * ARR + SC_C * 32 + SC_C * 4) * 4;
    LAS float* ybuf = (LAS float*)(lds + 2 * BUF);
    float S0 = 0.f, S1 = 0.f, S2 = 0.f, S3 = 0.f;
    v4f rw; v2u ra, rb, rk, rwr, rv; float rsc = 0.f;
    const int e4 = tid * 4;
#define RW_LOAD(c) do { const int t0_ = (c) * SC_C; const bool ok_ = (t0_ + (e4 >> 6)) < L; const size_t o_ = (size_t)t0_ * 64 + e4; \
        rw = ok_ ? *(const v4f*)(W + o_) : (v4f){1.f, 1.f, 1.f, 1.f}; ra = ok_ ? *(const v2u*)(Av + o_) : (v2u){0u, 0u}; rb = ok_ ? *(const v2u*)(Bv + o_) : (v2u){0u, 0u}; \
        rk = ok_ ? *(const v2u*)(Kv + o_) : (v2u){0u, 0u}; rwr = ok_ ? *(const v2u*)(WRv + o_) : (v2u){0u, 0u}; \
        if (tid < SC_C * 8) rv = (t0_ + (tid >> 3)) < L ? *(const v2u*)(Vv + (size_t)(t0_ + (tid >> 3)) * 64 + (tid & 7) * 4) : (v2u){0u, 0u}; \
        if (tid < SC_C * 4) rsc = (t0_ + (tid >> 2)) < L ? SC[(size_t)t0_ * 4 + tid] : 0.f; } while (0)
#define RW_STORE(p) do { LAS float* d_ = (LAS float*)(lds + (p) * BUF); \
        *(LAS v4f*)(d_ + e4) = rw; *(LAS v4f*)(d_ + ARR + e4) = (v4f){bflo(ra.x), bfhi(ra.x), bflo(ra.y), bfhi(ra.y)}; *(LAS v4f*)(d_ + 2 * ARR + e4) = (v4f){bflo(rb.x), bfhi(rb.x), bflo(rb.y), bfhi(rb.y)}; \
        *(LAS v4f*)(d_ + 3 * ARR + e4) = (v4f){bflo(rk.x), bfhi(rk.x), bflo(rk.y), bfhi(rk.y)}; *(LAS v4f*)(d_ + 4 * ARR + e4) = (v4f){bflo(rwr.x), bfhi(rwr.x), bflo(rwr.y), bfhi(rwr.y)}; \
        if (tid < SC_C * 8) *(LAS v4f*)(d_ + 5 * ARR + tid * 4) = (v4f){bflo(rv.x), bfhi(rv.x), bflo(rv.y), bfhi(rv.y)}; if (tid < SC_C * 4) d_[5 * ARR + SC_C * 32 + tid] = rsc; } while (0)
    constexpr int NCH = (L + SC_C - 1) / SC_C;
    RW_LOAD(0); RW_STORE(0); __syncthreads();
#pragma unroll 1
    for (int c = 0; c < NCH; ++c) {
        const int p = c & 1;
        if (c + 1 < NCH) RW_LOAD(c + 1);
        const int ns = (L - c * SC_C) < SC_C ? (L - c * SC_C) : SC_C;
        const LAS float* d = (const LAS float*)(lds + p * BUF);
        const LAS float* q = d + kp * 4; const LAS float* dv = d + 5 * ARR + row; const LAS float* dsc = d + 5 * ARR + SC_C * 32;
        v4f w4 = *(const LAS v4f*)(q), a4 = *(const LAS v4f*)(q + ARR), b4 = *(const LAS v4f*)(q + 2 * ARR), k4 = *(const LAS v4f*)(q + 3 * ARR), r4 = *(const LAS v4f*)(q + 4 * ARR);
        float vv = dv[0]; v2f sc = *(const LAS v2f*)(dsc);
#pragma unroll 2
        for (int s = 0; s < ns; ++s) {
            const int sn = (s + 1 < SC_C) ? s + 1 : s;
            const v4f nw4 = *(const LAS v4f*)(q + sn * 64), na4 = *(const LAS v4f*)(q + ARR + sn * 64), nb4 = *(const LAS v4f*)(q + 2 * ARR + sn * 64);
            const v4f nk4 = *(const LAS v4f*)(q + 3 * ARR + sn * 64), nr4 = *(const LAS v4f*)(q + 4 * ARR + sn * 64);
            const float nvv = dv[sn * 32]; const v2f nsc = *(const LAS v2f*)(dsc + sn * 4);
            float sa = (S0 * a4.x + S1 * a4.y) + (S2 * a4.z + S3 * a4.w), y1 = (S0 * r4.x + S1 * r4.y) + (S2 * r4.z + S3 * r4.w);
            sa = sum16(sa); y1 = sum16(y1);
            S0 = S0 * w4.x + sa * b4.x + vv * k4.x; S1 = S1 * w4.y + sa * b4.y + vv * k4.y; S2 = S2 * w4.z + sa * b4.z + vv * k4.z; S3 = S3 * w4.w + sa * b4.w + vv * k4.w;
            const float yo = y1 + sa * sc.x + vv * sc.y;
            if (kp == 0) ybuf[s * 32 + row] = yo;
            w4 = nw4; a4 = na4; b4 = nb4; k4 = nk4; r4 = nr4; vv = nvv; sc = nsc;
        }
        __syncthreads();
        { const int s = tid >> 4, r2 = (tid & 15) * 2;
          if (s < ns) *(v2f*)(YR + (size_t)(c * SC_C + s) * 256 + r2) = *(const LAS v2f*)(ybuf + s * 32 + r2); }
        if (c + 1 < NCH) RW_STORE(1 - p);
        __syncthreads();
    }
#undef RW_LOAD
#undef RW_STORE
}
__device__ PHASE_FN void hgrn_scan(const Ctx A, LAS unsigned char* lds, int unit_) {
    const int unit = opaque_s(unit_);
    const int tid = opaque_tid(), row = tid >> 4, kp = tid & 15;
    const int bh = unit >> 1, half = unit & 1, b = bh >> 2, h = bh & 3;
    const size_t base = (size_t)bh * L * 64;
    const float* Fv = (const float*)(A.ws + WS_HG_F) + base;
    const bf16* Kv = (const bf16*)(A.ws + WS_HG_K) + base; const bf16* Qv = (const bf16*)(A.ws + WS_HG_Q) + base; const bf16* Vv = (const bf16*)(A.ws + WS_HG_V) + base + half * 32;
    float* OR = (float*)(A.ws + WS_ORAW) + (size_t)b * L * 256 + h * 64 + half * 32;
    constexpr int ARR = SC_C * 64; constexpr int BUF = (3 * ARR + SC_C * 32) * 4;
    LAS float* obuf = (LAS float*)(lds + 2 * BUF);
    float S0 = 0.f, S1 = 0.f, S2 = 0.f, S3 = 0.f;
    v4f rf; v2u rk, rq, rv;
    const int e4 = tid * 4;
#define HG_LOAD(c) do { const int t0_ = (c) * SC_C; const bool ok_ = (t0_ + (e4 >> 6)) < L; const size_t o_ = (size_t)t0_ * 64 + e4; \
        rf = ok_ ? *(const v4f*)(Fv + o_) : (v4f){1.f, 1.f, 1.f, 1.f}; rk = ok_ ? *(const v2u*)(Kv + o_) : (v2u){0u, 0u}; rq = ok_ ? *(const v2u*)(Qv + o_) : (v2u){0u, 0u}; \
        if (tid < SC_C * 8) rv = (t0_ + (tid >> 3)) < L ? *(const v2u*)(Vv + (size_t)(t0_ + (tid >> 3)) * 64 + (tid & 7) * 4) : (v2u){0u, 0u}; } while (0)
#define HG_STORE(p) do { LAS float* d_ = (LAS float*)(lds + (p) * BUF); \
        *(LAS v4f*)(d_ + e4) = rf; *(LAS v4f*)(d_ + ARR + e4) = (v4f){bflo(rk.x), bfhi(rk.x), bflo(rk.y), bfhi(rk.y)}; \
        *(LAS v4f*)(d_ + 2 * ARR + e4) = (v4f){bflo(rq.x), bfhi(rq.x), bflo(rq.y), bfhi(rq.y)}; \
        if (tid < SC_C * 8) *(LAS v4f*)(d_ + 3 * ARR + tid * 4) = (v4f){bflo(rv.x), bfhi(rv.x), bflo(rv.y), bfhi(rv.y)}; } while (0)
    constexpr int NCH = (L + SC_C - 1) / SC_C;
    HG_LOAD(0); HG_STORE(0); __syncthreads();
#pragma unroll 1
    for (int c = 0; c < NCH; ++c) {
        const int p = c & 1;
        if (c + 1 < NCH) HG_LOAD(c + 1);
        const int ns = (L - c * SC_C) < SC_C ? (L - c * SC_C) : SC_C;
        const LAS float* d = (const LAS float*)(lds + p * BUF);
        const LAS float* q = d + kp * 4; const LAS float* dv = d + 3 * ARR + row;
        v4f f4 = *(const LAS v4f*)(q), k4 = *(const LAS v4f*)(q + ARR), q4 = *(const LAS v4f*)(q + 2 * ARR); float vv = dv[0];
#pragma unroll 2
        for (int s = 0; s < ns; ++s) {
            const int sn = (s + 1 < SC_C) ? s + 1 : s;
            const v4f nf4 = *(const LAS v4f*)(q + sn * 64), nk4 = *(const LAS v4f*)(q + ARR + sn * 64), nq4 = *(const LAS v4f*)(q + 2 * ARR + sn * 64);
            const float nvv = dv[sn * 32];
            S0 = S0 * f4.x + k4.x * vv; S1 = S1 * f4.y + k4.y * vv; S2 = S2 * f4.z + k4.z * vv; S3 = S3 * f4.w + k4.w * vv;
            float o = (q4.x * S0 + q4.y * S1) + (q4.z * S2 + q4.w * S3);
            o = sum16(o);
            if (kp == 0) obuf[s * 32 + row] = o;
            f4 = nf4; k4 = nk4; q4 = nq4; vv = nvv;
        }
        __syncthreads();
        { const int s = tid >> 4, r2 = (tid & 15) * 2;
          if (s < ns) *(v2f*)(OR + (size_t)(c * SC_C + s) * 256 + r2) = *(const LAS v2f*)(obuf + s * 32 + r2); }
        if (c + 1 < NCH) HG_STORE(1 - p);
        __syncthreads();
    }
#undef HG_LOAD
#undef HG_STORE
}
__device__ PHASE_FN void mixers_finish(const Ctx A, int l, int vcu, int G) {
    const int tid = opaque_tid(), lane = tid & 63, wave = tid >> 6;
    const int gw = vcu * NWAVES + wave, NGW = G * NWAVES;
    const int c4 = 4 * lane, hh = lane >> 4, d4 = 4 * (lane & 15);
    const float* YR = (const float*)(A.ws + WS_YRAW); const float* OR = (const float*)(A.ws + WS_ORAW);
    const bf16* RV = (const bf16*)(A.ws + WS_RW_V); const float* SC = (const float*)(A.ws + WS_RW_SC); const bf16* RG = (const bf16*)(A.ws + WS_RW_G); const bf16* HGt = (const bf16*)(A.ws + WS_HG_G);
    bf16* MIX = (bf16*)(A.ws + WS_MIX);
    const v4f lg = *(const v4f*)(gin(A, 14) + l * 256 + c4), lb = *(const v4f*)(gin(A, 15) + l * 256 + c4), ng = *(const v4f*)(gin(A, 24) + l * 256 + c4);
#pragma unroll 2
    for (int m = gw; m < T; m += NGW) {
        const int b = m / L, i = m - b * L; const size_t hm = ((size_t)(b * 4 + hh) * L + i);
        const v4f y = *(const v4f*)(YR + (size_t)m * 256 + c4), o = *(const v4f*)(OR + (size_t)m * 256 + c4);
        const v4f vv = ld_bf4(RV + hm * 64 + d4), g = ld_bf4(RG + (size_t)m * 256 + c4), hg = ld_bf4(HGt + (size_t)m * 256 + c4);
        const float bonus = SC[hm * 4 + 2];
        const float mean = sum16((y.x + y.y) + (y.z + y.w)) * (1.f / 64.f); const v4f dy = y - mean;
        const float var = sum16((dy.x * dy.x + dy.y * dy.y) + (dy.z * dy.z + dy.w * dy.w)) * (1.f / 64.f);
        const v4f yn = (dy * rsqrtf(var + 64e-5f) * lg + lb + vv * bonus) * g;
        st_bf4(MIX + (size_t)m * 1024 + c4, yn);
        const float ms = sum16((o.x * o.x + o.y * o.y) + (o.z * o.z + o.w * o.w)) * (1.f / 64.f);
        st_bf4(MIX + (size_t)m * 1024 + 768 + c4, o * rsqrtf(ms + 1e-5f) * ng * hg);
    }
}
constexpr int LR_SEG = 64, LR_NSEG = (L + LR_SEG - 1) / LR_SEG;
constexpr size_t WS_LR_AGG = 2032 * MiB;
constexpr size_t WS_LR_CARRY = WS_LR_AGG + 3 * MiB;
static_assert(WS_LR_CARRY + (size_t)NB * LR_NSEG * 256 * 4 <= WS_END, "lru aggregates");
__device__ PHASE_FN void lru_agg_phase(const Ctx A, int vcu, int G) {
    const int tid = opaque_tid(), lane = tid & 63, wave = tid >> 6;
    const int gw = vcu * NWAVES + wave, NGW = G * NWAVES;
    const float* LA = (const float*)(A.ws + WS_LR_A); const bf16* LU = (const bf16*)(A.ws + WS_LR_U); v2f* AGG = (v2f*)(A.ws + WS_LR_AGG);
#pragma unroll 1
    for (int it = gw; it < NB * LR_NSEG * 4; it += NGW) {
        const int cg = it & 3, q = it >> 2; const bool tail_ = q >= NB * (LR_NSEG - 1);
        const int b = tail_ ? q - NB * (LR_NSEG - 1) : q / (LR_NSEG - 1), sg = tail_ ? LR_NSEG - 1 : q - b * (LR_NSEG - 1), ch = cg * 64 + lane;
        const int t0 = sg * LR_SEG, ns = (L - t0) < LR_SEG ? (L - t0) : LR_SEG;
        const size_t m0 = (size_t)b * L + t0;
        float Ap = 1.f, Hl = 0.f;
#pragma unroll 1
        for (int i = 0; i < ns; i += 16) {
            float a[16], u[16];
#pragma unroll
            for (int j = 0; j < 16; ++j) { a[j] = LA[(m0 + i + j) * 256 + ch]; u[j] = bf2f(LU[(m0 + i + j) * 256 + ch]); }
#pragma unroll
            for (int j = 0; j < 16; ++j) { Hl = a[j] * Hl + u[j]; Ap *= a[j]; }
        }
        AGG[((size_t)b * LR_NSEG + sg) * 256 + ch] = (v2f){Ap, Hl};
    }
}
__device__ PHASE_FN void lru_carry_phase(const Ctx A, int first) {
    const int tid = opaque_tid(), lane = tid & 63, wave = tid >> 6;
    const int w = (opaque_s((int)blockIdx.x) - first) * NWAVES + wave;
    const int b = w >> 2, ch = (w & 3) * 64 + lane;
    const v2f* ag = (const v2f*)(A.ws + WS_LR_AGG) + (size_t)b * LR_NSEG * 256 + ch;
    float* CR = (float*)(A.ws + WS_LR_CARRY) + (size_t)b * LR_NSEG * 256 + ch;
    float hc = 0.f;
#pragma unroll 1
    for (int s0 = 0; s0 < LR_NSEG; s0 += 16) {
        v2f x[16];
#pragma unroll
        for (int j = 0; j < 16; ++j) { const int s = s0 + j < LR_NSEG ? s0 + j : LR_NSEG - 1; x[j] = ag[(size_t)s * 256]; }
#pragma unroll
        for (int j = 0; j < 16; ++j) if (s0 + j < LR_NSEG) { CR[(size_t)(s0 + j) * 256] = hc; hc = x[j].x * hc + x[j].y; }
    }
}
__device__ PHASE_FN void lru_out_phase(const Ctx A, int vcu, int G) {
    const int tid = opaque_tid(), lane = tid & 63, wave = tid >> 6;
    const int gw = vcu * NWAVES + wave, NGW = G * NWAVES;
    const float* LA = (const float*)(A.ws + WS_LR_A); const bf16* LU = (const bf16*)(A.ws + WS_LR_U); const bf16* LG = (const bf16*)(A.ws + WS_LR_G);
    const float* CR = (const float*)(A.ws + WS_LR_CARRY); bf16* MIX = (bf16*)(A.ws + WS_MIX);
#pragma unroll 1
    for (int it = gw; it < NB * LR_NSEG * 4; it += NGW) {
        const int cg = it & 3, q = it >> 2; const bool tail_ = q >= NB * (LR_NSEG - 1);
        const int b = tail_ ? q - NB * (LR_NSEG - 1) : q / (LR_NSEG - 1), sg = tail_ ? LR_NSEG - 1 : q - b * (LR_NSEG - 1), ch = cg * 64 + lane;
        const int t0 = sg * LR_SEG, ns = (L - t0) < LR_SEG ? (L - t0) : LR_SEG;
        const size_t m0 = (size_t)b * L + t0;
        float hc = CR[((size_t)b * LR_NSEG + sg) * 256 + ch];
#pragma unroll 1
        for (int i = 0; i < ns; i += 16) {
            float a[16], u[16], g[16];
#pragma unroll
            for (int j = 0; j < 16; ++j) { a[j] = LA[(m0 + i + j) * 256 + ch]; u[j] = bf2f(LU[(m0 + i + j) * 256 + ch]); g[j] = bf2f(LG[(m0 + i + j) * 256 + ch]); }
#pragma unroll
            for (int j = 0; j < 16; ++j) { hc = a[j] * hc + u[j]; MIX[(m0 + i + j) * 1024 + 512 + ch] = f2bf(hc * g[j]); }
        }
    }
}
static_assert(L % 16 == 0, "lru step groups");
constexpr int DSA_WBYTES = 34944;
constexpr int DSA_NW = 4;
__device__ __forceinline__ unsigned fkey(float f) { const unsigned u = __float_as_uint(f); return (u & 0x80000000u) ? ~u : (u | 0x80000000u); }
__device__ __forceinline__ void dsa_query(const Ctx A, LAS unsigned char* wl, int b, int i, int lane) {
    const bf16* DQ = (const bf16*)(A.ws + WS_DS_Q); const bf16* DK = (const bf16*)(A.ws + WS_DS_K); const bf16* DV = (const bf16*)(A.ws + WS_DS_V);
    const bf16* DQI = (const bf16*)(A.ws + WS_DS_QI); const bf16* DKI = (const bf16*)(A.ws + WS_DS_KI); const float* DWI = (const float*)(A.ws + WS_DS_WI);
    bf16* MIX = (bf16*)(A.ws + WS_HB);
    LAS unsigned* keys = (LAS unsigned*)wl; LAS float* qv = (LAS float*)(wl + 32896); LAS int* sel = (LAS int*)(wl + 32896 + 1024);
    const size_t m = (size_t)b * L + i, mb = (size_t)b * L;
    const int n = i + 1;
    LAS float* wil = (LAS float*)(wl + 32832);
    { const v4f q4 = ld_bf4(DQI + m * 256 + 4 * lane); *(LAS v4f*)(qv + 4 * lane) = q4; if (lane < 8) wil[lane] = DWI[m * 8 + lane]; }
    LDS_WAIT();
    for (int s = lane; s < n; s += 64) {
        const v4u* kp = (const v4u*)(DKI + (mb + s) * 32);
        float kf[32];
#pragma unroll
        for (int c = 0; c < 4; ++c) { const v4u x = kp[c]; kf[8 * c + 0] = bflo(x.x); kf[8 * c + 1] = bfhi(x.x); kf[8 * c + 2] = bflo(x.y); kf[8 * c + 3] = bfhi(x.y); kf[8 * c + 4] = bflo(x.z); kf[8 * c + 5] = bfhi(x.z); kf[8 * c + 6] = bflo(x.w); kf[8 * c + 7] = bfhi(x.w); }
        float sc = 0.f;
#pragma unroll 1
        for (int hx = 0; hx < 8; ++hx) { float dt = 0.f;
#pragma unroll
            for (int c = 0; c < 8; ++c) { const v4f q4 = *(const LAS v4f*)(qv + hx * 32 + 4 * c); dt += q4.x * kf[4 * c] + q4.y * kf[4 * c + 1] + q4.z * kf[4 * c + 2] + q4.w * kf[4 * c + 3]; }
            sc += wil[hx] * fmaxf(dt, 0.f); }
        keys[s] = fkey(sc);
    }
    LDS_WAIT();
    unsigned thr = 0u; int need = 0;
    if (n > 256) {
        unsigned prefix = 0u; need = 256;
#pragma unroll 1
        for (int shift = 28; shift >= 0; shift -= 4) {
            unsigned long long lo = 0ull, hi = 0ull;
            const unsigned himask = (shift == 28) ? 0u : (0xFFFFFFFFu << (shift + 4));
            for (int s = lane; s < n; s += 64) { const unsigned k = keys[s];
                if ((k & himask) == prefix) { const unsigned dg = (k >> shift) & 15u; const unsigned long long inc = 1ull << ((dg & 7u) * 8u); if (dg < 8u) lo += inc; else hi += inc; } }
            int cum = 0; unsigned dsel = 0u; int below = 0; bool found = false;
#pragma unroll
            for (int dg = 15; dg >= 0; --dg) {
                const unsigned mine = (unsigned)(((dg < 8 ? lo : hi) >> ((dg & 7) * 8)) & 0xFFull);
                int tot = (int)mine;
#pragma unroll
                for (int o = 1; o < 64; o <<= 1) tot += __shfl_xor(tot, o);
                if (!found && cum + tot >= need) { found = true; dsel = (unsigned)dg; below = cum; }
                cum += tot;
            }
            prefix |= dsel << shift; need -= below;
        }
        thr = prefix;
    }
    int cnt = 0;
    if (n <= 256) { for (int s = lane; s < n; s += 64) sel[s] = s; cnt = n; }
    else {
        int eq_taken = 0;
        for (int s0 = 0; s0 < n; s0 += 64) { const int s = s0 + lane; const unsigned k = (s < n) ? keys[s] : 0u; const bool in = s < n;
            const bool gt = in && (k > thr), eq = in && (k == thr);
            const unsigned long long meq = __ballot(eq); const int eq_before = __popcll(meq & ((1ull << lane) - 1ull));
            const bool take = gt || (eq && (eq_taken + eq_before) < need);
            const unsigned long long mt = __ballot(take); const int pos = cnt + __popcll(mt & ((1ull << lane) - 1ull));
            if (take && pos < 256) sel[pos] = s;
            cnt += __popcll(mt); eq_taken += __popcll(meq);
        }
        if (cnt > 256) cnt = 256;
    }
    LDS_WAIT();
    LAS float* pbuf = (LAS float*)wl;
    for (int h = 0; h < 4; ++h) {
        { const float qx = bf2f(DQ[m * 256 + h * 64 + lane]); qv[lane] = qx * 0.125f; }
        LDS_WAIT();
        float sj[4]; float mx = -3.0e38f;
#pragma unroll
        for (int r = 0; r < 4; ++r) { const int j = lane + 64 * r; sj[r] = -3.0e38f;
            if (j < cnt) { const int s = sel[j]; const v4u* kp = (const v4u*)(DK + (mb + s) * 256 + h * 64); float dt = 0.f;
#pragma unroll
                for (int c = 0; c < 8; ++c) { const v4u x = kp[c]; const v4f q0 = *(const LAS v4f*)(qv + 8 * c), q1 = *(const LAS v4f*)(qv + 8 * c + 4);
                    dt += q0.x * bflo(x.x) + q0.y * bfhi(x.x) + q0.z * bflo(x.y) + q0.w * bfhi(x.y) + q1.x * bflo(x.z) + q1.y * bfhi(x.z) + q1.z * bflo(x.w) + q1.w * bfhi(x.w); }
                sj[r] = dt; mx = fmaxf(mx, dt); } }
        mx = wave_max(mx);
        float sum = 0.f;
#pragma unroll
        for (int r = 0; r < 4; ++r) { const int j = lane + 64 * r; const float p = (j < cnt) ? __expf(sj[r] - mx) : 0.f; sum += p; pbuf[j] = p; }
        sum = wave_sum(sum);
        LDS_WAIT();
        float o = 0.f;
        for (int j = 0; j < cnt; ++j) { const int s = sel[j]; o += pbuf[j] * bf2f(DV[(mb + s) * 256 + h * 64 + lane]); }
        MIX[m * 1024 + 256 + h * 64 + lane] = f2bf(o / sum);
        LDS_WAIT();
    }
}
__device__ PHASE_FN void dsa_phase(const Ctx A, LAS unsigned char* lds, int l) {
    const int tid = opaque_tid(), lane = tid & 63, wave = tid >> 6;
    if (wave >= DSA_NW) return;
    unsigned* qhead = (unsigned*)(A.ws + WS_CTL) + CW_DSAQ + 64 * l;
    LAS unsigned char* wl = lds + wave * DSA_WBYTES;
    for (;;) {
        unsigned it = 0u;
        if (lane == 0) it = atomicAdd(qhead, 1u);
        it = __builtin_amdgcn_readfirstlane(it);
        if (it >= (unsigned)T) break;
        const int i = L - 1 - (int)(it >> 3), b = (int)(it & 7u);
        dsa_query(A, wl, b, i, lane);
    }
}
static_assert(DSA_NW * DSA_WBYTES <= MISC_OFF, "dsa lds");
typedef short s8 __attribute__((ext_vector_type(8)));
typedef short v4i16_t __attribute__((ext_vector_type(4)));
typedef unsigned u16v __attribute__((ext_vector_type(16)));
typedef unsigned long long u64;
constexpr int NQT16 = L / 16;
constexpr int NKB32 = (L + 31) / 32;
constexpr int MASK_PB = 66112;
constexpr size_t MASK_LAYER = (size_t)NB * MASK_PB * 64;
constexpr size_t WS_MASK = 1956 * MiB;
static_assert(WS_MASK >= WS_MIX_END && WS_MASK + 2 * MASK_LAYER + 256 <= 2032 * MiB, "mask region");
__device__ __forceinline__ size_t mask_row(int l, int b, int qt) { const int a = qt >> 1; return (size_t)l * (NB * MASK_PB) + (size_t)b * MASK_PB + ((qt & 1) ? (a + 1) * (a + 1) : a * (a + 1)); }
constexpr int CW_KMAX = 8960;
constexpr int CW_KIMAX = 9216;
constexpr int MI_KMAX = 640, MI_UNIT = 768, MI_KIMAX = 832;
constexpr int SEL_PF = 3;
constexpr int SEL_HROW = 259;

__device__ __forceinline__ void sel_scores(const s8 a1, const s8 a2, const s8 (&qb)[9], const float (&wv)[8], pg8::f32x4& i1, pg8::f32x4& i2) {
    const pg8::f32x4 z = (pg8::f32x4){0.f, 0.f, 0.f, 0.f};
    i1 = __builtin_amdgcn_mfma_f32_16x16x32_bf16(a1, qb[8], z, 0, 0, 0); i2 = __builtin_amdgcn_mfma_f32_16x16x32_bf16(a2, qb[8], z, 0, 0, 0);
#pragma unroll
    for (int h = 0; h < 8; ++h) {
        const pg8::f32x4 c1 = __builtin_amdgcn_mfma_f32_16x16x32_bf16(a1, qb[h], z, 0, 0, 0), c2 = __builtin_amdgcn_mfma_f32_16x16x32_bf16(a2, qb[h], z, 0, 0, 0);
#pragma unroll
        for (int j = 0; j < 4; ++j) { float t1 = fmaf(fabsf(c1[j]), wv[h], i1[j]), t2 = fmaf(fabsf(c2[j]), wv[h], i2[j]);
            asm("" : "+v"(t1)); asm("" : "+v"(t2)); i1[j] = t1; i2[j] = t2; }
    }
}
template <int MODE, bool DIAG>
__device__ __forceinline__ void sel_block(const s8 a1, const s8 a2, const s8 (&qb)[9], const float (&wv)[8], int kb, int tq, int r, int g, int lane,
                                          LAS unsigned* hrow, float sc_mul, float sc_add, u64* mrow) {
    pg8::f32x4 i1, i2; sel_scores(a1, a2, qb, wv, i1, i2);
    const int s0 = kb * 32 + 8 * g;
    u64 wds[8];
#pragma unroll
    for (int j = 0; j < 8; ++j) {
        const float sc = j < 4 ? i1[j & 3] : i2[j & 3];
        if (MODE == 3) { if (sc == 123456.789f) hrow[256] = 1u; }
        else if (MODE == 2) { wds[j] = DIAG ? __ballot((s0 + j) <= tq && sc >= sc_add) : __ballot(sc >= sc_add); }
        else { int xi = (int)__builtin_floorf(fmaf(sc, sc_mul, sc_add));
            unsigned bin = MODE == 0 ? (unsigned)min(max(xi, 0), 255) : (unsigned)(min(max(xi, -1), 256) + 1);
            if (DIAG) bin = ((s0 + j) <= tq) ? bin : (MODE == 0 ? 256u : 0u);
            if (MODE == 0 || bin != 0u) __hip_atomic_fetch_add(hrow + bin, 1u, __ATOMIC_RELAXED, __HIP_MEMORY_SCOPE_WORKGROUP); }
    }
    if (MODE == 2 && lane == 0) { u64* d = mrow + (size_t)kb * 8;
#pragma unroll
        for (int j = 0; j < 8; j += 2) { v4u o; o.x = (unsigned)wds[j]; o.y = (unsigned)(wds[j] >> 32); o.z = (unsigned)wds[j + 1]; o.w = (unsigned)(wds[j + 1] >> 32); *(v4u*)(d + j) = o; } }
}
template <int MODE>
__device__ __forceinline__ void sel_pass(const bf16* KIb, const s8 (&qb)[9], const float (&wv)[8], int nkb, int tq, int r, int g, int lane,
                                         LAS unsigned* hrow, float sc_mul, float sc_add, u64* mrow, int kb_first = 0, int kb_step = 1) {
    const bf16* kp = KIb + (size_t)(8 * (r >> 2) + (r & 3)) * 32 + 8 * g;
    v4u cur[2 * SEL_PF], nxt[2 * SEL_PF];
#pragma unroll
    for (int i = 0; i < SEL_PF; ++i) { const size_t kb = kb_first + i * kb_step; cur[2 * i] = *(const v4u*)(kp + kb * 1024); cur[2 * i + 1] = *(const v4u*)(kp + kb * 1024 + 128); }
#pragma unroll 1
    for (int kb0 = kb_first; kb0 < nkb; kb0 += SEL_PF * kb_step) {
#pragma unroll
        for (int i = 0; i < SEL_PF; ++i) { const size_t kb = kb0 + (SEL_PF + i) * kb_step; nxt[2 * i] = *(const v4u*)(kp + kb * 1024); nxt[2 * i + 1] = *(const v4u*)(kp + kb * 1024 + 128); }
#pragma unroll
        for (int i = 0; i < SEL_PF; ++i) { const int kb = kb0 + i * kb_step;
            if (kb < nkb - 1) sel_block<MODE, false>(__builtin_bit_cast(s8, cur[2 * i]), __builtin_bit_cast(s8, cur[2 * i + 1]), qb, wv, kb, tq, r, g, lane, hrow, sc_mul, sc_add, mrow);
            else if (kb == nkb - 1) sel_block<MODE, true>(__builtin_bit_cast(s8, cur[2 * i]), __builtin_bit_cast(s8, cur[2 * i + 1]), qb, wv, kb, tq, r, g, lane, hrow, sc_mul, sc_add, mrow); }
#pragma unroll
        for (int i = 0; i < 2 * SEL_PF; ++i) cur[i] = nxt[i];
    }
}
__device__ __forceinline__ void sel_scan(const LAS unsigned* hrow, int need, int& sel, int& above) {
    int cum = 0; sel = 0; above = 0; bool found = false;
#pragma unroll 8
    for (int bin = 255; bin >= 0; --bin) { const int c = (int)hrow[bin];
        if (!found && cum + c >= need) { found = true; sel = bin; above = cum; }
        cum += c; }
}
__device__ PHASE_FN void dsa_select_phase(const Ctx A, LAS unsigned char* lds, int l) {
    const int tid = opaque_tid(), lane = tid & 63, wave = tid >> 6, r = lane & 15, g = lane >> 4;
    const bf16* DQI = (const bf16*)(A.ws + WS_DS_QI); const bf16* DKI = (const bf16*)(A.ws + WS_DS_KI); const float* DWI = (const float*)(A.ws + WS_DS_WI);
    u64* MASK = (u64*)(A.ws + WS_MASK);
    unsigned* qhead = (unsigned*)(A.ws + WS_CTL) + CW_DSAQ + 64 * l;
    const unsigned* kimaxw = (const unsigned*)(A.ws + WS_CTL) + CW_KIMAX + 64 * l;
    LAS unsigned* hist = (LAS unsigned*)(lds + wave * (16 * SEL_HROW * 4));
    LAS unsigned* hrow = hist + r * SEL_HROW;
    for (;;) {
        unsigned it = 0u;
        if (lane == 0) it = atomicAdd(qhead, 1u);
        it = __builtin_amdgcn_readfirstlane(it);
        if (it >= (unsigned)(NB * NQT16)) break;
        const int qt = NQT16 - 1 - (int)(it >> 3), b = (int)(it & 7u);
        const size_t mb = (size_t)b * L, m0 = mb + (size_t)qt * 16;
        const int tq = qt * 16 + r, nkb = ((qt * 16 + 15) >> 5) + 1;
        s8 qb[9]; float wv[8];
#pragma unroll
        for (int h = 0; h < 8; ++h) qb[h] = *(const s8*)(DQI + (m0 + r) * 256 + h * 32 + 8 * g);
        { const v4f w0 = *(const v4f*)(DWI + (m0 + r) * 8), w1 = *(const v4f*)(DWI + (m0 + r) * 8 + 4);
          wv[0] = w0.x; wv[1] = w0.y; wv[2] = w0.z; wv[3] = w0.w; wv[4] = w1.x; wv[5] = w1.y; wv[6] = w1.z; wv[7] = w1.w; }
        float bq = 0.f;
        { float ql[8];
#pragma unroll
          for (int e = 0; e < 8; ++e) ql[e] = 0.f;
#pragma unroll
          for (int h = 0; h < 8; ++h) { float n2 = 0.f;
#pragma unroll
              for (int e = 0; e < 8; ++e) { const float x = bf2f((unsigned short)qb[h][e]); ql[e] += wv[h] * x; n2 += x * x; }
              n2 += __shfl_xor(n2, 16); n2 += __shfl_xor(n2, 32); bq += fabsf(wv[h]) * sqrtf(n2); }
          v4u pk; pk.x = pk2(ql[0], ql[1]); pk.y = pk2(ql[2], ql[3]); pk.z = pk2(ql[4], ql[5]); pk.w = pk2(ql[6], ql[7]); qb[8] = __builtin_bit_cast(s8, pk); }
        const bf16* KIb = DKI + mb * 32;
        float thr_f = -__builtin_inff();
        if (qt * 16 + 15 >= 256) {
            const float kim = sqrtf(__uint_as_float(__hip_atomic_load(kimaxw + b, __ATOMIC_RELAXED, __HIP_MEMORY_SCOPE_AGENT)));
            const float R = fmaxf(2.06f * bq * kim, 1e-30f), s0 = 128.f / R, w0 = R * (1.f / 128.f);
            const int n = tq + 1;
            bool done = false;
            if (qt * 16 >= 2048) {
                for (int i = lane; i < 16 * SEL_HROW; i += 64) hist[i] = 0u;
                LDS_WAIT();
                sel_pass<0>(KIb, qb, wv, nkb - 1, tq, r, g, lane, hrow, s0, 128.f, nullptr, 3, 8);
                LDS_WAIT();
                const int ns = 32 * ((nkb - 1 - 3 + 7) >> 3);
                const float rho = 256.f * (float)ns / (float)n, dev = 4.f * sqrtf(rho) + 2.f;
                int bl, ab; sel_scan(hrow, (int)(rho + dev) + 1, bl, ab);
                int bh = 255, ab2 = 0; const int rhi = (int)(rho - dev);
                if (rhi >= 1) sel_scan(hrow, rhi, bh, ab2);
                LDS_WAIT();
                const float lo = -R + (float)bl * w0, hi = (rhi >= 1) ? (-R + (float)(bh + 1) * w0) : (R * 1.001f);
                const float s1 = 256.f / (hi - lo);
                for (int i = lane; i < 16 * SEL_HROW; i += 64) hist[i] = 0u;
                LDS_WAIT();
                sel_pass<1>(KIb, qb, wv, nkb, tq, r, g, lane, hrow, s1, -lo * s1, nullptr);
                LDS_WAIT();
                const int above = (int)hrow[257]; int inr = 0;
#pragma unroll 8
                for (int bin = 1; bin <= 256; ++bin) inr += (int)hrow[bin];
                const bool ok = above < 256 && above + inr >= 256;
                if (ok) { int sel1, ab1; sel_scan(hrow + 1, 256 - above, sel1, ab1); thr_f = lo + (float)sel1 * ((hi - lo) * (1.f / 256.f)); }
                LDS_WAIT();
                done = __all(ok);
            }
            if (!done) {
                for (int i = lane; i < 16 * SEL_HROW; i += 64) hist[i] = 0u;
                LDS_WAIT();
                sel_pass<0>(KIb, qb, wv, nkb, tq, r, g, lane, hrow, s0, 128.f, nullptr);
                LDS_WAIT();
                int sel0, above0; sel_scan(hrow, 256, sel0, above0);
                LDS_WAIT();
                const float lo0 = -R + (float)sel0 * w0, s1 = 256.f / w0;
                for (int i = lane; i < 16 * SEL_HROW; i += 64) hist[i] = 0u;
                LDS_WAIT();
                sel_pass<1>(KIb, qb, wv, nkb, tq, r, g, lane, hrow, s1, -lo0 * s1, nullptr);
                LDS_WAIT();
                int sel1, above1; sel_scan(hrow + 1, 256 - above0, sel1, above1);
                LDS_WAIT();
                thr_f = lo0 + (float)sel1 * (w0 * (1.f / 256.f));
            }
            if (n <= 256) thr_f = -__builtin_inff();
        }
        sel_pass<2>(KIb, qb, wv, nkb, tq, r, g, lane, hrow, 0.f, thr_f, MASK + mask_row(l, b, qt) * 8);
    }
}

constexpr int AT_ROW = 144;
constexpr int AT_TILE = 64 * AT_ROW;
constexpr int AT_NQT = (L - 16) / 256;
constexpr int AT_NKT = (L + 63) / 64;
static_assert(16 + AT_NQT * 256 == L, "query tiling");
__device__ PHASE_FN void dsa_attn_phase(const Ctx A, LAS unsigned char* lds, int l) {
    const int tid = opaque_tid(), lane = tid & 63, wave = tid >> 6, r = lane & 15, g = lane >> 4;
    const bf16* DQ = (const bf16*)(A.ws + WS_DS_Q); const bf16* DK = (const bf16*)(A.ws + WS_DS_K); const bf16* DV = (const bf16*)(A.ws + WS_DS_V);
    const u64* MASK = (const u64*)(A.ws + WS_MASK); bf16* MIX = (bf16*)(A.ws + WS_MIX);
    unsigned* qhead = (unsigned*)(A.ws + WS_CTL) + CW_DSAQ + 64 * l + 16;
    const unsigned* kmaxw = (const unsigned*)(A.ws + WS_CTL) + CW_KMAX + 64 * l;
    LAS unsigned* unitw = (LAS unsigned*)(lds + MISC_OFF + MI_UNIT);
    const int ldkey = tid >> 3, ldch = tid & 7;
    for (;;) {
        __syncthreads();
        if (tid == 0) unitw[0] = atomicAdd(qhead, 1u);
        __syncthreads();
        const unsigned u = unitw[0];
        if (u >= (unsigned)(NB * 4 * (AT_NQT + 1))) break;
        const bool mini = u >= (unsigned)(NB * 4 * AT_NQT);
        const int qt = mini ? 0 : AT_NQT - 1 - (int)(u >> 5), b = (int)((u & 31u) >> 2), h = (int)(u & 3u);
        const size_t mb = (size_t)b * L;
        const int kmain = mini ? 0 : 4 * qt;
        const int nkt = mini ? 1 : ((4 * qt + 5 < AT_NKT) ? 4 * qt + 5 : AT_NKT);
        const float kmax2 = __uint_as_float(__hip_atomic_load(kmaxw + b * 4 + h, __ATOMIC_RELAXED, __HIP_MEMORY_SCOPE_AGENT));
        int tq[2], lb[2]; bool act[2];
        s8 qf[2][2]; float nc2[2];
        const GAS unsigned* mrow[2];
#pragma unroll
        for (int qi = 0; qi < 2; ++qi) { act[qi] = mini ? (wave == 0 && qi == 0) : true; tq[qi] = mini ? 0 : 16 + qt * 256 + wave * 32 + 16 * qi;
            lb[qi] = __builtin_amdgcn_readfirstlane(act[qi] ? ((tq[qi] + 15) >> 5) : -1);
            float qn2 = 0.f;
#pragma unroll
            for (int ks = 0; ks < 2; ++ks) { qf[qi][ks] = act[qi] ? *(const s8*)(DQ + (mb + tq[qi] + r) * 256 + h * 64 + 32 * ks + 8 * g) : (s8){0, 0, 0, 0, 0, 0, 0, 0};
#pragma unroll
                for (int e = 0; e < 8; ++e) { const float x = bf2f((unsigned short)qf[qi][ks][e]); qn2 += x * x; } }
            qn2 += __shfl_xor(qn2, 16); qn2 += __shfl_xor(qn2, 32);
            nc2[qi] = -sqrtf(qn2 * kmax2);
            const u64 mrow_u = (u64)(MASK + mask_row(l, b, tq[qi] >> 4) * 8);
            const unsigned lo = (unsigned)__builtin_amdgcn_readfirstlane((unsigned)mrow_u), hi = (unsigned)__builtin_amdgcn_readfirstlane((unsigned)(mrow_u >> 32));
            mrow[qi] = (const GAS unsigned*)(((u64)hi << 32) | (u64)lo); }
        pg8::f32x4 O[2][4], Ls[2];
#pragma unroll
        for (int qi = 0; qi < 2; ++qi) { Ls[qi] = (pg8::f32x4){0.f, 0.f, 0.f, 0.f};
#pragma unroll
            for (int db = 0; db < 4; ++db) O[qi][db] = (pg8::f32x4){0.f, 0.f, 0.f, 0.f}; }
        const s8 ones8 = (s8){0x3F80, 0x3F80, 0x3F80, 0x3F80, 0x3F80, 0x3F80, 0x3F80, 0x3F80};
#define AT_SLOAD(dst, qi_, kb_) asm volatile("s_load_dwordx16 %0, %1, 0x0" : "=s"(dst) : "s"(mrow[qi_] + (size_t)(kb_) * 16))
#define AT_MWAIT(m0_, m1_) asm volatile("s_waitcnt lgkmcnt(0)" : "+s"(m0_), "+s"(m1_))
#define AT_MWAIT_S2(a0_, a1_, b0_, b1_) asm volatile("s_waitcnt lgkmcnt(0)" : "+s"(a0_), "+s"(a1_), "+s"(b0_), "+s"(b1_), "+v"(Sa), "+v"(Sb), "+v"(Sc), "+v"(Sd), "+v"(Se), "+v"(Sf), "+v"(Sg), "+v"(Sh) :: "memory")
#define AT_MWAIT_O(a0_, a1_, b0_, b1_) asm volatile("s_waitcnt lgkmcnt(0)" : "+s"(a0_), "+s"(a1_), "+s"(b0_), "+s"(b1_), "+v"(O[1][0]), "+v"(O[1][1]), "+v"(O[1][2]), "+v"(O[1][3]), "+v"(Ls[1]) :: "memory")
        const bf16* kg = DK + (mb + ldkey) * 256 + h * 64 + ldch * 8; const bf16* vg = DV + (mb + ldkey) * 256 + h * 64 + ldch * 8;
        v4u rk0 = *(const v4u*)kg, rv0 = *(const v4u*)vg;
        const size_t to1 = (size_t)(nkt > 1 ? 1 : nkt - 1) * 64 * 256, to2 = (size_t)(nkt > 2 ? 2 : nkt - 1) * 64 * 256, to3 = (size_t)(nkt > 3 ? 3 : nkt - 1) * 64 * 256;
        v4u rk1 = *(const v4u*)(kg + to1), rv1 = *(const v4u*)(vg + to1), rk2 = *(const v4u*)(kg + to2), rv2 = *(const v4u*)(vg + to2), rk3 = *(const v4u*)(kg + to3), rv3 = *(const v4u*)(vg + to3);
        u16v m0, m1, n0, n1;
#define AT_STORE(boff, rk, rv) do { LAS unsigned char* kb_ = lds + (boff); LAS unsigned char* vb_ = kb_ + AT_TILE; \
            *(LAS v4u*)(kb_ + ldkey * AT_ROW + ldch * 16) = rk; *(LAS v4u*)(vb_ + ldkey * AT_ROW + ldch * 16) = rv; } while (0)
#define AT_LOAD(kt_, rk, rv) do { rk = *(const v4u*)(kg + (size_t)(kt_) * 64 * 256); rv = *(const v4u*)(vg + (size_t)(kt_) * 64 * 256); } while (0)
#define AT_KREAD(boff, blk) do { const LAS unsigned char* ka = lds + (boff) + ((blk) * 32 + 8 * (r >> 2) + (r & 3)) * AT_ROW + g * 16; \
            _Pragma("unroll") for (int ks = 0; ks < 2; ++ks) { kf[blk][ks][0] = *(const LAS s8*)(ka + ks * 64); kf[blk][ks][1] = *(const LAS s8*)(ka + 4 * AT_ROW + ks * 64); } } while (0)
#define AT_VREAD(boff, blk) do { const LAS unsigned char* va = lds + (boff) + AT_TILE + ((blk) * 32 + 8 * g + (r >> 2)) * AT_ROW + (r & 3) * 8; \
            _Pragma("unroll") for (int db = 0; db < 4; ++db) { \
                const v4i16_t x0 = __builtin_amdgcn_ds_read_tr16_b64_v4i16((LAS v4i16_t*)(va + db * 32)), x1 = __builtin_amdgcn_ds_read_tr16_b64_v4i16((LAS v4i16_t*)(va + 4 * AT_ROW + db * 32)); \
                vf[blk][db] = (s8){x0[0], x0[1], x0[2], x0[3], x1[0], x1[1], x1[2], x1[3]}; } } while (0)
#define AT_BLK_S(blk, qi, S1, S2) do { S1 = (pg8::f32x4){nc2[qi], nc2[qi], nc2[qi], nc2[qi]}; S2 = S1; \
            _Pragma("unroll") for (int ks = 0; ks < 2; ++ks) { \
                S1 = __builtin_amdgcn_mfma_f32_16x16x32_bf16(kf[blk][ks][0], qf[qi][ks], S1, 0, 0, 0); S2 = __builtin_amdgcn_mfma_f32_16x16x32_bf16(kf[blk][ks][1], qf[qi][ks], S2, 0, 0, 0); } } while (0)
#define AT_BLK_P(mq, S1, S2, pa) do { float p[8]; \
            _Pragma("unroll") for (int j = 0; j < 8; ++j) { \
                const bool bit = __builtin_amdgcn_inverse_ballot_w64(((u64)mq[2 * j + 1] << 32) | mq[2 * j]); \
                p[j] = bit ? __builtin_amdgcn_exp2f(j < 4 ? S1[j & 3] : S2[j & 3]) : 0.f; } \
            v4u pk; pk.x = pk2(p[0], p[1]); pk.y = pk2(p[2], p[3]); pk.z = pk2(p[4], p[5]); pk.w = pk2(p[6], p[7]); \
            pa = __builtin_bit_cast(s8, pk); } while (0)
#define AT_BLK_V(blk, qi, pa) do { \
            _Pragma("unroll") for (int db = 0; db < 4; ++db) O[qi][db] = __builtin_amdgcn_mfma_f32_16x16x32_bf16(pa, vf[blk][db], O[qi][db], 0, 0, 0); \
            Ls[qi] = __builtin_amdgcn_mfma_f32_16x16x32_bf16(pa, ones8, Ls[qi], 0, 0, 0); } while (0)
#define AT_ROTATE do { const int t_ = bc; bc = bn; bn = bs; bs = t_; } while (0)
#define AT_MAIN_BODY(kt, RK_LD, RV_LD, RK_ST, RV_ST, LASTWAIT) do { \
            { const int ktn_ = (kt) + 5 < nkt ? (kt) + 5 : nkt - 1; AT_LOAD(ktn_, RK_LD, RV_LD); } \
            AT_STORE(bs, RK_ST, RV_ST); \
            pg8::f32x4 Sa, Sb, Sc, Sd, Se, Sf, Sg, Sh; s8 pa0, pa1, pb0, pb1; \
            AT_BLK_S(0, 0, Sa, Sb); AT_BLK_S(1, 0, Sc, Sd); AT_BLK_S(0, 1, Se, Sf); AT_BLK_S(1, 1, Sg, Sh);        \
            AT_MWAIT_S2(m0, m1, n0, n1); \
            AT_KREAD(bn, 0); AT_KREAD(bn, 1); \
            AT_BLK_P(m0, Sa, Sb, pa0); AT_SLOAD(m0, 0, 2 * (kt) + 2); AT_BLK_P(m1, Sc, Sd, pa1); AT_SLOAD(m1, 0, 2 * (kt) + 3); \
            AT_BLK_V(0, 0, pa0); AT_BLK_V(1, 0, pa1); \
            AT_BLK_P(n0, Se, Sf, pb0); AT_SLOAD(n0, 1, 2 * (kt) + 2); AT_BLK_P(n1, Sg, Sh, pb1); AT_SLOAD(n1, 1, 2 * (kt) + 3); \
            AT_BLK_V(0, 1, pb0); AT_BLK_V(1, 1, pb1); \
            if (LASTWAIT) AT_MWAIT_O(m0, m1, n0, n1);                   \
            AT_VREAD(bn, 0); AT_VREAD(bn, 1); \
            AT_ROTATE; \
            __builtin_amdgcn_s_barrier(); } while (0)
#define AT_DIAG_STEP(kt, qi) do { \
            if (2 * (kt) + 1 <= lb[qi]) { pg8::f32x4 Sa, Sb, Sc, Sd; s8 pa0, pa1; AT_SLOAD(m0, qi, 2 * (kt)); AT_SLOAD(m1, qi, 2 * (kt) + 1); \
                AT_BLK_S(0, qi, Sa, Sb); AT_BLK_S(1, qi, Sc, Sd); AT_MWAIT(m0, m1); AT_BLK_P(m0, Sa, Sb, pa0); AT_BLK_P(m1, Sc, Sd, pa1); AT_BLK_V(0, qi, pa0); AT_BLK_V(1, qi, pa1); } \
            else if (2 * (kt) <= lb[qi]) { pg8::f32x4 Sa, Sb; s8 pa0; AT_SLOAD(m0, qi, 2 * (kt)); AT_SLOAD(m1, qi, 2 * (kt)); \
                AT_BLK_S(0, qi, Sa, Sb); AT_MWAIT(m0, m1); AT_BLK_P(m0, Sa, Sb, pa0); AT_BLK_V(0, qi, pa0); } } while (0)
#define AT_DIAG_BODY(kt, RK_LD, RV_LD, RK_ST, RV_ST) do { \
            { const int ktn_ = (kt) + 5 < nkt ? (kt) + 5 : nkt - 1; AT_LOAD(ktn_, RK_LD, RV_LD); } \
            AT_STORE(bs, RK_ST, RV_ST); \
            if (2 * (kt) <= lb[1] || 2 * (kt) <= lb[0]) { \
                AT_KREAD(bc, 0); AT_KREAD(bc, 1); AT_VREAD(bc, 0); AT_VREAD(bc, 1); \
                AT_DIAG_STEP(kt, 0); AT_DIAG_STEP(kt, 1); } \
            asm volatile("s_waitcnt lgkmcnt(0)" ::: "memory"); \
            AT_ROTATE; \
            __builtin_amdgcn_s_barrier(); } while (0)
        int bc = 0, bn = 2 * AT_TILE, bs = 4 * AT_TILE;
        s8 kf[2][2][2], vf[2][4];
        AT_SLOAD(m0, 0, 0); AT_SLOAD(m1, 0, 1); AT_SLOAD(n0, 1, 0); AT_SLOAD(n1, 1, 1);
        AT_STORE(bc, rk0, rv0);
        AT_STORE(bn, rk1, rv1);
        AT_LOAD(nkt > 4 ? 4 : nkt - 1, rk0, rv0);
        AT_MWAIT(m0, m1); AT_MWAIT(n0, n1);
        __syncthreads();
        AT_KREAD(bc, 0); AT_KREAD(bc, 1); AT_VREAD(bc, 0); AT_VREAD(bc, 1);
#pragma unroll 1
        for (int kt = 0; kt < kmain; kt += 4) {
            AT_MAIN_BODY(kt, rk1, rv1, rk2, rv2, false);
            AT_MAIN_BODY(kt + 1, rk2, rv2, rk3, rv3, false);
            AT_MAIN_BODY(kt + 2, rk3, rv3, rk0, rv0, false);
            AT_MAIN_BODY(kt + 3, rk0, rv0, rk1, rv1, true);
        }
#pragma unroll 1
        for (int kt = kmain; kt < nkt; kt += 4) {
            AT_DIAG_BODY(kt, rk1, rv1, rk2, rv2);
            AT_DIAG_BODY(kt + 1, rk2, rv2, rk3, rv3);
            AT_DIAG_BODY(kt + 2, rk3, rv3, rk0, rv0);
            AT_DIAG_BODY(kt + 3, rk0, rv0, rk1, rv1);
        }
#undef AT_ROTATE
#undef AT_MAIN_BODY
#undef AT_DIAG_BODY
#undef AT_DIAG_STEP
#undef AT_BLK_S
#undef AT_BLK_P
#undef AT_BLK_V
#undef AT_KREAD
#undef AT_VREAD
#undef AT_SLOAD
#undef AT_MWAIT
#undef AT_MWAIT_S2
#undef AT_MWAIT_O
#undef AT_LOAD
#undef AT_STORE
#pragma unroll
        for (int qi = 0; qi < 2; ++qi)
#pragma unroll
            for (int j = 0; j < 4; ++j) { const float ij = Ls[qi][j] > 0.f ? 1.f / Ls[qi][j] : 0.f; const int t = tq[qi] + 4 * g + j;
                if (act[qi]) {
#pragma unroll
                    for (int db = 0; db < 4; ++db) MIX[(mb + t) * 1024 + 256 + h * 64 + db * 16 + r] = f2bf(O[qi][db][j] * ij); } }
    }
}
constexpr int CK = 16;
constexpr int NCHK = L / CK;
static_assert(L % CK == 0, "chunk length");
constexpr int CKP_RW = 10, CKP_HG = 7;
constexpr int CKR_RW = CKP_RW * 1024 + 512, CKR_HG = CKP_HG * 1024 + 256;
constexpr size_t WS_CKF_RW = WS_PROJ + 136 * MiB;
constexpr size_t WS_CKF_HG = WS_CKF_RW + (size_t)32 * NCHK * CKR_RW;
static_assert(WS_CKF_HG + (size_t)32 * NCHK * CKR_HG <= WS_PROJ + (size_t)TP * NINP * 2, "chunk fragments fit in the dead proj region");
__device__ __forceinline__ s8 pack8(const pg8::f32x4 lo, const pg8::f32x4 hi) { v4u p; p.x = pk2(lo[0], lo[1]); p.y = pk2(lo[2], lo[3]); p.z = pk2(hi[0], hi[1]); p.w = pk2(hi[2], hi[3]); return __builtin_bit_cast(s8, p); }
template <int CTRL> __device__ __forceinline__ float dpp_shr1(float x) { return __int_as_float(__builtin_amdgcn_update_dpp(0x3F800000, __float_as_int(x), CTRL, 0xF, 0xF, false)); }
__device__ __forceinline__ float row_cumprod(float x) { x *= dpp_shr1<0x111>(x); x *= dpp_shr1<0x112>(x); x *= dpp_shr1<0x114>(x); x *= dpp_shr1<0x118>(x); return x; }

template <bool RWKV>
__device__ __forceinline__ void chunk_prep_item(const Ctx A, int bh, int c, int lane) {
    const int r = lane & 15, g = lane >> 4;
    const size_t base = ((size_t)bh * L + (size_t)c * CK + r) * 64;
    const float* Wg = (const float*)(A.ws + (RWKV ? WS_RW_W : WS_HG_F)) + base;
    const bf16* Ag = (const bf16*)(A.ws + WS_RW_A) + base; const bf16* Bg = (const bf16*)(A.ws + WS_RW_B) + base;
    const bf16* Kg = (const bf16*)(A.ws + (RWKV ? WS_RW_K : WS_HG_K)) + base; const bf16* Rg = (const bf16*)(A.ws + (RWKV ? WS_RW_WR : WS_HG_Q)) + base;
    GAS unsigned char* recb = A.ws + (RWKV ? WS_CKF_RW : WS_CKF_HG) + ((size_t)bh * NCHK + c) * (RWKV ? CKR_RW : CKR_HG);
    v4u* REC = (v4u*)recb + lane; v4f* GCp = (v4f*)(recb + (RWKV ? CKP_RW : CKP_HG) * 1024); float* Dp = (float*)(recb + CKP_RW * 1024 + 256);
    s8 Af[2], Bf[2], Kf[2], Rf[2], BTf[2], KTf[2];
    v4f gcv[4];
#pragma unroll
    for (int ks = 0; ks < 2; ++ks) {
        pg8::f32x4 ah[2], bh_[2], kh[2], rh[2], bt[2], kt[2];
#pragma unroll
        for (int hf = 0; hf < 2; ++hf) {
            const int k0 = 32 * ks + 16 * hf + 4 * g;
            const v4f w4 = *(const v4f*)(Wg + k0);
            v4f gt, gm, gc;
#pragma unroll
            for (int e = 0; e < 4; ++e) { gt[e] = row_cumprod(w4[e]); gm[e] = dpp_shr1<0x111>(gt[e]); gc[e] = __shfl(gt[e], 16 * g + 15); }
            gcv[2 * ks + hf] = gc;
            v4f inv; inv.x = __builtin_amdgcn_rcpf(gt.x); inv.y = __builtin_amdgcn_rcpf(gt.y); inv.z = __builtin_amdgcn_rcpf(gt.z); inv.w = __builtin_amdgcn_rcpf(gt.w);
            const v4f kk4 = ld_bf4(Kg + k0) * inv, rr4 = ld_bf4(Rg + k0) * (RWKV ? gm : gt);
            kh[hf] = kk4; rh[hf] = rr4; kt[hf] = kk4 * gc;
            if (RWKV) { ah[hf] = ld_bf4(Ag + k0) * gm; bh_[hf] = ld_bf4(Bg + k0) * inv; bt[hf] = bh_[hf] * gc; }
        }
        Kf[ks] = pack8(kh[0], kh[1]); Rf[ks] = pack8(rh[0], rh[1]); KTf[ks] = pack8(kt[0], kt[1]);
        if (RWKV) { Af[ks] = pack8(ah[0], ah[1]); Bf[ks] = pack8(bh_[0], bh_[1]); BTf[ks] = pack8(bt[0], bt[1]); }
    }
    const pg8::f32x4 z4 = (pg8::f32x4){0.f, 0.f, 0.f, 0.f};
    s8 selE, selO;
    { v4u e = (v4u){0u, 0u, 0u, 0u}, o = e; const int jj = r - 4 * g;
      if (jj >= 0 && jj < 4) { const unsigned one = 0x3F80u << (16 * (jj & 1)); if (jj < 2) { e.x = one; o.z = one; } else { e.y = one; o.w = one; } }
      selE = __builtin_bit_cast(s8, e); selO = __builtin_bit_cast(s8, o); }
    pg8::f32x4 MrkT = __builtin_amdgcn_mfma_f32_16x16x32_bf16(Kf[0], Rf[0], z4, 0, 0, 0); MrkT = __builtin_amdgcn_mfma_f32_16x16x32_bf16(Kf[1], Rf[1], MrkT, 0, 0, 0);
    const int tb = r >> 2, tj = r & 3;
    if (RWKV) {
        pg8::f32x4 LabT = __builtin_amdgcn_mfma_f32_16x16x32_bf16(Bf[0], Af[0], z4, 0, 0, 0); LabT = __builtin_amdgcn_mfma_f32_16x16x32_bf16(Bf[1], Af[1], LabT, 0, 0, 0);
        pg8::f32x4 LakT = __builtin_amdgcn_mfma_f32_16x16x32_bf16(Kf[0], Af[0], z4, 0, 0, 0); LakT = __builtin_amdgcn_mfma_f32_16x16x32_bf16(Kf[1], Af[1], LakT, 0, 0, 0);
        pg8::f32x4 MrbT = __builtin_amdgcn_mfma_f32_16x16x32_bf16(Bf[0], Rf[0], z4, 0, 0, 0); MrbT = __builtin_amdgcn_mfma_f32_16x16x32_bf16(Bf[1], Rf[1], MrbT, 0, 0, 0);
        const float d10 = __shfl(LabT[0], 20 * g + 1), d20 = __shfl(LabT[0], 20 * g + 2), d21 = __shfl(LabT[1], 20 * g + 2);
        const float d30 = __shfl(LabT[0], 20 * g + 3), d31 = __shfl(LabT[1], 20 * g + 3), d32 = __shfl(LabT[2], 20 * g + 3);
        pg8::f32x4 Loff, Lak, Mrb, Mrk;
#pragma unroll
        for (int j = 0; j < 4; ++j) { const bool below = g < tb, diag = g == tb;
            Loff[j] = below ? LabT[j] : 0.f; Lak[j] = (below || (diag && j < tj)) ? LakT[j] : 0.f;
            Mrb[j] = (below || (diag && j <= tj)) ? MrbT[j] : 0.f; Mrk[j] = (below || (diag && j <= tj)) ? MrkT[j] : 0.f; }
        REC[0 * 64] = __builtin_bit_cast(v4u, Af[0]); REC[1 * 64] = __builtin_bit_cast(v4u, Af[1]); REC[2 * 64] = __builtin_bit_cast(v4u, Rf[0]); REC[3 * 64] = __builtin_bit_cast(v4u, Rf[1]);
        REC[4 * 64] = __builtin_bit_cast(v4u, pack8(Loff, Lak)); REC[5 * 64] = __builtin_bit_cast(v4u, pack8(Mrb, Mrk));
        if (r == 0) { *(v4f*)(Dp + 8 * g) = (v4f){d10, d20, d21, d30}; *(v4f*)(Dp + 8 * g + 4) = (v4f){d31, d32, 0.f, 0.f}; }
#pragma unroll
        for (int mt = 0; mt < 4; ++mt) { const s8 sel = (mt & 1) ? selO : selE;
            const pg8::f32x4 K2 = __builtin_amdgcn_mfma_f32_16x16x32_bf16(KTf[mt >> 1], sel, z4, 0, 0, 0), B2 = __builtin_amdgcn_mfma_f32_16x16x32_bf16(BTf[mt >> 1], sel, z4, 0, 0, 0);
            REC[(6 + mt) * 64] = __builtin_bit_cast(v4u, pack8(B2, K2)); if (r == 15) GCp[4 * mt + g] = gcv[mt]; }
    } else {
        pg8::f32x4 Mrk;
#pragma unroll
        for (int j = 0; j < 4; ++j) Mrk[j] = (g < tb || (g == tb && j <= tj)) ? MrkT[j] : 0.f;
        REC[0 * 64] = __builtin_bit_cast(v4u, Rf[0]); REC[1 * 64] = __builtin_bit_cast(v4u, Rf[1]); REC[2 * 64] = __builtin_bit_cast(v4u, pack8(z4, Mrk));
#pragma unroll
        for (int mt = 0; mt < 4; ++mt) { const s8 sel = (mt & 1) ? selO : selE;
            const pg8::f32x4 K2 = __builtin_amdgcn_mfma_f32_16x16x32_bf16(KTf[mt >> 1], sel, z4, 0, 0, 0);
            REC[(3 + mt) * 64] = __builtin_bit_cast(v4u, pack8(z4, K2)); if (r == 15) GCp[4 * mt + g] = gcv[mt]; }
    }
}
__device__ PHASE_FN void chunk_prep_phase(const Ctx A, int vcu, int G) {
    const int tid = opaque_tid(), lane = tid & 63, wave = tid >> 6;
    const int gw = vcu * NWAVES + wave, NGW = G * NWAVES;
#pragma unroll 1
    for (int it = gw; it < 2 * 32 * NCHK; it += NGW) {
        const int mix = it >= 32 * NCHK, q = mix ? it - 32 * NCHK : it, bh = q / NCHK, c = q - bh * NCHK;
        if (mix) chunk_prep_item<false>(A, bh, c, lane); else chunk_prep_item<true>(A, bh, c, lane);
    }
}
template <bool RWKV>
__device__ PHASE_FN void chunk_scan(const Ctx A, LAS unsigned char* lds, int unit_) {
    const int unit = opaque_s(unit_);
    const int tid = opaque_tid(), lane = tid & 63, wave = tid >> 6, r = lane & 15, g = lane >> 4;
    const int slot = wave >> 2, nt = wave & 3;
    const int bh = 2 * unit + slot, b = bh >> 2, h = bh & 3;
    constexpr int NP = RWKV ? CKP_RW : CKP_HG;
    constexpr int NU = NP + 3;
    constexpr int NQ = (NU + 3) / 4;
    constexpr int RING = NU * 1024;
    constexpr size_t RB = RWKV ? CKR_RW : CKR_HG;
    const GAS unsigned char* recb = A.ws + (RWKV ? WS_CKF_RW : WS_CKF_HG) + (size_t)bh * NCHK * RB;
    const GAS unsigned char* vb = A.ws + (RWKV ? WS_RW_V : WS_HG_V) + (size_t)bh * L * 128;
    float* YR = (float*)(A.ws + (RWKV ? WS_YRAW : WS_ORAW)) + (size_t)b * L * 256 + h * 64 + nt * 16 + r;
    LAS unsigned char* ring = lds + slot * 2 * RING;
    static_assert(4 * (size_t)(CKP_RW + 3) * 1024 <= MISC_OFF, "chunk ring");
    auto unit_src = [&](int c_, int u) -> const GAS v4u* {
        if (u < NP) return (const GAS v4u*)(recb + (size_t)c_ * RB + u * 1024) + lane;
        if (u == NP) { const int q = lane * 16 < (int)(RB - NP * 1024) ? lane * 16 : (int)(RB - NP * 1024) - 16; return (const GAS v4u*)(recb + (size_t)c_ * RB + NP * 1024 + q); }
        return (const GAS v4u*)(vb + (size_t)c_ * CK * 128 + (u - NP - 1) * 1024) + lane; };
    v4u st0[NQ], st1[NQ], st2[NQ], st3[NQ];
#define CK_LD(S, c_) do { const int cc_ = (c_) < NCHK ? (c_) : NCHK - 1; _Pragma("unroll") for (int q = 0; q < NQ; ++q) { const int u = nt + 4 * q; if (u < NU) S[q] = *unit_src(cc_, u); } } while (0)
#define CK_ST(S, p_) do { _Pragma("unroll") for (int q = 0; q < NQ; ++q) { const int u = nt + 4 * q; if (u < NU) *(LAS v4u*)(ring + (p_) * RING + u * 1024 + lane * 16) = S[q]; } } while (0)
    pg8::f32x4 ST[4];
#pragma unroll
    for (int mt = 0; mt < 4; ++mt) ST[mt] = (pg8::f32x4){0.f, 0.f, 0.f, 0.f};
    const pg8::f32x4 z4 = (pg8::f32x4){0.f, 0.f, 0.f, 0.f};
    auto body = [&](const int c, const int p) __attribute__((always_inline)) {
        const LAS unsigned char* rb_ = ring + p * RING;
        const LAS unsigned char* sm = rb_ + NP * 1024;
        v4u pcs[NP]; v4f gqs[4]; v4f da = (v4f){0.f, 0.f, 0.f, 0.f}, db = da;
#pragma unroll
        for (int i = 0; i < NP; ++i) pcs[i] = *(const LAS v4u*)(rb_ + i * 1024 + lane * 16);
#pragma unroll
        for (int mt = 0; mt < 4; ++mt) gqs[mt] = *(const LAS v4f*)(sm + (16 * mt + 4 * g) * 4);
        if (RWKV) { da = *(const LAS v4f*)(sm + 256 + g * 32); db = *(const LAS v4f*)(sm + 256 + g * 32 + 16); }
#define PIECE(i) __builtin_bit_cast(s8, pcs[i])
        unsigned vp0, vp1;
        { const LAS unsigned short* vv = (const LAS unsigned short*)(rb_ + (NP + 1) * 1024) + (4 * g) * 64 + 16 * nt + r;
          vp0 = (unsigned)vv[0] | ((unsigned)vv[64] << 16); vp1 = (unsigned)vv[128] | ((unsigned)vv[192] << 16); }
        __builtin_amdgcn_sched_barrier(0);
        const s8 Sf0 = pack8(ST[0], ST[1]), Sf1 = pack8(ST[2], ST[3]);
        pg8::f32x4 U = z4, R0;
        if (RWKV) {
            R0 = __builtin_amdgcn_mfma_f32_16x16x32_bf16(PIECE(2), Sf0, z4, 0, 0, 0); R0 = __builtin_amdgcn_mfma_f32_16x16x32_bf16(PIECE(3), Sf1, R0, 0, 0, 0);
            pg8::f32x4 W0 = __builtin_amdgcn_mfma_f32_16x16x32_bf16(PIECE(0), Sf0, z4, 0, 0, 0); W0 = __builtin_amdgcn_mfma_f32_16x16x32_bf16(PIECE(1), Sf1, W0, 0, 0, 0);
            const float d10 = da.x, d20 = da.y, d21 = da.z, d30 = da.w, d31 = db.x, d32 = db.y;
            const s8 Ajac = PIECE(4);
#pragma unroll
            for (int rnd = 0; rnd < 4; ++rnd) {
                v4u bu; bu.x = pk2(U[0], U[1]); bu.y = pk2(U[2], U[3]); bu.z = vp0; bu.w = vp1;
                const pg8::f32x4 Wr = __builtin_amdgcn_mfma_f32_16x16x32_bf16(Ajac, __builtin_bit_cast(s8, bu), W0, 0, 0, 0);
                U[0] = Wr[0]; U[1] = Wr[1] + d10 * U[0]; U[2] = Wr[2] + d20 * U[0] + d21 * U[1]; U[3] = Wr[3] + d30 * U[0] + d31 * U[1] + d32 * U[2];
            }
        } else {
            R0 = __builtin_amdgcn_mfma_f32_16x16x32_bf16(PIECE(0), Sf0, z4, 0, 0, 0); R0 = __builtin_amdgcn_mfma_f32_16x16x32_bf16(PIECE(1), Sf1, R0, 0, 0, 0);
        }
        v4u buv; buv.x = pk2(U[0], U[1]); buv.y = pk2(U[2], U[3]); buv.z = vp0; buv.w = vp1;
        const s8 Buv = __builtin_bit_cast(s8, buv);
        const pg8::f32x4 Yt = __builtin_amdgcn_mfma_f32_16x16x32_bf16(PIECE(RWKV ? 5 : 2), Buv, R0, 0, 0, 0);
#pragma unroll
        for (int j = 0; j < 4; ++j) YR[(size_t)(c * CK + 4 * g + j) * 256] = Yt[j];
#pragma unroll
        for (int mt = 0; mt < 4; ++mt) {
            const v4f gq = gqs[mt];
            ST[mt][0] *= gq.x; ST[mt][1] *= gq.y; ST[mt][2] *= gq.z; ST[mt][3] *= gq.w;
            ST[mt] = __builtin_amdgcn_mfma_f32_16x16x32_bf16(PIECE((RWKV ? 6 : 3) + mt), Buv, ST[mt], 0, 0, 0);
        }
#undef PIECE
    };
    CK_LD(st0, 0); CK_LD(st1, 1); CK_LD(st2, 2); CK_LD(st3, 3);
    CK_ST(st0, 0);
    __syncthreads();
#define CK_TRIP(c_, SLD, SST, p_) do { CK_LD(SLD, (c_) + 4); body((c_), (p_)); CK_ST(SST, 1 - (p_)); __syncthreads(); } while (0)
    static_assert(NCHK % 4 == 1, "chunk loop: whole groups of four trips + one");
#pragma unroll 1
    for (int c = 0; c < NCHK - 1; c += 4) {
        CK_TRIP(c, st0, st1, 0);
        CK_TRIP(c + 1, st1, st2, 1);
        CK_TRIP(c + 2, st2, st3, 0);
        CK_TRIP(c + 3, st3, st0, 1);
    }
    CK_TRIP(NCHK - 1, st0, st1, 0);
#undef CK_TRIP
#undef CK_LD
#undef CK_ST
}
__device__ __forceinline__ float rowmax16(float x) { x = fmaxf(x, dpp_f<0xB1>(x)); x = fmaxf(x, dpp_f<0x4E>(x)); x = fmaxf(x, dpp_f<0x141>(x)); x = fmaxf(x, dpp_f<0x140>(x)); return x; }
__device__ __forceinline__ int rowmin16i(int x) { x = min(x, __builtin_amdgcn_update_dpp(0, x, 0xB1, 0xF, 0xF, true)); x = min(x, __builtin_amdgcn_update_dpp(0, x, 0x4E, 0xF, 0xF, true));
    x = min(x, __builtin_amdgcn_update_dpp(0, x, 0x141, 0xF, 0xF, true)); x = min(x, __builtin_amdgcn_update_dpp(0, x, 0x140, 0xF, 0xF, true)); return x; }
__device__ PHASE_FN void ln_router_phase(const Ctx A, LAS unsigned char* lds, int l, int vcu, int G) {
    const int tid = opaque_tid(), lane = tid & 63, wave = tid >> 6, r = lane & 15, g = lane >> 4;
    const int gw = vcu * NWAVES + wave, NGW = G * NWAVES;
    bf16* HB = (bf16*)(A.ws + WS_HB);
    int* TIDX = (int*)(A.ws + WS_TIDX); float* TGATE = (float*)(A.ws + WS_TGATE);
    unsigned* ecnt = (unsigned*)(A.ws + WS_CTL) + CW_ECNT + 64 * l;
    const float* gg = gin(A, 26) + l * D; const float* bb = gin(A, 27) + l * D;
    const float* rw = gin(A, 28) + (size_t)l * D * NE; const float* rb = gin(A, 29) + l * NE;
    LAS int* hist = (LAS int*)(lds + MISC_OFF + MI_HIST);
    if (tid < 32) hist[tid] = 0;
    for (int f = tid; f < 32 * 2 * 64; f += NTHR) { const int ks = f >> 7, nt = (f >> 6) & 1, ln = f & 63, n = ln & 15, g8 = ln >> 4;
        float w8[8];
#pragma unroll
        for (int e = 0; e < 8; ++e) w8[e] = rw[(size_t)(32 * ks + 8 * g8 + e) * NE + 16 * nt + n];
        v4u hi, lo; unsigned hh[4], ll[4];
#pragma unroll
        for (int e = 0; e < 4; ++e) { const unsigned ph = pk2(w8[2 * e], w8[2 * e + 1]); hh[e] = ph; ll[e] = pk2(w8[2 * e] - bflo(ph), w8[2 * e + 1] - bfhi(ph)); }
        hi = (v4u){hh[0], hh[1], hh[2], hh[3]}; lo = (v4u){ll[0], ll[1], ll[2], ll[3]};
        *(LAS v4u*)(lds + ((size_t)((ks * 2 + nt) * 2 + 0) * 64 + ln) * 16) = hi; *(LAS v4u*)(lds + ((size_t)((ks * 2 + nt) * 2 + 1) * 64 + ln) * 16) = lo; }
    __syncthreads();
    const float rb0 = rb[r], rb1 = rb[16 + r];
    auto lnrows = [&](size_t mrow, auto nrows_c) {
        constexpr int NR = decltype(nrows_c)::value;
        v4f x[NR][4];
#pragma unroll
        for (int u = 0; u < NR; ++u)
#pragma unroll
            for (int j = 0; j < 4; ++j) x[u][j] = ld_bf4(HB + (mrow + u) * D + 256 * j + 4 * lane);
#pragma unroll
        for (int u = 0; u < NR; ++u) { ln_row(x[u], gg, bb, lane);
#pragma unroll
            for (int j = 0; j < 4; ++j) { const size_t o = (mrow + u) * D + 256 * j + 4 * lane;
                v2u hi; hi.x = pk2(x[u][j].x, x[u][j].y); hi.y = pk2(x[u][j].z, x[u][j].w);
                *(v2u*)(HB + o) = hi; } }
    };
    auto ln2 = [&](size_t mrow) { lnrows(mrow, std::integral_constant<int, 2>{}); };
    auto route = [&](size_t m0) {
        pg8::f32x4 C0 = (pg8::f32x4){0.f, 0.f, 0.f, 0.f}, C1 = C0;
        const bf16* ah = HB + (m0 + r) * D + 8 * g;
#pragma unroll 4
        for (int ks = 0; ks < 32; ++ks) {
            const s8 xh = *(const s8*)(ah + 32 * ks);
            const LAS unsigned char* wf = lds + (size_t)(ks * 4) * 1024 + lane * 16;
            const s8 w0h = *(const LAS s8*)(wf), w0l = *(const LAS s8*)(wf + 1024), w1h = *(const LAS s8*)(wf + 2048), w1l = *(const LAS s8*)(wf + 3072);
            C0 = __builtin_amdgcn_mfma_f32_16x16x32_bf16(xh, w0h, C0, 0, 0, 0); C0 = __builtin_amdgcn_mfma_f32_16x16x32_bf16(xh, w0l, C0, 0, 0, 0);
            C1 = __builtin_amdgcn_mfma_f32_16x16x32_bf16(xh, w1h, C1, 0, 0, 0); C1 = __builtin_amdgcn_mfma_f32_16x16x32_bf16(xh, w1l, C1, 0, 0, 0);
        }
#pragma unroll
        for (int j = 0; j < 4; ++j) {
            float v0 = C0[j] + rb0, v1 = C1[j] + rb1;
            float tv[4]; int ti[4];
#pragma unroll
            for (int q = 0; q < 4; ++q) {
                const float mx = rowmax16(fmaxf(v0, v1));
                const int cand = (v0 == mx) ? r : ((v1 == mx) ? 16 + r : 64);
                const int bi = rowmin16i(cand);
                tv[q] = mx; ti[q] = bi;
                if (bi == r) v0 = -3.0e38f; if (bi == 16 + r) v1 = -3.0e38f;
            }
            const float e1 = __expf(tv[1] - tv[0]), e2 = __expf(tv[2] - tv[0]), e3 = __expf(tv[3] - tv[0]); const float inv = rcp_(1.f + e1 + e2 + e3);
            const size_t m = m0 + 4 * g + j;
            if (r == 0) { *(int4*)(TIDX + m * 4) = make_int4(ti[0], ti[1], ti[2], ti[3]); *(v4f*)(TGATE + m * 4) = (v4f){inv, e1 * inv, e2 * inv, e3 * inv}; }
            if (r < 4) lds_add(&hist[r == 0 ? ti[0] : r == 1 ? ti[1] : r == 2 ? ti[2] : ti[3]], 1);
        }
    };
    const int NT16 = T / 16, nfull = (NT16 / NGW) * NGW;
#pragma unroll 1
    for (int tile = gw; tile < nfull; tile += NGW) {
        const size_t m0 = (size_t)tile * 16;
#pragma unroll 1
        for (int t = 0; t < 16; t += 4) lnrows(m0 + t, std::integral_constant<int, 4>{});
        asm volatile("s_waitcnt vmcnt(0)" ::: "memory");
        route(m0);
    }
#pragma unroll 1
    for (int tile = nfull + vcu; tile < NT16; tile += G) {
        const size_t m0 = (size_t)tile * 16;
        ln2(m0 + 2 * wave);
        asm volatile("s_waitcnt vmcnt(0)" ::: "memory");
        __syncthreads();
        if (wave == 0) route(m0);
    }
    __syncthreads();
    if (tid < 32) atomicAdd(&ecnt[tid], (unsigned)hist[tid]);
}
__device__ __forceinline__ int build_tiles(const Ctx A, LAS unsigned char* lds, int l) {
    const int tid = opaque_tid();
    const unsigned* ecnt = (const unsigned*)(A.ws + WS_CTL) + CW_ECNT + 64 * l;
    LAS int* offs = (LAS int*)(lds + MISC_OFF + MI_OFFS); LAS int* tile_e = (LAS int*)(lds + MISC_OFF + MI_TILE); LAS int* nt = (LAS int*)(lds + MISC_OFF + MI_NT);
    __syncthreads();
    if (tid < 32) { int off = 0, mycnt = 0;
        for (int e = 0; e < 32; ++e) { const int c = (int)__hip_atomic_load(ecnt + e, __ATOMIC_RELAXED, __HIP_MEMORY_SCOPE_AGENT); if (e < tid) off += (c + 255) & ~255; if (e == tid) mycnt = c; }
        offs[tid] = off;
        const int t0 = off >> 8, t1 = (off + ((mycnt + 255) & ~255)) >> 8;
        for (int t = t0; t < t1; ++t) tile_e[t] = tid;
        if (tid == 31) nt[0] = t1; }
    __syncthreads();
    return nt[0];
}
__device__ PHASE_FN void moe_sort_phase(const Ctx A, LAS unsigned char* lds, int l) {
    const int tid = opaque_tid();
    const int* TIDX = (const int*)(A.ws + WS_TIDX); const float* TGATE = (const float*)(A.ws + WS_TGATE);
    int* SPOS = (int*)(A.ws + WS_SPOS); float* GSORT = (float*)(A.ws + WS_GSORT); int* RMAP = (int*)(A.ws + WS_RMAP);
    unsigned* ecur = (unsigned*)(A.ws + WS_CTL) + CW_ECUR + 64 * l; const unsigned* ecnt = (const unsigned*)(A.ws + WS_CTL) + CW_ECNT + 64 * l;
    LAS int* hist = (LAS int*)(lds + MISC_OFF + MI_HIST); LAS int* lcur = (LAS int*)(lds + MISC_OFF + MI_LCUR); LAS int* lbase = (LAS int*)(lds + MISC_OFF + MI_LBASE);
    LAS int* offs = (LAS int*)(lds + MISC_OFF + MI_OFFS);
    (void)build_tiles(A, lds, l);
    const int TPB = (T + (int)gridDim.x - 1) / (int)gridDim.x;
    const int mbeg = blockIdx.x * TPB, mend = (mbeg + TPB < T) ? mbeg + TPB : T;
    const int nslot = (mend > mbeg) ? (mend - mbeg) * 4 : 0;
    if (tid < 32) { hist[tid] = 0; lcur[tid] = 0; }
    __syncthreads();
    for (int s = tid; s < nslot; s += NTHR) lds_add(&hist[TIDX[(size_t)mbeg * 4 + s]], 1);
    __syncthreads();
    if (tid < 32) lbase[tid] = offs[tid] + (int)atomicAdd(&ecur[tid], (unsigned)hist[tid]);
    __syncthreads();
    for (int s = tid; s < nslot; s += NTHR) { const size_t gs = (size_t)mbeg * 4 + s; const int e = TIDX[gs];
        const int pos = lbase[e] + lds_add(&lcur[e], 1);
        SPOS[gs] = pos; GSORT[pos] = TGATE[gs]; RMAP[pos] = mbeg + (s >> 2); }
    if (blockIdx.x < 32) { const int e = blockIdx.x; const int c = (int)__hip_atomic_load(ecnt + e, __ATOMIC_RELAXED, __HIP_MEMORY_SCOPE_AGENT);
        const int p0 = offs[e] + c, p1 = offs[e] + ((c + 255) & ~255);
        for (int p = p0 + tid; p < p1; p += NTHR) RMAP[p] = 0; }
}
__device__ PHASE_FN void combine_ln_phase(const Ctx A, int l, int vcu, int G) {
    const int tid = opaque_tid(), lane = tid & 63, wave = tid >> 6;
    const int gw = vcu * NWAVES + wave, NGW = G * NWAVES;
    bf16* HB = (bf16*)(A.ws + WS_HB); const bf16* Y = (const bf16*)(A.ws + WS_YBUF); const int* SPOS = (const int*)(A.ws + WS_SPOS);
    const float* g = gin(A, 34) + l * D; const float* bb = gin(A, 35) + l * D;
#pragma unroll 1
    for (int m0 = 2 * gw; m0 < T; m0 += 2 * NGW) {
        v4f v[2][4];
#pragma unroll
        for (int t = 0; t < 2; ++t) { const int m = m0 + t;
            const int4 sp = *(const int4*)(SPOS + (size_t)m * 4);
#pragma unroll
            for (int j = 0; j < 4; ++j) { const size_t co = 256 * j + 4 * lane;
                const v4f y = ld_bf4(Y + (size_t)sp.x * D + co) + ld_bf4(Y + (size_t)sp.y * D + co) + ld_bf4(Y + (size_t)sp.z * D + co) + ld_bf4(Y + (size_t)sp.w * D + co);
                v[t][j] = ld_bf4(HB + (size_t)m * D + co) * ALPHA + y; } }
#pragma unroll
        for (int t = 0; t < 2; ++t) { const int m = m0 + t;
            ln_row(v[t], g, bb, lane);
            if (l == 0) {
#pragma unroll
                for (int j = 0; j < 4; ++j) st_bf4(HB + (size_t)m * D + 256 * j + 4 * lane, v[t][j]);
            } else {
                const int b = m / L, i = m - b * L;
                if (i >= NMETA) { float* o = (float*)(GAS float*)A.out + ((size_t)b * SEQ + (i - NMETA)) * D;
#pragma unroll
                    for (int j = 0; j < 4; ++j) *(v4f*)(o + 256 * j + 4 * lane) = v[t][j]; }
            }
        }
    }
}
constexpr int N_PHASES = 23;
#ifndef PH_ONLY
#define PH_ONLY -1
#endif
#define PHSEL(j) (PH_ONLY < 0 || PH_ONLY == (j))
#define IN(k) (lo <= (k) && (k) < hi)
#if MK_ONE_LAUNCH
#define GRID_BAR() xcd_barrier(bar)
#else
#define GRID_BAR() do { } while (0)
#endif
#define SEAM(k) do { if (IN(k) && IN((k) + 1)) GRID_BAR(); } while (0)
#define CTX() Ctx{args.in, args.out, launder(args.ws)}
#ifndef PROBE_PHASE
#define PROBE_PHASE -1
#endif
#ifndef PROBE_MULT
#define PROBE_MULT 4
#endif
#define PB_BEGIN(j) do { if (PROBE_PHASE == (j)) { pstamp = __builtin_amdgcn_s_memrealtime(); } } while (0)
#define PB_END(j) do { if (PROBE_PHASE == (j)) { pacc += __builtin_amdgcn_s_memrealtime() - pstamp; } } while (0)
__device__ __forceinline__ void layer_phases(const int l, const Args& args, LAS unsigned char* lds, const int G, const int bx, const int vcu, const int lo, const int hi, const XcdBarrier& bar, unsigned long long& pacc) {
    unsigned long long pstamp = 0ull; (void)pstamp;

        const int pb = 1 + 11 * l;
        PB_BEGIN(0);
        if (PHSEL(0) && IN(pb + 0)) { GAS unsigned char* wsl = launder(args.ws);
            pg8::Gemm g{(const pg8::bf16_t*)(wsl + WS_HB), (const pg8::bf16_t*)(wsl + WS_WIN) + (size_t)l * NINP * 1024, TP, NINP, 1024};
            pg8::StaticOrder S; S.init(TP, NINP, G, bx);
            pg8::EpiStoreBf16 E{(pg8::bf16_t*)(wsl + WS_PROJ), NINP};
            pg8::gemm_phase<pg8::EpiStoreBf16, pg8::StaticOrder, true, true>(lds, g, S, E);
            SEAM(pb + 0); PB_END(0);
        }
        PB_BEGIN(1);
        if (PHSEL(1) && IN(pb + 1)) { prep_phase(CTX(), lds, l, vcu, G); SEAM(pb + 1); PB_END(1); }
        PB_BEGIN(2);
        if (PHSEL(2) && IN(pb + 2)) { chunk_prep_phase(CTX(), vcu, G); lru_agg_phase(CTX(), vcu, G); SEAM(pb + 2); PB_END(2); }
        PB_BEGIN(3);
        if (PHSEL(3) && IN(pb + 3)) {
#ifndef PH2_SEL
#define PH2_SEL 15
#endif
            PB_BEGIN(20); PB_BEGIN(21); PB_BEGIN(22); PB_BEGIN(23);
#if SCAN_SEQ
            if ((PH2_SEL & 1) && bx < 64) rwkv_scan(CTX(), lds, bx); else if ((PH2_SEL & 2) && bx >= 64 && bx < 128) hgrn_scan(CTX(), lds, bx - 64); else if ((PH2_SEL & 4) && bx >= 128 && bx < 132) lru_carry_phase(CTX(), 128);
#else
            if ((PH2_SEL & 1) && bx < 16) chunk_scan<true>(CTX(), lds, bx); else if ((PH2_SEL & 2) && bx >= 16 && bx < 32) chunk_scan<false>(CTX(), lds, bx - 16); else if ((PH2_SEL & 4) && bx >= 32 && bx < 36) lru_carry_phase(CTX(), 32);
#endif
            __syncthreads();
            PB_END(20); PB_END(21); PB_END(22);
#if DSA_NAIVE
            if (PH2_SEL & 8) dsa_phase(CTX(), lds, l);
#else
            if (PH2_SEL & 8) dsa_select_phase(CTX(), lds, l);
#endif
            __syncthreads();
            PB_END(23);
            SEAM(pb + 3); PB_END(3);
        }
        PB_BEGIN(4);
        if (PHSEL(4) && IN(pb + 4)) {
            PB_BEGIN(24);
            lru_out_phase(CTX(), vcu, G);
            mixers_finish(CTX(), l, vcu, G);
            __syncthreads(); PB_END(24);
#if !DSA_NAIVE
            dsa_attn_phase(CTX(), lds, l);
#endif
            SEAM(pb + 4); PB_END(4);
        }
        PB_BEGIN(5);
        if (PHSEL(5) && IN(pb + 5)) { GAS unsigned char* wsl = launder(args.ws);
            pg8::Gemm g{(const pg8::bf16_t*)(wsl + WS_MIX), (const pg8::bf16_t*)(wsl + WS_WOUT) + (size_t)l * 1024 * 1024, TP, 1024, 1024};
            pg8::StaticOrder S; S.init(TP, 1024, G, bx);
            pg8::EpiResidBf E{(pg8::bf16_t*)(wsl + WS_HB), 1024, ALPHA};
            pg8::gemm_phase<pg8::EpiResidBf, pg8::StaticOrder, true, true>(lds, g, S, E);
            SEAM(pb + 5); PB_END(5);
        }
        PB_BEGIN(6);
        if (PHSEL(6) && IN(pb + 6)) { ln_router_phase(CTX(), lds, l, vcu, G); SEAM(pb + 6); PB_END(6); }
        PB_BEGIN(7);
        if (PHSEL(7) && IN(pb + 7)) { moe_sort_phase(CTX(), lds, l); SEAM(pb + 7); PB_END(7); }
        PB_BEGIN(8);
        if (PHSEL(8) && IN(pb + 8)) { GAS unsigned char* wsl = launder(args.ws);
            const int nt = build_tiles(CTX(), lds, l);
            pg8::Gemm g{(const pg8::bf16_t*)(wsl + WS_HB), (const pg8::bf16_t*)(wsl + WS_W1) + (size_t)l * 32 * 2048 * 1024, RMAX, 32 * 2048, 1024};
            pg8::MoeOrder S{nt * 8, G, vcu, 8, (const LAS int*)(lds + MISC_OFF + MI_TILE)};
            pg8::EpiSwiGLU E{(pg8::bf16_t*)(wsl + WS_ACT), (const float*)(const GAS float*)args.in[31] + (size_t)l * 32 * 2048};
            pg8::gemm_phase_gather<pg8::EpiSwiGLU, pg8::MoeOrder>(lds, g, S, E, (const int*)(wsl + WS_RMAP));
            SEAM(pb + 8); PB_END(8);
        }
        PB_BEGIN(9);
        if (PHSEL(9) && IN(pb + 9)) { GAS unsigned char* wsl = launder(args.ws);
            const int nt = build_tiles(CTX(), lds, l);
            pg8::Gemm g{(const pg8::bf16_t*)(wsl + WS_ACT), (const pg8::bf16_t*)(wsl + WS_W2) + (size_t)l * 32 * 1024 * 1024, RMAX, 32 * 1024, 1024};
            pg8::MoeOrder S{nt * 4, G, vcu, 4, (const LAS int*)(lds + MISC_OFF + MI_TILE)};
            pg8::EpiMoeOut E{(pg8::bf16_t*)(wsl + WS_YBUF), (const float*)(const GAS float*)args.in[33] + (size_t)l * 32 * 1024, (const float*)(wsl + WS_GSORT)};
            pg8::gemm_phase<pg8::EpiMoeOut, pg8::MoeOrder, true, true>(lds, g, S, E);
            SEAM(pb + 9); PB_END(9);
        }
        PB_BEGIN(10);
        if (PHSEL(10) && IN(pb + 10)) { combine_ln_phase(CTX(), l, vcu, G); SEAM(pb + 10); PB_END(10); }
}
__global__ void __launch_bounds__(NTHR, 2) trunk_fwd(Args args) {
    extern __shared__ __attribute__((aligned(16))) unsigned char lds_raw[];
    LAS unsigned char* lds = (LAS unsigned char*)lds_raw;
    const int tid = threadIdx.x;
    const int G = gridDim.x; const int bx = blockIdx.x; const int vcu = (G % 8 == 0) ? (bx % 8) * (G / 8) + bx / 8 : bx;
    unsigned* ctl = (unsigned*)(args.ws + WS_CTL);
    for (int u = tid; u < (LDS_BYTES - MISC_OFF) / 4; u += NTHR) ((LAS unsigned*)(lds + MISC_OFF))[u] = 0u;
    __syncthreads();
#if MK_ONE_LAUNCH
    XcdBarrier bar = xcd_barrier_post(ctl + CW_BAR, (volatile LAS unsigned*)(lds + MISC_OFF + MI_BAR));
#else
    XcdBarrier bar; bar.bar = ctl + CW_BAR; bar.x = 0; bar.st = nullptr;
#endif
    const int lo = args.ph_lo, hi = args.ph_hi;

    unsigned long long pacc = 0ull, pstamp = 0ull; (void)pstamp;
    PB_BEGIN(11);
    if (PHSEL(11) && IN(0)) { p0_prologue(CTX(), lds, vcu, G); SEAM(0); }
    PB_END(11);

#pragma unroll 1
    for (int l = 0; l < 2; ++l) layer_phases(l, args, lds, G, bx, vcu, lo, hi, bar, pacc);
    if (PROBE_PHASE >= 0 && bx == (PROBE_PHASE == 21 ? 16 : PROBE_PHASE == 22 ? 32 : PROBE_PHASE == 23 ? 255 : 0)) { const unsigned long long t0 = __builtin_amdgcn_s_memrealtime(); while (__builtin_amdgcn_s_memrealtime() - t0 < pacc * PROBE_MULT) __builtin_amdgcn_s_sleep(8); }
#undef IN
#undef SEAM
}

extern "C" void kernel_launch(void* const* d_in, const int* in_sizes, int n_in, void* d_out, int out_size, void* d_ws, size_t ws_size, hipStream_t stream) {
    static int grid = 0;
    if (grid == 0) {
        if (n_in != 36 || in_sizes[0] != NB * SEQ * D || out_size != NB * SEQ * D || ws_size < WS_END) {
            fprintf(stderr, "kernel_launch: unexpected problem (n_in %d, in0 %d, out %d, ws %zu, need %zu); nothing launched\n", n_in, n_in > 0 ? in_sizes[0] : -1, out_size, ws_size, (size_t)WS_END); grid = -1; return; }
        int dev = 0, cus = 0, per_cu = 0;
        if (hipGetDevice(&dev) != hipSuccess || hipDeviceGetAttribute(&cus, hipDeviceAttributeMultiprocessorCount, dev) != hipSuccess) { grid = -1; return; }
        if (hipFuncSetAttribute((const void*)trunk_fwd, hipFuncAttributeMaxDynamicSharedMemorySize, LDS_BYTES) != hipSuccess) { fprintf(stderr, "kernel_launch: hipFuncSetAttribute failed\n"); grid = -1; return; }
        if (hipOccupancyMaxActiveBlocksPerMultiprocessor(&per_cu, (const void*)trunk_fwd, NTHR, LDS_BYTES) != hipSuccess || per_cu < 1) { fprintf(stderr, "kernel_launch: occupancy query says %d\n", per_cu); (void)hipGetLastError(); }
        grid = cus;
        if (grid < 160 || grid > 512) { fprintf(stderr, "kernel_launch: unsupported CU count %d\n", cus); grid = -1; return; }
    }
    if (grid < 0) return;
    if (hipMemsetAsync((char*)d_ws + WS_CTL, 0, CTL_ZERO_BYTES, stream) != hipSuccess) return;
    Args a; memset(&a, 0, sizeof(a));
    for (int i = 0; i < 36; ++i) a.in[i] = (const float*)d_in[i];
    a.out = (float*)d_out; a.ws = (unsigned char*)d_ws;
#if MK_ONE_LAUNCH
    a.ph_lo = 0; a.ph_hi = N_PHASES;
    hipLaunchKernelGGL(trunk_fwd, dim3(grid), dim3(NTHR), LDS_BYTES, stream, a);
#else
    for (int p = 0; p < N_PHASES; ++p) { a.ph_lo = p; a.ph_hi = p + 1; hipLaunchKernelGGL(trunk_fwd, dim3(grid), dim3(NTHR), LDS_BYTES, stream, a); }
#endif
}
```

```cpp
#include <hip/hip_runtime.h>
#include <cstdio>
#include <cstdint>
#include <cstring>

#ifndef MK_ONE_LAUNCH
#define MK_ONE_LAUNCH 1
#endif

#ifndef SCAN_SEQ
#define SCAN_SEQ 0
#endif
#ifndef SCAN_MIX
#define SCAN_MIX 0
#endif
#ifndef DSA_NAIVE
#define DSA_NAIVE 0
#endif
#ifndef PHASE_FN
#define PHASE_FN __forceinline__
#endif
#define GAS __attribute__((address_space(1)))
#define LAS __attribute__((address_space(3)))
typedef unsigned short bf16;
typedef unsigned v4u __attribute__((ext_vector_type(4)));
typedef unsigned v2u __attribute__((ext_vector_type(2)));
typedef float v4f __attribute__((ext_vector_type(4)));
typedef float v2f __attribute__((ext_vector_type(2)));

constexpr int NB = 8, SEQ = 8192, NMETA = 16, L = SEQ + NMETA  , T = NB * L  , TP = 65792  , D = 1024;
constexpr int NINP = 3584;
constexpr int NE = 32, TOPK = 4;
constexpr int RMAX = 1058 * 256;
constexpr int C_RW = 0, C_RW_R = 0, C_RW_WD = 256, C_RW_K = 320, C_RW_V = 576, C_RW_AD = 832, C_RW_GD = 896;
constexpr int C_DS_Q = 960, C_DS_K = 1216, C_DS_V = 1472, C_DS_QI = 1728, C_DS_KI = 1984, C_DS_WI = 2016;
constexpr int C_LR_X = 2024, C_LR_G = 2280;
constexpr int C_HG_Q = 2536, C_HG_F = 2792, C_HG_I = 3048, C_HG_G = 3304;
constexpr float ALPHA = 1.41421356237f;
constexpr float LN_EPS = 1e-5f;

constexpr size_t MiB = 1u << 20;
constexpr size_t WS_CTL = 0, CTL_ZERO_BYTES = 1 * MiB;
constexpr size_t WS_WIN = 2 * MiB;
constexpr size_t WS_WOUT = 16 * MiB;
constexpr size_t WS_W1 = 20 * MiB;
constexpr size_t WS_W2 = 276 * MiB;
constexpr size_t WS_H = 404 * MiB;
constexpr size_t WS_MIX = WS_H;
constexpr size_t WS_HB = 661 * MiB;
constexpr size_t WS_BIG = 790 * MiB;
constexpr size_t WS_PROJ = WS_BIG;
constexpr size_t SZ_HM32 = (size_t)32 * L * 64 * 4;
constexpr size_t SZ_HM16 = SZ_HM32 / 2;
constexpr size_t SZ_TM16 = (size_t)T * 256 * 2;
constexpr size_t WS_RW_W = 1240 * MiB;
constexpr size_t WS_RW_A = WS_RW_W + SZ_HM32, WS_RW_B = WS_RW_A + SZ_HM16, WS_RW_K = WS_RW_B + SZ_HM16, WS_RW_WR = WS_RW_K + SZ_HM16, WS_RW_V = WS_RW_WR + SZ_HM16;
constexpr size_t WS_RW_G = WS_RW_V + SZ_HM16;
constexpr size_t WS_RW_SC = WS_RW_G + SZ_TM16;
constexpr size_t WS_DS_Q = WS_RW_SC + (size_t)32 * L * 16;
constexpr size_t WS_DS_K = WS_DS_Q + SZ_TM16, WS_DS_V = WS_DS_K + SZ_TM16, WS_DS_QI = WS_DS_V + SZ_TM16;
constexpr size_t WS_DS_KI = WS_DS_QI + SZ_TM16;
constexpr size_t WS_DS_WI = WS_DS_KI + (size_t)T * 64;
constexpr size_t WS_LR_A = WS_DS_WI + (size_t)T * 32;
constexpr size_t WS_LR_U = WS_LR_A + (size_t)T * 1024, WS_LR_G = WS_LR_U + SZ_TM16;
constexpr size_t WS_HG_F = WS_LR_G + SZ_TM16;
constexpr size_t WS_HG_K = WS_HG_F + SZ_HM32, WS_HG_Q = WS_HG_K + SZ_HM16, WS_HG_V = WS_HG_Q + SZ_HM16, WS_HG_G = WS_HG_V + SZ_HM16;
constexpr size_t WS_MIX_END = WS_HG_G + SZ_TM16;
constexpr size_t SZ_SORT = (size_t)RMAX * 1024 * 2;
constexpr size_t WS_SORTA = WS_BIG, WS_YBUF = WS_BIG, WS_ACT = WS_BIG + SZ_SORT;
constexpr size_t WS_TIDX = WS_ACT + SZ_SORT;
constexpr size_t WS_TGATE = WS_TIDX + (size_t)T * 16;
constexpr size_t WS_SPOS = WS_TGATE + (size_t)T * 16;
constexpr size_t WS_GSORT = WS_SPOS + (size_t)T * 16;
constexpr size_t WS_RMAP = WS_GSORT + (size_t)RMAX * 4;
constexpr size_t WS_MOE_END = WS_RMAP + (size_t)RMAX * 4;
constexpr size_t WS_END = 2040 * MiB;
static_assert(WS_MIX_END <= WS_END && WS_MOE_END <= WS_END, "workspace map");
static_assert(WS_PROJ + (size_t)TP * NINP * 2 <= WS_RW_W, "proj vs prep");
static_assert(WS_HB + (size_t)TP * 1024 * 2 <= WS_BIG && WS_H + (size_t)TP * 4096 <= WS_HB, "h/hb");

constexpr int CW_TMO = 0, CW_CODE = 1;
constexpr int CW_BAR = 4096;
constexpr int CW_DSAQ = 8192;
constexpr int CW_ECNT = 8448;
constexpr int CW_ECUR = 8704;

constexpr int LDS_BYTES = 163840;
constexpr int MISC_OFF = 155648;
constexpr int MI_BAR = 0, MI_HIST = 64, MI_LCUR = 192, MI_LBASE = 320, MI_NT = 448, MI_OFFS = 512, MI_TILE = 1024;
constexpr int NWAVES = 8, NTHR = 512;

__device__ __forceinline__ float bf2f(unsigned short x) { return __uint_as_float((unsigned)x << 16); }
__device__ __forceinline__ float bflo(unsigned x) { return __uint_as_float(x << 16); }
__device__ __forceinline__ float bfhi(unsigned x) { return __uint_as_float(x & 0xffff0000u); }
typedef float f32x2_t __attribute__((ext_vector_type(2))); typedef __bf16 bf16x2_t __attribute__((ext_vector_type(2)));
__device__ __forceinline__ unsigned pk2(float lo, float hi) { const f32x2_t v = {lo, hi}; const bf16x2_t b = __builtin_convertvector(v, bf16x2_t); return __builtin_bit_cast(unsigned, b); }
__device__ __forceinline__ bf16 f2bf(float f) { return (bf16)(pk2(f, 0.f) & 0xffffu); }
__device__ __forceinline__ v4f ld_bf4(const bf16* p) { const v2u x = *(const v2u*)p; return (v4f){bflo(x.x), bfhi(x.x), bflo(x.y), bfhi(x.y)}; }
__device__ __forceinline__ void st_bf4(bf16* p, v4f v) { v2u o; o.x = pk2(v.x, v.y); o.y = pk2(v.z, v.w); *(v2u*)p = o; }
__device__ __forceinline__ float wave_max(float v) {
#pragma unroll
    for (int o = 1; o < 64; o <<= 1) v = fmaxf(v, __shfl_xor(v, o));
    return v;
}
template <int CTRL> __device__ __forceinline__ float dpp_f(float x) { return __int_as_float(__builtin_amdgcn_update_dpp(0, __float_as_int(x), CTRL, 0xF, 0xF, true)); }
__device__ __forceinline__ float sum8(float x) { x += dpp_f<0xB1>(x); x += dpp_f<0x4E>(x); x += dpp_f<0x141>(x); return x; }
__device__ __forceinline__ float sum16(float x) { x = sum8(x); x += dpp_f<0x140>(x); return x; }
__device__ __forceinline__ float wave_sum(float v) {
    v = sum16(v);
    v += __shfl_xor(v, 16); v += __shfl_xor(v, 32);
    return v;
}
__device__ __forceinline__ float rcp_(float x) { return __builtin_amdgcn_rcpf(x); }
__device__ __forceinline__ float rsq_(float x) { return __builtin_amdgcn_rsqf(x); }
__device__ __forceinline__ float sigmoidf_(float x) { return rcp_(1.f + __expf(-x)); }
__device__ __forceinline__ float softplusf_(float x) { return x > 20.f ? x : log1pf(__expf(x)); }
__device__ __forceinline__ float gelu_tanh(float x) { const float u = 0.7978845608028654f * (x + 0.044715f * x * x * x); return 0.5f * x * (1.f + tanhf(u)); }
__device__ __forceinline__ int lds_add(LAS int* p, int v) { return __hip_atomic_fetch_add(p, v, __ATOMIC_RELAXED, __HIP_MEMORY_SCOPE_WORKGROUP); }
#define LDS_WAIT() asm volatile("s_waitcnt lgkmcnt(0)" ::: "memory")
#define VM_WAIT() asm volatile("s_waitcnt vmcnt(0)" ::: "memory")

__device__ __forceinline__ GAS unsigned char* launder(unsigned char* p) { GAS unsigned char* g = (GAS unsigned char*)p; asm volatile("" : "+s"(g)); return g; }
__device__ __forceinline__ int opaque_tid() { int t = (int)threadIdx.x; asm volatile("" : "+v"(t)); return t; }
__device__ __forceinline__ int opaque_s(int x) { return __builtin_amdgcn_readfirstlane(x); }
struct Args { const float* in[36]; float* out; unsigned char* ws; int ph_lo, ph_hi; };
struct Ctx { const float* const* in; float* out; GAS unsigned char* ws; };
__device__ __forceinline__ const float* gin(const Ctx& A, int k) { return (const float*)(const GAS float*)A.in[k]; }
namespace pg8 {
#define PG8_LAS __attribute__((address_space(3)))
typedef unsigned short bf16_t;
typedef short bf16x8 __attribute__((ext_vector_type(8)));
typedef float f32x4 __attribute__((ext_vector_type(4)));
typedef unsigned u32x4 __attribute__((ext_vector_type(4)));
constexpr int BM = 256, BK = 64, HALF = 128, HTB = HALF * BK * 2  , STAGE_BYTES = 8 * HTB, NXCD = 8, WGM = 8;

__host__ __device__ __forceinline__ int lds_byte(int r, int c) { const int st = (r >> 4) * 2 + (c >> 5), rr = r & 15, cc = c & 31, ob = rr * 64 + cc * 2; return st * 1024 + (ob ^ (((ob >> 9) & 1) << 5)); }
__host__ __device__ __forceinline__ void stage_rc(int b, int& R, int& C) { const int st = b / 1024, sb = b % 1024, swz = sb ^ (((sb >> 9) & 1) << 5); R = (st >> 1) * 16 + swz / 64; C = (st & 1) * 32 + (swz % 64) / 2; }
__host__ __device__ __forceinline__ int perm32(int rho) { const int n = rho >> 4, i = rho & 15; return 8 * (i >> 2) + 4 * n + (i & 3); }

struct Unit { int pm, pn; };
struct Gemm { const bf16_t* A; const bf16_t* Bt; int M, N, K; };

struct StaticOrder {
    int nM, nN, nwg, G, c;
    __host__ __device__ void init(int M, int N, int G_, int c_) { nM = M / BM; nN = N / BM; nwg = nM * nN; G = G_; c = c_; }
    __host__ __device__ bool next(int i, Unit& u) const {
        const long L = (long)i * G + c; if (L >= nwg) return false;
        int wgid = (int)L; { const int q = nwg / NXCD, r = nwg % NXCD, xcd = wgid % NXCD, off = wgid / NXCD; wgid = (xcd < r ? xcd * (q + 1) : r * (q + 1) + (xcd - r) * q) + off; }
        const int nig = WGM * nN, gid = wgid / nig, fm = gid * WGM, gsz = (nM - fm) < WGM ? (nM - fm) : WGM;
        u.pm = fm + ((wgid % nig) % gsz); u.pn = (wgid % nig) / gsz; return true;
    }
    __device__ __forceinline__ void a_ready(const Unit&) const {}
    __device__ __forceinline__ void done(const Unit&) const {}
};

__device__ __forceinline__ unsigned cvt_pk_bf16(float lo, float hi) { unsigned r; asm volatile("v_cvt_pk_bf16_f32 %0, %1, %2" : "=v"(r) : "v"(lo), "v"(hi)); return r; }
typedef float f32x2 __attribute__((ext_vector_type(2)));
typedef unsigned u32x2v __attribute__((ext_vector_type(2)));
typedef float pf32x2_t __attribute__((ext_vector_type(2))); typedef __bf16 pbf16x2_t __attribute__((ext_vector_type(2)));
__device__ __forceinline__ unsigned cvt_pk_bf16c(float lo, float hi) { const pf32x2_t v = {lo, hi}; const pbf16x2_t q = __builtin_convertvector(v, pbf16x2_t); return __builtin_bit_cast(unsigned, q); }
struct EpiStoreBf16 {
    static constexpr bool PERM = true, AFTER_DRAIN = false;
    bf16_t* O; int ldc;
    __device__ __forceinline__ void operator()(const f32x4 (&acc)[2][2][4][2], const Unit& u, int wr, int wc, int fr, int fq) const {
        const int row0 = u.pm * BM + wr * 64 + fr, col0 = u.pn * BM + wc * 32 + 8 * fq;
#pragma unroll
        for (int ai = 0; ai < 2; ++ai)
#pragma unroll
            for (int m = 0; m < 4; ++m) { bf16_t* rowp = O + (size_t)(row0 + ai * HALF + m * 16) * ldc + col0;
#pragma unroll
                for (int bj = 0; bj < 2; ++bj) { const f32x4 v0 = acc[ai][bj][m][0], v1 = acc[ai][bj][m][1];
                    u32x4 w; w.x = cvt_pk_bf16c(v0[0], v0[1]); w.y = cvt_pk_bf16c(v0[2], v0[3]); w.z = cvt_pk_bf16c(v1[0], v1[1]); w.w = cvt_pk_bf16c(v1[2], v1[3]);
                    *(u32x4*)(rowp + bj * HALF) = w; } }
    }
};
struct EpiResid {
    static constexpr bool PERM = false, AFTER_DRAIN = false;
    float* Hres; int ldc; float alpha;
    __device__ __forceinline__ void operator()(const f32x4 (&acc)[2][2][4][2], const Unit& u, int wr, int wc, int fr, int fq) const {
        const int row0 = u.pm * BM + wr * 64 + fr, col0 = u.pn * BM + wc * 32 + 4 * fq;
#pragma unroll
        for (int ai = 0; ai < 2; ++ai)
#pragma unroll
            for (int m = 0; m < 4; ++m) { float* rowp = Hres + (size_t)(row0 + ai * HALF + m * 16) * ldc + col0;
#pragma unroll
                for (int bj = 0; bj < 2; ++bj)
#pragma unroll
                    for (int n = 0; n < 2; ++n) { f32x4* p = (f32x4*)(rowp + bj * HALF + n * 16); const f32x4 old = *p; *p = old * alpha + acc[ai][bj][m][n]; } }
    }
};
struct EpiResidBf {
    static constexpr bool PERM = true, AFTER_DRAIN = false;
    bf16_t* Hb; int ldc; float alpha;
    __device__ __forceinline__ void operator()(const f32x4 (&acc)[2][2][4][2], const Unit& u, int wr, int wc, int fr, int fq) const {
        const int row0 = u.pm * BM + wr * 64 + fr, col0 = u.pn * BM + wc * 32 + 8 * fq;
#pragma unroll
        for (int ai = 0; ai < 2; ++ai)
#pragma unroll
            for (int m = 0; m < 4; ++m) { bf16_t* rowp = Hb + (size_t)(row0 + ai * HALF + m * 16) * ldc + col0;
#pragma unroll
                for (int bj = 0; bj < 2; ++bj) { const f32x4 v0 = acc[ai][bj][m][0], v1 = acc[ai][bj][m][1]; const u32x4 o = *(const u32x4*)(rowp + bj * HALF);
#define RB_LO(x_) __builtin_bit_cast(float, (x_) << 16)
#define RB_HI(x_) __builtin_bit_cast(float, (x_) & 0xffff0000u)
                    u32x4 w; w.x = cvt_pk_bf16c(RB_LO(o.x) * alpha + v0[0], RB_HI(o.x) * alpha + v0[1]); w.y = cvt_pk_bf16c(RB_LO(o.y) * alpha + v0[2], RB_HI(o.y) * alpha + v0[3]);
                    w.z = cvt_pk_bf16c(RB_LO(o.z) * alpha + v1[0], RB_HI(o.z) * alpha + v1[1]); w.w = cvt_pk_bf16c(RB_LO(o.w) * alpha + v1[2], RB_HI(o.w) * alpha + v1[3]);
#undef RB_LO
#undef RB_HI
                    *(u32x4*)(rowp + bj * HALF) = w; } }
    }
};
struct EpiSwiGLU {
    static constexpr bool PERM = true, AFTER_DRAIN = false;
    bf16_t* ACT; const float* b1;
    __device__ __forceinline__ void operator()(const f32x4 (&acc)[2][2][4][2], const Unit& u, int wr, int wc, int fr, int fq) const {
        const int e = u.pn >> 3, pnl = u.pn & 7;
        const int row0 = u.pm * BM + wr * 64 + fr, c8 = pnl * 128 + wc * 32 + 8 * fq;
        const float* bg = b1 + (size_t)e * 2048 + c8; const float* bl = bg + 1024;
        const f32x4 bg0 = *(const f32x4*)bg, bg1 = *(const f32x4*)(bg + 4), bl0 = *(const f32x4*)bl, bl1 = *(const f32x4*)(bl + 4);
#pragma unroll
        for (int ai = 0; ai < 2; ++ai)
#pragma unroll
            for (int m = 0; m < 4; ++m) {
                float o[8];
#pragma unroll
                for (int n = 0; n < 2; ++n) { const f32x4 g4 = acc[ai][0][m][n] + (n ? bg1 : bg0), l4 = acc[ai][1][m][n] + (n ? bl1 : bl0);
#pragma unroll
                    for (int j = 0; j < 4; ++j) { const float glu = fminf(g4[j], 7.f), lin = fminf(fmaxf(l4[j], -7.f), 7.f);
                        o[n * 4 + j] = glu * __builtin_amdgcn_rcpf(1.f + __builtin_amdgcn_exp2f(glu * (-1.702f * 1.4426950408889634f))) * (lin + 1.f); } }
                u32x4 w; w.x = cvt_pk_bf16c(o[0], o[1]); w.y = cvt_pk_bf16c(o[2], o[3]); w.z = cvt_pk_bf16c(o[4], o[5]); w.w = cvt_pk_bf16c(o[6], o[7]);
                *(u32x4*)(ACT + (size_t)(row0 + ai * HALF + m * 16) * 1024 + c8) = w; }
    }
};
struct EpiMoeOut {
    static constexpr bool PERM = true, AFTER_DRAIN = false;
    bf16_t* Y; const float* b2; const float* gate;
    __device__ __forceinline__ void operator()(const f32x4 (&acc)[2][2][4][2], const Unit& u, int wr, int wc, int fr, int fq) const {
        const int e = u.pn >> 2, pnl = u.pn & 3;
        const int row0 = u.pm * BM + wr * 64 + fr, c8 = pnl * 256 + wc * 32 + 8 * fq;
        const float* bb = b2 + (size_t)e * 1024 + c8;
        f32x4 bv[2][2];
#pragma unroll
        for (int bj = 0; bj < 2; ++bj) { bv[bj][0] = *(const f32x4*)(bb + bj * HALF); bv[bj][1] = *(const f32x4*)(bb + bj * HALF + 4); }
#pragma unroll
        for (int ai = 0; ai < 2; ++ai)
#pragma unroll
            for (int m = 0; m < 4; ++m) { const int row = row0 + ai * HALF + m * 16; const float gt = gate[row];
#pragma unroll
                for (int bj = 0; bj < 2; ++bj) { const f32x4 v0 = (acc[ai][bj][m][0] + bv[bj][0]) * gt, v1 = (acc[ai][bj][m][1] + bv[bj][1]) * gt;
                    u32x4 w; w.x = cvt_pk_bf16c(v0[0], v0[1]); w.y = cvt_pk_bf16c(v0[2], v0[3]); w.z = cvt_pk_bf16c(v1[0], v1[1]); w.w = cvt_pk_bf16c(v1[2], v1[3]);
                    *(u32x4*)(Y + (size_t)row * 1024 + c8 + bj * HALF) = w; } }
    }
};
struct MoeOrder {
    int n_units, G, c, npn; const PG8_LAS int* tile_e;
    __device__ __forceinline__ bool next(int i, Unit& u) const {
        const int Lx = i * G + c; if (Lx >= n_units) return false;
        const int tile = Lx / npn, pnl = Lx - tile * npn;
        u.pm = tile; u.pn = tile_e[tile] * npn + pnl; return true;
    }
    __device__ __forceinline__ void a_ready(const Unit&) const {}
    __device__ __forceinline__ void done(const Unit&) const {}
};

template <class Epi, class Sched, bool ALIGN_EPI = false, bool SP2 = false>
__device__ __forceinline__ void gemm_phase(PG8_LAS unsigned char* lds, const Gemm g, const Sched& S, const Epi& E) {
    const int tid = opaque_tid(), wid = __builtin_amdgcn_readfirstlane(tid >> 6), lane = tid & 63, wr = wid >> 2, wc = wid & 3, fr = lane & 15, fq = lane >> 4;
    const int K = g.K, nt = K / BK;
    unsigned voffA[2], voffB[2];
#pragma unroll
    for (int i = 0; i < 2; ++i) { int R, C; stage_rc(tid * 16 + i * 8192, R, C); const int Rb = Epi::PERM ? ((R & ~31) + perm32(R & 31)) : R;
        voffA[i] = (unsigned)(R * K + C) * 2u; voffB[i] = (unsigned)(Rb * K + C) * 2u; }
    const size_t kstep = (size_t)(BK * 2);
    const size_t hstep = (size_t)HALF * K * 2;
    const size_t tstep = 2 * hstep;
    const unsigned ldsw = (unsigned)wid * 1024u;
    const int aoff = lds_byte(wr * 64 + fr, fq * 8), boff = lds_byte(wc * 32 + fr, fq * 8);
#define PG8_SA(b, h) (((b) * 2 + (h)) * HTB)
#define PG8_SB(b, h) ((4 + (b) * 2 + (h)) * HTB)
#define PG8_STAGE(bufoff, gbase, voff) do { _Pragma("unroll") for (int _i = 0; _i < 2; ++_i) \
        __builtin_amdgcn_global_load_lds((const unsigned*)((const char*)(gbase) + (voff)[_i]), (PG8_LAS unsigned*)(lds + (bufoff) + ldsw + _i * 8192), 16, 0, 0); } while (0)
#define PG8_LDA(dst, b, h) do { _Pragma("unroll") for (int m = 0; m < 4; ++m) _Pragma("unroll") for (int k = 0; k < 2; ++k) dst[m][k] = *(const PG8_LAS bf16x8*)(lds + PG8_SA(b, h) + aoff + m * 2048 + k * 1024); } while (0)
#define PG8_LDB(dst, b, h) do { _Pragma("unroll") for (int n = 0; n < 2; ++n) _Pragma("unroll") for (int k = 0; k < 2; ++k) dst[n][k] = *(const PG8_LAS bf16x8*)(lds + PG8_SB(b, h) + boff + n * 2048 + k * 1024); } while (0)
#define PG8_MMA(ai, bj, At, Bt) do { __builtin_amdgcn_s_setprio(1); _Pragma("unroll") for (int m = 0; m < 4; ++m) _Pragma("unroll") for (int n = 0; n < 2; ++n) _Pragma("unroll") for (int k = 0; k < 2; ++k) \
        acc[ai][bj][m][n] = __builtin_amdgcn_mfma_f32_16x16x32_bf16(Bt[n][k], At[m][k], acc[ai][bj][m][n], 0, 0, 0); __builtin_amdgcn_s_setprio(0); } while (0)
#define PG8_WAIT_V(n) asm volatile("s_waitcnt vmcnt(" #n ")" ::: "memory")
#define PG8_WAIT_L(n) asm volatile("s_waitcnt lgkmcnt(" #n ")" ::: "memory")
#define PG8_BAR __builtin_amdgcn_s_barrier()
#define PG8_SCHED __builtin_amdgcn_sched_barrier(0)
    Unit cur, nxt; int ui = 0;
    if (!S.next(0, cur)) return;
    f32x4 acc[2][2][4][2];
#pragma unroll
    for (int a = 0; a < 2; ++a)
#pragma unroll
        for (int b = 0; b < 2; ++b)
#pragma unroll
            for (int m = 0; m < 4; ++m)
#pragma unroll
                for (int n = 0; n < 2; ++n) acc[a][b][m][n] = (f32x4){0.f, 0.f, 0.f, 0.f};
    bf16x8 At[4][2], B0[2][2], B1[2][2];
    const char* cA = (const char*)g.A + (size_t)cur.pm * tstep; const char* cB = (const char*)g.Bt + (size_t)cur.pn * tstep;
    S.a_ready(cur);
    if constexpr (SP2) {
        PG8_STAGE(PG8_SB(0, 0), cB, voffB); PG8_STAGE(PG8_SB(0, 1), cB + hstep, voffB); PG8_STAGE(PG8_SA(0, 0), cA, voffA); PG8_STAGE(PG8_SA(0, 1), cA + hstep, voffA);
        if (wr == 1) PG8_BAR;
        PG8_WAIT_V(2); PG8_BAR;
        PG8_STAGE(PG8_SB(1, 0), cB + kstep, voffB); PG8_STAGE(PG8_SA(1, 0), cA + kstep, voffA); PG8_STAGE(PG8_SB(1, 1), cB + hstep + kstep, voffB);
        PG8_WAIT_V(6); PG8_BAR;
    } else {
        PG8_STAGE(PG8_SB(0, 0), cB, voffB); PG8_STAGE(PG8_SA(0, 0), cA, voffA); PG8_STAGE(PG8_SB(0, 1), cB + hstep, voffB); PG8_STAGE(PG8_SA(0, 1), cA + hstep, voffA);
        if (wr == 1) PG8_BAR;
        PG8_WAIT_V(4); PG8_BAR;
        PG8_STAGE(PG8_SB(1, 0), cB + kstep, voffB); PG8_STAGE(PG8_SA(1, 0), cA + kstep, voffA); PG8_STAGE(PG8_SB(1, 1), cB + hstep + kstep, voffB);
        PG8_WAIT_V(6); PG8_BAR;
    }
    for (;;) {
        const bool has_next = S.next(ui + 1, nxt);
        const char* nA = has_next ? (const char*)g.A + (size_t)nxt.pm * tstep : cA; const char* nB = has_next ? (const char*)g.Bt + (size_t)nxt.pn * tstep : cB;
        for (int t = 0; t < nt; t += 2) {
            const bool last = (t == nt - 2);
            const char* a1 = cA + (size_t)(t + 1) * kstep;
            const char* a2 = last ? nA : cA + (size_t)(t + 2) * kstep; const char* b2 = last ? nB : cB + (size_t)(t + 2) * kstep;
            const char* a3 = a2 + kstep; const char* b3 = b2 + kstep;
            if (last && has_next) S.a_ready(nxt);
            if constexpr (SP2) {
            PG8_LDB(B0, 0, 0); PG8_LDB(B1, 0, 1); PG8_SCHED; PG8_LDA(At, 0, 0); PG8_STAGE(PG8_SA(1, 1), a1 + hstep, voffA);
            PG8_WAIT_V(8); PG8_WAIT_L(0); PG8_BAR; PG8_MMA(0, 0, At, B0); PG8_MMA(0, 1, At, B1); PG8_BAR; PG8_SCHED;
            PG8_LDA(At, 0, 1); PG8_STAGE(PG8_SB(0, 0), b2, voffB); PG8_STAGE(PG8_SB(0, 1), b2 + hstep, voffB); PG8_STAGE(PG8_SA(0, 0), a2, voffA);
            PG8_WAIT_V(8); PG8_WAIT_L(0); PG8_BAR; PG8_MMA(1, 0, At, B0); PG8_MMA(1, 1, At, B1); PG8_BAR; PG8_SCHED;
            PG8_LDB(B0, 1, 0); PG8_LDB(B1, 1, 1); PG8_SCHED; PG8_LDA(At, 1, 0); PG8_STAGE(PG8_SA(0, 1), a2 + hstep, voffA);
            PG8_WAIT_V(8); PG8_WAIT_L(0); PG8_BAR; PG8_MMA(0, 0, At, B0); PG8_MMA(0, 1, At, B1); PG8_BAR; PG8_SCHED;
            PG8_LDA(At, 1, 1); PG8_STAGE(PG8_SB(1, 0), b3, voffB); PG8_STAGE(PG8_SB(1, 1), b3 + hstep, voffB); PG8_STAGE(PG8_SA(1, 0), a3, voffA);
            PG8_WAIT_V(8); PG8_WAIT_L(0); PG8_BAR; PG8_MMA(1, 0, At, B0); PG8_MMA(1, 1, At, B1); PG8_BAR; PG8_SCHED;
            } else {
            PG8_LDB(B0, 0, 0); PG8_SCHED; PG8_LDA(At, 0, 0); PG8_STAGE(PG8_SA(1, 1), a1 + hstep, voffA);
            PG8_WAIT_L(8); PG8_BAR; PG8_WAIT_L(0); PG8_MMA(0, 0, At, B0); PG8_BAR; PG8_SCHED;
            PG8_LDB(B1, 0, 1); PG8_STAGE(PG8_SB(0, 0), b2, voffB);
            PG8_BAR; PG8_WAIT_L(0); PG8_MMA(0, 1, At, B1); PG8_BAR;
            PG8_LDA(At, 0, 1); PG8_STAGE(PG8_SA(0, 0), a2, voffA);
            PG8_BAR; PG8_WAIT_L(0); PG8_MMA(1, 0, At, B0); PG8_BAR; PG8_SCHED;
            PG8_STAGE(PG8_SB(0, 1), b2 + hstep, voffB);
            PG8_WAIT_V(6); PG8_BAR; PG8_MMA(1, 1, At, B1); PG8_BAR;
            PG8_LDB(B0, 1, 0); PG8_SCHED; PG8_LDA(At, 1, 0); PG8_STAGE(PG8_SA(0, 1), a2 + hstep, voffA);
            PG8_WAIT_L(8); PG8_BAR; PG8_WAIT_L(0); PG8_MMA(0, 0, At, B0); PG8_BAR; PG8_SCHED;
            PG8_LDB(B1, 1, 1); PG8_STAGE(PG8_SB(1, 0), b3, voffB);
            PG8_BAR; PG8_WAIT_L(0); PG8_MMA(0, 1, At, B1); PG8_BAR;
            PG8_LDA(At, 1, 1); PG8_STAGE(PG8_SA(1, 0), a3, voffA);
            PG8_BAR; PG8_WAIT_L(0); PG8_MMA(1, 0, At, B0); PG8_BAR; PG8_SCHED;
            PG8_STAGE(PG8_SB(1, 1), b3 + hstep, voffB);
            PG8_WAIT_V(6); PG8_BAR; PG8_MMA(1, 1, At, B1); PG8_BAR;
            }
        }
        if constexpr (ALIGN_EPI) { if (wr == 0) PG8_BAR; }
        if constexpr (!Epi::AFTER_DRAIN) { E(acc, cur, wr, wc, fr, fq); S.done(cur); }
        if (!has_next) break;
#pragma unroll
        for (int a = 0; a < 2; ++a)
#pragma unroll
            for (int b = 0; b < 2; ++b)
#pragma unroll
                for (int m = 0; m < 4; ++m)
#pragma unroll
                    for (int n = 0; n < 2; ++n) acc[a][b][m][n] = (f32x4){0.f, 0.f, 0.f, 0.f};
        cur = nxt; cA = nA; cB = nB; ++ui;
        if constexpr (ALIGN_EPI) { if (wr == 1) PG8_BAR; }
    }
    PG8_WAIT_V(0);
    if constexpr (!ALIGN_EPI) { if (wr == 0) PG8_BAR; }
    PG8_BAR;
    if constexpr (Epi::AFTER_DRAIN) { E.fused(acc, cur, wr, wc, fr, fq, lds, wid, lane); S.done(cur); }
#undef PG8_SA
#undef PG8_SB
#undef PG8_STAGE
#undef PG8_LDA
#undef PG8_LDB
#undef PG8_MMA
#undef PG8_WAIT_V
#undef PG8_WAIT_L
#undef PG8_BAR
#undef PG8_SCHED
}
}
namespace pg8 {
template <class Epi, class Sched>
__device__ __forceinline__ void gemm_phase_gather(PG8_LAS unsigned char* lds, const Gemm g, const Sched& S, const Epi& E, const int* rmap) {
    constexpr bool ALIGN_EPI = true, SP2 = true;
    const int tid = opaque_tid(), wid = __builtin_amdgcn_readfirstlane(tid >> 6), lane = tid & 63, wr = wid >> 2, wc = wid & 3, fr = lane & 15, fq = lane >> 4;
    const int K = g.K, nt = K / BK;
    unsigned voffB[2];
#pragma unroll
    for (int i = 0; i < 2; ++i) { int R, C; stage_rc(tid * 16 + i * 8192, R, C); const int Rb = Epi::PERM ? ((R & ~31) + perm32(R & 31)) : R;
        voffB[i] = (unsigned)(Rb * K + C) * 2u; }
    const size_t kstep = (size_t)(BK * 2);
    const size_t hstep = (size_t)HALF * K * 2;
    const size_t tstep = 2 * hstep;
    const unsigned ldsw = (unsigned)wid * 1024u;
    const int aoff = lds_byte(wr * 64 + fr, fq * 8), boff = lds_byte(wc * 32 + fr, fq * 8);
#define PG8_SA(b, h) (((b) * 2 + (h)) * HTB)
#define PG8_SB(b, h) ((4 + (b) * 2 + (h)) * HTB)
#define PG8_STAGE(bufoff, gbase, voff) do { _Pragma("unroll") for (int _i = 0; _i < 2; ++_i) \
        __builtin_amdgcn_global_load_lds((const unsigned*)((const char*)(gbase) + (voff)[_i]), (PG8_LAS unsigned*)(lds + (bufoff) + ldsw + _i * 8192), 16, 0, 0); } while (0)
#define PG8_LDA(dst, b, h) do { _Pragma("unroll") for (int m = 0; m < 4; ++m) _Pragma("unroll") for (int k = 0; k < 2; ++k) dst[m][k] = *(const PG8_LAS bf16x8*)(lds + PG8_SA(b, h) + aoff + m * 2048 + k * 1024); } while (0)
#define PG8_LDB(dst, b, h) do { _Pragma("unroll") for (int n = 0; n < 2; ++n) _Pragma("unroll") for (int k = 0; k < 2; ++k) dst[n][k] = *(const PG8_LAS bf16x8*)(lds + PG8_SB(b, h) + boff + n * 2048 + k * 1024); } while (0)
#define PG8_MMA(ai, bj, At, Bt) do { __builtin_amdgcn_s_setprio(1); _Pragma("unroll") for (int m = 0; m < 4; ++m) _Pragma("unroll") for (int n = 0; n < 2; ++n) _Pragma("unroll") for (int k = 0; k < 2; ++k) \
        acc[ai][bj][m][n] = __builtin_amdgcn_mfma_f32_16x16x32_bf16(Bt[n][k], At[m][k], acc[ai][bj][m][n], 0, 0, 0); __builtin_amdgcn_s_setprio(0); } while (0)
#define PG8_WAIT_V(n) asm volatile("s_waitcnt vmcnt(" #n ")" ::: "memory")
#define PG8_WAIT_L(n) asm volatile("s_waitcnt lgkmcnt(" #n ")" ::: "memory")
#define PG8_BAR __builtin_amdgcn_s_barrier()
#define PG8_SCHED __builtin_amdgcn_sched_barrier(0)
    Unit cur, nxt; int ui = 0;
    if (!S.next(0, cur)) return;
    f32x4 acc[2][2][4][2];
#pragma unroll
    for (int a = 0; a < 2; ++a)
#pragma unroll
        for (int b = 0; b < 2; ++b)
#pragma unroll
            for (int m = 0; m < 4; ++m)
#pragma unroll
                for (int n = 0; n < 2; ++n) acc[a][b][m][n] = (f32x4){0.f, 0.f, 0.f, 0.f};
    bf16x8 At[4][2], B0[2][2], B1[2][2];
    const char* gA = (const char*)g.A; const char* cB = (const char*)g.Bt + (size_t)cur.pn * tstep;
    unsigned gofc[2][2];
    constexpr int RM_OFF = 8 * HTB;
#pragma unroll
    for (int i_ = 0; i_ < 2; ++i_) { int R, C; stage_rc(tid * 16 + i_ * 8192, R, C);
#pragma unroll
        for (int h_ = 0; h_ < 2; ++h_) gofc[h_][i_] = (unsigned)rmap[(size_t)cur.pm * BM + h_ * HALF + R] * (unsigned)(K * 2) + (unsigned)C * 2u; }
    S.a_ready(cur);
    if constexpr (SP2) {
        PG8_STAGE(PG8_SB(0, 0), cB, voffB); PG8_STAGE(PG8_SB(0, 1), cB + hstep, voffB); PG8_STAGE(PG8_SA(0, 0), gA, gofc[0]); PG8_STAGE(PG8_SA(0, 1), gA, gofc[1]);
        if (wr == 1) PG8_BAR;
        PG8_WAIT_V(2); PG8_BAR;
        PG8_STAGE(PG8_SB(1, 0), cB + kstep, voffB); PG8_STAGE(PG8_SA(1, 0), gA + kstep, gofc[0]); PG8_STAGE(PG8_SB(1, 1), cB + hstep + kstep, voffB);
        PG8_WAIT_V(6); PG8_BAR;
    }
    for (;;) {
        const bool has_next = S.next(ui + 1, nxt);
        const char* nB = has_next ? (const char*)g.Bt + (size_t)nxt.pn * tstep : cB;
        if (has_next) { const unsigned rmoff = (unsigned)(opaque_tid() & 255) * 4u;
            __builtin_amdgcn_global_load_lds((const unsigned*)((const char*)(rmap + (size_t)nxt.pm * BM) + rmoff), (PG8_LAS unsigned*)(lds + RM_OFF + wid * 256), 4, 0, 0); }
        for (int t = 0; t < nt; t += 2) {
            const bool last = (t == nt - 2);
            const char* a1 = gA + (size_t)(t + 1) * kstep;
            const char* a2 = last ? gA : gA + (size_t)(t + 2) * kstep; const char* b2 = last ? nB : cB + (size_t)(t + 2) * kstep;
            const char* a3 = a2 + kstep; const char* b3 = b2 + kstep;
            if (last && has_next) S.a_ready(nxt);
            if constexpr (SP2) {
            PG8_LDB(B0, 0, 0); PG8_LDB(B1, 0, 1); PG8_SCHED; PG8_LDA(At, 0, 0); PG8_STAGE(PG8_SA(1, 1), a1, gofc[1]);
            PG8_WAIT_V(8); PG8_WAIT_L(0); PG8_BAR; PG8_MMA(0, 0, At, B0); PG8_MMA(0, 1, At, B1); PG8_BAR; PG8_SCHED;
            if (last && has_next) { const int tid2 = opaque_tid();
#pragma unroll
                for (int i_ = 0; i_ < 2; ++i_) { int R, C; stage_rc(tid2 * 16 + i_ * 8192, R, C);
#pragma unroll
                    for (int h_ = 0; h_ < 2; ++h_) gofc[h_][i_] = (unsigned)*(const PG8_LAS int*)(lds + RM_OFF + (h_ * HALF + R) * 4) * (unsigned)(K * 2) + (unsigned)C * 2u; }
                PG8_SCHED; }
            PG8_LDA(At, 0, 1); PG8_STAGE(PG8_SB(0, 0), b2, voffB); PG8_STAGE(PG8_SB(0, 1), b2 + hstep, voffB); PG8_STAGE(PG8_SA(0, 0), a2, gofc[0]);
            PG8_WAIT_V(8); PG8_WAIT_L(0); PG8_BAR; PG8_MMA(1, 0, At, B0); PG8_MMA(1, 1, At, B1); PG8_BAR; PG8_SCHED;
            PG8_LDB(B0, 1, 0); PG8_LDB(B1, 1, 1); PG8_SCHED; PG8_LDA(At, 1, 0); PG8_STAGE(PG8_SA(0, 1), a2, gofc[1]);
            PG8_WAIT_V(8); PG8_WAIT_L(0); PG8_BAR; PG8_MMA(0, 0, At, B0); PG8_MMA(0, 1, At, B1); PG8_BAR; PG8_SCHED;
            PG8_LDA(At, 1, 1); PG8_STAGE(PG8_SB(1, 0), b3, voffB); PG8_STAGE(PG8_SB(1, 1), b3 + hstep, voffB); PG8_STAGE(PG8_SA(1, 0), a3, gofc[0]);
            PG8_WAIT_V(8); PG8_WAIT_L(0); PG8_BAR; PG8_MMA(1, 0, At, B0); PG8_MMA(1, 1, At, B1); PG8_BAR; PG8_SCHED;
            }
        }
        if constexpr (ALIGN_EPI) { if (wr == 0) PG8_BAR; }
        if constexpr (!Epi::AFTER_DRAIN) { const int lane2 = opaque_tid() & 63; E(acc, cur, wr, wc, lane2 & 15, lane2 >> 4); S.done(cur); }
        if (!has_next) break;
#pragma unroll
        for (int a = 0; a < 2; ++a)
#pragma unroll
            for (int b = 0; b < 2; ++b)
#pragma unroll
                for (int m = 0; m < 4; ++m)
#pragma unroll
                    for (int n = 0; n < 2; ++n) acc[a][b][m][n] = (f32x4){0.f, 0.f, 0.f, 0.f};
        cur = nxt; cB = nB; ++ui;
        if constexpr (ALIGN_EPI) { if (wr == 1) PG8_BAR; }
    }
    PG8_WAIT_V(0);
    if constexpr (!ALIGN_EPI) { if (wr == 0) PG8_BAR; }
    PG8_BAR;
    if constexpr (Epi::AFTER_DRAIN) { E.fused(acc, cur, wr, wc, fr, fq, lds, wid, lane); S.done(cur); }
#undef PG8_SA
#undef PG8_SB
#undef PG8_STAGE
#undef PG8_LDA
#undef PG8_LDB
#undef PG8_MMA
#undef PG8_WAIT_V
#undef PG8_WAIT_L
#undef PG8_BAR
#undef PG8_SCHED
}
}
#define XB_TMO      128
#define XB_XCNT(j)  (256  + 64 * (j))
#define XB_XSUB(j)  (1280 + 64 * (j))
#define XB_XGEN(j)  (2304 + 64 * (j))
#define XB_TOP      3328
#define XB_TOPGEN   3392
#define XCD_BAR_WORDS 3456
#define XB_SPIN_CAP (1u << 18)
#define LAS __attribute__((address_space(3)))

__device__ __forceinline__ unsigned xb_ld(unsigned* p)              { return __hip_atomic_load(p, __ATOMIC_RELAXED, __HIP_MEMORY_SCOPE_AGENT); }
__device__ __forceinline__ unsigned xb_add(unsigned* p, unsigned v) { return __hip_atomic_fetch_add(p, v, __ATOMIC_RELAXED, __HIP_MEMORY_SCOPE_AGENT); }
__device__ __forceinline__ unsigned xb_xcc_id() { return (unsigned)__builtin_amdgcn_s_getreg((3 << 11) | 20) & 0xFu; }
#define XB_SPIN(cond, bar) do { unsigned _sp = 0; while (cond) { __builtin_amdgcn_s_sleep(1); \
    if ((++_sp & 255u) == 0u) { if (xb_ld(&(bar)[XB_TMO])) break; if (_sp > XB_SPIN_CAP) { atomicAdd(&(bar)[XB_TMO], 1u); break; } } } } while (0)

struct XcdBarrier {
    unsigned* bar; unsigned x;
    volatile LAS unsigned* st;
};

__device__ __forceinline__ XcdBarrier xcd_barrier_post(unsigned* bar, volatile LAS unsigned* st) {
    XcdBarrier b; b.bar = bar; b.x = xb_xcc_id(); b.st = st;
    if (threadIdx.x == 0) (void)xb_add(&bar[XB_XCNT(b.x)], 1u);
    return b;
}
__device__ __forceinline__ void xcd_barrier_complete(unsigned* bar, unsigned x, unsigned& nloc, unsigned& nx) {
    const unsigned G = gridDim.x * gridDim.y * gridDim.z;
    unsigned sum, cnt, mine, sp = 0u;
    for (;;) {
        sum = 0u; cnt = 0u; mine = 0u;
#pragma unroll
        for (unsigned j = 0; j < 16; ++j) { const unsigned c = xb_ld(&bar[XB_XCNT(j)]); sum += c; cnt += (c > 0u) ? 1u : 0u; mine = (j == x) ? c : mine; }
        if (sum == G) break;
        __builtin_amdgcn_s_sleep(1);
        if ((++sp & 255u) == 0u) { if (xb_ld(&bar[XB_TMO])) break; if (sp > XB_SPIN_CAP) { atomicAdd(&bar[XB_TMO], 1u); break; } }
    }
    nloc = mine > 0u ? mine : 1u; nx = cnt > 0u ? cnt : 1u;
}

__device__ __forceinline__ void xcd_barrier(const XcdBarrier& b) {
    asm volatile("s_waitcnt vmcnt(0)" ::: "memory");
    __syncthreads();
    if (threadIdx.x == 0) {
        unsigned* bar = b.bar;
        __builtin_amdgcn_s_waitcnt(0);
        unsigned nloc = b.st[0], nx = b.st[1];
        if (nloc == 0u) { xcd_barrier_complete(bar, b.x, nloc, nx); b.st[0] = nloc; b.st[1] = nx; }
        const unsigned old = xb_add(&bar[XB_XSUB(b.x)], 1u);
        const unsigned gen = old / nloc;
        if (old + 1u == (gen + 1u) * nloc) {
            __builtin_amdgcn_fence(__ATOMIC_RELEASE, "agent");
            asm volatile("s_waitcnt vmcnt(0)" ::: "memory");
            const unsigned og = xb_add(&bar[XB_TOP], 1u);
            const unsigned tg = og / nx;
            if (og + 1u == (tg + 1u) * nx) xb_add(&bar[XB_TOPGEN], 1u);
            else XB_SPIN(xb_ld(&bar[XB_TOPGEN]) == tg, bar);
            __builtin_amdgcn_fence(__ATOMIC_ACQUIRE, "agent");
            xb_add(&bar[XB_XGEN(b.x)], 1u);
            asm volatile("s_waitcnt vmcnt(0)" ::: "memory");
        } else {
            XB_SPIN(xb_ld(&bar[XB_XGEN(b.x)]) == gen, bar);
            __builtin_amdgcn_fence(__ATOMIC_ACQUIRE, "agent");
            asm volatile("s_waitcnt vmcnt(0)" ::: "memory");
        }
    }
    __syncthreads();
}
__device__ __forceinline__ void p0_transpose_item(const float* W, int ldw, int ncols_valid, int k0, int n0, bf16* WT, size_t dst_row0, int Kdst, LAS float* scr, int lane) {
    const int nn = n0 + (lane & 31); const bool ok = nn < ncols_valid;
#pragma unroll 8
    for (int i = 0; i < 32; ++i) { const int kk = 2 * i + (lane >> 5); scr[kk * 33 + (lane & 31)] = ok ? W[(size_t)(k0 + kk) * ldw + nn] : 0.f; }
    LDS_WAIT();
    const int c = lane & 7;
#pragma unroll
    for (int j = 0; j < 4; ++j) { const int n = (lane >> 3) + 8 * j; const LAS float* s = scr + (8 * c) * 33 + n;
        v4u o; o.x = pk2(s[0 * 33], s[1 * 33]); o.y = pk2(s[2 * 33], s[3 * 33]); o.z = pk2(s[4 * 33], s[5 * 33]); o.w = pk2(s[6 * 33], s[7 * 33]);
        *(v4u*)(WT + (dst_row0 + n) * (size_t)Kdst + k0 + 8 * c) = o; }
    LDS_WAIT();
}
__device__ __forceinline__ void ln_row(v4f (&v)[4], const float* g, const float* b, int lane) {
    float s = 0.f, s2 = 0.f;
#pragma unroll
    for (int j = 0; j < 4; ++j) { s += (v[j].x + v[j].y) + (v[j].z + v[j].w); s2 += (v[j].x * v[j].x + v[j].y * v[j].y) + (v[j].z * v[j].z + v[j].w * v[j].w); }
    s = wave_sum(s); s2 = wave_sum(s2);
    const float mean = s * (1.f / D);
    const float rstd = rsq_(fmaxf(s2 * (1.f / D) - mean * mean, 0.f) + LN_EPS);
#pragma unroll
    for (int j = 0; j < 4; ++j) v[j] = v[j] - mean;
#pragma unroll
    for (int j = 0; j < 4; ++j) { const v4f gg = *(const v4f*)(g + 256 * j + 4 * lane), bb = *(const v4f*)(b + 256 * j + 4 * lane); v[j] = v[j] * rstd * gg + bb; }
}
__device__ PHASE_FN void p0_prologue(const Ctx A, LAS unsigned char* lds, int vcu, int G) {
    const int tid = opaque_tid(), lane = tid & 63, wave = tid >> 6;
    LAS float* scr = (LAS float*)(lds + wave * 16384);
    const int gw = vcu * NWAVES + wave, NGW = G * NWAVES;
    bf16* Win_t = (bf16*)(A.ws + WS_WIN); bf16* Wout_t = (bf16*)(A.ws + WS_WOUT); bf16* W1_t = (bf16*)(A.ws + WS_W1); bf16* W2_t = (bf16*)(A.ws + WS_W2);
    constexpr int I_IN = 2 * 16 * (NINP / 32), I_OUT = 2 * 16 * 32, I_W1 = 64 * 16 * 64, I_W2 = 64 * 16 * 32;
    constexpr int NITEMS = I_IN + I_OUT + I_W1 + I_W2;
    for (int it = gw; it < NITEMS; it += NGW) {
        int r = it;
        if (r < I_IN) { const int l = r / (16 * 112), q = r % (16 * 112), kb = q / 112, nb = q % 112;
            p0_transpose_item(gin(A, 4) + (size_t)l * 1024 * 3560, 3560, 3560, kb * 64, nb * 32, Win_t + (size_t)l * NINP * 1024, (size_t)nb * 32, 1024, scr, lane); continue; }
        r -= I_IN;
        if (r < I_OUT) { const int l = r / 512, q = r % 512, kb = q / 32, nb = q % 32;
            p0_transpose_item(gin(A, 25) + (size_t)l * 1024 * 1024, 1024, 1024, kb * 64, nb * 32, Wout_t + (size_t)l * 1024 * 1024, (size_t)nb * 32, 1024, scr, lane); continue; }
        r -= I_OUT;
        if (r < I_W1) { const int le = r / 1024, q = r % 1024, kb = q / 64, nb = q % 64, n0 = nb * 32;
            const int np = n0 & 1023; const size_t drow = (size_t)256 * (np >> 7) + (n0 >= 1024 ? 128 : 0) + (np & 127);
            p0_transpose_item(gin(A, 30) + (size_t)le * 1024 * 2048, 2048, 2048, kb * 64, n0, W1_t + (size_t)le * 2048 * 1024, drow, 1024, scr, lane); continue; }
        r -= I_W1;
        { const int le = r / 512, q = r % 512, kb = q / 32, nb = q % 32;
            p0_transpose_item(gin(A, 32) + (size_t)le * 1024 * 1024, 1024, 1024, kb * 64, nb * 32, W2_t + (size_t)le * 1024 * 1024, (size_t)nb * 32, 1024, scr, lane); }
    }
    bf16* HB = (bf16*)(A.ws + WS_HB);
    for (int m = gw; m < T; m += NGW) {
        const int b = m / L, i = m - b * L;
        const float* src = (i < NMETA) ? gin(A, 1) + (size_t)i * D : gin(A, 0) + ((size_t)b * SEQ + (i - NMETA)) * D;
        v4f v[4];
#pragma unroll
        for (int j = 0; j < 4; ++j) v[j] = *(const v4f*)(src + 256 * j + 4 * lane);
        ln_row(v, gin(A, 2), gin(A, 3), lane);
#pragma unroll
        for (int j = 0; j < 4; ++j) st_bf4(HB + (size_t)m * D + 256 * j + 4 * lane, v[j]);
    }
}
constexpr int NTK = 2;
__device__ __forceinline__ float softplus_fast(float x) { return x > 15.f ? x : __logf(1.f + __expf(x)); }
__device__ __forceinline__ float tanh_fast(float x) { return 1.f - 2.f * rcp_(1.f + __expf(2.f * x)); }
__device__ __forceinline__ void sincos_red(float ang, float& sn, float& cs) {
    const float k = rintf(ang * 0.15915494309189535f);
    float r = fmaf(-k, 6.28318548202514648f, ang); r = fmaf(-k, -1.7484555e-7f, r);
    sn = __sinf(r); cs = __cosf(r);
}
constexpr int PREP_W = 98304, PREP_SCR = 4096;
__device__ __forceinline__ void prep_load_w(LAS unsigned char* lds, const float* src, int n, int dst_elem, int tid) {
    for (int i = tid * 4; i < n; i += NTHR * 4) { const v4f x = *(const v4f*)(src + i); v2u o; o.x = pk2(x.x, x.y); o.y = pk2(x.z, x.w); *(LAS v2u*)(lds + (size_t)(dst_elem + i) * 2) = o; }
}
__device__ PHASE_FN void prep_phase(const Ctx A, LAS unsigned char* lds, int l, int vcu, int G) {
    const int tid = opaque_tid(), lane = tid & 63, wave = tid >> 6;
    LAS float* scr = (LAS float*)(lds + PREP_W + wave * PREP_SCR);
    const int gw = vcu * NWAVES + wave, NGW = G * NWAVES;
    const bf16* PROJ = (const bf16*)(A.ws + WS_PROJ);
    const int c4 = 4 * lane, hh = lane >> 4, d4 = 4 * (lane & 15);
    const float* mu = gin(A, 5) + l * 960; const float* w0 = gin(A, 6) + l * 256; const float* w2 = gin(A, 7) + l * 64 * 256;
    const float* a0 = gin(A, 8) + l * 256; const float* a2 = gin(A, 9) + l * 64 * 256; const float* g2 = gin(A, 10) + l * 64 * 256;
    const float* k_k = gin(A, 11) + l * 256; const float* k_a = gin(A, 12) + l * 256; const float* r_k = gin(A, 13) + l * 256;
    const float* conv_w = gin(A, 16) + l * 4 * 256; const float* conv_b = gin(A, 17) + l * 256;
    const float* wa = gin(A, 18) + l * 4 * 64 * 64; const float* ba = gin(A, 19) + l * 256; const float* wx = gin(A, 20) + l * 4 * 64 * 64; const float* bx = gin(A, 21) + l * 256;
    const float* lam = gin(A, 22) + l * 256; const float* lbs = gin(A, 23);
    float* RW_W = (float*)(A.ws + WS_RW_W); bf16* RW_A = (bf16*)(A.ws + WS_RW_A); bf16* RW_B = (bf16*)(A.ws + WS_RW_B); bf16* RW_K = (bf16*)(A.ws + WS_RW_K);
    bf16* RW_WR = (bf16*)(A.ws + WS_RW_WR); bf16* RW_V = (bf16*)(A.ws + WS_RW_V); bf16* RW_G = (bf16*)(A.ws + WS_RW_G); float* RW_SC = (float*)(A.ws + WS_RW_SC);
    bf16* DS_Q = (bf16*)(A.ws + WS_DS_Q); bf16* DS_K = (bf16*)(A.ws + WS_DS_K); bf16* DS_V = (bf16*)(A.ws + WS_DS_V); bf16* DS_QI = (bf16*)(A.ws + WS_DS_QI);
    bf16* DS_KI = (bf16*)(A.ws + WS_DS_KI); float* DS_WI = (float*)(A.ws + WS_DS_WI);
    float* LR_A = (float*)(A.ws + WS_LR_A); bf16* LR_U = (bf16*)(A.ws + WS_LR_U); bf16* LR_G = (bf16*)(A.ws + WS_LR_G);
    float* HG_F = (float*)(A.ws + WS_HG_F); bf16* HG_K = (bf16*)(A.ws + WS_HG_K); bf16* HG_Q = (bf16*)(A.ws + WS_HG_Q); bf16* HG_V = (bf16*)(A.ws + WS_HG_V); bf16* HG_G = (bf16*)(A.ws + WS_HG_G);
    LAS unsigned* kmaxl = (LAS unsigned*)(lds + MISC_OFF + 640);
    LAS unsigned* kimaxl = (LAS unsigned*)(lds + MISC_OFF + 832);
    if (tid < 32) kmaxl[tid] = 0u;
    if (tid < 8) kimaxl[tid] = 0u;
    const bool q_rot = (lane & 15) < 4, q_hi = (lane & 15) >= 2;
    const bool i_rot = (lane & 7) < 2, i_hi = (lane & 7) == 1;

#define BF4R(q_) ((v4f){bflo((q_).x), bfhi((q_).x), bflo((q_).y), bfhi((q_).y)})
    {
        constexpr int RC_OFF = 98304;
        static_assert(RC_OFF + 8 * 1024 <= MISC_OFF, "pass R lds");
        for (int f = tid; f < 96 * 64; f += NTHR) { const int ln = f & 63, fr = f >> 6, ks = fr & 1, nt = (fr >> 1) & 15, mat = fr >> 5, rr = ln & 15, g8 = ln >> 4;
            const float* W = (mat == 0 ? w2 : mat == 1 ? a2 : g2) + (32 * ks + 8 * g8) * 256 + 64 * (nt >> 2) + 16 * (rr >> 2) + 4 * (nt & 3) + (rr & 3);
            v4u o; o.x = pk2(W[0], W[256]); o.y = pk2(W[512], W[768]); o.z = pk2(W[1024], W[1280]); o.w = pk2(W[1536], W[1792]);
            *(LAS v4u*)(lds + (size_t)fr * 1024 + ln * 16) = o; }
        LAS float* rc = (LAS float*)(lds + RC_OFF);
        if (tid < 256) { rc[tid] = mu[C_RW_R + tid]; rc[256 + tid] = mu[C_RW_K + tid]; rc[512 + tid] = mu[C_RW_V + tid]; rc[768 + tid] = w0[tid];
            rc[1024 + tid] = a0[tid]; rc[1280 + tid] = k_k[tid]; rc[1536 + tid] = k_a[tid]; rc[1792 + tid] = r_k[tid]; }
        __syncthreads();
        const int r = lane & 15, g = lane >> 4;
        const v4f z4 = (v4f){0.f, 0.f, 0.f, 0.f};
        auto r_tile = [&](const int tile, const int hd_lo, const int hd_hi) {
            const int m0 = tile * 16, b = m0 / L, i = m0 - b * L + r;
            const bf16* rowc = PROJ + (size_t)(m0 + r) * NINP;
            const bool hasp = i > 0; const bf16* rowp = hasp ? rowc - NINP : rowc;
            unsigned tch[4];
#pragma unroll
            for (int q = 0; q < 4; ++q) { const int ln_ = g + 4 * q < 15 ? g + 4 * q : 14; tch[q] = *(const unsigned*)(rowc + 64 * ln_); }
            pg8::bf16x8 Bf[3][2];
#pragma unroll
            for (int mat = 0; mat < 3; ++mat)
#pragma unroll
                for (int ks = 0; ks < 2; ++ks) { const int off = (mat == 0 ? C_RW_WD : mat == 1 ? C_RW_AD : C_RW_GD) + 32 * ks + 8 * g;
                    const v4u cq = *(const v4u*)(rowc + off), pq = *(const v4u*)(rowp + off);
                    const v4f m0v = *(const v4f*)(mu + off), m1v = *(const v4f*)(mu + off + 4);
                    float o8[8];
#pragma unroll
                    for (int e = 0; e < 8; ++e) { const unsigned cw = cq[e >> 1], pw = pq[e >> 1];
                        const float cur = (e & 1) ? bfhi(cw) : bflo(cw), prv = hasp ? ((e & 1) ? bfhi(pw) : bflo(pw)) : 0.f;
                        const float sv = cur + (prv - cur) * (e < 4 ? m0v[e & 3] : m1v[e & 3]);
                        o8[e] = mat == 0 ? tanh_fast(sv) : mat == 1 ? sv : sigmoidf_(sv); }
                    v4u pk; pk.x = pk2(o8[0], o8[1]); pk.y = pk2(o8[2], o8[3]); pk.z = pk2(o8[4], o8[5]); pk.w = pk2(o8[6], o8[7]);
                    Bf[mat][ks] = __builtin_bit_cast(pg8::bf16x8, pk); }
            asm volatile("" :: "v"(tch[0]), "v"(tch[1]), "v"(tch[2]), "v"(tch[3]));
#pragma unroll 1
            for (int hd = hd_lo; hd < hd_hi; ++hd) {
                pg8::f32x4 Cw[4], Ca[4], Cg[4];
#pragma unroll
                for (int nt = 0; nt < 4; ++nt) {
                    const LAS unsigned char* wf = lds + (size_t)((hd * 4 + nt) * 2) * 1024 + lane * 16;
                    pg8::f32x4 cw = (pg8::f32x4){0.f, 0.f, 0.f, 0.f}, ca = cw, cg = cw;
#pragma unroll
                    for (int ks = 0; ks < 2; ++ks) {
                        cw = __builtin_amdgcn_mfma_f32_16x16x32_bf16(*(const LAS pg8::bf16x8*)(wf + ks * 1024), Bf[0][ks], cw, 0, 0, 0);
                        ca = __builtin_amdgcn_mfma_f32_16x16x32_bf16(*(const LAS pg8::bf16x8*)(wf + 32768 + ks * 1024), Bf[1][ks], ca, 0, 0, 0);
                        cg = __builtin_amdgcn_mfma_f32_16x16x32_bf16(*(const LAS pg8::bf16x8*)(wf + 65536 + ks * 1024), Bf[2][ks], cg, 0, 0, 0); }
                    Cw[nt] = cw; Ca[nt] = ca; Cg[nt] = cg;
                }
                const size_t hrow = ((size_t)(b * 4 + hd) * L + i);
                v4f kun[4], kav_[4];
                float n2 = 0.f, sbr = 0.f, skr = 0.f, sbo = 0.f;
                const int cbh = hd * 64 + 16 * g;
                v4u Lr[2], Lk[2], Lv[2], Qr[2], Qk[2], Qv[2]; v2u oK[4], oWR[4], oV[4], oG[4];
#pragma unroll
                for (int h2 = 0; h2 < 2; ++h2) { Lr[h2] = *(const v4u*)(rowc + C_RW_R + cbh + 8 * h2); Lk[h2] = *(const v4u*)(rowc + C_RW_K + cbh + 8 * h2); Lv[h2] = *(const v4u*)(rowc + C_RW_V + cbh + 8 * h2);
                    Qr[h2] = *(const v4u*)(rowp + C_RW_R + cbh + 8 * h2); Qk[h2] = *(const v4u*)(rowp + C_RW_K + cbh + 8 * h2); Qv[h2] = *(const v4u*)(rowp + C_RW_V + cbh + 8 * h2); }
#define PREP_W4(V_, nt_) ((v4f){bflo(V_[(nt_) >> 1][2 * ((nt_) & 1)]), bfhi(V_[(nt_) >> 1][2 * ((nt_) & 1)]), bflo(V_[(nt_) >> 1][2 * ((nt_) & 1) + 1]), bfhi(V_[(nt_) >> 1][2 * ((nt_) & 1) + 1])})
#pragma unroll
                for (int nt = 0; nt < 4; ++nt) {
                    const int cc = cbh + 4 * nt, d4h = 16 * g + 4 * nt;
                    const v4f cr = PREP_W4(Lr, nt), ck = PREP_W4(Lk, nt), cv = PREP_W4(Lv, nt);
                    const v4f pr = hasp ? PREP_W4(Qr, nt) : z4, pk_ = hasp ? PREP_W4(Qk, nt) : z4, pv = hasp ? PREP_W4(Qv, nt) : z4;
                    const v4f mu_r = *(const LAS v4f*)(rc + cc), mu_k = *(const LAS v4f*)(rc + 256 + cc), mu_v = *(const LAS v4f*)(rc + 512 + cc), w0v = *(const LAS v4f*)(rc + 768 + cc);
                    const v4f a0v = *(const LAS v4f*)(rc + 1024 + cc), kkv = *(const LAS v4f*)(rc + 1280 + cc), kav = *(const LAS v4f*)(rc + 1536 + cc), rkv = *(const LAS v4f*)(rc + 1792 + cc);
                    const v4f rs = cr + (pr - cr) * mu_r, kx = ck + (pk_ - ck) * mu_k, vs = cv + (pv - cv) * mu_v;
                    v4f dec, km, wr, lg;
#pragma unroll
                    for (int e = 0; e < 4; ++e) {
                        const float wv = -softplus_fast(-(w0v[e] + Cw[nt][e])) - 0.5f;
                        dec[e] = __expf(-__expf(wv));
                        const float av = sigmoidf_(a0v[e] + Ca[nt][e]);
                        const float ku = kx[e] * kkv[e]; kun[nt][e] = ku; kav_[nt][e] = ku * av; n2 += ku * ku;
                        km[e] = kx[e] * (1.f + (av - 1.f) * kav[e]);
                        wr[e] = dec[e] * rs[e]; sbr += ku * av * rs[e]; skr += km[e] * rs[e]; sbo += rs[e] * km[e] * rkv[e];
                        lg[e] = Cg[nt][e]; }
                    *(v4f*)(RW_W + hrow * 64 + d4h) = dec;
                    oK[nt].x = pk2(km[0], km[1]); oK[nt].y = pk2(km[2], km[3]); oWR[nt].x = pk2(wr[0], wr[1]); oWR[nt].y = pk2(wr[2], wr[3]);
                    oV[nt].x = pk2(vs[0], vs[1]); oV[nt].y = pk2(vs[2], vs[3]); oG[nt].x = pk2(lg[0], lg[1]); oG[nt].y = pk2(lg[2], lg[3]);
                }
#undef PREP_W4
#pragma unroll
                for (int h2 = 0; h2 < 2; ++h2) { const size_t ho = hrow * 64 + 16 * g + 8 * h2;
                    *(v4u*)(RW_K + ho) = (v4u){oK[2 * h2].x, oK[2 * h2].y, oK[2 * h2 + 1].x, oK[2 * h2 + 1].y}; *(v4u*)(RW_WR + ho) = (v4u){oWR[2 * h2].x, oWR[2 * h2].y, oWR[2 * h2 + 1].x, oWR[2 * h2 + 1].y};
                    *(v4u*)(RW_V + ho) = (v4u){oV[2 * h2].x, oV[2 * h2].y, oV[2 * h2 + 1].x, oV[2 * h2 + 1].y};
                    *(v4u*)(RW_G + (size_t)(m0 + r) * 256 + cbh + 8 * h2) = (v4u){oG[2 * h2].x, oG[2 * h2].y, oG[2 * h2 + 1].x, oG[2 * h2 + 1].y}; }
                n2 += __shfl_xor(n2, 16); n2 += __shfl_xor(n2, 32);
                const float inv = rcp_(fmaxf(sqrtf(n2), 1e-12f));
#pragma unroll
                for (int h2 = 0; h2 < 2; ++h2) { const size_t ho = hrow * 64 + 16 * g + 8 * h2; const v4f a0_ = kun[2 * h2] * (-inv), a1_ = kun[2 * h2 + 1] * (-inv), b0_ = kav_[2 * h2] * inv, b1_ = kav_[2 * h2 + 1] * inv;
                    *(v4u*)(RW_A + ho) = (v4u){pk2(a0_[0], a0_[1]), pk2(a0_[2], a0_[3]), pk2(a1_[0], a1_[1]), pk2(a1_[2], a1_[3])};
                    *(v4u*)(RW_B + ho) = (v4u){pk2(b0_[0], b0_[1]), pk2(b0_[2], b0_[3]), pk2(b1_[0], b1_[1]), pk2(b1_[2], b1_[3])}; }
                sbr *= inv;
                sbr += __shfl_xor(sbr, 16); sbr += __shfl_xor(sbr, 32); skr += __shfl_xor(skr, 16); skr += __shfl_xor(skr, 32); sbo += __shfl_xor(sbo, 16); sbo += __shfl_xor(sbo, 32);
                if (g == 0) *(v4f*)(RW_SC + hrow * 4) = (v4f){sbr, skr, sbo, 0.f};
            }
        };
        const int NT16 = T / 16, nfull = (NT16 / NGW) * NGW;
#pragma unroll 1
        for (int it = gw; it < nfull + (NT16 - nfull) * 4; it += NGW) { const int q = it - nfull; const bool part = q >= 0;
            r_tile(part ? nfull + (q >> 2) : it, part ? (q & 3) : 0, part ? (q & 3) + 1 : 4); }
    }
    __syncthreads();
    {
        constexpr int XT_PITCH = 528, XT_BYTES = 16 * XT_PITCH, XT_OFF = 65536, LCST_OFF = XT_OFF + NWAVES * XT_BYTES;
        static_assert(LCST_OFF + 3 * 1024 <= MISC_OFF, "pass L lds");
        for (int f = tid; f < 64 * 64; f += NTHR) { const int ln = f & 63, fr = f >> 6, ks = fr & 1, nt = (fr >> 1) & 3, hd = (fr >> 3) & 3, mat = fr >> 5, rr = ln & 15, g8 = ln >> 4;
            const float* W = (mat ? wx : wa) + hd * 4096 + (32 * ks + 8 * g8) * 64 + 16 * (rr >> 2) + 4 * nt + (rr & 3);
            v4u o; o.x = pk2(W[0], W[64]); o.y = pk2(W[128], W[192]); o.z = pk2(W[256], W[320]); o.w = pk2(W[384], W[448]);
            *(LAS v4u*)(lds + (size_t)fr * 1024 + ln * 16) = o; }
        LAS float* cst = (LAS float*)(lds + LCST_OFF);
        if (tid < 256) { cst[tid] = ba[tid]; cst[256 + tid] = bx[tid];
            const float xs = -lam[tid], ys = __expf(xs);
            cst[512 + tid] = xs > 15.f ? xs : (ys < 0.01f ? ys * (1.f - ys * (0.5f - ys * 0.33333334f)) : __logf(1.f + ys)); }
        __syncthreads();
        LAS unsigned char* xt = lds + XT_OFF + wave * XT_BYTES;
        const int r = lane & 15, g = lane >> 4;
        const v4f cb = *(const v4f*)(conv_b + c4), cw0 = *(const v4f*)(conv_w + c4), cw1 = *(const v4f*)(conv_w + 256 + c4), cw2 = *(const v4f*)(conv_w + 512 + c4), cw3 = *(const v4f*)(conv_w + 768 + c4);
        auto l_tile = [&](const int tile, const int hd_lo, const int hd_hi) {
            const int m0 = tile * 16, b = m0 / L, i0 = m0 - b * L;
            const bf16* Pq = PROJ + (size_t)m0 * NINP;
            v2u xb[19], gr[16];
#pragma unroll
            for (int q = 0; q < 19; ++q) { const int ro = (i0 + q - 3 >= 0) ? q - 3 : 0; xb[q] = *(const v2u*)(Pq + (ptrdiff_t)ro * NINP + C_LR_X + c4); }
#pragma unroll
            for (int t = 0; t < 16; ++t) gr[t] = *(const v2u*)(Pq + (size_t)t * NINP + C_LR_G + c4);
            const v4f z4 = (v4f){0.f, 0.f, 0.f, 0.f};
            v4f x0 = i0 > 0 ? BF4R(xb[0]) : z4, x1 = i0 > 0 ? BF4R(xb[1]) : z4, x2 = i0 > 0 ? BF4R(xb[2]) : z4;
#pragma unroll
            for (int t = 0; t < 16; ++t) {
                const v4f x3 = BF4R(xb[t + 3]);
                const v4f xc = cb + cw0 * x0 + cw1 * x1 + cw2 * x2 + cw3 * x3;
                v2u o; o.x = pk2(xc.x, xc.y); o.y = pk2(xc.z, xc.w);
                *(LAS v2u*)(xt + t * XT_PITCH + c4 * 2) = o;
                x0 = x1; x1 = x2; x2 = x3;
                const v4f gv = BF4R(gr[t]); v4f gg;
#pragma unroll
                for (int e = 0; e < 4; ++e) { const float tt = 0.7978845608028654f * (gv[e] + 0.044715f * gv[e] * gv[e] * gv[e]); gg[e] = 0.5f * gv[e] * (1.f + tanh_fast(tt)); }
                if (hd_lo == 0) st_bf4(LR_G + (size_t)(m0 + t) * 256 + c4, gg);
            }
            LDS_WAIT();
#pragma unroll 1
            for (int hd = hd_lo; hd < hd_hi; ++hd) {
                const LAS unsigned char* xrow = xt + r * XT_PITCH + hd * 128;
                const pg8::bf16x8 bk0 = *(const LAS pg8::bf16x8*)(xrow + g * 16), bk1 = *(const LAS pg8::bf16x8*)(xrow + 64 + g * 16);
                pg8::f32x4 Ca[4], Cx[4];
#pragma unroll
                for (int nt = 0; nt < 4; ++nt) {
                    const LAS unsigned char* wf = lds + (size_t)((hd * 4 + nt) * 2) * 1024 + lane * 16;
                    const pg8::bf16x8 a0 = *(const LAS pg8::bf16x8*)(wf), a1 = *(const LAS pg8::bf16x8*)(wf + 1024), x0f = *(const LAS pg8::bf16x8*)(wf + 32768), x1f = *(const LAS pg8::bf16x8*)(wf + 32768 + 1024);
                    pg8::f32x4 ca = (pg8::f32x4){0.f, 0.f, 0.f, 0.f}, cx = ca;
                    ca = __builtin_amdgcn_mfma_f32_16x16x32_bf16(a0, bk0, ca, 0, 0, 0); ca = __builtin_amdgcn_mfma_f32_16x16x32_bf16(a1, bk1, ca, 0, 0, 0);
                    cx = __builtin_amdgcn_mfma_f32_16x16x32_bf16(x0f, bk0, cx, 0, 0, 0); cx = __builtin_amdgcn_mfma_f32_16x16x32_bf16(x1f, bk1, cx, 0, 0, 0);
                    Ca[nt] = ca; Cx[nt] = cx;
                }
                v2u oU[4];
#pragma unroll
                for (int nt = 0; nt < 4; ++nt) {
                    const int c0 = hd * 64 + 16 * g + 4 * nt;
                    const v4f bav = *(const LAS v4f*)(cst + c0), bxv = *(const LAS v4f*)(cst + 256 + c0), spl = *(const LAS v4f*)(cst + 512 + c0);
                    const v2u xq = *(const LAS v2u*)(xt + r * XT_PITCH + c0 * 2); const v4f xc = BF4R(xq);
                    v4f aa, uu;
#pragma unroll
                    for (int e = 0; e < 4; ++e) { const float rg = sigmoidf_(Ca[nt][e] + bav[e]), ig = sigmoidf_(Cx[nt][e] + bxv[e]);
                        const float la = -8.f * rg * spl[e]; aa[e] = __expf(la);
                        const float x2l = 2.f * la; const float om = (x2l > -0.1f) ? -(x2l * (1.f + x2l * (0.5f + x2l * (0.16666667f + x2l * 0.041666668f)))) : (1.f - __expf(x2l));
                        uu[e] = xc[e] * ig * __builtin_amdgcn_sqrtf(om); }
                    const size_t mo = (size_t)(m0 + r) * 256 + c0;
                    *(v4f*)(LR_A + mo) = aa; oU[nt].x = pk2(uu[0], uu[1]); oU[nt].y = pk2(uu[2], uu[3]);
                }
#pragma unroll
                for (int h2 = 0; h2 < 2; ++h2) *(v4u*)(LR_U + (size_t)(m0 + r) * 256 + hd * 64 + 16 * g + 8 * h2) = (v4u){oU[2 * h2].x, oU[2 * h2].y, oU[2 * h2 + 1].x, oU[2 * h2 + 1].y};
            }
        };
        const int NT16 = T / 16, nfull = (NT16 / NGW) * NGW;
#pragma unroll 1
        for (int it = gw; it < nfull + (NT16 - nfull) * 4; it += NGW) { const int q = it - nfull; const bool part = q >= 0;
            l_tile(part ? nfull + (q >> 2) : it, part ? (q & 3) : 0, part ? (q & 3) + 1 : 4); }
    }
    {
        float invf_q[4], invf_i[4];
#pragma unroll
        for (int e = 0; e < 4; ++e) { invf_q[e] = exp2f(-(float)((d4 + e) & 7) * (18.931568569324174f / 8.f)); invf_i[e] = exp2f(-(float)e * (18.931568569324174f / 4.f)); }
        v4f lb = (v4f){0.f, 0.f, 0.f, 0.f};
        if (l == 1) { const v4f x0 = *(const v4f*)(lbs + c4), x1 = *(const v4f*)(lbs + 256 + c4);
            lb.x = 1.f / (1.f + __expf(x0.x - x1.x)); lb.y = 1.f / (1.f + __expf(x0.y - x1.y)); lb.z = 1.f / (1.f + __expf(x0.z - x1.z)); lb.w = 1.f / (1.f + __expf(x0.w - x1.w)); }
#pragma unroll 2
        for (int m = gw; m < T; m += NGW) {
            const int b = m / L, i = m - b * L; const float pos = (float)i;
            const bf16* Pj = PROJ + (size_t)m * NINP;
            v4f q = ld_bf4(Pj + C_DS_Q + c4), k = ld_bf4(Pj + C_DS_K + c4);
            const v4f v = ld_bf4(Pj + C_DS_V + c4);
            v4f qi = ld_bf4(Pj + C_DS_QI + c4), ki = ld_bf4(Pj + C_DS_KI + 4 * (lane & 7));
            const v4f hq = ld_bf4(Pj + C_HG_Q + c4), z = ld_bf4(Pj + C_HG_F + c4), vi = ld_bf4(Pj + C_HG_I + c4), hgt = ld_bf4(Pj + C_HG_G + c4);
#pragma unroll
            for (int e = 0; e < 4; ++e) {
                const float qp = __shfl_xor(q[e], 2), kp = __shfl_xor(k[e], 2), qip = __shfl_xor(qi[e], 1), kip = __shfl_xor(ki[e], 1);
                float sn, cs; sincos_red(pos * invf_q[e], sn, cs);
                if (q_rot) { q[e] = q_hi ? (qp * sn + q[e] * cs) : (q[e] * cs - qp * sn); k[e] = q_hi ? (kp * sn + k[e] * cs) : (k[e] * cs - kp * sn); }
                sincos_red(pos * invf_i[e], sn, cs);
                if (i_rot) { qi[e] = i_hi ? (qip * sn + qi[e] * cs) : (qi[e] * cs - qip * sn); ki[e] = i_hi ? (kip * sn + ki[e] * cs) : (ki[e] * cs - kip * sn); }
            }
            { float kn2 = sum16(k.x * k.x + k.y * k.y + k.z * k.z + k.w * k.w); if ((lane & 15) == 0) __hip_atomic_fetch_max(kmaxl + b * 4 + hh, __float_as_uint(kn2 * 1.02f), __ATOMIC_RELAXED, __HIP_MEMORY_SCOPE_WORKGROUP); }
            st_bf4(DS_Q + (size_t)m * 256 + c4, q * (0.125f * 1.4426950408889634f));      st_bf4(DS_K + (size_t)m * 256 + c4, k); st_bf4(DS_V + (size_t)m * 256 + c4, v); st_bf4(DS_QI + (size_t)m * 256 + c4, qi);
            { float in2 = sum8(ki.x * ki.x + ki.y * ki.y + ki.z * ki.z + ki.w * ki.w); if (lane == 0) __hip_atomic_fetch_max(kimaxl + b, __float_as_uint(in2 * 1.02f), __ATOMIC_RELAXED, __HIP_MEMORY_SCOPE_WORKGROUP); }
            if (lane < 8) { st_bf4(DS_KI + (size_t)m * 32 + 4 * lane, ki); DS_WI[(size_t)m * 8 + lane] = bf2f(Pj[C_DS_WI + lane]) * 0.0625f; }
            v4f qs, f, kq, gs;
#pragma unroll
            for (int e = 0; e < 4; ++e) { const float sg = sigmoidf_(z[e]); qs[e] = hq[e] * sigmoidf_(hq[e]); f[e] = lb[e] + (1.f - lb[e]) * sg; kq[e] = (1.f - lb[e]) * (1.f - sg); gs[e] = hgt[e] * sigmoidf_(hgt[e]); }
            const size_t hm = ((size_t)(b * 4 + hh) * L + i) * 64 + d4;
            *(v4f*)(HG_F + hm) = f; st_bf4(HG_K + hm, kq); st_bf4(HG_Q + hm, qs); st_bf4(HG_V + hm, vi); st_bf4(HG_G + (size_t)m * 256 + c4, gs);
        }
    }
    __syncthreads();
    if (tid < 32) atomicMax((unsigned*)(A.ws + WS_CTL) + 8960 + 64 * l + tid, kmaxl[tid]);
    if (tid < 8) atomicMax((unsigned*)(A.ws + WS_CTL) + 9216 + 64 * l + tid, kimaxl[tid]);
}
constexpr int SC_C = 32;
constexpr size_t WS_YRAW = WS_PROJ;
constexpr size_t WS_ORAW = WS_PROJ + (size_t)T * 1024;
__device__ PHASE_FN void rwkv_scan(const Ctx A, LAS unsigned char* lds, int unit_) {
    const int unit = opaque_s(unit_);
    const int tid = opaque_tid(), row = tid >> 4, kp = tid & 15;
    const int bh = unit >> 1, half = unit & 1, b = bh >> 2, h = bh & 3;
    const size_t base = (size_t)bh * L * 64;
    const float* W = (const float*)(A.ws + WS_RW_W) + base;
    const bf16* Av = (const bf16*)(A.ws + WS_RW_A) + base; const bf16* Bv = (const bf16*)(A.ws + WS_RW_B) + base; const bf16* Kv = (const bf16*)(A.ws + WS_RW_K) + base;
    const bf16* WRv = (const bf16*)(A.ws + WS_RW_WR) + base; const bf16* Vv = (const bf16*)(A.ws + WS_RW_V) + base + half * 32;
    const float* SC = (const float*)(A.ws + WS_RW_SC) + (size_t)bh * L * 4;
    float* YR = (float*)(A.ws + WS_YRAW) + (size_t)b * L * 256 + h * 64 + half * 32;
    constexpr int ARR = SC_C * 64;
    constexpr int BUF = (5 * ARR + SC_C * 32 + SC_C * 4) * 4;
    LAS float* ybuf = (LAS float*)(lds + 2 * BUF);
    float S0 = 0.f, S1 = 0.f, S2 = 0.f, S3 = 0.f;
    v4f rw; v2u ra, rb, rk, rwr, rv; float rsc = 0.f;
    const int e4 = tid * 4;
#define RW_LOAD(c) do { const int t0_ = (c) * SC_C; const bool ok_ = (t0_ + (e4 >> 6)) < L; const size_t o_ = (size_t)t0_ * 64 + e4; \
        rw = ok_ ? *(const v4f*)(W + o_) : (v4f){1.f, 1.f, 1.f, 1.f}; ra = ok_ ? *(const v2u*)(Av + o_) : (v2u){0u, 0u}; rb = ok_ ? *(const v2u*)(Bv + o_) : (v2u){0u, 0u}; \
        rk = ok_ ? *(const v2u*)(Kv + o_) : (v2u){0u, 0u}; rwr = ok_ ? *(const v2u*)(WRv + o_) : (v2u){0u, 0u}; \
        if (tid < SC_C * 8) rv = (t0_ + (tid >> 3)) < L ? *(const v2u*)(Vv + (size_t)(t0_ + (tid >> 3)) * 64 + (tid & 7) * 4) : (v2u){0u, 0u}; \
        if (tid < SC_C * 4) rsc = (t0_ + (tid >> 2)) < L ? SC[(size_t)t0_ * 4 + tid] : 0.f; } while (0)
#define RW_STORE(p) do { LAS float* d_ = (LAS float*)(lds + (p) * BUF); \
        *(LAS v4f*)(d_ + e4) = rw; *(LAS v4f*)(d_ + ARR + e4) = (v4f){bflo(ra.x), bfhi(ra.x), bflo(ra.y), bfhi(ra.y)}; *(LAS v4f*)(d_ + 2 * ARR + e4) = (v4f){bflo(rb.x), bfhi(rb.x), bflo(rb.y), bfhi(rb.y)}; \
        *(LAS v4f*)(d_ + 3 * ARR + e4) = (v4f){bflo(rk.x), bfhi(rk.x), bflo(rk.y), bfhi(rk.y)}; *(LAS v4f*)(d_ + 4 * ARR + e4) = (v4f){bflo(rwr.x), bfhi(rwr.x), bflo(rwr.y), bfhi(rwr.y)}; \
        if (tid < SC_C * 8) *(LAS v4f*)(d_ + 5 * ARR + tid * 4) = (v4f){bflo(rv.x), bfhi(rv.x), bflo(rv.y), bfhi(rv.y)}; if (tid < SC_C * 4) d_[5 * ARR + SC_C * 32 + tid] = rsc; } while (0)
    constexpr int NCH = (L + SC_C - 1) / SC_C;
    RW_LOAD(0); RW_STORE(0); __syncthreads();
#pragma unroll 1
    for (int c = 0; c < NCH; ++c) {
        const int p = c & 1;
        if (c + 1 < NCH) RW_LOAD(c + 1);
        const int ns = (L - c * SC_C) < SC_C ? (L - c * SC_C) : SC_C;
        const LAS float* d = (const LAS float*)(lds + p * BUF);
        const LAS float* q = d + kp * 4; const LAS float* dv = d + 5 * ARR + row; const LAS float* dsc = d + 5 * ARR + SC_C * 32;
        v4f w4 = *(const LAS v4f*)(q), a4 = *(const LAS v4f*)(q + ARR), b4 = *(const LAS v4f*)(q + 2 * ARR), k4 = *(const LAS v4f*)(q + 3 * ARR), r4 = *(const LAS v4f*)(q + 4 * ARR);
        float vv = dv[0]; v2f sc = *(const LAS v2f*)(dsc);
#pragma unroll 2
        for (int s = 0; s < ns; ++s) {
            const int sn = (s + 1 < SC_C) ? s + 1 : s;
            const v4f nw4 = *(const LAS v4f*)(q + sn * 64), na4 = *(const LAS v4f*)(q + ARR + sn * 64), nb4 = *(const LAS v4f*)(q + 2 * ARR + sn * 64);
            const v4f nk4 = *(const LAS v4f*)(q + 3 * ARR + sn * 64), nr4 = *(const LAS v4f*)(q + 4 * ARR + sn * 64);
            const float nvv = dv[sn * 32]; const v2f nsc = *(const LAS v2f*)(dsc + sn * 4);
            float sa = (S0 * a4.x + S1 * a4.y) + (S2 * a4.z + S3 * a4.w), y1 = (S0 * r4.x + S1 * r4.y) + (S2 * r4.z + S3 * r4.w);
            sa = sum16(sa); y1 = sum16(y1);
            S0 = S0 * w4.x + sa * b4.x + vv * k4.x; S1 = S1 * w4.y + sa * b4.y + vv * k4.y; S2 = S2 * w4.z + sa * b4.z + vv * k4.z; S3 = S3 * w4.w + sa * b4.w + vv * k4.w;
            const float yo = y1 + sa * sc.x + vv * sc.y;
            if (kp == 0) ybuf[s * 32 + row] = yo;
            w4 = nw4; a4 = na4; b4 = nb4; k4 = nk4; r4 = nr4; vv = nvv; sc = nsc;
        }
        __syncthreads();
        { const int s = tid >> 4, r2 = (tid & 15) * 2;
          if (s < ns) *(v2f*)(YR + (size_t)(c * SC_C + s) * 256 + r2) = *(const LAS v2f*)(ybuf + s * 32 + r2); }
        if (c + 1 < NCH) RW_STORE(1 - p);
        __syncthreads();
    }
#undef RW_LOAD
#undef RW_STORE
}
__device__ PHASE_FN void hgrn_scan(const Ctx A, LAS unsigned char* lds, int unit_) {
    const int unit = opaque_s(unit_);
    const int tid = opaque_tid(), row = tid >> 4, kp = tid & 15;
    const int bh = unit >> 1, half = unit & 1, b = bh >> 2, h = bh & 3;
    const size_t base = (size_t)bh * L * 64;
    const float* Fv = (const float*)(A.ws + WS_HG_F) + base;
    const bf16* Kv = (const bf16*)(A.ws + WS_HG_K) + base; const bf16* Qv = (const bf16*)(A.ws + WS_HG_Q) + base; const bf16* Vv = (const bf16*)(A.ws + WS_HG_V) + base + half * 32;
    float* OR = (float*)(A.ws + WS_ORAW) + (size_t)b * L * 256 + h * 64 + half * 32;
    constexpr int ARR = SC_C * 64; constexpr int BUF = (3 * ARR + SC_C * 32) * 4;
    LAS float* obuf = (LAS float*)(lds + 2 * BUF);
    float S0 = 0.f, S1 = 0.f, S2 = 0.f, S3 = 0.f;
    v4f rf; v2u rk, rq, rv;
    const int e4 = tid * 4;
#define HG_LOAD(c) do { const int t0_ = (c) * SC_C; const bool ok_ = (t0_ + (e4 >> 6)) < L; const size_t o_ = (size_t)t0_ * 64 + e4; \
        rf = ok_ ? *(const v4f*)(Fv + o_) : (v4f){1.f, 1.f, 1.f, 1.f}; rk = ok_ ? *(const v2u*)(Kv + o_) : (v2u){0u, 0u}; rq = ok_ ? *(const v2u*)(Qv + o_) : (v2u){0u, 0u}; \
        if (tid < SC_C * 8) rv = (t0_ + (tid >> 3)) < L ? *(const v2u*)(Vv + (size_t)(t0_ + (tid >> 3)) * 64 + (tid & 7) * 4) : (v2u){0u, 0u}; } while (0)
#define HG_STORE(p) do { LAS float* d_ = (LAS float*)(lds + (p) * BUF); \
        *(LAS v4f*)(d_ + e4) = rf; *(LAS v4f*)(d_ + ARR + e4) = (v4f){bflo(rk.x), bfhi(rk.x), bflo(rk.y), bfhi(rk.y)}; \
        *(LAS v4f*)(d_ + 2 * ARR + e4) = (v4f){bflo(rq.x), bfhi(rq.x), bflo(rq.y), bfhi(rq.y)}; \
        if (tid < SC_C * 8) *(LAS v4f*)(d_ + 3 * ARR + tid * 4) = (v4f){bflo(rv.x), bfhi(rv.x), bflo(rv.y), bfhi(rv.y)}; } while (0)
    constexpr int NCH = (L + SC_C - 1) / SC_C;
    HG_LOAD(0); HG_STORE(0); __syncthreads();
#pragma unroll 1
    for (int c = 0; c < NCH; ++c) {
        const int p = c & 1;
        if (c + 1 < NCH) HG_LOAD(c + 1);
        const int ns = (L - c * SC_C) < SC_C ? (L - c * SC_C) : SC_C;
        const LAS float* d = (const LAS float*)(lds + p * BUF);
        const LAS float* q = d + kp * 4; const LAS float* dv = d + 3 * ARR + row;
        v4f f4 = *(const LAS v4f*)(q), k4 = *(const LAS v4f*)(q + ARR), q4 = *(const LAS v4f*)(q + 2 * ARR); float vv = dv[0];
#pragma unroll 2
        for (int s = 0; s < ns; ++s) {
            const int sn = (s + 1 < SC_C) ? s + 1 : s;
            const v4f nf4 = *(const LAS v4f*)(q + sn * 64), nk4 = *(const LAS v4f*)(q + ARR + sn * 64), nq4 = *(const LAS v4f*)(q + 2 * ARR + sn * 64);
            const float nvv = dv[sn * 32];
            S0 = S0 * f4.x + k4.x * vv; S1 = S1 * f4.y + k4.y * vv; S2 = S2 * f4.z + k4.z * vv; S3 = S3 * f4.w + k4.w * vv;
            float o = (q4.x * S0 + q4.y * S1) + (q4.z * S2 + q4.w * S3);
            o = sum16(o);
            if (kp == 0) obuf[s * 32 + row] = o;
            f4 = nf4; k4 = nk4; q4 = nq4; vv = nvv;
        }
        __syncthreads();
        { const int s = tid >> 4, r2 = (tid & 15) * 2;
          if (s < ns) *(v2f*)(OR + (size_t)(c * SC_C + s) * 256 + r2) = *(const LAS v2f*)(obuf + s * 32 + r2); }
        if (c + 1 < NCH) HG_STORE(1 - p);
        __syncthreads();
    }
#undef HG_LOAD
#undef HG_STORE
}
__device__ PHASE_FN void mixers_finish(const Ctx A, int l, int vcu, int G) {
    const int tid = opaque_tid(), lane = tid & 63, wave = tid >> 6;
    const int gw = vcu * NWAVES + wave, NGW = G * NWAVES;
    const int c4 = 4 * lane, hh = lane >> 4, d4 = 4 * (lane & 15);
    const float* YR = (const float*)(A.ws + WS_YRAW); const float* OR = (const float*)(A.ws + WS_ORAW);
    const bf16* RV = (const bf16*)(A.ws + WS_RW_V); const float* SC = (const float*)(A.ws + WS_RW_SC); const bf16* RG = (const bf16*)(A.ws + WS_RW_G); const bf16* HGt = (const bf16*)(A.ws + WS_HG_G);
    bf16* MIX = (bf16*)(A.ws + WS_MIX);
    const v4f lg = *(const v4f*)(gin(A, 14) + l * 256 + c4), lb = *(const v4f*)(gin(A, 15) + l * 256 + c4), ng = *(const v4f*)(gin(A, 24) + l * 256 + c4);
#pragma unroll 2
    for (int m = gw; m < T; m += NGW) {
        const int b = m / L, i = m - b * L; const size_t hm = ((size_t)(b * 4 + hh) * L + i);
        const v4f y = *(const v4f*)(YR + (size_t)m * 256 + c4), o = *(const v4f*)(OR + (size_t)m * 256 + c4);
        const v4f vv = ld_bf4(RV + hm * 64 + d4), g = ld_bf4(RG + (size_t)m * 256 + c4), hg = ld_bf4(HGt + (size_t)m * 256 + c4);
        const float bonus = SC[hm * 4 + 2];
        const float mean = sum16((y.x + y.y) + (y.z + y.w)) * (1.f / 64.f); const v4f dy = y - mean;
        const float var = sum16((dy.x * dy.x + dy.y * dy.y) + (dy.z * dy.z + dy.w * dy.w)) * (1.f / 64.f);
        const v4f yn = (dy * rsqrtf(var + 64e-5f) * lg + lb + vv * bonus) * g;
        st_bf4(MIX + (size_t)m * 1024 + c4, yn);
        const float ms = sum16((o.x * o.x + o.y * o.y) + (o.z * o.z + o.w * o.w)) * (1.f / 64.f);
        st_bf4(MIX + (size_t)m * 1024 + 768 + c4, o * rsqrtf(ms + 1e-5f) * ng * hg);
    }
}
constexpr int LR_SEG = 64, LR_NSEG = (L + LR_SEG - 1) / LR_SEG;
constexpr size_t WS_LR_AGG = 2032 * MiB;
constexpr size_t WS_LR_CARRY = WS_LR_AGG + 3 * MiB;
static_assert(WS_LR_CARRY + (size_t)NB * LR_NSEG * 256 * 4 <= WS_END, "lru aggregates");
__device__ PHASE_FN void lru_agg_phase(const Ctx A, int vcu, int G) {
    const int tid = opaque_tid(), lane = tid & 63, wave = tid >> 6;
    const int gw = vcu * NWAVES + wave, NGW = G * NWAVES;
    const float* LA = (const float*)(A.ws + WS_LR_A); const bf16* LU = (const bf16*)(A.ws + WS_LR_U); v2f* AGG = (v2f*)(A.ws + WS_LR_AGG);
#pragma unroll 1
    for (int it = gw; it < NB * LR_NSEG * 4; it += NGW) {
        const int cg = it & 3, q = it >> 2; const bool tail_ = q >= NB * (LR_NSEG - 1);
        const int b = tail_ ? q - NB * (LR_NSEG - 1) : q / (LR_NSEG - 1), sg = tail_ ? LR_NSEG - 1 : q - b * (LR_NSEG - 1), ch = cg * 64 + lane;
        const int t0 = sg * LR_SEG, ns = (L - t0) < LR_SEG ? (L - t0) : LR_SEG;
        const size_t m0 = (size_t)b * L + t0;
        float Ap = 1.f, Hl = 0.f;
#pragma unroll 1
        for (int i = 0; i < ns; i += 16) {
            float a[16], u[16];
#pragma unroll
            for (int j = 0; j < 16; ++j) { a[j] = LA[(m0 + i + j) * 256 + ch]; u[j] = bf2f(LU[(m0 + i + j) * 256 + ch]); }
#pragma unroll
            for (int j = 0; j < 16; ++j) { Hl = a[j] * Hl + u[j]; Ap *= a[j]; }
        }
        AGG[((size_t)b * LR_NSEG + sg) * 256 + ch] = (v2f){Ap, Hl};
    }
}
__device__ PHASE_FN void lru_carry_phase(const Ctx A, int first) {
    const int tid = opaque_tid(), lane = tid & 63, wave = tid >> 6;
    const int w = (opaque_s((int)blockIdx.x) - first) * NWAVES + wave;
    const int b = w >> 2, ch = (w & 3) * 64 + lane;
    const v2f* ag = (const v2f*)(A.ws + WS_LR_AGG) + (size_t)b * LR_NSEG * 256 + ch;
    float* CR = (float*)(A.ws + WS_LR_CARRY) + (size_t)b * LR_NSEG * 256 + ch;
    float hc = 0.f;
#pragma unroll 1
    for (int s0 = 0; s0 < LR_NSEG; s0 += 16) {
        v2f x[16];
#pragma unroll
        for (int j = 0; j < 16; ++j) { const int s = s0 + j < LR_NSEG ? s0 + j : LR_NSEG - 1; x[j] = ag[(size_t)s * 256]; }
#pragma unroll
        for (int j = 0; j < 16; ++j) if (s0 + j < LR_NSEG) { CR[(size_t)(s0 + j) * 256] = hc; hc = x[j].x * hc + x[j].y; }
    }
}
__device__ PHASE_FN void lru_out_phase(const Ctx A, int vcu, int G) {
    const int tid = opaque_tid(), lane = tid & 63, wave = tid >> 6;
    const int gw = vcu * NWAVES + wave, NGW = G * NWAVES;
    const float* LA = (const float*)(A.ws + WS_LR_A); const bf16* LU = (const bf16*)(A.ws + WS_LR_U); const bf16* LG = (const bf16*)(A.ws + WS_LR_G);
    const float* CR = (const float*)(A.ws + WS_LR_CARRY); bf16* MIX = (bf16*)(A.ws + WS_MIX);
#pragma unroll 1
    for (int it = gw; it < NB * LR_NSEG * 4; it += NGW) {
        const int cg = it & 3, q = it >> 2; const bool tail_ = q >= NB * (LR_NSEG - 1);
        const int b = tail_ ? q - NB * (LR_NSEG - 1) : q / (LR_NSEG - 1), sg = tail_ ? LR_NSEG - 1 : q - b * (LR_NSEG - 1), ch = cg * 64 + lane;
        const int t0 = sg * LR_SEG, ns = (L - t0) < LR_SEG ? (L - t0) : LR_SEG;
        const size_t m0 = (size_t)b * L + t0;
        float hc = CR[((size_t)b * LR_NSEG + sg) * 256 + ch];
#pragma unroll 1
        for (int i = 0; i < ns; i += 16) {
            float a[16], u[16], g[16];
#pragma unroll
            for (int j = 0; j < 16; ++j) { a[j] = LA[(m0 + i + j) * 256 + ch]; u[j] = bf2f(LU[(m0 + i + j) * 256 + ch]); g[j] = bf2f(LG[(m0 + i + j) * 256 + ch]); }
#pragma unroll
            for (int j = 0; j < 16; ++j) { hc = a[j] * hc + u[j]; MIX[(m0 + i + j) * 1024 + 512 + ch] = f2bf(hc * g[j]); }
        }
    }
}
static_assert(L % 16 == 0, "lru step groups");
constexpr int DSA_WBYTES = 34944;
constexpr int DSA_NW = 4;
__device__ __forceinline__ unsigned fkey(float f) { const unsigned u = __float_as_uint(f); return (u & 0x80000000u) ? ~u : (u | 0x80000000u); }
__device__ __forceinline__ void dsa_query(const Ctx A, LAS unsigned char* wl, int b, int i, int lane) {
    const bf16* DQ = (const bf16*)(A.ws + WS_DS_Q); const bf16* DK = (const bf16*)(A.ws + WS_DS_K); const bf16* DV = (const bf16*)(A.ws + WS_DS_V);
    const bf16* DQI = (const bf16*)(A.ws + WS_DS_QI); const bf16* DKI = (const bf16*)(A.ws + WS_DS_KI); const float* DWI = (const float*)(A.ws + WS_DS_WI);
    bf16* MIX = (bf16*)(A.ws + WS_HB);
    LAS unsigned* keys = (LAS unsigned*)wl; LAS float* qv = (LAS float*)(wl + 32896); LAS int* sel = (LAS int*)(wl + 32896 + 1024);
    const size_t m = (size_t)b * L + i, mb = (size_t)b * L;
    const int n = i + 1;
    LAS float* wil = (LAS float*)(wl + 32832);
    { const v4f q4 = ld_bf4(DQI + m * 256 + 4 * lane); *(LAS v4f*)(qv + 4 * lane) = q4; if (lane < 8) wil[lane] = DWI[m * 8 + lane]; }
    LDS_WAIT();
    for (int s = lane; s < n; s += 64) {
        const v4u* kp = (const v4u*)(DKI + (mb + s) * 32);
        float kf[32];
#pragma unroll
        for (int c = 0; c < 4; ++c) { const v4u x = kp[c]; kf[8 * c + 0] = bflo(x.x); kf[8 * c + 1] = bfhi(x.x); kf[8 * c + 2] = bflo(x.y); kf[8 * c + 3] = bfhi(x.y); kf[8 * c + 4] = bflo(x.z); kf[8 * c + 5] = bfhi(x.z); kf[8 * c + 6] = bflo(x.w); kf[8 * c + 7] = bfhi(x.w); }
        float sc = 0.f;
#pragma unroll 1
        for (int hx = 0; hx < 8; ++hx) { float dt = 0.f;
#pragma unroll
            for (int c = 0; c < 8; ++c) { const v4f q4 = *(const LAS v4f*)(qv + hx * 32 + 4 * c); dt += q4.x * kf[4 * c] + q4.y * kf[4 * c + 1] + q4.z * kf[4 * c + 2] + q4.w * kf[4 * c + 3]; }
            sc += wil[hx] * fmaxf(dt, 0.f); }
        keys[s] = fkey(sc);
    }
    LDS_WAIT();
    unsigned thr = 0u; int need = 0;
    if (n > 256) {
        unsigned prefix = 0u; need = 256;
#pragma unroll 1
        for (int shift = 28; shift >= 0; shift -= 4) {
            unsigned long long lo = 0ull, hi = 0ull;
            const unsigned himask = (shift == 28) ? 0u : (0xFFFFFFFFu << (shift + 4));
            for (int s = lane; s < n; s += 64) { const unsigned k = keys[s];
                if ((k & himask) == prefix) { const unsigned dg = (k >> shift) & 15u; const unsigned long long inc = 1ull << ((dg & 7u) * 8u); if (dg < 8u) lo += inc; else hi += inc; } }
            int cum = 0; unsigned dsel = 0u; int below = 0; bool found = false;
#pragma unroll
            for (int dg = 15; dg >= 0; --dg) {
                const unsigned mine = (unsigned)(((dg < 8 ? lo : hi) >> ((dg & 7) * 8)) & 0xFFull);
                int tot = (int)mine;
#pragma unroll
                for (int o = 1; o < 64; o <<= 1) tot += __shfl_xor(tot, o);
                if (!found && cum + tot >= need) { found = true; dsel = (unsigned)dg; below = cum; }
                cum += tot;
            }
            prefix |= dsel << shift; need -= below;
        }
        thr = prefix;
    }
    int cnt = 0;
    if (n <= 256) { for (int s = lane; s < n; s += 64) sel[s] = s; cnt = n; }
    else {
        int eq_taken = 0;
        for (int s0 = 0; s0 < n; s0 += 64) { const int s = s0 + lane; const unsigned k = (s < n) ? keys[s] : 0u; const bool in = s < n;
            const bool gt = in && (k > thr), eq = in && (k == thr);
            const unsigned long long meq = __ballot(eq); const int eq_before = __popcll(meq & ((1ull << lane) - 1ull));
            const bool take = gt || (eq && (eq_taken + eq_before) < need);
            const unsigned long long mt = __ballot(take); const int pos = cnt + __popcll(mt & ((1ull << lane) - 1ull));
            if (take && pos < 256) sel[pos] = s;
            cnt += __popcll(mt); eq_taken += __popcll(meq);
        }
        if (cnt > 256) cnt = 256;
    }
    LDS_WAIT();
    LAS float* pbuf = (LAS float*)wl;
    for (int h = 0; h < 4; ++h) {
        { const float qx = bf2f(DQ[m * 256 + h * 64 + lane]); qv[lane] = qx * 0.125f; }
        LDS_WAIT();
        float sj[4]; float mx = -3.0e38f;
#pragma unroll
        for (int r = 0; r < 4; ++r) { const int j = lane + 64 * r; sj[r] = -3.0e38f;
            if (j < cnt) { const int s = sel[j]; const v4u* kp = (const v4u*)(DK + (mb + s) * 256 + h * 64); float dt = 0.f;
#pragma unroll
                for (int c = 0; c < 8; ++c) { const v4u x = kp[c]; const v4f q0 = *(const LAS v4f*)(qv + 8 * c), q1 = *(const LAS v4f*)(qv + 8 * c + 4);
                    dt += q0.x * bflo(x.x) + q0.y * bfhi(x.x) + q0.z * bflo(x.y) + q0.w * bfhi(x.y) + q1.x * bflo(x.z) + q1.y * bfhi(x.z) + q1.z * bflo(x.w) + q1.w * bfhi(x.w); }
                sj[r] = dt; mx = fmaxf(mx, dt); } }
        mx = wave_max(mx);
        float sum = 0.f;
#pragma unroll
        for (int r = 0; r < 4; ++r) { const int j = lane + 64 * r; const float p = (j < cnt) ? __expf(sj[r] - mx) : 0.f; sum += p; pbuf[j] = p; }
        sum = wave_sum(sum);
        LDS_WAIT();
        float o = 0.f;
        for (int j = 0; j < cnt; ++j) { const int s = sel[j]; o += pbuf[j] * bf2f(DV[(mb + s) * 256 + h * 64 + lane]); }
        MIX[m * 1024 + 256 + h * 64 + lane] = f2bf(o / sum);
        LDS_WAIT();
    }
}
__device__ PHASE_FN void dsa_phase(const Ctx A, LAS unsigned char* lds, int l) {
    const int tid = opaque_tid(), lane = tid & 63, wave = tid >> 6;
    if (wave >= DSA_NW) return;
    unsigned* qhead = (unsigned*)(A.ws + WS_CTL) + CW_DSAQ + 64 * l;
    LAS unsigned char* wl = lds + wave * DSA_WBYTES;
    for (;;) {
        unsigned it = 0u;
        if (lane == 0) it = atomicAdd(qhead, 1u);
        it = __builtin_amdgcn_readfirstlane(it);
        if (it >= (unsigned)T) break;
        const int i = L - 1 - (int)(it >> 3), b = (int)(it & 7u);
        dsa_query(A, wl, b, i, lane);
    }
}
static_assert(DSA_NW * DSA_WBYTES <= MISC_OFF, "dsa lds");
typedef short s8 __attribute__((ext_vector_type(8)));
typedef short v4i16_t __attribute__((ext_vector_type(4)));
typedef unsigned u16v __attribute__((ext_vector_type(16)));
typedef unsigned long long u64;
constexpr int NQT16 = L / 16;
constexpr int NKB32 = (L + 31) / 32;
constexpr int MASK_PB = 66112;
constexpr size_t MASK_LAYER = (size_t)NB * MASK_PB * 64;
constexpr size_t WS_MASK = 1956 * MiB;
static_assert(WS_MASK >= WS_MIX_END && WS_MASK + 2 * MASK_LAYER + 256 <= 2032 * MiB, "mask region");
__device__ __forceinline__ size_t mask_row(int l, int b, int qt) { const int a = qt >> 1; return (size_t)l * (NB * MASK_PB) + (size_t)b * MASK_PB + ((qt & 1) ? (a + 1) * (a + 1) : a * (a + 1)); }
constexpr int CW_KMAX = 8960;
constexpr int CW_KIMAX = 9216;
constexpr int MI_KMAX = 640, MI_UNIT = 768, MI_KIMAX = 832;
constexpr int SEL_PF = 3;
constexpr int SEL_HROW = 259;

__device__ __forceinline__ void sel_scores(const s8 a1, const s8 a2, const s8 (&qb)[9], const float (&wv)[8], pg8::f32x4& i1, pg8::f32x4& i2) {
    const pg8::f32x4 z = (pg8::f32x4){0.f, 0.f, 0.f, 0.f};
    i1 = __builtin_amdgcn_mfma_f32_16x16x32_bf16(a1, qb[8], z, 0, 0, 0); i2 = __builtin_amdgcn_mfma_f32_16x16x32_bf16(a2, qb[8], z, 0, 0, 0);
#pragma unroll
    for (int h = 0; h < 8; ++h) {
        const pg8::f32x4 c1 = __builtin_amdgcn_mfma_f32_16x16x32_bf16(a1, qb[h], z, 0, 0, 0), c2 = __builtin_amdgcn_mfma_f32_16x16x32_bf16(a2, qb[h], z, 0, 0, 0);
#pragma unroll
        for (int j = 0; j < 4; ++j) { float t1 = fmaf(fabsf(c1[j]), wv[h], i1[j]), t2 = fmaf(fabsf(c2[j]), wv[h], i2[j]);
            asm("" : "+v"(t1)); asm("" : "+v"(t2)); i1[j] = t1; i2[j] = t2; }
    }
}
template <int MODE, bool DIAG>
__device__ __forceinline__ void sel_block(const s8 a1, const s8 a2, const s8 (&qb)[9], const float (&wv)[8], int kb, int tq, int r, int g, int lane,
                                          LAS unsigned* hrow, float sc_mul, float sc_add, u64* mrow) {
    pg8::f32x4 i1, i2; sel_scores(a1, a2, qb, wv, i1, i2);
    const int s0 = kb * 32 + 8 * g;
    u64 wds[8];
#pragma unroll
    for (int j = 0; j < 8; ++j) {
        const float sc = j < 4 ? i1[j & 3] : i2[j & 3];
        if (MODE == 3) { if (sc == 123456.789f) hrow[256] = 1u; }
        else if (MODE == 2) { wds[j] = DIAG ? __ballot((s0 + j) <= tq && sc >= sc_add) : __ballot(sc >= sc_add); }
        else { int xi = (int)__builtin_floorf(fmaf(sc, sc_mul, sc_add));
            unsigned bin = MODE == 0 ? (unsigned)min(max(xi, 0), 255) : (unsigned)(min(max(xi, -1), 256) + 1);
            if (DIAG) bin = ((s0 + j) <= tq) ? bin : (MODE == 0 ? 256u : 0u);
            if (MODE == 0 || bin != 0u) __hip_atomic_fetch_add(hrow + bin, 1u, __ATOMIC_RELAXED, __HIP_MEMORY_SCOPE_WORKGROUP); }
    }
    if (MODE == 2 && lane == 0) { u64* d = mrow + (size_t)kb * 8;
#pragma unroll
        for (int j = 0; j < 8; j += 2) { v4u o; o.x = (unsigned)wds[j]; o.y = (unsigned)(wds[j] >> 32); o.z = (unsigned)wds[j + 1]; o.w = (unsigned)(wds[j + 1] >> 32); *(v4u*)(d + j) = o; } }
}
template <int MODE>
__device__ __forceinline__ void sel_pass(const bf16* KIb, const s8 (&qb)[9], const float (&wv)[8], int nkb, int tq, int r, int g, int lane,
                                         LAS unsigned* hrow, float sc_mul, float sc_add, u64* mrow, int kb_first = 0, int kb_step = 1) {
    const bf16* kp = KIb + (size_t)(8 * (r >> 2) + (r & 3)) * 32 + 8 * g;
    v4u cur[2 * SEL_PF], nxt[2 * SEL_PF];
#pragma unroll
    for (int i = 0; i < SEL_PF; ++i) { const size_t kb = kb_first + i * kb_step; cur[2 * i] = *(const v4u*)(kp + kb * 1024); cur[2 * i + 1] = *(const v4u*)(kp + kb * 1024 + 128); }
#pragma unroll 1
    for (int kb0 = kb_first; kb0 < nkb; kb0 += SEL_PF * kb_step) {
#pragma unroll
        for (int i = 0; i < SEL_PF; ++i) { const size_t kb = kb0 + (SEL_PF + i) * kb_step; nxt[2 * i] = *(const v4u*)(kp + kb * 1024); nxt[2 * i + 1] = *(const v4u*)(kp + kb * 1024 + 128); }
#pragma unroll
        for (int i = 0; i < SEL_PF; ++i) { const int kb = kb0 + i * kb_step;
            if (kb < nkb - 1) sel_block<MODE, false>(__builtin_bit_cast(s8, cur[2 * i]), __builtin_bit_cast(s8, cur[2 * i + 1]), qb, wv, kb, tq, r, g, lane, hrow, sc_mul, sc_add, mrow);
            else if (kb == nkb - 1) sel_block<MODE, true>(__builtin_bit_cast(s8, cur[2 * i]), __builtin_bit_cast(s8, cur[2 * i + 1]), qb, wv, kb, tq, r, g, lane, hrow, sc_mul, sc_add, mrow); }
#pragma unroll
        for (int i = 0; i < 2 * SEL_PF; ++i) cur[i] = nxt[i];
    }
}
__device__ __forceinline__ void sel_scan(const LAS unsigned* hrow, int need, int& sel, int& above) {
    int cum = 0; sel = 0; above = 0; bool found = false;
#pragma unroll 8
    for (int bin = 255; bin >= 0; --bin) { const int c = (int)hrow[bin];
        if (!found && cum + c >= need) { found = true; sel = bin; above = cum; }
        cum += c; }
}
__device__ PHASE_FN void dsa_select_phase(const Ctx A, LAS unsigned char* lds, int l) {
    const int tid = opaque_tid(), lane = tid & 63, wave = tid >> 6, r = lane & 15, g = lane >> 4;
    const bf16* DQI = (const bf16*)(A.ws + WS_DS_QI); const bf16* DKI = (const bf16*)(A.ws + WS_DS_KI); const float* DWI = (const float*)(A.ws + WS_DS_WI);
    u64* MASK = (u64*)(A.ws + WS_MASK);
    unsigned* qhead = (unsigned*)(A.ws + WS_CTL) + CW_DSAQ + 64 * l;
    const unsigned* kimaxw = (const unsigned*)(A.ws + WS_CTL) + CW_KIMAX + 64 * l;
    LAS unsigned* hist = (LAS unsigned*)(lds + wave * (16 * SEL_HROW * 4));
    LAS unsigned* hrow = hist + r * SEL_HROW;
    for (;;) {
        unsigned it = 0u;
        if (lane == 0) it = atomicAdd(qhead, 1u);
        it = __builtin_amdgcn_readfirstlane(it);
        if (it >= (unsigned)(NB * NQT16)) break;
        const int qt = NQT16 - 1 - (int)(it >> 3), b = (int)(it & 7u);
        const size_t mb = (size_t)b * L, m0 = mb + (size_t)qt * 16;
        const int tq = qt * 16 + r, nkb = ((qt * 16 + 15) >> 5) + 1;
        s8 qb[9]; float wv[8];
#pragma unroll
        for (int h = 0; h < 8; ++h) qb[h] = *(const s8*)(DQI + (m0 + r) * 256 + h * 32 + 8 * g);
        { const v4f w0 = *(const v4f*)(DWI + (m0 + r) * 8), w1 = *(const v4f*)(DWI + (m0 + r) * 8 + 4);
          wv[0] = w0.x; wv[1] = w0.y; wv[2] = w0.z; wv[3] = w0.w; wv[4] = w1.x; wv[5] = w1.y; wv[6] = w1.z; wv[7] = w1.w; }
        float bq = 0.f;
        { float ql[8];
#pragma unroll
          for (int e = 0; e < 8; ++e) ql[e] = 0.f;
#pragma unroll
          for (int h = 0; h < 8; ++h) { float n2 = 0.f;
#pragma unroll
              for (int e = 0; e < 8; ++e) { const float x = bf2f((unsigned short)qb[h][e]); ql[e] += wv[h] * x; n2 += x * x; }
              n2 += __shfl_xor(n2, 16); n2 += __shfl_xor(n2, 32); bq += fabsf(wv[h]) * sqrtf(n2); }
          v4u pk; pk.x = pk2(ql[0], ql[1]); pk.y = pk2(ql[2], ql[3]); pk.z = pk2(ql[4], ql[5]); pk.w = pk2(ql[6], ql[7]); qb[8] = __builtin_bit_cast(s8, pk); }
        const bf16* KIb = DKI + mb * 32;
        float thr_f = -__builtin_inff();
        if (qt * 16 + 15 >= 256) {
            const float kim = sqrtf(__uint_as_float(__hip_atomic_load(kimaxw + b, __ATOMIC_RELAXED, __HIP_MEMORY_SCOPE_AGENT)));
            const float R = fmaxf(2.06f * bq * kim, 1e-30f), s0 = 128.f / R, w0 = R * (1.f / 128.f);
            const int n = tq + 1;
            bool done = false;
            if (qt * 16 >= 2048) {
                for (int i = lane; i < 16 * SEL_HROW; i += 64) hist[i] = 0u;
                LDS_WAIT();
                sel_pass<0>(KIb, qb, wv, nkb - 1, tq, r, g, lane, hrow, s0, 128.f, nullptr, 3, 8);
                LDS_WAIT();
                const int ns = 32 * ((nkb - 1 - 3 + 7) >> 3);
                const float rho = 256.f * (float)ns / (float)n, dev = 4.f * sqrtf(rho) + 2.f;
                int bl, ab; sel_scan(hrow, (int)(rho + dev) + 1, bl, ab);
                int bh = 255, ab2 = 0; const int rhi = (int)(rho - dev);
                if (rhi >= 1) sel_scan(hrow, rhi, bh, ab2);
                LDS_WAIT();
                const float lo = -R + (float)bl * w0, hi = (rhi >= 1) ? (-R + (float)(bh + 1) * w0) : (R * 1.001f);
                const float s1 = 256.f / (hi - lo);
                for (int i = lane; i < 16 * SEL_HROW; i += 64) hist[i] = 0u;
                LDS_WAIT();
                sel_pass<1>(KIb, qb, wv, nkb, tq, r, g, lane, hrow, s1, -lo * s1, nullptr);
                LDS_WAIT();
                const int above = (int)hrow[257]; int inr = 0;
#pragma unroll 8
                for (int bin = 1; bin <= 256; ++bin) inr += (int)hrow[bin];
                const bool ok = above < 256 && above + inr >= 256;
                if (ok) { int sel1, ab1; sel_scan(hrow + 1, 256 - above, sel1, ab1); thr_f = lo + (float)sel1 * ((hi - lo) * (1.f / 256.f)); }
                LDS_WAIT();
                done = __all(ok);
            }
            if (!done) {
                for (int i = lane; i < 16 * SEL_HROW; i += 64) hist[i] = 0u;
                LDS_WAIT();
                sel_pass<0>(KIb, qb, wv, nkb, tq, r, g, lane, hrow, s0, 128.f, nullptr);
                LDS_WAIT();
                int sel0, above0; sel_scan(hrow, 256, sel0, above0);
                LDS_WAIT();
                const float lo0 = -R + (float)sel0 * w0, s1 = 256.f / w0;
                for (int i = lane; i < 16 * SEL_HROW; i += 64) hist[i] = 0u;
                LDS_WAIT();
                sel_pass<1>(KIb, qb, wv, nkb, tq, r, g, lane, hrow, s1, -lo0 * s1, nullptr);
                LDS_WAIT();
                int sel1, above1; sel_scan(hrow + 1, 256 - above0, sel1, above1);
                LDS_WAIT();
                thr_f = lo0 + (float)sel1 * (w0 * (1.f / 256.f));
            }
            if (n <= 256) thr_f = -__builtin_inff();
        }
        sel_pass<2>(KIb, qb, wv, nkb, tq, r, g, lane, hrow, 0.f, thr_f, MASK + mask_row(l, b, qt) * 8);
    }
}

constexpr int AT_ROW = 144;
constexpr int AT_TILE = 64 * AT_ROW;
constexpr int AT_NQT = (L - 16) / 256;
constexpr int AT_NKT = (L + 63) / 64;
static_assert(16 + AT_NQT * 256 == L, "query tiling");
__device__ PHASE_FN void dsa_attn_phase(const Ctx A, LAS unsigned char* lds, int l) {
    const int tid = opaque_tid(), lane = tid & 63, wave = tid >> 6, r = lane & 15, g = lane >> 4;
    const bf16* DQ = (const bf16*)(A.ws + WS_DS_Q); const bf16* DK = (const bf16*)(A.ws + WS_DS_K); const bf16* DV = (const bf16*)(A.ws + WS_DS_V);
    const u64* MASK = (const u64*)(A.ws + WS_MASK); bf16* MIX = (bf16*)(A.ws + WS_MIX);
    unsigned* qhead = (unsigned*)(A.ws + WS_CTL) + CW_DSAQ + 64 * l + 16;
    const unsigned* kmaxw = (const unsigned*)(A.ws + WS_CTL) + CW_KMAX + 64 * l;
    LAS unsigned* unitw = (LAS unsigned*)(lds + MISC_OFF + MI_UNIT);
    const int ldkey = tid >> 3, ldch = tid & 7;
    for (;;) {
        __syncthreads();
        if (tid == 0) unitw[0] = atomicAdd(qhead, 1u);
        __syncthreads();
        const unsigned u = unitw[0];
        if (u >= (unsigned)(NB * 4 * (AT_NQT + 1))) break;
        const bool mini = u >= (unsigned)(NB * 4 * AT_NQT);
        const int qt = mini ? 0 : AT_NQT - 1 - (int)(u >> 5), b = (int)((u & 31u) >> 2), h = (int)(u & 3u);
        const size_t mb = (size_t)b * L;
        const int kmain = mini ? 0 : 4 * qt;
        const int nkt = mini ? 1 : ((4 * qt + 5 < AT_NKT) ? 4 * qt + 5 : AT_NKT);
        const float kmax2 = __uint_as_float(__hip_atomic_load(kmaxw + b * 4 + h, __ATOMIC_RELAXED, __HIP_MEMORY_SCOPE_AGENT));
        int tq[2], lb[2]; bool act[2];
        s8 qf[2][2]; float nc2[2];
        const GAS unsigned* mrow[2];
#pragma unroll
        for (int qi = 0; qi < 2; ++qi) { act[qi] = mini ? (wave == 0 && qi == 0) : true; tq[qi] = mini ? 0 : 16 + qt * 256 + wave * 32 + 16 * qi;
            lb[qi] = __builtin_amdgcn_readfirstlane(act[qi] ? ((tq[qi] + 15) >> 5) : -1);
            float qn2 = 0.f;
#pragma unroll
            for (int ks = 0; ks < 2; ++ks) { qf[qi][ks] = act[qi] ? *(const s8*)(DQ + (mb + tq[qi] + r) * 256 + h * 64 + 32 * ks + 8 * g) : (s8){0, 0, 0, 0, 0, 0, 0, 0};
#pragma unroll
                for (int e = 0; e < 8; ++e) { const float x = bf2f((unsigned short)qf[qi][ks][e]); qn2 += x * x; } }
            qn2 += __shfl_xor(qn2, 16); qn2 += __shfl_xor(qn2, 32);
            nc2[qi] = -sqrtf(qn2 * kmax2);
            const u64 mrow_u = (u64)(MASK + mask_row(l, b, tq[qi] >> 4) * 8);
            const unsigned lo = (unsigned)__builtin_amdgcn_readfirstlane((unsigned)mrow_u), hi = (unsigned)__builtin_amdgcn_readfirstlane((unsigned)(mrow_u >> 32));
            mrow[qi] = (const GAS unsigned*)(((u64)hi << 32) | (u64)lo); }
        pg8::f32x4 O[2][4], Ls[2];
#pragma unroll
        for (int qi = 0; qi < 2; ++qi) { Ls[qi] = (pg8::f32x4){0.f, 0.f, 0.f, 0.f};
#pragma unroll
            for (int db = 0; db < 4; ++db) O[qi][db] = (pg8::f32x4){0.f, 0.f, 0.f, 0.f}; }
        const s8 ones8 = (s8){0x3F80, 0x3F80, 0x3F80, 0x3F80, 0x3F80, 0x3F80, 0x3F80, 0x3F80};
#define AT_SLOAD(dst, qi_, kb_) asm volatile("s_load_dwordx16 %0, %1, 0x0" : "=s"(dst) : "s"(mrow[qi_] + (size_t)(kb_) * 16))
#define AT_MWAIT(m0_, m1_) asm volatile("s_waitcnt lgkmcnt(0)" : "+s"(m0_), "+s"(m1_))
#define AT_MWAIT_S2(a0_, a1_, b0_, b1_) asm volatile("s_waitcnt lgkmcnt(0)" : "+s"(a0_), "+s"(a1_), "+s"(b0_), "+s"(b1_), "+v"(Sa), "+v"(Sb), "+v"(Sc), "+v"(Sd), "+v"(Se), "+v"(Sf), "+v"(Sg), "+v"(Sh) :: "memory")
#define AT_MWAIT_O(a0_, a1_, b0_, b1_) asm volatile("s_waitcnt lgkmcnt(0)" : "+s"(a0_), "+s"(a1_), "+s"(b0_), "+s"(b1_), "+v"(O[1][0]), "+v"(O[1][1]), "+v"(O[1][2]), "+v"(O[1][3]), "+v"(Ls[1]) :: "memory")
        const bf16* kg = DK + (mb + ldkey) * 256 + h * 64 + ldch * 8; const bf16* vg = DV + (mb + ldkey) * 256 + h * 64 + ldch * 8;
        v4u rk0 = *(const v4u*)kg, rv0 = *(const v4u*)vg;
        const size_t to1 = (size_t)(nkt > 1 ? 1 : nkt - 1) * 64 * 256, to2 = (size_t)(nkt > 2 ? 2 : nkt - 1) * 64 * 256, to3 = (size_t)(nkt > 3 ? 3 : nkt - 1) * 64 * 256;
        v4u rk1 = *(const v4u*)(kg + to1), rv1 = *(const v4u*)(vg + to1), rk2 = *(const v4u*)(kg + to2), rv2 = *(const v4u*)(vg + to2), rk3 = *(const v4u*)(kg + to3), rv3 = *(const v4u*)(vg + to3);
        u16v m0, m1, n0, n1;
#define AT_STORE(boff, rk, rv) do { LAS unsigned char* kb_ = lds + (boff); LAS unsigned char* vb_ = kb_ + AT_TILE; \
            *(LAS v4u*)(kb_ + ldkey * AT_ROW + ldch * 16) = rk; *(LAS v4u*)(vb_ + ldkey * AT_ROW + ldch * 16) = rv; } while (0)
#define AT_LOAD(kt_, rk, rv) do { rk = *(const v4u*)(kg + (size_t)(kt_) * 64 * 256); rv = *(const v4u*)(vg + (size_t)(kt_) * 64 * 256); } while (0)
#define AT_KREAD(boff, blk) do { const LAS unsigned char* ka = lds + (boff) + ((blk) * 32 + 8 * (r >> 2) + (r & 3)) * AT_ROW + g * 16; \
            _Pragma("unroll") for (int ks = 0; ks < 2; ++ks) { kf[blk][ks][0] = *(const LAS s8*)(ka + ks * 64); kf[blk][ks][1] = *(const LAS s8*)(ka + 4 * AT_ROW + ks * 64); } } while (0)
#define AT_VREAD(boff, blk) do { const LAS unsigned char* va = lds + (boff) + AT_TILE + ((blk) * 32 + 8 * g + (r >> 2)) * AT_ROW + (r & 3) * 8; \
            _Pragma("unroll") for (int db = 0; db < 4; ++db) { \
                const v4i16_t x0 = __builtin_amdgcn_ds_read_tr16_b64_v4i16((LAS v4i16_t*)(va + db * 32)), x1 = __builtin_amdgcn_ds_read_tr16_b64_v4i16((LAS v4i16_t*)(va + 4 * AT_ROW + db * 32)); \
                vf[blk][db] = (s8){x0[0], x0[1], x0[2], x0[3], x1[0], x1[1], x1[2], x1[3]}; } } while (0)
#define AT_BLK_S(blk, qi, S1, S2) do { S1 = (pg8::f32x4){nc2[qi], nc2[qi], nc2[qi], nc2[qi]}; S2 = S1; \
            _Pragma("unroll") for (int ks = 0; ks < 2; ++ks) { \
                S1 = __builtin_amdgcn_mfma_f32_16x16x32_bf16(kf[blk][ks][0], qf[qi][ks], S1, 0, 0, 0); S2 = __builtin_amdgcn_mfma_f32_16x16x32_bf16(kf[blk][ks][1], qf[qi][ks], S2, 0, 0, 0); } } while (0)
#define AT_BLK_P(mq, S1, S2, pa) do { float p[8]; \
            _Pragma("unroll") for (int j = 0; j < 8; ++j) { \
                const bool bit = __builtin_amdgcn_inverse_ballot_w64(((u64)mq[2 * j + 1] << 32) | mq[2 * j]); \
                p[j] = bit ? __builtin_amdgcn_exp2f(j < 4 ? S1[j & 3] : S2[j & 3]) : 0.f; } \
            v4u pk; pk.x = pk2(p[0], p[1]); pk.y = pk2(p[2], p[3]); pk.z = pk2(p[4], p[5]); pk.w = pk2(p[6], p[7]); \
            pa = __builtin_bit_cast(s8, pk); } while (0)
#define AT_BLK_V(blk, qi, pa) do { \
            _Pragma("unroll") for (int db = 0; db < 4; ++db) O[qi][db] = __builtin_amdgcn_mfma_f32_16x16x32_bf16(pa, vf[blk][db], O[qi][db], 0, 0, 0); \
            Ls[qi] = __builtin_amdgcn_mfma_f32_16x16x32_bf16(pa, ones8, Ls[qi], 0, 0, 0); } while (0)
#define AT_ROTATE do { const int t_ = bc; bc = bn; bn = bs; bs = t_; } while (0)
#define AT_MAIN_BODY(kt, RK_LD, RV_LD, RK_ST, RV_ST, LASTWAIT) do { \
            { const int ktn_ = (kt) + 5 < nkt ? (kt) + 5 : nkt - 1; AT_LOAD(ktn_, RK_LD, RV_LD); } \
            AT_STORE(bs, RK_ST, RV_ST); \
            pg8::f32x4 Sa, Sb, Sc, Sd, Se, Sf, Sg, Sh; s8 pa0, pa1, pb0, pb1; \
            AT_BLK_S(0, 0, Sa, Sb); AT_BLK_S(1, 0, Sc, Sd); AT_BLK_S(0, 1, Se, Sf); AT_BLK_S(1, 1, Sg, Sh);        \
            AT_MWAIT_S2(m0, m1, n0, n1); \
            AT_KREAD(bn, 0); AT_KREAD(bn, 1); \
            AT_BLK_P(m0, Sa, Sb, pa0); AT_SLOAD(m0, 0, 2 * (kt) + 2); AT_BLK_P(m1, Sc, Sd, pa1); AT_SLOAD(m1, 0, 2 * (kt) + 3); \
            AT_BLK_V(0, 0, pa0); AT_BLK_V(1, 0, pa1); \
            AT_BLK_P(n0, Se, Sf, pb0); AT_SLOAD(n0, 1, 2 * (kt) + 2); AT_BLK_P(n1, Sg, Sh, pb1); AT_SLOAD(n1, 1, 2 * (kt) + 3); \
            AT_BLK_V(0, 1, pb0); AT_BLK_V(1, 1, pb1); \
            if (LASTWAIT) AT_MWAIT_O(m0, m1, n0, n1);                   \
            AT_VREAD(bn, 0); AT_VREAD(bn, 1); \
            AT_ROTATE; \
            __builtin_amdgcn_s_barrier(); } while (0)
#define AT_DIAG_STEP(kt, qi) do { \
            if (2 * (kt) + 1 <= lb[qi]) { pg8::f32x4 Sa, Sb, Sc, Sd; s8 pa0, pa1; AT_SLOAD(m0, qi, 2 * (kt)); AT_SLOAD(m1, qi, 2 * (kt) + 1); \
                AT_BLK_S(0, qi, Sa, Sb); AT_BLK_S(1, qi, Sc, Sd); AT_MWAIT(m0, m1); AT_BLK_P(m0, Sa, Sb, pa0); AT_BLK_P(m1, Sc, Sd, pa1); AT_BLK_V(0, qi, pa0); AT_BLK_V(1, qi, pa1); } \
            else if (2 * (kt) <= lb[qi]) { pg8::f32x4 Sa, Sb; s8 pa0; AT_SLOAD(m0, qi, 2 * (kt)); AT_SLOAD(m1, qi, 2 * (kt)); \
                AT_BLK_S(0, qi, Sa, Sb); AT_MWAIT(m0, m1); AT_BLK_P(m0, Sa, Sb, pa0); AT_BLK_V(0, qi, pa0); } } while (0)
#define AT_DIAG_BODY(kt, RK_LD, RV_LD, RK_ST, RV_ST) do { \
            { const int ktn_ = (kt) + 5 < nkt ? (kt) + 5 : nkt - 1; AT_LOAD(ktn_, RK_LD, RV_LD); } \
            AT_STORE(bs, RK_ST, RV_ST); \
            if (2 * (kt) <= lb[1] || 2 * (kt) <= lb[0]) { \
                AT_KREAD(bc, 0); AT_KREAD(bc, 1); AT_VREAD(bc, 0); AT_VREAD(bc, 1); \
                AT_DIAG_STEP(kt, 0); AT_DIAG_STEP(kt, 1); } \
            asm volatile("s_waitcnt lgkmcnt(0)" ::: "memory"); \
            AT_ROTATE; \
            __builtin_amdgcn_s_barrier(); } while (0)
        int bc = 0, bn = 2 * AT_TILE, bs = 4 * AT_TILE;
        s8 kf[2][2][2], vf[2][4];
        AT_SLOAD(m0, 0, 0); AT_SLOAD(m1, 0, 1); AT_SLOAD(n0, 1, 0); AT_SLOAD(n1, 1, 1);
        AT_STORE(bc, rk0, rv0);
        AT_STORE(bn, rk1, rv1);
        AT_LOAD(nkt > 4 ? 4 : nkt - 1, rk0, rv0);
        AT_MWAIT(m0, m1); AT_MWAIT(n0, n1);
        __syncthreads();
        AT_KREAD(bc, 0); AT_KREAD(bc, 1); AT_VREAD(bc, 0); AT_VREAD(bc, 1);
#pragma unroll 1
        for (int kt = 0; kt < kmain; kt += 4) {
            AT_MAIN_BODY(kt, rk1, rv1, rk2, rv2, false);
            AT_MAIN_BODY(kt + 1, rk2, rv2, rk3, rv3, false);
            AT_MAIN_BODY(kt + 2, rk3, rv3, rk0, rv0, false);
            AT_MAIN_BODY(kt + 3, rk0, rv0, rk1, rv1, true);
        }
#pragma unroll 1
        for (int kt = kmain; kt < nkt; kt += 4) {
            AT_DIAG_BODY(kt, rk1, rv1, rk2, rv2);
            AT_DIAG_BODY(kt + 1, rk2, rv2, rk3, rv3);
            AT_DIAG_BODY(kt + 2, rk3, rv3, rk0, rv0);
            AT_DIAG_BODY(kt + 3, rk0, rv0, rk1, rv1);
        }
#undef AT_ROTATE
#undef AT_MAIN_BODY
#undef AT_DIAG_BODY
#undef AT_DIAG_STEP
#undef AT_BLK_S
#undef AT_BLK_P
#undef AT_BLK_V
#undef AT_KREAD
#undef AT_VREAD
#undef AT_SLOAD
#undef AT_MWAIT
#undef AT_MWAIT_S2
#undef AT_MWAIT_O
#undef AT_LOAD
#undef AT_STORE
#pragma unroll
        for (int qi = 0; qi < 2; ++qi)
#pragma unroll
            for (int j = 0; j < 4; ++j) { const float ij = Ls[qi][j] > 0.f ? 1.f / Ls[qi][j] : 0.f; const int t = tq[qi] + 4 * g + j;
                if (act[qi]) {
#pragma unroll
                    for (int db = 0; db < 4; ++db) MIX[(mb + t) * 1024 + 256 + h * 64 + db * 16 + r] = f2bf(O[qi][db][j] * ij); } }
    }
}
constexpr int CK = 16;
constexpr int NCHK = L / CK;
static_assert(L % CK == 0, "chunk length");
constexpr int CKP_RW = 10, CKP_HG = 7;
constexpr int CKR_RW = CKP_RW * 1024 + 512, CKR_HG = CKP_HG * 1024 + 256;
constexpr size_t WS_CKF_RW = WS_PROJ + 136 * MiB;
constexpr size_t WS_CKF_HG = WS_CKF_RW + (size_t)32 * NCHK * CKR_RW;
static_assert(WS_CKF_HG + (size_t)32 * NCHK * CKR_HG <= WS_PROJ + (size_t)TP * NINP * 2, "chunk fragments fit in the dead proj region");
__device__ __forceinline__ s8 pack8(const pg8::f32x4 lo, const pg8::f32x4 hi) { v4u p; p.x = pk2(lo[0], lo[1]); p.y = pk2(lo[2], lo[3]); p.z = pk2(hi[0], hi[1]); p.w = pk2(hi[2], hi[3]); return __builtin_bit_cast(s8, p); }
template <int CTRL> __device__ __forceinline__ float dpp_shr1(float x) { return __int_as_float(__builtin_amdgcn_update_dpp(0x3F800000, __float_as_int(x), CTRL, 0xF, 0xF, false)); }
__device__ __forceinline__ float row_cumprod(float x) { x *= dpp_shr1<0x111>(x); x *= dpp_shr1<0x112>(x); x *= dpp_shr1<0x114>(x); x *= dpp_shr1<0x118>(x); return x; }

template <bool RWKV>
__device__ __forceinline__ void chunk_prep_item(const Ctx A, int bh, int c, int lane) {
    const int r = lane & 15, g = lane >> 4;
    const size_t base = ((size_t)bh * L + (size_t)c * CK + r) * 64;
    const float* Wg = (const float*)(A.ws + (RWKV ? WS_RW_W : WS_HG_F)) + base;
    const bf16* Ag = (const bf16*)(A.ws + WS_RW_A) + base; const bf16* Bg = (const bf16*)(A.ws + WS_RW_B) + base;
    const bf16* Kg = (const bf16*)(A.ws + (RWKV ? WS_RW_K : WS_HG_K)) + base; const bf16* Rg = (const bf16*)(A.ws + (RWKV ? WS_RW_WR : WS_HG_Q)) + base;
    GAS unsigned char* recb = A.ws + (RWKV ? WS_CKF_RW : WS_CKF_HG) + ((size_t)bh * NCHK + c) * (RWKV ? CKR_RW : CKR_HG);
    v4u* REC = (v4u*)recb + lane; v4f* GCp = (v4f*)(recb + (RWKV ? CKP_RW : CKP_HG) * 1024); float* Dp = (float*)(recb + CKP_RW * 1024 + 256);
    s8 Af[2], Bf[2], Kf[2], Rf[2], BTf[2], KTf[2];
    v4f gcv[4];
#pragma unroll
    for (int ks = 0; ks < 2; ++ks) {
        pg8::f32x4 ah[2], bh_[2], kh[2], rh[2], bt[2], kt[2];
#pragma unroll
        for (int hf = 0; hf < 2; ++hf) {
            const int k0 = 32 * ks + 16 * hf + 4 * g;
            const v4f w4 = *(const v4f*)(Wg + k0);
            v4f gt, gm, gc;
#pragma unroll
            for (int e = 0; e < 4; ++e) { gt[e] = row_cumprod(w4[e]); gm[e] = dpp_shr1<0x111>(gt[e]); gc[e] = __shfl(gt[e], 16 * g + 15); }
            gcv[2 * ks + hf] = gc;
            v4f inv; inv.x = __builtin_amdgcn_rcpf(gt.x); inv.y = __builtin_amdgcn_rcpf(gt.y); inv.z = __builtin_amdgcn_rcpf(gt.z); inv.w = __builtin_amdgcn_rcpf(gt.w);
            const v4f kk4 = ld_bf4(Kg + k0) * inv, rr4 = ld_bf4(Rg + k0) * (RWKV ? gm : gt);
            kh[hf] = kk4; rh[hf] = rr4; kt[hf] = kk4 * gc;
            if (RWKV) { ah[hf] = ld_bf4(Ag + k0) * gm; bh_[hf] = ld_bf4(Bg + k0) * inv; bt[hf] = bh_[hf] * gc; }
        }
        Kf[ks] = pack8(kh[0], kh[1]); Rf[ks] = pack8(rh[0], rh[1]); KTf[ks] = pack8(kt[0], kt[1]);
        if (RWKV) { Af[ks] = pack8(ah[0], ah[1]); Bf[ks] = pack8(bh_[0], bh_[1]); BTf[ks] = pack8(bt[0], bt[1]); }
    }
    const pg8::f32x4 z4 = (pg8::f32x4){0.f, 0.f, 0.f, 0.f};
    s8 selE, selO;
    { v4u e = (v4u){0u, 0u, 0u, 0u}, o = e; const int jj = r - 4 * g;
      if (jj >= 0 && jj < 4) { const unsigned one = 0x3F80u << (16 * (jj & 1)); if (jj < 2) { e.x = one; o.z = one; } else { e.y = one; o.w = one; } }
      selE = __builtin_bit_cast(s8, e); selO = __builtin_bit_cast(s8, o); }
    pg8::f32x4 MrkT = __builtin_amdgcn_mfma_f32_16x16x32_bf16(Kf[0], Rf[0], z4, 0, 0, 0); MrkT = __builtin_amdgcn_mfma_f32_16x16x32_bf16(Kf[1], Rf[1], MrkT, 0, 0, 0);
    const int tb = r >> 2, tj = r & 3;
    if (RWKV) {
        pg8::f32x4 LabT = __builtin_amdgcn_mfma_f32_16x16x32_bf16(Bf[0], Af[0], z4, 0, 0, 0); LabT = __builtin_amdgcn_mfma_f32_16x16x32_bf16(Bf[1], Af[1], LabT, 0, 0, 0);
        pg8::f32x4 LakT = __builtin_amdgcn_mfma_f32_16x16x32_bf16(Kf[0], Af[0], z4, 0, 0, 0); LakT = __builtin_amdgcn_mfma_f32_16x16x32_bf16(Kf[1], Af[1], LakT, 0, 0, 0);
        pg8::f32x4 MrbT = __builtin_amdgcn_mfma_f32_16x16x32_bf16(Bf[0], Rf[0], z4, 0, 0, 0); MrbT = __builtin_amdgcn_mfma_f32_16x16x32_bf16(Bf[1], Rf[1], MrbT, 0, 0, 0);
        const float d10 = __shfl(LabT[0], 20 * g + 1), d20 = __shfl(LabT[0], 20 * g + 2), d21 = __shfl(LabT[1], 20 * g + 2);
        const float d30 = __shfl(LabT[0], 20 * g + 3), d31 = __shfl(LabT[1], 20 * g + 3), d32 = __shfl(LabT[2], 20 * g + 3);
        pg8::f32x4 Loff, Lak, Mrb, Mrk;
#pragma unroll
        for (int j = 0; j < 4; ++j) { const bool below = g < tb, diag = g == tb;
            Loff[j] = below ? LabT[j] : 0.f; Lak[j] = (below || (diag && j < tj)) ? LakT[j] : 0.f;
            Mrb[j] = (below || (diag && j <= tj)) ? MrbT[j] : 0.f; Mrk[j] = (below || (diag && j <= tj)) ? MrkT[j] : 0.f; }
        REC[0 * 64] = __builtin_bit_cast(v4u, Af[0]); REC[1 * 64] = __builtin_bit_cast(v4u, Af[1]); REC[2 * 64] = __builtin_bit_cast(v4u, Rf[0]); REC[3 * 64] = __builtin_bit_cast(v4u, Rf[1]);
        REC[4 * 64] = __builtin_bit_cast(v4u, pack8(Loff, Lak)); REC[5 * 64] = __builtin_bit_cast(v4u, pack8(Mrb, Mrk));
        if (r == 0) { *(v4f*)(Dp + 8 * g) = (v4f){d10, d20, d21, d30}; *(v4f*)(Dp + 8 * g + 4) = (v4f){d31, d32, 0.f, 0.f}; }
#pragma unroll
        for (int mt = 0; mt < 4; ++mt) { const s8 sel = (mt & 1) ? selO : selE;
            const pg8::f32x4 K2 = __builtin_amdgcn_mfma_f32_16x16x32_bf16(KTf[mt >> 1], sel, z4, 0, 0, 0), B2 = __builtin_amdgcn_mfma_f32_16x16x32_bf16(BTf[mt >> 1], sel, z4, 0, 0, 0);
            REC[(6 + mt) * 64] = __builtin_bit_cast(v4u, pack8(B2, K2)); if (r == 15) GCp[4 * mt + g] = gcv[mt]; }
    } else {
        pg8::f32x4 Mrk;
#pragma unroll
        for (int j = 0; j < 4; ++j) Mrk[j] = (g < tb || (g == tb && j <= tj)) ? MrkT[j] : 0.f;
        REC[0 * 64] = __builtin_bit_cast(v4u, Rf[0]); REC[1 * 64] = __builtin_bit_cast(v4u, Rf[1]); REC[2 * 64] = __builtin_bit_cast(v4u, pack8(z4, Mrk));
#pragma unroll
        for (int mt = 0; mt < 4; ++mt) { const s8 sel = (mt & 1) ? selO : selE;
            const pg8::f32x4 K2 = __builtin_amdgcn_mfma_f32_16x16x32_bf16(KTf[mt >> 1], sel, z4, 0, 0, 0);
            REC[(3 + mt) * 64] = __builtin_bit_cast(v4u, pack8(z4, K2)); if (r == 15) GCp[4 * mt + g] = gcv[mt]; }
    }
}
__device__ PHASE_FN void chunk_prep_phase(const Ctx A, int vcu, int G) {
    const int tid = opaque_tid(), lane = tid & 63, wave = tid >> 6;
    const int gw = vcu * NWAVES + wave, NGW = G * NWAVES;
#pragma unroll 1
    for (int it = gw; it < 2 * 32 * NCHK; it += NGW) {
        const int mix = it >= 32 * NCHK, q = mix ? it - 32 * NCHK : it, bh = q / NCHK, c = q - bh * NCHK;
        if (mix) chunk_prep_item<false>(A, bh, c, lane); else chunk_prep_item<true>(A, bh, c, lane);
    }
}
template <bool RWKV>
__device__ PHASE_FN void chunk_scan(const Ctx A, LAS unsigned char* lds, int unit_) {
    const int unit = opaque_s(unit_);
    const int tid = opaque_tid(), lane = tid & 63, wave = tid >> 6, r = lane & 15, g = lane >> 4;
    const int slot = wave >> 2, nt = wave & 3;
    const int bh = 2 * unit + slot, b = bh >> 2, h = bh & 3;
    constexpr int NP = RWKV ? CKP_RW : CKP_HG;
    constexpr int NU = NP + 3;
    constexpr int NQ = (NU + 3) / 4;
    constexpr int RING = NU * 1024;
    constexpr size_t RB = RWKV ? CKR_RW : CKR_HG;
    const GAS unsigned char* recb = A.ws + (RWKV ? WS_CKF_RW : WS_CKF_HG) + (size_t)bh * NCHK * RB;
    const GAS unsigned char* vb = A.ws + (RWKV ? WS_RW_V : WS_HG_V) + (size_t)bh * L * 128;
    float* YR = (float*)(A.ws + (RWKV ? WS_YRAW : WS_ORAW)) + (size_t)b * L * 256 + h * 64 + nt * 16 + r;
    LAS unsigned char* ring = lds + slot * 2 * RING;
    static_assert(4 * (size_t)(CKP_RW + 3) * 1024 <= MISC_OFF, "chunk ring");
    auto unit_src = [&](int c_, int u) -> const GAS v4u* {
        if (u < NP) return (const GAS v4u*)(recb + (size_t)c_ * RB + u * 1024) + lane;
        if (u == NP) { const int q = lane * 16 < (int)(RB - NP * 1024) ? lane * 16 : (int)(RB - NP * 1024) - 16; return (const GAS v4u*)(recb + (size_t)c_ * RB + NP * 1024 + q); }
        return (const GAS v4u*)(vb + (size_t)c_ * CK * 128 + (u - NP - 1) * 1024) + lane; };
    v4u st0[NQ], st1[NQ], st2[NQ], st3[NQ];
#define CK_LD(S, c_) do { const int cc_ = (c_) < NCHK ? (c_) : NCHK - 1; _Pragma("unroll") for (int q = 0; q < NQ; ++q) { const int u = nt + 4 * q; if (u < NU) S[q] = *unit_src(cc_, u); } } while (0)
#define CK_ST(S, p_) do { _Pragma("unroll") for (int q = 0; q < NQ; ++q) { const int u = nt + 4 * q; if (u < NU) *(LAS v4u*)(ring + (p_) * RING + u * 1024 + lane * 16) = S[q]; } } while (0)
    pg8::f32x4 ST[4];
#pragma unroll
    for (int mt = 0; mt < 4; ++mt) ST[mt] = (pg8::f32x4){0.f, 0.f, 0.f, 0.f};
    const pg8::f32x4 z4 = (pg8::f32x4){0.f, 0.f, 0.f, 0.f};
    auto body = [&](const int c, const int p) __attribute__((always_inline)) {
        const LAS unsigned char* rb_ = ring + p * RING;
        const LAS unsigned char* sm = rb_ + NP * 1024;
        v4u pcs[NP]; v4f gqs[4]; v4f da = (v4f){0.f, 0.f, 0.f, 0.f}, db = da;
#pragma unroll
        for (int i = 0; i < NP; ++i) pcs[i] = *(const LAS v4u*)(rb_ + i * 1024 + lane * 16);
#pragma unroll
        for (int mt = 0; mt < 4; ++mt) gqs[mt] = *(const LAS v4f*)(sm + (16 * mt + 4 * g) * 4);
        if (RWKV) { da = *(const LAS v4f*)(sm + 256 + g * 32); db = *(const LAS v4f*)(sm + 256 + g * 32 + 16); }
#define PIECE(i) __builtin_bit_cast(s8, pcs[i])
        unsigned vp0, vp1;
        { const LAS unsigned short* vv = (const LAS unsigned short*)(rb_ + (NP + 1) * 1024) + (4 * g) * 64 + 16 * nt + r;
          vp0 = (unsigned)vv[0] | ((unsigned)vv[64] << 16); vp1 = (unsigned)vv[128] | ((unsigned)vv[192] << 16); }
        __builtin_amdgcn_sched_barrier(0);
        const s8 Sf0 = pack8(ST[0], ST[1]), Sf1 = pack8(ST[2], ST[3]);
        pg8::f32x4 U = z4, R0;
        if (RWKV) {
            R0 = __builtin_amdgcn_mfma_f32_16x16x32_bf16(PIECE(2), Sf0, z4, 0, 0, 0); R0 = __builtin_amdgcn_mfma_f32_16x16x32_bf16(PIECE(3), Sf1, R0, 0, 0, 0);
            pg8::f32x4 W0 = __builtin_amdgcn_mfma_f32_16x16x32_bf16(PIECE(0), Sf0, z4, 0, 0, 0); W0 = __builtin_amdgcn_mfma_f32_16x16x32_bf16(PIECE(1), Sf1, W0, 0, 0, 0);
            const float d10 = da.x, d20 = da.y, d21 = da.z, d30 = da.w, d31 = db.x, d32 = db.y;
            const s8 Ajac = PIECE(4);
#pragma unroll
            for (int rnd = 0; rnd < 4; ++rnd) {
                v4u bu; bu.x = pk2(U[0], U[1]); bu.y = pk2(U[2], U[3]); bu.z = vp0; bu.w = vp1;
                const pg8::f32x4 Wr = __builtin_amdgcn_mfma_f32_16x16x32_bf16(Ajac, __builtin_bit_cast(s8, bu), W0, 0, 0, 0);
                U[0] = Wr[0]; U[1] = Wr[1] + d10 * U[0]; U[2] = Wr[2] + d20 * U[0] + d21 * U[1]; U[3] = Wr[3] + d30 * U[0] + d31 * U[1] + d32 * U[2];
            }
        } else {
            R0 = __builtin_amdgcn_mfma_f32_16x16x32_bf16(PIECE(0), Sf0, z4, 0, 0, 0); R0 = __builtin_amdgcn_mfma_f32_16x16x32_bf16(PIECE(1), Sf1, R0, 0, 0, 0);
        }
        v4u buv; buv.x = pk2(U[0], U[1]); buv.y = pk2(U[2], U[3]); buv.z = vp0; buv.w = vp1;
        const s8 Buv = __builtin_bit_cast(s8, buv);
        const pg8::f32x4 Yt = __builtin_amdgcn_mfma_f32_16x16x32_bf16(PIECE(RWKV ? 5 : 2), Buv, R0, 0, 0, 0);
#pragma unroll
        for (int j = 0; j < 4; ++j) YR[(size_t)(c * CK + 4 * g + j) * 256] = Yt[j];
#pragma unroll
        for (int mt = 0; mt < 4; ++mt) {
            const v4f gq = gqs[mt];
            ST[mt][0] *= gq.x; ST[mt][1] *= gq.y; ST[mt][2] *= gq.z; ST[mt][3] *= gq.w;
            ST[mt] = __builtin_amdgcn_mfma_f32_16x16x32_bf16(PIECE((RWKV ? 6 : 3) + mt), Buv, ST[mt], 0, 0, 0);
        }
#undef PIECE
    };
    CK_LD(st0, 0); CK_LD(st1, 1); CK_LD(st2, 2); CK_LD(st3, 3);
    CK_ST(st0, 0);
    __syncthreads();
#define CK_TRIP(c_, SLD, SST, p_) do { CK_LD(SLD, (c_) + 4); body((c_), (p_)); CK_ST(SST, 1 - (p_)); __syncthreads(); } while (0)
    static_assert(NCHK % 4 == 1, "chunk loop: whole groups of four trips + one");
#pragma unroll 1
    for (int c = 0; c < NCHK - 1; c += 4) {
        CK_TRIP(c, st0, st1, 0);
        CK_TRIP(c + 1, st1, st2, 1);
        CK_TRIP(c + 2, st2, st3, 0);
        CK_TRIP(c + 3, st3, st0, 1);
    }
    CK_TRIP(NCHK - 1, st0, st1, 0);
#undef CK_TRIP
#undef CK_LD
#undef CK_ST
}
__device__ __forceinline__ float rowmax16(float x) { x = fmaxf(x, dpp_f<0xB1>(x)); x = fmaxf(x, dpp_f<0x4E>(x)); x = fmaxf(x, dpp_f<0x141>(x)); x = fmaxf(x, dpp_f<0x140>(x)); return x; }
__device__ __forceinline__ int rowmin16i(int x) { x = min(x, __builtin_amdgcn_update_dpp(0, x, 0xB1, 0xF, 0xF, true)); x = min(x, __builtin_amdgcn_update_dpp(0, x, 0x4E, 0xF, 0xF, true));
    x = min(x, __builtin_amdgcn_update_dpp(0, x, 0x141, 0xF, 0xF, true)); x = min(x, __builtin_amdgcn_update_dpp(0, x, 0x140, 0xF, 0xF, true)); return x; }
__device__ PHASE_FN void ln_router_phase(const Ctx A, LAS unsigned char* lds, int l, int vcu, int G) {
    const int tid = opaque_tid(), lane = tid & 63, wave = tid >> 6, r = lane & 15, g = lane >> 4;
    const int gw = vcu * NWAVES + wave, NGW = G * NWAVES;
    bf16* HB = (bf16*)(A.ws + WS_HB);
    int* TIDX = (int*)(A.ws + WS_TIDX); float* TGATE = (float*)(A.ws + WS_TGATE);
    unsigned* ecnt = (unsigned*)(A.ws + WS_CTL) + CW_ECNT + 64 * l;
    const float* gg = gin(A, 26) + l * D; const float* bb = gin(A, 27) + l * D;
    const float* rw = gin(A, 28) + (size_t)l * D * NE; const float* rb = gin(A, 29) + l * NE;
    LAS int* hist = (LAS int*)(lds + MISC_OFF + MI_HIST);
    if (tid < 32) hist[tid] = 0;
    for (int f = tid; f < 32 * 2 * 64; f += NTHR) { const int ks = f >> 7, nt = (f >> 6) & 1, ln = f & 63, n = ln & 15, g8 = ln >> 4;
        float w8[8];
#pragma unroll
        for (int e = 0; e < 8; ++e) w8[e] = rw[(size_t)(32 * ks + 8 * g8 + e) * NE + 16 * nt + n];
        v4u hi, lo; unsigned hh[4], ll[4];
#pragma unroll
        for (int e = 0; e < 4; ++e) { const unsigned ph = pk2(w8[2 * e], w8[2 * e + 1]); hh[e] = ph; ll[e] = pk2(w8[2 * e] - bflo(ph), w8[2 * e + 1] - bfhi(ph)); }
        hi = (v4u){hh[0], hh[1], hh[2], hh[3]}; lo = (v4u){ll[0], ll[1], ll[2], ll[3]};
        *(LAS v4u*)(lds + ((size_t)((ks * 2 + nt) * 2 + 0) * 64 + ln) * 16) = hi; *(LAS v4u*)(lds + ((size_t)((ks * 2 + nt) * 2 + 1) * 64 + ln) * 16) = lo; }
    __syncthreads();
    const float rb0 = rb[r], rb1 = rb[16 + r];
    auto lnrows = [&](size_t mrow, auto nrows_c) {
        constexpr int NR = decltype(nrows_c)::value;
        v4f x[NR][4];
#pragma unroll
        for (int u = 0; u < NR; ++u)
#pragma unroll
            for (int j = 0; j < 4; ++j) x[u][j] = ld_bf4(HB + (mrow + u) * D + 256 * j + 4 * lane);
#pragma unroll
        for (int u = 0; u < NR; ++u) { ln_row(x[u], gg, bb, lane);
#pragma unroll
            for (int j = 0; j < 4; ++j) { const size_t o = (mrow + u) * D + 256 * j + 4 * lane;
                v2u hi; hi.x = pk2(x[u][j].x, x[u][j].y); hi.y = pk2(x[u][j].z, x[u][j].w);
                *(v2u*)(HB + o) = hi; } }
    };
    auto ln2 = [&](size_t mrow) { lnrows(mrow, std::integral_constant<int, 2>{}); };
    auto route = [&](size_t m0) {
        pg8::f32x4 C0 = (pg8::f32x4){0.f, 0.f, 0.f, 0.f}, C1 = C0;
        const bf16* ah = HB + (m0 + r) * D + 8 * g;
#pragma unroll 4
        for (int ks = 0; ks < 32; ++ks) {
            const s8 xh = *(const s8*)(ah + 32 * ks);
            const LAS unsigned char* wf = lds + (size_t)(ks * 4) * 1024 + lane * 16;
            const s8 w0h = *(const LAS s8*)(wf), w0l = *(const LAS s8*)(wf + 1024), w1h = *(const LAS s8*)(wf + 2048), w1l = *(const LAS s8*)(wf + 3072);
            C0 = __builtin_amdgcn_mfma_f32_16x16x32_bf16(xh, w0h, C0, 0, 0, 0); C0 = __builtin_amdgcn_mfma_f32_16x16x32_bf16(xh, w0l, C0, 0, 0, 0);
            C1 = __builtin_amdgcn_mfma_f32_16x16x32_bf16(xh, w1h, C1, 0, 0, 0); C1 = __builtin_amdgcn_mfma_f32_16x16x32_bf16(xh, w1l, C1, 0, 0, 0);
        }
#pragma unroll
        for (int j = 0; j < 4; ++j) {
            float v0 = C0[j] + rb0, v1 = C1[j] + rb1;
            float tv[4]; int ti[4];
#pragma unroll
            for (int q = 0; q < 4; ++q) {
                const float mx = rowmax16(fmaxf(v0, v1));
                const int cand = (v0 == mx) ? r : ((v1 == mx) ? 16 + r : 64);
                const int bi = rowmin16i(cand);
                tv[q] = mx; ti[q] = bi;
                if (bi == r) v0 = -3.0e38f; if (bi == 16 + r) v1 = -3.0e38f;
            }
            const float e1 = __expf(tv[1] - tv[0]), e2 = __expf(tv[2] - tv[0]), e3 = __expf(tv[3] - tv[0]); const float inv = rcp_(1.f + e1 + e2 + e3);
            const size_t m = m0 + 4 * g + j;
            if (r == 0) { *(int4*)(TIDX + m * 4) = make_int4(ti[0], ti[1], ti[2], ti[3]); *(v4f*)(TGATE + m * 4) = (v4f){inv, e1 * inv, e2 * inv, e3 * inv}; }
            if (r < 4) lds_add(&hist[r == 0 ? ti[0] : r == 1 ? ti[1] : r == 2 ? ti[2] : ti[3]], 1);
        }
    };
    const int NT16 = T / 16, nfull = (NT16 / NGW) * NGW;
#pragma unroll 1
    for (int tile = gw; tile < nfull; tile += NGW) {
        const size_t m0 = (size_t)tile * 16;
#pragma unroll 1
        for (int t = 0; t < 16; t += 4) lnrows(m0 + t, std::integral_constant<int, 4>{});
        asm volatile("s_waitcnt vmcnt(0)" ::: "memory");
        route(m0);
    }
#pragma unroll 1
    for (int tile = nfull + vcu; tile < NT16; tile += G) {
        const size_t m0 = (size_t)tile * 16;
        ln2(m0 + 2 * wave);
        asm volatile("s_waitcnt vmcnt(0)" ::: "memory");
        __syncthreads();
        if (wave == 0) route(m0);
    }
    __syncthreads();
    if (tid < 32) atomicAdd(&ecnt[tid], (unsigned)hist[tid]);
}
__device__ __forceinline__ int build_tiles(const Ctx A, LAS unsigned char* lds, int l) {
    const int tid = opaque_tid();
    const unsigned* ecnt = (const unsigned*)(A.ws + WS_CTL) + CW_ECNT + 64 * l;
    LAS int* offs = (LAS int*)(lds + MISC_OFF + MI_OFFS); LAS int* tile_e = (LAS int*)(lds + MISC_OFF + MI_TILE); LAS int* nt = (LAS int*)(lds + MISC_OFF + MI_NT);
    __syncthreads();
    if (tid < 32) { int off = 0, mycnt = 0;
        for (int e = 0; e < 32; ++e) { const int c = (int)__hip_atomic_load(ecnt + e, __ATOMIC_RELAXED, __HIP_MEMORY_SCOPE_AGENT); if (e < tid) off += (c + 255) & ~255; if (e == tid) mycnt = c; }
        offs[tid] = off;
        const int t0 = off >> 8, t1 = (off + ((mycnt + 255) & ~255)) >> 8;
        for (int t = t0; t < t1; ++t) tile_e[t] = tid;
        if (tid == 31) nt[0] = t1; }
    __syncthreads();
    return nt[0];
}
__device__ PHASE_FN void moe_sort_phase(const Ctx A, LAS unsigned char* lds, int l) {
    const int tid = opaque_tid();
    const int* TIDX = (const int*)(A.ws + WS_TIDX); const float* TGATE = (const float*)(A.ws + WS_TGATE);
    int* SPOS = (int*)(A.ws + WS_SPOS); float* GSORT = (float*)(A.ws + WS_GSORT); int* RMAP = (int*)(A.ws + WS_RMAP);
    unsigned* ecur = (unsigned*)(A.ws + WS_CTL) + CW_ECUR + 64 * l; const unsigned* ecnt = (const unsigned*)(A.ws + WS_CTL) + CW_ECNT + 64 * l;
    LAS int* hist = (LAS int*)(lds + MISC_OFF + MI_HIST); LAS int* lcur = (LAS int*)(lds + MISC_OFF + MI_LCUR); LAS int* lbase = (LAS int*)(lds + MISC_OFF + MI_LBASE);
    LAS int* offs = (LAS int*)(lds + MISC_OFF + MI_OFFS);
    (void)build_tiles(A, lds, l);
    const int TPB = (T + (int)gridDim.x - 1) / (int)gridDim.x;
    const int mbeg = blockIdx.x * TPB, mend = (mbeg + TPB < T) ? mbeg + TPB : T;
    const int nslot = (mend > mbeg) ? (mend - mbeg) * 4 : 0;
    if (tid < 32) { hist[tid] = 0; lcur[tid] = 0; }
    __syncthreads();
    for (int s = tid; s < nslot; s += NTHR) lds_add(&hist[TIDX[(size_t)mbeg * 4 + s]], 1);
    __syncthreads();
    if (tid < 32) lbase[tid] = offs[tid] + (int)atomicAdd(&ecur[tid], (unsigned)hist[tid]);
    __syncthreads();
    for (int s = tid; s < nslot; s += NTHR) { const size_t gs = (size_t)mbeg * 4 + s; const int e = TIDX[gs];
        const int pos = lbase[e] + lds_add(&lcur[e], 1);
        SPOS[gs] = pos; GSORT[pos] = TGATE[gs]; RMAP[pos] = mbeg + (s >> 2); }
    if (blockIdx.x < 32) { const int e = blockIdx.x; const int c = (int)__hip_atomic_load(ecnt + e, __ATOMIC_RELAXED, __HIP_MEMORY_SCOPE_AGENT);
        const int p0 = offs[e] + c, p1 = offs[e] + ((c + 255) & ~255);
        for (int p = p0 + tid; p < p1; p += NTHR) RMAP[p] = 0; }
}
__device__ PHASE_FN void combine_ln_phase(const Ctx A, int l, int vcu, int G) {
    const int tid = opaque_tid(), lane = tid & 63, wave = tid >> 6;
    const int gw = vcu * NWAVES + wave, NGW = G * NWAVES;
    bf16* HB = (bf16*)(A.ws + WS_HB); const bf16* Y = (const bf16*)(A.ws + WS_YBUF); const int* SPOS = (const int*)(A.ws + WS_SPOS);
    const float* g = gin(A, 34) + l * D; const float* bb = gin(A, 35) + l * D;
#pragma unroll 1
    for (int m0 = 2 * gw; m0 < T; m0 += 2 * NGW) {
        v4f v[2][4];
#pragma unroll
        for (int t = 0; t < 2; ++t) { const int m = m0 + t;
            const int4 sp = *(const int4*)(SPOS + (size_t)m * 4);
#pragma unroll
            for (int j = 0; j < 4; ++j) { const size_t co = 256 * j + 4 * lane;
                const v4f y = ld_bf4(Y + (size_t)sp.x * D + co) + ld_bf4(Y + (size_t)sp.y * D + co) + ld_bf4(Y + (size_t)sp.z * D + co) + ld_bf4(Y + (size_t)sp.w * D + co);
                v[t][j] = ld_bf4(HB + (size_t)m * D + co) * ALPHA + y; } }
#pragma unroll
        for (int t = 0; t < 2; ++t) { const int m = m0 + t;
            ln_row(v[t], g, bb, lane);
            if (l == 0) {
#pragma unroll
                for (int j = 0; j < 4; ++j) st_bf4(HB + (size_t)m * D + 256 * j + 4 * lane, v[t][j]);
            } else {
                const int b = m / L, i = m - b * L;
                if (i >= NMETA) { float* o = (float*)(GAS float*)A.out + ((size_t)b * SEQ + (i - NMETA)) * D;
#pragma unroll
                    for (int j = 0; j < 4; ++j) *(v4f*)(o + 256 * j + 4 * lane) = v[t][j]; }
            }
        }
    }
}
constexpr int N_PHASES = 23;
#ifndef PH_ONLY
#define PH_ONLY -1
#endif
#define PHSEL(j) (PH_ONLY < 0 || PH_ONLY == (j))
#define IN(k) (lo <= (k) && (k) < hi)
#if MK_ONE_LAUNCH
#define GRID_BAR() xcd_barrier(bar)
#else
#define GRID_BAR() do { } while (0)
#endif
#define SEAM(k) do { if (IN(k) && IN((k) + 1)) GRID_BAR(); } while (0)
#define CTX() Ctx{args.in, args.out, launder(args.ws)}
#ifndef PROBE_PHASE
#define PROBE_PHASE -1
#endif
#ifndef PROBE_MULT
#define PROBE_MULT 4
#endif
#define PB_BEGIN(j) do { if (PROBE_PHASE == (j)) { pstamp = __builtin_amdgcn_s_memrealtime(); } } while (0)
#define PB_END(j) do { if (PROBE_PHASE == (j)) { pacc += __builtin_amdgcn_s_memrealtime() - pstamp; } } while (0)
__device__ __forceinline__ void layer_phases(const int l, const Args& args, LAS unsigned char* lds, const int G, const int bx, const int vcu, const int lo, const int hi, const XcdBarrier& bar, unsigned long long& pacc) {
    unsigned long long pstamp = 0ull; (void)pstamp;

        const int pb = 1 + 11 * l;
        PB_BEGIN(0);
        if (PHSEL(0) && IN(pb + 0)) { GAS unsigned char* wsl = launder(args.ws);
            pg8::Gemm g{(const pg8::bf16_t*)(wsl + WS_HB), (const pg8::bf16_t*)(wsl + WS_WIN) + (size_t)l * NINP * 1024, TP, NINP, 1024};
            pg8::StaticOrder S; S.init(TP, NINP, G, bx);
            pg8::EpiStoreBf16 E{(pg8::bf16_t*)(wsl + WS_PROJ), NINP};
            pg8::gemm_phase<pg8::EpiStoreBf16, pg8::StaticOrder, true, true>(lds, g, S, E);
            SEAM(pb + 0); PB_END(0);
        }
        PB_BEGIN(1);
        if (PHSEL(1) && IN(pb + 1)) { prep_phase(CTX(), lds, l, vcu, G); SEAM(pb + 1); PB_END(1); }
        PB_BEGIN(2);
        if (PHSEL(2) && IN(pb + 2)) { chunk_prep_phase(CTX(), vcu, G); lru_agg_phase(CTX(), vcu, G); SEAM(pb + 2); PB_END(2); }
        PB_BEGIN(3);
        if (PHSEL(3) && IN(pb + 3)) {
#ifndef PH2_SEL
#define PH2_SEL 15
#endif
            PB_BEGIN(20); PB_BEGIN(21); PB_BEGIN(22); PB_BEGIN(23);
#if SCAN_SEQ
            if ((PH2_SEL & 1) && bx < 64) rwkv_scan(CTX(), lds, bx); else if ((PH2_SEL & 2) && bx >= 64 && bx < 128) hgrn_scan(CTX(), lds, bx - 64); else if ((PH2_SEL & 4) && bx >= 128 && bx < 132) lru_carry_phase(CTX(), 128);
#else
            if ((PH2_SEL & 1) && bx < 16) chunk_scan<true>(CTX(), lds, bx); else if ((PH2_SEL & 2) && bx >= 16 && bx < 32) chunk_scan<false>(CTX(), lds, bx - 16); else if ((PH2_SEL & 4) && bx >= 32 && bx < 36) lru_carry_phase(CTX(), 32);
#endif
            __syncthreads();
            PB_END(20); PB_END(21); PB_END(22);
#if DSA_NAIVE
            if (PH2_SEL & 8) dsa_phase(CTX(), lds, l);
#else
            if (PH2_SEL & 8) dsa_select_phase(CTX(), lds, l);
#endif
            __syncthreads();
            PB_END(23);
            SEAM(pb + 3); PB_END(3);
        }
        PB_BEGIN(4);
        if (PHSEL(4) && IN(pb + 4)) {
            PB_BEGIN(24);
            lru_out_phase(CTX(), vcu, G);
            mixers_finish(CTX(), l, vcu, G);
            __syncthreads(); PB_END(24);
#if !DSA_NAIVE
            dsa_attn_phase(CTX(), lds, l);
#endif
            SEAM(pb + 4); PB_END(4);
        }
        PB_BEGIN(5);
        if (PHSEL(5) && IN(pb + 5)) { GAS unsigned char* wsl = launder(args.ws);
            pg8::Gemm g{(const pg8::bf16_t*)(wsl + WS_MIX), (const pg8::bf16_t*)(wsl + WS_WOUT) + (size_t)l * 1024 * 1024, TP, 1024, 1024};
            pg8::StaticOrder S; S.init(TP, 1024, G, bx);
            pg8::EpiResidBf E{(pg8::bf16_t*)(wsl + WS_HB), 1024, ALPHA};
            pg8::gemm_phase<pg8::EpiResidBf, pg8::StaticOrder, true, true>(lds, g, S, E);
            SEAM(pb + 5); PB_END(5);
        }
        PB_BEGIN(6);
        if (PHSEL(6) && IN(pb + 6)) { ln_router_phase(CTX(), lds, l, vcu, G); SEAM(pb + 6); PB_END(6); }
        PB_BEGIN(7);
        if (PHSEL(7) && IN(pb + 7)) { moe_sort_phase(CTX(), lds, l); SEAM(pb + 7); PB_END(7); }
        PB_BEGIN(8);
        if (PHSEL(8) && IN(pb + 8)) { GAS unsigned char* wsl = launder(args.ws);
            const int nt = build_tiles(CTX(), lds, l);
            pg8::Gemm g{(const pg8::bf16_t*)(wsl + WS_HB), (const pg8::bf16_t*)(wsl + WS_W1) + (size_t)l * 32 * 2048 * 1024, RMAX, 32 * 2048, 1024};
            pg8::MoeOrder S{nt * 8, G, vcu, 8, (const LAS int*)(lds + MISC_OFF + MI_TILE)};
            pg8::EpiSwiGLU E{(pg8::bf16_t*)(wsl + WS_ACT), (const float*)(const GAS float*)args.in[31] + (size_t)l * 32 * 2048};
            pg8::gemm_phase_gather<pg8::EpiSwiGLU, pg8::MoeOrder>(lds, g, S, E, (const int*)(wsl + WS_RMAP));
            SEAM(pb + 8); PB_END(8);
        }
        PB_BEGIN(9);
        if (PHSEL(9) && IN(pb + 9)) { GAS unsigned char* wsl = launder(args.ws);
            const int nt = build_tiles(CTX(), lds, l);
            pg8::Gemm g{(const pg8::bf16_t*)(wsl + WS_ACT), (const pg8::bf16_t*)(wsl + WS_W2) + (size_t)l * 32 * 1024 * 1024, RMAX, 32 * 1024, 1024};
            pg8::MoeOrder S{nt * 4, G, vcu, 4, (const LAS int*)(lds + MISC_OFF + MI_TILE)};
            pg8::EpiMoeOut E{(pg8::bf16_t*)(wsl + WS_YBUF), (const float*)(const GAS float*)args.in[33] + (size_t)l * 32 * 1024, (const float*)(wsl + WS_GSORT)};
            pg8::gemm_phase<pg8::EpiMoeOut, pg8::MoeOrder, true, true>(lds, g, S, E);
            SEAM(pb + 9); PB_END(9);
        }
        PB_BEGIN(10);
        if (PHSEL(10) && IN(pb + 10)) { combine_ln_phase(CTX(), l, vcu, G); SEAM(pb + 10); PB_END(10); }
}
__global__ void __launch_bounds__(NTHR, 2) trunk_fwd(Args args) {
    extern __shared__ __attribute__((aligned(16))) unsigned char lds_raw[];
    LAS unsigned char* lds = (LAS unsigned char*)lds_raw;
    const int tid = threadIdx.x;
    const int G = gridDim.x; const int bx = blockIdx.x; const int vcu = (G % 8 == 0) ? (bx % 8) * (G / 8) + bx / 8 : bx;
    unsigned* ctl = (unsigned*)(args.ws + WS_CTL);
    for (int u = tid; u < (LDS_BYTES - MISC_OFF) / 4; u += NTHR) ((LAS unsigned*)(lds + MISC_OFF))[u] = 0u;
    __syncthreads();
#if MK_ONE_LAUNCH
    XcdBarrier bar = xcd_barrier_post(ctl + CW_BAR, (volatile LAS unsigned*)(lds + MISC_OFF + MI_BAR));
#else
    XcdBarrier bar; bar.bar = ctl + CW_BAR; bar.x = 0; bar.st = nullptr;
#endif
    const int lo = args.ph_lo, hi = args.ph_hi;

    unsigned long long pacc = 0ull, pstamp = 0ull; (void)pstamp;
    PB_BEGIN(11);
    if (PHSEL(11) && IN(0)) { p0_prologue(CTX(), lds, vcu, G); SEAM(0); }
    PB_END(11);

#pragma unroll 1
    for (int l = 0; l < 2; ++l) layer_phases(l, args, lds, G, bx, vcu, lo, hi, bar, pacc);
    if (PROBE_PHASE >= 0 && bx == (PROBE_PHASE == 21 ? 16 : PROBE_PHASE == 22 ? 32 : PROBE_PHASE == 23 ? 255 : 0)) { const unsigned long long t0 = __builtin_amdgcn_s_memrealtime(); while (__builtin_amdgcn_s_memrealtime() - t0 < pacc * PROBE_MULT) __builtin_amdgcn_s_sleep(8); }
#undef IN
#undef SEAM
}

extern "C" void kernel_launch(void* const* d_in, const int* in_sizes, int n_in, void* d_out, int out_size, void* d_ws, size_t ws_size, hipStream_t stream) {
    static int grid = 0;
    if (grid == 0) {
        if (n_in != 36 || in_sizes[0] != NB * SEQ * D || out_size != NB * SEQ * D || ws_size < WS_END) {
            fprintf(stderr, "kernel_launch: unexpected problem (n_in %d, in0 %d, out %d, ws %zu, need %zu); nothing launched\n", n_in, n_in > 0 ? in_sizes[0] : -1, out_size, ws_size, (size_t)WS_END); grid = -1; return; }
        int dev = 0, cus = 0, per_cu = 0;
        if (hipGetDevice(&dev) != hipSuccess || hipDeviceGetAttribute(&cus, hipDeviceAttributeMultiprocessorCount, dev) != hipSuccess) { grid = -1; return; }
        if (hipFuncSetAttribute((const void*)trunk_fwd, hipFuncAttributeMaxDynamicSharedMemorySize, LDS_BYTES) != hipSuccess) { fprintf(stderr, "kernel_launch: hipFuncSetAttribute failed\n"); grid = -1; return; }
        if (hipOccupancyMaxActiveBlocksPerMultiprocessor(&per_cu, (const void*)trunk_fwd, NTHR, LDS_BYTES) != hipSuccess || per_cu < 1) { fprintf(stderr, "kernel_launch: occupancy query says %d\n", per_cu); (void)hipGetLastError(); }
        grid = cus;
        if (grid < 160 || grid > 512) { fprintf(stderr, "kernel_launch: unsupported CU count %d\n", cus); grid = -1; return; }
    }
    if (grid < 0) return;
    if (hipMemsetAsync((char*)d_ws + WS_CTL, 0, CTL_ZERO_BYTES, stream) != hipSuccess) return;
    Args a; memset(&a, 0, sizeof(a));
    for (int i = 0; i < 36; ++i) a.in[i] = (const float*)d_in[i];
    a.out = (float*)d_out; a.ws = (unsigned char*)d_ws;
#if MK_ONE_LAUNCH
    a.ph_lo = 0; a.ph_hi = N_PHASES;
    hipLaunchKernelGGL(trunk_fwd, dim3(grid), dim3(NTHR), LDS_BYTES, stream, a);
#else
    for (int p = 0; p < N_PHASES; ++p) { a.ph_lo = p; a.ph_hi = p + 1; hipLaunchKernelGGL(trunk_fwd, dim3(grid), dim3(NTHR), LDS_BYTES, stream, a); }
#endif
}
```

```cpp
#include <hip/hip_runtime.h>
#include <cstdio>
#include <cstdint>
#include <cstring>

#ifndef MK_ONE_LAUNCH
#define MK_ONE_LAUNCH 1
#endif

#ifndef SCAN_SEQ
#define SCAN_SEQ 0
#endif
#ifndef SCAN_MIX
#define SCAN_MIX 0
#endif
#ifndef DSA_NAIVE
#define DSA_NAIVE 0
#endif
#ifndef PHASE_FN
#define PHASE_FN __forceinline__
#endif
#define GAS __attribute__((address_space(1)))
#define LAS __attribute__((address_space(3)))
typedef unsigned short bf16;
typedef unsigned v4u __attribute__((ext_vector_type(4)));
typedef unsigned v2u __attribute__((ext_vector_type(2)));
typedef float v4f __attribute__((ext_vector_type(4)));
typedef float v2f __attribute__((ext_vector_type(2)));

constexpr int NB = 8, SEQ = 8192, NMETA = 16, L = SEQ + NMETA  , T = NB * L  , TP = 65792  , D = 1024;
constexpr int NINP = 3584;
constexpr int NE = 32, TOPK = 4;
constexpr int RMAX = 1058 * 256;
constexpr int C_RW = 0, C_RW_R = 0, C_RW_WD = 256, C_RW_K = 320, C_RW_V = 576, C_RW_AD = 832, C_RW_GD = 896;
constexpr int C_DS_Q = 960, C_DS_K = 1216, C_DS_V = 1472, C_DS_QI = 1728, C_DS_KI = 1984, C_DS_WI = 2016;
constexpr int C_LR_X = 2024, C_LR_G = 2280;
constexpr int C_HG_Q = 2536, C_HG_F = 2792, C_HG_I = 3048, C_HG_G = 3304;
constexpr float ALPHA = 1.41421356237f;
constexpr float LN_EPS = 1e-5f;

constexpr size_t MiB = 1u << 20;
constexpr size_t WS_CTL = 0, CTL_ZERO_BYTES = 1 * MiB;
constexpr size_t WS_WIN = 2 * MiB;
constexpr size_t WS_WOUT = 16 * MiB;
constexpr size_t WS_W1 = 20 * MiB;
constexpr size_t WS_W2 = 276 * MiB;
constexpr size_t WS_H = 404 * MiB;
constexpr size_t WS_MIX = WS_H;
constexpr size_t WS_HB = 661 * MiB;
constexpr size_t WS_BIG = 790 * MiB;
constexpr size_t WS_PROJ = WS_BIG;
constexpr size_t SZ_HM32 = (size_t)32 * L * 64 * 4;
constexpr size_t SZ_HM16 = SZ_HM32 / 2;
constexpr size_t SZ_TM16 = (size_t)T * 256 * 2;
constexpr size_t WS_RW_W = 1240 * MiB;
constexpr size_t WS_RW_A = WS_RW_W + SZ_HM32, WS_RW_B = WS_RW_A + SZ_HM16, WS_RW_K = WS_RW_B + SZ_HM16, WS_RW_WR = WS_RW_K + SZ_HM16, WS_RW_V = WS_RW_WR + SZ_HM16;
constexpr size_t WS_RW_G = WS_RW_V + SZ_HM16;
constexpr size_t WS_RW_SC = WS_RW_G + SZ_TM16;
constexpr size_t WS_DS_Q = WS_RW_SC + (size_t)32 * L * 16;
constexpr size_t WS_DS_K = WS_DS_Q + SZ_TM16, WS_DS_V = WS_DS_K + SZ_TM16, WS_DS_QI = WS_DS_V + SZ_TM16;
constexpr size_t WS_DS_KI = WS_DS_QI + SZ_TM16;
constexpr size_t WS_DS_WI = WS_DS_KI + (size_t)T * 64;
constexpr size_t WS_LR_A = WS_DS_WI + (size_t)T * 32;
constexpr size_t WS_LR_U = WS_LR_A + (size_t)T * 1024, WS_LR_G = WS_LR_U + SZ_TM16;
constexpr size_t WS_HG_F = WS_LR_G + SZ_TM16;
constexpr size_t WS_HG_K = WS_HG_F + SZ_HM32, WS_HG_Q = WS_HG_K + SZ_HM16, WS_HG_V = WS_HG_Q + SZ_HM16, WS_HG_G = WS_HG_V + SZ_HM16;
constexpr size_t WS_MIX_END = WS_HG_G + SZ_TM16;
constexpr size_t SZ_SORT = (size_t)RMAX * 1024 * 2;
constexpr size_t WS_SORTA = WS_BIG, WS_YBUF = WS_BIG, WS_ACT = WS_BIG + SZ_SORT;
constexpr size_t WS_TIDX = WS_ACT + SZ_SORT;
constexpr size_t WS_TGATE = WS_TIDX + (size_t)T * 16;
constexpr size_t WS_SPOS = WS_TGATE + (size_t)T * 16;
constexpr size_t WS_GSORT = WS_SPOS + (size_t)T * 16;
constexpr size_t WS_RMAP = WS_GSORT + (size_t)RMAX * 4;
constexpr size_t WS_MOE_END = WS_RMAP + (size_t)RMAX * 4;
constexpr size_t WS_END = 2040 * MiB;
static_assert(WS_MIX_END <= WS_END && WS_MOE_END <= WS_END, "workspace map");
static_assert(WS_PROJ + (size_t)TP * NINP * 2 <= WS_RW_W, "proj vs prep");
static_assert(WS_HB + (size_t)TP * 1024 * 2 <= WS_BIG && WS_H + (size_t)TP * 4096 <= WS_HB, "h/hb");

constexpr int CW_TMO = 0, CW_CODE = 1;
constexpr int CW_BAR = 4096;
constexpr int CW_DSAQ = 8192;
constexpr int CW_ECNT = 8448;
constexpr int CW_ECUR = 8704;

constexpr int LDS_BYTES = 163840;
constexpr int MISC_OFF = 155648;
constexpr int MI_BAR = 0, MI_HIST = 64, MI_LCUR = 192, MI_LBASE = 320, MI_NT = 448, MI_OFFS = 512, MI_TILE = 1024;
constexpr int NWAVES = 8, NTHR = 512;

__device__ __forceinline__ float bf2f(unsigned short x) { return __uint_as_float((unsigned)x << 16); }
__device__ __forceinline__ float bflo(unsigned x) { return __uint_as_float(x << 16); }
__device__ __forceinline__ float bfhi(unsigned x) { return __uint_as_float(x & 0xffff0000u); }
typedef float f32x2_t __attribute__((ext_vector_type(2))); typedef __bf16 bf16x2_t __attribute__((ext_vector_type(2)));
__device__ __forceinline__ unsigned pk2(float lo, float hi) { const f32x2_t v = {lo, hi}; const bf16x2_t b = __builtin_convertvector(v, bf16x2_t); return __builtin_bit_cast(unsigned, b); }
__device__ __forceinline__ bf16 f2bf(float f) { return (bf16)(pk2(f, 0.f) & 0xffffu); }
__device__ __forceinline__ v4f ld_bf4(const bf16* p) { const v2u x = *(const v2u*)p; return (v4f){bflo(x.x), bfhi(x.x), bflo(x.y), bfhi(x.y)}; }
__device__ __forceinline__ void st_bf4(bf16* p, v4f v) { v2u o; o.x = pk2(v.x, v.y); o.y = pk2(v.z, v.w); *(v2u*)p = o; }
__device__ __forceinline__ float wave_max(float v) {
#pragma unroll
    for (int o = 1; o < 64; o <<= 1) v = fmaxf(v, __shfl_xor(v, o));
    return v;
}
template <int CTRL> __device__ __forceinline__ float dpp_f(float x) { return __int_as_float(__builtin_amdgcn_update_dpp(0, __float_as_int(x), CTRL, 0xF, 0xF, true)); }
__device__ __forceinline__ float sum8(float x) { x += dpp_f<0xB1>(x); x += dpp_f<0x4E>(x); x += dpp_f<0x141>(x); return x; }
__device__ __forceinline__ float sum16(float x) { x = sum8(x); x += dpp_f<0x140>(x); return x; }
__device__ __forceinline__ float wave_sum(float v) {
    v = sum16(v);
    v += __shfl_xor(v, 16); v += __shfl_xor(v, 32);
    return v;
}
__device__ __forceinline__ float rcp_(float x) { return __builtin_amdgcn_rcpf(x); }
__device__ __forceinline__ float rsq_(float x) { return __builtin_amdgcn_rsqf(x); }
__device__ __forceinline__ float sigmoidf_(float x) { return rcp_(1.f + __expf(-x)); }
__device__ __forceinline__ float softplusf_(float x) { return x > 20.f ? x : log1pf(__expf(x)); }
__device__ __forceinline__ float gelu_tanh(float x) { const float u = 0.7978845608028654f * (x + 0.044715f * x * x * x); return 0.5f * x * (1.f + tanhf(u)); }
__device__ __forceinline__ int lds_add(LAS int* p, int v) { return __hip_atomic_fetch_add(p, v, __ATOMIC_RELAXED, __HIP_MEMORY_SCOPE_WORKGROUP); }
#define LDS_WAIT() asm volatile("s_waitcnt lgkmcnt(0)" ::: "memory")
#define VM_WAIT() asm volatile("s_waitcnt vmcnt(0)" ::: "memory")

__device__ __forceinline__ GAS unsigned char* launder(unsigned char* p) { GAS unsigned char* g = (GAS unsigned char*)p; asm volatile("" : "+s"(g)); return g; }
__device__ __forceinline__ int opaque_tid() { int t = (int)threadIdx.x; asm volatile("" : "+v"(t)); return t; }
__device__ __forceinline__ int opaque_s(int x) { return __builtin_amdgcn_readfirstlane(x); }
struct Args { const float* in[36]; float* out; unsigned char* ws; int ph_lo, ph_hi; };
struct Ctx { const float* const* in; float* out; GAS unsigned char* ws; };
__device__ __forceinline__ const float* gin(const Ctx& A, int k) { return (const float*)(const GAS float*)A.in[k]; }
namespace pg8 {
#define PG8_LAS __attribute__((address_space(3)))
typedef unsigned short bf16_t;
typedef short bf16x8 __attribute__((ext_vector_type(8)));
typedef float f32x4 __attribute__((ext_vector_type(4)));
typedef unsigned u32x4 __attribute__((ext_vector_type(4)));
constexpr int BM = 256, BK = 64, HALF = 128, HTB = HALF * BK * 2  , STAGE_BYTES = 8 * HTB, NXCD = 8, WGM = 8;

__host__ __device__ __forceinline__ int lds_byte(int r, int c) { const int st = (r >> 4) * 2 + (c >> 5), rr = r & 15, cc = c & 31, ob = rr * 64 + cc * 2; return st * 1024 + (ob ^ (((ob >> 9) & 1) << 5)); }
__host__ __device__ __forceinline__ void stage_rc(int b, int& R, int& C) { const int st = b / 1024, sb = b % 1024, swz = sb ^ (((sb >> 9) & 1) << 5); R = (st >> 1) * 16 + swz / 64; C = (st & 1) * 32 + (swz % 64) / 2; }
__host__ __device__ __forceinline__ int perm32(int rho) { const int n = rho >> 4, i = rho & 15; return 8 * (i >> 2) + 4 * n + (i & 3); }

struct Unit { int pm, pn; };
struct Gemm { const bf16_t* A; const bf16_t* Bt; int M, N, K; };

struct StaticOrder {
    int nM, nN, nwg, G, c;
    __host__ __device__ void init(int M, int N, int G_, int c_) { nM = M / BM; nN = N / BM; nwg = nM * nN; G = G_; c = c_; }
    __host__ __device__ bool next(int i, Unit& u) const {
        const long L = (long)i * G + c; if (L >= nwg) return false;
        int wgid = (int)L; { const int q = nwg / NXCD, r = nwg % NXCD, xcd = wgid % NXCD, off = wgid / NXCD; wgid = (xcd < r ? xcd * (q + 1) : r * (q + 1) + (xcd - r) * q) + off; }
        const int nig = WGM * nN, gid = wgid / nig, fm = gid * WGM, gsz = (nM - fm) < WGM ? (nM - fm) : WGM;
        u.pm = fm + ((wgid % nig) % gsz); u.pn = (wgid % nig) / gsz; return true;
    }
    __device__ __forceinline__ void a_ready(const Unit&) const {}
    __device__ __forceinline__ void done(const Unit&) const {}
};

__device__ __forceinline__ unsigned cvt_pk_bf16(float lo, float hi) { unsigned r; asm volatile("v_cvt_pk_bf16_f32 %0, %1, %2" : "=v"(r) : "v"(lo), "v"(hi)); return r; }
typedef float f32x2 __attribute__((ext_vector_type(2)));
typedef unsigned u32x2v __attribute__((ext_vector_type(2)));
typedef float pf32x2_t __attribute__((ext_vector_type(2))); typedef __bf16 pbf16x2_t __attribute__((ext_vector_type(2)));
__device__ __forceinline__ unsigned cvt_pk_bf16c(float lo, float hi) { const pf32x2_t v = {lo, hi}; const pbf16x2_t q = __builtin_convertvector(v, pbf16x2_t); return __builtin_bit_cast(unsigned, q); }
struct EpiStoreBf16 {
    static constexpr bool PERM = true, AFTER_DRAIN = false;
    bf16_t* O; int ldc;
    __device__ __forceinline__ void operator()(const f32x4 (&acc)[2][2][4][2], const Unit& u, int wr, int wc, int fr, int fq) const {
        const int row0 = u.pm * BM + wr * 64 + fr, col0 = u.pn * BM + wc * 32 + 8 * fq;
#pragma unroll
        for (int ai = 0; ai < 2; ++ai)
#pragma unroll
            for (int m = 0; m < 4; ++m) { bf16_t* rowp = O + (size_t)(row0 + ai * HALF + m * 16) * ldc + col0;
#pragma unroll
                for (int bj = 0; bj < 2; ++bj) { const f32x4 v0 = acc[ai][bj][m][0], v1 = acc[ai][bj][m][1];
                    u32x4 w; w.x = cvt_pk_bf16c(v0[0], v0[1]); w.y = cvt_pk_bf16c(v0[2], v0[3]); w.z = cvt_pk_bf16c(v1[0], v1[1]); w.w = cvt_pk_bf16c(v1[2], v1[3]);
                    *(u32x4*)(rowp + bj * HALF) = w; } }
    }
};
struct EpiResid {
    static constexpr bool PERM = false, AFTER_DRAIN = false;
    float* Hres; int ldc; float alpha;
    __device__ __forceinline__ void operator()(const f32x4 (&acc)[2][2][4][2], const Unit& u, int wr, int wc, int fr, int fq) const {
        const int row0 = u.pm * BM + wr * 64 + fr, col0 = u.pn * BM + wc * 32 + 4 * fq;
#pragma unroll
        for (int ai = 0; ai < 2; ++ai)
#pragma unroll
            for (int m = 0; m < 4; ++m) { float* rowp = Hres + (size_t)(row0 + ai * HALF + m * 16) * ldc + col0;
#pragma unroll
                for (int bj = 0; bj < 2; ++bj)
#pragma unroll
                    for (int n = 0; n < 2; ++n) { f32x4* p = (f32x4*)(rowp + bj * HALF + n * 16); const f32x4 old = *p; *p = old * alpha + acc[ai][bj][m][n]; } }
    }
};
struct EpiResidBf {
    static constexpr bool PERM = true, AFTER_DRAIN = false;
    bf16_t* Hb; int ldc; float alpha;
    __device__ __forceinline__ void operator()(const f32x4 (&acc)[2][2][4][2], const Unit& u, int wr, int wc, int fr, int fq) const {
        const int row0 = u.pm * BM + wr * 64 + fr, col0 = u.pn * BM + wc * 32 + 8 * fq;
#pragma unroll
        for (int ai = 0; ai < 2; ++ai)
#pragma unroll
            for (int m = 0; m < 4; ++m) { bf16_t* rowp = Hb + (size_t)(row0 + ai * HALF + m * 16) * ldc + col0;
#pragma unroll
                for (int bj = 0; bj < 2; ++bj) { const f32x4 v0 = acc[ai][bj][m][0], v1 = acc[ai][bj][m][1]; const u32x4 o = *(const u32x4*)(rowp + bj * HALF);
#define RB_LO(x_) __builtin_bit_cast(float, (x_) << 16)
#define RB_HI(x_) __builtin_bit_cast(float, (x_) & 0xffff0000u)
                    u32x4 w; w.x = cvt_pk_bf16c(RB_LO(o.x) * alpha + v0[0], RB_HI(o.x) * alpha + v0[1]); w.y = cvt_pk_bf16c(RB_LO(o.y) * alpha + v0[2], RB_HI(o.y) * alpha + v0[3]);
                    w.z = cvt_pk_bf16c(RB_LO(o.z) * alpha + v1[0], RB_HI(o.z) * alpha + v1[1]); w.w = cvt_pk_bf16c(RB_LO(o.w) * alpha + v1[2], RB_HI(o.w) * alpha + v1[3]);
#undef RB_LO
#undef RB_HI
                    *(u32x4*)(rowp + bj * HALF) = w; } }
    }
};
struct EpiSwiGLU {
    static constexpr bool PERM = true, AFTER_DRAIN = false;
    bf16_t* ACT; const float* b1;
    __device__ __forceinline__ void operator()(const f32x4 (&acc)[2][2][4][2], const Unit& u, int wr, int wc, int fr, int fq) const {
        const int e = u.pn >> 3, pnl = u.pn & 7;
        const int row0 = u.pm * BM + wr * 64 + fr, c8 = pnl * 128 + wc * 32 + 8 * fq;
        const float* bg = b1 + (size_t)e * 2048 + c8; const float* bl = bg + 1024;
        const f32x4 bg0 = *(const f32x4*)bg, bg1 = *(const f32x4*)(bg + 4), bl0 = *(const f32x4*)bl, bl1 = *(const f32x4*)(bl + 4);
#pragma unroll
        for (int ai = 0; ai < 2; ++ai)
#pragma unroll
            for (int m = 0; m < 4; ++m) {
                float o[8];
#pragma unroll
                for (int n = 0; n < 2; ++n) { const f32x4 g4 = acc[ai][0][m][n] + (n ? bg1 : bg0), l4 = acc[ai][1][m][n] + (n ? bl1 : bl0);
#pragma unroll
                    for (int j = 0; j < 4; ++j) { const float glu = fminf(g4[j], 7.f), lin = fminf(fmaxf(l4[j], -7.f), 7.f);
                        o[n * 4 + j] = glu * __builtin_amdgcn_rcpf(1.f + __builtin_amdgcn_exp2f(glu * (-1.702f * 1.4426950408889634f))) * (lin + 1.f); } }
                u32x4 w; w.x = cvt_pk_bf16c(o[0], o[1]); w.y = cvt_pk_bf16c(o[2], o[3]); w.z = cvt_pk_bf16c(o[4], o[5]); w.w = cvt_pk_bf16c(o[6], o[7]);
                *(u32x4*)(ACT + (size_t)(row0 + ai * HALF + m * 16) * 1024 + c8) = w; }
    }
};
struct EpiMoeOut {
    static constexpr bool PERM = true, AFTER_DRAIN = false;
    bf16_t* Y; const float* b2; const float* gate;
    __device__ __forceinline__ void operator()(const f32x4 (&acc)[2][2][4][2], const Unit& u, int wr, int wc, int fr, int fq) const {
        const int e = u.pn >> 2, pnl = u.pn & 3;
        const int row0 = u.pm * BM + wr * 64 + fr, c8 = pnl * 256 + wc * 32 + 8 * fq;
        const float* bb = b2 + (size_t)e * 1024 + c8;
        f32x4 bv[2][2];
#pragma unroll
        for (int bj = 0; bj < 2; ++bj) { bv[bj][0] = *(const f32x4*)(bb + bj * HALF); bv[bj][1] = *(const f32x4*)(bb + bj * HALF + 4); }
#pragma unroll
        for (int ai = 0; ai < 2; ++ai)
#pragma unroll
            for (int m = 0; m < 4; ++m) { const int row = row0 + ai * HALF + m * 16; const float gt = gate[row];
#pragma unroll
                for (int bj = 0; bj < 2; ++bj) { const f32x4 v0 = (acc[ai][bj][m][0] + bv[bj][0]) * gt, v1 = (acc[ai][bj][m][1] + bv[bj][1]) * gt;
                    u32x4 w; w.x = cvt_pk_bf16c(v0[0], v0[1]); w.y = cvt_pk_bf16c(v0[2], v0[3]); w.z = cvt_pk_bf16c(v1[0], v1[1]); w.w = cvt_pk_bf16c(v1[2], v1[3]);
                    *(u32x4*)(Y + (size_t)row * 1024 + c8 + bj * HALF) = w; } }
    }
};
struct MoeOrder {
    int n_units, G, c, npn; const PG8_LAS int* tile_e;
    __device__ __forceinline__ bool next(int i, Unit& u) const {
        const int Lx = i * G + c; if (Lx >= n_units) return false;
        const int tile = Lx / npn, pnl = Lx - tile * npn;
        u.pm = tile; u.pn = tile_e[tile] * npn + pnl; return true;
    }
    __device__ __forceinline__ void a_ready(const Unit&) const {}
    __device__ __forceinline__ void done(const Unit&) const {}
};

template <class Epi, class Sched, bool ALIGN_EPI = false, bool SP2 = false>
__device__ __forceinline__ void gemm_phase(PG8_LAS unsigned char* lds, const Gemm g, const Sched& S, const Epi& E) {
    const int tid = opaque_tid(), wid = __builtin_amdgcn_readfirstlane(tid >> 6), lane = tid & 63, wr = wid >> 2, wc = wid & 3, fr = lane & 15, fq = lane >> 4;
    const int K = g.K, nt = K / BK;
    unsigned voffA[2], voffB[2];
#pragma unroll
    for (int i = 0; i < 2; ++i) { int R, C; stage_rc(tid * 16 + i * 8192, R, C); const int Rb = Epi::PERM ? ((R & ~31) + perm32(R & 31)) : R;
        voffA[i] = (unsigned)(R * K + C) * 2u; voffB[i] = (unsigned)(Rb * K + C) * 2u; }
    const size_t kstep = (size_t)(BK * 2);
    const size_t hstep = (size_t)HALF * K * 2;
    const size_t tstep = 2 * hstep;
    const unsigned ldsw = (unsigned)wid * 1024u;
    const int aoff = lds_byte(wr * 64 + fr, fq * 8), boff = lds_byte(wc * 32 + fr, fq * 8);
#define PG8_SA(b, h) (((b) * 2 + (h)) * HTB)
#define PG8_SB(b, h) ((4 + (b) * 2 + (h)) * HTB)
#define PG8_STAGE(bufoff, gbase, voff) do { _Pragma("unroll") for (int _i = 0; _i < 2; ++_i) \
        __builtin_amdgcn_global_load_lds((const unsigned*)((const char*)(gbase) + (voff)[_i]), (PG8_LAS unsigned*)(lds + (bufoff) + ldsw + _i * 8192), 16, 0, 0); } while (0)
#define PG8_LDA(dst, b, h) do { _Pragma("unroll") for (int m = 0; m < 4; ++m) _Pragma("unroll") for (int k = 0; k < 2; ++k) dst[m][k] = *(const PG8_LAS bf16x8*)(lds + PG8_SA(b, h) + aoff + m * 2048 + k * 1024); } while (0)
#define PG8_LDB(dst, b, h) do { _Pragma("unroll") for (int n = 0; n < 2; ++n) _Pragma("unroll") for (int k = 0; k < 2; ++k) dst[n][k] = *(const PG8_LAS bf16x8*)(lds + PG8_SB(b, h) + boff + n * 2048 + k * 1024); } while (0)
#define PG8_MMA(ai, bj, At, Bt) do { __builtin_amdgcn_s_setprio(1); _Pragma("unroll") for (int m = 0; m < 4; ++m) _Pragma("unroll") for (int n = 0; n < 2; ++n) _Pragma("unroll") for (int k = 0; k < 2; ++k) \
        acc[ai][bj][m][n] = __builtin_amdgcn_mfma_f32_16x16x32_bf16(Bt[n][k], At[m][k], acc[ai][bj][m][n], 0, 0, 0); __builtin_amdgcn_s_setprio(0); } while (0)
#define PG8_WAIT_V(n) asm volatile("s_waitcnt vmcnt(" #n ")" ::: "memory")
#define PG8_WAIT_L(n) asm volatile("s_waitcnt lgkmcnt(" #n ")" ::: "memory")
#define PG8_BAR __builtin_amdgcn_s_barrier()
#define PG8_SCHED __builtin_amdgcn_sched_barrier(0)
    Unit cur, nxt; int ui = 0;
    if (!S.next(0, cur)) return;
    f32x4 acc[2][2][4][2];
#pragma unroll
    for (int a = 0; a < 2; ++a)
#pragma unroll
        for (int b = 0; b < 2; ++b)
#pragma unroll
            for (int m = 0; m < 4; ++m)
#pragma unroll
                for (int n = 0; n < 2; ++n) acc[a][b][m][n] = (f32x4){0.f, 0.f, 0.f, 0.f};
    bf16x8 At[4][2], B0[2][2], B1[2][2];
    const char* cA = (const char*)g.A + (size_t)cur.pm * tstep; const char* cB = (const char*)g.Bt + (size_t)cur.pn * tstep;
    S.a_ready(cur);
    if constexpr (SP2) {
        PG8_STAGE(PG8_SB(0, 0), cB, voffB); PG8_STAGE(PG8_SB(0, 1), cB + hstep, voffB); PG8_STAGE(PG8_SA(0, 0), cA, voffA); PG8_STAGE(PG8_SA(0, 1), cA + hstep, voffA);
        if (wr == 1) PG8_BAR;
        PG8_WAIT_V(2); PG8_BAR;
        PG8_STAGE(PG8_SB(1, 0), cB + kstep, voffB); PG8_STAGE(PG8_SA(1, 0), cA + kstep, voffA); PG8_STAGE(PG8_SB(1, 1), cB + hstep + kstep, voffB);
        PG8_WAIT_V(6); PG8_BAR;
    } else {
        PG8_STAGE(PG8_SB(0, 0), cB, voffB); PG8_STAGE(PG8_SA(0, 0), cA, voffA); PG8_STAGE(PG8_SB(0, 1), cB + hstep, voffB); PG8_STAGE(PG8_SA(0, 1), cA + hstep, voffA);
        if (wr == 1) PG8_BAR;
        PG8_WAIT_V(4); PG8_BAR;
        PG8_STAGE(PG8_SB(1, 0), cB + kstep, voffB); PG8_STAGE(PG8_SA(1, 0), cA + kstep, voffA); PG8_STAGE(PG8_SB(1, 1), cB + hstep + kstep, voffB);
        PG8_WAIT_V(6); PG8_BAR;
    }
    for (;;) {
        const bool has_next = S.next(ui + 1, nxt);
        const char* nA = has_next ? (const char*)g.A + (size_t)nxt.pm * tstep : cA; const char* nB = has_next ? (const char*)g.Bt + (size_t)nxt.pn * tstep : cB;
        for (int t = 0; t < nt; t += 2) {
            const bool last = (t == nt - 2);
            const char* a1 = cA + (size_t)(t + 1) * kstep;
            const char* a2 = last ? nA : cA + (size_t)(t + 2) * kstep; const char* b2 = last ? nB : cB + (size_t)(t + 2) * kstep;
            const char* a3 = a2 + kstep; const char* b3 = b2 + kstep;
            if (last && has_next) S.a_ready(nxt);
            if constexpr (SP2) {
            PG8_LDB(B0, 0, 0); PG8_LDB(B1, 0, 1); PG8_SCHED; PG8_LDA(At, 0, 0); PG8_STAGE(PG8_SA(1, 1), a1 + hstep, voffA);
            PG8_WAIT_V(8); PG8_WAIT_L(0); PG8_BAR; PG8_MMA(0, 0, At, B0); PG8_MMA(0, 1, At, B1); PG8_BAR; PG8_SCHED;
            PG8_LDA(At, 0, 1); PG8_STAGE(PG8_SB(0, 0), b2, voffB); PG8_STAGE(PG8_SB(0, 1), b2 + hstep, voffB); PG8_STAGE(PG8_SA(0, 0), a2, voffA);
            PG8_WAIT_V(8); PG8_WAIT_L(0); PG8_BAR; PG8_MMA(1, 0, At, B0); PG8_MMA(1, 1, At, B1); PG8_BAR; PG8_SCHED;
            PG8_LDB(B0, 1, 0); PG8_LDB(B1, 1, 1); PG8_SCHED; PG8_LDA(At, 1, 0); PG8_STAGE(PG8_SA(0, 1), a2 + hstep, voffA);
            PG8_WAIT_V(8); PG8_WAIT_L(0); PG8_BAR; PG8_MMA(0, 0, At, B0); PG8_MMA(0, 1, At, B1); PG8_BAR; PG8_SCHED;
            PG8_LDA(At, 1, 1); PG8_STAGE(PG8_SB(1, 0), b3, voffB); PG8_STAGE(PG8_SB(1, 1), b3 + hstep, voffB); PG8_STAGE(PG8_SA(1, 0), a3, voffA);
            PG8_WAIT_V(8); PG8_WAIT_L(0); PG8_BAR; PG8_MMA(1, 0, At, B0); PG8_MMA(1, 1, At, B1); PG8_BAR; PG8_SCHED;
            } else {
            PG8_LDB(B0, 0, 0); PG8_SCHED; PG8_LDA(At, 0, 0); PG8_STAGE(PG8_SA(1, 1), a1 + hstep, voffA);
            PG8_WAIT_L(8); PG8_BAR; PG8_WAIT_L(0); PG8_MMA(0, 0, At, B0); PG8_BAR; PG8_SCHED;
            PG8_LDB(B1, 0, 1); PG8_STAGE(PG8_SB(0, 0), b2, voffB);
            PG8_BAR; PG8_WAIT_L(0); PG8_MMA(0, 1, At, B1); PG8_BAR;
            PG8_LDA(At, 0, 1); PG8_STAGE(PG8_SA(0, 0), a2, voffA);
            PG8_BAR; PG8_WAIT_L(0); PG8_MMA(1, 0, At, B0); PG8_BAR; PG8_SCHED;
            PG8_STAGE(PG8_SB(0, 1), b2 + hstep, voffB);
            PG8_WAIT_V(6); PG8_BAR; PG8_MMA(1, 1, At, B1); PG8_BAR;
            PG8_LDB(B0, 1, 0); PG8_SCHED; PG8_LDA(At, 1, 0); PG8_STAGE(PG8_SA(0, 1), a2 + hstep, voffA);
            PG8_WAIT_L(8); PG8_BAR; PG8_WAIT_L(0); PG8_MMA(0, 0, At, B0); PG8_BAR; PG8_SCHED;
            PG8_LDB(B1, 1, 1); PG8_STAGE(PG8_SB(1, 0), b3, voffB);
            PG8_BAR; PG8_WAIT_L(0); PG8_MMA(0, 1, At, B1); PG8_BAR;
            PG8_LDA(At, 1, 1); PG8_STAGE(PG8_SA(1, 0), a3, voffA);
            PG8_BAR; PG8_WAIT_L(0); PG8_MMA(1, 0, At, B0); PG8_BAR; PG8_SCHED;
            PG8_STAGE(PG8_SB(1, 1), b3 + hstep, voffB);
            PG8_WAIT_V(6); PG8_BAR; PG8_MMA(1, 1, At, B1); PG8_BAR;
            }
        }
        if constexpr (ALIGN_EPI) { if (wr == 0) PG8_BAR; }
        if constexpr (!Epi::AFTER_DRAIN) { E(acc, cur, wr, wc, fr, fq); S.done(cur); }
        if (!has_next) break;
#pragma unroll
        for (int a = 0; a < 2; ++a)
#pragma unroll
            for (int b = 0; b < 2; ++b)
#pragma unroll
                for (int m = 0; m < 4; ++m)
#pragma unroll
                    for (int n = 0; n < 2; ++n) acc[a][b][m][n] = (f32x4){0.f, 0.f, 0.f, 0.f};
        cur = nxt; cA = nA; cB = nB; ++ui;
        if constexpr (ALIGN_EPI) { if (wr == 1) PG8_BAR; }
    }
    PG8_WAIT_V(0);
    if constexpr (!ALIGN_EPI) { if (wr == 0) PG8_BAR; }
    PG8_BAR;
    if constexpr (Epi::AFTER_DRAIN) { E.fused(acc, cur, wr, wc, fr, fq, lds, wid, lane); S.done(cur); }
#undef PG8_SA
#undef PG8_SB
#undef PG8_STAGE
#undef PG8_LDA
#undef PG8_LDB
#undef PG8_MMA
#undef PG8_WAIT_V
#undef PG8_WAIT_L
#undef PG8_BAR
#undef PG8_SCHED
}
}
namespace pg8 {
template <class Epi, class Sched>
__device__ __forceinline__ void gemm_phase_gather(PG8_LAS unsigned char* lds, const Gemm g, const Sched& S, const Epi& E, const int* rmap) {
    constexpr bool ALIGN_EPI = true, SP2 = true;
    const int tid = opaque_tid(), wid = __builtin_amdgcn_readfirstlane(tid >> 6), lane = tid & 63, wr = wid >> 2, wc = wid & 3, fr = lane & 15, fq = lane >> 4;
    const int K = g.K, nt = K / BK;
    unsigned voffB[2];
#pragma unroll
    for (int i = 0; i < 2; ++i) { int R, C; stage_rc(tid * 16 + i * 8192, R, C); const int Rb = Epi::PERM ? ((R & ~31) + perm32(R & 31)) : R;
        voffB[i] = (unsigned)(Rb * K + C) * 2u; }
    const size_t kstep = (size_t)(BK * 2);
    const size_t hstep = (size_t)HALF * K * 2;
    const size_t tstep = 2 * hstep;
    const unsigned ldsw = (unsigned)wid * 1024u;
    const int aoff = lds_byte(wr * 64 + fr, fq * 8), boff = lds_byte(wc * 32 + fr, fq * 8);
#define PG8_SA(b, h) (((b) * 2 + (h)) * HTB)
#define PG8_SB(b, h) ((4 + (b) * 2 + (h)) * HTB)
#define PG8_STAGE(bufoff, gbase, voff) do { _Pragma("unroll") for (int _i = 0; _i < 2; ++_i) \
        __builtin_amdgcn_global_load_lds((const unsigned*)((const char*)(gbase) + (voff)[_i]), (PG8_LAS unsigned*)(lds + (bufoff) + ldsw + _i * 8192), 16, 0, 0); } while (0)
#define PG8_LDA(dst, b, h) do { _Pragma("unroll") for (int m = 0; m < 4; ++m) _Pragma("unroll") for (int k = 0; k < 2; ++k) dst[m][k] = *(const PG8_LAS bf16x8*)(lds + PG8_SA(b, h) + aoff + m * 2048 + k * 1024); } while (0)
#define PG8_LDB(dst, b, h) do { _Pragma("unroll") for (int n = 0; n < 2; ++n) _Pragma("unroll") for (int k = 0; k < 2; ++k) dst[n][k] = *(const PG8_LAS bf16x8*)(lds + PG8_SB(b, h) + boff + n * 2048 + k * 1024); } while (0)
#define PG8_MMA(ai, bj, At, Bt) do { __builtin_amdgcn_s_setprio(1); _Pragma("unroll") for (int m = 0; m < 4; ++m) _Pragma("unroll") for (int n = 0; n < 2; ++n) _Pragma("unroll") for (int k = 0; k < 2; ++k) \
        acc[ai][bj][m][n] = __builtin_amdgcn_mfma_f32_16x16x32_bf16(Bt[n][k], At[m][k], acc[ai][bj][m][n], 0, 0, 0); __builtin_amdgcn_s_setprio(0); } while (0)
#define PG8_WAIT_V(n) asm volatile("s_waitcnt vmcnt(" #n ")" ::: "memory")
#define PG8_WAIT_L(n) asm volatile("s_waitcnt lgkmcnt(" #n ")" ::: "memory")
#define PG8_BAR __builtin_amdgcn_s_barrier()
#define PG8_SCHED __builtin_amdgcn_sched_barrier(0)
    Unit cur, nxt; int ui = 0;
    if (!S.next(0, cur)) return;
    f32x4 acc[2][2][4][2];
#pragma unroll
    for (int a = 0; a < 2; ++a)
#pragma unroll
        for (int b = 0; b < 2; ++b)
#pragma unroll
            for (int m = 0; m < 4; ++m)
#pragma unroll
                for (int n = 0; n < 2; ++n) acc[a][b][m][n] = (f32x4){0.f, 0.f, 0.f, 0.f};
    bf16x8 At[4][2], B0[2][2], B1[2][2];
    const char* gA = (const char*)g.A; const char* cB = (const char*)g.Bt + (size_t)cur.pn * tstep;
    unsigned gofc[2][2];
    constexpr int RM_OFF = 8 * HTB;
#pragma unroll
    for (int i_ = 0; i_ < 2; ++i_) { int R, C; stage_rc(tid * 16 + i_ * 8192, R, C);
#pragma unroll
        for (int h_ = 0; h_ < 2; ++h_) gofc[h_][i_] = (unsigned)rmap[(size_t)cur.pm * BM + h_ * HALF + R] * (unsigned)(K * 2) + (unsigned)C * 2u; }
    S.a_ready(cur);
    if constexpr (SP2) {
        PG8_STAGE(PG8_SB(0, 0), cB, voffB); PG8_STAGE(PG8_SB(0, 1), cB + hstep, voffB); PG8_STAGE(PG8_SA(0, 0), gA, gofc[0]); PG8_STAGE(PG8_SA(0, 1), gA, gofc[1]);
        if (wr == 1) PG8_BAR;
        PG8_WAIT_V(2); PG8_BAR;
        PG8_STAGE(PG8_SB(1, 0), cB + kstep, voffB); PG8_STAGE(PG8_SA(1, 0), gA + kstep, gofc[0]); PG8_STAGE(PG8_SB(1, 1), cB + hstep + kstep, voffB);
        PG8_WAIT_V(6); PG8_BAR;
    }
    for (;;) {
        const bool has_next = S.next(ui + 1, nxt);
        const char* nB = has_next ? (const char*)g.Bt + (size_t)nxt.pn * tstep : cB;
        if (has_next) { const unsigned rmoff = (unsigned)(opaque_tid() & 255) * 4u;
            __builtin_amdgcn_global_load_lds((const unsigned*)((const char*)(rmap + (size_t)nxt.pm * BM) + rmoff), (PG8_LAS unsigned*)(lds + RM_OFF + wid * 256), 4, 0, 0); }
        for (int t = 0; t < nt; t += 2) {
            const bool last = (t == nt - 2);
            const char* a1 = gA + (size_t)(t + 1) * kstep;
            const char* a2 = last ? gA : gA + (size_t)(t + 2) * kstep; const char* b2 = last ? nB : cB + (size_t)(t + 2) * kstep;
            const char* a3 = a2 + kstep; const char* b3 = b2 + kstep;
            if (last && has_next) S.a_ready(nxt);
            if constexpr (SP2) {
            PG8_LDB(B0, 0, 0); PG8_LDB(B1, 0, 1); PG8_SCHED; PG8_LDA(At, 0, 0); PG8_STAGE(PG8_SA(1, 1), a1, gofc[1]);
            PG8_WAIT_V(8); PG8_WAIT_L(0); PG8_BAR; PG8_MMA(0, 0, At, B0); PG8_MMA(0, 1, At, B1); PG8_BAR; PG8_SCHED;
            if (last && has_next) { const int tid2 = opaque_tid();
#pragma unroll
                for (int i_ = 0; i_ < 2; ++i_) { int R, C; stage_rc(tid2 * 16 + i_ * 8192, R, C);
#pragma unroll
                    for (int h_ = 0; h_ < 2; ++h_) gofc[h_][i_] = (unsigned)*(const PG8_LAS int*)(lds + RM_OFF + (h_ * HALF + R) * 4) * (unsigned)(K * 2) + (unsigned)C * 2u; }
                PG8_SCHED; }
            PG8_LDA(At, 0, 1); PG8_STAGE(PG8_SB(0, 0), b2, voffB); PG8_STAGE(PG8_SB(0, 1), b2 + hstep, voffB); PG8_STAGE(PG8_SA(0, 0), a2, gofc[0]);
            PG8_WAIT_V(8); PG8_WAIT_L(0); PG8_BAR; PG8_MMA(1, 0, At, B0); PG8_MMA(1, 1, At, B1); PG8_BAR; PG8_SCHED;
            PG8_LDB(B0, 1, 0); PG8_LDB(B1, 1, 1); PG8_SCHED; PG8_LDA(At, 1, 0); PG8_STAGE(PG8_SA(0, 1), a2, gofc[1]);
            PG8_WAIT_V(8); PG8_WAIT_L(0); PG8_BAR; PG8_MMA(0, 0, At, B0); PG8_MMA(0, 1, At, B1); PG8_BAR; PG8_SCHED;
            PG8_LDA(At, 1, 1); PG8_STAGE(PG8_SB(1, 0), b3, voffB); PG8_STAGE(PG8_SB(1, 1), b3 + hstep, voffB); PG8_STAGE(PG8_SA(1, 0), a3, gofc[0]);
            PG8_WAIT_V(8); PG8_WAIT_L(0); PG8_BAR; PG8_MMA(1, 0, At, B0); PG8_MMA(1, 1, At, B1); PG8_BAR; PG8_SCHED;
            }
        }
        if constexpr (ALIGN_EPI) { if (wr == 0) PG8_BAR; }
        if constexpr (!Epi::AFTER_DRAIN) { const int lane2 = opaque_tid() & 63; E(acc, cur, wr, wc, lane2 & 15, lane2 >> 4); S.done(cur); }
        if (!has_next) break;
#pragma unroll
        for (int a = 0; a < 2; ++a)
#pragma unroll
            for (int b = 0; b < 2; ++b)
#pragma unroll
                for (int m = 0; m < 4; ++m)
#pragma unroll
                    for (int n = 0; n < 2; ++n) acc[a][b][m][n] = (f32x4){0.f, 0.f, 0.f, 0.f};
        cur = nxt; cB = nB; ++ui;
        if constexpr (ALIGN_EPI) { if (wr == 1) PG8_BAR; }
    }
    PG8_WAIT_V(0);
    if constexpr (!ALIGN_EPI) { if (wr == 0) PG8_BAR; }
    PG8_BAR;
    if constexpr (Epi::AFTER_DRAIN) { E.fused(acc, cur, wr, wc, fr, fq, lds, wid, lane); S.done(cur); }
#undef PG8_SA
#undef PG8_SB
#undef PG8_STAGE
#undef PG8_LDA
#undef PG8_LDB
#undef PG8_MMA
#undef PG8_WAIT_V
#undef PG8_WAIT_L
#undef PG8_BAR
#undef PG8_SCHED
}
}
#define XB_TMO      128
#define XB_XCNT(j)  (256  + 64 * (j))
#define XB_XSUB(j)  (1280 + 64 * (j))
#define XB_XGEN(j)  (2304 + 64 * (j))
#define XB_TOP      3328
#define XB_TOPGEN   3392
#define XCD_BAR_WORDS 3456
#define XB_SPIN_CAP (1u << 18)
#define LAS __attribute__((address_space(3)))

__device__ __forceinline__ unsigned xb_ld(unsigned* p)              { return __hip_atomic_load(p, __ATOMIC_RELAXED, __HIP_MEMORY_SCOPE_AGENT); }
__device__ __forceinline__ unsigned xb_add(unsigned* p, unsigned v) { return __hip_atomic_fetch_add(p, v, __ATOMIC_RELAXED, __HIP_MEMORY_SCOPE_AGENT); }
__device__ __forceinline__ unsigned xb_xcc_id() { return (unsigned)__builtin_amdgcn_s_getreg((3 << 11) | 20) & 0xFu; }
#define XB_SPIN(cond, bar) do { unsigned _sp = 0; while (cond) { __builtin_amdgcn_s_sleep(1); \
    if ((++_sp & 255u) == 0u) { if (xb_ld(&(bar)[XB_TMO])) break; if (_sp > XB_SPIN_CAP) { atomicAdd(&(bar)[XB_TMO], 1u); break; } } } } while (0)

struct XcdBarrier {
    unsigned* bar; unsigned x;
    volatile LAS unsigned* st;
};

__device__ __forceinline__ XcdBarrier xcd_barrier_post(unsigned* bar, volatile LAS unsigned* st) {
    XcdBarrier b; b.bar = bar; b.x = xb_xcc_id(); b.st = st;
    if (threadIdx.x == 0) (void)xb_add(&bar[XB_XCNT(b.x)], 1u);
    return b;
}
__device__ __forceinline__ void xcd_barrier_complete(unsigned* bar, unsigned x, unsigned& nloc, unsigned& nx) {
    const unsigned G = gridDim.x * gridDim.y * gridDim.z;
    unsigned sum, cnt, mine, sp = 0u;
    for (;;) {
        sum = 0u; cnt = 0u; mine = 0u;
#pragma unroll
        for (unsigned j = 0; j < 16; ++j) { const unsigned c = xb_ld(&bar[XB_XCNT(j)]); sum += c; cnt += (c > 0u) ? 1u : 0u; mine = (j == x) ? c : mine; }
        if (sum == G) break;
        __builtin_amdgcn_s_sleep(1);
        if ((++sp & 255u) == 0u) { if (xb_ld(&bar[XB_TMO])) break; if (sp > XB_SPIN_CAP) { atomicAdd(&bar[XB_TMO], 1u); break; } }
    }
    nloc = mine > 0u ? mine : 1u; nx = cnt > 0u ? cnt : 1u;
}

__device__ __forceinline__ void xcd_barrier(const XcdBarrier& b) {
    asm volatile("s_waitcnt vmcnt(0)" ::: "memory");
    __syncthreads();
    if (threadIdx.x == 0) {
        unsigned* bar = b.bar;
        __builtin_amdgcn_s_waitcnt(0);
        unsigned nloc = b.st[0], nx = b.st[1];
        if (nloc == 0u) { xcd_barrier_complete(bar, b.x, nloc, nx); b.st[0] = nloc; b.st[1] = nx; }
        const unsigned old = xb_add(&bar[XB_XSUB(b.x)], 1u);
        const unsigned gen = old / nloc;
        if (old + 1u == (gen + 1u) * nloc) {
            __builtin_amdgcn_fence(__ATOMIC_RELEASE, "agent");
            asm volatile("s_waitcnt vmcnt(0)" ::: "memory");
            const unsigned og = xb_add(&bar[XB_TOP], 1u);
            const unsigned tg = og / nx;
            if (og + 1u == (tg + 1u) * nx) xb_add(&bar[XB_TOPGEN], 1u);
            else XB_SPIN(xb_ld(&bar[XB_TOPGEN]) == tg, bar);
            __builtin_amdgcn_fence(__ATOMIC_ACQUIRE, "agent");
            xb_add(&bar[XB_XGEN(b.x)], 1u);
            asm volatile("s_waitcnt vmcnt(0)" ::: "memory");
        } else {
            XB_SPIN(xb_ld(&bar[XB_XGEN(b.x)]) == gen, bar);
            __builtin_amdgcn_fence(__ATOMIC_ACQUIRE, "agent");
            asm volatile("s_waitcnt vmcnt(0)" ::: "memory");
        }
    }
    __syncthreads();
}
__device__ __forceinline__ void p0_transpose_item(const float* W, int ldw, int ncols_valid, int k0, int n0, bf16* WT, size_t dst_row0, int Kdst, LAS float* scr, int lane) {
    const int nn = n0 + (lane & 31); const bool ok = nn < ncols_valid;
#pragma unroll 8
    for (int i = 0; i < 32; ++i) { const int kk = 2 * i + (lane >> 5); scr[kk * 33 + (lane & 31)] = ok ? W[(size_t)(k0 + kk) * ldw + nn] : 0.f; }
    LDS_WAIT();
    const int c = lane & 7;
#pragma unroll
    for (int j = 0; j < 4; ++j) { const int n = (lane >> 3) + 8 * j; const LAS float* s = scr + (8 * c) * 33 + n;
        v4u o; o.x = pk2(s[0 * 33], s[1 * 33]); o.y = pk2(s[2 * 33], s[3 * 33]); o.z = pk2(s[4 * 33], s[5 * 33]); o.w = pk2(s[6 * 33], s[7 * 33]);
        *(v4u*)(WT + (dst_row0 + n) * (size_t)Kdst + k0 + 8 * c) = o; }
    LDS_WAIT();
}
__device__ __forceinline__ void ln_row(v4f (&v)[4], const float* g, const float* b, int lane) {
    float s = 0.f, s2 = 0.f;
#pragma unroll
    for (int j = 0; j < 4; ++j) { s += (v[j].x + v[j].y) + (v[j].z + v[j].w); s2 += (v[j].x * v[j].x + v[j].y * v[j].y) + (v[j].z * v[j].z + v[j].w * v[j].w); }
    s = wave_sum(s); s2 = wave_sum(s2);
    const float mean = s * (1.f / D);
    const float rstd = rsq_(fmaxf(s2 * (1.f / D) - mean * mean, 0.f) + LN_EPS);
#pragma unroll
    for (int j = 0; j < 4; ++j) v[j] = v[j] - mean;
#pragma unroll
    for (int j = 0; j < 4; ++j) { const v4f gg = *(const v4f*)(g + 256 * j + 4 * lane), bb = *(const v4f*)(b + 256 * j + 4 * lane); v[j] = v[j] * rstd * gg + bb; }
}
__device__ PHASE_FN void p0_prologue(const Ctx A, LAS unsigned char* lds, int vcu, int G) {
    const int tid = opaque_tid(), lane = tid & 63, wave = tid >> 6;
    LAS float* scr = (LAS float*)(lds + wave * 16384);
    const int gw = vcu * NWAVES + wave, NGW = G * NWAVES;
    bf16* Win_t = (bf16*)(A.ws + WS_WIN); bf16* Wout_t = (bf16*)(A.ws + WS_WOUT); bf16* W1_t = (bf16*)(A.ws + WS_W1); bf16* W2_t = (bf16*)(A.ws + WS_W2);
    constexpr int I_IN = 2 * 16 * (NINP / 32), I_OUT = 2 * 16 * 32, I_W1 = 64 * 16 * 64, I_W2 = 64 * 16 * 32;
    constexpr int NITEMS = I_IN + I_OUT + I_W1 + I_W2;
    for (int it = gw; it < NITEMS; it += NGW) {
        int r = it;
        if (r < I_IN) { const int l = r / (16 * 112), q = r % (16 * 112), kb = q / 112, nb = q % 112;
            p0_transpose_item(gin(A, 4) + (size_t)l * 1024 * 3560, 3560, 3560, kb * 64, nb * 32, Win_t + (size_t)l * NINP * 1024, (size_t)nb * 32, 1024, scr, lane); continue; }
        r -= I_IN;
        if (r < I_OUT) { const int l = r / 512, q = r % 512, kb = q / 32, nb = q % 32;
            p0_transpose_item(gin(A, 25) + (size_t)l * 1024 * 1024, 1024, 1024, kb * 64, nb * 32, Wout_t + (size_t)l * 1024 * 1024, (size_t)nb * 32, 1024, scr, lane); continue; }
        r -= I_OUT;
        if (r < I_W1) { const int le = r / 1024, q = r % 1024, kb = q / 64, nb = q % 64, n0 = nb * 32;
            const int np = n0 & 1023; const size_t drow = (size_t)256 * (np >> 7) + (n0 >= 1024 ? 128 : 0) + (np & 127);
            p0_transpose_item(gin(A, 30) + (size_t)le * 1024 * 2048, 2048, 2048, kb * 64, n0, W1_t + (size_t)le * 2048 * 1024, drow, 1024, scr, lane); continue; }
        r -= I_W1;
        { const int le = r / 512, q = r % 512, kb = q / 32, nb = q % 32;
            p0_transpose_item(gin(A, 32) + (size_t)le * 1024 * 1024, 1024, 1024, kb * 64, nb * 32, W2_t + (size_t)le * 1024 * 1024, (size_t)nb * 32, 1024, scr, lane); }
    }
    bf16* HB = (bf16*)(A.ws + WS_HB);
    for (int m = gw; m < T; m += NGW) {
        const int b = m / L, i = m - b * L;
        const float* src = (i < NMETA) ? gin(A, 1) + (size_t)i * D : gin(A, 0) + ((size_t)b * SEQ + (i - NMETA)) * D;
        v4f v[4];
#pragma unroll
        for (int j = 0; j < 4; ++j) v[j] = *(const v4f*)(src + 256 * j + 4 * lane);
        ln_row(v, gin(A, 2), gin(A, 3), lane);
#pragma unroll
        for (int j = 0; j < 4; ++j) st_bf4(HB + (size_t)m * D + 256 * j + 4 * lane, v[j]);
    }
}
constexpr int NTK = 2;
__device__ __forceinline__ float softplus_fast(float x) { return x > 15.f ? x : __logf(1.f + __expf(x)); }
__device__ __forceinline__ float tanh_fast(float x) { return 1.f - 2.f * rcp_(1.f + __expf(2.f * x)); }
__device__ __forceinline__ void sincos_red(float ang, float& sn, float& cs) {
    const float k = rintf(ang * 0.15915494309189535f);
    float r = fmaf(-k, 6.28318548202514648f, ang); r = fmaf(-k, -1.7484555e-7f, r);
    sn = __sinf(r); cs = __cosf(r);
}
constexpr int PREP_W = 98304, PREP_SCR = 4096;
__device__ __forceinline__ void prep_load_w(LAS unsigned char* lds, const float* src, int n, int dst_elem, int tid) {
    for (int i = tid * 4; i < n; i += NTHR * 4) { const v4f x = *(const v4f*)(src + i); v2u o; o.x = pk2(x.x, x.y); o.y = pk2(x.z, x.w); *(LAS v2u*)(lds + (size_t)(dst_elem + i) * 2) = o; }
}
__device__ PHASE_FN void prep_phase(const Ctx A, LAS unsigned char* lds, int l, int vcu, int G) {
    const int tid = opaque_tid(), lane = tid & 63, wave = tid >> 6;
    LAS float* scr = (LAS float*)(lds + PREP_W + wave * PREP_SCR);
    const int gw = vcu * NWAVES + wave, NGW = G * NWAVES;
    const bf16* PROJ = (const bf16*)(A.ws + WS_PROJ);
    const int c4 = 4 * lane, hh = lane >> 4, d4 = 4 * (lane & 15);
    const float* mu = gin(A, 5) + l * 960; const float* w0 = gin(A, 6) + l * 256; const float* w2 = gin(A, 7) + l * 64 * 256;
    const float* a0 = gin(A, 8) + l * 256; const float* a2 = gin(A, 9) + l * 64 * 256; const float* g2 = gin(A, 10) + l * 64 * 256;
    const float* k_k = gin(A, 11) + l * 256; const float* k_a = gin(A, 12) + l * 256; const float* r_k = gin(A, 13) + l * 256;
    const float* conv_w = gin(A, 16) + l * 4 * 256; const float* conv_b = gin(A, 17) + l * 256;
    const float* wa = gin(A, 18) + l * 4 * 64 * 64; const float* ba = gin(A, 19) + l * 256; const float* wx = gin(A, 20) + l * 4 * 64 * 64; const float* bx = gin(A, 21) + l * 256;
    const float* lam = gin(A, 22) + l * 256; const float* lbs = gin(A, 23);
    float* RW_W = (float*)(A.ws + WS_RW_W); bf16* RW_A = (bf16*)(A.ws + WS_RW_A); bf16* RW_B = (bf16*)(A.ws + WS_RW_B); bf16* RW_K = (bf16*)(A.ws + WS_RW_K);
    bf16* RW_WR = (bf16*)(A.ws + WS_RW_WR); bf16* RW_V = (bf16*)(A.ws + WS_RW_V); bf16* RW_G = (bf16*)(A.ws + WS_RW_G); float* RW_SC = (float*)(A.ws + WS_RW_SC);
    bf16* DS_Q = (bf16*)(A.ws + WS_DS_Q); bf16* DS_K = (bf16*)(A.ws + WS_DS_K); bf16* DS_V = (bf16*)(A.ws + WS_DS_V); bf16* DS_QI = (bf16*)(A.ws + WS_DS_QI);
    bf16* DS_KI = (bf16*)(A.ws + WS_DS_KI); float* DS_WI = (float*)(A.ws + WS_DS_WI);
    float* LR_A = (float*)(A.ws + WS_LR_A); bf16* LR_U = (bf16*)(A.ws + WS_LR_U); bf16* LR_G = (bf16*)(A.ws + WS_LR_G);
    float* HG_F = (float*)(A.ws + WS_HG_F); bf16* HG_K = (bf16*)(A.ws + WS_HG_K); bf16* HG_Q = (bf16*)(A.ws + WS_HG_Q); bf16* HG_V = (bf16*)(A.ws + WS_HG_V); bf16* HG_G = (bf16*)(A.ws + WS_HG_G);
    LAS unsigned* kmaxl = (LAS unsigned*)(lds + MISC_OFF + 640);
    LAS unsigned* kimaxl = (LAS unsigned*)(lds + MISC_OFF + 832);
    if (tid < 32) kmaxl[tid] = 0u;
    if (tid < 8) kimaxl[tid] = 0u;
    const bool q_rot = (lane & 15) < 4, q_hi = (lane & 15) >= 2;
    const bool i_rot = (lane & 7) < 2, i_hi = (lane & 7) == 1;

#define BF4R(q_) ((v4f){bflo((q_).x), bfhi((q_).x), bflo((q_).y), bfhi((q_).y)})
    {
        constexpr int RC_OFF = 98304;
        static_assert(RC_OFF + 8 * 1024 <= MISC_OFF, "pass R lds");
        for (int f = tid; f < 96 * 64; f += NTHR) { const int ln = f & 63, fr = f >> 6, ks = fr & 1, nt = (fr >> 1) & 15, mat = fr >> 5, rr = ln & 15, g8 = ln >> 4;
            const float* W = (mat == 0 ? w2 : mat == 1 ? a2 : g2) + (32 * ks + 8 * g8) * 256 + 64 * (nt >> 2) + 32 * ((nt >> 1) & 1) + 8 * (rr >> 2) + 4 * (nt & 1) + (rr & 3);
            v4u o; o.x = pk2(W[0], W[256]); o.y = pk2(W[512], W[768]); o.z = pk2(W[1024], W[1280]); o.w = pk2(W[1536], W[1792]);
            *(LAS v4u*)(lds + (size_t)fr * 1024 + ln * 16) = o; }
        LAS float* rc = (LAS float*)(lds + RC_OFF);
        if (tid < 256) { rc[tid] = mu[C_RW_R + tid]; rc[256 + tid] = mu[C_RW_K + tid]; rc[512 + tid] = mu[C_RW_V + tid]; rc[768 + tid] = w0[tid];
            rc[1024 + tid] = a0[tid]; rc[1280 + tid] = k_k[tid]; rc[1536 + tid] = k_a[tid]; rc[1792 + tid] = r_k[tid]; }
        __syncthreads();
        const int r = lane & 15, g = lane >> 4;
        const v4f z4 = (v4f){0.f, 0.f, 0.f, 0.f};
        auto r_tile = [&](const int tile, const int hd_lo, const int hd_hi) {
            const int m0 = tile * 16, b = m0 / L, i = m0 - b * L + r;
            const bf16* rowc = PROJ + (size_t)(m0 + r) * NINP;
            const bool hasp = i > 0; const bf16* rowp = hasp ? rowc - NINP : rowc;
            unsigned tch[4];
#pragma unroll
            for (int q = 0; q < 4; ++q) { const int ln_ = g + 4 * q < 15 ? g + 4 * q : 14; tch[q] = *(const unsigned*)(rowc + 64 * ln_); }
            pg8::bf16x8 Bf[3][2];
#pragma unroll
            for (int mat = 0; mat < 3; ++mat)
#pragma unroll
                for (int ks = 0; ks < 2; ++ks) { const int off = (mat == 0 ? C_RW_WD : mat == 1 ? C_RW_AD : C_RW_GD) + 32 * ks + 8 * g;
                    const v4u cq = *(const v4u*)(rowc + off), pq = *(const v4u*)(rowp + off);
                    const v4f m0v = *(const v4f*)(mu + off), m1v = *(const v4f*)(mu + off + 4);
                    float o8[8];
#pragma unroll
                    for (int e = 0; e < 8; ++e) { const unsigned cw = cq[e >> 1], pw = pq[e >> 1];
                        const float cur = (e & 1) ? bfhi(cw) : bflo(cw), prv = hasp ? ((e & 1) ? bfhi(pw) : bflo(pw)) : 0.f;
                        const float sv = cur + (prv - cur) * (e < 4 ? m0v[e & 3] : m1v[e & 3]);
                        o8[e] = mat == 0 ? tanh_fast(sv) : mat == 1 ? sv : sigmoidf_(sv); }
                    v4u pk; pk.x = pk2(o8[0], o8[1]); pk.y = pk2(o8[2], o8[3]); pk.z = pk2(o8[4], o8[5]); pk.w = pk2(o8[6], o8[7]);
                    Bf[mat][ks] = __builtin_bit_cast(pg8::bf16x8, pk); }
            asm volatile("" :: "v"(tch[0]), "v"(tch[1]), "v"(tch[2]), "v"(tch[3]));
#pragma unroll 1
            for (int hd = hd_lo; hd < hd_hi; ++hd) {
                pg8::f32x4 Cw[4], Ca[4], Cg[4];
#pragma unroll
                for (int nt = 0; nt < 4; ++nt) {
                    const LAS unsigned char* wf = lds + (size_t)((hd * 4 + nt) * 2) * 1024 + lane * 16;
                    pg8::f32x4 cw = (pg8::f32x4){0.f, 0.f, 0.f, 0.f}, ca = cw, cg = cw;
#pragma unroll
                    for (int ks = 0; ks < 2; ++ks) {
                        cw = __builtin_amdgcn_mfma_f32_16x16x32_bf16(*(const LAS pg8::bf16x8*)(wf + ks * 1024), Bf[0][ks], cw, 0, 0, 0);
                        ca = __builtin_amdgcn_mfma_f32_16x16x32_bf16(*(const LAS pg8::bf16x8*)(wf + 32768 + ks * 1024), Bf[1][ks], ca, 0, 0, 0);
                        cg = __builtin_amdgcn_mfma_f32_16x16x32_bf16(*(const LAS pg8::bf16x8*)(wf + 65536 + ks * 1024), Bf[2][ks], cg, 0, 0, 0); }
                    Cw[nt] = cw; Ca[nt] = ca; Cg[nt] = cg;
                }
                const size_t hrow = ((size_t)(b * 4 + hd) * L + i);
                v4f kun[4], kav_[4];
                float n2 = 0.f, sbr = 0.f, skr = 0.f, sbo = 0.f;
                const int cbh = hd * 64 + 8 * g;
                v4u Lr[2], Lk[2], Lv[2], Qr[2], Qk[2], Qv[2]; v2u oK[4], oWR[4], oV[4], oG[4];
#pragma unroll
                for (int h2 = 0; h2 < 2; ++h2) { Lr[h2] = *(const v4u*)(rowc + C_RW_R + cbh + 32 * h2); Lk[h2] = *(const v4u*)(rowc + C_RW_K + cbh + 32 * h2); Lv[h2] = *(const v4u*)(rowc + C_RW_V + cbh + 32 * h2);
                    Qr[h2] = *(const v4u*)(rowp + C_RW_R + cbh + 32 * h2); Qk[h2] = *(const v4u*)(rowp + C_RW_K + cbh + 32 * h2); Qv[h2] = *(const v4u*)(rowp + C_RW_V + cbh + 32 * h2); }
#define PREP_W4(V_, nt_) ((v4f){bflo(V_[(nt_) >> 1][2 * ((nt_) & 1)]), bfhi(V_[(nt_) >> 1][2 * ((nt_) & 1)]), bflo(V_[(nt_) >> 1][2 * ((nt_) & 1) + 1]), bfhi(V_[(nt_) >> 1][2 * ((nt_) & 1) + 1])})
#pragma unroll
                for (int nt = 0; nt < 4; ++nt) {
                    const int cc = cbh + 32 * (nt >> 1) + 4 * (nt & 1), d4h = 8 * g + 32 * (nt >> 1) + 4 * (nt & 1);
                    const v4f cr = PREP_W4(Lr, nt), ck = PREP_W4(Lk, nt), cv = PREP_W4(Lv, nt);
                    const v4f pr = hasp ? PREP_W4(Qr, nt) : z4, pk_ = hasp ? PREP_W4(Qk, nt) : z4, pv = hasp ? PREP_W4(Qv, nt) : z4;
                    const v4f mu_r = *(const LAS v4f*)(rc + cc), mu_k = *(const LAS v4f*)(rc + 256 + cc), mu_v = *(const LAS v4f*)(rc + 512 + cc), w0v = *(const LAS v4f*)(rc + 768 + cc);
                    const v4f a0v = *(const LAS v4f*)(rc + 1024 + cc), kkv = *(const LAS v4f*)(rc + 1280 + cc), kav = *(const LAS v4f*)(rc + 1536 + cc), rkv = *(const LAS v4f*)(rc + 1792 + cc);
                    const v4f rs = cr + (pr - cr) * mu_r, kx = ck + (pk_ - ck) * mu_k, vs = cv + (pv - cv) * mu_v;
                    v4f dec, km, wr, lg;
#pragma unroll
                    for (int e = 0; e < 4; ++e) {
                        const float wv = -softplus_fast(-(w0v[e] + Cw[nt][e])) - 0.5f;
                        dec[e] = __expf(-__expf(wv));
                        const float av = sigmoidf_(a0v[e] + Ca[nt][e]);
                        const float ku = kx[e] * kkv[e]; kun[nt][e] = ku; kav_[nt][e] = ku * av; n2 += ku * ku;
                        km[e] = kx[e] * (1.f + (av - 1.f) * kav[e]);
                        wr[e] = dec[e] * rs[e]; sbr += ku * av * rs[e]; skr += km[e] * rs[e]; sbo += rs[e] * km[e] * rkv[e];
                        lg[e] = Cg[nt][e]; }
                    *(v4f*)(RW_W + hrow * 64 + d4h) = dec;
                    oK[nt].x = pk2(km[0], km[1]); oK[nt].y = pk2(km[2], km[3]); oWR[nt].x = pk2(wr[0], wr[1]); oWR[nt].y = pk2(wr[2], wr[3]);
                    oV[nt].x = pk2(vs[0], vs[1]); oV[nt].y = pk2(vs[2], vs[3]); oG[nt].x = pk2(lg[0], lg[1]); oG[nt].y = pk2(lg[2], lg[3]);
                }
#undef PREP_W4
#pragma unroll
                for (int h2 = 0; h2 < 2; ++h2) { const size_t ho = hrow * 64 + 8 * g + 32 * h2;
                    *(v4u*)(RW_K + ho) = (v4u){oK[2 * h2].x, oK[2 * h2].y, oK[2 * h2 + 1].x, oK[2 * h2 + 1].y}; *(v4u*)(RW_WR + ho) = (v4u){oWR[2 * h2].x, oWR[2 * h2].y, oWR[2 * h2 + 1].x, oWR[2 * h2 + 1].y};
                    *(v4u*)(RW_V + ho) = (v4u){oV[2 * h2].x, oV[2 * h2].y, oV[2 * h2 + 1].x, oV[2 * h2 + 1].y};
                    *(v4u*)(RW_G + (size_t)(m0 + r) * 256 + cbh + 32 * h2) = (v4u){oG[2 * h2].x, oG[2 * h2].y, oG[2 * h2 + 1].x, oG[2 * h2 + 1].y}; }
                n2 += __shfl_xor(n2, 16); n2 += __shfl_xor(n2, 32);
                const float inv = rcp_(fmaxf(sqrtf(n2), 1e-12f));
#pragma unroll
                for (int h2 = 0; h2 < 2; ++h2) { const size_t ho = hrow * 64 + 8 * g + 32 * h2; const v4f a0_ = kun[2 * h2] * (-inv), a1_ = kun[2 * h2 + 1] * (-inv), b0_ = kav_[2 * h2] * inv, b1_ = kav_[2 * h2 + 1] * inv;
                    *(v4u*)(RW_A + ho) = (v4u){pk2(a0_[0], a0_[1]), pk2(a0_[2], a0_[3]), pk2(a1_[0], a1_[1]), pk2(a1_[2], a1_[3])};
                    *(v4u*)(RW_B + ho) = (v4u){pk2(b0_[0], b0_[1]), pk2(b0_[2], b0_[3]), pk2(b1_[0], b1_[1]), pk2(b1_[2], b1_[3])}; }
                sbr *= inv;
                sbr += __shfl_xor(sbr, 16); sbr += __shfl_xor(sbr, 32); skr += __shfl_xor(skr, 16); skr += __shfl_xor(skr, 32); sbo += __shfl_xor(sbo, 16); sbo += __shfl_xor(sbo, 32);
                if (g == 0) *(v4f*)(RW_SC + hrow * 4) = (v4f){sbr, skr, sbo, 0.f};
            }
        };
        const int NT16 = T / 16, nfull = (NT16 / NGW) * NGW;
#pragma unroll 1
        for (int it = gw; it < nfull + (NT16 - nfull) * 4; it += NGW) { const int q = it - nfull; const bool part = q >= 0;
            r_tile(part ? nfull + (q >> 2) : it, part ? (q & 3) : 0, part ? (q & 3) + 1 : 4); }
    }
    __syncthreads();
    {
        constexpr int XT_PITCH = 528, XT_BYTES = 16 * XT_PITCH, XT_OFF = 65536, LCST_OFF = XT_OFF + NWAVES * XT_BYTES;
        static_assert(LCST_OFF + 3 * 1024 <= MISC_OFF, "pass L lds");
        for (int f = tid; f < 64 * 64; f += NTHR) { const int ln = f & 63, fr = f >> 6, ks = fr & 1, nt = (fr >> 1) & 3, hd = (fr >> 3) & 3, mat = fr >> 5, rr = ln & 15, g8 = ln >> 4;
            const float* W = (mat ? wx : wa) + hd * 4096 + (32 * ks + 8 * g8) * 64 + 32 * (nt >> 1) + 8 * (rr >> 2) + 4 * (nt & 1) + (rr & 3);
            v4u o; o.x = pk2(W[0], W[64]); o.y = pk2(W[128], W[192]); o.z = pk2(W[256], W[320]); o.w = pk2(W[384], W[448]);
            *(LAS v4u*)(lds + (size_t)fr * 1024 + ln * 16) = o; }
        LAS float* cst = (LAS float*)(lds + LCST_OFF);
        if (tid < 256) { cst[tid] = ba[tid]; cst[256 + tid] = bx[tid];
            const float xs = -lam[tid], ys = __expf(xs);
            cst[512 + tid] = xs > 15.f ? xs : (ys < 0.01f ? ys * (1.f - ys * (0.5f - ys * 0.33333334f)) : __logf(1.f + ys)); }
        __syncthreads();
        LAS unsigned char* xt = lds + XT_OFF + wave * XT_BYTES;
        const int r = lane & 15, g = lane >> 4;
        const v4f cb = *(const v4f*)(conv_b + c4), cw0 = *(const v4f*)(conv_w + c4), cw1 = *(const v4f*)(conv_w + 256 + c4), cw2 = *(const v4f*)(conv_w + 512 + c4), cw3 = *(const v4f*)(conv_w + 768 + c4);
        auto l_tile = [&](const int tile, const int hd_lo, const int hd_hi) {
            const int m0 = tile * 16, b = m0 / L, i0 = m0 - b * L;
            const bf16* Pq = PROJ + (size_t)m0 * NINP;
            v2u xb[19], gr[16];
#pragma unroll
            for (int q = 0; q < 19; ++q) { const int ro = (i0 + q - 3 >= 0) ? q - 3 : 0; xb[q] = *(const v2u*)(Pq + (ptrdiff_t)ro * NINP + C_LR_X + c4); }
#pragma unroll
            for (int t = 0; t < 16; ++t) gr[t] = *(const v2u*)(Pq + (size_t)t * NINP + C_LR_G + c4);
            const v4f z4 = (v4f){0.f, 0.f, 0.f, 0.f};
            v4f x0 = i0 > 0 ? BF4R(xb[0]) : z4, x1 = i0 > 0 ? BF4R(xb[1]) : z4, x2 = i0 > 0 ? BF4R(xb[2]) : z4;
#pragma unroll
            for (int t = 0; t < 16; ++t) {
                const v4f x3 = BF4R(xb[t + 3]);
                const v4f xc = cb + cw0 * x0 + cw1 * x1 + cw2 * x2 + cw3 * x3;
                v2u o; o.x = pk2(xc.x, xc.y); o.y = pk2(xc.z, xc.w);
                *(LAS v2u*)(xt + t * XT_PITCH + c4 * 2) = o;
                x0 = x1; x1 = x2; x2 = x3;
                const v4f gv = BF4R(gr[t]); v4f gg;
#pragma unroll
                for (int e = 0; e < 4; ++e) { const float tt = 0.7978845608028654f * (gv[e] + 0.044715f * gv[e] * gv[e] * gv[e]); gg[e] = 0.5f * gv[e] * (1.f + tanh_fast(tt)); }
                if (hd_lo == 0) st_bf4(LR_G + (size_t)(m0 + t) * 256 + c4, gg);
            }
            LDS_WAIT();
#pragma unroll 1
            for (int hd = hd_lo; hd < hd_hi; ++hd) {
                const LAS unsigned char* xrow = xt + r * XT_PITCH + hd * 128;
                const pg8::bf16x8 bk0 = *(const LAS pg8::bf16x8*)(xrow + g * 16), bk1 = *(const LAS pg8::bf16x8*)(xrow + 64 + g * 16);
                pg8::f32x4 Ca[4], Cx[4];
#pragma unroll
                for (int nt = 0; nt < 4; ++nt) {
                    const LAS unsigned char* wf = lds + (size_t)((hd * 4 + nt) * 2) * 1024 + lane * 16;
                    const pg8::bf16x8 a0 = *(const LAS pg8::bf16x8*)(wf), a1 = *(const LAS pg8::bf16x8*)(wf + 1024), x0f = *(const LAS pg8::bf16x8*)(wf + 32768), x1f = *(const LAS pg8::bf16x8*)(wf + 32768 + 1024);
                    pg8::f32x4 ca = (pg8::f32x4){0.f, 0.f, 0.f, 0.f}, cx = ca;
                    ca = __builtin_amdgcn_mfma_f32_16x16x32_bf16(a0, bk0, ca, 0, 0, 0); ca = __builtin_amdgcn_mfma_f32_16x16x32_bf16(a1, bk1, ca, 0, 0, 0);
                    cx = __builtin_amdgcn_mfma_f32_16x16x32_bf16(x0f, bk0, cx, 0, 0, 0); cx = __builtin_amdgcn_mfma_f32_16x16x32_bf16(x1f, bk1, cx, 0, 0, 0);
                    Ca[nt] = ca; Cx[nt] = cx;
                }
                v2u oU[4];
#pragma unroll
                for (int nt = 0; nt < 4; ++nt) {
                    const int c0 = hd * 64 + 32 * (nt >> 1) + 8 * g + 4 * (nt & 1);
                    const v4f bav = *(const LAS v4f*)(cst + c0), bxv = *(const LAS v4f*)(cst + 256 + c0), spl = *(const LAS v4f*)(cst + 512 + c0);
                    const v2u xq = *(const LAS v2u*)(xt + r * XT_PITCH + c0 * 2); const v4f xc = BF4R(xq);
                    v4f aa, uu;
#pragma unroll
                    for (int e = 0; e < 4; ++e) { const float rg = sigmoidf_(Ca[nt][e] + bav[e]), ig = sigmoidf_(Cx[nt][e] + bxv[e]);
                        const float la = -8.f * rg * spl[e]; aa[e] = __expf(la);
                        const float x2l = 2.f * la; const float om = (x2l > -0.1f) ? -(x2l * (1.f + x2l * (0.5f + x2l * (0.16666667f + x2l * 0.041666668f)))) : (1.f - __expf(x2l));
                        uu[e] = xc[e] * ig * __builtin_amdgcn_sqrtf(om); }
                    const size_t mo = (size_t)(m0 + r) * 256 + c0;
                    *(v4f*)(LR_A + mo) = aa; oU[nt].x = pk2(uu[0], uu[1]); oU[nt].y = pk2(uu[2], uu[3]);
                }
#pragma unroll
                for (int h2 = 0; h2 < 2; ++h2) *(v4u*)(LR_U + (size_t)(m0 + r) * 256 + hd * 64 + 8 * g + 32 * h2) = (v4u){oU[2 * h2].x, oU[2 * h2].y, oU[2 * h2 + 1].x, oU[2 * h2 + 1].y};
            }
        };
        const int NT16 = T / 16, nfull = (NT16 / NGW) * NGW;
#pragma unroll 1
        for (int it = gw; it < nfull + (NT16 - nfull) * 4; it += NGW) { const int q = it - nfull; const bool part = q >= 0;
            l_tile(part ? nfull + (q >> 2) : it, part ? (q & 3) : 0, part ? (q & 3) + 1 : 4); }
    }
    {
        float invf_q[4], invf_i[4];
#pragma unroll
        for (int e = 0; e < 4; ++e) { invf_q[e] = exp2f(-(float)((d4 + e) & 7) * (18.931568569324174f / 8.f)); invf_i[e] = exp2f(-(float)e * (18.931568569324174f / 4.f)); }
        v4f lb = (v4f){0.f, 0.f, 0.f, 0.f};
        if (l == 1) { const v4f x0 = *(const v4f*)(lbs + c4), x1 = *(const v4f*)(lbs + 256 + c4);
            lb.x = 1.f / (1.f + __expf(x0.x - x1.x)); lb.y = 1.f / (1.f + __expf(x0.y - x1.y)); lb.z = 1.f / (1.f + __expf(x0.z - x1.z)); lb.w = 1.f / (1.f + __expf(x0.w - x1.w)); }
#pragma unroll 2
        for (int m = gw; m < T; m += NGW) {
            const int b = m / L, i = m - b * L; const float pos = (float)i;
            const bf16* Pj = PROJ + (size_t)m * NINP;
            v4f q = ld_bf4(Pj + C_DS_Q + c4), k = ld_bf4(Pj + C_DS_K + c4);
            const v4f v = ld_bf4(Pj + C_DS_V + c4);
            v4f qi = ld_bf4(Pj + C_DS_QI + c4), ki = ld_bf4(Pj + C_DS_KI + 4 * (lane & 7));
            const v4f hq = ld_bf4(Pj + C_HG_Q + c4), z = ld_bf4(Pj + C_HG_F + c4), vi = ld_bf4(Pj + C_HG_I + c4), hgt = ld_bf4(Pj + C_HG_G + c4);
#pragma unroll
            for (int e = 0; e < 4; ++e) {
                const float qp = __shfl_xor(q[e], 2), kp = __shfl_xor(k[e], 2), qip = __shfl_xor(qi[e], 1), kip = __shfl_xor(ki[e], 1);
                float sn, cs; sincos_red(pos * invf_q[e], sn, cs);
                if (q_rot) { q[e] = q_hi ? (qp * sn + q[e] * cs) : (q[e] * cs - qp * sn); k[e] = q_hi ? (kp * sn + k[e] * cs) : (k[e] * cs - kp * sn); }
                sincos_red(pos * invf_i[e], sn, cs);
                if (i_rot) { qi[e] = i_hi ? (qip * sn + qi[e] * cs) : (qi[e] * cs - qip * sn); ki[e] = i_hi ? (kip * sn + ki[e] * cs) : (ki[e] * cs - kip * sn); }
            }
            { float kn2 = sum16(k.x * k.x + k.y * k.y + k.z * k.z + k.w * k.w); if ((lane & 15) == 0) __hip_atomic_fetch_max(kmaxl + b * 4 + hh, __float_as_uint(kn2 * 1.02f), __ATOMIC_RELAXED, __HIP_MEMORY_SCOPE_WORKGROUP); }
            st_bf4(DS_Q + (size_t)m * 256 + c4, q * (0.125f * 1.4426950408889634f));      st_bf4(DS_K + (size_t)m * 256 + c4, k); st_bf4(DS_V + (size_t)m * 256 + c4, v); st_bf4(DS_QI + (size_t)m * 256 + c4, qi);
            { float in2 = sum8(ki.x * ki.x + ki.y * ki.y + ki.z * ki.z + ki.w * ki.w); if (lane == 0) __hip_atomic_fetch_max(kimaxl + b, __float_as_uint(in2 * 1.02f), __ATOMIC_RELAXED, __HIP_MEMORY_SCOPE_WORKGROUP); }
            if (lane < 8) { st_bf4(DS_KI + (size_t)m * 32 + 4 * lane, ki); DS_WI[(size_t)m * 8 + lane] = bf2f(Pj[C_DS_WI + lane]) * 0.0625f; }
            v4f qs, f, kq, gs;
#pragma unroll
            for (int e = 0; e < 4; ++e) { const float sg = sigmoidf_(z[e]); qs[e] = hq[e] * sigmoidf_(hq[e]); f[e] = lb[e] + (1.f - lb[e]) * sg; kq[e] = (1.f - lb[e]) * (1.f - sg); gs[e] = hgt[e] * sigmoidf_(hgt[e]); }
            const size_t hm = ((size_t)(b * 4 + hh) * L + i) * 64 + d4;
            *(v4f*)(HG_F + hm) = f; st_bf4(HG_K + hm, kq); st_bf4(HG_Q + hm, qs); st_bf4(HG_V + hm, vi); st_bf4(HG_G + (size_t)m * 256 + c4, gs);
        }
    }
    __syncthreads();
    if (tid < 32) atomicMax((unsigned*)(A.ws + WS_CTL) + 8960 + 64 * l + tid, kmaxl[tid]);
    if (tid < 8) atomicMax((unsigned*)(A.ws + WS_CTL) + 9216 + 64 * l + tid, kimaxl[tid]);
}
constexpr int SC_C = 32;
constexpr size_t WS_YRAW = WS_PROJ;
constexpr size_t WS_ORAW = WS_PROJ + (size_t)T * 1024;
__device__ PHASE_FN void rwkv_scan(const Ctx A, LAS unsigned char* lds, int unit_) {
    const int unit = opaque_s(unit_);
    const int tid = opaque_tid(), row = tid >> 4, kp = tid & 15;
    const int bh = unit >> 1, half = unit & 1, b = bh >> 2, h = bh & 3;
    const size_t base = (size_t)bh * L * 64;
    const float* W = (const float*)(A.ws + WS_RW_W) + base;
    const bf16* Av = (const bf16*)(A.ws + WS_RW_A) + base; const bf16* Bv = (const bf16*)(A.ws + WS_RW_B) + base; const bf16* Kv = (const bf16*)(A.ws + WS_RW_K) + base;
    const bf16* WRv = (const bf16*)(A.ws + WS_RW_WR) + base; const bf16* Vv = (const bf16*)(A.ws + WS_RW_V) + base + half * 32;
    const float* SC = (const float*)(A.ws + WS_RW_SC) + (size_t)bh * L * 4;
    float* YR = (float*)(A.ws + WS_YRAW) + (size_t)b * L * 256 + h * 64 + half * 32;
    constexpr int ARR = SC_C * 64;
    constexpr int BUF = (5 * ARR + SC_C * 32 + SC_C * 4) * 4;
    LAS float* ybuf = (LAS float*)(lds + 2 * BUF);
    float S0 = 0.f, S1 = 0.f, S2 = 0.f, S3 = 0.f;
    v4f rw; v2u ra, rb, rk, rwr, rv; float rsc = 0.f;
    const int e4 = tid * 4;
#define RW_LOAD(c) do { const int t0_ = (c) * SC_C; const bool ok_ = (t0_ + (e4 >> 6)) < L; const size_t o_ = (size_t)t0_ * 64 + e4; \
        rw = ok_ ? *(const v4f*)(W + o_) : (v4f){1.f, 1.f, 1.f, 1.f}; ra = ok_ ? *(const v2u*)(Av + o_) : (v2u){0u, 0u}; rb = ok_ ? *(const v2u*)(Bv + o_) : (v2u){0u, 0u}; \
        rk = ok_ ? *(const v2u*)(Kv + o_) : (v2u){0u, 0u}; rwr = ok_ ? *(const v2u*)(WRv + o_) : (v2u){0u, 0u}; \
        if (tid < SC_C * 8) rv = (t0_ + (tid >> 3)) < L ? *(const v2u*)(Vv + (size_t)(t0_ + (tid >> 3)) * 64 + (tid & 7) * 4) : (v2u){0u, 0u}; \
        if (tid < SC_C * 4) rsc = (t0_ + (tid >> 2)) < L ? SC[(size_t)t0_ * 4 + tid] : 0.f; } while (0)
#define RW_STORE(p) do { LAS float* d_ = (LAS float*)(lds + (p) * BUF); \
        *(LAS v4f*)(d_ + e4) = rw; *(LAS v4f*)(d_ + ARR + e4) = (v4f){bflo(ra.x), bfhi(ra.x), bflo(ra.y), bfhi(ra.y)}; *(LAS v4f*)(d_ + 2 * ARR + e4) = (v4f){bflo(rb.x), bfhi(rb.x), bflo(rb.y), bfhi(rb.y)}; \
        *(LAS v4f*)(d_ + 3 * ARR + e4) = (v4f){bflo(rk.x), bfhi(rk.x), bflo(rk.y), bfhi(rk.y)}; *(LAS v4f*)(d_ + 4 * ARR + e4) = (v4f){bflo(rwr.x), bfhi(rwr.x), bflo(rwr.y), bfhi(rwr.y)}; \
        if (tid < SC_C * 8) *(LAS v4f*)(d_ + 5 * ARR + tid * 4) = (v4f){bflo(rv.x), bfhi(rv.x), bflo(rv.y), bfhi(rv.y)}; if (tid < SC_C * 4) d_[5 * ARR + SC_C * 32 + tid] = rsc; } while (0)
    constexpr int NCH = (L + SC_C - 1) / SC_C;
    RW_LOAD(0); RW_STORE(0); __syncthreads();
#pragma unroll 1
    for (int c = 0; c < NCH; ++c) {
        const int p = c & 1;
        if (c + 1 < NCH) RW_LOAD(c + 1);
        const int ns = (L - c * SC_C) < SC_C ? (L - c * SC_C) : SC_C;
        const LAS float* d = (const LAS float*)(lds + p * BUF);
        const LAS float* q = d + kp * 4; const LAS float* dv = d + 5 * ARR + row; const LAS float* dsc = d + 5 * ARR + SC_C * 32;
        v4f w4 = *(const LAS v4f*)(q), a4 = *(const LAS v4f*)(q + ARR), b4 = *(const LAS v4f*)(q + 2 * ARR), k4 = *(const LAS v4f*)(q + 3 * ARR), r4 = *(const LAS v4f*)(q + 4 * ARR);
        float vv = dv[0]; v2f sc = *(const LAS v2f*)(dsc);
#pragma unroll 2
        for (int s = 0; s < ns; ++s) {
            const int sn = (s + 1 < SC_C) ? s + 1 : s;
            const v4f nw4 = *(const LAS v4f*)(q + sn * 64), na4 = *(const LAS v4f*)(q + ARR + sn * 64), nb4 = *(const LAS v4f*)(q + 2 * ARR + sn * 64);
            const v4f nk4 = *(const LAS v4f*)(q + 3 * ARR + sn * 64), nr4 = *(const LAS v4f*)(q + 4 * ARR + sn * 64);
            const float nvv = dv[sn * 32]; const v2f nsc = *(const LAS v2f*)(dsc + sn * 4);
            float sa = (S0 * a4.x + S1 * a4.y) + (S2 * a4.z + S3 * a4.w), y1 = (S0 * r4.x + S1 * r4.y) + (S2 * r4.z + S3 * r4.w);
            sa = sum16(sa); y1 = sum16(y1);
            S0 = S0 * w4.x + sa * b4.x + vv * k4.x; S1 = S1 * w4.y + sa * b4.y + vv * k4.y; S2 = S2 * w4.z + sa * b4.z + vv * k4.z; S3 = S3 * w4.w + sa * b4.w + vv * k4.w;
            const float yo = y1 + sa * sc.x + vv * sc.y;
            if (kp == 0) ybuf[s * 32 + row] = yo;
            w4 = nw4; a4 = na4; b4 = nb4; k4 = nk4; r4 = nr4; vv = nvv; sc = nsc;
        }
        __syncthreads();
        { const int s = tid >> 4, r2 = (tid & 15) * 2;
          if (s < ns) *(v2f*)(YR + (size_t)(c * SC_C + s) * 256 + r2) = *(const LAS v2f*)(ybuf + s * 32 + r2); }
        if (c + 1 < NCH) RW_STORE(1 - p);
        __syncthreads();
    }
#undef RW_LOAD
#undef RW_STORE
}
__device__ PHASE_FN void hgrn_scan(const Ctx A, LAS unsigned char* lds, int unit_) {
    const int unit = opaque_s(unit_);
    const int tid = opaque_tid(), row = tid >> 4, kp = tid & 15;
    const int bh = unit >> 1, half = unit & 1, b = bh >> 2, h = bh & 3;
    const size_t base = (size_t)bh * L * 64;
    const float* Fv = (const float*)(A.ws + WS_HG_F) + base;
    const bf16* Kv = (const bf16*)(A.ws + WS_HG_K) + base; const bf16* Qv = (const bf16*)(A.ws + WS_HG_Q) + base; const bf16* Vv = (const bf16*)(A.ws + WS_HG_V) + base + half * 32;
    float* OR = (float*)(A.ws + WS_ORAW) + (size_t)b * L * 256 + h * 64 + half * 32;
    constexpr int ARR = SC_C * 64; constexpr int BUF = (3 * ARR + SC_C * 32) * 4;
    LAS float* obuf = (LAS float*)(lds + 2 * BUF);
    float S0 = 0.f, S1 = 0.f, S2 = 0.f, S3 = 0.f;
    v4f rf; v2u rk, rq, rv;
    const int e4 = tid * 4;
#define HG_LOAD(c) do { const int t0_ = (c) * SC_C; const bool ok_ = (t0_ + (e4 >> 6)) < L; const size_t o_ = (size_t)t0_ * 64 + e4; \
        rf = ok_ ? *(const v4f*)(Fv + o_) : (v4f){1.f, 1.f, 1.f, 1.f}; rk = ok_ ? *(const v2u*)(Kv + o_) : (v2u){0u, 0u}; rq = ok_ ? *(const v2u*)(Qv + o_) : (v2u){0u, 0u}; \
        if (tid < SC_C * 8) rv = (t0_ + (tid >> 3)) < L ? *(const v2u*)(Vv + (size_t)(t0_ + (tid >> 3)) * 64 + (tid & 7) * 4) : (v2u){0u, 0u}; } while (0)
#define HG_STORE(p) do { LAS float* d_ = (LAS float*)(lds + (p) * BUF); \
        *(LAS v4f*)(d_ + e4) = rf; *(LAS v4f*)(d_ + ARR + e4) = (v4f){bflo(rk.x), bfhi(rk.x), bflo(rk.y), bfhi(rk.y)}; \
        *(LAS v4f*)(d_ + 2 * ARR + e4) = (v4f){bflo(rq.x), bfhi(rq.x), bflo(rq.y), bfhi(rq.y)}; \
        if (tid < SC_C * 8) *(LAS v4f*)(d_ + 3 * ARR + tid * 4) = (v4f){bflo(rv.x), bfhi(rv.x), bflo(rv.y), bfhi(rv.y)}; } while (0)
    constexpr int NCH = (L + SC_C - 1) / SC_C;
    HG_LOAD(0); HG_STORE(0); __syncthreads();
#pragma unroll 1
    for (int c = 0; c < NCH; ++c) {
        const int p = c & 1;
        if (c + 1 < NCH) HG_LOAD(c + 1);
        const int ns = (L - c * SC_C) < SC_C ? (L - c * SC_C) : SC_C;
        const LAS float* d = (const LAS float*)(lds + p * BUF);
        const LAS float* q = d + kp * 4; const LAS float* dv = d + 3 * ARR + row;
        v4f f4 = *(const LAS v4f*)(q), k4 = *(const LAS v4f*)(q + ARR), q4 = *(const LAS v4f*)(q + 2 * ARR); float vv = dv[0];
#pragma unroll 2
        for (int s = 0; s < ns; ++s) {
            const int sn = (s + 1 < SC_C) ? s + 1 : s;
            const v4f nf4 = *(const LAS v4f*)(q + sn * 64), nk4 = *(const LAS v4f*)(q + ARR + sn * 64), nq4 = *(const LAS v4f*)(q + 2 * ARR + sn * 64);
            const float nvv = dv[sn * 32];
            S0 = S0 * f4.x + k4.x * vv; S1 = S1 * f4.y + k4.y * vv; S2 = S2 * f4.z + k4.z * vv; S3 = S3 * f4.w + k4.w * vv;
            float o = (q4.x * S0 + q4.y * S1) + (q4.z * S2 + q4.w * S3);
            o = sum16(o);
            if (kp == 0) obuf[s * 32 + row] = o;
            f4 = nf4; k4 = nk4; q4 = nq4; vv = nvv;
        }
        __syncthreads();
        { const int s = tid >> 4, r2 = (tid & 15) * 2;
          if (s < ns) *(v2f*)(OR + (size_t)(c * SC_C + s) * 256 + r2) = *(const LAS v2f*)(obuf + s * 32 + r2); }
        if (c + 1 < NCH) HG_STORE(1 - p);
        __syncthreads();
    }
#undef HG_LOAD
#undef HG_STORE
}
__device__ PHASE_FN void mixers_finish(const Ctx A, int l, int vcu, int G) {
    const int tid = opaque_tid(), lane = tid & 63, wave = tid >> 6;
    const int gw = vcu * NWAVES + wave, NGW = G * NWAVES;
    const int c4 = 4 * lane, hh = lane >> 4, d4 = 4 * (lane & 15);
    const float* YR = (const float*)(A.ws + WS_YRAW); const float* OR = (const float*)(A.ws + WS_ORAW);
    const bf16* RV = (const bf16*)(A.ws + WS_RW_V); const float* SC = (const float*)(A.ws + WS_RW_SC); const bf16* RG = (const bf16*)(A.ws + WS_RW_G); const bf16* HGt = (const bf16*)(A.ws + WS_HG_G);
    bf16* MIX = (bf16*)(A.ws + WS_MIX);
    const v4f lg = *(const v4f*)(gin(A, 14) + l * 256 + c4), lb = *(const v4f*)(gin(A, 15) + l * 256 + c4), ng = *(const v4f*)(gin(A, 24) + l * 256 + c4);
#pragma unroll 2
    for (int m = gw; m < T; m += NGW) {
        const int b = m / L, i = m - b * L; const size_t hm = ((size_t)(b * 4 + hh) * L + i);
        const v4f y = *(const v4f*)(YR + (size_t)m * 256 + c4), o = *(const v4f*)(OR + (size_t)m * 256 + c4);
        const v4f vv = ld_bf4(RV + hm * 64 + d4), g = ld_bf4(RG + (size_t)m * 256 + c4), hg = ld_bf4(HGt + (size_t)m * 256 + c4);
        const float bonus = SC[hm * 4 + 2];
        const float mean = sum16((y.x + y.y) + (y.z + y.w)) * (1.f / 64.f); const v4f dy = y - mean;
        const float var = sum16((dy.x * dy.x + dy.y * dy.y) + (dy.z * dy.z + dy.w * dy.w)) * (1.f / 64.f);
        const v4f yn = (dy * rsqrtf(var + 64e-5f) * lg + lb + vv * bonus) * g;
        st_bf4(MIX + (size_t)m * 1024 + c4, yn);
        const float ms = sum16((o.x * o.x + o.y * o.y) + (o.z * o.z + o.w * o.w)) * (1.f / 64.f);
        st_bf4(MIX + (size_t)m * 1024 + 768 + c4, o * rsqrtf(ms + 1e-5f) * ng * hg);
    }
}
constexpr int LR_SEG = 64, LR_NSEG = (L + LR_SEG - 1) / LR_SEG;
constexpr size_t WS_LR_AGG = 2032 * MiB;
constexpr size_t WS_LR_CARRY = WS_LR_AGG + 3 * MiB;
static_assert(WS_LR_CARRY + (size_t)NB * LR_NSEG * 256 * 4 <= WS_END, "lru aggregates");
__device__ PHASE_FN void lru_agg_phase(const Ctx A, int vcu, int G) {
    const int tid = opaque_tid(), lane = tid & 63, wave = tid >> 6;
    const int gw = vcu * NWAVES + wave, NGW = G * NWAVES;
    const float* LA = (const float*)(A.ws + WS_LR_A); const bf16* LU = (const bf16*)(A.ws + WS_LR_U); v2f* AGG = (v2f*)(A.ws + WS_LR_AGG);
#pragma unroll 1
    for (int it = gw; it < NB * LR_NSEG * 4; it += NGW) {
        const int cg = it & 3, q = it >> 2; const bool tail_ = q >= NB * (LR_NSEG - 1);
        const int b = tail_ ? q - NB * (LR_NSEG - 1) : q / (LR_NSEG - 1), sg = tail_ ? LR_NSEG - 1 : q - b * (LR_NSEG - 1), ch = cg * 64 + lane;
        const int t0 = sg * LR_SEG, ns = (L - t0) < LR_SEG ? (L - t0) : LR_SEG;
        const size_t m0 = (size_t)b * L + t0;
        float Ap = 1.f, Hl = 0.f;
#pragma unroll 1
        for (int i = 0; i < ns; i += 16) {
            float a[16], u[16];
#pragma unroll
            for (int j = 0; j < 16; ++j) { a[j] = LA[(m0 + i + j) * 256 + ch]; u[j] = bf2f(LU[(m0 + i + j) * 256 + ch]); }
#pragma unroll
            for (int j = 0; j < 16; ++j) { Hl = a[j] * Hl + u[j]; Ap *= a[j]; }
        }
        AGG[((size_t)b * LR_NSEG + sg) * 256 + ch] = (v2f){Ap, Hl};
    }
}
__device__ PHASE_FN void lru_carry_phase(const Ctx A, int first) {
    const int tid = opaque_tid(), lane = tid & 63, wave = tid >> 6;
    const int w = (opaque_s((int)blockIdx.x) - first) * NWAVES + wave;
    const int b = w >> 2, ch = (w & 3) * 64 + lane;
    const v2f* ag = (const v2f*)(A.ws + WS_LR_AGG) + (size_t)b * LR_NSEG * 256 + ch;
    float* CR = (float*)(A.ws + WS_LR_CARRY) + (size_t)b * LR_NSEG * 256 + ch;
    float hc = 0.f;
#pragma unroll 1
    for (int s0 = 0; s0 < LR_NSEG; s0 += 16) {
        v2f x[16];
#pragma unroll
        for (int j = 0; j < 16; ++j) { const int s = s0 + j < LR_NSEG ? s0 + j : LR_NSEG - 1; x[j] = ag[(size_t)s * 256]; }
#pragma unroll
        for (int j = 0; j < 16; ++j) if (s0 + j < LR_NSEG) { CR[(size_t)(s0 + j) * 256] = hc; hc = x[j].x * hc + x[j].y; }
    }
}
__device__ PHASE_FN void lru_out_phase(const Ctx A, int vcu, int G) {
    const int tid = opaque_tid(), lane = tid & 63, wave = tid >> 6;
    const int gw = vcu * NWAVES + wave, NGW = G * NWAVES;
    const float* LA = (const float*)(A.ws + WS_LR_A); const bf16* LU = (const bf16*)(A.ws + WS_LR_U); const bf16* LG = (const bf16*)(A.ws + WS_LR_G);
    const float* CR = (const float*)(A.ws + WS_LR_CARRY); bf16* MIX = (bf16*)(A.ws + WS_MIX);
#pragma unroll 1
    for (int it = gw; it < NB * LR_NSEG * 4; it += NGW) {
        const int cg = it & 3, q = it >> 2; const bool tail_ = q >= NB * (LR_NSEG - 1);
        const int b = tail_ ? q - NB * (LR_NSEG - 1) : q / (LR_NSEG - 1), sg = tail_ ? LR_NSEG - 1 : q - b * (LR_NSEG - 1), ch = cg * 64 + lane;
        const int t0 = sg * LR_SEG, ns = (L - t0) < LR_SEG ? (L - t0) : LR_SEG;
        const size_t m0 = (size_t)b * L + t0;
        float hc = CR[((size_t)b * LR_NSEG + sg) * 256 + ch];
#pragma unroll 1
        for (int i = 0; i < ns; i += 16) {
            float a[16], u[16], g[16];
#pragma unroll
            for (int j = 0; j < 16; ++j) { a[j] = LA[(m0 + i + j) * 256 + ch]; u[j] = bf2f(LU[(m0 + i + j) * 256 + ch]); g[j] = bf2f(LG[(m0 + i + j) * 256 + ch]); }
#pragma unroll
            for (int j = 0; j < 16; ++j) { hc = a[j] * hc + u[j]; MIX[(m0 + i + j) * 1024 + 512 + ch] = f2bf(hc * g[j]); }
        }
    }
}
static_assert(L % 16 == 0, "lru step groups");
constexpr int DSA_WBYTES = 34944;
constexpr int DSA_NW = 4;
__device__ __forceinline__ unsigned fkey(float f) { const unsigned u = __float_as_uint(f); return (u & 0x80000000u) ? ~u : (u | 0x80000000u); }
__device__ __forceinline__ void dsa_query(const Ctx A, LAS unsigned char* wl, int b, int i, int lane) {
    const bf16* DQ = (const bf16*)(A.ws + WS_DS_Q); const bf16* DK = (const bf16*)(A.ws + WS_DS_K); const bf16* DV = (const bf16*)(A.ws + WS_DS_V);
    const bf16* DQI = (const bf16*)(A.ws + WS_DS_QI); const bf16* DKI = (const bf16*)(A.ws + WS_DS_KI); const float* DWI = (const float*)(A.ws + WS_DS_WI);
    bf16* MIX = (bf16*)(A.ws + WS_HB);
    LAS unsigned* keys = (LAS unsigned*)wl; LAS float* qv = (LAS float*)(wl + 32896); LAS int* sel = (LAS int*)(wl + 32896 + 1024);
    const size_t m = (size_t)b * L + i, mb = (size_t)b * L;
    const int n = i + 1;
    LAS float* wil = (LAS float*)(wl + 32832);
    { const v4f q4 = ld_bf4(DQI + m * 256 + 4 * lane); *(LAS v4f*)(qv + 4 * lane) = q4; if (lane < 8) wil[lane] = DWI[m * 8 + lane]; }
    LDS_WAIT();
    for (int s = lane; s < n; s += 64) {
        const v4u* kp = (const v4u*)(DKI + (mb + s) * 32);
        float kf[32];
#pragma unroll
        for (int c = 0; c < 4; ++c) { const v4u x = kp[c]; kf[8 * c + 0] = bflo(x.x); kf[8 * c + 1] = bfhi(x.x); kf[8 * c + 2] = bflo(x.y); kf[8 * c + 3] = bfhi(x.y); kf[8 * c + 4] = bflo(x.z); kf[8 * c + 5] = bfhi(x.z); kf[8 * c + 6] = bflo(x.w); kf[8 * c + 7] = bfhi(x.w); }
        float sc = 0.f;
#pragma unroll 1
        for (int hx = 0; hx < 8; ++hx) { float dt = 0.f;
#pragma unroll
            for (int c = 0; c < 8; ++c) { const v4f q4 = *(const LAS v4f*)(qv + hx * 32 + 4 * c); dt += q4.x * kf[4 * c] + q4.y * kf[4 * c + 1] + q4.z * kf[4 * c + 2] + q4.w * kf[4 * c + 3]; }
            sc += wil[hx] * fmaxf(dt, 0.f); }
        keys[s] = fkey(sc);
    }
    LDS_WAIT();
    unsigned thr = 0u; int need = 0;
    if (n > 256) {
        unsigned prefix = 0u; need = 256;
#pragma unroll 1
        for (int shift = 28; shift >= 0; shift -= 4) {
            unsigned long long lo = 0ull, hi = 0ull;
            const unsigned himask = (shift == 28) ? 0u : (0xFFFFFFFFu << (shift + 4));
            for (int s = lane; s < n; s += 64) { const unsigned k = keys[s];
                if ((k & himask) == prefix) { const unsigned dg = (k >> shift) & 15u; const unsigned long long inc = 1ull << ((dg & 7u) * 8u); if (dg < 8u) lo += inc; else hi += inc; } }
            int cum = 0; unsigned dsel = 0u; int below = 0; bool found = false;
#pragma unroll
            for (int dg = 15; dg >= 0; --dg) {
                const unsigned mine = (unsigned)(((dg < 8 ? lo : hi) >> ((dg & 7) * 8)) & 0xFFull);
                int tot = (int)mine;
#pragma unroll
                for (int o = 1; o < 64; o <<= 1) tot += __shfl_xor(tot, o);
                if (!found && cum + tot >= need) { found = true; dsel = (unsigned)dg; below = cum; }
                cum += tot;
            }
            prefix |= dsel << shift; need -= below;
        }
        thr = prefix;
    }
    int cnt = 0;
    if (n <= 256) { for (int s = lane; s < n; s += 64) sel[s] = s; cnt = n; }
    else {
        int eq_taken = 0;
        for (int s0 = 0; s0 < n; s0 += 64) { const int s = s0 + lane; const unsigned k = (s < n) ? keys[s] : 0u; const bool in = s < n;
            const bool gt = in && (k > thr), eq = in && (k == thr);
            const unsigned long long meq = __ballot(eq); const int eq_before = __popcll(meq & ((1ull << lane) - 1ull));
            const bool take = gt || (eq && (eq_taken + eq_before) < need);
            const unsigned long long mt = __ballot(take); const int pos = cnt + __popcll(mt & ((1ull << lane) - 1ull));
            if (take && pos < 256) sel[pos] = s;
            cnt += __popcll(mt); eq_taken += __popcll(meq);
        }
        if (cnt > 256) cnt = 256;
    }
    LDS_WAIT();
    LAS float* pbuf = (LAS float*)wl;
    for (int h = 0; h < 4; ++h) {
        { const float qx = bf2f(DQ[m * 256 + h * 64 + lane]); qv[lane] = qx * 0.125f; }
        LDS_WAIT();
        float sj[4]; float mx = -3.0e38f;
#pragma unroll
        for (int r = 0; r < 4; ++r) { const int j = lane + 64 * r; sj[r] = -3.0e38f;
            if (j < cnt) { const int s = sel[j]; const v4u* kp = (const v4u*)(DK + (mb + s) * 256 + h * 64); float dt = 0.f;
#pragma unroll
                for (int c = 0; c < 8; ++c) { const v4u x = kp[c]; const v4f q0 = *(const LAS v4f*)(qv + 8 * c), q1 = *(const LAS v4f*)(qv + 8 * c + 4);
                    dt += q0.x * bflo(x.x) + q0.y * bfhi(x.x) + q0.z * bflo(x.y) + q0.w * bfhi(x.y) + q1.x * bflo(x.z) + q1.y * bfhi(x.z) + q1.z * bflo(x.w) + q1.w * bfhi(x.w); }
                sj[r] = dt; mx = fmaxf(mx, dt); } }
        mx = wave_max(mx);
        float sum = 0.f;
#pragma unroll
        for (int r = 0; r < 4; ++r) { const int j = lane + 64 * r; const float p = (j < cnt) ? __expf(sj[r] - mx) : 0.f; sum += p; pbuf[j] = p; }
        sum = wave_sum(sum);
        LDS_WAIT();
        float o = 0.f;
        for (int j = 0; j < cnt; ++j) { const int s = sel[j]; o += pbuf[j] * bf2f(DV[(mb + s) * 256 + h * 64 + lane]); }
        MIX[m * 1024 + 256 + h * 64 + lane] = f2bf(o / sum);
        LDS_WAIT();
    }
}
__device__ PHASE_FN void dsa_phase(const Ctx A, LAS unsigned char* lds, int l) {
    const int tid = opaque_tid(), lane = tid & 63, wave = tid >> 6;
    if (wave >= DSA_NW) return;
    unsigned* qhead = (unsigned*)(A.ws + WS_CTL) + CW_DSAQ + 64 * l;
    LAS unsigned char* wl = lds + wave * DSA_WBYTES;
    for (;;) {
        unsigned it = 0u;
        if (lane == 0) it = atomicAdd(qhead, 1u);
        it = __builtin_amdgcn_readfirstlane(it);
        if (it >= (unsigned)T) break;
        const int i = L - 1 - (int)(it >> 3), b = (int)(it & 7u);
        dsa_query(A, wl, b, i, lane);
    }
}
static_assert(DSA_NW * DSA_WBYTES <= MISC_OFF, "dsa lds");
typedef short s8 __attribute__((ext_vector_type(8)));
typedef short v4i16_t __attribute__((ext_vector_type(4)));
typedef unsigned u16v __attribute__((ext_vector_type(16)));
typedef unsigned long long u64;
constexpr int NQT16 = L / 16;
constexpr int NKB32 = (L + 31) / 32;
constexpr int MASK_PB = 66112;
constexpr size_t MASK_LAYER = (size_t)NB * MASK_PB * 64;
constexpr size_t WS_MASK = 1956 * MiB;
static_assert(WS_MASK >= WS_MIX_END && WS_MASK + 2 * MASK_LAYER + 256 <= 2032 * MiB, "mask region");
__device__ __forceinline__ size_t mask_row(int l, int b, int qt) { const int a = qt >> 1; return (size_t)l * (NB * MASK_PB) + (size_t)b * MASK_PB + ((qt & 1) ? (a + 1) * (a + 1) : a * (a + 1)); }
constexpr int CW_KMAX = 8960;
constexpr int CW_KIMAX = 9216;
constexpr int MI_KMAX = 640, MI_UNIT = 768, MI_KIMAX = 832;
constexpr int SEL_PF = 3;
constexpr int SEL_HROW = 259;

__device__ __forceinline__ void sel_scores(const s8 a1, const s8 a2, const s8 (&qb)[9], const float (&wv)[8], pg8::f32x4& i1, pg8::f32x4& i2) {
    const pg8::f32x4 z = (pg8::f32x4){0.f, 0.f, 0.f, 0.f};
    i1 = __builtin_amdgcn_mfma_f32_16x16x32_bf16(a1, qb[8], z, 0, 0, 0); i2 = __builtin_amdgcn_mfma_f32_16x16x32_bf16(a2, qb[8], z, 0, 0, 0);
#pragma unroll
    for (int h = 0; h < 8; ++h) {
        const pg8::f32x4 c1 = __builtin_amdgcn_mfma_f32_16x16x32_bf16(a1, qb[h], z, 0, 0, 0), c2 = __builtin_amdgcn_mfma_f32_16x16x32_bf16(a2, qb[h], z, 0, 0, 0);
#pragma unroll
        for (int j = 0; j < 4; ++j) { float t1 = fmaf(fabsf(c1[j]), wv[h], i1[j]), t2 = fmaf(fabsf(c2[j]), wv[h], i2[j]);
            asm("" : "+v"(t1)); asm("" : "+v"(t2)); i1[j] = t1; i2[j] = t2; }
    }
}
template <int MODE, bool DIAG>
__device__ __forceinline__ void sel_block(const s8 a1, const s8 a2, const s8 (&qb)[9], const float (&wv)[8], int kb, int tq, int r, int g, int lane,
                                          LAS unsigned* hrow, float sc_mul, float sc_add, u64* mrow) {
    pg8::f32x4 i1, i2; sel_scores(a1, a2, qb, wv, i1, i2);
    const int s0 = kb * 32 + 8 * g;
    u64 wds[8];
#pragma unroll
    for (int j = 0; j < 8; ++j) {
        const float sc = j < 4 ? i1[j & 3] : i2[j & 3];
        if (MODE == 3) { if (sc == 123456.789f) hrow[256] = 1u; }
        else if (MODE == 2) { wds[j] = DIAG ? __ballot((s0 + j) <= tq && sc >= sc_add) : __ballot(sc >= sc_add); }
        else { int xi = (int)__builtin_floorf(fmaf(sc, sc_mul, sc_add));
            unsigned bin = MODE == 0 ? (unsigned)min(max(xi, 0), 255) : (unsigned)(min(max(xi, -1), 256) + 1);
            if (DIAG) bin = ((s0 + j) <= tq) ? bin : (MODE == 0 ? 256u : 0u);
            if (MODE == 0 || bin != 0u) __hip_atomic_fetch_add(hrow + bin, 1u, __ATOMIC_RELAXED, __HIP_MEMORY_SCOPE_WORKGROUP); }
    }
    if (MODE == 2 && lane == 0) { u64* d = mrow + (size_t)kb * 8;
#pragma unroll
        for (int j = 0; j < 8; j += 2) { v4u o; o.x = (unsigned)wds[j]; o.y = (unsigned)(wds[j] >> 32); o.z = (unsigned)wds[j + 1]; o.w = (unsigned)(wds[j + 1] >> 32); *(v4u*)(d + j) = o; } }
}
template <int MODE>
__device__ __forceinline__ void sel_pass(const bf16* KIb, const s8 (&qb)[9], const float (&wv)[8], int nkb, int tq, int r, int g, int lane,
                                         LAS unsigned* hrow, float sc_mul, float sc_add, u64* mrow, int kb_first = 0, int kb_step = 1) {
    const bf16* kp = KIb + (size_t)(8 * (r >> 2) + (r & 3)) * 32 + 8 * g;
    v4u cur[2 * SEL_PF], nxt[2 * SEL_PF];
#pragma unroll
    for (int i = 0; i < SEL_PF; ++i) { const size_t kb = kb_first + i * kb_step; cur[2 * i] = *(const v4u*)(kp + kb * 1024); cur[2 * i + 1] = *(const v4u*)(kp + kb * 1024 + 128); }
#pragma unroll 1
    for (int kb0 = kb_first; kb0 < nkb; kb0 += SEL_PF * kb_step) {
#pragma unroll
        for (int i = 0; i < SEL_PF; ++i) { const size_t kb = kb0 + (SEL_PF + i) * kb_step; nxt[2 * i] = *(const v4u*)(kp + kb * 1024); nxt[2 * i + 1] = *(const v4u*)(kp + kb * 1024 + 128); }
#pragma unroll
        for (int i = 0; i < SEL_PF; ++i) { const int kb = kb0 + i * kb_step;
            if (kb < nkb - 1) sel_block<MODE, false>(__builtin_bit_cast(s8, cur[2 * i]), __builtin_bit_cast(s8, cur[2 * i + 1]), qb, wv, kb, tq, r, g, lane, hrow, sc_mul, sc_add, mrow);
            else if (kb == nkb - 1) sel_block<MODE, true>(__builtin_bit_cast(s8, cur[2 * i]), __builtin_bit_cast(s8, cur[2 * i + 1]), qb, wv, kb, tq, r, g, lane, hrow, sc_mul, sc_add, mrow); }
#pragma unroll
        for (int i = 0; i < 2 * SEL_PF; ++i) cur[i] = nxt[i];
    }
}
__device__ __forceinline__ void sel_scan(const LAS unsigned* hrow, int need, int& sel, int& above) {
    int cum = 0; sel = 0; above = 0; bool found = false;
#pragma unroll 8
    for (int bin = 255; bin >= 0; --bin) { const int c = (int)hrow[bin];
        if (!found && cum + c >= need) { found = true; sel = bin; above = cum; }
        cum += c; }
}
__device__ PHASE_FN void dsa_select_phase(const Ctx A, LAS unsigned char* lds, int l) {
    const int tid = opaque_tid(), lane = tid & 63, wave = tid >> 6, r = lane & 15, g = lane >> 4;
    const bf16* DQI = (const bf16*)(A.ws + WS_DS_QI); const bf16* DKI = (const bf16*)(A.ws + WS_DS_KI); const float* DWI = (const float*)(A.ws + WS_DS_WI);
    u64* MASK = (u64*)(A.ws + WS_MASK);
    unsigned* qhead = (unsigned*)(A.ws + WS_CTL) + CW_DSAQ + 64 * l;
    const unsigned* kimaxw = (const unsigned*)(A.ws + WS_CTL) + CW_KIMAX + 64 * l;
    LAS unsigned* hist = (LAS unsigned*)(lds + wave * (16 * SEL_HROW * 4));
    LAS unsigned* hrow = hist + r * SEL_HROW;
    for (;;) {
        unsigned it = 0u;
        if (lane == 0) it = atomicAdd(qhead, 1u);
        it = __builtin_amdgcn_readfirstlane(it);
        if (it >= (unsigned)(NB * NQT16)) break;
        const int qt = NQT16 - 1 - (int)(it >> 3), b = (int)(it & 7u);
        const size_t mb = (size_t)b * L, m0 = mb + (size_t)qt * 16;
        const int tq = qt * 16 + r, nkb = ((qt * 16 + 15) >> 5) + 1;
        s8 qb[9]; float wv[8];
#pragma unroll
        for (int h = 0; h < 8; ++h) qb[h] = *(const s8*)(DQI + (m0 + r) * 256 + h * 32 + 8 * g);
        { const v4f w0 = *(const v4f*)(DWI + (m0 + r) * 8), w1 = *(const v4f*)(DWI + (m0 + r) * 8 + 4);
          wv[0] = w0.x; wv[1] = w0.y; wv[2] = w0.z; wv[3] = w0.w; wv[4] = w1.x; wv[5] = w1.y; wv[6] = w1.z; wv[7] = w1.w; }
        float bq = 0.f;
        { float ql[8];
#pragma unroll
          for (int e = 0; e < 8; ++e) ql[e] = 0.f;
#pragma unroll
          for (int h = 0; h < 8; ++h) { float n2 = 0.f;
#pragma unroll
              for (int e = 0; e < 8; ++e) { const float x = bf2f((unsigned short)qb[h][e]); ql[e] += wv[h] * x; n2 += x * x; }
              n2 += __shfl_xor(n2, 16); n2 += __shfl_xor(n2, 32); bq += fabsf(wv[h]) * sqrtf(n2); }
          v4u pk; pk.x = pk2(ql[0], ql[1]); pk.y = pk2(ql[2], ql[3]); pk.z = pk2(ql[4], ql[5]); pk.w = pk2(ql[6], ql[7]); qb[8] = __builtin_bit_cast(s8, pk); }
        const bf16* KIb = DKI + mb * 32;
        float thr_f = -__builtin_inff();
        if (qt * 16 + 15 >= 256) {
            const float kim = sqrtf(__uint_as_float(__hip_atomic_load(kimaxw + b, __ATOMIC_RELAXED, __HIP_MEMORY_SCOPE_AGENT)));
            const float R = fmaxf(2.06f * bq * kim, 1e-30f), s0 = 128.f / R, w0 = R * (1.f / 128.f);
            const int n = tq + 1;
            bool done = false;
            if (qt * 16 >= 2048) {
                for (int i = lane; i < 16 * SEL_HROW; i += 64) hist[i] = 0u;
                LDS_WAIT();
                sel_pass<0>(KIb, qb, wv, nkb - 1, tq, r, g, lane, hrow, s0, 128.f, nullptr, 3, 8);
                LDS_WAIT();
                const int ns = 32 * ((nkb - 1 - 3 + 7) >> 3);
                const float rho = 256.f * (float)ns / (float)n, dev = 4.f * sqrtf(rho) + 2.f;
                int bl, ab; sel_scan(hrow, (int)(rho + dev) + 1, bl, ab);
                int bh = 255, ab2 = 0; const int rhi = (int)(rho - dev);
                if (rhi >= 1) sel_scan(hrow, rhi, bh, ab2);
                LDS_WAIT();
                const float lo = -R + (float)bl * w0, hi = (rhi >= 1) ? (-R + (float)(bh + 1) * w0) : (R * 1.001f);
                const float s1 = 256.f / (hi - lo);
                for (int i = lane; i < 16 * SEL_HROW; i += 64) hist[i] = 0u;
                LDS_WAIT();
                sel_pass<1>(KIb, qb, wv, nkb, tq, r, g, lane, hrow, s1, -lo * s1, nullptr);
                LDS_WAIT();
                const int above = (int)hrow[257]; int inr = 0;
#pragma unroll 8
                for (int bin = 1; bin <= 256; ++bin) inr += (int)hrow[bin];
                const bool ok = above < 256 && above + inr >= 256;
                if (ok) { int sel1, ab1; sel_scan(hrow + 1, 256 - above, sel1, ab1); thr_f = lo + (float)sel1 * ((hi - lo) * (1.f / 256.f)); }
                LDS_WAIT();
                done = __all(ok);
            }
            if (!done) {
                for (int i = lane; i < 16 * SEL_HROW; i += 64) hist[i] = 0u;
                LDS_WAIT();
                sel_pass<0>(KIb, qb, wv, nkb, tq, r, g, lane, hrow, s0, 128.f, nullptr);
                LDS_WAIT();
                int sel0, above0; sel_scan(hrow, 256, sel0, above0);
                LDS_WAIT();
                const float lo0 = -R + (float)sel0 * w0, s1 = 256.f / w0;
                for (int i = lane; i < 16 * SEL_HROW; i += 64) hist[i] = 0u;
                LDS_WAIT();
                sel_pass<1>(KIb, qb, wv, nkb, tq, r, g, lane, hrow, s1, -lo0 * s1, nullptr);
                LDS_WAIT();
                int sel1, above1; sel_scan(hrow + 1, 256 - above0, sel1, above1);
                LDS_WAIT();
                thr_f = lo0 + (float)sel1 * (w0 * (1.f / 256.f));
            }
            if (n <= 256) thr_f = -__builtin_inff();
        }
        sel_pass<2>(KIb, qb, wv, nkb, tq, r, g, lane, hrow, 0.f, thr_f, MASK + mask_row(l, b, qt) * 8);
    }
}

constexpr int AT_ROW = 144;
constexpr int AT_TILE = 64 * AT_ROW;
constexpr int AT_NQT = (L - 16) / 256;
constexpr int AT_NKT = (L + 63) / 64;
static_assert(16 + AT_NQT * 256 == L, "query tiling");
__device__ PHASE_FN void dsa_attn_phase(const Ctx A, LAS unsigned char* lds, int l) {
    const int tid = opaque_tid(), lane = tid & 63, wave = tid >> 6, r = lane & 15, g = lane >> 4;
    const bf16* DQ = (const bf16*)(A.ws + WS_DS_Q); const bf16* DK = (const bf16*)(A.ws + WS_DS_K); const bf16* DV = (const bf16*)(A.ws + WS_DS_V);
    const u64* MASK = (const u64*)(A.ws + WS_MASK); bf16* MIX = (bf16*)(A.ws + WS_MIX);
    unsigned* qhead = (unsigned*)(A.ws + WS_CTL) + CW_DSAQ + 64 * l + 16;
    const unsigned* kmaxw = (const unsigned*)(A.ws + WS_CTL) + CW_KMAX + 64 * l;
    LAS unsigned* unitw = (LAS unsigned*)(lds + MISC_OFF + MI_UNIT);
    const int ldkey = tid >> 3, ldch = tid & 7;
    for (;;) {
        __syncthreads();
        if (tid == 0) unitw[0] = atomicAdd(qhead, 1u);
        __syncthreads();
        const unsigned u = unitw[0];
        if (u >= (unsigned)(NB * 4 * (AT_NQT + 1))) break;
        const bool mini = u >= (unsigned)(NB * 4 * AT_NQT);
        const int qt = mini ? 0 : AT_NQT - 1 - (int)(u >> 5), b = (int)((u & 31u) >> 2), h = (int)(u & 3u);
        const size_t mb = (size_t)b * L;
        const int kmain = mini ? 0 : 4 * qt;
        const int nkt = mini ? 1 : ((4 * qt + 5 < AT_NKT) ? 4 * qt + 5 : AT_NKT);
        const float kmax2 = __uint_as_float(__hip_atomic_load(kmaxw + b * 4 + h, __ATOMIC_RELAXED, __HIP_MEMORY_SCOPE_AGENT));
        int tq[2], lb[2]; bool act[2];
        s8 qf[2][2]; float nc2[2];
        const GAS unsigned* mrow[2];
#pragma unroll
        for (int qi = 0; qi < 2; ++qi) { act[qi] = mini ? (wave == 0 && qi == 0) : true; tq[qi] = mini ? 0 : 16 + qt * 256 + wave * 32 + 16 * qi;
            lb[qi] = __builtin_amdgcn_readfirstlane(act[qi] ? ((tq[qi] + 15) >> 5) : -1);
            float qn2 = 0.f;
#pragma unroll
            for (int ks = 0; ks < 2; ++ks) { qf[qi][ks] = act[qi] ? *(const s8*)(DQ + (mb + tq[qi] + r) * 256 + h * 64 + 32 * ks + 8 * g) : (s8){0, 0, 0, 0, 0, 0, 0, 0};
#pragma unroll
                for (int e = 0; e < 8; ++e) { const float x = bf2f((unsigned short)qf[qi][ks][e]); qn2 += x * x; } }
            qn2 += __shfl_xor(qn2, 16); qn2 += __shfl_xor(qn2, 32);
            nc2[qi] = -sqrtf(qn2 * kmax2);
            const u64 mrow_u = (u64)(MASK + mask_row(l, b, tq[qi] >> 4) * 8);
            const unsigned lo = (unsigned)__builtin_amdgcn_readfirstlane((unsigned)mrow_u), hi = (unsigned)__builtin_amdgcn_readfirstlane((unsigned)(mrow_u >> 32));
            mrow[qi] = (const GAS unsigned*)(((u64)hi << 32) | (u64)lo); }
        pg8::f32x4 O[2][4], Ls[2];
#pragma unroll
        for (int qi = 0; qi < 2; ++qi) { Ls[qi] = (pg8::f32x4){0.f, 0.f, 0.f, 0.f};
#pragma unroll
            for (int db = 0; db < 4; ++db) O[qi][db] = (pg8::f32x4){0.f, 0.f, 0.f, 0.f}; }
        const s8 ones8 = (s8){0x3F80, 0x3F80, 0x3F80, 0x3F80, 0x3F80, 0x3F80, 0x3F80, 0x3F80};
#define AT_SLOAD(dst, qi_, kb_) asm volatile("s_load_dwordx16 %0, %1, 0x0" : "=s"(dst) : "s"(mrow[qi_] + (size_t)(kb_) * 16))
#define AT_MWAIT(m0_, m1_) asm volatile("s_waitcnt lgkmcnt(0)" : "+s"(m0_), "+s"(m1_))
#define AT_MWAIT_S2(a0_, a1_, b0_, b1_) asm volatile("s_waitcnt lgkmcnt(0)" : "+s"(a0_), "+s"(a1_), "+s"(b0_), "+s"(b1_), "+v"(Sa), "+v"(Sb), "+v"(Sc), "+v"(Sd), "+v"(Se), "+v"(Sf), "+v"(Sg), "+v"(Sh) :: "memory")
#define AT_MWAIT_O(a0_, a1_, b0_, b1_) asm volatile("s_waitcnt lgkmcnt(0)" : "+s"(a0_), "+s"(a1_), "+s"(b0_), "+s"(b1_), "+v"(O[1][0]), "+v"(O[1][1]), "+v"(O[1][2]), "+v"(O[1][3]), "+v"(Ls[1]) :: "memory")
        const bf16* kg = DK + (mb + ldkey) * 256 + h * 64 + ldch * 8; const bf16* vg = DV + (mb + ldkey) * 256 + h * 64 + ldch * 8;
        v4u rk0 = *(const v4u*)kg, rv0 = *(const v4u*)vg;
        const size_t to1 = (size_t)(nkt > 1 ? 1 : nkt - 1) * 64 * 256, to2 = (size_t)(nkt > 2 ? 2 : nkt - 1) * 64 * 256, to3 = (size_t)(nkt > 3 ? 3 : nkt - 1) * 64 * 256;
        v4u rk1 = *(const v4u*)(kg + to1), rv1 = *(const v4u*)(vg + to1), rk2 = *(const v4u*)(kg + to2), rv2 = *(const v4u*)(vg + to2), rk3 = *(const v4u*)(kg + to3), rv3 = *(const v4u*)(vg + to3);
        u16v m0, m1, n0, n1;
#define AT_STORE(boff, rk, rv) do { LAS unsigned char* kb_ = lds + (boff); LAS unsigned char* vb_ = kb_ + AT_TILE; \
            *(LAS v4u*)(kb_ + ldkey * AT_ROW + ldch * 16) = rk; *(LAS v4u*)(vb_ + ldkey * AT_ROW + ldch * 16) = rv; } while (0)
#define AT_LOAD(kt_, rk, rv) do { rk = *(const v4u*)(kg + (size_t)(kt_) * 64 * 256); rv = *(const v4u*)(vg + (size_t)(kt_) * 64 * 256); } while (0)
#define AT_KREAD(boff, blk) do { const LAS unsigned char* ka = lds + (boff) + ((blk) * 32 + 8 * (r >> 2) + (r & 3)) * AT_ROW + g * 16; \
            _Pragma("unroll") for (int ks = 0; ks < 2; ++ks) { kf[blk][ks][0] = *(const LAS s8*)(ka + ks * 64); kf[blk][ks][1] = *(const LAS s8*)(ka + 4 * AT_ROW + ks * 64); } } while (0)
#define AT_VREAD(boff, blk) do { const LAS unsigned char* va = lds + (boff) + AT_TILE + ((blk) * 32 + 8 * g + (r >> 2)) * AT_ROW + (r & 3) * 8; \
            _Pragma("unroll") for (int db = 0; db < 4; ++db) { \
                const v4i16_t x0 = __builtin_amdgcn_ds_read_tr16_b64_v4i16((LAS v4i16_t*)(va + db * 32)), x1 = __builtin_amdgcn_ds_read_tr16_b64_v4i16((LAS v4i16_t*)(va + 4 * AT_ROW + db * 32)); \
                vf[blk][db] = (s8){x0[0], x0[1], x0[2], x0[3], x1[0], x1[1], x1[2], x1[3]}; } } while (0)
#define AT_BLK_S(blk, qi, S1, S2) do { S1 = (pg8::f32x4){nc2[qi], nc2[qi], nc2[qi], nc2[qi]}; S2 = S1; \
            _Pragma("unroll") for (int ks = 0; ks < 2; ++ks) { \
                S1 = __builtin_amdgcn_mfma_f32_16x16x32_bf16(kf[blk][ks][0], qf[qi][ks], S1, 0, 0, 0); S2 = __builtin_amdgcn_mfma_f32_16x16x32_bf16(kf[blk][ks][1], qf[qi][ks], S2, 0, 0, 0); } } while (0)
#define AT_BLK_P(mq, S1, S2, pa) do { float p[8]; \
            _Pragma("unroll") for (int j = 0; j < 8; ++j) { \
                const bool bit = __builtin_amdgcn_inverse_ballot_w64(((u64)mq[2 * j + 1] << 32) | mq[2 * j]); \
                p[j] = bit ? __builtin_amdgcn_exp2f(j < 4 ? S1[j & 3] : S2[j & 3]) : 0.f; } \
            v4u pk; pk.x = pk2(p[0], p[1]); pk.y = pk2(p[2], p[3]); pk.z = pk2(p[4], p[5]); pk.w = pk2(p[6], p[7]); \
            pa = __builtin_bit_cast(s8, pk); } while (0)
#define AT_BLK_V(blk, qi, pa) do { \
            _Pragma("unroll") for (int db = 0; db < 4; ++db) O[qi][db] = __builtin_amdgcn_mfma_f32_16x16x32_bf16(pa, vf[blk][db], O[qi][db], 0, 0, 0); \
            Ls[qi] = __builtin_amdgcn_mfma_f32_16x16x32_bf16(pa, ones8, Ls[qi], 0, 0, 0); } while (0)
#define AT_ROTATE do { const int t_ = bc; bc = bn; bn = bs; bs = t_; } while (0)
#define AT_MAIN_BODY(kt, RK_LD, RV_LD, RK_ST, RV_ST, LASTWAIT) do { \
            { const int ktn_ = (kt) + 5 < nkt ? (kt) + 5 : nkt - 1; AT_LOAD(ktn_, RK_LD, RV_LD); } \
            AT_STORE(bs, RK_ST, RV_ST); \
            pg8::f32x4 Sa, Sb, Sc, Sd, Se, Sf, Sg, Sh; s8 pa0, pa1, pb0, pb1; \
            AT_BLK_S(0, 0, Sa, Sb); AT_BLK_S(1, 0, Sc, Sd); AT_BLK_S(0, 1, Se, Sf); AT_BLK_S(1, 1, Sg, Sh);        \
            AT_MWAIT_S2(m0, m1, n0, n1); \
            AT_KREAD(bn, 0); AT_KREAD(bn, 1); \
            AT_BLK_P(m0, Sa, Sb, pa0); AT_SLOAD(m0, 0, 2 * (kt) + 2); AT_BLK_P(m1, Sc, Sd, pa1); AT_SLOAD(m1, 0, 2 * (kt) + 3); \
            AT_BLK_V(0, 0, pa0); AT_BLK_V(1, 0, pa1); \
            AT_BLK_P(n0, Se, Sf, pb0); AT_SLOAD(n0, 1, 2 * (kt) + 2); AT_BLK_P(n1, Sg, Sh, pb1); AT_SLOAD(n1, 1, 2 * (kt) + 3); \
            AT_BLK_V(0, 1, pb0); AT_BLK_V(1, 1, pb1); \
            if (LASTWAIT) AT_MWAIT_O(m0, m1, n0, n1);                   \
            AT_VREAD(bn, 0); AT_VREAD(bn, 1); \
            AT_ROTATE; \
            __builtin_amdgcn_s_barrier(); } while (0)
#define AT_DIAG_STEP(kt, qi) do { \
            if (2 * (kt) + 1 <= lb[qi]) { pg8::f32x4 Sa, Sb, Sc, Sd; s8 pa0, pa1; AT_SLOAD(m0, qi, 2 * (kt)); AT_SLOAD(m1, qi, 2 * (kt) + 1); \
                AT_BLK_S(0, qi, Sa, Sb); AT_BLK_S(1, qi, Sc, Sd); AT_MWAIT(m0, m1); AT_BLK_P(m0, Sa, Sb, pa0); AT_BLK_P(m1, Sc, Sd, pa1); AT_BLK_V(0, qi, pa0); AT_BLK_V(1, qi, pa1); } \
            else if (2 * (kt) <= lb[qi]) { pg8::f32x4 Sa, Sb; s8 pa0; AT_SLOAD(m0, qi, 2 * (kt)); AT_SLOAD(m1, qi, 2 * (kt)); \
                AT_BLK_S(0, qi, Sa, Sb); AT_MWAIT(m0, m1); AT_BLK_P(m0, Sa, Sb, pa0); AT_BLK_V(0, qi, pa0); } } while (0)
#define AT_DIAG_BODY(kt, RK_LD, RV_LD, RK_ST, RV_ST) do { \
            { const int ktn_ = (kt) + 5 < nkt ? (kt) + 5 : nkt - 1; AT_LOAD(ktn_, RK_LD, RV_LD); } \
            AT_STORE(bs, RK_ST, RV_ST); \
            if (2 * (kt) <= lb[1] || 2 * (kt) <= lb[0]) { \
                AT_KREAD(bc, 0); AT_KREAD(bc, 1); AT_VREAD(bc, 0); AT_VREAD(bc, 1); \
                AT_DIAG_STEP(kt, 0); AT_DIAG_STEP(kt, 1); } \
            asm volatile("s_waitcnt lgkmcnt(0)" ::: "memory"); \
            AT_ROTATE; \
            __builtin_amdgcn_s_barrier(); } while (0)
        int bc = 0, bn = 2 * AT_TILE, bs = 4 * AT_TILE;
        s8 kf[2][2][2], vf[2][4];
        AT_SLOAD(m0, 0, 0); AT_SLOAD(m1, 0, 1); AT_SLOAD(n0, 1, 0); AT_SLOAD(n1, 1, 1);
        AT_STORE(bc, rk0, rv0);
        AT_STORE(bn, rk1, rv1);
        AT_LOAD(nkt > 4 ? 4 : nkt - 1, rk0, rv0);
        AT_MWAIT(m0, m1); AT_MWAIT(n0, n1);
        __syncthreads();
        AT_KREAD(bc, 0); AT_KREAD(bc, 1); AT_VREAD(bc, 0); AT_VREAD(bc, 1);
#pragma unroll 1
        for (int kt = 0; kt < kmain; kt += 4) {
            AT_MAIN_BODY(kt, rk1, rv1, rk2, rv2, false);
            AT_MAIN_BODY(kt + 1, rk2, rv2, rk3, rv3, false);
            AT_MAIN_BODY(kt + 2, rk3, rv3, rk0, rv0, false);
            AT_MAIN_BODY(kt + 3, rk0, rv0, rk1, rv1, true);
        }
#pragma unroll 1
        for (int kt = kmain; kt < nkt; kt += 4) {
            AT_DIAG_BODY(kt, rk1, rv1, rk2, rv2);
            AT_DIAG_BODY(kt + 1, rk2, rv2, rk3, rv3);
            AT_DIAG_BODY(kt + 2, rk3, rv3, rk0, rv0);
            AT_DIAG_BODY(kt + 3, rk0, rv0, rk1, rv1);
        }
#undef AT_ROTATE
#undef AT_MAIN_BODY
#undef AT_DIAG_BODY
#undef AT_DIAG_STEP
#undef AT_BLK_S
#undef AT_BLK_P
#undef AT_BLK_V
#undef AT_KREAD
#undef AT_VREAD
#undef AT_SLOAD
#undef AT_MWAIT
#undef AT_MWAIT_S2
#undef AT_MWAIT_O
#undef AT_LOAD
#undef AT_STORE
#pragma unroll
        for (int qi = 0; qi < 2; ++qi)
#pragma unroll
            for (int j = 0; j < 4; ++j) { const float ij = Ls[qi][j] > 0.f ? 1.f / Ls[qi][j] : 0.f; const int t = tq[qi] + 4 * g + j;
                if (act[qi]) {
#pragma unroll
                    for (int db = 0; db < 4; ++db) MIX[(mb + t) * 1024 + 256 + h * 64 + db * 16 + r] = f2bf(O[qi][db][j] * ij); } }
    }
}
constexpr int CK = 16;
constexpr int NCHK = L / CK;
static_assert(L % CK == 0, "chunk length");
constexpr int CKP_RW = 10, CKP_HG = 7;
constexpr int CKR_RW = CKP_RW * 1024 + 512, CKR_HG = CKP_HG * 1024 + 256;
constexpr size_t WS_CKF_RW = WS_PROJ + 136 * MiB;
constexpr size_t WS_CKF_HG = WS_CKF_RW + (size_t)32 * NCHK * CKR_RW;
static_assert(WS_CKF_HG + (size_t)32 * NCHK * CKR_HG <= WS_PROJ + (size_t)TP * NINP * 2, "chunk fragments fit in the dead proj region");
__device__ __forceinline__ s8 pack8(const pg8::f32x4 lo, const pg8::f32x4 hi) { v4u p; p.x = pk2(lo[0], lo[1]); p.y = pk2(lo[2], lo[3]); p.z = pk2(hi[0], hi[1]); p.w = pk2(hi[2], hi[3]); return __builtin_bit_cast(s8, p); }
template <int CTRL> __device__ __forceinline__ float dpp_shr1(float x) { return __int_as_float(__builtin_amdgcn_update_dpp(0x3F800000, __float_as_int(x), CTRL, 0xF, 0xF, false)); }
__device__ __forceinline__ float row_cumprod(float x) { x *= dpp_shr1<0x111>(x); x *= dpp_shr1<0x112>(x); x *= dpp_shr1<0x114>(x); x *= dpp_shr1<0x118>(x); return x; }

template <bool RWKV>
__device__ __forceinline__ void chunk_prep_item(const Ctx A, int bh, int c, int lane) {
    const int r = lane & 15, g = lane >> 4;
    const size_t base = ((size_t)bh * L + (size_t)c * CK + r) * 64;
    const float* Wg = (const float*)(A.ws + (RWKV ? WS_RW_W : WS_HG_F)) + base;
    const bf16* Ag = (const bf16*)(A.ws + WS_RW_A) + base; const bf16* Bg = (const bf16*)(A.ws + WS_RW_B) + base;
    const bf16* Kg = (const bf16*)(A.ws + (RWKV ? WS_RW_K : WS_HG_K)) + base; const bf16* Rg = (const bf16*)(A.ws + (RWKV ? WS_RW_WR : WS_HG_Q)) + base;
    GAS unsigned char* recb = A.ws + (RWKV ? WS_CKF_RW : WS_CKF_HG) + ((size_t)bh * NCHK + c) * (RWKV ? CKR_RW : CKR_HG);
    v4u* REC = (v4u*)recb + lane; v4f* GCp = (v4f*)(recb + (RWKV ? CKP_RW : CKP_HG) * 1024); float* Dp = (float*)(recb + CKP_RW * 1024 + 256);
    s8 Af[2], Bf[2], Kf[2], Rf[2], BTf[2], KTf[2];
    v4f gcv[4];
#pragma unroll
    for (int ks = 0; ks < 2; ++ks) {
        pg8::f32x4 ah[2], bh_[2], kh[2], rh[2], bt[2], kt[2];
#pragma unroll
        for (int hf = 0; hf < 2; ++hf) {
            const int k0 = 32 * ks + 16 * hf + 4 * g;
            const v4f w4 = *(const v4f*)(Wg + k0);
            v4f gt, gm, gc;
#pragma unroll
            for (int e = 0; e < 4; ++e) { gt[e] = row_cumprod(w4[e]); gm[e] = dpp_shr1<0x111>(gt[e]); gc[e] = __shfl(gt[e], 16 * g + 15); }
            gcv[2 * ks + hf] = gc;
            v4f inv; inv.x = __builtin_amdgcn_rcpf(gt.x); inv.y = __builtin_amdgcn_rcpf(gt.y); inv.z = __builtin_amdgcn_rcpf(gt.z); inv.w = __builtin_amdgcn_rcpf(gt.w);
            const v4f kk4 = ld_bf4(Kg + k0) * inv, rr4 = ld_bf4(Rg + k0) * (RWKV ? gm : gt);
            kh[hf] = kk4; rh[hf] = rr4; kt[hf] = kk4 * gc;
            if (RWKV) { ah[hf] = ld_bf4(Ag + k0) * gm; bh_[hf] = ld_bf4(Bg + k0) * inv; bt[hf] = bh_[hf] * gc; }
        }
        Kf[ks] = pack8(kh[0], kh[1]); Rf[ks] = pack8(rh[0], rh[1]); KTf[ks] = pack8(kt[0], kt[1]);
        if (RWKV) { Af[ks] = pack8(ah[0], ah[1]); Bf[ks] = pack8(bh_[0], bh_[1]); BTf[ks] = pack8(bt[0], bt[1]); }
    }
    const pg8::f32x4 z4 = (pg8::f32x4){0.f, 0.f, 0.f, 0.f};
    s8 selE, selO;
    { v4u e = (v4u){0u, 0u, 0u, 0u}, o = e; const int jj = r - 4 * g;
      if (jj >= 0 && jj < 4) { const unsigned one = 0x3F80u << (16 * (jj & 1)); if (jj < 2) { e.x = one; o.z = one; } else { e.y = one; o.w = one; } }
      selE = __builtin_bit_cast(s8, e); selO = __builtin_bit_cast(s8, o); }
    pg8::f32x4 MrkT = __builtin_amdgcn_mfma_f32_16x16x32_bf16(Kf[0], Rf[0], z4, 0, 0, 0); MrkT = __builtin_amdgcn_mfma_f32_16x16x32_bf16(Kf[1], Rf[1], MrkT, 0, 0, 0);
    const int tb = r >> 2, tj = r & 3;
    if (RWKV) {
        pg8::f32x4 LabT = __builtin_amdgcn_mfma_f32_16x16x32_bf16(Bf[0], Af[0], z4, 0, 0, 0); LabT = __builtin_amdgcn_mfma_f32_16x16x32_bf16(Bf[1], Af[1], LabT, 0, 0, 0);
        pg8::f32x4 LakT = __builtin_amdgcn_mfma_f32_16x16x32_bf16(Kf[0], Af[0], z4, 0, 0, 0); LakT = __builtin_amdgcn_mfma_f32_16x16x32_bf16(Kf[1], Af[1], LakT, 0, 0, 0);
        pg8::f32x4 MrbT = __builtin_amdgcn_mfma_f32_16x16x32_bf16(Bf[0], Rf[0], z4, 0, 0, 0); MrbT = __builtin_amdgcn_mfma_f32_16x16x32_bf16(Bf[1], Rf[1], MrbT, 0, 0, 0);
        const float d10 = __shfl(LabT[0], 20 * g + 1), d20 = __shfl(LabT[0], 20 * g + 2), d21 = __shfl(LabT[1], 20 * g + 2);
        const float d30 = __shfl(LabT[0], 20 * g + 3), d31 = __shfl(LabT[1], 20 * g + 3), d32 = __shfl(LabT[2], 20 * g + 3);
        pg8::f32x4 Loff, Lak, Mrb, Mrk;
#pragma unroll
        for (int j = 0; j < 4; ++j) { const bool below = g < tb, diag = g == tb;
            Loff[j] = below ? LabT[j] : 0.f; Lak[j] = (below || (diag && j < tj)) ? LakT[j] : 0.f;
            Mrb[j] = (below || (diag && j <= tj)) ? MrbT[j] : 0.f; Mrk[j] = (below || (diag && j <= tj)) ? MrkT[j] : 0.f; }
        REC[0 * 64] = __builtin_bit_cast(v4u, Af[0]); REC[1 * 64] = __builtin_bit_cast(v4u, Af[1]); REC[2 * 64] = __builtin_bit_cast(v4u, Rf[0]); REC[3 * 64] = __builtin_bit_cast(v4u, Rf[1]);
        REC[4 * 64] = __builtin_bit_cast(v4u, pack8(Loff, Lak)); REC[5 * 64] = __builtin_bit_cast(v4u, pack8(Mrb, Mrk));
        if (r == 0) { *(v4f*)(Dp + 8 * g) = (v4f){d10, d20, d21, d30}; *(v4f*)(Dp + 8 * g + 4) = (v4f){d31, d32, 0.f, 0.f}; }
#pragma unroll
        for (int mt = 0; mt < 4; ++mt) { const s8 sel = (mt & 1) ? selO : selE;
            const pg8::f32x4 K2 = __builtin_amdgcn_mfma_f32_16x16x32_bf16(KTf[mt >> 1], sel, z4, 0, 0, 0), B2 = __builtin_amdgcn_mfma_f32_16x16x32_bf16(BTf[mt >> 1], sel, z4, 0, 0, 0);
            REC[(6 + mt) * 64] = __builtin_bit_cast(v4u, pack8(B2, K2)); if (r == 15) GCp[4 * mt + g] = gcv[mt]; }
    } else {
        pg8::f32x4 Mrk;
#pragma unroll
        for (int j = 0; j < 4; ++j) Mrk[j] = (g < tb || (g == tb && j <= tj)) ? MrkT[j] : 0.f;
        REC[0 * 64] = __builtin_bit_cast(v4u, Rf[0]); REC[1 * 64] = __builtin_bit_cast(v4u, Rf[1]); REC[2 * 64] = __builtin_bit_cast(v4u, pack8(z4, Mrk));
#pragma unroll
        for (int mt = 0; mt < 4; ++mt) { const s8 sel = (mt & 1) ? selO : selE;
            const pg8::f32x4 K2 = __builtin_amdgcn_mfma_f32_16x16x32_bf16(KTf[mt >> 1], sel, z4, 0, 0, 0);
            REC[(3 + mt) * 64] = __builtin_bit_cast(v4u, pack8(z4, K2)); if (r == 15) GCp[4 * mt + g] = gcv[mt]; }
    }
}
__device__ PHASE_FN void chunk_prep_phase(const Ctx A, int vcu, int G) {
    const int tid = opaque_tid(), lane = tid & 63, wave = tid >> 6;
    const int gw = vcu * NWAVES + wave, NGW = G * NWAVES;
#pragma unroll 1
    for (int it = gw; it < 2 * 32 * NCHK; it += NGW) {
        const int mix = it >= 32 * NCHK, q = mix ? it - 32 * NCHK : it, bh = q / NCHK, c = q - bh * NCHK;
        if (mix) chunk_prep_item<false>(A, bh, c, lane); else chunk_prep_item<true>(A, bh, c, lane);
    }
}
template <bool RWKV>
__device__ PHASE_FN void chunk_scan(const Ctx A, LAS unsigned char* lds, int unit_) {
    const int unit = opaque_s(unit_);
    const int tid = opaque_tid(), lane = tid & 63, wave = tid >> 6, r = lane & 15, g = lane >> 4;
    const int slot = wave >> 2, nt = wave & 3;
    const int bh = 2 * unit + slot, b = bh >> 2, h = bh & 3;
    constexpr int NP = RWKV ? CKP_RW : CKP_HG;
    constexpr int NU = NP + 3;
    constexpr int NQ = (NU + 3) / 4;
    constexpr int RING = NU * 1024;
    constexpr size_t RB = RWKV ? CKR_RW : CKR_HG;
    const GAS unsigned char* recb = A.ws + (RWKV ? WS_CKF_RW : WS_CKF_HG) + (size_t)bh * NCHK * RB;
    const GAS unsigned char* vb = A.ws + (RWKV ? WS_RW_V : WS_HG_V) + (size_t)bh * L * 128;
    float* YR = (float*)(A.ws + (RWKV ? WS_YRAW : WS_ORAW)) + (size_t)b * L * 256 + h * 64 + nt * 16 + r;
    LAS unsigned char* ring = lds + slot * 2 * RING;
    static_assert(4 * (size_t)(CKP_RW + 3) * 1024 <= MISC_OFF, "chunk ring");
    auto unit_src = [&](int c_, int u) -> const GAS v4u* {
        if (u < NP) return (const GAS v4u*)(recb + (size_t)c_ * RB + u * 1024) + lane;
        if (u == NP) { const int q = lane * 16 < (int)(RB - NP * 1024) ? lane * 16 : (int)(RB - NP * 1024) - 16; return (const GAS v4u*)(recb + (size_t)c_ * RB + NP * 1024 + q); }
        return (const GAS v4u*)(vb + (size_t)c_ * CK * 128 + (u - NP - 1) * 1024) + lane; };
    v4u st0[NQ], st1[NQ], st2[NQ], st3[NQ];
#define CK_LD(S, c_) do { const int cc_ = (c_) < NCHK ? (c_) : NCHK - 1; _Pragma("unroll") for (int q = 0; q < NQ; ++q) { const int u = nt + 4 * q; if (u < NU) S[q] = *unit_src(cc_, u); } } while (0)
#define CK_ST(S, p_) do { _Pragma("unroll") for (int q = 0; q < NQ; ++q) { const int u = nt + 4 * q; if (u < NU) *(LAS v4u*)(ring + (p_) * RING + u * 1024 + lane * 16) = S[q]; } } while (0)
    pg8::f32x4 ST[4];
#pragma unroll
    for (int mt = 0; mt < 4; ++mt) ST[mt] = (pg8::f32x4){0.f, 0.f, 0.f, 0.f};
    const pg8::f32x4 z4 = (pg8::f32x4){0.f, 0.f, 0.f, 0.f};
    auto body = [&](const int c, const int p) __attribute__((always_inline)) {
        const LAS unsigned char* rb_ = ring + p * RING;
        const LAS unsigned char* sm = rb_ + NP * 1024;
        v4u pcs[NP]; v4f gqs[4]; v4f da = (v4f){0.f, 0.f, 0.f, 0.f}, db = da;
#pragma unroll
        for (int i = 0; i < NP; ++i) pcs[i] = *(const LAS v4u*)(rb_ + i * 1024 + lane * 16);
#pragma unroll
        for (int mt = 0; mt < 4; ++mt) gqs[mt] = *(const LAS v4f*)(sm + (16 * mt + 4 * g) * 4);
        if (RWKV) { da = *(const LAS v4f*)(sm + 256 + g * 32); db = *(const LAS v4f*)(sm + 256 + g * 32 + 16); }
#define PIECE(i) __builtin_bit_cast(s8, pcs[i])
        unsigned vp0, vp1;
        { const LAS unsigned short* vv = (const LAS unsigned short*)(rb_ + (NP + 1) * 1024) + (4 * g) * 64 + 16 * nt + r;
          vp0 = (unsigned)vv[0] | ((unsigned)vv[64] << 16); vp1 = (unsigned)vv[128] | ((unsigned)vv[192] << 16); }
        __builtin_amdgcn_sched_barrier(0);
        const s8 Sf0 = pack8(ST[0], ST[1]), Sf1 = pack8(ST[2], ST[3]);
        pg8::f32x4 U = z4, R0;
        if (RWKV) {
            R0 = __builtin_amdgcn_mfma_f32_16x16x32_bf16(PIECE(2), Sf0, z4, 0, 0, 0); R0 = __builtin_amdgcn_mfma_f32_16x16x32_bf16(PIECE(3), Sf1, R0, 0, 0, 0);
            pg8::f32x4 W0 = __builtin_amdgcn_mfma_f32_16x16x32_bf16(PIECE(0), Sf0, z4, 0, 0, 0); W0 = __builtin_amdgcn_mfma_f32_16x16x32_bf16(PIECE(1), Sf1, W0, 0, 0, 0);
            const float d10 = da.x, d20 = da.y, d21 = da.z, d30 = da.w, d31 = db.x, d32 = db.y;
            const s8 Ajac = PIECE(4);
#pragma unroll
            for (int rnd = 0; rnd < 4; ++rnd) {
                v4u bu; bu.x = pk2(U[0], U[1]); bu.y = pk2(U[2], U[3]); bu.z = vp0; bu.w = vp1;
                const pg8::f32x4 Wr = __builtin_amdgcn_mfma_f32_16x16x32_bf16(Ajac, __builtin_bit_cast(s8, bu), W0, 0, 0, 0);
                U[0] = Wr[0]; U[1] = Wr[1] + d10 * U[0]; U[2] = Wr[2] + d20 * U[0] + d21 * U[1]; U[3] = Wr[3] + d30 * U[0] + d31 * U[1] + d32 * U[2];
            }
        } else {
            R0 = __builtin_amdgcn_mfma_f32_16x16x32_bf16(PIECE(0), Sf0, z4, 0, 0, 0); R0 = __builtin_amdgcn_mfma_f32_16x16x32_bf16(PIECE(1), Sf1, R0, 0, 0, 0);
        }
        v4u buv; buv.x = pk2(U[0], U[1]); buv.y = pk2(U[2], U[3]); buv.z = vp0; buv.w = vp1;
        const s8 Buv = __builtin_bit_cast(s8, buv);
        const pg8::f32x4 Yt = __builtin_amdgcn_mfma_f32_16x16x32_bf16(PIECE(RWKV ? 5 : 2), Buv, R0, 0, 0, 0);
#pragma unroll
        for (int j = 0; j < 4; ++j) YR[(size_t)(c * CK + 4 * g + j) * 256] = Yt[j];
#pragma unroll
        for (int mt = 0; mt < 4; ++mt) {
            const v4f gq = gqs[mt];
            ST[mt][0] *= gq.x; ST[mt][1] *= gq.y; ST[mt][2] *= gq.z; ST[mt][3] *= gq.w;
            ST[mt] = __builtin_amdgcn_mfma_f32_16x16x32_bf16(PIECE((RWKV ? 6 : 3) + mt), Buv, ST[mt], 0, 0, 0);
        }
#undef PIECE
    };
    CK_LD(st0, 0); CK_LD(st1, 1); CK_LD(st2, 2); CK_LD(st3, 3);
    CK_ST(st0, 0);
    __syncthreads();
#define CK_TRIP(c_, SLD, SST, p_) do { CK_LD(SLD, (c_) + 4); body((c_), (p_)); CK_ST(SST, 1 - (p_)); __syncthreads(); } while (0)
    static_assert(NCHK % 4 == 1, "chunk loop: whole groups of four trips + one");
#pragma unroll 1
    for (int c = 0; c < NCHK - 1; c += 4) {
        CK_TRIP(c, st0, st1, 0);
        CK_TRIP(c + 1, st1, st2, 1);
        CK_TRIP(c + 2, st2, st3, 0);
        CK_TRIP(c + 3, st3, st0, 1);
    }
    CK_TRIP(NCHK - 1, st0, st1, 0);
#undef CK_TRIP
#undef CK_LD
#undef CK_ST
}
__device__ __forceinline__ float rowmax16(float x) { x = fmaxf(x, dpp_f<0xB1>(x)); x = fmaxf(x, dpp_f<0x4E>(x)); x = fmaxf(x, dpp_f<0x141>(x)); x = fmaxf(x, dpp_f<0x140>(x)); return x; }
__device__ __forceinline__ int rowmin16i(int x) { x = min(x, __builtin_amdgcn_update_dpp(0, x, 0xB1, 0xF, 0xF, true)); x = min(x, __builtin_amdgcn_update_dpp(0, x, 0x4E, 0xF, 0xF, true));
    x = min(x, __builtin_amdgcn_update_dpp(0, x, 0x141, 0xF, 0xF, true)); x = min(x, __builtin_amdgcn_update_dpp(0, x, 0x140, 0xF, 0xF, true)); return x; }
__device__ PHASE_FN void ln_router_phase(const Ctx A, LAS unsigned char* lds, int l, int vcu, int G) {
    const int tid = opaque_tid(), lane = tid & 63, wave = tid >> 6, r = lane & 15, g = lane >> 4;
    const int gw = vcu * NWAVES + wave, NGW = G * NWAVES;
    bf16* HB = (bf16*)(A.ws + WS_HB);
    int* TIDX = (int*)(A.ws + WS_TIDX); float* TGATE = (float*)(A.ws + WS_TGATE);
    unsigned* ecnt = (unsigned*)(A.ws + WS_CTL) + CW_ECNT + 64 * l;
    const float* gg = gin(A, 26) + l * D; const float* bb = gin(A, 27) + l * D;
    const float* rw = gin(A, 28) + (size_t)l * D * NE; const float* rb = gin(A, 29) + l * NE;
    LAS int* hist = (LAS int*)(lds + MISC_OFF + MI_HIST);
    if (tid < 32) hist[tid] = 0;
    for (int f = tid; f < 32 * 2 * 64; f += NTHR) { const int ks = f >> 7, nt = (f >> 6) & 1, ln = f & 63, n = ln & 15, g8 = ln >> 4;
        float w8[8];
#pragma unroll
        for (int e = 0; e < 8; ++e) w8[e] = rw[(size_t)(32 * ks + 8 * g8 + e) * NE + 16 * nt + n];
        v4u hi, lo; unsigned hh[4], ll[4];
#pragma unroll
        for (int e = 0; e < 4; ++e) { const unsigned ph = pk2(w8[2 * e], w8[2 * e + 1]); hh[e] = ph; ll[e] = pk2(w8[2 * e] - bflo(ph), w8[2 * e + 1] - bfhi(ph)); }
        hi = (v4u){hh[0], hh[1], hh[2], hh[3]}; lo = (v4u){ll[0], ll[1], ll[2], ll[3]};
        *(LAS v4u*)(lds + ((size_t)((ks * 2 + nt) * 2 + 0) * 64 + ln) * 16) = hi; *(LAS v4u*)(lds + ((size_t)((ks * 2 + nt) * 2 + 1) * 64 + ln) * 16) = lo; }
    __syncthreads();
    const float rb0 = rb[r], rb1 = rb[16 + r];
    auto lnrows = [&](size_t mrow, auto nrows_c) {
        constexpr int NR = decltype(nrows_c)::value;
        v4f x[NR][4];
#pragma unroll
        for (int u = 0; u < NR; ++u)
#pragma unroll
            for (int j = 0; j < 4; ++j) x[u][j] = ld_bf4(HB + (mrow + u) * D + 256 * j + 4 * lane);
#pragma unroll
        for (int u = 0; u < NR; ++u) { ln_row(x[u], gg, bb, lane);
#pragma unroll
            for (int j = 0; j < 4; ++j) { const size_t o = (mrow + u) * D + 256 * j + 4 * lane;
                v2u hi; hi.x = pk2(x[u][j].x, x[u][j].y); hi.y = pk2(x[u][j].z, x[u][j].w);
                *(v2u*)(HB + o) = hi; } }
    };
    auto ln2 = [&](size_t mrow) { lnrows(mrow, std::integral_constant<int, 2>{}); };
    auto route = [&](size_t m0) {
        pg8::f32x4 C0 = (pg8::f32x4){0.f, 0.f, 0.f, 0.f}, C1 = C0;
        const bf16* ah = HB + (m0 + r) * D + 8 * g;
#pragma unroll 4
        for (int ks = 0; ks < 32; ++ks) {
            const s8 xh = *(const s8*)(ah + 32 * ks);
            const LAS unsigned char* wf = lds + (size_t)(ks * 4) * 1024 + lane * 16;
            const s8 w0h = *(const LAS s8*)(wf), w0l = *(const LAS s8*)(wf + 1024), w1h = *(const LAS s8*)(wf + 2048), w1l = *(const LAS s8*)(wf + 3072);
            C0 = __builtin_amdgcn_mfma_f32_16x16x32_bf16(xh, w0h, C0, 0, 0, 0); C0 = __builtin_amdgcn_mfma_f32_16x16x32_bf16(xh, w0l, C0, 0, 0, 0);
            C1 = __builtin_amdgcn_mfma_f32_16x16x32_bf16(xh, w1h, C1, 0, 0, 0); C1 = __builtin_amdgcn_mfma_f32_16x16x32_bf16(xh, w1l, C1, 0, 0, 0);
        }
#pragma unroll
        for (int j = 0; j < 4; ++j) {
            float v0 = C0[j] + rb0, v1 = C1[j] + rb1;
            float tv[4]; int ti[4];
#pragma unroll
            for (int q = 0; q < 4; ++q) {
                const float mx = rowmax16(fmaxf(v0, v1));
                const int cand = (v0 == mx) ? r : ((v1 == mx) ? 16 + r : 64);
                const int bi = rowmin16i(cand);
                tv[q] = mx; ti[q] = bi;
                if (bi == r) v0 = -3.0e38f; if (bi == 16 + r) v1 = -3.0e38f;
            }
            const float e1 = __expf(tv[1] - tv[0]), e2 = __expf(tv[2] - tv[0]), e3 = __expf(tv[3] - tv[0]); const float inv = rcp_(1.f + e1 + e2 + e3);
            const size_t m = m0 + 4 * g + j;
            if (r == 0) { *(int4*)(TIDX + m * 4) = make_int4(ti[0], ti[1], ti[2], ti[3]); *(v4f*)(TGATE + m * 4) = (v4f){inv, e1 * inv, e2 * inv, e3 * inv}; }
            if (r < 4) lds_add(&hist[r == 0 ? ti[0] : r == 1 ? ti[1] : r == 2 ? ti[2] : ti[3]], 1);
        }
    };
    const int NT16 = T / 16, nfull = (NT16 / NGW) * NGW;
#pragma unroll 1
    for (int tile = gw; tile < nfull; tile += NGW) {
        const size_t m0 = (size_t)tile * 16;
#pragma unroll 1
        for (int t = 0; t < 16; t += 4) lnrows(m0 + t, std::integral_constant<int, 4>{});
        asm volatile("s_waitcnt vmcnt(0)" ::: "memory");
        route(m0);
    }
#pragma unroll 1
    for (int tile = nfull + vcu; tile < NT16; tile += G) {
        const size_t m0 = (size_t)tile * 16;
        ln2(m0 + 2 * wave);
        asm volatile("s_waitcnt vmcnt(0)" ::: "memory");
        __syncthreads();
        if (wave == 0) route(m0);
    }
    __syncthreads();
    if (tid < 32) atomicAdd(&ecnt[tid], (unsigned)hist[tid]);
}
__device__ __forceinline__ int build_tiles(const Ctx A, LAS unsigned char* lds, int l) {
    const int tid = opaque_tid();
    const unsigned* ecnt = (const unsigned*)(A.ws + WS_CTL) + CW_ECNT + 64 * l;
    LAS int* offs = (LAS int*)(lds + MISC_OFF + MI_OFFS); LAS int* tile_e = (LAS int*)(lds + MISC_OFF + MI_TILE); LAS int* nt = (LAS int*)(lds + MISC_OFF + MI_NT);
    __syncthreads();
    if (tid < 32) { int off = 0, mycnt = 0;
        for (int e = 0; e < 32; ++e) { const int c = (int)__hip_atomic_load(ecnt + e, __ATOMIC_RELAXED, __HIP_MEMORY_SCOPE_AGENT); if (e < tid) off += (c + 255) & ~255; if (e == tid) mycnt = c; }
        offs[tid] = off;
        const int t0 = off >> 8, t1 = (off + ((mycnt + 255) & ~255)) >> 8;
        for (int t = t0; t < t1; ++t) tile_e[t] = tid;
        if (tid == 31) nt[0] = t1; }
    __syncthreads();
    return nt[0];
}
__device__ PHASE_FN void moe_sort_phase(const Ctx A, LAS unsigned char* lds, int l) {
    const int tid = opaque_tid();
    const int* TIDX = (const int*)(A.ws + WS_TIDX); const float* TGATE = (const float*)(A.ws + WS_TGATE);
    int* SPOS = (int*)(A.ws + WS_SPOS); float* GSORT = (float*)(A.ws + WS_GSORT); int* RMAP = (int*)(A.ws + WS_RMAP);
    unsigned* ecur = (unsigned*)(A.ws + WS_CTL) + CW_ECUR + 64 * l; const unsigned* ecnt = (const unsigned*)(A.ws + WS_CTL) + CW_ECNT + 64 * l;
    LAS int* hist = (LAS int*)(lds + MISC_OFF + MI_HIST); LAS int* lcur = (LAS int*)(lds + MISC_OFF + MI_LCUR); LAS int* lbase = (LAS int*)(lds + MISC_OFF + MI_LBASE);
    LAS int* offs = (LAS int*)(lds + MISC_OFF + MI_OFFS);
    (void)build_tiles(A, lds, l);
    const int TPB = (T + (int)gridDim.x - 1) / (int)gridDim.x;
    const int mbeg = blockIdx.x * TPB, mend = (mbeg + TPB < T) ? mbeg + TPB : T;
    const int nslot = (mend > mbeg) ? (mend - mbeg) * 4 : 0;
    if (tid < 32) { hist[tid] = 0; lcur[tid] = 0; }
    __syncthreads();
    for (int s = tid; s < nslot; s += NTHR) lds_add(&hist[TIDX[(size_t)mbeg * 4 + s]], 1);
    __syncthreads();
    if (tid < 32) lbase[tid] = offs[tid] + (int)atomicAdd(&ecur[tid], (unsigned)hist[tid]);
    __syncthreads();
    for (int s = tid; s < nslot; s += NTHR) { const size_t gs = (size_t)mbeg * 4 + s; const int e = TIDX[gs];
        const int pos = lbase[e] + lds_add(&lcur[e], 1);
        SPOS[gs] = pos; GSORT[pos] = TGATE[gs]; RMAP[pos] = mbeg + (s >> 2); }
    if (blockIdx.x < 32) { const int e = blockIdx.x; const int c = (int)__hip_atomic_load(ecnt + e, __ATOMIC_RELAXED, __HIP_MEMORY_SCOPE_AGENT);
        const int p0 = offs[e] + c, p1 = offs[e] + ((c + 255) & ~255);
        for (int p = p0 + tid; p < p1; p += NTHR) RMAP[p] = 0; }
}
__device__ PHASE_FN void combine_ln_phase(const Ctx A, int l, int vcu, int G) {
    const int tid = opaque_tid(), lane = tid & 63, wave = tid >> 6;
    const int gw = vcu * NWAVES + wave, NGW = G * NWAVES;
    bf16* HB = (bf16*)(A.ws + WS_HB); const bf16* Y = (const bf16*)(A.ws + WS_YBUF); const int* SPOS = (const int*)(A.ws + WS_SPOS);
    const float* g = gin(A, 34) + l * D; const float* bb = gin(A, 35) + l * D;
#pragma unroll 1
    for (int m0 = 2 * gw; m0 < T; m0 += 2 * NGW) {
        v4f v[2][4];
#pragma unroll
        for (int t = 0; t < 2; ++t) { const int m = m0 + t;
            const int4 sp = *(const int4*)(SPOS + (size_t)m * 4);
#pragma unroll
            for (int j = 0; j < 4; ++j) { const size_t co = 256 * j + 4 * lane;
                const v4f y = ld_bf4(Y + (size_t)sp.x * D + co) + ld_bf4(Y + (size_t)sp.y * D + co) + ld_bf4(Y + (size_t)sp.z * D + co) + ld_bf4(Y + (size_t)sp.w * D + co);
                v[t][j] = ld_bf4(HB + (size_t)m * D + co) * ALPHA + y; } }
#pragma unroll
        for (int t = 0; t < 2; ++t) { const int m = m0 + t;
            ln_row(v[t], g, bb, lane);
            if (l == 0) {
#pragma unroll
                for (int j = 0; j < 4; ++j) st_bf4(HB + (size_t)m * D + 256 * j + 4 * lane, v[t][j]);
            } else {
                const int b = m / L, i = m - b * L;
                if (i >= NMETA) { float* o = (float*)(GAS float*)A.out + ((size_t)b * SEQ + (i - NMETA)) * D;
#pragma unroll
                    for (int j = 0; j < 4; ++j) *(v4f*)(o + 256 * j + 4 * lane) = v[t][j]; }
            }
        }
    }
}
constexpr int N_PHASES = 23;
#ifndef PH_ONLY
#define PH_ONLY -1
#endif
#define PHSEL(j) (PH_ONLY < 0 || PH_ONLY == (j))
#define IN(k) (lo <= (k) && (k) < hi)
#if MK_ONE_LAUNCH
#define GRID_BAR() xcd_barrier(bar)
#else
#define GRID_BAR() do { } while (0)
#endif
#define SEAM(k) do { if (IN(k) && IN((k) + 1)) GRID_BAR(); } while (0)
#define CTX() Ctx{args.in, args.out, launder(args.ws)}
#ifndef PROBE_PHASE
#define PROBE_PHASE -1
#endif
#ifndef PROBE_MULT
#define PROBE_MULT 4
#endif
#define PB_BEGIN(j) do { if (PROBE_PHASE == (j)) { pstamp = __builtin_amdgcn_s_memrealtime(); } } while (0)
#define PB_END(j) do { if (PROBE_PHASE == (j)) { pacc += __builtin_amdgcn_s_memrealtime() - pstamp; } } while (0)
__device__ __forceinline__ void layer_phases(const int l, const Args& args, LAS unsigned char* lds, const int G, const int bx, const int vcu, const int lo, const int hi, const XcdBarrier& bar, unsigned long long& pacc) {
    unsigned long long pstamp = 0ull; (void)pstamp;

        const int pb = 1 + 11 * l;
        PB_BEGIN(0);
        if (PHSEL(0) && IN(pb + 0)) { GAS unsigned char* wsl = launder(args.ws);
            pg8::Gemm g{(const pg8::bf16_t*)(wsl + WS_HB), (const pg8::bf16_t*)(wsl + WS_WIN) + (size_t)l * NINP * 1024, TP, NINP, 1024};
            pg8::StaticOrder S; S.init(TP, NINP, G, bx);
            pg8::EpiStoreBf16 E{(pg8::bf16_t*)(wsl + WS_PROJ), NINP};
            pg8::gemm_phase<pg8::EpiStoreBf16, pg8::StaticOrder, true, true>(lds, g, S, E);
            SEAM(pb + 0); PB_END(0);
        }
        PB_BEGIN(1);
        if (PHSEL(1) && IN(pb + 1)) { prep_phase(CTX(), lds, l, vcu, G); SEAM(pb + 1); PB_END(1); }
        PB_BEGIN(2);
        if (PHSEL(2) && IN(pb + 2)) { chunk_prep_phase(CTX(), vcu, G); lru_agg_phase(CTX(), vcu, G); SEAM(pb + 2); PB_END(2); }
        PB_BEGIN(3);
        if (PHSEL(3) && IN(pb + 3)) {
#ifndef PH2_SEL
#define PH2_SEL 15
#endif
            PB_BEGIN(20); PB_BEGIN(21); PB_BEGIN(22); PB_BEGIN(23);
#if SCAN_SEQ
            if ((PH2_SEL & 1) && bx < 64) rwkv_scan(CTX(), lds, bx); else if ((PH2_SEL & 2) && bx >= 64 && bx < 128) hgrn_scan(CTX(), lds, bx - 64); else if ((PH2_SEL & 4) && bx >= 128 && bx < 132) lru_carry_phase(CTX(), 128);
#else
            if ((PH2_SEL & 1) && bx < 16) chunk_scan<true>(CTX(), lds, bx); else if ((PH2_SEL & 2) && bx >= 16 && bx < 32) chunk_scan<false>(CTX(), lds, bx - 16); else if ((PH2_SEL & 4) && bx >= 32 && bx < 36) lru_carry_phase(CTX(), 32);
#endif
            __syncthreads();
            PB_END(20); PB_END(21); PB_END(22);
#if DSA_NAIVE
            if (PH2_SEL & 8) dsa_phase(CTX(), lds, l);
#else
            if (PH2_SEL & 8) dsa_select_phase(CTX(), lds, l);
#endif
            __syncthreads();
            PB_END(23);
            SEAM(pb + 3); PB_END(3);
        }
        PB_BEGIN(4);
        if (PHSEL(4) && IN(pb + 4)) {
            PB_BEGIN(24);
            lru_out_phase(CTX(), vcu, G);
            mixers_finish(CTX(), l, vcu, G);
            __syncthreads(); PB_END(24);
#if !DSA_NAIVE
            dsa_attn_phase(CTX(), lds, l);
#endif
            SEAM(pb + 4); PB_END(4);
        }
        PB_BEGIN(5);
        if (PHSEL(5) && IN(pb + 5)) { GAS unsigned char* wsl = launder(args.ws);
            pg8::Gemm g{(const pg8::bf16_t*)(wsl + WS_MIX), (const pg8::bf16_t*)(wsl + WS_WOUT) + (size_t)l * 1024 * 1024, TP, 1024, 1024};
            pg8::StaticOrder S; S.init(TP, 1024, G, bx);
            pg8::EpiResidBf E{(pg8::bf16_t*)(wsl + WS_HB), 1024, ALPHA};
            pg8::gemm_phase<pg8::EpiResidBf, pg8::StaticOrder, true, true>(lds, g, S, E);
            SEAM(pb + 5); PB_END(5);
        }
        PB_BEGIN(6);
        if (PHSEL(6) && IN(pb + 6)) { ln_router_phase(CTX(), lds, l, vcu, G); SEAM(pb + 6); PB_END(6); }
        PB_BEGIN(7);
        if (PHSEL(7) && IN(pb + 7)) { moe_sort_phase(CTX(), lds, l); SEAM(pb + 7); PB_END(7); }
        PB_BEGIN(8);
        if (PHSEL(8) && IN(pb + 8)) { GAS unsigned char* wsl = launder(args.ws);
            const int nt = build_tiles(CTX(), lds, l);
            pg8::Gemm g{(const pg8::bf16_t*)(wsl + WS_HB), (const pg8::bf16_t*)(wsl + WS_W1) + (size_t)l * 32 * 2048 * 1024, RMAX, 32 * 2048, 1024};
            pg8::MoeOrder S{nt * 8, G, vcu, 8, (const LAS int*)(lds + MISC_OFF + MI_TILE)};
            pg8::EpiSwiGLU E{(pg8::bf16_t*)(wsl + WS_ACT), (const float*)(const GAS float*)args.in[31] + (size_t)l * 32 * 2048};
            pg8::gemm_phase_gather<pg8::EpiSwiGLU, pg8::MoeOrder>(lds, g, S, E, (const int*)(wsl + WS_RMAP));
            SEAM(pb + 8); PB_END(8);
        }
        PB_BEGIN(9);
        if (PHSEL(9) && IN(pb + 9)) { GAS unsigned char* wsl = launder(args.ws);
            const int nt = build_tiles(CTX(), lds, l);
            pg8::Gemm g{(const pg8::bf16_t*)(wsl + WS_ACT), (const pg8::bf16_t*)(wsl + WS_W2) + (size_t)l * 32 * 1024 * 1024, RMAX, 32 * 1024, 1024};
            pg8::MoeOrder S{nt * 4, G, vcu, 4, (const LAS int*)(lds + MISC_OFF + MI_TILE)};
            pg8::EpiMoeOut E{(pg8::bf16_t*)(wsl + WS_YBUF), (const float*)(const GAS float*)args.in[33] + (size_t)l * 32 * 1024, (const float*)(wsl + WS_GSORT)};
            pg8::gemm_phase<pg8::EpiMoeOut, pg8::MoeOrder, true, true>(lds, g, S, E);
            SEAM(pb + 9); PB_END(9);
        }
        PB_BEGIN(10);
        if (PHSEL(10) && IN(pb + 10)) { combine_ln_phase(CTX(), l, vcu, G); SEAM(pb + 10); PB_END(10); }
}
__global__ void __launch_bounds__(NTHR, 2) trunk_fwd(Args args) {
    extern __shared__ __attribute__((aligned(16))) unsigned char lds_raw[];
    LAS unsigned char* lds = (LAS unsigned char*)lds_raw;
    const int tid = threadIdx.x;
    const int G = gridDim.x; const int bx = blockIdx.x; const int vcu = (G % 8 == 0) ? (bx % 8) * (G / 8) + bx / 8 : bx;
    unsigned* ctl = (unsigned*)(args.ws + WS_CTL);
    for (int u = tid; u < (LDS_BYTES - MISC_OFF) / 4; u += NTHR) ((LAS unsigned*)(lds + MISC_OFF))[u] = 0u;
    __syncthreads();
#if MK_ONE_LAUNCH
    XcdBarrier bar = xcd_barrier_post(ctl + CW_BAR, (volatile LAS unsigned*)(lds + MISC_OFF + MI_BAR));
#else
    XcdBarrier bar; bar.bar = ctl + CW_BAR; bar.x = 0; bar.st = nullptr;
#endif
    const int lo = args.ph_lo, hi = args.ph_hi;

    unsigned long long pacc = 0ull, pstamp = 0ull; (void)pstamp;
    PB_BEGIN(11);
    if (PHSEL(11) && IN(0)) { p0_prologue(CTX(), lds, vcu, G); SEAM(0); }
    PB_END(11);

#pragma unroll 1
    for (int l = 0; l < 2; ++l) layer_phases(l, args, lds, G, bx, vcu, lo, hi, bar, pacc);
    if (PROBE_PHASE >= 0 && bx == (PROBE_PHASE == 21 ? 16 : PROBE_PHASE == 22 ? 32 : PROBE_PHASE == 23 ? 255 : 0)) { const unsigned long long t0 = __builtin_amdgcn_s_memrealtime(); while (__builtin_amdgcn_s_memrealtime() - t0 < pacc * PROBE_MULT) __builtin_amdgcn_s_sleep(8); }
#undef IN
#undef SEAM
}

extern "C" void kernel_launch(void* const* d_in, const int* in_sizes, int n_in, void* d_out, int out_size, void* d_ws, size_t ws_size, hipStream_t stream) {
    static int grid = 0;
    if (grid == 0) {
        if (n_in != 36 || in_sizes[0] != NB * SEQ * D || out_size != NB * SEQ * D || ws_size < WS_END) {
            fprintf(stderr, "kernel_launch: unexpected problem (n_in %d, in0 %d, out %d, ws %zu, need %zu); nothing launched\n", n_in, n_in > 0 ? in_sizes[0] : -1, out_size, ws_size, (size_t)WS_END); grid = -1; return; }
        int dev = 0, cus = 0, per_cu = 0;
        if (hipGetDevice(&dev) != hipSuccess || hipDeviceGetAttribute(&cus, hipDeviceAttributeMultiprocessorCount, dev) != hipSuccess) { grid = -1; return; }
        if (hipFuncSetAttribute((const void*)trunk_fwd, hipFuncAttributeMaxDynamicSharedMemorySize, LDS_BYTES) != hipSuccess) { fprintf(stderr, "kernel_launch: hipFuncSetAttribute failed\n"); grid = -1; return; }
        if (hipOccupancyMaxActiveBlocksPerMultiprocessor(&per_cu, (const void*)trunk_fwd, NTHR, LDS_BYTES) != hipSuccess || per_cu < 1) { fprintf(stderr, "kernel_launch: occupancy query says %d\n", per_cu); (void)hipGetLastError(); }
        grid = cus;
        if (grid < 160 || grid > 512) { fprintf(stderr, "kernel_launch: unsupported CU count %d\n", cus); grid = -1; return; }
    }
    if (grid < 0) return;
    if (hipMemsetAsync((char*)d_ws + WS_CTL, 0, CTL_ZERO_BYTES, stream) != hipSuccess) return;
    Args a; memset(&a, 0, sizeof(a));
    for (int i = 0; i < 36; ++i) a.in[i] = (const float*)d_in[i];
    a.out = (float*)d_out; a.ws = (unsigned char*)d_ws;
#if MK_ONE_LAUNCH
    a.ph_lo = 0; a.ph_hi = N_PHASES;
    hipLaunchKernelGGL(trunk_fwd, dim3(grid), dim3(NTHR), LDS_BYTES, stream, a);
#else
    for (int p = 0; p < N_PHASES; ++p) { a.ph_lo = p; a.ph_hi = p + 1; hipLaunchKernelGGL(trunk_fwd, dim3(grid), dim3(NTHR), LDS_BYTES, stream, a); }
#endif
}
```

```cpp
#include <hip/hip_runtime.h>
#include <cstdio>
#include <cstdint>
#include <cstring>

#ifndef MK_ONE_LAUNCH
#define MK_ONE_LAUNCH 1
#endif

#ifndef SCAN_SEQ
#define SCAN_SEQ 0
#endif
#ifndef SCAN_MIX
#define SCAN_MIX 0
#endif
#ifndef DSA_NAIVE
#define DSA_NAIVE 0
#endif
#ifndef PHASE_FN
#define PHASE_FN __forceinline__
#endif
#define GAS __attribute__((address_space(1)))
#define LAS __attribute__((address_space(3)))
typedef unsigned short bf16;
typedef unsigned v4u __attribute__((ext_vector_type(4)));
typedef unsigned v2u __attribute__((ext_vector_type(2)));
typedef float v4f __attribute__((ext_vector_type(4)));
typedef float v2f __attribute__((ext_vector_type(2)));

constexpr int NB = 8, SEQ = 8192, NMETA = 16, L = SEQ + NMETA  , T = NB * L  , TP = 65792  , D = 1024;
constexpr int NINP = 3584;
constexpr int NE = 32, TOPK = 4;
constexpr int RMAX = 1058 * 256;
constexpr int C_RW = 0, C_RW_R = 0, C_RW_WD = 256, C_RW_K = 320, C_RW_V = 576, C_RW_AD = 832, C_RW_GD = 896;
constexpr int C_DS_Q = 960, C_DS_K = 1216, C_DS_V = 1472, C_DS_QI = 1728, C_DS_KI = 1984, C_DS_WI = 2016;
constexpr int C_LR_X = 2024, C_LR_G = 2280;
constexpr int C_HG_Q = 2536, C_HG_F = 2792, C_HG_I = 3048, C_HG_G = 3304;
constexpr float ALPHA = 1.41421356237f;
constexpr float LN_EPS = 1e-5f;

constexpr size_t MiB = 1u << 20;
constexpr size_t WS_CTL = 0, CTL_ZERO_BYTES = 1 * MiB;
constexpr size_t WS_FRAG = 1 * MiB, FRAG_LAYER = (96 + 64) * 1024;
constexpr size_t WS_WIN = 2 * MiB;
constexpr size_t WS_WOUT = 16 * MiB;
constexpr size_t WS_W1 = 20 * MiB;
constexpr size_t WS_W2 = 276 * MiB;
constexpr size_t WS_H = 404 * MiB;
constexpr size_t WS_MIX = WS_H;
constexpr size_t WS_HB = 661 * MiB;
constexpr size_t WS_BIG = 790 * MiB;
constexpr size_t WS_PROJ = WS_BIG;
constexpr size_t SZ_HM32 = (size_t)32 * L * 64 * 4;
constexpr size_t SZ_HM16 = SZ_HM32 / 2;
constexpr size_t SZ_TM16 = (size_t)T * 256 * 2;
constexpr size_t WS_RW_W = 1240 * MiB;
constexpr size_t WS_RW_A = WS_RW_W + SZ_HM32, WS_RW_B = WS_RW_A + SZ_HM16, WS_RW_K = WS_RW_B + SZ_HM16, WS_RW_WR = WS_RW_K + SZ_HM16, WS_RW_V = WS_RW_WR + SZ_HM16;
constexpr size_t WS_RW_G = WS_RW_V + SZ_HM16;
constexpr size_t WS_RW_SC = WS_RW_G + SZ_TM16;
constexpr size_t WS_DS_Q = WS_RW_SC + (size_t)32 * L * 16;
constexpr size_t WS_DS_K = WS_DS_Q + SZ_TM16, WS_DS_V = WS_DS_K + SZ_TM16, WS_DS_QI = WS_DS_V + SZ_TM16;
constexpr size_t WS_DS_KI = WS_DS_QI + SZ_TM16;
constexpr size_t WS_DS_WI = WS_DS_KI + (size_t)T * 64;
constexpr size_t WS_LR_A = WS_DS_WI + (size_t)T * 32;
constexpr size_t WS_LR_U = WS_LR_A + (size_t)T * 1024, WS_LR_G = WS_LR_U + SZ_TM16;
constexpr size_t WS_HG_F = WS_LR_G + SZ_TM16;
constexpr size_t WS_HG_K = WS_HG_F + SZ_HM32, WS_HG_Q = WS_HG_K + SZ_HM16, WS_HG_V = WS_HG_Q + SZ_HM16, WS_HG_G = WS_HG_V + SZ_HM16;
constexpr size_t WS_MIX_END = WS_HG_G + SZ_TM16;
constexpr size_t SZ_SORT = (size_t)RMAX * 1024 * 2;
constexpr size_t WS_SORTA = WS_BIG, WS_YBUF = WS_BIG, WS_ACT = WS_BIG + SZ_SORT;
constexpr size_t WS_TIDX = WS_ACT + SZ_SORT;
constexpr size_t WS_TGATE = WS_TIDX + (size_t)T * 16;
constexpr size_t WS_SPOS = WS_TGATE + (size_t)T * 16;
constexpr size_t WS_GSORT = WS_SPOS + (size_t)T * 16;
constexpr size_t WS_RMAP = WS_GSORT + (size_t)RMAX * 4;
constexpr size_t WS_MOE_END = WS_RMAP + (size_t)RMAX * 4;
constexpr size_t WS_END = 2040 * MiB;
static_assert(WS_MIX_END <= WS_END && WS_MOE_END <= WS_END, "workspace map");
static_assert(WS_PROJ + (size_t)TP * NINP * 2 <= WS_RW_W, "proj vs prep");
static_assert(WS_HB + (size_t)TP * 1024 * 2 <= WS_BIG && WS_H + (size_t)TP * 4096 <= WS_HB, "h/hb");

constexpr int CW_TMO = 0, CW_CODE = 1;
constexpr int CW_BAR = 4096;
constexpr int CW_DSAQ = 8192;
constexpr int CW_ECNT = 8448;
constexpr int CW_ECUR = 8704;

constexpr int LDS_BYTES = 163840;
constexpr int MISC_OFF = 155648;
constexpr int MI_BAR = 0, MI_HIST = 64, MI_LCUR = 192, MI_LBASE = 320, MI_NT = 448, MI_OFFS = 512, MI_TILE = 1024;
constexpr int NWAVES = 8, NTHR = 512;

__device__ __forceinline__ float bf2f(unsigned short x) { return __uint_as_float((unsigned)x << 16); }
__device__ __forceinline__ float bflo(unsigned x) { return __uint_as_float(x << 16); }
__device__ __forceinline__ float bfhi(unsigned x) { return __uint_as_float(x & 0xffff0000u); }
typedef float f32x2_t __attribute__((ext_vector_type(2))); typedef __bf16 bf16x2_t __attribute__((ext_vector_type(2)));
__device__ __forceinline__ unsigned pk2(float lo, float hi) { const f32x2_t v = {lo, hi}; const bf16x2_t b = __builtin_convertvector(v, bf16x2_t); return __builtin_bit_cast(unsigned, b); }
__device__ __forceinline__ bf16 f2bf(float f) { return (bf16)(pk2(f, 0.f) & 0xffffu); }
__device__ __forceinline__ v4f ld_bf4(const bf16* p) { const v2u x = *(const v2u*)p; return (v4f){bflo(x.x), bfhi(x.x), bflo(x.y), bfhi(x.y)}; }
__device__ __forceinline__ void st_bf4(bf16* p, v4f v) { v2u o; o.x = pk2(v.x, v.y); o.y = pk2(v.z, v.w); *(v2u*)p = o; }
__device__ __forceinline__ float wave_max(float v) {
#pragma unroll
    for (int o = 1; o < 64; o <<= 1) v = fmaxf(v, __shfl_xor(v, o));
    return v;
}
template <int CTRL> __device__ __forceinline__ float dpp_f(float x) { return __int_as_float(__builtin_amdgcn_update_dpp(0, __float_as_int(x), CTRL, 0xF, 0xF, true)); }
__device__ __forceinline__ float sum8(float x) { x += dpp_f<0xB1>(x); x += dpp_f<0x4E>(x); x += dpp_f<0x141>(x); return x; }
__device__ __forceinline__ float sum16(float x) { x = sum8(x); x += dpp_f<0x140>(x); return x; }
__device__ __forceinline__ float wave_sum(float v) {
    v = sum16(v);
    v += __shfl_xor(v, 16); v += __shfl_xor(v, 32);
    return v;
}
__device__ __forceinline__ float rcp_(float x) { return __builtin_amdgcn_rcpf(x); }
__device__ __forceinline__ float rsq_(float x) { return __builtin_amdgcn_rsqf(x); }
__device__ __forceinline__ float sigmoidf_(float x) { return rcp_(1.f + __expf(-x)); }
__device__ __forceinline__ float softplusf_(float x) { return x > 20.f ? x : log1pf(__expf(x)); }
__device__ __forceinline__ float gelu_tanh(float x) { const float u = 0.7978845608028654f * (x + 0.044715f * x * x * x); return 0.5f * x * (1.f + tanhf(u)); }
__device__ __forceinline__ int lds_add(LAS int* p, int v) { return __hip_atomic_fetch_add(p, v, __ATOMIC_RELAXED, __HIP_MEMORY_SCOPE_WORKGROUP); }
#define LDS_WAIT() asm volatile("s_waitcnt lgkmcnt(0)" ::: "memory")
#define VM_WAIT() asm volatile("s_waitcnt vmcnt(0)" ::: "memory")

__device__ __forceinline__ GAS unsigned char* launder(unsigned char* p) { GAS unsigned char* g = (GAS unsigned char*)p; asm volatile("" : "+s"(g)); return g; }
__device__ __forceinline__ int opaque_tid() { int t = (int)threadIdx.x; asm volatile("" : "+v"(t)); return t; }
__device__ __forceinline__ int opaque_s(int x) { return __builtin_amdgcn_readfirstlane(x); }
struct Args { const float* in[36]; float* out; unsigned char* ws; int ph_lo, ph_hi; };
struct Ctx { const float* const* in; float* out; GAS unsigned char* ws; };
__device__ __forceinline__ const float* gin(const Ctx& A, int k) { return (const float*)(const GAS float*)A.in[k]; }
namespace pg8 {
#define PG8_LAS __attribute__((address_space(3)))
typedef unsigned short bf16_t;
typedef short bf16x8 __attribute__((ext_vector_type(8)));
typedef float f32x4 __attribute__((ext_vector_type(4)));
typedef unsigned u32x4 __attribute__((ext_vector_type(4)));
constexpr int BM = 256, BK = 64, HALF = 128, HTB = HALF * BK * 2  , STAGE_BYTES = 8 * HTB, NXCD = 8, WGM = 8;

__host__ __device__ __forceinline__ int lds_byte(int r, int c) { const int st = (r >> 4) * 2 + (c >> 5), rr = r & 15, cc = c & 31, ob = rr * 64 + cc * 2; return st * 1024 + (ob ^ (((ob >> 9) & 1) << 5)); }
__host__ __device__ __forceinline__ void stage_rc(int b, int& R, int& C) { const int st = b / 1024, sb = b % 1024, swz = sb ^ (((sb >> 9) & 1) << 5); R = (st >> 1) * 16 + swz / 64; C = (st & 1) * 32 + (swz % 64) / 2; }
__host__ __device__ __forceinline__ int perm32(int rho) { const int n = rho >> 4, i = rho & 15; return 8 * (i >> 2) + 4 * n + (i & 3); }

struct Unit { int pm, pn; };
struct Gemm { const bf16_t* A; const bf16_t* Bt; int M, N, K; };

struct StaticOrder {
    int nM, nN, nwg, G, c;
    __host__ __device__ void init(int M, int N, int G_, int c_) { nM = M / BM; nN = N / BM; nwg = nM * nN; G = G_; c = c_; }
    __host__ __device__ bool next(int i, Unit& u) const {
        const long L = (long)i * G + c; if (L >= nwg) return false;
        int wgid = (int)L; { const int q = nwg / NXCD, r = nwg % NXCD, xcd = wgid % NXCD, off = wgid / NXCD; wgid = (xcd < r ? xcd * (q + 1) : r * (q + 1) + (xcd - r) * q) + off; }
        const int nig = WGM * nN, gid = wgid / nig, fm = gid * WGM, gsz = (nM - fm) < WGM ? (nM - fm) : WGM;
        u.pm = fm + ((wgid % nig) % gsz); u.pn = (wgid % nig) / gsz; return true;
    }
    __device__ __forceinline__ void a_ready(const Unit&) const {}
    __device__ __forceinline__ void done(const Unit&) const {}
};

__device__ __forceinline__ unsigned cvt_pk_bf16(float lo, float hi) { unsigned r; asm volatile("v_cvt_pk_bf16_f32 %0, %1, %2" : "=v"(r) : "v"(lo), "v"(hi)); return r; }
typedef float f32x2 __attribute__((ext_vector_type(2)));
typedef unsigned u32x2v __attribute__((ext_vector_type(2)));
typedef float pf32x2_t __attribute__((ext_vector_type(2))); typedef __bf16 pbf16x2_t __attribute__((ext_vector_type(2)));
__device__ __forceinline__ unsigned cvt_pk_bf16c(float lo, float hi) { const pf32x2_t v = {lo, hi}; const pbf16x2_t q = __builtin_convertvector(v, pbf16x2_t); return __builtin_bit_cast(unsigned, q); }
struct EpiStoreBf16 {
    static constexpr bool PERM = true, AFTER_DRAIN = false;
    bf16_t* O; int ldc;
    __device__ __forceinline__ void operator()(const f32x4 (&acc)[2][2][4][2], const Unit& u, int wr, int wc, int fr, int fq) const {
        const int row0 = u.pm * BM + wr * 64 + fr, col0 = u.pn * BM + wc * 32 + 8 * fq;
#pragma unroll
        for (int ai = 0; ai < 2; ++ai)
#pragma unroll
            for (int m = 0; m < 4; ++m) { bf16_t* rowp = O + (size_t)(row0 + ai * HALF + m * 16) * ldc + col0;
#pragma unroll
                for (int bj = 0; bj < 2; ++bj) { const f32x4 v0 = acc[ai][bj][m][0], v1 = acc[ai][bj][m][1];
                    u32x4 w; w.x = cvt_pk_bf16c(v0[0], v0[1]); w.y = cvt_pk_bf16c(v0[2], v0[3]); w.z = cvt_pk_bf16c(v1[0], v1[1]); w.w = cvt_pk_bf16c(v1[2], v1[3]);
                    *(u32x4*)(rowp + bj * HALF) = w; } }
    }
};
struct EpiResid {
    static constexpr bool PERM = false, AFTER_DRAIN = false;
    float* Hres; int ldc; float alpha;
    __device__ __forceinline__ void operator()(const f32x4 (&acc)[2][2][4][2], const Unit& u, int wr, int wc, int fr, int fq) const {
        const int row0 = u.pm * BM + wr * 64 + fr, col0 = u.pn * BM + wc * 32 + 4 * fq;
#pragma unroll
        for (int ai = 0; ai < 2; ++ai)
#pragma unroll
            for (int m = 0; m < 4; ++m) { float* rowp = Hres + (size_t)(row0 + ai * HALF + m * 16) * ldc + col0;
#pragma unroll
                for (int bj = 0; bj < 2; ++bj)
#pragma unroll
                    for (int n = 0; n < 2; ++n) { f32x4* p = (f32x4*)(rowp + bj * HALF + n * 16); const f32x4 old = *p; *p = old * alpha + acc[ai][bj][m][n]; } }
    }
};
struct EpiResidBf {
    static constexpr bool PERM = true, AFTER_DRAIN = false;
    bf16_t* Hb; int ldc; float alpha;
    __device__ __forceinline__ void operator()(const f32x4 (&acc)[2][2][4][2], const Unit& u, int wr, int wc, int fr, int fq) const {
        const int row0 = u.pm * BM + wr * 64 + fr, col0 = u.pn * BM + wc * 32 + 8 * fq;
#pragma unroll
        for (int ai = 0; ai < 2; ++ai)
#pragma unroll
            for (int m = 0; m < 4; ++m) { bf16_t* rowp = Hb + (size_t)(row0 + ai * HALF + m * 16) * ldc + col0;
#pragma unroll
                for (int bj = 0; bj < 2; ++bj) { const f32x4 v0 = acc[ai][bj][m][0], v1 = acc[ai][bj][m][1]; const u32x4 o = *(const u32x4*)(rowp + bj * HALF);
#define RB_LO(x_) __builtin_bit_cast(float, (x_) << 16)
#define RB_HI(x_) __builtin_bit_cast(float, (x_) & 0xffff0000u)
                    u32x4 w; w.x = cvt_pk_bf16c(RB_LO(o.x) * alpha + v0[0], RB_HI(o.x) * alpha + v0[1]); w.y = cvt_pk_bf16c(RB_LO(o.y) * alpha + v0[2], RB_HI(o.y) * alpha + v0[3]);
                    w.z = cvt_pk_bf16c(RB_LO(o.z) * alpha + v1[0], RB_HI(o.z) * alpha + v1[1]); w.w = cvt_pk_bf16c(RB_LO(o.w) * alpha + v1[2], RB_HI(o.w) * alpha + v1[3]);
#undef RB_LO
#undef RB_HI
                    *(u32x4*)(rowp + bj * HALF) = w; } }
    }
};
struct EpiSwiGLU {
    static constexpr bool PERM = true, AFTER_DRAIN = false;
    bf16_t* ACT; const float* b1;
    __device__ __forceinline__ void operator()(const f32x4 (&acc)[2][2][4][2], const Unit& u, int wr, int wc, int fr, int fq) const {
        const int e = u.pn >> 3, pnl = u.pn & 7;
        const int row0 = u.pm * BM + wr * 64 + fr, c8 = pnl * 128 + wc * 32 + 8 * fq;
        const float* bg = b1 + (size_t)e * 2048 + c8; const float* bl = bg + 1024;
        const f32x4 bg0 = *(const f32x4*)bg, bg1 = *(const f32x4*)(bg + 4), bl0 = *(const f32x4*)bl, bl1 = *(const f32x4*)(bl + 4);
#pragma unroll
        for (int ai = 0; ai < 2; ++ai)
#pragma unroll
            for (int m = 0; m < 4; ++m) {
                float o[8];
#pragma unroll
                for (int n = 0; n < 2; ++n) { const f32x4 g4 = acc[ai][0][m][n] + (n ? bg1 : bg0), l4 = acc[ai][1][m][n] + (n ? bl1 : bl0);
#pragma unroll
                    for (int j = 0; j < 4; ++j) { const float glu = fminf(g4[j], 7.f), lin = fminf(fmaxf(l4[j], -7.f), 7.f);
                        o[n * 4 + j] = glu * __builtin_amdgcn_rcpf(1.f + __builtin_amdgcn_exp2f(glu * (-1.702f * 1.4426950408889634f))) * (lin + 1.f); } }
                u32x4 w; w.x = cvt_pk_bf16c(o[0], o[1]); w.y = cvt_pk_bf16c(o[2], o[3]); w.z = cvt_pk_bf16c(o[4], o[5]); w.w = cvt_pk_bf16c(o[6], o[7]);
                *(u32x4*)(ACT + (size_t)(row0 + ai * HALF + m * 16) * 1024 + c8) = w; }
    }
};
struct EpiMoeOut {
    static constexpr bool PERM = true, AFTER_DRAIN = false;
    bf16_t* Y; const float* b2; const float* gate;
    __device__ __forceinline__ void operator()(const f32x4 (&acc)[2][2][4][2], const Unit& u, int wr, int wc, int fr, int fq) const {
        const int e = u.pn >> 2, pnl = u.pn & 3;
        const int row0 = u.pm * BM + wr * 64 + fr, c8 = pnl * 256 + wc * 32 + 8 * fq;
        const float* bb = b2 + (size_t)e * 1024 + c8;
        f32x4 bv[2][2];
#pragma unroll
        for (int bj = 0; bj < 2; ++bj) { bv[bj][0] = *(const f32x4*)(bb + bj * HALF); bv[bj][1] = *(const f32x4*)(bb + bj * HALF + 4); }
#pragma unroll
        for (int ai = 0; ai < 2; ++ai)
#pragma unroll
            for (int m = 0; m < 4; ++m) { const int row = row0 + ai * HALF + m * 16; const float gt = gate[row];
#pragma unroll
                for (int bj = 0; bj < 2; ++bj) { const f32x4 v0 = (acc[ai][bj][m][0] + bv[bj][0]) * gt, v1 = (acc[ai][bj][m][1] + bv[bj][1]) * gt;
                    u32x4 w; w.x = cvt_pk_bf16c(v0[0], v0[1]); w.y = cvt_pk_bf16c(v0[2], v0[3]); w.z = cvt_pk_bf16c(v1[0], v1[1]); w.w = cvt_pk_bf16c(v1[2], v1[3]);
                    *(u32x4*)(Y + (size_t)row * 1024 + c8 + bj * HALF) = w; } }
    }
};
struct MoeOrder {
    int n_units, G, c, npn; const PG8_LAS int* tile_e;
    __device__ __forceinline__ bool next(int i, Unit& u) const {
        const int Lx = i * G + c; if (Lx >= n_units) return false;
        const int tile = Lx / npn, pnl = Lx - tile * npn;
        u.pm = tile; u.pn = tile_e[tile] * npn + pnl; return true;
    }
    __device__ __forceinline__ void a_ready(const Unit&) const {}
    __device__ __forceinline__ void done(const Unit&) const {}
};

template <class Epi, class Sched, bool ALIGN_EPI = false, bool SP2 = false>
__device__ __forceinline__ void gemm_phase(PG8_LAS unsigned char* lds, const Gemm g, const Sched& S, const Epi& E) {
    const int tid = opaque_tid(), wid = __builtin_amdgcn_readfirstlane(tid >> 6), lane = tid & 63, wr = wid >> 2, wc = wid & 3, fr = lane & 15, fq = lane >> 4;
    const int K = g.K, nt = K / BK;
    unsigned voffA[2], voffB[2];
#pragma unroll
    for (int i = 0; i < 2; ++i) { int R, C; stage_rc(tid * 16 + i * 8192, R, C); const int Rb = Epi::PERM ? ((R & ~31) + perm32(R & 31)) : R;
        voffA[i] = (unsigned)(R * K + C) * 2u; voffB[i] = (unsigned)(Rb * K + C) * 2u; }
    const size_t kstep = (size_t)(BK * 2);
    const size_t hstep = (size_t)HALF * K * 2;
    const size_t tstep = 2 * hstep;
    const unsigned ldsw = (unsigned)wid * 1024u;
    const int aoff = lds_byte(wr * 64 + fr, fq * 8), boff = lds_byte(wc * 32 + fr, fq * 8);
#define PG8_SA(b, h) (((b) * 2 + (h)) * HTB)
#define PG8_SB(b, h) ((4 + (b) * 2 + (h)) * HTB)
#define PG8_STAGE(bufoff, gbase, voff) do { _Pragma("unroll") for (int _i = 0; _i < 2; ++_i) \
        __builtin_amdgcn_global_load_lds((const unsigned*)((const char*)(gbase) + (voff)[_i]), (PG8_LAS unsigned*)(lds + (bufoff) + ldsw + _i * 8192), 16, 0, 0); } while (0)
#define PG8_LDA(dst, b, h) do { _Pragma("unroll") for (int m = 0; m < 4; ++m) _Pragma("unroll") for (int k = 0; k < 2; ++k) dst[m][k] = *(const PG8_LAS bf16x8*)(lds + PG8_SA(b, h) + aoff + m * 2048 + k * 1024); } while (0)
#define PG8_LDB(dst, b, h) do { _Pragma("unroll") for (int n = 0; n < 2; ++n) _Pragma("unroll") for (int k = 0; k < 2; ++k) dst[n][k] = *(const PG8_LAS bf16x8*)(lds + PG8_SB(b, h) + boff + n * 2048 + k * 1024); } while (0)
#define PG8_MMA(ai, bj, At, Bt) do { __builtin_amdgcn_s_setprio(1); _Pragma("unroll") for (int m = 0; m < 4; ++m) _Pragma("unroll") for (int n = 0; n < 2; ++n) _Pragma("unroll") for (int k = 0; k < 2; ++k) \
        acc[ai][bj][m][n] = __builtin_amdgcn_mfma_f32_16x16x32_bf16(Bt[n][k], At[m][k], acc[ai][bj][m][n], 0, 0, 0); __builtin_amdgcn_s_setprio(0); } while (0)
#define PG8_WAIT_V(n) asm volatile("s_waitcnt vmcnt(" #n ")" ::: "memory")
#define PG8_WAIT_L(n) asm volatile("s_waitcnt lgkmcnt(" #n ")" ::: "memory")
#define PG8_BAR __builtin_amdgcn_s_barrier()
#define PG8_SCHED __builtin_amdgcn_sched_barrier(0)
    Unit cur, nxt; int ui = 0;
    if (!S.next(0, cur)) return;
    f32x4 acc[2][2][4][2];
#pragma unroll
    for (int a = 0; a < 2; ++a)
#pragma unroll
        for (int b = 0; b < 2; ++b)
#pragma unroll
            for (int m = 0; m < 4; ++m)
#pragma unroll
                for (int n = 0; n < 2; ++n) acc[a][b][m][n] = (f32x4){0.f, 0.f, 0.f, 0.f};
    bf16x8 At[4][2], B0[2][2], B1[2][2];
    const char* cA = (const char*)g.A + (size_t)cur.pm * tstep; const char* cB = (const char*)g.Bt + (size_t)cur.pn * tstep;
    S.a_ready(cur);
    if constexpr (SP2) {
        PG8_STAGE(PG8_SB(0, 0), cB, voffB); PG8_STAGE(PG8_SB(0, 1), cB + hstep, voffB); PG8_STAGE(PG8_SA(0, 0), cA, voffA); PG8_STAGE(PG8_SA(0, 1), cA + hstep, voffA);
        if (wr == 1) PG8_BAR;
        PG8_WAIT_V(2); PG8_BAR;
        PG8_STAGE(PG8_SB(1, 0), cB + kstep, voffB); PG8_STAGE(PG8_SA(1, 0), cA + kstep, voffA); PG8_STAGE(PG8_SB(1, 1), cB + hstep + kstep, voffB);
        PG8_WAIT_V(6); PG8_BAR;
    } else {
        PG8_STAGE(PG8_SB(0, 0), cB, voffB); PG8_STAGE(PG8_SA(0, 0), cA, voffA); PG8_STAGE(PG8_SB(0, 1), cB + hstep, voffB); PG8_STAGE(PG8_SA(0, 1), cA + hstep, voffA);
        if (wr == 1) PG8_BAR;
        PG8_WAIT_V(4); PG8_BAR;
        PG8_STAGE(PG8_SB(1, 0), cB + kstep, voffB); PG8_STAGE(PG8_SA(1, 0), cA + kstep, voffA); PG8_STAGE(PG8_SB(1, 1), cB + hstep + kstep, voffB);
        PG8_WAIT_V(6); PG8_BAR;
    }
    for (;;) {
        const bool has_next = S.next(ui + 1, nxt);
        const char* nA = has_next ? (const char*)g.A + (size_t)nxt.pm * tstep : cA; const char* nB = has_next ? (const char*)g.Bt + (size_t)nxt.pn * tstep : cB;
        for (int t = 0; t < nt; t += 2) {
            const bool last = (t == nt - 2);
            const char* a1 = cA + (size_t)(t + 1) * kstep;
            const char* a2 = last ? nA : cA + (size_t)(t + 2) * kstep; const char* b2 = last ? nB : cB + (size_t)(t + 2) * kstep;
            const char* a3 = a2 + kstep; const char* b3 = b2 + kstep;
            if (last && has_next) S.a_ready(nxt);
            if constexpr (SP2) {
            PG8_LDB(B0, 0, 0); PG8_LDB(B1, 0, 1); PG8_SCHED; PG8_LDA(At, 0, 0); PG8_STAGE(PG8_SA(1, 1), a1 + hstep, voffA);
            PG8_WAIT_V(8); PG8_WAIT_L(0); PG8_BAR; PG8_MMA(0, 0, At, B0); PG8_MMA(0, 1, At, B1); PG8_BAR; PG8_SCHED;
            PG8_LDA(At, 0, 1); PG8_STAGE(PG8_SB(0, 0), b2, voffB); PG8_STAGE(PG8_SB(0, 1), b2 + hstep, voffB); PG8_STAGE(PG8_SA(0, 0), a2, voffA);
            PG8_WAIT_V(8); PG8_WAIT_L(0); PG8_BAR; PG8_MMA(1, 0, At, B0); PG8_MMA(1, 1, At, B1); PG8_BAR; PG8_SCHED;
            PG8_LDB(B0, 1, 0); PG8_LDB(B1, 1, 1); PG8_SCHED; PG8_LDA(At, 1, 0); PG8_STAGE(PG8_SA(0, 1), a2 + hstep, voffA);
            PG8_WAIT_V(8); PG8_WAIT_L(0); PG8_BAR; PG8_MMA(0, 0, At, B0); PG8_MMA(0, 1, At, B1); PG8_BAR; PG8_SCHED;
            PG8_LDA(At, 1, 1); PG8_STAGE(PG8_SB(1, 0), b3, voffB); PG8_STAGE(PG8_SB(1, 1), b3 + hstep, voffB); PG8_STAGE(PG8_SA(1, 0), a3, voffA);
            PG8_WAIT_V(8); PG8_WAIT_L(0); PG8_BAR; PG8_MMA(1, 0, At, B0); PG8_MMA(1, 1, At, B1); PG8_BAR; PG8_SCHED;
            } else {
            PG8_LDB(B0, 0, 0); PG8_SCHED; PG8_LDA(At, 0, 0); PG8_STAGE(PG8_SA(1, 1), a1 + hstep, voffA);
            PG8_WAIT_L(8); PG8_BAR; PG8_WAIT_L(0); PG8_MMA(0, 0, At, B0); PG8_BAR; PG8_SCHED;
            PG8_LDB(B1, 0, 1); PG8_STAGE(PG8_SB(0, 0), b2, voffB);
            PG8_BAR; PG8_WAIT_L(0); PG8_MMA(0, 1, At, B1); PG8_BAR;
            PG8_LDA(At, 0, 1); PG8_STAGE(PG8_SA(0, 0), a2, voffA);
            PG8_BAR; PG8_WAIT_L(0); PG8_MMA(1, 0, At, B0); PG8_BAR; PG8_SCHED;
            PG8_STAGE(PG8_SB(0, 1), b2 + hstep, voffB);
            PG8_WAIT_V(6); PG8_BAR; PG8_MMA(1, 1, At, B1); PG8_BAR;
            PG8_LDB(B0, 1, 0); PG8_SCHED; PG8_LDA(At, 1, 0); PG8_STAGE(PG8_SA(0, 1), a2 + hstep, voffA);
            PG8_WAIT_L(8); PG8_BAR; PG8_WAIT_L(0); PG8_MMA(0, 0, At, B0); PG8_BAR; PG8_SCHED;
            PG8_LDB(B1, 1, 1); PG8_STAGE(PG8_SB(1, 0), b3, voffB);
            PG8_BAR; PG8_WAIT_L(0); PG8_MMA(0, 1, At, B1); PG8_BAR;
            PG8_LDA(At, 1, 1); PG8_STAGE(PG8_SA(1, 0), a3, voffA);
            PG8_BAR; PG8_WAIT_L(0); PG8_MMA(1, 0, At, B0); PG8_BAR; PG8_SCHED;
            PG8_STAGE(PG8_SB(1, 1), b3 + hstep, voffB);
            PG8_WAIT_V(6); PG8_BAR; PG8_MMA(1, 1, At, B1); PG8_BAR;
            }
        }
        if constexpr (ALIGN_EPI) { if (wr == 0) PG8_BAR; }
        if constexpr (!Epi::AFTER_DRAIN) { E(acc, cur, wr, wc, fr, fq); S.done(cur); }
        if (!has_next) break;
#pragma unroll
        for (int a = 0; a < 2; ++a)
#pragma unroll
            for (int b = 0; b < 2; ++b)
#pragma unroll
                for (int m = 0; m < 4; ++m)
#pragma unroll
                    for (int n = 0; n < 2; ++n) acc[a][b][m][n] = (f32x4){0.f, 0.f, 0.f, 0.f};
        cur = nxt; cA = nA; cB = nB; ++ui;
        if constexpr (ALIGN_EPI) { if (wr == 1) PG8_BAR; }
    }
    PG8_WAIT_V(0);
    if constexpr (!ALIGN_EPI) { if (wr == 0) PG8_BAR; }
    PG8_BAR;
    if constexpr (Epi::AFTER_DRAIN) { E.fused(acc, cur, wr, wc, fr, fq, lds, wid, lane); S.done(cur); }
#undef PG8_SA
#undef PG8_SB
#undef PG8_STAGE
#undef PG8_LDA
#undef PG8_LDB
#undef PG8_MMA
#undef PG8_WAIT_V
#undef PG8_WAIT_L
#undef PG8_BAR
#undef PG8_SCHED
}
}
namespace pg8 {
template <class Epi, class Sched>
__device__ __forceinline__ void gemm_phase_gather(PG8_LAS unsigned char* lds, const Gemm g, const Sched& S, const Epi& E, const int* rmap) {
    constexpr bool ALIGN_EPI = true, SP2 = true;
    const int tid = opaque_tid(), wid = __builtin_amdgcn_readfirstlane(tid >> 6), lane = tid & 63, wr = wid >> 2, wc = wid & 3, fr = lane & 15, fq = lane >> 4;
    const int K = g.K, nt = K / BK;
    unsigned voffB[2];
#pragma unroll
    for (int i = 0; i < 2; ++i) { int R, C; stage_rc(tid * 16 + i * 8192, R, C); const int Rb = Epi::PERM ? ((R & ~31) + perm32(R & 31)) : R;
        voffB[i] = (unsigned)(Rb * K + C) * 2u; }
    const size_t kstep = (size_t)(BK * 2);
    const size_t hstep = (size_t)HALF * K * 2;
    const size_t tstep = 2 * hstep;
    const unsigned ldsw = (unsigned)wid * 1024u;
    const int aoff = lds_byte(wr * 64 + fr, fq * 8), boff = lds_byte(wc * 32 + fr, fq * 8);
#define PG8_SA(b, h) (((b) * 2 + (h)) * HTB)
#define PG8_SB(b, h) ((4 + (b) * 2 + (h)) * HTB)
#define PG8_STAGE(bufoff, gbase, voff) do { _Pragma("unroll") for (int _i = 0; _i < 2; ++_i) \
        __builtin_amdgcn_global_load_lds((const unsigned*)((const char*)(gbase) + (voff)[_i]), (PG8_LAS unsigned*)(lds + (bufoff) + ldsw + _i * 8192), 16, 0, 0); } while (0)
#define PG8_LDA(dst, b, h) do { _Pragma("unroll") for (int m = 0; m < 4; ++m) _Pragma("unroll") for (int k = 0; k < 2; ++k) dst[m][k] = *(const PG8_LAS bf16x8*)(lds + PG8_SA(b, h) + aoff + m * 2048 + k * 1024); } while (0)
#define PG8_LDB(dst, b, h) do { _Pragma("unroll") for (int n = 0; n < 2; ++n) _Pragma("unroll") for (int k = 0; k < 2; ++k) dst[n][k] = *(const PG8_LAS bf16x8*)(lds + PG8_SB(b, h) + boff + n * 2048 + k * 1024); } while (0)
#define PG8_MMA(ai, bj, At, Bt) do { __builtin_amdgcn_s_setprio(1); _Pragma("unroll") for (int m = 0; m < 4; ++m) _Pragma("unroll") for (int n = 0; n < 2; ++n) _Pragma("unroll") for (int k = 0; k < 2; ++k) \
        acc[ai][bj][m][n] = __builtin_amdgcn_mfma_f32_16x16x32_bf16(Bt[n][k], At[m][k], acc[ai][bj][m][n], 0, 0, 0); __builtin_amdgcn_s_setprio(0); } while (0)
#define PG8_WAIT_V(n) asm volatile("s_waitcnt vmcnt(" #n ")" ::: "memory")
#define PG8_WAIT_L(n) asm volatile("s_waitcnt lgkmcnt(" #n ")" ::: "memory")
#define PG8_BAR __builtin_amdgcn_s_barrier()
#define PG8_SCHED __builtin_amdgcn_sched_barrier(0)
    Unit cur, nxt; int ui = 0;
    if (!S.next(0, cur)) return;
    f32x4 acc[2][2][4][2];
#pragma unroll
    for (int a = 0; a < 2; ++a)
#pragma unroll
        for (int b = 0; b < 2; ++b)
#pragma unroll
            for (int m = 0; m < 4; ++m)
#pragma unroll
                for (int n = 0; n < 2; ++n) acc[a][b][m][n] = (f32x4){0.f, 0.f, 0.f, 0.f};
    bf16x8 At[4][2], B0[2][2], B1[2][2];
    const char* gA = (const char*)g.A; const char* cB = (const char*)g.Bt + (size_t)cur.pn * tstep;
    unsigned gofc[2][2];
    constexpr int RM_OFF = 8 * HTB;
#pragma unroll
    for (int i_ = 0; i_ < 2; ++i_) { int R, C; stage_rc(tid * 16 + i_ * 8192, R, C);
#pragma unroll
        for (int h_ = 0; h_ < 2; ++h_) gofc[h_][i_] = (unsigned)rmap[(size_t)cur.pm * BM + h_ * HALF + R] * (unsigned)(K * 2) + (unsigned)C * 2u; }
    S.a_ready(cur);
    if constexpr (SP2) {
        PG8_STAGE(PG8_SB(0, 0), cB, voffB); PG8_STAGE(PG8_SB(0, 1), cB + hstep, voffB); PG8_STAGE(PG8_SA(0, 0), gA, gofc[0]); PG8_STAGE(PG8_SA(0, 1), gA, gofc[1]);
        if (wr == 1) PG8_BAR;
        PG8_WAIT_V(2); PG8_BAR;
        PG8_STAGE(PG8_SB(1, 0), cB + kstep, voffB); PG8_STAGE(PG8_SA(1, 0), gA + kstep, gofc[0]); PG8_STAGE(PG8_SB(1, 1), cB + hstep + kstep, voffB);
        PG8_WAIT_V(6); PG8_BAR;
    }
    for (;;) {
        const bool has_next = S.next(ui + 1, nxt);
        const char* nB = has_next ? (const char*)g.Bt + (size_t)nxt.pn * tstep : cB;
        if (has_next) { const unsigned rmoff = (unsigned)(opaque_tid() & 255) * 4u;
            __builtin_amdgcn_global_load_lds((const unsigned*)((const char*)(rmap + (size_t)nxt.pm * BM) + rmoff), (PG8_LAS unsigned*)(lds + RM_OFF + wid * 256), 4, 0, 0); }
        for (int t = 0; t < nt; t += 2) {
            const bool last = (t == nt - 2);
            const char* a1 = gA + (size_t)(t + 1) * kstep;
            const char* a2 = last ? gA : gA + (size_t)(t + 2) * kstep; const char* b2 = last ? nB : cB + (size_t)(t + 2) * kstep;
            const char* a3 = a2 + kstep; const char* b3 = b2 + kstep;
            if (last && has_next) S.a_ready(nxt);
            if constexpr (SP2) {
            PG8_LDB(B0, 0, 0); PG8_LDB(B1, 0, 1); PG8_SCHED; PG8_LDA(At, 0, 0); PG8_STAGE(PG8_SA(1, 1), a1, gofc[1]);
            PG8_WAIT_V(8); PG8_WAIT_L(0); PG8_BAR; PG8_MMA(0, 0, At, B0); PG8_MMA(0, 1, At, B1); PG8_BAR; PG8_SCHED;
            if (last && has_next) { const int tid2 = opaque_tid();
#pragma unroll
                for (int i_ = 0; i_ < 2; ++i_) { int R, C; stage_rc(tid2 * 16 + i_ * 8192, R, C);
#pragma unroll
                    for (int h_ = 0; h_ < 2; ++h_) gofc[h_][i_] = (unsigned)*(const PG8_LAS int*)(lds + RM_OFF + (h_ * HALF + R) * 4) * (unsigned)(K * 2) + (unsigned)C * 2u; }
                PG8_SCHED; }
            PG8_LDA(At, 0, 1); PG8_STAGE(PG8_SB(0, 0), b2, voffB); PG8_STAGE(PG8_SB(0, 1), b2 + hstep, voffB); PG8_STAGE(PG8_SA(0, 0), a2, gofc[0]);
            PG8_WAIT_V(8); PG8_WAIT_L(0); PG8_BAR; PG8_MMA(1, 0, At, B0); PG8_MMA(1, 1, At, B1); PG8_BAR; PG8_SCHED;
            PG8_LDB(B0, 1, 0); PG8_LDB(B1, 1, 1); PG8_SCHED; PG8_LDA(At, 1, 0); PG8_STAGE(PG8_SA(0, 1), a2, gofc[1]);
            PG8_WAIT_V(8); PG8_WAIT_L(0); PG8_BAR; PG8_MMA(0, 0, At, B0); PG8_MMA(0, 1, At, B1); PG8_BAR; PG8_SCHED;
            PG8_LDA(At, 1, 1); PG8_STAGE(PG8_SB(1, 0), b3, voffB); PG8_STAGE(PG8_SB(1, 1), b3 + hstep, voffB); PG8_STAGE(PG8_SA(1, 0), a3, gofc[0]);
            PG8_WAIT_V(8); PG8_WAIT_L(0); PG8_BAR; PG8_MMA(1, 0, At, B0); PG8_MMA(1, 1, At, B1); PG8_BAR; PG8_SCHED;
            }
        }
        if constexpr (ALIGN_EPI) { if (wr == 0) PG8_BAR; }
        if constexpr (!Epi::AFTER_DRAIN) { const int lane2 = opaque_tid() & 63; E(acc, cur, wr, wc, lane2 & 15, lane2 >> 4); S.done(cur); }
        if (!has_next) break;
#pragma unroll
        for (int a = 0; a < 2; ++a)
#pragma unroll
            for (int b = 0; b < 2; ++b)
#pragma unroll
                for (int m = 0; m < 4; ++m)
#pragma unroll
                    for (int n = 0; n < 2; ++n) acc[a][b][m][n] = (f32x4){0.f, 0.f, 0.f, 0.f};
        cur = nxt; cB = nB; ++ui;
        if constexpr (ALIGN_EPI) { if (wr == 1) PG8_BAR; }
    }
    PG8_WAIT_V(0);
    if constexpr (!ALIGN_EPI) { if (wr == 0) PG8_BAR; }
    PG8_BAR;
    if constexpr (Epi::AFTER_DRAIN) { E.fused(acc, cur, wr, wc, fr, fq, lds, wid, lane); S.done(cur); }
#undef PG8_SA
#undef PG8_SB
#undef PG8_STAGE
#undef PG8_LDA
#undef PG8_LDB
#undef PG8_MMA
#undef PG8_WAIT_V
#undef PG8_WAIT_L
#undef PG8_BAR
#undef PG8_SCHED
}
}
#define XB_TMO      128
#define XB_XCNT(j)  (256  + 64 * (j))
#define XB_XSUB(j)  (1280 + 64 * (j))
#define XB_XGEN(j)  (2304 + 64 * (j))
#define XB_TOP      3328
#define XB_TOPGEN   3392
#define XCD_BAR_WORDS 3456
#define XB_SPIN_CAP (1u << 18)
#define LAS __attribute__((address_space(3)))

__device__ __forceinline__ unsigned xb_ld(unsigned* p)              { return __hip_atomic_load(p, __ATOMIC_RELAXED, __HIP_MEMORY_SCOPE_AGENT); }
__device__ __forceinline__ unsigned xb_add(unsigned* p, unsigned v) { return __hip_atomic_fetch_add(p, v, __ATOMIC_RELAXED, __HIP_MEMORY_SCOPE_AGENT); }
__device__ __forceinline__ unsigned xb_xcc_id() { return (unsigned)__builtin_amdgcn_s_getreg((3 << 11) | 20) & 0xFu; }
#define XB_SPIN(cond, bar) do { unsigned _sp = 0; while (cond) { __builtin_amdgcn_s_sleep(1); \
    if ((++_sp & 255u) == 0u) { if (xb_ld(&(bar)[XB_TMO])) break; if (_sp > XB_SPIN_CAP) { atomicAdd(&(bar)[XB_TMO], 1u); break; } } } } while (0)

struct XcdBarrier {
    unsigned* bar; unsigned x;
    volatile LAS unsigned* st;
};

__device__ __forceinline__ XcdBarrier xcd_barrier_post(unsigned* bar, volatile LAS unsigned* st) {
    XcdBarrier b; b.bar = bar; b.x = xb_xcc_id(); b.st = st;
    if (threadIdx.x == 0) (void)xb_add(&bar[XB_XCNT(b.x)], 1u);
    return b;
}
__device__ __forceinline__ void xcd_barrier_complete(unsigned* bar, unsigned x, unsigned& nloc, unsigned& nx) {
    const unsigned G = gridDim.x * gridDim.y * gridDim.z;
    unsigned sum, cnt, mine, sp = 0u;
    for (;;) {
        sum = 0u; cnt = 0u; mine = 0u;
#pragma unroll
        for (unsigned j = 0; j < 16; ++j) { const unsigned c = xb_ld(&bar[XB_XCNT(j)]); sum += c; cnt += (c > 0u) ? 1u : 0u; mine = (j == x) ? c : mine; }
        if (sum == G) break;
        __builtin_amdgcn_s_sleep(1);
        if ((++sp & 255u) == 0u) { if (xb_ld(&bar[XB_TMO])) break; if (sp > XB_SPIN_CAP) { atomicAdd(&bar[XB_TMO], 1u); break; } }
    }
    nloc = mine > 0u ? mine : 1u; nx = cnt > 0u ? cnt : 1u;
}

__device__ __forceinline__ void xcd_barrier(const XcdBarrier& b) {
    asm volatile("s_waitcnt vmcnt(0)" ::: "memory");
    __syncthreads();
    if (threadIdx.x == 0) {
        unsigned* bar = b.bar;
        __builtin_amdgcn_s_waitcnt(0);
        unsigned nloc = b.st[0], nx = b.st[1];
        if (nloc == 0u) { xcd_barrier_complete(bar, b.x, nloc, nx); b.st[0] = nloc; b.st[1] = nx; }
        const unsigned old = xb_add(&bar[XB_XSUB(b.x)], 1u);
        const unsigned gen = old / nloc;
        if (old + 1u == (gen + 1u) * nloc) {
            __builtin_amdgcn_fence(__ATOMIC_RELEASE, "agent");
            asm volatile("s_waitcnt vmcnt(0)" ::: "memory");
            const unsigned og = xb_add(&bar[XB_TOP], 1u);
            const unsigned tg = og / nx;
            if (og + 1u == (tg + 1u) * nx) xb_add(&bar[XB_TOPGEN], 1u);
            else XB_SPIN(xb_ld(&bar[XB_TOPGEN]) == tg, bar);
            __builtin_amdgcn_fence(__ATOMIC_ACQUIRE, "agent");
            xb_add(&bar[XB_XGEN(b.x)], 1u);
            asm volatile("s_waitcnt vmcnt(0)" ::: "memory");
        } else {
            XB_SPIN(xb_ld(&bar[XB_XGEN(b.x)]) == gen, bar);
            __builtin_amdgcn_fence(__ATOMIC_ACQUIRE, "agent");
            asm volatile("s_waitcnt vmcnt(0)" ::: "memory");
        }
    }
    __syncthreads();
}
__device__ __forceinline__ void p0_transpose_item(const float* W, int ldw, int ncols_valid, int k0, int n0, bf16* WT, size_t dst_row0, int Kdst, LAS float* scr, int lane) {
    const int nn = n0 + (lane & 31); const bool ok = nn < ncols_valid;
#pragma unroll 8
    for (int i = 0; i < 32; ++i) { const int kk = 2 * i + (lane >> 5); scr[kk * 33 + (lane & 31)] = ok ? W[(size_t)(k0 + kk) * ldw + nn] : 0.f; }
    LDS_WAIT();
    const int c = lane & 7;
#pragma unroll
    for (int j = 0; j < 4; ++j) { const int n = (lane >> 3) + 8 * j; const LAS float* s = scr + (8 * c) * 33 + n;
        v4u o; o.x = pk2(s[0 * 33], s[1 * 33]); o.y = pk2(s[2 * 33], s[3 * 33]); o.z = pk2(s[4 * 33], s[5 * 33]); o.w = pk2(s[6 * 33], s[7 * 33]);
        *(v4u*)(WT + (dst_row0 + n) * (size_t)Kdst + k0 + 8 * c) = o; }
    LDS_WAIT();
}
__device__ __forceinline__ void ln_row(v4f (&v)[4], const float* g, const float* b, int lane) {
    float s = 0.f, s2 = 0.f;
#pragma unroll
    for (int j = 0; j < 4; ++j) { s += (v[j].x + v[j].y) + (v[j].z + v[j].w); s2 += (v[j].x * v[j].x + v[j].y * v[j].y) + (v[j].z * v[j].z + v[j].w * v[j].w); }
    s = wave_sum(s); s2 = wave_sum(s2);
    const float mean = s * (1.f / D);
    const float rstd = rsq_(fmaxf(s2 * (1.f / D) - mean * mean, 0.f) + LN_EPS);
#pragma unroll
    for (int j = 0; j < 4; ++j) v[j] = v[j] - mean;
#pragma unroll
    for (int j = 0; j < 4; ++j) { const v4f gg = *(const v4f*)(g + 256 * j + 4 * lane), bb = *(const v4f*)(b + 256 * j + 4 * lane); v[j] = v[j] * rstd * gg + bb; }
}
__device__ PHASE_FN void p0_prologue(const Ctx A, LAS unsigned char* lds, int vcu, int G) {
    const int tid = opaque_tid(), lane = tid & 63, wave = tid >> 6;
    LAS float* scr = (LAS float*)(lds + wave * 16384);
    const int gw = vcu * NWAVES + wave, NGW = G * NWAVES;
    bf16* Win_t = (bf16*)(A.ws + WS_WIN); bf16* Wout_t = (bf16*)(A.ws + WS_WOUT); bf16* W1_t = (bf16*)(A.ws + WS_W1); bf16* W2_t = (bf16*)(A.ws + WS_W2);
    constexpr int I_IN = 2 * 16 * (NINP / 32), I_OUT = 2 * 16 * 32, I_W1 = 64 * 16 * 64, I_W2 = 64 * 16 * 32;
    constexpr int NITEMS = I_IN + I_OUT + I_W1 + I_W2;
    for (int it = gw; it < NITEMS; it += NGW) {
        int r = it;
        if (r < I_IN) { const int l = r / (16 * 112), q = r % (16 * 112), kb = q / 112, nb = q % 112;
            p0_transpose_item(gin(A, 4) + (size_t)l * 1024 * 3560, 3560, 3560, kb * 64, nb * 32, Win_t + (size_t)l * NINP * 1024, (size_t)nb * 32, 1024, scr, lane); continue; }
        r -= I_IN;
        if (r < I_OUT) { const int l = r / 512, q = r % 512, kb = q / 32, nb = q % 32;
            p0_transpose_item(gin(A, 25) + (size_t)l * 1024 * 1024, 1024, 1024, kb * 64, nb * 32, Wout_t + (size_t)l * 1024 * 1024, (size_t)nb * 32, 1024, scr, lane); continue; }
        r -= I_OUT;
        if (r < I_W1) { const int le = r / 1024, q = r % 1024, kb = q / 64, nb = q % 64, n0 = nb * 32;
            const int np = n0 & 1023; const size_t drow = (size_t)256 * (np >> 7) + (n0 >= 1024 ? 128 : 0) + (np & 127);
            p0_transpose_item(gin(A, 30) + (size_t)le * 1024 * 2048, 2048, 2048, kb * 64, n0, W1_t + (size_t)le * 2048 * 1024, drow, 1024, scr, lane); continue; }
        r -= I_W1;
        { const int le = r / 512, q = r % 512, kb = q / 32, nb = q % 32;
            p0_transpose_item(gin(A, 32) + (size_t)le * 1024 * 1024, 1024, 1024, kb * 64, nb * 32, W2_t + (size_t)le * 1024 * 1024, (size_t)nb * 32, 1024, scr, lane); }
    }
    for (int f = gw * 64 + lane; f < 2 * 160 * 64; f += NGW * 64) {
        const int l = f / (160 * 64), q = f - l * (160 * 64); v4u o;
        if (q < 96 * 64) { const int ln = q & 63, fr = q >> 6, ks = fr & 1, nt = (fr >> 1) & 15, mat = fr >> 5, rr = ln & 15, g8 = ln >> 4;
            const float* W = (mat == 0 ? gin(A, 7) : mat == 1 ? gin(A, 9) : gin(A, 10)) + (size_t)l * 64 * 256 + (32 * ks + 8 * g8) * 256 + 64 * (nt >> 2) + 32 * ((nt >> 1) & 1) + 8 * (rr >> 2) + 4 * (nt & 1) + (rr & 3);
            o.x = pk2(W[0], W[256]); o.y = pk2(W[512], W[768]); o.z = pk2(W[1024], W[1280]); o.w = pk2(W[1536], W[1792]); }
        else { const int q2 = q - 96 * 64, ln = q2 & 63, fr = q2 >> 6, ks = fr & 1, nt = (fr >> 1) & 3, hd = (fr >> 3) & 3, mat = fr >> 5, rr = ln & 15, g8 = ln >> 4;
            const float* W = (mat ? gin(A, 20) : gin(A, 18)) + (size_t)l * 4 * 64 * 64 + hd * 4096 + (32 * ks + 8 * g8) * 64 + 32 * (nt >> 1) + 8 * (rr >> 2) + 4 * (nt & 1) + (rr & 3);
            o.x = pk2(W[0], W[64]); o.y = pk2(W[128], W[192]); o.z = pk2(W[256], W[320]); o.w = pk2(W[384], W[448]); }
        *(v4u*)(A.ws + WS_FRAG + (size_t)l * FRAG_LAYER + (size_t)q * 16) = o;
    }
    bf16* HB = (bf16*)(A.ws + WS_HB);
    for (int m = gw; m < T; m += NGW) {
        const int b = m / L, i = m - b * L;
        const float* src = (i < NMETA) ? gin(A, 1) + (size_t)i * D : gin(A, 0) + ((size_t)b * SEQ + (i - NMETA)) * D;
        v4f v[4];
#pragma unroll
        for (int j = 0; j < 4; ++j) v[j] = *(const v4f*)(src + 256 * j + 4 * lane);
        ln_row(v, gin(A, 2), gin(A, 3), lane);
#pragma unroll
        for (int j = 0; j < 4; ++j) st_bf4(HB + (size_t)m * D + 256 * j + 4 * lane, v[j]);
    }
}
constexpr int NTK = 2;
__device__ __forceinline__ float softplus_fast(float x) { return x > 15.f ? x : __logf(1.f + __expf(x)); }
__device__ __forceinline__ float tanh_fast(float x) { return 1.f - 2.f * rcp_(1.f + __expf(2.f * x)); }
__device__ __forceinline__ void sincos_red(float ang, float& sn, float& cs) {
    const float k = rintf(ang * 0.15915494309189535f);
    float r = fmaf(-k, 6.28318548202514648f, ang); r = fmaf(-k, -1.7484555e-7f, r);
    sn = __sinf(r); cs = __cosf(r);
}
constexpr int PREP_W = 98304, PREP_SCR = 4096;
__device__ __forceinline__ void prep_load_w(LAS unsigned char* lds, const float* src, int n, int dst_elem, int tid) {
    for (int i = tid * 4; i < n; i += NTHR * 4) { const v4f x = *(const v4f*)(src + i); v2u o; o.x = pk2(x.x, x.y); o.y = pk2(x.z, x.w); *(LAS v2u*)(lds + (size_t)(dst_elem + i) * 2) = o; }
}
__device__ PHASE_FN void prep_phase(const Ctx A, LAS unsigned char* lds, int l, int vcu, int G) {
    const int tid = opaque_tid(), lane = tid & 63, wave = tid >> 6;
    LAS float* scr = (LAS float*)(lds + PREP_W + wave * PREP_SCR);
    const int gw = vcu * NWAVES + wave, NGW = G * NWAVES;
    const bf16* PROJ = (const bf16*)(A.ws + WS_PROJ);
    const int c4 = 4 * lane, hh = lane >> 4, d4 = 4 * (lane & 15);
    const float* mu = gin(A, 5) + l * 960; const float* w0 = gin(A, 6) + l * 256; const float* w2 = gin(A, 7) + l * 64 * 256;
    const float* a0 = gin(A, 8) + l * 256; const float* a2 = gin(A, 9) + l * 64 * 256; const float* g2 = gin(A, 10) + l * 64 * 256;
    const float* k_k = gin(A, 11) + l * 256; const float* k_a = gin(A, 12) + l * 256; const float* r_k = gin(A, 13) + l * 256;
    const float* conv_w = gin(A, 16) + l * 4 * 256; const float* conv_b = gin(A, 17) + l * 256;
    const float* wa = gin(A, 18) + l * 4 * 64 * 64; const float* ba = gin(A, 19) + l * 256; const float* wx = gin(A, 20) + l * 4 * 64 * 64; const float* bx = gin(A, 21) + l * 256;
    const float* lam = gin(A, 22) + l * 256; const float* lbs = gin(A, 23);
    float* RW_W = (float*)(A.ws + WS_RW_W); bf16* RW_A = (bf16*)(A.ws + WS_RW_A); bf16* RW_B = (bf16*)(A.ws + WS_RW_B); bf16* RW_K = (bf16*)(A.ws + WS_RW_K);
    bf16* RW_WR = (bf16*)(A.ws + WS_RW_WR); bf16* RW_V = (bf16*)(A.ws + WS_RW_V); bf16* RW_G = (bf16*)(A.ws + WS_RW_G); float* RW_SC = (float*)(A.ws + WS_RW_SC);
    bf16* DS_Q = (bf16*)(A.ws + WS_DS_Q); bf16* DS_K = (bf16*)(A.ws + WS_DS_K); bf16* DS_V = (bf16*)(A.ws + WS_DS_V); bf16* DS_QI = (bf16*)(A.ws + WS_DS_QI);
    bf16* DS_KI = (bf16*)(A.ws + WS_DS_KI); float* DS_WI = (float*)(A.ws + WS_DS_WI);
    float* LR_A = (float*)(A.ws + WS_LR_A); bf16* LR_U = (bf16*)(A.ws + WS_LR_U); bf16* LR_G = (bf16*)(A.ws + WS_LR_G);
    float* HG_F = (float*)(A.ws + WS_HG_F); bf16* HG_K = (bf16*)(A.ws + WS_HG_K); bf16* HG_Q = (bf16*)(A.ws + WS_HG_Q); bf16* HG_V = (bf16*)(A.ws + WS_HG_V); bf16* HG_G = (bf16*)(A.ws + WS_HG_G);
    LAS unsigned* kmaxl = (LAS unsigned*)(lds + MISC_OFF + 640);
    LAS unsigned* kimaxl = (LAS unsigned*)(lds + MISC_OFF + 832);
    if (tid < 32) kmaxl[tid] = 0u;
    if (tid < 8) kimaxl[tid] = 0u;
    const bool q_rot = (lane & 15) < 4, q_hi = (lane & 15) >= 2;
    const bool i_rot = (lane & 7) < 2, i_hi = (lane & 7) == 1;

#define BF4R(q_) ((v4f){bflo((q_).x), bfhi((q_).x), bflo((q_).y), bfhi((q_).y)})
    {
        constexpr int RC_OFF = 98304;
        static_assert(RC_OFF + 8 * 1024 <= MISC_OFF, "pass R lds");
        { const v4u* FR = (const v4u*)(A.ws + WS_FRAG + (size_t)l * FRAG_LAYER);
            for (int f = tid; f < 96 * 64; f += NTHR) *(LAS v4u*)(lds + (size_t)f * 16) = FR[f]; }
        LAS float* rc = (LAS float*)(lds + RC_OFF);
        if (tid < 256) { rc[tid] = mu[C_RW_R + tid]; rc[256 + tid] = mu[C_RW_K + tid]; rc[512 + tid] = mu[C_RW_V + tid]; rc[768 + tid] = w0[tid];
            rc[1024 + tid] = a0[tid]; rc[1280 + tid] = k_k[tid]; rc[1536 + tid] = k_a[tid]; rc[1792 + tid] = r_k[tid]; }
        __syncthreads();
        const int r = lane & 15, g = lane >> 4;
        const v4f z4 = (v4f){0.f, 0.f, 0.f, 0.f};
        auto r_tile = [&](const int tile, const int hd_lo, const int hd_hi) {
            const int m0 = tile * 16, b = m0 / L, i = m0 - b * L + r;
            const bf16* rowc = PROJ + (size_t)(m0 + r) * NINP;
            const bool hasp = i > 0; const bf16* rowp = hasp ? rowc - NINP : rowc;
            unsigned tch[4];
#pragma unroll
            for (int q = 0; q < 4; ++q) { const int ln_ = g + 4 * q < 15 ? g + 4 * q : 14; tch[q] = *(const unsigned*)(rowc + 64 * ln_); }
            pg8::bf16x8 Bf[3][2];
#pragma unroll
            for (int mat = 0; mat < 3; ++mat)
#pragma unroll
                for (int ks = 0; ks < 2; ++ks) { const int off = (mat == 0 ? C_RW_WD : mat == 1 ? C_RW_AD : C_RW_GD) + 32 * ks + 8 * g;
                    const v4u cq = *(const v4u*)(rowc + off), pq = *(const v4u*)(rowp + off);
                    const v4f m0v = *(const v4f*)(mu + off), m1v = *(const v4f*)(mu + off + 4);
                    float o8[8];
#pragma unroll
                    for (int e = 0; e < 8; ++e) { const unsigned cw = cq[e >> 1], pw = pq[e >> 1];
                        const float cur = (e & 1) ? bfhi(cw) : bflo(cw), prv = hasp ? ((e & 1) ? bfhi(pw) : bflo(pw)) : 0.f;
                        const float sv = cur + (prv - cur) * (e < 4 ? m0v[e & 3] : m1v[e & 3]);
                        o8[e] = mat == 0 ? tanh_fast(sv) : mat == 1 ? sv : sigmoidf_(sv); }
                    v4u pk; pk.x = pk2(o8[0], o8[1]); pk.y = pk2(o8[2], o8[3]); pk.z = pk2(o8[4], o8[5]); pk.w = pk2(o8[6], o8[7]);
                    Bf[mat][ks] = __builtin_bit_cast(pg8::bf16x8, pk); }
            asm volatile("" :: "v"(tch[0]), "v"(tch[1]), "v"(tch[2]), "v"(tch[3]));
#pragma unroll 1
            for (int hd = hd_lo; hd < hd_hi; ++hd) {
                pg8::f32x4 Cw[4], Ca[4], Cg[4];
#pragma unroll
                for (int nt = 0; nt < 4; ++nt) {
                    const LAS unsigned char* wf = lds + (size_t)((hd * 4 + nt) * 2) * 1024 + lane * 16;
                    pg8::f32x4 cw = (pg8::f32x4){0.f, 0.f, 0.f, 0.f}, ca = cw, cg = cw;
#pragma unroll
                    for (int ks = 0; ks < 2; ++ks) {
                        cw = __builtin_amdgcn_mfma_f32_16x16x32_bf16(*(const LAS pg8::bf16x8*)(wf + ks * 1024), Bf[0][ks], cw, 0, 0, 0);
                        ca = __builtin_amdgcn_mfma_f32_16x16x32_bf16(*(const LAS pg8::bf16x8*)(wf + 32768 + ks * 1024), Bf[1][ks], ca, 0, 0, 0);
                        cg = __builtin_amdgcn_mfma_f32_16x16x32_bf16(*(const LAS pg8::bf16x8*)(wf + 65536 + ks * 1024), Bf[2][ks], cg, 0, 0, 0); }
                    Cw[nt] = cw; Ca[nt] = ca; Cg[nt] = cg;
                }
                const size_t hrow = ((size_t)(b * 4 + hd) * L + i);
                v4f kun[4], kav_[4];
                float n2 = 0.f, sbr = 0.f, skr = 0.f, sbo = 0.f;
                const int cbh = hd * 64 + 8 * g;
                v4u Lr[2], Lk[2], Lv[2], Qr[2], Qk[2], Qv[2]; v2u oK[4], oWR[4], oV[4], oG[4];
#pragma unroll
                for (int h2 = 0; h2 < 2; ++h2) { Lr[h2] = *(const v4u*)(rowc + C_RW_R + cbh + 32 * h2); Lk[h2] = *(const v4u*)(rowc + C_RW_K + cbh + 32 * h2); Lv[h2] = *(const v4u*)(rowc + C_RW_V + cbh + 32 * h2);
                    Qr[h2] = *(const v4u*)(rowp + C_RW_R + cbh + 32 * h2); Qk[h2] = *(const v4u*)(rowp + C_RW_K + cbh + 32 * h2); Qv[h2] = *(const v4u*)(rowp + C_RW_V + cbh + 32 * h2); }
#define PREP_W4(V_, nt_) ((v4f){bflo(V_[(nt_) >> 1][2 * ((nt_) & 1)]), bfhi(V_[(nt_) >> 1][2 * ((nt_) & 1)]), bflo(V_[(nt_) >> 1][2 * ((nt_) & 1) + 1]), bfhi(V_[(nt_) >> 1][2 * ((nt_) & 1) + 1])})
#pragma unroll
                for (int nt = 0; nt < 4; ++nt) {
                    const int cc = cbh + 32 * (nt >> 1) + 4 * (nt & 1), d4h = 8 * g + 32 * (nt >> 1) + 4 * (nt & 1);
                    const v4f cr = PREP_W4(Lr, nt), ck = PREP_W4(Lk, nt), cv = PREP_W4(Lv, nt);
                    const v4f pr = hasp ? PREP_W4(Qr, nt) : z4, pk_ = hasp ? PREP_W4(Qk, nt) : z4, pv = hasp ? PREP_W4(Qv, nt) : z4;
                    const v4f mu_r = *(const LAS v4f*)(rc + cc), mu_k = *(const LAS v4f*)(rc + 256 + cc), mu_v = *(const LAS v4f*)(rc + 512 + cc), w0v = *(const LAS v4f*)(rc + 768 + cc);
                    const v4f a0v = *(const LAS v4f*)(rc + 1024 + cc), kkv = *(const LAS v4f*)(rc + 1280 + cc), kav = *(const LAS v4f*)(rc + 1536 + cc), rkv = *(const LAS v4f*)(rc + 1792 + cc);
                    const v4f rs = cr + (pr - cr) * mu_r, kx = ck + (pk_ - ck) * mu_k, vs = cv + (pv - cv) * mu_v;
                    v4f dec, km, wr, lg;
#pragma unroll
                    for (int e = 0; e < 4; ++e) {
                        const float wv = -softplus_fast(-(w0v[e] + Cw[nt][e])) - 0.5f;
                        dec[e] = __expf(-__expf(wv));
                        const float av = sigmoidf_(a0v[e] + Ca[nt][e]);
                        const float ku = kx[e] * kkv[e]; kun[nt][e] = ku; kav_[nt][e] = ku * av; n2 += ku * ku;
                        km[e] = kx[e] * (1.f + (av - 1.f) * kav[e]);
                        wr[e] = dec[e] * rs[e]; sbr += ku * av * rs[e]; skr += km[e] * rs[e]; sbo += rs[e] * km[e] * rkv[e];
                        lg[e] = Cg[nt][e]; }
                    *(v4f*)(RW_W + hrow * 64 + d4h) = dec;
                    oK[nt].x = pk2(km[0], km[1]); oK[nt].y = pk2(km[2], km[3]); oWR[nt].x = pk2(wr[0], wr[1]); oWR[nt].y = pk2(wr[2], wr[3]);
                    oV[nt].x = pk2(vs[0], vs[1]); oV[nt].y = pk2(vs[2], vs[3]); oG[nt].x = pk2(lg[0], lg[1]); oG[nt].y = pk2(lg[2], lg[3]);
                }
#undef PREP_W4
#pragma unroll
                for (int h2 = 0; h2 < 2; ++h2) { const size_t ho = hrow * 64 + 8 * g + 32 * h2;
                    *(v4u*)(RW_K + ho) = (v4u){oK[2 * h2].x, oK[2 * h2].y, oK[2 * h2 + 1].x, oK[2 * h2 + 1].y}; *(v4u*)(RW_WR + ho) = (v4u){oWR[2 * h2].x, oWR[2 * h2].y, oWR[2 * h2 + 1].x, oWR[2 * h2 + 1].y};
                    *(v4u*)(RW_V + ho) = (v4u){oV[2 * h2].x, oV[2 * h2].y, oV[2 * h2 + 1].x, oV[2 * h2 + 1].y};
                    *(v4u*)(RW_G + (size_t)(m0 + r) * 256 + cbh + 32 * h2) = (v4u){oG[2 * h2].x, oG[2 * h2].y, oG[2 * h2 + 1].x, oG[2 * h2 + 1].y}; }
                n2 += __shfl_xor(n2, 16); n2 += __shfl_xor(n2, 32);
                const float inv = rcp_(fmaxf(sqrtf(n2), 1e-12f));
#pragma unroll
                for (int h2 = 0; h2 < 2; ++h2) { const size_t ho = hrow * 64 + 8 * g + 32 * h2; const v4f a0_ = kun[2 * h2] * (-inv), a1_ = kun[2 * h2 + 1] * (-inv), b0_ = kav_[2 * h2] * inv, b1_ = kav_[2 * h2 + 1] * inv;
                    *(v4u*)(RW_A + ho) = (v4u){pk2(a0_[0], a0_[1]), pk2(a0_[2], a0_[3]), pk2(a1_[0], a1_[1]), pk2(a1_[2], a1_[3])};
                    *(v4u*)(RW_B + ho) = (v4u){pk2(b0_[0], b0_[1]), pk2(b0_[2], b0_[3]), pk2(b1_[0], b1_[1]), pk2(b1_[2], b1_[3])}; }
                sbr *= inv;
                sbr += __shfl_xor(sbr, 16); sbr += __shfl_xor(sbr, 32); skr += __shfl_xor(skr, 16); skr += __shfl_xor(skr, 32); sbo += __shfl_xor(sbo, 16); sbo += __shfl_xor(sbo, 32);
                if (g == 0) *(v4f*)(RW_SC + hrow * 4) = (v4f){sbr, skr, sbo, 0.f};
            }
        };
        const int NT16 = T / 16, nfull = (NT16 / NGW) * NGW;
#pragma unroll 1
        for (int it = gw; it < nfull + (NT16 - nfull) * 4; it += NGW) { const int q = it - nfull; const bool part = q >= 0;
            r_tile(part ? nfull + (q >> 2) : it, part ? (q & 3) : 0, part ? (q & 3) + 1 : 4); }
    }
    __syncthreads();
    {
        constexpr int XT_PITCH = 528, XT_BYTES = 16 * XT_PITCH, XT_OFF = 65536, LCST_OFF = XT_OFF + NWAVES * XT_BYTES;
        static_assert(LCST_OFF + 3 * 1024 <= MISC_OFF, "pass L lds");
        { const v4u* FL = (const v4u*)(A.ws + WS_FRAG + (size_t)l * FRAG_LAYER + 96 * 1024);
            for (int f = tid; f < 64 * 64; f += NTHR) *(LAS v4u*)(lds + (size_t)f * 16) = FL[f]; }
        LAS float* cst = (LAS float*)(lds + LCST_OFF);
        if (tid < 256) { cst[tid] = ba[tid]; cst[256 + tid] = bx[tid];
            const float xs = -lam[tid], ys = __expf(xs);
            cst[512 + tid] = xs > 15.f ? xs : (ys < 0.01f ? ys * (1.f - ys * (0.5f - ys * 0.33333334f)) : __logf(1.f + ys)); }
        __syncthreads();
        LAS unsigned char* xt = lds + XT_OFF + wave * XT_BYTES;
        const int r = lane & 15, g = lane >> 4;
        const v4f cb = *(const v4f*)(conv_b + c4), cw0 = *(const v4f*)(conv_w + c4), cw1 = *(const v4f*)(conv_w + 256 + c4), cw2 = *(const v4f*)(conv_w + 512 + c4), cw3 = *(const v4f*)(conv_w + 768 + c4);
        auto l_tile = [&](const int tile, const int hd_lo, const int hd_hi) {
            const int m0 = tile * 16, b = m0 / L, i0 = m0 - b * L;
            const bf16* Pq = PROJ + (size_t)m0 * NINP;
            v2u xb[19], gr[16];
#pragma unroll
            for (int q = 0; q < 19; ++q) { const int ro = (i0 + q - 3 >= 0) ? q - 3 : 0; xb[q] = *(const v2u*)(Pq + (ptrdiff_t)ro * NINP + C_LR_X + c4); }
#pragma unroll
            for (int t = 0; t < 16; ++t) gr[t] = *(const v2u*)(Pq + (size_t)t * NINP + C_LR_G + c4);
            const v4f z4 = (v4f){0.f, 0.f, 0.f, 0.f};
            v4f x0 = i0 > 0 ? BF4R(xb[0]) : z4, x1 = i0 > 0 ? BF4R(xb[1]) : z4, x2 = i0 > 0 ? BF4R(xb[2]) : z4;
#pragma unroll
            for (int t = 0; t < 16; ++t) {
                const v4f x3 = BF4R(xb[t + 3]);
                const v4f xc = cb + cw0 * x0 + cw1 * x1 + cw2 * x2 + cw3 * x3;
                v2u o; o.x = pk2(xc.x, xc.y); o.y = pk2(xc.z, xc.w);
                *(LAS v2u*)(xt + t * XT_PITCH + c4 * 2) = o;
                x0 = x1; x1 = x2; x2 = x3;
                const v4f gv = BF4R(gr[t]); v4f gg;
#pragma unroll
                for (int e = 0; e < 4; ++e) { const float tt = 0.7978845608028654f * (gv[e] + 0.044715f * gv[e] * gv[e] * gv[e]); gg[e] = 0.5f * gv[e] * (1.f + tanh_fast(tt)); }
                if (hd_lo == 0) st_bf4(LR_G + (size_t)(m0 + t) * 256 + c4, gg);
            }
            LDS_WAIT();
#pragma unroll 1
            for (int hd = hd_lo; hd < hd_hi; ++hd) {
                const LAS unsigned char* xrow = xt + r * XT_PITCH + hd * 128;
                const pg8::bf16x8 bk0 = *(const LAS pg8::bf16x8*)(xrow + g * 16), bk1 = *(const LAS pg8::bf16x8*)(xrow + 64 + g * 16);
                pg8::f32x4 Ca[4], Cx[4];
#pragma unroll
                for (int nt = 0; nt < 4; ++nt) {
                    const LAS unsigned char* wf = lds + (size_t)((hd * 4 + nt) * 2) * 1024 + lane * 16;
                    const pg8::bf16x8 a0 = *(const LAS pg8::bf16x8*)(wf), a1 = *(const LAS pg8::bf16x8*)(wf + 1024), x0f = *(const LAS pg8::bf16x8*)(wf + 32768), x1f = *(const LAS pg8::bf16x8*)(wf + 32768 + 1024);
                    pg8::f32x4 ca = (pg8::f32x4){0.f, 0.f, 0.f, 0.f}, cx = ca;
                    ca = __builtin_amdgcn_mfma_f32_16x16x32_bf16(a0, bk0, ca, 0, 0, 0); ca = __builtin_amdgcn_mfma_f32_16x16x32_bf16(a1, bk1, ca, 0, 0, 0);
                    cx = __builtin_amdgcn_mfma_f32_16x16x32_bf16(x0f, bk0, cx, 0, 0, 0); cx = __builtin_amdgcn_mfma_f32_16x16x32_bf16(x1f, bk1, cx, 0, 0, 0);
                    Ca[nt] = ca; Cx[nt] = cx;
                }
                v2u oU[4];
#pragma unroll
                for (int nt = 0; nt < 4; ++nt) {
                    const int c0 = hd * 64 + 32 * (nt >> 1) + 8 * g + 4 * (nt & 1);
                    const v4f bav = *(const LAS v4f*)(cst + c0), bxv = *(const LAS v4f*)(cst + 256 + c0), spl = *(const LAS v4f*)(cst + 512 + c0);
                    const v2u xq = *(const LAS v2u*)(xt + r * XT_PITCH + c0 * 2); const v4f xc = BF4R(xq);
                    v4f aa, uu;
#pragma unroll
                    for (int e = 0; e < 4; ++e) { const float rg = sigmoidf_(Ca[nt][e] + bav[e]), ig = sigmoidf_(Cx[nt][e] + bxv[e]);
                        const float la = -8.f * rg * spl[e]; aa[e] = __expf(la);
                        const float x2l = 2.f * la; const float om = (x2l > -0.1f) ? -(x2l * (1.f + x2l * (0.5f + x2l * (0.16666667f + x2l * 0.041666668f)))) : (1.f - __expf(x2l));
                        uu[e] = xc[e] * ig * __builtin_amdgcn_sqrtf(om); }
                    const size_t mo = (size_t)(m0 + r) * 256 + c0;
                    *(v4f*)(LR_A + mo) = aa; oU[nt].x = pk2(uu[0], uu[1]); oU[nt].y = pk2(uu[2], uu[3]);
                }
#pragma unroll
                for (int h2 = 0; h2 < 2; ++h2) *(v4u*)(LR_U + (size_t)(m0 + r) * 256 + hd * 64 + 8 * g + 32 * h2) = (v4u){oU[2 * h2].x, oU[2 * h2].y, oU[2 * h2 + 1].x, oU[2 * h2 + 1].y};
            }
        };
        const int NT16 = T / 16, nfull = (NT16 / NGW) * NGW;
#pragma unroll 1
        for (int it = gw; it < nfull + (NT16 - nfull) * 4; it += NGW) { const int q = it - nfull; const bool part = q >= 0;
            l_tile(part ? nfull + (q >> 2) : it, part ? (q & 3) : 0, part ? (q & 3) + 1 : 4); }
    }
    {
        float invf_q[4], invf_i[4];
#pragma unroll
        for (int e = 0; e < 4; ++e) { invf_q[e] = exp2f(-(float)((d4 + e) & 7) * (18.931568569324174f / 8.f)); invf_i[e] = exp2f(-(float)e * (18.931568569324174f / 4.f)); }
        v4f lb = (v4f){0.f, 0.f, 0.f, 0.f};
        if (l == 1) { const v4f x0 = *(const v4f*)(lbs + c4), x1 = *(const v4f*)(lbs + 256 + c4);
            lb.x = 1.f / (1.f + __expf(x0.x - x1.x)); lb.y = 1.f / (1.f + __expf(x0.y - x1.y)); lb.z = 1.f / (1.f + __expf(x0.z - x1.z)); lb.w = 1.f / (1.f + __expf(x0.w - x1.w)); }
#pragma unroll 2
        for (int m = gw; m < T; m += NGW) {
            const int b = m / L, i = m - b * L; const float pos = (float)i;
            const bf16* Pj = PROJ + (size_t)m * NINP;
            v4f q = ld_bf4(Pj + C_DS_Q + c4), k = ld_bf4(Pj + C_DS_K + c4);
            const v4f v = ld_bf4(Pj + C_DS_V + c4);
            v4f qi = ld_bf4(Pj + C_DS_QI + c4), ki = ld_bf4(Pj + C_DS_KI + 4 * (lane & 7));
            const v4f hq = ld_bf4(Pj + C_HG_Q + c4), z = ld_bf4(Pj + C_HG_F + c4), vi = ld_bf4(Pj + C_HG_I + c4), hgt = ld_bf4(Pj + C_HG_G + c4);
#pragma unroll
            for (int e = 0; e < 4; ++e) {
                const float qp = __shfl_xor(q[e], 2), kp = __shfl_xor(k[e], 2), qip = __shfl_xor(qi[e], 1), kip = __shfl_xor(ki[e], 1);
                float sn, cs; sincos_red(pos * invf_q[e], sn, cs);
                if (q_rot) { q[e] = q_hi ? (qp * sn + q[e] * cs) : (q[e] * cs - qp * sn); k[e] = q_hi ? (kp * sn + k[e] * cs) : (k[e] * cs - kp * sn); }
                sincos_red(pos * invf_i[e], sn, cs);
                if (i_rot) { qi[e] = i_hi ? (qip * sn + qi[e] * cs) : (qi[e] * cs - qip * sn); ki[e] = i_hi ? (kip * sn + ki[e] * cs) : (ki[e] * cs - kip * sn); }
            }
            { float kn2 = sum16(k.x * k.x + k.y * k.y + k.z * k.z + k.w * k.w); if ((lane & 15) == 0) __hip_atomic_fetch_max(kmaxl + b * 4 + hh, __float_as_uint(kn2 * 1.02f), __ATOMIC_RELAXED, __HIP_MEMORY_SCOPE_WORKGROUP); }
            st_bf4(DS_Q + (size_t)m * 256 + c4, q * (0.125f * 1.4426950408889634f));      st_bf4(DS_K + (size_t)m * 256 + c4, k); st_bf4(DS_V + (size_t)m * 256 + c4, v); st_bf4(DS_QI + (size_t)m * 256 + c4, qi);
            { float in2 = sum8(ki.x * ki.x + ki.y * ki.y + ki.z * ki.z + ki.w * ki.w); if (lane == 0) __hip_atomic_fetch_max(kimaxl + b, __float_as_uint(in2 * 1.02f), __ATOMIC_RELAXED, __HIP_MEMORY_SCOPE_WORKGROUP); }
            if (lane < 8) { st_bf4(DS_KI + (size_t)m * 32 + 4 * lane, ki); DS_WI[(size_t)m * 8 + lane] = bf2f(Pj[C_DS_WI + lane]) * 0.0625f; }
            v4f qs, f, kq, gs;
#pragma unroll
            for (int e = 0; e < 4; ++e) { const float sg = sigmoidf_(z[e]); qs[e] = hq[e] * sigmoidf_(hq[e]); f[e] = lb[e] + (1.f - lb[e]) * sg; kq[e] = (1.f - lb[e]) * (1.f - sg); gs[e] = hgt[e] * sigmoidf_(hgt[e]); }
            const size_t hm = ((size_t)(b * 4 + hh) * L + i) * 64 + d4;
            *(v4f*)(HG_F + hm) = f; st_bf4(HG_K + hm, kq); st_bf4(HG_Q + hm, qs); st_bf4(HG_V + hm, vi); st_bf4(HG_G + (size_t)m * 256 + c4, gs);
        }
    }
    __syncthreads();
    if (tid < 32) atomicMax((unsigned*)(A.ws + WS_CTL) + 8960 + 64 * l + tid, kmaxl[tid]);
    if (tid < 8) atomicMax((unsigned*)(A.ws + WS_CTL) + 9216 + 64 * l + tid, kimaxl[tid]);
}
constexpr int SC_C = 32;
constexpr size_t WS_YRAW = WS_PROJ;
constexpr size_t WS_ORAW = WS_PROJ + (size_t)T * 1024;
__device__ PHASE_FN void rwkv_scan(const Ctx A, LAS unsigned char* lds, int unit_) {
    const int unit = opaque_s(unit_);
    const int tid = opaque_tid(), row = tid >> 4, kp = tid & 15;
    const int bh = unit >> 1, half = unit & 1, b = bh >> 2, h = bh & 3;
    const size_t base = (size_t)bh * L * 64;
    const float* W = (const float*)(A.ws + WS_RW_W) + base;
    const bf16* Av = (const bf16*)(A.ws + WS_RW_A) + base; const bf16* Bv = (const bf16*)(A.ws + WS_RW_B) + base; const bf16* Kv = (const bf16*)(A.ws + WS_RW_K) + base;
    const bf16* WRv = (const bf16*)(A.ws + WS_RW_WR) + base; const bf16* Vv = (const bf16*)(A.ws + WS_RW_V) + base + half * 32;
    const float* SC = (const float*)(A.ws + WS_RW_SC) + (size_t)bh * L * 4;
    float* YR = (float*)(A.ws + WS_YRAW) + (size_t)b * L * 256 + h * 64 + half * 32;
    constexpr int ARR = SC_C * 64;
    constexpr int BUF = (5 * ARR + SC_C * 32 + SC_C * 4) * 4;
    LAS float* ybuf = (LAS float*)(lds + 2 * BUF);
    float S0 = 0.f, S1 = 0.f, S2 = 0.f, S3 = 0.f;
    v4f rw; v2u ra, rb, rk, rwr, rv; float rsc = 0.f;
    const int e4 = tid * 4;
#define RW_LOAD(c) do { const int t0_ = (c) * SC_C; const bool ok_ = (t0_ + (e4 >> 6)) < L; const size_t o_ = (size_t)t0_ * 64 + e4; \
        rw = ok_ ? *(const v4f*)(W + o_) : (v4f){1.f, 1.f, 1.f, 1.f}; ra = ok_ ? *(const v2u*)(Av + o_) : (v2u){0u, 0u}; rb = ok_ ? *(const v2u*)(Bv + o_) : (v2u){0u, 0u}; \
        rk = ok_ ? *(const v2u*)(Kv + o_) : (v2u){0u, 0u}; rwr = ok_ ? *(const v2u*)(WRv + o_) : (v2u){0u, 0u}; \
        if (tid < SC_C * 8) rv = (t0_ + (tid >> 3)) < L ? *(const v2u*)(Vv + (size_t)(t0_ + (tid >> 3)) * 64 + (tid & 7) * 4) : (v2u){0u, 0u}; \
        if (tid < SC_C * 4) rsc = (t0_ + (tid >> 2)) < L ? SC[(size_t)t0_ * 4 + tid] : 0.f; } while (0)
#define RW_STORE(p) do { LAS float* d_ = (LAS float*)(lds + (p) * BUF); \
        *(LAS v4f*)(d_ + e4) = rw; *(LAS v4f*)(d_ + ARR + e4) = (v4f){bflo(ra.x), bfhi(ra.x), bflo(ra.y), bfhi(ra.y)}; *(LAS v4f*)(d_ + 2 * ARR + e4) = (v4f){bflo(rb.x), bfhi(rb.x), bflo(rb.y), bfhi(rb.y)}; \
        *(LAS v4f*)(d_ + 3 * ARR + e4) = (v4f){bflo(rk.x), bfhi(rk.x), bflo(rk.y), bfhi(rk.y)}; *(LAS v4f*)(d_ + 4 * ARR + e4) = (v4f){bflo(rwr.x), bfhi(rwr.x), bflo(rwr.y), bfhi(rwr.y)}; \
        if (tid < SC_C * 8) *(LAS v4f*)(d_ + 5 * ARR + tid * 4) = (v4f){bflo(rv.x), bfhi(rv.x), bflo(rv.y), bfhi(rv.y)}; if (tid < SC_C * 4) d_[5 * ARR + SC_C * 32 + tid] = rsc; } while (0)
    constexpr int NCH = (L + SC_C - 1) / SC_C;
    RW_LOAD(0); RW_STORE(0); __syncthreads();
#pragma unroll 1
    for (int c = 0; c < NCH; ++c) {
        const int p = c & 1;
        if (c + 1 < NCH) RW_LOAD(c + 1);
        const int ns = (L - c * SC_C) < SC_C ? (L - c * SC_C) : SC_C;
        const LAS float* d = (const LAS float*)(lds + p * BUF);
        const LAS float* q = d + kp * 4; const LAS float* dv = d + 5 * ARR + row; const LAS float* dsc = d + 5 * ARR + SC_C * 32;
        v4f w4 = *(const LAS v4f*)(q), a4 = *(const LAS v4f*)(q + ARR), b4 = *(const LAS v4f*)(q + 2 * ARR), k4 = *(const LAS v4f*)(q + 3 * ARR), r4 = *(const LAS v4f*)(q + 4 * ARR);
        float vv = dv[0]; v2f sc = *(const LAS v2f*)(dsc);
#pragma unroll 2
        for (int s = 0; s < ns; ++s) {
            const int sn = (s + 1 < SC_C) ? s + 1 : s;
            const v4f nw4 = *(const LAS v4f*)(q + sn * 64), na4 = *(const LAS v4f*)(q + ARR + sn * 64), nb4 = *(const LAS v4f*)(q + 2 * ARR + sn * 64);
            const v4f nk4 = *(const LAS v4f*)(q + 3 * ARR + sn * 64), nr4 = *(const LAS v4f*)(q + 4 * ARR + sn * 64);
            const float nvv = dv[sn * 32]; const v2f nsc = *(const LAS v2f*)(dsc + sn * 4);
            float sa = (S0 * a4.x + S1 * a4.y) + (S2 * a4.z + S3 * a4.w), y1 = (S0 * r4.x + S1 * r4.y) + (S2 * r4.z + S3 * r4.w);
            sa = sum16(sa); y1 = sum16(y1);
            S0 = S0 * w4.x + sa * b4.x + vv * k4.x; S1 = S1 * w4.y + sa * b4.y + vv * k4.y; S2 = S2 * w4.z + sa * b4.z + vv * k4.z; S3 = S3 * w4.w + sa * b4.w + vv * k4.w;
            const float yo = y1 + sa * sc.x + vv * sc.y;
            if (kp == 0) ybuf[s * 32 + row] = yo;
            w4 = nw4; a4 = na4; b4 = nb4; k4 = nk4; r4 = nr4; vv = nvv; sc = nsc;
        }
        __syncthreads();
        { const int s = tid >> 4, r2 = (tid & 15) * 2;
          if (s < ns) *(v2f*)(YR + (size_t)(c * SC_C + s) * 256 + r2) = *(const LAS v2f*)(ybuf + s * 32 + r2); }
        if (c + 1 < NCH) RW_STORE(1 - p);
        __syncthreads();
    }
#undef RW_LOAD
#undef RW_STORE
}
__device__ PHASE_FN void hgrn_scan(const Ctx A, LAS unsigned char* lds, int unit_) {
    const int unit = opaque_s(unit_);
    const int tid = opaque_tid(), row = tid >> 4, kp = tid & 15;
    const int bh = unit >> 1, half = unit & 1, b = bh >> 2, h = bh & 3;
    const size_t base = (size_t)bh * L * 64;
    const float* Fv = (const float*)(A.ws + WS_HG_F) + base;
    const bf16* Kv = (const bf16*)(A.ws + WS_HG_K) + base; const bf16* Qv = (const bf16*)(A.ws + WS_HG_Q) + base; const bf16* Vv = (const bf16*)(A.ws + WS_HG_V) + base + half * 32;
    float* OR = (float*)(A.ws + WS_ORAW) + (size_t)b * L * 256 + h * 64 + half * 32;
    constexpr int ARR = SC_C * 64; constexpr int BUF = (3 * ARR + SC_C * 32) * 4;
    LAS float* obuf = (LAS float*)(lds + 2 * BUF);
    float S0 = 0.f, S1 = 0.f, S2 = 0.f, S3 = 0.f;
    v4f rf; v2u rk, rq, rv;
    const int e4 = tid * 4;
#define HG_LOAD(c) do { const int t0_ = (c) * SC_C; const bool ok_ = (t0_ + (e4 >> 6)) < L; const size_t o_ = (size_t)t0_ * 64 + e4; \
        rf = ok_ ? *(const v4f*)(Fv + o_) : (v4f){1.f, 1.f, 1.f, 1.f}; rk = ok_ ? *(const v2u*)(Kv + o_) : (v2u){0u, 0u}; rq = ok_ ? *(const v2u*)(Qv + o_) : (v2u){0u, 0u}; \
        if (tid < SC_C * 8) rv = (t0_ + (tid >> 3)) < L ? *(const v2u*)(Vv + (size_t)(t0_ + (tid >> 3)) * 64 + (tid & 7) * 4) : (v2u){0u, 0u}; } while (0)
#define HG_STORE(p) do { LAS float* d_ = (LAS float*)(lds + (p) * BUF); \
        *(LAS v4f*)(d_ + e4) = rf; *(LAS v4f*)(d_ + ARR + e4) = (v4f){bflo(rk.x), bfhi(rk.x), bflo(rk.y), bfhi(rk.y)}; \
        *(LAS v4f*)(d_ + 2 * ARR + e4) = (v4f){bflo(rq.x), bfhi(rq.x), bflo(rq.y), bfhi(rq.y)}; \
        if (tid < SC_C * 8) *(LAS v4f*)(d_ + 3 * ARR + tid * 4) = (v4f){bflo(rv.x), bfhi(rv.x), bflo(rv.y), bfhi(rv.y)}; } while (0)
    constexpr int NCH = (L + SC_C - 1) / SC_C;
    HG_LOAD(0); HG_STORE(0); __syncthreads();
#pragma unroll 1
    for (int c = 0; c < NCH; ++c) {
        const int p = c & 1;
        if (c + 1 < NCH) HG_LOAD(c + 1);
        const int ns = (L - c * SC_C) < SC_C ? (L - c * SC_C) : SC_C;
        const LAS float* d = (const LAS float*)(lds + p * BUF);
        const LAS float* q = d + kp * 4; const LAS float* dv = d + 3 * ARR + row;
        v4f f4 = *(const LAS v4f*)(q), k4 = *(const LAS v4f*)(q + ARR), q4 = *(const LAS v4f*)(q + 2 * ARR); float vv = dv[0];
#pragma unroll 2
        for (int s = 0; s < ns; ++s) {
            const int sn = (s + 1 < SC_C) ? s + 1 : s;
            const v4f nf4 = *(const LAS v4f*)(q + sn * 64), nk4 = *(const LAS v4f*)(q + ARR + sn * 64), nq4 = *(const LAS v4f*)(q + 2 * ARR + sn * 64);
            const float nvv = dv[sn * 32];
            S0 = S0 * f4.x + k4.x * vv; S1 = S1 * f4.y + k4.y * vv; S2 = S2 * f4.z + k4.z * vv; S3 = S3 * f4.w + k4.w * vv;
            float o = (q4.x * S0 + q4.y * S1) + (q4.z * S2 + q4.w * S3);
            o = sum16(o);
            if (kp == 0) obuf[s * 32 + row] = o;
            f4 = nf4; k4 = nk4; q4 = nq4; vv = nvv;
        }
        __syncthreads();
        { const int s = tid >> 4, r2 = (tid & 15) * 2;
          if (s < ns) *(v2f*)(OR + (size_t)(c * SC_C + s) * 256 + r2) = *(const LAS v2f*)(obuf + s * 32 + r2); }
        if (c + 1 < NCH) HG_STORE(1 - p);
        __syncthreads();
    }
#undef HG_LOAD
#undef HG_STORE
}
__device__ PHASE_FN void mixers_finish(const Ctx A, int l, int vcu, int G) {
    const int tid = opaque_tid(), lane = tid & 63, wave = tid >> 6;
    const int gw = vcu * NWAVES + wave, NGW = G * NWAVES;
    const int c4 = 4 * lane, hh = lane >> 4, d4 = 4 * (lane & 15);
    const float* YR = (const float*)(A.ws + WS_YRAW); const float* OR = (const float*)(A.ws + WS_ORAW);
    const bf16* RV = (const bf16*)(A.ws + WS_RW_V); const float* SC = (const float*)(A.ws + WS_RW_SC); const bf16* RG = (const bf16*)(A.ws + WS_RW_G); const bf16* HGt = (const bf16*)(A.ws + WS_HG_G);
    bf16* MIX = (bf16*)(A.ws + WS_MIX);
    const v4f lg = *(const v4f*)(gin(A, 14) + l * 256 + c4), lb = *(const v4f*)(gin(A, 15) + l * 256 + c4), ng = *(const v4f*)(gin(A, 24) + l * 256 + c4);
#pragma unroll 2
    for (int m = gw; m < T; m += NGW) {
        const int b = m / L, i = m - b * L; const size_t hm = ((size_t)(b * 4 + hh) * L + i);
        const v4f y = *(const v4f*)(YR + (size_t)m * 256 + c4), o = *(const v4f*)(OR + (size_t)m * 256 + c4);
        const v4f vv = ld_bf4(RV + hm * 64 + d4), g = ld_bf4(RG + (size_t)m * 256 + c4), hg = ld_bf4(HGt + (size_t)m * 256 + c4);
        const float bonus = SC[hm * 4 + 2];
        const float mean = sum16((y.x + y.y) + (y.z + y.w)) * (1.f / 64.f); const v4f dy = y - mean;
        const float var = sum16((dy.x * dy.x + dy.y * dy.y) + (dy.z * dy.z + dy.w * dy.w)) * (1.f / 64.f);
        const v4f yn = (dy * rsqrtf(var + 64e-5f) * lg + lb + vv * bonus) * g;
        st_bf4(MIX + (size_t)m * 1024 + c4, yn);
        const float ms = sum16((o.x * o.x + o.y * o.y) + (o.z * o.z + o.w * o.w)) * (1.f / 64.f);
        st_bf4(MIX + (size_t)m * 1024 + 768 + c4, o * rsqrtf(ms + 1e-5f) * ng * hg);
    }
}
constexpr int LR_SEG = 64, LR_NSEG = (L + LR_SEG - 1) / LR_SEG;
constexpr size_t WS_LR_AGG = 2032 * MiB;
constexpr size_t WS_LR_CARRY = WS_LR_AGG + 3 * MiB;
static_assert(WS_LR_CARRY + (size_t)NB * LR_NSEG * 256 * 4 <= WS_END, "lru aggregates");
__device__ PHASE_FN void lru_agg_phase(const Ctx A, int vcu, int G) {
    const int tid = opaque_tid(), lane = tid & 63, wave = tid >> 6;
    const int gw = vcu * NWAVES + wave, NGW = G * NWAVES;
    const float* LA = (const float*)(A.ws + WS_LR_A); const bf16* LU = (const bf16*)(A.ws + WS_LR_U); v2f* AGG = (v2f*)(A.ws + WS_LR_AGG);
#pragma unroll 1
    for (int it = gw; it < NB * LR_NSEG * 4; it += NGW) {
        const int cg = it & 3, q = it >> 2; const bool tail_ = q >= NB * (LR_NSEG - 1);
        const int b = tail_ ? q - NB * (LR_NSEG - 1) : q / (LR_NSEG - 1), sg = tail_ ? LR_NSEG - 1 : q - b * (LR_NSEG - 1), ch = cg * 64 + lane;
        const int t0 = sg * LR_SEG, ns = (L - t0) < LR_SEG ? (L - t0) : LR_SEG;
        const size_t m0 = (size_t)b * L + t0;
        float Ap = 1.f, Hl = 0.f;
#pragma unroll 1
        for (int i = 0; i < ns; i += 16) {
            float a[16], u[16];
#pragma unroll
            for (int j = 0; j < 16; ++j) { a[j] = LA[(m0 + i + j) * 256 + ch]; u[j] = bf2f(LU[(m0 + i + j) * 256 + ch]); }
#pragma unroll
            for (int j = 0; j < 16; ++j) { Hl = a[j] * Hl + u[j]; Ap *= a[j]; }
        }
        AGG[((size_t)b * LR_NSEG + sg) * 256 + ch] = (v2f){Ap, Hl};
    }
}
__device__ PHASE_FN void lru_carry_phase(const Ctx A, int first) {
    const int tid = opaque_tid(), lane = tid & 63, wave = tid >> 6;
    const int w = (opaque_s((int)blockIdx.x) - first) * NWAVES + wave;
    const int b = w >> 2, ch = (w & 3) * 64 + lane;
    const v2f* ag = (const v2f*)(A.ws + WS_LR_AGG) + (size_t)b * LR_NSEG * 256 + ch;
    float* CR = (float*)(A.ws + WS_LR_CARRY) + (size_t)b * LR_NSEG * 256 + ch;
    float hc = 0.f;
#pragma unroll 1
    for (int s0 = 0; s0 < LR_NSEG; s0 += 16) {
        v2f x[16];
#pragma unroll
        for (int j = 0; j < 16; ++j) { const int s = s0 + j < LR_NSEG ? s0 + j : LR_NSEG - 1; x[j] = ag[(size_t)s * 256]; }
#pragma unroll
        for (int j = 0; j < 16; ++j) if (s0 + j < LR_NSEG) { CR[(size_t)(s0 + j) * 256] = hc; hc = x[j].x * hc + x[j].y; }
    }
}
__device__ PHASE_FN void lru_out_phase(const Ctx A, int vcu, int G) {
    const int tid = opaque_tid(), lane = tid & 63, wave = tid >> 6;
    const int gw = vcu * NWAVES + wave, NGW = G * NWAVES;
    const float* LA = (const float*)(A.ws + WS_LR_A); const bf16* LU = (const bf16*)(A.ws + WS_LR_U); const bf16* LG = (const bf16*)(A.ws + WS_LR_G);
    const float* CR = (const float*)(A.ws + WS_LR_CARRY); bf16* MIX = (bf16*)(A.ws + WS_MIX);
#pragma unroll 1
    for (int it = gw; it < NB * LR_NSEG * 4; it += NGW) {
        const int cg = it & 3, q = it >> 2; const bool tail_ = q >= NB * (LR_NSEG - 1);
        const int b = tail_ ? q - NB * (LR_NSEG - 1) : q / (LR_NSEG - 1), sg = tail_ ? LR_NSEG - 1 : q - b * (LR_NSEG - 1), ch = cg * 64 + lane;
        const int t0 = sg * LR_SEG, ns = (L - t0) < LR_SEG ? (L - t0) : LR_SEG;
        const size_t m0 = (size_t)b * L + t0;
        float hc = CR[((size_t)b * LR_NSEG + sg) * 256 + ch];
#pragma unroll 1
        for (int i = 0; i < ns; i += 16) {
            float a[16], u[16], g[16];
#pragma unroll
            for (int j = 0; j < 16; ++j) { a[j] = LA[(m0 + i + j) * 256 + ch]; u[j] = bf2f(LU[(m0 + i + j) * 256 + ch]); g[j] = bf2f(LG[(m0 + i + j) * 256 + ch]); }
#pragma unroll
            for (int j = 0; j < 16; ++j) { hc = a[j] * hc + u[j]; MIX[(m0 + i + j) * 1024 + 512 + ch] = f2bf(hc * g[j]); }
        }
    }
}
static_assert(L % 16 == 0, "lru step groups");
constexpr int DSA_WBYTES = 34944;
constexpr int DSA_NW = 4;
__device__ __forceinline__ unsigned fkey(float f) { const unsigned u = __float_as_uint(f); return (u & 0x80000000u) ? ~u : (u | 0x80000000u); }
__device__ __forceinline__ void dsa_query(const Ctx A, LAS unsigned char* wl, int b, int i, int lane) {
    const bf16* DQ = (const bf16*)(A.ws + WS_DS_Q); const bf16* DK = (const bf16*)(A.ws + WS_DS_K); const bf16* DV = (const bf16*)(A.ws + WS_DS_V);
    const bf16* DQI = (const bf16*)(A.ws + WS_DS_QI); const bf16* DKI = (const bf16*)(A.ws + WS_DS_KI); const float* DWI = (const float*)(A.ws + WS_DS_WI);
    bf16* MIX = (bf16*)(A.ws + WS_HB);
    LAS unsigned* keys = (LAS unsigned*)wl; LAS float* qv = (LAS float*)(wl + 32896); LAS int* sel = (LAS int*)(wl + 32896 + 1024);
    const size_t m = (size_t)b * L + i, mb = (size_t)b * L;
    const int n = i + 1;
    LAS float* wil = (LAS float*)(wl + 32832);
    { const v4f q4 = ld_bf4(DQI + m * 256 + 4 * lane); *(LAS v4f*)(qv + 4 * lane) = q4; if (lane < 8) wil[lane] = DWI[m * 8 + lane]; }
    LDS_WAIT();
    for (int s = lane; s < n; s += 64) {
        const v4u* kp = (const v4u*)(DKI + (mb + s) * 32);
        float kf[32];
#pragma unroll
        for (int c = 0; c < 4; ++c) { const v4u x = kp[c]; kf[8 * c + 0] = bflo(x.x); kf[8 * c + 1] = bfhi(x.x); kf[8 * c + 2] = bflo(x.y); kf[8 * c + 3] = bfhi(x.y); kf[8 * c + 4] = bflo(x.z); kf[8 * c + 5] = bfhi(x.z); kf[8 * c + 6] = bflo(x.w); kf[8 * c + 7] = bfhi(x.w); }
        float sc = 0.f;
#pragma unroll 1
        for (int hx = 0; hx < 8; ++hx) { float dt = 0.f;
#pragma unroll
            for (int c = 0; c < 8; ++c) { const v4f q4 = *(const LAS v4f*)(qv + hx * 32 + 4 * c); dt += q4.x * kf[4 * c] + q4.y * kf[4 * c + 1] + q4.z * kf[4 * c + 2] + q4.w * kf[4 * c + 3]; }
            sc += wil[hx] * fmaxf(dt, 0.f); }
        keys[s] = fkey(sc);
    }
    LDS_WAIT();
    unsigned thr = 0u; int need = 0;
    if (n > 256) {
        unsigned prefix = 0u; need = 256;
#pragma unroll 1
        for (int shift = 28; shift >= 0; shift -= 4) {
            unsigned long long lo = 0ull, hi = 0ull;
            const unsigned himask = (shift == 28) ? 0u : (0xFFFFFFFFu << (shift + 4));
            for (int s = lane; s < n; s += 64) { const unsigned k = keys[s];
                if ((k & himask) == prefix) { const unsigned dg = (k >> shift) & 15u; const unsigned long long inc = 1ull << ((dg & 7u) * 8u); if (dg < 8u) lo += inc; else hi += inc; } }
            int cum = 0; unsigned dsel = 0u; int below = 0; bool found = false;
#pragma unroll
            for (int dg = 15; dg >= 0; --dg) {
                const unsigned mine = (unsigned)(((dg < 8 ? lo : hi) >> ((dg & 7) * 8)) & 0xFFull);
                int tot = (int)mine;
#pragma unroll
                for (int o = 1; o < 64; o <<= 1) tot += __shfl_xor(tot, o);
                if (!found && cum + tot >= need) { found = true; dsel = (unsigned)dg; below = cum; }
                cum += tot;
            }
            prefix |= dsel << shift; need -= below;
        }
        thr = prefix;
    }
    int cnt = 0;
    if (n <= 256) { for (int s = lane; s < n; s += 64) sel[s] = s; cnt = n; }
    else {
        int eq_taken = 0;
        for (int s0 = 0; s0 < n; s0 += 64) { const int s = s0 + lane; const unsigned k = (s < n) ? keys[s] : 0u; const bool in = s < n;
            const bool gt = in && (k > thr), eq = in && (k == thr);
            const unsigned long long meq = __ballot(eq); const int eq_before = __popcll(meq & ((1ull << lane) - 1ull));
            const bool take = gt || (eq && (eq_taken + eq_before) < need);
            const unsigned long long mt = __ballot(take); const int pos = cnt + __popcll(mt & ((1ull << lane) - 1ull));
            if (take && pos < 256) sel[pos] = s;
            cnt += __popcll(mt); eq_taken += __popcll(meq);
        }
        if (cnt > 256) cnt = 256;
    }
    LDS_WAIT();
    LAS float* pbuf = (LAS float*)wl;
    for (int h = 0; h < 4; ++h) {
        { const float qx = bf2f(DQ[m * 256 + h * 64 + lane]); qv[lane] = qx * 0.125f; }
        LDS_WAIT();
        float sj[4]; float mx = -3.0e38f;
#pragma unroll
        for (int r = 0; r < 4; ++r) { const int j = lane + 64 * r; sj[r] = -3.0e38f;
            if (j < cnt) { const int s = sel[j]; const v4u* kp = (const v4u*)(DK + (mb + s) * 256 + h * 64); float dt = 0.f;
#pragma unroll
                for (int c = 0; c < 8; ++c) { const v4u x = kp[c]; const v4f q0 = *(const LAS v4f*)(qv + 8 * c), q1 = *(const LAS v4f*)(qv + 8 * c + 4);
                    dt += q0.x * bflo(x.x) + q0.y * bfhi(x.x) + q0.z * bflo(x.y) + q0.w * bfhi(x.y) + q1.x * bflo(x.z) + q1.y * bfhi(x.z) + q1.z * bflo(x.w) + q1.w * bfhi(x.w); }
                sj[r] = dt; mx = fmaxf(mx, dt); } }
        mx = wave_max(mx);
        float sum = 0.f;
#pragma unroll
        for (int r = 0; r < 4; ++r) { const int j = lane + 64 * r; const float p = (j < cnt) ? __expf(sj[r] - mx) : 0.f; sum += p; pbuf[j] = p; }
        sum = wave_sum(sum);
        LDS_WAIT();
        float o = 0.f;
        for (int j = 0; j < cnt; ++j) { const int s = sel[j]; o += pbuf[j] * bf2f(DV[(mb + s) * 256 + h * 64 + lane]); }
        MIX[m * 1024 + 256 + h * 64 + lane] = f2bf(o / sum);
        LDS_WAIT();
    }
}
__device__ PHASE_FN void dsa_phase(const Ctx A, LAS unsigned char* lds, int l) {
    const int tid = opaque_tid(), lane = tid & 63, wave = tid >> 6;
    if (wave >= DSA_NW) return;
    unsigned* qhead = (unsigned*)(A.ws + WS_CTL) + CW_DSAQ + 64 * l;
    LAS unsigned char* wl = lds + wave * DSA_WBYTES;
    for (;;) {
        unsigned it = 0u;
        if (lane == 0) it = atomicAdd(qhead, 1u);
        it = __builtin_amdgcn_readfirstlane(it);
        if (it >= (unsigned)T) break;
        const int i = L - 1 - (int)(it >> 3), b = (int)(it & 7u);
        dsa_query(A, wl, b, i, lane);
    }
}
static_assert(DSA_NW * DSA_WBYTES <= MISC_OFF, "dsa lds");
typedef short s8 __attribute__((ext_vector_type(8)));
typedef short v4i16_t __attribute__((ext_vector_type(4)));
typedef unsigned u16v __attribute__((ext_vector_type(16)));
typedef unsigned long long u64;
constexpr int NQT16 = L / 16;
constexpr int NKB32 = (L + 31) / 32;
constexpr int MASK_PB = 66112;
constexpr size_t MASK_LAYER = (size_t)NB * MASK_PB * 64;
constexpr size_t WS_MASK = 1956 * MiB;
static_assert(WS_MASK >= WS_MIX_END && WS_MASK + 2 * MASK_LAYER + 256 <= 2032 * MiB, "mask region");
__device__ __forceinline__ size_t mask_row(int l, int b, int qt) { const int a = qt >> 1; return (size_t)l * (NB * MASK_PB) + (size_t)b * MASK_PB + ((qt & 1) ? (a + 1) * (a + 1) : a * (a + 1)); }
constexpr int CW_KMAX = 8960;
constexpr int CW_KIMAX = 9216;
constexpr int MI_KMAX = 640, MI_UNIT = 768, MI_KIMAX = 832;
constexpr int SEL_PF = 3;
constexpr int SEL_HROW = 259;

__device__ __forceinline__ void sel_scores(const s8 a1, const s8 a2, const s8 (&qb)[9], const float (&wv)[8], pg8::f32x4& i1, pg8::f32x4& i2) {
    const pg8::f32x4 z = (pg8::f32x4){0.f, 0.f, 0.f, 0.f};
    i1 = __builtin_amdgcn_mfma_f32_16x16x32_bf16(a1, qb[8], z, 0, 0, 0); i2 = __builtin_amdgcn_mfma_f32_16x16x32_bf16(a2, qb[8], z, 0, 0, 0);
#pragma unroll
    for (int h = 0; h < 8; ++h) {
        const pg8::f32x4 c1 = __builtin_amdgcn_mfma_f32_16x16x32_bf16(a1, qb[h], z, 0, 0, 0), c2 = __builtin_amdgcn_mfma_f32_16x16x32_bf16(a2, qb[h], z, 0, 0, 0);
#pragma unroll
        for (int j = 0; j < 4; ++j) { float t1 = fmaf(fabsf(c1[j]), wv[h], i1[j]), t2 = fmaf(fabsf(c2[j]), wv[h], i2[j]);
            asm("" : "+v"(t1)); asm("" : "+v"(t2)); i1[j] = t1; i2[j] = t2; }
    }
}
template <int MODE, bool DIAG>
__device__ __forceinline__ void sel_block(const s8 a1, const s8 a2, const s8 (&qb)[9], const float (&wv)[8], int kb, int tq, int r, int g, int lane,
                                          LAS unsigned* hrow, float sc_mul, float sc_add, u64* mrow) {
    pg8::f32x4 i1, i2; sel_scores(a1, a2, qb, wv, i1, i2);
    const int s0 = kb * 32 + 8 * g;
    u64 wds[8];
#pragma unroll
    for (int j = 0; j < 8; ++j) {
        const float sc = j < 4 ? i1[j & 3] : i2[j & 3];
        if (MODE == 3) { if (sc == 123456.789f) hrow[256] = 1u; }
        else if (MODE == 2) { wds[j] = DIAG ? __ballot((s0 + j) <= tq && sc >= sc_add) : __ballot(sc >= sc_add); }
        else { int xi = (int)__builtin_floorf(fmaf(sc, sc_mul, sc_add));
            unsigned bin = MODE == 0 ? (unsigned)min(max(xi, 0), 255) : (unsigned)(min(max(xi, -1), 256) + 1);
            if (DIAG) bin = ((s0 + j) <= tq) ? bin : (MODE == 0 ? 256u : 0u);
            if (MODE == 0 || bin != 0u) __hip_atomic_fetch_add(hrow + bin, 1u, __ATOMIC_RELAXED, __HIP_MEMORY_SCOPE_WORKGROUP); }
    }
    if (MODE == 2 && lane == 0) { u64* d = mrow + (size_t)kb * 8;
#pragma unroll
        for (int j = 0; j < 8; j += 2) { v4u o; o.x = (unsigned)wds[j]; o.y = (unsigned)(wds[j] >> 32); o.z = (unsigned)wds[j + 1]; o.w = (unsigned)(wds[j + 1] >> 32); *(v4u*)(d + j) = o; } }
}
template <int MODE>
__device__ __forceinline__ void sel_pass(const bf16* KIb, const s8 (&qb)[9], const float (&wv)[8], int nkb, int tq, int r, int g, int lane,
                                         LAS unsigned* hrow, float sc_mul, float sc_add, u64* mrow, int kb_first = 0, int kb_step = 1) {
    const bf16* kp = KIb + (size_t)(8 * (r >> 2) + (r & 3)) * 32 + 8 * g;
    v4u cur[2 * SEL_PF], nxt[2 * SEL_PF];
#pragma unroll
    for (int i = 0; i < SEL_PF; ++i) { const size_t kb = kb_first + i * kb_step; cur[2 * i] = *(const v4u*)(kp + kb * 1024); cur[2 * i + 1] = *(const v4u*)(kp + kb * 1024 + 128); }
#pragma unroll 1
    for (int kb0 = kb_first; kb0 < nkb; kb0 += SEL_PF * kb_step) {
#pragma unroll
        for (int i = 0; i < SEL_PF; ++i) { const size_t kb = kb0 + (SEL_PF + i) * kb_step; nxt[2 * i] = *(const v4u*)(kp + kb * 1024); nxt[2 * i + 1] = *(const v4u*)(kp + kb * 1024 + 128); }
#pragma unroll
        for (int i = 0; i < SEL_PF; ++i) { const int kb = kb0 + i * kb_step;
            if (kb < nkb - 1) sel_block<MODE, false>(__builtin_bit_cast(s8, cur[2 * i]), __builtin_bit_cast(s8, cur[2 * i + 1]), qb, wv, kb, tq, r, g, lane, hrow, sc_mul, sc_add, mrow);
            else if (kb == nkb - 1) sel_block<MODE, true>(__builtin_bit_cast(s8, cur[2 * i]), __builtin_bit_cast(s8, cur[2 * i + 1]), qb, wv, kb, tq, r, g, lane, hrow, sc_mul, sc_add, mrow); }
#pragma unroll
        for (int i = 0; i < 2 * SEL_PF; ++i) cur[i] = nxt[i];
    }
}
__device__ __forceinline__ void sel_scan(const LAS unsigned* hrow, int need, int& sel, int& above) {
    int cum = 0; sel = 0; above = 0; bool found = false;
#pragma unroll 8
    for (int bin = 255; bin >= 0; --bin) { const int c = (int)hrow[bin];
        if (!found && cum + c >= need) { found = true; sel = bin; above = cum; }
        cum += c; }
}
__device__ PHASE_FN void dsa_select_phase(const Ctx A, LAS unsigned char* lds, int l) {
    const int tid = opaque_tid(), lane = tid & 63, wave = tid >> 6, r = lane & 15, g = lane >> 4;
    const bf16* DQI = (const bf16*)(A.ws + WS_DS_QI); const bf16* DKI = (const bf16*)(A.ws + WS_DS_KI); const float* DWI = (const float*)(A.ws + WS_DS_WI);
    u64* MASK = (u64*)(A.ws + WS_MASK);
    unsigned* qhead = (unsigned*)(A.ws + WS_CTL) + CW_DSAQ + 64 * l;
    const unsigned* kimaxw = (const unsigned*)(A.ws + WS_CTL) + CW_KIMAX + 64 * l;
    LAS unsigned* hist = (LAS unsigned*)(lds + wave * (16 * SEL_HROW * 4));
    LAS unsigned* hrow = hist + r * SEL_HROW;
    for (;;) {
        unsigned it = 0u;
        if (lane == 0) it = atomicAdd(qhead, 1u);
        it = __builtin_amdgcn_readfirstlane(it);
        if (it >= (unsigned)(NB * NQT16)) break;
        const int qt = NQT16 - 1 - (int)(it >> 3), b = (int)(it & 7u);
        const size_t mb = (size_t)b * L, m0 = mb + (size_t)qt * 16;
        const int tq = qt * 16 + r, nkb = ((qt * 16 + 15) >> 5) + 1;
        s8 qb[9]; float wv[8];
#pragma unroll
        for (int h = 0; h < 8; ++h) qb[h] = *(const s8*)(DQI + (m0 + r) * 256 + h * 32 + 8 * g);
        { const v4f w0 = *(const v4f*)(DWI + (m0 + r) * 8), w1 = *(const v4f*)(DWI + (m0 + r) * 8 + 4);
          wv[0] = w0.x; wv[1] = w0.y; wv[2] = w0.z; wv[3] = w0.w; wv[4] = w1.x; wv[5] = w1.y; wv[6] = w1.z; wv[7] = w1.w; }
        float bq = 0.f;
        { float ql[8];
#pragma unroll
          for (int e = 0; e < 8; ++e) ql[e] = 0.f;
#pragma unroll
          for (int h = 0; h < 8; ++h) { float n2 = 0.f;
#pragma unroll
              for (int e = 0; e < 8; ++e) { const float x = bf2f((unsigned short)qb[h][e]); ql[e] += wv[h] * x; n2 += x * x; }
              n2 += __shfl_xor(n2, 16); n2 += __shfl_xor(n2, 32); bq += fabsf(wv[h]) * sqrtf(n2); }
          v4u pk; pk.x = pk2(ql[0], ql[1]); pk.y = pk2(ql[2], ql[3]); pk.z = pk2(ql[4], ql[5]); pk.w = pk2(ql[6], ql[7]); qb[8] = __builtin_bit_cast(s8, pk); }
        const bf16* KIb = DKI + mb * 32;
        float thr_f = -__builtin_inff();
        if (qt * 16 + 15 >= 256) {
            const float kim = sqrtf(__uint_as_float(__hip_atomic_load(kimaxw + b, __ATOMIC_RELAXED, __HIP_MEMORY_SCOPE_AGENT)));
            const float R = fmaxf(2.06f * bq * kim, 1e-30f), s0 = 128.f / R, w0 = R * (1.f / 128.f);
            const int n = tq + 1;
            bool done = false;
            if (qt * 16 >= 2048) {
                for (int i = lane; i < 16 * SEL_HROW; i += 64) hist[i] = 0u;
                LDS_WAIT();
                sel_pass<0>(KIb, qb, wv, nkb - 1, tq, r, g, lane, hrow, s0, 128.f, nullptr, 3, 8);
                LDS_WAIT();
                const int ns = 32 * ((nkb - 1 - 3 + 7) >> 3);
                const float rho = 256.f * (float)ns / (float)n, dev = 4.f * sqrtf(rho) + 2.f;
                int bl, ab; sel_scan(hrow, (int)(rho + dev) + 1, bl, ab);
                int bh = 255, ab2 = 0; const int rhi = (int)(rho - dev);
                if (rhi >= 1) sel_scan(hrow, rhi, bh, ab2);
                LDS_WAIT();
                const float lo = -R + (float)bl * w0, hi = (rhi >= 1) ? (-R + (float)(bh + 1) * w0) : (R * 1.001f);
                const float s1 = 256.f / (hi - lo);
                for (int i = lane; i < 16 * SEL_HROW; i += 64) hist[i] = 0u;
                LDS_WAIT();
                sel_pass<1>(KIb, qb, wv, nkb, tq, r, g, lane, hrow, s1, -lo * s1, nullptr);
                LDS_WAIT();
                const int above = (int)hrow[257]; int inr = 0;
#pragma unroll 8
                for (int bin = 1; bin <= 256; ++bin) inr += (int)hrow[bin];
                const bool ok = above < 256 && above + inr >= 256;
                if (ok) { int sel1, ab1; sel_scan(hrow + 1, 256 - above, sel1, ab1); thr_f = lo + (float)sel1 * ((hi - lo) * (1.f / 256.f)); }
                LDS_WAIT();
                done = __all(ok);
            }
            if (!done) {
                for (int i = lane; i < 16 * SEL_HROW; i += 64) hist[i] = 0u;
                LDS_WAIT();
                sel_pass<0>(KIb, qb, wv, nkb, tq, r, g, lane, hrow, s0, 128.f, nullptr);
                LDS_WAIT();
                int sel0, above0; sel_scan(hrow, 256, sel0, above0);
                LDS_WAIT();
                const float lo0 = -R + (float)sel0 * w0, s1 = 256.f / w0;
                for (int i = lane; i < 16 * SEL_HROW; i += 64) hist[i] = 0u;
                LDS_WAIT();
                sel_pass<1>(KIb, qb, wv, nkb, tq, r, g, lane, hrow, s1, -lo0 * s1, nullptr);
                LDS_WAIT();
                int sel1, above1; sel_scan(hrow + 1, 256 - above0, sel1, above1);
                LDS_WAIT();
                thr_f = lo0 + (float)sel1 * (w0 * (1.f / 256.f));
            }
            if (n <= 256) thr_f = -__builtin_inff();
        }
        sel_pass<2>(KIb, qb, wv, nkb, tq, r, g, lane, hrow, 0.f, thr_f, MASK + mask_row(l, b, qt) * 8);
    }
}

constexpr int AT_ROW = 144;
constexpr int AT_TILE = 64 * AT_ROW;
constexpr int AT_NQT = (L - 16) / 256;
constexpr int AT_NKT = (L + 63) / 64;
static_assert(16 + AT_NQT * 256 == L, "query tiling");
__device__ PHASE_FN void dsa_attn_phase(const Ctx A, LAS unsigned char* lds, int l) {
    const int tid = opaque_tid(), lane = tid & 63, wave = tid >> 6, r = lane & 15, g = lane >> 4;
    const bf16* DQ = (const bf16*)(A.ws + WS_DS_Q); const bf16* DK = (const bf16*)(A.ws + WS_DS_K); const bf16* DV = (const bf16*)(A.ws + WS_DS_V);
    const u64* MASK = (const u64*)(A.ws + WS_MASK); bf16* MIX = (bf16*)(A.ws + WS_MIX);
    unsigned* qhead = (unsigned*)(A.ws + WS_CTL) + CW_DSAQ + 64 * l + 16;
    const unsigned* kmaxw = (const unsigned*)(A.ws + WS_CTL) + CW_KMAX + 64 * l;
    LAS unsigned* unitw = (LAS unsigned*)(lds + MISC_OFF + MI_UNIT);
    const int ldkey = tid >> 3, ldch = tid & 7;
    for (;;) {
        __syncthreads();
        if (tid == 0) unitw[0] = atomicAdd(qhead, 1u);
        __syncthreads();
        const unsigned u = unitw[0];
        if (u >= (unsigned)(NB * 4 * (AT_NQT + 1))) break;
        const bool mini = u >= (unsigned)(NB * 4 * AT_NQT);
        const int qt = mini ? 0 : AT_NQT - 1 - (int)(u >> 5), b = (int)((u & 31u) >> 2), h = (int)(u & 3u);
        const size_t mb = (size_t)b * L;
        const int kmain = mini ? 0 : 4 * qt;
        const int nkt = mini ? 1 : ((4 * qt + 5 < AT_NKT) ? 4 * qt + 5 : AT_NKT);
        const float kmax2 = __uint_as_float(__hip_atomic_load(kmaxw + b * 4 + h, __ATOMIC_RELAXED, __HIP_MEMORY_SCOPE_AGENT));
        int tq[2], lb[2]; bool act[2];
        s8 qf[2][2]; float nc2[2];
        const GAS unsigned* mrow[2];
#pragma unroll
        for (int qi = 0; qi < 2; ++qi) { act[qi] = mini ? (wave == 0 && qi == 0) : true; tq[qi] = mini ? 0 : 16 + qt * 256 + wave * 32 + 16 * qi;
            lb[qi] = __builtin_amdgcn_readfirstlane(act[qi] ? ((tq[qi] + 15) >> 5) : -1);
            float qn2 = 0.f;
#pragma unroll
            for (int ks = 0; ks < 2; ++ks) { qf[qi][ks] = act[qi] ? *(const s8*)(DQ + (mb + tq[qi] + r) * 256 + h * 64 + 32 * ks + 8 * g) : (s8){0, 0, 0, 0, 0, 0, 0, 0};
#pragma unroll
                for (int e = 0; e < 8; ++e) { const float x = bf2f((unsigned short)qf[qi][ks][e]); qn2 += x * x; } }
            qn2 += __shfl_xor(qn2, 16); qn2 += __shfl_xor(qn2, 32);
            nc2[qi] = -sqrtf(qn2 * kmax2);
            const u64 mrow_u = (u64)(MASK + mask_row(l, b, tq[qi] >> 4) * 8);
            const unsigned lo = (unsigned)__builtin_amdgcn_readfirstlane((unsigned)mrow_u), hi = (unsigned)__builtin_amdgcn_readfirstlane((unsigned)(mrow_u >> 32));
            mrow[qi] = (const GAS unsigned*)(((u64)hi << 32) | (u64)lo); }
        pg8::f32x4 O[2][4], Ls[2];
#pragma unroll
        for (int qi = 0; qi < 2; ++qi) { Ls[qi] = (pg8::f32x4){0.f, 0.f, 0.f, 0.f};
#pragma unroll
            for (int db = 0; db < 4; ++db) O[qi][db] = (pg8::f32x4){0.f, 0.f, 0.f, 0.f}; }
        const s8 ones8 = (s8){0x3F80, 0x3F80, 0x3F80, 0x3F80, 0x3F80, 0x3F80, 0x3F80, 0x3F80};
#define AT_SLOAD(dst, qi_, kb_) asm volatile("s_load_dwordx16 %0, %1, 0x0" : "=s"(dst) : "s"(mrow[qi_] + (size_t)(kb_) * 16))
#define AT_MWAIT(m0_, m1_) asm volatile("s_waitcnt lgkmcnt(0)" : "+s"(m0_), "+s"(m1_))
#define AT_MWAIT_S2(a0_, a1_, b0_, b1_) asm volatile("s_waitcnt lgkmcnt(0)" : "+s"(a0_), "+s"(a1_), "+s"(b0_), "+s"(b1_), "+v"(Sa), "+v"(Sb), "+v"(Sc), "+v"(Sd), "+v"(Se), "+v"(Sf), "+v"(Sg), "+v"(Sh) :: "memory")
#define AT_MWAIT_O(a0_, a1_, b0_, b1_) asm volatile("s_waitcnt lgkmcnt(0)" : "+s"(a0_), "+s"(a1_), "+s"(b0_), "+s"(b1_), "+v"(O[1][0]), "+v"(O[1][1]), "+v"(O[1][2]), "+v"(O[1][3]), "+v"(Ls[1]) :: "memory")
        const bf16* kg = DK + (mb + ldkey) * 256 + h * 64 + ldch * 8; const bf16* vg = DV + (mb + ldkey) * 256 + h * 64 + ldch * 8;
        v4u rk0 = *(const v4u*)kg, rv0 = *(const v4u*)vg;
        const size_t to1 = (size_t)(nkt > 1 ? 1 : nkt - 1) * 64 * 256, to2 = (size_t)(nkt > 2 ? 2 : nkt - 1) * 64 * 256, to3 = (size_t)(nkt > 3 ? 3 : nkt - 1) * 64 * 256;
        v4u rk1 = *(const v4u*)(kg + to1), rv1 = *(const v4u*)(vg + to1), rk2 = *(const v4u*)(kg + to2), rv2 = *(const v4u*)(vg + to2), rk3 = *(const v4u*)(kg + to3), rv3 = *(const v4u*)(vg + to3);
        u16v m0, m1, n0, n1;
#define AT_STORE(boff, rk, rv) do { LAS unsigned char* kb_ = lds + (boff); LAS unsigned char* vb_ = kb_ + AT_TILE; \
            *(LAS v4u*)(kb_ + ldkey * AT_ROW + ldch * 16) = rk; *(LAS v4u*)(vb_ + ldkey * AT_ROW + ldch * 16) = rv; } while (0)
#define AT_LOAD(kt_, rk, rv) do { rk = *(const v4u*)(kg + (size_t)(kt_) * 64 * 256); rv = *(const v4u*)(vg + (size_t)(kt_) * 64 * 256); } while (0)
#define AT_KREAD(boff, blk) do { const LAS unsigned char* ka = lds + (boff) + ((blk) * 32 + 8 * (r >> 2) + (r & 3)) * AT_ROW + g * 16; \
            _Pragma("unroll") for (int ks = 0; ks < 2; ++ks) { kf[blk][ks][0] = *(const LAS s8*)(ka + ks * 64); kf[blk][ks][1] = *(const LAS s8*)(ka + 4 * AT_ROW + ks * 64); } } while (0)
#define AT_VREAD(boff, blk) do { const LAS unsigned char* va = lds + (boff) + AT_TILE + ((blk) * 32 + 8 * g + (r >> 2)) * AT_ROW + (r & 3) * 8; \
            _Pragma("unroll") for (int db = 0; db < 4; ++db) { \
                const v4i16_t x0 = __builtin_amdgcn_ds_read_tr16_b64_v4i16((LAS v4i16_t*)(va + db * 32)), x1 = __builtin_amdgcn_ds_read_tr16_b64_v4i16((LAS v4i16_t*)(va + 4 * AT_ROW + db * 32)); \
                vf[blk][db] = (s8){x0[0], x0[1], x0[2], x0[3], x1[0], x1[1], x1[2], x1[3]}; } } while (0)
#define AT_BLK_S(blk, qi, S1, S2) do { S1 = (pg8::f32x4){nc2[qi], nc2[qi], nc2[qi], nc2[qi]}; S2 = S1; \
            _Pragma("unroll") for (int ks = 0; ks < 2; ++ks) { \
                S1 = __builtin_amdgcn_mfma_f32_16x16x32_bf16(kf[blk][ks][0], qf[qi][ks], S1, 0, 0, 0); S2 = __builtin_amdgcn_mfma_f32_16x16x32_bf16(kf[blk][ks][1], qf[qi][ks], S2, 0, 0, 0); } } while (0)
#define AT_BLK_P(mq, S1, S2, pa) do { float p[8]; \
            _Pragma("unroll") for (int j = 0; j < 8; ++j) { \
                const bool bit = __builtin_amdgcn_inverse_ballot_w64(((u64)mq[2 * j + 1] << 32) | mq[2 * j]); \
                p[j] = bit ? __builtin_amdgcn_exp2f(j < 4 ? S1[j & 3] : S2[j & 3]) : 0.f; } \
            v4u pk; pk.x = pk2(p[0], p[1]); pk.y = pk2(p[2], p[3]); pk.z = pk2(p[4], p[5]); pk.w = pk2(p[6], p[7]); \
            pa = __builtin_bit_cast(s8, pk); } while (0)
#define AT_BLK_V(blk, qi, pa) do { \
            _Pragma("unroll") for (int db = 0; db < 4; ++db) O[qi][db] = __builtin_amdgcn_mfma_f32_16x16x32_bf16(pa, vf[blk][db], O[qi][db], 0, 0, 0); \
            Ls[qi] = __builtin_amdgcn_mfma_f32_16x16x32_bf16(pa, ones8, Ls[qi], 0, 0, 0); } while (0)
#define AT_ROTATE do { const int t_ = bc; bc = bn; bn = bs; bs = t_; } while (0)
#define AT_MAIN_BODY(kt, RK_LD, RV_LD, RK_ST, RV_ST, LASTWAIT) do { \
            { const int ktn_ = (kt) + 5 < nkt ? (kt) + 5 : nkt - 1; AT_LOAD(ktn_, RK_LD, RV_LD); } \
            AT_STORE(bs, RK_ST, RV_ST); \
            pg8::f32x4 Sa, Sb, Sc, Sd, Se, Sf, Sg, Sh; s8 pa0, pa1, pb0, pb1; \
            AT_BLK_S(0, 0, Sa, Sb); AT_BLK_S(1, 0, Sc, Sd); AT_BLK_S(0, 1, Se, Sf); AT_BLK_S(1, 1, Sg, Sh);        \
            AT_MWAIT_S2(m0, m1, n0, n1); \
            AT_KREAD(bn, 0); AT_KREAD(bn, 1); \
            AT_BLK_P(m0, Sa, Sb, pa0); AT_SLOAD(m0, 0, 2 * (kt) + 2); AT_BLK_P(m1, Sc, Sd, pa1); AT_SLOAD(m1, 0, 2 * (kt) + 3); \
            AT_BLK_V(0, 0, pa0); AT_BLK_V(1, 0, pa1); \
            AT_BLK_P(n0, Se, Sf, pb0); AT_SLOAD(n0, 1, 2 * (kt) + 2); AT_BLK_P(n1, Sg, Sh, pb1); AT_SLOAD(n1, 1, 2 * (kt) + 3); \
            AT_BLK_V(0, 1, pb0); AT_BLK_V(1, 1, pb1); \
            if (LASTWAIT) AT_MWAIT_O(m0, m1, n0, n1);                   \
            AT_VREAD(bn, 0); AT_VREAD(bn, 1); \
            AT_ROTATE; \
            __builtin_amdgcn_s_barrier(); } while (0)
#define AT_DIAG_STEP(kt, qi) do { \
            if (2 * (kt) + 1 <= lb[qi]) { pg8::f32x4 Sa, Sb, Sc, Sd; s8 pa0, pa1; AT_SLOAD(m0, qi, 2 * (kt)); AT_SLOAD(m1, qi, 2 * (kt) + 1); \
                AT_BLK_S(0, qi, Sa, Sb); AT_BLK_S(1, qi, Sc, Sd); AT_MWAIT(m0, m1); AT_BLK_P(m0, Sa, Sb, pa0); AT_BLK_P(m1, Sc, Sd, pa1); AT_BLK_V(0, qi, pa0); AT_BLK_V(1, qi, pa1); } \
            else if (2 * (kt) <= lb[qi]) { pg8::f32x4 Sa, Sb; s8 pa0; AT_SLOAD(m0, qi, 2 * (kt)); AT_SLOAD(m1, qi, 2 * (kt)); \
                AT_BLK_S(0, qi, Sa, Sb); AT_MWAIT(m0, m1); AT_BLK_P(m0, Sa, Sb, pa0); AT_BLK_V(0, qi, pa0); } } while (0)
#define AT_DIAG_BODY(kt, RK_LD, RV_LD, RK_ST, RV_ST) do { \
            { const int ktn_ = (kt) + 5 < nkt ? (kt) + 5 : nkt - 1; AT_LOAD(ktn_, RK_LD, RV_LD); } \
            AT_STORE(bs, RK_ST, RV_ST); \
            if (2 * (kt) <= lb[1] || 2 * (kt) <= lb[0]) { \
                AT_KREAD(bc, 0); AT_KREAD(bc, 1); AT_VREAD(bc, 0); AT_VREAD(bc, 1); \
                AT_DIAG_STEP(kt, 0); AT_DIAG_STEP(kt, 1); } \
            asm volatile("s_waitcnt lgkmcnt(0)" ::: "memory"); \
            AT_ROTATE; \
            __builtin_amdgcn_s_barrier(); } while (0)
        int bc = 0, bn = 2 * AT_TILE, bs = 4 * AT_TILE;
        s8 kf[2][2][2], vf[2][4];
        AT_SLOAD(m0, 0, 0); AT_SLOAD(m1, 0, 1); AT_SLOAD(n0, 1, 0); AT_SLOAD(n1, 1, 1);
        AT_STORE(bc, rk0, rv0);
        AT_STORE(bn, rk1, rv1);
        AT_LOAD(nkt > 4 ? 4 : nkt - 1, rk0, rv0);
        AT_MWAIT(m0, m1); AT_MWAIT(n0, n1);
        __syncthreads();
        AT_KREAD(bc, 0); AT_KREAD(bc, 1); AT_VREAD(bc, 0); AT_VREAD(bc, 1);
#pragma unroll 1
        for (int kt = 0; kt < kmain; kt += 4) {
            AT_MAIN_BODY(kt, rk1, rv1, rk2, rv2, false);
            AT_MAIN_BODY(kt + 1, rk2, rv2, rk3, rv3, false);
            AT_MAIN_BODY(kt + 2, rk3, rv3, rk0, rv0, false);
            AT_MAIN_BODY(kt + 3, rk0, rv0, rk1, rv1, true);
        }
#pragma unroll 1
        for (int kt = kmain; kt < nkt; kt += 4) {
            AT_DIAG_BODY(kt, rk1, rv1, rk2, rv2);
            AT_DIAG_BODY(kt + 1, rk2, rv2, rk3, rv3);
            AT_DIAG_BODY(kt + 2, rk3, rv3, rk0, rv0);
            AT_DIAG_BODY(kt + 3, rk0, rv0, rk1, rv1);
        }
#undef AT_ROTATE
#undef AT_MAIN_BODY
#undef AT_DIAG_BODY
#undef AT_DIAG_STEP
#undef AT_BLK_S
#undef AT_BLK_P
#undef AT_BLK_V
#undef AT_KREAD
#undef AT_VREAD
#undef AT_SLOAD
#undef AT_MWAIT
#undef AT_MWAIT_S2
#undef AT_MWAIT_O
#undef AT_LOAD
#undef AT_STORE
#pragma unroll
        for (int qi = 0; qi < 2; ++qi)
#pragma unroll
            for (int j = 0; j < 4; ++j) { const float ij = Ls[qi][j] > 0.f ? 1.f / Ls[qi][j] : 0.f; const int t = tq[qi] + 4 * g + j;
                if (act[qi]) {
#pragma unroll
                    for (int db = 0; db < 4; ++db) MIX[(mb + t) * 1024 + 256 + h * 64 + db * 16 + r] = f2bf(O[qi][db][j] * ij); } }
    }
}
constexpr int CK = 16;
constexpr int NCHK = L / CK;
static_assert(L % CK == 0, "chunk length");
constexpr int CKP_RW = 10, CKP_HG = 7;
constexpr int CKR_RW = CKP_RW * 1024 + 512, CKR_HG = CKP_HG * 1024 + 256;
constexpr size_t WS_CKF_RW = WS_PROJ + 136 * MiB;
constexpr size_t WS_CKF_HG = WS_CKF_RW + (size_t)32 * NCHK * CKR_RW;
static_assert(WS_CKF_HG + (size_t)32 * NCHK * CKR_HG <= WS_PROJ + (size_t)TP * NINP * 2, "chunk fragments fit in the dead proj region");
__device__ __forceinline__ s8 pack8(const pg8::f32x4 lo, const pg8::f32x4 hi) { v4u p; p.x = pk2(lo[0], lo[1]); p.y = pk2(lo[2], lo[3]); p.z = pk2(hi[0], hi[1]); p.w = pk2(hi[2], hi[3]); return __builtin_bit_cast(s8, p); }
template <int CTRL> __device__ __forceinline__ float dpp_shr1(float x) { return __int_as_float(__builtin_amdgcn_update_dpp(0x3F800000, __float_as_int(x), CTRL, 0xF, 0xF, false)); }
__device__ __forceinline__ float row_cumprod(float x) { x *= dpp_shr1<0x111>(x); x *= dpp_shr1<0x112>(x); x *= dpp_shr1<0x114>(x); x *= dpp_shr1<0x118>(x); return x; }

template <bool RWKV>
__device__ __forceinline__ void chunk_prep_item(const Ctx A, int bh, int c, int lane) {
    const int r = lane & 15, g = lane >> 4;
    const size_t base = ((size_t)bh * L + (size_t)c * CK + r) * 64;
    const float* Wg = (const float*)(A.ws + (RWKV ? WS_RW_W : WS_HG_F)) + base;
    const bf16* Ag = (const bf16*)(A.ws + WS_RW_A) + base; const bf16* Bg = (const bf16*)(A.ws + WS_RW_B) + base;
    const bf16* Kg = (const bf16*)(A.ws + (RWKV ? WS_RW_K : WS_HG_K)) + base; const bf16* Rg = (const bf16*)(A.ws + (RWKV ? WS_RW_WR : WS_HG_Q)) + base;
    GAS unsigned char* recb = A.ws + (RWKV ? WS_CKF_RW : WS_CKF_HG) + ((size_t)bh * NCHK + c) * (RWKV ? CKR_RW : CKR_HG);
    v4u* REC = (v4u*)recb + lane; v4f* GCp = (v4f*)(recb + (RWKV ? CKP_RW : CKP_HG) * 1024); float* Dp = (float*)(recb + CKP_RW * 1024 + 256);
    s8 Af[2], Bf[2], Kf[2], Rf[2], BTf[2], KTf[2];
    v4f gcv[4];
#pragma unroll
    for (int ks = 0; ks < 2; ++ks) {
        pg8::f32x4 ah[2], bh_[2], kh[2], rh[2], bt[2], kt[2];
#pragma unroll
        for (int hf = 0; hf < 2; ++hf) {
            const int k0 = 32 * ks + 16 * hf + 4 * g;
            const v4f w4 = *(const v4f*)(Wg + k0);
            v4f gt, gm, gc;
#pragma unroll
            for (int e = 0; e < 4; ++e) { gt[e] = row_cumprod(w4[e]); gm[e] = dpp_shr1<0x111>(gt[e]); gc[e] = __shfl(gt[e], 16 * g + 15); }
            gcv[2 * ks + hf] = gc;
            v4f inv; inv.x = __builtin_amdgcn_rcpf(gt.x); inv.y = __builtin_amdgcn_rcpf(gt.y); inv.z = __builtin_amdgcn_rcpf(gt.z); inv.w = __builtin_amdgcn_rcpf(gt.w);
            const v4f kk4 = ld_bf4(Kg + k0) * inv, rr4 = ld_bf4(Rg + k0) * (RWKV ? gm : gt);
            kh[hf] = kk4; rh[hf] = rr4; kt[hf] = kk4 * gc;
            if (RWKV) { ah[hf] = ld_bf4(Ag + k0) * gm; bh_[hf] = ld_bf4(Bg + k0) * inv; bt[hf] = bh_[hf] * gc; }
        }
        Kf[ks] = pack8(kh[0], kh[1]); Rf[ks] = pack8(rh[0], rh[1]); KTf[ks] = pack8(kt[0], kt[1]);
        if (RWKV) { Af[ks] = pack8(ah[0], ah[1]); Bf[ks] = pack8(bh_[0], bh_[1]); BTf[ks] = pack8(bt[0], bt[1]); }
    }
    const pg8::f32x4 z4 = (pg8::f32x4){0.f, 0.f, 0.f, 0.f};
    s8 selE, selO;
    { v4u e = (v4u){0u, 0u, 0u, 0u}, o = e; const int jj = r - 4 * g;
      if (jj >= 0 && jj < 4) { const unsigned one = 0x3F80u << (16 * (jj & 1)); if (jj < 2) { e.x = one; o.z = one; } else { e.y = one; o.w = one; } }
      selE = __builtin_bit_cast(s8, e); selO = __builtin_bit_cast(s8, o); }
    pg8::f32x4 MrkT = __builtin_amdgcn_mfma_f32_16x16x32_bf16(Kf[0], Rf[0], z4, 0, 0, 0); MrkT = __builtin_amdgcn_mfma_f32_16x16x32_bf16(Kf[1], Rf[1], MrkT, 0, 0, 0);
    const int tb = r >> 2, tj = r & 3;
    if (RWKV) {
        pg8::f32x4 LabT = __builtin_amdgcn_mfma_f32_16x16x32_bf16(Bf[0], Af[0], z4, 0, 0, 0); LabT = __builtin_amdgcn_mfma_f32_16x16x32_bf16(Bf[1], Af[1], LabT, 0, 0, 0);
        pg8::f32x4 LakT = __builtin_amdgcn_mfma_f32_16x16x32_bf16(Kf[0], Af[0], z4, 0, 0, 0); LakT = __builtin_amdgcn_mfma_f32_16x16x32_bf16(Kf[1], Af[1], LakT, 0, 0, 0);
        pg8::f32x4 MrbT = __builtin_amdgcn_mfma_f32_16x16x32_bf16(Bf[0], Rf[0], z4, 0, 0, 0); MrbT = __builtin_amdgcn_mfma_f32_16x16x32_bf16(Bf[1], Rf[1], MrbT, 0, 0, 0);
        const float d10 = __shfl(LabT[0], 20 * g + 1), d20 = __shfl(LabT[0], 20 * g + 2), d21 = __shfl(LabT[1], 20 * g + 2);
        const float d30 = __shfl(LabT[0], 20 * g + 3), d31 = __shfl(LabT[1], 20 * g + 3), d32 = __shfl(LabT[2], 20 * g + 3);
        pg8::f32x4 Loff, Lak, Mrb, Mrk;
#pragma unroll
        for (int j = 0; j < 4; ++j) { const bool below = g < tb, diag = g == tb;
            Loff[j] = below ? LabT[j] : 0.f; Lak[j] = (below || (diag && j < tj)) ? LakT[j] : 0.f;
            Mrb[j] = (below || (diag && j <= tj)) ? MrbT[j] : 0.f; Mrk[j] = (below || (diag && j <= tj)) ? MrkT[j] : 0.f; }
        REC[0 * 64] = __builtin_bit_cast(v4u, Af[0]); REC[1 * 64] = __builtin_bit_cast(v4u, Af[1]); REC[2 * 64] = __builtin_bit_cast(v4u, Rf[0]); REC[3 * 64] = __builtin_bit_cast(v4u, Rf[1]);
        REC[4 * 64] = __builtin_bit_cast(v4u, pack8(Loff, Lak)); REC[5 * 64] = __builtin_bit_cast(v4u, pack8(Mrb, Mrk));
        if (r == 0) { *(v4f*)(Dp + 8 * g) = (v4f){d10, d20, d21, d30}; *(v4f*)(Dp + 8 * g + 4) = (v4f){d31, d32, 0.f, 0.f}; }
#pragma unroll
        for (int mt = 0; mt < 4; ++mt) { const s8 sel = (mt & 1) ? selO : selE;
            const pg8::f32x4 K2 = __builtin_amdgcn_mfma_f32_16x16x32_bf16(KTf[mt >> 1], sel, z4, 0, 0, 0), B2 = __builtin_amdgcn_mfma_f32_16x16x32_bf16(BTf[mt >> 1], sel, z4, 0, 0, 0);
            REC[(6 + mt) * 64] = __builtin_bit_cast(v4u, pack8(B2, K2)); if (r == 15) GCp[4 * mt + g] = gcv[mt]; }
    } else {
        pg8::f32x4 Mrk;
#pragma unroll
        for (int j = 0; j < 4; ++j) Mrk[j] = (g < tb || (g == tb && j <= tj)) ? MrkT[j] : 0.f;
        REC[0 * 64] = __builtin_bit_cast(v4u, Rf[0]); REC[1 * 64] = __builtin_bit_cast(v4u, Rf[1]); REC[2 * 64] = __builtin_bit_cast(v4u, pack8(z4, Mrk));
#pragma unroll
        for (int mt = 0; mt < 4; ++mt) { const s8 sel = (mt & 1) ? selO : selE;
            const pg8::f32x4 K2 = __builtin_amdgcn_mfma_f32_16x16x32_bf16(KTf[mt >> 1], sel, z4, 0, 0, 0);
            REC[(3 + mt) * 64] = __builtin_bit_cast(v4u, pack8(z4, K2)); if (r == 15) GCp[4 * mt + g] = gcv[mt]; }
    }
}
__device__ PHASE_FN void chunk_prep_phase(const Ctx A, int vcu, int G) {
    const int tid = opaque_tid(), lane = tid & 63, wave = tid >> 6;
    const int gw = vcu * NWAVES + wave, NGW = G * NWAVES;
#pragma unroll 1
    for (int it = gw; it < 2 * 32 * NCHK; it += NGW) {
        const int mix = it >= 32 * NCHK, q = mix ? it - 32 * NCHK : it, bh = q / NCHK, c = q - bh * NCHK;
        if (mix) chunk_prep_item<false>(A, bh, c, lane); else chunk_prep_item<true>(A, bh, c, lane);
    }
}
template <bool RWKV>
__device__ PHASE_FN void chunk_scan(const Ctx A, LAS unsigned char* lds, int unit_) {
    const int unit = opaque_s(unit_);
    const int tid = opaque_tid(), lane = tid & 63, wave = tid >> 6, r = lane & 15, g = lane >> 4;
    const int slot = wave >> 2, nt = wave & 3;
    const int bh = 2 * unit + slot, b = bh >> 2, h = bh & 3;
    constexpr int NP = RWKV ? CKP_RW : CKP_HG;
    constexpr int NU = NP + 3;
    constexpr int NQ = (NU + 3) / 4;
    constexpr int RING = NU * 1024;
    constexpr size_t RB = RWKV ? CKR_RW : CKR_HG;
    const GAS unsigned char* recb = A.ws + (RWKV ? WS_CKF_RW : WS_CKF_HG) + (size_t)bh * NCHK * RB;
    const GAS unsigned char* vb = A.ws + (RWKV ? WS_RW_V : WS_HG_V) + (size_t)bh * L * 128;
    float* YR = (float*)(A.ws + (RWKV ? WS_YRAW : WS_ORAW)) + (size_t)b * L * 256 + h * 64 + nt * 16 + r;
    LAS unsigned char* ring = lds + slot * 2 * RING;
    static_assert(4 * (size_t)(CKP_RW + 3) * 1024 <= MISC_OFF, "chunk ring");
    auto unit_src = [&](int c_, int u) -> const GAS v4u* {
        if (u < NP) return (const GAS v4u*)(recb + (size_t)c_ * RB + u * 1024) + lane;
        if (u == NP) { const int q = lane * 16 < (int)(RB - NP * 1024) ? lane * 16 : (int)(RB - NP * 1024) - 16; return (const GAS v4u*)(recb + (size_t)c_ * RB + NP * 1024 + q); }
        return (const GAS v4u*)(vb + (size_t)c_ * CK * 128 + (u - NP - 1) * 1024) + lane; };
    v4u st0[NQ], st1[NQ], st2[NQ], st3[NQ];
#define CK_LD(S, c_) do { const int cc_ = (c_) < NCHK ? (c_) : NCHK - 1; _Pragma("unroll") for (int q = 0; q < NQ; ++q) { const int u = nt + 4 * q; if (u < NU) S[q] = *unit_src(cc_, u); } } while (0)
#define CK_ST(S, p_) do { _Pragma("unroll") for (int q = 0; q < NQ; ++q) { const int u = nt + 4 * q; if (u < NU) *(LAS v4u*)(ring + (p_) * RING + u * 1024 + lane * 16) = S[q]; } } while (0)
    pg8::f32x4 ST[4];
#pragma unroll
    for (int mt = 0; mt < 4; ++mt) ST[mt] = (pg8::f32x4){0.f, 0.f, 0.f, 0.f};
    const pg8::f32x4 z4 = (pg8::f32x4){0.f, 0.f, 0.f, 0.f};
    auto body = [&](const int c, const int p) __attribute__((always_inline)) {
        const LAS unsigned char* rb_ = ring + p * RING;
        const LAS unsigned char* sm = rb_ + NP * 1024;
        v4u pcs[NP]; v4f gqs[4]; v4f da = (v4f){0.f, 0.f, 0.f, 0.f}, db = da;
#pragma unroll
        for (int i = 0; i < NP; ++i) pcs[i] = *(const LAS v4u*)(rb_ + i * 1024 + lane * 16);
#pragma unroll
        for (int mt = 0; mt < 4; ++mt) gqs[mt] = *(const LAS v4f*)(sm + (16 * mt + 4 * g) * 4);
        if (RWKV) { da = *(const LAS v4f*)(sm + 256 + g * 32); db = *(const LAS v4f*)(sm + 256 + g * 32 + 16); }
#define PIECE(i) __builtin_bit_cast(s8, pcs[i])
        unsigned vp0, vp1;
        { const LAS unsigned short* vv = (const LAS unsigned short*)(rb_ + (NP + 1) * 1024) + (4 * g) * 64 + 16 * nt + r;
          vp0 = (unsigned)vv[0] | ((unsigned)vv[64] << 16); vp1 = (unsigned)vv[128] | ((unsigned)vv[192] << 16); }
        __builtin_amdgcn_sched_barrier(0);
        const s8 Sf0 = pack8(ST[0], ST[1]), Sf1 = pack8(ST[2], ST[3]);
        pg8::f32x4 U = z4, R0;
        if (RWKV) {
            R0 = __builtin_amdgcn_mfma_f32_16x16x32_bf16(PIECE(2), Sf0, z4, 0, 0, 0); R0 = __builtin_amdgcn_mfma_f32_16x16x32_bf16(PIECE(3), Sf1, R0, 0, 0, 0);
            pg8::f32x4 W0 = __builtin_amdgcn_mfma_f32_16x16x32_bf16(PIECE(0), Sf0, z4, 0, 0, 0); W0 = __builtin_amdgcn_mfma_f32_16x16x32_bf16(PIECE(1), Sf1, W0, 0, 0, 0);
            const float d10 = da.x, d20 = da.y, d21 = da.z, d30 = da.w, d31 = db.x, d32 = db.y;
            const s8 Ajac = PIECE(4);
#pragma unroll
            for (int rnd = 0; rnd < 4; ++rnd) {
                v4u bu; bu.x = pk2(U[0], U[1]); bu.y = pk2(U[2], U[3]); bu.z = vp0; bu.w = vp1;
                const pg8::f32x4 Wr = __builtin_amdgcn_mfma_f32_16x16x32_bf16(Ajac, __builtin_bit_cast(s8, bu), W0, 0, 0, 0);
                U[0] = Wr[0]; U[1] = Wr[1] + d10 * U[0]; U[2] = Wr[2] + d20 * U[0] + d21 * U[1]; U[3] = Wr[3] + d30 * U[0] + d31 * U[1] + d32 * U[2];
            }
        } else {
            R0 = __builtin_amdgcn_mfma_f32_16x16x32_bf16(PIECE(0), Sf0, z4, 0, 0, 0); R0 = __builtin_amdgcn_mfma_f32_16x16x32_bf16(PIECE(1), Sf1, R0, 0, 0, 0);
        }
        v4u buv; buv.x = pk2(U[0], U[1]); buv.y = pk2(U[2], U[3]); buv.z = vp0; buv.w = vp1;
        const s8 Buv = __builtin_bit_cast(s8, buv);
        const pg8::f32x4 Yt = __builtin_amdgcn_mfma_f32_16x16x32_bf16(PIECE(RWKV ? 5 : 2), Buv, R0, 0, 0, 0);
#pragma unroll
        for (int j = 0; j < 4; ++j) YR[(size_t)(c * CK + 4 * g + j) * 256] = Yt[j];
#pragma unroll
        for (int mt = 0; mt < 4; ++mt) {
            const v4f gq = gqs[mt];
            ST[mt][0] *= gq.x; ST[mt][1] *= gq.y; ST[mt][2] *= gq.z; ST[mt][3] *= gq.w;
            ST[mt] = __builtin_amdgcn_mfma_f32_16x16x32_bf16(PIECE((RWKV ? 6 : 3) + mt), Buv, ST[mt], 0, 0, 0);
        }
#undef PIECE
    };
    CK_LD(st0, 0); CK_LD(st1, 1); CK_LD(st2, 2); CK_LD(st3, 3);
    CK_ST(st0, 0);
    __syncthreads();
#define CK_TRIP(c_, SLD, SST, p_) do { CK_LD(SLD, (c_) + 4); body((c_), (p_)); CK_ST(SST, 1 - (p_)); __syncthreads(); } while (0)
    static_assert(NCHK % 4 == 1, "chunk loop: whole groups of four trips + one");
#pragma unroll 1
    for (int c = 0; c < NCHK - 1; c += 4) {
        CK_TRIP(c, st0, st1, 0);
        CK_TRIP(c + 1, st1, st2, 1);
        CK_TRIP(c + 2, st2, st3, 0);
        CK_TRIP(c + 3, st3, st0, 1);
    }
    CK_TRIP(NCHK - 1, st0, st1, 0);
#undef CK_TRIP
#undef CK_LD
#undef CK_ST
}
__device__ __forceinline__ float rowmax16(float x) { x = fmaxf(x, dpp_f<0xB1>(x)); x = fmaxf(x, dpp_f<0x4E>(x)); x = fmaxf(x, dpp_f<0x141>(x)); x = fmaxf(x, dpp_f<0x140>(x)); return x; }
__device__ __forceinline__ int rowmin16i(int x) { x = min(x, __builtin_amdgcn_update_dpp(0, x, 0xB1, 0xF, 0xF, true)); x = min(x, __builtin_amdgcn_update_dpp(0, x, 0x4E, 0xF, 0xF, true));
    x = min(x, __builtin_amdgcn_update_dpp(0, x, 0x141, 0xF, 0xF, true)); x = min(x, __builtin_amdgcn_update_dpp(0, x, 0x140, 0xF, 0xF, true)); return x; }
__device__ PHASE_FN void ln_router_phase(const Ctx A, LAS unsigned char* lds, int l, int vcu, int G) {
    const int tid = opaque_tid(), lane = tid & 63, wave = tid >> 6, r = lane & 15, g = lane >> 4;
    const int gw = vcu * NWAVES + wave, NGW = G * NWAVES;
    bf16* HB = (bf16*)(A.ws + WS_HB);
    int* TIDX = (int*)(A.ws + WS_TIDX); float* TGATE = (float*)(A.ws + WS_TGATE);
    unsigned* ecnt = (unsigned*)(A.ws + WS_CTL) + CW_ECNT + 64 * l;
    const float* gg = gin(A, 26) + l * D; const float* bb = gin(A, 27) + l * D;
    const float* rw = gin(A, 28) + (size_t)l * D * NE; const float* rb = gin(A, 29) + l * NE;
    LAS int* hist = (LAS int*)(lds + MISC_OFF + MI_HIST);
    if (tid < 32) hist[tid] = 0;
    for (int f = tid; f < 32 * 2 * 64; f += NTHR) { const int ks = f >> 7, nt = (f >> 6) & 1, ln = f & 63, n = ln & 15, g8 = ln >> 4;
        float w8[8];
#pragma unroll
        for (int e = 0; e < 8; ++e) w8[e] = rw[(size_t)(32 * ks + 8 * g8 + e) * NE + 16 * nt + n];
        v4u hi, lo; unsigned hh[4], ll[4];
#pragma unroll
        for (int e = 0; e < 4; ++e) { const unsigned ph = pk2(w8[2 * e], w8[2 * e + 1]); hh[e] = ph; ll[e] = pk2(w8[2 * e] - bflo(ph), w8[2 * e + 1] - bfhi(ph)); }
        hi = (v4u){hh[0], hh[1], hh[2], hh[3]}; lo = (v4u){ll[0], ll[1], ll[2], ll[3]};
        *(LAS v4u*)(lds + ((size_t)((ks * 2 + nt) * 2 + 0) * 64 + ln) * 16) = hi; *(LAS v4u*)(lds + ((size_t)((ks * 2 + nt) * 2 + 1) * 64 + ln) * 16) = lo; }
    __syncthreads();
    const float rb0 = rb[r], rb1 = rb[16 + r];
    auto lnrows = [&](size_t mrow, auto nrows_c) {
        constexpr int NR = decltype(nrows_c)::value;
        v4f x[NR][4];
#pragma unroll
        for (int u = 0; u < NR; ++u)
#pragma unroll
            for (int j = 0; j < 4; ++j) x[u][j] = ld_bf4(HB + (mrow + u) * D + 256 * j + 4 * lane);
#pragma unroll
        for (int u = 0; u < NR; ++u) { ln_row(x[u], gg, bb, lane);
#pragma unroll
            for (int j = 0; j < 4; ++j) { const size_t o = (mrow + u) * D + 256 * j + 4 * lane;
                v2u hi; hi.x = pk2(x[u][j].x, x[u][j].y); hi.y = pk2(x[u][j].z, x[u][j].w);
                *(v2u*)(HB + o) = hi; } }
    };
    auto ln2 = [&](size_t mrow) { lnrows(mrow, std::integral_constant<int, 2>{}); };
    auto route = [&](size_t m0) {
        pg8::f32x4 C0 = (pg8::f32x4){0.f, 0.f, 0.f, 0.f}, C1 = C0;
        const bf16* ah = HB + (m0 + r) * D + 8 * g;
#pragma unroll 4
        for (int ks = 0; ks < 32; ++ks) {
            const s8 xh = *(const s8*)(ah + 32 * ks);
            const LAS unsigned char* wf = lds + (size_t)(ks * 4) * 1024 + lane * 16;
            const s8 w0h = *(const LAS s8*)(wf), w0l = *(const LAS s8*)(wf + 1024), w1h = *(const LAS s8*)(wf + 2048), w1l = *(const LAS s8*)(wf + 3072);
            C0 = __builtin_amdgcn_mfma_f32_16x16x32_bf16(xh, w0h, C0, 0, 0, 0); C0 = __builtin_amdgcn_mfma_f32_16x16x32_bf16(xh, w0l, C0, 0, 0, 0);
            C1 = __builtin_amdgcn_mfma_f32_16x16x32_bf16(xh, w1h, C1, 0, 0, 0); C1 = __builtin_amdgcn_mfma_f32_16x16x32_bf16(xh, w1l, C1, 0, 0, 0);
        }
#pragma unroll
        for (int j = 0; j < 4; ++j) {
            float v0 = C0[j] + rb0, v1 = C1[j] + rb1;
            float tv[4]; int ti[4];
#pragma unroll
            for (int q = 0; q < 4; ++q) {
                const float mx = rowmax16(fmaxf(v0, v1));
                const int cand = (v0 == mx) ? r : ((v1 == mx) ? 16 + r : 64);
                const int bi = rowmin16i(cand);
                tv[q] = mx; ti[q] = bi;
                if (bi == r) v0 = -3.0e38f; if (bi == 16 + r) v1 = -3.0e38f;
            }
            const float e1 = __expf(tv[1] - tv[0]), e2 = __expf(tv[2] - tv[0]), e3 = __expf(tv[3] - tv[0]); const float inv = rcp_(1.f + e1 + e2 + e3);
            const size_t m = m0 + 4 * g + j;
            if (r == 0) { *(int4*)(TIDX + m * 4) = make_int4(ti[0], ti[1], ti[2], ti[3]); *(v4f*)(TGATE + m * 4) = (v4f){inv, e1 * inv, e2 * inv, e3 * inv}; }
            if (r < 4) lds_add(&hist[r == 0 ? ti[0] : r == 1 ? ti[1] : r == 2 ? ti[2] : ti[3]], 1);
        }
    };
    const int NT16 = T / 16, nfull = (NT16 / NGW) * NGW;
#pragma unroll 1
    for (int tile = gw; tile < nfull; tile += NGW) {
        const size_t m0 = (size_t)tile * 16;
#pragma unroll 1
        for (int t = 0; t < 16; t += 4) lnrows(m0 + t, std::integral_constant<int, 4>{});
        asm volatile("s_waitcnt vmcnt(0)" ::: "memory");
        route(m0);
    }
#pragma unroll 1
    for (int tile = nfull + vcu; tile < NT16; tile += G) {
        const size_t m0 = (size_t)tile * 16;
        ln2(m0 + 2 * wave);
        asm volatile("s_waitcnt vmcnt(0)" ::: "memory");
        __syncthreads();
        if (wave == 0) route(m0);
    }
    __syncthreads();
    if (tid < 32) atomicAdd(&ecnt[tid], (unsigned)hist[tid]);
}
__device__ __forceinline__ int build_tiles(const Ctx A, LAS unsigned char* lds, int l) {
    const int tid = opaque_tid();
    const unsigned* ecnt = (const unsigned*)(A.ws + WS_CTL) + CW_ECNT + 64 * l;
    LAS int* offs = (LAS int*)(lds + MISC_OFF + MI_OFFS); LAS int* tile_e = (LAS int*)(lds + MISC_OFF + MI_TILE); LAS int* nt = (LAS int*)(lds + MISC_OFF + MI_NT);
    __syncthreads();
    if (tid < 32) { int off = 0, mycnt = 0;
        for (int e = 0; e < 32; ++e) { const int c = (int)__hip_atomic_load(ecnt + e, __ATOMIC_RELAXED, __HIP_MEMORY_SCOPE_AGENT); if (e < tid) off += (c + 255) & ~255; if (e == tid) mycnt = c; }
        offs[tid] = off;
        const int t0 = off >> 8, t1 = (off + ((mycnt + 255) & ~255)) >> 8;
        for (int t = t0; t < t1; ++t) tile_e[t] = tid;
        if (tid == 31) nt[0] = t1; }
    __syncthreads();
    return nt[0];
}
__device__ PHASE_FN void moe_sort_phase(const Ctx A, LAS unsigned char* lds, int l) {
    const int tid = opaque_tid();
    const int* TIDX = (const int*)(A.ws + WS_TIDX); const float* TGATE = (const float*)(A.ws + WS_TGATE);
    int* SPOS = (int*)(A.ws + WS_SPOS); float* GSORT = (float*)(A.ws + WS_GSORT); int* RMAP = (int*)(A.ws + WS_RMAP);
    unsigned* ecur = (unsigned*)(A.ws + WS_CTL) + CW_ECUR + 64 * l; const unsigned* ecnt = (const unsigned*)(A.ws + WS_CTL) + CW_ECNT + 64 * l;
    LAS int* hist = (LAS int*)(lds + MISC_OFF + MI_HIST); LAS int* lcur = (LAS int*)(lds + MISC_OFF + MI_LCUR); LAS int* lbase = (LAS int*)(lds + MISC_OFF + MI_LBASE);
    LAS int* offs = (LAS int*)(lds + MISC_OFF + MI_OFFS);
    (void)build_tiles(A, lds, l);
    const int TPB = (T + (int)gridDim.x - 1) / (int)gridDim.x;
    const int mbeg = blockIdx.x * TPB, mend = (mbeg + TPB < T) ? mbeg + TPB : T;
    const int nslot = (mend > mbeg) ? (mend - mbeg) * 4 : 0;
    if (tid < 32) { hist[tid] = 0; lcur[tid] = 0; }
    __syncthreads();
    for (int s = tid; s < nslot; s += NTHR) lds_add(&hist[TIDX[(size_t)mbeg * 4 + s]], 1);
    __syncthreads();
    if (tid < 32) lbase[tid] = offs[tid] + (int)atomicAdd(&ecur[tid], (unsigned)hist[tid]);
    __syncthreads();
    for (int s = tid; s < nslot; s += NTHR) { const size_t gs = (size_t)mbeg * 4 + s; const int e = TIDX[gs];
        const int pos = lbase[e] + lds_add(&lcur[e], 1);
        SPOS[gs] = pos; GSORT[pos] = TGATE[gs]; RMAP[pos] = mbeg + (s >> 2); }
    if (blockIdx.x < 32) { const int e = blockIdx.x; const int c = (int)__hip_atomic_load(ecnt + e, __ATOMIC_RELAXED, __HIP_MEMORY_SCOPE_AGENT);
        const int p0 = offs[e] + c, p1 = offs[e] + ((c + 255) & ~255);
        for (int p = p0 + tid; p < p1; p += NTHR) RMAP[p] = 0; }
}
__device__ PHASE_FN void combine_ln_phase(const Ctx A, int l, int vcu, int G) {
    const int tid = opaque_tid(), lane = tid & 63, wave = tid >> 6;
    const int gw = vcu * NWAVES + wave, NGW = G * NWAVES;
    bf16* HB = (bf16*)(A.ws + WS_HB); const bf16* Y = (const bf16*)(A.ws + WS_YBUF); const int* SPOS = (const int*)(A.ws + WS_SPOS);
    const float* g = gin(A, 34) + l * D; const float* bb = gin(A, 35) + l * D;
#pragma unroll 1
    for (int m0 = 2 * gw; m0 < T; m0 += 2 * NGW) {
        v4f v[2][4];
#pragma unroll
        for (int t = 0; t < 2; ++t) { const int m = m0 + t;
            const int4 sp = *(const int4*)(SPOS + (size_t)m * 4);
#pragma unroll
            for (int j = 0; j < 4; ++j) { const size_t co = 256 * j + 4 * lane;
                const v4f y = ld_bf4(Y + (size_t)sp.x * D + co) + ld_bf4(Y + (size_t)sp.y * D + co) + ld_bf4(Y + (size_t)sp.z * D + co) + ld_bf4(Y + (size_t)sp.w * D + co);
                v[t][j] = ld_bf4(HB + (size_t)m * D + co) * ALPHA + y; } }
#pragma unroll
        for (int t = 0; t < 2; ++t) { const int m = m0 + t;
            ln_row(v[t], g, bb, lane);
            if (l == 0) {
#pragma unroll
                for (int j = 0; j < 4; ++j) st_bf4(HB + (size_t)m * D + 256 * j + 4 * lane, v[t][j]);
            } else {
                const int b = m / L, i = m - b * L;
                if (i >= NMETA) { float* o = (float*)(GAS float*)A.out + ((size_t)b * SEQ + (i - NMETA)) * D;
#pragma unroll
                    for (int j = 0; j < 4; ++j) *(v4f*)(o + 256 * j + 4 * lane) = v[t][j]; }
            }
        }
    }
}
constexpr int N_PHASES = 23;
#ifndef PH_ONLY
#define PH_ONLY -1
#endif
#define PHSEL(j) (PH_ONLY < 0 || PH_ONLY == (j))
#define IN(k) (lo <= (k) && (k) < hi)
#if MK_ONE_LAUNCH
#define GRID_BAR() xcd_barrier(bar)
#else
#define GRID_BAR() do { } while (0)
#endif
#define SEAM(k) do { if (IN(k) && IN((k) + 1)) GRID_BAR(); } while (0)
#define CTX() Ctx{args.in, args.out, launder(args.ws)}
#ifndef PROBE_PHASE
#define PROBE_PHASE -1
#endif
#ifndef PROBE_MULT
#define PROBE_MULT 4
#endif
#define PB_BEGIN(j) do { if (PROBE_PHASE == (j)) { pstamp = __builtin_amdgcn_s_memrealtime(); } } while (0)
#define PB_END(j) do { if (PROBE_PHASE == (j)) { pacc += __builtin_amdgcn_s_memrealtime() - pstamp; } } while (0)
__device__ __forceinline__ void layer_phases(const int l, const Args& args, LAS unsigned char* lds, const int G, const int bx, const int vcu, const int lo, const int hi, const XcdBarrier& bar, unsigned long long& pacc) {
    unsigned long long pstamp = 0ull; (void)pstamp;

        const int pb = 1 + 11 * l;
        PB_BEGIN(0);
        if (PHSEL(0) && IN(pb + 0)) { GAS unsigned char* wsl = launder(args.ws);
            pg8::Gemm g{(const pg8::bf16_t*)(wsl + WS_HB), (const pg8::bf16_t*)(wsl + WS_WIN) + (size_t)l * NINP * 1024, TP, NINP, 1024};
            pg8::StaticOrder S; S.init(TP, NINP, G, bx);
            pg8::EpiStoreBf16 E{(pg8::bf16_t*)(wsl + WS_PROJ), NINP};
            pg8::gemm_phase<pg8::EpiStoreBf16, pg8::StaticOrder, true, true>(lds, g, S, E);
            SEAM(pb + 0); PB_END(0);
        }
        PB_BEGIN(1);
        if (PHSEL(1) && IN(pb + 1)) { prep_phase(CTX(), lds, l, vcu, G); SEAM(pb + 1); PB_END(1); }
        PB_BEGIN(2);
        if (PHSEL(2) && IN(pb + 2)) { chunk_prep_phase(CTX(), vcu, G); lru_agg_phase(CTX(), vcu, G); SEAM(pb + 2); PB_END(2); }
        PB_BEGIN(3);
        if (PHSEL(3) && IN(pb + 3)) {
#ifndef PH2_SEL
#define PH2_SEL 15
#endif
            PB_BEGIN(20); PB_BEGIN(21); PB_BEGIN(22); PB_BEGIN(23);
#if SCAN_SEQ
            if ((PH2_SEL & 1) && bx < 64) rwkv_scan(CTX(), lds, bx); else if ((PH2_SEL & 2) && bx >= 64 && bx < 128) hgrn_scan(CTX(), lds, bx - 64); else if ((PH2_SEL & 4) && bx >= 128 && bx < 132) lru_carry_phase(CTX(), 128);
#else
            if ((PH2_SEL & 1) && bx < 16) chunk_scan<true>(CTX(), lds, bx); else if ((PH2_SEL & 2) && bx >= 16 && bx < 32) chunk_scan<false>(CTX(), lds, bx - 16); else if ((PH2_SEL & 4) && bx >= 32 && bx < 36) lru_carry_phase(CTX(), 32);
#endif
            __syncthreads();
            PB_END(20); PB_END(21); PB_END(22);
#if DSA_NAIVE
            if (PH2_SEL & 8) dsa_phase(CTX(), lds, l);
#else
            if (PH2_SEL & 8) dsa_select_phase(CTX(), lds, l);
#endif
            __syncthreads();
            PB_END(23);
            SEAM(pb + 3); PB_END(3);
        }
        PB_BEGIN(4);
        if (PHSEL(4) && IN(pb + 4)) {
            PB_BEGIN(24);
            lru_out_phase(CTX(), vcu, G);
            mixers_finish(CTX(), l, vcu, G);
            __syncthreads(); PB_END(24);
#if !DSA_NAIVE
            dsa_attn_phase(CTX(), lds, l);
#endif
            SEAM(pb + 4); PB_END(4);
        }
        PB_BEGIN(5);
        if (PHSEL(5) && IN(pb + 5)) { GAS unsigned char* wsl = launder(args.ws);
            pg8::Gemm g{(const pg8::bf16_t*)(wsl + WS_MIX), (const pg8::bf16_t*)(wsl + WS_WOUT) + (size_t)l * 1024 * 1024, TP, 1024, 1024};
            pg8::StaticOrder S; S.init(TP, 1024, G, bx);
            pg8::EpiResidBf E{(pg8::bf16_t*)(wsl + WS_HB), 1024, ALPHA};
            pg8::gemm_phase<pg8::EpiResidBf, pg8::StaticOrder, true, true>(lds, g, S, E);
            SEAM(pb + 5); PB_END(5);
        }
        PB_BEGIN(6);
        if (PHSEL(6) && IN(pb + 6)) { ln_router_phase(CTX(), lds, l, vcu, G); SEAM(pb + 6); PB_END(6); }
        PB_BEGIN(7);
        if (PHSEL(7) && IN(pb + 7)) { moe_sort_phase(CTX(), lds, l); SEAM(pb + 7); PB_END(7); }
        PB_BEGIN(8);
        if (PHSEL(8) && IN(pb + 8)) { GAS unsigned char* wsl = launder(args.ws);
            const int nt = build_tiles(CTX(), lds, l);
            pg8::Gemm g{(const pg8::bf16_t*)(wsl + WS_HB), (const pg8::bf16_t*)(wsl + WS_W1) + (size_t)l * 32 * 2048 * 1024, RMAX, 32 * 2048, 1024};
            pg8::MoeOrder S{nt * 8, G, vcu, 8, (const LAS int*)(lds + MISC_OFF + MI_TILE)};
            pg8::EpiSwiGLU E{(pg8::bf16_t*)(wsl + WS_ACT), (const float*)(const GAS float*)args.in[31] + (size_t)l * 32 * 2048};
            pg8::gemm_phase_gather<pg8::EpiSwiGLU, pg8::MoeOrder>(lds, g, S, E, (const int*)(wsl + WS_RMAP));
            SEAM(pb + 8); PB_END(8);
        }
        PB_BEGIN(9);
        if (PHSEL(9) && IN(pb + 9)) { GAS unsigned char* wsl = launder(args.ws);
            const int nt = build_tiles(CTX(), lds, l);
            pg8::Gemm g{(const pg8::bf16_t*)(wsl + WS_ACT), (const pg8::bf16_t*)(wsl + WS_W2) + (size_t)l * 32 * 1024 * 1024, RMAX, 32 * 1024, 1024};
            pg8::MoeOrder S{nt * 4, G, vcu, 4, (const LAS int*)(lds + MISC_OFF + MI_TILE)};
            pg8::EpiMoeOut E{(pg8::bf16_t*)(wsl + WS_YBUF), (const float*)(const GAS float*)args.in[33] + (size_t)l * 32 * 1024, (const float*)(wsl + WS_GSORT)};
            pg8::gemm_phase<pg8::EpiMoeOut, pg8::MoeOrder, true, true>(lds, g, S, E);
            SEAM(pb + 9); PB_END(9);
        }
        PB_BEGIN(10);
        if (PHSEL(10) && IN(pb + 10)) { combine_ln_phase(CTX(), l, vcu, G); SEAM(pb + 10); PB_END(10); }
}
__global__ void __launch_bounds__(NTHR, 2) trunk_fwd(Args args) {
    extern __shared__ __attribute__((aligned(16))) unsigned char lds_raw[];
    LAS unsigned char* lds = (LAS unsigned char*)lds_raw;
    const int tid = threadIdx.x;
    const int G = gridDim.x; const int bx = blockIdx.x; const int vcu = (G % 8 == 0) ? (bx % 8) * (G / 8) + bx / 8 : bx;
    unsigned* ctl = (unsigned*)(args.ws + WS_CTL);
    for (int u = tid; u < (LDS_BYTES - MISC_OFF) / 4; u += NTHR) ((LAS unsigned*)(lds + MISC_OFF))[u] = 0u;
    __syncthreads();
#if MK_ONE_LAUNCH
    XcdBarrier bar = xcd_barrier_post(ctl + CW_BAR, (volatile LAS unsigned*)(lds + MISC_OFF + MI_BAR));
#else
    XcdBarrier bar; bar.bar = ctl + CW_BAR; bar.x = 0; bar.st = nullptr;
#endif
    const int lo = args.ph_lo, hi = args.ph_hi;

    unsigned long long pacc = 0ull, pstamp = 0ull; (void)pstamp;
    PB_BEGIN(11);
    if (PHSEL(11) && IN(0)) { p0_prologue(CTX(), lds, vcu, G); SEAM(0); }
    PB_END(11);

#pragma unroll 1
    for (int l = 0; l < 2; ++l) layer_phases(l, args, lds, G, bx, vcu, lo, hi, bar, pacc);
    if (PROBE_PHASE >= 0 && bx == (PROBE_PHASE == 21 ? 16 : PROBE_PHASE == 22 ? 32 : PROBE_PHASE == 23 ? 255 : 0)) { const unsigned long long t0 = __builtin_amdgcn_s_memrealtime(); while (__builtin_amdgcn_s_memrealtime() - t0 < pacc * PROBE_MULT) __builtin_amdgcn_s_sleep(8); }
#undef IN
#undef SEAM
}

extern "C" void kernel_launch(void* const* d_in, const int* in_sizes, int n_in, void* d_out, int out_size, void* d_ws, size_t ws_size, hipStream_t stream) {
    static int grid = 0;
    if (grid == 0) {
        if (n_in != 36 || in_sizes[0] != NB * SEQ * D || out_size != NB * SEQ * D || ws_size < WS_END) {
            fprintf(stderr, "kernel_launch: unexpected problem (n_in %d, in0 %d, out %d, ws %zu, need %zu); nothing launched\n", n_in, n_in > 0 ? in_sizes[0] : -1, out_size, ws_size, (size_t)WS_END); grid = -1; return; }
        int dev = 0, cus = 0, per_cu = 0;
        if (hipGetDevice(&dev) != hipSuccess || hipDeviceGetAttribute(&cus, hipDeviceAttributeMultiprocessorCount, dev) != hipSuccess) { grid = -1; return; }
        if (hipFuncSetAttribute((const void*)trunk_fwd, hipFuncAttributeMaxDynamicSharedMemorySize, LDS_BYTES) != hipSuccess) { fprintf(stderr, "kernel_launch: hipFuncSetAttribute failed\n"); grid = -1; return; }
        if (hipOccupancyMaxActiveBlocksPerMultiprocessor(&per_cu, (const void*)trunk_fwd, NTHR, LDS_BYTES) != hipSuccess || per_cu < 1) { fprintf(stderr, "kernel_launch: occupancy query says %d\n", per_cu); (void)hipGetLastError(); }
        grid = cus;
        if (grid < 160 || grid > 512) { fprintf(stderr, "kernel_launch: unsupported CU count %d\n", cus); grid = -1; return; }
    }
    if (grid < 0) return;
    if (hipMemsetAsync((char*)d_ws + WS_CTL, 0, CTL_ZERO_BYTES, stream) != hipSuccess) return;
    Args a; memset(&a, 0, sizeof(a));
    for (int i = 0; i < 36; ++i) a.in[i] = (const float*)d_in[i];
    a.out = (float*)d_out; a.ws = (unsigned char*)d_ws;
#if MK_ONE_LAUNCH
    a.ph_lo = 0; a.ph_hi = N_PHASES;
    hipLaunchKernelGGL(trunk_fwd, dim3(grid), dim3(NTHR), LDS_BYTES, stream, a);
#else
    for (int p = 0; p < N_PHASES; ++p) { a.ph_lo = p; a.ph_hi = p + 1; hipLaunchKernelGGL(trunk_fwd, dim3(grid), dim3(NTHR), LDS_BYTES, stream, a); }
#endif
}
```

```cpp
#include <hip/hip_runtime.h>
#include <cstdio>
#include <cstdint>
#include <cstring>

#ifndef MK_ONE_LAUNCH
#define MK_ONE_LAUNCH 1
#endif

#ifndef SCAN_SEQ
#define SCAN_SEQ 0
#endif
#ifndef SCAN_MIX
#define SCAN_MIX 0
#endif
#ifndef DSA_NAIVE
#define DSA_NAIVE 0
#endif
#ifndef PHASE_FN
#define PHASE_FN __forceinline__
#endif
#define GAS __attribute__((address_space(1)))
#define LAS __attribute__((address_space(3)))
typedef unsigned short bf16;
typedef unsigned v4u __attribute__((ext_vector_type(4)));
typedef unsigned v2u __attribute__((ext_vector_type(2)));
typedef float v4f __attribute__((ext_vector_type(4)));
typedef float v2f __attribute__((ext_vector_type(2)));

constexpr int NB = 8, SEQ = 8192, NMETA = 16, L = SEQ + NMETA  , T = NB * L  , TP = 65792  , D = 1024;
constexpr int NINP = 3584;
constexpr int NE = 32, TOPK = 4;
constexpr int RMAX = 1058 * 256;
constexpr int C_RW = 0, C_RW_R = 0, C_RW_WD = 256, C_RW_K = 320, C_RW_V = 576, C_RW_AD = 832, C_RW_GD = 896;
constexpr int C_DS_Q = 960, C_DS_K = 1216, C_DS_V = 1472, C_DS_QI = 1728, C_DS_KI = 1984, C_DS_WI = 2016;
constexpr int C_LR_X = 2024, C_LR_G = 2280;
constexpr int C_HG_Q = 2536, C_HG_F = 2792, C_HG_I = 3048, C_HG_G = 3304;
constexpr float ALPHA = 1.41421356237f;
constexpr float LN_EPS = 1e-5f;

constexpr size_t MiB = 1u << 20;
constexpr size_t WS_CTL = 0, CTL_ZERO_BYTES = 1 * MiB;
constexpr size_t WS_FRAG = 1 * MiB, FRAG_LAYER = (96 + 64) * 1024;
constexpr size_t WS_WIN = 2 * MiB;
constexpr size_t WS_WOUT = 16 * MiB;
constexpr size_t WS_W1 = 20 * MiB;
constexpr size_t WS_W2 = 276 * MiB;
constexpr size_t WS_H = 404 * MiB;
constexpr size_t WS_MIX = WS_H;
constexpr size_t WS_HB = 661 * MiB;
constexpr size_t WS_BIG = 790 * MiB;
constexpr size_t WS_PROJ = WS_BIG;
constexpr size_t SZ_HM32 = (size_t)32 * L * 64 * 4;
constexpr size_t SZ_HM16 = SZ_HM32 / 2;
constexpr size_t SZ_TM16 = (size_t)T * 256 * 2;
constexpr size_t WS_RW_W = 1240 * MiB;
constexpr size_t WS_RW_A = WS_RW_W + SZ_HM32, WS_RW_B = WS_RW_A + SZ_HM16, WS_RW_K = WS_RW_B + SZ_HM16, WS_RW_WR = WS_RW_K + SZ_HM16, WS_RW_V = WS_RW_WR + SZ_HM16;
constexpr size_t WS_RW_G = WS_RW_V + SZ_HM16;
constexpr size_t WS_RW_SC = WS_RW_G + SZ_TM16;
constexpr size_t WS_DS_Q = WS_RW_SC + (size_t)32 * L * 16;
constexpr size_t WS_DS_K = WS_DS_Q + SZ_TM16, WS_DS_V = WS_DS_K + SZ_TM16, WS_DS_QI = WS_DS_V + SZ_TM16;
constexpr size_t WS_DS_KI = WS_DS_QI + SZ_TM16;
constexpr size_t WS_DS_WI = WS_DS_KI + (size_t)T * 64;
constexpr size_t WS_LR_A = WS_DS_WI + (size_t)T * 32;
constexpr size_t WS_LR_U = WS_LR_A + (size_t)T * 1024, WS_LR_G = WS_LR_U + SZ_TM16;
constexpr size_t WS_HG_F = WS_LR_G + SZ_TM16;
constexpr size_t WS_HG_K = WS_HG_F + SZ_HM32, WS_HG_Q = WS_HG_K + SZ_HM16, WS_HG_V = WS_HG_Q + SZ_HM16, WS_HG_G = WS_HG_V + SZ_HM16;
constexpr size_t WS_MIX_END = WS_HG_G + SZ_TM16;
constexpr size_t SZ_SORT = (size_t)RMAX * 1024 * 2;
constexpr size_t WS_SORTA = WS_BIG, WS_YBUF = WS_BIG, WS_ACT = WS_BIG + SZ_SORT;
constexpr size_t WS_TIDX = WS_ACT + SZ_SORT;
constexpr size_t WS_TGATE = WS_TIDX + (size_t)T * 16;
constexpr size_t WS_SPOS = WS_TGATE + (size_t)T * 16;
constexpr size_t WS_GSORT = WS_SPOS + (size_t)T * 16;
constexpr size_t WS_RMAP = WS_GSORT + (size_t)RMAX * 4;
constexpr size_t WS_MOE_END = WS_RMAP + (size_t)RMAX * 4;
constexpr size_t WS_END = 2040 * MiB;
static_assert(WS_MIX_END <= WS_END && WS_MOE_END <= WS_END, "workspace map");
static_assert(WS_PROJ + (size_t)TP * NINP * 2 <= WS_RW_W, "proj vs prep");
static_assert(WS_HB + (size_t)TP * 1024 * 2 <= WS_BIG && WS_H + (size_t)TP * 4096 <= WS_HB, "h/hb");

constexpr int CW_TMO = 0, CW_CODE = 1;
constexpr int CW_BAR = 4096;
constexpr int CW_DSAQ = 8192;
constexpr int CW_ECNT = 8448;
constexpr int CW_ECUR = 8704;

constexpr int LDS_BYTES = 163840;
constexpr int MISC_OFF = 155648;
constexpr int MI_BAR = 0, MI_HIST = 64, MI_LCUR = 192, MI_LBASE = 320, MI_NT = 448, MI_OFFS = 512, MI_TILE = 1024;
constexpr int NWAVES = 8, NTHR = 512;

__device__ __forceinline__ float bf2f(unsigned short x) { return __uint_as_float((unsigned)x << 16); }
__device__ __forceinline__ float bflo(unsigned x) { return __uint_as_float(x << 16); }
__device__ __forceinline__ float bfhi(unsigned x) { return __uint_as_float(x & 0xffff0000u); }
typedef float f32x2_t __attribute__((ext_vector_type(2))); typedef __bf16 bf16x2_t __attribute__((ext_vector_type(2)));
__device__ __forceinline__ unsigned pk2(float lo, float hi) { const f32x2_t v = {lo, hi}; const bf16x2_t b = __builtin_convertvector(v, bf16x2_t); return __builtin_bit_cast(unsigned, b); }
__device__ __forceinline__ bf16 f2bf(float f) { return (bf16)(pk2(f, 0.f) & 0xffffu); }
__device__ __forceinline__ v4f ld_bf4(const bf16* p) { const v2u x = *(const v2u*)p; return (v4f){bflo(x.x), bfhi(x.x), bflo(x.y), bfhi(x.y)}; }
__device__ __forceinline__ void st_bf4(bf16* p, v4f v) { v2u o; o.x = pk2(v.x, v.y); o.y = pk2(v.z, v.w); *(v2u*)p = o; }
__device__ __forceinline__ float wave_max(float v) {
#pragma unroll
    for (int o = 1; o < 64; o <<= 1) v = fmaxf(v, __shfl_xor(v, o));
    return v;
}
template <int CTRL> __device__ __forceinline__ float dpp_f(float x) { return __int_as_float(__builtin_amdgcn_update_dpp(0, __float_as_int(x), CTRL, 0xF, 0xF, true)); }
__device__ __forceinline__ float sum8(float x) { x += dpp_f<0xB1>(x); x += dpp_f<0x4E>(x); x += dpp_f<0x141>(x); return x; }
__device__ __forceinline__ float sum16(float x) { x = sum8(x); x += dpp_f<0x140>(x); return x; }
__device__ __forceinline__ float wave_sum(float v) {
    v = sum16(v);
    v += __shfl_xor(v, 16); v += __shfl_xor(v, 32);
    return v;
}
__device__ __forceinline__ float rcp_(float x) { return __builtin_amdgcn_rcpf(x); }
__device__ __forceinline__ float rsq_(float x) { return __builtin_amdgcn_rsqf(x); }
__device__ __forceinline__ float sigmoidf_(float x) { return rcp_(1.f + __expf(-x)); }
__device__ __forceinline__ float softplusf_(float x) { return x > 20.f ? x : log1pf(__expf(x)); }
__device__ __forceinline__ float gelu_tanh(float x) { const float u = 0.7978845608028654f * (x + 0.044715f * x * x * x); return 0.5f * x * (1.f + tanhf(u)); }
__device__ __forceinline__ int lds_add(LAS int* p, int v) { return __hip_atomic_fetch_add(p, v, __ATOMIC_RELAXED, __HIP_MEMORY_SCOPE_WORKGROUP); }
#define LDS_WAIT() asm volatile("s_waitcnt lgkmcnt(0)" ::: "memory")
#define VM_WAIT() asm volatile("s_waitcnt vmcnt(0)" ::: "memory")

__device__ __forceinline__ GAS unsigned char* launder(unsigned char* p) { GAS unsigned char* g = (GAS unsigned char*)p; asm volatile("" : "+s"(g)); return g; }
__device__ __forceinline__ int opaque_tid() { int t = (int)threadIdx.x; asm volatile("" : "+v"(t)); return t; }
__device__ __forceinline__ int opaque_s(int x) { return __builtin_amdgcn_readfirstlane(x); }
struct Args { const float* in[36]; float* out; unsigned char* ws; int ph_lo, ph_hi; };
struct Ctx { const float* const* in; float* out; GAS unsigned char* ws; };
__device__ __forceinline__ const float* gin(const Ctx& A, int k) { return (const float*)(const GAS float*)A.in[k]; }
namespace pg8 {
#define PG8_LAS __attribute__((address_space(3)))
typedef unsigned short bf16_t;
typedef short bf16x8 __attribute__((ext_vector_type(8)));
typedef float f32x4 __attribute__((ext_vector_type(4)));
typedef unsigned u32x4 __attribute__((ext_vector_type(4)));
constexpr int BM = 256, BK = 64, HALF = 128, HTB = HALF * BK * 2  , STAGE_BYTES = 8 * HTB, NXCD = 8, WGM = 8;

__host__ __device__ __forceinline__ int lds_byte(int r, int c) { const int st = (r >> 4) * 2 + (c >> 5), rr = r & 15, cc = c & 31, ob = rr * 64 + cc * 2; return st * 1024 + (ob ^ (((ob >> 9) & 1) << 5)); }
__host__ __device__ __forceinline__ void stage_rc(int b, int& R, int& C) { const int st = b / 1024, sb = b % 1024, swz = sb ^ (((sb >> 9) & 1) << 5); R = (st >> 1) * 16 + swz / 64; C = (st & 1) * 32 + (swz % 64) / 2; }
__host__ __device__ __forceinline__ int perm32(int rho) { const int n = rho >> 4, i = rho & 15; return 8 * (i >> 2) + 4 * n + (i & 3); }

struct Unit { int pm, pn; };
struct Gemm { const bf16_t* A; const bf16_t* Bt; int M, N, K; };

struct StaticOrder {
    int nM, nN, nwg, G, c;
    __host__ __device__ void init(int M, int N, int G_, int c_) { nM = M / BM; nN = N / BM; nwg = nM * nN; G = G_; c = c_; }
    __host__ __device__ bool next(int i, Unit& u) const {
        const long L = (long)i * G + c; if (L >= nwg) return false;
        int wgid = (int)L; { const int q = nwg / NXCD, r = nwg % NXCD, xcd = wgid % NXCD, off = wgid / NXCD; wgid = (xcd < r ? xcd * (q + 1) : r * (q + 1) + (xcd - r) * q) + off; }
        const int nig = WGM * nN, gid = wgid / nig, fm = gid * WGM, gsz = (nM - fm) < WGM ? (nM - fm) : WGM;
        u.pm = fm + ((wgid % nig) % gsz); u.pn = (wgid % nig) / gsz; return true;
    }
    __device__ __forceinline__ void a_ready(const Unit&) const {}
    __device__ __forceinline__ void done(const Unit&) const {}
};

__device__ __forceinline__ unsigned cvt_pk_bf16(float lo, float hi) { unsigned r; asm volatile("v_cvt_pk_bf16_f32 %0, %1, %2" : "=v"(r) : "v"(lo), "v"(hi)); return r; }
typedef float f32x2 __attribute__((ext_vector_type(2)));
typedef unsigned u32x2v __attribute__((ext_vector_type(2)));
typedef float pf32x2_t __attribute__((ext_vector_type(2))); typedef __bf16 pbf16x2_t __attribute__((ext_vector_type(2)));
__device__ __forceinline__ unsigned cvt_pk_bf16c(float lo, float hi) { const pf32x2_t v = {lo, hi}; const pbf16x2_t q = __builtin_convertvector(v, pbf16x2_t); return __builtin_bit_cast(unsigned, q); }
struct EpiStoreBf16 {
    static constexpr bool PERM = true, AFTER_DRAIN = false;
    bf16_t* O; int ldc;
    __device__ __forceinline__ void operator()(const f32x4 (&acc)[2][2][4][2], const Unit& u, int wr, int wc, int fr, int fq) const {
        const int row0 = u.pm * BM + wr * 64 + fr, col0 = u.pn * BM + wc * 32 + 8 * fq;
#pragma unroll
        for (int ai = 0; ai < 2; ++ai)
#pragma unroll
            for (int m = 0; m < 4; ++m) { bf16_t* rowp = O + (size_t)(row0 + ai * HALF + m * 16) * ldc + col0;
#pragma unroll
                for (int bj = 0; bj < 2; ++bj) { const f32x4 v0 = acc[ai][bj][m][0], v1 = acc[ai][bj][m][1];
                    u32x4 w; w.x = cvt_pk_bf16c(v0[0], v0[1]); w.y = cvt_pk_bf16c(v0[2], v0[3]); w.z = cvt_pk_bf16c(v1[0], v1[1]); w.w = cvt_pk_bf16c(v1[2], v1[3]);
                    *(u32x4*)(rowp + bj * HALF) = w; } }
    }
};
struct EpiResid {
    static constexpr bool PERM = false, AFTER_DRAIN = false;
    float* Hres; int ldc; float alpha;
    __device__ __forceinline__ void operator()(const f32x4 (&acc)[2][2][4][2], const Unit& u, int wr, int wc, int fr, int fq) const {
        const int row0 = u.pm * BM + wr * 64 + fr, col0 = u.pn * BM + wc * 32 + 4 * fq;
#pragma unroll
        for (int ai = 0; ai < 2; ++ai)
#pragma unroll
            for (int m = 0; m < 4; ++m) { float* rowp = Hres + (size_t)(row0 + ai * HALF + m * 16) * ldc + col0;
#pragma unroll
                for (int bj = 0; bj < 2; ++bj)
#pragma unroll
                    for (int n = 0; n < 2; ++n) { f32x4* p = (f32x4*)(rowp + bj * HALF + n * 16); const f32x4 old = *p; *p = old * alpha + acc[ai][bj][m][n]; } }
    }
};
struct EpiResidBf {
    static constexpr bool PERM = true, AFTER_DRAIN = false;
    bf16_t* Hb; int ldc; float alpha;
    __device__ __forceinline__ void operator()(const f32x4 (&acc)[2][2][4][2], const Unit& u, int wr, int wc, int fr, int fq) const {
        const int row0 = u.pm * BM + wr * 64 + fr, col0 = u.pn * BM + wc * 32 + 8 * fq;
#pragma unroll
        for (int ai = 0; ai < 2; ++ai)
#pragma unroll
            for (int m = 0; m < 4; ++m) { bf16_t* rowp = Hb + (size_t)(row0 + ai * HALF + m * 16) * ldc + col0;
#pragma unroll
                for (int bj = 0; bj < 2; ++bj) { const f32x4 v0 = acc[ai][bj][m][0], v1 = acc[ai][bj][m][1]; const u32x4 o = *(const u32x4*)(rowp + bj * HALF);
#define RB_LO(x_) __builtin_bit_cast(float, (x_) << 16)
#define RB_HI(x_) __builtin_bit_cast(float, (x_) & 0xffff0000u)
                    u32x4 w; w.x = cvt_pk_bf16c(RB_LO(o.x) * alpha + v0[0], RB_HI(o.x) * alpha + v0[1]); w.y = cvt_pk_bf16c(RB_LO(o.y) * alpha + v0[2], RB_HI(o.y) * alpha + v0[3]);
                    w.z = cvt_pk_bf16c(RB_LO(o.z) * alpha + v1[0], RB_HI(o.z) * alpha + v1[1]); w.w = cvt_pk_bf16c(RB_LO(o.w) * alpha + v1[2], RB_HI(o.w) * alpha + v1[3]);
#undef RB_LO
#undef RB_HI
                    *(u32x4*)(rowp + bj * HALF) = w; } }
    }
};
struct EpiSwiGLU {
    static constexpr bool PERM = true, AFTER_DRAIN = false;
    bf16_t* ACT; const float* b1;
    __device__ __forceinline__ void operator()(const f32x4 (&acc)[2][2][4][2], const Unit& u, int wr, int wc, int fr, int fq) const {
        const int e = u.pn >> 3, pnl = u.pn & 7;
        const int row0 = u.pm * BM + wr * 64 + fr, c8 = pnl * 128 + wc * 32 + 8 * fq;
        const float* bg = b1 + (size_t)e * 2048 + c8; const float* bl = bg + 1024;
        const f32x4 bg0 = *(const f32x4*)bg, bg1 = *(const f32x4*)(bg + 4), bl0 = *(const f32x4*)bl, bl1 = *(const f32x4*)(bl + 4);
#pragma unroll
        for (int ai = 0; ai < 2; ++ai)
#pragma unroll
            for (int m = 0; m < 4; ++m) {
                float o[8];
#pragma unroll
                for (int n = 0; n < 2; ++n) { const f32x4 g4 = acc[ai][0][m][n] + (n ? bg1 : bg0), l4 = acc[ai][1][m][n] + (n ? bl1 : bl0);
#pragma unroll
                    for (int j = 0; j < 4; ++j) { const float glu = fminf(g4[j], 7.f), lin = fminf(fmaxf(l4[j], -7.f), 7.f);
                        o[n * 4 + j] = glu * __builtin_amdgcn_rcpf(1.f + __builtin_amdgcn_exp2f(glu * (-1.702f * 1.4426950408889634f))) * (lin + 1.f); } }
                u32x4 w; w.x = cvt_pk_bf16c(o[0], o[1]); w.y = cvt_pk_bf16c(o[2], o[3]); w.z = cvt_pk_bf16c(o[4], o[5]); w.w = cvt_pk_bf16c(o[6], o[7]);
                *(u32x4*)(ACT + (size_t)(row0 + ai * HALF + m * 16) * 1024 + c8) = w; }
    }
};
struct EpiMoeOut {
    static constexpr bool PERM = true, AFTER_DRAIN = false;
    bf16_t* Y; const float* b2; const float* gate;
    __device__ __forceinline__ void operator()(const f32x4 (&acc)[2][2][4][2], const Unit& u, int wr, int wc, int fr, int fq) const {
        const int e = u.pn >> 2, pnl = u.pn & 3;
        const int row0 = u.pm * BM + wr * 64 + fr, c8 = pnl * 256 + wc * 32 + 8 * fq;
        const float* bb = b2 + (size_t)e * 1024 + c8;
        f32x4 bv[2][2];
#pragma unroll
        for (int bj = 0; bj < 2; ++bj) { bv[bj][0] = *(const f32x4*)(bb + bj * HALF); bv[bj][1] = *(const f32x4*)(bb + bj * HALF + 4); }
#pragma unroll
        for (int ai = 0; ai < 2; ++ai)
#pragma unroll
            for (int m = 0; m < 4; ++m) { const int row = row0 + ai * HALF + m * 16; const float gt = gate[row];
#pragma unroll
                for (int bj = 0; bj < 2; ++bj) { const f32x4 v0 = (acc[ai][bj][m][0] + bv[bj][0]) * gt, v1 = (acc[ai][bj][m][1] + bv[bj][1]) * gt;
                    u32x4 w; w.x = cvt_pk_bf16c(v0[0], v0[1]); w.y = cvt_pk_bf16c(v0[2], v0[3]); w.z = cvt_pk_bf16c(v1[0], v1[1]); w.w = cvt_pk_bf16c(v1[2], v1[3]);
                    *(u32x4*)(Y + (size_t)row * 1024 + c8 + bj * HALF) = w; } }
    }
};
struct MoeOrder {
    int n_units, G, c, npn; const PG8_LAS int* tile_e;
    __device__ __forceinline__ bool next(int i, Unit& u) const {
        const int Lx = i * G + c; if (Lx >= n_units) return false;
        const int tile = Lx / npn, pnl = Lx - tile * npn;
        u.pm = tile; u.pn = tile_e[tile] * npn + pnl; return true;
    }
    __device__ __forceinline__ void a_ready(const Unit&) const {}
    __device__ __forceinline__ void done(const Unit&) const {}
};

template <class Epi, class Sched, bool ALIGN_EPI = false, bool SP2 = false>
__device__ __forceinline__ void gemm_phase(PG8_LAS unsigned char* lds, const Gemm g, const Sched& S, const Epi& E) {
    const int tid = opaque_tid(), wid = __builtin_amdgcn_readfirstlane(tid >> 6), lane = tid & 63, wr = wid >> 2, wc = wid & 3, fr = lane & 15, fq = lane >> 4;
    const int K = g.K, nt = K / BK;
    unsigned voffA[2], voffB[2];
#pragma unroll
    for (int i = 0; i < 2; ++i) { int R, C; stage_rc(tid * 16 + i * 8192, R, C); const int Rb = Epi::PERM ? ((R & ~31) + perm32(R & 31)) : R;
        voffA[i] = (unsigned)(R * K + C) * 2u; voffB[i] = (unsigned)(Rb * K + C) * 2u; }
    const size_t kstep = (size_t)(BK * 2);
    const size_t hstep = (size_t)HALF * K * 2;
    const size_t tstep = 2 * hstep;
    const unsigned ldsw = (unsigned)wid * 1024u;
    const int aoff = lds_byte(wr * 64 + fr, fq * 8), boff = lds_byte(wc * 32 + fr, fq * 8);
#define PG8_SA(b, h) (((b) * 2 + (h)) * HTB)
#define PG8_SB(b, h) ((4 + (b) * 2 + (h)) * HTB)
#define PG8_STAGE(bufoff, gbase, voff) do { _Pragma("unroll") for (int _i = 0; _i < 2; ++_i) \
        __builtin_amdgcn_global_load_lds((const unsigned*)((const char*)(gbase) + (voff)[_i]), (PG8_LAS unsigned*)(lds + (bufoff) + ldsw + _i * 8192), 16, 0, 0); } while (0)
#define PG8_LDA(dst, b, h) do { _Pragma("unroll") for (int m = 0; m < 4; ++m) _Pragma("unroll") for (int k = 0; k < 2; ++k) dst[m][k] = *(const PG8_LAS bf16x8*)(lds + PG8_SA(b, h) + aoff + m * 2048 + k * 1024); } while (0)
#define PG8_LDB(dst, b, h) do { _Pragma("unroll") for (int n = 0; n < 2; ++n) _Pragma("unroll") for (int k = 0; k < 2; ++k) dst[n][k] = *(const PG8_LAS bf16x8*)(lds + PG8_SB(b, h) + boff + n * 2048 + k * 1024); } while (0)
#define PG8_MMA(ai, bj, At, Bt) do { __builtin_amdgcn_s_setprio(1); _Pragma("unroll") for (int m = 0; m < 4; ++m) _Pragma("unroll") for (int n = 0; n < 2; ++n) _Pragma("unroll") for (int k = 0; k < 2; ++k) \
        acc[ai][bj][m][n] = __builtin_amdgcn_mfma_f32_16x16x32_bf16(Bt[n][k], At[m][k], acc[ai][bj][m][n], 0, 0, 0); __builtin_amdgcn_s_setprio(0); } while (0)
#define PG8_WAIT_V(n) asm volatile("s_waitcnt vmcnt(" #n ")" ::: "memory")
#define PG8_WAIT_L(n) asm volatile("s_waitcnt lgkmcnt(" #n ")" ::: "memory")
#define PG8_BAR __builtin_amdgcn_s_barrier()
#define PG8_SCHED __builtin_amdgcn_sched_barrier(0)
    Unit cur, nxt; int ui = 0;
    if (!S.next(0, cur)) return;
    f32x4 acc[2][2][4][2];
#pragma unroll
    for (int a = 0; a < 2; ++a)
#pragma unroll
        for (int b = 0; b < 2; ++b)
#pragma unroll
            for (int m = 0; m < 4; ++m)
#pragma unroll
                for (int n = 0; n < 2; ++n) acc[a][b][m][n] = (f32x4){0.f, 0.f, 0.f, 0.f};
    bf16x8 At[4][2], B0[2][2], B1[2][2];
    const char* cA = (const char*)g.A + (size_t)cur.pm * tstep; const char* cB = (const char*)g.Bt + (size_t)cur.pn * tstep;
    S.a_ready(cur);
    if constexpr (SP2) {
        PG8_STAGE(PG8_SB(0, 0), cB, voffB); PG8_STAGE(PG8_SB(0, 1), cB + hstep, voffB); PG8_STAGE(PG8_SA(0, 0), cA, voffA); PG8_STAGE(PG8_SA(0, 1), cA + hstep, voffA);
        if (wr == 1) PG8_BAR;
        PG8_WAIT_V(2); PG8_BAR;
        PG8_STAGE(PG8_SB(1, 0), cB + kstep, voffB); PG8_STAGE(PG8_SA(1, 0), cA + kstep, voffA); PG8_STAGE(PG8_SB(1, 1), cB + hstep + kstep, voffB);
        PG8_WAIT_V(6); PG8_BAR;
    } else {
        PG8_STAGE(PG8_SB(0, 0), cB, voffB); PG8_STAGE(PG8_SA(0, 0), cA, voffA); PG8_STAGE(PG8_SB(0, 1), cB + hstep, voffB); PG8_STAGE(PG8_SA(0, 1), cA + hstep, voffA);
        if (wr == 1) PG8_BAR;
        PG8_WAIT_V(4); PG8_BAR;
        PG8_STAGE(PG8_SB(1, 0), cB + kstep, voffB); PG8_STAGE(PG8_SA(1, 0), cA + kstep, voffA); PG8_STAGE(PG8_SB(1, 1), cB + hstep + kstep, voffB);
        PG8_WAIT_V(6); PG8_BAR;
    }
    for (;;) {
        const bool has_next = S.next(ui + 1, nxt);
        const char* nA = has_next ? (const char*)g.A + (size_t)nxt.pm * tstep : cA; const char* nB = has_next ? (const char*)g.Bt + (size_t)nxt.pn * tstep : cB;
        for (int t = 0; t < nt; t += 2) {
            const bool last = (t == nt - 2);
            const char* a1 = cA + (size_t)(t + 1) * kstep;
            const char* a2 = last ? nA : cA + (size_t)(t + 2) * kstep; const char* b2 = last ? nB : cB + (size_t)(t + 2) * kstep;
            const char* a3 = a2 + kstep; const char* b3 = b2 + kstep;
            if (last && has_next) S.a_ready(nxt);
            if constexpr (SP2) {
            PG8_LDB(B0, 0, 0); PG8_LDB(B1, 0, 1); PG8_SCHED; PG8_LDA(At, 0, 0); PG8_STAGE(PG8_SA(1, 1), a1 + hstep, voffA);
            PG8_WAIT_V(8); PG8_WAIT_L(0); PG8_BAR; PG8_MMA(0, 0, At, B0); PG8_MMA(0, 1, At, B1); PG8_BAR; PG8_SCHED;
            PG8_LDA(At, 0, 1); PG8_STAGE(PG8_SB(0, 0), b2, voffB); PG8_STAGE(PG8_SB(0, 1), b2 + hstep, voffB); PG8_STAGE(PG8_SA(0, 0), a2, voffA);
            PG8_WAIT_V(8); PG8_WAIT_L(0); PG8_BAR; PG8_MMA(1, 0, At, B0); PG8_MMA(1, 1, At, B1); PG8_BAR; PG8_SCHED;
            PG8_LDB(B0, 1, 0); PG8_LDB(B1, 1, 1); PG8_SCHED; PG8_LDA(At, 1, 0); PG8_STAGE(PG8_SA(0, 1), a2 + hstep, voffA);
            PG8_WAIT_V(8); PG8_WAIT_L(0); PG8_BAR; PG8_MMA(0, 0, At, B0); PG8_MMA(0, 1, At, B1); PG8_BAR; PG8_SCHED;
            PG8_LDA(At, 1, 1); PG8_STAGE(PG8_SB(1, 0), b3, voffB); PG8_STAGE(PG8_SB(1, 1), b3 + hstep, voffB); PG8_STAGE(PG8_SA(1, 0), a3, voffA);
            PG8_WAIT_V(8); PG8_WAIT_L(0); PG8_BAR; PG8_MMA(1, 0, At, B0); PG8_MMA(1, 1, At, B1); PG8_BAR; PG8_SCHED;
            } else {
            PG8_LDB(B0, 0, 0); PG8_SCHED; PG8_LDA(At, 0, 0); PG8_STAGE(PG8_SA(1, 1), a1 + hstep, voffA);
            PG8_WAIT_L(8); PG8_BAR; PG8_WAIT_L(0); PG8_MMA(0, 0, At, B0); PG8_BAR; PG8_SCHED;
            PG8_LDB(B1, 0, 1); PG8_STAGE(PG8_SB(0, 0), b2, voffB);
            PG8_BAR; PG8_WAIT_L(0); PG8_MMA(0, 1, At, B1); PG8_BAR;
            PG8_LDA(At, 0, 1); PG8_STAGE(PG8_SA(0, 0), a2, voffA);
            PG8_BAR; PG8_WAIT_L(0); PG8_MMA(1, 0, At, B0); PG8_BAR; PG8_SCHED;
            PG8_STAGE(PG8_SB(0, 1), b2 + hstep, voffB);
            PG8_WAIT_V(6); PG8_BAR; PG8_MMA(1, 1, At, B1); PG8_BAR;
            PG8_LDB(B0, 1, 0); PG8_SCHED; PG8_LDA(At, 1, 0); PG8_STAGE(PG8_SA(0, 1), a2 + hstep, voffA);
            PG8_WAIT_L(8); PG8_BAR; PG8_WAIT_L(0); PG8_MMA(0, 0, At, B0); PG8_BAR; PG8_SCHED;
            PG8_LDB(B1, 1, 1); PG8_STAGE(PG8_SB(1, 0), b3, voffB);
            PG8_BAR; PG8_WAIT_L(0); PG8_MMA(0, 1, At, B1); PG8_BAR;
            PG8_LDA(At, 1, 1); PG8_STAGE(PG8_SA(1, 0), a3, voffA);
            PG8_BAR; PG8_WAIT_L(0); PG8_MMA(1, 0, At, B0); PG8_BAR; PG8_SCHED;
            PG8_STAGE(PG8_SB(1, 1), b3 + hstep, voffB);
            PG8_WAIT_V(6); PG8_BAR; PG8_MMA(1, 1, At, B1); PG8_BAR;
            }
        }
        if constexpr (ALIGN_EPI) { if (wr == 0) PG8_BAR; }
        if constexpr (!Epi::AFTER_DRAIN) { E(acc, cur, wr, wc, fr, fq); S.done(cur); }
        if (!has_next) break;
#pragma unroll
        for (int a = 0; a < 2; ++a)
#pragma unroll
            for (int b = 0; b < 2; ++b)
#pragma unroll
                for (int m = 0; m < 4; ++m)
#pragma unroll
                    for (int n = 0; n < 2; ++n) acc[a][b][m][n] = (f32x4){0.f, 0.f, 0.f, 0.f};
        cur = nxt; cA = nA; cB = nB; ++ui;
        if constexpr (ALIGN_EPI) { if (wr == 1) PG8_BAR; }
    }
    PG8_WAIT_V(0);
    if constexpr (!ALIGN_EPI) { if (wr == 0) PG8_BAR; }
    PG8_BAR;
    if constexpr (Epi::AFTER_DRAIN) { E.fused(acc, cur, wr, wc, fr, fq, lds, wid, lane); S.done(cur); }
#undef PG8_SA
#undef PG8_SB
#undef PG8_STAGE
#undef PG8_LDA
#undef PG8_LDB
#undef PG8_MMA
#undef PG8_WAIT_V
#undef PG8_WAIT_L
#undef PG8_BAR
#undef PG8_SCHED
}
}
namespace pg8 {
template <class Epi, class Sched>
__device__ __forceinline__ void gemm_phase_gather(PG8_LAS unsigned char* lds, const Gemm g, const Sched& S, const Epi& E, const int* rmap) {
    constexpr bool ALIGN_EPI = true, SP2 = true;
    const int tid = opaque_tid(), wid = __builtin_amdgcn_readfirstlane(tid >> 6), lane = tid & 63, wr = wid >> 2, wc = wid & 3, fr = lane & 15, fq = lane >> 4;
    const int K = g.K, nt = K / BK;
    unsigned voffB[2];
#pragma unroll
    for (int i = 0; i < 2; ++i) { int R, C; stage_rc(tid * 16 + i * 8192, R, C); const int Rb = Epi::PERM ? ((R & ~31) + perm32(R & 31)) : R;
        voffB[i] = (unsigned)(Rb * K + C) * 2u; }
    const size_t kstep = (size_t)(BK * 2);
    const size_t hstep = (size_t)HALF * K * 2;
    const size_t tstep = 2 * hstep;
    const unsigned ldsw = (unsigned)wid * 1024u;
    const int aoff = lds_byte(wr * 64 + fr, fq * 8), boff = lds_byte(wc * 32 + fr, fq * 8);
#define PG8_SA(b, h) (((b) * 2 + (h)) * HTB)
#define PG8_SB(b, h) ((4 + (b) * 2 + (h)) * HTB)
#define PG8_STAGE(bufoff, gbase, voff) do { _Pragma("unroll") for (int _i = 0; _i < 2; ++_i) \
        __builtin_amdgcn_global_load_lds((const unsigned*)((const char*)(gbase) + (voff)[_i]), (PG8_LAS unsigned*)(lds + (bufoff) + ldsw + _i * 8192), 16, 0, 0); } while (0)
#define PG8_LDA(dst, b, h) do { _Pragma("unroll") for (int m = 0; m < 4; ++m) _Pragma("unroll") for (int k = 0; k < 2; ++k) dst[m][k] = *(const PG8_LAS bf16x8*)(lds + PG8_SA(b, h) + aoff + m * 2048 + k * 1024); } while (0)
#define PG8_LDB(dst, b, h) do { _Pragma("unroll") for (int n = 0; n < 2; ++n) _Pragma("unroll") for (int k = 0; k < 2; ++k) dst[n][k] = *(const PG8_LAS bf16x8*)(lds + PG8_SB(b, h) + boff + n * 2048 + k * 1024); } while (0)
#define PG8_MMA(ai, bj, At, Bt) do { __builtin_amdgcn_s_setprio(1); _Pragma("unroll") for (int m = 0; m < 4; ++m) _Pragma("unroll") for (int n = 0; n < 2; ++n) _Pragma("unroll") for (int k = 0; k < 2; ++k) \
        acc[ai][bj][m][n] = __builtin_amdgcn_mfma_f32_16x16x32_bf16(Bt[n][k], At[m][k], acc[ai][bj][m][n], 0, 0, 0); __builtin_amdgcn_s_setprio(0); } while (0)
#define PG8_WAIT_V(n) asm volatile("s_waitcnt vmcnt(" #n ")" ::: "memory")
#define PG8_WAIT_L(n) asm volatile("s_waitcnt lgkmcnt(" #n ")" ::: "memory")
#define PG8_BAR __builtin_amdgcn_s_barrier()
#define PG8_SCHED __builtin_amdgcn_sched_barrier(0)
    Unit cur, nxt; int ui = 0;
    if (!S.next(0, cur)) return;
    f32x4 acc[2][2][4][2];
#pragma unroll
    for (int a = 0; a < 2; ++a)
#pragma unroll
        for (int b = 0; b < 2; ++b)
#pragma unroll
            for (int m = 0; m < 4; ++m)
#pragma unroll
                for (int n = 0; n < 2; ++n) acc[a][b][m][n] = (f32x4){0.f, 0.f, 0.f, 0.f};
    bf16x8 At[4][2], B0[2][2], B1[2][2];
    const char* gA = (const char*)g.A; const char* cB = (const char*)g.Bt + (size_t)cur.pn * tstep;
    unsigned gofc[2][2];
    constexpr int RM_OFF = 8 * HTB;
#pragma unroll
    for (int i_ = 0; i_ < 2; ++i_) { int R, C; stage_rc(tid * 16 + i_ * 8192, R, C);
#pragma unroll
        for (int h_ = 0; h_ < 2; ++h_) gofc[h_][i_] = (unsigned)rmap[(size_t)cur.pm * BM + h_ * HALF + R] * (unsigned)(K * 2) + (unsigned)C * 2u; }
    S.a_ready(cur);
    if constexpr (SP2) {
        PG8_STAGE(PG8_SB(0, 0), cB, voffB); PG8_STAGE(PG8_SB(0, 1), cB + hstep, voffB); PG8_STAGE(PG8_SA(0, 0), gA, gofc[0]); PG8_STAGE(PG8_SA(0, 1), gA, gofc[1]);
        if (wr == 1) PG8_BAR;
        PG8_WAIT_V(2); PG8_BAR;
        PG8_STAGE(PG8_SB(1, 0), cB + kstep, voffB); PG8_STAGE(PG8_SA(1, 0), gA + kstep, gofc[0]); PG8_STAGE(PG8_SB(1, 1), cB + hstep + kstep, voffB);
        PG8_WAIT_V(6); PG8_BAR;
    }
    for (;;) {
        const bool has_next = S.next(ui + 1, nxt);
        const char* nB = has_next ? (const char*)g.Bt + (size_t)nxt.pn * tstep : cB;
        if (has_next) { const unsigned rmoff = (unsigned)(opaque_tid() & 255) * 4u;
            __builtin_amdgcn_global_load_lds((const unsigned*)((const char*)(rmap + (size_t)nxt.pm * BM) + rmoff), (PG8_LAS unsigned*)(lds + RM_OFF + wid * 256), 4, 0, 0); }
        for (int t = 0; t < nt; t += 2) {
            const bool last = (t == nt - 2);
            const char* a1 = gA + (size_t)(t + 1) * kstep;
            const char* a2 = last ? gA : gA + (size_t)(t + 2) * kstep; const char* b2 = last ? nB : cB + (size_t)(t + 2) * kstep;
            const char* a3 = a2 + kstep; const char* b3 = b2 + kstep;
            if (last && has_next) S.a_ready(nxt);
            if constexpr (SP2) {
            PG8_LDB(B0, 0, 0); PG8_LDB(B1, 0, 1); PG8_SCHED; PG8_LDA(At, 0, 0); PG8_STAGE(PG8_SA(1, 1), a1, gofc[1]);
            PG8_WAIT_V(8); PG8_WAIT_L(0); PG8_BAR; PG8_MMA(0, 0, At, B0); PG8_MMA(0, 1, At, B1); PG8_BAR; PG8_SCHED;
            if (last && has_next) { const int tid2 = opaque_tid();
#pragma unroll
                for (int i_ = 0; i_ < 2; ++i_) { int R, C; stage_rc(tid2 * 16 + i_ * 8192, R, C);
#pragma unroll
                    for (int h_ = 0; h_ < 2; ++h_) gofc[h_][i_] = (unsigned)*(const PG8_LAS int*)(lds + RM_OFF + (h_ * HALF + R) * 4) * (unsigned)(K * 2) + (unsigned)C * 2u; }
                PG8_SCHED; }
            PG8_LDA(At, 0, 1); PG8_STAGE(PG8_SB(0, 0), b2, voffB); PG8_STAGE(PG8_SB(0, 1), b2 + hstep, voffB); PG8_STAGE(PG8_SA(0, 0), a2, gofc[0]);
            PG8_WAIT_V(8); PG8_WAIT_L(0); PG8_BAR; PG8_MMA(1, 0, At, B0); PG8_MMA(1, 1, At, B1); PG8_BAR; PG8_SCHED;
            PG8_LDB(B0, 1, 0); PG8_LDB(B1, 1, 1); PG8_SCHED; PG8_LDA(At, 1, 0); PG8_STAGE(PG8_SA(0, 1), a2, gofc[1]);
            PG8_WAIT_V(8); PG8_WAIT_L(0); PG8_BAR; PG8_MMA(0, 0, At, B0); PG8_MMA(0, 1, At, B1); PG8_BAR; PG8_SCHED;
            PG8_LDA(At, 1, 1); PG8_STAGE(PG8_SB(1, 0), b3, voffB); PG8_STAGE(PG8_SB(1, 1), b3 + hstep, voffB); PG8_STAGE(PG8_SA(1, 0), a3, gofc[0]);
            PG8_WAIT_V(8); PG8_WAIT_L(0); PG8_BAR; PG8_MMA(1, 0, At, B0); PG8_MMA(1, 1, At, B1); PG8_BAR; PG8_SCHED;
            }
        }
        if constexpr (ALIGN_EPI) { if (wr == 0) PG8_BAR; }
        if constexpr (!Epi::AFTER_DRAIN) { const int lane2 = opaque_tid() & 63; E(acc, cur, wr, wc, lane2 & 15, lane2 >> 4); S.done(cur); }
        if (!has_next) break;
#pragma unroll
        for (int a = 0; a < 2; ++a)
#pragma unroll
            for (int b = 0; b < 2; ++b)
#pragma unroll
                for (int m = 0; m < 4; ++m)
#pragma unroll
                    for (int n = 0; n < 2; ++n) acc[a][b][m][n] = (f32x4){0.f, 0.f, 0.f, 0.f};
        cur = nxt; cB = nB; ++ui;
        if constexpr (ALIGN_EPI) { if (wr == 1) PG8_BAR; }
    }
    PG8_WAIT_V(0);
    if constexpr (!ALIGN_EPI) { if (wr == 0) PG8_BAR; }
    PG8_BAR;
    if constexpr (Epi::AFTER_DRAIN) { E.fused(acc, cur, wr, wc, fr, fq, lds, wid, lane); S.done(cur); }
#undef PG8_SA
#undef PG8_SB
#undef PG8_STAGE
#undef PG8_LDA
#undef PG8_LDB
#undef PG8_MMA
#undef PG8_WAIT_V
#undef PG8_WAIT_L
#undef PG8_BAR
#undef PG8_SCHED
}
}
#define XB_TMO      128
#define XB_XCNT(j)  (256  + 64 * (j))
#define XB_XSUB(j)  (1280 + 64 * (j))
#define XB_XGEN(j)  (2304 + 64 * (j))
#define XB_TOP      3328
#define XB_TOPGEN   3392
#define XCD_BAR_WORDS 3456
#define XB_SPIN_CAP (1u << 18)
#define LAS __attribute__((address_space(3)))

__device__ __forceinline__ unsigned xb_ld(unsigned* p)              { return __hip_atomic_load(p, __ATOMIC_RELAXED, __HIP_MEMORY_SCOPE_AGENT); }
__device__ __forceinline__ unsigned xb_add(unsigned* p, unsigned v) { return __hip_atomic_fetch_add(p, v, __ATOMIC_RELAXED, __HIP_MEMORY_SCOPE_AGENT); }
__device__ __forceinline__ unsigned xb_xcc_id() { return (unsigned)__builtin_amdgcn_s_getreg((3 << 11) | 20) & 0xFu; }
#define XB_SPIN(cond, bar) do { unsigned _sp = 0; while (cond) { __builtin_amdgcn_s_sleep(1); \
    if ((++_sp & 255u) == 0u) { if (xb_ld(&(bar)[XB_TMO])) break; if (_sp > XB_SPIN_CAP) { atomicAdd(&(bar)[XB_TMO], 1u); break; } } } } while (0)

struct XcdBarrier {
    unsigned* bar; unsigned x;
    volatile LAS unsigned* st;
};

__device__ __forceinline__ XcdBarrier xcd_barrier_post(unsigned* bar, volatile LAS unsigned* st) {
    XcdBarrier b; b.bar = bar; b.x = xb_xcc_id(); b.st = st;
    if (threadIdx.x == 0) (void)xb_add(&bar[XB_XCNT(b.x)], 1u);
    return b;
}
__device__ __forceinline__ void xcd_barrier_complete(unsigned* bar, unsigned x, unsigned& nloc, unsigned& nx) {
    const unsigned G = gridDim.x * gridDim.y * gridDim.z;
    unsigned sum, cnt, mine, sp = 0u;
    for (;;) {
        sum = 0u; cnt = 0u; mine = 0u;
#pragma unroll
        for (unsigned j = 0; j < 16; ++j) { const unsigned c = xb_ld(&bar[XB_XCNT(j)]); sum += c; cnt += (c > 0u) ? 1u : 0u; mine = (j == x) ? c : mine; }
        if (sum == G) break;
        __builtin_amdgcn_s_sleep(1);
        if ((++sp & 255u) == 0u) { if (xb_ld(&bar[XB_TMO])) break; if (sp > XB_SPIN_CAP) { atomicAdd(&bar[XB_TMO], 1u); break; } }
    }
    nloc = mine > 0u ? mine : 1u; nx = cnt > 0u ? cnt : 1u;
}

__device__ __forceinline__ void xcd_barrier(const XcdBarrier& b) {
    asm volatile("s_waitcnt vmcnt(0)" ::: "memory");
    __syncthreads();
    if (threadIdx.x == 0) {
        unsigned* bar = b.bar;
        __builtin_amdgcn_s_waitcnt(0);
        unsigned nloc = b.st[0], nx = b.st[1];
        if (nloc == 0u) { xcd_barrier_complete(bar, b.x, nloc, nx); b.st[0] = nloc; b.st[1] = nx; }
        const unsigned old = xb_add(&bar[XB_XSUB(b.x)], 1u);
        const unsigned gen = old / nloc;
        if (old + 1u == (gen + 1u) * nloc) {
            __builtin_amdgcn_fence(__ATOMIC_RELEASE, "agent");
            asm volatile("s_waitcnt vmcnt(0)" ::: "memory");
            const unsigned og = xb_add(&bar[XB_TOP], 1u);
            const unsigned tg = og / nx;
            if (og + 1u == (tg + 1u) * nx) xb_add(&bar[XB_TOPGEN], 1u);
            else XB_SPIN(xb_ld(&bar[XB_TOPGEN]) == tg, bar);
            __builtin_amdgcn_fence(__ATOMIC_ACQUIRE, "agent");
            xb_add(&bar[XB_XGEN(b.x)], 1u);
            asm volatile("s_waitcnt vmcnt(0)" ::: "memory");
        } else {
            XB_SPIN(xb_ld(&bar[XB_XGEN(b.x)]) == gen, bar);
            __builtin_amdgcn_fence(__ATOMIC_ACQUIRE, "agent");
            asm volatile("s_waitcnt vmcnt(0)" ::: "memory");
        }
    }
    __syncthreads();
}
__device__ __forceinline__ void p0_transpose_item(const float* W, int ldw, int ncols_valid, int k0, int n0, bf16* WT, size_t dst_row0, int Kdst, LAS float* scr, int lane) {
    const int nn = n0 + (lane & 31); const bool ok = nn < ncols_valid;
#pragma unroll 8
    for (int i = 0; i < 32; ++i) { const int kk = 2 * i + (lane >> 5); scr[kk * 33 + (lane & 31)] = ok ? W[(size_t)(k0 + kk) * ldw + nn] : 0.f; }
    LDS_WAIT();
    const int c = lane & 7;
#pragma unroll
    for (int j = 0; j < 4; ++j) { const int n = (lane >> 3) + 8 * j; const LAS float* s = scr + (8 * c) * 33 + n;
        v4u o; o.x = pk2(s[0 * 33], s[1 * 33]); o.y = pk2(s[2 * 33], s[3 * 33]); o.z = pk2(s[4 * 33], s[5 * 33]); o.w = pk2(s[6 * 33], s[7 * 33]);
        *(v4u*)(WT + (dst_row0 + n) * (size_t)Kdst + k0 + 8 * c) = o; }
    LDS_WAIT();
}
template <bool WIDE = false>
__device__ __forceinline__ void ln_row(v4f (&v)[4], const float* g, const float* b, int lane) {
    float s = 0.f, s2 = 0.f;
#pragma unroll
    for (int j = 0; j < 4; ++j) { s += (v[j].x + v[j].y) + (v[j].z + v[j].w); s2 += (v[j].x * v[j].x + v[j].y * v[j].y) + (v[j].z * v[j].z + v[j].w * v[j].w); }
    s = wave_sum(s); s2 = wave_sum(s2);
    const float mean = s * (1.f / D);
    const float rstd = rsq_(fmaxf(s2 * (1.f / D) - mean * mean, 0.f) + LN_EPS);
#pragma unroll
    for (int j = 0; j < 4; ++j) v[j] = v[j] - mean;
#pragma unroll
    for (int j = 0; j < 4; ++j) { const int co = WIDE ? 512 * (j >> 1) + 8 * lane + 4 * (j & 1) : 256 * j + 4 * lane; const v4f gg = *(const v4f*)(g + co), bb = *(const v4f*)(b + co); v[j] = v[j] * rstd * gg + bb; }
}
__device__ PHASE_FN void p0_prologue(const Ctx A, LAS unsigned char* lds, int vcu, int G) {
    const int tid = opaque_tid(), lane = tid & 63, wave = tid >> 6;
    LAS float* scr = (LAS float*)(lds + wave * 16384);
    const int gw = vcu * NWAVES + wave, NGW = G * NWAVES;
    bf16* Win_t = (bf16*)(A.ws + WS_WIN); bf16* Wout_t = (bf16*)(A.ws + WS_WOUT); bf16* W1_t = (bf16*)(A.ws + WS_W1); bf16* W2_t = (bf16*)(A.ws + WS_W2);
    constexpr int I_IN = 2 * 16 * (NINP / 32), I_OUT = 2 * 16 * 32, I_W1 = 64 * 16 * 64, I_W2 = 64 * 16 * 32;
    constexpr int NITEMS = I_IN + I_OUT + I_W1 + I_W2;
    for (int it = gw; it < NITEMS; it += NGW) {
        int r = it;
        if (r < I_IN) { const int l = r / (16 * 112), q = r % (16 * 112), kb = q / 112, nb = q % 112;
            p0_transpose_item(gin(A, 4) + (size_t)l * 1024 * 3560, 3560, 3560, kb * 64, nb * 32, Win_t + (size_t)l * NINP * 1024, (size_t)nb * 32, 1024, scr, lane); continue; }
        r -= I_IN;
        if (r < I_OUT) { const int l = r / 512, q = r % 512, kb = q / 32, nb = q % 32;
            p0_transpose_item(gin(A, 25) + (size_t)l * 1024 * 1024, 1024, 1024, kb * 64, nb * 32, Wout_t + (size_t)l * 1024 * 1024, (size_t)nb * 32, 1024, scr, lane); continue; }
        r -= I_OUT;
        if (r < I_W1) { const int le = r / 1024, q = r % 1024, kb = q / 64, nb = q % 64, n0 = nb * 32;
            const int np = n0 & 1023; const size_t drow = (size_t)256 * (np >> 7) + (n0 >= 1024 ? 128 : 0) + (np & 127);
            p0_transpose_item(gin(A, 30) + (size_t)le * 1024 * 2048, 2048, 2048, kb * 64, n0, W1_t + (size_t)le * 2048 * 1024, drow, 1024, scr, lane); continue; }
        r -= I_W1;
        { const int le = r / 512, q = r % 512, kb = q / 32, nb = q % 32;
            p0_transpose_item(gin(A, 32) + (size_t)le * 1024 * 1024, 1024, 1024, kb * 64, nb * 32, W2_t + (size_t)le * 1024 * 1024, (size_t)nb * 32, 1024, scr, lane); }
    }
    for (int f = gw * 64 + lane; f < 2 * 160 * 64; f += NGW * 64) {
        const int l = f / (160 * 64), q = f - l * (160 * 64); v4u o;
        if (q < 96 * 64) { const int ln = q & 63, fr = q >> 6, ks = fr & 1, nt = (fr >> 1) & 15, mat = fr >> 5, rr = ln & 15, g8 = ln >> 4;
            const float* W = (mat == 0 ? gin(A, 7) : mat == 1 ? gin(A, 9) : gin(A, 10)) + (size_t)l * 64 * 256 + (32 * ks + 8 * g8) * 256 + 64 * (nt >> 2) + 32 * ((nt >> 1) & 1) + 8 * (rr >> 2) + 4 * (nt & 1) + (rr & 3);
            o.x = pk2(W[0], W[256]); o.y = pk2(W[512], W[768]); o.z = pk2(W[1024], W[1280]); o.w = pk2(W[1536], W[1792]); }
        else { const int q2 = q - 96 * 64, ln = q2 & 63, fr = q2 >> 6, ks = fr & 1, nt = (fr >> 1) & 3, hd = (fr >> 3) & 3, mat = fr >> 5, rr = ln & 15, g8 = ln >> 4;
            const float* W = (mat ? gin(A, 20) : gin(A, 18)) + (size_t)l * 4 * 64 * 64 + hd * 4096 + (32 * ks + 8 * g8) * 64 + 32 * (nt >> 1) + 8 * (rr >> 2) + 4 * (nt & 1) + (rr & 3);
            o.x = pk2(W[0], W[64]); o.y = pk2(W[128], W[192]); o.z = pk2(W[256], W[320]); o.w = pk2(W[384], W[448]); }
        *(v4u*)(A.ws + WS_FRAG + (size_t)l * FRAG_LAYER + (size_t)q * 16) = o;
    }
    bf16* HB = (bf16*)(A.ws + WS_HB);
    for (int m = gw; m < T; m += NGW) {
        const int b = m / L, i = m - b * L;
        const float* src = (i < NMETA) ? gin(A, 1) + (size_t)i * D : gin(A, 0) + ((size_t)b * SEQ + (i - NMETA)) * D;
        v4f v[4];
#pragma unroll
        for (int j = 0; j < 4; ++j) v[j] = *(const v4f*)(src + 256 * j + 4 * lane);
        ln_row(v, gin(A, 2), gin(A, 3), lane);
#pragma unroll
        for (int j = 0; j < 4; ++j) st_bf4(HB + (size_t)m * D + 256 * j + 4 * lane, v[j]);
    }
}
constexpr int NTK = 2;
__device__ __forceinline__ float softplus_fast(float x) { return x > 15.f ? x : __logf(1.f + __expf(x)); }
__device__ __forceinline__ float tanh_fast(float x) { return 1.f - 2.f * rcp_(1.f + __expf(2.f * x)); }
__device__ __forceinline__ void sincos_red(float ang, float& sn, float& cs) {
    const float k = rintf(ang * 0.15915494309189535f);
    float r = fmaf(-k, 6.28318548202514648f, ang); r = fmaf(-k, -1.7484555e-7f, r);
    sn = __sinf(r); cs = __cosf(r);
}
constexpr int PREP_W = 98304, PREP_SCR = 4096;
__device__ __forceinline__ void prep_load_w(LAS unsigned char* lds, const float* src, int n, int dst_elem, int tid) {
    for (int i = tid * 4; i < n; i += NTHR * 4) { const v4f x = *(const v4f*)(src + i); v2u o; o.x = pk2(x.x, x.y); o.y = pk2(x.z, x.w); *(LAS v2u*)(lds + (size_t)(dst_elem + i) * 2) = o; }
}
__device__ PHASE_FN void prep_phase(const Ctx A, LAS unsigned char* lds, int l, int vcu, int G) {
    const int tid = opaque_tid(), lane = tid & 63, wave = tid >> 6;
    LAS float* scr = (LAS float*)(lds + PREP_W + wave * PREP_SCR);
    const int gw = vcu * NWAVES + wave, NGW = G * NWAVES;
    const bf16* PROJ = (const bf16*)(A.ws + WS_PROJ);
    const int c4 = 4 * lane, hh = lane >> 4, d4 = 4 * (lane & 15);
    const float* mu = gin(A, 5) + l * 960; const float* w0 = gin(A, 6) + l * 256; const float* w2 = gin(A, 7) + l * 64 * 256;
    const float* a0 = gin(A, 8) + l * 256; const float* a2 = gin(A, 9) + l * 64 * 256; const float* g2 = gin(A, 10) + l * 64 * 256;
    const float* k_k = gin(A, 11) + l * 256; const float* k_a = gin(A, 12) + l * 256; const float* r_k = gin(A, 13) + l * 256;
    const float* conv_w = gin(A, 16) + l * 4 * 256; const float* conv_b = gin(A, 17) + l * 256;
    const float* wa = gin(A, 18) + l * 4 * 64 * 64; const float* ba = gin(A, 19) + l * 256; const float* wx = gin(A, 20) + l * 4 * 64 * 64; const float* bx = gin(A, 21) + l * 256;
    const float* lam = gin(A, 22) + l * 256; const float* lbs = gin(A, 23);
    float* RW_W = (float*)(A.ws + WS_RW_W); bf16* RW_A = (bf16*)(A.ws + WS_RW_A); bf16* RW_B = (bf16*)(A.ws + WS_RW_B); bf16* RW_K = (bf16*)(A.ws + WS_RW_K);
    bf16* RW_WR = (bf16*)(A.ws + WS_RW_WR); bf16* RW_V = (bf16*)(A.ws + WS_RW_V); bf16* RW_G = (bf16*)(A.ws + WS_RW_G); float* RW_SC = (float*)(A.ws + WS_RW_SC);
    bf16* DS_Q = (bf16*)(A.ws + WS_DS_Q); bf16* DS_K = (bf16*)(A.ws + WS_DS_K); bf16* DS_V = (bf16*)(A.ws + WS_DS_V); bf16* DS_QI = (bf16*)(A.ws + WS_DS_QI);
    bf16* DS_KI = (bf16*)(A.ws + WS_DS_KI); float* DS_WI = (float*)(A.ws + WS_DS_WI);
    float* LR_A = (float*)(A.ws + WS_LR_A); bf16* LR_U = (bf16*)(A.ws + WS_LR_U); bf16* LR_G = (bf16*)(A.ws + WS_LR_G);
    float* HG_F = (float*)(A.ws + WS_HG_F); bf16* HG_K = (bf16*)(A.ws + WS_HG_K); bf16* HG_Q = (bf16*)(A.ws + WS_HG_Q); bf16* HG_V = (bf16*)(A.ws + WS_HG_V); bf16* HG_G = (bf16*)(A.ws + WS_HG_G);
    LAS unsigned* kmaxl = (LAS unsigned*)(lds + MISC_OFF + 640);
    LAS unsigned* kimaxl = (LAS unsigned*)(lds + MISC_OFF + 832);
    if (tid < 32) kmaxl[tid] = 0u;
    if (tid < 8) kimaxl[tid] = 0u;
    const bool q_rot = (lane & 15) < 4, q_hi = (lane & 15) >= 2;
    const bool i_rot = (lane & 7) < 2, i_hi = (lane & 7) == 1;

#define BF4R(q_) ((v4f){bflo((q_).x), bfhi((q_).x), bflo((q_).y), bfhi((q_).y)})
    {
        constexpr int RC_OFF = 98304;
        static_assert(RC_OFF + 8 * 1024 <= MISC_OFF, "pass R lds");
        { const v4u* FR = (const v4u*)(A.ws + WS_FRAG + (size_t)l * FRAG_LAYER);
            for (int f = tid; f < 96 * 64; f += NTHR) *(LAS v4u*)(lds + (size_t)f * 16) = FR[f]; }
        LAS float* rc = (LAS float*)(lds + RC_OFF);
        if (tid < 256) { rc[tid] = mu[C_RW_R + tid]; rc[256 + tid] = mu[C_RW_K + tid]; rc[512 + tid] = mu[C_RW_V + tid]; rc[768 + tid] = w0[tid];
            rc[1024 + tid] = a0[tid]; rc[1280 + tid] = k_k[tid]; rc[1536 + tid] = k_a[tid]; rc[1792 + tid] = r_k[tid]; }
        __syncthreads();
        const int r = lane & 15, g = lane >> 4;
        const v4f z4 = (v4f){0.f, 0.f, 0.f, 0.f};
        auto r_tile = [&](const int tile, const int hd_lo, const int hd_hi) {
            const int m0 = tile * 16, b = m0 / L, i = m0 - b * L + r;
            const bf16* rowc = PROJ + (size_t)(m0 + r) * NINP;
            const bool hasp = i > 0; const bf16* rowp = hasp ? rowc - NINP : rowc;
            unsigned tch[4];
#pragma unroll
            for (int q = 0; q < 4; ++q) { const int ln_ = g + 4 * q < 15 ? g + 4 * q : 14; tch[q] = *(const unsigned*)(rowc + 64 * ln_); }
            pg8::bf16x8 Bf[3][2];
#pragma unroll
            for (int mat = 0; mat < 3; ++mat)
#pragma unroll
                for (int ks = 0; ks < 2; ++ks) { const int off = (mat == 0 ? C_RW_WD : mat == 1 ? C_RW_AD : C_RW_GD) + 32 * ks + 8 * g;
                    const v4u cq = *(const v4u*)(rowc + off), pq = *(const v4u*)(rowp + off);
                    const v4f m0v = *(const v4f*)(mu + off), m1v = *(const v4f*)(mu + off + 4);
                    float o8[8];
#pragma unroll
                    for (int e = 0; e < 8; ++e) { const unsigned cw = cq[e >> 1], pw = pq[e >> 1];
                        const float cur = (e & 1) ? bfhi(cw) : bflo(cw), prv = hasp ? ((e & 1) ? bfhi(pw) : bflo(pw)) : 0.f;
                        const float sv = cur + (prv - cur) * (e < 4 ? m0v[e & 3] : m1v[e & 3]);
                        o8[e] = mat == 0 ? tanh_fast(sv) : mat == 1 ? sv : sigmoidf_(sv); }
                    v4u pk; pk.x = pk2(o8[0], o8[1]); pk.y = pk2(o8[2], o8[3]); pk.z = pk2(o8[4], o8[5]); pk.w = pk2(o8[6], o8[7]);
                    Bf[mat][ks] = __builtin_bit_cast(pg8::bf16x8, pk); }
            asm volatile("" :: "v"(tch[0]), "v"(tch[1]), "v"(tch[2]), "v"(tch[3]));
#pragma unroll 1
            for (int hd = hd_lo; hd < hd_hi; ++hd) {
                pg8::f32x4 Cw[4], Ca[4], Cg[4];
#pragma unroll
                for (int nt = 0; nt < 4; ++nt) {
                    const LAS unsigned char* wf = lds + (size_t)((hd * 4 + nt) * 2) * 1024 + lane * 16;
                    pg8::f32x4 cw = (pg8::f32x4){0.f, 0.f, 0.f, 0.f}, ca = cw, cg = cw;
#pragma unroll
                    for (int ks = 0; ks < 2; ++ks) {
                        cw = __builtin_amdgcn_mfma_f32_16x16x32_bf16(*(const LAS pg8::bf16x8*)(wf + ks * 1024), Bf[0][ks], cw, 0, 0, 0);
                        ca = __builtin_amdgcn_mfma_f32_16x16x32_bf16(*(const LAS pg8::bf16x8*)(wf + 32768 + ks * 1024), Bf[1][ks], ca, 0, 0, 0);
                        cg = __builtin_amdgcn_mfma_f32_16x16x32_bf16(*(const LAS pg8::bf16x8*)(wf + 65536 + ks * 1024), Bf[2][ks], cg, 0, 0, 0); }
                    Cw[nt] = cw; Ca[nt] = ca; Cg[nt] = cg;
                }
                const size_t hrow = ((size_t)(b * 4 + hd) * L + i);
                v4f kun[4], kav_[4];
                float n2 = 0.f, sbr = 0.f, skr = 0.f, sbo = 0.f;
                const int cbh = hd * 64 + 8 * g;
                v4u Lr[2], Lk[2], Lv[2], Qr[2], Qk[2], Qv[2]; v2u oK[4], oWR[4], oV[4], oG[4];
#pragma unroll
                for (int h2 = 0; h2 < 2; ++h2) { Lr[h2] = *(const v4u*)(rowc + C_RW_R + cbh + 32 * h2); Lk[h2] = *(const v4u*)(rowc + C_RW_K + cbh + 32 * h2); Lv[h2] = *(const v4u*)(rowc + C_RW_V + cbh + 32 * h2);
                    Qr[h2] = *(const v4u*)(rowp + C_RW_R + cbh + 32 * h2); Qk[h2] = *(const v4u*)(rowp + C_RW_K + cbh + 32 * h2); Qv[h2] = *(const v4u*)(rowp + C_RW_V + cbh + 32 * h2); }
#define PREP_W4(V_, nt_) ((v4f){bflo(V_[(nt_) >> 1][2 * ((nt_) & 1)]), bfhi(V_[(nt_) >> 1][2 * ((nt_) & 1)]), bflo(V_[(nt_) >> 1][2 * ((nt_) & 1) + 1]), bfhi(V_[(nt_) >> 1][2 * ((nt_) & 1) + 1])})
#pragma unroll
                for (int nt = 0; nt < 4; ++nt) {
                    const int cc = cbh + 32 * (nt >> 1) + 4 * (nt & 1), d4h = 8 * g + 32 * (nt >> 1) + 4 * (nt & 1);
                    const v4f cr = PREP_W4(Lr, nt), ck = PREP_W4(Lk, nt), cv = PREP_W4(Lv, nt);
                    const v4f pr = hasp ? PREP_W4(Qr, nt) : z4, pk_ = hasp ? PREP_W4(Qk, nt) : z4, pv = hasp ? PREP_W4(Qv, nt) : z4;
                    const v4f mu_r = *(const LAS v4f*)(rc + cc), mu_k = *(const LAS v4f*)(rc + 256 + cc), mu_v = *(const LAS v4f*)(rc + 512 + cc), w0v = *(const LAS v4f*)(rc + 768 + cc);
                    const v4f a0v = *(const LAS v4f*)(rc + 1024 + cc), kkv = *(const LAS v4f*)(rc + 1280 + cc), kav = *(const LAS v4f*)(rc + 1536 + cc), rkv = *(const LAS v4f*)(rc + 1792 + cc);
                    const v4f rs = cr + (pr - cr) * mu_r, kx = ck + (pk_ - ck) * mu_k, vs = cv + (pv - cv) * mu_v;
                    v4f dec, km, wr, lg;
#pragma unroll
                    for (int e = 0; e < 4; ++e) {
                        const float wv = -softplus_fast(-(w0v[e] + Cw[nt][e])) - 0.5f;
                        dec[e] = __expf(-__expf(wv));
                        const float av = sigmoidf_(a0v[e] + Ca[nt][e]);
                        const float ku = kx[e] * kkv[e]; kun[nt][e] = ku; kav_[nt][e] = ku * av; n2 += ku * ku;
                        km[e] = kx[e] * (1.f + (av - 1.f) * kav[e]);
                        wr[e] = dec[e] * rs[e]; sbr += ku * av * rs[e]; skr += km[e] * rs[e]; sbo += rs[e] * km[e] * rkv[e];
                        lg[e] = Cg[nt][e]; }
                    *(v4f*)(RW_W + hrow * 64 + d4h) = dec;
                    oK[nt].x = pk2(km[0], km[1]); oK[nt].y = pk2(km[2], km[3]); oWR[nt].x = pk2(wr[0], wr[1]); oWR[nt].y = pk2(wr[2], wr[3]);
                    oV[nt].x = pk2(vs[0], vs[1]); oV[nt].y = pk2(vs[2], vs[3]); oG[nt].x = pk2(lg[0], lg[1]); oG[nt].y = pk2(lg[2], lg[3]);
                }
#undef PREP_W4
#pragma unroll
                for (int h2 = 0; h2 < 2; ++h2) { const size_t ho = hrow * 64 + 8 * g + 32 * h2;
                    *(v4u*)(RW_K + ho) = (v4u){oK[2 * h2].x, oK[2 * h2].y, oK[2 * h2 + 1].x, oK[2 * h2 + 1].y}; *(v4u*)(RW_WR + ho) = (v4u){oWR[2 * h2].x, oWR[2 * h2].y, oWR[2 * h2 + 1].x, oWR[2 * h2 + 1].y};
                    *(v4u*)(RW_V + ho) = (v4u){oV[2 * h2].x, oV[2 * h2].y, oV[2 * h2 + 1].x, oV[2 * h2 + 1].y};
                    *(v4u*)(RW_G + (size_t)(m0 + r) * 256 + cbh + 32 * h2) = (v4u){oG[2 * h2].x, oG[2 * h2].y, oG[2 * h2 + 1].x, oG[2 * h2 + 1].y}; }
                n2 += __shfl_xor(n2, 16); n2 += __shfl_xor(n2, 32);
                const float inv = rcp_(fmaxf(sqrtf(n2), 1e-12f));
#pragma unroll
                for (int h2 = 0; h2 < 2; ++h2) { const size_t ho = hrow * 64 + 8 * g + 32 * h2; const v4f a0_ = kun[2 * h2] * (-inv), a1_ = kun[2 * h2 + 1] * (-inv), b0_ = kav_[2 * h2] * inv, b1_ = kav_[2 * h2 + 1] * inv;
                    *(v4u*)(RW_A + ho) = (v4u){pk2(a0_[0], a0_[1]), pk2(a0_[2], a0_[3]), pk2(a1_[0], a1_[1]), pk2(a1_[2], a1_[3])};
                    *(v4u*)(RW_B + ho) = (v4u){pk2(b0_[0], b0_[1]), pk2(b0_[2], b0_[3]), pk2(b1_[0], b1_[1]), pk2(b1_[2], b1_[3])}; }
                sbr *= inv;
                sbr += __shfl_xor(sbr, 16); sbr += __shfl_xor(sbr, 32); skr += __shfl_xor(skr, 16); skr += __shfl_xor(skr, 32); sbo += __shfl_xor(sbo, 16); sbo += __shfl_xor(sbo, 32);
                if (g == 0) *(v4f*)(RW_SC + hrow * 4) = (v4f){sbr, skr, sbo, 0.f};
            }
        };
        const int NT16 = T / 16, nfull = (NT16 / NGW) * NGW;
#pragma unroll 1
        for (int it = gw; it < nfull + (NT16 - nfull) * 4; it += NGW) { const int q = it - nfull; const bool part = q >= 0;
            r_tile(part ? nfull + (q >> 2) : it, part ? (q & 3) : 0, part ? (q & 3) + 1 : 4); }
    }
    __syncthreads();
    {
        constexpr int XT_PITCH = 528, XT_BYTES = 16 * XT_PITCH, XT_OFF = 65536, LCST_OFF = XT_OFF + NWAVES * XT_BYTES;
        static_assert(LCST_OFF + 3 * 1024 <= MISC_OFF, "pass L lds");
        { const v4u* FL = (const v4u*)(A.ws + WS_FRAG + (size_t)l * FRAG_LAYER + 96 * 1024);
            for (int f = tid; f < 64 * 64; f += NTHR) *(LAS v4u*)(lds + (size_t)f * 16) = FL[f]; }
        LAS float* cst = (LAS float*)(lds + LCST_OFF);
        if (tid < 256) { cst[tid] = ba[tid]; cst[256 + tid] = bx[tid];
            const float xs = -lam[tid], ys = __expf(xs);
            cst[512 + tid] = xs > 15.f ? xs : (ys < 0.01f ? ys * (1.f - ys * (0.5f - ys * 0.33333334f)) : __logf(1.f + ys)); }
        __syncthreads();
        LAS unsigned char* xt = lds + XT_OFF + wave * XT_BYTES;
        const int r = lane & 15, g = lane >> 4;
        const v4f cb = *(const v4f*)(conv_b + c4), cw0 = *(const v4f*)(conv_w + c4), cw1 = *(const v4f*)(conv_w + 256 + c4), cw2 = *(const v4f*)(conv_w + 512 + c4), cw3 = *(const v4f*)(conv_w + 768 + c4);
        auto l_tile = [&](const int tile, const int hd_lo, const int hd_hi) {
            const int m0 = tile * 16, b = m0 / L, i0 = m0 - b * L;
            const bf16* Pq = PROJ + (size_t)m0 * NINP;
            v2u xb[19], gr[16];
#pragma unroll
            for (int q = 0; q < 19; ++q) { const int ro = (i0 + q - 3 >= 0) ? q - 3 : 0; xb[q] = *(const v2u*)(Pq + (ptrdiff_t)ro * NINP + C_LR_X + c4); }
#pragma unroll
            for (int t = 0; t < 16; ++t) gr[t] = *(const v2u*)(Pq + (size_t)t * NINP + C_LR_G + c4);
            const v4f z4 = (v4f){0.f, 0.f, 0.f, 0.f};
            v4f x0 = i0 > 0 ? BF4R(xb[0]) : z4, x1 = i0 > 0 ? BF4R(xb[1]) : z4, x2 = i0 > 0 ? BF4R(xb[2]) : z4;
#pragma unroll
            for (int t = 0; t < 16; ++t) {
                const v4f x3 = BF4R(xb[t + 3]);
                const v4f xc = cb + cw0 * x0 + cw1 * x1 + cw2 * x2 + cw3 * x3;
                v2u o; o.x = pk2(xc.x, xc.y); o.y = pk2(xc.z, xc.w);
                *(LAS v2u*)(xt + t * XT_PITCH + c4 * 2) = o;
                x0 = x1; x1 = x2; x2 = x3;
                const v4f gv = BF4R(gr[t]); v4f gg;
#pragma unroll
                for (int e = 0; e < 4; ++e) { const float tt = 0.7978845608028654f * (gv[e] + 0.044715f * gv[e] * gv[e] * gv[e]); gg[e] = 0.5f * gv[e] * (1.f + tanh_fast(tt)); }
                if (hd_lo == 0) st_bf4(LR_G + (size_t)(m0 + t) * 256 + c4, gg);
            }
            LDS_WAIT();
#pragma unroll 1
            for (int hd = hd_lo; hd < hd_hi; ++hd) {
                const LAS unsigned char* xrow = xt + r * XT_PITCH + hd * 128;
                const pg8::bf16x8 bk0 = *(const LAS pg8::bf16x8*)(xrow + g * 16), bk1 = *(const LAS pg8::bf16x8*)(xrow + 64 + g * 16);
                pg8::f32x4 Ca[4], Cx[4];
#pragma unroll
                for (int nt = 0; nt < 4; ++nt) {
                    const LAS unsigned char* wf = lds + (size_t)((hd * 4 + nt) * 2) * 1024 + lane * 16;
                    const pg8::bf16x8 a0 = *(const LAS pg8::bf16x8*)(wf), a1 = *(const LAS pg8::bf16x8*)(wf + 1024), x0f = *(const LAS pg8::bf16x8*)(wf + 32768), x1f = *(const LAS pg8::bf16x8*)(wf + 32768 + 1024);
                    pg8::f32x4 ca = (pg8::f32x4){0.f, 0.f, 0.f, 0.f}, cx = ca;
                    ca = __builtin_amdgcn_mfma_f32_16x16x32_bf16(a0, bk0, ca, 0, 0, 0); ca = __builtin_amdgcn_mfma_f32_16x16x32_bf16(a1, bk1, ca, 0, 0, 0);
                    cx = __builtin_amdgcn_mfma_f32_16x16x32_bf16(x0f, bk0, cx, 0, 0, 0); cx = __builtin_amdgcn_mfma_f32_16x16x32_bf16(x1f, bk1, cx, 0, 0, 0);
                    Ca[nt] = ca; Cx[nt] = cx;
                }
                v2u oU[4];
#pragma unroll
                for (int nt = 0; nt < 4; ++nt) {
                    const int c0 = hd * 64 + 32 * (nt >> 1) + 8 * g + 4 * (nt & 1);
                    const v4f bav = *(const LAS v4f*)(cst + c0), bxv = *(const LAS v4f*)(cst + 256 + c0), spl = *(const LAS v4f*)(cst + 512 + c0);
                    const v2u xq = *(const LAS v2u*)(xt + r * XT_PITCH + c0 * 2); const v4f xc = BF4R(xq);
                    v4f aa, uu;
#pragma unroll
                    for (int e = 0; e < 4; ++e) { const float rg = sigmoidf_(Ca[nt][e] + bav[e]), ig = sigmoidf_(Cx[nt][e] + bxv[e]);
                        const float la = -8.f * rg * spl[e]; aa[e] = __expf(la);
                        const float x2l = 2.f * la; const float om = (x2l > -0.1f) ? -(x2l * (1.f + x2l * (0.5f + x2l * (0.16666667f + x2l * 0.041666668f)))) : (1.f - __expf(x2l));
                        uu[e] = xc[e] * ig * __builtin_amdgcn_sqrtf(om); }
                    const size_t mo = (size_t)(m0 + r) * 256 + c0;
                    *(v4f*)(LR_A + mo) = aa; oU[nt].x = pk2(uu[0], uu[1]); oU[nt].y = pk2(uu[2], uu[3]);
                }
#pragma unroll
                for (int h2 = 0; h2 < 2; ++h2) *(v4u*)(LR_U + (size_t)(m0 + r) * 256 + hd * 64 + 8 * g + 32 * h2) = (v4u){oU[2 * h2].x, oU[2 * h2].y, oU[2 * h2 + 1].x, oU[2 * h2 + 1].y};
            }
        };
        const int NT16 = T / 16, nfull = (NT16 / NGW) * NGW;
#pragma unroll 1
        for (int it = gw; it < nfull + (NT16 - nfull) * 4; it += NGW) { const int q = it - nfull; const bool part = q >= 0;
            l_tile(part ? nfull + (q >> 2) : it, part ? (q & 3) : 0, part ? (q & 3) + 1 : 4); }
    }
    {
        float invf_q[4], invf_i[4];
#pragma unroll
        for (int e = 0; e < 4; ++e) { invf_q[e] = exp2f(-(float)((d4 + e) & 7) * (18.931568569324174f / 8.f)); invf_i[e] = exp2f(-(float)e * (18.931568569324174f / 4.f)); }
        v4f lb = (v4f){0.f, 0.f, 0.f, 0.f};
        if (l == 1) { const v4f x0 = *(const v4f*)(lbs + c4), x1 = *(const v4f*)(lbs + 256 + c4);
            lb.x = 1.f / (1.f + __expf(x0.x - x1.x)); lb.y = 1.f / (1.f + __expf(x0.y - x1.y)); lb.z = 1.f / (1.f + __expf(x0.z - x1.z)); lb.w = 1.f / (1.f + __expf(x0.w - x1.w)); }
#pragma unroll 2
        for (int m = gw; m < T; m += NGW) {
            const int b = m / L, i = m - b * L; const float pos = (float)i;
            const bf16* Pj = PROJ + (size_t)m * NINP;
            v4f q = ld_bf4(Pj + C_DS_Q + c4), k = ld_bf4(Pj + C_DS_K + c4);
            const v4f v = ld_bf4(Pj + C_DS_V + c4);
            v4f qi = ld_bf4(Pj + C_DS_QI + c4), ki = ld_bf4(Pj + C_DS_KI + 4 * (lane & 7));
            const v4f hq = ld_bf4(Pj + C_HG_Q + c4), z = ld_bf4(Pj + C_HG_F + c4), vi = ld_bf4(Pj + C_HG_I + c4), hgt = ld_bf4(Pj + C_HG_G + c4);
#pragma unroll
            for (int e = 0; e < 4; ++e) {
                const float qp = __shfl_xor(q[e], 2), kp = __shfl_xor(k[e], 2), qip = __shfl_xor(qi[e], 1), kip = __shfl_xor(ki[e], 1);
                float sn, cs; sincos_red(pos * invf_q[e], sn, cs);
                if (q_rot) { q[e] = q_hi ? (qp * sn + q[e] * cs) : (q[e] * cs - qp * sn); k[e] = q_hi ? (kp * sn + k[e] * cs) : (k[e] * cs - kp * sn); }
                sincos_red(pos * invf_i[e], sn, cs);
                if (i_rot) { qi[e] = i_hi ? (qip * sn + qi[e] * cs) : (qi[e] * cs - qip * sn); ki[e] = i_hi ? (kip * sn + ki[e] * cs) : (ki[e] * cs - kip * sn); }
            }
            { float kn2 = sum16(k.x * k.x + k.y * k.y + k.z * k.z + k.w * k.w); if ((lane & 15) == 0) __hip_atomic_fetch_max(kmaxl + b * 4 + hh, __float_as_uint(kn2 * 1.02f), __ATOMIC_RELAXED, __HIP_MEMORY_SCOPE_WORKGROUP); }
            st_bf4(DS_Q + (size_t)m * 256 + c4, q * (0.125f * 1.4426950408889634f));      st_bf4(DS_K + (size_t)m * 256 + c4, k); st_bf4(DS_V + (size_t)m * 256 + c4, v); st_bf4(DS_QI + (size_t)m * 256 + c4, qi);
            { float in2 = sum8(ki.x * ki.x + ki.y * ki.y + ki.z * ki.z + ki.w * ki.w); if (lane == 0) __hip_atomic_fetch_max(kimaxl + b, __float_as_uint(in2 * 1.02f), __ATOMIC_RELAXED, __HIP_MEMORY_SCOPE_WORKGROUP); }
            if (lane < 8) { st_bf4(DS_KI + (size_t)m * 32 + 4 * lane, ki); DS_WI[(size_t)m * 8 + lane] = bf2f(Pj[C_DS_WI + lane]) * 0.0625f; }
            v4f qs, f, kq, gs;
#pragma unroll
            for (int e = 0; e < 4; ++e) { const float sg = sigmoidf_(z[e]); qs[e] = hq[e] * sigmoidf_(hq[e]); f[e] = lb[e] + (1.f - lb[e]) * sg; kq[e] = (1.f - lb[e]) * (1.f - sg); gs[e] = hgt[e] * sigmoidf_(hgt[e]); }
            const size_t hm = ((size_t)(b * 4 + hh) * L + i) * 64 + d4;
            *(v4f*)(HG_F + hm) = f; st_bf4(HG_K + hm, kq); st_bf4(HG_Q + hm, qs); st_bf4(HG_V + hm, vi); st_bf4(HG_G + (size_t)m * 256 + c4, gs);
        }
    }
    __syncthreads();
    if (tid < 32) atomicMax((unsigned*)(A.ws + WS_CTL) + 8960 + 64 * l + tid, kmaxl[tid]);
    if (tid < 8) atomicMax((unsigned*)(A.ws + WS_CTL) + 9216 + 64 * l + tid, kimaxl[tid]);
}
constexpr int SC_C = 32;
constexpr size_t WS_YRAW = WS_PROJ;
constexpr size_t WS_ORAW = WS_PROJ + (size_t)T * 1024;
__device__ PHASE_FN void rwkv_scan(const Ctx A, LAS unsigned char* lds, int unit_) {
    const int unit = opaque_s(unit_);
    const int tid = opaque_tid(), row = tid >> 4, kp = tid & 15;
    const int bh = unit >> 1, half = unit & 1, b = bh >> 2, h = bh & 3;
    const size_t base = (size_t)bh * L * 64;
    const float* W = (const float*)(A.ws + WS_RW_W) + base;
    const bf16* Av = (const bf16*)(A.ws + WS_RW_A) + base; const bf16* Bv = (const bf16*)(A.ws + WS_RW_B) + base; const bf16* Kv = (const bf16*)(A.ws + WS_RW_K) + base;
    const bf16* WRv = (const bf16*)(A.ws + WS_RW_WR) + base; const bf16* Vv = (const bf16*)(A.ws + WS_RW_V) + base + half * 32;
    const float* SC = (const float*)(A.ws + WS_RW_SC) + (size_t)bh * L * 4;
    float* YR = (float*)(A.ws + WS_YRAW) + (size_t)b * L * 256 + h * 64 + half * 32;
    constexpr int ARR = SC_C * 64;
    constexpr int BUF = (5 * ARR + SC_C * 32 + SC_C * 4) * 4;
    LAS float* ybuf = (LAS float*)(lds + 2 * BUF);
    float S0 = 0.f, S1 = 0.f, S2 = 0.f, S3 = 0.f;
    v4f rw; v2u ra, rb, rk, rwr, rv; float rsc = 0.f;
    const int e4 = tid * 4;
#define RW_LOAD(c) do { const int t0_ = (c) * SC_C; const bool ok_ = (t0_ + (e4 >> 6)) < L; const size_t o_ = (size_t)t0_ * 64 + e4; \
        rw = ok_ ? *(const v4f*)(W + o_) : (v4f){1.f, 1.f, 1.f, 1.f}; ra = ok_ ? *(const v2u*)(Av + o_) : (v2u){0u, 0u}; rb = ok_ ? *(const v2u*)(Bv + o_) : (v2u){0u, 0u}; \
        rk = ok_ ? *(const v2u*)(Kv + o_) : (v2u){0u, 0u}; rwr = ok_ ? *(const v2u*)(WRv + o_) : (v2u){0u, 0u}; \
        if (tid < SC_C * 8) rv = (t0_ + (tid >> 3)) < L ? *(const v2u*)(Vv + (size_t)(t0_ + (tid >> 3)) * 64 + (tid & 7) * 4) : (v2u){0u, 0u}; \
        if (tid < SC_C * 4) rsc = (t0_ + (tid >> 2)) < L ? SC[(size_t)t0_ * 4 + tid] : 0.f; } while (0)
#define RW_STORE(p) do { LAS float* d_ = (LAS float*)(lds + (p) * BUF); \
        *(LAS v4f*)(d_ + e4) = rw; *(LAS v4f*)(d_ + ARR + e4) = (v4f){bflo(ra.x), bfhi(ra.x), bflo(ra.y), bfhi(ra.y)}; *(LAS v4f*)(d_ + 2 * ARR + e4) = (v4f){bflo(rb.x), bfhi(rb.x), bflo(rb.y), bfhi(rb.y)}; \
        *(LAS v4f*)(d_ + 3 * ARR + e4) = (v4f){bflo(rk.x), bfhi(rk.x), bflo(rk.y), bfhi(rk.y)}; *(LAS v4f*)(d_ + 4 * ARR + e4) = (v4f){bflo(rwr.x), bfhi(rwr.x), bflo(rwr.y), bfhi(rwr.y)}; \
        if (tid < SC_C * 8) *(LAS v4f*)(d_ + 5 * ARR + tid * 4) = (v4f){bflo(rv.x), bfhi(rv.x), bflo(rv.y), bfhi(rv.y)}; if (tid < SC_C * 4) d_[5 * ARR + SC_C * 32 + tid] = rsc; } while (0)
    constexpr int NCH = (L + SC_C - 1) / SC_C;
    RW_LOAD(0); RW_STORE(0); __syncthreads();
#pragma unroll 1
    for (int c = 0; c < NCH; ++c) {
        const int p = c & 1;
        if (c + 1 < NCH) RW_LOAD(c + 1);
        const int ns = (L - c * SC_C) < SC_C ? (L - c * SC_C) : SC_C;
        const LAS float* d = (const LAS float*)(lds + p * BUF);
        const LAS float* q = d + kp * 4; const LAS float* dv = d + 5 * ARR + row; const LAS float* dsc = d + 5 * ARR + SC_C * 32;
        v4f w4 = *(const LAS v4f*)(q), a4 = *(const LAS v4f*)(q + ARR), b4 = *(const LAS v4f*)(q + 2 * ARR), k4 = *(const LAS v4f*)(q + 3 * ARR), r4 = *(const LAS v4f*)(q + 4 * ARR);
        float vv = dv[0]; v2f sc = *(const LAS v2f*)(dsc);
#pragma unroll 2
        for (int s = 0; s < ns; ++s) {
            const int sn = (s + 1 < SC_C) ? s + 1 : s;
            const v4f nw4 = *(const LAS v4f*)(q + sn * 64), na4 = *(const LAS v4f*)(q + ARR + sn * 64), nb4 = *(const LAS v4f*)(q + 2 * ARR + sn * 64);
            const v4f nk4 = *(const LAS v4f*)(q + 3 * ARR + sn * 64), nr4 = *(const LAS v4f*)(q + 4 * ARR + sn * 64);
            const float nvv = dv[sn * 32]; const v2f nsc = *(const LAS v2f*)(dsc + sn * 4);
            float sa = (S0 * a4.x + S1 * a4.y) + (S2 * a4.z + S3 * a4.w), y1 = (S0 * r4.x + S1 * r4.y) + (S2 * r4.z + S3 * r4.w);
            sa = sum16(sa); y1 = sum16(y1);
            S0 = S0 * w4.x + sa * b4.x + vv * k4.x; S1 = S1 * w4.y + sa * b4.y + vv * k4.y; S2 = S2 * w4.z + sa * b4.z + vv * k4.z; S3 = S3 * w4.w + sa * b4.w + vv * k4.w;
            const float yo = y1 + sa * sc.x + vv * sc.y;
            if (kp == 0) ybuf[s * 32 + row] = yo;
            w4 = nw4; a4 = na4; b4 = nb4; k4 = nk4; r4 = nr4; vv = nvv; sc = nsc;
        }
        __syncthreads();
        { const int s = tid >> 4, r2 = (tid & 15) * 2;
          if (s < ns) *(v2f*)(YR + (size_t)(c * SC_C + s) * 256 + r2) = *(const LAS v2f*)(ybuf + s * 32 + r2); }
        if (c + 1 < NCH) RW_STORE(1 - p);
        __syncthreads();
    }
#undef RW_LOAD
#undef RW_STORE
}
__device__ PHASE_FN void hgrn_scan(const Ctx A, LAS unsigned char* lds, int unit_) {
    const int unit = opaque_s(unit_);
    const int tid = opaque_tid(), row = tid >> 4, kp = tid & 15;
    const int bh = unit >> 1, half = unit & 1, b = bh >> 2, h = bh & 3;
    const size_t base = (size_t)bh * L * 64;
    const float* Fv = (const float*)(A.ws + WS_HG_F) + base;
    const bf16* Kv = (const bf16*)(A.ws + WS_HG_K) + base; const bf16* Qv = (const bf16*)(A.ws + WS_HG_Q) + base; const bf16* Vv = (const bf16*)(A.ws + WS_HG_V) + base + half * 32;
    float* OR = (float*)(A.ws + WS_ORAW) + (size_t)b * L * 256 + h * 64 + half * 32;
    constexpr int ARR = SC_C * 64; constexpr int BUF = (3 * ARR + SC_C * 32) * 4;
    LAS float* obuf = (LAS float*)(lds + 2 * BUF);
    float S0 = 0.f, S1 = 0.f, S2 = 0.f, S3 = 0.f;
    v4f rf; v2u rk, rq, rv;
    const int e4 = tid * 4;
#define HG_LOAD(c) do { const int t0_ = (c) * SC_C; const bool ok_ = (t0_ + (e4 >> 6)) < L; const size_t o_ = (size_t)t0_ * 64 + e4; \
        rf = ok_ ? *(const v4f*)(Fv + o_) : (v4f){1.f, 1.f, 1.f, 1.f}; rk = ok_ ? *(const v2u*)(Kv + o_) : (v2u){0u, 0u}; rq = ok_ ? *(const v2u*)(Qv + o_) : (v2u){0u, 0u}; \
        if (tid < SC_C * 8) rv = (t0_ + (tid >> 3)) < L ? *(const v2u*)(Vv + (size_t)(t0_ + (tid >> 3)) * 64 + (tid & 7) * 4) : (v2u){0u, 0u}; } while (0)
#define HG_STORE(p) do { LAS float* d_ = (LAS float*)(lds + (p) * BUF); \
        *(LAS v4f*)(d_ + e4) = rf; *(LAS v4f*)(d_ + ARR + e4) = (v4f){bflo(rk.x), bfhi(rk.x), bflo(rk.y), bfhi(rk.y)}; \
        *(LAS v4f*)(d_ + 2 * ARR + e4) = (v4f){bflo(rq.x), bfhi(rq.x), bflo(rq.y), bfhi(rq.y)}; \
        if (tid < SC_C * 8) *(LAS v4f*)(d_ + 3 * ARR + tid * 4) = (v4f){bflo(rv.x), bfhi(rv.x), bflo(rv.y), bfhi(rv.y)}; } while (0)
    constexpr int NCH = (L + SC_C - 1) / SC_C;
    HG_LOAD(0); HG_STORE(0); __syncthreads();
#pragma unroll 1
    for (int c = 0; c < NCH; ++c) {
        const int p = c & 1;
        if (c + 1 < NCH) HG_LOAD(c + 1);
        const int ns = (L - c * SC_C) < SC_C ? (L - c * SC_C) : SC_C;
        const LAS float* d = (const LAS float*)(lds + p * BUF);
        const LAS float* q = d + kp * 4; const LAS float* dv = d + 3 * ARR + row;
        v4f f4 = *(const LAS v4f*)(q), k4 = *(const LAS v4f*)(q + ARR), q4 = *(const LAS v4f*)(q + 2 * ARR); float vv = dv[0];
#pragma unroll 2
        for (int s = 0; s < ns; ++s) {
            const int sn = (s + 1 < SC_C) ? s + 1 : s;
            const v4f nf4 = *(const LAS v4f*)(q + sn * 64), nk4 = *(const LAS v4f*)(q + ARR + sn * 64), nq4 = *(const LAS v4f*)(q + 2 * ARR + sn * 64);
            const float nvv = dv[sn * 32];
            S0 = S0 * f4.x + k4.x * vv; S1 = S1 * f4.y + k4.y * vv; S2 = S2 * f4.z + k4.z * vv; S3 = S3 * f4.w + k4.w * vv;
            float o = (q4.x * S0 + q4.y * S1) + (q4.z * S2 + q4.w * S3);
            o = sum16(o);
            if (kp == 0) obuf[s * 32 + row] = o;
            f4 = nf4; k4 = nk4; q4 = nq4; vv = nvv;
        }
        __syncthreads();
        { const int s = tid >> 4, r2 = (tid & 15) * 2;
          if (s < ns) *(v2f*)(OR + (size_t)(c * SC_C + s) * 256 + r2) = *(const LAS v2f*)(obuf + s * 32 + r2); }
        if (c + 1 < NCH) HG_STORE(1 - p);
        __syncthreads();
    }
#undef HG_LOAD
#undef HG_STORE
}
__device__ PHASE_FN void mixers_finish(const Ctx A, int l, int vcu, int G) {
    const int tid = opaque_tid(), lane = tid & 63, wave = tid >> 6;
    const int gw = vcu * NWAVES + wave, NGW = G * NWAVES;
    const int c4 = 4 * lane, hh = lane >> 4, d4 = 4 * (lane & 15);
    const float* YR = (const float*)(A.ws + WS_YRAW); const float* OR = (const float*)(A.ws + WS_ORAW);
    const bf16* RV = (const bf16*)(A.ws + WS_RW_V); const float* SC = (const float*)(A.ws + WS_RW_SC); const bf16* RG = (const bf16*)(A.ws + WS_RW_G); const bf16* HGt = (const bf16*)(A.ws + WS_HG_G);
    bf16* MIX = (bf16*)(A.ws + WS_MIX);
    const v4f lg = *(const v4f*)(gin(A, 14) + l * 256 + c4), lb = *(const v4f*)(gin(A, 15) + l * 256 + c4), ng = *(const v4f*)(gin(A, 24) + l * 256 + c4);
#pragma unroll 2
    for (int m = gw; m < T; m += NGW) {
        const int b = m / L, i = m - b * L; const size_t hm = ((size_t)(b * 4 + hh) * L + i);
        const v4f y = *(const v4f*)(YR + (size_t)m * 256 + c4), o = *(const v4f*)(OR + (size_t)m * 256 + c4);
        const v4f vv = ld_bf4(RV + hm * 64 + d4), g = ld_bf4(RG + (size_t)m * 256 + c4), hg = ld_bf4(HGt + (size_t)m * 256 + c4);
        const float bonus = SC[hm * 4 + 2];
        const float mean = sum16((y.x + y.y) + (y.z + y.w)) * (1.f / 64.f); const v4f dy = y - mean;
        const float var = sum16((dy.x * dy.x + dy.y * dy.y) + (dy.z * dy.z + dy.w * dy.w)) * (1.f / 64.f);
        const v4f yn = (dy * rsqrtf(var + 64e-5f) * lg + lb + vv * bonus) * g;
        st_bf4(MIX + (size_t)m * 1024 + c4, yn);
        const float ms = sum16((o.x * o.x + o.y * o.y) + (o.z * o.z + o.w * o.w)) * (1.f / 64.f);
        st_bf4(MIX + (size_t)m * 1024 + 768 + c4, o * rsqrtf(ms + 1e-5f) * ng * hg);
    }
}
constexpr int LR_SEG = 64, LR_NSEG = (L + LR_SEG - 1) / LR_SEG;
constexpr size_t WS_LR_AGG = 2032 * MiB;
constexpr size_t WS_LR_CARRY = WS_LR_AGG + 3 * MiB;
static_assert(WS_LR_CARRY + (size_t)NB * LR_NSEG * 256 * 4 <= WS_END, "lru aggregates");
__device__ PHASE_FN void lru_agg_phase(const Ctx A, int vcu, int G) {
    const int tid = opaque_tid(), lane = tid & 63, wave = tid >> 6;
    const int gw = vcu * NWAVES + wave, NGW = G * NWAVES;
    const float* LA = (const float*)(A.ws + WS_LR_A); const bf16* LU = (const bf16*)(A.ws + WS_LR_U); v2f* AGG = (v2f*)(A.ws + WS_LR_AGG);
#pragma unroll 1
    for (int it = (gw & 1) ? NB * LR_NSEG : (gw >> 1); it < NB * LR_NSEG; it += NGW / 2) {
        const int q = it; const bool tail_ = q >= NB * (LR_NSEG - 1);
        const int b = tail_ ? q - NB * (LR_NSEG - 1) : q / (LR_NSEG - 1), sg = tail_ ? LR_NSEG - 1 : q - b * (LR_NSEG - 1), ch = 4 * lane;
        const int t0 = sg * LR_SEG, ns = (L - t0) < LR_SEG ? (L - t0) : LR_SEG;
        const size_t m0 = (size_t)b * L + t0;
        v4f Ap = (v4f){1.f, 1.f, 1.f, 1.f}, Hl = (v4f){0.f, 0.f, 0.f, 0.f};
#pragma unroll 1
        for (int i = 0; i < ns; i += 16) {
            v4f a[16]; v2u u[16];
#pragma unroll
            for (int j = 0; j < 16; ++j) { a[j] = *(const v4f*)(LA + (m0 + i + j) * 256 + ch); u[j] = *(const v2u*)(LU + (m0 + i + j) * 256 + ch); }
#pragma unroll
            for (int j = 0; j < 16; ++j) { const v4f uf = (v4f){bflo(u[j].x), bfhi(u[j].x), bflo(u[j].y), bfhi(u[j].y)}; Hl = a[j] * Hl + uf; Ap = Ap * a[j]; }
        }
        *(v4f*)(AGG + ((size_t)b * LR_NSEG + sg) * 256 + ch) = (v4f){Ap.x, Hl.x, Ap.y, Hl.y}; *(v4f*)(AGG + ((size_t)b * LR_NSEG + sg) * 256 + ch + 2) = (v4f){Ap.z, Hl.z, Ap.w, Hl.w};
    }
}
__device__ PHASE_FN void lru_carry_phase(const Ctx A, int first) {
    const int tid = opaque_tid(), lane = tid & 63, wave = tid >> 6;
    const int w = (opaque_s((int)blockIdx.x) - first) * NWAVES + wave;
    const int b = w >> 2, ch = (w & 3) * 64 + lane;
    const v2f* ag = (const v2f*)(A.ws + WS_LR_AGG) + (size_t)b * LR_NSEG * 256 + ch;
    float* CR = (float*)(A.ws + WS_LR_CARRY) + (size_t)b * LR_NSEG * 256 + ch;
    float hc = 0.f;
#pragma unroll 1
    for (int s0 = 0; s0 < LR_NSEG; s0 += 16) {
        v2f x[16];
#pragma unroll
        for (int j = 0; j < 16; ++j) { const int s = s0 + j < LR_NSEG ? s0 + j : LR_NSEG - 1; x[j] = ag[(size_t)s * 256]; }
#pragma unroll
        for (int j = 0; j < 16; ++j) if (s0 + j < LR_NSEG) { CR[(size_t)(s0 + j) * 256] = hc; hc = x[j].x * hc + x[j].y; }
    }
}
__device__ PHASE_FN void lru_out_phase(const Ctx A, int vcu, int G) {
    const int tid = opaque_tid(), lane = tid & 63, wave = tid >> 6;
    const int gw = vcu * NWAVES + wave, NGW = G * NWAVES;
    const float* LA = (const float*)(A.ws + WS_LR_A); const bf16* LU = (const bf16*)(A.ws + WS_LR_U); const bf16* LG = (const bf16*)(A.ws + WS_LR_G);
    const float* CR = (const float*)(A.ws + WS_LR_CARRY); bf16* MIX = (bf16*)(A.ws + WS_MIX);
#pragma unroll 1
    for (int it = (gw & 1) ? NB * LR_NSEG : (gw >> 1); it < NB * LR_NSEG; it += NGW / 2) {
        const int q = it; const bool tail_ = q >= NB * (LR_NSEG - 1);
        const int b = tail_ ? q - NB * (LR_NSEG - 1) : q / (LR_NSEG - 1), sg = tail_ ? LR_NSEG - 1 : q - b * (LR_NSEG - 1), ch = 4 * lane;
        const int t0 = sg * LR_SEG, ns = (L - t0) < LR_SEG ? (L - t0) : LR_SEG;
        const size_t m0 = (size_t)b * L + t0;
        v4f hc = *(const v4f*)(CR + ((size_t)b * LR_NSEG + sg) * 256 + ch);
#pragma unroll 1
        for (int i = 0; i < ns; i += 16) {
            v4f a[16]; v2u u[16], g[16];
#pragma unroll
            for (int j = 0; j < 16; ++j) { a[j] = *(const v4f*)(LA + (m0 + i + j) * 256 + ch); u[j] = *(const v2u*)(LU + (m0 + i + j) * 256 + ch); g[j] = *(const v2u*)(LG + (m0 + i + j) * 256 + ch); }
#pragma unroll
            for (int j = 0; j < 16; ++j) { const v4f uf = (v4f){bflo(u[j].x), bfhi(u[j].x), bflo(u[j].y), bfhi(u[j].y)}, gf = (v4f){bflo(g[j].x), bfhi(g[j].x), bflo(g[j].y), bfhi(g[j].y)};
                hc = a[j] * hc + uf; st_bf4(MIX + (m0 + i + j) * 1024 + 512 + ch, hc * gf); }
        }
    }
}
static_assert(L % 16 == 0, "lru step groups");
constexpr int DSA_WBYTES = 34944;
constexpr int DSA_NW = 4;
__device__ __forceinline__ unsigned fkey(float f) { const unsigned u = __float_as_uint(f); return (u & 0x80000000u) ? ~u : (u | 0x80000000u); }
__device__ __forceinline__ void dsa_query(const Ctx A, LAS unsigned char* wl, int b, int i, int lane) {
    const bf16* DQ = (const bf16*)(A.ws + WS_DS_Q); const bf16* DK = (const bf16*)(A.ws + WS_DS_K); const bf16* DV = (const bf16*)(A.ws + WS_DS_V);
    const bf16* DQI = (const bf16*)(A.ws + WS_DS_QI); const bf16* DKI = (const bf16*)(A.ws + WS_DS_KI); const float* DWI = (const float*)(A.ws + WS_DS_WI);
    bf16* MIX = (bf16*)(A.ws + WS_HB);
    LAS unsigned* keys = (LAS unsigned*)wl; LAS float* qv = (LAS float*)(wl + 32896); LAS int* sel = (LAS int*)(wl + 32896 + 1024);
    const size_t m = (size_t)b * L + i, mb = (size_t)b * L;
    const int n = i + 1;
    LAS float* wil = (LAS float*)(wl + 32832);
    { const v4f q4 = ld_bf4(DQI + m * 256 + 4 * lane); *(LAS v4f*)(qv + 4 * lane) = q4; if (lane < 8) wil[lane] = DWI[m * 8 + lane]; }
    LDS_WAIT();
    for (int s = lane; s < n; s += 64) {
        const v4u* kp = (const v4u*)(DKI + (mb + s) * 32);
        float kf[32];
#pragma unroll
        for (int c = 0; c < 4; ++c) { const v4u x = kp[c]; kf[8 * c + 0] = bflo(x.x); kf[8 * c + 1] = bfhi(x.x); kf[8 * c + 2] = bflo(x.y); kf[8 * c + 3] = bfhi(x.y); kf[8 * c + 4] = bflo(x.z); kf[8 * c + 5] = bfhi(x.z); kf[8 * c + 6] = bflo(x.w); kf[8 * c + 7] = bfhi(x.w); }
        float sc = 0.f;
#pragma unroll 1
        for (int hx = 0; hx < 8; ++hx) { float dt = 0.f;
#pragma unroll
            for (int c = 0; c < 8; ++c) { const v4f q4 = *(const LAS v4f*)(qv + hx * 32 + 4 * c); dt += q4.x * kf[4 * c] + q4.y * kf[4 * c + 1] + q4.z * kf[4 * c + 2] + q4.w * kf[4 * c + 3]; }
            sc += wil[hx] * fmaxf(dt, 0.f); }
        keys[s] = fkey(sc);
    }
    LDS_WAIT();
    unsigned thr = 0u; int need = 0;
    if (n > 256) {
        unsigned prefix = 0u; need = 256;
#pragma unroll 1
        for (int shift = 28; shift >= 0; shift -= 4) {
            unsigned long long lo = 0ull, hi = 0ull;
            const unsigned himask = (shift == 28) ? 0u : (0xFFFFFFFFu << (shift + 4));
            for (int s = lane; s < n; s += 64) { const unsigned k = keys[s];
                if ((k & himask) == prefix) { const unsigned dg = (k >> shift) & 15u; const unsigned long long inc = 1ull << ((dg & 7u) * 8u); if (dg < 8u) lo += inc; else hi += inc; } }
            int cum = 0; unsigned dsel = 0u; int below = 0; bool found = false;
#pragma unroll
            for (int dg = 15; dg >= 0; --dg) {
                const unsigned mine = (unsigned)(((dg < 8 ? lo : hi) >> ((dg & 7) * 8)) & 0xFFull);
                int tot = (int)mine;
#pragma unroll
                for (int o = 1; o < 64; o <<= 1) tot += __shfl_xor(tot, o);
                if (!found && cum + tot >= need) { found = true; dsel = (unsigned)dg; below = cum; }
                cum += tot;
            }
            prefix |= dsel << shift; need -= below;
        }
        thr = prefix;
    }
    int cnt = 0;
    if (n <= 256) { for (int s = lane; s < n; s += 64) sel[s] = s; cnt = n; }
    else {
        int eq_taken = 0;
        for (int s0 = 0; s0 < n; s0 += 64) { const int s = s0 + lane; const unsigned k = (s < n) ? keys[s] : 0u; const bool in = s < n;
            const bool gt = in && (k > thr), eq = in && (k == thr);
            const unsigned long long meq = __ballot(eq); const int eq_before = __popcll(meq & ((1ull << lane) - 1ull));
            const bool take = gt || (eq && (eq_taken + eq_before) < need);
            const unsigned long long mt = __ballot(take); const int pos = cnt + __popcll(mt & ((1ull << lane) - 1ull));
            if (take && pos < 256) sel[pos] = s;
            cnt += __popcll(mt); eq_taken += __popcll(meq);
        }
        if (cnt > 256) cnt = 256;
    }
    LDS_WAIT();
    LAS float* pbuf = (LAS float*)wl;
    for (int h = 0; h < 4; ++h) {
        { const float qx = bf2f(DQ[m * 256 + h * 64 + lane]); qv[lane] = qx * 0.125f; }
        LDS_WAIT();
        float sj[4]; float mx = -3.0e38f;
#pragma unroll
        for (int r = 0; r < 4; ++r) { const int j = lane + 64 * r; sj[r] = -3.0e38f;
            if (j < cnt) { const int s = sel[j]; const v4u* kp = (const v4u*)(DK + (mb + s) * 256 + h * 64); float dt = 0.f;
#pragma unroll
                for (int c = 0; c < 8; ++c) { const v4u x = kp[c]; const v4f q0 = *(const LAS v4f*)(qv + 8 * c), q1 = *(const LAS v4f*)(qv + 8 * c + 4);
                    dt += q0.x * bflo(x.x) + q0.y * bfhi(x.x) + q0.z * bflo(x.y) + q0.w * bfhi(x.y) + q1.x * bflo(x.z) + q1.y * bfhi(x.z) + q1.z * bflo(x.w) + q1.w * bfhi(x.w); }
                sj[r] = dt; mx = fmaxf(mx, dt); } }
        mx = wave_max(mx);
        float sum = 0.f;
#pragma unroll
        for (int r = 0; r < 4; ++r) { const int j = lane + 64 * r; const float p = (j < cnt) ? __expf(sj[r] - mx) : 0.f; sum += p; pbuf[j] = p; }
        sum = wave_sum(sum);
        LDS_WAIT();
        float o = 0.f;
        for (int j = 0; j < cnt; ++j) { const int s = sel[j]; o += pbuf[j] * bf2f(DV[(mb + s) * 256 + h * 64 + lane]); }
        MIX[m * 1024 + 256 + h * 64 + lane] = f2bf(o / sum);
        LDS_WAIT();
    }
}
__device__ PHASE_FN void dsa_phase(const Ctx A, LAS unsigned char* lds, int l) {
    const int tid = opaque_tid(), lane = tid & 63, wave = tid >> 6;
    if (wave >= DSA_NW) return;
    unsigned* qhead = (unsigned*)(A.ws + WS_CTL) + CW_DSAQ + 64 * l;
    LAS unsigned char* wl = lds + wave * DSA_WBYTES;
    for (;;) {
        unsigned it = 0u;
        if (lane == 0) it = atomicAdd(qhead, 1u);
        it = __builtin_amdgcn_readfirstlane(it);
        if (it >= (unsigned)T) break;
        const int i = L - 1 - (int)(it >> 3), b = (int)(it & 7u);
        dsa_query(A, wl, b, i, lane);
    }
}
static_assert(DSA_NW * DSA_WBYTES <= MISC_OFF, "dsa lds");
typedef short s8 __attribute__((ext_vector_type(8)));
typedef short v4i16_t __attribute__((ext_vector_type(4)));
typedef unsigned u16v __attribute__((ext_vector_type(16)));
typedef unsigned long long u64;
constexpr int NQT16 = L / 16;
constexpr int NKB32 = (L + 31) / 32;
constexpr int MASK_PB = 66112;
constexpr size_t MASK_LAYER = (size_t)NB * MASK_PB * 64;
constexpr size_t WS_MASK = 1956 * MiB;
static_assert(WS_MASK >= WS_MIX_END && WS_MASK + 2 * MASK_LAYER + 256 <= 2032 * MiB, "mask region");
__device__ __forceinline__ size_t mask_row(int l, int b, int qt) { const int a = qt >> 1; return (size_t)l * (NB * MASK_PB) + (size_t)b * MASK_PB + ((qt & 1) ? (a + 1) * (a + 1) : a * (a + 1)); }
constexpr int CW_KMAX = 8960;
constexpr int CW_KIMAX = 9216;
constexpr int MI_KMAX = 640, MI_UNIT = 768, MI_KIMAX = 832;
constexpr int SEL_PF = 3;
constexpr int SEL_HROW = 259;

__device__ __forceinline__ void sel_scores(const s8 a1, const s8 a2, const s8 (&qb)[9], const float (&wv)[8], pg8::f32x4& i1, pg8::f32x4& i2) {
    const pg8::f32x4 z = (pg8::f32x4){0.f, 0.f, 0.f, 0.f};
    i1 = __builtin_amdgcn_mfma_f32_16x16x32_bf16(a1, qb[8], z, 0, 0, 0); i2 = __builtin_amdgcn_mfma_f32_16x16x32_bf16(a2, qb[8], z, 0, 0, 0);
#pragma unroll
    for (int h = 0; h < 8; ++h) {
        const pg8::f32x4 c1 = __builtin_amdgcn_mfma_f32_16x16x32_bf16(a1, qb[h], z, 0, 0, 0), c2 = __builtin_amdgcn_mfma_f32_16x16x32_bf16(a2, qb[h], z, 0, 0, 0);
#pragma unroll
        for (int j = 0; j < 4; ++j) { float t1 = fmaf(fabsf(c1[j]), wv[h], i1[j]), t2 = fmaf(fabsf(c2[j]), wv[h], i2[j]);
            asm("" : "+v"(t1)); asm("" : "+v"(t2)); i1[j] = t1; i2[j] = t2; }
    }
}
template <int MODE, bool DIAG>
__device__ __forceinline__ void sel_block(const s8 a1, const s8 a2, const s8 (&qb)[9], const float (&wv)[8], int kb, int tq, int r, int g, int lane,
                                          LAS unsigned* hrow, float sc_mul, float sc_add, u64* mrow) {
    pg8::f32x4 i1, i2; sel_scores(a1, a2, qb, wv, i1, i2);
    const int s0 = kb * 32 + 8 * g;
    u64 wds[8];
#pragma unroll
    for (int j = 0; j < 8; ++j) {
        const float sc = j < 4 ? i1[j & 3] : i2[j & 3];
        if (MODE == 3) { if (sc == 123456.789f) hrow[256] = 1u; }
        else if (MODE == 2) { wds[j] = DIAG ? __ballot((s0 + j) <= tq && sc >= sc_add) : __ballot(sc >= sc_add); }
        else { int xi = (int)__builtin_floorf(fmaf(sc, sc_mul, sc_add));
            unsigned bin = MODE == 0 ? (unsigned)min(max(xi, 0), 255) : (unsigned)(min(max(xi, -1), 256) + 1);
            if (DIAG) bin = ((s0 + j) <= tq) ? bin : (MODE == 0 ? 256u : 0u);
            if (MODE == 0 || bin != 0u) __hip_atomic_fetch_add(hrow + bin, 1u, __ATOMIC_RELAXED, __HIP_MEMORY_SCOPE_WORKGROUP); }
    }
    if (MODE == 2 && lane == 0) { u64* d = mrow + (size_t)kb * 8;
#pragma unroll
        for (int j = 0; j < 8; j += 2) { v4u o; o.x = (unsigned)wds[j]; o.y = (unsigned)(wds[j] >> 32); o.z = (unsigned)wds[j + 1]; o.w = (unsigned)(wds[j + 1] >> 32); *(v4u*)(d + j) = o; } }
}
template <int MODE>
__device__ __forceinline__ void sel_pass(const bf16* KIb, const s8 (&qb)[9], const float (&wv)[8], int nkb, int tq, int r, int g, int lane,
                                         LAS unsigned* hrow, float sc_mul, float sc_add, u64* mrow, int kb_first = 0, int kb_step = 1) {
    const bf16* kp = KIb + (size_t)(8 * (r >> 2) + (r & 3)) * 32 + 8 * g;
    v4u cur[2 * SEL_PF], nxt[2 * SEL_PF];
#pragma unroll
    for (int i = 0; i < SEL_PF; ++i) { const size_t kb = kb_first + i * kb_step; cur[2 * i] = *(const v4u*)(kp + kb * 1024); cur[2 * i + 1] = *(const v4u*)(kp + kb * 1024 + 128); }
#pragma unroll 1
    for (int kb0 = kb_first; kb0 < nkb; kb0 += SEL_PF * kb_step) {
#pragma unroll
        for (int i = 0; i < SEL_PF; ++i) { const size_t kb = kb0 + (SEL_PF + i) * kb_step; nxt[2 * i] = *(const v4u*)(kp + kb * 1024); nxt[2 * i + 1] = *(const v4u*)(kp + kb * 1024 + 128); }
#pragma unroll
        for (int i = 0; i < SEL_PF; ++i) { const int kb = kb0 + i * kb_step;
            if (kb < nkb - 1) sel_block<MODE, false>(__builtin_bit_cast(s8, cur[2 * i]), __builtin_bit_cast(s8, cur[2 * i + 1]), qb, wv, kb, tq, r, g, lane, hrow, sc_mul, sc_add, mrow);
            else if (kb == nkb - 1) sel_block<MODE, true>(__builtin_bit_cast(s8, cur[2 * i]), __builtin_bit_cast(s8, cur[2 * i + 1]), qb, wv, kb, tq, r, g, lane, hrow, sc_mul, sc_add, mrow); }
#pragma unroll
        for (int i = 0; i < 2 * SEL_PF; ++i) cur[i] = nxt[i];
    }
}
__device__ __forceinline__ void sel_scan(const LAS unsigned* hrow, int need, int& sel, int& above) {
    int cum = 0; sel = 0; above = 0; bool found = false;
#pragma unroll 8
    for (int bin = 255; bin >= 0; --bin) { const int c = (int)hrow[bin];
        if (!found && cum + c >= need) { found = true; sel = bin; above = cum; }
        cum += c; }
}
__device__ PHASE_FN void dsa_select_phase(const Ctx A, LAS unsigned char* lds, int l) {
    const int tid = opaque_tid(), lane = tid & 63, wave = tid >> 6, r = lane & 15, g = lane >> 4;
    const bf16* DQI = (const bf16*)(A.ws + WS_DS_QI); const bf16* DKI = (const bf16*)(A.ws + WS_DS_KI); const float* DWI = (const float*)(A.ws + WS_DS_WI);
    u64* MASK = (u64*)(A.ws + WS_MASK);
    unsigned* qhead = (unsigned*)(A.ws + WS_CTL) + CW_DSAQ + 64 * l;
    const unsigned* kimaxw = (const unsigned*)(A.ws + WS_CTL) + CW_KIMAX + 64 * l;
    LAS unsigned* hist = (LAS unsigned*)(lds + wave * (16 * SEL_HROW * 4));
    LAS unsigned* hrow = hist + r * SEL_HROW;
    for (;;) {
        unsigned it = 0u;
        if (lane == 0) it = atomicAdd(qhead, 1u);
        it = __builtin_amdgcn_readfirstlane(it);
        if (it >= (unsigned)(NB * NQT16)) break;
        const int qt = NQT16 - 1 - (int)(it >> 3), b = (int)(it & 7u);
        const size_t mb = (size_t)b * L, m0 = mb + (size_t)qt * 16;
        const int tq = qt * 16 + r, nkb = ((qt * 16 + 15) >> 5) + 1;
        s8 qb[9]; float wv[8];
#pragma unroll
        for (int h = 0; h < 8; ++h) qb[h] = *(const s8*)(DQI + (m0 + r) * 256 + h * 32 + 8 * g);
        { const v4f w0 = *(const v4f*)(DWI + (m0 + r) * 8), w1 = *(const v4f*)(DWI + (m0 + r) * 8 + 4);
          wv[0] = w0.x; wv[1] = w0.y; wv[2] = w0.z; wv[3] = w0.w; wv[4] = w1.x; wv[5] = w1.y; wv[6] = w1.z; wv[7] = w1.w; }
        float bq = 0.f;
        { float ql[8];
#pragma unroll
          for (int e = 0; e < 8; ++e) ql[e] = 0.f;
#pragma unroll
          for (int h = 0; h < 8; ++h) { float n2 = 0.f;
#pragma unroll
              for (int e = 0; e < 8; ++e) { const float x = bf2f((unsigned short)qb[h][e]); ql[e] += wv[h] * x; n2 += x * x; }
              n2 += __shfl_xor(n2, 16); n2 += __shfl_xor(n2, 32); bq += fabsf(wv[h]) * sqrtf(n2); }
          v4u pk; pk.x = pk2(ql[0], ql[1]); pk.y = pk2(ql[2], ql[3]); pk.z = pk2(ql[4], ql[5]); pk.w = pk2(ql[6], ql[7]); qb[8] = __builtin_bit_cast(s8, pk); }
        const bf16* KIb = DKI + mb * 32;
        float thr_f = -__builtin_inff();
        if (qt * 16 + 15 >= 256) {
            const float kim = sqrtf(__uint_as_float(__hip_atomic_load(kimaxw + b, __ATOMIC_RELAXED, __HIP_MEMORY_SCOPE_AGENT)));
            const float R = fmaxf(2.06f * bq * kim, 1e-30f), s0 = 128.f / R, w0 = R * (1.f / 128.f);
            const int n = tq + 1;
            bool done = false;
            if (qt * 16 >= 2048) {
                for (int i = lane; i < 16 * SEL_HROW; i += 64) hist[i] = 0u;
                LDS_WAIT();
                sel_pass<0>(KIb, qb, wv, nkb - 1, tq, r, g, lane, hrow, s0, 128.f, nullptr, 3, 8);
                LDS_WAIT();
                const int ns = 32 * ((nkb - 1 - 3 + 7) >> 3);
                const float rho = 256.f * (float)ns / (float)n, dev = 4.f * sqrtf(rho) + 2.f;
                int bl, ab; sel_scan(hrow, (int)(rho + dev) + 1, bl, ab);
                int bh = 255, ab2 = 0; const int rhi = (int)(rho - dev);
                if (rhi >= 1) sel_scan(hrow, rhi, bh, ab2);
                LDS_WAIT();
                const float lo = -R + (float)bl * w0, hi = (rhi >= 1) ? (-R + (float)(bh + 1) * w0) : (R * 1.001f);
                const float s1 = 256.f / (hi - lo);
                for (int i = lane; i < 16 * SEL_HROW; i += 64) hist[i] = 0u;
                LDS_WAIT();
                sel_pass<1>(KIb, qb, wv, nkb, tq, r, g, lane, hrow, s1, -lo * s1, nullptr);
                LDS_WAIT();
                const int above = (int)hrow[257]; int inr = 0;
#pragma unroll 8
                for (int bin = 1; bin <= 256; ++bin) inr += (int)hrow[bin];
                const bool ok = above < 256 && above + inr >= 256;
                if (ok) { int sel1, ab1; sel_scan(hrow + 1, 256 - above, sel1, ab1); thr_f = lo + (float)sel1 * ((hi - lo) * (1.f / 256.f)); }
                LDS_WAIT();
                done = __all(ok);
            }
            if (!done) {
                for (int i = lane; i < 16 * SEL_HROW; i += 64) hist[i] = 0u;
                LDS_WAIT();
                sel_pass<0>(KIb, qb, wv, nkb, tq, r, g, lane, hrow, s0, 128.f, nullptr);
                LDS_WAIT();
                int sel0, above0; sel_scan(hrow, 256, sel0, above0);
                LDS_WAIT();
                const float lo0 = -R + (float)sel0 * w0, s1 = 256.f / w0;
                for (int i = lane; i < 16 * SEL_HROW; i += 64) hist[i] = 0u;
                LDS_WAIT();
                sel_pass<1>(KIb, qb, wv, nkb, tq, r, g, lane, hrow, s1, -lo0 * s1, nullptr);
                LDS_WAIT();
                int sel1, above1; sel_scan(hrow + 1, 256 - above0, sel1, above1);
                LDS_WAIT();
                thr_f = lo0 + (float)sel1 * (w0 * (1.f / 256.f));
            }
            if (n <= 256) thr_f = -__builtin_inff();
        }
        sel_pass<2>(KIb, qb, wv, nkb, tq, r, g, lane, hrow, 0.f, thr_f, MASK + mask_row(l, b, qt) * 8);
    }
}

constexpr int AT_ROW = 144;
constexpr int AT_TILE = 64 * AT_ROW;
constexpr int AT_NQT = (L - 16) / 256;
constexpr int AT_NKT = (L + 63) / 64;
static_assert(16 + AT_NQT * 256 == L, "query tiling");
__device__ PHASE_FN void dsa_attn_phase(const Ctx A, LAS unsigned char* lds, int l) {
    const int tid = opaque_tid(), lane = tid & 63, wave = tid >> 6, r = lane & 15, g = lane >> 4;
    const bf16* DQ = (const bf16*)(A.ws + WS_DS_Q); const bf16* DK = (const bf16*)(A.ws + WS_DS_K); const bf16* DV = (const bf16*)(A.ws + WS_DS_V);
    const u64* MASK = (const u64*)(A.ws + WS_MASK); bf16* MIX = (bf16*)(A.ws + WS_MIX);
    unsigned* qhead = (unsigned*)(A.ws + WS_CTL) + CW_DSAQ + 64 * l + 16;
    const unsigned* kmaxw = (const unsigned*)(A.ws + WS_CTL) + CW_KMAX + 64 * l;
    LAS unsigned* unitw = (LAS unsigned*)(lds + MISC_OFF + MI_UNIT);
    const int ldkey = tid >> 3, ldch = tid & 7;
    for (;;) {
        __syncthreads();
        if (tid == 0) unitw[0] = atomicAdd(qhead, 1u);
        __syncthreads();
        const unsigned u = unitw[0];
        if (u >= (unsigned)(NB * 4 * (AT_NQT + 1))) break;
        const bool mini = u >= (unsigned)(NB * 4 * AT_NQT);
        const int qt = mini ? 0 : AT_NQT - 1 - (int)(u >> 5), b = (int)((u & 31u) >> 2), h = (int)(u & 3u);
        const size_t mb = (size_t)b * L;
        const int kmain = mini ? 0 : 4 * qt;
        const int nkt = mini ? 1 : ((4 * qt + 5 < AT_NKT) ? 4 * qt + 5 : AT_NKT);
        const float kmax2 = __uint_as_float(__hip_atomic_load(kmaxw + b * 4 + h, __ATOMIC_RELAXED, __HIP_MEMORY_SCOPE_AGENT));
        int tq[2], lb[2]; bool act[2];
        s8 qf[2][2]; float nc2[2];
        const GAS unsigned* mrow[2];
#pragma unroll
        for (int qi = 0; qi < 2; ++qi) { act[qi] = mini ? (wave == 0 && qi == 0) : true; tq[qi] = mini ? 0 : 16 + qt * 256 + wave * 32 + 16 * qi;
            lb[qi] = __builtin_amdgcn_readfirstlane(act[qi] ? ((tq[qi] + 15) >> 5) : -1);
            float qn2 = 0.f;
#pragma unroll
            for (int ks = 0; ks < 2; ++ks) { qf[qi][ks] = act[qi] ? *(const s8*)(DQ + (mb + tq[qi] + r) * 256 + h * 64 + 32 * ks + 8 * g) : (s8){0, 0, 0, 0, 0, 0, 0, 0};
#pragma unroll
                for (int e = 0; e < 8; ++e) { const float x = bf2f((unsigned short)qf[qi][ks][e]); qn2 += x * x; } }
            qn2 += __shfl_xor(qn2, 16); qn2 += __shfl_xor(qn2, 32);
            nc2[qi] = -sqrtf(qn2 * kmax2);
            const u64 mrow_u = (u64)(MASK + mask_row(l, b, tq[qi] >> 4) * 8);
            const unsigned lo = (unsigned)__builtin_amdgcn_readfirstlane((unsigned)mrow_u), hi = (unsigned)__builtin_amdgcn_readfirstlane((unsigned)(mrow_u >> 32));
            mrow[qi] = (const GAS unsigned*)(((u64)hi << 32) | (u64)lo); }
        pg8::f32x4 O[2][4], Ls[2];
#pragma unroll
        for (int qi = 0; qi < 2; ++qi) { Ls[qi] = (pg8::f32x4){0.f, 0.f, 0.f, 0.f};
#pragma unroll
            for (int db = 0; db < 4; ++db) O[qi][db] = (pg8::f32x4){0.f, 0.f, 0.f, 0.f}; }
        const s8 ones8 = (s8){0x3F80, 0x3F80, 0x3F80, 0x3F80, 0x3F80, 0x3F80, 0x3F80, 0x3F80};
#define AT_SLOAD(dst, qi_, kb_) asm volatile("s_load_dwordx16 %0, %1, 0x0" : "=s"(dst) : "s"(mrow[qi_] + (size_t)(kb_) * 16))
#define AT_MWAIT(m0_, m1_) asm volatile("s_waitcnt lgkmcnt(0)" : "+s"(m0_), "+s"(m1_))
#define AT_MWAIT_S2(a0_, a1_, b0_, b1_) asm volatile("s_waitcnt lgkmcnt(0)" : "+s"(a0_), "+s"(a1_), "+s"(b0_), "+s"(b1_), "+v"(Sa), "+v"(Sb), "+v"(Sc), "+v"(Sd), "+v"(Se), "+v"(Sf), "+v"(Sg), "+v"(Sh) :: "memory")
#define AT_MWAIT_O(a0_, a1_, b0_, b1_) asm volatile("s_waitcnt lgkmcnt(0)" : "+s"(a0_), "+s"(a1_), "+s"(b0_), "+s"(b1_), "+v"(O[1][0]), "+v"(O[1][1]), "+v"(O[1][2]), "+v"(O[1][3]), "+v"(Ls[1]) :: "memory")
        const bf16* kg = DK + (mb + ldkey) * 256 + h * 64 + ldch * 8; const bf16* vg = DV + (mb + ldkey) * 256 + h * 64 + ldch * 8;
        v4u rk0 = *(const v4u*)kg, rv0 = *(const v4u*)vg;
        const size_t to1 = (size_t)(nkt > 1 ? 1 : nkt - 1) * 64 * 256, to2 = (size_t)(nkt > 2 ? 2 : nkt - 1) * 64 * 256, to3 = (size_t)(nkt > 3 ? 3 : nkt - 1) * 64 * 256;
        v4u rk1 = *(const v4u*)(kg + to1), rv1 = *(const v4u*)(vg + to1), rk2 = *(const v4u*)(kg + to2), rv2 = *(const v4u*)(vg + to2), rk3 = *(const v4u*)(kg + to3), rv3 = *(const v4u*)(vg + to3);
        u16v m0, m1, n0, n1;
#define AT_STORE(boff, rk, rv) do { LAS unsigned char* kb_ = lds + (boff); LAS unsigned char* vb_ = kb_ + AT_TILE; \
            *(LAS v4u*)(kb_ + ldkey * AT_ROW + ldch * 16) = rk; *(LAS v4u*)(vb_ + ldkey * AT_ROW + ldch * 16) = rv; } while (0)
#define AT_LOAD(kt_, rk, rv) do { rk = *(const v4u*)(kg + (size_t)(kt_) * 64 * 256); rv = *(const v4u*)(vg + (size_t)(kt_) * 64 * 256); } while (0)
#define AT_KREAD(boff, blk) do { const LAS unsigned char* ka = lds + (boff) + ((blk) * 32 + 8 * (r >> 2) + (r & 3)) * AT_ROW + g * 16; \
            _Pragma("unroll") for (int ks = 0; ks < 2; ++ks) { kf[blk][ks][0] = *(const LAS s8*)(ka + ks * 64); kf[blk][ks][1] = *(const LAS s8*)(ka + 4 * AT_ROW + ks * 64); } } while (0)
#define AT_VREAD(boff, blk) do { const LAS unsigned char* va = lds + (boff) + AT_TILE + ((blk) * 32 + 8 * g + (r >> 2)) * AT_ROW + (r & 3) * 8; \
            _Pragma("unroll") for (int db = 0; db < 4; ++db) { \
                const v4i16_t x0 = __builtin_amdgcn_ds_read_tr16_b64_v4i16((LAS v4i16_t*)(va + db * 32)), x1 = __builtin_amdgcn_ds_read_tr16_b64_v4i16((LAS v4i16_t*)(va + 4 * AT_ROW + db * 32)); \
                vf[blk][db] = (s8){x0[0], x0[1], x0[2], x0[3], x1[0], x1[1], x1[2], x1[3]}; } } while (0)
#define AT_BLK_S(blk, qi, S1, S2) do { S1 = (pg8::f32x4){nc2[qi], nc2[qi], nc2[qi], nc2[qi]}; S2 = S1; \
            _Pragma("unroll") for (int ks = 0; ks < 2; ++ks) { \
                S1 = __builtin_amdgcn_mfma_f32_16x16x32_bf16(kf[blk][ks][0], qf[qi][ks], S1, 0, 0, 0); S2 = __builtin_amdgcn_mfma_f32_16x16x32_bf16(kf[blk][ks][1], qf[qi][ks], S2, 0, 0, 0); } } while (0)
#define AT_BLK_P(mq, S1, S2, pa) do { float p[8]; \
            _Pragma("unroll") for (int j = 0; j < 8; ++j) { \
                const bool bit = __builtin_amdgcn_inverse_ballot_w64(((u64)mq[2 * j + 1] << 32) | mq[2 * j]); \
                p[j] = bit ? __builtin_amdgcn_exp2f(j < 4 ? S1[j & 3] : S2[j & 3]) : 0.f; } \
            v4u pk; pk.x = pk2(p[0], p[1]); pk.y = pk2(p[2], p[3]); pk.z = pk2(p[4], p[5]); pk.w = pk2(p[6], p[7]); \
            pa = __builtin_bit_cast(s8, pk); } while (0)
#define AT_BLK_V(blk, qi, pa) do { \
            _Pragma("unroll") for (int db = 0; db < 4; ++db) O[qi][db] = __builtin_amdgcn_mfma_f32_16x16x32_bf16(pa, vf[blk][db], O[qi][db], 0, 0, 0); \
            Ls[qi] = __builtin_amdgcn_mfma_f32_16x16x32_bf16(pa, ones8, Ls[qi], 0, 0, 0); } while (0)
#define AT_ROTATE do { const int t_ = bc; bc = bn; bn = bs; bs = t_; } while (0)
#define AT_MAIN_BODY(kt, RK_LD, RV_LD, RK_ST, RV_ST, LASTWAIT) do { \
            { const int ktn_ = (kt) + 5 < nkt ? (kt) + 5 : nkt - 1; AT_LOAD(ktn_, RK_LD, RV_LD); } \
            AT_STORE(bs, RK_ST, RV_ST); \
            pg8::f32x4 Sa, Sb, Sc, Sd, Se, Sf, Sg, Sh; s8 pa0, pa1, pb0, pb1; \
            AT_BLK_S(0, 0, Sa, Sb); AT_BLK_S(1, 0, Sc, Sd); AT_BLK_S(0, 1, Se, Sf); AT_BLK_S(1, 1, Sg, Sh);        \
            AT_MWAIT_S2(m0, m1, n0, n1); \
            AT_KREAD(bn, 0); AT_KREAD(bn, 1); \
            AT_BLK_P(m0, Sa, Sb, pa0); AT_SLOAD(m0, 0, 2 * (kt) + 2); AT_BLK_P(m1, Sc, Sd, pa1); AT_SLOAD(m1, 0, 2 * (kt) + 3); \
            AT_BLK_V(0, 0, pa0); AT_BLK_V(1, 0, pa1); \
            AT_BLK_P(n0, Se, Sf, pb0); AT_SLOAD(n0, 1, 2 * (kt) + 2); AT_BLK_P(n1, Sg, Sh, pb1); AT_SLOAD(n1, 1, 2 * (kt) + 3); \
            AT_BLK_V(0, 1, pb0); AT_BLK_V(1, 1, pb1); \
            if (LASTWAIT) AT_MWAIT_O(m0, m1, n0, n1);                   \
            AT_VREAD(bn, 0); AT_VREAD(bn, 1); \
            AT_ROTATE; \
            __builtin_amdgcn_s_barrier(); } while (0)
#define AT_DIAG_STEP(kt, qi) do { \
            if (2 * (kt) + 1 <= lb[qi]) { pg8::f32x4 Sa, Sb, Sc, Sd; s8 pa0, pa1; AT_SLOAD(m0, qi, 2 * (kt)); AT_SLOAD(m1, qi, 2 * (kt) + 1); \
                AT_BLK_S(0, qi, Sa, Sb); AT_BLK_S(1, qi, Sc, Sd); AT_MWAIT(m0, m1); AT_BLK_P(m0, Sa, Sb, pa0); AT_BLK_P(m1, Sc, Sd, pa1); AT_BLK_V(0, qi, pa0); AT_BLK_V(1, qi, pa1); } \
            else if (2 * (kt) <= lb[qi]) { pg8::f32x4 Sa, Sb; s8 pa0; AT_SLOAD(m0, qi, 2 * (kt)); AT_SLOAD(m1, qi, 2 * (kt)); \
                AT_BLK_S(0, qi, Sa, Sb); AT_MWAIT(m0, m1); AT_BLK_P(m0, Sa, Sb, pa0); AT_BLK_V(0, qi, pa0); } } while (0)
#define AT_DIAG_BODY(kt, RK_LD, RV_LD, RK_ST, RV_ST) do { \
            { const int ktn_ = (kt) + 5 < nkt ? (kt) + 5 : nkt - 1; AT_LOAD(ktn_, RK_LD, RV_LD); } \
            AT_STORE(bs, RK_ST, RV_ST); \
            if (2 * (kt) <= lb[1] || 2 * (kt) <= lb[0]) { \
                AT_KREAD(bc, 0); AT_KREAD(bc, 1); AT_VREAD(bc, 0); AT_VREAD(bc, 1); \
                AT_DIAG_STEP(kt, 0); AT_DIAG_STEP(kt, 1); } \
            asm volatile("s_waitcnt lgkmcnt(0)" ::: "memory"); \
            AT_ROTATE; \
            __builtin_amdgcn_s_barrier(); } while (0)
        int bc = 0, bn = 2 * AT_TILE, bs = 4 * AT_TILE;
        s8 kf[2][2][2], vf[2][4];
        AT_SLOAD(m0, 0, 0); AT_SLOAD(m1, 0, 1); AT_SLOAD(n0, 1, 0); AT_SLOAD(n1, 1, 1);
        AT_STORE(bc, rk0, rv0);
        AT_STORE(bn, rk1, rv1);
        AT_LOAD(nkt > 4 ? 4 : nkt - 1, rk0, rv0);
        AT_MWAIT(m0, m1); AT_MWAIT(n0, n1);
        __syncthreads();
        AT_KREAD(bc, 0); AT_KREAD(bc, 1); AT_VREAD(bc, 0); AT_VREAD(bc, 1);
#pragma unroll 1
        for (int kt = 0; kt < kmain; kt += 4) {
            AT_MAIN_BODY(kt, rk1, rv1, rk2, rv2, false);
            AT_MAIN_BODY(kt + 1, rk2, rv2, rk3, rv3, false);
            AT_MAIN_BODY(kt + 2, rk3, rv3, rk0, rv0, false);
            AT_MAIN_BODY(kt + 3, rk0, rv0, rk1, rv1, true);
        }
#pragma unroll 1
        for (int kt = kmain; kt < nkt; kt += 4) {
            AT_DIAG_BODY(kt, rk1, rv1, rk2, rv2);
            AT_DIAG_BODY(kt + 1, rk2, rv2, rk3, rv3);
            AT_DIAG_BODY(kt + 2, rk3, rv3, rk0, rv0);
            AT_DIAG_BODY(kt + 3, rk0, rv0, rk1, rv1);
        }
#undef AT_ROTATE
#undef AT_MAIN_BODY
#undef AT_DIAG_BODY
#undef AT_DIAG_STEP
#undef AT_BLK_S
#undef AT_BLK_P
#undef AT_BLK_V
#undef AT_KREAD
#undef AT_VREAD
#undef AT_SLOAD
#undef AT_MWAIT
#undef AT_MWAIT_S2
#undef AT_MWAIT_O
#undef AT_LOAD
#undef AT_STORE
#pragma unroll
        for (int qi = 0; qi < 2; ++qi)
#pragma unroll
            for (int j = 0; j < 4; ++j) { const float ij = Ls[qi][j] > 0.f ? 1.f / Ls[qi][j] : 0.f; const int t = tq[qi] + 4 * g + j;
                if (act[qi]) {
#pragma unroll
                    for (int db = 0; db < 4; ++db) MIX[(mb + t) * 1024 + 256 + h * 64 + db * 16 + r] = f2bf(O[qi][db][j] * ij); } }
    }
}
constexpr int CK = 16;
constexpr int NCHK = L / CK;
static_assert(L % CK == 0, "chunk length");
constexpr int CKP_RW = 10, CKP_HG = 7;
constexpr int CKR_RW = CKP_RW * 1024 + 512, CKR_HG = CKP_HG * 1024 + 256;
constexpr size_t WS_CKF_RW = WS_PROJ + 136 * MiB;
constexpr size_t WS_CKF_HG = WS_CKF_RW + (size_t)32 * NCHK * CKR_RW;
static_assert(WS_CKF_HG + (size_t)32 * NCHK * CKR_HG <= WS_PROJ + (size_t)TP * NINP * 2, "chunk fragments fit in the dead proj region");
__device__ __forceinline__ s8 pack8(const pg8::f32x4 lo, const pg8::f32x4 hi) { v4u p; p.x = pk2(lo[0], lo[1]); p.y = pk2(lo[2], lo[3]); p.z = pk2(hi[0], hi[1]); p.w = pk2(hi[2], hi[3]); return __builtin_bit_cast(s8, p); }
template <int CTRL> __device__ __forceinline__ float dpp_shr1(float x) { return __int_as_float(__builtin_amdgcn_update_dpp(0x3F800000, __float_as_int(x), CTRL, 0xF, 0xF, false)); }
__device__ __forceinline__ float row_cumprod(float x) { x *= dpp_shr1<0x111>(x); x *= dpp_shr1<0x112>(x); x *= dpp_shr1<0x114>(x); x *= dpp_shr1<0x118>(x); return x; }

template <bool RWKV>
__device__ __forceinline__ void chunk_prep_item(const Ctx A, int bh, int c, int lane) {
    const int r = lane & 15, g = lane >> 4;
    const size_t base = ((size_t)bh * L + (size_t)c * CK + r) * 64;
    const float* Wg = (const float*)(A.ws + (RWKV ? WS_RW_W : WS_HG_F)) + base;
    const bf16* Ag = (const bf16*)(A.ws + WS_RW_A) + base; const bf16* Bg = (const bf16*)(A.ws + WS_RW_B) + base;
    const bf16* Kg = (const bf16*)(A.ws + (RWKV ? WS_RW_K : WS_HG_K)) + base; const bf16* Rg = (const bf16*)(A.ws + (RWKV ? WS_RW_WR : WS_HG_Q)) + base;
    GAS unsigned char* recb = A.ws + (RWKV ? WS_CKF_RW : WS_CKF_HG) + ((size_t)bh * NCHK + c) * (RWKV ? CKR_RW : CKR_HG);
    v4u* REC = (v4u*)recb + lane; v4f* GCp = (v4f*)(recb + (RWKV ? CKP_RW : CKP_HG) * 1024); float* Dp = (float*)(recb + CKP_RW * 1024 + 256);
    s8 Af[2], Bf[2], Kf[2], Rf[2], BTf[2], KTf[2];
    v4f gcv[4];
#pragma unroll
    for (int ks = 0; ks < 2; ++ks) {
        pg8::f32x4 ah[2], bh_[2], kh[2], rh[2], bt[2], kt[2];
#pragma unroll
        for (int hf = 0; hf < 2; ++hf) {
            const int k0 = 32 * ks + 16 * hf + 4 * g;
            const v4f w4 = *(const v4f*)(Wg + k0);
            v4f gt, gm, gc;
#pragma unroll
            for (int e = 0; e < 4; ++e) { gt[e] = row_cumprod(w4[e]); gm[e] = dpp_shr1<0x111>(gt[e]); gc[e] = __shfl(gt[e], 16 * g + 15); }
            gcv[2 * ks + hf] = gc;
            v4f inv; inv.x = __builtin_amdgcn_rcpf(gt.x); inv.y = __builtin_amdgcn_rcpf(gt.y); inv.z = __builtin_amdgcn_rcpf(gt.z); inv.w = __builtin_amdgcn_rcpf(gt.w);
            const v4f kk4 = ld_bf4(Kg + k0) * inv, rr4 = ld_bf4(Rg + k0) * (RWKV ? gm : gt);
            kh[hf] = kk4; rh[hf] = rr4; kt[hf] = kk4 * gc;
            if (RWKV) { ah[hf] = ld_bf4(Ag + k0) * gm; bh_[hf] = ld_bf4(Bg + k0) * inv; bt[hf] = bh_[hf] * gc; }
        }
        Kf[ks] = pack8(kh[0], kh[1]); Rf[ks] = pack8(rh[0], rh[1]); KTf[ks] = pack8(kt[0], kt[1]);
        if (RWKV) { Af[ks] = pack8(ah[0], ah[1]); Bf[ks] = pack8(bh_[0], bh_[1]); BTf[ks] = pack8(bt[0], bt[1]); }
    }
    const pg8::f32x4 z4 = (pg8::f32x4){0.f, 0.f, 0.f, 0.f};
    s8 selE, selO;
    { v4u e = (v4u){0u, 0u, 0u, 0u}, o = e; const int jj = r - 4 * g;
      if (jj >= 0 && jj < 4) { const unsigned one = 0x3F80u << (16 * (jj & 1)); if (jj < 2) { e.x = one; o.z = one; } else { e.y = one; o.w = one; } }
      selE = __builtin_bit_cast(s8, e); selO = __builtin_bit_cast(s8, o); }
    pg8::f32x4 MrkT = __builtin_amdgcn_mfma_f32_16x16x32_bf16(Kf[0], Rf[0], z4, 0, 0, 0); MrkT = __builtin_amdgcn_mfma_f32_16x16x32_bf16(Kf[1], Rf[1], MrkT, 0, 0, 0);
    const int tb = r >> 2, tj = r & 3;
    if (RWKV) {
        pg8::f32x4 LabT = __builtin_amdgcn_mfma_f32_16x16x32_bf16(Bf[0], Af[0], z4, 0, 0, 0); LabT = __builtin_amdgcn_mfma_f32_16x16x32_bf16(Bf[1], Af[1], LabT, 0, 0, 0);
        pg8::f32x4 LakT = __builtin_amdgcn_mfma_f32_16x16x32_bf16(Kf[0], Af[0], z4, 0, 0, 0); LakT = __builtin_amdgcn_mfma_f32_16x16x32_bf16(Kf[1], Af[1], LakT, 0, 0, 0);
        pg8::f32x4 MrbT = __builtin_amdgcn_mfma_f32_16x16x32_bf16(Bf[0], Rf[0], z4, 0, 0, 0); MrbT = __builtin_amdgcn_mfma_f32_16x16x32_bf16(Bf[1], Rf[1], MrbT, 0, 0, 0);
        const float d10 = __shfl(LabT[0], 20 * g + 1), d20 = __shfl(LabT[0], 20 * g + 2), d21 = __shfl(LabT[1], 20 * g + 2);
        const float d30 = __shfl(LabT[0], 20 * g + 3), d31 = __shfl(LabT[1], 20 * g + 3), d32 = __shfl(LabT[2], 20 * g + 3);
        pg8::f32x4 Loff, Lak, Mrb, Mrk;
#pragma unroll
        for (int j = 0; j < 4; ++j) { const bool below = g < tb, diag = g == tb;
            Loff[j] = below ? LabT[j] : 0.f; Lak[j] = (below || (diag && j < tj)) ? LakT[j] : 0.f;
            Mrb[j] = (below || (diag && j <= tj)) ? MrbT[j] : 0.f; Mrk[j] = (below || (diag && j <= tj)) ? MrkT[j] : 0.f; }
        REC[0 * 64] = __builtin_bit_cast(v4u, Af[0]); REC[1 * 64] = __builtin_bit_cast(v4u, Af[1]); REC[2 * 64] = __builtin_bit_cast(v4u, Rf[0]); REC[3 * 64] = __builtin_bit_cast(v4u, Rf[1]);
        REC[4 * 64] = __builtin_bit_cast(v4u, pack8(Loff, Lak)); REC[5 * 64] = __builtin_bit_cast(v4u, pack8(Mrb, Mrk));
        if (r == 0) { *(v4f*)(Dp + 8 * g) = (v4f){d10, d20, d21, d30}; *(v4f*)(Dp + 8 * g + 4) = (v4f){d31, d32, 0.f, 0.f}; }
#pragma unroll
        for (int mt = 0; mt < 4; ++mt) { const s8 sel = (mt & 1) ? selO : selE;
            const pg8::f32x4 K2 = __builtin_amdgcn_mfma_f32_16x16x32_bf16(KTf[mt >> 1], sel, z4, 0, 0, 0), B2 = __builtin_amdgcn_mfma_f32_16x16x32_bf16(BTf[mt >> 1], sel, z4, 0, 0, 0);
            REC[(6 + mt) * 64] = __builtin_bit_cast(v4u, pack8(B2, K2)); if (r == 15) GCp[4 * mt + g] = gcv[mt]; }
    } else {
        pg8::f32x4 Mrk;
#pragma unroll
        for (int j = 0; j < 4; ++j) Mrk[j] = (g < tb || (g == tb && j <= tj)) ? MrkT[j] : 0.f;
        REC[0 * 64] = __builtin_bit_cast(v4u, Rf[0]); REC[1 * 64] = __builtin_bit_cast(v4u, Rf[1]); REC[2 * 64] = __builtin_bit_cast(v4u, pack8(z4, Mrk));
#pragma unroll
        for (int mt = 0; mt < 4; ++mt) { const s8 sel = (mt & 1) ? selO : selE;
            const pg8::f32x4 K2 = __builtin_amdgcn_mfma_f32_16x16x32_bf16(KTf[mt >> 1], sel, z4, 0, 0, 0);
            REC[(3 + mt) * 64] = __builtin_bit_cast(v4u, pack8(z4, K2)); if (r == 15) GCp[4 * mt + g] = gcv[mt]; }
    }
}
__device__ PHASE_FN void chunk_prep_phase(const Ctx A, int vcu, int G) {
    const int tid = opaque_tid(), lane = tid & 63, wave = tid >> 6;
    const int gw = vcu * NWAVES + wave, NGW = G * NWAVES;
#pragma unroll 1
    for (int it = gw; it < 2 * 32 * NCHK; it += NGW) {
        const int mix = it >= 32 * NCHK, q = mix ? it - 32 * NCHK : it, bh = q / NCHK, c = q - bh * NCHK;
        if (mix) chunk_prep_item<false>(A, bh, c, lane); else chunk_prep_item<true>(A, bh, c, lane);
    }
}
template <bool RWKV>
__device__ PHASE_FN void chunk_scan(const Ctx A, LAS unsigned char* lds, int unit_) {
    const int unit = opaque_s(unit_);
    const int tid = opaque_tid(), lane = tid & 63, wave = tid >> 6, r = lane & 15, g = lane >> 4;
    const int slot = wave >> 2, nt = wave & 3;
    const int bh = 2 * unit + slot, b = bh >> 2, h = bh & 3;
    constexpr int NP = RWKV ? CKP_RW : CKP_HG;
    constexpr int NU = NP + 3;
    constexpr int NQ = (NU + 3) / 4;
    constexpr int RING = NU * 1024;
    constexpr size_t RB = RWKV ? CKR_RW : CKR_HG;
    const GAS unsigned char* recb = A.ws + (RWKV ? WS_CKF_RW : WS_CKF_HG) + (size_t)bh * NCHK * RB;
    const GAS unsigned char* vb = A.ws + (RWKV ? WS_RW_V : WS_HG_V) + (size_t)bh * L * 128;
    float* YR = (float*)(A.ws + (RWKV ? WS_YRAW : WS_ORAW)) + (size_t)b * L * 256 + h * 64 + nt * 16 + r;
    LAS unsigned char* ring = lds + slot * 2 * RING;
    static_assert(4 * (size_t)(CKP_RW + 3) * 1024 <= MISC_OFF, "chunk ring");
    auto unit_src = [&](int c_, int u) -> const GAS v4u* {
        if (u < NP) return (const GAS v4u*)(recb + (size_t)c_ * RB + u * 1024) + lane;
        if (u == NP) { const int q = lane * 16 < (int)(RB - NP * 1024) ? lane * 16 : (int)(RB - NP * 1024) - 16; return (const GAS v4u*)(recb + (size_t)c_ * RB + NP * 1024 + q); }
        return (const GAS v4u*)(vb + (size_t)c_ * CK * 128 + (u - NP - 1) * 1024) + lane; };
    v4u st0[NQ], st1[NQ], st2[NQ], st3[NQ];
#define CK_LD(S, c_) do { const int cc_ = (c_) < NCHK ? (c_) : NCHK - 1; _Pragma("unroll") for (int q = 0; q < NQ; ++q) { const int u = nt + 4 * q; if (u < NU) S[q] = *unit_src(cc_, u); } } while (0)
#define CK_ST(S, p_) do { _Pragma("unroll") for (int q = 0; q < NQ; ++q) { const int u = nt + 4 * q; if (u < NU) *(LAS v4u*)(ring + (p_) * RING + u * 1024 + lane * 16) = S[q]; } } while (0)
    pg8::f32x4 ST[4];
#pragma unroll
    for (int mt = 0; mt < 4; ++mt) ST[mt] = (pg8::f32x4){0.f, 0.f, 0.f, 0.f};
    const pg8::f32x4 z4 = (pg8::f32x4){0.f, 0.f, 0.f, 0.f};
    auto body = [&](const int c, const int p) __attribute__((always_inline)) {
        const LAS unsigned char* rb_ = ring + p * RING;
        const LAS unsigned char* sm = rb_ + NP * 1024;
        v4u pcs[NP]; v4f gqs[4]; v4f da = (v4f){0.f, 0.f, 0.f, 0.f}, db = da;
#pragma unroll
        for (int i = 0; i < NP; ++i) pcs[i] = *(const LAS v4u*)(rb_ + i * 1024 + lane * 16);
#pragma unroll
        for (int mt = 0; mt < 4; ++mt) gqs[mt] = *(const LAS v4f*)(sm + (16 * mt + 4 * g) * 4);
        if (RWKV) { da = *(const LAS v4f*)(sm + 256 + g * 32); db = *(const LAS v4f*)(sm + 256 + g * 32 + 16); }
#define PIECE(i) __builtin_bit_cast(s8, pcs[i])
        unsigned vp0, vp1;
        { const LAS unsigned short* vv = (const LAS unsigned short*)(rb_ + (NP + 1) * 1024) + (4 * g) * 64 + 16 * nt + r;
          vp0 = (unsigned)vv[0] | ((unsigned)vv[64] << 16); vp1 = (unsigned)vv[128] | ((unsigned)vv[192] << 16); }
        __builtin_amdgcn_sched_barrier(0);
        const s8 Sf0 = pack8(ST[0], ST[1]), Sf1 = pack8(ST[2], ST[3]);
        pg8::f32x4 U = z4, R0;
        if (RWKV) {
            R0 = __builtin_amdgcn_mfma_f32_16x16x32_bf16(PIECE(2), Sf0, z4, 0, 0, 0); R0 = __builtin_amdgcn_mfma_f32_16x16x32_bf16(PIECE(3), Sf1, R0, 0, 0, 0);
            pg8::f32x4 W0 = __builtin_amdgcn_mfma_f32_16x16x32_bf16(PIECE(0), Sf0, z4, 0, 0, 0); W0 = __builtin_amdgcn_mfma_f32_16x16x32_bf16(PIECE(1), Sf1, W0, 0, 0, 0);
            const float d10 = da.x, d20 = da.y, d21 = da.z, d30 = da.w, d31 = db.x, d32 = db.y;
            const s8 Ajac = PIECE(4);
#pragma unroll
            for (int rnd = 0; rnd < 4; ++rnd) {
                v4u bu; bu.x = pk2(U[0], U[1]); bu.y = pk2(U[2], U[3]); bu.z = vp0; bu.w = vp1;
                const pg8::f32x4 Wr = __builtin_amdgcn_mfma_f32_16x16x32_bf16(Ajac, __builtin_bit_cast(s8, bu), W0, 0, 0, 0);
                U[0] = Wr[0]; U[1] = Wr[1] + d10 * U[0]; U[2] = Wr[2] + d20 * U[0] + d21 * U[1]; U[3] = Wr[3] + d30 * U[0] + d31 * U[1] + d32 * U[2];
            }
        } else {
            R0 = __builtin_amdgcn_mfma_f32_16x16x32_bf16(PIECE(0), Sf0, z4, 0, 0, 0); R0 = __builtin_amdgcn_mfma_f32_16x16x32_bf16(PIECE(1), Sf1, R0, 0, 0, 0);
        }
        v4u buv; buv.x = pk2(U[0], U[1]); buv.y = pk2(U[2], U[3]); buv.z = vp0; buv.w = vp1;
        const s8 Buv = __builtin_bit_cast(s8, buv);
        const pg8::f32x4 Yt = __builtin_amdgcn_mfma_f32_16x16x32_bf16(PIECE(RWKV ? 5 : 2), Buv, R0, 0, 0, 0);
#pragma unroll
        for (int j = 0; j < 4; ++j) YR[(size_t)(c * CK + 4 * g + j) * 256] = Yt[j];
#pragma unroll
        for (int mt = 0; mt < 4; ++mt) {
            const v4f gq = gqs[mt];
            ST[mt][0] *= gq.x; ST[mt][1] *= gq.y; ST[mt][2] *= gq.z; ST[mt][3] *= gq.w;
            ST[mt] = __builtin_amdgcn_mfma_f32_16x16x32_bf16(PIECE((RWKV ? 6 : 3) + mt), Buv, ST[mt], 0, 0, 0);
        }
#undef PIECE
    };
    CK_LD(st0, 0); CK_LD(st1, 1); CK_LD(st2, 2); CK_LD(st3, 3);
    CK_ST(st0, 0);
    __syncthreads();
#define CK_TRIP(c_, SLD, SST, p_) do { CK_LD(SLD, (c_) + 4); body((c_), (p_)); CK_ST(SST, 1 - (p_)); __syncthreads(); } while (0)
    static_assert(NCHK % 4 == 1, "chunk loop: whole groups of four trips + one");
#pragma unroll 1
    for (int c = 0; c < NCHK - 1; c += 4) {
        CK_TRIP(c, st0, st1, 0);
        CK_TRIP(c + 1, st1, st2, 1);
        CK_TRIP(c + 2, st2, st3, 0);
        CK_TRIP(c + 3, st3, st0, 1);
    }
    CK_TRIP(NCHK - 1, st0, st1, 0);
#undef CK_TRIP
#undef CK_LD
#undef CK_ST
}
__device__ __forceinline__ float rowmax16(float x) { x = fmaxf(x, dpp_f<0xB1>(x)); x = fmaxf(x, dpp_f<0x4E>(x)); x = fmaxf(x, dpp_f<0x141>(x)); x = fmaxf(x, dpp_f<0x140>(x)); return x; }
__device__ __forceinline__ int rowmin16i(int x) { x = min(x, __builtin_amdgcn_update_dpp(0, x, 0xB1, 0xF, 0xF, true)); x = min(x, __builtin_amdgcn_update_dpp(0, x, 0x4E, 0xF, 0xF, true));
    x = min(x, __builtin_amdgcn_update_dpp(0, x, 0x141, 0xF, 0xF, true)); x = min(x, __builtin_amdgcn_update_dpp(0, x, 0x140, 0xF, 0xF, true)); return x; }
__device__ PHASE_FN void ln_router_phase(const Ctx A, LAS unsigned char* lds, int l, int vcu, int G) {
    const int tid = opaque_tid(), lane = tid & 63, wave = tid >> 6, r = lane & 15, g = lane >> 4;
    const int gw = vcu * NWAVES + wave, NGW = G * NWAVES;
    bf16* HB = (bf16*)(A.ws + WS_HB);
    int* TIDX = (int*)(A.ws + WS_TIDX); float* TGATE = (float*)(A.ws + WS_TGATE);
    unsigned* ecnt = (unsigned*)(A.ws + WS_CTL) + CW_ECNT + 64 * l;
    const float* gg = gin(A, 26) + l * D; const float* bb = gin(A, 27) + l * D;
    const float* rw = gin(A, 28) + (size_t)l * D * NE; const float* rb = gin(A, 29) + l * NE;
    LAS int* hist = (LAS int*)(lds + MISC_OFF + MI_HIST);
    if (tid < 32) hist[tid] = 0;
    for (int f = tid; f < 32 * 2 * 64; f += NTHR) { const int ks = f >> 7, nt = (f >> 6) & 1, ln = f & 63, n = ln & 15, g8 = ln >> 4;
        float w8[8];
#pragma unroll
        for (int e = 0; e < 8; ++e) w8[e] = rw[(size_t)(32 * ks + 8 * g8 + e) * NE + 16 * nt + n];
        v4u hi, lo; unsigned hh[4], ll[4];
#pragma unroll
        for (int e = 0; e < 4; ++e) { const unsigned ph = pk2(w8[2 * e], w8[2 * e + 1]); hh[e] = ph; ll[e] = pk2(w8[2 * e] - bflo(ph), w8[2 * e + 1] - bfhi(ph)); }
        hi = (v4u){hh[0], hh[1], hh[2], hh[3]}; lo = (v4u){ll[0], ll[1], ll[2], ll[3]};
        *(LAS v4u*)(lds + ((size_t)((ks * 2 + nt) * 2 + 0) * 64 + ln) * 16) = hi; *(LAS v4u*)(lds + ((size_t)((ks * 2 + nt) * 2 + 1) * 64 + ln) * 16) = lo; }
    __syncthreads();
    const float rb0 = rb[r], rb1 = rb[16 + r];
    auto lnrows = [&](size_t mrow, auto nrows_c) {
        constexpr int NR = decltype(nrows_c)::value;
        v4f x[NR][4];
#pragma unroll
        for (int u = 0; u < NR; ++u)
#pragma unroll
            for (int hb2 = 0; hb2 < 2; ++hb2) { const v4u q = *(const v4u*)(HB + (mrow + u) * D + 512 * hb2 + 8 * lane);
                x[u][2 * hb2] = (v4f){bflo(q.x), bfhi(q.x), bflo(q.y), bfhi(q.y)}; x[u][2 * hb2 + 1] = (v4f){bflo(q.z), bfhi(q.z), bflo(q.w), bfhi(q.w)}; }
#pragma unroll
        for (int u = 0; u < NR; ++u) { ln_row<true>(x[u], gg, bb, lane);
#pragma unroll
            for (int hb2 = 0; hb2 < 2; ++hb2) { const v4f p0 = x[u][2 * hb2], p1 = x[u][2 * hb2 + 1];
                *(v4u*)(HB + (mrow + u) * D + 512 * hb2 + 8 * lane) = (v4u){pk2(p0.x, p0.y), pk2(p0.z, p0.w), pk2(p1.x, p1.y), pk2(p1.z, p1.w)}; } }
    };
    auto ln2 = [&](size_t mrow) { lnrows(mrow, std::integral_constant<int, 2>{}); };
    auto route = [&](size_t m0) {
        pg8::f32x4 C0 = (pg8::f32x4){0.f, 0.f, 0.f, 0.f}, C1 = C0;
        const bf16* ah = HB + (m0 + r) * D + 8 * g;
#pragma unroll 4
        for (int ks = 0; ks < 32; ++ks) {
            const s8 xh = *(const s8*)(ah + 32 * ks);
            const LAS unsigned char* wf = lds + (size_t)(ks * 4) * 1024 + lane * 16;
            const s8 w0h = *(const LAS s8*)(wf), w0l = *(const LAS s8*)(wf + 1024), w1h = *(const LAS s8*)(wf + 2048), w1l = *(const LAS s8*)(wf + 3072);
            C0 = __builtin_amdgcn_mfma_f32_16x16x32_bf16(xh, w0h, C0, 0, 0, 0); C0 = __builtin_amdgcn_mfma_f32_16x16x32_bf16(xh, w0l, C0, 0, 0, 0);
            C1 = __builtin_amdgcn_mfma_f32_16x16x32_bf16(xh, w1h, C1, 0, 0, 0); C1 = __builtin_amdgcn_mfma_f32_16x16x32_bf16(xh, w1l, C1, 0, 0, 0);
        }
#pragma unroll
        for (int j = 0; j < 4; ++j) {
            float v0 = C0[j] + rb0, v1 = C1[j] + rb1;
            float tv[4]; int ti[4];
#pragma unroll
            for (int q = 0; q < 4; ++q) {
                const float mx = rowmax16(fmaxf(v0, v1));
                const int cand = (v0 == mx) ? r : ((v1 == mx) ? 16 + r : 64);
                const int bi = rowmin16i(cand);
                tv[q] = mx; ti[q] = bi;
                if (bi == r) v0 = -3.0e38f; if (bi == 16 + r) v1 = -3.0e38f;
            }
            const float e1 = __expf(tv[1] - tv[0]), e2 = __expf(tv[2] - tv[0]), e3 = __expf(tv[3] - tv[0]); const float inv = rcp_(1.f + e1 + e2 + e3);
            const size_t m = m0 + 4 * g + j;
            if (r == 0) { *(int4*)(TIDX + m * 4) = make_int4(ti[0], ti[1], ti[2], ti[3]); *(v4f*)(TGATE + m * 4) = (v4f){inv, e1 * inv, e2 * inv, e3 * inv}; }
            if (r < 4) lds_add(&hist[r == 0 ? ti[0] : r == 1 ? ti[1] : r == 2 ? ti[2] : ti[3]], 1);
        }
    };
    const int NT16 = T / 16, nfull = (NT16 / NGW) * NGW;
#pragma unroll 1
    for (int tile = gw; tile < nfull; tile += NGW) {
        const size_t m0 = (size_t)tile * 16;
#pragma unroll 1
        for (int t = 0; t < 16; t += 4) lnrows(m0 + t, std::integral_constant<int, 4>{});
        asm volatile("s_waitcnt vmcnt(0)" ::: "memory");
        route(m0);
    }
#pragma unroll 1
    for (int tile = nfull + vcu; tile < NT16; tile += G) {
        const size_t m0 = (size_t)tile * 16;
        ln2(m0 + 2 * wave);
        asm volatile("s_waitcnt vmcnt(0)" ::: "memory");
        __syncthreads();
        if (wave == 0) route(m0);
    }
    __syncthreads();
    if (tid < 32) atomicAdd(&ecnt[tid], (unsigned)hist[tid]);
}
__device__ __forceinline__ int build_tiles(const Ctx A, LAS unsigned char* lds, int l) {
    const int tid = opaque_tid();
    const unsigned* ecnt = (const unsigned*)(A.ws + WS_CTL) + CW_ECNT + 64 * l;
    LAS int* offs = (LAS int*)(lds + MISC_OFF + MI_OFFS); LAS int* tile_e = (LAS int*)(lds + MISC_OFF + MI_TILE); LAS int* nt = (LAS int*)(lds + MISC_OFF + MI_NT);
    __syncthreads();
    if (tid < 32) { int off = 0, mycnt = 0;
        for (int e = 0; e < 32; ++e) { const int c = (int)__hip_atomic_load(ecnt + e, __ATOMIC_RELAXED, __HIP_MEMORY_SCOPE_AGENT); if (e < tid) off += (c + 255) & ~255; if (e == tid) mycnt = c; }
        offs[tid] = off;
        const int t0 = off >> 8, t1 = (off + ((mycnt + 255) & ~255)) >> 8;
        for (int t = t0; t < t1; ++t) tile_e[t] = tid;
        if (tid == 31) nt[0] = t1; }
    __syncthreads();
    return nt[0];
}
__device__ PHASE_FN void moe_sort_phase(const Ctx A, LAS unsigned char* lds, int l) {
    const int tid = opaque_tid();
    const int* TIDX = (const int*)(A.ws + WS_TIDX); const float* TGATE = (const float*)(A.ws + WS_TGATE);
    int* SPOS = (int*)(A.ws + WS_SPOS); float* GSORT = (float*)(A.ws + WS_GSORT); int* RMAP = (int*)(A.ws + WS_RMAP);
    unsigned* ecur = (unsigned*)(A.ws + WS_CTL) + CW_ECUR + 64 * l; const unsigned* ecnt = (const unsigned*)(A.ws + WS_CTL) + CW_ECNT + 64 * l;
    LAS int* hist = (LAS int*)(lds + MISC_OFF + MI_HIST); LAS int* lcur = (LAS int*)(lds + MISC_OFF + MI_LCUR); LAS int* lbase = (LAS int*)(lds + MISC_OFF + MI_LBASE);
    LAS int* offs = (LAS int*)(lds + MISC_OFF + MI_OFFS);
    (void)build_tiles(A, lds, l);
    const int TPB = (T + (int)gridDim.x - 1) / (int)gridDim.x;
    const int mbeg = blockIdx.x * TPB, mend = (mbeg + TPB < T) ? mbeg + TPB : T;
    const int nslot = (mend > mbeg) ? (mend - mbeg) * 4 : 0;
    if (tid < 32) { hist[tid] = 0; lcur[tid] = 0; }
    __syncthreads();
    for (int s = tid; s < nslot; s += NTHR) lds_add(&hist[TIDX[(size_t)mbeg * 4 + s]], 1);
    __syncthreads();
    if (tid < 32) lbase[tid] = offs[tid] + (int)atomicAdd(&ecur[tid], (unsigned)hist[tid]);
    __syncthreads();
    for (int s = tid; s < nslot; s += NTHR) { const size_t gs = (size_t)mbeg * 4 + s; const int e = TIDX[gs];
        const int pos = lbase[e] + lds_add(&lcur[e], 1);
        SPOS[gs] = pos; GSORT[pos] = TGATE[gs]; RMAP[pos] = mbeg + (s >> 2); }
    if (blockIdx.x < 32) { const int e = blockIdx.x; const int c = (int)__hip_atomic_load(ecnt + e, __ATOMIC_RELAXED, __HIP_MEMORY_SCOPE_AGENT);
        const int p0 = offs[e] + c, p1 = offs[e] + ((c + 255) & ~255);
        for (int p = p0 + tid; p < p1; p += NTHR) RMAP[p] = 0; }
}
__device__ PHASE_FN void combine_ln_phase(const Ctx A, int l, int vcu, int G) {
    const int tid = opaque_tid(), lane = tid & 63, wave = tid >> 6;
    const int gw = vcu * NWAVES + wave, NGW = G * NWAVES;
    bf16* HB = (bf16*)(A.ws + WS_HB); const bf16* Y = (const bf16*)(A.ws + WS_YBUF); const int* SPOS = (const int*)(A.ws + WS_SPOS);
    const float* g = gin(A, 34) + l * D; const float* bb = gin(A, 35) + l * D;
#pragma unroll 1
    for (int m0 = 2 * gw; m0 < T; m0 += 2 * NGW) {
        v4f v[2][4];
#pragma unroll
        for (int t = 0; t < 2; ++t) { const int m = m0 + t;
            const int4 sp = *(const int4*)(SPOS + (size_t)m * 4);
#pragma unroll
            for (int j = 0; j < 4; ++j) { const size_t co = 256 * j + 4 * lane;
                const v4f y = ld_bf4(Y + (size_t)sp.x * D + co) + ld_bf4(Y + (size_t)sp.y * D + co) + ld_bf4(Y + (size_t)sp.z * D + co) + ld_bf4(Y + (size_t)sp.w * D + co);
                v[t][j] = ld_bf4(HB + (size_t)m * D + co) * ALPHA + y; } }
#pragma unroll
        for (int t = 0; t < 2; ++t) { const int m = m0 + t;
            ln_row(v[t], g, bb, lane);
            if (l == 0) {
#pragma unroll
                for (int j = 0; j < 4; ++j) st_bf4(HB + (size_t)m * D + 256 * j + 4 * lane, v[t][j]);
            } else {
                const int b = m / L, i = m - b * L;
                if (i >= NMETA) { float* o = (float*)(GAS float*)A.out + ((size_t)b * SEQ + (i - NMETA)) * D;
#pragma unroll
                    for (int j = 0; j < 4; ++j) *(v4f*)(o + 256 * j + 4 * lane) = v[t][j]; }
            }
        }
    }
}
constexpr int N_PHASES = 23;
#ifndef PH_ONLY
#define PH_ONLY -1
#endif
#define PHSEL(j) (PH_ONLY < 0 || PH_ONLY == (j))
#define IN(k) (lo <= (k) && (k) < hi)
#if MK_ONE_LAUNCH
#define GRID_BAR() xcd_barrier(bar)
#else
#define GRID_BAR() do { } while (0)
#endif
#define SEAM(k) do { if (IN(k) && IN((k) + 1)) GRID_BAR(); } while (0)
#define CTX() Ctx{args.in, args.out, launder(args.ws)}
#ifndef PROBE_PHASE
#define PROBE_PHASE -1
#endif
#ifndef PROBE_MULT
#define PROBE_MULT 4
#endif
#define PB_BEGIN(j) do { if (PROBE_PHASE == (j)) { pstamp = __builtin_amdgcn_s_memrealtime(); } } while (0)
#define PB_END(j) do { if (PROBE_PHASE == (j)) { pacc += __builtin_amdgcn_s_memrealtime() - pstamp; } } while (0)
__device__ __forceinline__ void layer_phases(const int l, const Args& args, LAS unsigned char* lds, const int G, const int bx, const int vcu, const int lo, const int hi, const XcdBarrier& bar, unsigned long long& pacc) {
    unsigned long long pstamp = 0ull; (void)pstamp;

        const int pb = 1 + 11 * l;
        PB_BEGIN(0);
        if (PHSEL(0) && IN(pb + 0)) { GAS unsigned char* wsl = launder(args.ws);
            pg8::Gemm g{(const pg8::bf16_t*)(wsl + WS_HB), (const pg8::bf16_t*)(wsl + WS_WIN) + (size_t)l * NINP * 1024, TP, NINP, 1024};
            pg8::StaticOrder S; S.init(TP, NINP, G, bx);
            pg8::EpiStoreBf16 E{(pg8::bf16_t*)(wsl + WS_PROJ), NINP};
            pg8::gemm_phase<pg8::EpiStoreBf16, pg8::StaticOrder, true, true>(lds, g, S, E);
            SEAM(pb + 0); PB_END(0);
        }
        PB_BEGIN(1);
        if (PHSEL(1) && IN(pb + 1)) { prep_phase(CTX(), lds, l, vcu, G); SEAM(pb + 1); PB_END(1); }
        PB_BEGIN(2);
        if (PHSEL(2) && IN(pb + 2)) { chunk_prep_phase(CTX(), vcu, G); lru_agg_phase(CTX(), vcu, G); SEAM(pb + 2); PB_END(2); }
        PB_BEGIN(3);
        if (PHSEL(3) && IN(pb + 3)) {
#ifndef PH2_SEL
#define PH2_SEL 15
#endif
            PB_BEGIN(20); PB_BEGIN(21); PB_BEGIN(22); PB_BEGIN(23);
#if SCAN_SEQ
            if ((PH2_SEL & 1) && bx < 64) rwkv_scan(CTX(), lds, bx); else if ((PH2_SEL & 2) && bx >= 64 && bx < 128) hgrn_scan(CTX(), lds, bx - 64); else if ((PH2_SEL & 4) && bx >= 128 && bx < 132) lru_carry_phase(CTX(), 128);
#else
            if ((PH2_SEL & 1) && bx < 16) chunk_scan<true>(CTX(), lds, bx); else if ((PH2_SEL & 2) && bx >= 16 && bx < 32) chunk_scan<false>(CTX(), lds, bx - 16); else if ((PH2_SEL & 4) && bx >= 32 && bx < 36) lru_carry_phase(CTX(), 32);
#endif
            __syncthreads();
            PB_END(20); PB_END(21); PB_END(22);
#if DSA_NAIVE
            if (PH2_SEL & 8) dsa_phase(CTX(), lds, l);
#else
            if (PH2_SEL & 8) dsa_select_phase(CTX(), lds, l);
#endif
            __syncthreads();
            PB_END(23);
            SEAM(pb + 3); PB_END(3);
        }
        PB_BEGIN(4);
        if (PHSEL(4) && IN(pb + 4)) {
            PB_BEGIN(24);
            lru_out_phase(CTX(), vcu, G);
            mixers_finish(CTX(), l, vcu, G);
            __syncthreads(); PB_END(24);
#if !DSA_NAIVE
            dsa_attn_phase(CTX(), lds, l);
#endif
            SEAM(pb + 4); PB_END(4);
        }
        PB_BEGIN(5);
        if (PHSEL(5) && IN(pb + 5)) { GAS unsigned char* wsl = launder(args.ws);
            pg8::Gemm g{(const pg8::bf16_t*)(wsl + WS_MIX), (const pg8::bf16_t*)(wsl + WS_WOUT) + (size_t)l * 1024 * 1024, TP, 1024, 1024};
            pg8::StaticOrder S; S.init(TP, 1024, G, bx);
            pg8::EpiResidBf E{(pg8::bf16_t*)(wsl + WS_HB), 1024, ALPHA};
            pg8::gemm_phase<pg8::EpiResidBf, pg8::StaticOrder, true, true>(lds, g, S, E);
            SEAM(pb + 5); PB_END(5);
        }
        PB_BEGIN(6);
        if (PHSEL(6) && IN(pb + 6)) { ln_router_phase(CTX(), lds, l, vcu, G); SEAM(pb + 6); PB_END(6); }
        PB_BEGIN(7);
        if (PHSEL(7) && IN(pb + 7)) { moe_sort_phase(CTX(), lds, l); SEAM(pb + 7); PB_END(7); }
        PB_BEGIN(8);
        if (PHSEL(8) && IN(pb + 8)) { GAS unsigned char* wsl = launder(args.ws);
            const int nt = build_tiles(CTX(), lds, l);
            pg8::Gemm g{(const pg8::bf16_t*)(wsl + WS_HB), (const pg8::bf16_t*)(wsl + WS_W1) + (size_t)l * 32 * 2048 * 1024, RMAX, 32 * 2048, 1024};
            pg8::MoeOrder S{nt * 8, G, vcu, 8, (const LAS int*)(lds + MISC_OFF + MI_TILE)};
            pg8::EpiSwiGLU E{(pg8::bf16_t*)(wsl + WS_ACT), (const float*)(const GAS float*)args.in[31] + (size_t)l * 32 * 2048};
            pg8::gemm_phase_gather<pg8::EpiSwiGLU, pg8::MoeOrder>(lds, g, S, E, (const int*)(wsl + WS_RMAP));
            SEAM(pb + 8); PB_END(8);
        }
        PB_BEGIN(9);
        if (PHSEL(9) && IN(pb + 9)) { GAS unsigned char* wsl = launder(args.ws);
            const int nt = build_tiles(CTX(), lds, l);
            pg8::Gemm g{(const pg8::bf16_t*)(wsl + WS_ACT), (const pg8::bf16_t*)(wsl + WS_W2) + (size_t)l * 32 * 1024 * 1024, RMAX, 32 * 1024, 1024};
            pg8::MoeOrder S{nt * 4, G, vcu, 4, (const LAS int*)(lds + MISC_OFF + MI_TILE)};
            pg8::EpiMoeOut E{(pg8::bf16_t*)(wsl + WS_YBUF), (const float*)(const GAS float*)args.in[33] + (size_t)l * 32 * 1024, (const float*)(wsl + WS_GSORT)};
            pg8::gemm_phase<pg8::EpiMoeOut, pg8::MoeOrder, true, true>(lds, g, S, E);
            SEAM(pb + 9); PB_END(9);
        }
        PB_BEGIN(10);
        if (PHSEL(10) && IN(pb + 10)) { combine_ln_phase(CTX(), l, vcu, G); SEAM(pb + 10); PB_END(10); }
}
__global__ void __launch_bounds__(NTHR, 2) trunk_fwd(Args args) {
    extern __shared__ __attribute__((aligned(16))) unsigned char lds_raw[];
    LAS unsigned char* lds = (LAS unsigned char*)lds_raw;
    const int tid = threadIdx.x;
    const int G = gridDim.x; const int bx = blockIdx.x; const int vcu = (G % 8 == 0) ? (bx % 8) * (G / 8) + bx / 8 : bx;
    unsigned* ctl = (unsigned*)(args.ws + WS_CTL);
    for (int u = tid; u < (LDS_BYTES - MISC_OFF) / 4; u += NTHR) ((LAS unsigned*)(lds + MISC_OFF))[u] = 0u;
    __syncthreads();
#if MK_ONE_LAUNCH
    XcdBarrier bar = xcd_barrier_post(ctl + CW_BAR, (volatile LAS unsigned*)(lds + MISC_OFF + MI_BAR));
#else
    XcdBarrier bar; bar.bar = ctl + CW_BAR; bar.x = 0; bar.st = nullptr;
#endif
    const int lo = args.ph_lo, hi = args.ph_hi;

    unsigned long long pacc = 0ull, pstamp = 0ull; (void)pstamp;
    PB_BEGIN(11);
    if (PHSEL(11) && IN(0)) { p0_prologue(CTX(), lds, vcu, G); SEAM(0); }
    PB_END(11);

#pragma unroll 1
    for (int l = 0; l < 2; ++l) layer_phases(l, args, lds, G, bx, vcu, lo, hi, bar, pacc);
    if (PROBE_PHASE >= 0 && bx == (PROBE_PHASE == 21 ? 16 : PROBE_PHASE == 22 ? 32 : PROBE_PHASE == 23 ? 255 : 0)) { const unsigned long long t0 = __builtin_amdgcn_s_memrealtime(); while (__builtin_amdgcn_s_memrealtime() - t0 < pacc * PROBE_MULT) __builtin_amdgcn_s_sleep(8); }
#undef IN
#undef SEAM
}

extern "C" void kernel_launch(void* const* d_in, const int* in_sizes, int n_in, void* d_out, int out_size, void* d_ws, size_t ws_size, hipStream_t stream) {
    static int grid = 0;
    if (grid == 0) {
        if (n_in != 36 || in_sizes[0] != NB * SEQ * D || out_size != NB * SEQ * D || ws_size < WS_END) {
            fprintf(stderr, "kernel_launch: unexpected problem (n_in %d, in0 %d, out %d, ws %zu, need %zu); nothing launched\n", n_in, n_in > 0 ? in_sizes[0] : -1, out_size, ws_size, (size_t)WS_END); grid = -1; return; }
        int dev = 0, cus = 0, per_cu = 0;
        if (hipGetDevice(&dev) != hipSuccess || hipDeviceGetAttribute(&cus, hipDeviceAttributeMultiprocessorCount, dev) != hipSuccess) { grid = -1; return; }
        if (hipFuncSetAttribute((const void*)trunk_fwd, hipFuncAttributeMaxDynamicSharedMemorySize, LDS_BYTES) != hipSuccess) { fprintf(stderr, "kernel_launch: hipFuncSetAttribute failed\n"); grid = -1; return; }
        if (hipOccupancyMaxActiveBlocksPerMultiprocessor(&per_cu, (const void*)trunk_fwd, NTHR, LDS_BYTES) != hipSuccess || per_cu < 1) { fprintf(stderr, "kernel_launch: occupancy query says %d\n", per_cu); (void)hipGetLastError(); }
        grid = cus;
        if (grid < 160 || grid > 512) { fprintf(stderr, "kernel_launch: unsupported CU count %d\n", cus); grid = -1; return; }
    }
    if (grid < 0) return;
    if (hipMemsetAsync((char*)d_ws + WS_CTL, 0, CTL_ZERO_BYTES, stream) != hipSuccess) return;
    Args a; memset(&a, 0, sizeof(a));
    for (int i = 0; i < 36; ++i) a.in[i] = (const float*)d_in[i];
    a.out = (float*)d_out; a.ws = (unsigned char*)d_ws;
#if MK_ONE_LAUNCH
    a.ph_lo = 0; a.ph_hi = N_PHASES;
    hipLaunchKernelGGL(trunk_fwd, dim3(grid), dim3(NTHR), LDS_BYTES, stream, a);
#else
    for (int p = 0; p < N_PHASES; ++p) { a.ph_lo = p; a.ph_hi = p + 1; hipLaunchKernelGGL(trunk_fwd, dim3(grid), dim3(NTHR), LDS_BYTES, stream, a); }
#endif
}
```
